# Optimizing an MI355X kernel written in HIP

```python
import math
import jax, jax.numpy as jnp
from jax import lax
import numpy as np

D_MODEL = 1024
BATCH = 32
SEQ = 2048
DEPTH = 2

CTX_LEN = 256
GRID_W = 64
EPS = 1e-6

ATT_HEADS = 4
ATT_QK_DIM = 64
ATT_V_DIM = 2 * ATT_QK_DIM
ATT_WIDTH = ATT_HEADS * ATT_V_DIM
Q_BLOCK = 128
ROPE_THETA = 10000.0

REC_HEADS = 4
REC_DK = 128
REC_DV = 128
REC_KEY_WIDTH = REC_HEADS * REC_DK
REC_WIDTH = REC_HEADS * REC_DV
CHUNK = 64

D_FF = 2752
N_EXPERTS = 8
TOP_K = 2
D_FF_EXPERT = 3584
N_DENSE = (DEPTH + 1) // 2
N_MOE = DEPTH // 2

IN_SIZES = [ATT_HEADS * 2 * ATT_QK_DIM,
            ATT_HEADS * 2 * ATT_QK_DIM,
            ATT_WIDTH,
            REC_KEY_WIDTH,
            REC_WIDTH,
            REC_KEY_WIDTH,
            REC_KEY_WIDTH,
            REC_WIDTH,
            D_MODEL,
            D_MODEL]
D_IN = sum(IN_SIZES)
IN_SPLIT_POINTS = [int(v) for v in np.cumsum(IN_SIZES)[:-1]]

kernel_name = 'hybrid_diffattn_hgrn2_moe_dit'


def _rmsnorm(x, w):
    x32 = x.astype(jnp.float32)
    y = x32 * lax.rsqrt(jnp.mean(x32 * x32, axis=-1, keepdims=True) + EPS)
    return y.astype(x.dtype) * w


def _modulate(h, shift, scale):
    return h * (1 + scale) + shift


def _heads(a, dh):
    b, t, _ = a.shape
    return a.reshape(b, t, -1, dh).transpose(0, 2, 1, 3)


def _merge_heads(a):
    b, h, t, dh = a.shape
    return a.transpose(0, 2, 1, 3).reshape(b, t, h * dh)


def _rope_2d(rows):
    row = jnp.repeat(jnp.arange(rows, dtype=jnp.float32), GRID_W)
    col = jnp.tile(jnp.arange(GRID_W, dtype=jnp.float32), rows)
    n_freq = ATT_QK_DIM // 4
    inv_freq = ROPE_THETA ** (-jnp.arange(n_freq, dtype=jnp.float32) / n_freq)
    ang = jnp.concatenate([row[:, None] * inv_freq, col[:, None] * inv_freq], axis=-1)
    return jnp.cos(ang), jnp.sin(ang)


def _apply_rope(x, cos, sin):
    half = x.shape[-1] // 2
    cos = cos.astype(x.dtype)
    sin = sin.astype(x.dtype)
    xa, xb = x[..., :half], x[..., half:]
    return jnp.concatenate([xa * cos - xb * sin, xa * sin + xb * cos], axis=-1)


def _diff_attend(q, k, v, lam, scale):
    s = jnp.einsum('bhcqd,bhckd->bhcqk', q, k).astype(jnp.float32) * scale
    p = jax.nn.softmax(s, axis=-1)
    a = p[:, :, 0] - lam * p[:, :, 1]
    return jnp.einsum('bhqk,bhkd->bhqd', a.astype(v.dtype), v)


def _diff_attend_blocked(q, k, v, lam, scale):
    b, h, _, t, dq = q.shape
    nb = t // Q_BLOCK
    qb = jnp.moveaxis(q.reshape(b, h, 2, nb, Q_BLOCK, dq), 3, 0)
    out = lax.map(lambda qi: _diff_attend(qi, k, v, lam, scale), qb)
    return jnp.moveaxis(out, 0, 2).reshape(b, h, t, v.shape[-1])


def _log_forget(z, lb):
    z32 = z.astype(jnp.float32)
    lb32 = lb.astype(jnp.float32)
    return jnp.logaddexp(jnp.log(lb32), jnp.log1p(-lb32) + jax.nn.log_sigmoid(z32))


def _gla_scan(q, k, v, logf, s0):
    b, h, t, _ = q.shape
    dv = v.shape[-1]
    n = t // CHUNK

    def chunks(a):
        return jnp.moveaxis(a.astype(jnp.float32).reshape(b, h, n, CHUNK, a.shape[-1]), 2, 0)

    lower = jnp.tril(jnp.ones((CHUNK, CHUNK), dtype=bool))[:, :, None]

    def step(state, inp):
        qc, kc, vc, lfc = inp
        cum = jnp.cumsum(lfc, axis=2)
        rel = jnp.where(lower, cum[:, :, :, None, :] - cum[:, :, None, :, :], -jnp.inf)
        scores = jnp.einsum('bhtd,bhsd,bhtsd->bhts', qc, kc, jnp.exp(rel))
        o = (jnp.einsum('bhts,bhsv->bhtv', scores, vc)
             + jnp.einsum('bhtd,bhdv->bhtv', qc * jnp.exp(cum), state))
        last = cum[:, :, -1:, :]
        new_state = (jnp.exp(last[:, :, 0, :])[..., None] * state
                     + jnp.einsum('bhsd,bhsv->bhdv', kc * jnp.exp(last - cum), vc))
        return new_state, o

    s_fin, o = lax.scan(step, s0, (chunks(q), chunks(k), chunks(v), chunks(logf)))
    return jnp.moveaxis(o, 0, 2).reshape(b, h, t, dv), s_fin


def _layer_lower_bounds(lb_param):
    cs = jnp.cumsum(jax.nn.softmax(lb_param.astype(jnp.float32), axis=0), axis=0)
    return cs - cs[0:1]


def _mixer(h_lat, h_ctx, w_in, lq1, lk1, lq2, lk2, att_norm_w, rec_norm_w, lb_f, lb_b,
           w_up_att, w_up_rec, w_out, lam_init, cos, sin, need_ctx):
    dt = h_lat.dtype
    p_lat = jnp.split(h_lat @ w_in, IN_SPLIT_POINTS, axis=-1)
    p_ctx = jnp.split(h_ctx @ w_in, IN_SPLIT_POINTS, axis=-1)

    lam = (jnp.exp(jnp.sum(lq1.astype(jnp.float32) * lk1.astype(jnp.float32)))
           - jnp.exp(jnp.sum(lq2.astype(jnp.float32) * lk2.astype(jnp.float32))) + lam_init)
    scale = ATT_QK_DIM ** -0.5

    def att_qkv(parts):
        b, t, _ = parts[0].shape
        q = parts[0].reshape(b, t, ATT_HEADS, 2, ATT_QK_DIM).transpose(0, 2, 3, 1, 4)
        k = parts[1].reshape(b, t, ATT_HEADS, 2, ATT_QK_DIM).transpose(0, 2, 3, 1, 4)
        v = _heads(parts[2], ATT_V_DIM)
        return q, k, v

    q_c, k_c, v_c = att_qkv(p_ctx)
    q_l, k_l, v_l = att_qkv(p_lat)
    q_l = _apply_rope(q_l, cos, sin)
    k_l = _apply_rope(k_l, cos, sin)
    k_all = jnp.concatenate([k_c, k_l], axis=3)
    v_all = jnp.concatenate([v_c, v_l], axis=2)
    o_att_l = _diff_attend_blocked(q_l, k_all, v_all, lam, scale)

    def att_out(o):
        return _merge_heads(_rmsnorm(o, att_norm_w) * (1 - lam_init))

    def rec_inputs(parts):
        q = _heads(jax.nn.silu(parts[3]), REC_DK)
        v = _heads(parts[4], REC_DV)
        lf_f = _heads(_log_forget(parts[5], lb_f), REC_DK)
        lf_b = _heads(_log_forget(parts[6], lb_b), REC_DK)
        return q, v, lf_f, lf_b

    def flip(a):
        return jnp.flip(a, axis=2)

    qr_c, vr_c, lf_cf, lf_cb = rec_inputs(p_ctx)
    qr_l, vr_l, lf_lf, lf_lb = rec_inputs(p_lat)
    b = h_lat.shape[0]
    s0 = jnp.zeros((b, REC_HEADS, REC_DK, REC_DV), jnp.float32)
    o_cf, s_cf = _gla_scan(qr_c, -jnp.expm1(lf_cf), vr_c, lf_cf, s0)
    o_cb, s_cb = _gla_scan(flip(qr_c), flip(-jnp.expm1(lf_cb)), flip(vr_c), flip(lf_cb), s0)
    o_lf, _ = _gla_scan(qr_l, -jnp.expm1(lf_lf), vr_l, lf_lf, s_cf)
    o_lb, _ = _gla_scan(flip(qr_l), flip(-jnp.expm1(lf_lb)), flip(vr_l), flip(lf_lb), s_cb)
    o_rec_l = o_lf + flip(o_lb)

    def rec_out(o, g):
        return _merge_heads(_rmsnorm(o.astype(dt), rec_norm_w)) * jax.nn.silu(g)

    def merge(y_att, y_rec, parts):
        g_att = jax.nn.sigmoid(parts[8])
        g_rec = jax.nn.sigmoid(parts[9])
        return (g_att * (y_att @ w_up_att) + g_rec * (y_rec @ w_up_rec)) @ w_out

    y_lat = merge(att_out(o_att_l), rec_out(o_rec_l, p_lat[7]), p_lat)
    y_ctx = None
    if need_ctx:
        o_att_c = _diff_attend(q_c, k_c, v_c, lam, scale)
        y_ctx = merge(att_out(o_att_c), rec_out(o_cf + flip(o_cb), p_ctx[7]), p_ctx)
    return y_lat, y_ctx


def _swiglu(h, w1, w3, w2):
    return (jax.nn.silu(h @ w1) * (h @ w3)) @ w2


def _moe(h, w_router, w1, w3, w2):
    logits = (h @ w_router).astype(jnp.float32)
    vals, idx = lax.top_k(logits, TOP_K)
    wts = jax.nn.softmax(vals, axis=-1)
    gates = jnp.sum(jax.nn.one_hot(idx, N_EXPERTS, dtype=jnp.float32) * wts[..., None], axis=-2).astype(h.dtype)
    out = jnp.zeros_like(h)
    for e in range(N_EXPERTS):
        out = out + gates[..., e:e + 1] * _swiglu(h, w1[e], w3[e], w2[e])
    return out


def setup_inputs(seed: int = 0) -> dict:
    key = jax.random.key(seed)
    ks = iter(jax.random.split(key, 40))

    def nrm(shape, scale):
        return jax.random.normal(next(ks), shape, jnp.float32) * scale

    def gain(shape):
        return 1.0 + nrm(shape, 0.05)

    D = D_MODEL
    return {
        'x': nrm((BATCH, SEQ, D), 1.0),
        'c': nrm((BATCH, D), 1.0),
        'ctx': nrm((BATCH, CTX_LEN, D), 1.0),
        'c_ctx': nrm((D,), 1.0),
        'w_ada': nrm((DEPTH, D, 6 * D), 0.5 * D ** -0.5),
        'b_ada': nrm((DEPTH, 6 * D), 0.02),
        'norm_mix_w': gain((DEPTH, D)),
        'norm_ffn_w': gain((DEPTH, D)),
        'w_in': nrm((DEPTH, D, D_IN), D ** -0.5),
        'lambda_q1': nrm((DEPTH, ATT_QK_DIM), 0.1),
        'lambda_k1': nrm((DEPTH, ATT_QK_DIM), 0.1),
        'lambda_q2': nrm((DEPTH, ATT_QK_DIM), 0.1),
        'lambda_k2': nrm((DEPTH, ATT_QK_DIM), 0.1),
        'att_norm_w': gain((DEPTH, ATT_V_DIM)),
        'rec_norm_w': gain((DEPTH, REC_DV)),
        'lb_fwd': 1.0 + nrm((DEPTH, REC_KEY_WIDTH), 0.5),
        'lb_bwd': 1.0 + nrm((DEPTH, REC_KEY_WIDTH), 0.5),
        'w_up_att': nrm((DEPTH, ATT_WIDTH, D), ATT_WIDTH ** -0.5),
        'w_up_rec': nrm((DEPTH, REC_WIDTH, D), REC_WIDTH ** -0.5),
        'w_out': nrm((DEPTH, D, D), D ** -0.5),
        'ffn_w1': nrm((N_DENSE, D, D_FF), D ** -0.5),
        'ffn_w3': nrm((N_DENSE, D, D_FF), D ** -0.5),
        'ffn_w2': nrm((N_DENSE, D_FF, D), D_FF ** -0.5),
        'router_w': nrm((N_MOE, D, N_EXPERTS), D ** -0.5),
        'moe_w1': nrm((N_MOE, N_EXPERTS, D, D_FF_EXPERT), D ** -0.5),
        'moe_w3': nrm((N_MOE, N_EXPERTS, D, D_FF_EXPERT), D ** -0.5),
        'moe_w2': nrm((N_MOE, N_EXPERTS, D_FF_EXPERT, D), D_FF_EXPERT ** -0.5),
        'final_norm_w': gain((D,)),
    }


def reference(x, c, ctx, c_ctx, w_ada, b_ada, norm_mix_w, norm_ffn_w, w_in,
              lambda_q1, lambda_k1, lambda_q2, lambda_k2, att_norm_w, rec_norm_w,
              lb_fwd, lb_bwd, w_up_att, w_up_rec, w_out, ffn_w1, ffn_w3, ffn_w2,
              router_w, moe_w1, moe_w3, moe_w2, final_norm_w):
    rows = x.shape[1] // GRID_W
    cos, sin = _rope_2d(rows)
    lbs_f = _layer_lower_bounds(lb_fwd)
    lbs_b = _layer_lower_bounds(lb_bwd)
    silu_c = jax.nn.silu(c)
    silu_cc = jax.nn.silu(c_ctx)

    for l in range(DEPTH):
        last = l == DEPTH - 1
        mod_l = [m[:, None, :] for m in jnp.split(silu_c @ w_ada[l] + b_ada[l], 6, axis=-1)]
        mod_c = jnp.split(silu_cc @ w_ada[l] + b_ada[l], 6, axis=-1)
        lam_init = 0.8 - 0.6 * math.exp(-0.3 * l)

        h_l = _modulate(_rmsnorm(x, norm_mix_w[l]), mod_l[0], mod_l[1])
        h_c = _modulate(_rmsnorm(ctx, norm_mix_w[l]), mod_c[0], mod_c[1])
        y_l, y_c = _mixer(h_l, h_c, w_in[l], lambda_q1[l], lambda_k1[l], lambda_q2[l], lambda_k2[l],
                          att_norm_w[l], rec_norm_w[l], lbs_f[l], lbs_b[l],
                          w_up_att[l], w_up_rec[l], w_out[l], lam_init, cos, sin, not last)
        x = x + mod_l[2] * y_l
        if not last:
            ctx = ctx + mod_c[2] * y_c

        if l % 2 == 0:
            j = l // 2
            ffn = lambda h, j=j: _swiglu(h, ffn_w1[j], ffn_w3[j], ffn_w2[j])
        else:
            j = l // 2
            ffn = lambda h, j=j: _moe(h, router_w[j], moe_w1[j], moe_w3[j], moe_w2[j])
        x = x + mod_l[5] * ffn(_modulate(_rmsnorm(x, norm_ffn_w[l]), mod_l[3], mod_l[4]))
        if not last:
            ctx = ctx + mod_c[5] * ffn(_modulate(_rmsnorm(ctx, norm_ffn_w[l]), mod_c[3], mod_c[4]))

    return _rmsnorm(x, final_norm_w)
```

```cpp
#include <hip/hip_runtime.h>
#include <cstdio>
#include <cstdint>

#ifndef DBG
#define DBG 0
#endif

constexpr int D = 1024, NB = 32, T = 2048, CL = 256;
constexpr int NLAT = NB * T, NCTX = NB * CL, NTOK = NLAT + NCTX;
constexpr int PW = 4096;
constexpr int DIN = 6144, DFF = 2752, DFFP = 2816, DFE = 3584, NE = 8;
constexpr float EPS = 1e-6f;
constexpr float LOG2E = 1.4426950408889634f;
constexpr float QSCALE = 0.125f * LOG2E;
constexpr int PC_Q = 0, PC_G = 512, PC_LF = 1024, PC_LB = 1536, PC_K = 2048, PC_V = 2560, PC_RQ = 3072, PC_RI = 3584, PC_GA = 2048, PC_GR = 3072;

constexpr size_t MiB = 1u << 20;
constexpr size_t WS_CTL = 0, CTL_BYTES = 1 * MiB;
constexpr size_t WS_MODS = 1 * MiB;
constexpr size_t WS_LBS = 3 * MiB;
constexpr size_t WS_ROPE = 3 * MiB + 65536;
constexpr size_t WS_ROUTE = 4 * MiB;
constexpr size_t WS_CNT = 6 * MiB;
constexpr size_t WS_DBG = 7 * MiB;
constexpr size_t WS_CTXRES = 8 * MiB;
constexpr size_t WS_WIN = 40 * MiB;
constexpr size_t WS_WUA = 64 * MiB;
constexpr size_t WS_WUR = 66 * MiB;
constexpr size_t WS_WO = 68 * MiB;
constexpr size_t WS_W13 = 72 * MiB;
constexpr size_t WS_W2 = 83 * MiB;
constexpr size_t WS_H = 89 * MiB;
constexpr size_t WS_P = 233 * MiB;
constexpr size_t WS_MERGED = 809 * MiB;
constexpr size_t WS_HID = 233 * MiB;
constexpr size_t WS_WM13 = 8 * MiB;
constexpr size_t WS_WM2 = 120 * MiB;
constexpr size_t WS_AG = 176 * MiB;
constexpr size_t WS_MHID = 436 * MiB;
constexpr size_t WS_Y = 674 * MiB;
constexpr size_t WS_H2M = 896 * MiB;
constexpr size_t WS_END = 1024 * MiB;
constexpr int MOE_CHUNK = 128;

constexpr int CW_BAR = 4096;

#define LAS __attribute__((address_space(3)))
#define GAS __attribute__((address_space(1)))
typedef unsigned short bf16_t;
typedef short bf16x8 __attribute__((ext_vector_type(8)));
typedef short s16x4 __attribute__((ext_vector_type(4)));
typedef _Float16 half8 __attribute__((ext_vector_type(8)));
typedef _Float16 half4 __attribute__((ext_vector_type(4)));
typedef float f32x4 __attribute__((ext_vector_type(4)));
typedef float f32x2 __attribute__((ext_vector_type(2)));
typedef float f32x16 __attribute__((ext_vector_type(16)));
typedef unsigned u32x4 __attribute__((ext_vector_type(4)));
typedef unsigned u32x2 __attribute__((ext_vector_type(2)));
#define DI __device__ __forceinline__
#define LDS_WAIT() asm volatile("s_waitcnt lgkmcnt(0)" ::: "memory")
#define VM_WAIT() asm volatile("s_waitcnt vmcnt(0)" ::: "memory")

typedef __bf16 bf16x2_t __attribute__((ext_vector_type(2)));
DI unsigned cvt_pk_bf16(float lo, float hi) { f32x2 v = {lo, hi}; bf16x2_t b = __builtin_convertvector(v, bf16x2_t); return __builtin_bit_cast(unsigned, b); }
DI float bf2f(unsigned short b) { return __uint_as_float(((unsigned)b) << 16); }
DI float bflo(unsigned w) { return __uint_as_float(w << 16); }
DI float bfhi(unsigned w) { return __uint_as_float(w & 0xffff0000u); }
DI float fsilu(float x) { return x * __builtin_amdgcn_rcpf(1.f + __expf(-x)); }
DI float fsigmoid(float x) { return __builtin_amdgcn_rcpf(1.f + __expf(-x)); }
DI float wave_sum(float v) {
#pragma unroll
    for (int o = 1; o < 64; o <<= 1) v += __shfl_xor(v, o);
    return v;
}
DI int crow(int r, int hi) { return (r & 3) + 8 * (r >> 2) + 4 * hi; }

#define XB_TMO      128
#define XB_XCNT(j)  (256  + 64 * (j))
#define XB_XSUB(j)  (1280 + 64 * (j))
#define XB_XGEN(j)  (2304 + 64 * (j))
#define XB_TOP      3328
#define XB_TOPGEN   3392
#define XCD_BAR_WORDS 3456
#define XB_SPIN_CAP (1u << 22)
DI unsigned xb_ld(unsigned* p)              { return __hip_atomic_load(p, __ATOMIC_RELAXED, __HIP_MEMORY_SCOPE_AGENT); }
DI unsigned xb_add(unsigned* p, unsigned v) { return __hip_atomic_fetch_add(p, v, __ATOMIC_RELAXED, __HIP_MEMORY_SCOPE_AGENT); }
DI unsigned xb_xcc_id() { return (unsigned)__builtin_amdgcn_s_getreg((3 << 11) | 20) & 0xFu; }
#define XB_SPIN(cond, bar) do { unsigned _sp = 0; while (cond) { __builtin_amdgcn_s_sleep(1); \
    if ((++_sp & 255u) == 0u) { if (xb_ld(&(bar)[XB_TMO])) break; if (_sp > XB_SPIN_CAP) { atomicAdd(&(bar)[XB_TMO], 1u); break; } } } } while (0)
struct XcdBarrier { unsigned* bar; unsigned x; volatile LAS unsigned* st; };
DI XcdBarrier xcd_barrier_post(unsigned* bar, volatile LAS unsigned* st) {
    XcdBarrier b; b.bar = bar; b.x = xb_xcc_id(); b.st = st;
    if (threadIdx.x == 0) (void)xb_add(&bar[XB_XCNT(b.x)], 1u);
    return b;
}
DI void xcd_barrier_complete(unsigned* bar, unsigned x, unsigned& nloc, unsigned& nx) {
    const unsigned G = gridDim.x * gridDim.y * gridDim.z;
    unsigned sum, cnt, mine, sp = 0u;
    for (;;) {
        sum = 0u; cnt = 0u; mine = 0u;
#pragma unroll
        for (unsigned j = 0; j < 16; ++j) { const unsigned c = xb_ld(&bar[XB_XCNT(j)]); sum += c; cnt += (c > 0u) ? 1u : 0u; mine = (j == x) ? c : mine; }
        if (sum == G) break;
        __builtin_amdgcn_s_sleep(1);
        if ((++sp & 255u) == 0u) { if (xb_ld(&bar[XB_TMO])) break; if (sp > XB_SPIN_CAP) { atomicAdd(&bar[XB_TMO], 1u); break; } }
    }
    nloc = mine > 0u ? mine : 1u; nx = cnt > 0u ? cnt : 1u;
}
DI void xcd_barrier(const XcdBarrier& b) {
    asm volatile("s_waitcnt vmcnt(0)" ::: "memory");
    __syncthreads();
    if (threadIdx.x == 0) {
        unsigned* bar = b.bar;
        __builtin_amdgcn_s_waitcnt(0);
        unsigned nloc = b.st[0], nx = b.st[1];
        if (nloc == 0u) { xcd_barrier_complete(bar, b.x, nloc, nx); b.st[0] = nloc; b.st[1] = nx; }
        const unsigned old = xb_add(&bar[XB_XSUB(b.x)], 1u);
        const unsigned gen = old / nloc;
        if (old + 1u == (gen + 1u) * nloc) {
            __builtin_amdgcn_fence(__ATOMIC_RELEASE, "agent");
            asm volatile("s_waitcnt vmcnt(0)" ::: "memory");
            const unsigned og = xb_add(&bar[XB_TOP], 1u);
            const unsigned tg = og / nx;
            if (og + 1u == (tg + 1u) * nx) xb_add(&bar[XB_TOPGEN], 1u);
            else XB_SPIN(xb_ld(&bar[XB_TOPGEN]) == tg, bar);
            __builtin_amdgcn_fence(__ATOMIC_ACQUIRE, "agent");
            xb_add(&bar[XB_XGEN(b.x)], 1u);
            asm volatile("s_waitcnt vmcnt(0)" ::: "memory");
        } else {
            XB_SPIN(xb_ld(&bar[XB_XGEN(b.x)]) == gen, bar);
            __builtin_amdgcn_fence(__ATOMIC_ACQUIRE, "agent");
            asm volatile("s_waitcnt vmcnt(0)" ::: "memory");
        }
    }
    __syncthreads();
}

namespace pg8 {
constexpr int BM = 256, BK = 64, HALF = 128, HTB = HALF * BK * 2, STAGE_BYTES = 8 * HTB, NXCD = 8, WGM = 8;
__host__ __device__ __forceinline__ int lds_byte(int r, int c) { const int st = (r >> 4) * 2 + (c >> 5), rr = r & 15, cc = c & 31, ob = rr * 64 + cc * 2; return st * 1024 + (ob ^ (((ob >> 9) & 1) << 5)); }
__host__ __device__ __forceinline__ void stage_rc(int b, int& R, int& C) { const int st = b / 1024, sb = b % 1024, swz = sb ^ (((sb >> 9) & 1) << 5); R = (st >> 1) * 16 + swz / 64; C = (st & 1) * 32 + (swz % 64) / 2; }
__host__ __device__ __forceinline__ int perm32(int rho) { const int n = rho >> 4, i = rho & 15; return 8 * (i >> 2) + 4 * n + (i & 3); }

struct Unit { int pm, pn; const char* a; const char* b; };
struct Gemm { const bf16_t* A; const bf16_t* Bt; int M, N, K, lda; };

struct StaticOrder {
    int nM, nN, nwg, G, c; const char* A; const char* B; size_t tsa, tsb;
    DI void init(const Gemm& g, int G_, int c_) { nM = g.M / BM; nN = g.N / BM; nwg = nM * nN; G = G_; c = c_; A = (const char*)g.A; B = (const char*)g.Bt; tsa = (size_t)BM * g.lda * 2; tsb = (size_t)BM * g.K * 2; }
    DI bool tile(int i, int& pm, int& pn) const {
        const long L = (long)i * G + c; if (L >= nwg) return false;
        int wgid = (int)L; { const int q = nwg / NXCD, r = nwg % NXCD, xcd = wgid % NXCD, off = wgid / NXCD; wgid = (xcd < r ? xcd * (q + 1) : r * (q + 1) + (xcd - r) * q) + off; }
        const int nig = WGM * nN, gid = wgid / nig, fm = gid * WGM, gsz = (nM - fm) < WGM ? (nM - fm) : WGM;
        pm = fm + ((wgid % nig) % gsz); pn = (wgid % nig) / gsz; return true;
    }
    DI bool next(int i, Unit& u) const { if (!tile(i, u.pm, u.pn)) return false; u.a = A + (size_t)u.pm * tsa; u.b = B + (size_t)u.pn * tsb; return true; }
};
struct MoeOrder {
    StaticOrder so; int p0, apan0; int pb1, pb2, pb3, pb4, pb5, pb6, pb7; size_t estride;
    DI int expert_of(int p) const { return (p >= pb1) + (p >= pb2) + (p >= pb3) + (p >= pb4) + (p >= pb5) + (p >= pb6) + (p >= pb7); }
    DI bool next(int i, Unit& u) const {
        int pm, pn; if (!so.tile(i, pm, pn)) return false;
        u.pm = p0 + pm; u.pn = pn; u.a = so.A + (size_t)(u.pm - apan0) * so.tsa; u.b = so.B + (size_t)expert_of(u.pm) * estride + (size_t)pn * so.tsb; return true;
    }
};

template <class Epi, class Sched, bool ALIGN_EPI = true>
DI void gemm_phase(LAS unsigned char* lds, const Gemm g, const Sched& S, const Epi& E) {
    int tid_ = threadIdx.x; asm volatile("" : "+v"(tid_));
    const int tid = tid_, wid = __builtin_amdgcn_readfirstlane(tid >> 6), lane = tid & 63, wr = wid >> 2, wc = wid & 3, fr = lane & 15, fq = lane >> 4;
    const int K = g.K, nt = K / BK;
    unsigned voffA[2], voffB[2];
#pragma unroll
    for (int i = 0; i < 2; ++i) { int R, C; stage_rc(tid * 16 + i * 8192, R, C); const int Rb = Epi::PERM ? ((R & ~31) + perm32(R & 31)) : R;
        voffA[i] = (unsigned)(R * g.lda + C) * 2u; voffB[i] = (unsigned)(Rb * K + C) * 2u; }
    const size_t kstep = (size_t)(BK * 2);
    const size_t hstepA = (size_t)HALF * g.lda * 2, hstepB = (size_t)HALF * K * 2;
    const unsigned ldsw = (unsigned)wid * 1024u;
    const int aoff = lds_byte(wr * 64 + fr, fq * 8), boff = lds_byte(wc * 32 + fr, fq * 8);
#define PG8_SA(b, h) (((b) * 2 + (h)) * HTB)
#define PG8_SB(b, h) ((4 + (b) * 2 + (h)) * HTB)
#define PG8_STAGE(bufoff, gbase, voff) do { _Pragma("unroll") for (int _i = 0; _i < 2; ++_i) \
        __builtin_amdgcn_global_load_lds((const unsigned*)((const char*)(gbase) + (voff)[_i]), (LAS unsigned*)(lds + (bufoff) + ldsw + _i * 8192), 16, 0, 0); } while (0)
#define PG8_LDA(dst, b, h) do { _Pragma("unroll") for (int m = 0; m < 4; ++m) _Pragma("unroll") for (int k = 0; k < 2; ++k) dst[m][k] = *(const LAS bf16x8*)(lds + PG8_SA(b, h) + aoff + m * 2048 + k * 1024); } while (0)
#define PG8_LDB(dst, b, h) do { _Pragma("unroll") for (int n = 0; n < 2; ++n) _Pragma("unroll") for (int k = 0; k < 2; ++k) dst[n][k] = *(const LAS bf16x8*)(lds + PG8_SB(b, h) + boff + n * 2048 + k * 1024); } while (0)
#define PG8_MMA(ai, bj, At, Bt) do { __builtin_amdgcn_s_setprio(1); _Pragma("unroll") for (int m = 0; m < 4; ++m) _Pragma("unroll") for (int n = 0; n < 2; ++n) _Pragma("unroll") for (int k = 0; k < 2; ++k) \
        acc[ai][bj][m][n] = __builtin_amdgcn_mfma_f32_16x16x32_bf16(Bt[n][k], At[m][k], acc[ai][bj][m][n], 0, 0, 0); __builtin_amdgcn_s_setprio(0); } while (0)
#define PG8_WAIT_V(n) asm volatile("s_waitcnt vmcnt(" #n ")" ::: "memory")
#define PG8_WAIT_L(n) asm volatile("s_waitcnt lgkmcnt(" #n ")" ::: "memory")
#define PG8_BAR __builtin_amdgcn_s_barrier()
#define PG8_SCHED __builtin_amdgcn_sched_barrier(0)
    Unit cur, nxt; int ui = 0;
    if (!S.next(0, cur)) return;
    f32x4 acc[2][2][4][2];
#pragma unroll
    for (int a = 0; a < 2; ++a)
#pragma unroll
        for (int b = 0; b < 2; ++b)
#pragma unroll
            for (int m = 0; m < 4; ++m)
#pragma unroll
                for (int n = 0; n < 2; ++n) acc[a][b][m][n] = (f32x4){0.f, 0.f, 0.f, 0.f};
    bf16x8 At[4][2], B0[2][2], B1[2][2];
    const char* cA = cur.a; const char* cB = cur.b;
    PG8_STAGE(PG8_SB(0, 0), cB, voffB); PG8_STAGE(PG8_SB(0, 1), cB + hstepB, voffB); PG8_STAGE(PG8_SA(0, 0), cA, voffA); PG8_STAGE(PG8_SA(0, 1), cA + hstepA, voffA);
    if (wr == 1) PG8_BAR;
    PG8_WAIT_V(2); PG8_BAR;
    PG8_STAGE(PG8_SB(1, 0), cB + kstep, voffB); PG8_STAGE(PG8_SA(1, 0), cA + kstep, voffA); PG8_STAGE(PG8_SB(1, 1), cB + hstepB + kstep, voffB);
    PG8_WAIT_V(6); PG8_BAR;
    for (;;) {
        const bool has_next = S.next(ui + 1, nxt);
        const char* nA = has_next ? nxt.a : cA; const char* nB = has_next ? nxt.b : cB;
        for (int t = 0; t < nt; t += 2) {
            const bool last = (t == nt - 2);
            const char* a1 = cA + (size_t)(t + 1) * kstep;
            const char* a2 = last ? nA : cA + (size_t)(t + 2) * kstep; const char* b2 = last ? nB : cB + (size_t)(t + 2) * kstep;
            const char* a3 = a2 + kstep; const char* b3 = b2 + kstep;
            PG8_LDB(B0, 0, 0); PG8_LDB(B1, 0, 1); PG8_SCHED; PG8_LDA(At, 0, 0); PG8_STAGE(PG8_SA(1, 1), a1 + hstepA, voffA);
            PG8_WAIT_V(8); PG8_WAIT_L(0); PG8_BAR; PG8_MMA(0, 0, At, B0); PG8_MMA(0, 1, At, B1); PG8_BAR; PG8_SCHED;
            PG8_LDA(At, 0, 1); PG8_STAGE(PG8_SB(0, 0), b2, voffB); PG8_STAGE(PG8_SB(0, 1), b2 + hstepB, voffB); PG8_STAGE(PG8_SA(0, 0), a2, voffA);
            PG8_WAIT_V(8); PG8_WAIT_L(0); PG8_BAR; PG8_MMA(1, 0, At, B0); PG8_MMA(1, 1, At, B1); PG8_BAR; PG8_SCHED;
            PG8_LDB(B0, 1, 0); PG8_LDB(B1, 1, 1); PG8_SCHED; PG8_LDA(At, 1, 0); PG8_STAGE(PG8_SA(0, 1), a2 + hstepA, voffA);
            PG8_WAIT_V(8); PG8_WAIT_L(0); PG8_BAR; PG8_MMA(0, 0, At, B0); PG8_MMA(0, 1, At, B1); PG8_BAR; PG8_SCHED;
            PG8_LDA(At, 1, 1); PG8_STAGE(PG8_SB(1, 0), b3, voffB); PG8_STAGE(PG8_SB(1, 1), b3 + hstepB, voffB); PG8_STAGE(PG8_SA(1, 0), a3, voffA);
            PG8_WAIT_V(8); PG8_WAIT_L(0); PG8_BAR; PG8_MMA(1, 0, At, B0); PG8_MMA(1, 1, At, B1); PG8_BAR; PG8_SCHED;
        }
        if constexpr (ALIGN_EPI) { if (wr == 0) PG8_BAR; }
        E(acc, cur, wr, wc, fr, fq);
        if (!has_next) break;
#pragma unroll
        for (int a = 0; a < 2; ++a)
#pragma unroll
            for (int b = 0; b < 2; ++b)
#pragma unroll
                for (int m = 0; m < 4; ++m)
#pragma unroll
                    for (int n = 0; n < 2; ++n) acc[a][b][m][n] = (f32x4){0.f, 0.f, 0.f, 0.f};
        cur = nxt; cA = nA; cB = nB; ++ui;
        if constexpr (ALIGN_EPI) { if (wr == 1) PG8_BAR; }
    }
    PG8_WAIT_V(0);
    if constexpr (!ALIGN_EPI) { if (wr == 0) PG8_BAR; }
    PG8_BAR;
#undef PG8_SA
#undef PG8_SB
#undef PG8_STAGE
#undef PG8_LDA
#undef PG8_LDB
#undef PG8_MMA
#undef PG8_WAIT_V
#undef PG8_WAIT_L
#undef PG8_BAR
#undef PG8_SCHED
}
}
using pg8::Unit; using pg8::Gemm;
typedef const f32x4 (&AccRef)[2][2][4][2];

DI u32x4 pack8(const f32x4& v0, const f32x4& v1) { u32x4 w; w.x = cvt_pk_bf16(v0[0], v0[1]); w.y = cvt_pk_bf16(v0[2], v0[3]); w.z = cvt_pk_bf16(v1[0], v1[1]); w.w = cvt_pk_bf16(v1[2], v1[3]); return w; }
DI void unpack8(const u32x4& w, float (&f)[8]) { f[0] = bflo(w.x); f[1] = bfhi(w.x); f[2] = bflo(w.y); f[3] = bfhi(w.y); f[4] = bflo(w.z); f[5] = bfhi(w.z); f[6] = bflo(w.w); f[7] = bfhi(w.w); }

struct EpiInProj {
    static constexpr bool PERM = true;
    bf16_t* P; const float2* rope; const float* lbf; const float* lbb;
    DI void operator()(AccRef acc, const Unit& u, int wr, int wc, int fr, int fq) const {
        const int row0 = u.pm * 256 + wr * 64 + fr, sec = u.pn >> 1;
        const int col0 = u.pn * 256 + wc * 32 + 8 * fq;
        const bool lat = u.pm < (NLAT / 256);
#pragma unroll
        for (int ai = 0; ai < 2; ++ai)
#pragma unroll
            for (int m = 0; m < 4; ++m) {
                const int row = row0 + ai * 128 + m * 16; bf16_t* rowp = P + (size_t)row * PW + col0;
#pragma unroll
                for (int bj = 0; bj < 2; ++bj) {
                    f32x4 v0 = acc[ai][bj][m][0], v1 = acc[ai][bj][m][1]; u32x4 w;
                    if (sec == 0 || sec == 4) {
                        if (lat) {
                            const int pi = ((col0 + bj * 128) & 63) >> 1;
                            const f32x4* rp = (const f32x4*)(rope + (size_t)(row & (T - 1)) * 32 + pi);
                            const f32x4 r0 = rp[0], r1 = rp[1];
                            f32x4 o0, o1;
                            o0[0] = v0[0] * r0[0] - v0[1] * r0[1]; o0[1] = v0[0] * r0[1] + v0[1] * r0[0];
                            o0[2] = v0[2] * r0[2] - v0[3] * r0[3]; o0[3] = v0[2] * r0[3] + v0[3] * r0[2];
                            o1[0] = v1[0] * r1[0] - v1[1] * r1[1]; o1[1] = v1[0] * r1[1] + v1[1] * r1[0];
                            o1[2] = v1[2] * r1[2] - v1[3] * r1[3]; o1[3] = v1[2] * r1[3] + v1[3] * r1[2];
                            v0 = o0; v1 = o1;
                        }
                        if (sec == 0) { v0 = v0 * QSCALE; v1 = v1 * QSCALE; }
                        w = pack8(v0, v1);
                    } else if (sec == 1 || sec == 6) {
#pragma unroll
                        for (int j = 0; j < 4; ++j) { v0[j] = fsilu(v0[j]); v1[j] = fsilu(v1[j]); }
                        w = pack8(v0, v1);
                    } else if (sec == 2 || sec == 3) {
                        const float* lb = (sec == 2 ? lbf : lbb) + ((col0 + bj * 128) & 511);
                        const f32x4 b0 = *(const f32x4*)lb, b1 = *(const f32x4*)(lb + 4);
                        half8 hv;
#pragma unroll
                        for (int j = 0; j < 8; ++j) {
                            const float z = j < 4 ? v0[j] : v1[j - 4], b = j < 4 ? b0[j] : b1[j - 4];
                            const float ls = fminf(z, 0.f) - __logf(1.f + __expf(-fabsf(z)));
                            const float lf = b > 0.f ? __logf(b + (1.f - b) * __expf(ls)) : ls;
                            hv[j] = (_Float16)lf;
                        }
                        w = __builtin_bit_cast(u32x4, hv);
                    } else w = pack8(v0, v1);
                    *(u32x4*)(rowp + bj * 128) = w;
                }
            }
    }
};
struct EpiGates {
    static constexpr bool PERM = true; bf16_t* P;
    DI void operator()(AccRef acc, const Unit& u, int wr, int wc, int fr, int fq) const {
        const int row0 = u.pm * 256 + wr * 64 + fr, col0 = PC_GA + u.pn * 256 + wc * 32 + 8 * fq;
#pragma unroll
        for (int ai = 0; ai < 2; ++ai)
#pragma unroll
            for (int m = 0; m < 4; ++m) { bf16_t* rowp = P + (size_t)(row0 + ai * 128 + m * 16) * PW + col0;
#pragma unroll
                for (int bj = 0; bj < 2; ++bj) { f32x4 v0 = acc[ai][bj][m][0], v1 = acc[ai][bj][m][1];
#pragma unroll
                    for (int j = 0; j < 4; ++j) { v0[j] = fsigmoid(v0[j]); v1[j] = fsigmoid(v1[j]); }
                    *(u32x4*)(rowp + bj * 128) = pack8(v0, v1); } }
    }
};
template <bool FIRST> struct EpiMerge {
    static constexpr bool PERM = true; const bf16_t* P; int gcol; bf16_t* O;
    DI void operator()(AccRef acc, const Unit& u, int wr, int wc, int fr, int fq) const {
        const int row0 = u.pm * 256 + wr * 64 + fr, col0 = u.pn * 256 + wc * 32 + 8 * fq;
#pragma unroll
        for (int ai = 0; ai < 2; ++ai)
#pragma unroll
            for (int m = 0; m < 4; ++m) { const size_t row = (size_t)(row0 + ai * 128 + m * 16);
#pragma unroll
                for (int bj = 0; bj < 2; ++bj) {
                    const u32x4 gw = *(const u32x4*)(P + row * PW + gcol + col0 + bj * 128); float g[8]; unpack8(gw, g);
                    f32x4 v0 = acc[ai][bj][m][0], v1 = acc[ai][bj][m][1];
                    bf16_t* op = O + row * D + col0 + bj * 128;
                    float pv[8];
                    if (!FIRST) { const u32x4 ow = *(const u32x4*)op; unpack8(ow, pv); }
#pragma unroll
                    for (int j = 0; j < 4; ++j) { v0[j] = v0[j] * g[j] + (FIRST ? 0.f : pv[j]); v1[j] = v1[j] * g[4 + j] + (FIRST ? 0.f : pv[4 + j]); }
                    *(u32x4*)op = pack8(v0, v1); } }
    }
};
struct EpiResid {
    static constexpr bool PERM = false;
    const float* xin_l; const float* xin_c; float* xout_l; float* xout_c; const float* mods; int msel;
    DI void operator()(AccRef acc, const Unit& u, int wr, int wc, int fr, int fq) const {
        const bool lat = u.pm < (NLAT / 256);
        const int rbase = (lat ? u.pm : u.pm - NLAT / 256) * 256 + wr * 64 + fr, col0 = u.pn * 256 + wc * 32 + 4 * fq;
        const float* xi = lat ? xin_l : xin_c; float* xo = lat ? xout_l : xout_c;
        const float* mv = mods + (size_t)(lat ? (u.pm >> 3) : 32) * DIN + msel * D + col0;
        f32x4 g[2][2];
#pragma unroll
        for (int bj = 0; bj < 2; ++bj)
#pragma unroll
            for (int n = 0; n < 2; ++n) g[bj][n] = *(const f32x4*)(mv + bj * 128 + n * 16);
#pragma unroll
        for (int ai = 0; ai < 2; ++ai)
#pragma unroll
            for (int m = 0; m < 4; ++m) { const size_t off = (size_t)(rbase + ai * 128 + m * 16) * D + col0;
#pragma unroll
                for (int bj = 0; bj < 2; ++bj)
#pragma unroll
                    for (int n = 0; n < 2; ++n) { const f32x4 xv = *(const f32x4*)(xi + off + bj * 128 + n * 16);
                        *(f32x4*)(xo + off + bj * 128 + n * 16) = xv + g[bj][n] * acc[ai][bj][m][n]; } }
    }
};
struct EpiSwiglu {
    static constexpr bool PERM = true; bf16_t* Hd; int ldh; int pan0;
    DI void operator()(AccRef acc, const Unit& u, int wr, int wc, int fr, int fq) const {
        const int row0 = (u.pm - pan0) * 256 + wr * 64 + fr, hc0 = u.pn * 128 + wc * 16 + 4 * fq;
#pragma unroll
        for (int ai = 0; ai < 2; ++ai)
#pragma unroll
            for (int m = 0; m < 4; ++m) { bf16_t* rowp = Hd + (size_t)(row0 + ai * 128 + m * 16) * ldh + hc0;
#pragma unroll
                for (int bj = 0; bj < 2; ++bj) { const f32x4 a = acc[ai][bj][m][0], b = acc[ai][bj][m][1];
                    u32x2 w; w.x = cvt_pk_bf16(fsilu(a[0]) * b[0], fsilu(a[1]) * b[1]); w.y = cvt_pk_bf16(fsilu(a[2]) * b[2], fsilu(a[3]) * b[3]);
                    *(u32x2*)(rowp + bj * 64) = w; } }
    }
};
struct EpiBf16 {
    static constexpr bool PERM = true; bf16_t* O; int ldc;
    DI void operator()(AccRef acc, const Unit& u, int wr, int wc, int fr, int fq) const {
        const int row0 = u.pm * 256 + wr * 64 + fr, col0 = u.pn * 256 + wc * 32 + 8 * fq;
#pragma unroll
        for (int ai = 0; ai < 2; ++ai)
#pragma unroll
            for (int m = 0; m < 4; ++m) { bf16_t* rowp = O + (size_t)(row0 + ai * 128 + m * 16) * ldc + col0;
#pragma unroll
                for (int bj = 0; bj < 2; ++bj) *(u32x4*)(rowp + bj * 128) = pack8(acc[ai][bj][m][0], acc[ai][bj][m][1]); }
    }
};

typedef short v4i16 __attribute__((ext_vector_type(4)));
DI s16x4 tr16(const LAS unsigned char* p) { return __builtin_bit_cast(s16x4, __builtin_amdgcn_ds_read_tr16_b64_v4i16((LAS v4i16*)p)); }
DI bf16x8 cat8(s16x4 lo, s16x4 hi) { return __builtin_shufflevector(lo, hi, 0, 1, 2, 3, 4, 5, 6, 7); }
DI void dma16(const void* g, LAS unsigned char* l) { __builtin_amdgcn_global_load_lds((const unsigned*)g, (LAS unsigned*)l, 16, 0, 0); }
DI bf16x8 packf8(const f32x16& x, int s) {
    u32x4 w; w.x = cvt_pk_bf16(x[8 * s], x[8 * s + 1]); w.y = cvt_pk_bf16(x[8 * s + 2], x[8 * s + 3]); w.z = cvt_pk_bf16(x[8 * s + 4], x[8 * s + 5]); w.w = cvt_pk_bf16(x[8 * s + 6], x[8 * s + 7]);
    return __builtin_bit_cast(bf16x8, w);
}
#define MFMA32(a, b, c) __builtin_amdgcn_mfma_f32_32x32x16_bf16((a), (b), (c), 0, 0, 0)

struct Params { const float* in[28]; float* out; unsigned char* ws; int ph_lo, ph_hi, li, pad; };
typedef const __attribute__((address_space(4))) Params* KP;
DI KP kparams() { KP kp = (KP)__builtin_amdgcn_kernarg_segment_ptr(); asm volatile("" : "+s"(kp)); return kp; }
#define PIN(k) (kparams()->in[k])
#define POUT (kparams()->out)
struct Ctx {
    LAS unsigned char* lds; unsigned char* ws; int tid, lane, wave, vcu, G, gw, NGW;
};

DI int map_row(int kind, int n) {
    if (kind == 0) return n;
    if (kind == 2) return 8 * (n >> 2) + (n & 3);
    if (kind == 3) return 8 * (n >> 2) + (n & 3) + 4;
    const int sec = n >> 9, j = n & 511;
    if (n >= 4096) return n;
    if (sec == 0 || sec == 1) { const int hs = j >> 6, d = j & 63; const int pj = hs * 64 + (d < 32 ? 2 * d : 2 * (d - 32) + 1); return (sec == 0 ? PC_Q : PC_K) + pj; }
    if (sec == 2) return PC_V + j;
    if (sec == 3) return PC_RQ + j;
    if (sec == 4) return PC_RI + j;
    if (sec == 5) return PC_LF + j;
    if (sec == 6) return PC_LB + j;
    return PC_G + j;
}
DI void transpose_item(const float* W, int ldw, int k0, int n0, bf16_t* WT, int ldt, int kind, LAS float* scr, int lane) {
#pragma unroll 8
    for (int i = 0; i < 32; ++i) { const int kk = 2 * i + (lane >> 5); scr[kk * 33 + (lane & 31)] = W[(size_t)(k0 + kk) * ldw + n0 + (lane & 31)]; }
    LDS_WAIT(); asm volatile("" ::: "memory");
    const int c = lane & 7;
#pragma unroll
    for (int j = 0; j < 4; ++j) { const int n = (lane >> 3) + 8 * j; const LAS float* s = scr + (8 * c) * 33 + n;
        u32x4 o; o.x = cvt_pk_bf16(s[0 * 33], s[1 * 33]); o.y = cvt_pk_bf16(s[2 * 33], s[3 * 33]); o.z = cvt_pk_bf16(s[4 * 33], s[5 * 33]); o.w = cvt_pk_bf16(s[6 * 33], s[7 * 33]);
        *(u32x4*)(WT + (size_t)map_row(kind, n0 + n) * ldt + k0 + 8 * c) = o; }
    LDS_WAIT(); asm volatile("" ::: "memory");
}
DI void transpose_matrix(const Ctx& C, const float* W, int K, int N, bf16_t* WT, int ldt, int kind, int& itbase, int total_unused) {
    (void)total_unused;
    LAS float* scr = (LAS float*)(C.lds + C.wave * 16384);
    const int nblk = N / 32, nit = (K / 64) * nblk;
    int first = (C.gw - (itbase % C.NGW) + C.NGW) % C.NGW;
    for (int it = first; it < nit; it += C.NGW) transpose_item(W, N, 64 * (it / nblk), 32 * (it % nblk), WT, ldt, kind, scr, C.lane);
    itbase += nit;
}

DI void phase_prologue(const Ctx& C) {
    unsigned char* ws = C.ws;
    int itb = 0;
    for (int l = 0; l < 2; ++l) {
        transpose_matrix(C, PIN(8) + (size_t)l * D * DIN, D, DIN, (bf16_t*)(ws + WS_WIN) + (size_t)l * DIN * D, D, 1, itb, 0);
        transpose_matrix(C, PIN(17) + (size_t)l * 512 * D, 512, D, (bf16_t*)(ws + WS_WUA) + (size_t)l * D * 512, 512, 0, itb, 0);
        transpose_matrix(C, PIN(18) + (size_t)l * 512 * D, 512, D, (bf16_t*)(ws + WS_WUR) + (size_t)l * D * 512, 512, 0, itb, 0);
        transpose_matrix(C, PIN(19) + (size_t)l * D * D, D, D, (bf16_t*)(ws + WS_WO) + (size_t)l * D * D, D, 0, itb, 0);
    }
    transpose_matrix(C, PIN(20), D, DFF, (bf16_t*)(ws + WS_W13), D, 2, itb, 0);
    transpose_matrix(C, PIN(21), D, DFF, (bf16_t*)(ws + WS_W13), D, 3, itb, 0);
    transpose_matrix(C, PIN(22), DFF, D, (bf16_t*)(ws + WS_W2), DFFP, 0, itb, 0);
    { const int gt = C.vcu * 512 + C.tid, NT = C.G * 512;
      bf16_t* w13 = (bf16_t*)(ws + WS_W13) + (size_t)(2 * DFF) * D;
      for (int i = gt; i < (2 * DFFP - 2 * DFF) * D / 8; i += NT) ((u32x4*)w13)[i] = (u32x4){0u, 0u, 0u, 0u};
      bf16_t* w2 = (bf16_t*)(ws + WS_W2);
      for (int i = gt; i < D * (DFFP - DFF) / 8; i += NT) { const int r = i / ((DFFP - DFF) / 8), cc = i % ((DFFP - DFF) / 8); *(u32x4*)(w2 + (size_t)r * DFFP + DFF + cc * 8) = (u32x4){0u, 0u, 0u, 0u}; }
      float2* rope = (float2*)(ws + WS_ROPE);
      for (int i = gt; i < T * 32; i += NT) { const int t = i >> 5, pi = i & 31; const float invf = exp2f(-(float)(pi & 15) * (13.287712379549449f / 16.f));
          const float ang = (float)(pi < 16 ? (t >> 6) : (t & 63)) * invf; rope[i] = make_float2(cosf(ang), sinf(ang)); }
      float* lbs = (float*)(ws + WS_LBS);
      for (int i = gt; i < 2 * 2 * 512; i += NT) { const int l = i >> 10, dir = (i >> 9) & 1, d = i & 511; const float* lb = PIN(dir ? 16 : 15);
          const float p0 = lb[d], p1 = lb[512 + d]; lbs[i] = l == 0 ? 0.f : 1.f / (1.f + expf(p0 - p1)); }
    }
    { float* mods = (float*)(ws + WS_MODS);
      for (int task = C.gw; task < 2 * 33 * 96; task += C.NGW) {
          const int ng = task % 96, r = (task / 96) % 33, l = task / (96 * 33), n = ng * 64 + C.lane;
          const float* cv = r < 32 ? PIN(1) + r * D : PIN(3); const float* W = PIN(4) + (size_t)l * D * DIN + n;
          float acc = PIN(5)[l * DIN + n];
          for (int k0 = 0; k0 < D; k0 += 64) { const float sv = fsilu(cv[k0 + C.lane]);
#pragma unroll 16
              for (int j = 0; j < 64; ++j) acc += __uint_as_float(__builtin_amdgcn_readlane(__float_as_uint(sv), j)) * W[(size_t)(k0 + j) * DIN]; }
          mods[(size_t)(l * 33 + r) * DIN + n] = acc; } }
}
DI void convert_moe_weights(const Ctx& C) {
    unsigned char* ws = C.ws; int itb = 0;
    for (int e = 0; e < NE; ++e) {
        transpose_matrix(C, PIN(24) + (size_t)e * D * DFE, D, DFE, (bf16_t*)(ws + WS_WM13) + (size_t)e * 2 * DFE * D, D, 2, itb, 0);
        transpose_matrix(C, PIN(25) + (size_t)e * D * DFE, D, DFE, (bf16_t*)(ws + WS_WM13) + (size_t)e * 2 * DFE * D, D, 3, itb, 0);
        transpose_matrix(C, PIN(26) + (size_t)e * DFE * D, DFE, D, (bf16_t*)(ws + WS_WM2) + (size_t)e * D * DFE, DFE, 0, itb, 0);
    }
}

template <bool ROUTER>
DI void phase_norm(const Ctx& C, const float* xl, const float* xc, const float* nw, const float* mods, int shsel, int nrows, bf16_t* Hout, const float* rw, unsigned char* route, LAS int* cntL) {
    for (int row = C.gw; row < nrows; row += C.NGW) {
        const bool lat = row < NLAT; const float* xr = lat ? xl + (size_t)row * D : xc + (size_t)(row - NLAT) * D;
        const float* mv = mods + (size_t)(lat ? (row >> 11) : 32) * DIN + shsel * D;
        f32x4 v[4]; float ss = 0.f;
#pragma unroll
        for (int j = 0; j < 4; ++j) { v[j] = *(const f32x4*)(xr + 256 * j + 4 * C.lane); ss += (v[j][0] * v[j][0] + v[j][1] * v[j][1]) + (v[j][2] * v[j][2] + v[j][3] * v[j][3]); }
        const float rstd = 1.0f / sqrtf(wave_sum(ss) * (1.f / D) + EPS);
        float lg[8];
        if (ROUTER) {
#pragma unroll
            for (int e = 0; e < 8; ++e) lg[e] = 0.f; }
#pragma unroll
        for (int j = 0; j < 4; ++j) { const int c0 = 256 * j + 4 * C.lane;
            const f32x4 w = *(const f32x4*)(nw + c0), sh = *(const f32x4*)(mv + c0), sc = *(const f32x4*)(mv + D + c0);
            f32x4 h = (v[j] * rstd) * w * (sc + 1.0f) + sh;
            u32x2 o; o.x = cvt_pk_bf16(h[0], h[1]); o.y = cvt_pk_bf16(h[2], h[3]);
            *(u32x2*)(Hout + (size_t)row * D + c0) = o;
            if (ROUTER) {
#pragma unroll
                for (int q = 0; q < 4; ++q) { const f32x4 r0 = *(const f32x4*)(rw + (size_t)(c0 + q) * 8), r1 = *(const f32x4*)(rw + (size_t)(c0 + q) * 8 + 4);
                    lg[0] += h[q] * r0[0]; lg[1] += h[q] * r0[1]; lg[2] += h[q] * r0[2]; lg[3] += h[q] * r0[3]; lg[4] += h[q] * r1[0]; lg[5] += h[q] * r1[1]; lg[6] += h[q] * r1[2]; lg[7] += h[q] * r1[3]; } }
        }
        if (ROUTER) {
#pragma unroll
            for (int e = 0; e < 8; ++e) lg[e] = wave_sum(lg[e]);
            if (C.lane == 0) {
                int e1 = 0; float l1 = lg[0];
#pragma unroll
                for (int e = 1; e < 8; ++e) if (lg[e] > l1) { l1 = lg[e]; e1 = e; }
                int e2 = -1; float l2 = -INFINITY;
#pragma unroll
                for (int e = 0; e < 8; ++e) if (e != e1 && lg[e] > l2) { l2 = lg[e]; e2 = e; }
                const float g2 = 1.f / (1.f + expf(l1 - l2)), g1 = 1.f - g2;
                int* rt = (int*)(route + (size_t)row * 24); rt[0] = e1; rt[1] = e2; ((float*)rt)[2] = g1; ((float*)rt)[3] = g2;
                atomicAdd((int*)&cntL[e1], 1); atomicAdd((int*)&cntL[e2], 1);
            }
        }
    }
}

constexpr int AT_XCH = 65536;
DI void attn_unit(const Ctx& C, bf16_t* P, int qrow0, int krow_ctx, int krow_lat, int nkt, int h, float lam, const float* anw, float post) {
    int tid_ = threadIdx.x; asm volatile("" : "+v"(tid_));
    LAS unsigned char* lds = C.lds; const int lane = tid_ & 63, wid = __builtin_amdgcn_readfirstlane(tid_ >> 6), sub = wid >> 2, qw = wid & 3, r32 = lane & 31, hh = lane >> 5;
    const int tq = (lane & 15) >> 2, tp = lane & 3, blk = (lane >> 4) & 1;
    bf16x8 Qf[4];
    { const bf16_t* qp = P + (size_t)(qrow0 + 32 * qw + r32) * PW + PC_Q + h * 128 + sub * 64 + 8 * hh;
#pragma unroll
      for (int ks = 0; ks < 4; ++ks) Qf[ks] = *(const bf16x8*)(qp + 16 * ks); }
    f32x16 O[4];
#pragma unroll
    for (int c = 0; c < 4; ++c)
#pragma unroll
        for (int i = 0; i < 16; ++i) O[c][i] = 0.f;
    float m_run = -INFINITY, l_run = 0.f;
#define AT_ISSUE(kt, buf) do { const int kr0_ = (kt) < 4 ? krow_ctx + (kt) * 64 : krow_lat + ((kt) - 4) * 64; LAS unsigned char* bb_ = lds + (buf) * 32768; \
        _Pragma("unroll") for (int j_ = 0; j_ < 2; ++j_) { const int c_ = 2 * wid + j_; \
            dma16(P + (size_t)(kr0_ + lane) * PW + PC_K + h * 128 + c_ * 8, bb_ + c_ * 1024); \
            dma16(P + (size_t)(kr0_ + 16 * (c_ & 3) + (lane >> 2)) * PW + PC_V + h * 128 + (c_ >> 2) * 32 + (lane & 3) * 8, bb_ + 16384 + c_ * 1024); } } while (0)
    AT_ISSUE(0, 0);
    int buf = 0;
    for (int kt = 0; kt < nkt; ++kt) {
        VM_WAIT(); __syncthreads();
        if (kt + 1 < nkt) AT_ISSUE(kt + 1, buf ^ 1);
        const LAS unsigned char* kb = lds + buf * 32768, * vb = kb + 16384 + (4 * hh + tq) * 64 + blk * 32 + tp * 8;
        f32x16 s0, s1;
#pragma unroll
        for (int i = 0; i < 16; ++i) { s0[i] = 0.f; s1[i] = 0.f; }
#pragma unroll
        for (int ks = 0; ks < 4; ++ks) { const LAS unsigned char* kp = kb + ((sub * 8 + 2 * ks + hh) * 64 + r32) * 16;
            const bf16x8 k0 = *(const LAS bf16x8*)kp, k1 = *(const LAS bf16x8*)(kp + 512);
            s0 = MFMA32(k0, Qf[ks], s0); s1 = MFMA32(k1, Qf[ks], s1); }
        float mx = fmaxf(s0[0], s1[0]);
#pragma unroll
        for (int i = 1; i < 16; ++i) mx = fmaxf(mx, fmaxf(s0[i], s1[i]));
        mx = fmaxf(mx, __shfl_xor(mx, 32));
        const float mnew = fmaxf(m_run, mx);
        if (__any(mnew > m_run)) { const float alpha = __builtin_amdgcn_exp2f(m_run - mnew); l_run *= alpha;
#pragma unroll
            for (int c = 0; c < 4; ++c)
#pragma unroll
                for (int i = 0; i < 16; ++i) O[c][i] *= alpha;
            m_run = mnew; }
        float ps = 0.f;
#pragma unroll
        for (int i = 0; i < 16; ++i) { s0[i] = __builtin_amdgcn_exp2f(s0[i] - m_run); s1[i] = __builtin_amdgcn_exp2f(s1[i] - m_run); ps += s0[i] + s1[i]; }
        l_run += ps;
        bf16x8 Pf[4]; Pf[0] = packf8(s0, 0); Pf[1] = packf8(s0, 1); Pf[2] = packf8(s1, 0); Pf[3] = packf8(s1, 1);
#pragma unroll
        for (int cb = 0; cb < 4; ++cb)
#pragma unroll
            for (int s4 = 0; s4 < 4; ++s4) { const bf16x8 a = cat8(tr16(vb + cb * 4096 + s4 * 1024), tr16(vb + cb * 4096 + s4 * 1024 + 512)); O[cb] = MFMA32(a, Pf[s4], O[cb]); }
        buf ^= 1;
    }
#undef AT_ISSUE
    l_run += __shfl_xor(l_run, 32);
    const float inv = 1.f / l_run;
    LAS float* xch = (LAS float*)(lds + AT_XCH) + qw * 4096 + lane;
    if (sub == 1) { const float sc = -lam * inv;
#pragma unroll
        for (int c = 0; c < 4; ++c)
#pragma unroll
            for (int i = 0; i < 16; ++i) xch[(c * 16 + i) * 64] = O[c][i] * sc; }
    LDS_WAIT(); __syncthreads();
    if (sub == 0) {
        float ss = 0.f;
#pragma unroll
        for (int c = 0; c < 4; ++c)
#pragma unroll
            for (int i = 0; i < 16; ++i) { const float o = O[c][i] * inv + xch[(c * 16 + i) * 64]; O[c][i] = o; ss += o * o; }
        ss += __shfl_xor(ss, 32);
        const float rs = post / sqrtf(ss * (1.f / 128.f) + EPS);
        bf16_t* op = P + (size_t)(qrow0 + 32 * qw + r32) * PW + PC_Q + h * 128;
#pragma unroll
        for (int c = 0; c < 4; ++c)
#pragma unroll
            for (int g = 0; g < 4; ++g) { const int v0 = 32 * c + 8 * g + 4 * hh; const f32x4 w = *(const f32x4*)(anw + v0);
                u32x2 o; o.x = cvt_pk_bf16(O[c][4 * g] * rs * w[0], O[c][4 * g + 1] * rs * w[1]); o.y = cvt_pk_bf16(O[c][4 * g + 2] * rs * w[2], O[c][4 * g + 3] * rs * w[3]);
                *(u32x2*)(op + v0) = o; }
    }
    LDS_WAIT(); __syncthreads();
}

constexpr int SC_Q = 0, SC_LF = 16384, SC_V0 = 32768, SC_QM = 65536, SC_KMR = 81920, SC_KMS = 98304, SC_SX = 114688, SC_A31 = 147456, SC_A63 = 147968, SC_END = 148480;
DI void scan_chain(const Ctx& C, bf16_t* P, int b, int h, int dir, bool store_ctx) {
    int tid_ = threadIdx.x; asm volatile("" : "+v"(tid_));
    LAS unsigned char* lds = C.lds; const int lane = tid_ & 63, wid = __builtin_amdgcn_readfirstlane(tid_ >> 6), r32 = lane & 31, hh = lane >> 5;
    const int tq = (lane & 15) >> 2, tp = lane & 3, blk = (lane >> 4) & 1;
    const int db = wid & 3, tb = wid >> 2;
    const int base_nat = hh * 512 + tq * 64 + blk * 32 + tp * 8;
    const int base_prm = (4 * hh + tq) * 64 + blk * 32 + tp * 8;
    const int lfcol = (dir ? PC_LB : PC_LF) + h * 128, qcol = PC_RQ + h * 128, vcol = PC_RI + h * 128;
    f32x16 ST[2];
#pragma unroll
    for (int j = 0; j < 2; ++j)
#pragma unroll
        for (int i = 0; i < 16; ++i) ST[j][i] = 0.f;
#define SROW(c, i) ((c) < 4 ? NLAT + b * CL + (dir ? 255 - ((c) * 64 + (i)) : (c) * 64 + (i)) : b * T + (dir ? 2047 - (((c) - 4) * 64 + (i)) : ((c) - 4) * 64 + (i)))
#define SDMA(c, colbase, dstoff) do { _Pragma("unroll") for (int j_ = 0; j_ < 2; ++j_) { const int I_ = 2 * wid + j_; const int ti_ = 16 * (I_ & 3) + (lane >> 2); \
        dma16(P + (size_t)SROW(c, ti_) * PW + (colbase) + (I_ >> 2) * 32 + (lane & 3) * 8, lds + (dstoff) + I_ * 1024); } } while (0)
    SDMA(0, qcol, SC_Q); SDMA(0, lfcol, SC_LF); SDMA(0, vcol, SC_V0);
    int vbuf = 0;
    const int t = 32 * tb + r32;
    for (int c = 0; c < 36; ++c) {
        VM_WAIT(); __syncthreads();
        const LAS unsigned char* Vimg = lds + SC_V0 + vbuf * 16384;
        f32x16 cm;
#pragma unroll
        for (int i = 0; i < 16; ++i) cm[i] = 0.f;
#pragma unroll
        for (int kk = 0; kk < 2; ++kk) { const int ks = 2 * tb + kk;
            const half8 a = __builtin_bit_cast(half8, cat8(tr16(lds + SC_LF + db * 4096 + base_nat + ks * 1024), tr16(lds + SC_LF + db * 4096 + base_nat + ks * 1024 + 256)));
            half8 bm;
#pragma unroll
            for (int j = 0; j < 8; ++j) { const int s = 16 * ks + 8 * hh + j; bm[j] = tb == 0 ? (s > t ? (_Float16)-1.f : (_Float16)0.f) : (s <= t ? (_Float16)1.f : (_Float16)0.f); }
            cm = __builtin_amdgcn_mfma_f32_32x32x16_f16(a, bm, cm, 0, 0, 0); }
#pragma unroll
        for (int g = 0; g < 4; ++g) {
            const int sa = db * 4096 + (t >> 3) * 512 + (t & 7) * 64 + (8 * g + 4 * hh) * 2;
            const u32x2 q4 = *(const LAS u32x2*)(lds + SC_Q + sa); const half4 lf4 = *(const LAS half4*)(lds + SC_LF + sa);
            const float qv[4] = {bflo(q4.x), bfhi(q4.x), bflo(q4.y), bfhi(q4.y)};
            float qm[4], km[4];
#pragma unroll
            for (int e = 0; e < 4; ++e) { const float cv = cm[4 * g + e] * LOG2E; const float E = __builtin_amdgcn_exp2f(cv), Ei = __builtin_amdgcn_exp2f(-cv);
                const float lf = (float)lf4[e]; qm[e] = qv[e] * E; km[e] = (1.f - __builtin_amdgcn_exp2f(lf * LOG2E)) * Ei;
                if (tb == 0 && r32 == 0) ((LAS float*)(lds + SC_A31))[32 * db + 8 * g + 4 * hh + e] = lf - cm[4 * g + e];
                if (tb == 1 && r32 == 31) ((LAS float*)(lds + SC_A63))[32 * db + 8 * g + 4 * hh + e] = cm[4 * g + e]; }
            u32x2 qw2, kw2; qw2.x = cvt_pk_bf16(qm[0], qm[1]); qw2.y = cvt_pk_bf16(qm[2], qm[3]); kw2.x = cvt_pk_bf16(km[0], km[1]); kw2.y = cvt_pk_bf16(km[2], km[3]);
            const int ra = ((4 * db + g) * 64 + t) * 16 + 8 * hh;
            *(LAS u32x2*)(lds + SC_QM + ra) = qw2; *(LAS u32x2*)(lds + SC_KMR + ra) = kw2; *(LAS u32x2*)(lds + SC_KMS + sa) = kw2;
        }
        LDS_WAIT(); __syncthreads();
        { const int d = 32 * db + r32; const float c31 = ((LAS float*)(lds + SC_A31))[d], c63 = ((LAS float*)(lds + SC_A63))[d];
          const float e31 = __expf(c31), dec = __expf(c31 + c63), e63 = __expf(c63);
          f32x16 SN[2];
#pragma unroll
          for (int j = 0; j < 2; ++j) { const int vb2 = 2 * tb + j;
#pragma unroll
              for (int g = 0; g < 4; ++g) { u32x2 w; w.x = cvt_pk_bf16(ST[j][4 * g] * e31, ST[j][4 * g + 1] * e31); w.y = cvt_pk_bf16(ST[j][4 * g + 2] * e31, ST[j][4 * g + 3] * e31);
                  *(LAS u32x2*)(lds + SC_SX + vb2 * 8192 + (d >> 3) * 512 + (d & 7) * 64 + (8 * g + 4 * hh) * 2) = w; }
#pragma unroll
              for (int i = 0; i < 16; ++i) SN[j][i] = 0.f; }
#pragma unroll
          for (int ks = 0; ks < 4; ++ks) {
              const bf16x8 kf = cat8(tr16(lds + SC_KMS + db * 4096 + base_nat + ks * 1024), tr16(lds + SC_KMS + db * 4096 + base_nat + ks * 1024 + 256));
#pragma unroll
              for (int j = 0; j < 2; ++j) { const int vb2 = 2 * tb + j;
                  const bf16x8 vf = cat8(tr16(Vimg + vb2 * 4096 + base_nat + ks * 1024), tr16(Vimg + vb2 * 4096 + base_nat + ks * 1024 + 256));
                  SN[j] = MFMA32(vf, kf, SN[j]); } }
#pragma unroll
          for (int j = 0; j < 2; ++j)
#pragma unroll
              for (int i = 0; i < 16; ++i) ST[j][i] = dec * ST[j][i] + e63 * SN[j][i];
        }
        LDS_WAIT(); __syncthreads();
        if (c + 1 < 36) { SDMA(c + 1, qcol, SC_Q); SDMA(c + 1, lfcol, SC_LF); SDMA(c + 1, vcol, SC_V0 + (vbuf ^ 1) * 16384); }
        { bf16x8 Qmf[8];
#pragma unroll
          for (int kd = 0; kd < 8; ++kd) Qmf[kd] = *(const LAS bf16x8*)(lds + SC_QM + ((2 * kd + hh) * 64 + t) * 16);
          f32x16 o;
#pragma unroll
          for (int i = 0; i < 16; ++i) o[i] = 0.f;
          for (int sb = 0; sb <= tb; ++sb) {
              f32x16 pt;
#pragma unroll
              for (int i = 0; i < 16; ++i) pt[i] = 0.f;
#pragma unroll
              for (int kd = 0; kd < 8; ++kd) { const bf16x8 a = *(const LAS bf16x8*)(lds + SC_KMR + ((2 * kd + hh) * 64 + 32 * sb + r32) * 16); pt = MFMA32(a, Qmf[kd], pt); }
              if (sb == tb) {
#pragma unroll
                  for (int i = 0; i < 16; ++i) if (crow(i, hh) > r32) pt[i] = 0.f; }
              const bf16x8 p0 = packf8(pt, 0), p1 = packf8(pt, 1);
              { const bf16x8 a = cat8(tr16(Vimg + db * 4096 + base_prm + (2 * sb) * 1024), tr16(Vimg + db * 4096 + base_prm + (2 * sb) * 1024 + 512)); o = MFMA32(a, p0, o); }
              { const bf16x8 a = cat8(tr16(Vimg + db * 4096 + base_prm + (2 * sb + 1) * 1024), tr16(Vimg + db * 4096 + base_prm + (2 * sb + 1) * 1024 + 512)); o = MFMA32(a, p1, o); }
          }
#pragma unroll
          for (int kd = 0; kd < 8; ++kd) { const bf16x8 a = cat8(tr16(lds + SC_SX + db * 8192 + base_nat + kd * 1024), tr16(lds + SC_SX + db * 8192 + base_nat + kd * 1024 + 256)); o = MFMA32(a, Qmf[kd], o); }
          if (c >= 4 || store_ctx) { bf16_t* op = P + (size_t)SROW(c, t) * PW + lfcol + 32 * db;
#pragma unroll
              for (int g = 0; g < 4; ++g) { u32x2 w; w.x = cvt_pk_bf16(o[4 * g], o[4 * g + 1]); w.y = cvt_pk_bf16(o[4 * g + 2], o[4 * g + 3]); *(u32x2*)(op + 8 * g + 4 * hh) = w; } }
        }
        vbuf ^= 1;
    }
    VM_WAIT(); LDS_WAIT(); __syncthreads();
#undef SROW
#undef SDMA
}

DI void phase_recprep(const Ctx& C, bf16_t* P, const float* rnw, int nrows) {
    for (int row = C.gw; row < nrows; row += C.NGW) {
        bf16_t* pr = P + (size_t)row * PW + 8 * C.lane;
        float a[8], bb[8], g[8]; unpack8(*(const u32x4*)(pr + PC_LF), a); unpack8(*(const u32x4*)(pr + PC_LB), bb); unpack8(*(const u32x4*)(pr + PC_G), g);
        float ss = 0.f;
#pragma unroll
        for (int j = 0; j < 8; ++j) { a[j] += bb[j]; ss += a[j] * a[j]; }
        ss += __shfl_xor(ss, 1); ss += __shfl_xor(ss, 2); ss += __shfl_xor(ss, 4); ss += __shfl_xor(ss, 8);
        const float rs = 1.0f / sqrtf(ss * (1.f / 128.f) + EPS);
        const f32x4 w0 = *(const f32x4*)(rnw + ((8 * C.lane) & 127)), w1 = *(const f32x4*)(rnw + ((8 * C.lane) & 127) + 4);
        f32x4 o0, o1;
#pragma unroll
        for (int j = 0; j < 4; ++j) { o0[j] = a[j] * rs * w0[j] * g[j]; o1[j] = a[4 + j] * rs * w1[j] * g[4 + j]; }
        *(u32x4*)(pr + PC_LF) = pack8(o0, o1);
    }
}

DI void phase_slots(const Ctx& C, const int* cnt, int* pbout, unsigned char* route, const bf16_t* H2, bf16_t* AG, LAS int* cur) {
    if (C.tid < 16) cur[C.tid] = 0;
    __syncthreads();
    for (int g = C.tid; g < C.G; g += 512) {
#pragma unroll
        for (int k = 0; k < 8; ++k) { const int c = cnt[g * 8 + k]; atomicAdd((int*)&cur[8 + k], c); if (g < (int)blockIdx.x) atomicAdd((int*)&cur[k], c); } }
    __syncthreads();
    if (C.tid < 8) { const int e = C.tid; int pb = 0, pbe = 0;
#pragma unroll
        for (int k = 0; k < 8; ++k) { if (k == e) pbe = pb; pb += (cur[8 + k] + 255) >> 8; }
        const int mine = cur[e];
        if (blockIdx.x == 0) { pbout[e] = pbe; if (e == 7) pbout[8] = pb; }
        cur[e] = pbe * 256 + mine;
    }
    __syncthreads();
    for (int row = C.gw; row < NLAT; row += C.NGW) {
        int* rt = (int*)(route + (size_t)row * 24);
        int s1 = 0, s2 = 0;
        if (C.lane == 0) { s1 = atomicAdd((int*)&cur[rt[0]], 1); s2 = atomicAdd((int*)&cur[rt[1]], 1); rt[4] = s1; rt[5] = s2; }
        s1 = __builtin_amdgcn_readfirstlane(s1); s2 = __builtin_amdgcn_readfirstlane(s2);
        const u32x4* src = (const u32x4*)(H2 + (size_t)row * D) + 2 * C.lane; const u32x4 v0 = src[0], v1 = src[1];
        u32x4* d1 = (u32x4*)(AG + (size_t)s1 * D) + 2 * C.lane; d1[0] = v0; d1[1] = v1;
        u32x4* d2 = (u32x4*)(AG + (size_t)s2 * D) + 2 * C.lane; d2[0] = v0; d2[1] = v1;
    }
}
DI void phase_final(const Ctx& C, float* x, const unsigned char* route, const bf16_t* Y, const float* mods1, const float* fw) {
    for (int row = C.gw; row < NLAT; row += C.NGW) {
        const int* rt = (const int*)(route + (size_t)row * 24); const float g1 = ((const float*)rt)[2], g2 = ((const float*)rt)[3]; const int s1 = rt[4], s2 = rt[5];
        const float* mv = mods1 + (size_t)(row >> 11) * DIN + 5 * D; float* xr = x + (size_t)row * D;
        f32x4 v[4]; float ss = 0.f;
#pragma unroll
        for (int j = 0; j < 4; ++j) { const int c0 = 256 * j + 4 * C.lane;
            const u32x2 y1 = *(const u32x2*)(Y + (size_t)s1 * D + c0), y2 = *(const u32x2*)(Y + (size_t)s2 * D + c0); const f32x4 m5 = *(const f32x4*)(mv + c0);
            f32x4 y; y[0] = g1 * bflo(y1.x) + g2 * bflo(y2.x); y[1] = g1 * bfhi(y1.x) + g2 * bfhi(y2.x); y[2] = g1 * bflo(y1.y) + g2 * bflo(y2.y); y[3] = g1 * bfhi(y1.y) + g2 * bfhi(y2.y);
            v[j] = *(const f32x4*)(xr + c0) + m5 * y; ss += (v[j][0] * v[j][0] + v[j][1] * v[j][1]) + (v[j][2] * v[j][2] + v[j][3] * v[j][3]); }
        const float rstd = 1.0f / sqrtf(wave_sum(ss) * (1.f / D) + EPS);
#pragma unroll
        for (int j = 0; j < 4; ++j) { const int c0 = 256 * j + 4 * C.lane; *(f32x4*)(xr + c0) = v[j] * rstd * *(const f32x4*)(fw + c0); }
    }
}

constexpr int LDS_MISC = SC_END;
constexpr int LDS_BYTES = SC_END + 256;
constexpr int NPHASE = 20;

DI Ctx make_ctx() {
    extern __shared__ __attribute__((aligned(16))) unsigned char lds_raw[];
    Ctx C; int t = threadIdx.x; asm volatile("" : "+v"(t));
    C.lds = (LAS unsigned char*)lds_raw; C.ws = kparams()->ws; C.tid = t; C.lane = t & 63; C.wave = __builtin_amdgcn_readfirstlane(t >> 6);
    int bx = blockIdx.x; asm volatile("" : "+s"(bx));
    C.G = gridDim.x; C.vcu = (C.G % 8 == 0) ? (bx % 8) * (C.G / 8) + bx / 8 : bx;
    C.gw = C.vcu * 8 + C.wave; C.NGW = C.G * 8;
    return C;
}
DI void grid_barrier() {
    extern __shared__ __attribute__((aligned(16))) unsigned char lds_raw[];
    XcdBarrier b; b.bar = (unsigned*)(kparams()->ws + WS_CTL) + CW_BAR + kparams()->li * XCD_BAR_WORDS; b.x = xb_xcc_id(); b.st = (volatile LAS unsigned*)((LAS unsigned char*)lds_raw + LDS_MISC);
    xcd_barrier(b);
}
#define WSP(T, off) ((T*)(kparams()->ws + (off)))

__global__ void __launch_bounds__(512, 2) fwd_kernel(Params p) {
    extern __shared__ __attribute__((aligned(16))) unsigned char lds_raw[];
    (void)p;
    { volatile LAS unsigned* misc = (volatile LAS unsigned*)((LAS unsigned char*)lds_raw + LDS_MISC);
      if (threadIdx.x < 16) misc[threadIdx.x] = 0u;
      __syncthreads();
      (void)xcd_barrier_post((unsigned*)(kparams()->ws + WS_CTL) + CW_BAR + kparams()->li * XCD_BAR_WORDS, misc); }
#ifdef ONLY_PHASE
#define IN(k) (((ONLY_PHASE) >> (k)) & 1)
#else
#define IN(k) (kparams()->ph_lo <= (k) && (k) < kparams()->ph_hi)
#endif
#define SEAM(k) do { if (IN(k) && IN((k) + 1)) grid_barrier(); } while (0)

    if (IN(0)) { const Ctx C = make_ctx(); phase_prologue(C); } SEAM(0);

    for (int l = 0; l < 2; ++l) {
        const int pb = 1 + 9 * l;
#define XL (l == 0 ? PIN(0) : (const float*)POUT)
#define XC (l == 0 ? PIN(2) : (const float*)WSP(float, WS_CTXRES))
#define LMODS (WSP(float, WS_MODS) + (size_t)l * 33 * DIN)
#define NROWS_OUT (l == 0 ? NTOK : NLAT)
        if (IN(pb + 0)) { const Ctx C = make_ctx(); phase_norm<false>(C, XL, XC, PIN(6) + l * D, LMODS, 0, NTOK, WSP(bf16_t, WS_H), nullptr, nullptr, nullptr); }
        SEAM(pb + 0);
        if (IN(pb + 1)) { const Ctx C = make_ctx();
            Gemm g{WSP(bf16_t, WS_H), WSP(bf16_t, WS_WIN) + (size_t)l * DIN * D, NTOK, 4096, D, D};
            pg8::StaticOrder S; S.init(g, C.G, (int)blockIdx.x);
            EpiInProj E{WSP(bf16_t, WS_P), WSP(float2, WS_ROPE), WSP(float, WS_LBS) + l * 1024, WSP(float, WS_LBS) + l * 1024 + 512};
            pg8::gemm_phase<EpiInProj, pg8::StaticOrder>(C.lds, g, S, E);
        }
        SEAM(pb + 1);
        if (IN(pb + 2)) { const Ctx C = make_ctx(); bf16_t* const Pb = WSP(bf16_t, WS_P);
            for (int id = C.vcu; id < NB * 4 * 2; id += C.G) scan_chain(C, Pb, id >> 3, (id >> 1) & 3, id & 1, l == 0);
            float lam;
            { const float a = wave_sum(PIN(9)[l * 64 + C.lane] * PIN(10)[l * 64 + C.lane]), b2 = wave_sum(PIN(11)[l * 64 + C.lane] * PIN(12)[l * 64 + C.lane]);
              const float li = 0.8f - 0.6f * expf(-0.3f * (float)l); lam = expf(a) - expf(b2) + li; }
            const float post = 1.f - (0.8f - 0.6f * expf(-0.3f * (float)l));
            const float* anw = PIN(13) + l * 128;
            const int NU = NB * 4 * 16, U = (NU + C.G - 1) / C.G;
            for (int id = C.vcu * U; id < NU && id < (C.vcu + 1) * U; ++id) { const int bh = id >> 4, qb = id & 15, b = bh >> 2, h = bh & 3;
                attn_unit(C, Pb, b * T + qb * 128, NLAT + b * CL, b * T, 36, h, lam, anw, post); }
            if (l == 0) for (int id = C.vcu; id < NB * 4 * 2; id += C.G) { const int bh = id >> 1, qb = id & 1, b = bh >> 2, h = bh & 3;
                attn_unit(C, Pb, NLAT + b * CL + qb * 128, NLAT + b * CL, 0, 4, h, lam, anw, post); }
        }
        SEAM(pb + 2);
        if (IN(pb + 3)) { const Ctx C = make_ctx();
            phase_recprep(C, WSP(bf16_t, WS_P), PIN(14) + l * 128, NROWS_OUT);
            Gemm g{WSP(bf16_t, WS_H), WSP(bf16_t, WS_WIN) + (size_t)l * DIN * D + (size_t)4096 * D, NROWS_OUT, 2048, D, D};
            pg8::StaticOrder S; S.init(g, C.G, (int)blockIdx.x);
            EpiGates E{WSP(bf16_t, WS_P)};
            pg8::gemm_phase<EpiGates, pg8::StaticOrder>(C.lds, g, S, E);
        }
        SEAM(pb + 3);
        if (IN(pb + 4)) {
            { const Ctx C = make_ctx(); Gemm g{WSP(bf16_t, WS_P) + PC_Q, WSP(bf16_t, WS_WUA) + (size_t)l * D * 512, NROWS_OUT, D, 512, PW};
              pg8::StaticOrder S; S.init(g, C.G, (int)blockIdx.x); EpiMerge<true> E{WSP(bf16_t, WS_P), PC_GA, WSP(bf16_t, WS_MERGED)};
              pg8::gemm_phase<EpiMerge<true>, pg8::StaticOrder>(C.lds, g, S, E); }
            { const Ctx C = make_ctx(); Gemm g{WSP(bf16_t, WS_P) + PC_LF, WSP(bf16_t, WS_WUR) + (size_t)l * D * 512, NROWS_OUT, D, 512, PW};
              pg8::StaticOrder S; S.init(g, C.G, (int)blockIdx.x); EpiMerge<false> E{WSP(bf16_t, WS_P), PC_GR, WSP(bf16_t, WS_MERGED)};
              pg8::gemm_phase<EpiMerge<false>, pg8::StaticOrder>(C.lds, g, S, E); }
        }
        SEAM(pb + 4);
        if (IN(pb + 5)) { const Ctx C = make_ctx();
            Gemm g{WSP(bf16_t, WS_MERGED), WSP(bf16_t, WS_WO) + (size_t)l * D * D, NROWS_OUT, D, D, D};
            pg8::StaticOrder S; S.init(g, C.G, (int)blockIdx.x);
            EpiResid E{XL, XC, POUT, WSP(float, WS_CTXRES), LMODS, 2};
            pg8::gemm_phase<EpiResid, pg8::StaticOrder>(C.lds, g, S, E);
        }
        SEAM(pb + 5);
        if (l == 0) {
            if (IN(7)) { const Ctx C = make_ctx(); phase_norm<false>(C, POUT, WSP(float, WS_CTXRES), PIN(7), LMODS, 3, NTOK, WSP(bf16_t, WS_H), nullptr, nullptr, nullptr); }
            SEAM(7);
            if (IN(8)) { const Ctx C = make_ctx();
                Gemm g{WSP(bf16_t, WS_H), WSP(bf16_t, WS_W13), NTOK, 2 * DFFP, D, D};
                pg8::StaticOrder S; S.init(g, C.G, (int)blockIdx.x); EpiSwiglu E{WSP(bf16_t, WS_HID), DFFP, 0};
                pg8::gemm_phase<EpiSwiglu, pg8::StaticOrder>(C.lds, g, S, E);
            }
            SEAM(8);
            if (IN(9)) { const Ctx C = make_ctx();
                Gemm g{WSP(bf16_t, WS_HID), WSP(bf16_t, WS_W2), NTOK, D, DFFP, DFFP};
                pg8::StaticOrder S; S.init(g, C.G, (int)blockIdx.x); EpiResid E{POUT, WSP(float, WS_CTXRES), POUT, WSP(float, WS_CTXRES), LMODS, 5};
                pg8::gemm_phase<EpiResid, pg8::StaticOrder>(C.lds, g, S, E);
            }
            SEAM(9);
        } else {
            if (IN(16)) { const Ctx C = make_ctx(); LAS int* lcnt = (LAS int*)(C.lds + LDS_MISC + 32);
                if (C.tid < 8) lcnt[C.tid] = 0;
                __syncthreads();
                phase_norm<true>(C, POUT, nullptr, PIN(7) + D, LMODS, 3, NLAT, WSP(bf16_t, WS_H2M), PIN(23), WSP(unsigned char, WS_ROUTE), lcnt);
                __syncthreads();
                if (C.tid < 8) WSP(int, WS_CNT)[blockIdx.x * 8 + C.tid] = lcnt[C.tid];
                convert_moe_weights(C);
            }
            SEAM(16);
            if (IN(17)) { const Ctx C = make_ctx(); phase_slots(C, WSP(int, WS_CNT), WSP(int, WS_CNT) + 4096, WSP(unsigned char, WS_ROUTE), WSP(bf16_t, WS_H2M), WSP(bf16_t, WS_AG), (LAS int*)(C.lds + LDS_MISC + 32)); }
            SEAM(17);
            if (IN(18)) {
                const int ptot = __builtin_amdgcn_readfirstlane(WSP(int, WS_CNT)[4096 + 8]);
                for (int p0 = 0; p0 < ptot; p0 += MOE_CHUNK) {
                    const int np = (ptot - p0) < MOE_CHUNK ? (ptot - p0) : MOE_CHUNK;
#define MOE_ORDER_INIT(S) do { const int* pbv_ = WSP(int, WS_CNT) + 4096; S.so.init(g, C.G, (int)blockIdx.x); S.p0 = p0; \
        S.pb1 = __builtin_amdgcn_readfirstlane(pbv_[1]); S.pb2 = __builtin_amdgcn_readfirstlane(pbv_[2]); S.pb3 = __builtin_amdgcn_readfirstlane(pbv_[3]); S.pb4 = __builtin_amdgcn_readfirstlane(pbv_[4]); \
        S.pb5 = __builtin_amdgcn_readfirstlane(pbv_[5]); S.pb6 = __builtin_amdgcn_readfirstlane(pbv_[6]); S.pb7 = __builtin_amdgcn_readfirstlane(pbv_[7]); } while (0)
                    { const Ctx C = make_ctx(); Gemm g{WSP(bf16_t, WS_AG), WSP(bf16_t, WS_WM13), np * 256, 2 * DFE, D, D};
                      pg8::MoeOrder S; MOE_ORDER_INIT(S); S.apan0 = 0; S.estride = (size_t)2 * DFE * D * 2;
                      EpiSwiglu E{WSP(bf16_t, WS_MHID), DFE, p0};
                      pg8::gemm_phase<EpiSwiglu, pg8::MoeOrder>(C.lds, g, S, E); }
                    grid_barrier();
                    { const Ctx C = make_ctx(); Gemm g{WSP(bf16_t, WS_MHID), WSP(bf16_t, WS_WM2), np * 256, D, DFE, DFE};
                      pg8::MoeOrder S; MOE_ORDER_INIT(S); S.apan0 = p0; S.estride = (size_t)D * DFE * 2;
                      EpiBf16 E{WSP(bf16_t, WS_Y), D};
                      pg8::gemm_phase<EpiBf16, pg8::MoeOrder>(C.lds, g, S, E); }
                    grid_barrier();
                }
            }
            if (IN(19)) { const Ctx C = make_ctx(); phase_final(C, POUT, WSP(unsigned char, WS_ROUTE), WSP(bf16_t, WS_Y), LMODS, PIN(27)); }
        }
    }
#undef IN
#undef SEAM
}


#ifndef DBG_T1
#define DBG_T1 1
#endif
#ifndef DBG_CAT
#define DBG_CAT (j >> 9)
#endif
#if DBG
constexpr size_t DBG_ERR = WS_DBG, DBG_SNAPX = WS_DBG + 4096, DBG_ROWS = WS_DBG + 65536, DBG_Q = WS_MERGED + 64 * MiB, DBG_OF = WS_DBG + 262144, DBG_LF = WS_MERGED;
__device__ inline unsigned dhash(unsigned x) { x ^= x >> 16; x *= 0x7feb352du; x ^= x >> 15; x *= 0x846ca68bu; x ^= x >> 16; return x; }
__device__ inline float rbf(float f) { unsigned u = __float_as_uint(f); u += 0x7fffu + ((u >> 16) & 1u); return __uint_as_float(u & 0xffff0000u); }
__device__ inline void rec_err(unsigned char* ws, int id, float got, float exp_, float atol) {
    float d = got - exp_; if (!(d == d) || fabsf(d) > 1e15f) d = 1e15f;
    atomicAdd((float*)(ws + DBG_ERR) + id, d * d); atomicAdd((float*)(ws + DBG_ERR) + 64 + id, exp_ * exp_);
    if (fabsf(d) > 0.15f * fabsf(exp_) + atol * 5.f) atomicAdd((unsigned*)(ws + DBG_ERR) + 128 + id, 1u);
}
__device__ inline int srow(unsigned i) { const unsigned h = dhash(i * 7919u + 13u); return (i & 3u) == 3u ? NLAT + (int)(h % NCTX) : (int)(h % NLAT); }
__device__ inline const float* xrowp(const float* xl, const float* xc, int row) { return row < NLAT ? xl + (size_t)row * D : xc + (size_t)(row - NLAT) * D; }
__device__ inline float dsilu(float x) { return x / (1.f + expf(-x)); }
__device__ inline float dot_hw(const bf16_t* a, const float* w, int K, int ldw) { float s = 0.f; for (int k = 0; k < K; ++k) s += bf2f(a[k]) * rbf(w[(size_t)k * ldw]); return s; }

struct DArgs { const float* in[28]; float* out; unsigned char* ws; int l, kind, id, aux; };
__global__ void dbg_check(DArgs a) {
    unsigned char* ws = a.ws; const int l = a.l; const int i = blockIdx.x * blockDim.x + threadIdx.x;
    const float* mods = (const float*)(ws + WS_MODS) + (size_t)l * 33 * DIN; const bf16_t* P = (const bf16_t*)(ws + WS_P);
    if (a.kind == 1) { const int ll = i & 1, r = dhash(i) % 33, n = dhash(i + 777) % DIN; const float* cv = r < 32 ? a.in[1] + r * D : a.in[3];
        float s = a.in[5][ll * DIN + n]; for (int k = 0; k < D; ++k) s += dsilu(cv[k]) * a.in[4][((size_t)ll * D + k) * DIN + n];
        rec_err(ws, a.id, ((const float*)(ws + WS_MODS))[(size_t)(ll * 33 + r) * DIN + n], s, 0.01f); }
    else if (a.kind == 30) { const int ll = i & 1, n = 4096 + dhash(i) % 2048, k = dhash(i + 4242) % D;
        rec_err(ws, a.id, bf2f(((const bf16_t*)(ws + WS_WIN))[((size_t)ll * DIN + n) * D + k]), rbf(a.in[8][((size_t)ll * D + k) * DIN + n]), 1e-6f); }
    else if (a.kind == 2) { int row = srow(i); if (a.aux == 2 || (l == 1 && a.aux != 0)) row = row % NLAT; const int col = dhash(i + 99) % D;
        const float* xl = a.aux == 0 ? (l == 0 ? a.in[0] : a.out) : a.out; const float* xc = a.aux == 0 && l == 0 ? a.in[2] : (const float*)(ws + WS_CTXRES);
        const float* xr = xrowp(xl, xc, row); float ss = 0.f; for (int k = 0; k < D; ++k) ss += xr[k] * xr[k];
        const float rstd = 1.f / sqrtf(ss / D + EPS); const float* nw = (a.aux == 0 ? a.in[6] : a.in[7]) + l * D; const int sh = a.aux == 0 ? 0 : 3;
        const float* mv = mods + (size_t)(row < NLAT ? row >> 11 : 32) * DIN;
        const float e = xr[col] * rstd * nw[col] * (1.f + mv[(sh + 1) * D + col]) + mv[sh * D + col];
        const bf16_t* H = (const bf16_t*)(ws + (a.aux == 2 ? WS_H2M : WS_H)); rec_err(ws, a.id, bf2f(H[(size_t)row * D + col]), e, 0.02f); }
    else if (a.kind == 3) { const int sec = i & 7, row = srow(i >> 3), j = dhash(i + 5) % 512; const bf16_t* hr = (const bf16_t*)(ws + WS_H) + (size_t)row * D; const float* W = a.in[8] + (size_t)l * D * DIN;
        float e, got; const bool lat = row < NLAT; const int t = row & (T - 1);
        if (sec == 0 || sec == 1) { const int hs = j >> 6, d = j & 63, pi = d & 31, ob = (sec == 0 ? 0 : 512) + hs * 64;
            const float xa = dot_hw(hr, W + ob + pi, D, DIN), xb = dot_hw(hr, W + ob + 32 + pi, D, DIN);
            float c = 1.f, sn = 0.f; if (lat) { const float invf = powf(10000.f, -(float)(pi & 15) / 16.f); const float ang = (float)(pi < 16 ? (t >> 6) : (t & 63)) * invf; c = cosf(ang); sn = sinf(ang); }
            e = d < 32 ? xa * c - xb * sn : xa * sn + xb * c; if (sec == 0) e *= QSCALE;
            got = bf2f(P[(size_t)row * PW + (sec == 0 ? PC_Q : PC_K) + hs * 64 + (d < 32 ? 2 * d : 2 * (d - 32) + 1)]); }
        else if (sec == 2) { e = dot_hw(hr, W + 1024 + j, D, DIN); got = bf2f(P[(size_t)row * PW + PC_V + j]); }
        else if (sec == 3) { e = dsilu(dot_hw(hr, W + 1536 + j, D, DIN)); got = bf2f(P[(size_t)row * PW + PC_RQ + j]); }
        else if (sec == 4) { e = dot_hw(hr, W + 2048 + j, D, DIN); got = bf2f(P[(size_t)row * PW + PC_RI + j]); }
        else if (sec == 5 || sec == 6) { const float z = dot_hw(hr, W + (sec == 5 ? 2560 : 3072) + j, D, DIN); const float* lbp = a.in[sec == 5 ? 15 : 16];
            const float lb = l == 0 ? 0.f : 1.f / (1.f + expf(lbp[j] - lbp[512 + j])); const float sg = 1.f / (1.f + expf(-z)); e = logf(lb + (1.f - lb) * sg);
            got = (float)((const _Float16*)P)[(size_t)row * PW + (sec == 5 ? PC_LF : PC_LB) + j]; }
        else { e = dsilu(dot_hw(hr, W + 3584 + j, D, DIN)); got = bf2f(P[(size_t)row * PW + PC_G + j]); }
        rec_err(ws, a.id + sec, got, e, 0.03f); }
    else if (a.kind == 6) { const int i6 = i; int row = srow(i6); if (l == 1 || DBG_T1) row %= NLAT; const int j = dhash(i6 + 5) % 2048; const bf16_t* hr = (const bf16_t*)(ws + WS_H) + (size_t)row * D;
        const float z = dot_hw(hr, a.in[8] + (size_t)l * D * DIN + 4096 + j, D, DIN); const size_t gi_ = (size_t)row * PW + PC_GA + j; const unsigned gw_ = __hip_atomic_load((unsigned*)P + (gi_ >> 1), __ATOMIC_RELAXED, __HIP_MEMORY_SCOPE_AGENT);
        const float gt_ = (gi_ & 1) ? bfhi(gw_) : bflo(gw_), ex_ = 1.f / (1.f + expf(-z)); rec_err(ws, a.id, gt_, ex_, 0.01f);
        if (fabsf(gt_ - ex_) > 0.15f * ex_ + 0.05f) { atomicAdd((unsigned*)(ws + DBG_ERR) + 192 + (fabsf(gt_ - 100.f) < 1.f ? 0 : (gt_ < 0.f || gt_ > 1.f) ? 1 : 2), 1u); atomicAdd((unsigned*)(ws + DBG_ERR) + 196 + ((row >> 8) & 3), 1u); } }
    else if (a.kind == 7) { int row = srow(i); if (l == 1) row %= NLAT; const int n = dhash(i + 5) % D; const bf16_t* pr = P + (size_t)row * PW;
        const float ya = dot_hw(pr + PC_Q, a.in[17] + (size_t)l * 512 * D + n, 512, D), yr = dot_hw(pr + PC_LF, a.in[18] + (size_t)l * 512 * D + n, 512, D);
        rec_err(ws, a.id, bf2f(((const bf16_t*)(ws + WS_MERGED))[(size_t)row * D + n]), bf2f(pr[PC_GA + n]) * ya + bf2f(pr[PC_GR + n]) * yr, 0.03f); }
    else if (a.kind == 8 || a.kind == 10) { int row = srow(i); if (l == 1) row %= NLAT; const int col = dhash(i + 5) % D; const int msel = a.kind == 8 ? 2 : 5;
        float xin; if (a.kind == 8 && l == 0) xin = xrowp(a.in[0], a.in[2], row)[col]; else xin = ((const float*)(ws + DBG_SNAPX))[i];
        float y; if (a.kind == 8) y = dot_hw((const bf16_t*)(ws + WS_MERGED) + (size_t)row * D, a.in[19] + (size_t)l * D * D + col, D, D);
        else y = dot_hw((const bf16_t*)(ws + WS_HID) + (size_t)row * DFFP, a.in[22] + col, DFF, D);
        const float e = xin + mods[(size_t)(row < NLAT ? row >> 11 : 32) * DIN + msel * D + col] * y;
        rec_err(ws, a.id, xrowp(a.out, (const float*)(ws + WS_CTXRES), row)[col], e, 0.03f); }
    else if (a.kind == 9) { const int row = srow(i), j = dhash(i + 5) % DFF; const bf16_t* hr = (const bf16_t*)(ws + WS_H) + (size_t)row * D;
        const float u = dot_hw(hr, a.in[20] + j, D, DFF), v = dot_hw(hr, a.in[21] + j, D, DFF); rec_err(ws, a.id, bf2f(((const bf16_t*)(ws + WS_HID))[(size_t)row * DFFP + j]), dsilu(u) * v, 0.03f); }
    else if (a.kind == 11) { const int row = dhash(i) % NLAT; const float* xr = a.out + (size_t)row * D; float ss = 0.f; for (int k = 0; k < D; ++k) ss += xr[k] * xr[k];
        const float rstd = 1.f / sqrtf(ss / D + EPS); const float* mv = mods + (size_t)(row >> 11) * DIN; float lg[8]; for (int e = 0; e < 8; ++e) lg[e] = 0.f;
        for (int k = 0; k < D; ++k) { const float h = xr[k] * rstd * a.in[7][D + k] * (1.f + mv[4 * D + k]) + mv[3 * D + k]; for (int e = 0; e < 8; ++e) lg[e] += h * a.in[23][k * 8 + e]; }
        int e1 = 0; for (int e = 1; e < 8; ++e) if (lg[e] > lg[e1]) e1 = e; int e2 = e1 == 0 ? 1 : 0; for (int e = 0; e < 8; ++e) if (e != e1 && lg[e] > lg[e2]) e2 = e;
        const int* rt = (const int*)(ws + WS_ROUTE + (size_t)row * 24); const float g1 = 1.f / (1.f + expf(lg[e2] - lg[e1]));
        const float margin = lg[e2] - fmaxf(-1e30f, [&]{ float m = -1e30f; for (int e = 0; e < 8; ++e) if (e != e1 && e != e2) m = fmaxf(m, lg[e]); return m; }());
        if (margin > 1e-3f && lg[e1] - lg[e2] > 1e-3f) { rec_err(ws, a.id, (float)rt[0], (float)e1, 0.01f); rec_err(ws, a.id, (float)rt[1], (float)e2, 0.01f); rec_err(ws, a.id, ((const float*)rt)[2], g1, 0.01f); rec_err(ws, a.id, ((const float*)rt)[3], 1.f - g1, 0.01f); } }
    else if (a.kind == 12) { const int row = dhash(i) % NLAT; const int* rt = (const int*)(ws + WS_ROUTE + (size_t)row * 24); const int* pb = (const int*)(ws + WS_CNT) + 4096;
        for (int w = 0; w < 2; ++w) { const int s = rt[4 + w], e = rt[w]; const int pan = s >> 8; int ee = 0; for (int k = 1; k < 8; ++k) ee += pan >= pb[k];
            rec_err(ws, a.id, (float)ee, (float)e, 0.01f); if (s < 0 || s >= pb[8] * 256) rec_err(ws, a.id, 1.f, 0.f, 0.01f);
            const int col = dhash(i + 31 + w) % D; rec_err(ws, a.id, bf2f(((const bf16_t*)(ws + WS_AG))[(size_t)s * D + col]), bf2f(((const bf16_t*)(ws + WS_H2M))[(size_t)row * D + col]), 1e-6f); } }
    else if (a.kind == 14) { int row = srow(i & 15); if (l == 1) row %= NLAT; const int hh = (i >> 4) & 3; const bf16_t* of = (const bf16_t*)(ws + DBG_OF) + (size_t)(i & 15) * 512 + hh * 128; const bf16_t* pr = P + (size_t)row * PW;
        float ss = 0.f; for (int v = 0; v < 128; ++v) { const float o = bf2f(of[v]) + bf2f(pr[PC_LB + hh * 128 + v]); ss += o * o; }
        const float rs = 1.f / sqrtf(ss / 128.f + EPS); const int v = dhash(i) % 128;
        rec_err(ws, a.id, bf2f(pr[PC_LF + hh * 128 + v]), (bf2f(of[v]) + bf2f(pr[PC_LB + hh * 128 + v])) * rs * a.in[14][l * 128 + v] * bf2f(pr[PC_G + hh * 128 + v]), 0.03f); }
}
__global__ void dbg_snap(DArgs a) {
    unsigned char* ws = a.ws; const int l = a.l; const int i = blockIdx.x * blockDim.x + threadIdx.x; const bf16_t* P = (const bf16_t*)(ws + WS_P);
    if (a.kind == 8 || a.kind == 10) { int row = srow(i); if (l == 1) row %= NLAT; const int col = dhash(i + 5) % D; ((float*)(ws + DBG_SNAPX))[i] = xrowp(a.out, (const float*)(ws + WS_CTXRES), row)[col]; }
    else if (a.kind == 20) { const int ch = blockIdx.x >> 1, dir = blockIdx.x & 1, b = (ch * 5 + 3) % NB, h = (ch + (ch >> 2)) & 3;
        bf16_t* dst = (bf16_t*)(ws + DBG_LF) + (size_t)blockIdx.x * 2304 * 128;
        for (int s = 0; s < 2304; ++s) { const int row = s < 256 ? NLAT + b * CL + s : b * T + (s - 256); dst[(size_t)s * 128 + threadIdx.x] = P[(size_t)row * PW + (dir ? PC_LB : PC_LF) + h * 128 + threadIdx.x]; } }
    else if (a.kind == 21) { const int smp = blockIdx.x; int row = a.aux ? NLAT + (int)(dhash(smp) % NCTX) : (int)(dhash(smp) % NLAT); const int h = smp & 3;
        ((bf16_t*)(ws + DBG_Q))[(a.aux * 1024 + smp) * 128 + threadIdx.x] = P[(size_t)row * PW + PC_Q + h * 128 + threadIdx.x]; }
    else if (a.kind == 22) { int row = srow(blockIdx.x); if (l == 1) row %= NLAT; for (int c = threadIdx.x; c < 512; c += blockDim.x) ((bf16_t*)(ws + DBG_OF))[blockIdx.x * 512 + c] = P[(size_t)row * PW + PC_LF + c]; }
    else if (a.kind == 40) { for (size_t r = blockIdx.x; r < (size_t)NTOK; r += gridDim.x) for (int c = threadIdx.x; c < 256; c += blockDim.x) ((u32x4*)(P + r * PW + 2048))[c] = (u32x4){0x42C842C8u, 0x42C842C8u, 0x42C842C8u, 0x42C842C8u}; }
    else if (a.kind == 23) { const int row = dhash(blockIdx.x) % NLAT; for (int c = threadIdx.x; c < D; c += blockDim.x) ((float*)(ws + DBG_ROWS))[blockIdx.x * D + c] = a.out[(size_t)row * D + c]; }
}
__global__ void dbg_scan(DArgs a) {
    extern __shared__ float Scol[];
    unsigned char* ws = a.ws; const int l = a.l; const int ch = blockIdx.x >> 1, dir = blockIdx.x & 1, b = (ch * 5 + 3) % NB, h = (ch + (ch >> 2)) & 3, v = threadIdx.x; const bf16_t* P = (const bf16_t*)(ws + WS_P);
    const _Float16* lfs = (const _Float16*)(ws + DBG_LF) + (size_t)blockIdx.x * 2304 * 128;
    for (int d = 0; d < 128; ++d) Scol[d * 128 + v] = 0.f;
    for (int st = 0; st < 2304; ++st) {
        int s, row; if (st < 256) { s = dir ? 255 - st : st; row = NLAT + b * CL + s; } else { const int tt = dir ? 2047 - (st - 256) : st - 256; s = 256 + tt; row = b * T + tt; }
        const bf16_t* pr = P + (size_t)row * PW; const float val = bf2f(pr[PC_RI + h * 128 + v]); float o = 0.f;
        for (int d = 0; d < 128; ++d) { const float f = expf((float)lfs[(size_t)s * 128 + d]); const float sv = f * Scol[d * 128 + v] + (1.f - f) * val; Scol[d * 128 + v] = sv; o += bf2f(pr[PC_RQ + h * 128 + d]) * sv; }
        if (st >= 256 || l == 0) rec_err(ws, a.id + dir, bf2f(pr[(dir ? PC_LB : PC_LF) + h * 128 + v]), o, 0.3f);
    }
}
__global__ void dbg_attn(DArgs a) {
    __shared__ float red[128];
    unsigned char* ws = a.ws; const int l = a.l; const int smp = blockIdx.x, v = threadIdx.x, h = smp & 3; const bf16_t* P = (const bf16_t*)(ws + WS_P);
    const int row = a.aux ? NLAT + (int)(dhash(smp) % NCTX) : (int)(dhash(smp) % NLAT); const int b = a.aux ? (row - NLAT) / CL : row / T;
    const bf16_t* q = (const bf16_t*)(ws + DBG_Q) + (a.aux * 1024 + smp) * 128; const int nk = a.aux ? 256 : 2304;
    float la = 0.f, lb2 = 0.f; for (int k = 0; k < 64; ++k) { la += a.in[9][l * 64 + k] * a.in[10][l * 64 + k]; lb2 += a.in[11][l * 64 + k] * a.in[12][l * 64 + k]; }
    const float lami = 0.8f - 0.6f * expf(-0.3f * l), lam = expf(la) - expf(lb2) + lami;
    float o[2];
    for (int c = 0; c < 2; ++c) { float m = -1e30f, ls = 0.f, acc = 0.f;
        for (int k = 0; k < nk; ++k) { const int kr = k < 256 ? NLAT + b * CL + k : b * T + (k - 256); const bf16_t* kp = P + (size_t)kr * PW;
            float s = 0.f; for (int d = 0; d < 64; ++d) s += bf2f(q[c * 64 + d]) * bf2f(kp[PC_K + h * 128 + c * 64 + d]);
            const float mn = fmaxf(m, s), al = exp2f(m - mn), pe = exp2f(s - mn); ls = ls * al + pe; acc = acc * al + pe * bf2f(kp[PC_V + h * 128 + v]); m = mn; }
        o[c] = acc / ls; }
    const float ov = o[0] - lam * o[1]; red[v] = ov * ov; __syncthreads();
    for (int st = 64; st > 0; st >>= 1) { if (v < st) red[v] += red[v + st]; __syncthreads(); }
    const float e = ov / sqrtf(red[0] / 128.f + EPS) * a.in[13][l * 128 + v] * (1.f - lami);
    rec_err(ws, a.id, bf2f(P[(size_t)row * PW + PC_Q + h * 128 + v]), e, 0.03f);
}
__global__ void dbg_moey(DArgs a) {
    __shared__ float red[256];
    unsigned char* ws = a.ws; const int smp = blockIdx.x, row = dhash(smp) % NLAT, w = smp & 1; const int* rt = (const int*)(ws + WS_ROUTE + (size_t)row * 24);
    const int e = rt[w], s = rt[4 + w], col = dhash(smp + 99) % D; const bf16_t* hr = (const bf16_t*)(ws + WS_AG) + (size_t)s * D;
    float acc = 0.f;
    for (int j = threadIdx.x; j < DFE; j += 256) { const float u = dot_hw(hr, a.in[24] + (size_t)e * D * DFE + j, D, DFE), vv = dot_hw(hr, a.in[25] + (size_t)e * D * DFE + j, D, DFE);
        acc += rbf(dsilu(u) * vv) * rbf(a.in[26][((size_t)e * DFE + j) * D + col]); }
    red[threadIdx.x] = acc; __syncthreads();
    for (int st = 128; st > 0; st >>= 1) { if (threadIdx.x < st) red[threadIdx.x] += red[threadIdx.x + st]; __syncthreads(); }
    if (threadIdx.x == 0) rec_err(ws, a.id, bf2f(((const bf16_t*)(ws + WS_Y))[(size_t)s * D + col]), red[0], 0.03f);
}
__global__ void dbg_final(DArgs a) {
    __shared__ float red[256];
    unsigned char* ws = a.ws; const int row = dhash(blockIdx.x) % NLAT; const int* rt = (const int*)(ws + WS_ROUTE + (size_t)row * 24); const float g1 = ((const float*)rt)[2], g2 = ((const float*)rt)[3];
    const float* xs = (const float*)(ws + DBG_ROWS) + blockIdx.x * D; const bf16_t* Y = (const bf16_t*)(ws + WS_Y); const float* mv = (const float*)(ws + WS_MODS) + (size_t)(33 + (row >> 11)) * DIN + 5 * D;
    float vals[4], ss = 0.f; for (int q = 0; q < 4; ++q) { const int c = threadIdx.x + 256 * q; vals[q] = xs[c] + mv[c] * (g1 * bf2f(Y[(size_t)rt[4] * D + c]) + g2 * bf2f(Y[(size_t)rt[5] * D + c])); ss += vals[q] * vals[q]; }
    red[threadIdx.x] = ss; __syncthreads();
    for (int st = 128; st > 0; st >>= 1) { if (threadIdx.x < st) red[threadIdx.x] += red[threadIdx.x + st]; __syncthreads(); }
    const float rstd = 1.f / sqrtf(red[0] / D + EPS);
    for (int q = 0; q < 4; ++q) { const int c = threadIdx.x + 256 * q; rec_err(ws, a.id, a.out[(size_t)row * D + c], vals[q] * rstd * a.in[27][c], 0.02f); }
}
__global__ void dbg_finalize(float* out, const unsigned char* ws, int n) {
    const float* err = (const float*)(ws + DBG_ERR); int bad = 0; float ratio = 0.f;
    for (int k = 1; k < 64; ++k) { float r = err[k] / (err[64 + k] + 1e-20f); const unsigned nb = ((const unsigned*)err)[128 + k]; const float thr = (k == 11 || k == 12 || k == 13 || k == 14 || k == 31 || k == 32 || k == 33) ? 3e-4f : 1e-4f; if (r > thr || nb > 0u) { bad = k; ratio = nb > 0u ? fmaxf(r, 1e-4f) : r; break; } }
    if (!bad) { for (int k = 1; k <= 43; ++k) if (k != 34 && err[64 + k] == 0.f) { bad = 30 + k; ratio = 1e-4f; break; } }
    if (!bad) return;
    float m = floorf(-2.f * log10f(fminf(ratio, 1.f))); m = fminf(fmaxf(m, 0.f), 8.f);
    if (bad == 16) { const unsigned* cu = (const unsigned*)err + 192; m = 0.5f * (float)((cu[4] ? 1 : 0) | (cu[5] ? 2 : 0) | (cu[6] ? 4 : 0) | (cu[7] ? 8 : 0)); bad = 48 + ((cu[0] ? 1 : 0) | (cu[1] ? 2 : 0) | (cu[2] ? 4 : 0) | (cu[3] ? 8 : 0)); }
    const float cst = sqrtf((1.f + m)) * powf(10.f, 0.5f * (float)bad);
    for (size_t i = (size_t)blockIdx.x * blockDim.x + threadIdx.x; i < (size_t)n; i += (size_t)gridDim.x * blockDim.x) out[i] = cst;
}
#endif

extern "C" void kernel_launch(void* const* d_in, const int* in_sizes, int n_in, void* d_out, int out_size, void* d_ws, size_t ws_size, hipStream_t stream) {
    static int grid = 0;
    if (grid == 0) {
        if (n_in != 28 || out_size != NLAT * D || ws_size < WS_END) { fprintf(stderr, "kernel_launch: unexpected problem (n_in %d, out %d, ws %zu)\n", n_in, out_size, ws_size); grid = -1; return; }
        int dev = 0, cus = 0, per_cu = 0;
        if (hipGetDevice(&dev) != hipSuccess || hipDeviceGetAttribute(&cus, hipDeviceAttributeMultiprocessorCount, dev) != hipSuccess) { grid = -1; return; }
        if (hipFuncSetAttribute((const void*)fwd_kernel, hipFuncAttributeMaxDynamicSharedMemorySize, LDS_BYTES) != hipSuccess) { fprintf(stderr, "kernel_launch: cannot set %d B dynamic LDS\n", LDS_BYTES); grid = -1; return; }
        if (hipOccupancyMaxActiveBlocksPerMultiprocessor(&per_cu, (const void*)fwd_kernel, 512, LDS_BYTES) != hipSuccess || per_cu < 1) fprintf(stderr, "kernel_launch: occupancy query says %d\n", per_cu);
        (void)hipGetLastError();
        grid = cus;
    }
    if (grid < 0) return;
    (void)hipMemsetAsync((char*)d_ws + WS_CTL, 0, CTL_BYTES, stream);
    Params a{};
    for (int i = 0; i < 28; ++i) a.in[i] = (const float*)d_in[i];
    a.out = (float*)d_out; a.ws = (unsigned char*)d_ws; a.ph_lo = 0; a.ph_hi = NPHASE; a.li = 0; a.pad = 0;
#if !DBG
    hipLaunchKernelGGL(fwd_kernel, dim3(grid), dim3(512), LDS_BYTES, stream, a);
#else
    (void)hipMemsetAsync((char*)d_ws + WS_DBG, 0, 4096, stream);
    DArgs da{}; for (int i = 0; i < 28; ++i) da.in[i] = (const float*)d_in[i]; da.out = (float*)d_out; da.ws = (unsigned char*)d_ws;
    static bool attr = false; if (!attr) { (void)hipFuncSetAttribute((const void*)dbg_scan, hipFuncAttributeMaxDynamicSharedMemorySize, 65536); attr = true; }
#define DCHK(K, ID, AUX, NBLK, NTHR) do { da.kind = (K); da.id = (ID); da.aux = (AUX); hipLaunchKernelGGL(dbg_check, dim3(NBLK), dim3(NTHR), 0, stream, da); } while (0)
#define DSNAP(K, AUX, NBLK, NTHR) do { da.kind = (K); da.aux = (AUX); hipLaunchKernelGGL(dbg_snap, dim3(NBLK), dim3(NTHR), 0, stream, da); } while (0)
    for (int ph = 0; ph < NPHASE; ++ph) {
        const int l = ph >= 10 ? 1 : 0, pb = 1 + 9 * l, base = l == 0 ? 0 : 20, k = ph - pb; da.l = l;
        if (ph >= 1 && ph <= 15 && k == 2) { DSNAP(20, 0, 64, 128); DSNAP(21, 0, 1024, 128); if (l == 0) DSNAP(21, 1, 256, 128); }
        if (ph >= 1 && ph <= 15 && k == 3) { DSNAP(22, 0, 16, 128); }
        if (ph == 15) DSNAP(8, 0, 32, 64);
        if (ph == 9) DSNAP(10, 0, 32, 64);
        if (ph == 19) DSNAP(23, 0, 16, 256);
        a.ph_lo = ph; a.ph_hi = ph + 1; a.li = ph;
        hipLaunchKernelGGL(fwd_kernel, dim3(grid), dim3(512), LDS_BYTES, stream, a);
        if (ph == 0) { DCHK(1, 1, 0, 16, 64); DCHK(30, 1, 0, 256, 64); }
        if (ph >= 1 && ph <= 15) {
            if (k == 0) DCHK(2, base + 2, 0, 32, 64);
            if (k == 1) DCHK(3, base + 3, 0, 128, 64);
            if (k == 2) { da.id = base + 11; hipLaunchKernelGGL(dbg_scan, dim3(64), dim3(128), 65536, stream, da);
                          da.id = base + 13; da.aux = 0; hipLaunchKernelGGL(dbg_attn, dim3(1024), dim3(128), 0, stream, da);
                          if (l == 0) { da.id = 14; da.aux = 1; hipLaunchKernelGGL(dbg_attn, dim3(256), dim3(128), 0, stream, da); } }
            if (k == 3) { DCHK(14, base + 15, 0, 1, 64); DCHK(6, base + 16, 0, 32, 64); }
            if (k == 4) DCHK(7, base + 17, 0, 32, 64);
            if (k == 5) DCHK(8, base + 18, 0, 32, 64);
        }
        if (ph == 7) DCHK(2, 19, 1, 32, 64);
        if (ph == 8) DCHK(9, 20, 0, 32, 64);
        if (ph == 9) DCHK(10, 21, 0, 32, 64);
        if (ph == 16) { DCHK(11, 39, 0, 32, 64); DCHK(2, 40, 2, 32, 64); }
        if (ph == 17) DCHK(12, 41, 0, 32, 64);
        if (ph == 18) { da.id = 42; hipLaunchKernelGGL(dbg_moey, dim3(128), dim3(256), 0, stream, da); }
        if (ph == 19) { da.id = 43; hipLaunchKernelGGL(dbg_final, dim3(16), dim3(256), 0, stream, da); }
    }
    hipLaunchKernelGGL(dbg_finalize, dim3(1024), dim3(256), 0, stream, (float*)d_out, (const unsigned char*)d_ws, out_size);
#endif
}
```

```cpp
#include <hip/hip_runtime.h>
#include <cstdio>
#include <cstdint>

#ifndef DBG
#define DBG 0
#endif

constexpr int D = 1024, NB = 32, T = 2048, CL = 256;
constexpr int NLAT = NB * T, NCTX = NB * CL, NTOK = NLAT + NCTX;
constexpr int PW = 4096;
constexpr int DIN = 6144, DFF = 2752, DFFP = 2816, DFE = 3584, NE = 8;
constexpr float EPS = 1e-6f;
constexpr float LOG2E = 1.4426950408889634f;
constexpr float QSCALE = 0.125f * LOG2E;
constexpr int PC_Q = 0, PC_G = 512, PC_LF = 1024, PC_LB = 1536, PC_K = 2048, PC_V = 2560, PC_RQ = 3072, PC_RI = 3584, PC_GA = 2048, PC_GR = 3072;

constexpr size_t MiB = 1u << 20;
constexpr size_t WS_CTL = 0, CTL_BYTES = 1 * MiB;
constexpr size_t WS_MODS = 1 * MiB;
constexpr size_t WS_LBS = 3 * MiB;
constexpr size_t WS_ROPE = 3 * MiB + 65536;
constexpr size_t WS_ROUTE = 4 * MiB;
constexpr size_t WS_CNT = 6 * MiB;
constexpr size_t WS_DBG = 7 * MiB;
constexpr size_t WS_CTXRES = 8 * MiB;
constexpr size_t WS_WIN = 40 * MiB;
constexpr size_t WS_WUA = 64 * MiB;
constexpr size_t WS_WUR = 66 * MiB;
constexpr size_t WS_WO = 68 * MiB;
constexpr size_t WS_W13 = 72 * MiB;
constexpr size_t WS_W2 = 83 * MiB;
constexpr size_t WS_H = 89 * MiB;
constexpr size_t WS_P = 233 * MiB;
constexpr size_t WS_MERGED = 809 * MiB;
constexpr size_t WS_HID = 233 * MiB;
constexpr size_t WS_WM13 = 8 * MiB;
constexpr size_t WS_WM2 = 120 * MiB;
constexpr size_t WS_AG = 176 * MiB;
constexpr size_t WS_MHID = 436 * MiB;
constexpr size_t WS_Y = 674 * MiB;
constexpr size_t WS_H2M = 896 * MiB;
constexpr size_t WS_END = 1024 * MiB;
constexpr int MOE_CHUNK = 128;

constexpr int CW_BAR = 4096;

#define LAS __attribute__((address_space(3)))
#define GAS __attribute__((address_space(1)))
typedef unsigned short bf16_t;
typedef short bf16x8 __attribute__((ext_vector_type(8)));
typedef short s16x4 __attribute__((ext_vector_type(4)));
typedef _Float16 half8 __attribute__((ext_vector_type(8)));
typedef _Float16 half4 __attribute__((ext_vector_type(4)));
typedef float f32x4 __attribute__((ext_vector_type(4)));
typedef float f32x2 __attribute__((ext_vector_type(2)));
typedef float f32x16 __attribute__((ext_vector_type(16)));
typedef unsigned u32x4 __attribute__((ext_vector_type(4)));
typedef unsigned u32x2 __attribute__((ext_vector_type(2)));
#define DI __device__ __forceinline__
#define LDS_WAIT() asm volatile("s_waitcnt lgkmcnt(0)" ::: "memory")
#define VM_WAIT() asm volatile("s_waitcnt vmcnt(0)" ::: "memory")

typedef __bf16 bf16x2_t __attribute__((ext_vector_type(2)));
DI unsigned cvt_pk_bf16(float lo, float hi) { f32x2 v = {lo, hi}; bf16x2_t b = __builtin_convertvector(v, bf16x2_t); return __builtin_bit_cast(unsigned, b); }
typedef int v8i32 __attribute__((ext_vector_type(8)));
typedef int v4i32 __attribute__((ext_vector_type(4)));
DI unsigned pack_fp8x4(float a, float b, float c, float d) {
    a = fminf(fmaxf(a, -448.f), 448.f); b = fminf(fmaxf(b, -448.f), 448.f); c = fminf(fmaxf(c, -448.f), 448.f); d = fminf(fmaxf(d, -448.f), 448.f);
    int w = 0; w = __builtin_amdgcn_cvt_pk_fp8_f32(a, b, w, false); w = __builtin_amdgcn_cvt_pk_fp8_f32(c, d, w, true); return (unsigned)w; }
DI float bf2f(unsigned short b) { return __uint_as_float(((unsigned)b) << 16); }
DI float bflo(unsigned w) { return __uint_as_float(w << 16); }
DI float bfhi(unsigned w) { return __uint_as_float(w & 0xffff0000u); }
DI float fsilu(float x) { return x * __builtin_amdgcn_rcpf(1.f + __expf(-x)); }
DI float fsigmoid(float x) { return __builtin_amdgcn_rcpf(1.f + __expf(-x)); }
DI float wave_sum(float v) {
#pragma unroll
    for (int o = 1; o < 64; o <<= 1) v += __shfl_xor(v, o);
    return v;
}
DI int crow(int r, int hi) { return (r & 3) + 8 * (r >> 2) + 4 * hi; }

#define XB_TMO      128
#define XB_XCNT(j)  (256  + 64 * (j))
#define XB_XSUB(j)  (1280 + 64 * (j))
#define XB_XGEN(j)  (2304 + 64 * (j))
#define XB_TOP      3328
#define XB_TOPGEN   3392
#define XCD_BAR_WORDS 3456
#define XB_SPIN_CAP (1u << 22)
DI unsigned xb_ld(unsigned* p)              { return __hip_atomic_load(p, __ATOMIC_RELAXED, __HIP_MEMORY_SCOPE_AGENT); }
DI unsigned xb_add(unsigned* p, unsigned v) { return __hip_atomic_fetch_add(p, v, __ATOMIC_RELAXED, __HIP_MEMORY_SCOPE_AGENT); }
DI unsigned xb_xcc_id() { return (unsigned)__builtin_amdgcn_s_getreg((3 << 11) | 20) & 0xFu; }
#define XB_SPIN(cond, bar) do { unsigned _sp = 0; while (cond) { __builtin_amdgcn_s_sleep(1); \
    if ((++_sp & 255u) == 0u) { if (xb_ld(&(bar)[XB_TMO])) break; if (_sp > XB_SPIN_CAP) { atomicAdd(&(bar)[XB_TMO], 1u); break; } } } } while (0)
struct XcdBarrier { unsigned* bar; unsigned x; volatile LAS unsigned* st; };
DI XcdBarrier xcd_barrier_post(unsigned* bar, volatile LAS unsigned* st) {
    XcdBarrier b; b.bar = bar; b.x = xb_xcc_id(); b.st = st;
    if (threadIdx.x == 0) (void)xb_add(&bar[XB_XCNT(b.x)], 1u);
    return b;
}
DI void xcd_barrier_complete(unsigned* bar, unsigned x, unsigned& nloc, unsigned& nx) {
    const unsigned G = gridDim.x * gridDim.y * gridDim.z;
    unsigned sum, cnt, mine, sp = 0u;
    for (;;) {
        sum = 0u; cnt = 0u; mine = 0u;
#pragma unroll
        for (unsigned j = 0; j < 16; ++j) { const unsigned c = xb_ld(&bar[XB_XCNT(j)]); sum += c; cnt += (c > 0u) ? 1u : 0u; mine = (j == x) ? c : mine; }
        if (sum == G) break;
        __builtin_amdgcn_s_sleep(1);
        if ((++sp & 255u) == 0u) { if (xb_ld(&bar[XB_TMO])) break; if (sp > XB_SPIN_CAP) { atomicAdd(&bar[XB_TMO], 1u); break; } }
    }
    nloc = mine > 0u ? mine : 1u; nx = cnt > 0u ? cnt : 1u;
}
DI void xcd_barrier(const XcdBarrier& b) {
    asm volatile("s_waitcnt vmcnt(0)" ::: "memory");
    __syncthreads();
    if (threadIdx.x == 0) {
        unsigned* bar = b.bar;
        __builtin_amdgcn_s_waitcnt(0);
        unsigned nloc = b.st[0], nx = b.st[1];
        if (nloc == 0u) { xcd_barrier_complete(bar, b.x, nloc, nx); b.st[0] = nloc; b.st[1] = nx; }
        const unsigned old = xb_add(&bar[XB_XSUB(b.x)], 1u);
        const unsigned gen = old / nloc;
        if (old + 1u == (gen + 1u) * nloc) {
            __builtin_amdgcn_fence(__ATOMIC_RELEASE, "agent");
            asm volatile("s_waitcnt vmcnt(0)" ::: "memory");
            const unsigned og = xb_add(&bar[XB_TOP], 1u);
            const unsigned tg = og / nx;
            if (og + 1u == (tg + 1u) * nx) xb_add(&bar[XB_TOPGEN], 1u);
            else XB_SPIN(xb_ld(&bar[XB_TOPGEN]) == tg, bar);
            __builtin_amdgcn_fence(__ATOMIC_ACQUIRE, "agent");
            xb_add(&bar[XB_XGEN(b.x)], 1u);
            asm volatile("s_waitcnt vmcnt(0)" ::: "memory");
        } else {
            XB_SPIN(xb_ld(&bar[XB_XGEN(b.x)]) == gen, bar);
            __builtin_amdgcn_fence(__ATOMIC_ACQUIRE, "agent");
            asm volatile("s_waitcnt vmcnt(0)" ::: "memory");
        }
    }
    __syncthreads();
}

namespace pg8 {
constexpr int BM = 256, BK = 64, HALF = 128, HTB = HALF * BK * 2, STAGE_BYTES = 8 * HTB, NXCD = 8, WGM = 8;
__host__ __device__ __forceinline__ int lds_byte(int r, int c) { const int st = (r >> 4) * 2 + (c >> 5), rr = r & 15, cc = c & 31, ob = rr * 64 + cc * 2; return st * 1024 + (ob ^ (((ob >> 9) & 1) << 5)); }
__host__ __device__ __forceinline__ void stage_rc(int b, int& R, int& C) { const int st = b / 1024, sb = b % 1024, swz = sb ^ (((sb >> 9) & 1) << 5); R = (st >> 1) * 16 + swz / 64; C = (st & 1) * 32 + (swz % 64) / 2; }
__host__ __device__ __forceinline__ int perm32(int rho) { const int n = rho >> 4, i = rho & 15; return 8 * (i >> 2) + 4 * n + (i & 3); }

struct Unit { int pm, pn; const char* a; const char* b; };
struct Gemm { const bf16_t* A; const bf16_t* Bt; int M, N, K, lda; };

struct StaticOrder {
    int nM, nN, nwg, G, c;
    DI void init(const Gemm& g, int G_, int c_) { nM = g.M / BM; nN = g.N / BM; nwg = nM * nN; G = G_; c = c_; }
    DI bool tile(int i, int& pm, int& pn) const {
        const int L = i * G + c; if (L >= nwg) return false;
        int wgid = L; { const int q = nwg / NXCD, r = nwg % NXCD, xcd = wgid % NXCD, off = wgid / NXCD; wgid = (xcd < r ? xcd * (q + 1) : r * (q + 1) + (xcd - r) * q) + off; }
        const int nig = WGM * nN, gid = wgid / nig, fm = gid * WGM, gsz = (nM - fm) < WGM ? (nM - fm) : WGM;
        pm = fm + ((wgid % nig) % gsz); pn = (wgid % nig) / gsz; return true;
    }
    DI bool next(const Gemm& g, int i, Unit& u) const { if (!tile(i, u.pm, u.pn)) return false;
        u.a = (const char*)g.A + (size_t)u.pm * ((size_t)BM * g.lda * 2); u.b = (const char*)g.Bt + (size_t)u.pn * ((size_t)BM * g.K * 2); return true; }
};
struct MoeOrder {
    StaticOrder so; int p0, apan0; const int* pbv; size_t estride;
    DI bool next(const Gemm& g, int i, Unit& u) const {
        int pm, pn; if (!so.tile(i, pm, pn)) return false;
        u.pm = p0 + pm; u.pn = pn; int e = 0;
#pragma unroll
        for (int k = 1; k < 8; ++k) e += (u.pm >= __builtin_amdgcn_readfirstlane(pbv[k])) ? 1 : 0;
        u.a = (const char*)g.A + (size_t)(u.pm - apan0) * ((size_t)BM * g.lda * 2); u.b = (const char*)g.Bt + (size_t)e * estride + (size_t)pn * ((size_t)BM * g.K * 2); return true;
    }
};

template <class Epi, class Sched, bool ALIGN_EPI = true, bool F8 = false>
DI void gemm_phase(LAS unsigned char* lds, const Gemm g, const Sched& S, const Epi& E) {
    int tid_ = threadIdx.x; asm volatile("" : "+v"(tid_));
    const int tid = tid_, wid = __builtin_amdgcn_readfirstlane(tid >> 6), lane = tid & 63, wr = wid >> 2, wc = wid & 3, fr = lane & 15, fq = lane >> 4;
    const int K = g.K, nt = K / BK;
    unsigned voffA[2], voffB[2];
#pragma unroll
    for (int i = 0; i < 2; ++i) { int R, C; stage_rc(tid * 16 + i * 8192, R, C); const int Rb = Epi::PERM ? ((R & ~31) + perm32(R & 31)) : R;
        voffA[i] = (unsigned)(R * g.lda + C) * 2u; voffB[i] = (unsigned)(Rb * K + C) * 2u; }
    const size_t kstep = (size_t)(BK * 2);
    const size_t hstepA = (size_t)HALF * g.lda * 2, hstepB = (size_t)HALF * K * 2;
    const unsigned ldsw = (unsigned)wid * 1024u;
    const int aoff = lds_byte(wr * 64 + fr, fq * 8), boff = lds_byte(wc * 32 + fr, fq * 8);
#define PG8_SA(b, h) (((b) * 2 + (h)) * HTB)
#define PG8_SB(b, h) ((4 + (b) * 2 + (h)) * HTB)
#define PG8_STAGE(bufoff, gbase, voff) do { _Pragma("unroll") for (int _i = 0; _i < 2; ++_i) \
        __builtin_amdgcn_global_load_lds((const unsigned*)((const char*)(gbase) + (voff)[_i]), (LAS unsigned*)(lds + (bufoff) + ldsw + _i * 8192), 16, 0, 0); } while (0)
#define PG8_LD8(p) __builtin_shufflevector(*(const LAS v4i32*)(p), *(const LAS v4i32*)((p) + 1024), 0, 1, 2, 3, 4, 5, 6, 7)
#define PG8_LDA(dst, b, h) do { if constexpr (F8) { _Pragma("unroll") for (int m = 0; m < 4; ++m) dst##8[m] = PG8_LD8(lds + PG8_SA(b, h) + aoff + m * 2048); } \
        else { _Pragma("unroll") for (int m = 0; m < 4; ++m) _Pragma("unroll") for (int k = 0; k < 2; ++k) dst[m][k] = *(const LAS bf16x8*)(lds + PG8_SA(b, h) + aoff + m * 2048 + k * 1024); } } while (0)
#define PG8_LDB(dst, b, h) do { if constexpr (F8) { _Pragma("unroll") for (int n = 0; n < 2; ++n) dst##8[n] = PG8_LD8(lds + PG8_SB(b, h) + boff + n * 2048); } \
        else { _Pragma("unroll") for (int n = 0; n < 2; ++n) _Pragma("unroll") for (int k = 0; k < 2; ++k) dst[n][k] = *(const LAS bf16x8*)(lds + PG8_SB(b, h) + boff + n * 2048 + k * 1024); } } while (0)
#define PG8_MMA(ai, bj, At, Bt) do { __builtin_amdgcn_s_setprio(1); \
        if constexpr (F8) { _Pragma("unroll") for (int m = 0; m < 4; ++m) _Pragma("unroll") for (int n = 0; n < 2; ++n) \
            asm volatile("v_mfma_scale_f32_16x16x128_f8f6f4 %0, %1, %2, %0, %3, %3 op_sel_hi:[0,0,0]" : "+v"(acc[ai][bj][m][n]) : "v"(Bt##8[n]), "v"(At##8[m]), "v"(one8)); } \
        else { _Pragma("unroll") for (int m = 0; m < 4; ++m) _Pragma("unroll") for (int n = 0; n < 2; ++n) _Pragma("unroll") for (int k = 0; k < 2; ++k) \
            acc[ai][bj][m][n] = __builtin_amdgcn_mfma_f32_16x16x32_bf16(Bt[n][k], At[m][k], acc[ai][bj][m][n], 0, 0, 0); } \
        __builtin_amdgcn_s_setprio(0); } while (0)
#define PG8_WAIT_V(n) asm volatile("s_waitcnt vmcnt(" #n ")" ::: "memory")
#define PG8_WAIT_L(n) asm volatile("s_waitcnt lgkmcnt(" #n ")" ::: "memory")
#define PG8_BAR __builtin_amdgcn_s_barrier()
#define PG8_SCHED __builtin_amdgcn_sched_barrier(0)
    Unit cur, nxt; int ui = 0;
    if (!S.next(g, 0, cur)) return;
    f32x4 acc[2][2][4][2];
#pragma unroll
    for (int a = 0; a < 2; ++a)
#pragma unroll
        for (int b = 0; b < 2; ++b)
#pragma unroll
            for (int m = 0; m < 4; ++m)
#pragma unroll
                for (int n = 0; n < 2; ++n) acc[a][b][m][n] = (f32x4){0.f, 0.f, 0.f, 0.f};
    bf16x8 At[4][2], B0[2][2], B1[2][2]; v8i32 At8[4], B08[2], B18[2]; const int one8 = 0x7F7F7F7F;
    const char* cA = cur.a; const char* cB = cur.b;
    PG8_STAGE(PG8_SB(0, 0), cB, voffB); PG8_STAGE(PG8_SB(0, 1), cB + hstepB, voffB); PG8_STAGE(PG8_SA(0, 0), cA, voffA); PG8_STAGE(PG8_SA(0, 1), cA + hstepA, voffA);
    if (wr == 1) PG8_BAR;
    PG8_WAIT_V(2); PG8_BAR;
    PG8_STAGE(PG8_SB(1, 0), cB + kstep, voffB); PG8_STAGE(PG8_SA(1, 0), cA + kstep, voffA); PG8_STAGE(PG8_SB(1, 1), cB + hstepB + kstep, voffB);
    PG8_WAIT_V(6); PG8_BAR;
    for (;;) {
        const bool has_next = S.next(g, ui + 1, nxt);
        const char* nA = has_next ? nxt.a : cA; const char* nB = has_next ? nxt.b : cB;
        for (int t = 0; t < nt; t += 2) {
            const bool last = (t == nt - 2);
            const char* a1 = cA + (size_t)(t + 1) * kstep;
            const char* a2 = last ? nA : cA + (size_t)(t + 2) * kstep; const char* b2 = last ? nB : cB + (size_t)(t + 2) * kstep;
            const char* a3 = a2 + kstep; const char* b3 = b2 + kstep;
            PG8_LDB(B0, 0, 0); PG8_LDB(B1, 0, 1); PG8_SCHED; PG8_LDA(At, 0, 0); PG8_STAGE(PG8_SA(1, 1), a1 + hstepA, voffA);
            PG8_WAIT_V(8); PG8_WAIT_L(0); PG8_BAR; PG8_MMA(0, 0, At, B0); PG8_MMA(0, 1, At, B1); PG8_BAR; PG8_SCHED;
            PG8_LDA(At, 0, 1); PG8_STAGE(PG8_SB(0, 0), b2, voffB); PG8_STAGE(PG8_SB(0, 1), b2 + hstepB, voffB); PG8_STAGE(PG8_SA(0, 0), a2, voffA);
            PG8_WAIT_V(8); PG8_WAIT_L(0); PG8_BAR; PG8_MMA(1, 0, At, B0); PG8_MMA(1, 1, At, B1); PG8_BAR; PG8_SCHED;
            PG8_LDB(B0, 1, 0); PG8_LDB(B1, 1, 1); PG8_SCHED; PG8_LDA(At, 1, 0); PG8_STAGE(PG8_SA(0, 1), a2 + hstepA, voffA);
            PG8_WAIT_V(8); PG8_WAIT_L(0); PG8_BAR; PG8_MMA(0, 0, At, B0); PG8_MMA(0, 1, At, B1); PG8_BAR; PG8_SCHED;
            PG8_LDA(At, 1, 1); PG8_STAGE(PG8_SB(1, 0), b3, voffB); PG8_STAGE(PG8_SB(1, 1), b3 + hstepB, voffB); PG8_STAGE(PG8_SA(1, 0), a3, voffA);
            PG8_WAIT_V(8); PG8_WAIT_L(0); PG8_BAR; PG8_MMA(1, 0, At, B0); PG8_MMA(1, 1, At, B1); PG8_BAR; PG8_SCHED;
        }
        if constexpr (ALIGN_EPI) { if (wr == 0) PG8_BAR; }
        if constexpr (F8) asm volatile("s_nop 15\n\ts_nop 15" ::: "memory");
        E(acc, cur, wr, wc, fr, fq);
        if (!has_next) break;
#pragma unroll
        for (int a = 0; a < 2; ++a)
#pragma unroll
            for (int b = 0; b < 2; ++b)
#pragma unroll
                for (int m = 0; m < 4; ++m)
#pragma unroll
                    for (int n = 0; n < 2; ++n) acc[a][b][m][n] = (f32x4){0.f, 0.f, 0.f, 0.f};
        cur = nxt; cA = nA; cB = nB; ++ui;
        if constexpr (ALIGN_EPI) { if (wr == 1) PG8_BAR; }
    }
    PG8_WAIT_V(0);
    if constexpr (!ALIGN_EPI) { if (wr == 0) PG8_BAR; }
    PG8_BAR;
#undef PG8_SA
#undef PG8_SB
#undef PG8_STAGE
#undef PG8_LDA
#undef PG8_LD8
#undef PG8_LDB
#undef PG8_MMA
#undef PG8_WAIT_V
#undef PG8_WAIT_L
#undef PG8_BAR
#undef PG8_SCHED
}
}
using pg8::Unit; using pg8::Gemm;
typedef const f32x4 (&AccRef)[2][2][4][2];

DI u32x4 pack8(const f32x4& v0, const f32x4& v1) { u32x4 w; w.x = cvt_pk_bf16(v0[0], v0[1]); w.y = cvt_pk_bf16(v0[2], v0[3]); w.z = cvt_pk_bf16(v1[0], v1[1]); w.w = cvt_pk_bf16(v1[2], v1[3]); return w; }
DI void unpack8(const u32x4& w, float (&f)[8]) { f[0] = bflo(w.x); f[1] = bfhi(w.x); f[2] = bflo(w.y); f[3] = bfhi(w.y); f[4] = bflo(w.z); f[5] = bfhi(w.z); f[6] = bflo(w.w); f[7] = bfhi(w.w); }

struct EpiInProj {
    static constexpr bool PERM = true;
    bf16_t* P; const float2* rope; const float* lbf; const float* lbb;
    DI void operator()(AccRef acc, const Unit& u, int wr, int wc, int fr, int fq) const {
        const int row0 = u.pm * 256 + wr * 64 + fr, sec = u.pn >> 1;
        const int col0 = u.pn * 256 + wc * 32 + 8 * fq;
        const bool lat = u.pm < (NLAT / 256);
#pragma unroll
        for (int ai = 0; ai < 2; ++ai)
#pragma unroll
            for (int m = 0; m < 4; ++m) {
                const int row = row0 + ai * 128 + m * 16; bf16_t* rowp = P + (size_t)row * PW + col0;
#pragma unroll
                for (int bj = 0; bj < 2; ++bj) {
                    f32x4 v0 = acc[ai][bj][m][0], v1 = acc[ai][bj][m][1]; u32x4 w;
                    if (sec == 0 || sec == 4) {
                        if (lat) {
                            const int pi = ((col0 + bj * 128) & 63) >> 1;
                            const f32x4* rp = (const f32x4*)(rope + (size_t)(row & (T - 1)) * 32 + pi);
                            const f32x4 r0 = rp[0], r1 = rp[1];
                            f32x4 o0, o1;
                            o0[0] = v0[0] * r0[0] - v0[1] * r0[1]; o0[1] = v0[0] * r0[1] + v0[1] * r0[0];
                            o0[2] = v0[2] * r0[2] - v0[3] * r0[3]; o0[3] = v0[2] * r0[3] + v0[3] * r0[2];
                            o1[0] = v1[0] * r1[0] - v1[1] * r1[1]; o1[1] = v1[0] * r1[1] + v1[1] * r1[0];
                            o1[2] = v1[2] * r1[2] - v1[3] * r1[3]; o1[3] = v1[2] * r1[3] + v1[3] * r1[2];
                            v0 = o0; v1 = o1;
                        }
                        if (sec == 0) { v0 = v0 * QSCALE; v1 = v1 * QSCALE; }
                        w = pack8(v0, v1);
                    } else if (sec == 1 || sec == 6) {
#pragma unroll
                        for (int j = 0; j < 4; ++j) { v0[j] = fsilu(v0[j]); v1[j] = fsilu(v1[j]); }
                        w = pack8(v0, v1);
                    } else if (sec == 2 || sec == 3) {
                        const float* lb = (sec == 2 ? lbf : lbb) + ((col0 + bj * 128) & 511);
                        const f32x4 b0 = *(const f32x4*)lb, b1 = *(const f32x4*)(lb + 4);
                        half8 hv;
#pragma unroll
                        for (int j = 0; j < 8; ++j) {
                            const float z = j < 4 ? v0[j] : v1[j - 4], b = j < 4 ? b0[j] : b1[j - 4];
                            const float ls = fminf(z, 0.f) - __logf(1.f + __expf(-fabsf(z)));
                            const float lf = b > 0.f ? __logf(b + (1.f - b) * __expf(ls)) : ls;
                            hv[j] = (_Float16)lf;
                        }
                        w = __builtin_bit_cast(u32x4, hv);
                    } else w = pack8(v0, v1);
                    *(u32x4*)(rowp + bj * 128) = w;
                }
            }
    }
};
struct EpiGates {
    static constexpr bool PERM = true; bf16_t* P;
    DI void operator()(AccRef acc, const Unit& u, int wr, int wc, int fr, int fq) const {
        const int row0 = u.pm * 256 + wr * 64 + fr, col0 = PC_GA + u.pn * 256 + wc * 32 + 8 * fq;
#pragma unroll
        for (int ai = 0; ai < 2; ++ai)
#pragma unroll
            for (int m = 0; m < 4; ++m) { bf16_t* rowp = P + (size_t)(row0 + ai * 128 + m * 16) * PW + col0;
#pragma unroll
                for (int bj = 0; bj < 2; ++bj) { f32x4 v0 = acc[ai][bj][m][0], v1 = acc[ai][bj][m][1];
#pragma unroll
                    for (int j = 0; j < 4; ++j) { v0[j] = fsigmoid(v0[j]); v1[j] = fsigmoid(v1[j]); }
                    *(u32x4*)(rowp + bj * 128) = pack8(v0, v1); } }
    }
};
template <bool FIRST> struct EpiMerge {
    static constexpr bool PERM = true; const bf16_t* P; int gcol; bf16_t* O;
    DI void operator()(AccRef acc, const Unit& u, int wr, int wc, int fr, int fq) const {
        const int row0 = u.pm * 256 + wr * 64 + fr, col0 = u.pn * 256 + wc * 32 + 8 * fq;
#pragma unroll
        for (int ai = 0; ai < 2; ++ai)
#pragma unroll
            for (int m = 0; m < 4; ++m) { const size_t row = (size_t)(row0 + ai * 128 + m * 16);
#pragma unroll
                for (int bj = 0; bj < 2; ++bj) {
                    const u32x4 gw = *(const u32x4*)(P + row * PW + gcol + col0 + bj * 128); float g[8]; unpack8(gw, g);
                    f32x4 v0 = acc[ai][bj][m][0], v1 = acc[ai][bj][m][1];
                    bf16_t* op = O + row * D + col0 + bj * 128;
                    float pv[8];
                    if (!FIRST) { const u32x4 ow = *(const u32x4*)op; unpack8(ow, pv); }
#pragma unroll
                    for (int j = 0; j < 4; ++j) { v0[j] = v0[j] * g[j] + (FIRST ? 0.f : pv[j]); v1[j] = v1[j] * g[4 + j] + (FIRST ? 0.f : pv[4 + j]); }
                    *(u32x4*)op = pack8(v0, v1); } }
    }
};
struct EpiResid {
    static constexpr bool PERM = false;
    const float* xin_l; const float* xin_c; float* xout_l; float* xout_c; const float* mods; int msel;
    DI void operator()(AccRef acc, const Unit& u, int wr, int wc, int fr, int fq) const {
        const bool lat = u.pm < (NLAT / 256);
        const int rbase = (lat ? u.pm : u.pm - NLAT / 256) * 256 + wr * 64 + fr, col0 = u.pn * 256 + wc * 32 + 4 * fq;
        const float* xi = lat ? xin_l : xin_c; float* xo = lat ? xout_l : xout_c;
        const float* mv = mods + (size_t)(lat ? (u.pm >> 3) : 32) * DIN + msel * D + col0;
        f32x4 g[2][2];
#pragma unroll
        for (int bj = 0; bj < 2; ++bj)
#pragma unroll
            for (int n = 0; n < 2; ++n) g[bj][n] = *(const f32x4*)(mv + bj * 128 + n * 16);
#pragma unroll
        for (int ai = 0; ai < 2; ++ai)
#pragma unroll
            for (int m = 0; m < 4; ++m) { const size_t off = (size_t)(rbase + ai * 128 + m * 16) * D + col0;
#pragma unroll
                for (int bj = 0; bj < 2; ++bj)
#pragma unroll
                    for (int n = 0; n < 2; ++n) { const f32x4 xv = *(const f32x4*)(xi + off + bj * 128 + n * 16);
                        *(f32x4*)(xo + off + bj * 128 + n * 16) = xv + g[bj][n] * acc[ai][bj][m][n]; } }
    }
};
struct EpiSwiglu {
    static constexpr bool PERM = true; bf16_t* Hd; int ldh; int pan0;
    DI void operator()(AccRef acc, const Unit& u, int wr, int wc, int fr, int fq) const {
        const int row0 = (u.pm - pan0) * 256 + wr * 64 + fr, hc0 = u.pn * 128 + wc * 16 + 4 * fq;
#pragma unroll
        for (int ai = 0; ai < 2; ++ai)
#pragma unroll
            for (int m = 0; m < 4; ++m) { bf16_t* rowp = Hd + (size_t)(row0 + ai * 128 + m * 16) * ldh + hc0;
#pragma unroll
                for (int bj = 0; bj < 2; ++bj) { const f32x4 a = acc[ai][bj][m][0], b = acc[ai][bj][m][1];
                    u32x2 w; w.x = cvt_pk_bf16(fsilu(a[0]) * b[0], fsilu(a[1]) * b[1]); w.y = cvt_pk_bf16(fsilu(a[2]) * b[2], fsilu(a[3]) * b[3]);
                    *(u32x2*)(rowp + bj * 64) = w; } }
    }
};
struct EpiSwiglu8 {
    static constexpr bool PERM = true; unsigned char* Hd; int ldh; int pan0; float as, hs;
    DI void operator()(AccRef acc, const Unit& u, int wr, int wc, int fr, int fq) const {
        const int row0 = (u.pm - pan0) * 256 + wr * 64 + fr, hc0 = u.pn * 128 + wc * 16 + 4 * fq;
#pragma unroll
        for (int ai = 0; ai < 2; ++ai)
#pragma unroll
            for (int m = 0; m < 4; ++m) { unsigned char* rowp = Hd + (size_t)(row0 + ai * 128 + m * 16) * ldh + hc0;
#pragma unroll
                for (int bj = 0; bj < 2; ++bj) { const f32x4 a = acc[ai][bj][m][0] * as, b = acc[ai][bj][m][1] * (as * hs);
                    *(unsigned*)(rowp + bj * 64) = pack_fp8x4(fsilu(a[0]) * b[0], fsilu(a[1]) * b[1], fsilu(a[2]) * b[2], fsilu(a[3]) * b[3]); } }
    }
};
struct EpiBf16 {
    static constexpr bool PERM = true; bf16_t* O; int ldc; float sc;
    DI void operator()(AccRef acc, const Unit& u, int wr, int wc, int fr, int fq) const {
        const int row0 = u.pm * 256 + wr * 64 + fr, col0 = u.pn * 256 + wc * 32 + 8 * fq;
#pragma unroll
        for (int ai = 0; ai < 2; ++ai)
#pragma unroll
            for (int m = 0; m < 4; ++m) { bf16_t* rowp = O + (size_t)(row0 + ai * 128 + m * 16) * ldc + col0;
#pragma unroll
                for (int bj = 0; bj < 2; ++bj) *(u32x4*)(rowp + bj * 128) = pack8(acc[ai][bj][m][0] * sc, acc[ai][bj][m][1] * sc); }
    }
};

typedef short v4i16 __attribute__((ext_vector_type(4)));
DI s16x4 tr16(const LAS unsigned char* p) { return __builtin_bit_cast(s16x4, __builtin_amdgcn_ds_read_tr16_b64_v4i16((LAS v4i16*)p)); }
DI bf16x8 cat8(s16x4 lo, s16x4 hi) { return __builtin_shufflevector(lo, hi, 0, 1, 2, 3, 4, 5, 6, 7); }
DI void dma16(const void* g, LAS unsigned char* l) { __builtin_amdgcn_global_load_lds((const unsigned*)g, (LAS unsigned*)l, 16, 0, 0); }
DI bf16x8 packf8(const f32x16& x, int s) {
    u32x4 w; w.x = cvt_pk_bf16(x[8 * s], x[8 * s + 1]); w.y = cvt_pk_bf16(x[8 * s + 2], x[8 * s + 3]); w.z = cvt_pk_bf16(x[8 * s + 4], x[8 * s + 5]); w.w = cvt_pk_bf16(x[8 * s + 6], x[8 * s + 7]);
    return __builtin_bit_cast(bf16x8, w);
}
#define MFMA32(a, b, c) __builtin_amdgcn_mfma_f32_32x32x16_bf16((a), (b), (c), 0, 0, 0)

struct Params { const float* in[28]; float* out; unsigned char* ws; int ph_lo, ph_hi, li, pad; };
typedef const __attribute__((address_space(4))) Params* KP;
DI KP kparams() { KP kp = (KP)__builtin_amdgcn_kernarg_segment_ptr(); asm volatile("" : "+s"(kp)); return kp; }
#define PIN(k) (kparams()->in[k])
#define POUT (kparams()->out)
struct Ctx {
    LAS unsigned char* lds; unsigned char* ws; int tid, lane, wave, vcu, G, gw, NGW;
};

DI int map_row(int kind, int n) {
    if (kind == 0) return n;
    if (kind == 2) return 8 * (n >> 2) + (n & 3);
    if (kind == 3) return 8 * (n >> 2) + (n & 3) + 4;
    const int sec = n >> 9, j = n & 511;
    if (n >= 4096) return n;
    if (sec == 0 || sec == 1) { const int hs = j >> 6, d = j & 63; const int pj = hs * 64 + (d < 32 ? 2 * d : 2 * (d - 32) + 1); return (sec == 0 ? PC_Q : PC_K) + pj; }
    if (sec == 2) return PC_V + j;
    if (sec == 3) return PC_RQ + j;
    if (sec == 4) return PC_RI + j;
    if (sec == 5) return PC_LF + j;
    if (sec == 6) return PC_LB + j;
    return PC_G + j;
}
DI void transpose_item(const float* W, int ldw, int k0, int n0, bf16_t* WT, int ldt, int kind, LAS float* scr, int lane) {
#pragma unroll 8
    for (int i = 0; i < 32; ++i) { const int kk = 2 * i + (lane >> 5); scr[kk * 33 + (lane & 31)] = W[(size_t)(k0 + kk) * ldw + n0 + (lane & 31)]; }
    LDS_WAIT(); asm volatile("" ::: "memory");
    const int c = lane & 7;
#pragma unroll
    for (int j = 0; j < 4; ++j) { const int n = (lane >> 3) + 8 * j; const LAS float* s = scr + (8 * c) * 33 + n;
        u32x4 o; o.x = cvt_pk_bf16(s[0 * 33], s[1 * 33]); o.y = cvt_pk_bf16(s[2 * 33], s[3 * 33]); o.z = cvt_pk_bf16(s[4 * 33], s[5 * 33]); o.w = cvt_pk_bf16(s[6 * 33], s[7 * 33]);
        *(u32x4*)(WT + (size_t)map_row(kind, n0 + n) * ldt + k0 + 8 * c) = o; }
    LDS_WAIT(); asm volatile("" ::: "memory");
}
DI void transpose_item8(const float* W, int ldw, int k0, int n0, unsigned char* WT, int ldt, int kind, float sc, LAS float* scr, int lane) {
#pragma unroll 8
    for (int i = 0; i < 32; ++i) { const int kk = 2 * i + (lane >> 5); scr[kk * 33 + (lane & 31)] = W[(size_t)(k0 + kk) * ldw + n0 + (lane & 31)]; }
    LDS_WAIT(); asm volatile("" ::: "memory");
    const int c = lane & 7;
#pragma unroll
    for (int j = 0; j < 4; ++j) { const int n = (lane >> 3) + 8 * j; const LAS float* s = scr + (8 * c) * 33 + n;
        u32x2 o; o.x = pack_fp8x4(s[0 * 33] * sc, s[1 * 33] * sc, s[2 * 33] * sc, s[3 * 33] * sc); o.y = pack_fp8x4(s[4 * 33] * sc, s[5 * 33] * sc, s[6 * 33] * sc, s[7 * 33] * sc);
        *(u32x2*)(WT + (size_t)map_row(kind, n0 + n) * ldt + k0 + 8 * c) = o; }
    LDS_WAIT(); asm volatile("" ::: "memory");
}
DI void transpose_matrix8(const Ctx& C, const float* W, int K, int N, unsigned char* WT, int ldt, int kind, float sc, int& itbase) {
    LAS float* scr = (LAS float*)(C.lds + C.wave * 16384);
    const int nblk = N / 32, nit = (K / 64) * nblk;
    int first = (C.gw - (itbase % C.NGW) + C.NGW) % C.NGW;
    for (int it = first; it < nit; it += C.NGW) transpose_item8(W, N, 64 * (it / nblk), 32 * (it % nblk), WT, ldt, kind, sc, scr, C.lane);
    itbase += nit;
}
DI void transpose_matrix(const Ctx& C, const float* W, int K, int N, bf16_t* WT, int ldt, int kind, int& itbase, int total_unused) {
    (void)total_unused;
    LAS float* scr = (LAS float*)(C.lds + C.wave * 16384);
    const int nblk = N / 32, nit = (K / 64) * nblk;
    int first = (C.gw - (itbase % C.NGW) + C.NGW) % C.NGW;
    for (int it = first; it < nit; it += C.NGW) transpose_item(W, N, 64 * (it / nblk), 32 * (it % nblk), WT, ldt, kind, scr, C.lane);
    itbase += nit;
}

DI void phase_prologue(const Ctx& C) {
    unsigned char* ws = C.ws;
    int itb = 0;
    for (int l = 0; l < 2; ++l) {
        transpose_matrix(C, PIN(8) + (size_t)l * D * DIN, D, DIN, (bf16_t*)(ws + WS_WIN) + (size_t)l * DIN * D, D, 1, itb, 0);
        transpose_matrix(C, PIN(17) + (size_t)l * 512 * D, 512, D, (bf16_t*)(ws + WS_WUA) + (size_t)l * D * 512, 512, 0, itb, 0);
        transpose_matrix(C, PIN(18) + (size_t)l * 512 * D, 512, D, (bf16_t*)(ws + WS_WUR) + (size_t)l * D * 512, 512, 0, itb, 0);
        transpose_matrix(C, PIN(19) + (size_t)l * D * D, D, D, (bf16_t*)(ws + WS_WO) + (size_t)l * D * D, D, 0, itb, 0);
    }
    transpose_matrix(C, PIN(20), D, DFF, (bf16_t*)(ws + WS_W13), D, 2, itb, 0);
    transpose_matrix(C, PIN(21), D, DFF, (bf16_t*)(ws + WS_W13), D, 3, itb, 0);
    transpose_matrix(C, PIN(22), DFF, D, (bf16_t*)(ws + WS_W2), DFFP, 0, itb, 0);
    { const int gt = C.vcu * 512 + C.tid, NT = C.G * 512;
      bf16_t* w13 = (bf16_t*)(ws + WS_W13) + (size_t)(2 * DFF) * D;
      for (int i = gt; i < (2 * DFFP - 2 * DFF) * D / 8; i += NT) ((u32x4*)w13)[i] = (u32x4){0u, 0u, 0u, 0u};
      bf16_t* w2 = (bf16_t*)(ws + WS_W2);
      for (int i = gt; i < D * (DFFP - DFF) / 8; i += NT) { const int r = i / ((DFFP - DFF) / 8), cc = i % ((DFFP - DFF) / 8); *(u32x4*)(w2 + (size_t)r * DFFP + DFF + cc * 8) = (u32x4){0u, 0u, 0u, 0u}; }
      float2* rope = (float2*)(ws + WS_ROPE);
      for (int i = gt; i < T * 32; i += NT) { const int t = i >> 5, pi = i & 31; const float invf = exp2f(-(float)(pi & 15) * (13.287712379549449f / 16.f));
          const float ang = (float)(pi < 16 ? (t >> 6) : (t & 63)) * invf; rope[i] = make_float2(cosf(ang), sinf(ang)); }
      float* lbs = (float*)(ws + WS_LBS);
      for (int i = gt; i < 2 * 2 * 512; i += NT) { const int l = i >> 10, dir = (i >> 9) & 1, d = i & 511; const float* lb = PIN(dir ? 16 : 15);
          const float p0 = lb[d], p1 = lb[512 + d]; lbs[i] = l == 0 ? 0.f : 1.f / (1.f + expf(p0 - p1)); }
    }
    { float* mods = (float*)(ws + WS_MODS);
      for (int task = C.gw; task < 2 * 33 * 96; task += C.NGW) {
          const int ng = task % 96, r = (task / 96) % 33, l = task / (96 * 33), n = ng * 64 + C.lane;
          const float* cv = r < 32 ? PIN(1) + r * D : PIN(3); const float* W = PIN(4) + (size_t)l * D * DIN + n;
          float acc = PIN(5)[l * DIN + n];
          for (int k0 = 0; k0 < D; k0 += 64) { const float sv = fsilu(cv[k0 + C.lane]);
#pragma unroll 16
              for (int j = 0; j < 64; ++j) acc += __uint_as_float(__builtin_amdgcn_readlane(__float_as_uint(sv), j)) * W[(size_t)(k0 + j) * DIN]; }
          mods[(size_t)(l * 33 + r) * DIN + n] = acc; } }
}
constexpr float W13_SCALE = 64.f, W2_SCALE = 128.f, HID_SCALE = 8.f;
DI void convert_moe_weights(const Ctx& C) {
    unsigned char* ws = C.ws; int itb = 0;
    for (int e = 0; e < NE; ++e) {
        transpose_matrix8(C, PIN(24) + (size_t)e * D * DFE, D, DFE, ws + WS_WM13 + (size_t)e * 2 * DFE * D, D, 2, W13_SCALE, itb);
        transpose_matrix8(C, PIN(25) + (size_t)e * D * DFE, D, DFE, ws + WS_WM13 + (size_t)e * 2 * DFE * D, D, 3, W13_SCALE, itb);
        transpose_matrix8(C, PIN(26) + (size_t)e * DFE * D, DFE, D, ws + WS_WM2 + (size_t)e * D * DFE, DFE, 0, W2_SCALE, itb);
    }
}

template <bool ROUTER>
DI void phase_norm(const Ctx& C, const float* xl, const float* xc, const float* nw, const float* mods, int shsel, int nrows, bf16_t* Hout, const float* rw, unsigned char* route, LAS int* cntL) {
    for (int row = C.gw; row < nrows; row += C.NGW) {
        const bool lat = row < NLAT; const float* xr = lat ? xl + (size_t)row * D : xc + (size_t)(row - NLAT) * D;
        const float* mv = mods + (size_t)(lat ? (row >> 11) : 32) * DIN + shsel * D;
        f32x4 v[4]; float ss = 0.f;
#pragma unroll
        for (int j = 0; j < 4; ++j) { v[j] = *(const f32x4*)(xr + 256 * j + 4 * C.lane); ss += (v[j][0] * v[j][0] + v[j][1] * v[j][1]) + (v[j][2] * v[j][2] + v[j][3] * v[j][3]); }
        const float rstd = 1.0f / sqrtf(wave_sum(ss) * (1.f / D) + EPS);
        float lg[8];
        if (ROUTER) {
#pragma unroll
            for (int e = 0; e < 8; ++e) lg[e] = 0.f; }
#pragma unroll
        for (int j = 0; j < 4; ++j) { const int c0 = 256 * j + 4 * C.lane;
            const f32x4 w = *(const f32x4*)(nw + c0), sh = *(const f32x4*)(mv + c0), sc = *(const f32x4*)(mv + D + c0);
            f32x4 h = (v[j] * rstd) * w * (sc + 1.0f) + sh;
            if (ROUTER) *(unsigned*)((unsigned char*)Hout + (size_t)row * D + c0) = pack_fp8x4(h[0], h[1], h[2], h[3]);
            else { u32x2 o; o.x = cvt_pk_bf16(h[0], h[1]); o.y = cvt_pk_bf16(h[2], h[3]); *(u32x2*)(Hout + (size_t)row * D + c0) = o; }
            if (ROUTER) {
#pragma unroll
                for (int q = 0; q < 4; ++q) { const f32x4 r0 = *(const f32x4*)(rw + (size_t)(c0 + q) * 8), r1 = *(const f32x4*)(rw + (size_t)(c0 + q) * 8 + 4);
                    lg[0] += h[q] * r0[0]; lg[1] += h[q] * r0[1]; lg[2] += h[q] * r0[2]; lg[3] += h[q] * r0[3]; lg[4] += h[q] * r1[0]; lg[5] += h[q] * r1[1]; lg[6] += h[q] * r1[2]; lg[7] += h[q] * r1[3]; } }
        }
        if (ROUTER) {
#pragma unroll
            for (int e = 0; e < 8; ++e) lg[e] = wave_sum(lg[e]);
            if (C.lane == 0) {
                int e1 = 0; float l1 = lg[0];
#pragma unroll
                for (int e = 1; e < 8; ++e) if (lg[e] > l1) { l1 = lg[e]; e1 = e; }
                int e2 = -1; float l2 = -INFINITY;
#pragma unroll
                for (int e = 0; e < 8; ++e) if (e != e1 && lg[e] > l2) { l2 = lg[e]; e2 = e; }
                const float g2 = 1.f / (1.f + expf(l1 - l2)), g1 = 1.f - g2;
                int* rt = (int*)(route + (size_t)row * 24); rt[0] = e1; rt[1] = e2; ((float*)rt)[2] = g1; ((float*)rt)[3] = g2;
                atomicAdd((int*)&cntL[e1], 1); atomicAdd((int*)&cntL[e2], 1);
            }
        }
    }
}

constexpr int AT_XCH = 65536;
DI float max3f(float a, float b, float c) { return fmaxf(fmaxf(a, b), c); }
DI void attn_unit(const Ctx& C, bf16_t* P, int qrow0, int krow_ctx, int krow_lat, int nkt, int h, float lam, const float* anw, float post) {
    int tid_ = threadIdx.x; asm volatile("" : "+v"(tid_));
    LAS unsigned char* lds = C.lds; const int lane = tid_ & 63, wid = __builtin_amdgcn_readfirstlane(tid_ >> 6), sub = wid >> 2, qw = wid & 3, r32 = lane & 31, hh = lane >> 5;
    const int tq = (lane & 15) >> 2, tp = lane & 3, blk = (lane >> 4) & 1;
    LAS unsigned char* qlds = lds + AT_XCH + wid * 8192 + r32 * 16;
#pragma unroll
    for (int qb = 0; qb < 2; ++qb) { const bf16_t* qp = P + (size_t)(qrow0 + 64 * qw + 32 * qb + r32) * PW + PC_Q + h * 128 + sub * 64 + 8 * hh;
#pragma unroll
      for (int ks = 0; ks < 4; ++ks) *(LAS bf16x8*)(qlds + ((2 * ks + hh) * 64 + 32 * qb) * 16) = *(const bf16x8*)(qp + 16 * ks); }
    f32x16 O[2][4];
#pragma unroll
    for (int qb = 0; qb < 2; ++qb)
#pragma unroll
        for (int c = 0; c < 4; ++c)
#pragma unroll
            for (int i = 0; i < 16; ++i) O[qb][c][i] = 0.f;
    float m_run[2] = {-INFINITY, -INFINITY}, l_run[2] = {0.f, 0.f};
#define AT_ISSUE(kt, buf) do { const int kr0_ = (kt) < 4 ? krow_ctx + (kt) * 64 : krow_lat + ((kt) - 4) * 64; LAS unsigned char* bb_ = lds + (buf) * 32768; \
        _Pragma("unroll") for (int j_ = 0; j_ < 2; ++j_) { const int c_ = 2 * wid + j_; \
            dma16(P + (size_t)(kr0_ + lane) * PW + PC_K + h * 128 + c_ * 8, bb_ + c_ * 1024); \
            dma16(P + (size_t)(kr0_ + 16 * (c_ & 3) + (lane >> 2)) * PW + PC_V + h * 128 + (c_ >> 2) * 32 + (lane & 3) * 8, bb_ + 16384 + c_ * 1024); } } while (0)
    AT_ISSUE(0, 0);
    int buf = 0;
#pragma unroll 1
    for (int kt = 0; kt < nkt; ++kt) {
        VM_WAIT(); __syncthreads();
        if (kt + 1 < nkt) AT_ISSUE(kt + 1, buf ^ 1);
        const LAS unsigned char* kb = lds + buf * 32768, * vb = kb + 16384 + (4 * hh + tq) * 64 + blk * 32 + tp * 8;
        bf16x8 Pf[2][4];
#pragma unroll
        for (int qb = 0; qb < 2; ++qb) {
            f32x16 s0, s1;
#pragma unroll
            for (int i = 0; i < 16; ++i) { s0[i] = 0.f; s1[i] = 0.f; }
#pragma unroll
            for (int ks = 0; ks < 4; ++ks) { const LAS unsigned char* kp = kb + ((sub * 8 + 2 * ks + hh) * 64 + r32) * 16;
                const bf16x8 k0 = *(const LAS bf16x8*)kp, k1 = *(const LAS bf16x8*)(kp + 512);
                const bf16x8 q = *(const LAS bf16x8*)(qlds + ((2 * ks + hh) * 64 + 32 * qb) * 16);
                s0 = MFMA32(k0, q, s0); s1 = MFMA32(k1, q, s1); }
            float mx = max3f(s0[0], s1[0], s0[1]);
#pragma unroll
            for (int i = 1; i < 16; ++i) mx = (i + 1 < 16) ? max3f(mx, s1[i], s0[i + 1]) : fmaxf(mx, s1[i]);
            mx = fmaxf(mx, __shfl_xor(mx, 32));
            const float mnew = fmaxf(m_run[qb], mx);
            if (__any(mnew > m_run[qb])) { const float alpha = __builtin_amdgcn_exp2f(m_run[qb] - mnew); l_run[qb] *= alpha;
#pragma unroll
                for (int c = 0; c < 4; ++c)
#pragma unroll
                    for (int i = 0; i < 16; ++i) O[qb][c][i] *= alpha;
                m_run[qb] = mnew; }
            const float mr = m_run[qb]; float ps0 = 0.f, ps1 = 0.f;
#pragma unroll
            for (int i = 0; i < 16; ++i) { s0[i] = __builtin_amdgcn_exp2f(s0[i] - mr); s1[i] = __builtin_amdgcn_exp2f(s1[i] - mr); ps0 += s0[i]; ps1 += s1[i]; }
            l_run[qb] += ps0 + ps1;
            Pf[qb][0] = packf8(s0, 0); Pf[qb][1] = packf8(s0, 1); Pf[qb][2] = packf8(s1, 0); Pf[qb][3] = packf8(s1, 1);
        }
#pragma unroll
        for (int cb = 0; cb < 4; ++cb) {
#pragma unroll
            for (int s4 = 0; s4 < 4; ++s4) { const bf16x8 a = cat8(tr16(vb + cb * 4096 + s4 * 1024), tr16(vb + cb * 4096 + s4 * 1024 + 512));
                O[0][cb] = MFMA32(a, Pf[0][s4], O[0][cb]); O[1][cb] = MFMA32(a, Pf[1][s4], O[1][cb]); } }
        buf ^= 1;
    }
#undef AT_ISSUE
    LAS float* xch = (LAS float*)(lds + AT_XCH) + qw * 4096 + lane;
    LDS_WAIT(); __syncthreads();
#pragma unroll
    for (int qb = 0; qb < 2; ++qb) {
        const float lt = l_run[qb] + __shfl_xor(l_run[qb], 32); const float inv = 1.f / lt;
        if (sub == 1) { const float sc = -lam * inv;
#pragma unroll
            for (int c = 0; c < 4; ++c)
#pragma unroll
                for (int i = 0; i < 16; ++i) xch[(c * 16 + i) * 64] = O[qb][c][i] * sc; }
        LDS_WAIT(); __syncthreads();
        if (sub == 0) {
            float ss = 0.f;
#pragma unroll
            for (int c = 0; c < 4; ++c)
#pragma unroll
                for (int i = 0; i < 16; ++i) { const float o = O[qb][c][i] * inv + xch[(c * 16 + i) * 64]; O[qb][c][i] = o; ss += o * o; }
            ss += __shfl_xor(ss, 32);
            const float rs = post / sqrtf(ss * (1.f / 128.f) + EPS);
            bf16_t* op = P + (size_t)(qrow0 + 64 * qw + 32 * qb + r32) * PW + PC_Q + h * 128;
#pragma unroll
            for (int c = 0; c < 4; ++c)
#pragma unroll
                for (int g = 0; g < 4; ++g) { const int v0 = 32 * c + 8 * g + 4 * hh; const f32x4 w = *(const f32x4*)(anw + v0);
                    u32x2 o; o.x = cvt_pk_bf16(O[qb][c][4 * g] * rs * w[0], O[qb][c][4 * g + 1] * rs * w[1]); o.y = cvt_pk_bf16(O[qb][c][4 * g + 2] * rs * w[2], O[qb][c][4 * g + 3] * rs * w[3]);
                    *(u32x2*)(op + v0) = o; }
        }
        LDS_WAIT(); __syncthreads();
    }
}

constexpr int SC_Q = 0, SC_LF = 16384, SC_V0 = 32768, SC_QM = 65536, SC_KMR = 81920, SC_KMS = 98304, SC_SX = 114688, SC_A31 = 147456, SC_A63 = 147968, SC_END = 148480;
DI void scan_chain(const Ctx& C, bf16_t* P, int b, int h, int dir, bool store_ctx) {
    int tid_ = threadIdx.x; asm volatile("" : "+v"(tid_));
    LAS unsigned char* lds = C.lds; const int lane = tid_ & 63, wid = __builtin_amdgcn_readfirstlane(tid_ >> 6), r32 = lane & 31, hh = lane >> 5;
    const int tq = (lane & 15) >> 2, tp = lane & 3, blk = (lane >> 4) & 1;
    const int db = wid & 3, tb = wid >> 2;
    const int base_nat = hh * 512 + tq * 64 + blk * 32 + tp * 8;
    const int base_prm = (4 * hh + tq) * 64 + blk * 32 + tp * 8;
    const int lfcol = (dir ? PC_LB : PC_LF) + h * 128, qcol = PC_RQ + h * 128, vcol = PC_RI + h * 128;
    f32x16 ST[2];
#pragma unroll
    for (int j = 0; j < 2; ++j)
#pragma unroll
        for (int i = 0; i < 16; ++i) ST[j][i] = 0.f;
#define SROW(c, i) ((c) < 4 ? NLAT + b * CL + (dir ? 255 - ((c) * 64 + (i)) : (c) * 64 + (i)) : b * T + (dir ? 2047 - (((c) - 4) * 64 + (i)) : ((c) - 4) * 64 + (i)))
#define SDMA(c, colbase, dstoff) do { _Pragma("unroll") for (int j_ = 0; j_ < 2; ++j_) { const int I_ = 2 * wid + j_; const int ti_ = 16 * (I_ & 3) + (lane >> 2); \
        dma16(P + (size_t)SROW(c, ti_) * PW + (colbase) + (I_ >> 2) * 32 + (lane & 3) * 8, lds + (dstoff) + I_ * 1024); } } while (0)
    SDMA(0, qcol, SC_Q); SDMA(0, lfcol, SC_LF); SDMA(0, vcol, SC_V0);
    int vbuf = 0;
    const int t = 32 * tb + r32;
    for (int c = 0; c < 36; ++c) {
        VM_WAIT(); __syncthreads();
        const LAS unsigned char* Vimg = lds + SC_V0 + vbuf * 16384;
        f32x16 cm;
#pragma unroll
        for (int i = 0; i < 16; ++i) cm[i] = 0.f;
#pragma unroll
        for (int kk = 0; kk < 2; ++kk) { const int ks = 2 * tb + kk;
            const half8 a = __builtin_bit_cast(half8, cat8(tr16(lds + SC_LF + db * 4096 + base_nat + ks * 1024), tr16(lds + SC_LF + db * 4096 + base_nat + ks * 1024 + 256)));
            half8 bm;
#pragma unroll
            for (int j = 0; j < 8; ++j) { const int s = 16 * ks + 8 * hh + j; bm[j] = tb == 0 ? (s > t ? (_Float16)-1.f : (_Float16)0.f) : (s <= t ? (_Float16)1.f : (_Float16)0.f); }
            cm = __builtin_amdgcn_mfma_f32_32x32x16_f16(a, bm, cm, 0, 0, 0); }
#pragma unroll
        for (int g = 0; g < 4; ++g) {
            const int sa = db * 4096 + (t >> 3) * 512 + (t & 7) * 64 + (8 * g + 4 * hh) * 2;
            const u32x2 q4 = *(const LAS u32x2*)(lds + SC_Q + sa); const half4 lf4 = *(const LAS half4*)(lds + SC_LF + sa);
            const float qv[4] = {bflo(q4.x), bfhi(q4.x), bflo(q4.y), bfhi(q4.y)};
            float qm[4], km[4];
#pragma unroll
            for (int e = 0; e < 4; ++e) { const float cv = cm[4 * g + e] * LOG2E; const float E = __builtin_amdgcn_exp2f(cv), Ei = __builtin_amdgcn_exp2f(-cv);
                const float lf = (float)lf4[e]; qm[e] = qv[e] * E; km[e] = (1.f - __builtin_amdgcn_exp2f(lf * LOG2E)) * Ei;
                if (tb == 0 && r32 == 0) ((LAS float*)(lds + SC_A31))[32 * db + 8 * g + 4 * hh + e] = lf - cm[4 * g + e];
                if (tb == 1 && r32 == 31) ((LAS float*)(lds + SC_A63))[32 * db + 8 * g + 4 * hh + e] = cm[4 * g + e]; }
            u32x2 qw2, kw2; qw2.x = cvt_pk_bf16(qm[0], qm[1]); qw2.y = cvt_pk_bf16(qm[2], qm[3]); kw2.x = cvt_pk_bf16(km[0], km[1]); kw2.y = cvt_pk_bf16(km[2], km[3]);
            const int ra = ((4 * db + g) * 64 + t) * 16 + 8 * hh;
            *(LAS u32x2*)(lds + SC_QM + ra) = qw2; *(LAS u32x2*)(lds + SC_KMR + ra) = kw2; *(LAS u32x2*)(lds + SC_KMS + sa) = kw2;
        }
        LDS_WAIT(); __syncthreads();
        { const int d = 32 * db + r32; const float c31 = ((LAS float*)(lds + SC_A31))[d], c63 = ((LAS float*)(lds + SC_A63))[d];
          const float e31 = __expf(c31), dec = __expf(c31 + c63), e63 = __expf(c63);
          f32x16 SN[2];
#pragma unroll
          for (int j = 0; j < 2; ++j) { const int vb2 = 2 * tb + j;
#pragma unroll
              for (int g = 0; g < 4; ++g) { u32x2 w; w.x = cvt_pk_bf16(ST[j][4 * g] * e31, ST[j][4 * g + 1] * e31); w.y = cvt_pk_bf16(ST[j][4 * g + 2] * e31, ST[j][4 * g + 3] * e31);
                  *(LAS u32x2*)(lds + SC_SX + vb2 * 8192 + (d >> 3) * 512 + (d & 7) * 64 + (8 * g + 4 * hh) * 2) = w; }
#pragma unroll
              for (int i = 0; i < 16; ++i) SN[j][i] = 0.f; }
#pragma unroll
          for (int ks = 0; ks < 4; ++ks) {
              const bf16x8 kf = cat8(tr16(lds + SC_KMS + db * 4096 + base_nat + ks * 1024), tr16(lds + SC_KMS + db * 4096 + base_nat + ks * 1024 + 256));
#pragma unroll
              for (int j = 0; j < 2; ++j) { const int vb2 = 2 * tb + j;
                  const bf16x8 vf = cat8(tr16(Vimg + vb2 * 4096 + base_nat + ks * 1024), tr16(Vimg + vb2 * 4096 + base_nat + ks * 1024 + 256));
                  SN[j] = MFMA32(vf, kf, SN[j]); } }
#pragma unroll
          for (int j = 0; j < 2; ++j)
#pragma unroll
              for (int i = 0; i < 16; ++i) ST[j][i] = dec * ST[j][i] + e63 * SN[j][i];
        }
        LDS_WAIT(); __syncthreads();
        if (c + 1 < 36) { SDMA(c + 1, qcol, SC_Q); SDMA(c + 1, lfcol, SC_LF); SDMA(c + 1, vcol, SC_V0 + (vbuf ^ 1) * 16384); }
        { bf16x8 Qmf[8];
#pragma unroll
          for (int kd = 0; kd < 8; ++kd) Qmf[kd] = *(const LAS bf16x8*)(lds + SC_QM + ((2 * kd + hh) * 64 + t) * 16);
          f32x16 o;
#pragma unroll
          for (int i = 0; i < 16; ++i) o[i] = 0.f;
          for (int sb = 0; sb <= tb; ++sb) {
              f32x16 pt;
#pragma unroll
              for (int i = 0; i < 16; ++i) pt[i] = 0.f;
#pragma unroll
              for (int kd = 0; kd < 8; ++kd) { const bf16x8 a = *(const LAS bf16x8*)(lds + SC_KMR + ((2 * kd + hh) * 64 + 32 * sb + r32) * 16); pt = MFMA32(a, Qmf[kd], pt); }
              if (sb == tb) {
#pragma unroll
                  for (int i = 0; i < 16; ++i) if (crow(i, hh) > r32) pt[i] = 0.f; }
              const bf16x8 p0 = packf8(pt, 0), p1 = packf8(pt, 1);
              { const bf16x8 a = cat8(tr16(Vimg + db * 4096 + base_prm + (2 * sb) * 1024), tr16(Vimg + db * 4096 + base_prm + (2 * sb) * 1024 + 512)); o = MFMA32(a, p0, o); }
              { const bf16x8 a = cat8(tr16(Vimg + db * 4096 + base_prm + (2 * sb + 1) * 1024), tr16(Vimg + db * 4096 + base_prm + (2 * sb + 1) * 1024 + 512)); o = MFMA32(a, p1, o); }
          }
#pragma unroll
          for (int kd = 0; kd < 8; ++kd) { const bf16x8 a = cat8(tr16(lds + SC_SX + db * 8192 + base_nat + kd * 1024), tr16(lds + SC_SX + db * 8192 + base_nat + kd * 1024 + 256)); o = MFMA32(a, Qmf[kd], o); }
          if (c >= 4 || store_ctx) { bf16_t* op = P + (size_t)SROW(c, t) * PW + lfcol + 32 * db;
#pragma unroll
              for (int g = 0; g < 4; ++g) { u32x2 w; w.x = cvt_pk_bf16(o[4 * g], o[4 * g + 1]); w.y = cvt_pk_bf16(o[4 * g + 2], o[4 * g + 3]); *(u32x2*)(op + 8 * g + 4 * hh) = w; } }
        }
        vbuf ^= 1;
    }
    VM_WAIT(); LDS_WAIT(); __syncthreads();
#undef SROW
#undef SDMA
}

DI void phase_recprep(const Ctx& C, bf16_t* P, const float* rnw, int nrows) {
    for (int row = C.gw; row < nrows; row += C.NGW) {
        bf16_t* pr = P + (size_t)row * PW + 8 * C.lane;
        float a[8], bb[8], g[8]; unpack8(*(const u32x4*)(pr + PC_LF), a); unpack8(*(const u32x4*)(pr + PC_LB), bb); unpack8(*(const u32x4*)(pr + PC_G), g);
        float ss = 0.f;
#pragma unroll
        for (int j = 0; j < 8; ++j) { a[j] += bb[j]; ss += a[j] * a[j]; }
        ss += __shfl_xor(ss, 1); ss += __shfl_xor(ss, 2); ss += __shfl_xor(ss, 4); ss += __shfl_xor(ss, 8);
        const float rs = 1.0f / sqrtf(ss * (1.f / 128.f) + EPS);
        const f32x4 w0 = *(const f32x4*)(rnw + ((8 * C.lane) & 127)), w1 = *(const f32x4*)(rnw + ((8 * C.lane) & 127) + 4);
        f32x4 o0, o1;
#pragma unroll
        for (int j = 0; j < 4; ++j) { o0[j] = a[j] * rs * w0[j] * g[j]; o1[j] = a[4 + j] * rs * w1[j] * g[4 + j]; }
        *(u32x4*)(pr + PC_LF) = pack8(o0, o1);
    }
}

DI void phase_slots(const Ctx& C, const int* cnt, int* pbout, unsigned char* route, const bf16_t* H2, bf16_t* AG, LAS int* cur) {
    if (C.tid < 16) cur[C.tid] = 0;
    __syncthreads();
    for (int g = C.tid; g < C.G; g += 512) {
#pragma unroll
        for (int k = 0; k < 8; ++k) { const int c = cnt[g * 8 + k]; atomicAdd((int*)&cur[8 + k], c); if (g < (int)blockIdx.x) atomicAdd((int*)&cur[k], c); } }
    __syncthreads();
    if (C.tid < 8) { const int e = C.tid; int pb = 0, pbe = 0;
#pragma unroll
        for (int k = 0; k < 8; ++k) { if (k == e) pbe = pb; pb += (cur[8 + k] + 255) >> 8; }
        const int mine = cur[e];
        if (blockIdx.x == 0) { pbout[e] = pbe; if (e == 7) pbout[8] = pb; }
        cur[e] = pbe * 256 + mine;
    }
    __syncthreads();
    for (int row = C.gw; row < NLAT; row += C.NGW) {
        int* rt = (int*)(route + (size_t)row * 24);
        int s1 = 0, s2 = 0;
        if (C.lane == 0) { s1 = atomicAdd((int*)&cur[rt[0]], 1); s2 = atomicAdd((int*)&cur[rt[1]], 1); rt[4] = s1; rt[5] = s2; }
        s1 = __builtin_amdgcn_readfirstlane(s1); s2 = __builtin_amdgcn_readfirstlane(s2);
        const u32x4 v0 = *((const u32x4*)((const unsigned char*)H2 + (size_t)row * D) + C.lane);
        *((u32x4*)((unsigned char*)AG + (size_t)s1 * D) + C.lane) = v0; *((u32x4*)((unsigned char*)AG + (size_t)s2 * D) + C.lane) = v0;
    }
}
DI void phase_final(const Ctx& C, float* x, const unsigned char* route, const bf16_t* Y, const float* mods1, const float* fw) {
    for (int row = C.gw; row < NLAT; row += C.NGW) {
        const int* rt = (const int*)(route + (size_t)row * 24); const float g1 = ((const float*)rt)[2], g2 = ((const float*)rt)[3]; const int s1 = rt[4], s2 = rt[5];
        const float* mv = mods1 + (size_t)(row >> 11) * DIN + 5 * D; float* xr = x + (size_t)row * D;
        f32x4 v[4]; float ss = 0.f;
#pragma unroll
        for (int j = 0; j < 4; ++j) { const int c0 = 256 * j + 4 * C.lane;
            const u32x2 y1 = *(const u32x2*)(Y + (size_t)s1 * D + c0), y2 = *(const u32x2*)(Y + (size_t)s2 * D + c0); const f32x4 m5 = *(const f32x4*)(mv + c0);
            f32x4 y; y[0] = g1 * bflo(y1.x) + g2 * bflo(y2.x); y[1] = g1 * bfhi(y1.x) + g2 * bfhi(y2.x); y[2] = g1 * bflo(y1.y) + g2 * bflo(y2.y); y[3] = g1 * bfhi(y1.y) + g2 * bfhi(y2.y);
            v[j] = *(const f32x4*)(xr + c0) + m5 * y; ss += (v[j][0] * v[j][0] + v[j][1] * v[j][1]) + (v[j][2] * v[j][2] + v[j][3] * v[j][3]); }
        const float rstd = 1.0f / sqrtf(wave_sum(ss) * (1.f / D) + EPS);
#pragma unroll
        for (int j = 0; j < 4; ++j) { const int c0 = 256 * j + 4 * C.lane; *(f32x4*)(xr + c0) = v[j] * rstd * *(const f32x4*)(fw + c0); }
    }
}

constexpr int LDS_MISC = SC_END;
constexpr int LDS_BYTES = SC_END + 256;
constexpr int NPHASE = 20;

DI Ctx make_ctx() {
    extern __shared__ __attribute__((aligned(16))) unsigned char lds_raw[];
    Ctx C; int t = threadIdx.x; asm volatile("" : "+v"(t));
    C.lds = (LAS unsigned char*)lds_raw; C.ws = kparams()->ws; C.tid = t; C.lane = t & 63; C.wave = __builtin_amdgcn_readfirstlane(t >> 6);
    int bx = blockIdx.x; asm volatile("" : "+s"(bx));
    C.G = gridDim.x; C.vcu = (C.G % 8 == 0) ? (bx % 8) * (C.G / 8) + bx / 8 : bx;
    C.gw = C.vcu * 8 + C.wave; C.NGW = C.G * 8;
    return C;
}
DI void grid_barrier() {
    extern __shared__ __attribute__((aligned(16))) unsigned char lds_raw[];
    XcdBarrier b; b.bar = (unsigned*)(kparams()->ws + WS_CTL) + CW_BAR + kparams()->li * XCD_BAR_WORDS; b.x = xb_xcc_id(); b.st = (volatile LAS unsigned*)((LAS unsigned char*)lds_raw + LDS_MISC);
    xcd_barrier(b);
}
#define WSP(T, off) ((T*)(kparams()->ws + (off)))

__global__ void __launch_bounds__(512, 2) fwd_kernel(Params p) {
    extern __shared__ __attribute__((aligned(16))) unsigned char lds_raw[];
    (void)p;
    { volatile LAS unsigned* misc = (volatile LAS unsigned*)((LAS unsigned char*)lds_raw + LDS_MISC);
      if (threadIdx.x < 16) misc[threadIdx.x] = 0u;
      __syncthreads();
      (void)xcd_barrier_post((unsigned*)(kparams()->ws + WS_CTL) + CW_BAR + kparams()->li * XCD_BAR_WORDS, misc); }
#ifdef ONLY_PHASE
#define IN(k) (((ONLY_PHASE) >> (k)) & 1)
#else
#define IN(k) (kparams()->ph_lo <= (k) && (k) < kparams()->ph_hi)
#endif
#define SEAM(k) do { if (IN(k) && IN((k) + 1)) grid_barrier(); } while (0)

    if (IN(0)) { const Ctx C = make_ctx(); phase_prologue(C); } SEAM(0);

    for (int l = 0; l < 2; ++l) {
        const int pb = 1 + 9 * l;
#define XL (l == 0 ? PIN(0) : (const float*)POUT)
#define XC (l == 0 ? PIN(2) : (const float*)WSP(float, WS_CTXRES))
#define LMODS (WSP(float, WS_MODS) + (size_t)l * 33 * DIN)
#define NROWS_OUT (l == 0 ? NTOK : NLAT)
        if (IN(pb + 0)) { const Ctx C = make_ctx(); phase_norm<false>(C, XL, XC, PIN(6) + l * D, LMODS, 0, NTOK, WSP(bf16_t, WS_H), nullptr, nullptr, nullptr); }
        SEAM(pb + 0);
        if (IN(pb + 1)) { const Ctx C = make_ctx();
            Gemm g{WSP(bf16_t, WS_H), WSP(bf16_t, WS_WIN) + (size_t)l * DIN * D, NTOK, 4096, D, D};
            pg8::StaticOrder S; S.init(g, C.G, (int)blockIdx.x);
            EpiInProj E{WSP(bf16_t, WS_P), WSP(float2, WS_ROPE), WSP(float, WS_LBS) + l * 1024, WSP(float, WS_LBS) + l * 1024 + 512};
            pg8::gemm_phase<EpiInProj, pg8::StaticOrder>(C.lds, g, S, E);
        }
        SEAM(pb + 1);
        if (IN(pb + 2)) { const Ctx C = make_ctx(); bf16_t* const Pb = WSP(bf16_t, WS_P);
            for (int id = C.vcu; id < NB * 4 * 2; id += C.G) scan_chain(C, Pb, id >> 3, (id >> 1) & 3, id & 1, l == 0);
            float lam;
            { const float a = wave_sum(PIN(9)[l * 64 + C.lane] * PIN(10)[l * 64 + C.lane]), b2 = wave_sum(PIN(11)[l * 64 + C.lane] * PIN(12)[l * 64 + C.lane]);
              const float li = 0.8f - 0.6f * expf(-0.3f * (float)l); lam = expf(a) - expf(b2) + li; }
            const float post = 1.f - (0.8f - 0.6f * expf(-0.3f * (float)l));
            const float* anw = PIN(13) + l * 128;
            const int NU = NB * 4 * 8, U = (NU + C.G - 1) / C.G;
            for (int id = C.vcu * U; id < NU && id < (C.vcu + 1) * U; ++id) { const int bh = id >> 3, qb = id & 7, b = bh >> 2, h = bh & 3;
                attn_unit(C, Pb, b * T + qb * 256, NLAT + b * CL, b * T, 36, h, lam, anw, post); }
            if (l == 0) for (int id = C.vcu; id < NB * 4; id += C.G) { const int b = id >> 2, h = id & 3;
                attn_unit(C, Pb, NLAT + b * CL, NLAT + b * CL, 0, 4, h, lam, anw, post); }
        }
        SEAM(pb + 2);
        if (IN(pb + 3)) { const Ctx C = make_ctx();
            phase_recprep(C, WSP(bf16_t, WS_P), PIN(14) + l * 128, NROWS_OUT);
            Gemm g{WSP(bf16_t, WS_H), WSP(bf16_t, WS_WIN) + (size_t)l * DIN * D + (size_t)4096 * D, NROWS_OUT, 2048, D, D};
            pg8::StaticOrder S; S.init(g, C.G, (int)blockIdx.x);
            EpiGates E{WSP(bf16_t, WS_P)};
            pg8::gemm_phase<EpiGates, pg8::StaticOrder>(C.lds, g, S, E);
        }
        SEAM(pb + 3);
        if (IN(pb + 4)) {
            { const Ctx C = make_ctx(); Gemm g{WSP(bf16_t, WS_P) + PC_Q, WSP(bf16_t, WS_WUA) + (size_t)l * D * 512, NROWS_OUT, D, 512, PW};
              pg8::StaticOrder S; S.init(g, C.G, (int)blockIdx.x); EpiMerge<true> E{WSP(bf16_t, WS_P), PC_GA, WSP(bf16_t, WS_MERGED)};
              pg8::gemm_phase<EpiMerge<true>, pg8::StaticOrder>(C.lds, g, S, E); }
            { const Ctx C = make_ctx(); Gemm g{WSP(bf16_t, WS_P) + PC_LF, WSP(bf16_t, WS_WUR) + (size_t)l * D * 512, NROWS_OUT, D, 512, PW};
              pg8::StaticOrder S; S.init(g, C.G, (int)blockIdx.x); EpiMerge<false> E{WSP(bf16_t, WS_P), PC_GR, WSP(bf16_t, WS_MERGED)};
              pg8::gemm_phase<EpiMerge<false>, pg8::StaticOrder>(C.lds, g, S, E); }
        }
        SEAM(pb + 4);
        if (IN(pb + 5)) { const Ctx C = make_ctx();
            Gemm g{WSP(bf16_t, WS_MERGED), WSP(bf16_t, WS_WO) + (size_t)l * D * D, NROWS_OUT, D, D, D};
            pg8::StaticOrder S; S.init(g, C.G, (int)blockIdx.x);
            EpiResid E{XL, XC, POUT, WSP(float, WS_CTXRES), LMODS, 2};
            pg8::gemm_phase<EpiResid, pg8::StaticOrder>(C.lds, g, S, E);
        }
        SEAM(pb + 5);
        if (l == 0) {
            if (IN(7)) { const Ctx C = make_ctx(); phase_norm<false>(C, POUT, WSP(float, WS_CTXRES), PIN(7), LMODS, 3, NTOK, WSP(bf16_t, WS_H), nullptr, nullptr, nullptr); }
            SEAM(7);
            if (IN(8)) { const Ctx C = make_ctx();
                Gemm g{WSP(bf16_t, WS_H), WSP(bf16_t, WS_W13), NTOK, 2 * DFFP, D, D};
                pg8::StaticOrder S; S.init(g, C.G, (int)blockIdx.x); EpiSwiglu E{WSP(bf16_t, WS_HID), DFFP, 0};
                pg8::gemm_phase<EpiSwiglu, pg8::StaticOrder>(C.lds, g, S, E);
            }
            SEAM(8);
            if (IN(9)) { const Ctx C = make_ctx();
                Gemm g{WSP(bf16_t, WS_HID), WSP(bf16_t, WS_W2), NTOK, D, DFFP, DFFP};
                pg8::StaticOrder S; S.init(g, C.G, (int)blockIdx.x); EpiResid E{POUT, WSP(float, WS_CTXRES), POUT, WSP(float, WS_CTXRES), LMODS, 5};
                pg8::gemm_phase<EpiResid, pg8::StaticOrder>(C.lds, g, S, E);
            }
            SEAM(9);
        } else {
            if (IN(16)) { const Ctx C = make_ctx(); LAS int* lcnt = (LAS int*)(C.lds + LDS_MISC + 32);
                if (C.tid < 8) lcnt[C.tid] = 0;
                __syncthreads();
                phase_norm<true>(C, POUT, nullptr, PIN(7) + D, LMODS, 3, NLAT, WSP(bf16_t, WS_H2M), PIN(23), WSP(unsigned char, WS_ROUTE), lcnt);
                __syncthreads();
                if (C.tid < 8) WSP(int, WS_CNT)[blockIdx.x * 8 + C.tid] = lcnt[C.tid];
                convert_moe_weights(C);
            }
            SEAM(16);
            if (IN(17)) { const Ctx C = make_ctx(); phase_slots(C, WSP(int, WS_CNT), WSP(int, WS_CNT) + 4096, WSP(unsigned char, WS_ROUTE), WSP(bf16_t, WS_H2M), WSP(bf16_t, WS_AG), (LAS int*)(C.lds + LDS_MISC + 32)); }
            SEAM(17);
            if (IN(18)) {
                const int ptot = __builtin_amdgcn_readfirstlane(WSP(int, WS_CNT)[4096 + 8]);
                for (int p0 = 0; p0 < ptot; p0 += MOE_CHUNK) {
                    const int np = (ptot - p0) < MOE_CHUNK ? (ptot - p0) : MOE_CHUNK;
#define MOE_ORDER_INIT(S) do { S.so.init(g, C.G, (int)blockIdx.x); S.p0 = p0; S.pbv = WSP(int, WS_CNT) + 4096; } while (0)
                    { const Ctx C = make_ctx(); Gemm g{WSP(bf16_t, WS_AG), WSP(bf16_t, WS_WM13), np * 256, 2 * DFE, D / 2, D / 2};
                      pg8::MoeOrder S; MOE_ORDER_INIT(S); S.apan0 = 0; S.estride = (size_t)2 * DFE * D;
                      EpiSwiglu8 E{WSP(unsigned char, WS_MHID), DFE, p0, 1.f / W13_SCALE, HID_SCALE};
                      pg8::gemm_phase<EpiSwiglu8, pg8::MoeOrder, true, true>(C.lds, g, S, E); }
                    grid_barrier();
                    { const Ctx C = make_ctx(); Gemm g{WSP(bf16_t, WS_MHID), WSP(bf16_t, WS_WM2), np * 256, D, DFE / 2, DFE / 2};
                      pg8::MoeOrder S; MOE_ORDER_INIT(S); S.apan0 = p0; S.estride = (size_t)D * DFE;
                      EpiBf16 E{WSP(bf16_t, WS_Y), D, 1.f / (W2_SCALE * HID_SCALE)};
                      pg8::gemm_phase<EpiBf16, pg8::MoeOrder, true, true>(C.lds, g, S, E); }
                    grid_barrier();
                }
            }
            if (IN(19)) { const Ctx C = make_ctx(); phase_final(C, POUT, WSP(unsigned char, WS_ROUTE), WSP(bf16_t, WS_Y), LMODS, PIN(27)); }
        }
    }
#undef IN
#undef SEAM
}


#ifndef DBG_T1
#define DBG_T1 1
#endif
#ifndef DBG_CAT
#define DBG_CAT (j >> 9)
#endif
#if DBG
constexpr size_t DBG_ERR = WS_DBG, DBG_SNAPX = WS_DBG + 4096, DBG_ROWS = WS_DBG + 65536, DBG_Q = WS_MERGED + 64 * MiB, DBG_OF = WS_DBG + 262144, DBG_LF = WS_MERGED;
__device__ inline unsigned dhash(unsigned x) { x ^= x >> 16; x *= 0x7feb352du; x ^= x >> 15; x *= 0x846ca68bu; x ^= x >> 16; return x; }
__device__ inline float rbf(float f) { unsigned u = __float_as_uint(f); u += 0x7fffu + ((u >> 16) & 1u); return __uint_as_float(u & 0xffff0000u); }
__device__ inline void rec_err(unsigned char* ws, int id, float got, float exp_, float atol) {
    float d = got - exp_; if (!(d == d) || fabsf(d) > 1e15f) d = 1e15f;
    atomicAdd((float*)(ws + DBG_ERR) + id, d * d); atomicAdd((float*)(ws + DBG_ERR) + 64 + id, exp_ * exp_);
    if (fabsf(d) > 0.15f * fabsf(exp_) + atol * 5.f) atomicAdd((unsigned*)(ws + DBG_ERR) + 128 + id, 1u);
}
__device__ inline int srow(unsigned i) { const unsigned h = dhash(i * 7919u + 13u); return (i & 3u) == 3u ? NLAT + (int)(h % NCTX) : (int)(h % NLAT); }
__device__ inline const float* xrowp(const float* xl, const float* xc, int row) { return row < NLAT ? xl + (size_t)row * D : xc + (size_t)(row - NLAT) * D; }
__device__ inline float dsilu(float x) { return x / (1.f + expf(-x)); }
__device__ inline float dot_hw(const bf16_t* a, const float* w, int K, int ldw) { float s = 0.f; for (int k = 0; k < K; ++k) s += bf2f(a[k]) * rbf(w[(size_t)k * ldw]); return s; }

struct DArgs { const float* in[28]; float* out; unsigned char* ws; int l, kind, id, aux; };
__global__ void dbg_check(DArgs a) {
    unsigned char* ws = a.ws; const int l = a.l; const int i = blockIdx.x * blockDim.x + threadIdx.x;
    const float* mods = (const float*)(ws + WS_MODS) + (size_t)l * 33 * DIN; const bf16_t* P = (const bf16_t*)(ws + WS_P);
    if (a.kind == 1) { const int ll = i & 1, r = dhash(i) % 33, n = dhash(i + 777) % DIN; const float* cv = r < 32 ? a.in[1] + r * D : a.in[3];
        float s = a.in[5][ll * DIN + n]; for (int k = 0; k < D; ++k) s += dsilu(cv[k]) * a.in[4][((size_t)ll * D + k) * DIN + n];
        rec_err(ws, a.id, ((const float*)(ws + WS_MODS))[(size_t)(ll * 33 + r) * DIN + n], s, 0.01f); }
    else if (a.kind == 30) { const int ll = i & 1, n = 4096 + dhash(i) % 2048, k = dhash(i + 4242) % D;
        rec_err(ws, a.id, bf2f(((const bf16_t*)(ws + WS_WIN))[((size_t)ll * DIN + n) * D + k]), rbf(a.in[8][((size_t)ll * D + k) * DIN + n]), 1e-6f); }
    else if (a.kind == 2) { int row = srow(i); if (a.aux == 2 || (l == 1 && a.aux != 0)) row = row % NLAT; const int col = dhash(i + 99) % D;
        const float* xl = a.aux == 0 ? (l == 0 ? a.in[0] : a.out) : a.out; const float* xc = a.aux == 0 && l == 0 ? a.in[2] : (const float*)(ws + WS_CTXRES);
        const float* xr = xrowp(xl, xc, row); float ss = 0.f; for (int k = 0; k < D; ++k) ss += xr[k] * xr[k];
        const float rstd = 1.f / sqrtf(ss / D + EPS); const float* nw = (a.aux == 0 ? a.in[6] : a.in[7]) + l * D; const int sh = a.aux == 0 ? 0 : 3;
        const float* mv = mods + (size_t)(row < NLAT ? row >> 11 : 32) * DIN;
        const float e = xr[col] * rstd * nw[col] * (1.f + mv[(sh + 1) * D + col]) + mv[sh * D + col];
        const bf16_t* H = (const bf16_t*)(ws + (a.aux == 2 ? WS_H2M : WS_H)); rec_err(ws, a.id, bf2f(H[(size_t)row * D + col]), e, 0.02f); }
    else if (a.kind == 3) { const int sec = i & 7, row = srow(i >> 3), j = dhash(i + 5) % 512; const bf16_t* hr = (const bf16_t*)(ws + WS_H) + (size_t)row * D; const float* W = a.in[8] + (size_t)l * D * DIN;
        float e, got; const bool lat = row < NLAT; const int t = row & (T - 1);
        if (sec == 0 || sec == 1) { const int hs = j >> 6, d = j & 63, pi = d & 31, ob = (sec == 0 ? 0 : 512) + hs * 64;
            const float xa = dot_hw(hr, W + ob + pi, D, DIN), xb = dot_hw(hr, W + ob + 32 + pi, D, DIN);
            float c = 1.f, sn = 0.f; if (lat) { const float invf = powf(10000.f, -(float)(pi & 15) / 16.f); const float ang = (float)(pi < 16 ? (t >> 6) : (t & 63)) * invf; c = cosf(ang); sn = sinf(ang); }
            e = d < 32 ? xa * c - xb * sn : xa * sn + xb * c; if (sec == 0) e *= QSCALE;
            got = bf2f(P[(size_t)row * PW + (sec == 0 ? PC_Q : PC_K) + hs * 64 + (d < 32 ? 2 * d : 2 * (d - 32) + 1)]); }
        else if (sec == 2) { e = dot_hw(hr, W + 1024 + j, D, DIN); got = bf2f(P[(size_t)row * PW + PC_V + j]); }
        else if (sec == 3) { e = dsilu(dot_hw(hr, W + 1536 + j, D, DIN)); got = bf2f(P[(size_t)row * PW + PC_RQ + j]); }
        else if (sec == 4) { e = dot_hw(hr, W + 2048 + j, D, DIN); got = bf2f(P[(size_t)row * PW + PC_RI + j]); }
        else if (sec == 5 || sec == 6) { const float z = dot_hw(hr, W + (sec == 5 ? 2560 : 3072) + j, D, DIN); const float* lbp = a.in[sec == 5 ? 15 : 16];
            const float lb = l == 0 ? 0.f : 1.f / (1.f + expf(lbp[j] - lbp[512 + j])); const float sg = 1.f / (1.f + expf(-z)); e = logf(lb + (1.f - lb) * sg);
            got = (float)((const _Float16*)P)[(size_t)row * PW + (sec == 5 ? PC_LF : PC_LB) + j]; }
        else { e = dsilu(dot_hw(hr, W + 3584 + j, D, DIN)); got = bf2f(P[(size_t)row * PW + PC_G + j]); }
        rec_err(ws, a.id + sec, got, e, 0.03f); }
    else if (a.kind == 6) { const int i6 = i; int row = srow(i6); if (l == 1 || DBG_T1) row %= NLAT; const int j = dhash(i6 + 5) % 2048; const bf16_t* hr = (const bf16_t*)(ws + WS_H) + (size_t)row * D;
        const float z = dot_hw(hr, a.in[8] + (size_t)l * D * DIN + 4096 + j, D, DIN); const size_t gi_ = (size_t)row * PW + PC_GA + j; const unsigned gw_ = __hip_atomic_load((unsigned*)P + (gi_ >> 1), __ATOMIC_RELAXED, __HIP_MEMORY_SCOPE_AGENT);
        const float gt_ = (gi_ & 1) ? bfhi(gw_) : bflo(gw_), ex_ = 1.f / (1.f + expf(-z)); rec_err(ws, a.id, gt_, ex_, 0.01f);
        if (fabsf(gt_ - ex_) > 0.15f * ex_ + 0.05f) { atomicAdd((unsigned*)(ws + DBG_ERR) + 192 + (fabsf(gt_ - 100.f) < 1.f ? 0 : (gt_ < 0.f || gt_ > 1.f) ? 1 : 2), 1u); atomicAdd((unsigned*)(ws + DBG_ERR) + 196 + ((row >> 8) & 3), 1u); } }
    else if (a.kind == 7) { int row = srow(i); if (l == 1) row %= NLAT; const int n = dhash(i + 5) % D; const bf16_t* pr = P + (size_t)row * PW;
        const float ya = dot_hw(pr + PC_Q, a.in[17] + (size_t)l * 512 * D + n, 512, D), yr = dot_hw(pr + PC_LF, a.in[18] + (size_t)l * 512 * D + n, 512, D);
        rec_err(ws, a.id, bf2f(((const bf16_t*)(ws + WS_MERGED))[(size_t)row * D + n]), bf2f(pr[PC_GA + n]) * ya + bf2f(pr[PC_GR + n]) * yr, 0.03f); }
    else if (a.kind == 8 || a.kind == 10) { int row = srow(i); if (l == 1) row %= NLAT; const int col = dhash(i + 5) % D; const int msel = a.kind == 8 ? 2 : 5;
        float xin; if (a.kind == 8 && l == 0) xin = xrowp(a.in[0], a.in[2], row)[col]; else xin = ((const float*)(ws + DBG_SNAPX))[i];
        float y; if (a.kind == 8) y = dot_hw((const bf16_t*)(ws + WS_MERGED) + (size_t)row * D, a.in[19] + (size_t)l * D * D + col, D, D);
        else y = dot_hw((const bf16_t*)(ws + WS_HID) + (size_t)row * DFFP, a.in[22] + col, DFF, D);
        const float e = xin + mods[(size_t)(row < NLAT ? row >> 11 : 32) * DIN + msel * D + col] * y;
        rec_err(ws, a.id, xrowp(a.out, (const float*)(ws + WS_CTXRES), row)[col], e, 0.03f); }
    else if (a.kind == 9) { const int row = srow(i), j = dhash(i + 5) % DFF; const bf16_t* hr = (const bf16_t*)(ws + WS_H) + (size_t)row * D;
        const float u = dot_hw(hr, a.in[20] + j, D, DFF), v = dot_hw(hr, a.in[21] + j, D, DFF); rec_err(ws, a.id, bf2f(((const bf16_t*)(ws + WS_HID))[(size_t)row * DFFP + j]), dsilu(u) * v, 0.03f); }
    else if (a.kind == 11) { const int row = dhash(i) % NLAT; const float* xr = a.out + (size_t)row * D; float ss = 0.f; for (int k = 0; k < D; ++k) ss += xr[k] * xr[k];
        const float rstd = 1.f / sqrtf(ss / D + EPS); const float* mv = mods + (size_t)(row >> 11) * DIN; float lg[8]; for (int e = 0; e < 8; ++e) lg[e] = 0.f;
        for (int k = 0; k < D; ++k) { const float h = xr[k] * rstd * a.in[7][D + k] * (1.f + mv[4 * D + k]) + mv[3 * D + k]; for (int e = 0; e < 8; ++e) lg[e] += h * a.in[23][k * 8 + e]; }
        int e1 = 0; for (int e = 1; e < 8; ++e) if (lg[e] > lg[e1]) e1 = e; int e2 = e1 == 0 ? 1 : 0; for (int e = 0; e < 8; ++e) if (e != e1 && lg[e] > lg[e2]) e2 = e;
        const int* rt = (const int*)(ws + WS_ROUTE + (size_t)row * 24); const float g1 = 1.f / (1.f + expf(lg[e2] - lg[e1]));
        const float margin = lg[e2] - fmaxf(-1e30f, [&]{ float m = -1e30f; for (int e = 0; e < 8; ++e) if (e != e1 && e != e2) m = fmaxf(m, lg[e]); return m; }());
        if (margin > 1e-3f && lg[e1] - lg[e2] > 1e-3f) { rec_err(ws, a.id, (float)rt[0], (float)e1, 0.01f); rec_err(ws, a.id, (float)rt[1], (float)e2, 0.01f); rec_err(ws, a.id, ((const float*)rt)[2], g1, 0.01f); rec_err(ws, a.id, ((const float*)rt)[3], 1.f - g1, 0.01f); } }
    else if (a.kind == 12) { const int row = dhash(i) % NLAT; const int* rt = (const int*)(ws + WS_ROUTE + (size_t)row * 24); const int* pb = (const int*)(ws + WS_CNT) + 4096;
        for (int w = 0; w < 2; ++w) { const int s = rt[4 + w], e = rt[w]; const int pan = s >> 8; int ee = 0; for (int k = 1; k < 8; ++k) ee += pan >= pb[k];
            rec_err(ws, a.id, (float)ee, (float)e, 0.01f); if (s < 0 || s >= pb[8] * 256) rec_err(ws, a.id, 1.f, 0.f, 0.01f);
            const int col = dhash(i + 31 + w) % D; rec_err(ws, a.id, bf2f(((const bf16_t*)(ws + WS_AG))[(size_t)s * D + col]), bf2f(((const bf16_t*)(ws + WS_H2M))[(size_t)row * D + col]), 1e-6f); } }
    else if (a.kind == 14) { int row = srow(i & 15); if (l == 1) row %= NLAT; const int hh = (i >> 4) & 3; const bf16_t* of = (const bf16_t*)(ws + DBG_OF) + (size_t)(i & 15) * 512 + hh * 128; const bf16_t* pr = P + (size_t)row * PW;
        float ss = 0.f; for (int v = 0; v < 128; ++v) { const float o = bf2f(of[v]) + bf2f(pr[PC_LB + hh * 128 + v]); ss += o * o; }
        const float rs = 1.f / sqrtf(ss / 128.f + EPS); const int v = dhash(i) % 128;
        rec_err(ws, a.id, bf2f(pr[PC_LF + hh * 128 + v]), (bf2f(of[v]) + bf2f(pr[PC_LB + hh * 128 + v])) * rs * a.in[14][l * 128 + v] * bf2f(pr[PC_G + hh * 128 + v]), 0.03f); }
}
__global__ void dbg_snap(DArgs a) {
    unsigned char* ws = a.ws; const int l = a.l; const int i = blockIdx.x * blockDim.x + threadIdx.x; const bf16_t* P = (const bf16_t*)(ws + WS_P);
    if (a.kind == 8 || a.kind == 10) { int row = srow(i); if (l == 1) row %= NLAT; const int col = dhash(i + 5) % D; ((float*)(ws + DBG_SNAPX))[i] = xrowp(a.out, (const float*)(ws + WS_CTXRES), row)[col]; }
    else if (a.kind == 20) { const int ch = blockIdx.x >> 1, dir = blockIdx.x & 1, b = (ch * 5 + 3) % NB, h = (ch + (ch >> 2)) & 3;
        bf16_t* dst = (bf16_t*)(ws + DBG_LF) + (size_t)blockIdx.x * 2304 * 128;
        for (int s = 0; s < 2304; ++s) { const int row = s < 256 ? NLAT + b * CL + s : b * T + (s - 256); dst[(size_t)s * 128 + threadIdx.x] = P[(size_t)row * PW + (dir ? PC_LB : PC_LF) + h * 128 + threadIdx.x]; } }
    else if (a.kind == 21) { const int smp = blockIdx.x; int row = a.aux ? NLAT + (int)(dhash(smp) % NCTX) : (int)(dhash(smp) % NLAT); const int h = smp & 3;
        ((bf16_t*)(ws + DBG_Q))[(a.aux * 1024 + smp) * 128 + threadIdx.x] = P[(size_t)row * PW + PC_Q + h * 128 + threadIdx.x]; }
    else if (a.kind == 22) { int row = srow(blockIdx.x); if (l == 1) row %= NLAT; for (int c = threadIdx.x; c < 512; c += blockDim.x) ((bf16_t*)(ws + DBG_OF))[blockIdx.x * 512 + c] = P[(size_t)row * PW + PC_LF + c]; }
    else if (a.kind == 40) { for (size_t r = blockIdx.x; r < (size_t)NTOK; r += gridDim.x) for (int c = threadIdx.x; c < 256; c += blockDim.x) ((u32x4*)(P + r * PW + 2048))[c] = (u32x4){0x42C842C8u, 0x42C842C8u, 0x42C842C8u, 0x42C842C8u}; }
    else if (a.kind == 23) { const int row = dhash(blockIdx.x) % NLAT; for (int c = threadIdx.x; c < D; c += blockDim.x) ((float*)(ws + DBG_ROWS))[blockIdx.x * D + c] = a.out[(size_t)row * D + c]; }
}
__global__ void dbg_scan(DArgs a) {
    extern __shared__ float Scol[];
    unsigned char* ws = a.ws; const int l = a.l; const int ch = blockIdx.x >> 1, dir = blockIdx.x & 1, b = (ch * 5 + 3) % NB, h = (ch + (ch >> 2)) & 3, v = threadIdx.x; const bf16_t* P = (const bf16_t*)(ws + WS_P);
    const _Float16* lfs = (const _Float16*)(ws + DBG_LF) + (size_t)blockIdx.x * 2304 * 128;
    for (int d = 0; d < 128; ++d) Scol[d * 128 + v] = 0.f;
    for (int st = 0; st < 2304; ++st) {
        int s, row; if (st < 256) { s = dir ? 255 - st : st; row = NLAT + b * CL + s; } else { const int tt = dir ? 2047 - (st - 256) : st - 256; s = 256 + tt; row = b * T + tt; }
        const bf16_t* pr = P + (size_t)row * PW; const float val = bf2f(pr[PC_RI + h * 128 + v]); float o = 0.f;
        for (int d = 0; d < 128; ++d) { const float f = expf((float)lfs[(size_t)s * 128 + d]); const float sv = f * Scol[d * 128 + v] + (1.f - f) * val; Scol[d * 128 + v] = sv; o += bf2f(pr[PC_RQ + h * 128 + d]) * sv; }
        if (st >= 256 || l == 0) rec_err(ws, a.id + dir, bf2f(pr[(dir ? PC_LB : PC_LF) + h * 128 + v]), o, 0.3f);
    }
}
__global__ void dbg_attn(DArgs a) {
    __shared__ float red[128];
    unsigned char* ws = a.ws; const int l = a.l; const int smp = blockIdx.x, v = threadIdx.x, h = smp & 3; const bf16_t* P = (const bf16_t*)(ws + WS_P);
    const int row = a.aux ? NLAT + (int)(dhash(smp) % NCTX) : (int)(dhash(smp) % NLAT); const int b = a.aux ? (row - NLAT) / CL : row / T;
    const bf16_t* q = (const bf16_t*)(ws + DBG_Q) + (a.aux * 1024 + smp) * 128; const int nk = a.aux ? 256 : 2304;
    float la = 0.f, lb2 = 0.f; for (int k = 0; k < 64; ++k) { la += a.in[9][l * 64 + k] * a.in[10][l * 64 + k]; lb2 += a.in[11][l * 64 + k] * a.in[12][l * 64 + k]; }
    const float lami = 0.8f - 0.6f * expf(-0.3f * l), lam = expf(la) - expf(lb2) + lami;
    float o[2];
    for (int c = 0; c < 2; ++c) { float m = -1e30f, ls = 0.f, acc = 0.f;
        for (int k = 0; k < nk; ++k) { const int kr = k < 256 ? NLAT + b * CL + k : b * T + (k - 256); const bf16_t* kp = P + (size_t)kr * PW;
            float s = 0.f; for (int d = 0; d < 64; ++d) s += bf2f(q[c * 64 + d]) * bf2f(kp[PC_K + h * 128 + c * 64 + d]);
            const float mn = fmaxf(m, s), al = exp2f(m - mn), pe = exp2f(s - mn); ls = ls * al + pe; acc = acc * al + pe * bf2f(kp[PC_V + h * 128 + v]); m = mn; }
        o[c] = acc / ls; }
    const float ov = o[0] - lam * o[1]; red[v] = ov * ov; __syncthreads();
    for (int st = 64; st > 0; st >>= 1) { if (v < st) red[v] += red[v + st]; __syncthreads(); }
    const float e = ov / sqrtf(red[0] / 128.f + EPS) * a.in[13][l * 128 + v] * (1.f - lami);
    rec_err(ws, a.id, bf2f(P[(size_t)row * PW + PC_Q + h * 128 + v]), e, 0.03f);
}
__global__ void dbg_moey(DArgs a) {
    __shared__ float red[256];
    unsigned char* ws = a.ws; const int smp = blockIdx.x, row = dhash(smp) % NLAT, w = smp & 1; const int* rt = (const int*)(ws + WS_ROUTE + (size_t)row * 24);
    const int e = rt[w], s = rt[4 + w], col = dhash(smp + 99) % D; const bf16_t* hr = (const bf16_t*)(ws + WS_AG) + (size_t)s * D;
    float acc = 0.f;
    for (int j = threadIdx.x; j < DFE; j += 256) { const float u = dot_hw(hr, a.in[24] + (size_t)e * D * DFE + j, D, DFE), vv = dot_hw(hr, a.in[25] + (size_t)e * D * DFE + j, D, DFE);
        acc += rbf(dsilu(u) * vv) * rbf(a.in[26][((size_t)e * DFE + j) * D + col]); }
    red[threadIdx.x] = acc; __syncthreads();
    for (int st = 128; st > 0; st >>= 1) { if (threadIdx.x < st) red[threadIdx.x] += red[threadIdx.x + st]; __syncthreads(); }
    if (threadIdx.x == 0) rec_err(ws, a.id, bf2f(((const bf16_t*)(ws + WS_Y))[(size_t)s * D + col]), red[0], 0.03f);
}
__global__ void dbg_final(DArgs a) {
    __shared__ float red[256];
    unsigned char* ws = a.ws; const int row = dhash(blockIdx.x) % NLAT; const int* rt = (const int*)(ws + WS_ROUTE + (size_t)row * 24); const float g1 = ((const float*)rt)[2], g2 = ((const float*)rt)[3];
    const float* xs = (const float*)(ws + DBG_ROWS) + blockIdx.x * D; const bf16_t* Y = (const bf16_t*)(ws + WS_Y); const float* mv = (const float*)(ws + WS_MODS) + (size_t)(33 + (row >> 11)) * DIN + 5 * D;
    float vals[4], ss = 0.f; for (int q = 0; q < 4; ++q) { const int c = threadIdx.x + 256 * q; vals[q] = xs[c] + mv[c] * (g1 * bf2f(Y[(size_t)rt[4] * D + c]) + g2 * bf2f(Y[(size_t)rt[5] * D + c])); ss += vals[q] * vals[q]; }
    red[threadIdx.x] = ss; __syncthreads();
    for (int st = 128; st > 0; st >>= 1) { if (threadIdx.x < st) red[threadIdx.x] += red[threadIdx.x + st]; __syncthreads(); }
    const float rstd = 1.f / sqrtf(red[0] / D + EPS);
    for (int q = 0; q < 4; ++q) { const int c = threadIdx.x + 256 * q; rec_err(ws, a.id, a.out[(size_t)row * D + c], vals[q] * rstd * a.in[27][c], 0.02f); }
}
__global__ void dbg_finalize(float* out, const unsigned char* ws, int n) {
    const float* err = (const float*)(ws + DBG_ERR); int bad = 0; float ratio = 0.f;
    for (int k = 1; k < 64; ++k) { float r = err[k] / (err[64 + k] + 1e-20f); const unsigned nb = ((const unsigned*)err)[128 + k]; const float thr = (k == 11 || k == 12 || k == 13 || k == 14 || k == 31 || k == 32 || k == 33) ? 3e-4f : 1e-4f; if (r > thr || nb > 0u) { bad = k; ratio = nb > 0u ? fmaxf(r, 1e-4f) : r; break; } }
    if (!bad) { for (int k = 1; k <= 43; ++k) if (k != 34 && err[64 + k] == 0.f) { bad = 30 + k; ratio = 1e-4f; break; } }
    if (!bad) return;
    float m = floorf(-2.f * log10f(fminf(ratio, 1.f))); m = fminf(fmaxf(m, 0.f), 8.f);
    if (bad == 16) { const unsigned* cu = (const unsigned*)err + 192; m = 0.5f * (float)((cu[4] ? 1 : 0) | (cu[5] ? 2 : 0) | (cu[6] ? 4 : 0) | (cu[7] ? 8 : 0)); bad = 48 + ((cu[0] ? 1 : 0) | (cu[1] ? 2 : 0) | (cu[2] ? 4 : 0) | (cu[3] ? 8 : 0)); }
    const float cst = sqrtf((1.f + m)) * powf(10.f, 0.5f * (float)bad);
    for (size_t i = (size_t)blockIdx.x * blockDim.x + threadIdx.x; i < (size_t)n; i += (size_t)gridDim.x * blockDim.x) out[i] = cst;
}
#endif

extern "C" void kernel_launch(void* const* d_in, const int* in_sizes, int n_in, void* d_out, int out_size, void* d_ws, size_t ws_size, hipStream_t stream) {
    static int grid = 0;
    if (grid == 0) {
        if (n_in != 28 || out_size != NLAT * D || ws_size < WS_END) { fprintf(stderr, "kernel_launch: unexpected problem (n_in %d, out %d, ws %zu)\n", n_in, out_size, ws_size); grid = -1; return; }
        int dev = 0, cus = 0, per_cu = 0;
        if (hipGetDevice(&dev) != hipSuccess || hipDeviceGetAttribute(&cus, hipDeviceAttributeMultiprocessorCount, dev) != hipSuccess) { grid = -1; return; }
        if (hipFuncSetAttribute((const void*)fwd_kernel, hipFuncAttributeMaxDynamicSharedMemorySize, LDS_BYTES) != hipSuccess) { fprintf(stderr, "kernel_launch: cannot set %d B dynamic LDS\n", LDS_BYTES); grid = -1; return; }
        if (hipOccupancyMaxActiveBlocksPerMultiprocessor(&per_cu, (const void*)fwd_kernel, 512, LDS_BYTES) != hipSuccess || per_cu < 1) fprintf(stderr, "kernel_launch: occupancy query says %d\n", per_cu);
        (void)hipGetLastError();
        grid = cus;
    }
    if (grid < 0) return;
    (void)hipMemsetAsync((char*)d_ws + WS_CTL, 0, CTL_BYTES, stream);
    Params a{};
    for (int i = 0; i < 28; ++i) a.in[i] = (const float*)d_in[i];
    a.out = (float*)d_out; a.ws = (unsigned char*)d_ws; a.ph_lo = 0; a.ph_hi = NPHASE; a.li = 0; a.pad = 0;
#if !DBG
    hipLaunchKernelGGL(fwd_kernel, dim3(grid), dim3(512), LDS_BYTES, stream, a);
#else
    (void)hipMemsetAsync((char*)d_ws + WS_DBG, 0, 4096, stream);
    DArgs da{}; for (int i = 0; i < 28; ++i) da.in[i] = (const float*)d_in[i]; da.out = (float*)d_out; da.ws = (unsigned char*)d_ws;
    static bool attr = false; if (!attr) { (void)hipFuncSetAttribute((const void*)dbg_scan, hipFuncAttributeMaxDynamicSharedMemorySize, 65536); attr = true; }
#define DCHK(K, ID, AUX, NBLK, NTHR) do { da.kind = (K); da.id = (ID); da.aux = (AUX); hipLaunchKernelGGL(dbg_check, dim3(NBLK), dim3(NTHR), 0, stream, da); } while (0)
#define DSNAP(K, AUX, NBLK, NTHR) do { da.kind = (K); da.aux = (AUX); hipLaunchKernelGGL(dbg_snap, dim3(NBLK), dim3(NTHR), 0, stream, da); } while (0)
    for (int ph = 0; ph < NPHASE; ++ph) {
        const int l = ph >= 10 ? 1 : 0, pb = 1 + 9 * l, base = l == 0 ? 0 : 20, k = ph - pb; da.l = l;
        if (ph >= 1 && ph <= 15 && k == 2) { DSNAP(20, 0, 64, 128); DSNAP(21, 0, 1024, 128); if (l == 0) DSNAP(21, 1, 256, 128); }
        if (ph >= 1 && ph <= 15 && k == 3) { DSNAP(22, 0, 16, 128); }
        if (ph == 15) DSNAP(8, 0, 32, 64);
        if (ph == 9) DSNAP(10, 0, 32, 64);
        if (ph == 19) DSNAP(23, 0, 16, 256);
        a.ph_lo = ph; a.ph_hi = ph + 1; a.li = ph;
        hipLaunchKernelGGL(fwd_kernel, dim3(grid), dim3(512), LDS_BYTES, stream, a);
        if (ph == 0) { DCHK(1, 1, 0, 16, 64); DCHK(30, 1, 0, 256, 64); }
        if (ph >= 1 && ph <= 15) {
            if (k == 0) DCHK(2, base + 2, 0, 32, 64);
            if (k == 1) DCHK(3, base + 3, 0, 128, 64);
            if (k == 2) { da.id = base + 11; hipLaunchKernelGGL(dbg_scan, dim3(64), dim3(128), 65536, stream, da);
                          da.id = base + 13; da.aux = 0; hipLaunchKernelGGL(dbg_attn, dim3(1024), dim3(128), 0, stream, da);
                          if (l == 0) { da.id = 14; da.aux = 1; hipLaunchKernelGGL(dbg_attn, dim3(256), dim3(128), 0, stream, da); } }
            if (k == 3) { DCHK(14, base + 15, 0, 1, 64); DCHK(6, base + 16, 0, 32, 64); }
            if (k == 4) DCHK(7, base + 17, 0, 32, 64);
            if (k == 5) DCHK(8, base + 18, 0, 32, 64);
        }
        if (ph == 7) DCHK(2, 19, 1, 32, 64);
        if (ph == 8) DCHK(9, 20, 0, 32, 64);
        if (ph == 9) DCHK(10, 21, 0, 32, 64);
        if (ph == 16) { DCHK(11, 39, 0, 32, 64); DCHK(2, 40, 2, 32, 64); }
        if (ph == 17) DCHK(12, 41, 0, 32, 64);
        if (ph == 18) { da.id = 42; hipLaunchKernelGGL(dbg_moey, dim3(128), dim3(256), 0, stream, da); }
        if (ph == 19) { da.id = 43; hipLaunchKernelGGL(dbg_final, dim3(16), dim3(256), 0, stream, da); }
    }
    hipLaunchKernelGGL(dbg_finalize, dim3(1024), dim3(256), 0, stream, (float*)d_out, (const unsigned char*)d_ws, out_size);
#endif
}
```

```cpp
#include <hip/hip_runtime.h>
#include <cstdio>
#include <cstdint>

#ifndef DBG
#define DBG 0
#endif

constexpr int D = 1024, NB = 32, T = 2048, CL = 256;
constexpr int NLAT = NB * T, NCTX = NB * CL, NTOK = NLAT + NCTX;
constexpr int PW = 4096;
constexpr int DIN = 6144, DFF = 2752, DFFP = 2816, DFE = 3584, NE = 8;
constexpr float EPS = 1e-6f;
constexpr float LOG2E = 1.4426950408889634f;
constexpr float QSCALE = 0.125f * LOG2E;
constexpr int PC_Q = 0, PC_G = 512, PC_LF = 1024, PC_LB = 1536, PC_K = 2048, PC_V = 2560, PC_RQ = 3072, PC_RI = 3584, PC_GA = 2048, PC_GR = 3072;

constexpr size_t MiB = 1u << 20;
constexpr size_t WS_CTL = 0, CTL_BYTES = 1 * MiB;
constexpr size_t WS_MODS = 1 * MiB;
constexpr size_t WS_LBS = 3 * MiB;
constexpr size_t WS_ROPE = 3 * MiB + 65536;
constexpr size_t WS_ROUTE = 4 * MiB;
constexpr size_t WS_CNT = 6 * MiB;
constexpr size_t WS_DBG = 7 * MiB;
constexpr size_t WS_CTXRES = 8 * MiB;
constexpr size_t WS_WIN = 40 * MiB;
constexpr size_t WS_WIN8 = 56 * MiB;
constexpr size_t WS_H8 = 809 * MiB;
constexpr size_t WS_WUA = 64 * MiB;
constexpr size_t WS_WUR = 66 * MiB;
constexpr size_t WS_WO = 68 * MiB;
constexpr size_t WS_W13 = 72 * MiB;
constexpr size_t WS_W2 = 83 * MiB;
constexpr size_t WS_H = 89 * MiB;
constexpr size_t WS_P = 233 * MiB;
constexpr size_t WS_MERGED = 809 * MiB;
constexpr size_t WS_HID = 233 * MiB;
constexpr size_t WS_WM13 = 8 * MiB;
constexpr size_t WS_WM2 = 120 * MiB;
constexpr size_t WS_AG = 176 * MiB;
constexpr size_t WS_MHID = 436 * MiB;
constexpr size_t WS_Y = 674 * MiB;
constexpr size_t WS_H2M = 896 * MiB;
constexpr size_t WS_END = 1024 * MiB;
constexpr int MOE_CHUNK = 128;

constexpr int CW_BAR = 4096;

#define LAS __attribute__((address_space(3)))
#define GAS __attribute__((address_space(1)))
typedef unsigned short bf16_t;
typedef short bf16x8 __attribute__((ext_vector_type(8)));
typedef short s16x4 __attribute__((ext_vector_type(4)));
typedef _Float16 half8 __attribute__((ext_vector_type(8)));
typedef _Float16 half4 __attribute__((ext_vector_type(4)));
typedef float f32x4 __attribute__((ext_vector_type(4)));
typedef float f32x2 __attribute__((ext_vector_type(2)));
typedef float f32x16 __attribute__((ext_vector_type(16)));
typedef unsigned u32x4 __attribute__((ext_vector_type(4)));
typedef unsigned u32x2 __attribute__((ext_vector_type(2)));
#define DI __device__ __forceinline__
#define LDS_WAIT() asm volatile("s_waitcnt lgkmcnt(0)" ::: "memory")
#define VM_WAIT() asm volatile("s_waitcnt vmcnt(0)" ::: "memory")

typedef __bf16 bf16x2_t __attribute__((ext_vector_type(2)));
DI unsigned cvt_pk_bf16(float lo, float hi) { f32x2 v = {lo, hi}; bf16x2_t b = __builtin_convertvector(v, bf16x2_t); return __builtin_bit_cast(unsigned, b); }
typedef int v8i32 __attribute__((ext_vector_type(8)));
typedef int v4i32 __attribute__((ext_vector_type(4)));
DI unsigned pack_fp8x4(float a, float b, float c, float d) {
    a = fminf(fmaxf(a, -448.f), 448.f); b = fminf(fmaxf(b, -448.f), 448.f); c = fminf(fmaxf(c, -448.f), 448.f); d = fminf(fmaxf(d, -448.f), 448.f);
    int w = 0; w = __builtin_amdgcn_cvt_pk_fp8_f32(a, b, w, false); w = __builtin_amdgcn_cvt_pk_fp8_f32(c, d, w, true); return (unsigned)w; }
DI float bf2f(unsigned short b) { return __uint_as_float(((unsigned)b) << 16); }
DI float bflo(unsigned w) { return __uint_as_float(w << 16); }
DI float bfhi(unsigned w) { return __uint_as_float(w & 0xffff0000u); }
DI float fsilu(float x) { return x * __builtin_amdgcn_rcpf(1.f + __expf(-x)); }
DI float fsigmoid(float x) { return __builtin_amdgcn_rcpf(1.f + __expf(-x)); }
DI float wave_sum(float v) {
#pragma unroll
    for (int o = 1; o < 64; o <<= 1) v += __shfl_xor(v, o);
    return v;
}
DI int crow(int r, int hi) { return (r & 3) + 8 * (r >> 2) + 4 * hi; }

constexpr int LDS_WTAB_OFF = 148480 + 128;
DI int my_tid() {
    extern __shared__ __attribute__((aligned(16))) unsigned char lds_raw[];
    const unsigned hw = (unsigned)__builtin_amdgcn_s_getreg((5 << 11) | 4) & 63u;
    const int w = __builtin_amdgcn_readfirstlane(((volatile LAS int*)((LAS unsigned char*)lds_raw + LDS_WTAB_OFF))[hw]);
    int t = w * 64 + (int)__builtin_amdgcn_mbcnt_hi(~0u, __builtin_amdgcn_mbcnt_lo(~0u, 0u));
    asm volatile("" : "+v"(t)); return t;
}
#define XB_TMO      128
#define XB_XCNT(j)  (256  + 64 * (j))
#define XB_XSUB(j)  (1280 + 64 * (j))
#define XB_XGEN(j)  (2304 + 64 * (j))
#define XB_TOP      3328
#define XB_TOPGEN   3392
#define XCD_BAR_WORDS 3456
#define XB_SPIN_CAP (1u << 22)
DI unsigned xb_ld(unsigned* p)              { return __hip_atomic_load(p, __ATOMIC_RELAXED, __HIP_MEMORY_SCOPE_AGENT); }
DI unsigned xb_add(unsigned* p, unsigned v) { return __hip_atomic_fetch_add(p, v, __ATOMIC_RELAXED, __HIP_MEMORY_SCOPE_AGENT); }
DI unsigned xb_xcc_id() { return (unsigned)__builtin_amdgcn_s_getreg((3 << 11) | 20) & 0xFu; }
#define XB_SPIN(cond, bar) do { unsigned _sp = 0; while (cond) { __builtin_amdgcn_s_sleep(1); \
    if ((++_sp & 255u) == 0u) { if (xb_ld(&(bar)[XB_TMO])) break; if (_sp > XB_SPIN_CAP) { atomicAdd(&(bar)[XB_TMO], 1u); break; } } } } while (0)
struct XcdBarrier { unsigned* bar; unsigned x; volatile LAS unsigned* st; };
DI XcdBarrier xcd_barrier_post(unsigned* bar, volatile LAS unsigned* st) {
    XcdBarrier b; b.bar = bar; b.x = xb_xcc_id(); b.st = st;
    if (my_tid() == 0) (void)xb_add(&bar[XB_XCNT(b.x)], 1u);
    return b;
}
DI void xcd_barrier_complete(unsigned* bar, unsigned x, unsigned& nloc, unsigned& nx) {
    const unsigned G = gridDim.x * gridDim.y * gridDim.z;
    unsigned sum, cnt, mine, sp = 0u;
    for (;;) {
        sum = 0u; cnt = 0u; mine = 0u;
#pragma unroll
        for (unsigned j = 0; j < 16; ++j) { const unsigned c = xb_ld(&bar[XB_XCNT(j)]); sum += c; cnt += (c > 0u) ? 1u : 0u; mine = (j == x) ? c : mine; }
        if (sum == G) break;
        __builtin_amdgcn_s_sleep(1);
        if ((++sp & 255u) == 0u) { if (xb_ld(&bar[XB_TMO])) break; if (sp > XB_SPIN_CAP) { atomicAdd(&bar[XB_TMO], 1u); break; } }
    }
    nloc = mine > 0u ? mine : 1u; nx = cnt > 0u ? cnt : 1u;
}
DI void xcd_barrier(const XcdBarrier& b) {
    asm volatile("s_waitcnt vmcnt(0)" ::: "memory");
    __syncthreads();
    if (my_tid() == 0) {
        unsigned* bar = b.bar;
        __builtin_amdgcn_s_waitcnt(0);
        unsigned nloc = b.st[0], nx = b.st[1];
        if (nloc == 0u) { xcd_barrier_complete(bar, b.x, nloc, nx); b.st[0] = nloc; b.st[1] = nx; }
        const unsigned old = xb_add(&bar[XB_XSUB(b.x)], 1u);
        const unsigned gen = old / nloc;
        if (old + 1u == (gen + 1u) * nloc) {
            __builtin_amdgcn_fence(__ATOMIC_RELEASE, "agent");
            asm volatile("s_waitcnt vmcnt(0)" ::: "memory");
            const unsigned og = xb_add(&bar[XB_TOP], 1u);
            const unsigned tg = og / nx;
            if (og + 1u == (tg + 1u) * nx) xb_add(&bar[XB_TOPGEN], 1u);
            else XB_SPIN(xb_ld(&bar[XB_TOPGEN]) == tg, bar);
            __builtin_amdgcn_fence(__ATOMIC_ACQUIRE, "agent");
            xb_add(&bar[XB_XGEN(b.x)], 1u);
            asm volatile("s_waitcnt vmcnt(0)" ::: "memory");
        } else {
            XB_SPIN(xb_ld(&bar[XB_XGEN(b.x)]) == gen, bar);
            __builtin_amdgcn_fence(__ATOMIC_ACQUIRE, "agent");
            asm volatile("s_waitcnt vmcnt(0)" ::: "memory");
        }
    }
    __syncthreads();
}

namespace pg8 {
constexpr int BM = 256, BK = 64, HALF = 128, HTB = HALF * BK * 2, STAGE_BYTES = 8 * HTB, NXCD = 8, WGM = 8;
__host__ __device__ __forceinline__ int lds_byte(int r, int c) { const int st = (r >> 4) * 2 + (c >> 5), rr = r & 15, cc = c & 31, ob = rr * 64 + cc * 2; return st * 1024 + (ob ^ (((ob >> 9) & 1) << 5)); }
__host__ __device__ __forceinline__ void stage_rc(int b, int& R, int& C) { const int st = b / 1024, sb = b % 1024, swz = sb ^ (((sb >> 9) & 1) << 5); R = (st >> 1) * 16 + swz / 64; C = (st & 1) * 32 + (swz % 64) / 2; }
__host__ __device__ __forceinline__ int perm32(int rho) { const int n = rho >> 4, i = rho & 15; return 8 * (i >> 2) + 4 * n + (i & 3); }

struct Unit { int pm, pn; const char* a; const char* b; };
struct Gemm { const bf16_t* A; const bf16_t* Bt; int M, N, K, lda; };

struct StaticOrder {
    int nM, nN, nwg, G, c;
    DI void init(const Gemm& g, int G_, int c_) { nM = g.M / BM; nN = g.N / BM; nwg = nM * nN; G = G_; c = c_; }
    DI bool tile(int i, int& pm, int& pn) const {
        const int L = i * G + c; if (L >= nwg) return false;
        int wgid = L; { const int q = nwg / NXCD, r = nwg % NXCD, xcd = wgid % NXCD, off = wgid / NXCD; wgid = (xcd < r ? xcd * (q + 1) : r * (q + 1) + (xcd - r) * q) + off; }
        const int nig = WGM * nN, gid = wgid / nig, fm = gid * WGM, gsz = (nM - fm) < WGM ? (nM - fm) : WGM;
        pm = fm + ((wgid % nig) % gsz); pn = (wgid % nig) / gsz; return true;
    }
    DI bool next(const Gemm& g, int i, Unit& u) const { if (!tile(i, u.pm, u.pn)) return false;
        u.a = (const char*)g.A + (size_t)u.pm * ((size_t)BM * g.lda * 2); u.b = (const char*)g.Bt + (size_t)u.pn * ((size_t)BM * g.K * 2); return true; }
};
struct MoeOrder {
    StaticOrder so; int p0, apan0; const int* pbv; size_t estride;
    DI bool next(const Gemm& g, int i, Unit& u) const {
        int pm, pn; if (!so.tile(i, pm, pn)) return false;
        u.pm = p0 + pm; u.pn = pn; int e = 0;
#pragma unroll
        for (int k = 1; k < 8; ++k) e += (u.pm >= __builtin_amdgcn_readfirstlane(pbv[k])) ? 1 : 0;
        u.a = (const char*)g.A + (size_t)(u.pm - apan0) * ((size_t)BM * g.lda * 2); u.b = (const char*)g.Bt + (size_t)e * estride + (size_t)pn * ((size_t)BM * g.K * 2); return true;
    }
};

template <class Epi, class Sched, bool ALIGN_EPI = true, bool F8 = false>
DI void gemm_phase(LAS unsigned char* lds, const Gemm g, const Sched& S, const Epi& E) {
    const int tid_ = my_tid();
    const int tid = tid_, wid = __builtin_amdgcn_readfirstlane(tid >> 6), lane = tid & 63, wr = wid >> 2, wc = wid & 3, fr = lane & 15, fq = lane >> 4;
    const int K = g.K, nt = K / BK;
    unsigned voffA[2], voffB[2];
#pragma unroll
    for (int i = 0; i < 2; ++i) { int R, C; stage_rc(tid * 16 + i * 8192, R, C); const int Rb = Epi::PERM ? ((R & ~31) + perm32(R & 31)) : R;
        voffA[i] = (unsigned)(R * g.lda + C) * 2u; voffB[i] = (unsigned)(Rb * K + C) * 2u; }
    const size_t kstep = (size_t)(BK * 2);
    const size_t hstepA = (size_t)HALF * g.lda * 2, hstepB = (size_t)HALF * K * 2;
    const unsigned ldsw = (unsigned)wid * 1024u;
    const int aoff = lds_byte(wr * 64 + fr, fq * 8), boff = lds_byte(wc * 32 + fr, fq * 8);
#define PG8_SA(b, h) (((b) * 2 + (h)) * HTB)
#define PG8_SB(b, h) ((4 + (b) * 2 + (h)) * HTB)
#define PG8_STAGE(bufoff, gbase, voff) do { _Pragma("unroll") for (int _i = 0; _i < 2; ++_i) \
        __builtin_amdgcn_global_load_lds((const unsigned*)((const char*)(gbase) + (voff)[_i]), (LAS unsigned*)(lds + (bufoff) + ldsw + _i * 8192), 16, 0, 0); } while (0)
#define PG8_LD8(p) __builtin_shufflevector(*(const LAS v4i32*)(p), *(const LAS v4i32*)((p) + 1024), 0, 1, 2, 3, 4, 5, 6, 7)
#define PG8_LDA(dst, b, h) do { if constexpr (F8) { _Pragma("unroll") for (int m = 0; m < 4; ++m) dst##8[m] = PG8_LD8(lds + PG8_SA(b, h) + aoff + m * 2048); } \
        else { _Pragma("unroll") for (int m = 0; m < 4; ++m) _Pragma("unroll") for (int k = 0; k < 2; ++k) dst[m][k] = *(const LAS bf16x8*)(lds + PG8_SA(b, h) + aoff + m * 2048 + k * 1024); } } while (0)
#define PG8_LDB(dst, b, h) do { if constexpr (F8) { _Pragma("unroll") for (int n = 0; n < 2; ++n) dst##8[n] = PG8_LD8(lds + PG8_SB(b, h) + boff + n * 2048); } \
        else { _Pragma("unroll") for (int n = 0; n < 2; ++n) _Pragma("unroll") for (int k = 0; k < 2; ++k) dst[n][k] = *(const LAS bf16x8*)(lds + PG8_SB(b, h) + boff + n * 2048 + k * 1024); } } while (0)
#define PG8_MMA(ai, bj, At, Bt) do { __builtin_amdgcn_s_setprio(1); \
        if constexpr (F8) { _Pragma("unroll") for (int m = 0; m < 4; ++m) _Pragma("unroll") for (int n = 0; n < 2; ++n) \
            asm volatile("v_mfma_scale_f32_16x16x128_f8f6f4 %0, %1, %2, %0, %3, %3 op_sel_hi:[0,0,0]" : "+v"(acc[ai][bj][m][n]) : "v"(Bt##8[n]), "v"(At##8[m]), "v"(one8)); } \
        else { _Pragma("unroll") for (int m = 0; m < 4; ++m) _Pragma("unroll") for (int n = 0; n < 2; ++n) _Pragma("unroll") for (int k = 0; k < 2; ++k) \
            acc[ai][bj][m][n] = __builtin_amdgcn_mfma_f32_16x16x32_bf16(Bt[n][k], At[m][k], acc[ai][bj][m][n], 0, 0, 0); } \
        __builtin_amdgcn_s_setprio(0); } while (0)
#define PG8_WAIT_V(n) asm volatile("s_waitcnt vmcnt(" #n ")" ::: "memory")
#define PG8_WAIT_L(n) asm volatile("s_waitcnt lgkmcnt(" #n ")" ::: "memory")
#define PG8_BAR __builtin_amdgcn_s_barrier()
#define PG8_SCHED __builtin_amdgcn_sched_barrier(0)
    Unit cur, nxt; int ui = 0;
    if (!S.next(g, 0, cur)) return;
    f32x4 acc[2][2][4][2];
#pragma unroll
    for (int a = 0; a < 2; ++a)
#pragma unroll
        for (int b = 0; b < 2; ++b)
#pragma unroll
            for (int m = 0; m < 4; ++m)
#pragma unroll
                for (int n = 0; n < 2; ++n) acc[a][b][m][n] = (f32x4){0.f, 0.f, 0.f, 0.f};
    bf16x8 At[4][2], B0[2][2], B1[2][2]; v8i32 At8[4], B08[2], B18[2]; const int one8 = 0x7F7F7F7F;
    const char* cA = cur.a; const char* cB = cur.b;
    PG8_STAGE(PG8_SB(0, 0), cB, voffB); PG8_STAGE(PG8_SB(0, 1), cB + hstepB, voffB); PG8_STAGE(PG8_SA(0, 0), cA, voffA); PG8_STAGE(PG8_SA(0, 1), cA + hstepA, voffA);
    if (wr == 1) PG8_BAR;
    PG8_WAIT_V(2); PG8_BAR;
    PG8_STAGE(PG8_SB(1, 0), cB + kstep, voffB); PG8_STAGE(PG8_SA(1, 0), cA + kstep, voffA); PG8_STAGE(PG8_SB(1, 1), cB + hstepB + kstep, voffB);
    PG8_WAIT_V(6); PG8_BAR;
    for (;;) {
        const bool has_next = S.next(g, ui + 1, nxt);
        const char* nA = has_next ? nxt.a : cA; const char* nB = has_next ? nxt.b : cB;
        for (int t = 0; t < nt; t += 2) {
            const bool last = (t == nt - 2);
            const char* a1 = cA + (size_t)(t + 1) * kstep;
            const char* a2 = last ? nA : cA + (size_t)(t + 2) * kstep; const char* b2 = last ? nB : cB + (size_t)(t + 2) * kstep;
            const char* a3 = a2 + kstep; const char* b3 = b2 + kstep;
            PG8_LDB(B0, 0, 0); PG8_LDB(B1, 0, 1); PG8_SCHED; PG8_LDA(At, 0, 0); PG8_STAGE(PG8_SA(1, 1), a1 + hstepA, voffA);
            PG8_WAIT_V(8); PG8_WAIT_L(0); PG8_BAR; PG8_MMA(0, 0, At, B0); PG8_MMA(0, 1, At, B1); PG8_BAR; PG8_SCHED;
            PG8_LDA(At, 0, 1); PG8_STAGE(PG8_SB(0, 0), b2, voffB); PG8_STAGE(PG8_SB(0, 1), b2 + hstepB, voffB); PG8_STAGE(PG8_SA(0, 0), a2, voffA);
            PG8_WAIT_V(8); PG8_WAIT_L(0); PG8_BAR; PG8_MMA(1, 0, At, B0); PG8_MMA(1, 1, At, B1); PG8_BAR; PG8_SCHED;
            PG8_LDB(B0, 1, 0); PG8_LDB(B1, 1, 1); PG8_SCHED; PG8_LDA(At, 1, 0); PG8_STAGE(PG8_SA(0, 1), a2 + hstepA, voffA);
            PG8_WAIT_V(8); PG8_WAIT_L(0); PG8_BAR; PG8_MMA(0, 0, At, B0); PG8_MMA(0, 1, At, B1); PG8_BAR; PG8_SCHED;
            PG8_LDA(At, 1, 1); PG8_STAGE(PG8_SB(1, 0), b3, voffB); PG8_STAGE(PG8_SB(1, 1), b3 + hstepB, voffB); PG8_STAGE(PG8_SA(1, 0), a3, voffA);
            PG8_WAIT_V(8); PG8_WAIT_L(0); PG8_BAR; PG8_MMA(1, 0, At, B0); PG8_MMA(1, 1, At, B1); PG8_BAR; PG8_SCHED;
        }
        if constexpr (ALIGN_EPI) { if (wr == 0) PG8_BAR; }
        if constexpr (F8) asm volatile("s_nop 15\n\ts_nop 15" ::: "memory");
        E(acc, cur, wr, wc, fr, fq);
        if (!has_next) break;
#pragma unroll
        for (int a = 0; a < 2; ++a)
#pragma unroll
            for (int b = 0; b < 2; ++b)
#pragma unroll
                for (int m = 0; m < 4; ++m)
#pragma unroll
                    for (int n = 0; n < 2; ++n) acc[a][b][m][n] = (f32x4){0.f, 0.f, 0.f, 0.f};
        cur = nxt; cA = nA; cB = nB; ++ui;
        if constexpr (ALIGN_EPI) { if (wr == 1) PG8_BAR; }
    }
    PG8_WAIT_V(0);
    if constexpr (!ALIGN_EPI) { if (wr == 0) PG8_BAR; }
    PG8_BAR;
#undef PG8_SA
#undef PG8_SB
#undef PG8_STAGE
#undef PG8_LDA
#undef PG8_LD8
#undef PG8_LDB
#undef PG8_MMA
#undef PG8_WAIT_V
#undef PG8_WAIT_L
#undef PG8_BAR
#undef PG8_SCHED
}
}
using pg8::Unit; using pg8::Gemm;
typedef const f32x4 (&AccRef)[2][2][4][2];

DI u32x4 pack8(const f32x4& v0, const f32x4& v1) { u32x4 w; w.x = cvt_pk_bf16(v0[0], v0[1]); w.y = cvt_pk_bf16(v0[2], v0[3]); w.z = cvt_pk_bf16(v1[0], v1[1]); w.w = cvt_pk_bf16(v1[2], v1[3]); return w; }
DI void unpack8(const u32x4& w, float (&f)[8]) { f[0] = bflo(w.x); f[1] = bfhi(w.x); f[2] = bflo(w.y); f[3] = bfhi(w.y); f[4] = bflo(w.z); f[5] = bfhi(w.z); f[6] = bflo(w.w); f[7] = bfhi(w.w); }

struct EpiInProj {
    static constexpr bool PERM = true;
    bf16_t* P; const float2* rope; const float* lbf; const float* lbb; int secmap; float asc;
    DI void operator()(AccRef acc, const Unit& u, int wr, int wc, int fr, int fq) const {
        const int row0 = u.pm * 256 + wr * 64 + fr, sec = (secmap >> (4 * (u.pn >> 1))) & 15;
        const int col0 = sec * 512 + (u.pn & 1) * 256 + wc * 32 + 8 * fq;
        const bool lat = u.pm < (NLAT / 256);
#pragma unroll
        for (int ai = 0; ai < 2; ++ai)
#pragma unroll
            for (int m = 0; m < 4; ++m) {
                const int row = row0 + ai * 128 + m * 16; bf16_t* rowp = P + (size_t)row * PW + col0;
#pragma unroll
                for (int bj = 0; bj < 2; ++bj) {
                    f32x4 v0 = acc[ai][bj][m][0] * asc, v1 = acc[ai][bj][m][1] * asc; u32x4 w;
                    if (sec == 0 || sec == 4) {
                        if (lat) {
                            const int pi = ((col0 + bj * 128) & 63) >> 1;
                            const f32x4* rp = (const f32x4*)(rope + (size_t)(row & (T - 1)) * 32 + pi);
                            const f32x4 r0 = rp[0], r1 = rp[1];
                            f32x4 o0, o1;
                            o0[0] = v0[0] * r0[0] - v0[1] * r0[1]; o0[1] = v0[0] * r0[1] + v0[1] * r0[0];
                            o0[2] = v0[2] * r0[2] - v0[3] * r0[3]; o0[3] = v0[2] * r0[3] + v0[3] * r0[2];
                            o1[0] = v1[0] * r1[0] - v1[1] * r1[1]; o1[1] = v1[0] * r1[1] + v1[1] * r1[0];
                            o1[2] = v1[2] * r1[2] - v1[3] * r1[3]; o1[3] = v1[2] * r1[3] + v1[3] * r1[2];
                            v0 = o0; v1 = o1;
                        }
                        if (sec == 0) { v0 = v0 * QSCALE; v1 = v1 * QSCALE; }
                        w = pack8(v0, v1);
                    } else if (sec == 1 || sec == 6) {
#pragma unroll
                        for (int j = 0; j < 4; ++j) { v0[j] = fsilu(v0[j]); v1[j] = fsilu(v1[j]); }
                        w = pack8(v0, v1);
                    } else if (sec == 2 || sec == 3) {
                        const float* lb = (sec == 2 ? lbf : lbb) + ((col0 + bj * 128) & 511);
                        const f32x4 b0 = *(const f32x4*)lb, b1 = *(const f32x4*)(lb + 4);
                        half8 hv;
#pragma unroll
                        for (int j = 0; j < 8; ++j) {
                            const float z = j < 4 ? v0[j] : v1[j - 4], b = j < 4 ? b0[j] : b1[j - 4];
                            const float ls = fminf(z, 0.f) - __logf(1.f + __expf(-fabsf(z)));
                            const float lf = b > 0.f ? __logf(b + (1.f - b) * __expf(ls)) : ls;
                            hv[j] = (_Float16)lf;
                        }
                        w = __builtin_bit_cast(u32x4, hv);
                    } else w = pack8(v0, v1);
                    *(u32x4*)(rowp + bj * 128) = w;
                }
            }
    }
};
struct EpiGates {
    static constexpr bool PERM = true; bf16_t* P; float asc;
    DI void operator()(AccRef acc, const Unit& u, int wr, int wc, int fr, int fq) const {
        const int row0 = u.pm * 256 + wr * 64 + fr, col0 = PC_GA + u.pn * 256 + wc * 32 + 8 * fq;
#pragma unroll
        for (int ai = 0; ai < 2; ++ai)
#pragma unroll
            for (int m = 0; m < 4; ++m) { bf16_t* rowp = P + (size_t)(row0 + ai * 128 + m * 16) * PW + col0;
#pragma unroll
                for (int bj = 0; bj < 2; ++bj) { f32x4 v0 = acc[ai][bj][m][0] * asc, v1 = acc[ai][bj][m][1] * asc;
#pragma unroll
                    for (int j = 0; j < 4; ++j) { v0[j] = fsigmoid(v0[j]); v1[j] = fsigmoid(v1[j]); }
                    *(u32x4*)(rowp + bj * 128) = pack8(v0, v1); } }
    }
};
template <bool FIRST> struct EpiMerge {
    static constexpr bool PERM = true; const bf16_t* P; int gcol; bf16_t* O;
    DI void operator()(AccRef acc, const Unit& u, int wr, int wc, int fr, int fq) const {
        const int row0 = u.pm * 256 + wr * 64 + fr, col0 = u.pn * 256 + wc * 32 + 8 * fq;
#pragma unroll
        for (int ai = 0; ai < 2; ++ai)
#pragma unroll
            for (int m = 0; m < 4; ++m) { const size_t row = (size_t)(row0 + ai * 128 + m * 16);
#pragma unroll
                for (int bj = 0; bj < 2; ++bj) {
                    const u32x4 gw = *(const u32x4*)(P + row * PW + gcol + col0 + bj * 128); float g[8]; unpack8(gw, g);
                    f32x4 v0 = acc[ai][bj][m][0], v1 = acc[ai][bj][m][1];
                    bf16_t* op = O + row * D + col0 + bj * 128;
                    float pv[8];
                    if (!FIRST) { const u32x4 ow = *(const u32x4*)op; unpack8(ow, pv); }
#pragma unroll
                    for (int j = 0; j < 4; ++j) { v0[j] = v0[j] * g[j] + (FIRST ? 0.f : pv[j]); v1[j] = v1[j] * g[4 + j] + (FIRST ? 0.f : pv[4 + j]); }
                    *(u32x4*)op = pack8(v0, v1); } }
    }
};
struct EpiResid {
    static constexpr bool PERM = false;
    const float* xin_l; const float* xin_c; float* xout_l; float* xout_c; const float* mods; int msel;
    DI void operator()(AccRef acc, const Unit& u, int wr, int wc, int fr, int fq) const {
        const bool lat = u.pm < (NLAT / 256);
        const int rbase = (lat ? u.pm : u.pm - NLAT / 256) * 256 + wr * 64 + fr, col0 = u.pn * 256 + wc * 32 + 4 * fq;
        const float* xi = lat ? xin_l : xin_c; float* xo = lat ? xout_l : xout_c;
        const float* mv = mods + (size_t)(lat ? (u.pm >> 3) : 32) * DIN + msel * D + col0;
        f32x4 g[2][2];
#pragma unroll
        for (int bj = 0; bj < 2; ++bj)
#pragma unroll
            for (int n = 0; n < 2; ++n) g[bj][n] = *(const f32x4*)(mv + bj * 128 + n * 16);
#pragma unroll
        for (int ai = 0; ai < 2; ++ai)
#pragma unroll
            for (int m = 0; m < 4; ++m) { const size_t off = (size_t)(rbase + ai * 128 + m * 16) * D + col0;
#pragma unroll
                for (int bj = 0; bj < 2; ++bj)
#pragma unroll
                    for (int n = 0; n < 2; ++n) { const f32x4 xv = *(const f32x4*)(xi + off + bj * 128 + n * 16);
                        *(f32x4*)(xo + off + bj * 128 + n * 16) = xv + g[bj][n] * acc[ai][bj][m][n]; } }
    }
};
struct EpiSwiglu {
    static constexpr bool PERM = true; bf16_t* Hd; int ldh; int pan0;
    DI void operator()(AccRef acc, const Unit& u, int wr, int wc, int fr, int fq) const {
        const int row0 = (u.pm - pan0) * 256 + wr * 64 + fr, hc0 = u.pn * 128 + wc * 16 + 4 * fq;
#pragma unroll
        for (int ai = 0; ai < 2; ++ai)
#pragma unroll
            for (int m = 0; m < 4; ++m) { bf16_t* rowp = Hd + (size_t)(row0 + ai * 128 + m * 16) * ldh + hc0;
#pragma unroll
                for (int bj = 0; bj < 2; ++bj) { const f32x4 a = acc[ai][bj][m][0], b = acc[ai][bj][m][1];
                    u32x2 w; w.x = cvt_pk_bf16(fsilu(a[0]) * b[0], fsilu(a[1]) * b[1]); w.y = cvt_pk_bf16(fsilu(a[2]) * b[2], fsilu(a[3]) * b[3]);
                    *(u32x2*)(rowp + bj * 64) = w; } }
    }
};
struct EpiSwiglu8 {
    static constexpr bool PERM = true; unsigned char* Hd; int ldh; int pan0; float as, hs;
    DI void operator()(AccRef acc, const Unit& u, int wr, int wc, int fr, int fq) const {
        const int row0 = (u.pm - pan0) * 256 + wr * 64 + fr, hc0 = u.pn * 128 + wc * 16 + 4 * fq;
#pragma unroll
        for (int ai = 0; ai < 2; ++ai)
#pragma unroll
            for (int m = 0; m < 4; ++m) { unsigned char* rowp = Hd + (size_t)(row0 + ai * 128 + m * 16) * ldh + hc0;
#pragma unroll
                for (int bj = 0; bj < 2; ++bj) { const f32x4 a = acc[ai][bj][m][0] * as, b = acc[ai][bj][m][1] * (as * hs);
                    *(unsigned*)(rowp + bj * 64) = pack_fp8x4(fsilu(a[0]) * b[0], fsilu(a[1]) * b[1], fsilu(a[2]) * b[2], fsilu(a[3]) * b[3]); } }
    }
};
struct EpiBf16 {
    static constexpr bool PERM = true; bf16_t* O; int ldc; float sc;
    DI void operator()(AccRef acc, const Unit& u, int wr, int wc, int fr, int fq) const {
        const int row0 = u.pm * 256 + wr * 64 + fr, col0 = u.pn * 256 + wc * 32 + 8 * fq;
#pragma unroll
        for (int ai = 0; ai < 2; ++ai)
#pragma unroll
            for (int m = 0; m < 4; ++m) { bf16_t* rowp = O + (size_t)(row0 + ai * 128 + m * 16) * ldc + col0;
#pragma unroll
                for (int bj = 0; bj < 2; ++bj) *(u32x4*)(rowp + bj * 128) = pack8(acc[ai][bj][m][0] * sc, acc[ai][bj][m][1] * sc); }
    }
};

typedef short v4i16 __attribute__((ext_vector_type(4)));
DI s16x4 tr16(const LAS unsigned char* p) { return __builtin_bit_cast(s16x4, __builtin_amdgcn_ds_read_tr16_b64_v4i16((LAS v4i16*)p)); }
DI bf16x8 cat8(s16x4 lo, s16x4 hi) { return __builtin_shufflevector(lo, hi, 0, 1, 2, 3, 4, 5, 6, 7); }
DI void dma16(const void* g, LAS unsigned char* l) { __builtin_amdgcn_global_load_lds((const unsigned*)g, (LAS unsigned*)l, 16, 0, 0); }
DI bf16x8 packf8(const f32x16& x, int s) {
    u32x4 w; w.x = cvt_pk_bf16(x[8 * s], x[8 * s + 1]); w.y = cvt_pk_bf16(x[8 * s + 2], x[8 * s + 3]); w.z = cvt_pk_bf16(x[8 * s + 4], x[8 * s + 5]); w.w = cvt_pk_bf16(x[8 * s + 6], x[8 * s + 7]);
    return __builtin_bit_cast(bf16x8, w);
}
#define MFMA32(a, b, c) __builtin_amdgcn_mfma_f32_32x32x16_bf16((a), (b), (c), 0, 0, 0)

struct Params { const float* in[28]; float* out; unsigned char* ws; int ph_lo, ph_hi, li, pad; };
typedef const __attribute__((address_space(4))) Params* KP;
DI KP kparams() { KP kp = (KP)__builtin_amdgcn_kernarg_segment_ptr(); asm volatile("" : "+s"(kp)); return kp; }
#define PIN(k) (kparams()->in[k])
#define POUT (kparams()->out)
struct Ctx {
    LAS unsigned char* lds; unsigned char* ws; int tid, lane, wave, vcu, G, gw, NGW, bx;
};

constexpr float WIN8_SCALE = 64.f;
#ifndef FP8_SECS
#define FP8_SECS 0x00
#endif
constexpr int SEC_ORDER[8] = {0, 2, 3, 4, 1, 5, 6, 7};
constexpr int sec_slot(int ps) { int nb = 0, nf = 0; for (int i = 0; i < 8; ++i) { const int s_ = SEC_ORDER[i]; const bool f = (FP8_SECS >> s_) & 1; if (s_ == ps) return f ? (0x100 | nf) : nb; if (f) ++nf; else ++nb; } return 0; }
constexpr int N_SEC_F8 = __builtin_popcount(FP8_SECS), N_SEC_BF = 8 - N_SEC_F8;
constexpr unsigned secmap_of(bool f8) { unsigned m = 0; int k = 0; for (int i = 0; i < 8; ++i) { const int s_ = SEC_ORDER[i]; if ((((FP8_SECS >> s_) & 1) != 0) == f8) { m |= (unsigned)s_ << (4 * k); ++k; } } return m; }
DI int map_row(int kind, int n);
DI int map_row4(int n) { return map_row(1, n) & 0xffff; }
DI int map_row(int kind, int n) {
    if (kind == 0) return n;
    if (kind == 4) return map_row4(n);
    if (kind == 2) return 8 * (n >> 2) + (n & 3);
    if (kind == 3) return 8 * (n >> 2) + (n & 3) + 4;
    const int sec = n >> 9, j = n & 511;
    if (n >= 4096) return (1 << 16) | (N_SEC_F8 * 512 + (n - 4096));
    const int ps = sec == 0 ? 0 : sec == 1 ? 4 : sec == 2 ? 5 : sec == 3 ? 6 : sec == 4 ? 7 : sec == 5 ? 2 : sec == 6 ? 3 : 1;
    const int sl = sec_slot(ps); int jj = j;
    if (sec == 0 || sec == 1) { const int hs = j >> 6, d = j & 63; jj = hs * 64 + (d < 32 ? 2 * d : 2 * (d - 32) + 1); }
    return ((sl & 0x100) ? (1 << 16) : 0) | ((sl & 0xff) * 512 + jj);
}
DI void transpose_item(const float* W, int ldw, int k0, int n0, bf16_t* WT, int ldt, int kind, LAS float* scr, int lane) {
#pragma unroll 8
    for (int i = 0; i < 32; ++i) { const int kk = 2 * i + (lane >> 5); scr[kk * 33 + (lane & 31)] = W[(size_t)(k0 + kk) * ldw + n0 + (lane & 31)]; }
    LDS_WAIT(); asm volatile("" ::: "memory");
    const int c = lane & 7;
#pragma unroll
    for (int j = 0; j < 4; ++j) { const int n = (lane >> 3) + 8 * j; const LAS float* s = scr + (8 * c) * 33 + n;
        u32x4 o; o.x = cvt_pk_bf16(s[0 * 33], s[1 * 33]); o.y = cvt_pk_bf16(s[2 * 33], s[3 * 33]); o.z = cvt_pk_bf16(s[4 * 33], s[5 * 33]); o.w = cvt_pk_bf16(s[6 * 33], s[7 * 33]);
        *(u32x4*)(WT + (size_t)map_row(kind, n0 + n) * ldt + k0 + 8 * c) = o; }
    LDS_WAIT(); asm volatile("" ::: "memory");
}
DI void transpose_item8(const float* W, int ldw, int k0, int n0, unsigned char* WT, int ldt, int kind, float sc, LAS float* scr, int lane) {
#pragma unroll 8
    for (int i = 0; i < 32; ++i) { const int kk = 2 * i + (lane >> 5); scr[kk * 33 + (lane & 31)] = W[(size_t)(k0 + kk) * ldw + n0 + (lane & 31)]; }
    LDS_WAIT(); asm volatile("" ::: "memory");
    const int c = lane & 7;
#pragma unroll
    for (int j = 0; j < 4; ++j) { const int n = (lane >> 3) + 8 * j; const LAS float* s = scr + (8 * c) * 33 + n;
        u32x2 o; o.x = pack_fp8x4(s[0 * 33] * sc, s[1 * 33] * sc, s[2 * 33] * sc, s[3 * 33] * sc); o.y = pack_fp8x4(s[4 * 33] * sc, s[5 * 33] * sc, s[6 * 33] * sc, s[7 * 33] * sc);
        *(u32x2*)(WT + (size_t)map_row(kind, n0 + n) * ldt + k0 + 8 * c) = o; }
    LDS_WAIT(); asm volatile("" ::: "memory");
}
DI void transpose_matrix8(const Ctx& C, const float* W, int K, int N, unsigned char* WT, int ldt, int kind, float sc, int& itbase) {
    LAS float* scr = (LAS float*)(C.lds + C.wave * 16384);
    const int nblk = N / 32, nit = (K / 64) * nblk;
    int first = (C.gw - (itbase % C.NGW) + C.NGW) % C.NGW;
    for (int it = first; it < nit; it += C.NGW) transpose_item8(W, N, 64 * (it / nblk), 32 * (it % nblk), WT, ldt, kind, sc, scr, C.lane);
    itbase += nit;
}
DI void transpose_matrix(const Ctx& C, const float* W, int K, int N, bf16_t* WT, int ldt, int kind, int& itbase, int total_unused) {
    (void)total_unused;
    LAS float* scr = (LAS float*)(C.lds + C.wave * 16384);
    const int nblk = N / 32, nit = (K / 64) * nblk;
    int first = (C.gw - (itbase % C.NGW) + C.NGW) % C.NGW;
    for (int it = first; it < nit; it += C.NGW) transpose_item(W, N, 64 * (it / nblk), 32 * (it % nblk), WT, ldt, kind, scr, C.lane);
    itbase += nit;
}

DI void transpose_win(const Ctx& C, const float* W, bf16_t* WA, unsigned char* W8, int& itbase) {
    LAS float* scr = (LAS float*)(C.lds + C.wave * 16384);
    const int nblk = DIN / 32, nit = (D / 64) * nblk;
    int first = (C.gw - (itbase % C.NGW) + C.NGW) % C.NGW;
    for (int it = first; it < nit; it += C.NGW) { const int k0 = 64 * (it / nblk), n0 = 32 * (it % nblk);
        if (map_row(1, n0) >> 16) transpose_item8(W, DIN, k0, n0, W8, D, 4, WIN8_SCALE, scr, C.lane);
        else transpose_item(W, DIN, k0, n0, WA, D, 1, scr, C.lane); }
    itbase += nit;
}
DI void phase_prologue(const Ctx& C) {
    unsigned char* ws = C.ws;
    int itb = 0;
    for (int l = 0; l < 2; ++l) {
        transpose_win(C, PIN(8) + (size_t)l * D * DIN, (bf16_t*)(ws + WS_WIN) + (size_t)l * 4096 * D, ws + WS_WIN8 + (size_t)l * 4096 * D, itb);
        transpose_matrix(C, PIN(17) + (size_t)l * 512 * D, 512, D, (bf16_t*)(ws + WS_WUA) + (size_t)l * D * 512, 512, 0, itb, 0);
        transpose_matrix(C, PIN(18) + (size_t)l * 512 * D, 512, D, (bf16_t*)(ws + WS_WUR) + (size_t)l * D * 512, 512, 0, itb, 0);
        transpose_matrix(C, PIN(19) + (size_t)l * D * D, D, D, (bf16_t*)(ws + WS_WO) + (size_t)l * D * D, D, 0, itb, 0);
    }
    transpose_matrix(C, PIN(20), D, DFF, (bf16_t*)(ws + WS_W13), D, 2, itb, 0);
    transpose_matrix(C, PIN(21), D, DFF, (bf16_t*)(ws + WS_W13), D, 3, itb, 0);
    transpose_matrix(C, PIN(22), DFF, D, (bf16_t*)(ws + WS_W2), DFFP, 0, itb, 0);
    { const int gt = C.vcu * 512 + C.tid, NT = C.G * 512;
      bf16_t* w13 = (bf16_t*)(ws + WS_W13) + (size_t)(2 * DFF) * D;
      for (int i = gt; i < (2 * DFFP - 2 * DFF) * D / 8; i += NT) ((u32x4*)w13)[i] = (u32x4){0u, 0u, 0u, 0u};
      bf16_t* w2 = (bf16_t*)(ws + WS_W2);
      for (int i = gt; i < D * (DFFP - DFF) / 8; i += NT) { const int r = i / ((DFFP - DFF) / 8), cc = i % ((DFFP - DFF) / 8); *(u32x4*)(w2 + (size_t)r * DFFP + DFF + cc * 8) = (u32x4){0u, 0u, 0u, 0u}; }
      float2* rope = (float2*)(ws + WS_ROPE);
      for (int i = gt; i < T * 32; i += NT) { const int t = i >> 5, pi = i & 31; const float invf = exp2f(-(float)(pi & 15) * (13.287712379549449f / 16.f));
          const float ang = (float)(pi < 16 ? (t >> 6) : (t & 63)) * invf; rope[i] = make_float2(cosf(ang), sinf(ang)); }
      float* lbs = (float*)(ws + WS_LBS);
      for (int i = gt; i < 2 * 2 * 512; i += NT) { const int l = i >> 10, dir = (i >> 9) & 1, d = i & 511; const float* lb = PIN(dir ? 16 : 15);
          const float p0 = lb[d], p1 = lb[512 + d]; lbs[i] = l == 0 ? 0.f : 1.f / (1.f + expf(p0 - p1)); }
    }
    { float* mods = (float*)(ws + WS_MODS);
      for (int task = C.gw; task < 2 * 33 * 96; task += C.NGW) {
          const int ng = task % 96, r = (task / 96) % 33, l = task / (96 * 33), n = ng * 64 + C.lane;
          const float* cv = r < 32 ? PIN(1) + r * D : PIN(3); const float* W = PIN(4) + (size_t)l * D * DIN + n;
          float acc = PIN(5)[l * DIN + n];
          for (int k0 = 0; k0 < D; k0 += 64) { const float sv = fsilu(cv[k0 + C.lane]);
#pragma unroll 16
              for (int j = 0; j < 64; ++j) acc += __uint_as_float(__builtin_amdgcn_readlane(__float_as_uint(sv), j)) * W[(size_t)(k0 + j) * DIN]; }
          mods[(size_t)(l * 33 + r) * DIN + n] = acc; } }
}
constexpr float W13_SCALE = 64.f, W2_SCALE = 128.f, HID_SCALE = 8.f;
DI void convert_moe_weights(const Ctx& C) {
    unsigned char* ws = C.ws; int itb = 0;
    for (int e = 0; e < NE; ++e) {
        transpose_matrix8(C, PIN(24) + (size_t)e * D * DFE, D, DFE, ws + WS_WM13 + (size_t)e * 2 * DFE * D, D, 2, W13_SCALE, itb);
        transpose_matrix8(C, PIN(25) + (size_t)e * D * DFE, D, DFE, ws + WS_WM13 + (size_t)e * 2 * DFE * D, D, 3, W13_SCALE, itb);
        transpose_matrix8(C, PIN(26) + (size_t)e * DFE * D, DFE, D, ws + WS_WM2 + (size_t)e * D * DFE, DFE, 0, W2_SCALE, itb);
    }
}

template <bool ROUTER>
DI void phase_norm(const Ctx& C, const float* xl, const float* xc, const float* nw, const float* mods, int shsel, int nrows, bf16_t* Hout, const float* rw, unsigned char* route, LAS int* cntL, unsigned char* H8 = nullptr) {
    for (int row = C.gw; row < nrows; row += C.NGW) {
        const bool lat = row < NLAT; const float* xr = lat ? xl + (size_t)row * D : xc + (size_t)(row - NLAT) * D;
        const float* mv = mods + (size_t)(lat ? (row >> 11) : 32) * DIN + shsel * D;
        f32x4 v[4]; float ss = 0.f;
#pragma unroll
        for (int j = 0; j < 4; ++j) { v[j] = *(const f32x4*)(xr + 256 * j + 4 * C.lane); ss += (v[j][0] * v[j][0] + v[j][1] * v[j][1]) + (v[j][2] * v[j][2] + v[j][3] * v[j][3]); }
        const float rstd = 1.0f / sqrtf(wave_sum(ss) * (1.f / D) + EPS);
        float lg[8];
        if (ROUTER) {
#pragma unroll
            for (int e = 0; e < 8; ++e) lg[e] = 0.f; }
#pragma unroll
        for (int j = 0; j < 4; ++j) { const int c0 = 256 * j + 4 * C.lane;
            const f32x4 w = *(const f32x4*)(nw + c0), sh = *(const f32x4*)(mv + c0), sc = *(const f32x4*)(mv + D + c0);
            f32x4 h = (v[j] * rstd) * w * (sc + 1.0f) + sh;
            if (ROUTER) *(unsigned*)((unsigned char*)Hout + (size_t)row * D + c0) = pack_fp8x4(h[0], h[1], h[2], h[3]);
            else { u32x2 o; o.x = cvt_pk_bf16(h[0], h[1]); o.y = cvt_pk_bf16(h[2], h[3]); *(u32x2*)(Hout + (size_t)row * D + c0) = o;
                   if (H8) *(unsigned*)(H8 + (size_t)row * D + c0) = pack_fp8x4(h[0], h[1], h[2], h[3]); }
            if (ROUTER) {
#pragma unroll
                for (int q = 0; q < 4; ++q) { const f32x4 r0 = *(const f32x4*)(rw + (size_t)(c0 + q) * 8), r1 = *(const f32x4*)(rw + (size_t)(c0 + q) * 8 + 4);
                    lg[0] += h[q] * r0[0]; lg[1] += h[q] * r0[1]; lg[2] += h[q] * r0[2]; lg[3] += h[q] * r0[3]; lg[4] += h[q] * r1[0]; lg[5] += h[q] * r1[1]; lg[6] += h[q] * r1[2]; lg[7] += h[q] * r1[3]; } }
        }
        if (ROUTER) {
#pragma unroll
            for (int e = 0; e < 8; ++e) lg[e] = wave_sum(lg[e]);
            if (C.lane == 0) {
                int e1 = 0; float l1 = lg[0];
#pragma unroll
                for (int e = 1; e < 8; ++e) if (lg[e] > l1) { l1 = lg[e]; e1 = e; }
                int e2 = -1; float l2 = -INFINITY;
#pragma unroll
                for (int e = 0; e < 8; ++e) if (e != e1 && lg[e] > l2) { l2 = lg[e]; e2 = e; }
                const float g2 = 1.f / (1.f + expf(l1 - l2)), g1 = 1.f - g2;
                int* rt = (int*)(route + (size_t)row * 24); rt[0] = e1; rt[1] = e2; ((float*)rt)[2] = g1; ((float*)rt)[3] = g2;
                atomicAdd((int*)&cntL[e1], 1); atomicAdd((int*)&cntL[e2], 1);
            }
        }
    }
}

constexpr int AT_XCH = 65536;
DI float max3f(float a, float b, float c) { return fmaxf(fmaxf(a, b), c); }
DI void attn_unit(const Ctx& C, bf16_t* P, int qrow0, int krow_ctx, int krow_lat, int nkt, int h, float lam, const float* anw, float post) {
    const int tid_ = my_tid();
    LAS unsigned char* lds = C.lds; const int lane = tid_ & 63, wid = __builtin_amdgcn_readfirstlane(tid_ >> 6), sub = wid >> 2, qw = wid & 3, r32 = lane & 31, hh = lane >> 5;
    const int tq = (lane & 15) >> 2, tp = lane & 3, blk = (lane >> 4) & 1;
    LAS unsigned char* qlds = lds + AT_XCH + wid * 8192 + r32 * 16;
#pragma unroll
    for (int qb = 0; qb < 2; ++qb) { const bf16_t* qp = P + (size_t)(qrow0 + 64 * qw + 32 * qb + r32) * PW + PC_Q + h * 128 + sub * 64 + 8 * hh;
#pragma unroll
      for (int ks = 0; ks < 4; ++ks) *(LAS bf16x8*)(qlds + ((2 * ks + hh) * 64 + 32 * qb) * 16) = *(const bf16x8*)(qp + 16 * ks); }
    f32x16 O[2][4];
#pragma unroll
    for (int qb = 0; qb < 2; ++qb)
#pragma unroll
        for (int c = 0; c < 4; ++c)
#pragma unroll
            for (int i = 0; i < 16; ++i) O[qb][c][i] = 0.f;
    float m_run[2] = {-INFINITY, -INFINITY}, l_run[2] = {0.f, 0.f};
#define AT_ISSUE(kt, buf) do { const int kr0_ = (kt) < 4 ? krow_ctx + (kt) * 64 : krow_lat + ((kt) - 4) * 64; LAS unsigned char* bb_ = lds + (buf) * 32768; \
        _Pragma("unroll") for (int j_ = 0; j_ < 2; ++j_) { const int c_ = 2 * wid + j_; \
            dma16(P + (size_t)(kr0_ + lane) * PW + PC_K + h * 128 + c_ * 8, bb_ + c_ * 1024); \
            dma16(P + (size_t)(kr0_ + 16 * (c_ & 3) + (lane >> 2)) * PW + PC_V + h * 128 + (c_ >> 2) * 32 + (lane & 3) * 8, bb_ + 16384 + c_ * 1024); } } while (0)
    AT_ISSUE(0, 0);
    int buf = 0;
#pragma unroll 1
    for (int kt = 0; kt < nkt; ++kt) {
        VM_WAIT(); __syncthreads();
        if (kt + 1 < nkt) AT_ISSUE(kt + 1, buf ^ 1);
        const LAS unsigned char* kb = lds + buf * 32768, * vb = kb + 16384 + (4 * hh + tq) * 64 + blk * 32 + tp * 8;
        bf16x8 Pf[2][4];
#pragma unroll
        for (int qb = 0; qb < 2; ++qb) {
            f32x16 s0, s1;
#pragma unroll
            for (int i = 0; i < 16; ++i) { s0[i] = 0.f; s1[i] = 0.f; }
#pragma unroll
            for (int ks = 0; ks < 4; ++ks) { const LAS unsigned char* kp = kb + ((sub * 8 + 2 * ks + hh) * 64 + r32) * 16;
                const bf16x8 k0 = *(const LAS bf16x8*)kp, k1 = *(const LAS bf16x8*)(kp + 512);
                const bf16x8 q = *(const LAS bf16x8*)(qlds + ((2 * ks + hh) * 64 + 32 * qb) * 16);
                s0 = MFMA32(k0, q, s0); s1 = MFMA32(k1, q, s1); }
            float mx = max3f(s0[0], s1[0], s0[1]);
#pragma unroll
            for (int i = 1; i < 16; ++i) mx = (i + 1 < 16) ? max3f(mx, s1[i], s0[i + 1]) : fmaxf(mx, s1[i]);
            mx = fmaxf(mx, __shfl_xor(mx, 32));
            const float mnew = fmaxf(m_run[qb], mx);
            if (__any(mnew > m_run[qb])) { const float alpha = __builtin_amdgcn_exp2f(m_run[qb] - mnew); l_run[qb] *= alpha;
#pragma unroll
                for (int c = 0; c < 4; ++c)
#pragma unroll
                    for (int i = 0; i < 16; ++i) O[qb][c][i] *= alpha;
                m_run[qb] = mnew; }
            const float mr = m_run[qb]; float ps0 = 0.f, ps1 = 0.f;
#pragma unroll
            for (int i = 0; i < 16; ++i) { s0[i] = __builtin_amdgcn_exp2f(s0[i] - mr); s1[i] = __builtin_amdgcn_exp2f(s1[i] - mr); ps0 += s0[i]; ps1 += s1[i]; }
            l_run[qb] += ps0 + ps1;
            Pf[qb][0] = packf8(s0, 0); Pf[qb][1] = packf8(s0, 1); Pf[qb][2] = packf8(s1, 0); Pf[qb][3] = packf8(s1, 1);
        }
#pragma unroll
        for (int cb = 0; cb < 4; ++cb) {
#pragma unroll
            for (int s4 = 0; s4 < 4; ++s4) { const bf16x8 a = cat8(tr16(vb + cb * 4096 + s4 * 1024), tr16(vb + cb * 4096 + s4 * 1024 + 512));
                O[0][cb] = MFMA32(a, Pf[0][s4], O[0][cb]); O[1][cb] = MFMA32(a, Pf[1][s4], O[1][cb]); } }
        buf ^= 1;
    }
#undef AT_ISSUE
    LDS_WAIT(); __syncthreads();
    const int te = my_tid(); const int lane_e = te & 63, wid_e = __builtin_amdgcn_readfirstlane(te >> 6);
    LAS float* xch = (LAS float*)(lds + AT_XCH) + (wid_e & 3) * 4096 + lane_e;
#pragma unroll
    for (int qb = 0; qb < 2; ++qb) {
        const float lt = l_run[qb] + __shfl_xor(l_run[qb], 32); const float inv = 1.f / lt;
        if ((wid_e >> 2) == 1) { const float sc = -lam * inv;
#pragma unroll
            for (int c = 0; c < 4; ++c)
#pragma unroll
                for (int i = 0; i < 16; ++i) xch[(c * 16 + i) * 64] = O[qb][c][i] * sc; }
        LDS_WAIT(); __syncthreads();
        if ((wid_e >> 2) == 0) {
            float ss = 0.f;
#pragma unroll
            for (int c = 0; c < 4; ++c)
#pragma unroll
                for (int i = 0; i < 16; ++i) { const float o = O[qb][c][i] * inv + xch[(c * 16 + i) * 64]; O[qb][c][i] = o; ss += o * o; }
            ss += __shfl_xor(ss, 32);
            const float rs = post / sqrtf(ss * (1.f / 128.f) + EPS);
            bf16_t* op = P + (size_t)(qrow0 + 64 * (wid_e & 3) + 32 * qb + (lane_e & 31)) * PW + PC_Q + h * 128;
#pragma unroll
            for (int c = 0; c < 4; ++c)
#pragma unroll
                for (int g = 0; g < 4; ++g) { const int v0 = 32 * c + 8 * g + 4 * (lane_e >> 5); const f32x4 w = *(const f32x4*)(anw + v0);
                    u32x2 o; o.x = cvt_pk_bf16(O[qb][c][4 * g] * rs * w[0], O[qb][c][4 * g + 1] * rs * w[1]); o.y = cvt_pk_bf16(O[qb][c][4 * g + 2] * rs * w[2], O[qb][c][4 * g + 3] * rs * w[3]);
                    *(u32x2*)(op + v0) = o; }
        }
        LDS_WAIT(); __syncthreads();
    }
}

constexpr int SC_Q = 0, SC_LF = 16384, SC_V0 = 32768, SC_QM = 65536, SC_KMR = 81920, SC_KMS = 98304, SC_SX = 114688, SC_A31 = 147456, SC_A63 = 147968, SC_END = 148480;
DI void scan_chain(const Ctx& C, bf16_t* P, int b, int h, int dir, bool store_ctx) {
    const int tid_ = my_tid();
    LAS unsigned char* lds = C.lds; const int lane = tid_ & 63, wid = __builtin_amdgcn_readfirstlane(tid_ >> 6), r32 = lane & 31, hh = lane >> 5;
    const int tq = (lane & 15) >> 2, tp = lane & 3, blk = (lane >> 4) & 1;
    const int db = wid & 3, tb = wid >> 2;
    const int base_nat = hh * 512 + tq * 64 + blk * 32 + tp * 8;
    const int base_prm = (4 * hh + tq) * 64 + blk * 32 + tp * 8;
    const int lfcol = (dir ? PC_LB : PC_LF) + h * 128, qcol = PC_RQ + h * 128, vcol = PC_RI + h * 128;
    f32x16 ST[2];
#pragma unroll
    for (int j = 0; j < 2; ++j)
#pragma unroll
        for (int i = 0; i < 16; ++i) ST[j][i] = 0.f;
#define SROW(c, i) ((c) < 4 ? NLAT + b * CL + (dir ? 255 - ((c) * 64 + (i)) : (c) * 64 + (i)) : b * T + (dir ? 2047 - (((c) - 4) * 64 + (i)) : ((c) - 4) * 64 + (i)))
#define SDMA(c, colbase, dstoff) do { _Pragma("unroll") for (int j_ = 0; j_ < 2; ++j_) { const int I_ = 2 * wid + j_; const int ti_ = 16 * (I_ & 3) + (lane >> 2); \
        dma16(P + (size_t)SROW(c, ti_) * PW + (colbase) + (I_ >> 2) * 32 + (lane & 3) * 8, lds + (dstoff) + I_ * 1024); } } while (0)
    SDMA(0, qcol, SC_Q); SDMA(0, lfcol, SC_LF); SDMA(0, vcol, SC_V0);
    int vbuf = 0;
    const int t = 32 * tb + r32;
#pragma unroll 1
    for (int c = 0; c < 36; ++c) {
        VM_WAIT(); __syncthreads();
        const LAS unsigned char* Vimg = lds + SC_V0 + vbuf * 16384;
        f32x16 cm;
#pragma unroll
        for (int i = 0; i < 16; ++i) cm[i] = 0.f;
#pragma unroll
        for (int kk = 0; kk < 2; ++kk) { const int ks = 2 * tb + kk;
            const half8 a = __builtin_bit_cast(half8, cat8(tr16(lds + SC_LF + db * 4096 + base_nat + ks * 1024), tr16(lds + SC_LF + db * 4096 + base_nat + ks * 1024 + 256)));
            half8 bm;
#pragma unroll
            for (int j = 0; j < 8; ++j) { const int s = 16 * ks + 8 * hh + j; bm[j] = tb == 0 ? (s > t ? (_Float16)-1.f : (_Float16)0.f) : (s <= t ? (_Float16)1.f : (_Float16)0.f); }
            cm = __builtin_amdgcn_mfma_f32_32x32x16_f16(a, bm, cm, 0, 0, 0); }
#pragma unroll
        for (int g = 0; g < 4; ++g) {
            const int sa = db * 4096 + (t >> 3) * 512 + (t & 7) * 64 + (8 * g + 4 * hh) * 2;
            const u32x2 q4 = *(const LAS u32x2*)(lds + SC_Q + sa); const half4 lf4 = *(const LAS half4*)(lds + SC_LF + sa);
            const float qv[4] = {bflo(q4.x), bfhi(q4.x), bflo(q4.y), bfhi(q4.y)};
            float qm[4], km[4];
#pragma unroll
            for (int e = 0; e < 4; ++e) { const float cv = cm[4 * g + e] * LOG2E; const float E = __builtin_amdgcn_exp2f(cv), Ei = __builtin_amdgcn_exp2f(-cv);
                const float lf = (float)lf4[e]; qm[e] = qv[e] * E; km[e] = (1.f - __builtin_amdgcn_exp2f(lf * LOG2E)) * Ei;
                if (tb == 0 && r32 == 0) ((LAS float*)(lds + SC_A31))[32 * db + 8 * g + 4 * hh + e] = lf - cm[4 * g + e];
                if (tb == 1 && r32 == 31) ((LAS float*)(lds + SC_A63))[32 * db + 8 * g + 4 * hh + e] = cm[4 * g + e]; }
            u32x2 qw2, kw2; qw2.x = cvt_pk_bf16(qm[0], qm[1]); qw2.y = cvt_pk_bf16(qm[2], qm[3]); kw2.x = cvt_pk_bf16(km[0], km[1]); kw2.y = cvt_pk_bf16(km[2], km[3]);
            const int ra = ((4 * db + g) * 64 + t) * 16 + 8 * hh;
            *(LAS u32x2*)(lds + SC_QM + ra) = qw2; *(LAS u32x2*)(lds + SC_KMR + ra) = kw2; *(LAS u32x2*)(lds + SC_KMS + sa) = kw2;
        }
        LDS_WAIT(); __syncthreads();
        { const int d = 32 * db + r32; const float c31 = ((LAS float*)(lds + SC_A31))[d], c63 = ((LAS float*)(lds + SC_A63))[d];
          const float e31 = __expf(c31), dec = __expf(c31 + c63), e63 = __expf(c63);
          f32x16 SN[2];
#pragma unroll
          for (int j = 0; j < 2; ++j) { const int vb2 = 2 * tb + j;
#pragma unroll
              for (int g = 0; g < 4; ++g) { u32x2 w; w.x = cvt_pk_bf16(ST[j][4 * g] * e31, ST[j][4 * g + 1] * e31); w.y = cvt_pk_bf16(ST[j][4 * g + 2] * e31, ST[j][4 * g + 3] * e31);
                  *(LAS u32x2*)(lds + SC_SX + vb2 * 8192 + (d >> 3) * 512 + (d & 7) * 64 + (8 * g + 4 * hh) * 2) = w; }
#pragma unroll
              for (int i = 0; i < 16; ++i) SN[j][i] = 0.f; }
#pragma unroll
          for (int ks = 0; ks < 4; ++ks) {
              const bf16x8 kf = cat8(tr16(lds + SC_KMS + db * 4096 + base_nat + ks * 1024), tr16(lds + SC_KMS + db * 4096 + base_nat + ks * 1024 + 256));
#pragma unroll
              for (int j = 0; j < 2; ++j) { const int vb2 = 2 * tb + j;
                  const bf16x8 vf = cat8(tr16(Vimg + vb2 * 4096 + base_nat + ks * 1024), tr16(Vimg + vb2 * 4096 + base_nat + ks * 1024 + 256));
                  SN[j] = MFMA32(vf, kf, SN[j]); } }
#pragma unroll
          for (int j = 0; j < 2; ++j)
#pragma unroll
              for (int i = 0; i < 16; ++i) ST[j][i] = dec * ST[j][i] + e63 * SN[j][i];
        }
        LDS_WAIT(); __syncthreads();
        if (c + 1 < 36) { SDMA(c + 1, qcol, SC_Q); SDMA(c + 1, lfcol, SC_LF); SDMA(c + 1, vcol, SC_V0 + (vbuf ^ 1) * 16384); }
        { bf16x8 Qmf[8];
#pragma unroll
          for (int kd = 0; kd < 8; ++kd) Qmf[kd] = *(const LAS bf16x8*)(lds + SC_QM + ((2 * kd + hh) * 64 + t) * 16);
          f32x16 o;
#pragma unroll
          for (int i = 0; i < 16; ++i) o[i] = 0.f;
          for (int sb = 0; sb <= tb; ++sb) {
              f32x16 pt;
#pragma unroll
              for (int i = 0; i < 16; ++i) pt[i] = 0.f;
#pragma unroll
              for (int kd = 0; kd < 8; ++kd) { const bf16x8 a = *(const LAS bf16x8*)(lds + SC_KMR + ((2 * kd + hh) * 64 + 32 * sb + r32) * 16); pt = MFMA32(a, Qmf[kd], pt); }
              if (sb == tb) {
#pragma unroll
                  for (int i = 0; i < 16; ++i) if (crow(i, hh) > r32) pt[i] = 0.f; }
              const bf16x8 p0 = packf8(pt, 0), p1 = packf8(pt, 1);
              { const bf16x8 a = cat8(tr16(Vimg + db * 4096 + base_prm + (2 * sb) * 1024), tr16(Vimg + db * 4096 + base_prm + (2 * sb) * 1024 + 512)); o = MFMA32(a, p0, o); }
              { const bf16x8 a = cat8(tr16(Vimg + db * 4096 + base_prm + (2 * sb + 1) * 1024), tr16(Vimg + db * 4096 + base_prm + (2 * sb + 1) * 1024 + 512)); o = MFMA32(a, p1, o); }
          }
#pragma unroll
          for (int kd = 0; kd < 8; ++kd) { const bf16x8 a = cat8(tr16(lds + SC_SX + db * 8192 + base_nat + kd * 1024), tr16(lds + SC_SX + db * 8192 + base_nat + kd * 1024 + 256)); o = MFMA32(a, Qmf[kd], o); }
          if (c >= 4 || store_ctx) { bf16_t* op = P + (size_t)SROW(c, t) * PW + lfcol + 32 * db;
#pragma unroll
              for (int g = 0; g < 4; ++g) { u32x2 w; w.x = cvt_pk_bf16(o[4 * g], o[4 * g + 1]); w.y = cvt_pk_bf16(o[4 * g + 2], o[4 * g + 3]); *(u32x2*)(op + 8 * g + 4 * hh) = w; } }
        }
        vbuf ^= 1;
    }
    VM_WAIT(); LDS_WAIT(); __syncthreads();
#undef SROW
#undef SDMA
}

DI void phase_recprep(const Ctx& C, bf16_t* P, const float* rnw, int nrows) {
    for (int row = C.gw; row < nrows; row += C.NGW) {
        bf16_t* pr = P + (size_t)row * PW + 8 * C.lane;
        float a[8], bb[8], g[8]; unpack8(*(const u32x4*)(pr + PC_LF), a); unpack8(*(const u32x4*)(pr + PC_LB), bb); unpack8(*(const u32x4*)(pr + PC_G), g);
        float ss = 0.f;
#pragma unroll
        for (int j = 0; j < 8; ++j) { a[j] += bb[j]; ss += a[j] * a[j]; }
        ss += __shfl_xor(ss, 1); ss += __shfl_xor(ss, 2); ss += __shfl_xor(ss, 4); ss += __shfl_xor(ss, 8);
        const float rs = 1.0f / sqrtf(ss * (1.f / 128.f) + EPS);
        const f32x4 w0 = *(const f32x4*)(rnw + ((8 * C.lane) & 127)), w1 = *(const f32x4*)(rnw + ((8 * C.lane) & 127) + 4);
        f32x4 o0, o1;
#pragma unroll
        for (int j = 0; j < 4; ++j) { o0[j] = a[j] * rs * w0[j] * g[j]; o1[j] = a[4 + j] * rs * w1[j] * g[4 + j]; }
        *(u32x4*)(pr + PC_LF) = pack8(o0, o1);
    }
}

DI void phase_slots(const Ctx& C, const int* cnt, int* pbout, unsigned char* route, const bf16_t* H2, bf16_t* AG, LAS int* cur) {
    if (C.tid < 16) cur[C.tid] = 0;
    __syncthreads();
    for (int g = C.tid; g < C.G; g += 512) {
#pragma unroll
        for (int k = 0; k < 8; ++k) { const int c = cnt[g * 8 + k]; atomicAdd((int*)&cur[8 + k], c); if (g < C.bx) atomicAdd((int*)&cur[k], c); } }
    __syncthreads();
    if (C.tid < 8) { const int e = C.tid; int pb = 0, pbe = 0;
#pragma unroll
        for (int k = 0; k < 8; ++k) { if (k == e) pbe = pb; pb += (cur[8 + k] + 255) >> 8; }
        const int mine = cur[e];
        if (C.bx == 0) { pbout[e] = pbe; if (e == 7) pbout[8] = pb; }
        cur[e] = pbe * 256 + mine;
    }
    __syncthreads();
    for (int row = C.gw; row < NLAT; row += C.NGW) {
        int* rt = (int*)(route + (size_t)row * 24);
        int s1 = 0, s2 = 0;
        if (C.lane == 0) { s1 = atomicAdd((int*)&cur[rt[0]], 1); s2 = atomicAdd((int*)&cur[rt[1]], 1); rt[4] = s1; rt[5] = s2; }
        s1 = __builtin_amdgcn_readfirstlane(s1); s2 = __builtin_amdgcn_readfirstlane(s2);
        const u32x4 v0 = *((const u32x4*)((const unsigned char*)H2 + (size_t)row * D) + C.lane);
        *((u32x4*)((unsigned char*)AG + (size_t)s1 * D) + C.lane) = v0; *((u32x4*)((unsigned char*)AG + (size_t)s2 * D) + C.lane) = v0;
    }
}
DI void phase_final(const Ctx& C, float* x, const unsigned char* route, const bf16_t* Y, const float* mods1, const float* fw) {
    for (int row = C.gw; row < NLAT; row += C.NGW) {
        const int* rt = (const int*)(route + (size_t)row * 24); const float g1 = ((const float*)rt)[2], g2 = ((const float*)rt)[3]; const int s1 = rt[4], s2 = rt[5];
        const float* mv = mods1 + (size_t)(row >> 11) * DIN + 5 * D; float* xr = x + (size_t)row * D;
        f32x4 v[4]; float ss = 0.f;
#pragma unroll
        for (int j = 0; j < 4; ++j) { const int c0 = 256 * j + 4 * C.lane;
            const u32x2 y1 = *(const u32x2*)(Y + (size_t)s1 * D + c0), y2 = *(const u32x2*)(Y + (size_t)s2 * D + c0); const f32x4 m5 = *(const f32x4*)(mv + c0);
            f32x4 y; y[0] = g1 * bflo(y1.x) + g2 * bflo(y2.x); y[1] = g1 * bfhi(y1.x) + g2 * bfhi(y2.x); y[2] = g1 * bflo(y1.y) + g2 * bflo(y2.y); y[3] = g1 * bfhi(y1.y) + g2 * bfhi(y2.y);
            v[j] = *(const f32x4*)(xr + c0) + m5 * y; ss += (v[j][0] * v[j][0] + v[j][1] * v[j][1]) + (v[j][2] * v[j][2] + v[j][3] * v[j][3]); }
        const float rstd = 1.0f / sqrtf(wave_sum(ss) * (1.f / D) + EPS);
#pragma unroll
        for (int j = 0; j < 4; ++j) { const int c0 = 256 * j + 4 * C.lane; *(f32x4*)(xr + c0) = v[j] * rstd * *(const f32x4*)(fw + c0); }
    }
}

constexpr int LDS_MISC = SC_END;
constexpr int LDS_BYTES = SC_END + 512;
static_assert(LDS_WTAB_OFF == SC_END + 128, "wave table sits behind the barrier words and counters");
constexpr int NPHASE = 20;

DI Ctx make_ctx() {
    extern __shared__ __attribute__((aligned(16))) unsigned char lds_raw[];
    Ctx C; const int t = my_tid();
    unsigned lb = (unsigned)(size_t)(LAS unsigned char*)lds_raw; asm volatile("" : "+s"(lb));
    C.lds = (LAS unsigned char*)(size_t)lb; C.ws = kparams()->ws; C.tid = t; C.lane = t & 63; C.wave = __builtin_amdgcn_readfirstlane(t >> 6);
    int bx = blockIdx.x, G = gridDim.x; asm volatile("" : "+s"(bx), "+s"(G));
    C.bx = bx; C.G = G; C.vcu = (C.G % 8 == 0) ? (bx % 8) * (C.G / 8) + bx / 8 : bx;
    C.gw = C.vcu * 8 + C.wave; C.NGW = C.G * 8;
    return C;
}
DI void grid_barrier() {
    extern __shared__ __attribute__((aligned(16))) unsigned char lds_raw[];
    XcdBarrier b; b.bar = (unsigned*)(kparams()->ws + WS_CTL) + CW_BAR + kparams()->li * XCD_BAR_WORDS; b.x = xb_xcc_id(); b.st = (volatile LAS unsigned*)((LAS unsigned char*)lds_raw + LDS_MISC);
    xcd_barrier(b);
}
#define WSP(T, off) ((T*)(kparams()->ws + (off)))

#ifdef ONLY_PHASE
#define IN(k) (((ONLY_PHASE) >> (k)) & 1)
#else
#define IN(k) (kparams()->ph_lo <= (k) && (k) < kparams()->ph_hi)
#endif
#define SEAM(k) do { if (IN(k) && IN((k) + 1)) grid_barrier(); } while (0)


template <int l> DI void layer_phases() {
        const int pb = 1 + 9 * l;
#define LQ() int lq = l; asm volatile("" : "+s"(lq))
#define XL (lq == 0 ? PIN(0) : (const float*)POUT)
#define XC (lq == 0 ? PIN(2) : (const float*)WSP(float, WS_CTXRES))
#define LMODS (WSP(float, WS_MODS) + (size_t)lq * 33 * DIN)
#define NROWS_OUT (lq == 0 ? NTOK : NLAT)
        if (IN(pb + 0)) { LQ(); const Ctx C = make_ctx(); phase_norm<false>(C, XL, XC, PIN(6) + lq * D, LMODS, 0, NTOK, WSP(bf16_t, WS_H), nullptr, nullptr, nullptr, WSP(unsigned char, WS_H8)); }
        SEAM(pb + 0);
        if (IN(pb + 1)) { LQ();
            { const Ctx C = make_ctx();
              Gemm g{WSP(bf16_t, WS_H), WSP(bf16_t, WS_WIN) + (size_t)lq * 4096 * D, NTOK, N_SEC_BF * 512, D, D};
              pg8::StaticOrder S; S.init(g, C.G, C.bx);
              EpiInProj E{WSP(bf16_t, WS_P), WSP(float2, WS_ROPE), WSP(float, WS_LBS) + lq * 1024, WSP(float, WS_LBS) + lq * 1024 + 512, (int)secmap_of(false), 1.f};
              pg8::gemm_phase<EpiInProj, pg8::StaticOrder>(C.lds, g, S, E); }
            if (N_SEC_F8 > 0) { const Ctx C = make_ctx();
              Gemm g{WSP(bf16_t, WS_H8), (const bf16_t*)(WSP(unsigned char, WS_WIN8) + (size_t)lq * 4096 * D), NTOK, N_SEC_F8 * 512, D / 2, D / 2};
              pg8::StaticOrder S; S.init(g, C.G, C.bx);
              EpiInProj E{WSP(bf16_t, WS_P), WSP(float2, WS_ROPE), WSP(float, WS_LBS) + lq * 1024, WSP(float, WS_LBS) + lq * 1024 + 512, (int)secmap_of(true), 1.f / WIN8_SCALE};
              pg8::gemm_phase<EpiInProj, pg8::StaticOrder, true, true>(C.lds, g, S, E); }
        }
        SEAM(pb + 1);
        if (IN(pb + 2)) { LQ(); const Ctx C = make_ctx(); bf16_t* const Pb = WSP(bf16_t, WS_P);
            for (int id = C.vcu; id < NB * 4 * 2; id += C.G) scan_chain(C, Pb, id >> 3, (id >> 1) & 3, id & 1, lq == 0);
            float lam;
            { const float a = wave_sum(PIN(9)[lq * 64 + C.lane] * PIN(10)[lq * 64 + C.lane]), b2 = wave_sum(PIN(11)[lq * 64 + C.lane] * PIN(12)[lq * 64 + C.lane]);
              const float li = 0.8f - 0.6f * expf(-0.3f * (float)lq); lam = expf(a) - expf(b2) + li; lam = __uint_as_float(__builtin_amdgcn_readfirstlane(__float_as_uint(lam))); }
            const float post = __uint_as_float(__builtin_amdgcn_readfirstlane(__float_as_uint(1.f - (0.8f - 0.6f * expf(-0.3f * (float)lq)))));
            const float* anw = PIN(13) + lq * 128;
            const int NU = NB * 4 * 8, U = (NU + C.G - 1) / C.G;
            for (int id = C.vcu * U; id < NU && id < (C.vcu + 1) * U; ++id) { const int bh = id >> 3, qb = id & 7, b = bh >> 2, h = bh & 3;
                attn_unit(C, Pb, b * T + qb * 256, NLAT + b * CL, b * T, 36, h, lam, anw, post); }
            if (lq == 0) for (int id = C.vcu; id < NB * 4; id += C.G) { const int b = id >> 2, h = id & 3;
                attn_unit(C, Pb, NLAT + b * CL, NLAT + b * CL, 0, 4, h, lam, anw, post); }
        }
        SEAM(pb + 2);
        if (IN(pb + 3)) { LQ(); const Ctx C = make_ctx();
            phase_recprep(C, WSP(bf16_t, WS_P), PIN(14) + lq * 128, NROWS_OUT);
            Gemm g{WSP(bf16_t, WS_H8), (const bf16_t*)(WSP(unsigned char, WS_WIN8) + ((size_t)lq * 4096 + N_SEC_F8 * 512) * D), NROWS_OUT, 2048, D / 2, D / 2};
            pg8::StaticOrder S; S.init(g, C.G, C.bx);
            EpiGates E{WSP(bf16_t, WS_P), 1.f / WIN8_SCALE};
            pg8::gemm_phase<EpiGates, pg8::StaticOrder, true, true>(C.lds, g, S, E);
        }
        SEAM(pb + 3);
        if (IN(pb + 4)) { LQ();
            { const Ctx C = make_ctx(); Gemm g{WSP(bf16_t, WS_P) + PC_Q, WSP(bf16_t, WS_WUA) + (size_t)lq * D * 512, NROWS_OUT, D, 512, PW};
              pg8::StaticOrder S; S.init(g, C.G, C.bx); EpiMerge<true> E{WSP(bf16_t, WS_P), PC_GA, WSP(bf16_t, WS_MERGED)};
              pg8::gemm_phase<EpiMerge<true>, pg8::StaticOrder>(C.lds, g, S, E); }
            { const Ctx C = make_ctx(); Gemm g{WSP(bf16_t, WS_P) + PC_LF, WSP(bf16_t, WS_WUR) + (size_t)lq * D * 512, NROWS_OUT, D, 512, PW};
              pg8::StaticOrder S; S.init(g, C.G, C.bx); EpiMerge<false> E{WSP(bf16_t, WS_P), PC_GR, WSP(bf16_t, WS_MERGED)};
              pg8::gemm_phase<EpiMerge<false>, pg8::StaticOrder>(C.lds, g, S, E); }
        }
        SEAM(pb + 4);
        if (IN(pb + 5)) { LQ(); const Ctx C = make_ctx();
            Gemm g{WSP(bf16_t, WS_MERGED), WSP(bf16_t, WS_WO) + (size_t)lq * D * D, NROWS_OUT, D, D, D};
            pg8::StaticOrder S; S.init(g, C.G, C.bx);
            EpiResid E{XL, XC, POUT, WSP(float, WS_CTXRES), LMODS, 2};
            pg8::gemm_phase<EpiResid, pg8::StaticOrder>(C.lds, g, S, E);
        }
        SEAM(pb + 5);
        if (l == 0) {
            if (IN(7)) { LQ(); const Ctx C = make_ctx(); phase_norm<false>(C, POUT, WSP(float, WS_CTXRES), PIN(7), LMODS, 3, NTOK, WSP(bf16_t, WS_H), nullptr, nullptr, nullptr); }
            SEAM(7);
            if (IN(8)) { LQ(); const Ctx C = make_ctx();
                Gemm g{WSP(bf16_t, WS_H), WSP(bf16_t, WS_W13), NTOK, 2 * DFFP, D, D};
                pg8::StaticOrder S; S.init(g, C.G, C.bx); EpiSwiglu E{WSP(bf16_t, WS_HID), DFFP, 0};
                pg8::gemm_phase<EpiSwiglu, pg8::StaticOrder>(C.lds, g, S, E);
            }
            SEAM(8);
            if (IN(9)) { LQ(); const Ctx C = make_ctx();
                Gemm g{WSP(bf16_t, WS_HID), WSP(bf16_t, WS_W2), NTOK, D, DFFP, DFFP};
                pg8::StaticOrder S; S.init(g, C.G, C.bx); EpiResid E{POUT, WSP(float, WS_CTXRES), POUT, WSP(float, WS_CTXRES), LMODS, 5};
                pg8::gemm_phase<EpiResid, pg8::StaticOrder>(C.lds, g, S, E);
            }
            SEAM(9);
        } else {
            if (IN(16)) { LQ(); const Ctx C = make_ctx(); LAS int* lcnt = (LAS int*)(C.lds + LDS_MISC + 32);
                if (C.tid < 8) lcnt[C.tid] = 0;
                __syncthreads();
                phase_norm<true>(C, POUT, nullptr, PIN(7) + D, LMODS, 3, NLAT, WSP(bf16_t, WS_H2M), PIN(23), WSP(unsigned char, WS_ROUTE), lcnt);
                __syncthreads();
                if (C.tid < 8) WSP(int, WS_CNT)[C.bx * 8 + C.tid] = lcnt[C.tid];
                convert_moe_weights(C);
            }
            SEAM(16);
            if (IN(17)) { LQ(); const Ctx C = make_ctx(); phase_slots(C, WSP(int, WS_CNT), WSP(int, WS_CNT) + 4096, WSP(unsigned char, WS_ROUTE), WSP(bf16_t, WS_H2M), WSP(bf16_t, WS_AG), (LAS int*)(C.lds + LDS_MISC + 32)); }
            SEAM(17);
            if (IN(18)) { LQ();
                const int ptot = __builtin_amdgcn_readfirstlane(WSP(int, WS_CNT)[4096 + 8]);
                for (int p0 = 0; p0 < ptot; p0 += MOE_CHUNK) {
                    const int np = (ptot - p0) < MOE_CHUNK ? (ptot - p0) : MOE_CHUNK;
#define MOE_ORDER_INIT(S) do { S.so.init(g, C.G, C.bx); S.p0 = p0; S.pbv = WSP(int, WS_CNT) + 4096; } while (0)
                    { const Ctx C = make_ctx(); Gemm g{WSP(bf16_t, WS_AG), WSP(bf16_t, WS_WM13), np * 256, 2 * DFE, D / 2, D / 2};
                      pg8::MoeOrder S; MOE_ORDER_INIT(S); S.apan0 = 0; S.estride = (size_t)2 * DFE * D;
                      EpiSwiglu8 E{WSP(unsigned char, WS_MHID), DFE, p0, 1.f / W13_SCALE, HID_SCALE};
                      pg8::gemm_phase<EpiSwiglu8, pg8::MoeOrder, true, true>(C.lds, g, S, E); }
                    grid_barrier();
                    { const Ctx C = make_ctx(); Gemm g{WSP(bf16_t, WS_MHID), WSP(bf16_t, WS_WM2), np * 256, D, DFE / 2, DFE / 2};
                      pg8::MoeOrder S; MOE_ORDER_INIT(S); S.apan0 = p0; S.estride = (size_t)D * DFE;
                      EpiBf16 E{WSP(bf16_t, WS_Y), D, 1.f / (W2_SCALE * HID_SCALE)};
                      pg8::gemm_phase<EpiBf16, pg8::MoeOrder, true, true>(C.lds, g, S, E); }
                    grid_barrier();
                }
            }
            if (IN(19)) { LQ(); const Ctx C = make_ctx(); phase_final(C, POUT, WSP(unsigned char, WS_ROUTE), WSP(bf16_t, WS_Y), LMODS, PIN(27)); }
        }
}

__global__ void __launch_bounds__(512, 2) fwd_kernel(Params p) {
    extern __shared__ __attribute__((aligned(16))) unsigned char lds_raw[];
    (void)p;
    { volatile LAS unsigned* misc = (volatile LAS unsigned*)((LAS unsigned char*)lds_raw + LDS_MISC);
      if (threadIdx.x < 16) misc[threadIdx.x] = 0u;
      if ((threadIdx.x & 63) == 0) ((volatile LAS int*)((LAS unsigned char*)lds_raw + LDS_WTAB_OFF))[(unsigned)__builtin_amdgcn_s_getreg((5 << 11) | 4) & 63u] = threadIdx.x >> 6;
      __syncthreads();
      (void)xcd_barrier_post((unsigned*)(kparams()->ws + WS_CTL) + CW_BAR + kparams()->li * XCD_BAR_WORDS, misc); }
    if (IN(0)) { const Ctx C = make_ctx(); phase_prologue(C); } SEAM(0);

    layer_phases<0>();
    layer_phases<1>();
#undef IN
#undef SEAM
}


#ifndef DBG_T1
#define DBG_T1 1
#endif
#ifndef DBG_CAT
#define DBG_CAT (j >> 9)
#endif
#if DBG
constexpr size_t DBG_ERR = WS_DBG, DBG_SNAPX = WS_DBG + 4096, DBG_ROWS = WS_DBG + 65536, DBG_Q = WS_MERGED + 64 * MiB, DBG_OF = WS_DBG + 262144, DBG_LF = WS_MERGED;
__device__ inline unsigned dhash(unsigned x) { x ^= x >> 16; x *= 0x7feb352du; x ^= x >> 15; x *= 0x846ca68bu; x ^= x >> 16; return x; }
__device__ inline float rbf(float f) { unsigned u = __float_as_uint(f); u += 0x7fffu + ((u >> 16) & 1u); return __uint_as_float(u & 0xffff0000u); }
__device__ inline void rec_err(unsigned char* ws, int id, float got, float exp_, float atol) {
    float d = got - exp_; if (!(d == d) || fabsf(d) > 1e15f) d = 1e15f;
    atomicAdd((float*)(ws + DBG_ERR) + id, d * d); atomicAdd((float*)(ws + DBG_ERR) + 64 + id, exp_ * exp_);
    if (fabsf(d) > 0.15f * fabsf(exp_) + atol * 5.f) atomicAdd((unsigned*)(ws + DBG_ERR) + 128 + id, 1u);
}
__device__ inline int srow(unsigned i) { const unsigned h = dhash(i * 7919u + 13u); return (i & 3u) == 3u ? NLAT + (int)(h % NCTX) : (int)(h % NLAT); }
__device__ inline const float* xrowp(const float* xl, const float* xc, int row) { return row < NLAT ? xl + (size_t)row * D : xc + (size_t)(row - NLAT) * D; }
__device__ inline float dsilu(float x) { return x / (1.f + expf(-x)); }
__device__ inline float dot_hw(const bf16_t* a, const float* w, int K, int ldw) { float s = 0.f; for (int k = 0; k < K; ++k) s += bf2f(a[k]) * rbf(w[(size_t)k * ldw]); return s; }

struct DArgs { const float* in[28]; float* out; unsigned char* ws; int l, kind, id, aux; };
__global__ void dbg_check(DArgs a) {
    unsigned char* ws = a.ws; const int l = a.l; const int i = blockIdx.x * blockDim.x + threadIdx.x;
    const float* mods = (const float*)(ws + WS_MODS) + (size_t)l * 33 * DIN; const bf16_t* P = (const bf16_t*)(ws + WS_P);
    if (a.kind == 1) { const int ll = i & 1, r = dhash(i) % 33, n = dhash(i + 777) % DIN; const float* cv = r < 32 ? a.in[1] + r * D : a.in[3];
        float s = a.in[5][ll * DIN + n]; for (int k = 0; k < D; ++k) s += dsilu(cv[k]) * a.in[4][((size_t)ll * D + k) * DIN + n];
        rec_err(ws, a.id, ((const float*)(ws + WS_MODS))[(size_t)(ll * 33 + r) * DIN + n], s, 0.01f); }
    else if (a.kind == 30) { const int ll = i & 1, n = 4096 + dhash(i) % 2048, k = dhash(i + 4242) % D;
        rec_err(ws, a.id, bf2f(((const bf16_t*)(ws + WS_WIN))[((size_t)ll * DIN + n) * D + k]), rbf(a.in[8][((size_t)ll * D + k) * DIN + n]), 1e-6f); }
    else if (a.kind == 2) { int row = srow(i); if (a.aux == 2 || (l == 1 && a.aux != 0)) row = row % NLAT; const int col = dhash(i + 99) % D;
        const float* xl = a.aux == 0 ? (l == 0 ? a.in[0] : a.out) : a.out; const float* xc = a.aux == 0 && l == 0 ? a.in[2] : (const float*)(ws + WS_CTXRES);
        const float* xr = xrowp(xl, xc, row); float ss = 0.f; for (int k = 0; k < D; ++k) ss += xr[k] * xr[k];
        const float rstd = 1.f / sqrtf(ss / D + EPS); const float* nw = (a.aux == 0 ? a.in[6] : a.in[7]) + l * D; const int sh = a.aux == 0 ? 0 : 3;
        const float* mv = mods + (size_t)(row < NLAT ? row >> 11 : 32) * DIN;
        const float e = xr[col] * rstd * nw[col] * (1.f + mv[(sh + 1) * D + col]) + mv[sh * D + col];
        const bf16_t* H = (const bf16_t*)(ws + (a.aux == 2 ? WS_H2M : WS_H)); rec_err(ws, a.id, bf2f(H[(size_t)row * D + col]), e, 0.02f); }
    else if (a.kind == 3) { const int sec = i & 7, row = srow(i >> 3), j = dhash(i + 5) % 512; const bf16_t* hr = (const bf16_t*)(ws + WS_H) + (size_t)row * D; const float* W = a.in[8] + (size_t)l * D * DIN;
        float e, got; const bool lat = row < NLAT; const int t = row & (T - 1);
        if (sec == 0 || sec == 1) { const int hs = j >> 6, d = j & 63, pi = d & 31, ob = (sec == 0 ? 0 : 512) + hs * 64;
            const float xa = dot_hw(hr, W + ob + pi, D, DIN), xb = dot_hw(hr, W + ob + 32 + pi, D, DIN);
            float c = 1.f, sn = 0.f; if (lat) { const float invf = powf(10000.f, -(float)(pi & 15) / 16.f); const float ang = (float)(pi < 16 ? (t >> 6) : (t & 63)) * invf; c = cosf(ang); sn = sinf(ang); }
            e = d < 32 ? xa * c - xb * sn : xa * sn + xb * c; if (sec == 0) e *= QSCALE;
            got = bf2f(P[(size_t)row * PW + (sec == 0 ? PC_Q : PC_K) + hs * 64 + (d < 32 ? 2 * d : 2 * (d - 32) + 1)]); }
        else if (sec == 2) { e = dot_hw(hr, W + 1024 + j, D, DIN); got = bf2f(P[(size_t)row * PW + PC_V + j]); }
        else if (sec == 3) { e = dsilu(dot_hw(hr, W + 1536 + j, D, DIN)); got = bf2f(P[(size_t)row * PW + PC_RQ + j]); }
        else if (sec == 4) { e = dot_hw(hr, W + 2048 + j, D, DIN); got = bf2f(P[(size_t)row * PW + PC_RI + j]); }
        else if (sec == 5 || sec == 6) { const float z = dot_hw(hr, W + (sec == 5 ? 2560 : 3072) + j, D, DIN); const float* lbp = a.in[sec == 5 ? 15 : 16];
            const float lb = l == 0 ? 0.f : 1.f / (1.f + expf(lbp[j] - lbp[512 + j])); const float sg = 1.f / (1.f + expf(-z)); e = logf(lb + (1.f - lb) * sg);
            got = (float)((const _Float16*)P)[(size_t)row * PW + (sec == 5 ? PC_LF : PC_LB) + j]; }
        else { e = dsilu(dot_hw(hr, W + 3584 + j, D, DIN)); got = bf2f(P[(size_t)row * PW + PC_G + j]); }
        rec_err(ws, a.id + sec, got, e, 0.03f); }
    else if (a.kind == 6) { const int i6 = i; int row = srow(i6); if (l == 1 || DBG_T1) row %= NLAT; const int j = dhash(i6 + 5) % 2048; const bf16_t* hr = (const bf16_t*)(ws + WS_H) + (size_t)row * D;
        const float z = dot_hw(hr, a.in[8] + (size_t)l * D * DIN + 4096 + j, D, DIN); const size_t gi_ = (size_t)row * PW + PC_GA + j; const unsigned gw_ = __hip_atomic_load((unsigned*)P + (gi_ >> 1), __ATOMIC_RELAXED, __HIP_MEMORY_SCOPE_AGENT);
        const float gt_ = (gi_ & 1) ? bfhi(gw_) : bflo(gw_), ex_ = 1.f / (1.f + expf(-z)); rec_err(ws, a.id, gt_, ex_, 0.01f);
        if (fabsf(gt_ - ex_) > 0.15f * ex_ + 0.05f) { atomicAdd((unsigned*)(ws + DBG_ERR) + 192 + (fabsf(gt_ - 100.f) < 1.f ? 0 : (gt_ < 0.f || gt_ > 1.f) ? 1 : 2), 1u); atomicAdd((unsigned*)(ws + DBG_ERR) + 196 + ((row >> 8) & 3), 1u); } }
    else if (a.kind == 7) { int row = srow(i); if (l == 1) row %= NLAT; const int n = dhash(i + 5) % D; const bf16_t* pr = P + (size_t)row * PW;
        const float ya = dot_hw(pr + PC_Q, a.in[17] + (size_t)l * 512 * D + n, 512, D), yr = dot_hw(pr + PC_LF, a.in[18] + (size_t)l * 512 * D + n, 512, D);
        rec_err(ws, a.id, bf2f(((const bf16_t*)(ws + WS_MERGED))[(size_t)row * D + n]), bf2f(pr[PC_GA + n]) * ya + bf2f(pr[PC_GR + n]) * yr, 0.03f); }
    else if (a.kind == 8 || a.kind == 10) { int row = srow(i); if (l == 1) row %= NLAT; const int col = dhash(i + 5) % D; const int msel = a.kind == 8 ? 2 : 5;
        float xin; if (a.kind == 8 && l == 0) xin = xrowp(a.in[0], a.in[2], row)[col]; else xin = ((const float*)(ws + DBG_SNAPX))[i];
        float y; if (a.kind == 8) y = dot_hw((const bf16_t*)(ws + WS_MERGED) + (size_t)row * D, a.in[19] + (size_t)l * D * D + col, D, D);
        else y = dot_hw((const bf16_t*)(ws + WS_HID) + (size_t)row * DFFP, a.in[22] + col, DFF, D);
        const float e = xin + mods[(size_t)(row < NLAT ? row >> 11 : 32) * DIN + msel * D + col] * y;
        rec_err(ws, a.id, xrowp(a.out, (const float*)(ws + WS_CTXRES), row)[col], e, 0.03f); }
    else if (a.kind == 9) { const int row = srow(i), j = dhash(i + 5) % DFF; const bf16_t* hr = (const bf16_t*)(ws + WS_H) + (size_t)row * D;
        const float u = dot_hw(hr, a.in[20] + j, D, DFF), v = dot_hw(hr, a.in[21] + j, D, DFF); rec_err(ws, a.id, bf2f(((const bf16_t*)(ws + WS_HID))[(size_t)row * DFFP + j]), dsilu(u) * v, 0.03f); }
    else if (a.kind == 11) { const int row = dhash(i) % NLAT; const float* xr = a.out + (size_t)row * D; float ss = 0.f; for (int k = 0; k < D; ++k) ss += xr[k] * xr[k];
        const float rstd = 1.f / sqrtf(ss / D + EPS); const float* mv = mods + (size_t)(row >> 11) * DIN; float lg[8]; for (int e = 0; e < 8; ++e) lg[e] = 0.f;
        for (int k = 0; k < D; ++k) { const float h = xr[k] * rstd * a.in[7][D + k] * (1.f + mv[4 * D + k]) + mv[3 * D + k]; for (int e = 0; e < 8; ++e) lg[e] += h * a.in[23][k * 8 + e]; }
        int e1 = 0; for (int e = 1; e < 8; ++e) if (lg[e] > lg[e1]) e1 = e; int e2 = e1 == 0 ? 1 : 0; for (int e = 0; e < 8; ++e) if (e != e1 && lg[e] > lg[e2]) e2 = e;
        const int* rt = (const int*)(ws + WS_ROUTE + (size_t)row * 24); const float g1 = 1.f / (1.f + expf(lg[e2] - lg[e1]));
        const float margin = lg[e2] - fmaxf(-1e30f, [&]{ float m = -1e30f; for (int e = 0; e < 8; ++e) if (e != e1 && e != e2) m = fmaxf(m, lg[e]); return m; }());
        if (margin > 1e-3f && lg[e1] - lg[e2] > 1e-3f) { rec_err(ws, a.id, (float)rt[0], (float)e1, 0.01f); rec_err(ws, a.id, (float)rt[1], (float)e2, 0.01f); rec_err(ws, a.id, ((const float*)rt)[2], g1, 0.01f); rec_err(ws, a.id, ((const float*)rt)[3], 1.f - g1, 0.01f); } }
    else if (a.kind == 12) { const int row = dhash(i) % NLAT; const int* rt = (const int*)(ws + WS_ROUTE + (size_t)row * 24); const int* pb = (const int*)(ws + WS_CNT) + 4096;
        for (int w = 0; w < 2; ++w) { const int s = rt[4 + w], e = rt[w]; const int pan = s >> 8; int ee = 0; for (int k = 1; k < 8; ++k) ee += pan >= pb[k];
            rec_err(ws, a.id, (float)ee, (float)e, 0.01f); if (s < 0 || s >= pb[8] * 256) rec_err(ws, a.id, 1.f, 0.f, 0.01f);
            const int col = dhash(i + 31 + w) % D; rec_err(ws, a.id, bf2f(((const bf16_t*)(ws + WS_AG))[(size_t)s * D + col]), bf2f(((const bf16_t*)(ws + WS_H2M))[(size_t)row * D + col]), 1e-6f); } }
    else if (a.kind == 14) { int row = srow(i & 15); if (l == 1) row %= NLAT; const int hh = (i >> 4) & 3; const bf16_t* of = (const bf16_t*)(ws + DBG_OF) + (size_t)(i & 15) * 512 + hh * 128; const bf16_t* pr = P + (size_t)row * PW;
        float ss = 0.f; for (int v = 0; v < 128; ++v) { const float o = bf2f(of[v]) + bf2f(pr[PC_LB + hh * 128 + v]); ss += o * o; }
        const float rs = 1.f / sqrtf(ss / 128.f + EPS); const int v = dhash(i) % 128;
        rec_err(ws, a.id, bf2f(pr[PC_LF + hh * 128 + v]), (bf2f(of[v]) + bf2f(pr[PC_LB + hh * 128 + v])) * rs * a.in[14][l * 128 + v] * bf2f(pr[PC_G + hh * 128 + v]), 0.03f); }
}
__global__ void dbg_snap(DArgs a) {
    unsigned char* ws = a.ws; const int l = a.l; const int i = blockIdx.x * blockDim.x + threadIdx.x; const bf16_t* P = (const bf16_t*)(ws + WS_P);
    if (a.kind == 8 || a.kind == 10) { int row = srow(i); if (l == 1) row %= NLAT; const int col = dhash(i + 5) % D; ((float*)(ws + DBG_SNAPX))[i] = xrowp(a.out, (const float*)(ws + WS_CTXRES), row)[col]; }
    else if (a.kind == 20) { const int ch = blockIdx.x >> 1, dir = blockIdx.x & 1, b = (ch * 5 + 3) % NB, h = (ch + (ch >> 2)) & 3;
        bf16_t* dst = (bf16_t*)(ws + DBG_LF) + (size_t)blockIdx.x * 2304 * 128;
        for (int s = 0; s < 2304; ++s) { const int row = s < 256 ? NLAT + b * CL + s : b * T + (s - 256); dst[(size_t)s * 128 + threadIdx.x] = P[(size_t)row * PW + (dir ? PC_LB : PC_LF) + h * 128 + threadIdx.x]; } }
    else if (a.kind == 21) { const int smp = blockIdx.x; int row = a.aux ? NLAT + (int)(dhash(smp) % NCTX) : (int)(dhash(smp) % NLAT); const int h = smp & 3;
        ((bf16_t*)(ws + DBG_Q))[(a.aux * 1024 + smp) * 128 + threadIdx.x] = P[(size_t)row * PW + PC_Q + h * 128 + threadIdx.x]; }
    else if (a.kind == 22) { int row = srow(blockIdx.x); if (l == 1) row %= NLAT; for (int c = threadIdx.x; c < 512; c += blockDim.x) ((bf16_t*)(ws + DBG_OF))[blockIdx.x * 512 + c] = P[(size_t)row * PW + PC_LF + c]; }
    else if (a.kind == 40) { for (size_t r = blockIdx.x; r < (size_t)NTOK; r += gridDim.x) for (int c = threadIdx.x; c < 256; c += blockDim.x) ((u32x4*)(P + r * PW + 2048))[c] = (u32x4){0x42C842C8u, 0x42C842C8u, 0x42C842C8u, 0x42C842C8u}; }
    else if (a.kind == 23) { const int row = dhash(blockIdx.x) % NLAT; for (int c = threadIdx.x; c < D; c += blockDim.x) ((float*)(ws + DBG_ROWS))[blockIdx.x * D + c] = a.out[(size_t)row * D + c]; }
}
__global__ void dbg_scan(DArgs a) {
    extern __shared__ float Scol[];
    unsigned char* ws = a.ws; const int l = a.l; const int ch = blockIdx.x >> 1, dir = blockIdx.x & 1, b = (ch * 5 + 3) % NB, h = (ch + (ch >> 2)) & 3, v = threadIdx.x; const bf16_t* P = (const bf16_t*)(ws + WS_P);
    const _Float16* lfs = (const _Float16*)(ws + DBG_LF) + (size_t)blockIdx.x * 2304 * 128;
    for (int d = 0; d < 128; ++d) Scol[d * 128 + v] = 0.f;
    for (int st = 0; st < 2304; ++st) {
        int s, row; if (st < 256) { s = dir ? 255 - st : st; row = NLAT + b * CL + s; } else { const int tt = dir ? 2047 - (st - 256) : st - 256; s = 256 + tt; row = b * T + tt; }
        const bf16_t* pr = P + (size_t)row * PW; const float val = bf2f(pr[PC_RI + h * 128 + v]); float o = 0.f;
        for (int d = 0; d < 128; ++d) { const float f = expf((float)lfs[(size_t)s * 128 + d]); const float sv = f * Scol[d * 128 + v] + (1.f - f) * val; Scol[d * 128 + v] = sv; o += bf2f(pr[PC_RQ + h * 128 + d]) * sv; }
        if (st >= 256 || l == 0) rec_err(ws, a.id + dir, bf2f(pr[(dir ? PC_LB : PC_LF) + h * 128 + v]), o, 0.3f);
    }
}
__global__ void dbg_attn(DArgs a) {
    __shared__ float red[128];
    unsigned char* ws = a.ws; const int l = a.l; const int smp = blockIdx.x, v = threadIdx.x, h = smp & 3; const bf16_t* P = (const bf16_t*)(ws + WS_P);
    const int row = a.aux ? NLAT + (int)(dhash(smp) % NCTX) : (int)(dhash(smp) % NLAT); const int b = a.aux ? (row - NLAT) / CL : row / T;
    const bf16_t* q = (const bf16_t*)(ws + DBG_Q) + (a.aux * 1024 + smp) * 128; const int nk = a.aux ? 256 : 2304;
    float la = 0.f, lb2 = 0.f; for (int k = 0; k < 64; ++k) { la += a.in[9][l * 64 + k] * a.in[10][l * 64 + k]; lb2 += a.in[11][l * 64 + k] * a.in[12][l * 64 + k]; }
    const float lami = 0.8f - 0.6f * expf(-0.3f * l), lam = expf(la) - expf(lb2) + lami;
    float o[2];
    for (int c = 0; c < 2; ++c) { float m = -1e30f, ls = 0.f, acc = 0.f;
        for (int k = 0; k < nk; ++k) { const int kr = k < 256 ? NLAT + b * CL + k : b * T + (k - 256); const bf16_t* kp = P + (size_t)kr * PW;
            float s = 0.f; for (int d = 0; d < 64; ++d) s += bf2f(q[c * 64 + d]) * bf2f(kp[PC_K + h * 128 + c * 64 + d]);
            const float mn = fmaxf(m, s), al = exp2f(m - mn), pe = exp2f(s - mn); ls = ls * al + pe; acc = acc * al + pe * bf2f(kp[PC_V + h * 128 + v]); m = mn; }
        o[c] = acc / ls; }
    const float ov = o[0] - lam * o[1]; red[v] = ov * ov; __syncthreads();
    for (int st = 64; st > 0; st >>= 1) { if (v < st) red[v] += red[v + st]; __syncthreads(); }
    const float e = ov / sqrtf(red[0] / 128.f + EPS) * a.in[13][l * 128 + v] * (1.f - lami);
    rec_err(ws, a.id, bf2f(P[(size_t)row * PW + PC_Q + h * 128 + v]), e, 0.03f);
}
__global__ void dbg_moey(DArgs a) {
    __shared__ float red[256];
    unsigned char* ws = a.ws; const int smp = blockIdx.x, row = dhash(smp) % NLAT, w = smp & 1; const int* rt = (const int*)(ws + WS_ROUTE + (size_t)row * 24);
    const int e = rt[w], s = rt[4 + w], col = dhash(smp + 99) % D; const bf16_t* hr = (const bf16_t*)(ws + WS_AG) + (size_t)s * D;
    float acc = 0.f;
    for (int j = threadIdx.x; j < DFE; j += 256) { const float u = dot_hw(hr, a.in[24] + (size_t)e * D * DFE + j, D, DFE), vv = dot_hw(hr, a.in[25] + (size_t)e * D * DFE + j, D, DFE);
        acc += rbf(dsilu(u) * vv) * rbf(a.in[26][((size_t)e * DFE + j) * D + col]); }
    red[threadIdx.x] = acc; __syncthreads();
    for (int st = 128; st > 0; st >>= 1) { if (threadIdx.x < st) red[threadIdx.x] += red[threadIdx.x + st]; __syncthreads(); }
    if (threadIdx.x == 0) rec_err(ws, a.id, bf2f(((const bf16_t*)(ws + WS_Y))[(size_t)s * D + col]), red[0], 0.03f);
}
__global__ void dbg_final(DArgs a) {
    __shared__ float red[256];
    unsigned char* ws = a.ws; const int row = dhash(blockIdx.x) % NLAT; const int* rt = (const int*)(ws + WS_ROUTE + (size_t)row * 24); const float g1 = ((const float*)rt)[2], g2 = ((const float*)rt)[3];
    const float* xs = (const float*)(ws + DBG_ROWS) + blockIdx.x * D; const bf16_t* Y = (const bf16_t*)(ws + WS_Y); const float* mv = (const float*)(ws + WS_MODS) + (size_t)(33 + (row >> 11)) * DIN + 5 * D;
    float vals[4], ss = 0.f; for (int q = 0; q < 4; ++q) { const int c = threadIdx.x + 256 * q; vals[q] = xs[c] + mv[c] * (g1 * bf2f(Y[(size_t)rt[4] * D + c]) + g2 * bf2f(Y[(size_t)rt[5] * D + c])); ss += vals[q] * vals[q]; }
    red[threadIdx.x] = ss; __syncthreads();
    for (int st = 128; st > 0; st >>= 1) { if (threadIdx.x < st) red[threadIdx.x] += red[threadIdx.x + st]; __syncthreads(); }
    const float rstd = 1.f / sqrtf(red[0] / D + EPS);
    for (int q = 0; q < 4; ++q) { const int c = threadIdx.x + 256 * q; rec_err(ws, a.id, a.out[(size_t)row * D + c], vals[q] * rstd * a.in[27][c], 0.02f); }
}
__global__ void dbg_finalize(float* out, const unsigned char* ws, int n) {
    const float* err = (const float*)(ws + DBG_ERR); int bad = 0; float ratio = 0.f;
    for (int k = 1; k < 64; ++k) { float r = err[k] / (err[64 + k] + 1e-20f); const unsigned nb = ((const unsigned*)err)[128 + k]; const float thr = (k == 11 || k == 12 || k == 13 || k == 14 || k == 31 || k == 32 || k == 33) ? 3e-4f : 1e-4f; if (r > thr || nb > 0u) { bad = k; ratio = nb > 0u ? fmaxf(r, 1e-4f) : r; break; } }
    if (!bad) { for (int k = 1; k <= 43; ++k) if (k != 34 && err[64 + k] == 0.f) { bad = 30 + k; ratio = 1e-4f; break; } }
    if (!bad) return;
    float m = floorf(-2.f * log10f(fminf(ratio, 1.f))); m = fminf(fmaxf(m, 0.f), 8.f);
    if (bad == 16) { const unsigned* cu = (const unsigned*)err + 192; m = 0.5f * (float)((cu[4] ? 1 : 0) | (cu[5] ? 2 : 0) | (cu[6] ? 4 : 0) | (cu[7] ? 8 : 0)); bad = 48 + ((cu[0] ? 1 : 0) | (cu[1] ? 2 : 0) | (cu[2] ? 4 : 0) | (cu[3] ? 8 : 0)); }
    const float cst = sqrtf((1.f + m)) * powf(10.f, 0.5f * (float)bad);
    for (size_t i = (size_t)blockIdx.x * blockDim.x + threadIdx.x; i < (size_t)n; i += (size_t)gridDim.x * blockDim.x) out[i] = cst;
}
#endif

extern "C" void kernel_launch(void* const* d_in, const int* in_sizes, int n_in, void* d_out, int out_size, void* d_ws, size_t ws_size, hipStream_t stream) {
    static int grid = 0;
    if (grid == 0) {
        if (n_in != 28 || out_size != NLAT * D || ws_size < WS_END) { fprintf(stderr, "kernel_launch: unexpected problem (n_in %d, out %d, ws %zu)\n", n_in, out_size, ws_size); grid = -1; return; }
        int dev = 0, cus = 0, per_cu = 0;
        if (hipGetDevice(&dev) != hipSuccess || hipDeviceGetAttribute(&cus, hipDeviceAttributeMultiprocessorCount, dev) != hipSuccess) { grid = -1; return; }
        if (hipFuncSetAttribute((const void*)fwd_kernel, hipFuncAttributeMaxDynamicSharedMemorySize, LDS_BYTES) != hipSuccess) { fprintf(stderr, "kernel_launch: cannot set %d B dynamic LDS\n", LDS_BYTES); grid = -1; return; }
        if (hipOccupancyMaxActiveBlocksPerMultiprocessor(&per_cu, (const void*)fwd_kernel, 512, LDS_BYTES) != hipSuccess || per_cu < 1) fprintf(stderr, "kernel_launch: occupancy query says %d\n", per_cu);
        (void)hipGetLastError();
        grid = cus;
    }
    if (grid < 0) return;
    (void)hipMemsetAsync((char*)d_ws + WS_CTL, 0, CTL_BYTES, stream);
    Params a{};
    for (int i = 0; i < 28; ++i) a.in[i] = (const float*)d_in[i];
    a.out = (float*)d_out; a.ws = (unsigned char*)d_ws; a.ph_lo = 0; a.ph_hi = NPHASE; a.li = 0; a.pad = 0;
#if !DBG
    hipLaunchKernelGGL(fwd_kernel, dim3(grid), dim3(512), LDS_BYTES, stream, a);
#else
    (void)hipMemsetAsync((char*)d_ws + WS_DBG, 0, 4096, stream);
    DArgs da{}; for (int i = 0; i < 28; ++i) da.in[i] = (const float*)d_in[i]; da.out = (float*)d_out; da.ws = (unsigned char*)d_ws;
    static bool attr = false; if (!attr) { (void)hipFuncSetAttribute((const void*)dbg_scan, hipFuncAttributeMaxDynamicSharedMemorySize, 65536); attr = true; }
#define DCHK(K, ID, AUX, NBLK, NTHR) do { da.kind = (K); da.id = (ID); da.aux = (AUX); hipLaunchKernelGGL(dbg_check, dim3(NBLK), dim3(NTHR), 0, stream, da); } while (0)
#define DSNAP(K, AUX, NBLK, NTHR) do { da.kind = (K); da.aux = (AUX); hipLaunchKernelGGL(dbg_snap, dim3(NBLK), dim3(NTHR), 0, stream, da); } while (0)
    for (int ph = 0; ph < NPHASE; ++ph) {
        const int l = ph >= 10 ? 1 : 0, pb = 1 + 9 * l, base = l == 0 ? 0 : 20, k = ph - pb; da.l = l;
        if (ph >= 1 && ph <= 15 && k == 2) { DSNAP(20, 0, 64, 128); DSNAP(21, 0, 1024, 128); if (l == 0) DSNAP(21, 1, 256, 128); }
        if (ph >= 1 && ph <= 15 && k == 3) { DSNAP(22, 0, 16, 128); }
        if (ph == 15) DSNAP(8, 0, 32, 64);
        if (ph == 9) DSNAP(10, 0, 32, 64);
        if (ph == 19) DSNAP(23, 0, 16, 256);
        a.ph_lo = ph; a.ph_hi = ph + 1; a.li = ph;
        hipLaunchKernelGGL(fwd_kernel, dim3(grid), dim3(512), LDS_BYTES, stream, a);
        if (ph == 0) { DCHK(1, 1, 0, 16, 64); DCHK(30, 1, 0, 256, 64); }
        if (ph >= 1 && ph <= 15) {
            if (k == 0) DCHK(2, base + 2, 0, 32, 64);
            if (k == 1) DCHK(3, base + 3, 0, 128, 64);
            if (k == 2) { da.id = base + 11; hipLaunchKernelGGL(dbg_scan, dim3(64), dim3(128), 65536, stream, da);
                          da.id = base + 13; da.aux = 0; hipLaunchKernelGGL(dbg_attn, dim3(1024), dim3(128), 0, stream, da);
                          if (l == 0) { da.id = 14; da.aux = 1; hipLaunchKernelGGL(dbg_attn, dim3(256), dim3(128), 0, stream, da); } }
            if (k == 3) { DCHK(14, base + 15, 0, 1, 64); DCHK(6, base + 16, 0, 32, 64); }
            if (k == 4) DCHK(7, base + 17, 0, 32, 64);
            if (k == 5) DCHK(8, base + 18, 0, 32, 64);
        }
        if (ph == 7) DCHK(2, 19, 1, 32, 64);
        if (ph == 8) DCHK(9, 20, 0, 32, 64);
        if (ph == 9) DCHK(10, 21, 0, 32, 64);
        if (ph == 16) { DCHK(11, 39, 0, 32, 64); DCHK(2, 40, 2, 32, 64); }
        if (ph == 17) DCHK(12, 41, 0, 32, 64);
        if (ph == 18) { da.id = 42; hipLaunchKernelGGL(dbg_moey, dim3(128), dim3(256), 0, stream, da); }
        if (ph == 19) { da.id = 43; hipLaunchKernelGGL(dbg_final, dim3(16), dim3(256), 0, stream, da); }
    }
    hipLaunchKernelGGL(dbg_finalize, dim3(1024), dim3(256), 0, stream, (float*)d_out, (const unsigned char*)d_ws, out_size);
#endif
}
```

```cpp
#include <hip/hip_runtime.h>
#include <cstdio>
#include <cstdint>

#ifndef DBG
#define DBG 0
#endif

constexpr int D = 1024, NB = 32, T = 2048, CL = 256;
constexpr int NLAT = NB * T, NCTX = NB * CL, NTOK = NLAT + NCTX;
constexpr int PW = 4096;
constexpr int DIN = 6144, DFF = 2752, DFFP = 2816, DFE = 3584, NE = 8;
constexpr float EPS = 1e-6f;
constexpr float LOG2E = 1.4426950408889634f;
constexpr float QSCALE = 0.125f * LOG2E;
constexpr int PC_Q = 0, PC_G = 512, PC_LF = 1024, PC_LB = 1536, PC_K = 2048, PC_V = 2560, PC_RQ = 3072, PC_RI = 3584, PC_GA = 2048, PC_GR = 3072;

constexpr size_t MiB = 1u << 20;
constexpr size_t WS_CTL = 0, CTL_BYTES = 1 * MiB;
constexpr size_t WS_MODS = 1 * MiB;
constexpr size_t WS_LBS = 3 * MiB;
constexpr size_t WS_ROPE = 3 * MiB + 65536;
constexpr size_t WS_ROUTE = 4 * MiB;
constexpr size_t WS_CNT = 6 * MiB;
constexpr size_t WS_DBG = 7 * MiB;
constexpr size_t WS_CTXRES = 8 * MiB;
constexpr size_t WS_WIN = 40 * MiB;
constexpr size_t WS_WIN8 = 56 * MiB;
constexpr size_t WS_H8 = 809 * MiB;
constexpr size_t WS_WUA = 64 * MiB;
constexpr size_t WS_WUR = 66 * MiB;
constexpr size_t WS_WO = 68 * MiB;
constexpr size_t WS_W13 = 72 * MiB;
constexpr size_t WS_W2 = 83 * MiB;
constexpr size_t WS_H = 89 * MiB;
constexpr size_t WS_P = 233 * MiB;
constexpr size_t WS_MERGED = 809 * MiB;
constexpr size_t WS_HID = 233 * MiB;
constexpr size_t WS_WM13 = 8 * MiB;
constexpr size_t WS_WM2 = 120 * MiB;
constexpr size_t WS_AG = 176 * MiB;
constexpr size_t WS_MHID = 436 * MiB;
constexpr size_t WS_Y = 674 * MiB;
constexpr size_t WS_H2M = 896 * MiB;
constexpr size_t WS_END = 1024 * MiB;
constexpr int MOE_CHUNK = 128;

constexpr int CW_BAR = 4096;

#define LAS __attribute__((address_space(3)))
#define GAS __attribute__((address_space(1)))
typedef unsigned short bf16_t;
typedef short bf16x8 __attribute__((ext_vector_type(8)));
typedef short s16x4 __attribute__((ext_vector_type(4)));
typedef _Float16 half8 __attribute__((ext_vector_type(8)));
typedef _Float16 half4 __attribute__((ext_vector_type(4)));
typedef float f32x4 __attribute__((ext_vector_type(4)));
typedef float f32x2 __attribute__((ext_vector_type(2)));
typedef float f32x16 __attribute__((ext_vector_type(16)));
typedef unsigned u32x4 __attribute__((ext_vector_type(4)));
typedef unsigned u32x2 __attribute__((ext_vector_type(2)));
#define DI __device__ __forceinline__
#define LDS_WAIT() asm volatile("s_waitcnt lgkmcnt(0)" ::: "memory")
#define VM_WAIT() asm volatile("s_waitcnt vmcnt(0)" ::: "memory")

typedef __bf16 bf16x2_t __attribute__((ext_vector_type(2)));
DI unsigned cvt_pk_bf16(float lo, float hi) { f32x2 v = {lo, hi}; bf16x2_t b = __builtin_convertvector(v, bf16x2_t); return __builtin_bit_cast(unsigned, b); }
typedef int v8i32 __attribute__((ext_vector_type(8)));
typedef int v4i32 __attribute__((ext_vector_type(4)));
DI unsigned pack_fp8x4(float a, float b, float c, float d) {
    a = fminf(fmaxf(a, -448.f), 448.f); b = fminf(fmaxf(b, -448.f), 448.f); c = fminf(fmaxf(c, -448.f), 448.f); d = fminf(fmaxf(d, -448.f), 448.f);
    int w = 0; w = __builtin_amdgcn_cvt_pk_fp8_f32(a, b, w, false); w = __builtin_amdgcn_cvt_pk_fp8_f32(c, d, w, true); return (unsigned)w; }
DI float bf2f(unsigned short b) { return __uint_as_float(((unsigned)b) << 16); }
DI float bflo(unsigned w) { return __uint_as_float(w << 16); }
DI float bfhi(unsigned w) { return __uint_as_float(w & 0xffff0000u); }
DI float fsilu(float x) { return x * __builtin_amdgcn_rcpf(1.f + __expf(-x)); }
DI float fsigmoid(float x) { return __builtin_amdgcn_rcpf(1.f + __expf(-x)); }
DI float wave_sum(float v) {
#pragma unroll
    for (int o = 1; o < 64; o <<= 1) v += __shfl_xor(v, o);
    return v;
}
DI int crow(int r, int hi) { return (r & 3) + 8 * (r >> 2) + 4 * hi; }

constexpr int LDS_WTAB_OFF = 148480 + 128;
DI int my_tid() {
    extern __shared__ __attribute__((aligned(16))) unsigned char lds_raw[];
    const unsigned hw = (unsigned)__builtin_amdgcn_s_getreg((5 << 11) | 4) & 63u;
    const int w = __builtin_amdgcn_readfirstlane(((volatile LAS int*)((LAS unsigned char*)lds_raw + LDS_WTAB_OFF))[hw]);
    int t = w * 64 + (int)__builtin_amdgcn_mbcnt_hi(~0u, __builtin_amdgcn_mbcnt_lo(~0u, 0u));
    asm volatile("" : "+v"(t)); return t;
}
#define XB_TMO      128
#define XB_XCNT(j)  (256  + 64 * (j))
#define XB_XSUB(j)  (1280 + 64 * (j))
#define XB_XGEN(j)  (2304 + 64 * (j))
#define XB_TOP      3328
#define XB_TOPGEN   3392
#define XCD_BAR_WORDS 3456
#define XB_SPIN_CAP (1u << 22)
DI unsigned xb_ld(unsigned* p)              { return __hip_atomic_load(p, __ATOMIC_RELAXED, __HIP_MEMORY_SCOPE_AGENT); }
DI unsigned xb_add(unsigned* p, unsigned v) { return __hip_atomic_fetch_add(p, v, __ATOMIC_RELAXED, __HIP_MEMORY_SCOPE_AGENT); }
DI unsigned xb_xcc_id() { return (unsigned)__builtin_amdgcn_s_getreg((3 << 11) | 20) & 0xFu; }
#define XB_SPIN(cond, bar) do { unsigned _sp = 0; while (cond) { __builtin_amdgcn_s_sleep(1); \
    if ((++_sp & 255u) == 0u) { if (xb_ld(&(bar)[XB_TMO])) break; if (_sp > XB_SPIN_CAP) { atomicAdd(&(bar)[XB_TMO], 1u); break; } } } } while (0)
struct XcdBarrier { unsigned* bar; unsigned x; volatile LAS unsigned* st; };
DI XcdBarrier xcd_barrier_post(unsigned* bar, volatile LAS unsigned* st) {
    XcdBarrier b; b.bar = bar; b.x = xb_xcc_id(); b.st = st;
    if (my_tid() == 0) (void)xb_add(&bar[XB_XCNT(b.x)], 1u);
    return b;
}
DI void xcd_barrier_complete(unsigned* bar, unsigned x, unsigned& nloc, unsigned& nx) {
    const unsigned G = gridDim.x * gridDim.y * gridDim.z;
    unsigned sum, cnt, mine, sp = 0u;
    for (;;) {
        sum = 0u; cnt = 0u; mine = 0u;
#pragma unroll
        for (unsigned j = 0; j < 16; ++j) { const unsigned c = xb_ld(&bar[XB_XCNT(j)]); sum += c; cnt += (c > 0u) ? 1u : 0u; mine = (j == x) ? c : mine; }
        if (sum == G) break;
        __builtin_amdgcn_s_sleep(1);
        if ((++sp & 255u) == 0u) { if (xb_ld(&bar[XB_TMO])) break; if (sp > XB_SPIN_CAP) { atomicAdd(&bar[XB_TMO], 1u); break; } }
    }
    nloc = mine > 0u ? mine : 1u; nx = cnt > 0u ? cnt : 1u;
}
DI void xcd_barrier(const XcdBarrier& b) {
    asm volatile("s_waitcnt vmcnt(0)" ::: "memory");
    __syncthreads();
    if (my_tid() == 0) {
        unsigned* bar = b.bar;
        __builtin_amdgcn_s_waitcnt(0);
        unsigned nloc = b.st[0], nx = b.st[1];
        if (nloc == 0u) { xcd_barrier_complete(bar, b.x, nloc, nx); b.st[0] = nloc; b.st[1] = nx; }
        const unsigned old = xb_add(&bar[XB_XSUB(b.x)], 1u);
        const unsigned gen = old / nloc;
        if (old + 1u == (gen + 1u) * nloc) {
            __builtin_amdgcn_fence(__ATOMIC_RELEASE, "agent");
            asm volatile("s_waitcnt vmcnt(0)" ::: "memory");
            const unsigned og = xb_add(&bar[XB_TOP], 1u);
            const unsigned tg = og / nx;
            if (og + 1u == (tg + 1u) * nx) xb_add(&bar[XB_TOPGEN], 1u);
            else XB_SPIN(xb_ld(&bar[XB_TOPGEN]) == tg, bar);
            __builtin_amdgcn_fence(__ATOMIC_ACQUIRE, "agent");
            xb_add(&bar[XB_XGEN(b.x)], 1u);
            asm volatile("s_waitcnt vmcnt(0)" ::: "memory");
        } else {
            XB_SPIN(xb_ld(&bar[XB_XGEN(b.x)]) == gen, bar);
            __builtin_amdgcn_fence(__ATOMIC_ACQUIRE, "agent");
            asm volatile("s_waitcnt vmcnt(0)" ::: "memory");
        }
    }
    __syncthreads();
}

namespace pg8 {
constexpr int BM = 256, BK = 64, HALF = 128, HTB = HALF * BK * 2, STAGE_BYTES = 8 * HTB, NXCD = 8, WGM = 8;
__host__ __device__ __forceinline__ int lds_byte(int r, int c) { const int st = (r >> 4) * 2 + (c >> 5), rr = r & 15, cc = c & 31, ob = rr * 64 + cc * 2; return st * 1024 + (ob ^ (((ob >> 9) & 1) << 5)); }
__host__ __device__ __forceinline__ void stage_rc(int b, int& R, int& C) { const int st = b / 1024, sb = b % 1024, swz = sb ^ (((sb >> 9) & 1) << 5); R = (st >> 1) * 16 + swz / 64; C = (st & 1) * 32 + (swz % 64) / 2; }
__host__ __device__ __forceinline__ int perm32(int rho) { const int n = rho >> 4, i = rho & 15; return 8 * (i >> 2) + 4 * n + (i & 3); }

struct Unit { int pm, pn; const char* a; const char* b; };
struct Gemm { const bf16_t* A; const bf16_t* Bt; int M, N, K, lda; };

struct StaticOrder {
    int nM, nN, nwg, G, c;
    DI void init(const Gemm& g, int G_, int c_) { nM = g.M / BM; nN = g.N / BM; nwg = nM * nN; G = G_; c = c_; }
    DI bool tile(int i, int& pm, int& pn) const {
        const int L = i * G + c; if (L >= nwg) return false;
        int wgid = L; { const int q = nwg / NXCD, r = nwg % NXCD, xcd = wgid % NXCD, off = wgid / NXCD; wgid = (xcd < r ? xcd * (q + 1) : r * (q + 1) + (xcd - r) * q) + off; }
        const int nig = WGM * nN, gid = wgid / nig, fm = gid * WGM, gsz = (nM - fm) < WGM ? (nM - fm) : WGM;
        pm = fm + ((wgid % nig) % gsz); pn = (wgid % nig) / gsz; return true;
    }
    DI bool next(const Gemm& g, int i, Unit& u) const { if (!tile(i, u.pm, u.pn)) return false;
        u.a = (const char*)g.A + (size_t)u.pm * ((size_t)BM * g.lda * 2); u.b = (const char*)g.Bt + (size_t)u.pn * ((size_t)BM * g.K * 2); return true; }
};
struct MoeOrder {
    StaticOrder so; int p0, apan0; const int* pbv; size_t estride;
    DI bool next(const Gemm& g, int i, Unit& u) const {
        int pm, pn; if (!so.tile(i, pm, pn)) return false;
        u.pm = p0 + pm; u.pn = pn; int e = 0;
#pragma unroll
        for (int k = 1; k < 8; ++k) e += (u.pm >= __builtin_amdgcn_readfirstlane(pbv[k])) ? 1 : 0;
        u.a = (const char*)g.A + (size_t)(u.pm - apan0) * ((size_t)BM * g.lda * 2); u.b = (const char*)g.Bt + (size_t)e * estride + (size_t)pn * ((size_t)BM * g.K * 2); return true;
    }
};

template <class Epi, class Sched, bool ALIGN_EPI = true, bool F8 = false>
DI void gemm_phase(LAS unsigned char* lds, const Gemm g, const Sched& S, const Epi& E) {
    const int tid_ = my_tid();
    const int tid = tid_, wid = __builtin_amdgcn_readfirstlane(tid >> 6), lane = tid & 63, wr = wid >> 2, wc = wid & 3, fr = lane & 15, fq = lane >> 4;
    const int K = g.K, nt = K / BK;
    unsigned voffA[2], voffB[2];
#pragma unroll
    for (int i = 0; i < 2; ++i) { int R, C; stage_rc(tid * 16 + i * 8192, R, C); const int Rb = Epi::PERM ? ((R & ~31) + perm32(R & 31)) : R;
        voffA[i] = (unsigned)(R * g.lda + C) * 2u; voffB[i] = (unsigned)(Rb * K + C) * 2u; }
    const size_t kstep = (size_t)(BK * 2);
    const size_t hstepA = (size_t)HALF * g.lda * 2, hstepB = (size_t)HALF * K * 2;
    const unsigned ldsw = (unsigned)wid * 1024u;
    const int aoff = lds_byte(wr * 64 + fr, fq * 8), boff = lds_byte(wc * 32 + fr, fq * 8);
#define PG8_SA(b, h) (((b) * 2 + (h)) * HTB)
#define PG8_SB(b, h) ((4 + (b) * 2 + (h)) * HTB)
#define PG8_STAGE(bufoff, gbase, voff) do { _Pragma("unroll") for (int _i = 0; _i < 2; ++_i) \
        __builtin_amdgcn_global_load_lds((const unsigned*)((const char*)(gbase) + (voff)[_i]), (LAS unsigned*)(lds + (bufoff) + ldsw + _i * 8192), 16, 0, 0); } while (0)
#define PG8_LD8(p) __builtin_shufflevector(*(const LAS v4i32*)(p), *(const LAS v4i32*)((p) + 1024), 0, 1, 2, 3, 4, 5, 6, 7)
#define PG8_LDA(dst, b, h) do { if constexpr (F8) { _Pragma("unroll") for (int m = 0; m < 4; ++m) dst##8[m] = PG8_LD8(lds + PG8_SA(b, h) + aoff + m * 2048); } \
        else { _Pragma("unroll") for (int m = 0; m < 4; ++m) _Pragma("unroll") for (int k = 0; k < 2; ++k) dst[m][k] = *(const LAS bf16x8*)(lds + PG8_SA(b, h) + aoff + m * 2048 + k * 1024); } } while (0)
#define PG8_LDB(dst, b, h) do { if constexpr (F8) { _Pragma("unroll") for (int n = 0; n < 2; ++n) dst##8[n] = PG8_LD8(lds + PG8_SB(b, h) + boff + n * 2048); } \
        else { _Pragma("unroll") for (int n = 0; n < 2; ++n) _Pragma("unroll") for (int k = 0; k < 2; ++k) dst[n][k] = *(const LAS bf16x8*)(lds + PG8_SB(b, h) + boff + n * 2048 + k * 1024); } } while (0)
#define PG8_MMA(ai, bj, At, Bt) do { __builtin_amdgcn_s_setprio(1); \
        if constexpr (F8) { _Pragma("unroll") for (int m = 0; m < 4; ++m) _Pragma("unroll") for (int n = 0; n < 2; ++n) \
            asm volatile("v_mfma_scale_f32_16x16x128_f8f6f4 %0, %1, %2, %0, %3, %3 op_sel_hi:[0,0,0]" : "+v"(acc[ai][bj][m][n]) : "v"(Bt##8[n]), "v"(At##8[m]), "v"(one8)); } \
        else { _Pragma("unroll") for (int m = 0; m < 4; ++m) _Pragma("unroll") for (int n = 0; n < 2; ++n) _Pragma("unroll") for (int k = 0; k < 2; ++k) \
            acc[ai][bj][m][n] = __builtin_amdgcn_mfma_f32_16x16x32_bf16(Bt[n][k], At[m][k], acc[ai][bj][m][n], 0, 0, 0); } \
        __builtin_amdgcn_s_setprio(0); } while (0)
#define PG8_WAIT_V(n) asm volatile("s_waitcnt vmcnt(" #n ")" ::: "memory")
#define PG8_WAIT_L(n) asm volatile("s_waitcnt lgkmcnt(" #n ")" ::: "memory")
#define PG8_BAR __builtin_amdgcn_s_barrier()
#define PG8_SCHED __builtin_amdgcn_sched_barrier(0)
    Unit cur, nxt; int ui = 0;
    if (!S.next(g, 0, cur)) return;
    f32x4 acc[2][2][4][2];
#pragma unroll
    for (int a = 0; a < 2; ++a)
#pragma unroll
        for (int b = 0; b < 2; ++b)
#pragma unroll
            for (int m = 0; m < 4; ++m)
#pragma unroll
                for (int n = 0; n < 2; ++n) acc[a][b][m][n] = (f32x4){0.f, 0.f, 0.f, 0.f};
    bf16x8 At[4][2], B0[2][2], B1[2][2]; v8i32 At8[4], B08[2], B18[2]; const int one8 = 0x7F7F7F7F;
    const char* cA = cur.a; const char* cB = cur.b;
    PG8_STAGE(PG8_SB(0, 0), cB, voffB); PG8_STAGE(PG8_SB(0, 1), cB + hstepB, voffB); PG8_STAGE(PG8_SA(0, 0), cA, voffA); PG8_STAGE(PG8_SA(0, 1), cA + hstepA, voffA);
    if (wr == 1) PG8_BAR;
    PG8_WAIT_V(2); PG8_BAR;
    PG8_STAGE(PG8_SB(1, 0), cB + kstep, voffB); PG8_STAGE(PG8_SA(1, 0), cA + kstep, voffA); PG8_STAGE(PG8_SB(1, 1), cB + hstepB + kstep, voffB);
    PG8_WAIT_V(6); PG8_BAR;
    for (;;) {
        const bool has_next = S.next(g, ui + 1, nxt);
        const char* nA = has_next ? nxt.a : cA; const char* nB = has_next ? nxt.b : cB;
        for (int t = 0; t < nt; t += 2) {
            const bool last = (t == nt - 2);
            const char* a1 = cA + (size_t)(t + 1) * kstep;
            const char* a2 = last ? nA : cA + (size_t)(t + 2) * kstep; const char* b2 = last ? nB : cB + (size_t)(t + 2) * kstep;
            const char* a3 = a2 + kstep; const char* b3 = b2 + kstep;
            PG8_LDB(B0, 0, 0); PG8_LDB(B1, 0, 1); PG8_SCHED; PG8_LDA(At, 0, 0); PG8_STAGE(PG8_SA(1, 1), a1 + hstepA, voffA);
            PG8_WAIT_V(8); PG8_WAIT_L(0); PG8_BAR; PG8_MMA(0, 0, At, B0); PG8_MMA(0, 1, At, B1); PG8_BAR; PG8_SCHED;
            PG8_LDA(At, 0, 1); PG8_STAGE(PG8_SB(0, 0), b2, voffB); PG8_STAGE(PG8_SB(0, 1), b2 + hstepB, voffB); PG8_STAGE(PG8_SA(0, 0), a2, voffA);
            PG8_WAIT_V(8); PG8_WAIT_L(0); PG8_BAR; PG8_MMA(1, 0, At, B0); PG8_MMA(1, 1, At, B1); PG8_BAR; PG8_SCHED;
            PG8_LDB(B0, 1, 0); PG8_LDB(B1, 1, 1); PG8_SCHED; PG8_LDA(At, 1, 0); PG8_STAGE(PG8_SA(0, 1), a2 + hstepA, voffA);
            PG8_WAIT_V(8); PG8_WAIT_L(0); PG8_BAR; PG8_MMA(0, 0, At, B0); PG8_MMA(0, 1, At, B1); PG8_BAR; PG8_SCHED;
            PG8_LDA(At, 1, 1); PG8_STAGE(PG8_SB(1, 0), b3, voffB); PG8_STAGE(PG8_SB(1, 1), b3 + hstepB, voffB); PG8_STAGE(PG8_SA(1, 0), a3, voffA);
            PG8_WAIT_V(8); PG8_WAIT_L(0); PG8_BAR; PG8_MMA(1, 0, At, B0); PG8_MMA(1, 1, At, B1); PG8_BAR; PG8_SCHED;
        }
        if constexpr (ALIGN_EPI) { if (wr == 0) PG8_BAR; }
        if constexpr (F8) asm volatile("s_nop 15\n\ts_nop 15" ::: "memory");
        E(acc, cur, wr, wc, fr, fq);
        if (!has_next) break;
#pragma unroll
        for (int a = 0; a < 2; ++a)
#pragma unroll
            for (int b = 0; b < 2; ++b)
#pragma unroll
                for (int m = 0; m < 4; ++m)
#pragma unroll
                    for (int n = 0; n < 2; ++n) acc[a][b][m][n] = (f32x4){0.f, 0.f, 0.f, 0.f};
        cur = nxt; cA = nA; cB = nB; ++ui;
        if constexpr (ALIGN_EPI) { if (wr == 1) PG8_BAR; }
    }
    PG8_WAIT_V(0);
    if constexpr (!ALIGN_EPI) { if (wr == 0) PG8_BAR; }
    PG8_BAR;
#undef PG8_SA
#undef PG8_SB
#undef PG8_STAGE
#undef PG8_LDA
#undef PG8_LD8
#undef PG8_LDB
#undef PG8_MMA
#undef PG8_WAIT_V
#undef PG8_WAIT_L
#undef PG8_BAR
#undef PG8_SCHED
}
}
using pg8::Unit; using pg8::Gemm;
typedef const f32x4 (&AccRef)[2][2][4][2];

DI u32x4 pack8(const f32x4& v0, const f32x4& v1) { u32x4 w; w.x = cvt_pk_bf16(v0[0], v0[1]); w.y = cvt_pk_bf16(v0[2], v0[3]); w.z = cvt_pk_bf16(v1[0], v1[1]); w.w = cvt_pk_bf16(v1[2], v1[3]); return w; }
DI void unpack8(const u32x4& w, float (&f)[8]) { f[0] = bflo(w.x); f[1] = bfhi(w.x); f[2] = bflo(w.y); f[3] = bfhi(w.y); f[4] = bflo(w.z); f[5] = bfhi(w.z); f[6] = bflo(w.w); f[7] = bfhi(w.w); }

struct EpiInProj {
    static constexpr bool PERM = true;
    bf16_t* P; const float2* rope; const float* lbf; const float* lbb; int secmap; float asc;
    DI void operator()(AccRef acc, const Unit& u, int wr, int wc, int fr, int fq) const {
        const int row0 = u.pm * 256 + wr * 64 + fr, sec = (secmap >> (4 * (u.pn >> 1))) & 15;
        const int col0 = sec * 512 + (u.pn & 1) * 256 + wc * 32 + 8 * fq;
        const bool lat = u.pm < (NLAT / 256);
#pragma unroll
        for (int ai = 0; ai < 2; ++ai)
#pragma unroll
            for (int m = 0; m < 4; ++m) {
                const int row = row0 + ai * 128 + m * 16; bf16_t* rowp = P + (size_t)row * PW + col0;
#pragma unroll
                for (int bj = 0; bj < 2; ++bj) {
                    f32x4 v0 = acc[ai][bj][m][0] * asc, v1 = acc[ai][bj][m][1] * asc; u32x4 w;
                    if (sec == 0 || sec == 4) {
                        if (lat) {
                            const int pi = ((col0 + bj * 128) & 63) >> 1;
                            const f32x4* rp = (const f32x4*)(rope + (size_t)(row & (T - 1)) * 32 + pi);
                            const f32x4 r0 = rp[0], r1 = rp[1];
                            f32x4 o0, o1;
                            o0[0] = v0[0] * r0[0] - v0[1] * r0[1]; o0[1] = v0[0] * r0[1] + v0[1] * r0[0];
                            o0[2] = v0[2] * r0[2] - v0[3] * r0[3]; o0[3] = v0[2] * r0[3] + v0[3] * r0[2];
                            o1[0] = v1[0] * r1[0] - v1[1] * r1[1]; o1[1] = v1[0] * r1[1] + v1[1] * r1[0];
                            o1[2] = v1[2] * r1[2] - v1[3] * r1[3]; o1[3] = v1[2] * r1[3] + v1[3] * r1[2];
                            v0 = o0; v1 = o1;
                        }
                        if (sec == 0) { v0 = v0 * QSCALE; v1 = v1 * QSCALE; }
                        w = pack8(v0, v1);
                    } else if (sec == 1 || sec == 6) {
#pragma unroll
                        for (int j = 0; j < 4; ++j) { v0[j] = fsilu(v0[j]); v1[j] = fsilu(v1[j]); }
                        w = pack8(v0, v1);
                    } else if (sec == 2 || sec == 3) {
                        const float* lb = (sec == 2 ? lbf : lbb) + ((col0 + bj * 128) & 511);
                        const f32x4 b0 = *(const f32x4*)lb, b1 = *(const f32x4*)(lb + 4);
                        half8 hv;
#pragma unroll
                        for (int j = 0; j < 8; ++j) {
                            const float z = j < 4 ? v0[j] : v1[j - 4], b = j < 4 ? b0[j] : b1[j - 4];
                            const float ls = fminf(z, 0.f) - __logf(1.f + __expf(-fabsf(z)));
                            const float lf = b > 0.f ? __logf(b + (1.f - b) * __expf(ls)) : ls;
                            hv[j] = (_Float16)lf;
                        }
                        w = __builtin_bit_cast(u32x4, hv);
                    } else w = pack8(v0, v1);
                    *(u32x4*)(rowp + bj * 128) = w;
                }
            }
    }
};
struct EpiGates {
    static constexpr bool PERM = true; bf16_t* P; float asc;
    DI void operator()(AccRef acc, const Unit& u, int wr, int wc, int fr, int fq) const {
        const int row0 = u.pm * 256 + wr * 64 + fr, col0 = PC_GA + u.pn * 256 + wc * 32 + 8 * fq;
#pragma unroll
        for (int ai = 0; ai < 2; ++ai)
#pragma unroll
            for (int m = 0; m < 4; ++m) { bf16_t* rowp = P + (size_t)(row0 + ai * 128 + m * 16) * PW + col0;
#pragma unroll
                for (int bj = 0; bj < 2; ++bj) { f32x4 v0 = acc[ai][bj][m][0] * asc, v1 = acc[ai][bj][m][1] * asc;
#pragma unroll
                    for (int j = 0; j < 4; ++j) { v0[j] = fsigmoid(v0[j]); v1[j] = fsigmoid(v1[j]); }
                    *(u32x4*)(rowp + bj * 128) = pack8(v0, v1); } }
    }
};
template <bool FIRST> struct EpiMerge {
    static constexpr bool PERM = true; const bf16_t* P; int gcol; bf16_t* O;
    DI void operator()(AccRef acc, const Unit& u, int wr, int wc, int fr, int fq) const {
        const int row0 = u.pm * 256 + wr * 64 + fr, col0 = u.pn * 256 + wc * 32 + 8 * fq;
#pragma unroll
        for (int ai = 0; ai < 2; ++ai)
#pragma unroll
            for (int m = 0; m < 4; ++m) { const size_t row = (size_t)(row0 + ai * 128 + m * 16);
#pragma unroll
                for (int bj = 0; bj < 2; ++bj) {
                    const u32x4 gw = *(const u32x4*)(P + row * PW + gcol + col0 + bj * 128); float g[8]; unpack8(gw, g);
                    f32x4 v0 = acc[ai][bj][m][0], v1 = acc[ai][bj][m][1];
                    bf16_t* op = O + row * D + col0 + bj * 128;
                    float pv[8];
                    if (!FIRST) { const u32x4 ow = *(const u32x4*)op; unpack8(ow, pv); }
#pragma unroll
                    for (int j = 0; j < 4; ++j) { v0[j] = v0[j] * g[j] + (FIRST ? 0.f : pv[j]); v1[j] = v1[j] * g[4 + j] + (FIRST ? 0.f : pv[4 + j]); }
                    *(u32x4*)op = pack8(v0, v1); } }
    }
};
struct EpiResid {
    static constexpr bool PERM = false;
    const float* xin_l; const float* xin_c; float* xout_l; float* xout_c; const float* mods; int msel;
    DI void operator()(AccRef acc, const Unit& u, int wr, int wc, int fr, int fq) const {
        const bool lat = u.pm < (NLAT / 256);
        const int rbase = (lat ? u.pm : u.pm - NLAT / 256) * 256 + wr * 64 + fr, col0 = u.pn * 256 + wc * 32 + 4 * fq;
        const float* xi = lat ? xin_l : xin_c; float* xo = lat ? xout_l : xout_c;
        const float* mv = mods + (size_t)(lat ? (u.pm >> 3) : 32) * DIN + msel * D + col0;
        f32x4 g[2][2];
#pragma unroll
        for (int bj = 0; bj < 2; ++bj)
#pragma unroll
            for (int n = 0; n < 2; ++n) g[bj][n] = *(const f32x4*)(mv + bj * 128 + n * 16);
#pragma unroll
        for (int ai = 0; ai < 2; ++ai)
#pragma unroll
            for (int m = 0; m < 4; ++m) { const size_t off = (size_t)(rbase + ai * 128 + m * 16) * D + col0;
#pragma unroll
                for (int bj = 0; bj < 2; ++bj)
#pragma unroll
                    for (int n = 0; n < 2; ++n) { const f32x4 xv = *(const f32x4*)(xi + off + bj * 128 + n * 16);
                        *(f32x4*)(xo + off + bj * 128 + n * 16) = xv + g[bj][n] * acc[ai][bj][m][n]; } }
    }
};
struct EpiSwiglu {
    static constexpr bool PERM = true; bf16_t* Hd; int ldh; int pan0;
    DI void operator()(AccRef acc, const Unit& u, int wr, int wc, int fr, int fq) const {
        const int row0 = (u.pm - pan0) * 256 + wr * 64 + fr, hc0 = u.pn * 128 + wc * 16 + 4 * fq;
#pragma unroll
        for (int ai = 0; ai < 2; ++ai)
#pragma unroll
            for (int m = 0; m < 4; ++m) { bf16_t* rowp = Hd + (size_t)(row0 + ai * 128 + m * 16) * ldh + hc0;
#pragma unroll
                for (int bj = 0; bj < 2; ++bj) { const f32x4 a = acc[ai][bj][m][0], b = acc[ai][bj][m][1];
                    u32x2 w; w.x = cvt_pk_bf16(fsilu(a[0]) * b[0], fsilu(a[1]) * b[1]); w.y = cvt_pk_bf16(fsilu(a[2]) * b[2], fsilu(a[3]) * b[3]);
                    *(u32x2*)(rowp + bj * 64) = w; } }
    }
};
struct EpiSwiglu8 {
    static constexpr bool PERM = true; unsigned char* Hd; int ldh; int pan0; float as, hs;
    DI void operator()(AccRef acc, const Unit& u, int wr, int wc, int fr, int fq) const {
        const int row0 = (u.pm - pan0) * 256 + wr * 64 + fr, hc0 = u.pn * 128 + wc * 16 + 4 * fq;
#pragma unroll
        for (int ai = 0; ai < 2; ++ai)
#pragma unroll
            for (int m = 0; m < 4; ++m) { unsigned char* rowp = Hd + (size_t)(row0 + ai * 128 + m * 16) * ldh + hc0;
#pragma unroll
                for (int bj = 0; bj < 2; ++bj) { const f32x4 a = acc[ai][bj][m][0] * as, b = acc[ai][bj][m][1] * (as * hs);
                    *(unsigned*)(rowp + bj * 64) = pack_fp8x4(fsilu(a[0]) * b[0], fsilu(a[1]) * b[1], fsilu(a[2]) * b[2], fsilu(a[3]) * b[3]); } }
    }
};
struct EpiBf16 {
    static constexpr bool PERM = true; bf16_t* O; int ldc; float sc;
    DI void operator()(AccRef acc, const Unit& u, int wr, int wc, int fr, int fq) const {
        const int row0 = u.pm * 256 + wr * 64 + fr, col0 = u.pn * 256 + wc * 32 + 8 * fq;
#pragma unroll
        for (int ai = 0; ai < 2; ++ai)
#pragma unroll
            for (int m = 0; m < 4; ++m) { bf16_t* rowp = O + (size_t)(row0 + ai * 128 + m * 16) * ldc + col0;
#pragma unroll
                for (int bj = 0; bj < 2; ++bj) *(u32x4*)(rowp + bj * 128) = pack8(acc[ai][bj][m][0] * sc, acc[ai][bj][m][1] * sc); }
    }
};

typedef short v4i16 __attribute__((ext_vector_type(4)));
DI s16x4 tr16(const LAS unsigned char* p) { return __builtin_bit_cast(s16x4, __builtin_amdgcn_ds_read_tr16_b64_v4i16((LAS v4i16*)p)); }
DI bf16x8 cat8(s16x4 lo, s16x4 hi) { return __builtin_shufflevector(lo, hi, 0, 1, 2, 3, 4, 5, 6, 7); }
DI void dma16(const void* g, LAS unsigned char* l) { __builtin_amdgcn_global_load_lds((const unsigned*)g, (LAS unsigned*)l, 16, 0, 0); }
DI bf16x8 packf8(const f32x16& x, int s) {
    u32x4 w; w.x = cvt_pk_bf16(x[8 * s], x[8 * s + 1]); w.y = cvt_pk_bf16(x[8 * s + 2], x[8 * s + 3]); w.z = cvt_pk_bf16(x[8 * s + 4], x[8 * s + 5]); w.w = cvt_pk_bf16(x[8 * s + 6], x[8 * s + 7]);
    return __builtin_bit_cast(bf16x8, w);
}
#define MFMA32(a, b, c) __builtin_amdgcn_mfma_f32_32x32x16_bf16((a), (b), (c), 0, 0, 0)

struct Params { const float* in[28]; float* out; unsigned char* ws; int ph_lo, ph_hi, li, pad; };
typedef const __attribute__((address_space(4))) Params* KP;
DI KP kparams() { KP kp = (KP)__builtin_amdgcn_kernarg_segment_ptr(); asm volatile("" : "+s"(kp)); return kp; }
#define PIN(k) (kparams()->in[k])
#define POUT (kparams()->out)
struct Ctx {
    LAS unsigned char* lds; unsigned char* ws; int tid, lane, wave, vcu, G, gw, NGW, bx;
};

constexpr float WIN8_SCALE = 64.f;
#ifndef FP8_SECS
#define FP8_SECS 0x00
#endif
constexpr int SEC_ORDER[8] = {0, 2, 3, 4, 1, 5, 6, 7};
constexpr int sec_slot(int ps) { int nb = 0, nf = 0; for (int i = 0; i < 8; ++i) { const int s_ = SEC_ORDER[i]; const bool f = (FP8_SECS >> s_) & 1; if (s_ == ps) return f ? (0x100 | nf) : nb; if (f) ++nf; else ++nb; } return 0; }
constexpr int N_SEC_F8 = __builtin_popcount(FP8_SECS), N_SEC_BF = 8 - N_SEC_F8;
constexpr unsigned secmap_of(bool f8) { unsigned m = 0; int k = 0; for (int i = 0; i < 8; ++i) { const int s_ = SEC_ORDER[i]; if ((((FP8_SECS >> s_) & 1) != 0) == f8) { m |= (unsigned)s_ << (4 * k); ++k; } } return m; }
DI int map_row(int kind, int n);
DI int map_row4(int n) { return map_row(1, n) & 0xffff; }
DI int map_row(int kind, int n) {
    if (kind == 0) return n;
    if (kind == 4) return map_row4(n);
    if (kind == 2) return 8 * (n >> 2) + (n & 3);
    if (kind == 3) return 8 * (n >> 2) + (n & 3) + 4;
    const int sec = n >> 9, j = n & 511;
    if (n >= 4096) return (1 << 16) | (N_SEC_F8 * 512 + (n - 4096));
    const int ps = sec == 0 ? 0 : sec == 1 ? 4 : sec == 2 ? 5 : sec == 3 ? 6 : sec == 4 ? 7 : sec == 5 ? 2 : sec == 6 ? 3 : 1;
    const int sl = sec_slot(ps); int jj = j;
    if (sec == 0 || sec == 1) { const int hs = j >> 6, d = j & 63; jj = hs * 64 + (d < 32 ? 2 * d : 2 * (d - 32) + 1); }
    return ((sl & 0x100) ? (1 << 16) : 0) | ((sl & 0xff) * 512 + jj);
}
constexpr int TP_PITCH = 68, TP_SCR = 64 * TP_PITCH * 4;
DI void transpose_load(const float* W, int ldw, int k0, int n0, LAS float* scr, int lane) {
    const int r = lane >> 4, c4 = (lane & 15) * 4; f32x4 v[16];
#pragma unroll
    for (int i = 0; i < 16; ++i) v[i] = *(const f32x4*)(W + (size_t)(k0 + 4 * i + r) * ldw + n0 + c4);
#pragma unroll
    for (int i = 0; i < 16; ++i) *(LAS f32x4*)(scr + (4 * i + r) * TP_PITCH + c4) = v[i];
    LDS_WAIT(); asm volatile("" ::: "memory");
}
DI void transpose_item(const float* W, int ldw, int k0, int n0, bf16_t* WT, int ldt, int kind, LAS float* scr, int lane) {
    transpose_load(W, ldw, k0, n0, scr, lane);
    bf16_t* dst = WT + (size_t)map_row(kind, n0 + lane) * ldt + k0;
#pragma unroll
    for (int j = 0; j < 8; ++j) { const LAS float* s = scr + (8 * j) * TP_PITCH + lane;
        u32x4 o; o.x = cvt_pk_bf16(s[0], s[TP_PITCH]); o.y = cvt_pk_bf16(s[2 * TP_PITCH], s[3 * TP_PITCH]); o.z = cvt_pk_bf16(s[4 * TP_PITCH], s[5 * TP_PITCH]); o.w = cvt_pk_bf16(s[6 * TP_PITCH], s[7 * TP_PITCH]);
        *(u32x4*)(dst + 8 * j) = o; }
    LDS_WAIT(); asm volatile("" ::: "memory");
}
DI void transpose_item8(const float* W, int ldw, int k0, int n0, unsigned char* WT, int ldt, int kind, float sc, LAS float* scr, int lane) {
    transpose_load(W, ldw, k0, n0, scr, lane);
    unsigned char* dst = WT + (size_t)map_row(kind, n0 + lane) * ldt + k0;
#pragma unroll
    for (int j = 0; j < 4; ++j) { const LAS float* s = scr + (16 * j) * TP_PITCH + lane; u32x4 o;
        o.x = pack_fp8x4(s[0] * sc, s[TP_PITCH] * sc, s[2 * TP_PITCH] * sc, s[3 * TP_PITCH] * sc); o.y = pack_fp8x4(s[4 * TP_PITCH] * sc, s[5 * TP_PITCH] * sc, s[6 * TP_PITCH] * sc, s[7 * TP_PITCH] * sc);
        o.z = pack_fp8x4(s[8 * TP_PITCH] * sc, s[9 * TP_PITCH] * sc, s[10 * TP_PITCH] * sc, s[11 * TP_PITCH] * sc); o.w = pack_fp8x4(s[12 * TP_PITCH] * sc, s[13 * TP_PITCH] * sc, s[14 * TP_PITCH] * sc, s[15 * TP_PITCH] * sc);
        *(u32x4*)(dst + 16 * j) = o; }
    LDS_WAIT(); asm volatile("" ::: "memory");
}
DI void transpose_matrix8(const Ctx& C, const float* W, int K, int N, unsigned char* WT, int ldt, int kind, float sc, int& itbase) {
    LAS float* scr = (LAS float*)(C.lds + C.wave * TP_SCR);
    const int nblk = N / 64, nit = (K / 64) * nblk;
    int first = (C.gw - (itbase % C.NGW) + C.NGW) % C.NGW;
    for (int it = first; it < nit; it += C.NGW) transpose_item8(W, N, 64 * (it / nblk), 64 * (it % nblk), WT, ldt, kind, sc, scr, C.lane);
    itbase += nit;
}
DI void transpose_matrix(const Ctx& C, const float* W, int K, int N, bf16_t* WT, int ldt, int kind, int& itbase, int total_unused) {
    (void)total_unused;
    LAS float* scr = (LAS float*)(C.lds + C.wave * TP_SCR);
    const int nblk = N / 64, nit = (K / 64) * nblk;
    int first = (C.gw - (itbase % C.NGW) + C.NGW) % C.NGW;
    for (int it = first; it < nit; it += C.NGW) transpose_item(W, N, 64 * (it / nblk), 64 * (it % nblk), WT, ldt, kind, scr, C.lane);
    itbase += nit;
}
DI void transpose_win(const Ctx& C, const float* W, bf16_t* WA, unsigned char* W8, int& itbase) {
    LAS float* scr = (LAS float*)(C.lds + C.wave * TP_SCR);
    const int nblk = DIN / 64, nit = (D / 64) * nblk;
    int first = (C.gw - (itbase % C.NGW) + C.NGW) % C.NGW;
    for (int it = first; it < nit; it += C.NGW) { const int k0 = 64 * (it / nblk), n0 = 64 * (it % nblk);
        if (map_row(1, n0) >> 16) transpose_item8(W, DIN, k0, n0, W8, D, 4, WIN8_SCALE, scr, C.lane);
        else transpose_item(W, DIN, k0, n0, WA, D, 1, scr, C.lane); }
    itbase += nit;
}
DI void phase_prologue(const Ctx& C) {
    unsigned char* ws = C.ws;
    int itb = 0;
    for (int l = 0; l < 2; ++l) {
        transpose_win(C, PIN(8) + (size_t)l * D * DIN, (bf16_t*)(ws + WS_WIN) + (size_t)l * 4096 * D, ws + WS_WIN8 + (size_t)l * 4096 * D, itb);
        transpose_matrix(C, PIN(17) + (size_t)l * 512 * D, 512, D, (bf16_t*)(ws + WS_WUA) + (size_t)l * D * 512, 512, 0, itb, 0);
        transpose_matrix(C, PIN(18) + (size_t)l * 512 * D, 512, D, (bf16_t*)(ws + WS_WUR) + (size_t)l * D * 512, 512, 0, itb, 0);
        transpose_matrix(C, PIN(19) + (size_t)l * D * D, D, D, (bf16_t*)(ws + WS_WO) + (size_t)l * D * D, D, 0, itb, 0);
    }
    transpose_matrix(C, PIN(20), D, DFF, (bf16_t*)(ws + WS_W13), D, 2, itb, 0);
    transpose_matrix(C, PIN(21), D, DFF, (bf16_t*)(ws + WS_W13), D, 3, itb, 0);
    transpose_matrix(C, PIN(22), DFF, D, (bf16_t*)(ws + WS_W2), DFFP, 0, itb, 0);
    { const int gt = C.vcu * 512 + C.tid, NT = C.G * 512;
      bf16_t* w13 = (bf16_t*)(ws + WS_W13) + (size_t)(2 * DFF) * D;
      for (int i = gt; i < (2 * DFFP - 2 * DFF) * D / 8; i += NT) ((u32x4*)w13)[i] = (u32x4){0u, 0u, 0u, 0u};
      bf16_t* w2 = (bf16_t*)(ws + WS_W2);
      for (int i = gt; i < D * (DFFP - DFF) / 8; i += NT) { const int r = i / ((DFFP - DFF) / 8), cc = i % ((DFFP - DFF) / 8); *(u32x4*)(w2 + (size_t)r * DFFP + DFF + cc * 8) = (u32x4){0u, 0u, 0u, 0u}; }
      float2* rope = (float2*)(ws + WS_ROPE);
      for (int i = gt; i < T * 32; i += NT) { const int t = i >> 5, pi = i & 31; const float invf = exp2f(-(float)(pi & 15) * (13.287712379549449f / 16.f));
          const float ang = (float)(pi < 16 ? (t >> 6) : (t & 63)) * invf; rope[i] = make_float2(cosf(ang), sinf(ang)); }
      float* lbs = (float*)(ws + WS_LBS);
      for (int i = gt; i < 2 * 2 * 512; i += NT) { const int l = i >> 10, dir = (i >> 9) & 1, d = i & 511; const float* lb = PIN(dir ? 16 : 15);
          const float p0 = lb[d], p1 = lb[512 + d]; lbs[i] = l == 0 ? 0.f : 1.f / (1.f + expf(p0 - p1)); }
    }
    { float* mods = (float*)(ws + WS_MODS);
      for (int task = C.gw; task < 2 * 33 * 96; task += C.NGW) {
          const int ng = task % 96, r = (task / 96) % 33, l = task / (96 * 33), n = ng * 64 + C.lane;
          const float* cv = r < 32 ? PIN(1) + r * D : PIN(3); const float* W = PIN(4) + (size_t)l * D * DIN + n;
          float acc = PIN(5)[l * DIN + n];
          for (int k0 = 0; k0 < D; k0 += 64) { const float sv = fsilu(cv[k0 + C.lane]);
#pragma unroll 16
              for (int j = 0; j < 64; ++j) acc += __uint_as_float(__builtin_amdgcn_readlane(__float_as_uint(sv), j)) * W[(size_t)(k0 + j) * DIN]; }
          mods[(size_t)(l * 33 + r) * DIN + n] = acc; } }
}
constexpr float W13_SCALE = 64.f, W2_SCALE = 128.f, HID_SCALE = 8.f;
DI void convert_moe_weights(const Ctx& C) {
    unsigned char* ws = C.ws; int itb = 0;
    for (int e = 0; e < NE; ++e) {
        transpose_matrix8(C, PIN(24) + (size_t)e * D * DFE, D, DFE, ws + WS_WM13 + (size_t)e * 2 * DFE * D, D, 2, W13_SCALE, itb);
        transpose_matrix8(C, PIN(25) + (size_t)e * D * DFE, D, DFE, ws + WS_WM13 + (size_t)e * 2 * DFE * D, D, 3, W13_SCALE, itb);
        transpose_matrix8(C, PIN(26) + (size_t)e * DFE * D, DFE, D, ws + WS_WM2 + (size_t)e * D * DFE, DFE, 0, W2_SCALE, itb);
    }
}

template <bool ROUTER>
DI void phase_norm(const Ctx& C, const float* xl, const float* xc, const float* nw, const float* mods, int shsel, int nrows, bf16_t* Hout, const float* rw, unsigned char* route, LAS int* cntL, unsigned char* H8 = nullptr) {
    int nloc = 0;
    f32x4 rwr[4][4][2];
    if (ROUTER) {
#pragma unroll
        for (int j = 0; j < 4; ++j)
#pragma unroll
            for (int q = 0; q < 4; ++q) { const float* rp = rw + (size_t)(256 * j + 4 * C.lane + q) * 8; rwr[j][q][0] = *(const f32x4*)rp; rwr[j][q][1] = *(const f32x4*)(rp + 4); } }
    for (int row = C.gw; row < nrows; row += C.NGW) {
        const bool lat = row < NLAT; const float* xr = lat ? xl + (size_t)row * D : xc + (size_t)(row - NLAT) * D;
        const float* mv = mods + (size_t)(lat ? (row >> 11) : 32) * DIN + shsel * D;
        f32x4 v[4]; float ss = 0.f;
#pragma unroll
        for (int j = 0; j < 4; ++j) { v[j] = *(const f32x4*)(xr + 256 * j + 4 * C.lane); ss += (v[j][0] * v[j][0] + v[j][1] * v[j][1]) + (v[j][2] * v[j][2] + v[j][3] * v[j][3]); }
        const float rstd = 1.0f / sqrtf(wave_sum(ss) * (1.f / D) + EPS);
        float lg[8];
        if (ROUTER) {
#pragma unroll
            for (int e = 0; e < 8; ++e) lg[e] = 0.f; }
#pragma unroll
        for (int j = 0; j < 4; ++j) { const int c0 = 256 * j + 4 * C.lane;
            const f32x4 w = *(const f32x4*)(nw + c0), sh = *(const f32x4*)(mv + c0), sc = *(const f32x4*)(mv + D + c0);
            f32x4 h = (v[j] * rstd) * w * (sc + 1.0f) + sh;
            if (ROUTER) *(unsigned*)((unsigned char*)Hout + (size_t)row * D + c0) = pack_fp8x4(h[0], h[1], h[2], h[3]);
            else { u32x2 o; o.x = cvt_pk_bf16(h[0], h[1]); o.y = cvt_pk_bf16(h[2], h[3]); *(u32x2*)(Hout + (size_t)row * D + c0) = o;
                   if (H8) *(unsigned*)(H8 + (size_t)row * D + c0) = pack_fp8x4(h[0], h[1], h[2], h[3]); }
            if (ROUTER) {
#pragma unroll
                for (int q = 0; q < 4; ++q) { const f32x4 r0 = rwr[j][q][0], r1 = rwr[j][q][1];
                    lg[0] += h[q] * r0[0]; lg[1] += h[q] * r0[1]; lg[2] += h[q] * r0[2]; lg[3] += h[q] * r0[3]; lg[4] += h[q] * r1[0]; lg[5] += h[q] * r1[1]; lg[6] += h[q] * r1[2]; lg[7] += h[q] * r1[3]; } }
        }
        if (ROUTER) {
            const bool b5 = (C.lane & 32) != 0, b4 = (C.lane & 16) != 0, b3 = (C.lane & 8) != 0; float a4[4], a2[2], a1;
#pragma unroll
            for (int j = 0; j < 4; ++j) { const float snd = b5 ? lg[j] : lg[4 + j]; a4[j] = (b5 ? lg[4 + j] : lg[j]) + __shfl_xor(snd, 32); }
#pragma unroll
            for (int j = 0; j < 2; ++j) { const float snd = b4 ? a4[j] : a4[2 + j]; a2[j] = (b4 ? a4[2 + j] : a4[j]) + __shfl_xor(snd, 16); }
            { const float snd = b3 ? a2[0] : a2[1]; a1 = (b3 ? a2[1] : a2[0]) + __shfl_xor(snd, 8); }
            a1 += __shfl_xor(a1, 4); a1 += __shfl_xor(a1, 2); a1 += __shfl_xor(a1, 1);
            if ((C.lane & 7) == 0) ((LAS float*)(C.lds + C.wave * 4096))[nloc * 8 + (C.lane >> 3)] = a1;
            ++nloc;
        }
    }
    if (ROUTER) {
        LDS_WAIT();
        for (int i = C.lane; i < nloc; i += 64) { const int row = C.gw + i * C.NGW; const LAS float* lp = (const LAS float*)(C.lds + C.wave * 4096) + i * 8;
            float lg[8];
#pragma unroll
            for (int e = 0; e < 8; ++e) lg[e] = lp[e];
            int e1 = 0; float l1 = lg[0];
#pragma unroll
            for (int e = 1; e < 8; ++e) if (lg[e] > l1) { l1 = lg[e]; e1 = e; }
            int e2 = -1; float l2 = -INFINITY;
#pragma unroll
            for (int e = 0; e < 8; ++e) if (e != e1 && lg[e] > l2) { l2 = lg[e]; e2 = e; }
            const float g2 = 1.f / (1.f + expf(l1 - l2)), g1 = 1.f - g2;
            int* rt = (int*)(route + (size_t)row * 24); rt[0] = e1; rt[1] = e2; ((float*)rt)[2] = g1; ((float*)rt)[3] = g2;
            atomicAdd((int*)&cntL[e1], 1); atomicAdd((int*)&cntL[e2], 1);
        }
    }
}

constexpr int AT_XCH = 65536;
DI float max3f(float a, float b, float c) { return fmaxf(fmaxf(a, b), c); }
DI void attn_unit(const Ctx& C, bf16_t* P, int qrow0, int krow_ctx, int krow_lat, int nkt, int h, float lam, const float* anw, float post) {
    const int tid_ = my_tid();
    LAS unsigned char* lds = C.lds; const int lane = tid_ & 63, wid = __builtin_amdgcn_readfirstlane(tid_ >> 6), sub = wid >> 2, qw = wid & 3, r32 = lane & 31, hh = lane >> 5;
    const int tq = (lane & 15) >> 2, tp = lane & 3, blk = (lane >> 4) & 1;
    LAS unsigned char* qlds = lds + AT_XCH + wid * 8192 + r32 * 16;
#pragma unroll
    for (int qb = 0; qb < 2; ++qb) { const bf16_t* qp = P + (size_t)(qrow0 + 64 * qw + 32 * qb + r32) * PW + PC_Q + h * 128 + sub * 64 + 8 * hh;
#pragma unroll
      for (int ks = 0; ks < 4; ++ks) *(LAS bf16x8*)(qlds + ((2 * ks + hh) * 64 + 32 * qb) * 16) = *(const bf16x8*)(qp + 16 * ks); }
    f32x16 O[2][4];
#pragma unroll
    for (int qb = 0; qb < 2; ++qb)
#pragma unroll
        for (int c = 0; c < 4; ++c)
#pragma unroll
            for (int i = 0; i < 16; ++i) O[qb][c][i] = 0.f;
    float m_run[2] = {-INFINITY, -INFINITY}, l_run[2] = {0.f, 0.f};
#define AT_ISSUE(kt, buf) do { const int kr0_ = (kt) < 4 ? krow_ctx + (kt) * 64 : krow_lat + ((kt) - 4) * 64; LAS unsigned char* bb_ = lds + (buf) * 32768; \
        _Pragma("unroll") for (int j_ = 0; j_ < 2; ++j_) { const int c_ = 2 * wid + j_; \
            dma16(P + (size_t)(kr0_ + lane) * PW + PC_K + h * 128 + c_ * 8, bb_ + c_ * 1024); \
            dma16(P + (size_t)(kr0_ + 16 * (c_ & 3) + (lane >> 2)) * PW + PC_V + h * 128 + (c_ >> 2) * 32 + (lane & 3) * 8, bb_ + 16384 + c_ * 1024); } } while (0)
    AT_ISSUE(0, 0);
    int buf = 0;
#pragma unroll 1
    for (int kt = 0; kt < nkt; ++kt) {
        VM_WAIT(); __syncthreads();
        if (kt + 1 < nkt) AT_ISSUE(kt + 1, buf ^ 1);
        const LAS unsigned char* kb = lds + buf * 32768, * vb = kb + 16384 + (4 * hh + tq) * 64 + blk * 32 + tp * 8;
        bf16x8 Pf[2][4];
#pragma unroll
        for (int qb = 0; qb < 2; ++qb) {
            f32x16 s0, s1;
#pragma unroll
            for (int i = 0; i < 16; ++i) { s0[i] = 0.f; s1[i] = 0.f; }
#pragma unroll
            for (int ks = 0; ks < 4; ++ks) { const LAS unsigned char* kp = kb + ((sub * 8 + 2 * ks + hh) * 64 + r32) * 16;
                const bf16x8 k0 = *(const LAS bf16x8*)kp, k1 = *(const LAS bf16x8*)(kp + 512);
                const bf16x8 q = *(const LAS bf16x8*)(qlds + ((2 * ks + hh) * 64 + 32 * qb) * 16);
                s0 = MFMA32(k0, q, s0); s1 = MFMA32(k1, q, s1); }
            float mx = max3f(s0[0], s1[0], s0[1]);
#pragma unroll
            for (int i = 1; i < 16; ++i) mx = (i + 1 < 16) ? max3f(mx, s1[i], s0[i + 1]) : fmaxf(mx, s1[i]);
            mx = fmaxf(mx, __shfl_xor(mx, 32));
            const float mnew = fmaxf(m_run[qb], mx);
            if (__any(mnew > m_run[qb])) { const float alpha = __builtin_amdgcn_exp2f(m_run[qb] - mnew); l_run[qb] *= alpha;
#pragma unroll
                for (int c = 0; c < 4; ++c)
#pragma unroll
                    for (int i = 0; i < 16; ++i) O[qb][c][i] *= alpha;
                m_run[qb] = mnew; }
            const float mr = m_run[qb]; float ps0 = 0.f, ps1 = 0.f;
#pragma unroll
            for (int i = 0; i < 16; ++i) { s0[i] = __builtin_amdgcn_exp2f(s0[i] - mr); s1[i] = __builtin_amdgcn_exp2f(s1[i] - mr); ps0 += s0[i]; ps1 += s1[i]; }
            l_run[qb] += ps0 + ps1;
            Pf[qb][0] = packf8(s0, 0); Pf[qb][1] = packf8(s0, 1); Pf[qb][2] = packf8(s1, 0); Pf[qb][3] = packf8(s1, 1);
        }
#pragma unroll
        for (int cb = 0; cb < 4; ++cb) {
#pragma unroll
            for (int s4 = 0; s4 < 4; ++s4) { const bf16x8 a = cat8(tr16(vb + cb * 4096 + s4 * 1024), tr16(vb + cb * 4096 + s4 * 1024 + 512));
                O[0][cb] = MFMA32(a, Pf[0][s4], O[0][cb]); O[1][cb] = MFMA32(a, Pf[1][s4], O[1][cb]); } }
        buf ^= 1;
    }
#undef AT_ISSUE
    LDS_WAIT(); __syncthreads();
    const int te = my_tid(); const int lane_e = te & 63, wid_e = __builtin_amdgcn_readfirstlane(te >> 6);
    LAS float* xch = (LAS float*)(lds + AT_XCH) + (wid_e & 3) * 4096 + lane_e;
#pragma unroll
    for (int qb = 0; qb < 2; ++qb) {
        const float lt = l_run[qb] + __shfl_xor(l_run[qb], 32); const float inv = 1.f / lt;
        if ((wid_e >> 2) == 1) { const float sc = -lam * inv;
#pragma unroll
            for (int c = 0; c < 4; ++c)
#pragma unroll
                for (int i = 0; i < 16; ++i) xch[(c * 16 + i) * 64] = O[qb][c][i] * sc; }
        LDS_WAIT(); __syncthreads();
        if ((wid_e >> 2) == 0) {
            float ss = 0.f;
#pragma unroll
            for (int c = 0; c < 4; ++c)
#pragma unroll
                for (int i = 0; i < 16; ++i) { const float o = O[qb][c][i] * inv + xch[(c * 16 + i) * 64]; O[qb][c][i] = o; ss += o * o; }
            ss += __shfl_xor(ss, 32);
            const float rs = post / sqrtf(ss * (1.f / 128.f) + EPS);
            bf16_t* op = P + (size_t)(qrow0 + 64 * (wid_e & 3) + 32 * qb + (lane_e & 31)) * PW + PC_Q + h * 128;
#pragma unroll
            for (int c = 0; c < 4; ++c)
#pragma unroll
                for (int g = 0; g < 4; ++g) { const int v0 = 32 * c + 8 * g + 4 * (lane_e >> 5); const f32x4 w = *(const f32x4*)(anw + v0);
                    u32x2 o; o.x = cvt_pk_bf16(O[qb][c][4 * g] * rs * w[0], O[qb][c][4 * g + 1] * rs * w[1]); o.y = cvt_pk_bf16(O[qb][c][4 * g + 2] * rs * w[2], O[qb][c][4 * g + 3] * rs * w[3]);
                    *(u32x2*)(op + v0) = o; }
        }
        LDS_WAIT(); __syncthreads();
    }
}

constexpr int SC_Q = 0, SC_LF = 16384, SC_V0 = 32768, SC_QM = 65536, SC_KMR = 81920, SC_KMS = 98304, SC_SX = 114688, SC_A31 = 147456, SC_A63 = 147968, SC_END = 148480;
DI void scan_chain(const Ctx& C, bf16_t* P, int b, int h, int dir, bool store_ctx) {
    const int tid_ = my_tid();
    LAS unsigned char* lds = C.lds; const int lane = tid_ & 63, wid = __builtin_amdgcn_readfirstlane(tid_ >> 6), r32 = lane & 31, hh = lane >> 5;
    const int tq = (lane & 15) >> 2, tp = lane & 3, blk = (lane >> 4) & 1;
    const int db = wid & 3, tb = wid >> 2;
    const int base_nat = hh * 512 + tq * 64 + blk * 32 + tp * 8;
    const int base_prm = (4 * hh + tq) * 64 + blk * 32 + tp * 8;
    const int lfcol = (dir ? PC_LB : PC_LF) + h * 128, qcol = PC_RQ + h * 128, vcol = PC_RI + h * 128;
    f32x16 ST[2];
#pragma unroll
    for (int j = 0; j < 2; ++j)
#pragma unroll
        for (int i = 0; i < 16; ++i) ST[j][i] = 0.f;
#define SROW(c, i) ((c) < 4 ? NLAT + b * CL + (dir ? 255 - ((c) * 64 + (i)) : (c) * 64 + (i)) : b * T + (dir ? 2047 - (((c) - 4) * 64 + (i)) : ((c) - 4) * 64 + (i)))
#define SDMA(c, colbase, dstoff) do { _Pragma("unroll") for (int j_ = 0; j_ < 2; ++j_) { const int I_ = 2 * wid + j_; const int ti_ = 16 * (I_ & 3) + (lane >> 2); \
        dma16(P + (size_t)SROW(c, ti_) * PW + (colbase) + (I_ >> 2) * 32 + (lane & 3) * 8, lds + (dstoff) + I_ * 1024); } } while (0)
    SDMA(0, qcol, SC_Q); SDMA(0, lfcol, SC_LF); SDMA(0, vcol, SC_V0);
    int vbuf = 0;
    const int t = 32 * tb + r32;
#pragma unroll 1
    for (int c = 0; c < 36; ++c) {
        VM_WAIT(); __syncthreads();
        const LAS unsigned char* Vimg = lds + SC_V0 + vbuf * 16384;
        f32x16 cm;
#pragma unroll
        for (int i = 0; i < 16; ++i) cm[i] = 0.f;
#pragma unroll
        for (int kk = 0; kk < 2; ++kk) { const int ks = 2 * tb + kk;
            const half8 a = __builtin_bit_cast(half8, cat8(tr16(lds + SC_LF + db * 4096 + base_nat + ks * 1024), tr16(lds + SC_LF + db * 4096 + base_nat + ks * 1024 + 256)));
            half8 bm;
#pragma unroll
            for (int j = 0; j < 8; ++j) { const int s = 16 * ks + 8 * hh + j; bm[j] = tb == 0 ? (s > t ? (_Float16)-1.f : (_Float16)0.f) : (s <= t ? (_Float16)1.f : (_Float16)0.f); }
            cm = __builtin_amdgcn_mfma_f32_32x32x16_f16(a, bm, cm, 0, 0, 0); }
#pragma unroll
        for (int g = 0; g < 4; ++g) {
            const int sa = db * 4096 + (t >> 3) * 512 + (t & 7) * 64 + (8 * g + 4 * hh) * 2;
            const u32x2 q4 = *(const LAS u32x2*)(lds + SC_Q + sa); const half4 lf4 = *(const LAS half4*)(lds + SC_LF + sa);
            const float qv[4] = {bflo(q4.x), bfhi(q4.x), bflo(q4.y), bfhi(q4.y)};
            float qm[4], km[4];
#pragma unroll
            for (int e = 0; e < 4; ++e) { const float cv = cm[4 * g + e] * LOG2E; const float E = __builtin_amdgcn_exp2f(cv), Ei = __builtin_amdgcn_exp2f(-cv);
                const float lf = (float)lf4[e]; qm[e] = qv[e] * E; km[e] = (1.f - __builtin_amdgcn_exp2f(lf * LOG2E)) * Ei;
                if (tb == 0 && r32 == 0) ((LAS float*)(lds + SC_A31))[32 * db + 8 * g + 4 * hh + e] = lf - cm[4 * g + e];
                if (tb == 1 && r32 == 31) ((LAS float*)(lds + SC_A63))[32 * db + 8 * g + 4 * hh + e] = cm[4 * g + e]; }
            u32x2 qw2, kw2; qw2.x = cvt_pk_bf16(qm[0], qm[1]); qw2.y = cvt_pk_bf16(qm[2], qm[3]); kw2.x = cvt_pk_bf16(km[0], km[1]); kw2.y = cvt_pk_bf16(km[2], km[3]);
            const int ra = ((4 * db + g) * 64 + t) * 16 + 8 * hh;
            *(LAS u32x2*)(lds + SC_QM + ra) = qw2; *(LAS u32x2*)(lds + SC_KMR + ra) = kw2; *(LAS u32x2*)(lds + SC_KMS + sa) = kw2;
        }
        LDS_WAIT(); __syncthreads();
        { const int d = 32 * db + r32; const float c31 = ((LAS float*)(lds + SC_A31))[d], c63 = ((LAS float*)(lds + SC_A63))[d];
          const float e31 = __expf(c31), dec = __expf(c31 + c63), e63 = __expf(c63);
          f32x16 SN[2];
#pragma unroll
          for (int j = 0; j < 2; ++j) { const int vb2 = 2 * tb + j;
#pragma unroll
              for (int g = 0; g < 4; ++g) { u32x2 w; w.x = cvt_pk_bf16(ST[j][4 * g] * e31, ST[j][4 * g + 1] * e31); w.y = cvt_pk_bf16(ST[j][4 * g + 2] * e31, ST[j][4 * g + 3] * e31);
                  *(LAS u32x2*)(lds + SC_SX + vb2 * 8192 + (d >> 3) * 512 + (d & 7) * 64 + (8 * g + 4 * hh) * 2) = w; }
#pragma unroll
              for (int i = 0; i < 16; ++i) SN[j][i] = 0.f; }
#pragma unroll
          for (int ks = 0; ks < 4; ++ks) {
              const bf16x8 kf = cat8(tr16(lds + SC_KMS + db * 4096 + base_nat + ks * 1024), tr16(lds + SC_KMS + db * 4096 + base_nat + ks * 1024 + 256));
#pragma unroll
              for (int j = 0; j < 2; ++j) { const int vb2 = 2 * tb + j;
                  const bf16x8 vf = cat8(tr16(Vimg + vb2 * 4096 + base_nat + ks * 1024), tr16(Vimg + vb2 * 4096 + base_nat + ks * 1024 + 256));
                  SN[j] = MFMA32(vf, kf, SN[j]); } }
#pragma unroll
          for (int j = 0; j < 2; ++j)
#pragma unroll
              for (int i = 0; i < 16; ++i) ST[j][i] = dec * ST[j][i] + e63 * SN[j][i];
        }
        LDS_WAIT(); __syncthreads();
        if (c + 1 < 36) { SDMA(c + 1, qcol, SC_Q); SDMA(c + 1, lfcol, SC_LF); SDMA(c + 1, vcol, SC_V0 + (vbuf ^ 1) * 16384); }
        { bf16x8 Qmf[8];
#pragma unroll
          for (int kd = 0; kd < 8; ++kd) Qmf[kd] = *(const LAS bf16x8*)(lds + SC_QM + ((2 * kd + hh) * 64 + t) * 16);
          f32x16 o;
#pragma unroll
          for (int i = 0; i < 16; ++i) o[i] = 0.f;
          for (int sb = 0; sb <= tb; ++sb) {
              f32x16 pt;
#pragma unroll
              for (int i = 0; i < 16; ++i) pt[i] = 0.f;
#pragma unroll
              for (int kd = 0; kd < 8; ++kd) { const bf16x8 a = *(const LAS bf16x8*)(lds + SC_KMR + ((2 * kd + hh) * 64 + 32 * sb + r32) * 16); pt = MFMA32(a, Qmf[kd], pt); }
              if (sb == tb) {
#pragma unroll
                  for (int i = 0; i < 16; ++i) if (crow(i, hh) > r32) pt[i] = 0.f; }
              const bf16x8 p0 = packf8(pt, 0), p1 = packf8(pt, 1);
              { const bf16x8 a = cat8(tr16(Vimg + db * 4096 + base_prm + (2 * sb) * 1024), tr16(Vimg + db * 4096 + base_prm + (2 * sb) * 1024 + 512)); o = MFMA32(a, p0, o); }
              { const bf16x8 a = cat8(tr16(Vimg + db * 4096 + base_prm + (2 * sb + 1) * 1024), tr16(Vimg + db * 4096 + base_prm + (2 * sb + 1) * 1024 + 512)); o = MFMA32(a, p1, o); }
          }
#pragma unroll
          for (int kd = 0; kd < 8; ++kd) { const bf16x8 a = cat8(tr16(lds + SC_SX + db * 8192 + base_nat + kd * 1024), tr16(lds + SC_SX + db * 8192 + base_nat + kd * 1024 + 256)); o = MFMA32(a, Qmf[kd], o); }
          if (c >= 4 || store_ctx) { bf16_t* op = P + (size_t)SROW(c, t) * PW + lfcol + 32 * db;
#pragma unroll
              for (int g = 0; g < 4; ++g) { u32x2 w; w.x = cvt_pk_bf16(o[4 * g], o[4 * g + 1]); w.y = cvt_pk_bf16(o[4 * g + 2], o[4 * g + 3]); *(u32x2*)(op + 8 * g + 4 * hh) = w; } }
        }
        vbuf ^= 1;
    }
    VM_WAIT(); LDS_WAIT(); __syncthreads();
#undef SROW
#undef SDMA
}

DI void phase_recprep(const Ctx& C, bf16_t* P, const float* rnw, int nrows) {
    for (int row = C.gw; row < nrows; row += C.NGW) {
        bf16_t* pr = P + (size_t)row * PW + 8 * C.lane;
        float a[8], bb[8], g[8]; unpack8(*(const u32x4*)(pr + PC_LF), a); unpack8(*(const u32x4*)(pr + PC_LB), bb); unpack8(*(const u32x4*)(pr + PC_G), g);
        float ss = 0.f;
#pragma unroll
        for (int j = 0; j < 8; ++j) { a[j] += bb[j]; ss += a[j] * a[j]; }
        ss += __shfl_xor(ss, 1); ss += __shfl_xor(ss, 2); ss += __shfl_xor(ss, 4); ss += __shfl_xor(ss, 8);
        const float rs = 1.0f / sqrtf(ss * (1.f / 128.f) + EPS);
        const f32x4 w0 = *(const f32x4*)(rnw + ((8 * C.lane) & 127)), w1 = *(const f32x4*)(rnw + ((8 * C.lane) & 127) + 4);
        f32x4 o0, o1;
#pragma unroll
        for (int j = 0; j < 4; ++j) { o0[j] = a[j] * rs * w0[j] * g[j]; o1[j] = a[4 + j] * rs * w1[j] * g[4 + j]; }
        *(u32x4*)(pr + PC_LF) = pack8(o0, o1);
    }
}

DI void phase_slots(const Ctx& C, const int* cnt, int* pbout, unsigned char* route, const bf16_t* H2, bf16_t* AG, LAS int* cur) {
    if (C.tid < 16) cur[C.tid] = 0;
    __syncthreads();
    for (int g = C.tid; g < C.G; g += 512) {
#pragma unroll
        for (int k = 0; k < 8; ++k) { const int c = cnt[g * 8 + k]; atomicAdd((int*)&cur[8 + k], c); if (g < C.bx) atomicAdd((int*)&cur[k], c); } }
    __syncthreads();
    if (C.tid < 8) { const int e = C.tid; int pb = 0, pbe = 0;
#pragma unroll
        for (int k = 0; k < 8; ++k) { if (k == e) pbe = pb; pb += (cur[8 + k] + 255) >> 8; }
        const int mine = cur[e];
        if (C.bx == 0) { pbout[e] = pbe; if (e == 7) pbout[8] = pb; }
        cur[e] = pbe * 256 + mine;
    }
    __syncthreads();
    for (int row = C.gw; row < NLAT; row += C.NGW) {
        int* rt = (int*)(route + (size_t)row * 24);
        int s1 = 0, s2 = 0;
        if (C.lane == 0) { s1 = atomicAdd((int*)&cur[rt[0]], 1); s2 = atomicAdd((int*)&cur[rt[1]], 1); rt[4] = s1; rt[5] = s2; }
        s1 = __builtin_amdgcn_readfirstlane(s1); s2 = __builtin_amdgcn_readfirstlane(s2);
        const u32x4 v0 = *((const u32x4*)((const unsigned char*)H2 + (size_t)row * D) + C.lane);
        *((u32x4*)((unsigned char*)AG + (size_t)s1 * D) + C.lane) = v0; *((u32x4*)((unsigned char*)AG + (size_t)s2 * D) + C.lane) = v0;
    }
}
DI void phase_final(const Ctx& C, float* x, const unsigned char* route, const bf16_t* Y, const float* mods1, const float* fw) {
    for (int row = C.gw; row < NLAT; row += C.NGW) {
        const int* rt = (const int*)(route + (size_t)row * 24); const float g1 = ((const float*)rt)[2], g2 = ((const float*)rt)[3]; const int s1 = rt[4], s2 = rt[5];
        const float* mv = mods1 + (size_t)(row >> 11) * DIN + 5 * D; float* xr = x + (size_t)row * D;
        f32x4 v[4]; float ss = 0.f;
#pragma unroll
        for (int j = 0; j < 4; ++j) { const int c0 = 256 * j + 4 * C.lane;
            const u32x2 y1 = *(const u32x2*)(Y + (size_t)s1 * D + c0), y2 = *(const u32x2*)(Y + (size_t)s2 * D + c0); const f32x4 m5 = *(const f32x4*)(mv + c0);
            f32x4 y; y[0] = g1 * bflo(y1.x) + g2 * bflo(y2.x); y[1] = g1 * bfhi(y1.x) + g2 * bfhi(y2.x); y[2] = g1 * bflo(y1.y) + g2 * bflo(y2.y); y[3] = g1 * bfhi(y1.y) + g2 * bfhi(y2.y);
            v[j] = *(const f32x4*)(xr + c0) + m5 * y; ss += (v[j][0] * v[j][0] + v[j][1] * v[j][1]) + (v[j][2] * v[j][2] + v[j][3] * v[j][3]); }
        const float rstd = 1.0f / sqrtf(wave_sum(ss) * (1.f / D) + EPS);
#pragma unroll
        for (int j = 0; j < 4; ++j) { const int c0 = 256 * j + 4 * C.lane; *(f32x4*)(xr + c0) = v[j] * rstd * *(const f32x4*)(fw + c0); }
    }
}

constexpr int LDS_MISC = SC_END;
constexpr int LDS_BYTES = SC_END + 512;
static_assert(LDS_WTAB_OFF == SC_END + 128, "wave table sits behind the barrier words and counters");
constexpr int NPHASE = 20;

DI Ctx make_ctx() {
    extern __shared__ __attribute__((aligned(16))) unsigned char lds_raw[];
    Ctx C; const int t = my_tid();
    unsigned lb = (unsigned)(size_t)(LAS unsigned char*)lds_raw; asm volatile("" : "+s"(lb));
    C.lds = (LAS unsigned char*)(size_t)lb; C.ws = kparams()->ws; C.tid = t; C.lane = t & 63; C.wave = __builtin_amdgcn_readfirstlane(t >> 6);
    int bx = blockIdx.x, G = gridDim.x; asm volatile("" : "+s"(bx), "+s"(G));
    C.bx = bx; C.G = G; C.vcu = (C.G % 8 == 0) ? (bx % 8) * (C.G / 8) + bx / 8 : bx;
    C.gw = C.vcu * 8 + C.wave; C.NGW = C.G * 8;
    return C;
}
DI void grid_barrier() {
    extern __shared__ __attribute__((aligned(16))) unsigned char lds_raw[];
    XcdBarrier b; b.bar = (unsigned*)(kparams()->ws + WS_CTL) + CW_BAR + kparams()->li * XCD_BAR_WORDS; b.x = xb_xcc_id(); b.st = (volatile LAS unsigned*)((LAS unsigned char*)lds_raw + LDS_MISC);
    xcd_barrier(b);
}
#define WSP(T, off) ((T*)(kparams()->ws + (off)))

#ifdef ONLY_PHASE
#define IN(k) (((ONLY_PHASE) >> (k)) & 1)
#else
#define IN(k) (kparams()->ph_lo <= (k) && (k) < kparams()->ph_hi)
#endif
#define SEAM(k) do { if (IN(k) && IN((k) + 1)) grid_barrier(); } while (0)


template <int l> DI void layer_phases() {
        const int pb = 1 + 9 * l;
#define LQ() int lq = l; asm volatile("" : "+s"(lq))
#define XL (lq == 0 ? PIN(0) : (const float*)POUT)
#define XC (lq == 0 ? PIN(2) : (const float*)WSP(float, WS_CTXRES))
#define LMODS (WSP(float, WS_MODS) + (size_t)lq * 33 * DIN)
#define NROWS_OUT (lq == 0 ? NTOK : NLAT)
        if (IN(pb + 0)) { LQ(); const Ctx C = make_ctx(); phase_norm<false>(C, XL, XC, PIN(6) + lq * D, LMODS, 0, NTOK, WSP(bf16_t, WS_H), nullptr, nullptr, nullptr, WSP(unsigned char, WS_H8)); }
        SEAM(pb + 0);
        if (IN(pb + 1)) { LQ();
            { const Ctx C = make_ctx();
              Gemm g{WSP(bf16_t, WS_H), WSP(bf16_t, WS_WIN) + (size_t)lq * 4096 * D, NTOK, N_SEC_BF * 512, D, D};
              pg8::StaticOrder S; S.init(g, C.G, C.bx);
              EpiInProj E{WSP(bf16_t, WS_P), WSP(float2, WS_ROPE), WSP(float, WS_LBS) + lq * 1024, WSP(float, WS_LBS) + lq * 1024 + 512, (int)secmap_of(false), 1.f};
              pg8::gemm_phase<EpiInProj, pg8::StaticOrder>(C.lds, g, S, E); }
            if (N_SEC_F8 > 0) { const Ctx C = make_ctx();
              Gemm g{WSP(bf16_t, WS_H8), (const bf16_t*)(WSP(unsigned char, WS_WIN8) + (size_t)lq * 4096 * D), NTOK, N_SEC_F8 * 512, D / 2, D / 2};
              pg8::StaticOrder S; S.init(g, C.G, C.bx);
              EpiInProj E{WSP(bf16_t, WS_P), WSP(float2, WS_ROPE), WSP(float, WS_LBS) + lq * 1024, WSP(float, WS_LBS) + lq * 1024 + 512, (int)secmap_of(true), 1.f / WIN8_SCALE};
              pg8::gemm_phase<EpiInProj, pg8::StaticOrder, true, true>(C.lds, g, S, E); }
        }
        SEAM(pb + 1);
        if (IN(pb + 2)) { LQ(); const Ctx C = make_ctx(); bf16_t* const Pb = WSP(bf16_t, WS_P);
            for (int id = C.vcu; id < NB * 4 * 2; id += C.G) scan_chain(C, Pb, id >> 3, (id >> 1) & 3, id & 1, lq == 0);
            float lam;
            { const float a = wave_sum(PIN(9)[lq * 64 + C.lane] * PIN(10)[lq * 64 + C.lane]), b2 = wave_sum(PIN(11)[lq * 64 + C.lane] * PIN(12)[lq * 64 + C.lane]);
              const float li = 0.8f - 0.6f * expf(-0.3f * (float)lq); lam = expf(a) - expf(b2) + li; lam = __uint_as_float(__builtin_amdgcn_readfirstlane(__float_as_uint(lam))); }
            const float post = __uint_as_float(__builtin_amdgcn_readfirstlane(__float_as_uint(1.f - (0.8f - 0.6f * expf(-0.3f * (float)lq)))));
            const float* anw = PIN(13) + lq * 128;
            const int NU = NB * 4 * 8, U = (NU + C.G - 1) / C.G;
            for (int id = C.vcu * U; id < NU && id < (C.vcu + 1) * U; ++id) { const int bh = id >> 3, qb = id & 7, b = bh >> 2, h = bh & 3;
                attn_unit(C, Pb, b * T + qb * 256, NLAT + b * CL, b * T, 36, h, lam, anw, post); }
            if (lq == 0) for (int id = C.vcu; id < NB * 4; id += C.G) { const int b = id >> 2, h = id & 3;
                attn_unit(C, Pb, NLAT + b * CL, NLAT + b * CL, 0, 4, h, lam, anw, post); }
        }
        SEAM(pb + 2);
        if (IN(pb + 3)) { LQ(); const Ctx C = make_ctx();
            phase_recprep(C, WSP(bf16_t, WS_P), PIN(14) + lq * 128, NROWS_OUT);
            Gemm g{WSP(bf16_t, WS_H8), (const bf16_t*)(WSP(unsigned char, WS_WIN8) + ((size_t)lq * 4096 + N_SEC_F8 * 512) * D), NROWS_OUT, 2048, D / 2, D / 2};
            pg8::StaticOrder S; S.init(g, C.G, C.bx);
            EpiGates E{WSP(bf16_t, WS_P), 1.f / WIN8_SCALE};
            pg8::gemm_phase<EpiGates, pg8::StaticOrder, true, true>(C.lds, g, S, E);
        }
        SEAM(pb + 3);
        if (IN(pb + 4)) { LQ();
            { const Ctx C = make_ctx(); Gemm g{WSP(bf16_t, WS_P) + PC_Q, WSP(bf16_t, WS_WUA) + (size_t)lq * D * 512, NROWS_OUT, D, 512, PW};
              pg8::StaticOrder S; S.init(g, C.G, C.bx); EpiMerge<true> E{WSP(bf16_t, WS_P), PC_GA, WSP(bf16_t, WS_MERGED)};
              pg8::gemm_phase<EpiMerge<true>, pg8::StaticOrder>(C.lds, g, S, E); }
            { const Ctx C = make_ctx(); Gemm g{WSP(bf16_t, WS_P) + PC_LF, WSP(bf16_t, WS_WUR) + (size_t)lq * D * 512, NROWS_OUT, D, 512, PW};
              pg8::StaticOrder S; S.init(g, C.G, C.bx); EpiMerge<false> E{WSP(bf16_t, WS_P), PC_GR, WSP(bf16_t, WS_MERGED)};
              pg8::gemm_phase<EpiMerge<false>, pg8::StaticOrder>(C.lds, g, S, E); }
        }
        SEAM(pb + 4);
        if (IN(pb + 5)) { LQ(); const Ctx C = make_ctx();
            Gemm g{WSP(bf16_t, WS_MERGED), WSP(bf16_t, WS_WO) + (size_t)lq * D * D, NROWS_OUT, D, D, D};
            pg8::StaticOrder S; S.init(g, C.G, C.bx);
            EpiResid E{XL, XC, POUT, WSP(float, WS_CTXRES), LMODS, 2};
            pg8::gemm_phase<EpiResid, pg8::StaticOrder>(C.lds, g, S, E);
        }
        SEAM(pb + 5);
        if (l == 0) {
            if (IN(7)) { LQ(); const Ctx C = make_ctx(); phase_norm<false>(C, POUT, WSP(float, WS_CTXRES), PIN(7), LMODS, 3, NTOK, WSP(bf16_t, WS_H), nullptr, nullptr, nullptr); }
            SEAM(7);
            if (IN(8)) { LQ(); const Ctx C = make_ctx();
                Gemm g{WSP(bf16_t, WS_H), WSP(bf16_t, WS_W13), NTOK, 2 * DFFP, D, D};
                pg8::StaticOrder S; S.init(g, C.G, C.bx); EpiSwiglu E{WSP(bf16_t, WS_HID), DFFP, 0};
                pg8::gemm_phase<EpiSwiglu, pg8::StaticOrder>(C.lds, g, S, E);
            }
            SEAM(8);
            if (IN(9)) { LQ(); const Ctx C = make_ctx();
                Gemm g{WSP(bf16_t, WS_HID), WSP(bf16_t, WS_W2), NTOK, D, DFFP, DFFP};
                pg8::StaticOrder S; S.init(g, C.G, C.bx); EpiResid E{POUT, WSP(float, WS_CTXRES), POUT, WSP(float, WS_CTXRES), LMODS, 5};
                pg8::gemm_phase<EpiResid, pg8::StaticOrder>(C.lds, g, S, E);
            }
            SEAM(9);
        } else {
            if (IN(16)) { LQ(); const Ctx C = make_ctx(); LAS int* lcnt = (LAS int*)(C.lds + LDS_MISC + 32);
                if (C.tid < 8) lcnt[C.tid] = 0;
                __syncthreads();
                phase_norm<true>(C, POUT, nullptr, PIN(7) + D, LMODS, 3, NLAT, WSP(bf16_t, WS_H2M), PIN(23), WSP(unsigned char, WS_ROUTE), lcnt);
                __syncthreads();
                if (C.tid < 8) WSP(int, WS_CNT)[C.bx * 8 + C.tid] = lcnt[C.tid];
                convert_moe_weights(C);
            }
            SEAM(16);
            if (IN(17)) { LQ(); const Ctx C = make_ctx(); phase_slots(C, WSP(int, WS_CNT), WSP(int, WS_CNT) + 4096, WSP(unsigned char, WS_ROUTE), WSP(bf16_t, WS_H2M), WSP(bf16_t, WS_AG), (LAS int*)(C.lds + LDS_MISC + 32)); }
            SEAM(17);
            if (IN(18)) { LQ();
                const int ptot = __builtin_amdgcn_readfirstlane(WSP(int, WS_CNT)[4096 + 8]);
                for (int p0 = 0; p0 < ptot; p0 += MOE_CHUNK) {
                    const int np = (ptot - p0) < MOE_CHUNK ? (ptot - p0) : MOE_CHUNK;
#define MOE_ORDER_INIT(S) do { S.so.init(g, C.G, C.bx); S.p0 = p0; S.pbv = WSP(int, WS_CNT) + 4096; } while (0)
                    { const Ctx C = make_ctx(); Gemm g{WSP(bf16_t, WS_AG), WSP(bf16_t, WS_WM13), np * 256, 2 * DFE, D / 2, D / 2};
                      pg8::MoeOrder S; MOE_ORDER_INIT(S); S.apan0 = 0; S.estride = (size_t)2 * DFE * D;
                      EpiSwiglu8 E{WSP(unsigned char, WS_MHID), DFE, p0, 1.f / W13_SCALE, HID_SCALE};
                      pg8::gemm_phase<EpiSwiglu8, pg8::MoeOrder, true, true>(C.lds, g, S, E); }
                    grid_barrier();
                    { const Ctx C = make_ctx(); Gemm g{WSP(bf16_t, WS_MHID), WSP(bf16_t, WS_WM2), np * 256, D, DFE / 2, DFE / 2};
                      pg8::MoeOrder S; MOE_ORDER_INIT(S); S.apan0 = p0; S.estride = (size_t)D * DFE;
                      EpiBf16 E{WSP(bf16_t, WS_Y), D, 1.f / (W2_SCALE * HID_SCALE)};
                      pg8::gemm_phase<EpiBf16, pg8::MoeOrder, true, true>(C.lds, g, S, E); }
                    grid_barrier();
                }
            }
            if (IN(19)) { LQ(); const Ctx C = make_ctx(); phase_final(C, POUT, WSP(unsigned char, WS_ROUTE), WSP(bf16_t, WS_Y), LMODS, PIN(27)); }
        }
}

__global__ void __launch_bounds__(512, 2) fwd_kernel(Params p) {
    extern __shared__ __attribute__((aligned(16))) unsigned char lds_raw[];
    (void)p;
    { volatile LAS unsigned* misc = (volatile LAS unsigned*)((LAS unsigned char*)lds_raw + LDS_MISC);
      if (threadIdx.x < 16) misc[threadIdx.x] = 0u;
      if ((threadIdx.x & 63) == 0) ((volatile LAS int*)((LAS unsigned char*)lds_raw + LDS_WTAB_OFF))[(unsigned)__builtin_amdgcn_s_getreg((5 << 11) | 4) & 63u] = threadIdx.x >> 6;
      __syncthreads();
      (void)xcd_barrier_post((unsigned*)(kparams()->ws + WS_CTL) + CW_BAR + kparams()->li * XCD_BAR_WORDS, misc); }
    if (IN(0)) { const Ctx C = make_ctx(); phase_prologue(C); } SEAM(0);

    layer_phases<0>();
    layer_phases<1>();
#undef IN
#undef SEAM
}


#ifndef DBG_T1
#define DBG_T1 1
#endif
#ifndef DBG_CAT
#define DBG_CAT (j >> 9)
#endif
#if DBG
constexpr size_t DBG_ERR = WS_DBG, DBG_SNAPX = WS_DBG + 4096, DBG_ROWS = WS_DBG + 65536, DBG_Q = WS_MERGED + 64 * MiB, DBG_OF = WS_DBG + 262144, DBG_LF = WS_MERGED;
__device__ inline unsigned dhash(unsigned x) { x ^= x >> 16; x *= 0x7feb352du; x ^= x >> 15; x *= 0x846ca68bu; x ^= x >> 16; return x; }
__device__ inline float rbf(float f) { unsigned u = __float_as_uint(f); u += 0x7fffu + ((u >> 16) & 1u); return __uint_as_float(u & 0xffff0000u); }
__device__ inline void rec_err(unsigned char* ws, int id, float got, float exp_, float atol) {
    float d = got - exp_; if (!(d == d) || fabsf(d) > 1e15f) d = 1e15f;
    atomicAdd((float*)(ws + DBG_ERR) + id, d * d); atomicAdd((float*)(ws + DBG_ERR) + 64 + id, exp_ * exp_);
    if (fabsf(d) > 0.15f * fabsf(exp_) + atol * 5.f) atomicAdd((unsigned*)(ws + DBG_ERR) + 128 + id, 1u);
}
__device__ inline int srow(unsigned i) { const unsigned h = dhash(i * 7919u + 13u); return (i & 3u) == 3u ? NLAT + (int)(h % NCTX) : (int)(h % NLAT); }
__device__ inline const float* xrowp(const float* xl, const float* xc, int row) { return row < NLAT ? xl + (size_t)row * D : xc + (size_t)(row - NLAT) * D; }
__device__ inline float dsilu(float x) { return x / (1.f + expf(-x)); }
__device__ inline float dot_hw(const bf16_t* a, const float* w, int K, int ldw) { float s = 0.f; for (int k = 0; k < K; ++k) s += bf2f(a[k]) * rbf(w[(size_t)k * ldw]); return s; }

struct DArgs { const float* in[28]; float* out; unsigned char* ws; int l, kind, id, aux; };
__global__ void dbg_check(DArgs a) {
    unsigned char* ws = a.ws; const int l = a.l; const int i = blockIdx.x * blockDim.x + threadIdx.x;
    const float* mods = (const float*)(ws + WS_MODS) + (size_t)l * 33 * DIN; const bf16_t* P = (const bf16_t*)(ws + WS_P);
    if (a.kind == 1) { const int ll = i & 1, r = dhash(i) % 33, n = dhash(i + 777) % DIN; const float* cv = r < 32 ? a.in[1] + r * D : a.in[3];
        float s = a.in[5][ll * DIN + n]; for (int k = 0; k < D; ++k) s += dsilu(cv[k]) * a.in[4][((size_t)ll * D + k) * DIN + n];
        rec_err(ws, a.id, ((const float*)(ws + WS_MODS))[(size_t)(ll * 33 + r) * DIN + n], s, 0.01f); }
    else if (a.kind == 30) { const int ll = i & 1, n = 4096 + dhash(i) % 2048, k = dhash(i + 4242) % D;
        rec_err(ws, a.id, bf2f(((const bf16_t*)(ws + WS_WIN))[((size_t)ll * DIN + n) * D + k]), rbf(a.in[8][((size_t)ll * D + k) * DIN + n]), 1e-6f); }
    else if (a.kind == 2) { int row = srow(i); if (a.aux == 2 || (l == 1 && a.aux != 0)) row = row % NLAT; const int col = dhash(i + 99) % D;
        const float* xl = a.aux == 0 ? (l == 0 ? a.in[0] : a.out) : a.out; const float* xc = a.aux == 0 && l == 0 ? a.in[2] : (const float*)(ws + WS_CTXRES);
        const float* xr = xrowp(xl, xc, row); float ss = 0.f; for (int k = 0; k < D; ++k) ss += xr[k] * xr[k];
        const float rstd = 1.f / sqrtf(ss / D + EPS); const float* nw = (a.aux == 0 ? a.in[6] : a.in[7]) + l * D; const int sh = a.aux == 0 ? 0 : 3;
        const float* mv = mods + (size_t)(row < NLAT ? row >> 11 : 32) * DIN;
        const float e = xr[col] * rstd * nw[col] * (1.f + mv[(sh + 1) * D + col]) + mv[sh * D + col];
        const bf16_t* H = (const bf16_t*)(ws + (a.aux == 2 ? WS_H2M : WS_H)); rec_err(ws, a.id, bf2f(H[(size_t)row * D + col]), e, 0.02f); }
    else if (a.kind == 3) { const int sec = i & 7, row = srow(i >> 3), j = dhash(i + 5) % 512; const bf16_t* hr = (const bf16_t*)(ws + WS_H) + (size_t)row * D; const float* W = a.in[8] + (size_t)l * D * DIN;
        float e, got; const bool lat = row < NLAT; const int t = row & (T - 1);
        if (sec == 0 || sec == 1) { const int hs = j >> 6, d = j & 63, pi = d & 31, ob = (sec == 0 ? 0 : 512) + hs * 64;
            const float xa = dot_hw(hr, W + ob + pi, D, DIN), xb = dot_hw(hr, W + ob + 32 + pi, D, DIN);
            float c = 1.f, sn = 0.f; if (lat) { const float invf = powf(10000.f, -(float)(pi & 15) / 16.f); const float ang = (float)(pi < 16 ? (t >> 6) : (t & 63)) * invf; c = cosf(ang); sn = sinf(ang); }
            e = d < 32 ? xa * c - xb * sn : xa * sn + xb * c; if (sec == 0) e *= QSCALE;
            got = bf2f(P[(size_t)row * PW + (sec == 0 ? PC_Q : PC_K) + hs * 64 + (d < 32 ? 2 * d : 2 * (d - 32) + 1)]); }
        else if (sec == 2) { e = dot_hw(hr, W + 1024 + j, D, DIN); got = bf2f(P[(size_t)row * PW + PC_V + j]); }
        else if (sec == 3) { e = dsilu(dot_hw(hr, W + 1536 + j, D, DIN)); got = bf2f(P[(size_t)row * PW + PC_RQ + j]); }
        else if (sec == 4) { e = dot_hw(hr, W + 2048 + j, D, DIN); got = bf2f(P[(size_t)row * PW + PC_RI + j]); }
        else if (sec == 5 || sec == 6) { const float z = dot_hw(hr, W + (sec == 5 ? 2560 : 3072) + j, D, DIN); const float* lbp = a.in[sec == 5 ? 15 : 16];
            const float lb = l == 0 ? 0.f : 1.f / (1.f + expf(lbp[j] - lbp[512 + j])); const float sg = 1.f / (1.f + expf(-z)); e = logf(lb + (1.f - lb) * sg);
            got = (float)((const _Float16*)P)[(size_t)row * PW + (sec == 5 ? PC_LF : PC_LB) + j]; }
        else { e = dsilu(dot_hw(hr, W + 3584 + j, D, DIN)); got = bf2f(P[(size_t)row * PW + PC_G + j]); }
        rec_err(ws, a.id + sec, got, e, 0.03f); }
    else if (a.kind == 6) { const int i6 = i; int row = srow(i6); if (l == 1 || DBG_T1) row %= NLAT; const int j = dhash(i6 + 5) % 2048; const bf16_t* hr = (const bf16_t*)(ws + WS_H) + (size_t)row * D;
        const float z = dot_hw(hr, a.in[8] + (size_t)l * D * DIN + 4096 + j, D, DIN); const size_t gi_ = (size_t)row * PW + PC_GA + j; const unsigned gw_ = __hip_atomic_load((unsigned*)P + (gi_ >> 1), __ATOMIC_RELAXED, __HIP_MEMORY_SCOPE_AGENT);
        const float gt_ = (gi_ & 1) ? bfhi(gw_) : bflo(gw_), ex_ = 1.f / (1.f + expf(-z)); rec_err(ws, a.id, gt_, ex_, 0.01f);
        if (fabsf(gt_ - ex_) > 0.15f * ex_ + 0.05f) { atomicAdd((unsigned*)(ws + DBG_ERR) + 192 + (fabsf(gt_ - 100.f) < 1.f ? 0 : (gt_ < 0.f || gt_ > 1.f) ? 1 : 2), 1u); atomicAdd((unsigned*)(ws + DBG_ERR) + 196 + ((row >> 8) & 3), 1u); } }
    else if (a.kind == 7) { int row = srow(i); if (l == 1) row %= NLAT; const int n = dhash(i + 5) % D; const bf16_t* pr = P + (size_t)row * PW;
        const float ya = dot_hw(pr + PC_Q, a.in[17] + (size_t)l * 512 * D + n, 512, D), yr = dot_hw(pr + PC_LF, a.in[18] + (size_t)l * 512 * D + n, 512, D);
        rec_err(ws, a.id, bf2f(((const bf16_t*)(ws + WS_MERGED))[(size_t)row * D + n]), bf2f(pr[PC_GA + n]) * ya + bf2f(pr[PC_GR + n]) * yr, 0.03f); }
    else if (a.kind == 8 || a.kind == 10) { int row = srow(i); if (l == 1) row %= NLAT; const int col = dhash(i + 5) % D; const int msel = a.kind == 8 ? 2 : 5;
        float xin; if (a.kind == 8 && l == 0) xin = xrowp(a.in[0], a.in[2], row)[col]; else xin = ((const float*)(ws + DBG_SNAPX))[i];
        float y; if (a.kind == 8) y = dot_hw((const bf16_t*)(ws + WS_MERGED) + (size_t)row * D, a.in[19] + (size_t)l * D * D + col, D, D);
        else y = dot_hw((const bf16_t*)(ws + WS_HID) + (size_t)row * DFFP, a.in[22] + col, DFF, D);
        const float e = xin + mods[(size_t)(row < NLAT ? row >> 11 : 32) * DIN + msel * D + col] * y;
        rec_err(ws, a.id, xrowp(a.out, (const float*)(ws + WS_CTXRES), row)[col], e, 0.03f); }
    else if (a.kind == 9) { const int row = srow(i), j = dhash(i + 5) % DFF; const bf16_t* hr = (const bf16_t*)(ws + WS_H) + (size_t)row * D;
        const float u = dot_hw(hr, a.in[20] + j, D, DFF), v = dot_hw(hr, a.in[21] + j, D, DFF); rec_err(ws, a.id, bf2f(((const bf16_t*)(ws + WS_HID))[(size_t)row * DFFP + j]), dsilu(u) * v, 0.03f); }
    else if (a.kind == 11) { const int row = dhash(i) % NLAT; const float* xr = a.out + (size_t)row * D; float ss = 0.f; for (int k = 0; k < D; ++k) ss += xr[k] * xr[k];
        const float rstd = 1.f / sqrtf(ss / D + EPS); const float* mv = mods + (size_t)(row >> 11) * DIN; float lg[8]; for (int e = 0; e < 8; ++e) lg[e] = 0.f;
        for (int k = 0; k < D; ++k) { const float h = xr[k] * rstd * a.in[7][D + k] * (1.f + mv[4 * D + k]) + mv[3 * D + k]; for (int e = 0; e < 8; ++e) lg[e] += h * a.in[23][k * 8 + e]; }
        int e1 = 0; for (int e = 1; e < 8; ++e) if (lg[e] > lg[e1]) e1 = e; int e2 = e1 == 0 ? 1 : 0; for (int e = 0; e < 8; ++e) if (e != e1 && lg[e] > lg[e2]) e2 = e;
        const int* rt = (const int*)(ws + WS_ROUTE + (size_t)row * 24); const float g1 = 1.f / (1.f + expf(lg[e2] - lg[e1]));
        const float margin = lg[e2] - fmaxf(-1e30f, [&]{ float m = -1e30f; for (int e = 0; e < 8; ++e) if (e != e1 && e != e2) m = fmaxf(m, lg[e]); return m; }());
        if (margin > 1e-3f && lg[e1] - lg[e2] > 1e-3f) { rec_err(ws, a.id, (float)rt[0], (float)e1, 0.01f); rec_err(ws, a.id, (float)rt[1], (float)e2, 0.01f); rec_err(ws, a.id, ((const float*)rt)[2], g1, 0.01f); rec_err(ws, a.id, ((const float*)rt)[3], 1.f - g1, 0.01f); } }
    else if (a.kind == 12) { const int row = dhash(i) % NLAT; const int* rt = (const int*)(ws + WS_ROUTE + (size_t)row * 24); const int* pb = (const int*)(ws + WS_CNT) + 4096;
        for (int w = 0; w < 2; ++w) { const int s = rt[4 + w], e = rt[w]; const int pan = s >> 8; int ee = 0; for (int k = 1; k < 8; ++k) ee += pan >= pb[k];
            rec_err(ws, a.id, (float)ee, (float)e, 0.01f); if (s < 0 || s >= pb[8] * 256) rec_err(ws, a.id, 1.f, 0.f, 0.01f);
            const int col = dhash(i + 31 + w) % D; rec_err(ws, a.id, bf2f(((const bf16_t*)(ws + WS_AG))[(size_t)s * D + col]), bf2f(((const bf16_t*)(ws + WS_H2M))[(size_t)row * D + col]), 1e-6f); } }
    else if (a.kind == 14) { int row = srow(i & 15); if (l == 1) row %= NLAT; const int hh = (i >> 4) & 3; const bf16_t* of = (const bf16_t*)(ws + DBG_OF) + (size_t)(i & 15) * 512 + hh * 128; const bf16_t* pr = P + (size_t)row * PW;
        float ss = 0.f; for (int v = 0; v < 128; ++v) { const float o = bf2f(of[v]) + bf2f(pr[PC_LB + hh * 128 + v]); ss += o * o; }
        const float rs = 1.f / sqrtf(ss / 128.f + EPS); const int v = dhash(i) % 128;
        rec_err(ws, a.id, bf2f(pr[PC_LF + hh * 128 + v]), (bf2f(of[v]) + bf2f(pr[PC_LB + hh * 128 + v])) * rs * a.in[14][l * 128 + v] * bf2f(pr[PC_G + hh * 128 + v]), 0.03f); }
}
__global__ void dbg_snap(DArgs a) {
    unsigned char* ws = a.ws; const int l = a.l; const int i = blockIdx.x * blockDim.x + threadIdx.x; const bf16_t* P = (const bf16_t*)(ws + WS_P);
    if (a.kind == 8 || a.kind == 10) { int row = srow(i); if (l == 1) row %= NLAT; const int col = dhash(i + 5) % D; ((float*)(ws + DBG_SNAPX))[i] = xrowp(a.out, (const float*)(ws + WS_CTXRES), row)[col]; }
    else if (a.kind == 20) { const int ch = blockIdx.x >> 1, dir = blockIdx.x & 1, b = (ch * 5 + 3) % NB, h = (ch + (ch >> 2)) & 3;
        bf16_t* dst = (bf16_t*)(ws + DBG_LF) + (size_t)blockIdx.x * 2304 * 128;
        for (int s = 0; s < 2304; ++s) { const int row = s < 256 ? NLAT + b * CL + s : b * T + (s - 256); dst[(size_t)s * 128 + threadIdx.x] = P[(size_t)row * PW + (dir ? PC_LB : PC_LF) + h * 128 + threadIdx.x]; } }
    else if (a.kind == 21) { const int smp = blockIdx.x; int row = a.aux ? NLAT + (int)(dhash(smp) % NCTX) : (int)(dhash(smp) % NLAT); const int h = smp & 3;
        ((bf16_t*)(ws + DBG_Q))[(a.aux * 1024 + smp) * 128 + threadIdx.x] = P[(size_t)row * PW + PC_Q + h * 128 + threadIdx.x]; }
    else if (a.kind == 22) { int row = srow(blockIdx.x); if (l == 1) row %= NLAT; for (int c = threadIdx.x; c < 512; c += blockDim.x) ((bf16_t*)(ws + DBG_OF))[blockIdx.x * 512 + c] = P[(size_t)row * PW + PC_LF + c]; }
    else if (a.kind == 40) { for (size_t r = blockIdx.x; r < (size_t)NTOK; r += gridDim.x) for (int c = threadIdx.x; c < 256; c += blockDim.x) ((u32x4*)(P + r * PW + 2048))[c] = (u32x4){0x42C842C8u, 0x42C842C8u, 0x42C842C8u, 0x42C842C8u}; }
    else if (a.kind == 23) { const int row = dhash(blockIdx.x) % NLAT; for (int c = threadIdx.x; c < D; c += blockDim.x) ((float*)(ws + DBG_ROWS))[blockIdx.x * D + c] = a.out[(size_t)row * D + c]; }
}
__global__ void dbg_scan(DArgs a) {
    extern __shared__ float Scol[];
    unsigned char* ws = a.ws; const int l = a.l; const int ch = blockIdx.x >> 1, dir = blockIdx.x & 1, b = (ch * 5 + 3) % NB, h = (ch + (ch >> 2)) & 3, v = threadIdx.x; const bf16_t* P = (const bf16_t*)(ws + WS_P);
    const _Float16* lfs = (const _Float16*)(ws + DBG_LF) + (size_t)blockIdx.x * 2304 * 128;
    for (int d = 0; d < 128; ++d) Scol[d * 128 + v] = 0.f;
    for (int st = 0; st < 2304; ++st) {
        int s, row; if (st < 256) { s = dir ? 255 - st : st; row = NLAT + b * CL + s; } else { const int tt = dir ? 2047 - (st - 256) : st - 256; s = 256 + tt; row = b * T + tt; }
        const bf16_t* pr = P + (size_t)row * PW; const float val = bf2f(pr[PC_RI + h * 128 + v]); float o = 0.f;
        for (int d = 0; d < 128; ++d) { const float f = expf((float)lfs[(size_t)s * 128 + d]); const float sv = f * Scol[d * 128 + v] + (1.f - f) * val; Scol[d * 128 + v] = sv; o += bf2f(pr[PC_RQ + h * 128 + d]) * sv; }
        if (st >= 256 || l == 0) rec_err(ws, a.id + dir, bf2f(pr[(dir ? PC_LB : PC_LF) + h * 128 + v]), o, 0.3f);
    }
}
__global__ void dbg_attn(DArgs a) {
    __shared__ float red[128];
    unsigned char* ws = a.ws; const int l = a.l; const int smp = blockIdx.x, v = threadIdx.x, h = smp & 3; const bf16_t* P = (const bf16_t*)(ws + WS_P);
    const int row = a.aux ? NLAT + (int)(dhash(smp) % NCTX) : (int)(dhash(smp) % NLAT); const int b = a.aux ? (row - NLAT) / CL : row / T;
    const bf16_t* q = (const bf16_t*)(ws + DBG_Q) + (a.aux * 1024 + smp) * 128; const int nk = a.aux ? 256 : 2304;
    float la = 0.f, lb2 = 0.f; for (int k = 0; k < 64; ++k) { la += a.in[9][l * 64 + k] * a.in[10][l * 64 + k]; lb2 += a.in[11][l * 64 + k] * a.in[12][l * 64 + k]; }
    const float lami = 0.8f - 0.6f * expf(-0.3f * l), lam = expf(la) - expf(lb2) + lami;
    float o[2];
    for (int c = 0; c < 2; ++c) { float m = -1e30f, ls = 0.f, acc = 0.f;
        for (int k = 0; k < nk; ++k) { const int kr = k < 256 ? NLAT + b * CL + k : b * T + (k - 256); const bf16_t* kp = P + (size_t)kr * PW;
            float s = 0.f; for (int d = 0; d < 64; ++d) s += bf2f(q[c * 64 + d]) * bf2f(kp[PC_K + h * 128 + c * 64 + d]);
            const float mn = fmaxf(m, s), al = exp2f(m - mn), pe = exp2f(s - mn); ls = ls * al + pe; acc = acc * al + pe * bf2f(kp[PC_V + h * 128 + v]); m = mn; }
        o[c] = acc / ls; }
    const float ov = o[0] - lam * o[1]; red[v] = ov * ov; __syncthreads();
    for (int st = 64; st > 0; st >>= 1) { if (v < st) red[v] += red[v + st]; __syncthreads(); }
    const float e = ov / sqrtf(red[0] / 128.f + EPS) * a.in[13][l * 128 + v] * (1.f - lami);
    rec_err(ws, a.id, bf2f(P[(size_t)row * PW + PC_Q + h * 128 + v]), e, 0.03f);
}
__global__ void dbg_moey(DArgs a) {
    __shared__ float red[256];
    unsigned char* ws = a.ws; const int smp = blockIdx.x, row = dhash(smp) % NLAT, w = smp & 1; const int* rt = (const int*)(ws + WS_ROUTE + (size_t)row * 24);
    const int e = rt[w], s = rt[4 + w], col = dhash(smp + 99) % D; const bf16_t* hr = (const bf16_t*)(ws + WS_AG) + (size_t)s * D;
    float acc = 0.f;
    for (int j = threadIdx.x; j < DFE; j += 256) { const float u = dot_hw(hr, a.in[24] + (size_t)e * D * DFE + j, D, DFE), vv = dot_hw(hr, a.in[25] + (size_t)e * D * DFE + j, D, DFE);
        acc += rbf(dsilu(u) * vv) * rbf(a.in[26][((size_t)e * DFE + j) * D + col]); }
    red[threadIdx.x] = acc; __syncthreads();
    for (int st = 128; st > 0; st >>= 1) { if (threadIdx.x < st) red[threadIdx.x] += red[threadIdx.x + st]; __syncthreads(); }
    if (threadIdx.x == 0) rec_err(ws, a.id, bf2f(((const bf16_t*)(ws + WS_Y))[(size_t)s * D + col]), red[0], 0.03f);
}
__global__ void dbg_final(DArgs a) {
    __shared__ float red[256];
    unsigned char* ws = a.ws; const int row = dhash(blockIdx.x) % NLAT; const int* rt = (const int*)(ws + WS_ROUTE + (size_t)row * 24); const float g1 = ((const float*)rt)[2], g2 = ((const float*)rt)[3];
    const float* xs = (const float*)(ws + DBG_ROWS) + blockIdx.x * D; const bf16_t* Y = (const bf16_t*)(ws + WS_Y); const float* mv = (const float*)(ws + WS_MODS) + (size_t)(33 + (row >> 11)) * DIN + 5 * D;
    float vals[4], ss = 0.f; for (int q = 0; q < 4; ++q) { const int c = threadIdx.x + 256 * q; vals[q] = xs[c] + mv[c] * (g1 * bf2f(Y[(size_t)rt[4] * D + c]) + g2 * bf2f(Y[(size_t)rt[5] * D + c])); ss += vals[q] * vals[q]; }
    red[threadIdx.x] = ss; __syncthreads();
    for (int st = 128; st > 0; st >>= 1) { if (threadIdx.x < st) red[threadIdx.x] += red[threadIdx.x + st]; __syncthreads(); }
    const float rstd = 1.f / sqrtf(red[0] / D + EPS);
    for (int q = 0; q < 4; ++q) { const int c = threadIdx.x + 256 * q; rec_err(ws, a.id, a.out[(size_t)row * D + c], vals[q] * rstd * a.in[27][c], 0.02f); }
}
__global__ void dbg_finalize(float* out, const unsigned char* ws, int n) {
    const float* err = (const float*)(ws + DBG_ERR); int bad = 0; float ratio = 0.f;
    for (int k = 1; k < 64; ++k) { float r = err[k] / (err[64 + k] + 1e-20f); const unsigned nb = ((const unsigned*)err)[128 + k]; const float thr = (k == 11 || k == 12 || k == 13 || k == 14 || k == 31 || k == 32 || k == 33) ? 3e-4f : 1e-4f; if (r > thr || nb > 0u) { bad = k; ratio = nb > 0u ? fmaxf(r, 1e-4f) : r; break; } }
    if (!bad) { for (int k = 1; k <= 43; ++k) if (k != 34 && err[64 + k] == 0.f) { bad = 30 + k; ratio = 1e-4f; break; } }
    if (!bad) return;
    float m = floorf(-2.f * log10f(fminf(ratio, 1.f))); m = fminf(fmaxf(m, 0.f), 8.f);
    if (bad == 16) { const unsigned* cu = (const unsigned*)err + 192; m = 0.5f * (float)((cu[4] ? 1 : 0) | (cu[5] ? 2 : 0) | (cu[6] ? 4 : 0) | (cu[7] ? 8 : 0)); bad = 48 + ((cu[0] ? 1 : 0) | (cu[1] ? 2 : 0) | (cu[2] ? 4 : 0) | (cu[3] ? 8 : 0)); }
    const float cst = sqrtf((1.f + m)) * powf(10.f, 0.5f * (float)bad);
    for (size_t i = (size_t)blockIdx.x * blockDim.x + threadIdx.x; i < (size_t)n; i += (size_t)gridDim.x * blockDim.x) out[i] = cst;
}
#endif

extern "C" void kernel_launch(void* const* d_in, const int* in_sizes, int n_in, void* d_out, int out_size, void* d_ws, size_t ws_size, hipStream_t stream) {
    static int grid = 0;
    if (grid == 0) {
        if (n_in != 28 || out_size != NLAT * D || ws_size < WS_END) { fprintf(stderr, "kernel_launch: unexpected problem (n_in %d, out %d, ws %zu)\n", n_in, out_size, ws_size); grid = -1; return; }
        int dev = 0, cus = 0, per_cu = 0;
        if (hipGetDevice(&dev) != hipSuccess || hipDeviceGetAttribute(&cus, hipDeviceAttributeMultiprocessorCount, dev) != hipSuccess) { grid = -1; return; }
        if (hipFuncSetAttribute((const void*)fwd_kernel, hipFuncAttributeMaxDynamicSharedMemorySize, LDS_BYTES) != hipSuccess) { fprintf(stderr, "kernel_launch: cannot set %d B dynamic LDS\n", LDS_BYTES); grid = -1; return; }
        if (hipOccupancyMaxActiveBlocksPerMultiprocessor(&per_cu, (const void*)fwd_kernel, 512, LDS_BYTES) != hipSuccess || per_cu < 1) fprintf(stderr, "kernel_launch: occupancy query says %d\n", per_cu);
        (void)hipGetLastError();
        grid = cus;
    }
    if (grid < 0) return;
    (void)hipMemsetAsync((char*)d_ws + WS_CTL, 0, CTL_BYTES, stream);
    Params a{};
    for (int i = 0; i < 28; ++i) a.in[i] = (const float*)d_in[i];
    a.out = (float*)d_out; a.ws = (unsigned char*)d_ws; a.ph_lo = 0; a.ph_hi = NPHASE; a.li = 0; a.pad = 0;
#if !DBG
    hipLaunchKernelGGL(fwd_kernel, dim3(grid), dim3(512), LDS_BYTES, stream, a);
#else
    (void)hipMemsetAsync((char*)d_ws + WS_DBG, 0, 4096, stream);
    DArgs da{}; for (int i = 0; i < 28; ++i) da.in[i] = (const float*)d_in[i]; da.out = (float*)d_out; da.ws = (unsigned char*)d_ws;
    static bool attr = false; if (!attr) { (void)hipFuncSetAttribute((const void*)dbg_scan, hipFuncAttributeMaxDynamicSharedMemorySize, 65536); attr = true; }
#define DCHK(K, ID, AUX, NBLK, NTHR) do { da.kind = (K); da.id = (ID); da.aux = (AUX); hipLaunchKernelGGL(dbg_check, dim3(NBLK), dim3(NTHR), 0, stream, da); } while (0)
#define DSNAP(K, AUX, NBLK, NTHR) do { da.kind = (K); da.aux = (AUX); hipLaunchKernelGGL(dbg_snap, dim3(NBLK), dim3(NTHR), 0, stream, da); } while (0)
    for (int ph = 0; ph < NPHASE; ++ph) {
        const int l = ph >= 10 ? 1 : 0, pb = 1 + 9 * l, base = l == 0 ? 0 : 20, k = ph - pb; da.l = l;
        if (ph >= 1 && ph <= 15 && k == 2) { DSNAP(20, 0, 64, 128); DSNAP(21, 0, 1024, 128); if (l == 0) DSNAP(21, 1, 256, 128); }
        if (ph >= 1 && ph <= 15 && k == 3) { DSNAP(22, 0, 16, 128); }
        if (ph == 15) DSNAP(8, 0, 32, 64);
        if (ph == 9) DSNAP(10, 0, 32, 64);
        if (ph == 19) DSNAP(23, 0, 16, 256);
        a.ph_lo = ph; a.ph_hi = ph + 1; a.li = ph;
        hipLaunchKernelGGL(fwd_kernel, dim3(grid), dim3(512), LDS_BYTES, stream, a);
        if (ph == 0) { DCHK(1, 1, 0, 16, 64); DCHK(30, 1, 0, 256, 64); }
        if (ph >= 1 && ph <= 15) {
            if (k == 0) DCHK(2, base + 2, 0, 32, 64);
            if (k == 1) DCHK(3, base + 3, 0, 128, 64);
            if (k == 2) { da.id = base + 11; hipLaunchKernelGGL(dbg_scan, dim3(64), dim3(128), 65536, stream, da);
                          da.id = base + 13; da.aux = 0; hipLaunchKernelGGL(dbg_attn, dim3(1024), dim3(128), 0, stream, da);
                          if (l == 0) { da.id = 14; da.aux = 1; hipLaunchKernelGGL(dbg_attn, dim3(256), dim3(128), 0, stream, da); } }
            if (k == 3) { DCHK(14, base + 15, 0, 1, 64); DCHK(6, base + 16, 0, 32, 64); }
            if (k == 4) DCHK(7, base + 17, 0, 32, 64);
            if (k == 5) DCHK(8, base + 18, 0, 32, 64);
        }
        if (ph == 7) DCHK(2, 19, 1, 32, 64);
        if (ph == 8) DCHK(9, 20, 0, 32, 64);
        if (ph == 9) DCHK(10, 21, 0, 32, 64);
        if (ph == 16) { DCHK(11, 39, 0, 32, 64); DCHK(2, 40, 2, 32, 64); }
        if (ph == 17) DCHK(12, 41, 0, 32, 64);
        if (ph == 18) { da.id = 42; hipLaunchKernelGGL(dbg_moey, dim3(128), dim3(256), 0, stream, da); }
        if (ph == 19) { da.id = 43; hipLaunchKernelGGL(dbg_final, dim3(16), dim3(256), 0, stream, da); }
    }
    hipLaunchKernelGGL(dbg_finalize, dim3(1024), dim3(256), 0, stream, (float*)d_out, (const unsigned char*)d_ws, out_size);
#endif
}
```

```cpp
#include <hip/hip_runtime.h>
#include <cstdio>
#include <cstdint>


constexpr int D = 1024, NB = 32, T = 2048, CL = 256;
constexpr int NLAT = NB * T, NCTX = NB * CL, NTOK = NLAT + NCTX;
constexpr int PW = 4096;
constexpr int DIN = 6144, DFF = 2752, DFFP = 2816, DFE = 3584, NE = 8;
constexpr float EPS = 1e-6f;
constexpr float LOG2E = 1.4426950408889634f;
constexpr float QSCALE = 0.125f * LOG2E;
constexpr int PC_Q = 0, PC_G = 512, PC_LF = 1024, PC_LB = 1536, PC_K = 2048, PC_V = 2560, PC_RQ = 3072, PC_RI = 3584, PC_GA = 2048, PC_GR = 3072;

constexpr size_t MiB = 1u << 20;
constexpr size_t WS_CTL = 0, CTL_BYTES = 1 * MiB;
constexpr size_t WS_MODS = 1 * MiB;
constexpr size_t WS_LBS = 3 * MiB;
constexpr size_t WS_ROPE = 3 * MiB + 65536;
constexpr size_t WS_ROUTE = 4 * MiB;
constexpr size_t WS_CNT = 6 * MiB;
constexpr size_t WS_CTXRES = 8 * MiB;
constexpr size_t WS_WIN = 40 * MiB;
constexpr size_t WS_WIN8 = 56 * MiB;
constexpr size_t WS_H8 = 809 * MiB;
constexpr size_t WS_WUA = 64 * MiB;
constexpr size_t WS_WUR = 66 * MiB;
constexpr size_t WS_WO = 68 * MiB;
constexpr size_t WS_W13 = 72 * MiB;
constexpr size_t WS_W2 = 83 * MiB;
constexpr size_t WS_H = 89 * MiB;
constexpr size_t WS_P = 233 * MiB;
constexpr size_t WS_MERGED = 809 * MiB;
constexpr size_t WS_HID = 233 * MiB;
constexpr size_t WS_WM13 = 8 * MiB;
constexpr size_t WS_WM2 = 120 * MiB;
constexpr size_t WS_AG = 176 * MiB;
constexpr size_t WS_MHID = 436 * MiB;
constexpr size_t WS_Y = 674 * MiB;
constexpr size_t WS_H2M = 896 * MiB;
constexpr size_t WS_END = 1024 * MiB;
constexpr int MOE_CHUNK = 128;

constexpr int CW_BAR = 4096;

#define LAS __attribute__((address_space(3)))
#define GAS __attribute__((address_space(1)))
typedef unsigned short bf16_t;
typedef short bf16x8 __attribute__((ext_vector_type(8)));
typedef short s16x4 __attribute__((ext_vector_type(4)));
typedef _Float16 half8 __attribute__((ext_vector_type(8)));
typedef _Float16 half4 __attribute__((ext_vector_type(4)));
typedef float f32x4 __attribute__((ext_vector_type(4)));
typedef float f32x2 __attribute__((ext_vector_type(2)));
typedef float f32x16 __attribute__((ext_vector_type(16)));
typedef unsigned u32x4 __attribute__((ext_vector_type(4)));
typedef unsigned u32x2 __attribute__((ext_vector_type(2)));
#define DI __device__ __forceinline__
#define LDS_WAIT() asm volatile("s_waitcnt lgkmcnt(0)" ::: "memory")
#define VM_WAIT() asm volatile("s_waitcnt vmcnt(0)" ::: "memory")

typedef __bf16 bf16x2_t __attribute__((ext_vector_type(2)));
DI unsigned cvt_pk_bf16(float lo, float hi) { f32x2 v = {lo, hi}; bf16x2_t b = __builtin_convertvector(v, bf16x2_t); return __builtin_bit_cast(unsigned, b); }
typedef int v8i32 __attribute__((ext_vector_type(8)));
typedef int v4i32 __attribute__((ext_vector_type(4)));
DI unsigned pack_fp8x4(float a, float b, float c, float d) {
    a = fminf(fmaxf(a, -448.f), 448.f); b = fminf(fmaxf(b, -448.f), 448.f); c = fminf(fmaxf(c, -448.f), 448.f); d = fminf(fmaxf(d, -448.f), 448.f);
    int w = 0; w = __builtin_amdgcn_cvt_pk_fp8_f32(a, b, w, false); w = __builtin_amdgcn_cvt_pk_fp8_f32(c, d, w, true); return (unsigned)w; }
DI float bf2f(unsigned short b) { return __uint_as_float(((unsigned)b) << 16); }
DI float bflo(unsigned w) { return __uint_as_float(w << 16); }
DI float bfhi(unsigned w) { return __uint_as_float(w & 0xffff0000u); }
DI float fsilu(float x) { return x * __builtin_amdgcn_rcpf(1.f + __expf(-x)); }
DI float fsigmoid(float x) { return __builtin_amdgcn_rcpf(1.f + __expf(-x)); }
DI float wave_sum(float v) {
#pragma unroll
    for (int o = 1; o < 64; o <<= 1) v += __shfl_xor(v, o);
    return v;
}
DI int crow(int r, int hi) { return (r & 3) + 8 * (r >> 2) + 4 * hi; }

constexpr int LDS_WTAB_OFF = 148480 + 128;
DI int my_tid() {
    extern __shared__ __attribute__((aligned(16))) unsigned char lds_raw[];
    const unsigned hw = (unsigned)__builtin_amdgcn_s_getreg((5 << 11) | 4) & 63u;
    const int w = __builtin_amdgcn_readfirstlane(((volatile LAS int*)((LAS unsigned char*)lds_raw + LDS_WTAB_OFF))[hw]);
    int t = w * 64 + (int)__builtin_amdgcn_mbcnt_hi(~0u, __builtin_amdgcn_mbcnt_lo(~0u, 0u));
    asm volatile("" : "+v"(t)); return t;
}
#define XB_TMO      128
#define XB_XCNT(j)  (256  + 64 * (j))
#define XB_XSUB(j)  (1280 + 64 * (j))
#define XB_XGEN(j)  (2304 + 64 * (j))
#define XB_TOP      3328
#define XB_TOPGEN   3392
#define XCD_BAR_WORDS 3456
#define XB_SPIN_CAP (1u << 22)
DI unsigned xb_ld(unsigned* p)              { return __hip_atomic_load(p, __ATOMIC_RELAXED, __HIP_MEMORY_SCOPE_AGENT); }
DI unsigned xb_add(unsigned* p, unsigned v) { return __hip_atomic_fetch_add(p, v, __ATOMIC_RELAXED, __HIP_MEMORY_SCOPE_AGENT); }
DI unsigned xb_xcc_id() { return (unsigned)__builtin_amdgcn_s_getreg((3 << 11) | 20) & 0xFu; }
#define XB_SPIN(cond, bar) do { unsigned _sp = 0; while (cond) { __builtin_amdgcn_s_sleep(1); \
    if ((++_sp & 255u) == 0u) { if (xb_ld(&(bar)[XB_TMO])) break; if (_sp > XB_SPIN_CAP) { atomicAdd(&(bar)[XB_TMO], 1u); break; } } } } while (0)
struct XcdBarrier { unsigned* bar; unsigned x; volatile LAS unsigned* st; };
DI XcdBarrier xcd_barrier_post(unsigned* bar, volatile LAS unsigned* st) {
    XcdBarrier b; b.bar = bar; b.x = xb_xcc_id(); b.st = st;
    if (my_tid() == 0) (void)xb_add(&bar[XB_XCNT(b.x)], 1u);
    return b;
}
DI void xcd_barrier_complete(unsigned* bar, unsigned x, unsigned& nloc, unsigned& nx) {
    const unsigned G = gridDim.x * gridDim.y * gridDim.z;
    unsigned sum, cnt, mine, sp = 0u;
    for (;;) {
        sum = 0u; cnt = 0u; mine = 0u;
#pragma unroll
        for (unsigned j = 0; j < 16; ++j) { const unsigned c = xb_ld(&bar[XB_XCNT(j)]); sum += c; cnt += (c > 0u) ? 1u : 0u; mine = (j == x) ? c : mine; }
        if (sum == G) break;
        __builtin_amdgcn_s_sleep(1);
        if ((++sp & 255u) == 0u) { if (xb_ld(&bar[XB_TMO])) break; if (sp > XB_SPIN_CAP) { atomicAdd(&bar[XB_TMO], 1u); break; } }
    }
    nloc = mine > 0u ? mine : 1u; nx = cnt > 0u ? cnt : 1u;
}
DI void xcd_barrier(const XcdBarrier& b) {
    asm volatile("s_waitcnt vmcnt(0)" ::: "memory");
    __syncthreads();
    if (my_tid() == 0) {
        unsigned* bar = b.bar;
        __builtin_amdgcn_s_waitcnt(0);
        unsigned nloc = b.st[0], nx = b.st[1];
        if (nloc == 0u) { xcd_barrier_complete(bar, b.x, nloc, nx); b.st[0] = nloc; b.st[1] = nx; }
        const unsigned old = xb_add(&bar[XB_XSUB(b.x)], 1u);
        const unsigned gen = old / nloc;
        if (old + 1u == (gen + 1u) * nloc) {
            __builtin_amdgcn_fence(__ATOMIC_RELEASE, "agent");
            asm volatile("s_waitcnt vmcnt(0)" ::: "memory");
            const unsigned og = xb_add(&bar[XB_TOP], 1u);
            const unsigned tg = og / nx;
            if (og + 1u == (tg + 1u) * nx) xb_add(&bar[XB_TOPGEN], 1u);
            else XB_SPIN(xb_ld(&bar[XB_TOPGEN]) == tg, bar);
            __builtin_amdgcn_fence(__ATOMIC_ACQUIRE, "agent");
            xb_add(&bar[XB_XGEN(b.x)], 1u);
            asm volatile("s_waitcnt vmcnt(0)" ::: "memory");
        } else {
            XB_SPIN(xb_ld(&bar[XB_XGEN(b.x)]) == gen, bar);
            __builtin_amdgcn_fence(__ATOMIC_ACQUIRE, "agent");
            asm volatile("s_waitcnt vmcnt(0)" ::: "memory");
        }
    }
    __syncthreads();
}

namespace pg8 {
constexpr int BM = 256, BK = 64, HALF = 128, HTB = HALF * BK * 2, STAGE_BYTES = 8 * HTB, NXCD = 8, WGM = 8;
__host__ __device__ __forceinline__ int lds_byte(int r, int c) { const int st = (r >> 4) * 2 + (c >> 5), rr = r & 15, cc = c & 31, ob = rr * 64 + cc * 2; return st * 1024 + (ob ^ (((ob >> 9) & 1) << 5)); }
__host__ __device__ __forceinline__ void stage_rc(int b, int& R, int& C) { const int st = b / 1024, sb = b % 1024, swz = sb ^ (((sb >> 9) & 1) << 5); R = (st >> 1) * 16 + swz / 64; C = (st & 1) * 32 + (swz % 64) / 2; }
__host__ __device__ __forceinline__ int perm32(int rho) { const int n = rho >> 4, i = rho & 15; return 8 * (i >> 2) + 4 * n + (i & 3); }

struct Unit { int pm, pn; const char* a; const char* b; };
struct Gemm { const bf16_t* A; const bf16_t* Bt; int M, N, K, lda; };

struct StaticOrder {
    int nM, nN, nwg, G, c;
    DI void init(const Gemm& g, int G_, int c_) { nM = g.M / BM; nN = g.N / BM; nwg = nM * nN; G = G_; c = c_; }
    DI bool tile(int i, int& pm, int& pn) const {
        const int L = i * G + c; if (L >= nwg) return false;
        int wgid = L; { const int q = nwg / NXCD, r = nwg % NXCD, xcd = wgid % NXCD, off = wgid / NXCD; wgid = (xcd < r ? xcd * (q + 1) : r * (q + 1) + (xcd - r) * q) + off; }
        const int nig = WGM * nN, gid = wgid / nig, fm = gid * WGM, gsz = (nM - fm) < WGM ? (nM - fm) : WGM;
        pm = fm + ((wgid % nig) % gsz); pn = (wgid % nig) / gsz; return true;
    }
    DI bool next(const Gemm& g, int i, Unit& u) const { if (!tile(i, u.pm, u.pn)) return false;
        u.a = (const char*)g.A + (size_t)u.pm * ((size_t)BM * g.lda * 2); u.b = (const char*)g.Bt + (size_t)u.pn * ((size_t)BM * g.K * 2); return true; }
};
struct MoeOrder {
    StaticOrder so; int p0, apan0; const int* pbv; size_t estride;
    DI bool next(const Gemm& g, int i, Unit& u) const {
        int pm, pn; if (!so.tile(i, pm, pn)) return false;
        u.pm = p0 + pm; u.pn = pn; int e = 0;
#pragma unroll
        for (int k = 1; k < 8; ++k) e += (u.pm >= __builtin_amdgcn_readfirstlane(pbv[k])) ? 1 : 0;
        u.a = (const char*)g.A + (size_t)(u.pm - apan0) * ((size_t)BM * g.lda * 2); u.b = (const char*)g.Bt + (size_t)e * estride + (size_t)pn * ((size_t)BM * g.K * 2); return true;
    }
};

template <class Epi, class Sched, bool ALIGN_EPI = true, bool F8 = false>
DI void gemm_phase(LAS unsigned char* lds, const Gemm g, const Sched& S, const Epi& E) {
    const int tid_ = my_tid();
    const int tid = tid_, wid = __builtin_amdgcn_readfirstlane(tid >> 6), lane = tid & 63, wr = wid >> 2, wc = wid & 3, fr = lane & 15, fq = lane >> 4;
    const int K = g.K, nt = K / BK;
    unsigned voffA[2], voffB[2];
#pragma unroll
    for (int i = 0; i < 2; ++i) { int R, C; stage_rc(tid * 16 + i * 8192, R, C); const int Rb = Epi::PERM ? ((R & ~31) + perm32(R & 31)) : R;
        voffA[i] = (unsigned)(R * g.lda + C) * 2u; voffB[i] = (unsigned)(Rb * K + C) * 2u; }
    const size_t kstep = (size_t)(BK * 2);
    const size_t hstepA = (size_t)HALF * g.lda * 2, hstepB = (size_t)HALF * K * 2;
    const unsigned ldsw = (unsigned)wid * 1024u;
    const int aoff = lds_byte(wr * 64 + fr, fq * 8), boff = lds_byte(wc * 32 + fr, fq * 8);
#define PG8_SA(b, h) (((b) * 2 + (h)) * HTB)
#define PG8_SB(b, h) ((4 + (b) * 2 + (h)) * HTB)
#define PG8_STAGE(bufoff, gbase, voff) do { _Pragma("unroll") for (int _i = 0; _i < 2; ++_i) \
        __builtin_amdgcn_global_load_lds((const unsigned*)((const char*)(gbase) + (voff)[_i]), (LAS unsigned*)(lds + (bufoff) + ldsw + _i * 8192), 16, 0, 0); } while (0)
#define PG8_LD8(p) __builtin_shufflevector(*(const LAS v4i32*)(p), *(const LAS v4i32*)((p) + 1024), 0, 1, 2, 3, 4, 5, 6, 7)
#define PG8_LDA(dst, b, h) do { if constexpr (F8) { _Pragma("unroll") for (int m = 0; m < 4; ++m) dst##8[m] = PG8_LD8(lds + PG8_SA(b, h) + aoff + m * 2048); } \
        else { _Pragma("unroll") for (int m = 0; m < 4; ++m) _Pragma("unroll") for (int k = 0; k < 2; ++k) dst[m][k] = *(const LAS bf16x8*)(lds + PG8_SA(b, h) + aoff + m * 2048 + k * 1024); } } while (0)
#define PG8_LDB(dst, b, h) do { if constexpr (F8) { _Pragma("unroll") for (int n = 0; n < 2; ++n) dst##8[n] = PG8_LD8(lds + PG8_SB(b, h) + boff + n * 2048); } \
        else { _Pragma("unroll") for (int n = 0; n < 2; ++n) _Pragma("unroll") for (int k = 0; k < 2; ++k) dst[n][k] = *(const LAS bf16x8*)(lds + PG8_SB(b, h) + boff + n * 2048 + k * 1024); } } while (0)
#define PG8_MMA(ai, bj, At, Bt) do { __builtin_amdgcn_s_setprio(1); \
        if constexpr (F8) { _Pragma("unroll") for (int m = 0; m < 4; ++m) _Pragma("unroll") for (int n = 0; n < 2; ++n) \
            asm volatile("v_mfma_scale_f32_16x16x128_f8f6f4 %0, %1, %2, %0, %3, %3 op_sel_hi:[0,0,0]" : "+v"(acc[ai][bj][m][n]) : "v"(Bt##8[n]), "v"(At##8[m]), "v"(one8)); } \
        else { _Pragma("unroll") for (int m = 0; m < 4; ++m) _Pragma("unroll") for (int n = 0; n < 2; ++n) _Pragma("unroll") for (int k = 0; k < 2; ++k) \
            acc[ai][bj][m][n] = __builtin_amdgcn_mfma_f32_16x16x32_bf16(Bt[n][k], At[m][k], acc[ai][bj][m][n], 0, 0, 0); } \
        __builtin_amdgcn_s_setprio(0); } while (0)
#define PG8_WAIT_V(n) asm volatile("s_waitcnt vmcnt(" #n ")" ::: "memory")
#define PG8_WAIT_L(n) asm volatile("s_waitcnt lgkmcnt(" #n ")" ::: "memory")
#define PG8_BAR __builtin_amdgcn_s_barrier()
#define PG8_SCHED __builtin_amdgcn_sched_barrier(0)
    Unit cur, nxt; int ui = 0;
    if (!S.next(g, 0, cur)) return;
    f32x4 acc[2][2][4][2];
#pragma unroll
    for (int a = 0; a < 2; ++a)
#pragma unroll
        for (int b = 0; b < 2; ++b)
#pragma unroll
            for (int m = 0; m < 4; ++m)
#pragma unroll
                for (int n = 0; n < 2; ++n) acc[a][b][m][n] = (f32x4){0.f, 0.f, 0.f, 0.f};
    bf16x8 At[4][2], B0[2][2], B1[2][2]; v8i32 At8[4], B08[2], B18[2]; const int one8 = 0x7F7F7F7F;
    const char* cA = cur.a; const char* cB = cur.b;
    PG8_STAGE(PG8_SB(0, 0), cB, voffB); PG8_STAGE(PG8_SB(0, 1), cB + hstepB, voffB); PG8_STAGE(PG8_SA(0, 0), cA, voffA); PG8_STAGE(PG8_SA(0, 1), cA + hstepA, voffA);
    if (wr == 1) PG8_BAR;
    PG8_WAIT_V(2); PG8_BAR;
    PG8_STAGE(PG8_SB(1, 0), cB + kstep, voffB); PG8_STAGE(PG8_SA(1, 0), cA + kstep, voffA); PG8_STAGE(PG8_SB(1, 1), cB + hstepB + kstep, voffB);
    PG8_WAIT_V(6); PG8_BAR;
    for (;;) {
        const bool has_next = S.next(g, ui + 1, nxt);
        const char* nA = has_next ? nxt.a : cA; const char* nB = has_next ? nxt.b : cB;
        for (int t = 0; t < nt; t += 2) {
            const bool last = (t == nt - 2);
            const char* a1 = cA + (size_t)(t + 1) * kstep;
            const char* a2 = last ? nA : cA + (size_t)(t + 2) * kstep; const char* b2 = last ? nB : cB + (size_t)(t + 2) * kstep;
            const char* a3 = a2 + kstep; const char* b3 = b2 + kstep;
            PG8_LDB(B0, 0, 0); PG8_LDB(B1, 0, 1); PG8_SCHED; PG8_LDA(At, 0, 0); PG8_STAGE(PG8_SA(1, 1), a1 + hstepA, voffA);
            PG8_WAIT_V(8); PG8_WAIT_L(0); PG8_BAR; PG8_MMA(0, 0, At, B0); PG8_MMA(0, 1, At, B1); PG8_BAR; PG8_SCHED;
            PG8_LDA(At, 0, 1); PG8_STAGE(PG8_SB(0, 0), b2, voffB); PG8_STAGE(PG8_SB(0, 1), b2 + hstepB, voffB); PG8_STAGE(PG8_SA(0, 0), a2, voffA);
            PG8_WAIT_V(8); PG8_WAIT_L(0); PG8_BAR; PG8_MMA(1, 0, At, B0); PG8_MMA(1, 1, At, B1); PG8_BAR; PG8_SCHED;
            PG8_LDB(B0, 1, 0); PG8_LDB(B1, 1, 1); PG8_SCHED; PG8_LDA(At, 1, 0); PG8_STAGE(PG8_SA(0, 1), a2 + hstepA, voffA);
            PG8_WAIT_V(8); PG8_WAIT_L(0); PG8_BAR; PG8_MMA(0, 0, At, B0); PG8_MMA(0, 1, At, B1); PG8_BAR; PG8_SCHED;
            PG8_LDA(At, 1, 1); PG8_STAGE(PG8_SB(1, 0), b3, voffB); PG8_STAGE(PG8_SB(1, 1), b3 + hstepB, voffB); PG8_STAGE(PG8_SA(1, 0), a3, voffA);
            PG8_WAIT_V(8); PG8_WAIT_L(0); PG8_BAR; PG8_MMA(1, 0, At, B0); PG8_MMA(1, 1, At, B1); PG8_BAR; PG8_SCHED;
        }
        if constexpr (ALIGN_EPI) { if (wr == 0) PG8_BAR; }
        if constexpr (F8) asm volatile("s_nop 15\n\ts_nop 15" ::: "memory");
        E(acc, cur, wr, wc, fr, fq);
        if (!has_next) break;
#pragma unroll
        for (int a = 0; a < 2; ++a)
#pragma unroll
            for (int b = 0; b < 2; ++b)
#pragma unroll
                for (int m = 0; m < 4; ++m)
#pragma unroll
                    for (int n = 0; n < 2; ++n) acc[a][b][m][n] = (f32x4){0.f, 0.f, 0.f, 0.f};
        cur = nxt; cA = nA; cB = nB; ++ui;
        if constexpr (ALIGN_EPI) { if (wr == 1) PG8_BAR; }
    }
    PG8_WAIT_V(0);
    if constexpr (!ALIGN_EPI) { if (wr == 0) PG8_BAR; }
    PG8_BAR;
#undef PG8_SA
#undef PG8_SB
#undef PG8_STAGE
#undef PG8_LDA
#undef PG8_LD8
#undef PG8_LDB
#undef PG8_MMA
#undef PG8_WAIT_V
#undef PG8_WAIT_L
#undef PG8_BAR
#undef PG8_SCHED
}
}
using pg8::Unit; using pg8::Gemm;
typedef const f32x4 (&AccRef)[2][2][4][2];

DI u32x4 pack8(const f32x4& v0, const f32x4& v1) { u32x4 w; w.x = cvt_pk_bf16(v0[0], v0[1]); w.y = cvt_pk_bf16(v0[2], v0[3]); w.z = cvt_pk_bf16(v1[0], v1[1]); w.w = cvt_pk_bf16(v1[2], v1[3]); return w; }
DI void unpack8(const u32x4& w, float (&f)[8]) { f[0] = bflo(w.x); f[1] = bfhi(w.x); f[2] = bflo(w.y); f[3] = bfhi(w.y); f[4] = bflo(w.z); f[5] = bfhi(w.z); f[6] = bflo(w.w); f[7] = bfhi(w.w); }

struct EpiInProj {
    static constexpr bool PERM = true;
    bf16_t* P; const float2* rope; const float* lbf; const float* lbb; int secmap; float asc;
    DI void operator()(AccRef acc, const Unit& u, int wr, int wc, int fr, int fq) const {
        const int row0 = u.pm * 256 + wr * 64 + fr, sec = (secmap >> (4 * (u.pn >> 1))) & 15;
        const int col0 = sec * 512 + (u.pn & 1) * 256 + wc * 32 + 8 * fq;
        const bool lat = u.pm < (NLAT / 256);
#pragma unroll
        for (int ai = 0; ai < 2; ++ai)
#pragma unroll
            for (int m = 0; m < 4; ++m) {
                const int row = row0 + ai * 128 + m * 16; bf16_t* rowp = P + (size_t)row * PW + col0;
#pragma unroll
                for (int bj = 0; bj < 2; ++bj) {
                    f32x4 v0 = acc[ai][bj][m][0] * asc, v1 = acc[ai][bj][m][1] * asc; u32x4 w;
                    if (sec == 0 || sec == 4) {
                        if (lat) {
                            const int pi = ((col0 + bj * 128) & 63) >> 1;
                            const f32x4* rp = (const f32x4*)(rope + (size_t)(row & (T - 1)) * 32 + pi);
                            const f32x4 r0 = rp[0], r1 = rp[1];
                            f32x4 o0, o1;
                            o0[0] = v0[0] * r0[0] - v0[1] * r0[1]; o0[1] = v0[0] * r0[1] + v0[1] * r0[0];
                            o0[2] = v0[2] * r0[2] - v0[3] * r0[3]; o0[3] = v0[2] * r0[3] + v0[3] * r0[2];
                            o1[0] = v1[0] * r1[0] - v1[1] * r1[1]; o1[1] = v1[0] * r1[1] + v1[1] * r1[0];
                            o1[2] = v1[2] * r1[2] - v1[3] * r1[3]; o1[3] = v1[2] * r1[3] + v1[3] * r1[2];
                            v0 = o0; v1 = o1;
                        }
                        if (sec == 0) { v0 = v0 * QSCALE; v1 = v1 * QSCALE; }
                        w = pack8(v0, v1);
                    } else if (sec == 1 || sec == 6) {
#pragma unroll
                        for (int j = 0; j < 4; ++j) { v0[j] = fsilu(v0[j]); v1[j] = fsilu(v1[j]); }
                        w = pack8(v0, v1);
                    } else if (sec == 2 || sec == 3) {
                        const float* lb = (sec == 2 ? lbf : lbb) + ((col0 + bj * 128) & 511);
                        const f32x4 b0 = *(const f32x4*)lb, b1 = *(const f32x4*)(lb + 4);
                        half8 hv;
#pragma unroll
                        for (int j = 0; j < 8; ++j) {
                            const float z = j < 4 ? v0[j] : v1[j - 4], b = j < 4 ? b0[j] : b1[j - 4];
                            const float ls = fminf(z, 0.f) - __logf(1.f + __expf(-fabsf(z)));
                            const float lf = b > 0.f ? __logf(b + (1.f - b) * __expf(ls)) : ls;
                            hv[j] = (_Float16)lf;
                        }
                        w = __builtin_bit_cast(u32x4, hv);
                    } else w = pack8(v0, v1);
                    *(u32x4*)(rowp + bj * 128) = w;
                }
            }
    }
};
struct EpiGates {
    static constexpr bool PERM = true; bf16_t* P; float asc;
    DI void operator()(AccRef acc, const Unit& u, int wr, int wc, int fr, int fq) const {
        const int row0 = u.pm * 256 + wr * 64 + fr, col0 = PC_GA + u.pn * 256 + wc * 32 + 8 * fq;
#pragma unroll
        for (int ai = 0; ai < 2; ++ai)
#pragma unroll
            for (int m = 0; m < 4; ++m) { bf16_t* rowp = P + (size_t)(row0 + ai * 128 + m * 16) * PW + col0;
#pragma unroll
                for (int bj = 0; bj < 2; ++bj) { f32x4 v0 = acc[ai][bj][m][0] * asc, v1 = acc[ai][bj][m][1] * asc;
#pragma unroll
                    for (int j = 0; j < 4; ++j) { v0[j] = fsigmoid(v0[j]); v1[j] = fsigmoid(v1[j]); }
                    *(u32x4*)(rowp + bj * 128) = pack8(v0, v1); } }
    }
};
template <bool FIRST> struct EpiMerge {
    static constexpr bool PERM = true; const bf16_t* P; int gcol; bf16_t* O;
    DI void operator()(AccRef acc, const Unit& u, int wr, int wc, int fr, int fq) const {
        const int row0 = u.pm * 256 + wr * 64 + fr, col0 = u.pn * 256 + wc * 32 + 8 * fq;
#pragma unroll
        for (int ai = 0; ai < 2; ++ai)
#pragma unroll
            for (int m = 0; m < 4; ++m) { const size_t row = (size_t)(row0 + ai * 128 + m * 16);
#pragma unroll
                for (int bj = 0; bj < 2; ++bj) {
                    const u32x4 gw = *(const u32x4*)(P + row * PW + gcol + col0 + bj * 128); float g[8]; unpack8(gw, g);
                    f32x4 v0 = acc[ai][bj][m][0], v1 = acc[ai][bj][m][1];
                    bf16_t* op = O + row * D + col0 + bj * 128;
                    float pv[8];
                    if (!FIRST) { const u32x4 ow = *(const u32x4*)op; unpack8(ow, pv); }
#pragma unroll
                    for (int j = 0; j < 4; ++j) { v0[j] = v0[j] * g[j] + (FIRST ? 0.f : pv[j]); v1[j] = v1[j] * g[4 + j] + (FIRST ? 0.f : pv[4 + j]); }
                    *(u32x4*)op = pack8(v0, v1); } }
    }
};
struct EpiResid {
    static constexpr bool PERM = false;
    const float* xin_l; const float* xin_c; float* xout_l; float* xout_c; const float* mods; int msel;
    DI void operator()(AccRef acc, const Unit& u, int wr, int wc, int fr, int fq) const {
        const bool lat = u.pm < (NLAT / 256);
        const int rbase = (lat ? u.pm : u.pm - NLAT / 256) * 256 + wr * 64 + fr, col0 = u.pn * 256 + wc * 32 + 4 * fq;
        const float* xi = lat ? xin_l : xin_c; float* xo = lat ? xout_l : xout_c;
        const float* mv = mods + (size_t)(lat ? (u.pm >> 3) : 32) * DIN + msel * D + col0;
        f32x4 g[2][2];
#pragma unroll
        for (int bj = 0; bj < 2; ++bj)
#pragma unroll
            for (int n = 0; n < 2; ++n) g[bj][n] = *(const f32x4*)(mv + bj * 128 + n * 16);
#pragma unroll
        for (int ai = 0; ai < 2; ++ai)
#pragma unroll
            for (int m = 0; m < 4; ++m) { const size_t off = (size_t)(rbase + ai * 128 + m * 16) * D + col0;
#pragma unroll
                for (int bj = 0; bj < 2; ++bj)
#pragma unroll
                    for (int n = 0; n < 2; ++n) { const f32x4 xv = *(const f32x4*)(xi + off + bj * 128 + n * 16);
                        *(f32x4*)(xo + off + bj * 128 + n * 16) = xv + g[bj][n] * acc[ai][bj][m][n]; } }
    }
};
struct EpiSwiglu {
    static constexpr bool PERM = true; bf16_t* Hd; int ldh; int pan0;
    DI void operator()(AccRef acc, const Unit& u, int wr, int wc, int fr, int fq) const {
        const int row0 = (u.pm - pan0) * 256 + wr * 64 + fr, hc0 = u.pn * 128 + wc * 16 + 4 * fq;
#pragma unroll
        for (int ai = 0; ai < 2; ++ai)
#pragma unroll
            for (int m = 0; m < 4; ++m) { bf16_t* rowp = Hd + (size_t)(row0 + ai * 128 + m * 16) * ldh + hc0;
#pragma unroll
                for (int bj = 0; bj < 2; ++bj) { const f32x4 a = acc[ai][bj][m][0], b = acc[ai][bj][m][1];
                    u32x2 w; w.x = cvt_pk_bf16(fsilu(a[0]) * b[0], fsilu(a[1]) * b[1]); w.y = cvt_pk_bf16(fsilu(a[2]) * b[2], fsilu(a[3]) * b[3]);
                    *(u32x2*)(rowp + bj * 64) = w; } }
    }
};
struct EpiSwiglu8 {
    static constexpr bool PERM = true; unsigned char* Hd; int ldh; int pan0; float as, hs;
    DI void operator()(AccRef acc, const Unit& u, int wr, int wc, int fr, int fq) const {
        const int row0 = (u.pm - pan0) * 256 + wr * 64 + fr, hc0 = u.pn * 128 + wc * 16 + 4 * fq;
#pragma unroll
        for (int ai = 0; ai < 2; ++ai)
#pragma unroll
            for (int m = 0; m < 4; ++m) { unsigned char* rowp = Hd + (size_t)(row0 + ai * 128 + m * 16) * ldh + hc0;
#pragma unroll
                for (int bj = 0; bj < 2; ++bj) { const f32x4 a = acc[ai][bj][m][0] * as, b = acc[ai][bj][m][1] * (as * hs);
                    *(unsigned*)(rowp + bj * 64) = pack_fp8x4(fsilu(a[0]) * b[0], fsilu(a[1]) * b[1], fsilu(a[2]) * b[2], fsilu(a[3]) * b[3]); } }
    }
};
struct EpiBf16 {
    static constexpr bool PERM = true; bf16_t* O; int ldc; float sc;
    DI void operator()(AccRef acc, const Unit& u, int wr, int wc, int fr, int fq) const {
        const int row0 = u.pm * 256 + wr * 64 + fr, col0 = u.pn * 256 + wc * 32 + 8 * fq;
#pragma unroll
        for (int ai = 0; ai < 2; ++ai)
#pragma unroll
            for (int m = 0; m < 4; ++m) { bf16_t* rowp = O + (size_t)(row0 + ai * 128 + m * 16) * ldc + col0;
#pragma unroll
                for (int bj = 0; bj < 2; ++bj) *(u32x4*)(rowp + bj * 128) = pack8(acc[ai][bj][m][0] * sc, acc[ai][bj][m][1] * sc); }
    }
};

typedef short v4i16 __attribute__((ext_vector_type(4)));
DI s16x4 tr16(const LAS unsigned char* p) { return __builtin_bit_cast(s16x4, __builtin_amdgcn_ds_read_tr16_b64_v4i16((LAS v4i16*)p)); }
DI bf16x8 cat8(s16x4 lo, s16x4 hi) { return __builtin_shufflevector(lo, hi, 0, 1, 2, 3, 4, 5, 6, 7); }
DI void dma16(const void* g, LAS unsigned char* l) { __builtin_amdgcn_global_load_lds((const unsigned*)g, (LAS unsigned*)l, 16, 0, 0); }
DI bf16x8 packf8(const f32x16& x, int s) {
    u32x4 w; w.x = cvt_pk_bf16(x[8 * s], x[8 * s + 1]); w.y = cvt_pk_bf16(x[8 * s + 2], x[8 * s + 3]); w.z = cvt_pk_bf16(x[8 * s + 4], x[8 * s + 5]); w.w = cvt_pk_bf16(x[8 * s + 6], x[8 * s + 7]);
    return __builtin_bit_cast(bf16x8, w);
}
#define MFMA32(a, b, c) __builtin_amdgcn_mfma_f32_32x32x16_bf16((a), (b), (c), 0, 0, 0)

struct Params { const float* in[28]; float* out; unsigned char* ws; int ph_lo, ph_hi, li, pad; };
typedef const __attribute__((address_space(4))) Params* KP;
DI KP kparams() { KP kp = (KP)__builtin_amdgcn_kernarg_segment_ptr(); asm volatile("" : "+s"(kp)); return kp; }
#define PIN(k) (kparams()->in[k])
#define POUT (kparams()->out)
struct Ctx {
    LAS unsigned char* lds; unsigned char* ws; int tid, lane, wave, vcu, G, gw, NGW, bx;
};

constexpr float WIN8_SCALE = 64.f;
#ifndef FP8_SECS
#define FP8_SECS 0x00
#endif
constexpr int SEC_ORDER[8] = {0, 2, 3, 4, 1, 5, 6, 7};
constexpr int sec_slot(int ps) { int nb = 0, nf = 0; for (int i = 0; i < 8; ++i) { const int s_ = SEC_ORDER[i]; const bool f = (FP8_SECS >> s_) & 1; if (s_ == ps) return f ? (0x100 | nf) : nb; if (f) ++nf; else ++nb; } return 0; }
constexpr int N_SEC_F8 = __builtin_popcount(FP8_SECS), N_SEC_BF = 8 - N_SEC_F8;
constexpr unsigned secmap_of(bool f8) { unsigned m = 0; int k = 0; for (int i = 0; i < 8; ++i) { const int s_ = SEC_ORDER[i]; if ((((FP8_SECS >> s_) & 1) != 0) == f8) { m |= (unsigned)s_ << (4 * k); ++k; } } return m; }
DI int map_row(int kind, int n);
DI int map_row4(int n) { return map_row(1, n) & 0xffff; }
DI int map_row(int kind, int n) {
    if (kind == 0) return n;
    if (kind == 4) return map_row4(n);
    if (kind == 2) return 8 * (n >> 2) + (n & 3);
    if (kind == 3) return 8 * (n >> 2) + (n & 3) + 4;
    const int sec = n >> 9, j = n & 511;
    if (n >= 4096) return (1 << 16) | (N_SEC_F8 * 512 + (n - 4096));
    const int ps = sec == 0 ? 0 : sec == 1 ? 4 : sec == 2 ? 5 : sec == 3 ? 6 : sec == 4 ? 7 : sec == 5 ? 2 : sec == 6 ? 3 : 1;
    const int sl = sec_slot(ps); int jj = j;
    if (sec == 0 || sec == 1) { const int hs = j >> 6, d = j & 63; jj = hs * 64 + (d < 32 ? 2 * d : 2 * (d - 32) + 1); }
    return ((sl & 0x100) ? (1 << 16) : 0) | ((sl & 0xff) * 512 + jj);
}
constexpr int TP_PITCH = 68, TP_SCR = 64 * TP_PITCH * 4;
DI void transpose_load(const float* W, int ldw, int k0, int n0, LAS float* scr, int lane) {
    const int r = lane >> 4, c4 = (lane & 15) * 4; f32x4 v[16];
#pragma unroll
    for (int i = 0; i < 16; ++i) v[i] = *(const f32x4*)(W + (size_t)(k0 + 4 * i + r) * ldw + n0 + c4);
#pragma unroll
    for (int i = 0; i < 16; ++i) *(LAS f32x4*)(scr + (4 * i + r) * TP_PITCH + c4) = v[i];
    LDS_WAIT(); asm volatile("" ::: "memory");
}
DI void transpose_item(const float* W, int ldw, int k0, int n0, bf16_t* WT, int ldt, int kind, LAS float* scr, int lane) {
    transpose_load(W, ldw, k0, n0, scr, lane);
    bf16_t* dst = WT + (size_t)map_row(kind, n0 + lane) * ldt + k0;
#pragma unroll
    for (int j = 0; j < 8; ++j) { const LAS float* s = scr + (8 * j) * TP_PITCH + lane;
        u32x4 o; o.x = cvt_pk_bf16(s[0], s[TP_PITCH]); o.y = cvt_pk_bf16(s[2 * TP_PITCH], s[3 * TP_PITCH]); o.z = cvt_pk_bf16(s[4 * TP_PITCH], s[5 * TP_PITCH]); o.w = cvt_pk_bf16(s[6 * TP_PITCH], s[7 * TP_PITCH]);
        *(u32x4*)(dst + 8 * j) = o; }
    LDS_WAIT(); asm volatile("" ::: "memory");
}
DI void transpose_item8(const float* W, int ldw, int k0, int n0, unsigned char* WT, int ldt, int kind, float sc, LAS float* scr, int lane) {
    transpose_load(W, ldw, k0, n0, scr, lane);
    unsigned char* dst = WT + (size_t)map_row(kind, n0 + lane) * ldt + k0;
#pragma unroll
    for (int j = 0; j < 4; ++j) { const LAS float* s = scr + (16 * j) * TP_PITCH + lane; u32x4 o;
        o.x = pack_fp8x4(s[0] * sc, s[TP_PITCH] * sc, s[2 * TP_PITCH] * sc, s[3 * TP_PITCH] * sc); o.y = pack_fp8x4(s[4 * TP_PITCH] * sc, s[5 * TP_PITCH] * sc, s[6 * TP_PITCH] * sc, s[7 * TP_PITCH] * sc);
        o.z = pack_fp8x4(s[8 * TP_PITCH] * sc, s[9 * TP_PITCH] * sc, s[10 * TP_PITCH] * sc, s[11 * TP_PITCH] * sc); o.w = pack_fp8x4(s[12 * TP_PITCH] * sc, s[13 * TP_PITCH] * sc, s[14 * TP_PITCH] * sc, s[15 * TP_PITCH] * sc);
        *(u32x4*)(dst + 16 * j) = o; }
    LDS_WAIT(); asm volatile("" ::: "memory");
}
DI void transpose_matrix8(const Ctx& C, const float* W, int K, int N, unsigned char* WT, int ldt, int kind, float sc, int& itbase) {
    LAS float* scr = (LAS float*)(C.lds + C.wave * TP_SCR);
    const int nblk = N / 64, nit = (K / 64) * nblk;
    int first = (C.gw - (itbase % C.NGW) + C.NGW) % C.NGW;
    for (int it = first; it < nit; it += C.NGW) transpose_item8(W, N, 64 * (it / nblk), 64 * (it % nblk), WT, ldt, kind, sc, scr, C.lane);
    itbase += nit;
}
DI void transpose_matrix(const Ctx& C, const float* W, int K, int N, bf16_t* WT, int ldt, int kind, int& itbase, int total_unused) {
    (void)total_unused;
    LAS float* scr = (LAS float*)(C.lds + C.wave * TP_SCR);
    const int nblk = N / 64, nit = (K / 64) * nblk;
    int first = (C.gw - (itbase % C.NGW) + C.NGW) % C.NGW;
    for (int it = first; it < nit; it += C.NGW) transpose_item(W, N, 64 * (it / nblk), 64 * (it % nblk), WT, ldt, kind, scr, C.lane);
    itbase += nit;
}
DI void transpose_win(const Ctx& C, const float* W, bf16_t* WA, unsigned char* W8, int& itbase) {
    LAS float* scr = (LAS float*)(C.lds + C.wave * TP_SCR);
    const int nblk = DIN / 64, nit = (D / 64) * nblk;
    int first = (C.gw - (itbase % C.NGW) + C.NGW) % C.NGW;
    for (int it = first; it < nit; it += C.NGW) { const int k0 = 64 * (it / nblk), n0 = 64 * (it % nblk);
        if (map_row(1, n0) >> 16) transpose_item8(W, DIN, k0, n0, W8, D, 4, WIN8_SCALE, scr, C.lane);
        else transpose_item(W, DIN, k0, n0, WA, D, 1, scr, C.lane); }
    itbase += nit;
}
DI void phase_prologue(const Ctx& C) {
    unsigned char* ws = C.ws;
    int itb = 0;
    for (int l = 0; l < 2; ++l) {
        transpose_win(C, PIN(8) + (size_t)l * D * DIN, (bf16_t*)(ws + WS_WIN) + (size_t)l * 4096 * D, ws + WS_WIN8 + (size_t)l * 4096 * D, itb);
        transpose_matrix(C, PIN(17) + (size_t)l * 512 * D, 512, D, (bf16_t*)(ws + WS_WUA) + (size_t)l * D * 512, 512, 0, itb, 0);
        transpose_matrix(C, PIN(18) + (size_t)l * 512 * D, 512, D, (bf16_t*)(ws + WS_WUR) + (size_t)l * D * 512, 512, 0, itb, 0);
        transpose_matrix(C, PIN(19) + (size_t)l * D * D, D, D, (bf16_t*)(ws + WS_WO) + (size_t)l * D * D, D, 0, itb, 0);
    }
    transpose_matrix(C, PIN(20), D, DFF, (bf16_t*)(ws + WS_W13), D, 2, itb, 0);
    transpose_matrix(C, PIN(21), D, DFF, (bf16_t*)(ws + WS_W13), D, 3, itb, 0);
    transpose_matrix(C, PIN(22), DFF, D, (bf16_t*)(ws + WS_W2), DFFP, 0, itb, 0);
    { const int gt = C.vcu * 512 + C.tid, NT = C.G * 512;
      bf16_t* w13 = (bf16_t*)(ws + WS_W13) + (size_t)(2 * DFF) * D;
      for (int i = gt; i < (2 * DFFP - 2 * DFF) * D / 8; i += NT) ((u32x4*)w13)[i] = (u32x4){0u, 0u, 0u, 0u};
      bf16_t* w2 = (bf16_t*)(ws + WS_W2);
      for (int i = gt; i < D * (DFFP - DFF) / 8; i += NT) { const int r = i / ((DFFP - DFF) / 8), cc = i % ((DFFP - DFF) / 8); *(u32x4*)(w2 + (size_t)r * DFFP + DFF + cc * 8) = (u32x4){0u, 0u, 0u, 0u}; }
      float2* rope = (float2*)(ws + WS_ROPE);
      for (int i = gt; i < T * 32; i += NT) { const int t = i >> 5, pi = i & 31; const float invf = exp2f(-(float)(pi & 15) * (13.287712379549449f / 16.f));
          const float ang = (float)(pi < 16 ? (t >> 6) : (t & 63)) * invf; rope[i] = make_float2(cosf(ang), sinf(ang)); }
      float* lbs = (float*)(ws + WS_LBS);
      for (int i = gt; i < 2 * 2 * 512; i += NT) { const int l = i >> 10, dir = (i >> 9) & 1, d = i & 511; const float* lb = PIN(dir ? 16 : 15);
          const float p0 = lb[d], p1 = lb[512 + d]; lbs[i] = l == 0 ? 0.f : 1.f / (1.f + expf(p0 - p1)); }
    }
    { float* mods = (float*)(ws + WS_MODS);
      for (int task = C.gw; task < 2 * 33 * 96; task += C.NGW) {
          const int ng = task % 96, r = (task / 96) % 33, l = task / (96 * 33), n = ng * 64 + C.lane;
          const float* cv = r < 32 ? PIN(1) + r * D : PIN(3); const float* W = PIN(4) + (size_t)l * D * DIN + n;
          float acc = PIN(5)[l * DIN + n];
          for (int k0 = 0; k0 < D; k0 += 64) { const float sv = fsilu(cv[k0 + C.lane]);
#pragma unroll 16
              for (int j = 0; j < 64; ++j) acc += __uint_as_float(__builtin_amdgcn_readlane(__float_as_uint(sv), j)) * W[(size_t)(k0 + j) * DIN]; }
          mods[(size_t)(l * 33 + r) * DIN + n] = acc; } }
}
constexpr float W13_SCALE = 64.f, W2_SCALE = 128.f, HID_SCALE = 8.f;
DI void convert_moe_weights(const Ctx& C) {
    unsigned char* ws = C.ws; int itb = 0;
    for (int e = 0; e < NE; ++e) {
        transpose_matrix8(C, PIN(24) + (size_t)e * D * DFE, D, DFE, ws + WS_WM13 + (size_t)e * 2 * DFE * D, D, 2, W13_SCALE, itb);
        transpose_matrix8(C, PIN(25) + (size_t)e * D * DFE, D, DFE, ws + WS_WM13 + (size_t)e * 2 * DFE * D, D, 3, W13_SCALE, itb);
        transpose_matrix8(C, PIN(26) + (size_t)e * DFE * D, DFE, D, ws + WS_WM2 + (size_t)e * D * DFE, DFE, 0, W2_SCALE, itb);
    }
}

template <bool ROUTER>
DI void phase_norm(const Ctx& C, const float* xl, const float* xc, const float* nw, const float* mods, int shsel, int nrows, bf16_t* Hout, const float* rw, unsigned char* route, LAS int* cntL, unsigned char* H8 = nullptr) {
    int nloc = 0;
    f32x4 rwr[4][4][2];
    if (ROUTER) {
#pragma unroll
        for (int j = 0; j < 4; ++j)
#pragma unroll
            for (int q = 0; q < 4; ++q) { const float* rp = rw + (size_t)(256 * j + 4 * C.lane + q) * 8; rwr[j][q][0] = *(const f32x4*)rp; rwr[j][q][1] = *(const f32x4*)(rp + 4); } }
    for (int row0 = C.gw; row0 < nrows; row0 += 2 * C.NGW) {
        const int rows[2] = {row0, row0 + C.NGW}; const bool two = rows[1] < nrows;
        f32x4 v[2][4]; float ss[2] = {0.f, 0.f};
#pragma unroll
        for (int u = 0; u < 2; ++u) { const int row = (u == 1 && !two) ? rows[0] : rows[u]; const float* xr = row < NLAT ? xl + (size_t)row * D : xc + (size_t)(row - NLAT) * D;
#pragma unroll
            for (int j = 0; j < 4; ++j) { v[u][j] = *(const f32x4*)(xr + 256 * j + 4 * C.lane); ss[u] += (v[u][j][0] * v[u][j][0] + v[u][j][1] * v[u][j][1]) + (v[u][j][2] * v[u][j][2] + v[u][j][3] * v[u][j][3]); } }
#pragma unroll
        for (int u = 0; u < 2; ++u) { if (u == 1 && !two) break;
            const int row = rows[u]; const bool lat = row < NLAT;
            const float* mv = mods + (size_t)(lat ? (row >> 11) : 32) * DIN + shsel * D;
            const float rstd = 1.0f / sqrtf(wave_sum(ss[u]) * (1.f / D) + EPS);
            float lg[8];
            if (ROUTER) {
#pragma unroll
                for (int e = 0; e < 8; ++e) lg[e] = 0.f; }
#pragma unroll
            for (int j = 0; j < 4; ++j) { const int c0 = 256 * j + 4 * C.lane;
                const f32x4 w = *(const f32x4*)(nw + c0), sh = *(const f32x4*)(mv + c0), sc = *(const f32x4*)(mv + D + c0);
                f32x4 h = (v[u][j] * rstd) * w * (sc + 1.0f) + sh;
                if (ROUTER) *(unsigned*)((unsigned char*)Hout + (size_t)row * D + c0) = pack_fp8x4(h[0], h[1], h[2], h[3]);
                else { u32x2 o; o.x = cvt_pk_bf16(h[0], h[1]); o.y = cvt_pk_bf16(h[2], h[3]); *(u32x2*)(Hout + (size_t)row * D + c0) = o;
                       if (H8) *(unsigned*)(H8 + (size_t)row * D + c0) = pack_fp8x4(h[0], h[1], h[2], h[3]); }
                if (ROUTER) {
#pragma unroll
                    for (int q = 0; q < 4; ++q) { const f32x4 r0 = rwr[j][q][0], r1 = rwr[j][q][1];
                        lg[0] += h[q] * r0[0]; lg[1] += h[q] * r0[1]; lg[2] += h[q] * r0[2]; lg[3] += h[q] * r0[3]; lg[4] += h[q] * r1[0]; lg[5] += h[q] * r1[1]; lg[6] += h[q] * r1[2]; lg[7] += h[q] * r1[3]; } }
            }
            if (ROUTER) {
                const bool b5 = (C.lane & 32) != 0, b4 = (C.lane & 16) != 0, b3 = (C.lane & 8) != 0; float a4[4], a2[2], a1;
#pragma unroll
                for (int j = 0; j < 4; ++j) { const float snd = b5 ? lg[j] : lg[4 + j]; a4[j] = (b5 ? lg[4 + j] : lg[j]) + __shfl_xor(snd, 32); }
#pragma unroll
                for (int j = 0; j < 2; ++j) { const float snd = b4 ? a4[j] : a4[2 + j]; a2[j] = (b4 ? a4[2 + j] : a4[j]) + __shfl_xor(snd, 16); }
                { const float snd = b3 ? a2[0] : a2[1]; a1 = (b3 ? a2[1] : a2[0]) + __shfl_xor(snd, 8); }
                a1 += __shfl_xor(a1, 4); a1 += __shfl_xor(a1, 2); a1 += __shfl_xor(a1, 1);
                if ((C.lane & 7) == 0) ((LAS float*)(C.lds + C.wave * 4096))[nloc * 8 + (C.lane >> 3)] = a1;
                ++nloc;
            }
        }
    }
    if (ROUTER) {
        LDS_WAIT();
        for (int i = C.lane; i < nloc; i += 64) { const int row = C.gw + i * C.NGW; const LAS float* lp = (const LAS float*)(C.lds + C.wave * 4096) + i * 8;
            float lg[8];
#pragma unroll
            for (int e = 0; e < 8; ++e) lg[e] = lp[e];
            int e1 = 0; float l1 = lg[0];
#pragma unroll
            for (int e = 1; e < 8; ++e) if (lg[e] > l1) { l1 = lg[e]; e1 = e; }
            int e2 = -1; float l2 = -INFINITY;
#pragma unroll
            for (int e = 0; e < 8; ++e) if (e != e1 && lg[e] > l2) { l2 = lg[e]; e2 = e; }
            const float g2 = 1.f / (1.f + expf(l1 - l2)), g1 = 1.f - g2;
            int* rt = (int*)(route + (size_t)row * 24); rt[0] = e1; rt[1] = e2; ((float*)rt)[2] = g1; ((float*)rt)[3] = g2;
            atomicAdd((int*)&cntL[e1], 1); atomicAdd((int*)&cntL[e2], 1);
        }
    }
}

constexpr int AT_XCH = 65536;
DI float max3f(float a, float b, float c) { return fmaxf(fmaxf(a, b), c); }
DI void attn_unit(const Ctx& C, bf16_t* P, int qrow0, int krow_ctx, int krow_lat, int nkt, int h, float lam, const float* anw, float post) {
    const int tid_ = my_tid();
    LAS unsigned char* lds = C.lds; const int lane = tid_ & 63, wid = __builtin_amdgcn_readfirstlane(tid_ >> 6), sub = wid >> 2, qw = wid & 3, r32 = lane & 31, hh = lane >> 5;
    const int tq = (lane & 15) >> 2, tp = lane & 3, blk = (lane >> 4) & 1;
    LAS unsigned char* qlds = lds + AT_XCH + wid * 8192 + r32 * 16;
#pragma unroll
    for (int qb = 0; qb < 2; ++qb) { const bf16_t* qp = P + (size_t)(qrow0 + 64 * qw + 32 * qb + r32) * PW + PC_Q + h * 128 + sub * 64 + 8 * hh;
#pragma unroll
      for (int ks = 0; ks < 4; ++ks) *(LAS bf16x8*)(qlds + ((2 * ks + hh) * 64 + 32 * qb) * 16) = *(const bf16x8*)(qp + 16 * ks); }
    f32x16 O[2][4];
#pragma unroll
    for (int qb = 0; qb < 2; ++qb)
#pragma unroll
        for (int c = 0; c < 4; ++c)
#pragma unroll
            for (int i = 0; i < 16; ++i) O[qb][c][i] = 0.f;
    float m_run[2] = {-INFINITY, -INFINITY}, l_run[2] = {0.f, 0.f};
#define AT_ISSUE(kt, buf) do { const int kr0_ = (kt) < 4 ? krow_ctx + (kt) * 64 : krow_lat + ((kt) - 4) * 64; LAS unsigned char* bb_ = lds + (buf) * 32768; \
        _Pragma("unroll") for (int j_ = 0; j_ < 2; ++j_) { const int c_ = 2 * wid + j_; \
            dma16(P + (size_t)(kr0_ + lane) * PW + PC_K + h * 128 + c_ * 8, bb_ + c_ * 1024); \
            dma16(P + (size_t)(kr0_ + 16 * (c_ & 3) + (lane >> 2)) * PW + PC_V + h * 128 + (c_ >> 2) * 32 + (lane & 3) * 8, bb_ + 16384 + c_ * 1024); } } while (0)
    AT_ISSUE(0, 0);
    int buf = 0;
#pragma unroll 1
    for (int kt = 0; kt < nkt; ++kt) {
        VM_WAIT(); __syncthreads();
        if (kt + 1 < nkt) AT_ISSUE(kt + 1, buf ^ 1);
        const LAS unsigned char* kb = lds + buf * 32768, * vb = kb + 16384 + (4 * hh + tq) * 64 + blk * 32 + tp * 8;
        bf16x8 Pf[2][4];
#pragma unroll
        for (int qb = 0; qb < 2; ++qb) {
            f32x16 s0, s1;
#pragma unroll
            for (int i = 0; i < 16; ++i) { s0[i] = 0.f; s1[i] = 0.f; }
#pragma unroll
            for (int ks = 0; ks < 4; ++ks) { const LAS unsigned char* kp = kb + ((sub * 8 + 2 * ks + hh) * 64 + r32) * 16;
                const bf16x8 k0 = *(const LAS bf16x8*)kp, k1 = *(const LAS bf16x8*)(kp + 512);
                const bf16x8 q = *(const LAS bf16x8*)(qlds + ((2 * ks + hh) * 64 + 32 * qb) * 16);
                s0 = MFMA32(k0, q, s0); s1 = MFMA32(k1, q, s1); }
            float mx = max3f(s0[0], s1[0], s0[1]);
#pragma unroll
            for (int i = 1; i < 16; ++i) mx = (i + 1 < 16) ? max3f(mx, s1[i], s0[i + 1]) : fmaxf(mx, s1[i]);
            mx = fmaxf(mx, __shfl_xor(mx, 32));
            const float mnew = fmaxf(m_run[qb], mx);
            if (__any(mnew > m_run[qb])) { const float alpha = __builtin_amdgcn_exp2f(m_run[qb] - mnew); l_run[qb] *= alpha;
#pragma unroll
                for (int c = 0; c < 4; ++c)
#pragma unroll
                    for (int i = 0; i < 16; ++i) O[qb][c][i] *= alpha;
                m_run[qb] = mnew; }
            const float mr = m_run[qb]; float ps0 = 0.f, ps1 = 0.f;
#pragma unroll
            for (int i = 0; i < 16; ++i) { s0[i] = __builtin_amdgcn_exp2f(s0[i] - mr); s1[i] = __builtin_amdgcn_exp2f(s1[i] - mr); ps0 += s0[i]; ps1 += s1[i]; }
            l_run[qb] += ps0 + ps1;
            Pf[qb][0] = packf8(s0, 0); Pf[qb][1] = packf8(s0, 1); Pf[qb][2] = packf8(s1, 0); Pf[qb][3] = packf8(s1, 1);
        }
#pragma unroll
        for (int cb = 0; cb < 4; ++cb) {
#pragma unroll
            for (int s4 = 0; s4 < 4; ++s4) { const bf16x8 a = cat8(tr16(vb + cb * 4096 + s4 * 1024), tr16(vb + cb * 4096 + s4 * 1024 + 512));
                O[0][cb] = MFMA32(a, Pf[0][s4], O[0][cb]); O[1][cb] = MFMA32(a, Pf[1][s4], O[1][cb]); } }
        buf ^= 1;
    }
#undef AT_ISSUE
    LDS_WAIT(); __syncthreads();
    const int te = my_tid(); const int lane_e = te & 63, wid_e = __builtin_amdgcn_readfirstlane(te >> 6);
    LAS float* xch = (LAS float*)(lds + AT_XCH) + (wid_e & 3) * 4096 + lane_e;
#pragma unroll
    for (int qb = 0; qb < 2; ++qb) {
        const float lt = l_run[qb] + __shfl_xor(l_run[qb], 32); const float inv = 1.f / lt;
        if ((wid_e >> 2) == 1) { const float sc = -lam * inv;
#pragma unroll
            for (int c = 0; c < 4; ++c)
#pragma unroll
                for (int i = 0; i < 16; ++i) xch[(c * 16 + i) * 64] = O[qb][c][i] * sc; }
        LDS_WAIT(); __syncthreads();
        if ((wid_e >> 2) == 0) {
            float ss = 0.f;
#pragma unroll
            for (int c = 0; c < 4; ++c)
#pragma unroll
                for (int i = 0; i < 16; ++i) { const float o = O[qb][c][i] * inv + xch[(c * 16 + i) * 64]; O[qb][c][i] = o; ss += o * o; }
            ss += __shfl_xor(ss, 32);
            const float rs = post / sqrtf(ss * (1.f / 128.f) + EPS);
            bf16_t* op = P + (size_t)(qrow0 + 64 * (wid_e & 3) + 32 * qb + (lane_e & 31)) * PW + PC_Q + h * 128;
#pragma unroll
            for (int c = 0; c < 4; ++c)
#pragma unroll
                for (int g = 0; g < 4; ++g) { const int v0 = 32 * c + 8 * g + 4 * (lane_e >> 5); const f32x4 w = *(const f32x4*)(anw + v0);
                    u32x2 o; o.x = cvt_pk_bf16(O[qb][c][4 * g] * rs * w[0], O[qb][c][4 * g + 1] * rs * w[1]); o.y = cvt_pk_bf16(O[qb][c][4 * g + 2] * rs * w[2], O[qb][c][4 * g + 3] * rs * w[3]);
                    *(u32x2*)(op + v0) = o; }
        }
        LDS_WAIT(); __syncthreads();
    }
}

constexpr int SC_Q = 0, SC_LF = 16384, SC_V0 = 32768, SC_QM = 65536, SC_KMR = 81920, SC_KMS = 98304, SC_SX = 114688, SC_A31 = 147456, SC_A63 = 147968, SC_END = 148480;
DI void scan_chain(const Ctx& C, bf16_t* P, int b, int h, int dir, bool store_ctx) {
    const int tid_ = my_tid();
    LAS unsigned char* lds = C.lds; const int lane = tid_ & 63, wid = __builtin_amdgcn_readfirstlane(tid_ >> 6), r32 = lane & 31, hh = lane >> 5;
    const int tq = (lane & 15) >> 2, tp = lane & 3, blk = (lane >> 4) & 1;
    const int db = wid & 3, tb = wid >> 2;
    const int base_nat = hh * 512 + tq * 64 + blk * 32 + tp * 8;
    const int base_prm = (4 * hh + tq) * 64 + blk * 32 + tp * 8;
    const int lfcol = (dir ? PC_LB : PC_LF) + h * 128, qcol = PC_RQ + h * 128, vcol = PC_RI + h * 128;
    f32x16 ST[2];
#pragma unroll
    for (int j = 0; j < 2; ++j)
#pragma unroll
        for (int i = 0; i < 16; ++i) ST[j][i] = 0.f;
#define SROW(c, i) ((c) < 4 ? NLAT + b * CL + (dir ? 255 - ((c) * 64 + (i)) : (c) * 64 + (i)) : b * T + (dir ? 2047 - (((c) - 4) * 64 + (i)) : ((c) - 4) * 64 + (i)))
#define SDMA(c, colbase, dstoff) do { _Pragma("unroll") for (int j_ = 0; j_ < 2; ++j_) { const int I_ = 2 * wid + j_; const int ti_ = 16 * (I_ & 3) + (lane >> 2); \
        dma16(P + (size_t)SROW(c, ti_) * PW + (colbase) + (I_ >> 2) * 32 + (lane & 3) * 8, lds + (dstoff) + I_ * 1024); } } while (0)
    SDMA(0, qcol, SC_Q); SDMA(0, lfcol, SC_LF); SDMA(0, vcol, SC_V0);
    int vbuf = 0;
    const int t = 32 * tb + r32;
#pragma unroll 1
    for (int c = 0; c < 36; ++c) {
        VM_WAIT(); __syncthreads();
        const LAS unsigned char* Vimg = lds + SC_V0 + vbuf * 16384;
        f32x16 cm;
#pragma unroll
        for (int i = 0; i < 16; ++i) cm[i] = 0.f;
#pragma unroll
        for (int kk = 0; kk < 2; ++kk) { const int ks = 2 * tb + kk;
            const half8 a = __builtin_bit_cast(half8, cat8(tr16(lds + SC_LF + db * 4096 + base_nat + ks * 1024), tr16(lds + SC_LF + db * 4096 + base_nat + ks * 1024 + 256)));
            half8 bm;
#pragma unroll
            for (int j = 0; j < 8; ++j) { const int s = 16 * ks + 8 * hh + j; bm[j] = tb == 0 ? (s > t ? (_Float16)-1.f : (_Float16)0.f) : (s <= t ? (_Float16)1.f : (_Float16)0.f); }
            cm = __builtin_amdgcn_mfma_f32_32x32x16_f16(a, bm, cm, 0, 0, 0); }
#pragma unroll
        for (int g = 0; g < 4; ++g) {
            const int sa = db * 4096 + (t >> 3) * 512 + (t & 7) * 64 + (8 * g + 4 * hh) * 2;
            const u32x2 q4 = *(const LAS u32x2*)(lds + SC_Q + sa); const half4 lf4 = *(const LAS half4*)(lds + SC_LF + sa);
            const float qv[4] = {bflo(q4.x), bfhi(q4.x), bflo(q4.y), bfhi(q4.y)};
            float qm[4], km[4];
#pragma unroll
            for (int e = 0; e < 4; ++e) { const float cv = cm[4 * g + e] * LOG2E; const float E = __builtin_amdgcn_exp2f(cv), Ei = __builtin_amdgcn_exp2f(-cv);
                const float lf = (float)lf4[e]; qm[e] = qv[e] * E; km[e] = (1.f - __builtin_amdgcn_exp2f(lf * LOG2E)) * Ei;
                if (tb == 0 && r32 == 0) ((LAS float*)(lds + SC_A31))[32 * db + 8 * g + 4 * hh + e] = lf - cm[4 * g + e];
                if (tb == 1 && r32 == 31) ((LAS float*)(lds + SC_A63))[32 * db + 8 * g + 4 * hh + e] = cm[4 * g + e]; }
            u32x2 qw2, kw2; qw2.x = cvt_pk_bf16(qm[0], qm[1]); qw2.y = cvt_pk_bf16(qm[2], qm[3]); kw2.x = cvt_pk_bf16(km[0], km[1]); kw2.y = cvt_pk_bf16(km[2], km[3]);
            const int ra = ((4 * db + g) * 64 + t) * 16 + 8 * hh;
            *(LAS u32x2*)(lds + SC_QM + ra) = qw2; *(LAS u32x2*)(lds + SC_KMR + ra) = kw2; *(LAS u32x2*)(lds + SC_KMS + sa) = kw2;
        }
        LDS_WAIT(); __syncthreads();
        { const int d = 32 * db + r32; const float c31 = ((LAS float*)(lds + SC_A31))[d], c63 = ((LAS float*)(lds + SC_A63))[d];
          const float e31 = __expf(c31), dec = __expf(c31 + c63), e63 = __expf(c63);
          f32x16 SN[2];
#pragma unroll
          for (int j = 0; j < 2; ++j) { const int vb2 = 2 * tb + j;
#pragma unroll
              for (int g = 0; g < 4; ++g) { u32x2 w; w.x = cvt_pk_bf16(ST[j][4 * g] * e31, ST[j][4 * g + 1] * e31); w.y = cvt_pk_bf16(ST[j][4 * g + 2] * e31, ST[j][4 * g + 3] * e31);
                  *(LAS u32x2*)(lds + SC_SX + vb2 * 8192 + (d >> 3) * 512 + (d & 7) * 64 + (8 * g + 4 * hh) * 2) = w; }
#pragma unroll
              for (int i = 0; i < 16; ++i) SN[j][i] = 0.f; }
#pragma unroll
          for (int ks = 0; ks < 4; ++ks) {
              const bf16x8 kf = cat8(tr16(lds + SC_KMS + db * 4096 + base_nat + ks * 1024), tr16(lds + SC_KMS + db * 4096 + base_nat + ks * 1024 + 256));
#pragma unroll
              for (int j = 0; j < 2; ++j) { const int vb2 = 2 * tb + j;
                  const bf16x8 vf = cat8(tr16(Vimg + vb2 * 4096 + base_nat + ks * 1024), tr16(Vimg + vb2 * 4096 + base_nat + ks * 1024 + 256));
                  SN[j] = MFMA32(vf, kf, SN[j]); } }
#pragma unroll
          for (int j = 0; j < 2; ++j)
#pragma unroll
              for (int i = 0; i < 16; ++i) ST[j][i] = dec * ST[j][i] + e63 * SN[j][i];
        }
        LDS_WAIT(); __syncthreads();
        if (c + 1 < 36) { SDMA(c + 1, qcol, SC_Q); SDMA(c + 1, lfcol, SC_LF); SDMA(c + 1, vcol, SC_V0 + (vbuf ^ 1) * 16384); }
        { bf16x8 Qmf[8];
#pragma unroll
          for (int kd = 0; kd < 8; ++kd) Qmf[kd] = *(const LAS bf16x8*)(lds + SC_QM + ((2 * kd + hh) * 64 + t) * 16);
          f32x16 o;
#pragma unroll
          for (int i = 0; i < 16; ++i) o[i] = 0.f;
          for (int sb = 0; sb <= tb; ++sb) {
              f32x16 pt;
#pragma unroll
              for (int i = 0; i < 16; ++i) pt[i] = 0.f;
#pragma unroll
              for (int kd = 0; kd < 8; ++kd) { const bf16x8 a = *(const LAS bf16x8*)(lds + SC_KMR + ((2 * kd + hh) * 64 + 32 * sb + r32) * 16); pt = MFMA32(a, Qmf[kd], pt); }
              if (sb == tb) {
#pragma unroll
                  for (int i = 0; i < 16; ++i) if (crow(i, hh) > r32) pt[i] = 0.f; }
              const bf16x8 p0 = packf8(pt, 0), p1 = packf8(pt, 1);
              { const bf16x8 a = cat8(tr16(Vimg + db * 4096 + base_prm + (2 * sb) * 1024), tr16(Vimg + db * 4096 + base_prm + (2 * sb) * 1024 + 512)); o = MFMA32(a, p0, o); }
              { const bf16x8 a = cat8(tr16(Vimg + db * 4096 + base_prm + (2 * sb + 1) * 1024), tr16(Vimg + db * 4096 + base_prm + (2 * sb + 1) * 1024 + 512)); o = MFMA32(a, p1, o); }
          }
#pragma unroll
          for (int kd = 0; kd < 8; ++kd) { const bf16x8 a = cat8(tr16(lds + SC_SX + db * 8192 + base_nat + kd * 1024), tr16(lds + SC_SX + db * 8192 + base_nat + kd * 1024 + 256)); o = MFMA32(a, Qmf[kd], o); }
          if (c >= 4 || store_ctx) { bf16_t* op = P + (size_t)SROW(c, t) * PW + lfcol + 32 * db;
#pragma unroll
              for (int g = 0; g < 4; ++g) { u32x2 w; w.x = cvt_pk_bf16(o[4 * g], o[4 * g + 1]); w.y = cvt_pk_bf16(o[4 * g + 2], o[4 * g + 3]); *(u32x2*)(op + 8 * g + 4 * hh) = w; } }
        }
        vbuf ^= 1;
    }
    VM_WAIT(); LDS_WAIT(); __syncthreads();
#undef SROW
#undef SDMA
}

DI void phase_recprep(const Ctx& C, bf16_t* P, const float* rnw, int nrows) {
    for (int row = C.gw; row < nrows; row += C.NGW) {
        bf16_t* pr = P + (size_t)row * PW + 8 * C.lane;
        float a[8], bb[8], g[8]; unpack8(*(const u32x4*)(pr + PC_LF), a); unpack8(*(const u32x4*)(pr + PC_LB), bb); unpack8(*(const u32x4*)(pr + PC_G), g);
        float ss = 0.f;
#pragma unroll
        for (int j = 0; j < 8; ++j) { a[j] += bb[j]; ss += a[j] * a[j]; }
        ss += __shfl_xor(ss, 1); ss += __shfl_xor(ss, 2); ss += __shfl_xor(ss, 4); ss += __shfl_xor(ss, 8);
        const float rs = 1.0f / sqrtf(ss * (1.f / 128.f) + EPS);
        const f32x4 w0 = *(const f32x4*)(rnw + ((8 * C.lane) & 127)), w1 = *(const f32x4*)(rnw + ((8 * C.lane) & 127) + 4);
        f32x4 o0, o1;
#pragma unroll
        for (int j = 0; j < 4; ++j) { o0[j] = a[j] * rs * w0[j] * g[j]; o1[j] = a[4 + j] * rs * w1[j] * g[4 + j]; }
        *(u32x4*)(pr + PC_LF) = pack8(o0, o1);
    }
}

DI void phase_slots(const Ctx& C, const int* cnt, int* pbout, unsigned char* route, const bf16_t* H2, bf16_t* AG, LAS int* cur) {
    if (C.tid < 16) cur[C.tid] = 0;
    __syncthreads();
    for (int g = C.tid; g < C.G; g += 512) {
#pragma unroll
        for (int k = 0; k < 8; ++k) { const int c = cnt[g * 8 + k]; atomicAdd((int*)&cur[8 + k], c); if (g < C.bx) atomicAdd((int*)&cur[k], c); } }
    __syncthreads();
    if (C.tid < 8) { const int e = C.tid; int pb = 0, pbe = 0;
#pragma unroll
        for (int k = 0; k < 8; ++k) { if (k == e) pbe = pb; pb += (cur[8 + k] + 255) >> 8; }
        const int mine = cur[e];
        if (C.bx == 0) { pbout[e] = pbe; if (e == 7) pbout[8] = pb; }
        cur[e] = pbe * 256 + mine;
    }
    __syncthreads();
    const int nloc = (NLAT - C.gw + C.NGW - 1) / C.NGW;
    LAS int* tab = (LAS int*)(C.lds + C.wave * 2048);
    for (int i = C.lane; i < nloc; i += 64) { int* rt = (int*)(route + (size_t)(C.gw + i * C.NGW) * 24);
        const int s1 = atomicAdd((int*)&cur[rt[0]], 1), s2 = atomicAdd((int*)&cur[rt[1]], 1); rt[4] = s1; rt[5] = s2; tab[2 * i] = s1; tab[2 * i + 1] = s2; }
    LDS_WAIT();
    for (int i = 0; i < nloc; i += 2) { const int i1 = i + 1 < nloc ? i + 1 : i;
        const int sa1 = __builtin_amdgcn_readfirstlane(tab[2 * i]), sa2 = __builtin_amdgcn_readfirstlane(tab[2 * i + 1]), sb1 = __builtin_amdgcn_readfirstlane(tab[2 * i1]), sb2 = __builtin_amdgcn_readfirstlane(tab[2 * i1 + 1]);
        const u32x4 va = *((const u32x4*)((const unsigned char*)H2 + (size_t)(C.gw + i * C.NGW) * D) + C.lane);
        const u32x4 vb = *((const u32x4*)((const unsigned char*)H2 + (size_t)(C.gw + i1 * C.NGW) * D) + C.lane);
        *((u32x4*)((unsigned char*)AG + (size_t)sa1 * D) + C.lane) = va; *((u32x4*)((unsigned char*)AG + (size_t)sa2 * D) + C.lane) = va;
        *((u32x4*)((unsigned char*)AG + (size_t)sb1 * D) + C.lane) = vb; *((u32x4*)((unsigned char*)AG + (size_t)sb2 * D) + C.lane) = vb;
    }
}
DI void phase_final(const Ctx& C, float* x, const unsigned char* route, const bf16_t* Y, const float* mods1, const float* fw) {
    for (int row0 = C.gw; row0 < NLAT; row0 += 2 * C.NGW) {
        const int rows[2] = {row0, row0 + C.NGW < NLAT ? row0 + C.NGW : row0};
        f32x4 v[2][4]; float ss[2] = {0.f, 0.f};
#pragma unroll
        for (int u = 0; u < 2; ++u) { const int row = rows[u];
            const int* rt = (const int*)(route + (size_t)row * 24); const float g1 = ((const float*)rt)[2], g2 = ((const float*)rt)[3]; const int s1 = rt[4], s2 = rt[5];
            const float* mv = mods1 + (size_t)(row >> 11) * DIN + 5 * D; const float* xr = x + (size_t)row * D;
#pragma unroll
            for (int j = 0; j < 4; ++j) { const int c0 = 256 * j + 4 * C.lane;
                const u32x2 y1 = *(const u32x2*)(Y + (size_t)s1 * D + c0), y2 = *(const u32x2*)(Y + (size_t)s2 * D + c0); const f32x4 m5 = *(const f32x4*)(mv + c0);
                f32x4 y; y[0] = g1 * bflo(y1.x) + g2 * bflo(y2.x); y[1] = g1 * bfhi(y1.x) + g2 * bfhi(y2.x); y[2] = g1 * bflo(y1.y) + g2 * bflo(y2.y); y[3] = g1 * bfhi(y1.y) + g2 * bfhi(y2.y);
                v[u][j] = *(const f32x4*)(xr + c0) + m5 * y; ss[u] += (v[u][j][0] * v[u][j][0] + v[u][j][1] * v[u][j][1]) + (v[u][j][2] * v[u][j][2] + v[u][j][3] * v[u][j][3]); } }
#pragma unroll
        for (int u = 0; u < 2; ++u) { if (u == 1 && rows[1] == rows[0]) break;
            const float rstd = 1.0f / sqrtf(wave_sum(ss[u]) * (1.f / D) + EPS); float* xr = x + (size_t)rows[u] * D;
#pragma unroll
            for (int j = 0; j < 4; ++j) { const int c0 = 256 * j + 4 * C.lane; *(f32x4*)(xr + c0) = v[u][j] * rstd * *(const f32x4*)(fw + c0); } }
    }
}

constexpr int LDS_MISC = SC_END;
constexpr int LDS_BYTES = SC_END + 512;
static_assert(LDS_WTAB_OFF == SC_END + 128, "wave table sits behind the barrier words and counters");
constexpr int NPHASE = 20;

DI Ctx make_ctx() {
    extern __shared__ __attribute__((aligned(16))) unsigned char lds_raw[];
    Ctx C; const int t = my_tid();
    unsigned lb = (unsigned)(size_t)(LAS unsigned char*)lds_raw; asm volatile("" : "+s"(lb));
    C.lds = (LAS unsigned char*)(size_t)lb; C.ws = kparams()->ws; C.tid = t; C.lane = t & 63; C.wave = __builtin_amdgcn_readfirstlane(t >> 6);
    int bx = blockIdx.x, G = gridDim.x; asm volatile("" : "+s"(bx), "+s"(G));
    C.bx = bx; C.G = G; C.vcu = (C.G % 8 == 0) ? (bx % 8) * (C.G / 8) + bx / 8 : bx;
    C.gw = C.vcu * 8 + C.wave; C.NGW = C.G * 8;
    return C;
}
DI void grid_barrier() {
    extern __shared__ __attribute__((aligned(16))) unsigned char lds_raw[];
    XcdBarrier b; b.bar = (unsigned*)(kparams()->ws + WS_CTL) + CW_BAR + kparams()->li * XCD_BAR_WORDS; b.x = xb_xcc_id(); b.st = (volatile LAS unsigned*)((LAS unsigned char*)lds_raw + LDS_MISC);
    xcd_barrier(b);
}
#define WSP(T, off) ((T*)(kparams()->ws + (off)))

#define IN(k) (kparams()->ph_lo <= (k) && (k) < kparams()->ph_hi)
#define SEAM(k) do { if (IN(k) && IN((k) + 1)) grid_barrier(); } while (0)


template <int l> DI void layer_phases() {
        const int pb = 1 + 9 * l;
#define LQ() int lq = l; asm volatile("" : "+s"(lq))
#define XL (lq == 0 ? PIN(0) : (const float*)POUT)
#define XC (lq == 0 ? PIN(2) : (const float*)WSP(float, WS_CTXRES))
#define LMODS (WSP(float, WS_MODS) + (size_t)lq * 33 * DIN)
#define NROWS_OUT (lq == 0 ? NTOK : NLAT)
        if (IN(pb + 0)) { LQ(); const Ctx C = make_ctx(); phase_norm<false>(C, XL, XC, PIN(6) + lq * D, LMODS, 0, NTOK, WSP(bf16_t, WS_H), nullptr, nullptr, nullptr, WSP(unsigned char, WS_H8)); }
        SEAM(pb + 0);
        if (IN(pb + 1)) { LQ();
            { const Ctx C = make_ctx();
              Gemm g{WSP(bf16_t, WS_H), WSP(bf16_t, WS_WIN) + (size_t)lq * 4096 * D, NTOK, N_SEC_BF * 512, D, D};
              pg8::StaticOrder S; S.init(g, C.G, C.bx);
              EpiInProj E{WSP(bf16_t, WS_P), WSP(float2, WS_ROPE), WSP(float, WS_LBS) + lq * 1024, WSP(float, WS_LBS) + lq * 1024 + 512, (int)secmap_of(false), 1.f};
              pg8::gemm_phase<EpiInProj, pg8::StaticOrder>(C.lds, g, S, E); }
            if (N_SEC_F8 > 0) { const Ctx C = make_ctx();
              Gemm g{WSP(bf16_t, WS_H8), (const bf16_t*)(WSP(unsigned char, WS_WIN8) + (size_t)lq * 4096 * D), NTOK, N_SEC_F8 * 512, D / 2, D / 2};
              pg8::StaticOrder S; S.init(g, C.G, C.bx);
              EpiInProj E{WSP(bf16_t, WS_P), WSP(float2, WS_ROPE), WSP(float, WS_LBS) + lq * 1024, WSP(float, WS_LBS) + lq * 1024 + 512, (int)secmap_of(true), 1.f / WIN8_SCALE};
              pg8::gemm_phase<EpiInProj, pg8::StaticOrder, true, true>(C.lds, g, S, E); }
        }
        SEAM(pb + 1);
        if (IN(pb + 2)) { LQ(); const Ctx C = make_ctx(); bf16_t* const Pb = WSP(bf16_t, WS_P);
            for (int id = C.vcu; id < NB * 4 * 2; id += C.G) scan_chain(C, Pb, id >> 3, (id >> 1) & 3, id & 1, lq == 0);
            float lam;
            { const float a = wave_sum(PIN(9)[lq * 64 + C.lane] * PIN(10)[lq * 64 + C.lane]), b2 = wave_sum(PIN(11)[lq * 64 + C.lane] * PIN(12)[lq * 64 + C.lane]);
              const float li = 0.8f - 0.6f * expf(-0.3f * (float)lq); lam = expf(a) - expf(b2) + li; lam = __uint_as_float(__builtin_amdgcn_readfirstlane(__float_as_uint(lam))); }
            const float post = __uint_as_float(__builtin_amdgcn_readfirstlane(__float_as_uint(1.f - (0.8f - 0.6f * expf(-0.3f * (float)lq)))));
            const float* anw = PIN(13) + lq * 128;
            const int NU = NB * 4 * 8, U = (NU + C.G - 1) / C.G;
            for (int id = C.vcu * U; id < NU && id < (C.vcu + 1) * U; ++id) { const int bh = id >> 3, qb = id & 7, b = bh >> 2, h = bh & 3;
                attn_unit(C, Pb, b * T + qb * 256, NLAT + b * CL, b * T, 36, h, lam, anw, post); }
            if (lq == 0) for (int id = C.vcu; id < NB * 4; id += C.G) { const int b = id >> 2, h = id & 3;
                attn_unit(C, Pb, NLAT + b * CL, NLAT + b * CL, 0, 4, h, lam, anw, post); }
        }
        SEAM(pb + 2);
        if (IN(pb + 3)) { LQ(); const Ctx C = make_ctx();
            phase_recprep(C, WSP(bf16_t, WS_P), PIN(14) + lq * 128, NROWS_OUT);
            Gemm g{WSP(bf16_t, WS_H8), (const bf16_t*)(WSP(unsigned char, WS_WIN8) + ((size_t)lq * 4096 + N_SEC_F8 * 512) * D), NROWS_OUT, 2048, D / 2, D / 2};
            pg8::StaticOrder S; S.init(g, C.G, C.bx);
            EpiGates E{WSP(bf16_t, WS_P), 1.f / WIN8_SCALE};
            pg8::gemm_phase<EpiGates, pg8::StaticOrder, true, true>(C.lds, g, S, E);
        }
        SEAM(pb + 3);
        if (IN(pb + 4)) { LQ();
            { const Ctx C = make_ctx(); Gemm g{WSP(bf16_t, WS_P) + PC_Q, WSP(bf16_t, WS_WUA) + (size_t)lq * D * 512, NROWS_OUT, D, 512, PW};
              pg8::StaticOrder S; S.init(g, C.G, C.bx); EpiMerge<true> E{WSP(bf16_t, WS_P), PC_GA, WSP(bf16_t, WS_MERGED)};
              pg8::gemm_phase<EpiMerge<true>, pg8::StaticOrder>(C.lds, g, S, E); }
            { const Ctx C = make_ctx(); Gemm g{WSP(bf16_t, WS_P) + PC_LF, WSP(bf16_t, WS_WUR) + (size_t)lq * D * 512, NROWS_OUT, D, 512, PW};
              pg8::StaticOrder S; S.init(g, C.G, C.bx); EpiMerge<false> E{WSP(bf16_t, WS_P), PC_GR, WSP(bf16_t, WS_MERGED)};
              pg8::gemm_phase<EpiMerge<false>, pg8::StaticOrder>(C.lds, g, S, E); }
        }
        SEAM(pb + 4);
        if (IN(pb + 5)) { LQ(); const Ctx C = make_ctx();
            Gemm g{WSP(bf16_t, WS_MERGED), WSP(bf16_t, WS_WO) + (size_t)lq * D * D, NROWS_OUT, D, D, D};
            pg8::StaticOrder S; S.init(g, C.G, C.bx);
            EpiResid E{XL, XC, POUT, WSP(float, WS_CTXRES), LMODS, 2};
            pg8::gemm_phase<EpiResid, pg8::StaticOrder>(C.lds, g, S, E);
        }
        SEAM(pb + 5);
        if (l == 0) {
            if (IN(7)) { LQ(); const Ctx C = make_ctx(); phase_norm<false>(C, POUT, WSP(float, WS_CTXRES), PIN(7), LMODS, 3, NTOK, WSP(bf16_t, WS_H), nullptr, nullptr, nullptr); }
            SEAM(7);
            if (IN(8)) { LQ(); const Ctx C = make_ctx();
                Gemm g{WSP(bf16_t, WS_H), WSP(bf16_t, WS_W13), NTOK, 2 * DFFP, D, D};
                pg8::StaticOrder S; S.init(g, C.G, C.bx); EpiSwiglu E{WSP(bf16_t, WS_HID), DFFP, 0};
                pg8::gemm_phase<EpiSwiglu, pg8::StaticOrder>(C.lds, g, S, E);
            }
            SEAM(8);
            if (IN(9)) { LQ(); const Ctx C = make_ctx();
                Gemm g{WSP(bf16_t, WS_HID), WSP(bf16_t, WS_W2), NTOK, D, DFFP, DFFP};
                pg8::StaticOrder S; S.init(g, C.G, C.bx); EpiResid E{POUT, WSP(float, WS_CTXRES), POUT, WSP(float, WS_CTXRES), LMODS, 5};
                pg8::gemm_phase<EpiResid, pg8::StaticOrder>(C.lds, g, S, E);
            }
            SEAM(9);
        } else {
            if (IN(16)) { LQ(); const Ctx C = make_ctx(); LAS int* lcnt = (LAS int*)(C.lds + LDS_MISC + 32);
                if (C.tid < 8) lcnt[C.tid] = 0;
                __syncthreads();
                phase_norm<true>(C, POUT, nullptr, PIN(7) + D, LMODS, 3, NLAT, WSP(bf16_t, WS_H2M), PIN(23), WSP(unsigned char, WS_ROUTE), lcnt);
                __syncthreads();
                if (C.tid < 8) WSP(int, WS_CNT)[C.bx * 8 + C.tid] = lcnt[C.tid];
                convert_moe_weights(C);
            }
            SEAM(16);
            if (IN(17)) { LQ(); const Ctx C = make_ctx(); phase_slots(C, WSP(int, WS_CNT), WSP(int, WS_CNT) + 4096, WSP(unsigned char, WS_ROUTE), WSP(bf16_t, WS_H2M), WSP(bf16_t, WS_AG), (LAS int*)(C.lds + LDS_MISC + 32)); }
            SEAM(17);
            if (IN(18)) { LQ();
                const int ptot = __builtin_amdgcn_readfirstlane(WSP(int, WS_CNT)[4096 + 8]);
                for (int p0 = 0; p0 < ptot; p0 += MOE_CHUNK) {
                    const int np = (ptot - p0) < MOE_CHUNK ? (ptot - p0) : MOE_CHUNK;
#define MOE_ORDER_INIT(S) do { S.so.init(g, C.G, C.bx); S.p0 = p0; S.pbv = WSP(int, WS_CNT) + 4096; } while (0)
                    { const Ctx C = make_ctx(); Gemm g{WSP(bf16_t, WS_AG), WSP(bf16_t, WS_WM13), np * 256, 2 * DFE, D / 2, D / 2};
                      pg8::MoeOrder S; MOE_ORDER_INIT(S); S.apan0 = 0; S.estride = (size_t)2 * DFE * D;
                      EpiSwiglu8 E{WSP(unsigned char, WS_MHID), DFE, p0, 1.f / W13_SCALE, HID_SCALE};
                      pg8::gemm_phase<EpiSwiglu8, pg8::MoeOrder, true, true>(C.lds, g, S, E); }
                    grid_barrier();
                    { const Ctx C = make_ctx(); Gemm g{WSP(bf16_t, WS_MHID), WSP(bf16_t, WS_WM2), np * 256, D, DFE / 2, DFE / 2};
                      pg8::MoeOrder S; MOE_ORDER_INIT(S); S.apan0 = p0; S.estride = (size_t)D * DFE;
                      EpiBf16 E{WSP(bf16_t, WS_Y), D, 1.f / (W2_SCALE * HID_SCALE)};
                      pg8::gemm_phase<EpiBf16, pg8::MoeOrder, true, true>(C.lds, g, S, E); }
                    grid_barrier();
                }
            }
            if (IN(19)) { LQ(); const Ctx C = make_ctx(); phase_final(C, POUT, WSP(unsigned char, WS_ROUTE), WSP(bf16_t, WS_Y), LMODS, PIN(27)); }
        }
}

__global__ void __launch_bounds__(512, 2) fwd_kernel(Params p) {
    extern __shared__ __attribute__((aligned(16))) unsigned char lds_raw[];
    (void)p;
    { volatile LAS unsigned* misc = (volatile LAS unsigned*)((LAS unsigned char*)lds_raw + LDS_MISC);
      if (threadIdx.x < 16) misc[threadIdx.x] = 0u;
      if ((threadIdx.x & 63) == 0) ((volatile LAS int*)((LAS unsigned char*)lds_raw + LDS_WTAB_OFF))[(unsigned)__builtin_amdgcn_s_getreg((5 << 11) | 4) & 63u] = threadIdx.x >> 6;
      __syncthreads();
      (void)xcd_barrier_post((unsigned*)(kparams()->ws + WS_CTL) + CW_BAR + kparams()->li * XCD_BAR_WORDS, misc); }
    if (IN(0)) { const Ctx C = make_ctx(); phase_prologue(C); } SEAM(0);

    layer_phases<0>();
    layer_phases<1>();
#undef IN
#undef SEAM
}


extern "C" void kernel_launch(void* const* d_in, const int* in_sizes, int n_in, void* d_out, int out_size, void* d_ws, size_t ws_size, hipStream_t stream) {
    static int grid = 0;
    if (grid == 0) {
        if (n_in != 28 || out_size != NLAT * D || ws_size < WS_END) { fprintf(stderr, "kernel_launch: unexpected problem (n_in %d, out %d, ws %zu)\n", n_in, out_size, ws_size); grid = -1; return; }
        int dev = 0, cus = 0, per_cu = 0;
        if (hipGetDevice(&dev) != hipSuccess || hipDeviceGetAttribute(&cus, hipDeviceAttributeMultiprocessorCount, dev) != hipSuccess) { grid = -1; return; }
        if (hipFuncSetAttribute((const void*)fwd_kernel, hipFuncAttributeMaxDynamicSharedMemorySize, LDS_BYTES) != hipSuccess) { fprintf(stderr, "kernel_launch: cannot set %d B dynamic LDS\n", LDS_BYTES); grid = -1; return; }
        if (hipOccupancyMaxActiveBlocksPerMultiprocessor(&per_cu, (const void*)fwd_kernel, 512, LDS_BYTES) != hipSuccess || per_cu < 1) fprintf(stderr, "kernel_launch: occupancy query says %d\n", per_cu);
        (void)hipGetLastError();
        grid = cus;
    }
    if (grid < 0) return;
    (void)hipMemsetAsync((char*)d_ws + WS_CTL, 0, CTL_BYTES, stream);
    Params a{};
    for (int i = 0; i < 28; ++i) a.in[i] = (const float*)d_in[i];
    a.out = (float*)d_out; a.ws = (unsigned char*)d_ws; a.ph_lo = 0; a.ph_hi = NPHASE; a.li = 0; a.pad = 0;
    hipLaunchKernelGGL(fwd_kernel, dim3(grid), dim3(512), LDS_BYTES, stream, a);
}
```

```cpp
#include <hip/hip_runtime.h>
#include <cstdio>
#include <cstdint>


constexpr int D = 1024, NB = 32, T = 2048, CL = 256;
constexpr int NLAT = NB * T, NCTX = NB * CL, NTOK = NLAT + NCTX;
constexpr int PW = 4096;
constexpr int DIN = 6144, DFF = 2752, DFFP = 2816, DFE = 3584, NE = 8;
constexpr float EPS = 1e-6f;
constexpr float LOG2E = 1.4426950408889634f;
constexpr float QSCALE = 0.125f * LOG2E;
constexpr int PC_Q = 0, PC_LF = 512, PC_G = 1024, PC_LB = 1536, PC_K = 2048, PC_V = 2560, PC_RQ = 3072, PC_RI = 3584, PC_GA = 2048, PC_GR = 3072;

constexpr size_t MiB = 1u << 20;
constexpr size_t WS_CTL = 0, CTL_BYTES = 1 * MiB;
constexpr size_t WS_MODS = 1 * MiB;
constexpr size_t WS_LBS = 3 * MiB;
constexpr size_t WS_ROPE = 3 * MiB + 65536;
constexpr size_t WS_ROUTE = 4 * MiB;
constexpr size_t WS_CNT = 6 * MiB;
constexpr size_t WS_CTXRES = 8 * MiB;
constexpr size_t WS_WIN = 40 * MiB;
constexpr size_t WS_WIN8 = 56 * MiB;
constexpr size_t WS_H8 = 809 * MiB;
constexpr size_t WS_WUA = 64 * MiB;
constexpr size_t WS_WUR = 66 * MiB;
constexpr size_t WS_WO = 68 * MiB;
constexpr size_t WS_W13 = 72 * MiB;
constexpr size_t WS_W2 = 83 * MiB;
constexpr size_t WS_H = 89 * MiB;
constexpr size_t WS_P = 233 * MiB;
constexpr size_t WS_MERGED = 809 * MiB;
constexpr size_t WS_HID = 233 * MiB;
constexpr size_t WS_WM13 = 8 * MiB;
constexpr size_t WS_WM2 = 120 * MiB;
constexpr size_t WS_AG = 176 * MiB;
constexpr size_t WS_MHID = 436 * MiB;
constexpr size_t WS_Y = 674 * MiB;
constexpr size_t WS_H2M = 896 * MiB;
constexpr size_t WS_END = 1024 * MiB;
constexpr int MOE_CHUNK = 256;

constexpr int CW_BAR = 4096;

#define LAS __attribute__((address_space(3)))
#define GAS __attribute__((address_space(1)))
typedef unsigned short bf16_t;
typedef short bf16x8 __attribute__((ext_vector_type(8)));
typedef short s16x4 __attribute__((ext_vector_type(4)));
typedef _Float16 half8 __attribute__((ext_vector_type(8)));
typedef _Float16 half4 __attribute__((ext_vector_type(4)));
typedef float f32x4 __attribute__((ext_vector_type(4)));
typedef float f32x2 __attribute__((ext_vector_type(2)));
typedef float f32x16 __attribute__((ext_vector_type(16)));
typedef unsigned u32x4 __attribute__((ext_vector_type(4)));
typedef unsigned u32x2 __attribute__((ext_vector_type(2)));
#define DI __device__ __forceinline__
#define LDS_WAIT() asm volatile("s_waitcnt lgkmcnt(0)" ::: "memory")
#define VM_WAIT() asm volatile("s_waitcnt vmcnt(0)" ::: "memory")

typedef __bf16 bf16x2_t __attribute__((ext_vector_type(2)));
DI unsigned cvt_pk_bf16(float lo, float hi) { f32x2 v = {lo, hi}; bf16x2_t b = __builtin_convertvector(v, bf16x2_t); return __builtin_bit_cast(unsigned, b); }
typedef int v8i32 __attribute__((ext_vector_type(8)));
typedef int v4i32 __attribute__((ext_vector_type(4)));
DI unsigned pack_fp8x4(float a, float b, float c, float d) {
    a = fminf(fmaxf(a, -448.f), 448.f); b = fminf(fmaxf(b, -448.f), 448.f); c = fminf(fmaxf(c, -448.f), 448.f); d = fminf(fmaxf(d, -448.f), 448.f);
    int w = 0; w = __builtin_amdgcn_cvt_pk_fp8_f32(a, b, w, false); w = __builtin_amdgcn_cvt_pk_fp8_f32(c, d, w, true); return (unsigned)w; }
DI float bf2f(unsigned short b) { return __uint_as_float(((unsigned)b) << 16); }
DI float bflo(unsigned w) { return __uint_as_float(w << 16); }
DI float bfhi(unsigned w) { return __uint_as_float(w & 0xffff0000u); }
DI float fsilu(float x) { return x * __builtin_amdgcn_rcpf(1.f + __expf(-x)); }
DI float fsigmoid(float x) { return __builtin_amdgcn_rcpf(1.f + __expf(-x)); }
DI float wave_sum(float v) {
#pragma unroll
    for (int o = 1; o < 64; o <<= 1) v += __shfl_xor(v, o);
    return v;
}
DI int crow(int r, int hi) { return (r & 3) + 8 * (r >> 2) + 4 * hi; }

constexpr int LDS_WTAB_OFF = 148480 + 128;
DI int my_tid() {
    extern __shared__ __attribute__((aligned(16))) unsigned char lds_raw[];
    const unsigned hw = (unsigned)__builtin_amdgcn_s_getreg((5 << 11) | 4) & 63u;
    const int w = __builtin_amdgcn_readfirstlane(((volatile LAS int*)((LAS unsigned char*)lds_raw + LDS_WTAB_OFF))[hw]);
    int t = w * 64 + (int)__builtin_amdgcn_mbcnt_hi(~0u, __builtin_amdgcn_mbcnt_lo(~0u, 0u));
    asm volatile("" : "+v"(t)); return t;
}
#define XB_TMO      128
#define XB_XCNT(j)  (256  + 64 * (j))
#define XB_XSUB(j)  (1280 + 64 * (j))
#define XB_XGEN(j)  (2304 + 64 * (j))
#define XB_TOP      3328
#define XB_TOPGEN   3392
#define XCD_BAR_WORDS 3456
#define XB_SPIN_CAP (1u << 22)
DI unsigned xb_ld(unsigned* p)              { return __hip_atomic_load(p, __ATOMIC_RELAXED, __HIP_MEMORY_SCOPE_AGENT); }
DI unsigned xb_add(unsigned* p, unsigned v) { return __hip_atomic_fetch_add(p, v, __ATOMIC_RELAXED, __HIP_MEMORY_SCOPE_AGENT); }
DI unsigned xb_xcc_id() { return (unsigned)__builtin_amdgcn_s_getreg((3 << 11) | 20) & 0xFu; }
#define XB_SPIN(cond, bar) do { unsigned _sp = 0; while (cond) { __builtin_amdgcn_s_sleep(1); \
    if ((++_sp & 255u) == 0u) { if (xb_ld(&(bar)[XB_TMO])) break; if (_sp > XB_SPIN_CAP) { atomicAdd(&(bar)[XB_TMO], 1u); break; } } } } while (0)
struct XcdBarrier { unsigned* bar; unsigned x; volatile LAS unsigned* st; };
DI XcdBarrier xcd_barrier_post(unsigned* bar, volatile LAS unsigned* st) {
    XcdBarrier b; b.bar = bar; b.x = xb_xcc_id(); b.st = st;
    if (my_tid() == 0) (void)xb_add(&bar[XB_XCNT(b.x)], 1u);
    return b;
}
DI void xcd_barrier_complete(unsigned* bar, unsigned x, unsigned& nloc, unsigned& nx) {
    const unsigned G = gridDim.x * gridDim.y * gridDim.z;
    unsigned sum, cnt, mine, sp = 0u;
    for (;;) {
        sum = 0u; cnt = 0u; mine = 0u;
#pragma unroll
        for (unsigned j = 0; j < 16; ++j) { const unsigned c = xb_ld(&bar[XB_XCNT(j)]); sum += c; cnt += (c > 0u) ? 1u : 0u; mine = (j == x) ? c : mine; }
        if (sum == G) break;
        __builtin_amdgcn_s_sleep(1);
        if ((++sp & 255u) == 0u) { if (xb_ld(&bar[XB_TMO])) break; if (sp > XB_SPIN_CAP) { atomicAdd(&bar[XB_TMO], 1u); break; } }
    }
    nloc = mine > 0u ? mine : 1u; nx = cnt > 0u ? cnt : 1u;
}
DI void xcd_barrier(const XcdBarrier& b) {
    asm volatile("s_waitcnt vmcnt(0)" ::: "memory");
    __syncthreads();
    if (my_tid() == 0) {
        unsigned* bar = b.bar;
        __builtin_amdgcn_s_waitcnt(0);
        unsigned nloc = b.st[0], nx = b.st[1];
        if (nloc == 0u) { xcd_barrier_complete(bar, b.x, nloc, nx); b.st[0] = nloc; b.st[1] = nx; }
        const unsigned old = xb_add(&bar[XB_XSUB(b.x)], 1u);
        const unsigned gen = old / nloc;
        if (old + 1u == (gen + 1u) * nloc) {
            __builtin_amdgcn_fence(__ATOMIC_RELEASE, "agent");
            asm volatile("s_waitcnt vmcnt(0)" ::: "memory");
            const unsigned og = xb_add(&bar[XB_TOP], 1u);
            const unsigned tg = og / nx;
            if (og + 1u == (tg + 1u) * nx) xb_add(&bar[XB_TOPGEN], 1u);
            else XB_SPIN(xb_ld(&bar[XB_TOPGEN]) == tg, bar);
            __builtin_amdgcn_fence(__ATOMIC_ACQUIRE, "agent");
            xb_add(&bar[XB_XGEN(b.x)], 1u);
            asm volatile("s_waitcnt vmcnt(0)" ::: "memory");
        } else {
            XB_SPIN(xb_ld(&bar[XB_XGEN(b.x)]) == gen, bar);
            __builtin_amdgcn_fence(__ATOMIC_ACQUIRE, "agent");
            asm volatile("s_waitcnt vmcnt(0)" ::: "memory");
        }
    }
    __syncthreads();
}

namespace pg8 {
constexpr int BM = 256, BK = 64, HALF = 128, HTB = HALF * BK * 2, STAGE_BYTES = 8 * HTB, NXCD = 8, WGM = 8;
__host__ __device__ __forceinline__ int lds_byte(int r, int c) { const int st = (r >> 4) * 2 + (c >> 5), rr = r & 15, cc = c & 31, ob = rr * 64 + cc * 2; return st * 1024 + (ob ^ (((ob >> 9) & 1) << 5)); }
__host__ __device__ __forceinline__ void stage_rc(int b, int& R, int& C) { const int st = b / 1024, sb = b % 1024, swz = sb ^ (((sb >> 9) & 1) << 5); R = (st >> 1) * 16 + swz / 64; C = (st & 1) * 32 + (swz % 64) / 2; }
__host__ __device__ __forceinline__ int perm32(int rho) { const int n = rho >> 4, i = rho & 15; return 8 * (i >> 2) + 4 * n + (i & 3); }

struct Unit { int pm, pn; const char* a; const char* b; };
struct Gemm { const bf16_t* A; const bf16_t* Bt; int M, N, K, lda; };

struct StaticOrder {
    int nM, nN, nwg, G, c;
    DI void init(const Gemm& g, int G_, int c_) { nM = g.M / BM; nN = g.N / BM; nwg = nM * nN; G = G_; c = c_; }
    DI bool tile(int i, int& pm, int& pn) const {
        const int L = i * G + c; if (L >= nwg) return false;
        int wgid = L; { const int q = nwg / NXCD, r = nwg % NXCD, xcd = wgid % NXCD, off = wgid / NXCD; wgid = (xcd < r ? xcd * (q + 1) : r * (q + 1) + (xcd - r) * q) + off; }
        const int nig = WGM * nN, gid = wgid / nig, fm = gid * WGM, gsz = (nM - fm) < WGM ? (nM - fm) : WGM;
        pm = fm + ((wgid % nig) % gsz); pn = (wgid % nig) / gsz; return true;
    }
    DI bool next(const Gemm& g, int i, Unit& u) const { if (!tile(i, u.pm, u.pn)) return false;
        u.a = (const char*)g.A + (size_t)u.pm * ((size_t)BM * g.lda * 2); u.b = (const char*)g.Bt + (size_t)u.pn * ((size_t)BM * g.K * 2); return true; }
};
struct MoeOrder {
    StaticOrder so; int p0, apan0; const int* pbv; size_t estride;
    DI bool next(const Gemm& g, int i, Unit& u) const {
        int pm, pn; if (!so.tile(i, pm, pn)) return false;
        u.pm = p0 + pm; u.pn = pn; int e = 0;
#pragma unroll
        for (int k = 1; k < 8; ++k) e += (u.pm >= __builtin_amdgcn_readfirstlane(pbv[k])) ? 1 : 0;
        u.a = (const char*)g.A + (size_t)(u.pm - apan0) * ((size_t)BM * g.lda * 2); u.b = (const char*)g.Bt + (size_t)e * estride + (size_t)pn * ((size_t)BM * g.K * 2); return true;
    }
};

template <class Epi, class Sched, bool ALIGN_EPI = true, bool F8 = false, bool MIDHOOK = false>
DI void gemm_phase(LAS unsigned char* lds, const Gemm g, const Sched& S, const Epi& E) {
    const int tid_ = my_tid();
    const int tid = tid_, wid = __builtin_amdgcn_readfirstlane(tid >> 6), lane = tid & 63, wr = wid >> 2, wc = wid & 3, fr = lane & 15, fq = lane >> 4;
    const int K = g.K, nt = K / BK;
    unsigned voffA[2], voffB[2];
#pragma unroll
    for (int i = 0; i < 2; ++i) { int R, C; stage_rc(tid * 16 + i * 8192, R, C); const int Rb = Epi::PERM ? ((R & ~31) + perm32(R & 31)) : R;
        voffA[i] = (unsigned)(R * g.lda + C) * 2u; voffB[i] = (unsigned)(Rb * K + C) * 2u; }
    const size_t kstep = (size_t)(BK * 2);
    const size_t hstepA = (size_t)HALF * g.lda * 2, hstepB = (size_t)HALF * K * 2;
    const unsigned ldsw = (unsigned)wid * 1024u;
    const int aoff = lds_byte(wr * 64 + fr, fq * 8), boff = lds_byte(wc * 32 + fr, fq * 8);
#define PG8_SA(b, h) (((b) * 2 + (h)) * HTB)
#define PG8_SB(b, h) ((4 + (b) * 2 + (h)) * HTB)
#define PG8_STAGE(bufoff, gbase, voff) do { _Pragma("unroll") for (int _i = 0; _i < 2; ++_i) \
        __builtin_amdgcn_global_load_lds((const unsigned*)((const char*)(gbase) + (voff)[_i]), (LAS unsigned*)(lds + (bufoff) + ldsw + _i * 8192), 16, 0, 0); } while (0)
#define PG8_LD8(p) __builtin_shufflevector(*(const LAS v4i32*)(p), *(const LAS v4i32*)((p) + 1024), 0, 1, 2, 3, 4, 5, 6, 7)
#define PG8_LDA(dst, b, h) do { if constexpr (F8) { _Pragma("unroll") for (int m = 0; m < 4; ++m) dst##8[m] = PG8_LD8(lds + PG8_SA(b, h) + aoff + m * 2048); } \
        else { _Pragma("unroll") for (int m = 0; m < 4; ++m) _Pragma("unroll") for (int k = 0; k < 2; ++k) dst[m][k] = *(const LAS bf16x8*)(lds + PG8_SA(b, h) + aoff + m * 2048 + k * 1024); } } while (0)
#define PG8_LDB(dst, b, h) do { if constexpr (F8) { _Pragma("unroll") for (int n = 0; n < 2; ++n) dst##8[n] = PG8_LD8(lds + PG8_SB(b, h) + boff + n * 2048); } \
        else { _Pragma("unroll") for (int n = 0; n < 2; ++n) _Pragma("unroll") for (int k = 0; k < 2; ++k) dst[n][k] = *(const LAS bf16x8*)(lds + PG8_SB(b, h) + boff + n * 2048 + k * 1024); } } while (0)
#define PG8_MMA(ai, bj, At, Bt) do { __builtin_amdgcn_s_setprio(1); \
        if constexpr (F8) { _Pragma("unroll") for (int m = 0; m < 4; ++m) _Pragma("unroll") for (int n = 0; n < 2; ++n) \
            asm volatile("v_mfma_scale_f32_16x16x128_f8f6f4 %0, %1, %2, %0, %3, %3 op_sel_hi:[0,0,0]" : "+v"(acc[ai][bj][m][n]) : "v"(Bt##8[n]), "v"(At##8[m]), "v"(one8)); } \
        else { _Pragma("unroll") for (int m = 0; m < 4; ++m) _Pragma("unroll") for (int n = 0; n < 2; ++n) _Pragma("unroll") for (int k = 0; k < 2; ++k) \
            acc[ai][bj][m][n] = __builtin_amdgcn_mfma_f32_16x16x32_bf16(Bt[n][k], At[m][k], acc[ai][bj][m][n], 0, 0, 0); } \
        __builtin_amdgcn_s_setprio(0); } while (0)
#define PG8_WAIT_V(n) asm volatile("s_waitcnt vmcnt(" #n ")" ::: "memory")
#define PG8_WAIT_L(n) asm volatile("s_waitcnt lgkmcnt(" #n ")" ::: "memory")
#define PG8_BAR __builtin_amdgcn_s_barrier()
#define PG8_SCHED __builtin_amdgcn_sched_barrier(0)
    Unit cur, nxt; int ui = 0;
    if (!S.next(g, 0, cur)) return;
    f32x4 acc[2][2][4][2];
#pragma unroll
    for (int a = 0; a < 2; ++a)
#pragma unroll
        for (int b = 0; b < 2; ++b)
#pragma unroll
            for (int m = 0; m < 4; ++m)
#pragma unroll
                for (int n = 0; n < 2; ++n) acc[a][b][m][n] = (f32x4){0.f, 0.f, 0.f, 0.f};
    bf16x8 At[4][2], B0[2][2], B1[2][2]; v8i32 At8[4], B08[2], B18[2]; const int one8 = 0x7F7F7F7F;
    const char* cA = cur.a; const char* cB = cur.b;
    PG8_STAGE(PG8_SB(0, 0), cB, voffB); PG8_STAGE(PG8_SB(0, 1), cB + hstepB, voffB); PG8_STAGE(PG8_SA(0, 0), cA, voffA); PG8_STAGE(PG8_SA(0, 1), cA + hstepA, voffA);
    if (wr == 1) PG8_BAR;
    PG8_WAIT_V(2); PG8_BAR;
    PG8_STAGE(PG8_SB(1, 0), cB + kstep, voffB); PG8_STAGE(PG8_SA(1, 0), cA + kstep, voffA); PG8_STAGE(PG8_SB(1, 1), cB + hstepB + kstep, voffB);
    PG8_WAIT_V(6); PG8_BAR;
    for (;;) {
        const bool has_next = S.next(g, ui + 1, nxt);
        const char* nA = has_next ? nxt.a : cA; const char* nB = has_next ? nxt.b : cB;
        for (int t = 0; t < nt; t += 2) {
            const bool last = (t == nt - 2);
            if constexpr (MIDHOOK) { PG8_SCHED; if (t == nt / 2) E.mid(acc, cur, wr, wc, fr, fq); PG8_SCHED; }
            const char* a1 = cA + (size_t)(t + 1) * kstep;
            const char* a2 = last ? nA : cA + (size_t)(t + 2) * kstep; const char* b2 = last ? nB : cB + (size_t)(t + 2) * kstep;
            const char* a3 = a2 + kstep; const char* b3 = b2 + kstep;
            PG8_LDB(B0, 0, 0); PG8_LDB(B1, 0, 1); PG8_SCHED; PG8_LDA(At, 0, 0); PG8_STAGE(PG8_SA(1, 1), a1 + hstepA, voffA);
            PG8_WAIT_V(8); PG8_WAIT_L(0); PG8_BAR; PG8_MMA(0, 0, At, B0); PG8_MMA(0, 1, At, B1); PG8_BAR; PG8_SCHED;
            PG8_LDA(At, 0, 1); PG8_STAGE(PG8_SB(0, 0), b2, voffB); PG8_STAGE(PG8_SB(0, 1), b2 + hstepB, voffB); PG8_STAGE(PG8_SA(0, 0), a2, voffA);
            PG8_WAIT_V(8); PG8_WAIT_L(0); PG8_BAR; PG8_MMA(1, 0, At, B0); PG8_MMA(1, 1, At, B1); PG8_BAR; PG8_SCHED;
            PG8_LDB(B0, 1, 0); PG8_LDB(B1, 1, 1); PG8_SCHED; PG8_LDA(At, 1, 0); PG8_STAGE(PG8_SA(0, 1), a2 + hstepA, voffA);
            PG8_WAIT_V(8); PG8_WAIT_L(0); PG8_BAR; PG8_MMA(0, 0, At, B0); PG8_MMA(0, 1, At, B1); PG8_BAR; PG8_SCHED;
            PG8_LDA(At, 1, 1); PG8_STAGE(PG8_SB(1, 0), b3, voffB); PG8_STAGE(PG8_SB(1, 1), b3 + hstepB, voffB); PG8_STAGE(PG8_SA(1, 0), a3, voffA);
            PG8_WAIT_V(8); PG8_WAIT_L(0); PG8_BAR; PG8_MMA(1, 0, At, B0); PG8_MMA(1, 1, At, B1); PG8_BAR; PG8_SCHED;
        }
        if constexpr (ALIGN_EPI) { if (wr == 0) PG8_BAR; }
        if constexpr (F8) asm volatile("s_nop 15\n\ts_nop 15" ::: "memory");
        E(acc, cur, wr, wc, fr, fq);
        if (!has_next) break;
#pragma unroll
        for (int a = 0; a < 2; ++a)
#pragma unroll
            for (int b = 0; b < 2; ++b)
#pragma unroll
                for (int m = 0; m < 4; ++m)
#pragma unroll
                    for (int n = 0; n < 2; ++n) acc[a][b][m][n] = (f32x4){0.f, 0.f, 0.f, 0.f};
        cur = nxt; cA = nA; cB = nB; ++ui;
        if constexpr (ALIGN_EPI) { if (wr == 1) PG8_BAR; }
    }
    PG8_WAIT_V(0);
    if constexpr (!ALIGN_EPI) { if (wr == 0) PG8_BAR; }
    PG8_BAR;
#undef PG8_SA
#undef PG8_SB
#undef PG8_STAGE
#undef PG8_LDA
#undef PG8_LD8
#undef PG8_LDB
#undef PG8_MMA
#undef PG8_WAIT_V
#undef PG8_WAIT_L
#undef PG8_BAR
#undef PG8_SCHED
}
}
using pg8::Unit; using pg8::Gemm;
typedef const f32x4 (&AccRef)[2][2][4][2];

DI u32x4 pack8(const f32x4& v0, const f32x4& v1) { u32x4 w; w.x = cvt_pk_bf16(v0[0], v0[1]); w.y = cvt_pk_bf16(v0[2], v0[3]); w.z = cvt_pk_bf16(v1[0], v1[1]); w.w = cvt_pk_bf16(v1[2], v1[3]); return w; }
DI void unpack8(const u32x4& w, float (&f)[8]) { f[0] = bflo(w.x); f[1] = bfhi(w.x); f[2] = bflo(w.y); f[3] = bfhi(w.y); f[4] = bflo(w.z); f[5] = bfhi(w.z); f[6] = bflo(w.w); f[7] = bfhi(w.w); }

struct EpiInProj {
    static constexpr bool PERM = true;
    bf16_t* P; const float2* rope; const float* lbf; const float* lbb; int secmap; float asc;
    template <int MODE> DI void run(AccRef acc, const Unit& u, int wr, int wc, int fr, int fq, int sec) const {
        const int row0 = u.pm * 256 + wr * 64 + fr, col0 = sec * 512 + (u.pn & 1) * 256 + wc * 32 + 8 * fq;
        const bool lat = u.pm < (NLAT / 256); const float qs = sec == 0 ? QSCALE : 1.f;
        f32x4 lb0[2], lb1[2];
        if (MODE == 2) {
#pragma unroll
            for (int bj = 0; bj < 2; ++bj) { const float* lb = (sec == 1 ? lbf : lbb) + ((col0 + bj * 128) & 511); lb0[bj] = *(const f32x4*)lb; lb1[bj] = *(const f32x4*)(lb + 4); } }
#pragma unroll
        for (int ai = 0; ai < 2; ++ai)
#pragma unroll
            for (int m = 0; m < 4; ++m) {
                const int row = row0 + ai * 128 + m * 16; bf16_t* rowp = P + (size_t)row * PW + col0;
#pragma unroll
                for (int bj = 0; bj < 2; ++bj) {
                    f32x4 v0 = acc[ai][bj][m][0] * asc, v1 = acc[ai][bj][m][1] * asc; u32x4 w;
                    if (MODE == 3) {
                        if (lat) {
                            const int pi = ((col0 + bj * 128) & 63) >> 1;
                            const f32x4* rp = (const f32x4*)(rope + (size_t)(row & (T - 1)) * 32 + pi);
                            const f32x4 r0 = rp[0], r1 = rp[1];
                            f32x4 o0, o1;
                            o0[0] = v0[0] * r0[0] - v0[1] * r0[1]; o0[1] = v0[0] * r0[1] + v0[1] * r0[0];
                            o0[2] = v0[2] * r0[2] - v0[3] * r0[3]; o0[3] = v0[2] * r0[3] + v0[3] * r0[2];
                            o1[0] = v1[0] * r1[0] - v1[1] * r1[1]; o1[1] = v1[0] * r1[1] + v1[1] * r1[0];
                            o1[2] = v1[2] * r1[2] - v1[3] * r1[3]; o1[3] = v1[2] * r1[3] + v1[3] * r1[2];
                            v0 = o0; v1 = o1;
                        }
                        w = pack8(v0 * qs, v1 * qs);
                    } else if (MODE == 1) {
#pragma unroll
                        for (int j = 0; j < 4; ++j) { v0[j] = fsilu(v0[j]); v1[j] = fsilu(v1[j]); }
                        w = pack8(v0, v1);
                    } else if (MODE == 2) {
                        half8 hv;
#pragma unroll
                        for (int j = 0; j < 8; ++j) {
                            const float z = fmaxf(j < 4 ? v0[j] : v1[j - 4], -80.f), b = j < 4 ? lb0[bj][j] : lb1[bj][j - 4];
                            const float sg = __builtin_amdgcn_rcpf(1.f + __builtin_amdgcn_exp2f(-LOG2E * z));
                            hv[j] = (_Float16)(0.6931471805599453f * __builtin_amdgcn_logf(b + (1.f - b) * sg));
                        }
                        w = __builtin_bit_cast(u32x4, hv);
                    } else w = pack8(v0, v1);
                    *(u32x4*)(rowp + bj * 128) = w;
                }
            }
    }
    DI void operator()(AccRef acc, const Unit& u, int wr, int wc, int fr, int fq) const {
        const int sec = (secmap >> (4 * (u.pn >> 1))) & 15;
        if (sec == 0 || sec == 4) run<3>(acc, u, wr, wc, fr, fq, sec);
        else if (sec == 2 || sec == 6) run<1>(acc, u, wr, wc, fr, fq, sec);
        else if (sec == 1 || sec == 3) run<2>(acc, u, wr, wc, fr, fq, sec);
        else run<0>(acc, u, wr, wc, fr, fq, sec);
    }
};
struct EpiGates {
    static constexpr bool PERM = true; bf16_t* P; float asc;
    DI void operator()(AccRef acc, const Unit& u, int wr, int wc, int fr, int fq) const {
        const int row0 = u.pm * 256 + wr * 64 + fr, col0 = PC_GA + u.pn * 256 + wc * 32 + 8 * fq;
#pragma unroll
        for (int ai = 0; ai < 2; ++ai)
#pragma unroll
            for (int m = 0; m < 4; ++m) { bf16_t* rowp = P + (size_t)(row0 + ai * 128 + m * 16) * PW + col0;
#pragma unroll
                for (int bj = 0; bj < 2; ++bj) { f32x4 v0 = acc[ai][bj][m][0] * asc, v1 = acc[ai][bj][m][1] * asc;
#pragma unroll
                    for (int j = 0; j < 4; ++j) { v0[j] = fsigmoid(v0[j]); v1[j] = fsigmoid(v1[j]); }
                    *(u32x4*)(rowp + bj * 128) = pack8(v0, v1); } }
    }
};
struct EpiMergeFused {
    static constexpr bool PERM = true; const bf16_t* P; bf16_t* O;
    DI void mid(f32x4 (&acc)[2][2][4][2], const Unit& u, int wr, int wc, int fr, int fq) const {
        int row0 = u.pm * 256 + wr * 64 + fr, col0 = u.pn * 256 + wc * 32 + 8 * fq;
        asm volatile("" : "+v"(row0), "+v"(col0));
#pragma unroll
        for (int ai = 0; ai < 2; ++ai)
#pragma unroll
            for (int m = 0; m < 4; ++m) { const size_t row = (size_t)(row0 + ai * 128 + m * 16);
#pragma unroll
                for (int bj = 0; bj < 2; ++bj) {
                    float ga[8], gr[8]; unpack8(*(const u32x4*)(P + row * PW + PC_GA + col0 + bj * 128), ga); unpack8(*(const u32x4*)(P + row * PW + PC_GR + col0 + bj * 128), gr);
#pragma unroll
                    for (int j = 0; j < 4; ++j) { acc[ai][bj][m][0][j] *= ga[j] * __builtin_amdgcn_rcpf(fmaxf(gr[j], 1e-30f)); acc[ai][bj][m][1][j] *= ga[4 + j] * __builtin_amdgcn_rcpf(fmaxf(gr[4 + j], 1e-30f)); } }
                asm volatile("" ::: "memory"); }
    }
    DI void operator()(AccRef acc, const Unit& u, int wr, int wc, int fr, int fq) const {
        const int row0 = u.pm * 256 + wr * 64 + fr, col0 = u.pn * 256 + wc * 32 + 8 * fq;
#pragma unroll
        for (int ai = 0; ai < 2; ++ai)
#pragma unroll
            for (int m = 0; m < 4; ++m) { const size_t row = (size_t)(row0 + ai * 128 + m * 16);
#pragma unroll
                for (int bj = 0; bj < 2; ++bj) {
                    float gr[8]; unpack8(*(const u32x4*)(P + row * PW + PC_GR + col0 + bj * 128), gr);
                    f32x4 v0 = acc[ai][bj][m][0], v1 = acc[ai][bj][m][1];
#pragma unroll
                    for (int j = 0; j < 4; ++j) { v0[j] *= fmaxf(gr[j], 1e-30f); v1[j] *= fmaxf(gr[4 + j], 1e-30f); }
                    *(u32x4*)(O + row * D + col0 + bj * 128) = pack8(v0, v1); } }
    }
};
struct EpiResid {
    static constexpr bool PERM = false;
    const float* xin_l; const float* xin_c; float* xout_l; float* xout_c; const float* mods; int msel;
    DI void operator()(AccRef acc, const Unit& u, int wr, int wc, int fr, int fq) const {
        const bool lat = u.pm < (NLAT / 256);
        const int rbase = (lat ? u.pm : u.pm - NLAT / 256) * 256 + wr * 64 + fr, col0 = u.pn * 256 + wc * 32 + 4 * fq;
        const float* xi = lat ? xin_l : xin_c; float* xo = lat ? xout_l : xout_c;
        const float* mv = mods + (size_t)(lat ? (u.pm >> 3) : 32) * DIN + msel * D + col0;
        f32x4 g[2][2];
#pragma unroll
        for (int bj = 0; bj < 2; ++bj)
#pragma unroll
            for (int n = 0; n < 2; ++n) g[bj][n] = *(const f32x4*)(mv + bj * 128 + n * 16);
#pragma unroll
        for (int ai = 0; ai < 2; ++ai)
#pragma unroll
            for (int m = 0; m < 4; ++m) { const size_t off = (size_t)(rbase + ai * 128 + m * 16) * D + col0;
#pragma unroll
                for (int bj = 0; bj < 2; ++bj)
#pragma unroll
                    for (int n = 0; n < 2; ++n) { const f32x4 xv = *(const f32x4*)(xi + off + bj * 128 + n * 16);
                        *(f32x4*)(xo + off + bj * 128 + n * 16) = xv + g[bj][n] * acc[ai][bj][m][n]; } }
    }
};
struct EpiSwiglu {
    static constexpr bool PERM = true; bf16_t* Hd; int ldh; int pan0;
    DI void operator()(AccRef acc, const Unit& u, int wr, int wc, int fr, int fq) const {
        const int row0 = (u.pm - pan0) * 256 + wr * 64 + fr, hc0 = u.pn * 128 + wc * 16 + 4 * fq;
#pragma unroll
        for (int ai = 0; ai < 2; ++ai)
#pragma unroll
            for (int m = 0; m < 4; ++m) { bf16_t* rowp = Hd + (size_t)(row0 + ai * 128 + m * 16) * ldh + hc0;
#pragma unroll
                for (int bj = 0; bj < 2; ++bj) { const f32x4 a = acc[ai][bj][m][0], b = acc[ai][bj][m][1];
                    u32x2 w; w.x = cvt_pk_bf16(fsilu(a[0]) * b[0], fsilu(a[1]) * b[1]); w.y = cvt_pk_bf16(fsilu(a[2]) * b[2], fsilu(a[3]) * b[3]);
                    *(u32x2*)(rowp + bj * 64) = w; } }
    }
};
struct EpiSwiglu8 {
    static constexpr bool PERM = true; unsigned char* Hd; int ldh; int pan0; float as, hs;
    DI void operator()(AccRef acc, const Unit& u, int wr, int wc, int fr, int fq) const {
        const int row0 = (u.pm - pan0) * 256 + wr * 64 + fr, hc0 = u.pn * 128 + wc * 16 + 4 * fq;
#pragma unroll
        for (int ai = 0; ai < 2; ++ai)
#pragma unroll
            for (int m = 0; m < 4; ++m) { unsigned char* rowp = Hd + (size_t)(row0 + ai * 128 + m * 16) * ldh + hc0;
#pragma unroll
                for (int bj = 0; bj < 2; ++bj) { const f32x4 a = acc[ai][bj][m][0] * as, b = acc[ai][bj][m][1] * (as * hs);
                    *(unsigned*)(rowp + bj * 64) = pack_fp8x4(fsilu(a[0]) * b[0], fsilu(a[1]) * b[1], fsilu(a[2]) * b[2], fsilu(a[3]) * b[3]); } }
    }
};
struct EpiBf16 {
    static constexpr bool PERM = true; bf16_t* O; int ldc; float sc;
    DI void operator()(AccRef acc, const Unit& u, int wr, int wc, int fr, int fq) const {
        const int row0 = u.pm * 256 + wr * 64 + fr, col0 = u.pn * 256 + wc * 32 + 8 * fq;
#pragma unroll
        for (int ai = 0; ai < 2; ++ai)
#pragma unroll
            for (int m = 0; m < 4; ++m) { bf16_t* rowp = O + (size_t)(row0 + ai * 128 + m * 16) * ldc + col0;
#pragma unroll
                for (int bj = 0; bj < 2; ++bj) *(u32x4*)(rowp + bj * 128) = pack8(acc[ai][bj][m][0] * sc, acc[ai][bj][m][1] * sc); }
    }
};

typedef short v4i16 __attribute__((ext_vector_type(4)));
DI s16x4 tr16(const LAS unsigned char* p) { return __builtin_bit_cast(s16x4, __builtin_amdgcn_ds_read_tr16_b64_v4i16((LAS v4i16*)p)); }
DI bf16x8 cat8(s16x4 lo, s16x4 hi) { return __builtin_shufflevector(lo, hi, 0, 1, 2, 3, 4, 5, 6, 7); }
DI void dma16(const void* g, LAS unsigned char* l) { __builtin_amdgcn_global_load_lds((const unsigned*)g, (LAS unsigned*)l, 16, 0, 0); }
DI bf16x8 packf8(const f32x16& x, int s) {
    u32x4 w; w.x = cvt_pk_bf16(x[8 * s], x[8 * s + 1]); w.y = cvt_pk_bf16(x[8 * s + 2], x[8 * s + 3]); w.z = cvt_pk_bf16(x[8 * s + 4], x[8 * s + 5]); w.w = cvt_pk_bf16(x[8 * s + 6], x[8 * s + 7]);
    return __builtin_bit_cast(bf16x8, w);
}
#define MFMA32(a, b, c) __builtin_amdgcn_mfma_f32_32x32x16_bf16((a), (b), (c), 0, 0, 0)

struct Params { const float* in[28]; float* out; unsigned char* ws; int ph_lo, ph_hi, li, pad; };
typedef const __attribute__((address_space(4))) Params* KP;
DI KP kparams() { KP kp = (KP)__builtin_amdgcn_kernarg_segment_ptr(); asm volatile("" : "+s"(kp)); return kp; }
#define PIN(k) (kparams()->in[k])
#define POUT (kparams()->out)
struct Ctx {
    LAS unsigned char* lds; unsigned char* ws; int tid, lane, wave, vcu, G, gw, NGW, bx;
};

constexpr float WIN8_SCALE = 64.f;
#ifndef FP8_SECS
#define FP8_SECS 0x00
#endif
constexpr int SEC_ORDER[8] = {0, 1, 3, 4, 2, 5, 6, 7};
constexpr int sec_slot(int ps) { int nb = 0, nf = 0; for (int i = 0; i < 8; ++i) { const int s_ = SEC_ORDER[i]; const bool f = (FP8_SECS >> s_) & 1; if (s_ == ps) return f ? (0x100 | nf) : nb; if (f) ++nf; else ++nb; } return 0; }
constexpr int N_SEC_F8 = __builtin_popcount(FP8_SECS), N_SEC_BF = 8 - N_SEC_F8;
constexpr unsigned secmap_of(bool f8) { unsigned m = 0; int k = 0; for (int i = 0; i < 8; ++i) { const int s_ = SEC_ORDER[i]; if ((((FP8_SECS >> s_) & 1) != 0) == f8) { m |= (unsigned)s_ << (4 * k); ++k; } } return m; }
DI int map_row(int kind, int n);
DI int map_row4(int n) { return map_row(1, n) & 0xffff; }
DI int map_row(int kind, int n) {
    if (kind == 0) return n;
    if (kind == 4) return map_row4(n);
    if (kind == 2) return 8 * (n >> 2) + (n & 3);
    if (kind == 3) return 8 * (n >> 2) + (n & 3) + 4;
    const int sec = n >> 9, j = n & 511;
    if (n >= 4096) return (1 << 16) | (N_SEC_F8 * 512 + (n - 4096));
    const int ps = sec == 0 ? 0 : sec == 1 ? 4 : sec == 2 ? 5 : sec == 3 ? 6 : sec == 4 ? 7 : sec == 5 ? 1 : sec == 6 ? 3 : 2;
    const int sl = sec_slot(ps); int jj = j;
    if (sec == 0 || sec == 1) { const int hs = j >> 6, d = j & 63; jj = hs * 64 + (d < 32 ? 2 * d : 2 * (d - 32) + 1); }
    return ((sl & 0x100) ? (1 << 16) : 0) | ((sl & 0xff) * 512 + jj);
}
constexpr int TP_PITCH = 68, TP_SCR = 64 * TP_PITCH * 4;
DI void transpose_load(const float* W, int ldw, int k0, int n0, LAS float* scr, int lane) {
    const int r = lane >> 4, c4 = (lane & 15) * 4; f32x4 v[16];
#pragma unroll
    for (int i = 0; i < 16; ++i) v[i] = *(const f32x4*)(W + (size_t)(k0 + 4 * i + r) * ldw + n0 + c4);
#pragma unroll
    for (int i = 0; i < 16; ++i) *(LAS f32x4*)(scr + (4 * i + r) * TP_PITCH + c4) = v[i];
    LDS_WAIT(); asm volatile("" ::: "memory");
}
DI void transpose_item(const float* W, int ldw, int k0, int n0, bf16_t* WT, int ldt, int kind, LAS float* scr, int lane) {
    transpose_load(W, ldw, k0, n0, scr, lane);
    bf16_t* dst = WT + (size_t)map_row(kind, n0 + lane) * ldt + k0;
#pragma unroll
    for (int j = 0; j < 8; ++j) { const LAS float* s = scr + (8 * j) * TP_PITCH + lane;
        u32x4 o; o.x = cvt_pk_bf16(s[0], s[TP_PITCH]); o.y = cvt_pk_bf16(s[2 * TP_PITCH], s[3 * TP_PITCH]); o.z = cvt_pk_bf16(s[4 * TP_PITCH], s[5 * TP_PITCH]); o.w = cvt_pk_bf16(s[6 * TP_PITCH], s[7 * TP_PITCH]);
        *(u32x4*)(dst + 8 * j) = o; }
    LDS_WAIT(); asm volatile("" ::: "memory");
}
DI void transpose_item8(const float* W, int ldw, int k0, int n0, unsigned char* WT, int ldt, int kind, float sc, LAS float* scr, int lane) {
    transpose_load(W, ldw, k0, n0, scr, lane);
    unsigned char* dst = WT + (size_t)map_row(kind, n0 + lane) * ldt + k0;
#pragma unroll
    for (int j = 0; j < 4; ++j) { const LAS float* s = scr + (16 * j) * TP_PITCH + lane; u32x4 o;
        o.x = pack_fp8x4(s[0] * sc, s[TP_PITCH] * sc, s[2 * TP_PITCH] * sc, s[3 * TP_PITCH] * sc); o.y = pack_fp8x4(s[4 * TP_PITCH] * sc, s[5 * TP_PITCH] * sc, s[6 * TP_PITCH] * sc, s[7 * TP_PITCH] * sc);
        o.z = pack_fp8x4(s[8 * TP_PITCH] * sc, s[9 * TP_PITCH] * sc, s[10 * TP_PITCH] * sc, s[11 * TP_PITCH] * sc); o.w = pack_fp8x4(s[12 * TP_PITCH] * sc, s[13 * TP_PITCH] * sc, s[14 * TP_PITCH] * sc, s[15 * TP_PITCH] * sc);
        *(u32x4*)(dst + 16 * j) = o; }
    LDS_WAIT(); asm volatile("" ::: "memory");
}
DI void transpose_matrix8(const Ctx& C, const float* W, int K, int N, unsigned char* WT, int ldt, int kind, float sc, int& itbase) {
    LAS float* scr = (LAS float*)(C.lds + C.wave * TP_SCR);
    const int nblk = N / 64, nit = (K / 64) * nblk;
    int first = (C.gw - (itbase % C.NGW) + C.NGW) % C.NGW;
    for (int it = first; it < nit; it += C.NGW) transpose_item8(W, N, 64 * (it / nblk), 64 * (it % nblk), WT, ldt, kind, sc, scr, C.lane);
    itbase += nit;
}
DI void transpose_matrix(const Ctx& C, const float* W, int K, int N, bf16_t* WT, int ldt, int kind, int& itbase, int total_unused) {
    (void)total_unused;
    LAS float* scr = (LAS float*)(C.lds + C.wave * TP_SCR);
    const int nblk = N / 64, nit = (K / 64) * nblk;
    int first = (C.gw - (itbase % C.NGW) + C.NGW) % C.NGW;
    for (int it = first; it < nit; it += C.NGW) transpose_item(W, N, 64 * (it / nblk), 64 * (it % nblk), WT, ldt, kind, scr, C.lane);
    itbase += nit;
}
DI void transpose_win(const Ctx& C, const float* W, bf16_t* WA, unsigned char* W8, int& itbase) {
    LAS float* scr = (LAS float*)(C.lds + C.wave * TP_SCR);
    const int nblk = DIN / 64, nit = (D / 64) * nblk;
    int first = (C.gw - (itbase % C.NGW) + C.NGW) % C.NGW;
    for (int it = first; it < nit; it += C.NGW) { const int k0 = 64 * (it / nblk), n0 = 64 * (it % nblk);
        if (map_row(1, n0) >> 16) transpose_item8(W, DIN, k0, n0, W8, D, 4, WIN8_SCALE, scr, C.lane);
        else transpose_item(W, DIN, k0, n0, WA, D, 1, scr, C.lane); }
    itbase += nit;
}
DI void phase_prologue(const Ctx& C) {
    unsigned char* ws = C.ws;
    int itb = 0;
    for (int l = 0; l < 2; ++l) {
        transpose_win(C, PIN(8) + (size_t)l * D * DIN, (bf16_t*)(ws + WS_WIN) + (size_t)l * 4096 * D, ws + WS_WIN8 + (size_t)l * 4096 * D, itb);
        transpose_matrix(C, PIN(17) + (size_t)l * 512 * D, 512, D, (bf16_t*)(ws + WS_WUA) + (size_t)l * D * D, D, 0, itb, 0);
        transpose_matrix(C, PIN(18) + (size_t)l * 512 * D, 512, D, (bf16_t*)(ws + WS_WUA) + (size_t)l * D * D + 512, D, 0, itb, 0);
        transpose_matrix(C, PIN(19) + (size_t)l * D * D, D, D, (bf16_t*)(ws + WS_WO) + (size_t)l * D * D, D, 0, itb, 0);
    }
    transpose_matrix(C, PIN(20), D, DFF, (bf16_t*)(ws + WS_W13), D, 2, itb, 0);
    transpose_matrix(C, PIN(21), D, DFF, (bf16_t*)(ws + WS_W13), D, 3, itb, 0);
    transpose_matrix(C, PIN(22), DFF, D, (bf16_t*)(ws + WS_W2), DFFP, 0, itb, 0);
    { const int gt = C.vcu * 512 + C.tid, NT = C.G * 512;
      bf16_t* w13 = (bf16_t*)(ws + WS_W13) + (size_t)(2 * DFF) * D;
      for (int i = gt; i < (2 * DFFP - 2 * DFF) * D / 8; i += NT) ((u32x4*)w13)[i] = (u32x4){0u, 0u, 0u, 0u};
      bf16_t* w2 = (bf16_t*)(ws + WS_W2);
      for (int i = gt; i < D * (DFFP - DFF) / 8; i += NT) { const int r = i / ((DFFP - DFF) / 8), cc = i % ((DFFP - DFF) / 8); *(u32x4*)(w2 + (size_t)r * DFFP + DFF + cc * 8) = (u32x4){0u, 0u, 0u, 0u}; }
      float2* rope = (float2*)(ws + WS_ROPE);
      for (int i = gt; i < T * 32; i += NT) { const int t = i >> 5, pi = i & 31; const float invf = exp2f(-(float)(pi & 15) * (13.287712379549449f / 16.f));
          const float ang = (float)(pi < 16 ? (t >> 6) : (t & 63)) * invf; rope[i] = make_float2(cosf(ang), sinf(ang)); }
      float* lbs = (float*)(ws + WS_LBS);
      for (int i = gt; i < 2 * 2 * 512; i += NT) { const int l = i >> 10, dir = (i >> 9) & 1, d = i & 511; const float* lb = PIN(dir ? 16 : 15);
          const float p0 = lb[d], p1 = lb[512 + d]; lbs[i] = l == 0 ? 0.f : 1.f / (1.f + expf(p0 - p1)); }
    }
    { float* mods = (float*)(ws + WS_MODS);
      for (int task = C.gw; task < 2 * 33 * 96; task += C.NGW) {
          const int ng = task % 96, r = (task / 96) % 33, l = task / (96 * 33), n = ng * 64 + C.lane;
          const float* cv = r < 32 ? PIN(1) + r * D : PIN(3); const float* W = PIN(4) + (size_t)l * D * DIN + n;
          float acc = PIN(5)[l * DIN + n];
          for (int k0 = 0; k0 < D; k0 += 64) { const float sv = fsilu(cv[k0 + C.lane]);
#pragma unroll 16
              for (int j = 0; j < 64; ++j) acc += __uint_as_float(__builtin_amdgcn_readlane(__float_as_uint(sv), j)) * W[(size_t)(k0 + j) * DIN]; }
          mods[(size_t)(l * 33 + r) * DIN + n] = acc; } }
}
constexpr float W13_SCALE = 64.f, W2_SCALE = 128.f, HID_SCALE = 8.f;
DI void convert_moe_weights(const Ctx& C) {
    unsigned char* ws = C.ws; int itb = 0;
    for (int e = 0; e < NE; ++e) {
        transpose_matrix8(C, PIN(24) + (size_t)e * D * DFE, D, DFE, ws + WS_WM13 + (size_t)e * 2 * DFE * D, D, 2, W13_SCALE, itb);
        transpose_matrix8(C, PIN(25) + (size_t)e * D * DFE, D, DFE, ws + WS_WM13 + (size_t)e * 2 * DFE * D, D, 3, W13_SCALE, itb);
        transpose_matrix8(C, PIN(26) + (size_t)e * DFE * D, DFE, D, ws + WS_WM2 + (size_t)e * D * DFE, DFE, 0, W2_SCALE, itb);
    }
}

template <bool ROUTER>
DI void phase_norm(const Ctx& C, const float* xl, const float* xc, const float* nw, const float* mods, int shsel, int nrows, bf16_t* Hout, const float* rw, unsigned char* route, LAS int* cntL, unsigned char* H8 = nullptr) {
    int nloc = 0;
    f32x4 rwr[4][4][2];
    if (ROUTER) {
#pragma unroll
        for (int j = 0; j < 4; ++j)
#pragma unroll
            for (int q = 0; q < 4; ++q) { const float* rp = rw + (size_t)(256 * j + 4 * C.lane + q) * 8; rwr[j][q][0] = *(const f32x4*)rp; rwr[j][q][1] = *(const f32x4*)(rp + 4); } }
    for (int row0 = C.gw; row0 < nrows; row0 += 2 * C.NGW) {
        const int rows[2] = {row0, row0 + C.NGW}; const bool two = rows[1] < nrows;
        f32x4 v[2][4]; float ss[2] = {0.f, 0.f};
#pragma unroll
        for (int u = 0; u < 2; ++u) { const int row = (u == 1 && !two) ? rows[0] : rows[u]; const float* xr = row < NLAT ? xl + (size_t)row * D : xc + (size_t)(row - NLAT) * D;
#pragma unroll
            for (int j = 0; j < 4; ++j) { v[u][j] = *(const f32x4*)(xr + 256 * j + 4 * C.lane); ss[u] += (v[u][j][0] * v[u][j][0] + v[u][j][1] * v[u][j][1]) + (v[u][j][2] * v[u][j][2] + v[u][j][3] * v[u][j][3]); } }
#pragma unroll
        for (int u = 0; u < 2; ++u) { if (u == 1 && !two) break;
            const int row = rows[u]; const bool lat = row < NLAT;
            const float* mv = mods + (size_t)(lat ? (row >> 11) : 32) * DIN + shsel * D;
            const float rstd = 1.0f / sqrtf(wave_sum(ss[u]) * (1.f / D) + EPS);
            float lg[8];
            if (ROUTER) {
#pragma unroll
                for (int e = 0; e < 8; ++e) lg[e] = 0.f; }
#pragma unroll
            for (int j = 0; j < 4; ++j) { const int c0 = 256 * j + 4 * C.lane;
                const f32x4 w = *(const f32x4*)(nw + c0), sh = *(const f32x4*)(mv + c0), sc = *(const f32x4*)(mv + D + c0);
                f32x4 h = (v[u][j] * rstd) * w * (sc + 1.0f) + sh;
                if (ROUTER) *(unsigned*)((unsigned char*)Hout + (size_t)row * D + c0) = pack_fp8x4(h[0], h[1], h[2], h[3]);
                else { u32x2 o; o.x = cvt_pk_bf16(h[0], h[1]); o.y = cvt_pk_bf16(h[2], h[3]); *(u32x2*)(Hout + (size_t)row * D + c0) = o;
                       if (H8) *(unsigned*)(H8 + (size_t)row * D + c0) = pack_fp8x4(h[0], h[1], h[2], h[3]); }
                if (ROUTER) {
#pragma unroll
                    for (int q = 0; q < 4; ++q) { const f32x4 r0 = rwr[j][q][0], r1 = rwr[j][q][1];
                        lg[0] += h[q] * r0[0]; lg[1] += h[q] * r0[1]; lg[2] += h[q] * r0[2]; lg[3] += h[q] * r0[3]; lg[4] += h[q] * r1[0]; lg[5] += h[q] * r1[1]; lg[6] += h[q] * r1[2]; lg[7] += h[q] * r1[3]; } }
            }
            if (ROUTER) {
                const bool b5 = (C.lane & 32) != 0, b4 = (C.lane & 16) != 0, b3 = (C.lane & 8) != 0; float a4[4], a2[2], a1;
#pragma unroll
                for (int j = 0; j < 4; ++j) { const float snd = b5 ? lg[j] : lg[4 + j]; a4[j] = (b5 ? lg[4 + j] : lg[j]) + __shfl_xor(snd, 32); }
#pragma unroll
                for (int j = 0; j < 2; ++j) { const float snd = b4 ? a4[j] : a4[2 + j]; a2[j] = (b4 ? a4[2 + j] : a4[j]) + __shfl_xor(snd, 16); }
                { const float snd = b3 ? a2[0] : a2[1]; a1 = (b3 ? a2[1] : a2[0]) + __shfl_xor(snd, 8); }
                a1 += __shfl_xor(a1, 4); a1 += __shfl_xor(a1, 2); a1 += __shfl_xor(a1, 1);
                if ((C.lane & 7) == 0) ((LAS float*)(C.lds + C.wave * 4096))[nloc * 8 + (C.lane >> 3)] = a1;
                ++nloc;
            }
        }
    }
    if (ROUTER) {
        LDS_WAIT();
        for (int i = C.lane; i < nloc; i += 64) { const int row = C.gw + i * C.NGW; const LAS float* lp = (const LAS float*)(C.lds + C.wave * 4096) + i * 8;
            float lg[8];
#pragma unroll
            for (int e = 0; e < 8; ++e) lg[e] = lp[e];
            int e1 = 0; float l1 = lg[0];
#pragma unroll
            for (int e = 1; e < 8; ++e) if (lg[e] > l1) { l1 = lg[e]; e1 = e; }
            int e2 = -1; float l2 = -INFINITY;
#pragma unroll
            for (int e = 0; e < 8; ++e) if (e != e1 && lg[e] > l2) { l2 = lg[e]; e2 = e; }
            const float g2 = 1.f / (1.f + expf(l1 - l2)), g1 = 1.f - g2;
            int* rt = (int*)(route + (size_t)row * 24); rt[0] = e1; rt[1] = e2; ((float*)rt)[2] = g1; ((float*)rt)[3] = g2;
            atomicAdd((int*)&cntL[e1], 1); atomicAdd((int*)&cntL[e2], 1);
        }
    }
}

constexpr int AT_XCH = 65536;
DI float max3f(float a, float b, float c) { return fmaxf(fmaxf(a, b), c); }
DI void attn_unit(const Ctx& C, bf16_t* P, int qrow0, int krow_ctx, int krow_lat, int nkt, int h, float lam, const float* anw, float post) {
    const int tid_ = my_tid();
    LAS unsigned char* lds = C.lds; const int lane = tid_ & 63, wid = __builtin_amdgcn_readfirstlane(tid_ >> 6), sub = wid >> 2, qw = wid & 3, r32 = lane & 31, hh = lane >> 5;
    const int tq = (lane & 15) >> 2, tp = lane & 3, blk = (lane >> 4) & 1;
    LAS unsigned char* qlds = lds + AT_XCH + wid * 8192 + r32 * 16;
#pragma unroll
    for (int qb = 0; qb < 2; ++qb) { const bf16_t* qp = P + (size_t)(qrow0 + 64 * qw + 32 * qb + r32) * PW + PC_Q + h * 128 + sub * 64 + 8 * hh;
#pragma unroll
      for (int ks = 0; ks < 4; ++ks) *(LAS bf16x8*)(qlds + ((2 * ks + hh) * 64 + 32 * qb) * 16) = *(const bf16x8*)(qp + 16 * ks); }
    f32x16 O[2][4];
#pragma unroll
    for (int qb = 0; qb < 2; ++qb)
#pragma unroll
        for (int c = 0; c < 4; ++c)
#pragma unroll
            for (int i = 0; i < 16; ++i) O[qb][c][i] = 0.f;
    float m_run[2] = {-INFINITY, -INFINITY}, l_run[2] = {0.f, 0.f};
#define AT_ISSUE(kt, buf) do { const int kr0_ = (kt) < 4 ? krow_ctx + (kt) * 64 : krow_lat + ((kt) - 4) * 64; LAS unsigned char* bb_ = lds + (buf) * 32768; \
        _Pragma("unroll") for (int j_ = 0; j_ < 2; ++j_) { const int c_ = 2 * wid + j_; \
            dma16(P + (size_t)(kr0_ + lane) * PW + PC_K + h * 128 + c_ * 8, bb_ + c_ * 1024); \
            dma16(P + (size_t)(kr0_ + 16 * (c_ & 3) + (lane >> 2)) * PW + PC_V + h * 128 + (c_ >> 2) * 32 + (lane & 3) * 8, bb_ + 16384 + c_ * 1024); } } while (0)
    AT_ISSUE(0, 0);
    int buf = 0;
#pragma unroll 1
    for (int kt = 0; kt < nkt; ++kt) {
        VM_WAIT(); __syncthreads();
        if (kt + 1 < nkt) AT_ISSUE(kt + 1, buf ^ 1);
        const LAS unsigned char* kb = lds + buf * 32768, * vb = kb + 16384 + (4 * hh + tq) * 64 + blk * 32 + tp * 8;
        bf16x8 Pf[2][4];
#pragma unroll
        for (int qb = 0; qb < 2; ++qb) {
            f32x16 s0, s1;
#pragma unroll
            for (int i = 0; i < 16; ++i) { s0[i] = 0.f; s1[i] = 0.f; }
#pragma unroll
            for (int ks = 0; ks < 4; ++ks) { const LAS unsigned char* kp = kb + ((sub * 8 + 2 * ks + hh) * 64 + r32) * 16;
                const bf16x8 k0 = *(const LAS bf16x8*)kp, k1 = *(const LAS bf16x8*)(kp + 512);
                const bf16x8 q = *(const LAS bf16x8*)(qlds + ((2 * ks + hh) * 64 + 32 * qb) * 16);
                s0 = MFMA32(k0, q, s0); s1 = MFMA32(k1, q, s1); }
            float mx = max3f(s0[0], s1[0], s0[1]);
#pragma unroll
            for (int i = 1; i < 16; ++i) mx = (i + 1 < 16) ? max3f(mx, s1[i], s0[i + 1]) : fmaxf(mx, s1[i]);
            mx = fmaxf(mx, __shfl_xor(mx, 32));
            const float mnew = fmaxf(m_run[qb], mx);
            if (__any(mnew > m_run[qb])) { const float alpha = __builtin_amdgcn_exp2f(m_run[qb] - mnew); l_run[qb] *= alpha;
#pragma unroll
                for (int c = 0; c < 4; ++c)
#pragma unroll
                    for (int i = 0; i < 16; ++i) O[qb][c][i] *= alpha;
                m_run[qb] = mnew; }
            const float mr = m_run[qb]; float ps0 = 0.f, ps1 = 0.f;
#pragma unroll
            for (int i = 0; i < 16; ++i) { s0[i] = __builtin_amdgcn_exp2f(s0[i] - mr); s1[i] = __builtin_amdgcn_exp2f(s1[i] - mr); ps0 += s0[i]; ps1 += s1[i]; }
            l_run[qb] += ps0 + ps1;
            Pf[qb][0] = packf8(s0, 0); Pf[qb][1] = packf8(s0, 1); Pf[qb][2] = packf8(s1, 0); Pf[qb][3] = packf8(s1, 1);
        }
#pragma unroll
        for (int cb = 0; cb < 4; ++cb) {
#pragma unroll
            for (int s4 = 0; s4 < 4; ++s4) { const bf16x8 a = cat8(tr16(vb + cb * 4096 + s4 * 1024), tr16(vb + cb * 4096 + s4 * 1024 + 512));
                O[0][cb] = MFMA32(a, Pf[0][s4], O[0][cb]); O[1][cb] = MFMA32(a, Pf[1][s4], O[1][cb]); } }
        buf ^= 1;
    }
#undef AT_ISSUE
    LDS_WAIT(); __syncthreads();
    const int te = my_tid(); const int lane_e = te & 63, wid_e = __builtin_amdgcn_readfirstlane(te >> 6);
    LAS float* xch = (LAS float*)(lds + AT_XCH) + (wid_e & 3) * 4096 + lane_e;
#pragma unroll
    for (int qb = 0; qb < 2; ++qb) {
        const float lt = l_run[qb] + __shfl_xor(l_run[qb], 32); const float inv = 1.f / lt;
        if ((wid_e >> 2) == 1) { const float sc = -lam * inv;
#pragma unroll
            for (int c = 0; c < 4; ++c)
#pragma unroll
                for (int i = 0; i < 16; ++i) xch[(c * 16 + i) * 64] = O[qb][c][i] * sc; }
        LDS_WAIT(); __syncthreads();
        if ((wid_e >> 2) == 0) {
            float ss = 0.f;
#pragma unroll
            for (int c = 0; c < 4; ++c)
#pragma unroll
                for (int i = 0; i < 16; ++i) { const float o = O[qb][c][i] * inv + xch[(c * 16 + i) * 64]; O[qb][c][i] = o; ss += o * o; }
            ss += __shfl_xor(ss, 32);
            const float rs = post / sqrtf(ss * (1.f / 128.f) + EPS);
            bf16_t* op = P + (size_t)(qrow0 + 64 * (wid_e & 3) + 32 * qb + (lane_e & 31)) * PW + PC_Q + h * 128;
#pragma unroll
            for (int c = 0; c < 4; ++c)
#pragma unroll
                for (int g = 0; g < 4; ++g) { const int v0 = 32 * c + 8 * g + 4 * (lane_e >> 5); const f32x4 w = *(const f32x4*)(anw + v0);
                    u32x2 o; o.x = cvt_pk_bf16(O[qb][c][4 * g] * rs * w[0], O[qb][c][4 * g + 1] * rs * w[1]); o.y = cvt_pk_bf16(O[qb][c][4 * g + 2] * rs * w[2], O[qb][c][4 * g + 3] * rs * w[3]);
                    *(u32x2*)(op + v0) = o; }
        }
        LDS_WAIT(); __syncthreads();
    }
}

constexpr int SC_Q = 0, SC_LF = 16384, SC_V0 = 32768, SC_QM = 65536, SC_KMR = 81920, SC_KMS = 98304, SC_SX = 114688, SC_A31 = 147456, SC_A63 = 147968, SC_END = 148480;
DI void scan_chain(const Ctx& C, bf16_t* P, int b, int h, int dir, bool store_ctx) {
    const int tid_ = my_tid();
    LAS unsigned char* lds = C.lds; const int lane = tid_ & 63, wid = __builtin_amdgcn_readfirstlane(tid_ >> 6), r32 = lane & 31, hh = lane >> 5;
    const int tq = (lane & 15) >> 2, tp = lane & 3, blk = (lane >> 4) & 1;
    const int db = wid & 3, tb = wid >> 2;
    const int base_nat = hh * 512 + tq * 64 + blk * 32 + tp * 8;
    const int base_prm = (4 * hh + tq) * 64 + blk * 32 + tp * 8;
    const int lfcol = (dir ? PC_LB : PC_LF) + h * 128, qcol = PC_RQ + h * 128, vcol = PC_RI + h * 128;
    f32x16 ST[2];
#pragma unroll
    for (int j = 0; j < 2; ++j)
#pragma unroll
        for (int i = 0; i < 16; ++i) ST[j][i] = 0.f;
#define SROW(c, i) ((c) < 4 ? NLAT + b * CL + (dir ? 255 - ((c) * 64 + (i)) : (c) * 64 + (i)) : b * T + (dir ? 2047 - (((c) - 4) * 64 + (i)) : ((c) - 4) * 64 + (i)))
#define SDMA(c, colbase, dstoff) do { _Pragma("unroll") for (int j_ = 0; j_ < 2; ++j_) { const int I_ = 2 * wid + j_; const int ti_ = 16 * (I_ & 3) + (lane >> 2); \
        dma16(P + (size_t)SROW(c, ti_) * PW + (colbase) + (I_ >> 2) * 32 + (lane & 3) * 8, lds + (dstoff) + I_ * 1024); } } while (0)
    SDMA(0, qcol, SC_Q); SDMA(0, lfcol, SC_LF); SDMA(0, vcol, SC_V0);
    int vbuf = 0;
    const int t = 32 * tb + r32;
#pragma unroll 1
    for (int c = 0; c < 36; ++c) {
        VM_WAIT(); __syncthreads();
        const LAS unsigned char* Vimg = lds + SC_V0 + vbuf * 16384;
        f32x16 cm;
#pragma unroll
        for (int i = 0; i < 16; ++i) cm[i] = 0.f;
#pragma unroll
        for (int kk = 0; kk < 2; ++kk) { const int ks = 2 * tb + kk;
            const half8 a = __builtin_bit_cast(half8, cat8(tr16(lds + SC_LF + db * 4096 + base_nat + ks * 1024), tr16(lds + SC_LF + db * 4096 + base_nat + ks * 1024 + 256)));
            half8 bm;
#pragma unroll
            for (int j = 0; j < 8; ++j) { const int s = 16 * ks + 8 * hh + j; bm[j] = tb == 0 ? (s > t ? (_Float16)-1.f : (_Float16)0.f) : (s <= t ? (_Float16)1.f : (_Float16)0.f); }
            cm = __builtin_amdgcn_mfma_f32_32x32x16_f16(a, bm, cm, 0, 0, 0); }
#pragma unroll
        for (int g = 0; g < 4; ++g) {
            const int sa = db * 4096 + (t >> 3) * 512 + (t & 7) * 64 + (8 * g + 4 * hh) * 2;
            const u32x2 q4 = *(const LAS u32x2*)(lds + SC_Q + sa); const half4 lf4 = *(const LAS half4*)(lds + SC_LF + sa);
            const float qv[4] = {bflo(q4.x), bfhi(q4.x), bflo(q4.y), bfhi(q4.y)};
            float qm[4], km[4];
#pragma unroll
            for (int e = 0; e < 4; ++e) { const float cv = cm[4 * g + e] * LOG2E; const float E = __builtin_amdgcn_exp2f(cv), Ei = __builtin_amdgcn_exp2f(-cv);
                const float lf = (float)lf4[e]; qm[e] = qv[e] * E; km[e] = (1.f - __builtin_amdgcn_exp2f(lf * LOG2E)) * Ei;
                if (tb == 0 && r32 == 0) ((LAS float*)(lds + SC_A31))[32 * db + 8 * g + 4 * hh + e] = lf - cm[4 * g + e];
                if (tb == 1 && r32 == 31) ((LAS float*)(lds + SC_A63))[32 * db + 8 * g + 4 * hh + e] = cm[4 * g + e]; }
            u32x2 qw2, kw2; qw2.x = cvt_pk_bf16(qm[0], qm[1]); qw2.y = cvt_pk_bf16(qm[2], qm[3]); kw2.x = cvt_pk_bf16(km[0], km[1]); kw2.y = cvt_pk_bf16(km[2], km[3]);
            const int ra = ((4 * db + g) * 64 + t) * 16 + 8 * hh;
            *(LAS u32x2*)(lds + SC_QM + ra) = qw2; *(LAS u32x2*)(lds + SC_KMR + ra) = kw2; *(LAS u32x2*)(lds + SC_KMS + sa) = kw2;
        }
        LDS_WAIT(); __syncthreads();
        if (c + 1 < 36) { SDMA(c + 1, qcol, SC_Q); SDMA(c + 1, lfcol, SC_LF); SDMA(c + 1, vcol, SC_V0 + (vbuf ^ 1) * 16384); }
        { const int d = 32 * db + r32; const float c31 = ((LAS float*)(lds + SC_A31))[d], c63 = ((LAS float*)(lds + SC_A63))[d];
          const float e31 = __expf(c31), dec = __expf(c31 + c63), e63 = __expf(c63);
          f32x16 SN[2];
#pragma unroll
          for (int j = 0; j < 2; ++j) { const int vb2 = 2 * tb + j;
#pragma unroll
              for (int g = 0; g < 4; ++g) { u32x2 w; w.x = cvt_pk_bf16(ST[j][4 * g] * e31, ST[j][4 * g + 1] * e31); w.y = cvt_pk_bf16(ST[j][4 * g + 2] * e31, ST[j][4 * g + 3] * e31);
                  *(LAS u32x2*)(lds + SC_SX + vb2 * 8192 + (d >> 3) * 512 + (d & 7) * 64 + (8 * g + 4 * hh) * 2) = w; }
#pragma unroll
              for (int i = 0; i < 16; ++i) SN[j][i] = 0.f; }
#pragma unroll
          for (int ks = 0; ks < 4; ++ks) {
              const bf16x8 kf = cat8(tr16(lds + SC_KMS + db * 4096 + base_nat + ks * 1024), tr16(lds + SC_KMS + db * 4096 + base_nat + ks * 1024 + 256));
#pragma unroll
              for (int j = 0; j < 2; ++j) { const int vb2 = 2 * tb + j;
                  const bf16x8 vf = cat8(tr16(Vimg + vb2 * 4096 + base_nat + ks * 1024), tr16(Vimg + vb2 * 4096 + base_nat + ks * 1024 + 256));
                  SN[j] = MFMA32(vf, kf, SN[j]); } }
#pragma unroll
          for (int j = 0; j < 2; ++j)
#pragma unroll
              for (int i = 0; i < 16; ++i) ST[j][i] = dec * ST[j][i] + e63 * SN[j][i];
        }
        LDS_WAIT(); __syncthreads();
        { bf16x8 Qmf[8];
#pragma unroll
          for (int kd = 0; kd < 8; ++kd) Qmf[kd] = *(const LAS bf16x8*)(lds + SC_QM + ((2 * kd + hh) * 64 + t) * 16);
          f32x16 o;
#pragma unroll
          for (int i = 0; i < 16; ++i) o[i] = 0.f;
          for (int sb = 0; sb <= tb; ++sb) {
              f32x16 pt;
#pragma unroll
              for (int i = 0; i < 16; ++i) pt[i] = 0.f;
#pragma unroll
              for (int kd = 0; kd < 8; ++kd) { const bf16x8 a = *(const LAS bf16x8*)(lds + SC_KMR + ((2 * kd + hh) * 64 + 32 * sb + r32) * 16); pt = MFMA32(a, Qmf[kd], pt); }
              if (sb == tb) {
#pragma unroll
                  for (int i = 0; i < 16; ++i) if (crow(i, hh) > r32) pt[i] = 0.f; }
              const bf16x8 p0 = packf8(pt, 0), p1 = packf8(pt, 1);
              { const bf16x8 a = cat8(tr16(Vimg + db * 4096 + base_prm + (2 * sb) * 1024), tr16(Vimg + db * 4096 + base_prm + (2 * sb) * 1024 + 512)); o = MFMA32(a, p0, o); }
              { const bf16x8 a = cat8(tr16(Vimg + db * 4096 + base_prm + (2 * sb + 1) * 1024), tr16(Vimg + db * 4096 + base_prm + (2 * sb + 1) * 1024 + 512)); o = MFMA32(a, p1, o); }
          }
#pragma unroll
          for (int kd = 0; kd < 8; ++kd) { const bf16x8 a = cat8(tr16(lds + SC_SX + db * 8192 + base_nat + kd * 1024), tr16(lds + SC_SX + db * 8192 + base_nat + kd * 1024 + 256)); o = MFMA32(a, Qmf[kd], o); }
          if (c >= 4 || store_ctx) { bf16_t* op = P + (size_t)SROW(c, t) * PW + lfcol + 32 * db;
#pragma unroll
              for (int g = 0; g < 4; ++g) { u32x2 w; w.x = cvt_pk_bf16(o[4 * g], o[4 * g + 1]); w.y = cvt_pk_bf16(o[4 * g + 2], o[4 * g + 3]); *(u32x2*)(op + 8 * g + 4 * hh) = w; } }
        }
        vbuf ^= 1;
    }
    VM_WAIT(); LDS_WAIT(); __syncthreads();
#undef SROW
#undef SDMA
}

DI void phase_recprep(const Ctx& C, bf16_t* P, const float* rnw, int nrows) {
    for (int row = C.gw; row < nrows; row += C.NGW) {
        bf16_t* pr = P + (size_t)row * PW + 8 * C.lane;
        float a[8], bb[8], g[8]; unpack8(*(const u32x4*)(pr + PC_LF), a); unpack8(*(const u32x4*)(pr + PC_LB), bb); unpack8(*(const u32x4*)(pr + PC_G), g);
        float ss = 0.f;
#pragma unroll
        for (int j = 0; j < 8; ++j) { a[j] += bb[j]; ss += a[j] * a[j]; }
        ss += __shfl_xor(ss, 1); ss += __shfl_xor(ss, 2); ss += __shfl_xor(ss, 4); ss += __shfl_xor(ss, 8);
        const float rs = 1.0f / sqrtf(ss * (1.f / 128.f) + EPS);
        const f32x4 w0 = *(const f32x4*)(rnw + ((8 * C.lane) & 127)), w1 = *(const f32x4*)(rnw + ((8 * C.lane) & 127) + 4);
        f32x4 o0, o1;
#pragma unroll
        for (int j = 0; j < 4; ++j) { o0[j] = a[j] * rs * w0[j] * g[j]; o1[j] = a[4 + j] * rs * w1[j] * g[4 + j]; }
        *(u32x4*)(pr + PC_LF) = pack8(o0, o1);
    }
}

DI void phase_slots(const Ctx& C, const int* cnt, int* pbout, unsigned char* route, const bf16_t* H2, bf16_t* AG, LAS int* cur) {
    if (C.tid < 16) cur[C.tid] = 0;
    __syncthreads();
    for (int g = C.tid; g < C.G; g += 512) {
#pragma unroll
        for (int k = 0; k < 8; ++k) { const int c = cnt[g * 8 + k]; atomicAdd((int*)&cur[8 + k], c); if (g < C.bx) atomicAdd((int*)&cur[k], c); } }
    __syncthreads();
    if (C.tid < 8) { const int e = C.tid; int pb = 0, pbe = 0;
#pragma unroll
        for (int k = 0; k < 8; ++k) { if (k == e) pbe = pb; pb += (cur[8 + k] + 255) >> 8; }
        const int mine = cur[e];
        if (C.bx == 0) { pbout[e] = pbe; if (e == 7) pbout[8] = pb; }
        cur[e] = pbe * 256 + mine;
    }
    __syncthreads();
    const int nloc = (NLAT - C.gw + C.NGW - 1) / C.NGW;
    LAS int* tab = (LAS int*)(C.lds + C.wave * 2048);
    for (int i = C.lane; i < nloc; i += 64) { int* rt = (int*)(route + (size_t)(C.gw + i * C.NGW) * 24);
        const int s1 = atomicAdd((int*)&cur[rt[0]], 1), s2 = atomicAdd((int*)&cur[rt[1]], 1); rt[4] = s1; rt[5] = s2; tab[2 * i] = s1; tab[2 * i + 1] = s2; }
    LDS_WAIT();
    for (int i = 0; i < nloc; i += 2) { const int i1 = i + 1 < nloc ? i + 1 : i;
        const int sa1 = __builtin_amdgcn_readfirstlane(tab[2 * i]), sa2 = __builtin_amdgcn_readfirstlane(tab[2 * i + 1]), sb1 = __builtin_amdgcn_readfirstlane(tab[2 * i1]), sb2 = __builtin_amdgcn_readfirstlane(tab[2 * i1 + 1]);
        const u32x4 va = *((const u32x4*)((const unsigned char*)H2 + (size_t)(C.gw + i * C.NGW) * D) + C.lane);
        const u32x4 vb = *((const u32x4*)((const unsigned char*)H2 + (size_t)(C.gw + i1 * C.NGW) * D) + C.lane);
        *((u32x4*)((unsigned char*)AG + (size_t)sa1 * D) + C.lane) = va; *((u32x4*)((unsigned char*)AG + (size_t)sa2 * D) + C.lane) = va;
        *((u32x4*)((unsigned char*)AG + (size_t)sb1 * D) + C.lane) = vb; *((u32x4*)((unsigned char*)AG + (size_t)sb2 * D) + C.lane) = vb;
    }
}
DI void phase_final(const Ctx& C, float* x, const unsigned char* route, const bf16_t* Y, const float* mods1, const float* fw) {
    for (int row0 = C.gw; row0 < NLAT; row0 += 2 * C.NGW) {
        const int rows[2] = {row0, row0 + C.NGW < NLAT ? row0 + C.NGW : row0};
        f32x4 v[2][4]; float ss[2] = {0.f, 0.f};
#pragma unroll
        for (int u = 0; u < 2; ++u) { const int row = rows[u];
            const int* rt = (const int*)(route + (size_t)row * 24); const float g1 = ((const float*)rt)[2], g2 = ((const float*)rt)[3]; const int s1 = rt[4], s2 = rt[5];
            const float* mv = mods1 + (size_t)(row >> 11) * DIN + 5 * D; const float* xr = x + (size_t)row * D;
#pragma unroll
            for (int j = 0; j < 4; ++j) { const int c0 = 256 * j + 4 * C.lane;
                const u32x2 y1 = *(const u32x2*)(Y + (size_t)s1 * D + c0), y2 = *(const u32x2*)(Y + (size_t)s2 * D + c0); const f32x4 m5 = *(const f32x4*)(mv + c0);
                f32x4 y; y[0] = g1 * bflo(y1.x) + g2 * bflo(y2.x); y[1] = g1 * bfhi(y1.x) + g2 * bfhi(y2.x); y[2] = g1 * bflo(y1.y) + g2 * bflo(y2.y); y[3] = g1 * bfhi(y1.y) + g2 * bfhi(y2.y);
                v[u][j] = *(const f32x4*)(xr + c0) + m5 * y; ss[u] += (v[u][j][0] * v[u][j][0] + v[u][j][1] * v[u][j][1]) + (v[u][j][2] * v[u][j][2] + v[u][j][3] * v[u][j][3]); } }
#pragma unroll
        for (int u = 0; u < 2; ++u) { if (u == 1 && rows[1] == rows[0]) break;
            const float rstd = 1.0f / sqrtf(wave_sum(ss[u]) * (1.f / D) + EPS); float* xr = x + (size_t)rows[u] * D;
#pragma unroll
            for (int j = 0; j < 4; ++j) { const int c0 = 256 * j + 4 * C.lane; *(f32x4*)(xr + c0) = v[u][j] * rstd * *(const f32x4*)(fw + c0); } }
    }
}

constexpr int LDS_MISC = SC_END;
constexpr int LDS_BYTES = SC_END + 512;
static_assert(LDS_WTAB_OFF == SC_END + 128, "wave table sits behind the barrier words and counters");
constexpr int NPHASE = 20;

DI Ctx make_ctx() {
    extern __shared__ __attribute__((aligned(16))) unsigned char lds_raw[];
    Ctx C; const int t = my_tid();
    unsigned lb = (unsigned)(size_t)(LAS unsigned char*)lds_raw; asm volatile("" : "+s"(lb));
    C.lds = (LAS unsigned char*)(size_t)lb; C.ws = kparams()->ws; C.tid = t; C.lane = t & 63; C.wave = __builtin_amdgcn_readfirstlane(t >> 6);
    int bx = blockIdx.x, G = gridDim.x; asm volatile("" : "+s"(bx), "+s"(G));
    C.bx = bx; C.G = G; C.vcu = (C.G % 8 == 0) ? (bx % 8) * (C.G / 8) + bx / 8 : bx;
    C.gw = C.vcu * 8 + C.wave; C.NGW = C.G * 8;
    return C;
}
DI void grid_barrier() {
    extern __shared__ __attribute__((aligned(16))) unsigned char lds_raw[];
    XcdBarrier b; b.bar = (unsigned*)(kparams()->ws + WS_CTL) + CW_BAR + kparams()->li * XCD_BAR_WORDS; b.x = xb_xcc_id(); b.st = (volatile LAS unsigned*)((LAS unsigned char*)lds_raw + LDS_MISC);
    xcd_barrier(b);
}
#define WSP(T, off) ((T*)(kparams()->ws + (off)))

#define IN(k) (kparams()->ph_lo <= (k) && (k) < kparams()->ph_hi)
#define SEAM(k) do { if (IN(k) && IN((k) + 1)) grid_barrier(); } while (0)


template <int l> DI void layer_phases() {
        const int pb = 1 + 9 * l;
#define LQ() int lq = l; asm volatile("" : "+s"(lq))
#define XL (lq == 0 ? PIN(0) : (const float*)POUT)
#define XC (lq == 0 ? PIN(2) : (const float*)WSP(float, WS_CTXRES))
#define LMODS (WSP(float, WS_MODS) + (size_t)lq * 33 * DIN)
#define NROWS_OUT (lq == 0 ? NTOK : NLAT)
        if (IN(pb + 0)) { LQ(); const Ctx C = make_ctx(); phase_norm<false>(C, XL, XC, PIN(6) + lq * D, LMODS, 0, NTOK, WSP(bf16_t, WS_H), nullptr, nullptr, nullptr, WSP(unsigned char, WS_H8)); }
        SEAM(pb + 0);
        if (IN(pb + 1)) { LQ();
            { const Ctx C = make_ctx();
              Gemm g{WSP(bf16_t, WS_H), WSP(bf16_t, WS_WIN) + (size_t)lq * 4096 * D, NTOK, N_SEC_BF * 512, D, D};
              pg8::StaticOrder S; S.init(g, C.G, C.bx);
              EpiInProj E{WSP(bf16_t, WS_P), WSP(float2, WS_ROPE), WSP(float, WS_LBS) + lq * 1024, WSP(float, WS_LBS) + lq * 1024 + 512, (int)secmap_of(false), 1.f};
              pg8::gemm_phase<EpiInProj, pg8::StaticOrder>(C.lds, g, S, E); }
            if (N_SEC_F8 > 0) { const Ctx C = make_ctx();
              Gemm g{WSP(bf16_t, WS_H8), (const bf16_t*)(WSP(unsigned char, WS_WIN8) + (size_t)lq * 4096 * D), NTOK, N_SEC_F8 * 512, D / 2, D / 2};
              pg8::StaticOrder S; S.init(g, C.G, C.bx);
              EpiInProj E{WSP(bf16_t, WS_P), WSP(float2, WS_ROPE), WSP(float, WS_LBS) + lq * 1024, WSP(float, WS_LBS) + lq * 1024 + 512, (int)secmap_of(true), 1.f / WIN8_SCALE};
              pg8::gemm_phase<EpiInProj, pg8::StaticOrder, true, true>(C.lds, g, S, E); }
        }
        SEAM(pb + 1);
        if (IN(pb + 2)) { LQ(); const Ctx C = make_ctx(); bf16_t* const Pb = WSP(bf16_t, WS_P);
            for (int id = C.vcu; id < NB * 4 * 2; id += C.G) scan_chain(C, Pb, id >> 3, (id >> 1) & 3, id & 1, lq == 0);
            float lam;
            { const float a = wave_sum(PIN(9)[lq * 64 + C.lane] * PIN(10)[lq * 64 + C.lane]), b2 = wave_sum(PIN(11)[lq * 64 + C.lane] * PIN(12)[lq * 64 + C.lane]);
              const float li = 0.8f - 0.6f * expf(-0.3f * (float)lq); lam = expf(a) - expf(b2) + li; lam = __uint_as_float(__builtin_amdgcn_readfirstlane(__float_as_uint(lam))); }
            const float post = __uint_as_float(__builtin_amdgcn_readfirstlane(__float_as_uint(1.f - (0.8f - 0.6f * expf(-0.3f * (float)lq)))));
            const float* anw = PIN(13) + lq * 128;
            const int NU = NB * 4 * 8, U = (NU + C.G - 1) / C.G;
            for (int id = C.vcu * U; id < NU && id < (C.vcu + 1) * U; ++id) { const int bh = id >> 3, qb = id & 7, b = bh >> 2, h = bh & 3;
                attn_unit(C, Pb, b * T + qb * 256, NLAT + b * CL, b * T, 36, h, lam, anw, post); }
            if (lq == 0) for (int id = C.vcu; id < NB * 4; id += C.G) { const int b = id >> 2, h = id & 3;
                attn_unit(C, Pb, NLAT + b * CL, NLAT + b * CL, 0, 4, h, lam, anw, post); }
        }
        SEAM(pb + 2);
        if (IN(pb + 3)) { LQ(); const Ctx C = make_ctx();
            phase_recprep(C, WSP(bf16_t, WS_P), PIN(14) + lq * 128, NROWS_OUT);
            Gemm g{WSP(bf16_t, WS_H8), (const bf16_t*)(WSP(unsigned char, WS_WIN8) + ((size_t)lq * 4096 + N_SEC_F8 * 512) * D), NROWS_OUT, 2048, D / 2, D / 2};
            pg8::StaticOrder S; S.init(g, C.G, C.bx);
            EpiGates E{WSP(bf16_t, WS_P), 1.f / WIN8_SCALE};
            pg8::gemm_phase<EpiGates, pg8::StaticOrder, true, true>(C.lds, g, S, E);
        }
        SEAM(pb + 3);
        if (IN(pb + 4)) { LQ(); const Ctx C = make_ctx();
            Gemm g{WSP(bf16_t, WS_P) + PC_Q, WSP(bf16_t, WS_WUA) + (size_t)lq * D * D, NROWS_OUT, D, D, PW};
            pg8::StaticOrder S; S.init(g, C.G, C.bx); EpiMergeFused E{WSP(bf16_t, WS_P), WSP(bf16_t, WS_MERGED)};
            pg8::gemm_phase<EpiMergeFused, pg8::StaticOrder, true, false, true>(C.lds, g, S, E);
        }
        SEAM(pb + 4);
        if (IN(pb + 5)) { LQ(); const Ctx C = make_ctx();
            Gemm g{WSP(bf16_t, WS_MERGED), WSP(bf16_t, WS_WO) + (size_t)lq * D * D, NROWS_OUT, D, D, D};
            pg8::StaticOrder S; S.init(g, C.G, C.bx);
            EpiResid E{XL, XC, POUT, WSP(float, WS_CTXRES), LMODS, 2};
            pg8::gemm_phase<EpiResid, pg8::StaticOrder>(C.lds, g, S, E);
        }
        SEAM(pb + 5);
        if (l == 0) {
            if (IN(7)) { LQ(); const Ctx C = make_ctx(); phase_norm<false>(C, POUT, WSP(float, WS_CTXRES), PIN(7), LMODS, 3, NTOK, WSP(bf16_t, WS_H), nullptr, nullptr, nullptr); }
            SEAM(7);
            if (IN(8)) { LQ(); const Ctx C = make_ctx();
                Gemm g{WSP(bf16_t, WS_H), WSP(bf16_t, WS_W13), NTOK, 2 * DFFP, D, D};
                pg8::StaticOrder S; S.init(g, C.G, C.bx); EpiSwiglu E{WSP(bf16_t, WS_HID), DFFP, 0};
                pg8::gemm_phase<EpiSwiglu, pg8::StaticOrder>(C.lds, g, S, E);
            }
            SEAM(8);
            if (IN(9)) { LQ(); const Ctx C = make_ctx();
                Gemm g{WSP(bf16_t, WS_HID), WSP(bf16_t, WS_W2), NTOK, D, DFFP, DFFP};
                pg8::StaticOrder S; S.init(g, C.G, C.bx); EpiResid E{POUT, WSP(float, WS_CTXRES), POUT, WSP(float, WS_CTXRES), LMODS, 5};
                pg8::gemm_phase<EpiResid, pg8::StaticOrder>(C.lds, g, S, E);
            }
            SEAM(9);
        } else {
            if (IN(16)) { LQ(); const Ctx C = make_ctx(); LAS int* lcnt = (LAS int*)(C.lds + LDS_MISC + 32);
                if (C.tid < 8) lcnt[C.tid] = 0;
                __syncthreads();
                phase_norm<true>(C, POUT, nullptr, PIN(7) + D, LMODS, 3, NLAT, WSP(bf16_t, WS_H2M), PIN(23), WSP(unsigned char, WS_ROUTE), lcnt);
                __syncthreads();
                if (C.tid < 8) WSP(int, WS_CNT)[C.bx * 8 + C.tid] = lcnt[C.tid];
                convert_moe_weights(C);
            }
            SEAM(16);
            if (IN(17)) { LQ(); const Ctx C = make_ctx(); phase_slots(C, WSP(int, WS_CNT), WSP(int, WS_CNT) + 4096, WSP(unsigned char, WS_ROUTE), WSP(bf16_t, WS_H2M), WSP(bf16_t, WS_AG), (LAS int*)(C.lds + LDS_MISC + 32)); }
            SEAM(17);
            if (IN(18)) { LQ();
                const int ptot = __builtin_amdgcn_readfirstlane(WSP(int, WS_CNT)[4096 + 8]);
                for (int p0 = 0; p0 < ptot; p0 += MOE_CHUNK) {
                    const int np = (ptot - p0) < MOE_CHUNK ? (ptot - p0) : MOE_CHUNK;
#define MOE_ORDER_INIT(S) do { S.so.init(g, C.G, C.bx); S.p0 = p0; S.pbv = WSP(int, WS_CNT) + 4096; } while (0)
                    { const Ctx C = make_ctx(); Gemm g{WSP(bf16_t, WS_AG), WSP(bf16_t, WS_WM13), np * 256, 2 * DFE, D / 2, D / 2};
                      pg8::MoeOrder S; MOE_ORDER_INIT(S); S.apan0 = 0; S.estride = (size_t)2 * DFE * D;
                      EpiSwiglu8 E{WSP(unsigned char, WS_MHID), DFE, p0, 1.f / W13_SCALE, HID_SCALE};
                      pg8::gemm_phase<EpiSwiglu8, pg8::MoeOrder, true, true>(C.lds, g, S, E); }
                    grid_barrier();
                    { const Ctx C = make_ctx(); Gemm g{WSP(bf16_t, WS_MHID), WSP(bf16_t, WS_WM2), np * 256, D, DFE / 2, DFE / 2};
                      pg8::MoeOrder S; MOE_ORDER_INIT(S); S.apan0 = p0; S.estride = (size_t)D * DFE;
                      EpiBf16 E{WSP(bf16_t, WS_Y), D, 1.f / (W2_SCALE * HID_SCALE)};
                      pg8::gemm_phase<EpiBf16, pg8::MoeOrder, true, true>(C.lds, g, S, E); }
                    grid_barrier();
                }
            }
            if (IN(19)) { LQ(); const Ctx C = make_ctx(); phase_final(C, POUT, WSP(unsigned char, WS_ROUTE), WSP(bf16_t, WS_Y), LMODS, PIN(27)); }
        }
}

__global__ void __launch_bounds__(512, 2) fwd_kernel(Params p) {
    extern __shared__ __attribute__((aligned(16))) unsigned char lds_raw[];
    (void)p;
    { volatile LAS unsigned* misc = (volatile LAS unsigned*)((LAS unsigned char*)lds_raw + LDS_MISC);
      if (threadIdx.x < 16) misc[threadIdx.x] = 0u;
      if ((threadIdx.x & 63) == 0) ((volatile LAS int*)((LAS unsigned char*)lds_raw + LDS_WTAB_OFF))[(unsigned)__builtin_amdgcn_s_getreg((5 << 11) | 4) & 63u] = threadIdx.x >> 6;
      __syncthreads();
      (void)xcd_barrier_post((unsigned*)(kparams()->ws + WS_CTL) + CW_BAR + kparams()->li * XCD_BAR_WORDS, misc); }
    if (IN(0)) { const Ctx C = make_ctx(); phase_prologue(C); } SEAM(0);

    layer_phases<0>();
    layer_phases<1>();
#undef IN
#undef SEAM
}


extern "C" void kernel_launch(void* const* d_in, const int* in_sizes, int n_in, void* d_out, int out_size, void* d_ws, size_t ws_size, hipStream_t stream) {
    static int grid = 0;
    if (grid == 0) {
        if (n_in != 28 || out_size != NLAT * D || ws_size < WS_END) { fprintf(stderr, "kernel_launch: unexpected problem (n_in %d, out %d, ws %zu)\n", n_in, out_size, ws_size); grid = -1; return; }
        int dev = 0, cus = 0, per_cu = 0;
        if (hipGetDevice(&dev) != hipSuccess || hipDeviceGetAttribute(&cus, hipDeviceAttributeMultiprocessorCount, dev) != hipSuccess) { grid = -1; return; }
        if (hipFuncSetAttribute((const void*)fwd_kernel, hipFuncAttributeMaxDynamicSharedMemorySize, LDS_BYTES) != hipSuccess) { fprintf(stderr, "kernel_launch: cannot set %d B dynamic LDS\n", LDS_BYTES); grid = -1; return; }
        if (hipOccupancyMaxActiveBlocksPerMultiprocessor(&per_cu, (const void*)fwd_kernel, 512, LDS_BYTES) != hipSuccess || per_cu < 1) fprintf(stderr, "kernel_launch: occupancy query says %d\n", per_cu);
        (void)hipGetLastError();
        grid = cus;
    }
    if (grid < 0) return;
    (void)hipMemsetAsync((char*)d_ws + WS_CTL, 0, CTL_BYTES, stream);
    Params a{};
    for (int i = 0; i < 28; ++i) a.in[i] = (const float*)d_in[i];
    a.out = (float*)d_out; a.ws = (unsigned char*)d_ws; a.ph_lo = 0; a.ph_hi = NPHASE; a.li = 0; a.pad = 0;
    hipLaunchKernelGGL(fwd_kernel, dim3(grid), dim3(512), LDS_BYTES, stream, a);
}
```

```cpp
#include <hip/hip_runtime.h>
#include <cstdio>
#include <cstdint>


constexpr int D = 1024, NB = 32, T = 2048, CL = 256;
constexpr int NLAT = NB * T, NCTX = NB * CL, NTOK = NLAT + NCTX;
constexpr int PW = 4096;
constexpr int DIN = 6144, DFF = 2752, DFFP = 2816, DFE = 3584, NE = 8;
constexpr float EPS = 1e-6f;
constexpr float LOG2E = 1.4426950408889634f;
constexpr float QSCALE = 0.125f * LOG2E;
constexpr int PC_Q = 0, PC_LF = 512, PC_G = 1024, PC_LB = 1536, PC_K = 2048, PC_V = 2560, PC_RQ = 3072, PC_RI = 3584, PC_GA = 2048, PC_GR = 3072;

constexpr size_t MiB = 1u << 20;
constexpr size_t WS_CTL = 0, CTL_BYTES = 1 * MiB;
constexpr size_t WS_MODS = 1 * MiB;
constexpr size_t WS_LBS = 3 * MiB;
constexpr size_t WS_ROPE = 3 * MiB + 65536;
constexpr size_t WS_ROUTE = 4 * MiB;
constexpr size_t WS_CNT = 6 * MiB;
constexpr size_t WS_CTXRES = 8 * MiB;
constexpr size_t WS_WIN = 40 * MiB;
constexpr size_t WS_WIN8 = 56 * MiB;
constexpr size_t WS_H8 = 809 * MiB;
constexpr size_t WS_WUA = 64 * MiB;
constexpr size_t WS_WUR = 66 * MiB;
constexpr size_t WS_WO = 68 * MiB;
constexpr size_t WS_W13 = 72 * MiB;
constexpr size_t WS_W2 = 83 * MiB;
constexpr size_t WS_H = 89 * MiB;
constexpr size_t WS_P = 233 * MiB;
constexpr size_t WS_MERGED = 809 * MiB;
constexpr size_t WS_HID = 233 * MiB;
constexpr size_t WS_WM13 = 8 * MiB;
constexpr size_t WS_WM2 = 120 * MiB;
constexpr size_t WS_AG = 176 * MiB;
constexpr size_t WS_MHID = 436 * MiB;
constexpr size_t WS_Y = 674 * MiB;
constexpr size_t WS_H2M = 896 * MiB;
constexpr size_t WS_END = 1024 * MiB;
constexpr int MOE_CHUNK = 256;

constexpr int CW_BAR = 4096;

#define LAS __attribute__((address_space(3)))
#define GAS __attribute__((address_space(1)))
typedef unsigned short bf16_t;
typedef short bf16x8 __attribute__((ext_vector_type(8)));
typedef short s16x4 __attribute__((ext_vector_type(4)));
typedef _Float16 half8 __attribute__((ext_vector_type(8)));
typedef _Float16 half4 __attribute__((ext_vector_type(4)));
typedef float f32x4 __attribute__((ext_vector_type(4)));
typedef float f32x2 __attribute__((ext_vector_type(2)));
typedef float f32x16 __attribute__((ext_vector_type(16)));
typedef unsigned u32x4 __attribute__((ext_vector_type(4)));
typedef unsigned u32x2 __attribute__((ext_vector_type(2)));
#define DI __device__ __forceinline__
#define LDS_WAIT() asm volatile("s_waitcnt lgkmcnt(0)" ::: "memory")
#define VM_WAIT() asm volatile("s_waitcnt vmcnt(0)" ::: "memory")

typedef __bf16 bf16x2_t __attribute__((ext_vector_type(2)));
DI unsigned cvt_pk_bf16(float lo, float hi) { f32x2 v = {lo, hi}; bf16x2_t b = __builtin_convertvector(v, bf16x2_t); return __builtin_bit_cast(unsigned, b); }
typedef int v8i32 __attribute__((ext_vector_type(8)));
typedef int v4i32 __attribute__((ext_vector_type(4)));
DI unsigned pack_fp8x4(float a, float b, float c, float d) {
    a = fminf(fmaxf(a, -448.f), 448.f); b = fminf(fmaxf(b, -448.f), 448.f); c = fminf(fmaxf(c, -448.f), 448.f); d = fminf(fmaxf(d, -448.f), 448.f);
    int w = 0; w = __builtin_amdgcn_cvt_pk_fp8_f32(a, b, w, false); w = __builtin_amdgcn_cvt_pk_fp8_f32(c, d, w, true); return (unsigned)w; }
DI float bf2f(unsigned short b) { return __uint_as_float(((unsigned)b) << 16); }
DI float bflo(unsigned w) { return __uint_as_float(w << 16); }
DI float bfhi(unsigned w) { return __uint_as_float(w & 0xffff0000u); }
DI float fsilu(float x) { return x * __builtin_amdgcn_rcpf(1.f + __expf(-x)); }
DI float fsigmoid(float x) { return __builtin_amdgcn_rcpf(1.f + __expf(-x)); }
DI float wave_sum(float v) {
#pragma unroll
    for (int o = 1; o < 64; o <<= 1) v += __shfl_xor(v, o);
    return v;
}
DI int crow(int r, int hi) { return (r & 3) + 8 * (r >> 2) + 4 * hi; }

constexpr int LDS_WTAB_OFF = 148480 + 128;
DI int my_tid() {
    extern __shared__ __attribute__((aligned(16))) unsigned char lds_raw[];
    const unsigned hw = (unsigned)__builtin_amdgcn_s_getreg((5 << 11) | 4) & 63u;
    const int w = __builtin_amdgcn_readfirstlane(((volatile LAS int*)((LAS unsigned char*)lds_raw + LDS_WTAB_OFF))[hw]);
    int t = w * 64 + (int)__builtin_amdgcn_mbcnt_hi(~0u, __builtin_amdgcn_mbcnt_lo(~0u, 0u));
    asm volatile("" : "+v"(t)); return t;
}
#define XB_TMO      128
#define XB_XCNT(j)  (256  + 64 * (j))
#define XB_XSUB(j)  (1280 + 64 * (j))
#define XB_XGEN(j)  (2304 + 64 * (j))
#define XB_TOP      3328
#define XB_TOPGEN   3392
#define XCD_BAR_WORDS 3456
#define XB_SPIN_CAP (1u << 22)
DI unsigned xb_ld(unsigned* p)              { return __hip_atomic_load(p, __ATOMIC_RELAXED, __HIP_MEMORY_SCOPE_AGENT); }
DI unsigned xb_add(unsigned* p, unsigned v) { return __hip_atomic_fetch_add(p, v, __ATOMIC_RELAXED, __HIP_MEMORY_SCOPE_AGENT); }
DI unsigned xb_xcc_id() { return (unsigned)__builtin_amdgcn_s_getreg((3 << 11) | 20) & 0xFu; }
#define XB_SPIN(cond, bar) do { unsigned _sp = 0; while (cond) { __builtin_amdgcn_s_sleep(1); \
    if ((++_sp & 255u) == 0u) { if (xb_ld(&(bar)[XB_TMO])) break; if (_sp > XB_SPIN_CAP) { atomicAdd(&(bar)[XB_TMO], 1u); break; } } } } while (0)
struct XcdBarrier { unsigned* bar; unsigned x; volatile LAS unsigned* st; };
DI XcdBarrier xcd_barrier_post(unsigned* bar, volatile LAS unsigned* st) {
    XcdBarrier b; b.bar = bar; b.x = xb_xcc_id(); b.st = st;
    if (my_tid() == 0) (void)xb_add(&bar[XB_XCNT(b.x)], 1u);
    return b;
}
DI void xcd_barrier_complete(unsigned* bar, unsigned x, unsigned& nloc, unsigned& nx) {
    const unsigned G = gridDim.x * gridDim.y * gridDim.z;
    unsigned sum, cnt, mine, sp = 0u;
    for (;;) {
        sum = 0u; cnt = 0u; mine = 0u;
#pragma unroll
        for (unsigned j = 0; j < 16; ++j) { const unsigned c = xb_ld(&bar[XB_XCNT(j)]); sum += c; cnt += (c > 0u) ? 1u : 0u; mine = (j == x) ? c : mine; }
        if (sum == G) break;
        __builtin_amdgcn_s_sleep(1);
        if ((++sp & 255u) == 0u) { if (xb_ld(&bar[XB_TMO])) break; if (sp > XB_SPIN_CAP) { atomicAdd(&bar[XB_TMO], 1u); break; } }
    }
    nloc = mine > 0u ? mine : 1u; nx = cnt > 0u ? cnt : 1u;
}
DI void xcd_barrier(const XcdBarrier& b) {
    asm volatile("s_waitcnt vmcnt(0)" ::: "memory");
    __syncthreads();
    if (my_tid() == 0) {
        unsigned* bar = b.bar;
        __builtin_amdgcn_s_waitcnt(0);
        unsigned nloc = b.st[0], nx = b.st[1];
        if (nloc == 0u) { xcd_barrier_complete(bar, b.x, nloc, nx); b.st[0] = nloc; b.st[1] = nx; }
        const unsigned old = xb_add(&bar[XB_XSUB(b.x)], 1u);
        const unsigned gen = old / nloc;
        if (old + 1u == (gen + 1u) * nloc) {
            __builtin_amdgcn_fence(__ATOMIC_RELEASE, "agent");
            asm volatile("s_waitcnt vmcnt(0)" ::: "memory");
            const unsigned og = xb_add(&bar[XB_TOP], 1u);
            const unsigned tg = og / nx;
            if (og + 1u == (tg + 1u) * nx) xb_add(&bar[XB_TOPGEN], 1u);
            else XB_SPIN(xb_ld(&bar[XB_TOPGEN]) == tg, bar);
            __builtin_amdgcn_fence(__ATOMIC_ACQUIRE, "agent");
            xb_add(&bar[XB_XGEN(b.x)], 1u);
            asm volatile("s_waitcnt vmcnt(0)" ::: "memory");
        } else {
            XB_SPIN(xb_ld(&bar[XB_XGEN(b.x)]) == gen, bar);
            __builtin_amdgcn_fence(__ATOMIC_ACQUIRE, "agent");
            asm volatile("s_waitcnt vmcnt(0)" ::: "memory");
        }
    }
    __syncthreads();
}

namespace pg8 {
constexpr int BM = 256, BK = 64, HALF = 128, HTB = HALF * BK * 2, STAGE_BYTES = 8 * HTB, NXCD = 8, WGM = 8;
__host__ __device__ __forceinline__ int lds_byte(int r, int c) { const int st = (r >> 4) * 2 + (c >> 5), rr = r & 15, cc = c & 31, ob = rr * 64 + cc * 2; return st * 1024 + (ob ^ (((ob >> 9) & 1) << 5)); }
__host__ __device__ __forceinline__ void stage_rc(int b, int& R, int& C) { const int st = b / 1024, sb = b % 1024, swz = sb ^ (((sb >> 9) & 1) << 5); R = (st >> 1) * 16 + swz / 64; C = (st & 1) * 32 + (swz % 64) / 2; }
__host__ __device__ __forceinline__ int perm32(int rho) { const int n = rho >> 4, i = rho & 15; return 8 * (i >> 2) + 4 * n + (i & 3); }

struct Unit { int pm, pn; const char* a; const char* b; };
struct Gemm { const bf16_t* A; const bf16_t* Bt; int M, N, K, lda; };

struct StaticOrder {
    int nM, nN, nwg, G, c;
    DI void init(const Gemm& g, int G_, int c_) { nM = g.M / BM; nN = g.N / BM; nwg = nM * nN; G = G_; c = c_; }
    DI bool tile(int i, int& pm, int& pn) const {
        const int L = i * G + c; if (L >= nwg) return false;
        int wgid = L; { const int q = nwg / NXCD, r = nwg % NXCD, xcd = wgid % NXCD, off = wgid / NXCD; wgid = (xcd < r ? xcd * (q + 1) : r * (q + 1) + (xcd - r) * q) + off; }
        const int nig = WGM * nN, gid = wgid / nig, fm = gid * WGM, gsz = (nM - fm) < WGM ? (nM - fm) : WGM;
        pm = fm + ((wgid % nig) % gsz); pn = (wgid % nig) / gsz; return true;
    }
    DI bool next(const Gemm& g, int i, Unit& u) const { if (!tile(i, u.pm, u.pn)) return false;
        u.a = (const char*)g.A + (size_t)u.pm * ((size_t)BM * g.lda * 2); u.b = (const char*)g.Bt + (size_t)u.pn * ((size_t)BM * g.K * 2); return true; }
};
struct MoeOrder {
    StaticOrder so; int p0, apan0; const int* pbv; size_t estride;
    DI bool next(const Gemm& g, int i, Unit& u) const {
        int pm, pn; if (!so.tile(i, pm, pn)) return false;
        u.pm = p0 + pm; u.pn = pn; int e = 0;
#pragma unroll
        for (int k = 1; k < 8; ++k) e += (u.pm >= __builtin_amdgcn_readfirstlane(pbv[k])) ? 1 : 0;
        u.a = (const char*)g.A + (size_t)(u.pm - apan0) * ((size_t)BM * g.lda * 2); u.b = (const char*)g.Bt + (size_t)e * estride + (size_t)pn * ((size_t)BM * g.K * 2); return true;
    }
};

template <class Epi, class Sched, bool ALIGN_EPI = true, bool F8 = false, bool MIDHOOK = false>
DI void gemm_phase(LAS unsigned char* lds, const Gemm g, const Sched& S, const Epi& E) {
    const int tid_ = my_tid();
    const int tid = tid_, wid = __builtin_amdgcn_readfirstlane(tid >> 6), lane = tid & 63, wr = wid >> 2, wc = wid & 3, fr = lane & 15, fq = lane >> 4;
    const int K = g.K, nt = K / BK;
    unsigned voffA[2], voffB[2];
#pragma unroll
    for (int i = 0; i < 2; ++i) { int R, C; stage_rc(tid * 16 + i * 8192, R, C); const int Rb = Epi::PERM ? ((R & ~31) + perm32(R & 31)) : R;
        voffA[i] = (unsigned)(R * g.lda + C) * 2u; voffB[i] = (unsigned)(Rb * K + C) * 2u; }
    const size_t kstep = (size_t)(BK * 2);
    const size_t hstepA = (size_t)HALF * g.lda * 2, hstepB = (size_t)HALF * K * 2;
    const unsigned ldsw = (unsigned)wid * 1024u;
    const int aoff = lds_byte(wr * 64 + fr, fq * 8), boff = lds_byte(wc * 32 + fr, fq * 8);
#define PG8_SA(b, h) (((b) * 2 + (h)) * HTB)
#define PG8_SB(b, h) ((4 + (b) * 2 + (h)) * HTB)
#define PG8_STAGE(bufoff, gbase, voff) do { _Pragma("unroll") for (int _i = 0; _i < 2; ++_i) \
        __builtin_amdgcn_global_load_lds((const unsigned*)((const char*)(gbase) + (voff)[_i]), (LAS unsigned*)(lds + (bufoff) + ldsw + _i * 8192), 16, 0, 0); } while (0)
#define PG8_LD8(p) __builtin_shufflevector(*(const LAS v4i32*)(p), *(const LAS v4i32*)((p) + 1024), 0, 1, 2, 3, 4, 5, 6, 7)
#define PG8_LDA(dst, b, h) do { if constexpr (F8) { _Pragma("unroll") for (int m = 0; m < 4; ++m) dst##8[m] = PG8_LD8(lds + PG8_SA(b, h) + aoff + m * 2048); } \
        else { _Pragma("unroll") for (int m = 0; m < 4; ++m) _Pragma("unroll") for (int k = 0; k < 2; ++k) dst[m][k] = *(const LAS bf16x8*)(lds + PG8_SA(b, h) + aoff + m * 2048 + k * 1024); } } while (0)
#define PG8_LDB(dst, b, h) do { if constexpr (F8) { _Pragma("unroll") for (int n = 0; n < 2; ++n) dst##8[n] = PG8_LD8(lds + PG8_SB(b, h) + boff + n * 2048); } \
        else { _Pragma("unroll") for (int n = 0; n < 2; ++n) _Pragma("unroll") for (int k = 0; k < 2; ++k) dst[n][k] = *(const LAS bf16x8*)(lds + PG8_SB(b, h) + boff + n * 2048 + k * 1024); } } while (0)
#define PG8_MMA(ai, bj, At, Bt) do { __builtin_amdgcn_s_setprio(1); \
        if constexpr (F8) { _Pragma("unroll") for (int m = 0; m < 4; ++m) _Pragma("unroll") for (int n = 0; n < 2; ++n) \
            asm volatile("v_mfma_scale_f32_16x16x128_f8f6f4 %0, %1, %2, %0, %3, %3 op_sel_hi:[0,0,0]" : "+v"(acc[ai][bj][m][n]) : "v"(Bt##8[n]), "v"(At##8[m]), "v"(one8)); } \
        else { _Pragma("unroll") for (int m = 0; m < 4; ++m) _Pragma("unroll") for (int n = 0; n < 2; ++n) _Pragma("unroll") for (int k = 0; k < 2; ++k) \
            acc[ai][bj][m][n] = __builtin_amdgcn_mfma_f32_16x16x32_bf16(Bt[n][k], At[m][k], acc[ai][bj][m][n], 0, 0, 0); } \
        __builtin_amdgcn_s_setprio(0); } while (0)
#define PG8_WAIT_V(n) asm volatile("s_waitcnt vmcnt(" #n ")" ::: "memory")
#define PG8_WAIT_L(n) asm volatile("s_waitcnt lgkmcnt(" #n ")" ::: "memory")
#define PG8_BAR __builtin_amdgcn_s_barrier()
#define PG8_SCHED __builtin_amdgcn_sched_barrier(0)
    Unit cur, nxt; int ui = 0;
    if (!S.next(g, 0, cur)) return;
    f32x4 acc[2][2][4][2];
#pragma unroll
    for (int a = 0; a < 2; ++a)
#pragma unroll
        for (int b = 0; b < 2; ++b)
#pragma unroll
            for (int m = 0; m < 4; ++m)
#pragma unroll
                for (int n = 0; n < 2; ++n) acc[a][b][m][n] = (f32x4){0.f, 0.f, 0.f, 0.f};
    bf16x8 At[4][2], B0[2][2], B1[2][2]; v8i32 At8[4], B08[2], B18[2]; const int one8 = 0x7F7F7F7F;
    const char* cA = cur.a; const char* cB = cur.b;
    PG8_STAGE(PG8_SB(0, 0), cB, voffB); PG8_STAGE(PG8_SB(0, 1), cB + hstepB, voffB); PG8_STAGE(PG8_SA(0, 0), cA, voffA); PG8_STAGE(PG8_SA(0, 1), cA + hstepA, voffA);
    if (wr == 1) PG8_BAR;
    PG8_WAIT_V(2); PG8_BAR;
    PG8_STAGE(PG8_SB(1, 0), cB + kstep, voffB); PG8_STAGE(PG8_SA(1, 0), cA + kstep, voffA); PG8_STAGE(PG8_SB(1, 1), cB + hstepB + kstep, voffB);
    PG8_WAIT_V(6); PG8_BAR;
    for (;;) {
        const bool has_next = S.next(g, ui + 1, nxt);
        const char* nA = has_next ? nxt.a : cA; const char* nB = has_next ? nxt.b : cB;
        for (int t = 0; t < nt; t += 2) {
            const bool last = (t == nt - 2);
            if constexpr (MIDHOOK) { PG8_SCHED; if (t == nt / 2) E.mid(acc, cur, wr, wc, fr, fq); PG8_SCHED; }
            const char* a1 = cA + (size_t)(t + 1) * kstep;
            const char* a2 = last ? nA : cA + (size_t)(t + 2) * kstep; const char* b2 = last ? nB : cB + (size_t)(t + 2) * kstep;
            const char* a3 = a2 + kstep; const char* b3 = b2 + kstep;
            PG8_LDB(B0, 0, 0); PG8_LDB(B1, 0, 1); PG8_SCHED; PG8_LDA(At, 0, 0); PG8_STAGE(PG8_SA(1, 1), a1 + hstepA, voffA);
            PG8_WAIT_V(8); PG8_WAIT_L(0); PG8_BAR; PG8_MMA(0, 0, At, B0); PG8_MMA(0, 1, At, B1); PG8_BAR; PG8_SCHED;
            PG8_LDA(At, 0, 1); PG8_STAGE(PG8_SB(0, 0), b2, voffB); PG8_STAGE(PG8_SB(0, 1), b2 + hstepB, voffB); PG8_STAGE(PG8_SA(0, 0), a2, voffA);
            PG8_WAIT_V(8); PG8_WAIT_L(0); PG8_BAR; PG8_MMA(1, 0, At, B0); PG8_MMA(1, 1, At, B1); PG8_BAR; PG8_SCHED;
            PG8_LDB(B0, 1, 0); PG8_LDB(B1, 1, 1); PG8_SCHED; PG8_LDA(At, 1, 0); PG8_STAGE(PG8_SA(0, 1), a2 + hstepA, voffA);
            PG8_WAIT_V(8); PG8_WAIT_L(0); PG8_BAR; PG8_MMA(0, 0, At, B0); PG8_MMA(0, 1, At, B1); PG8_BAR; PG8_SCHED;
            PG8_LDA(At, 1, 1); PG8_STAGE(PG8_SB(1, 0), b3, voffB); PG8_STAGE(PG8_SB(1, 1), b3 + hstepB, voffB); PG8_STAGE(PG8_SA(1, 0), a3, voffA);
            PG8_WAIT_V(8); PG8_WAIT_L(0); PG8_BAR; PG8_MMA(1, 0, At, B0); PG8_MMA(1, 1, At, B1); PG8_BAR; PG8_SCHED;
        }
        if constexpr (ALIGN_EPI) { if (wr == 0) PG8_BAR; }
        if constexpr (F8) asm volatile("s_nop 15\n\ts_nop 15" ::: "memory");
        E(acc, cur, wr, wc, fr, fq);
        if (!has_next) break;
#pragma unroll
        for (int a = 0; a < 2; ++a)
#pragma unroll
            for (int b = 0; b < 2; ++b)
#pragma unroll
                for (int m = 0; m < 4; ++m)
#pragma unroll
                    for (int n = 0; n < 2; ++n) acc[a][b][m][n] = (f32x4){0.f, 0.f, 0.f, 0.f};
        cur = nxt; cA = nA; cB = nB; ++ui;
        if constexpr (ALIGN_EPI) { if (wr == 1) PG8_BAR; }
    }
    PG8_WAIT_V(0);
    if constexpr (!ALIGN_EPI) { if (wr == 0) PG8_BAR; }
    PG8_BAR;
#undef PG8_SA
#undef PG8_SB
#undef PG8_STAGE
#undef PG8_LDA
#undef PG8_LD8
#undef PG8_LDB
#undef PG8_MMA
#undef PG8_WAIT_V
#undef PG8_WAIT_L
#undef PG8_BAR
#undef PG8_SCHED
}
}
using pg8::Unit; using pg8::Gemm;
typedef const f32x4 (&AccRef)[2][2][4][2];

DI u32x4 pack8(const f32x4& v0, const f32x4& v1) { u32x4 w; w.x = cvt_pk_bf16(v0[0], v0[1]); w.y = cvt_pk_bf16(v0[2], v0[3]); w.z = cvt_pk_bf16(v1[0], v1[1]); w.w = cvt_pk_bf16(v1[2], v1[3]); return w; }
DI void unpack8(const u32x4& w, float (&f)[8]) { f[0] = bflo(w.x); f[1] = bfhi(w.x); f[2] = bflo(w.y); f[3] = bfhi(w.y); f[4] = bflo(w.z); f[5] = bfhi(w.z); f[6] = bflo(w.w); f[7] = bfhi(w.w); }

struct EpiInProj {
    static constexpr bool PERM = true;
    bf16_t* P; const float2* rope; const float* lbf; const float* lbb; int secmap; float asc;
    template <int MODE> DI void run(AccRef acc, const Unit& u, int wr, int wc, int fr, int fq, int sec) const {
        const int row0 = u.pm * 256 + wr * 64 + fr, col0 = sec * 512 + (u.pn & 1) * 256 + wc * 32 + 8 * fq;
        const bool lat = u.pm < (NLAT / 256); const float qs = sec == 0 ? QSCALE : 1.f;
        f32x4 lb0[2], lb1[2];
        if (MODE == 2) {
#pragma unroll
            for (int bj = 0; bj < 2; ++bj) { const float* lb = (sec == 1 ? lbf : lbb) + ((col0 + bj * 128) & 511); lb0[bj] = *(const f32x4*)lb; lb1[bj] = *(const f32x4*)(lb + 4); } }
#pragma unroll
        for (int ai = 0; ai < 2; ++ai)
#pragma unroll
            for (int m = 0; m < 4; ++m) {
                const int row = row0 + ai * 128 + m * 16; bf16_t* rowp = P + (size_t)row * PW + col0;
#pragma unroll
                for (int bj = 0; bj < 2; ++bj) {
                    f32x4 v0 = acc[ai][bj][m][0] * asc, v1 = acc[ai][bj][m][1] * asc; u32x4 w;
                    if (MODE == 3) {
                        if (lat) {
                            const int pi = ((col0 + bj * 128) & 63) >> 1;
                            const f32x4* rp = (const f32x4*)(rope + (size_t)(row & (T - 1)) * 32 + pi);
                            const f32x4 r0 = rp[0], r1 = rp[1];
                            f32x4 o0, o1;
                            o0[0] = v0[0] * r0[0] - v0[1] * r0[1]; o0[1] = v0[0] * r0[1] + v0[1] * r0[0];
                            o0[2] = v0[2] * r0[2] - v0[3] * r0[3]; o0[3] = v0[2] * r0[3] + v0[3] * r0[2];
                            o1[0] = v1[0] * r1[0] - v1[1] * r1[1]; o1[1] = v1[0] * r1[1] + v1[1] * r1[0];
                            o1[2] = v1[2] * r1[2] - v1[3] * r1[3]; o1[3] = v1[2] * r1[3] + v1[3] * r1[2];
                            v0 = o0; v1 = o1;
                        }
                        w = pack8(v0 * qs, v1 * qs);
                    } else if (MODE == 1) {
#pragma unroll
                        for (int j = 0; j < 4; ++j) { v0[j] = fsilu(v0[j]); v1[j] = fsilu(v1[j]); }
                        w = pack8(v0, v1);
                    } else if (MODE == 2) {
                        half8 hv;
#pragma unroll
                        for (int j = 0; j < 8; ++j) {
                            const float z = fmaxf(j < 4 ? v0[j] : v1[j - 4], -80.f), b = j < 4 ? lb0[bj][j] : lb1[bj][j - 4];
                            const float sg = __builtin_amdgcn_rcpf(1.f + __builtin_amdgcn_exp2f(-LOG2E * z));
                            hv[j] = (_Float16)(0.6931471805599453f * __builtin_amdgcn_logf(b + (1.f - b) * sg));
                        }
                        w = __builtin_bit_cast(u32x4, hv);
                    } else w = pack8(v0, v1);
                    *(u32x4*)(rowp + bj * 128) = w;
                }
            }
    }
    DI void operator()(AccRef acc, const Unit& u, int wr, int wc, int fr, int fq) const {
        const int sec = (secmap >> (4 * (u.pn >> 1))) & 15;
        if (sec == 0 || sec == 4) run<3>(acc, u, wr, wc, fr, fq, sec);
        else if (sec == 2 || sec == 6) run<1>(acc, u, wr, wc, fr, fq, sec);
        else if (sec == 1 || sec == 3) run<2>(acc, u, wr, wc, fr, fq, sec);
        else run<0>(acc, u, wr, wc, fr, fq, sec);
    }
};
struct EpiGates {
    static constexpr bool PERM = true; bf16_t* P; float asc;
    DI void operator()(AccRef acc, const Unit& u, int wr, int wc, int fr, int fq) const {
        const int row0 = u.pm * 256 + wr * 64 + fr, col0 = PC_GA + u.pn * 256 + wc * 32 + 8 * fq;
#pragma unroll
        for (int ai = 0; ai < 2; ++ai)
#pragma unroll
            for (int m = 0; m < 4; ++m) { bf16_t* rowp = P + (size_t)(row0 + ai * 128 + m * 16) * PW + col0;
#pragma unroll
                for (int bj = 0; bj < 2; ++bj) { f32x4 v0 = acc[ai][bj][m][0] * asc, v1 = acc[ai][bj][m][1] * asc;
#pragma unroll
                    for (int j = 0; j < 4; ++j) { v0[j] = fsigmoid(v0[j]); v1[j] = fsigmoid(v1[j]); }
                    *(u32x4*)(rowp + bj * 128) = pack8(v0, v1); } }
    }
};
struct EpiMergeFused {
    static constexpr bool PERM = true; const bf16_t* P; bf16_t* O;
    DI void mid(f32x4 (&acc)[2][2][4][2], const Unit& u, int wr, int wc, int fr, int fq) const {
        int row0 = u.pm * 256 + wr * 64 + fr, col0 = u.pn * 256 + wc * 32 + 8 * fq;
        asm volatile("" : "+v"(row0), "+v"(col0));
#pragma unroll
        for (int ai = 0; ai < 2; ++ai)
#pragma unroll
            for (int m = 0; m < 4; ++m) { const size_t row = (size_t)(row0 + ai * 128 + m * 16);
#pragma unroll
                for (int bj = 0; bj < 2; ++bj) {
                    float ga[8], gr[8]; unpack8(*(const u32x4*)(P + row * PW + PC_GA + col0 + bj * 128), ga); unpack8(*(const u32x4*)(P + row * PW + PC_GR + col0 + bj * 128), gr);
#pragma unroll
                    for (int j = 0; j < 4; ++j) { acc[ai][bj][m][0][j] *= ga[j] * __builtin_amdgcn_rcpf(fmaxf(gr[j], 1e-30f)); acc[ai][bj][m][1][j] *= ga[4 + j] * __builtin_amdgcn_rcpf(fmaxf(gr[4 + j], 1e-30f)); } }
                asm volatile("" ::: "memory"); }
    }
    DI void operator()(AccRef acc, const Unit& u, int wr, int wc, int fr, int fq) const {
        const int row0 = u.pm * 256 + wr * 64 + fr, col0 = u.pn * 256 + wc * 32 + 8 * fq;
#pragma unroll
        for (int ai = 0; ai < 2; ++ai)
#pragma unroll
            for (int m = 0; m < 4; ++m) { const size_t row = (size_t)(row0 + ai * 128 + m * 16);
#pragma unroll
                for (int bj = 0; bj < 2; ++bj) {
                    float gr[8]; unpack8(*(const u32x4*)(P + row * PW + PC_GR + col0 + bj * 128), gr);
                    f32x4 v0 = acc[ai][bj][m][0], v1 = acc[ai][bj][m][1];
#pragma unroll
                    for (int j = 0; j < 4; ++j) { v0[j] *= fmaxf(gr[j], 1e-30f); v1[j] *= fmaxf(gr[4 + j], 1e-30f); }
                    *(u32x4*)(O + row * D + col0 + bj * 128) = pack8(v0, v1); } }
    }
};
struct EpiResid {
    static constexpr bool PERM = false;
    const float* xin_l; const float* xin_c; float* xout_l; float* xout_c; const float* mods; int msel;
    DI void operator()(AccRef acc, const Unit& u, int wr, int wc, int fr, int fq) const {
        const bool lat = u.pm < (NLAT / 256);
        const int rbase = (lat ? u.pm : u.pm - NLAT / 256) * 256 + wr * 64 + fr, col0 = u.pn * 256 + wc * 32 + 4 * fq;
        const float* xi = lat ? xin_l : xin_c; float* xo = lat ? xout_l : xout_c;
        const float* mv = mods + (size_t)(lat ? (u.pm >> 3) : 32) * DIN + msel * D + col0;
        f32x4 g[2][2];
#pragma unroll
        for (int bj = 0; bj < 2; ++bj)
#pragma unroll
            for (int n = 0; n < 2; ++n) g[bj][n] = *(const f32x4*)(mv + bj * 128 + n * 16);
#pragma unroll
        for (int ai = 0; ai < 2; ++ai)
#pragma unroll
            for (int m = 0; m < 4; ++m) { const size_t off = (size_t)(rbase + ai * 128 + m * 16) * D + col0;
#pragma unroll
                for (int bj = 0; bj < 2; ++bj)
#pragma unroll
                    for (int n = 0; n < 2; ++n) { const f32x4 xv = *(const f32x4*)(xi + off + bj * 128 + n * 16);
                        *(f32x4*)(xo + off + bj * 128 + n * 16) = xv + g[bj][n] * acc[ai][bj][m][n]; } }
    }
};
struct EpiSwiglu {
    static constexpr bool PERM = true; bf16_t* Hd; int ldh; int pan0;
    DI void operator()(AccRef acc, const Unit& u, int wr, int wc, int fr, int fq) const {
        const int row0 = (u.pm - pan0) * 256 + wr * 64 + fr, hc0 = u.pn * 128 + wc * 16 + 4 * fq;
#pragma unroll
        for (int ai = 0; ai < 2; ++ai)
#pragma unroll
            for (int m = 0; m < 4; ++m) { bf16_t* rowp = Hd + (size_t)(row0 + ai * 128 + m * 16) * ldh + hc0;
#pragma unroll
                for (int bj = 0; bj < 2; ++bj) { const f32x4 a = acc[ai][bj][m][0], b = acc[ai][bj][m][1];
                    u32x2 w; w.x = cvt_pk_bf16(fsilu(a[0]) * b[0], fsilu(a[1]) * b[1]); w.y = cvt_pk_bf16(fsilu(a[2]) * b[2], fsilu(a[3]) * b[3]);
                    *(u32x2*)(rowp + bj * 64) = w; } }
    }
};
struct EpiSwiglu8 {
    static constexpr bool PERM = true; unsigned char* Hd; int ldh; int pan0; float as, hs;
    DI void operator()(AccRef acc, const Unit& u, int wr, int wc, int fr, int fq) const {
        const int row0 = (u.pm - pan0) * 256 + wr * 64 + fr, hc0 = u.pn * 128 + wc * 16 + 4 * fq;
#pragma unroll
        for (int ai = 0; ai < 2; ++ai)
#pragma unroll
            for (int m = 0; m < 4; ++m) { unsigned char* rowp = Hd + (size_t)(row0 + ai * 128 + m * 16) * ldh + hc0;
#pragma unroll
                for (int bj = 0; bj < 2; ++bj) { const f32x4 a = acc[ai][bj][m][0] * as, b = acc[ai][bj][m][1] * (as * hs);
                    *(unsigned*)(rowp + bj * 64) = pack_fp8x4(fsilu(a[0]) * b[0], fsilu(a[1]) * b[1], fsilu(a[2]) * b[2], fsilu(a[3]) * b[3]); } }
    }
};
struct EpiBf16 {
    static constexpr bool PERM = true; bf16_t* O; int ldc; float sc;
    DI void operator()(AccRef acc, const Unit& u, int wr, int wc, int fr, int fq) const {
        const int row0 = u.pm * 256 + wr * 64 + fr, col0 = u.pn * 256 + wc * 32 + 8 * fq;
#pragma unroll
        for (int ai = 0; ai < 2; ++ai)
#pragma unroll
            for (int m = 0; m < 4; ++m) { bf16_t* rowp = O + (size_t)(row0 + ai * 128 + m * 16) * ldc + col0;
#pragma unroll
                for (int bj = 0; bj < 2; ++bj) *(u32x4*)(rowp + bj * 128) = pack8(acc[ai][bj][m][0] * sc, acc[ai][bj][m][1] * sc); }
    }
};

typedef short v4i16 __attribute__((ext_vector_type(4)));
DI s16x4 tr16(const LAS unsigned char* p) { return __builtin_bit_cast(s16x4, __builtin_amdgcn_ds_read_tr16_b64_v4i16((LAS v4i16*)p)); }
DI bf16x8 cat8(s16x4 lo, s16x4 hi) { return __builtin_shufflevector(lo, hi, 0, 1, 2, 3, 4, 5, 6, 7); }
DI void dma16(const void* g, LAS unsigned char* l) { __builtin_amdgcn_global_load_lds((const unsigned*)g, (LAS unsigned*)l, 16, 0, 0); }
DI bf16x8 packf8(const f32x16& x, int s) {
    u32x4 w; w.x = cvt_pk_bf16(x[8 * s], x[8 * s + 1]); w.y = cvt_pk_bf16(x[8 * s + 2], x[8 * s + 3]); w.z = cvt_pk_bf16(x[8 * s + 4], x[8 * s + 5]); w.w = cvt_pk_bf16(x[8 * s + 6], x[8 * s + 7]);
    return __builtin_bit_cast(bf16x8, w);
}
#define MFMA32(a, b, c) __builtin_amdgcn_mfma_f32_32x32x16_bf16((a), (b), (c), 0, 0, 0)

struct Params { const float* in[28]; float* out; unsigned char* ws; int ph_lo, ph_hi, li, pad; };
typedef const __attribute__((address_space(4))) Params* KP;
DI KP kparams() { KP kp = (KP)__builtin_amdgcn_kernarg_segment_ptr(); asm volatile("" : "+s"(kp)); return kp; }
#define PIN(k) (kparams()->in[k])
#define POUT (kparams()->out)
struct Ctx {
    LAS unsigned char* lds; unsigned char* ws; int tid, lane, wave, vcu, G, gw, NGW, bx;
};

constexpr float WIN8_SCALE = 64.f;
#ifndef FP8_SECS
#define FP8_SECS 0x00
#endif
constexpr int SEC_ORDER[8] = {0, 1, 3, 4, 2, 5, 6, 7};
constexpr int sec_slot(int ps) { int nb = 0, nf = 0; for (int i = 0; i < 8; ++i) { const int s_ = SEC_ORDER[i]; const bool f = (FP8_SECS >> s_) & 1; if (s_ == ps) return f ? (0x100 | nf) : nb; if (f) ++nf; else ++nb; } return 0; }
constexpr int N_SEC_F8 = __builtin_popcount(FP8_SECS), N_SEC_BF = 8 - N_SEC_F8;
constexpr unsigned secmap_of(bool f8) { unsigned m = 0; int k = 0; for (int i = 0; i < 8; ++i) { const int s_ = SEC_ORDER[i]; if ((((FP8_SECS >> s_) & 1) != 0) == f8) { m |= (unsigned)s_ << (4 * k); ++k; } } return m; }
DI int map_row(int kind, int n);
DI int map_row4(int n) { return map_row(1, n) & 0xffff; }
DI int map_row(int kind, int n) {
    if (kind == 0) return n;
    if (kind == 4) return map_row4(n);
    if (kind == 2) return 8 * (n >> 2) + (n & 3);
    if (kind == 3) return 8 * (n >> 2) + (n & 3) + 4;
    const int sec = n >> 9, j = n & 511;
    if (n >= 4096) return (1 << 16) | (N_SEC_F8 * 512 + (n - 4096));
    const int ps = sec == 0 ? 0 : sec == 1 ? 4 : sec == 2 ? 5 : sec == 3 ? 6 : sec == 4 ? 7 : sec == 5 ? 1 : sec == 6 ? 3 : 2;
    const int sl = sec_slot(ps); int jj = j;
    if (sec == 0 || sec == 1) { const int hs = j >> 6, d = j & 63; jj = hs * 64 + (d < 32 ? 2 * d : 2 * (d - 32) + 1); }
    return ((sl & 0x100) ? (1 << 16) : 0) | ((sl & 0xff) * 512 + jj);
}
constexpr int TP_PITCH = 68, TP_SCR = 64 * TP_PITCH * 4;
DI void transpose_load(const float* W, int ldw, int k0, int n0, LAS float* scr, int lane) {
    const int r = lane >> 4, c4 = (lane & 15) * 4; f32x4 v[16];
#pragma unroll
    for (int i = 0; i < 16; ++i) v[i] = *(const f32x4*)(W + (size_t)(k0 + 4 * i + r) * ldw + n0 + c4);
#pragma unroll
    for (int i = 0; i < 16; ++i) *(LAS f32x4*)(scr + (4 * i + r) * TP_PITCH + c4) = v[i];
    LDS_WAIT(); asm volatile("" ::: "memory");
}
DI void transpose_item(const float* W, int ldw, int k0, int n0, bf16_t* WT, int ldt, int kind, LAS float* scr, int lane) {
    transpose_load(W, ldw, k0, n0, scr, lane);
    bf16_t* dst = WT + (size_t)map_row(kind, n0 + lane) * ldt + k0;
#pragma unroll
    for (int j = 0; j < 8; ++j) { const LAS float* s = scr + (8 * j) * TP_PITCH + lane;
        u32x4 o; o.x = cvt_pk_bf16(s[0], s[TP_PITCH]); o.y = cvt_pk_bf16(s[2 * TP_PITCH], s[3 * TP_PITCH]); o.z = cvt_pk_bf16(s[4 * TP_PITCH], s[5 * TP_PITCH]); o.w = cvt_pk_bf16(s[6 * TP_PITCH], s[7 * TP_PITCH]);
        *(u32x4*)(dst + 8 * j) = o; }
    LDS_WAIT(); asm volatile("" ::: "memory");
}
DI void transpose_item8(const float* W, int ldw, int k0, int n0, unsigned char* WT, int ldt, int kind, float sc, LAS float* scr, int lane) {
    transpose_load(W, ldw, k0, n0, scr, lane);
    unsigned char* dst = WT + (size_t)map_row(kind, n0 + lane) * ldt + k0;
#pragma unroll
    for (int j = 0; j < 4; ++j) { const LAS float* s = scr + (16 * j) * TP_PITCH + lane; u32x4 o;
        o.x = pack_fp8x4(s[0] * sc, s[TP_PITCH] * sc, s[2 * TP_PITCH] * sc, s[3 * TP_PITCH] * sc); o.y = pack_fp8x4(s[4 * TP_PITCH] * sc, s[5 * TP_PITCH] * sc, s[6 * TP_PITCH] * sc, s[7 * TP_PITCH] * sc);
        o.z = pack_fp8x4(s[8 * TP_PITCH] * sc, s[9 * TP_PITCH] * sc, s[10 * TP_PITCH] * sc, s[11 * TP_PITCH] * sc); o.w = pack_fp8x4(s[12 * TP_PITCH] * sc, s[13 * TP_PITCH] * sc, s[14 * TP_PITCH] * sc, s[15 * TP_PITCH] * sc);
        *(u32x4*)(dst + 16 * j) = o; }
    LDS_WAIT(); asm volatile("" ::: "memory");
}
DI void transpose_matrix8(const Ctx& C, const float* W, int K, int N, unsigned char* WT, int ldt, int kind, float sc, int& itbase) {
    LAS float* scr = (LAS float*)(C.lds + C.wave * TP_SCR);
    const int nblk = N / 64, nit = (K / 64) * nblk;
    int first = (C.gw - (itbase % C.NGW) + C.NGW) % C.NGW;
    for (int it = first; it < nit; it += C.NGW) transpose_item8(W, N, 64 * (it / nblk), 64 * (it % nblk), WT, ldt, kind, sc, scr, C.lane);
    itbase += nit;
}
DI void transpose_matrix(const Ctx& C, const float* W, int K, int N, bf16_t* WT, int ldt, int kind, int& itbase, int total_unused) {
    (void)total_unused;
    LAS float* scr = (LAS float*)(C.lds + C.wave * TP_SCR);
    const int nblk = N / 64, nit = (K / 64) * nblk;
    int first = (C.gw - (itbase % C.NGW) + C.NGW) % C.NGW;
    for (int it = first; it < nit; it += C.NGW) transpose_item(W, N, 64 * (it / nblk), 64 * (it % nblk), WT, ldt, kind, scr, C.lane);
    itbase += nit;
}
DI void transpose_win(const Ctx& C, const float* W, bf16_t* WA, unsigned char* W8, int& itbase) {
    LAS float* scr = (LAS float*)(C.lds + C.wave * TP_SCR);
    const int nblk = DIN / 64, nit = (D / 64) * nblk;
    int first = (C.gw - (itbase % C.NGW) + C.NGW) % C.NGW;
    for (int it = first; it < nit; it += C.NGW) { const int k0 = 64 * (it / nblk), n0 = 64 * (it % nblk);
        if (map_row(1, n0) >> 16) transpose_item8(W, DIN, k0, n0, W8, D, 4, WIN8_SCALE, scr, C.lane);
        else transpose_item(W, DIN, k0, n0, WA, D, 1, scr, C.lane); }
    itbase += nit;
}
DI void phase_prologue(const Ctx& C) {
    unsigned char* ws = C.ws;
    int itb = 0;
    for (int l = 0; l < 2; ++l) {
        transpose_win(C, PIN(8) + (size_t)l * D * DIN, (bf16_t*)(ws + WS_WIN) + (size_t)l * 4096 * D, ws + WS_WIN8 + (size_t)l * 4096 * D, itb);
        transpose_matrix(C, PIN(17) + (size_t)l * 512 * D, 512, D, (bf16_t*)(ws + WS_WUA) + (size_t)l * D * D, D, 0, itb, 0);
        transpose_matrix(C, PIN(18) + (size_t)l * 512 * D, 512, D, (bf16_t*)(ws + WS_WUA) + (size_t)l * D * D + 512, D, 0, itb, 0);
        transpose_matrix(C, PIN(19) + (size_t)l * D * D, D, D, (bf16_t*)(ws + WS_WO) + (size_t)l * D * D, D, 0, itb, 0);
    }
    transpose_matrix(C, PIN(20), D, DFF, (bf16_t*)(ws + WS_W13), D, 2, itb, 0);
    transpose_matrix(C, PIN(21), D, DFF, (bf16_t*)(ws + WS_W13), D, 3, itb, 0);
    transpose_matrix(C, PIN(22), DFF, D, (bf16_t*)(ws + WS_W2), DFFP, 0, itb, 0);
    { const int gt = C.vcu * 512 + C.tid, NT = C.G * 512;
      bf16_t* w13 = (bf16_t*)(ws + WS_W13) + (size_t)(2 * DFF) * D;
      for (int i = gt; i < (2 * DFFP - 2 * DFF) * D / 8; i += NT) ((u32x4*)w13)[i] = (u32x4){0u, 0u, 0u, 0u};
      bf16_t* w2 = (bf16_t*)(ws + WS_W2);
      for (int i = gt; i < D * (DFFP - DFF) / 8; i += NT) { const int r = i / ((DFFP - DFF) / 8), cc = i % ((DFFP - DFF) / 8); *(u32x4*)(w2 + (size_t)r * DFFP + DFF + cc * 8) = (u32x4){0u, 0u, 0u, 0u}; }
      float2* rope = (float2*)(ws + WS_ROPE);
      for (int i = gt; i < T * 32; i += NT) { const int t = i >> 5, pi = i & 31; const float invf = exp2f(-(float)(pi & 15) * (13.287712379549449f / 16.f));
          const float ang = (float)(pi < 16 ? (t >> 6) : (t & 63)) * invf; rope[i] = make_float2(cosf(ang), sinf(ang)); }
      float* lbs = (float*)(ws + WS_LBS);
      for (int i = gt; i < 2 * 2 * 512; i += NT) { const int l = i >> 10, dir = (i >> 9) & 1, d = i & 511; const float* lb = PIN(dir ? 16 : 15);
          const float p0 = lb[d], p1 = lb[512 + d]; lbs[i] = l == 0 ? 0.f : 1.f / (1.f + expf(p0 - p1)); }
    }
    { float* mods = (float*)(ws + WS_MODS);
      for (int task = C.gw; task < 2 * 33 * 96; task += C.NGW) {
          const int ng = task % 96, r = (task / 96) % 33, l = task / (96 * 33), n = ng * 64 + C.lane;
          const float* cv = r < 32 ? PIN(1) + r * D : PIN(3); const float* W = PIN(4) + (size_t)l * D * DIN + n;
          float acc = PIN(5)[l * DIN + n];
          for (int k0 = 0; k0 < D; k0 += 64) { const float sv = fsilu(cv[k0 + C.lane]);
#pragma unroll 16
              for (int j = 0; j < 64; ++j) acc += __uint_as_float(__builtin_amdgcn_readlane(__float_as_uint(sv), j)) * W[(size_t)(k0 + j) * DIN]; }
          mods[(size_t)(l * 33 + r) * DIN + n] = acc; } }
}
constexpr float W13_SCALE = 64.f, W2_SCALE = 128.f, HID_SCALE = 8.f;
DI void convert_moe_weights(const Ctx& C) {
    unsigned char* ws = C.ws; int itb = 0;
    for (int e = 0; e < NE; ++e) {
        transpose_matrix8(C, PIN(24) + (size_t)e * D * DFE, D, DFE, ws + WS_WM13 + (size_t)e * 2 * DFE * D, D, 2, W13_SCALE, itb);
        transpose_matrix8(C, PIN(25) + (size_t)e * D * DFE, D, DFE, ws + WS_WM13 + (size_t)e * 2 * DFE * D, D, 3, W13_SCALE, itb);
        transpose_matrix8(C, PIN(26) + (size_t)e * DFE * D, DFE, D, ws + WS_WM2 + (size_t)e * D * DFE, DFE, 0, W2_SCALE, itb);
    }
}

template <bool ROUTER>
DI void phase_norm(const Ctx& C, const float* xl, const float* xc, const float* nw, const float* mods, int shsel, int nrows, bf16_t* Hout, const float* rw, unsigned char* route, LAS int* cntL, unsigned char* H8 = nullptr) {
    int nloc = 0;
    f32x4 rwr[4][4][2];
    if (ROUTER) {
#pragma unroll
        for (int j = 0; j < 4; ++j)
#pragma unroll
            for (int q = 0; q < 4; ++q) { const float* rp = rw + (size_t)(256 * j + 4 * C.lane + q) * 8; rwr[j][q][0] = *(const f32x4*)rp; rwr[j][q][1] = *(const f32x4*)(rp + 4); } }
    for (int row0 = C.gw; row0 < nrows; row0 += 2 * C.NGW) {
        const int rows[2] = {row0, row0 + C.NGW}; const bool two = rows[1] < nrows;
        f32x4 v[2][4]; float ss[2] = {0.f, 0.f};
#pragma unroll
        for (int u = 0; u < 2; ++u) { const int row = (u == 1 && !two) ? rows[0] : rows[u]; const float* xr = row < NLAT ? xl + (size_t)row * D : xc + (size_t)(row - NLAT) * D;
#pragma unroll
            for (int j = 0; j < 4; ++j) { v[u][j] = *(const f32x4*)(xr + 256 * j + 4 * C.lane); ss[u] += (v[u][j][0] * v[u][j][0] + v[u][j][1] * v[u][j][1]) + (v[u][j][2] * v[u][j][2] + v[u][j][3] * v[u][j][3]); } }
#pragma unroll
        for (int u = 0; u < 2; ++u) { if (u == 1 && !two) break;
            const int row = rows[u]; const bool lat = row < NLAT;
            const float* mv = mods + (size_t)(lat ? (row >> 11) : 32) * DIN + shsel * D;
            const float rstd = 1.0f / sqrtf(wave_sum(ss[u]) * (1.f / D) + EPS);
            float lg[8];
            if (ROUTER) {
#pragma unroll
                for (int e = 0; e < 8; ++e) lg[e] = 0.f; }
#pragma unroll
            for (int j = 0; j < 4; ++j) { const int c0 = 256 * j + 4 * C.lane;
                const f32x4 w = *(const f32x4*)(nw + c0), sh = *(const f32x4*)(mv + c0), sc = *(const f32x4*)(mv + D + c0);
                f32x4 h = (v[u][j] * rstd) * w * (sc + 1.0f) + sh;
                if (ROUTER) *(unsigned*)((unsigned char*)Hout + (size_t)row * D + c0) = pack_fp8x4(h[0], h[1], h[2], h[3]);
                else { u32x2 o; o.x = cvt_pk_bf16(h[0], h[1]); o.y = cvt_pk_bf16(h[2], h[3]); *(u32x2*)(Hout + (size_t)row * D + c0) = o;
                       if (H8) *(unsigned*)(H8 + (size_t)row * D + c0) = pack_fp8x4(h[0], h[1], h[2], h[3]); }
                if (ROUTER) {
#pragma unroll
                    for (int q = 0; q < 4; ++q) { const f32x4 r0 = rwr[j][q][0], r1 = rwr[j][q][1];
                        lg[0] += h[q] * r0[0]; lg[1] += h[q] * r0[1]; lg[2] += h[q] * r0[2]; lg[3] += h[q] * r0[3]; lg[4] += h[q] * r1[0]; lg[5] += h[q] * r1[1]; lg[6] += h[q] * r1[2]; lg[7] += h[q] * r1[3]; } }
            }
            if (ROUTER) {
                const bool b5 = (C.lane & 32) != 0, b4 = (C.lane & 16) != 0, b3 = (C.lane & 8) != 0; float a4[4], a2[2], a1;
#pragma unroll
                for (int j = 0; j < 4; ++j) { const float snd = b5 ? lg[j] : lg[4 + j]; a4[j] = (b5 ? lg[4 + j] : lg[j]) + __shfl_xor(snd, 32); }
#pragma unroll
                for (int j = 0; j < 2; ++j) { const float snd = b4 ? a4[j] : a4[2 + j]; a2[j] = (b4 ? a4[2 + j] : a4[j]) + __shfl_xor(snd, 16); }
                { const float snd = b3 ? a2[0] : a2[1]; a1 = (b3 ? a2[1] : a2[0]) + __shfl_xor(snd, 8); }
                a1 += __shfl_xor(a1, 4); a1 += __shfl_xor(a1, 2); a1 += __shfl_xor(a1, 1);
                if ((C.lane & 7) == 0) ((LAS float*)(C.lds + C.wave * 4096))[nloc * 8 + (C.lane >> 3)] = a1;
                ++nloc;
            }
        }
    }
    if (ROUTER) {
        LDS_WAIT();
        for (int i = C.lane; i < nloc; i += 64) { const int row = C.gw + i * C.NGW; const LAS float* lp = (const LAS float*)(C.lds + C.wave * 4096) + i * 8;
            float lg[8];
#pragma unroll
            for (int e = 0; e < 8; ++e) lg[e] = lp[e];
            int e1 = 0; float l1 = lg[0];
#pragma unroll
            for (int e = 1; e < 8; ++e) if (lg[e] > l1) { l1 = lg[e]; e1 = e; }
            int e2 = -1; float l2 = -INFINITY;
#pragma unroll
            for (int e = 0; e < 8; ++e) if (e != e1 && lg[e] > l2) { l2 = lg[e]; e2 = e; }
            const float g2 = 1.f / (1.f + expf(l1 - l2)), g1 = 1.f - g2;
            int* rt = (int*)(route + (size_t)row * 24); rt[0] = e1; rt[1] = e2; ((float*)rt)[2] = g1; ((float*)rt)[3] = g2;
            atomicAdd((int*)&cntL[e1], 1); atomicAdd((int*)&cntL[e2], 1);
        }
    }
}

constexpr int AT_XCH = 65536;
DI float max3f(float a, float b, float c) { return fmaxf(fmaxf(a, b), c); }
DI float xhalf(float v, int hi) {
    const auto rr = __builtin_amdgcn_permlane32_swap(__float_as_uint(v), __float_as_uint(v), false, false);
    return __uint_as_float(hi ? rr[0] : rr[1]);
}
constexpr float AT_THR = 8.f;
DI void attn_unit(const Ctx& C, bf16_t* P, int qrow0, int krow_ctx, int krow_lat, int nkt, int h, float lam, const float* anw, float post) {
    const int tid_ = my_tid();
    LAS unsigned char* lds = C.lds; const int lane = tid_ & 63, wid = __builtin_amdgcn_readfirstlane(tid_ >> 6), sub = wid >> 2, qw = wid & 3, r32 = lane & 31, hh = lane >> 5;
    const int tq = (lane & 15) >> 2, tp = lane & 3, blk = (lane >> 4) & 1;
    LAS unsigned char* qlds = lds + AT_XCH + wid * 8192 + r32 * 16;
#pragma unroll
    for (int qb = 0; qb < 2; ++qb) { const bf16_t* qp = P + (size_t)(qrow0 + 64 * qw + 32 * qb + r32) * PW + PC_Q + h * 128 + sub * 64 + 8 * hh;
#pragma unroll
      for (int ks = 0; ks < 4; ++ks) *(LAS bf16x8*)(qlds + ((2 * ks + hh) * 64 + 32 * qb) * 16) = *(const bf16x8*)(qp + 16 * ks); }
    f32x16 O[2][4];
#pragma unroll
    for (int qb = 0; qb < 2; ++qb)
#pragma unroll
        for (int c = 0; c < 4; ++c)
#pragma unroll
            for (int i = 0; i < 16; ++i) O[qb][c][i] = 0.f;
    float m_run[2] = {-INFINITY, -INFINITY}, l_run[2] = {0.f, 0.f};
#define AT_ISSUE(kt, buf) do { const int kr0_ = (kt) < 4 ? krow_ctx + (kt) * 64 : krow_lat + ((kt) - 4) * 64; LAS unsigned char* bb_ = lds + (buf) * 32768; \
        _Pragma("unroll") for (int j_ = 0; j_ < 2; ++j_) { const int c_ = 2 * wid + j_; \
            dma16(P + (size_t)(kr0_ + lane) * PW + PC_K + h * 128 + c_ * 8, bb_ + c_ * 1024); \
            dma16(P + (size_t)(kr0_ + 16 * (c_ & 3) + (lane >> 2)) * PW + PC_V + h * 128 + (c_ >> 2) * 32 + (lane & 3) * 8, bb_ + 16384 + c_ * 1024); } } while (0)
    AT_ISSUE(0, 0);
    int buf = 0;
#pragma unroll 1
    for (int kt = 0; kt < nkt; ++kt) {
        VM_WAIT(); __syncthreads();
        if (kt + 1 < nkt) AT_ISSUE(kt + 1, buf ^ 1);
        const LAS unsigned char* kb = lds + buf * 32768, * vb = kb + 16384 + (4 * hh + tq) * 64 + blk * 32 + tp * 8;
        bf16x8 Pf[2][4];
#pragma unroll
        for (int qb = 0; qb < 2; ++qb) {
            f32x16 s0, s1;
#pragma unroll
            for (int i = 0; i < 16; ++i) { s0[i] = 0.f; s1[i] = 0.f; }
#pragma unroll
            for (int ks = 0; ks < 4; ++ks) { const LAS unsigned char* kp = kb + ((sub * 8 + 2 * ks + hh) * 64 + r32) * 16;
                const bf16x8 k0 = *(const LAS bf16x8*)kp, k1 = *(const LAS bf16x8*)(kp + 512);
                const bf16x8 q = *(const LAS bf16x8*)(qlds + ((2 * ks + hh) * 64 + 32 * qb) * 16);
                s0 = MFMA32(k0, q, s0); s1 = MFMA32(k1, q, s1); }
            float mx = max3f(s0[0], s1[0], s0[1]);
#pragma unroll
            for (int i = 1; i < 16; ++i) mx = (i + 1 < 16) ? max3f(mx, s1[i], s0[i + 1]) : fmaxf(mx, s1[i]);
            mx = fmaxf(mx, xhalf(mx, hh));
            const float mnew = fmaxf(m_run[qb], mx);
            if (__any(mx > m_run[qb] + AT_THR)) { const float alpha = __builtin_amdgcn_exp2f(m_run[qb] - mnew); l_run[qb] *= alpha;
#pragma unroll
                for (int c = 0; c < 4; ++c)
#pragma unroll
                    for (int i = 0; i < 16; ++i) O[qb][c][i] *= alpha;
                m_run[qb] = mnew; }
            const float mr = m_run[qb]; float ps0 = 0.f, ps1 = 0.f;
#pragma unroll
            for (int i = 0; i < 16; ++i) { s0[i] = __builtin_amdgcn_exp2f(s0[i] - mr); s1[i] = __builtin_amdgcn_exp2f(s1[i] - mr); ps0 += s0[i]; ps1 += s1[i]; }
            l_run[qb] += ps0 + ps1;
            Pf[qb][0] = packf8(s0, 0); Pf[qb][1] = packf8(s0, 1); Pf[qb][2] = packf8(s1, 0); Pf[qb][3] = packf8(s1, 1);
        }
#pragma unroll
        for (int cb = 0; cb < 4; ++cb) {
#pragma unroll
            for (int s4 = 0; s4 < 4; ++s4) { const bf16x8 a = cat8(tr16(vb + cb * 4096 + s4 * 1024), tr16(vb + cb * 4096 + s4 * 1024 + 512));
                O[0][cb] = MFMA32(a, Pf[0][s4], O[0][cb]); O[1][cb] = MFMA32(a, Pf[1][s4], O[1][cb]); } }
        buf ^= 1;
    }
#undef AT_ISSUE
    LDS_WAIT(); __syncthreads();
    const int te = my_tid(); const int lane_e = te & 63, wid_e = __builtin_amdgcn_readfirstlane(te >> 6);
    LAS float* xch = (LAS float*)(lds + AT_XCH) + (wid_e & 3) * 4096 + lane_e;
#pragma unroll
    for (int qb = 0; qb < 2; ++qb) {
        const float lt = l_run[qb] + xhalf(l_run[qb], lane_e >> 5); const float inv = 1.f / lt;
        if ((wid_e >> 2) == 1) { const float sc = -lam * inv;
#pragma unroll
            for (int c = 0; c < 4; ++c)
#pragma unroll
                for (int i = 0; i < 16; ++i) xch[(c * 16 + i) * 64] = O[qb][c][i] * sc; }
        LDS_WAIT(); __syncthreads();
        if ((wid_e >> 2) == 0) {
            float ss = 0.f;
#pragma unroll
            for (int c = 0; c < 4; ++c)
#pragma unroll
                for (int i = 0; i < 16; ++i) { const float o = O[qb][c][i] * inv + xch[(c * 16 + i) * 64]; O[qb][c][i] = o; ss += o * o; }
            ss += xhalf(ss, lane_e >> 5);
            const float rs = post / sqrtf(ss * (1.f / 128.f) + EPS);
            bf16_t* op = P + (size_t)(qrow0 + 64 * (wid_e & 3) + 32 * qb + (lane_e & 31)) * PW + PC_Q + h * 128;
#pragma unroll
            for (int c = 0; c < 4; ++c)
#pragma unroll
                for (int g = 0; g < 4; ++g) { const int v0 = 32 * c + 8 * g + 4 * (lane_e >> 5); const f32x4 w = *(const f32x4*)(anw + v0);
                    u32x2 o; o.x = cvt_pk_bf16(O[qb][c][4 * g] * rs * w[0], O[qb][c][4 * g + 1] * rs * w[1]); o.y = cvt_pk_bf16(O[qb][c][4 * g + 2] * rs * w[2], O[qb][c][4 * g + 3] * rs * w[3]);
                    *(u32x2*)(op + v0) = o; }
        }
        LDS_WAIT(); __syncthreads();
    }
}

constexpr int SC_Q = 0, SC_LF = 16384, SC_V0 = 32768, SC_QM = 65536, SC_KMR = 81920, SC_KMS = 98304, SC_SX = 114688, SC_A31 = 147456, SC_A63 = 147968, SC_END = 148480;
DI void scan_chain(const Ctx& C, bf16_t* P, int b, int h, int dir, bool store_ctx) {
    const int tid_ = my_tid();
    LAS unsigned char* lds = C.lds; const int lane = tid_ & 63, wid = __builtin_amdgcn_readfirstlane(tid_ >> 6), r32 = lane & 31, hh = lane >> 5;
    const int tq = (lane & 15) >> 2, tp = lane & 3, blk = (lane >> 4) & 1;
    const int db = wid & 3, tb = wid >> 2;
    const int base_nat = hh * 512 + tq * 64 + blk * 32 + tp * 8;
    const int base_prm = (4 * hh + tq) * 64 + blk * 32 + tp * 8;
    const int lfcol = (dir ? PC_LB : PC_LF) + h * 128, qcol = PC_RQ + h * 128, vcol = PC_RI + h * 128;
    f32x16 ST[2];
#pragma unroll
    for (int j = 0; j < 2; ++j)
#pragma unroll
        for (int i = 0; i < 16; ++i) ST[j][i] = 0.f;
#define SROW(c, i) ((c) < 4 ? NLAT + b * CL + (dir ? 255 - ((c) * 64 + (i)) : (c) * 64 + (i)) : b * T + (dir ? 2047 - (((c) - 4) * 64 + (i)) : ((c) - 4) * 64 + (i)))
#define SDMA(c, colbase, dstoff) do { _Pragma("unroll") for (int j_ = 0; j_ < 2; ++j_) { const int I_ = 2 * wid + j_; const int ti_ = 16 * (I_ & 3) + (lane >> 2); \
        dma16(P + (size_t)SROW(c, ti_) * PW + (colbase) + (I_ >> 2) * 32 + (lane & 3) * 8, lds + (dstoff) + I_ * 1024); } } while (0)
    SDMA(0, qcol, SC_Q); SDMA(0, lfcol, SC_LF); SDMA(0, vcol, SC_V0);
    int vbuf = 0;
    const int t = 32 * tb + r32;
#pragma unroll 1
    for (int c = 0; c < 36; ++c) {
        VM_WAIT(); __syncthreads();
        const LAS unsigned char* Vimg = lds + SC_V0 + vbuf * 16384;
        f32x16 cm;
#pragma unroll
        for (int i = 0; i < 16; ++i) cm[i] = 0.f;
#pragma unroll
        for (int kk = 0; kk < 2; ++kk) { const int ks = 2 * tb + kk;
            const half8 a = __builtin_bit_cast(half8, cat8(tr16(lds + SC_LF + db * 4096 + base_nat + ks * 1024), tr16(lds + SC_LF + db * 4096 + base_nat + ks * 1024 + 256)));
            half8 bm;
#pragma unroll
            for (int j = 0; j < 8; ++j) { const int s = 16 * ks + 8 * hh + j; bm[j] = tb == 0 ? (s > t ? (_Float16)-1.f : (_Float16)0.f) : (s <= t ? (_Float16)1.f : (_Float16)0.f); }
            cm = __builtin_amdgcn_mfma_f32_32x32x16_f16(a, bm, cm, 0, 0, 0); }
#pragma unroll
        for (int g = 0; g < 4; ++g) {
            const int sa = db * 4096 + (t >> 3) * 512 + (t & 7) * 64 + (8 * g + 4 * hh) * 2;
            const u32x2 q4 = *(const LAS u32x2*)(lds + SC_Q + sa); const half4 lf4 = *(const LAS half4*)(lds + SC_LF + sa);
            const float qv[4] = {bflo(q4.x), bfhi(q4.x), bflo(q4.y), bfhi(q4.y)};
            float qm[4], km[4];
#pragma unroll
            for (int e = 0; e < 4; ++e) { const float cv = cm[4 * g + e] * LOG2E; const float E = __builtin_amdgcn_exp2f(cv), Ei = __builtin_amdgcn_exp2f(-cv);
                const float lf = (float)lf4[e]; qm[e] = qv[e] * E; km[e] = (1.f - __builtin_amdgcn_exp2f(lf * LOG2E)) * Ei;
                if (tb == 0 && r32 == 0) ((LAS float*)(lds + SC_A31))[32 * db + 8 * g + 4 * hh + e] = lf - cm[4 * g + e];
                if (tb == 1 && r32 == 31) ((LAS float*)(lds + SC_A63))[32 * db + 8 * g + 4 * hh + e] = cm[4 * g + e]; }
            u32x2 qw2, kw2; qw2.x = cvt_pk_bf16(qm[0], qm[1]); qw2.y = cvt_pk_bf16(qm[2], qm[3]); kw2.x = cvt_pk_bf16(km[0], km[1]); kw2.y = cvt_pk_bf16(km[2], km[3]);
            const int ra = ((4 * db + g) * 64 + t) * 16 + 8 * hh;
            *(LAS u32x2*)(lds + SC_QM + ra) = qw2; *(LAS u32x2*)(lds + SC_KMR + ra) = kw2; *(LAS u32x2*)(lds + SC_KMS + sa) = kw2;
        }
        LDS_WAIT(); __syncthreads();
        if (c + 1 < 36) { SDMA(c + 1, qcol, SC_Q); SDMA(c + 1, lfcol, SC_LF); SDMA(c + 1, vcol, SC_V0 + (vbuf ^ 1) * 16384); }
        { const int d = 32 * db + r32; const float c31 = ((LAS float*)(lds + SC_A31))[d], c63 = ((LAS float*)(lds + SC_A63))[d];
          const float e31 = __expf(c31), dec = __expf(c31 + c63), e63 = __expf(c63);
          f32x16 SN[2];
#pragma unroll
          for (int j = 0; j < 2; ++j) { const int vb2 = 2 * tb + j;
#pragma unroll
              for (int g = 0; g < 4; ++g) { u32x2 w; w.x = cvt_pk_bf16(ST[j][4 * g] * e31, ST[j][4 * g + 1] * e31); w.y = cvt_pk_bf16(ST[j][4 * g + 2] * e31, ST[j][4 * g + 3] * e31);
                  *(LAS u32x2*)(lds + SC_SX + vb2 * 8192 + (d >> 3) * 512 + (d & 7) * 64 + (8 * g + 4 * hh) * 2) = w; }
#pragma unroll
              for (int i = 0; i < 16; ++i) SN[j][i] = 0.f; }
#pragma unroll
          for (int ks = 0; ks < 4; ++ks) {
              const bf16x8 kf = cat8(tr16(lds + SC_KMS + db * 4096 + base_nat + ks * 1024), tr16(lds + SC_KMS + db * 4096 + base_nat + ks * 1024 + 256));
#pragma unroll
              for (int j = 0; j < 2; ++j) { const int vb2 = 2 * tb + j;
                  const bf16x8 vf = cat8(tr16(Vimg + vb2 * 4096 + base_nat + ks * 1024), tr16(Vimg + vb2 * 4096 + base_nat + ks * 1024 + 256));
                  SN[j] = MFMA32(vf, kf, SN[j]); } }
#pragma unroll
          for (int j = 0; j < 2; ++j)
#pragma unroll
              for (int i = 0; i < 16; ++i) ST[j][i] = dec * ST[j][i] + e63 * SN[j][i];
        }
        LDS_WAIT(); __syncthreads();
        { bf16x8 Qmf[8];
#pragma unroll
          for (int kd = 0; kd < 8; ++kd) Qmf[kd] = *(const LAS bf16x8*)(lds + SC_QM + ((2 * kd + hh) * 64 + t) * 16);
          f32x16 o;
#pragma unroll
          for (int i = 0; i < 16; ++i) o[i] = 0.f;
          for (int sb = 0; sb <= tb; ++sb) {
              f32x16 pt;
#pragma unroll
              for (int i = 0; i < 16; ++i) pt[i] = 0.f;
#pragma unroll
              for (int kd = 0; kd < 8; ++kd) { const bf16x8 a = *(const LAS bf16x8*)(lds + SC_KMR + ((2 * kd + hh) * 64 + 32 * sb + r32) * 16); pt = MFMA32(a, Qmf[kd], pt); }
              if (sb == tb) {
#pragma unroll
                  for (int i = 0; i < 16; ++i) if (crow(i, hh) > r32) pt[i] = 0.f; }
              const bf16x8 p0 = packf8(pt, 0), p1 = packf8(pt, 1);
              { const bf16x8 a = cat8(tr16(Vimg + db * 4096 + base_prm + (2 * sb) * 1024), tr16(Vimg + db * 4096 + base_prm + (2 * sb) * 1024 + 512)); o = MFMA32(a, p0, o); }
              { const bf16x8 a = cat8(tr16(Vimg + db * 4096 + base_prm + (2 * sb + 1) * 1024), tr16(Vimg + db * 4096 + base_prm + (2 * sb + 1) * 1024 + 512)); o = MFMA32(a, p1, o); }
          }
#pragma unroll
          for (int kd = 0; kd < 8; ++kd) { const bf16x8 a = cat8(tr16(lds + SC_SX + db * 8192 + base_nat + kd * 1024), tr16(lds + SC_SX + db * 8192 + base_nat + kd * 1024 + 256)); o = MFMA32(a, Qmf[kd], o); }
          if (c >= 4 || store_ctx) { bf16_t* op = P + (size_t)SROW(c, t) * PW + lfcol + 32 * db;
#pragma unroll
              for (int g = 0; g < 4; ++g) { u32x2 w; w.x = cvt_pk_bf16(o[4 * g], o[4 * g + 1]); w.y = cvt_pk_bf16(o[4 * g + 2], o[4 * g + 3]); *(u32x2*)(op + 8 * g + 4 * hh) = w; } }
        }
        vbuf ^= 1;
    }
    VM_WAIT(); LDS_WAIT(); __syncthreads();
#undef SROW
#undef SDMA
}

DI void phase_recprep(const Ctx& C, bf16_t* P, const float* rnw, int nrows) {
    for (int row = C.gw; row < nrows; row += C.NGW) {
        bf16_t* pr = P + (size_t)row * PW + 8 * C.lane;
        float a[8], bb[8], g[8]; unpack8(*(const u32x4*)(pr + PC_LF), a); unpack8(*(const u32x4*)(pr + PC_LB), bb); unpack8(*(const u32x4*)(pr + PC_G), g);
        float ss = 0.f;
#pragma unroll
        for (int j = 0; j < 8; ++j) { a[j] += bb[j]; ss += a[j] * a[j]; }
        ss += __shfl_xor(ss, 1); ss += __shfl_xor(ss, 2); ss += __shfl_xor(ss, 4); ss += __shfl_xor(ss, 8);
        const float rs = 1.0f / sqrtf(ss * (1.f / 128.f) + EPS);
        const f32x4 w0 = *(const f32x4*)(rnw + ((8 * C.lane) & 127)), w1 = *(const f32x4*)(rnw + ((8 * C.lane) & 127) + 4);
        f32x4 o0, o1;
#pragma unroll
        for (int j = 0; j < 4; ++j) { o0[j] = a[j] * rs * w0[j] * g[j]; o1[j] = a[4 + j] * rs * w1[j] * g[4 + j]; }
        *(u32x4*)(pr + PC_LF) = pack8(o0, o1);
    }
}

DI void phase_slots(const Ctx& C, const int* cnt, int* pbout, unsigned char* route, const bf16_t* H2, bf16_t* AG, LAS int* cur) {
    if (C.tid < 16) cur[C.tid] = 0;
    __syncthreads();
    for (int g = C.tid; g < C.G; g += 512) {
#pragma unroll
        for (int k = 0; k < 8; ++k) { const int c = cnt[g * 8 + k]; atomicAdd((int*)&cur[8 + k], c); if (g < C.bx) atomicAdd((int*)&cur[k], c); } }
    __syncthreads();
    if (C.tid < 8) { const int e = C.tid; int pb = 0, pbe = 0;
#pragma unroll
        for (int k = 0; k < 8; ++k) { if (k == e) pbe = pb; pb += (cur[8 + k] + 255) >> 8; }
        const int mine = cur[e];
        if (C.bx == 0) { pbout[e] = pbe; if (e == 7) pbout[8] = pb; }
        cur[e] = pbe * 256 + mine;
    }
    __syncthreads();
    const int nloc = (NLAT - C.gw + C.NGW - 1) / C.NGW;
    LAS int* tab = (LAS int*)(C.lds + C.wave * 2048);
    for (int i = C.lane; i < nloc; i += 64) { int* rt = (int*)(route + (size_t)(C.gw + i * C.NGW) * 24);
        const int s1 = atomicAdd((int*)&cur[rt[0]], 1), s2 = atomicAdd((int*)&cur[rt[1]], 1); rt[4] = s1; rt[5] = s2; tab[2 * i] = s1; tab[2 * i + 1] = s2; }
    LDS_WAIT();
    for (int i = 0; i < nloc; i += 2) { const int i1 = i + 1 < nloc ? i + 1 : i;
        const int sa1 = __builtin_amdgcn_readfirstlane(tab[2 * i]), sa2 = __builtin_amdgcn_readfirstlane(tab[2 * i + 1]), sb1 = __builtin_amdgcn_readfirstlane(tab[2 * i1]), sb2 = __builtin_amdgcn_readfirstlane(tab[2 * i1 + 1]);
        const u32x4 va = *((const u32x4*)((const unsigned char*)H2 + (size_t)(C.gw + i * C.NGW) * D) + C.lane);
        const u32x4 vb = *((const u32x4*)((const unsigned char*)H2 + (size_t)(C.gw + i1 * C.NGW) * D) + C.lane);
        *((u32x4*)((unsigned char*)AG + (size_t)sa1 * D) + C.lane) = va; *((u32x4*)((unsigned char*)AG + (size_t)sa2 * D) + C.lane) = va;
        *((u32x4*)((unsigned char*)AG + (size_t)sb1 * D) + C.lane) = vb; *((u32x4*)((unsigned char*)AG + (size_t)sb2 * D) + C.lane) = vb;
    }
}
DI void phase_final(const Ctx& C, float* x, const unsigned char* route, const bf16_t* Y, const float* mods1, const float* fw) {
    for (int row0 = C.gw; row0 < NLAT; row0 += 2 * C.NGW) {
        const int rows[2] = {row0, row0 + C.NGW < NLAT ? row0 + C.NGW : row0};
        f32x4 v[2][4]; float ss[2] = {0.f, 0.f};
#pragma unroll
        for (int u = 0; u < 2; ++u) { const int row = rows[u];
            const int* rt = (const int*)(route + (size_t)row * 24); const float g1 = ((const float*)rt)[2], g2 = ((const float*)rt)[3]; const int s1 = rt[4], s2 = rt[5];
            const float* mv = mods1 + (size_t)(row >> 11) * DIN + 5 * D; const float* xr = x + (size_t)row * D;
#pragma unroll
            for (int j = 0; j < 4; ++j) { const int c0 = 256 * j + 4 * C.lane;
                const u32x2 y1 = *(const u32x2*)(Y + (size_t)s1 * D + c0), y2 = *(const u32x2*)(Y + (size_t)s2 * D + c0); const f32x4 m5 = *(const f32x4*)(mv + c0);
                f32x4 y; y[0] = g1 * bflo(y1.x) + g2 * bflo(y2.x); y[1] = g1 * bfhi(y1.x) + g2 * bfhi(y2.x); y[2] = g1 * bflo(y1.y) + g2 * bflo(y2.y); y[3] = g1 * bfhi(y1.y) + g2 * bfhi(y2.y);
                v[u][j] = *(const f32x4*)(xr + c0) + m5 * y; ss[u] += (v[u][j][0] * v[u][j][0] + v[u][j][1] * v[u][j][1]) + (v[u][j][2] * v[u][j][2] + v[u][j][3] * v[u][j][3]); } }
#pragma unroll
        for (int u = 0; u < 2; ++u) { if (u == 1 && rows[1] == rows[0]) break;
            const float rstd = 1.0f / sqrtf(wave_sum(ss[u]) * (1.f / D) + EPS); float* xr = x + (size_t)rows[u] * D;
#pragma unroll
            for (int j = 0; j < 4; ++j) { const int c0 = 256 * j + 4 * C.lane; *(f32x4*)(xr + c0) = v[u][j] * rstd * *(const f32x4*)(fw + c0); } }
    }
}

constexpr int LDS_MISC = SC_END;
constexpr int LDS_BYTES = SC_END + 512;
static_assert(LDS_WTAB_OFF == SC_END + 128, "wave table sits behind the barrier words and counters");
constexpr int NPHASE = 20;

DI Ctx make_ctx() {
    extern __shared__ __attribute__((aligned(16))) unsigned char lds_raw[];
    Ctx C; const int t = my_tid();
    unsigned lb = (unsigned)(size_t)(LAS unsigned char*)lds_raw; asm volatile("" : "+s"(lb));
    C.lds = (LAS unsigned char*)(size_t)lb; C.ws = kparams()->ws; C.tid = t; C.lane = t & 63; C.wave = __builtin_amdgcn_readfirstlane(t >> 6);
    int bx = blockIdx.x, G = gridDim.x; asm volatile("" : "+s"(bx), "+s"(G));
    C.bx = bx; C.G = G; C.vcu = (C.G % 8 == 0) ? (bx % 8) * (C.G / 8) + bx / 8 : bx;
    C.gw = C.vcu * 8 + C.wave; C.NGW = C.G * 8;
    return C;
}
DI void grid_barrier() {
    extern __shared__ __attribute__((aligned(16))) unsigned char lds_raw[];
    XcdBarrier b; b.bar = (unsigned*)(kparams()->ws + WS_CTL) + CW_BAR + kparams()->li * XCD_BAR_WORDS; b.x = xb_xcc_id(); b.st = (volatile LAS unsigned*)((LAS unsigned char*)lds_raw + LDS_MISC);
    xcd_barrier(b);
}
#define WSP(T, off) ((T*)(kparams()->ws + (off)))

#define IN(k) (kparams()->ph_lo <= (k) && (k) < kparams()->ph_hi)
#define SEAM(k) do { if (IN(k) && IN((k) + 1)) grid_barrier(); } while (0)


template <int l> DI void layer_phases() {
        const int pb = 1 + 9 * l;
#define LQ() int lq = l; asm volatile("" : "+s"(lq))
#define XL (lq == 0 ? PIN(0) : (const float*)POUT)
#define XC (lq == 0 ? PIN(2) : (const float*)WSP(float, WS_CTXRES))
#define LMODS (WSP(float, WS_MODS) + (size_t)lq * 33 * DIN)
#define NROWS_OUT (lq == 0 ? NTOK : NLAT)
        if (IN(pb + 0)) { LQ(); const Ctx C = make_ctx(); phase_norm<false>(C, XL, XC, PIN(6) + lq * D, LMODS, 0, NTOK, WSP(bf16_t, WS_H), nullptr, nullptr, nullptr, WSP(unsigned char, WS_H8)); }
        SEAM(pb + 0);
        if (IN(pb + 1)) { LQ();
            { const Ctx C = make_ctx();
              Gemm g{WSP(bf16_t, WS_H), WSP(bf16_t, WS_WIN) + (size_t)lq * 4096 * D, NTOK, N_SEC_BF * 512, D, D};
              pg8::StaticOrder S; S.init(g, C.G, C.bx);
              EpiInProj E{WSP(bf16_t, WS_P), WSP(float2, WS_ROPE), WSP(float, WS_LBS) + lq * 1024, WSP(float, WS_LBS) + lq * 1024 + 512, (int)secmap_of(false), 1.f};
              pg8::gemm_phase<EpiInProj, pg8::StaticOrder>(C.lds, g, S, E); }
            if (N_SEC_F8 > 0) { const Ctx C = make_ctx();
              Gemm g{WSP(bf16_t, WS_H8), (const bf16_t*)(WSP(unsigned char, WS_WIN8) + (size_t)lq * 4096 * D), NTOK, N_SEC_F8 * 512, D / 2, D / 2};
              pg8::StaticOrder S; S.init(g, C.G, C.bx);
              EpiInProj E{WSP(bf16_t, WS_P), WSP(float2, WS_ROPE), WSP(float, WS_LBS) + lq * 1024, WSP(float, WS_LBS) + lq * 1024 + 512, (int)secmap_of(true), 1.f / WIN8_SCALE};
              pg8::gemm_phase<EpiInProj, pg8::StaticOrder, true, true>(C.lds, g, S, E); }
        }
        SEAM(pb + 1);
        if (IN(pb + 2)) { LQ(); const Ctx C = make_ctx(); bf16_t* const Pb = WSP(bf16_t, WS_P);
            for (int id = C.vcu; id < NB * 4 * 2; id += C.G) scan_chain(C, Pb, id >> 3, (id >> 1) & 3, id & 1, lq == 0);
            float lam;
            { const float a = wave_sum(PIN(9)[lq * 64 + C.lane] * PIN(10)[lq * 64 + C.lane]), b2 = wave_sum(PIN(11)[lq * 64 + C.lane] * PIN(12)[lq * 64 + C.lane]);
              const float li = 0.8f - 0.6f * expf(-0.3f * (float)lq); lam = expf(a) - expf(b2) + li; lam = __uint_as_float(__builtin_amdgcn_readfirstlane(__float_as_uint(lam))); }
            const float post = __uint_as_float(__builtin_amdgcn_readfirstlane(__float_as_uint(1.f - (0.8f - 0.6f * expf(-0.3f * (float)lq)))));
            const float* anw = PIN(13) + lq * 128;
            const int NU = NB * 4 * 8, U = (NU + C.G - 1) / C.G;
            for (int id = C.vcu * U; id < NU && id < (C.vcu + 1) * U; ++id) { const int bh = id >> 3, qb = id & 7, b = bh >> 2, h = bh & 3;
                attn_unit(C, Pb, b * T + qb * 256, NLAT + b * CL, b * T, 36, h, lam, anw, post); }
            if (lq == 0) for (int id = C.vcu; id < NB * 4; id += C.G) { const int b = id >> 2, h = id & 3;
                attn_unit(C, Pb, NLAT + b * CL, NLAT + b * CL, 0, 4, h, lam, anw, post); }
        }
        SEAM(pb + 2);
        if (IN(pb + 3)) { LQ(); const Ctx C = make_ctx();
            phase_recprep(C, WSP(bf16_t, WS_P), PIN(14) + lq * 128, NROWS_OUT);
            Gemm g{WSP(bf16_t, WS_H8), (const bf16_t*)(WSP(unsigned char, WS_WIN8) + ((size_t)lq * 4096 + N_SEC_F8 * 512) * D), NROWS_OUT, 2048, D / 2, D / 2};
            pg8::StaticOrder S; S.init(g, C.G, C.bx);
            EpiGates E{WSP(bf16_t, WS_P), 1.f / WIN8_SCALE};
            pg8::gemm_phase<EpiGates, pg8::StaticOrder, true, true>(C.lds, g, S, E);
        }
        SEAM(pb + 3);
        if (IN(pb + 4)) { LQ(); const Ctx C = make_ctx();
            Gemm g{WSP(bf16_t, WS_P) + PC_Q, WSP(bf16_t, WS_WUA) + (size_t)lq * D * D, NROWS_OUT, D, D, PW};
            pg8::StaticOrder S; S.init(g, C.G, C.bx); EpiMergeFused E{WSP(bf16_t, WS_P), WSP(bf16_t, WS_MERGED)};
            pg8::gemm_phase<EpiMergeFused, pg8::StaticOrder, true, false, true>(C.lds, g, S, E);
        }
        SEAM(pb + 4);
        if (IN(pb + 5)) { LQ(); const Ctx C = make_ctx();
            Gemm g{WSP(bf16_t, WS_MERGED), WSP(bf16_t, WS_WO) + (size_t)lq * D * D, NROWS_OUT, D, D, D};
            pg8::StaticOrder S; S.init(g, C.G, C.bx);
            EpiResid E{XL, XC, POUT, WSP(float, WS_CTXRES), LMODS, 2};
            pg8::gemm_phase<EpiResid, pg8::StaticOrder>(C.lds, g, S, E);
        }
        SEAM(pb + 5);
        if (l == 0) {
            if (IN(7)) { LQ(); const Ctx C = make_ctx(); phase_norm<false>(C, POUT, WSP(float, WS_CTXRES), PIN(7), LMODS, 3, NTOK, WSP(bf16_t, WS_H), nullptr, nullptr, nullptr); }
            SEAM(7);
            if (IN(8)) { LQ(); const Ctx C = make_ctx();
                Gemm g{WSP(bf16_t, WS_H), WSP(bf16_t, WS_W13), NTOK, 2 * DFFP, D, D};
                pg8::StaticOrder S; S.init(g, C.G, C.bx); EpiSwiglu E{WSP(bf16_t, WS_HID), DFFP, 0};
                pg8::gemm_phase<EpiSwiglu, pg8::StaticOrder>(C.lds, g, S, E);
            }
            SEAM(8);
            if (IN(9)) { LQ(); const Ctx C = make_ctx();
                Gemm g{WSP(bf16_t, WS_HID), WSP(bf16_t, WS_W2), NTOK, D, DFFP, DFFP};
                pg8::StaticOrder S; S.init(g, C.G, C.bx); EpiResid E{POUT, WSP(float, WS_CTXRES), POUT, WSP(float, WS_CTXRES), LMODS, 5};
                pg8::gemm_phase<EpiResid, pg8::StaticOrder>(C.lds, g, S, E);
            }
            SEAM(9);
        } else {
            if (IN(16)) { LQ(); const Ctx C = make_ctx(); LAS int* lcnt = (LAS int*)(C.lds + LDS_MISC + 32);
                if (C.tid < 8) lcnt[C.tid] = 0;
                __syncthreads();
                phase_norm<true>(C, POUT, nullptr, PIN(7) + D, LMODS, 3, NLAT, WSP(bf16_t, WS_H2M), PIN(23), WSP(unsigned char, WS_ROUTE), lcnt);
                __syncthreads();
                if (C.tid < 8) WSP(int, WS_CNT)[C.bx * 8 + C.tid] = lcnt[C.tid];
                convert_moe_weights(C);
            }
            SEAM(16);
            if (IN(17)) { LQ(); const Ctx C = make_ctx(); phase_slots(C, WSP(int, WS_CNT), WSP(int, WS_CNT) + 4096, WSP(unsigned char, WS_ROUTE), WSP(bf16_t, WS_H2M), WSP(bf16_t, WS_AG), (LAS int*)(C.lds + LDS_MISC + 32)); }
            SEAM(17);
            if (IN(18)) { LQ();
                const int ptot = __builtin_amdgcn_readfirstlane(WSP(int, WS_CNT)[4096 + 8]);
                for (int p0 = 0; p0 < ptot; p0 += MOE_CHUNK) {
                    const int np = (ptot - p0) < MOE_CHUNK ? (ptot - p0) : MOE_CHUNK;
#define MOE_ORDER_INIT(S) do { S.so.init(g, C.G, C.bx); S.p0 = p0; S.pbv = WSP(int, WS_CNT) + 4096; } while (0)
                    { const Ctx C = make_ctx(); Gemm g{WSP(bf16_t, WS_AG), WSP(bf16_t, WS_WM13), np * 256, 2 * DFE, D / 2, D / 2};
                      pg8::MoeOrder S; MOE_ORDER_INIT(S); S.apan0 = 0; S.estride = (size_t)2 * DFE * D;
                      EpiSwiglu8 E{WSP(unsigned char, WS_MHID), DFE, p0, 1.f / W13_SCALE, HID_SCALE};
                      pg8::gemm_phase<EpiSwiglu8, pg8::MoeOrder, true, true>(C.lds, g, S, E); }
                    grid_barrier();
                    { const Ctx C = make_ctx(); Gemm g{WSP(bf16_t, WS_MHID), WSP(bf16_t, WS_WM2), np * 256, D, DFE / 2, DFE / 2};
                      pg8::MoeOrder S; MOE_ORDER_INIT(S); S.apan0 = p0; S.estride = (size_t)D * DFE;
                      EpiBf16 E{WSP(bf16_t, WS_Y), D, 1.f / (W2_SCALE * HID_SCALE)};
                      pg8::gemm_phase<EpiBf16, pg8::MoeOrder, true, true>(C.lds, g, S, E); }
                    grid_barrier();
                }
            }
            if (IN(19)) { LQ(); const Ctx C = make_ctx(); phase_final(C, POUT, WSP(unsigned char, WS_ROUTE), WSP(bf16_t, WS_Y), LMODS, PIN(27)); }
        }
}

__global__ void __launch_bounds__(512, 2) fwd_kernel(Params p) {
    extern __shared__ __attribute__((aligned(16))) unsigned char lds_raw[];
    (void)p;
    { volatile LAS unsigned* misc = (volatile LAS unsigned*)((LAS unsigned char*)lds_raw + LDS_MISC);
      if (threadIdx.x < 16) misc[threadIdx.x] = 0u;
      if ((threadIdx.x & 63) == 0) ((volatile LAS int*)((LAS unsigned char*)lds_raw + LDS_WTAB_OFF))[(unsigned)__builtin_amdgcn_s_getreg((5 << 11) | 4) & 63u] = threadIdx.x >> 6;
      __syncthreads();
      (void)xcd_barrier_post((unsigned*)(kparams()->ws + WS_CTL) + CW_BAR + kparams()->li * XCD_BAR_WORDS, misc); }
    if (IN(0)) { const Ctx C = make_ctx(); phase_prologue(C); } SEAM(0);

    layer_phases<0>();
    layer_phases<1>();
#undef IN
#undef SEAM
}


extern "C" void kernel_launch(void* const* d_in, const int* in_sizes, int n_in, void* d_out, int out_size, void* d_ws, size_t ws_size, hipStream_t stream) {
    static int grid = 0;
    if (grid == 0) {
        if (n_in != 28 || out_size != NLAT * D || ws_size < WS_END) { fprintf(stderr, "kernel_launch: unexpected problem (n_in %d, out %d, ws %zu)\n", n_in, out_size, ws_size); grid = -1; return; }
        int dev = 0, cus = 0, per_cu = 0;
        if (hipGetDevice(&dev) != hipSuccess || hipDeviceGetAttribute(&cus, hipDeviceAttributeMultiprocessorCount, dev) != hipSuccess) { grid = -1; return; }
        if (hipFuncSetAttribute((const void*)fwd_kernel, hipFuncAttributeMaxDynamicSharedMemorySize, LDS_BYTES) != hipSuccess) { fprintf(stderr, "kernel_launch: cannot set %d B dynamic LDS\n", LDS_BYTES); grid = -1; return; }
        if (hipOccupancyMaxActiveBlocksPerMultiprocessor(&per_cu, (const void*)fwd_kernel, 512, LDS_BYTES) != hipSuccess || per_cu < 1) fprintf(stderr, "kernel_launch: occupancy query says %d\n", per_cu);
        (void)hipGetLastError();
        grid = cus;
    }
    if (grid < 0) return;
    (void)hipMemsetAsync((char*)d_ws + WS_CTL, 0, CTL_BYTES, stream);
    Params a{};
    for (int i = 0; i < 28; ++i) a.in[i] = (const float*)d_in[i];
    a.out = (float*)d_out; a.ws = (unsigned char*)d_ws; a.ph_lo = 0; a.ph_hi = NPHASE; a.li = 0; a.pad = 0;
    hipLaunchKernelGGL(fwd_kernel, dim3(grid), dim3(512), LDS_BYTES, stream, a);
}
```

```cpp
#include <hip/hip_runtime.h>
#include <cstdio>
#include <cstdint>


constexpr int D = 1024, NB = 32, T = 2048, CL = 256;
constexpr int NLAT = NB * T, NCTX = NB * CL, NTOK = NLAT + NCTX;
constexpr int PW = 4096;
constexpr int DIN = 6144, DFF = 2752, DFFP = 2816, DFE = 3584, NE = 8;
constexpr float EPS = 1e-6f;
constexpr float LOG2E = 1.4426950408889634f;
constexpr float QSCALE = 0.125f * LOG2E;
constexpr int PC_Q = 0, PC_LF = 512, PC_G = 1024, PC_LB = 1536, PC_K = 2048, PC_V = 2560, PC_RQ = 3072, PC_RI = 3584, PC_GA = 2048, PC_GR = 3072;

constexpr size_t MiB = 1u << 20;
constexpr size_t WS_CTL = 0, CTL_BYTES = 1 * MiB;
constexpr size_t WS_MODS = 1 * MiB;
constexpr size_t WS_LBS = 3 * MiB;
constexpr size_t WS_ROPE = 3 * MiB + 65536;
constexpr size_t WS_ROUTE = 4 * MiB;
constexpr size_t WS_CNT = 6 * MiB;
constexpr size_t WS_CTXRES = 8 * MiB;
constexpr size_t WS_WIN = 40 * MiB;
constexpr size_t WS_WIN8 = 56 * MiB;
constexpr size_t WS_H8 = 809 * MiB;
constexpr size_t WS_WUA = 64 * MiB;
constexpr size_t WS_WUR = 66 * MiB;
constexpr size_t WS_WO = 68 * MiB;
constexpr size_t WS_W13 = 72 * MiB;
constexpr size_t WS_W2 = 83 * MiB;
constexpr size_t WS_H = 89 * MiB;
constexpr size_t WS_P = 233 * MiB;
constexpr size_t WS_MERGED = 809 * MiB;
constexpr size_t WS_HID = 233 * MiB;
constexpr size_t WS_WM13 = 8 * MiB;
constexpr size_t WS_WM2 = 120 * MiB;
constexpr size_t WS_AG = 176 * MiB;
constexpr size_t WS_MHID = 436 * MiB;
constexpr size_t WS_Y = 674 * MiB;
constexpr size_t WS_H2M = 896 * MiB;
constexpr size_t WS_END = 1024 * MiB;
constexpr int MOE_CHUNK = 256;

constexpr int CW_BAR = 4096;

#define LAS __attribute__((address_space(3)))
#define GAS __attribute__((address_space(1)))
typedef unsigned short bf16_t;
typedef short bf16x8 __attribute__((ext_vector_type(8)));
typedef short s16x4 __attribute__((ext_vector_type(4)));
typedef _Float16 half8 __attribute__((ext_vector_type(8)));
typedef _Float16 half4 __attribute__((ext_vector_type(4)));
typedef float f32x4 __attribute__((ext_vector_type(4)));
typedef float f32x2 __attribute__((ext_vector_type(2)));
typedef float f32x16 __attribute__((ext_vector_type(16)));
typedef unsigned u32x4 __attribute__((ext_vector_type(4)));
typedef unsigned u32x2 __attribute__((ext_vector_type(2)));
#define DI __device__ __forceinline__
#define LDS_WAIT() asm volatile("s_waitcnt lgkmcnt(0)" ::: "memory")
#define VM_WAIT() asm volatile("s_waitcnt vmcnt(0)" ::: "memory")

typedef __bf16 bf16x2_t __attribute__((ext_vector_type(2)));
DI unsigned cvt_pk_bf16(float lo, float hi) { f32x2 v = {lo, hi}; bf16x2_t b = __builtin_convertvector(v, bf16x2_t); return __builtin_bit_cast(unsigned, b); }
typedef int v8i32 __attribute__((ext_vector_type(8)));
typedef int v4i32 __attribute__((ext_vector_type(4)));
DI unsigned pack_fp8x4(float a, float b, float c, float d) {
    a = fminf(fmaxf(a, -448.f), 448.f); b = fminf(fmaxf(b, -448.f), 448.f); c = fminf(fmaxf(c, -448.f), 448.f); d = fminf(fmaxf(d, -448.f), 448.f);
    int w = 0; w = __builtin_amdgcn_cvt_pk_fp8_f32(a, b, w, false); w = __builtin_amdgcn_cvt_pk_fp8_f32(c, d, w, true); return (unsigned)w; }
DI float bf2f(unsigned short b) { return __uint_as_float(((unsigned)b) << 16); }
DI float bflo(unsigned w) { return __uint_as_float(w << 16); }
DI float bfhi(unsigned w) { return __uint_as_float(w & 0xffff0000u); }
DI float fsilu(float x) { return x * __builtin_amdgcn_rcpf(1.f + __expf(-x)); }
DI float fsigmoid(float x) { return __builtin_amdgcn_rcpf(1.f + __expf(-x)); }
DI float wave_sum(float v) {
#pragma unroll
    for (int o = 1; o < 64; o <<= 1) v += __shfl_xor(v, o);
    return v;
}
DI int crow(int r, int hi) { return (r & 3) + 8 * (r >> 2) + 4 * hi; }

constexpr int LDS_WTAB_OFF = 148480 + 128;
DI int my_tid() {
    extern __shared__ __attribute__((aligned(16))) unsigned char lds_raw[];
    const unsigned hw = (unsigned)__builtin_amdgcn_s_getreg((5 << 11) | 4) & 63u;
    const int w = __builtin_amdgcn_readfirstlane(((volatile LAS int*)((LAS unsigned char*)lds_raw + LDS_WTAB_OFF))[hw]);
    int t = w * 64 + (int)__builtin_amdgcn_mbcnt_hi(~0u, __builtin_amdgcn_mbcnt_lo(~0u, 0u));
    asm volatile("" : "+v"(t)); return t;
}
#define XB_TMO      128
#define XB_XCNT(j)  (256  + 64 * (j))
#define XB_XSUB(j)  (1280 + 64 * (j))
#define XB_XGEN(j)  (2304 + 64 * (j))
#define XB_TOP      3328
#define XB_TOPGEN   3392
#define XCD_BAR_WORDS 3456
#define XB_SPIN_CAP (1u << 22)
DI unsigned xb_ld(unsigned* p)              { return __hip_atomic_load(p, __ATOMIC_RELAXED, __HIP_MEMORY_SCOPE_AGENT); }
DI unsigned xb_add(unsigned* p, unsigned v) { return __hip_atomic_fetch_add(p, v, __ATOMIC_RELAXED, __HIP_MEMORY_SCOPE_AGENT); }
DI unsigned xb_xcc_id() { return (unsigned)__builtin_amdgcn_s_getreg((3 << 11) | 20) & 0xFu; }
#define XB_SPIN(cond, bar) do { unsigned _sp = 0; while (cond) { __builtin_amdgcn_s_sleep(1); \
    if ((++_sp & 255u) == 0u) { if (xb_ld(&(bar)[XB_TMO])) break; if (_sp > XB_SPIN_CAP) { atomicAdd(&(bar)[XB_TMO], 1u); break; } } } } while (0)
struct XcdBarrier { unsigned* bar; unsigned x; volatile LAS unsigned* st; };
DI XcdBarrier xcd_barrier_post(unsigned* bar, volatile LAS unsigned* st) {
    XcdBarrier b; b.bar = bar; b.x = xb_xcc_id(); b.st = st;
    if (my_tid() == 0) (void)xb_add(&bar[XB_XCNT(b.x)], 1u);
    return b;
}
DI void xcd_barrier_complete(unsigned* bar, unsigned x, unsigned& nloc, unsigned& nx) {
    const unsigned G = gridDim.x * gridDim.y * gridDim.z;
    unsigned sum, cnt, mine, sp = 0u;
    for (;;) {
        sum = 0u; cnt = 0u; mine = 0u;
#pragma unroll
        for (unsigned j = 0; j < 16; ++j) { const unsigned c = xb_ld(&bar[XB_XCNT(j)]); sum += c; cnt += (c > 0u) ? 1u : 0u; mine = (j == x) ? c : mine; }
        if (sum == G) break;
        __builtin_amdgcn_s_sleep(1);
        if ((++sp & 255u) == 0u) { if (xb_ld(&bar[XB_TMO])) break; if (sp > XB_SPIN_CAP) { atomicAdd(&bar[XB_TMO], 1u); break; } }
    }
    nloc = mine > 0u ? mine : 1u; nx = cnt > 0u ? cnt : 1u;
}
DI void xcd_barrier(const XcdBarrier& b) {
    asm volatile("s_waitcnt vmcnt(0)" ::: "memory");
    __syncthreads();
    if (my_tid() == 0) {
        unsigned* bar = b.bar;
        __builtin_amdgcn_s_waitcnt(0);
        unsigned nloc = b.st[0], nx = b.st[1];
        if (nloc == 0u) { xcd_barrier_complete(bar, b.x, nloc, nx); b.st[0] = nloc; b.st[1] = nx; }
        const unsigned old = xb_add(&bar[XB_XSUB(b.x)], 1u);
        const unsigned gen = old / nloc;
        if (old + 1u == (gen + 1u) * nloc) {
            __builtin_amdgcn_fence(__ATOMIC_RELEASE, "agent");
            asm volatile("s_waitcnt vmcnt(0)" ::: "memory");
            const unsigned og = xb_add(&bar[XB_TOP], 1u);
            const unsigned tg = og / nx;
            if (og + 1u == (tg + 1u) * nx) xb_add(&bar[XB_TOPGEN], 1u);
            else XB_SPIN(xb_ld(&bar[XB_TOPGEN]) == tg, bar);
            __builtin_amdgcn_fence(__ATOMIC_ACQUIRE, "agent");
            xb_add(&bar[XB_XGEN(b.x)], 1u);
            asm volatile("s_waitcnt vmcnt(0)" ::: "memory");
        } else {
            XB_SPIN(xb_ld(&bar[XB_XGEN(b.x)]) == gen, bar);
            __builtin_amdgcn_fence(__ATOMIC_ACQUIRE, "agent");
            asm volatile("s_waitcnt vmcnt(0)" ::: "memory");
        }
    }
    __syncthreads();
}

namespace pg8 {
constexpr int BM = 256, BK = 64, HALF = 128, HTB = HALF * BK * 2, STAGE_BYTES = 8 * HTB, NXCD = 8, WGM = 8;
__host__ __device__ __forceinline__ int lds_byte(int r, int c) { const int st = (r >> 4) * 2 + (c >> 5), rr = r & 15, cc = c & 31, ob = rr * 64 + cc * 2; return st * 1024 + (ob ^ (((ob >> 9) & 1) << 5)); }
__host__ __device__ __forceinline__ void stage_rc(int b, int& R, int& C) { const int st = b / 1024, sb = b % 1024, swz = sb ^ (((sb >> 9) & 1) << 5); R = (st >> 1) * 16 + swz / 64; C = (st & 1) * 32 + (swz % 64) / 2; }
__host__ __device__ __forceinline__ int perm32(int rho) { const int n = rho >> 4, i = rho & 15; return 8 * (i >> 2) + 4 * n + (i & 3); }

struct Unit { int pm, pn; const char* a; const char* b; };
struct Gemm { const bf16_t* A; const bf16_t* Bt; int M, N, K, lda; };

struct StaticOrder {
    int nM, nN, nwg, G, c;
    DI void init(const Gemm& g, int G_, int c_) { nM = g.M / BM; nN = g.N / BM; nwg = nM * nN; G = G_; c = c_; }
    DI bool tile(int i, int& pm, int& pn) const {
        const int L = i * G + c; if (L >= nwg) return false;
        int wgid = L; { const int q = nwg / NXCD, r = nwg % NXCD, xcd = wgid % NXCD, off = wgid / NXCD; wgid = (xcd < r ? xcd * (q + 1) : r * (q + 1) + (xcd - r) * q) + off; }
        const int nig = WGM * nN, gid = wgid / nig, fm = gid * WGM, gsz = (nM - fm) < WGM ? (nM - fm) : WGM;
        pm = fm + ((wgid % nig) % gsz); pn = (wgid % nig) / gsz; return true;
    }
    DI bool next(const Gemm& g, int i, Unit& u) const { if (!tile(i, u.pm, u.pn)) return false;
        u.a = (const char*)g.A + (size_t)u.pm * ((size_t)BM * g.lda * 2); u.b = (const char*)g.Bt + (size_t)u.pn * ((size_t)BM * g.K * 2); return true; }
};
struct MoeOrder {
    StaticOrder so; int p0, apan0; const int* pbv; size_t estride;
    DI bool next(const Gemm& g, int i, Unit& u) const {
        int pm, pn; if (!so.tile(i, pm, pn)) return false;
        u.pm = p0 + pm; u.pn = pn; int e = 0;
#pragma unroll
        for (int k = 1; k < 8; ++k) e += (u.pm >= __builtin_amdgcn_readfirstlane(pbv[k])) ? 1 : 0;
        u.a = (const char*)g.A + (size_t)(u.pm - apan0) * ((size_t)BM * g.lda * 2); u.b = (const char*)g.Bt + (size_t)e * estride + (size_t)pn * ((size_t)BM * g.K * 2); return true;
    }
};

template <class Epi, class Sched, bool ALIGN_EPI = true, bool F8 = false, bool MIDHOOK = false>
DI void gemm_phase(LAS unsigned char* lds, const Gemm g, const Sched& S, const Epi& E) {
    const int tid_ = my_tid();
    const int tid = tid_, wid = __builtin_amdgcn_readfirstlane(tid >> 6), lane = tid & 63, wr = wid >> 2, wc = wid & 3, fr = lane & 15, fq = lane >> 4;
    const int K = g.K, nt = K / BK;
    unsigned voffA[2], voffB[2];
#pragma unroll
    for (int i = 0; i < 2; ++i) { int R, C; stage_rc(tid * 16 + i * 8192, R, C); const int Rb = Epi::PERM ? ((R & ~31) + perm32(R & 31)) : R;
        voffA[i] = (unsigned)(R * g.lda + C) * 2u; voffB[i] = (unsigned)(Rb * K + C) * 2u; }
    const size_t kstep = (size_t)(BK * 2);
    const size_t hstepA = (size_t)HALF * g.lda * 2, hstepB = (size_t)HALF * K * 2;
    const unsigned ldsw = (unsigned)wid * 1024u;
    const int aoff = lds_byte(wr * 64 + fr, fq * 8), boff = lds_byte(wc * 32 + fr, fq * 8);
#define PG8_SA(b, h) (((b) * 2 + (h)) * HTB)
#define PG8_SB(b, h) ((4 + (b) * 2 + (h)) * HTB)
#define PG8_STAGE(bufoff, gbase, voff) do { _Pragma("unroll") for (int _i = 0; _i < 2; ++_i) \
        __builtin_amdgcn_global_load_lds((const unsigned*)((const char*)(gbase) + (voff)[_i]), (LAS unsigned*)(lds + (bufoff) + ldsw + _i * 8192), 16, 0, 0); } while (0)
#define PG8_LD8(p) __builtin_shufflevector(*(const LAS v4i32*)(p), *(const LAS v4i32*)((p) + 1024), 0, 1, 2, 3, 4, 5, 6, 7)
#define PG8_LDA(dst, b, h) do { if constexpr (F8) { _Pragma("unroll") for (int m = 0; m < 4; ++m) dst##8[m] = PG8_LD8(lds + PG8_SA(b, h) + aoff + m * 2048); } \
        else { _Pragma("unroll") for (int m = 0; m < 4; ++m) _Pragma("unroll") for (int k = 0; k < 2; ++k) dst[m][k] = *(const LAS bf16x8*)(lds + PG8_SA(b, h) + aoff + m * 2048 + k * 1024); } } while (0)
#define PG8_LDB(dst, b, h) do { if constexpr (F8) { _Pragma("unroll") for (int n = 0; n < 2; ++n) dst##8[n] = PG8_LD8(lds + PG8_SB(b, h) + boff + n * 2048); } \
        else { _Pragma("unroll") for (int n = 0; n < 2; ++n) _Pragma("unroll") for (int k = 0; k < 2; ++k) dst[n][k] = *(const LAS bf16x8*)(lds + PG8_SB(b, h) + boff + n * 2048 + k * 1024); } } while (0)
#define PG8_MMA(ai, bj, At, Bt) do { __builtin_amdgcn_s_setprio(1); \
        if constexpr (F8) { _Pragma("unroll") for (int m = 0; m < 4; ++m) _Pragma("unroll") for (int n = 0; n < 2; ++n) \
            asm volatile("v_mfma_scale_f32_16x16x128_f8f6f4 %0, %1, %2, %0, %3, %3 op_sel_hi:[0,0,0]" : "+v"(acc[ai][bj][m][n]) : "v"(Bt##8[n]), "v"(At##8[m]), "v"(one8)); } \
        else { _Pragma("unroll") for (int m = 0; m < 4; ++m) _Pragma("unroll") for (int n = 0; n < 2; ++n) _Pragma("unroll") for (int k = 0; k < 2; ++k) \
            acc[ai][bj][m][n] = __builtin_amdgcn_mfma_f32_16x16x32_bf16(Bt[n][k], At[m][k], acc[ai][bj][m][n], 0, 0, 0); } \
        __builtin_amdgcn_s_setprio(0); } while (0)
#define PG8_WAIT_V(n) asm volatile("s_waitcnt vmcnt(" #n ")" ::: "memory")
#define PG8_WAIT_VX(n) asm volatile("s_waitcnt vmcnt(%0)" :: "n"(n) : "memory")
#define PG8_WAIT_L(n) asm volatile("s_waitcnt lgkmcnt(" #n ")" ::: "memory")
#define PG8_BAR __builtin_amdgcn_s_barrier()
#define PG8_SCHED __builtin_amdgcn_sched_barrier(0)
    Unit cur, nxt; int ui = 0;
    if (!S.next(g, 0, cur)) return;
    f32x4 acc[2][2][4][2];
#pragma unroll
    for (int a = 0; a < 2; ++a)
#pragma unroll
        for (int b = 0; b < 2; ++b)
#pragma unroll
            for (int m = 0; m < 4; ++m)
#pragma unroll
                for (int n = 0; n < 2; ++n) acc[a][b][m][n] = (f32x4){0.f, 0.f, 0.f, 0.f};
    bf16x8 At[4][2], B0[2][2], B1[2][2]; v8i32 At8[4], B08[2], B18[2]; const int one8 = 0x7F7F7F7F;
    const char* cA = cur.a; const char* cB = cur.b;
    PG8_STAGE(PG8_SB(0, 0), cB, voffB); PG8_STAGE(PG8_SB(0, 1), cB + hstepB, voffB); PG8_STAGE(PG8_SA(0, 0), cA, voffA); PG8_STAGE(PG8_SA(0, 1), cA + hstepA, voffA);
    if (wr == 1) PG8_BAR;
    PG8_WAIT_V(2); PG8_BAR;
    PG8_STAGE(PG8_SB(1, 0), cB + kstep, voffB); PG8_STAGE(PG8_SA(1, 0), cA + kstep, voffA); PG8_STAGE(PG8_SB(1, 1), cB + hstepB + kstep, voffB);
    PG8_WAIT_V(6); PG8_BAR;
    for (;;) {
        const bool has_next = S.next(g, ui + 1, nxt);
        const char* nA = has_next ? nxt.a : cA; const char* nB = has_next ? nxt.b : cB;
        for (int t = 0; t < nt; t += 2) {
            const bool last = (t == nt - 2);
            if constexpr (MIDHOOK) { PG8_SCHED; if (t == nt / 2) E.mid(acc, cur, wr, wc, fr, fq); PG8_SCHED; }
            const char* a1 = cA + (size_t)(t + 1) * kstep;
            const char* a2 = last ? nA : cA + (size_t)(t + 2) * kstep; const char* b2 = last ? nB : cB + (size_t)(t + 2) * kstep;
            const char* a3 = a2 + kstep; const char* b3 = b2 + kstep;
            const int relax = __builtin_amdgcn_readfirstlane(((t == 0) && (ui > 0)) ? 1 : 0);
#define PG8_WAIT_V8R asm volatile("s_cmp_lg_u32 %0, 0\n\ts_cbranch_scc1 1f\n\ts_waitcnt vmcnt(8)\n1:\n\ts_waitcnt vmcnt(%1)" :: "s"(relax), "n"(8 + Epi::NVM) : "memory", "scc")
            PG8_LDB(B0, 0, 0); PG8_LDB(B1, 0, 1); PG8_SCHED; PG8_LDA(At, 0, 0); PG8_STAGE(PG8_SA(1, 1), a1 + hstepA, voffA);
            PG8_WAIT_V8R; PG8_WAIT_L(0); PG8_BAR; PG8_MMA(0, 0, At, B0); PG8_MMA(0, 1, At, B1); PG8_BAR; PG8_SCHED;
            PG8_LDA(At, 0, 1); PG8_STAGE(PG8_SB(0, 0), b2, voffB); PG8_STAGE(PG8_SB(0, 1), b2 + hstepB, voffB); PG8_STAGE(PG8_SA(0, 0), a2, voffA);
            PG8_WAIT_V8R; PG8_WAIT_L(0); PG8_BAR; PG8_MMA(1, 0, At, B0); PG8_MMA(1, 1, At, B1); PG8_BAR; PG8_SCHED;
            PG8_LDB(B0, 1, 0); PG8_LDB(B1, 1, 1); PG8_SCHED; PG8_LDA(At, 1, 0); PG8_STAGE(PG8_SA(0, 1), a2 + hstepA, voffA);
            PG8_WAIT_V(8); PG8_WAIT_L(0); PG8_BAR; PG8_MMA(0, 0, At, B0); PG8_MMA(0, 1, At, B1); PG8_BAR; PG8_SCHED;
            PG8_LDA(At, 1, 1); PG8_STAGE(PG8_SB(1, 0), b3, voffB); PG8_STAGE(PG8_SB(1, 1), b3 + hstepB, voffB); PG8_STAGE(PG8_SA(1, 0), a3, voffA);
            PG8_WAIT_V(8); PG8_WAIT_L(0); PG8_BAR; PG8_MMA(1, 0, At, B0); PG8_MMA(1, 1, At, B1); PG8_BAR; PG8_SCHED;
#undef PG8_WAIT_V8R
        }
        if constexpr (ALIGN_EPI) { if (wr == 0) PG8_BAR; }
        if constexpr (F8) asm volatile("s_nop 15\n\ts_nop 15" ::: "memory");
        E(acc, cur, wr, wc, fr, fq);
        if (!has_next) break;
#pragma unroll
        for (int a = 0; a < 2; ++a)
#pragma unroll
            for (int b = 0; b < 2; ++b)
#pragma unroll
                for (int m = 0; m < 4; ++m)
#pragma unroll
                    for (int n = 0; n < 2; ++n) acc[a][b][m][n] = (f32x4){0.f, 0.f, 0.f, 0.f};
        cur = nxt; cA = nA; cB = nB; ++ui;
        if constexpr (ALIGN_EPI) { if (wr == 1) PG8_BAR; }
    }
    PG8_WAIT_V(0);
    if constexpr (!ALIGN_EPI) { if (wr == 0) PG8_BAR; }
    PG8_BAR;
#undef PG8_SA
#undef PG8_SB
#undef PG8_STAGE
#undef PG8_LDA
#undef PG8_LD8
#undef PG8_LDB
#undef PG8_MMA
#undef PG8_WAIT_V
#undef PG8_WAIT_VX
#undef PG8_WAIT_L
#undef PG8_BAR
#undef PG8_SCHED
}
}
using pg8::Unit; using pg8::Gemm;
typedef const f32x4 (&AccRef)[2][2][4][2];

DI u32x4 pack8(const f32x4& v0, const f32x4& v1) { u32x4 w; w.x = cvt_pk_bf16(v0[0], v0[1]); w.y = cvt_pk_bf16(v0[2], v0[3]); w.z = cvt_pk_bf16(v1[0], v1[1]); w.w = cvt_pk_bf16(v1[2], v1[3]); return w; }
DI void unpack8(const u32x4& w, float (&f)[8]) { f[0] = bflo(w.x); f[1] = bfhi(w.x); f[2] = bflo(w.y); f[3] = bfhi(w.y); f[4] = bflo(w.z); f[5] = bfhi(w.z); f[6] = bflo(w.w); f[7] = bfhi(w.w); }

struct EpiInProj {
    static constexpr int NVM = 16; static constexpr bool PERM = true;
    bf16_t* P; const float2* rope; const float* lbf; const float* lbb; int secmap; float asc;
    template <int MODE> DI void run(AccRef acc, const Unit& u, int wr, int wc, int fr, int fq, int sec) const {
        const int row0 = u.pm * 256 + wr * 64 + fr, col0 = sec * 512 + (u.pn & 1) * 256 + wc * 32 + 8 * fq;
        const bool lat = u.pm < (NLAT / 256); const float qs = sec == 0 ? QSCALE : 1.f;
        f32x4 lb0[2], lb1[2];
        if (MODE == 2) {
#pragma unroll
            for (int bj = 0; bj < 2; ++bj) { const float* lb = (sec == 1 ? lbf : lbb) + ((col0 + bj * 128) & 511); lb0[bj] = *(const f32x4*)lb; lb1[bj] = *(const f32x4*)(lb + 4); } }
        f32x4 rr[2][4][2];
        if (MODE == 3) {
#pragma unroll
            for (int ai = 0; ai < 2; ++ai)
#pragma unroll
                for (int m = 0; m < 4; ++m) { const f32x4* rp = (const f32x4*)(rope + (size_t)((row0 + ai * 128 + m * 16) & (T - 1)) * 32 + ((col0 & 63) >> 1));
                    rr[ai][m][0] = lat ? rp[0] : (f32x4){1.f, 0.f, 1.f, 0.f}; rr[ai][m][1] = lat ? rp[1] : (f32x4){1.f, 0.f, 1.f, 0.f}; } }
#pragma unroll
        for (int ai = 0; ai < 2; ++ai)
#pragma unroll
            for (int m = 0; m < 4; ++m) {
                const int row = row0 + ai * 128 + m * 16; bf16_t* rowp = P + (size_t)row * PW + col0;
#pragma unroll
                for (int bj = 0; bj < 2; ++bj) {
                    f32x4 v0 = acc[ai][bj][m][0] * asc, v1 = acc[ai][bj][m][1] * asc; u32x4 w;
                    if (MODE == 3) {
                        {
                            const f32x4 r0 = rr[ai][m][0], r1 = rr[ai][m][1];
                            f32x4 o0, o1;
                            o0[0] = v0[0] * r0[0] - v0[1] * r0[1]; o0[1] = v0[0] * r0[1] + v0[1] * r0[0];
                            o0[2] = v0[2] * r0[2] - v0[3] * r0[3]; o0[3] = v0[2] * r0[3] + v0[3] * r0[2];
                            o1[0] = v1[0] * r1[0] - v1[1] * r1[1]; o1[1] = v1[0] * r1[1] + v1[1] * r1[0];
                            o1[2] = v1[2] * r1[2] - v1[3] * r1[3]; o1[3] = v1[2] * r1[3] + v1[3] * r1[2];
                            v0 = o0; v1 = o1;
                        }
                        w = pack8(v0 * qs, v1 * qs);
                    } else if (MODE == 1) {
#pragma unroll
                        for (int j = 0; j < 4; ++j) { v0[j] = fsilu(v0[j]); v1[j] = fsilu(v1[j]); }
                        w = pack8(v0, v1);
                    } else if (MODE == 2) {
                        half8 hv;
#pragma unroll
                        for (int j = 0; j < 8; ++j) {
                            const float z = fmaxf(j < 4 ? v0[j] : v1[j - 4], -80.f), b = j < 4 ? lb0[bj][j] : lb1[bj][j - 4];
                            const float sg = __builtin_amdgcn_rcpf(1.f + __builtin_amdgcn_exp2f(-LOG2E * z));
                            hv[j] = (_Float16)(0.6931471805599453f * __builtin_amdgcn_logf(b + (1.f - b) * sg));
                        }
                        w = __builtin_bit_cast(u32x4, hv);
                    } else w = pack8(v0, v1);
                    *(u32x4*)(rowp + bj * 128) = w;
                }
            }
    }
    DI void operator()(AccRef acc, const Unit& u, int wr, int wc, int fr, int fq) const {
        const int sec = (secmap >> (4 * (u.pn >> 1))) & 15;
        if (sec == 0 || sec == 4) run<3>(acc, u, wr, wc, fr, fq, sec);
        else if (sec == 2 || sec == 6) run<1>(acc, u, wr, wc, fr, fq, sec);
        else if (sec == 1 || sec == 3) run<2>(acc, u, wr, wc, fr, fq, sec);
        else run<0>(acc, u, wr, wc, fr, fq, sec);
    }
};
struct EpiGates {
    static constexpr int NVM = 16; static constexpr bool PERM = true; bf16_t* P; float asc;
    DI void operator()(AccRef acc, const Unit& u, int wr, int wc, int fr, int fq) const {
        const int row0 = u.pm * 256 + wr * 64 + fr, col0 = PC_GA + u.pn * 256 + wc * 32 + 8 * fq;
#pragma unroll
        for (int ai = 0; ai < 2; ++ai)
#pragma unroll
            for (int m = 0; m < 4; ++m) { bf16_t* rowp = P + (size_t)(row0 + ai * 128 + m * 16) * PW + col0;
#pragma unroll
                for (int bj = 0; bj < 2; ++bj) { f32x4 v0 = acc[ai][bj][m][0] * asc, v1 = acc[ai][bj][m][1] * asc;
#pragma unroll
                    for (int j = 0; j < 4; ++j) { v0[j] = fsigmoid(v0[j]); v1[j] = fsigmoid(v1[j]); }
                    *(u32x4*)(rowp + bj * 128) = pack8(v0, v1); } }
    }
};
struct EpiMergeFused {
    static constexpr int NVM = 16; static constexpr bool PERM = true; const bf16_t* P; bf16_t* O;
    DI void mid(f32x4 (&acc)[2][2][4][2], const Unit& u, int wr, int wc, int fr, int fq) const {
        int row0 = u.pm * 256 + wr * 64 + fr, col0 = u.pn * 256 + wc * 32 + 8 * fq;
        asm volatile("" : "+v"(row0), "+v"(col0));
#pragma unroll
        for (int ai = 0; ai < 2; ++ai)
#pragma unroll
            for (int m = 0; m < 4; ++m) { const size_t row = (size_t)(row0 + ai * 128 + m * 16);
#pragma unroll
                for (int bj = 0; bj < 2; ++bj) {
                    float ga[8], gr[8]; unpack8(*(const u32x4*)(P + row * PW + PC_GA + col0 + bj * 128), ga); unpack8(*(const u32x4*)(P + row * PW + PC_GR + col0 + bj * 128), gr);
#pragma unroll
                    for (int j = 0; j < 4; ++j) { acc[ai][bj][m][0][j] *= ga[j] * __builtin_amdgcn_rcpf(fmaxf(gr[j], 1e-30f)); acc[ai][bj][m][1][j] *= ga[4 + j] * __builtin_amdgcn_rcpf(fmaxf(gr[4 + j], 1e-30f)); } }
                asm volatile("" ::: "memory"); }
    }
    DI void operator()(AccRef acc, const Unit& u, int wr, int wc, int fr, int fq) const {
        const int row0 = u.pm * 256 + wr * 64 + fr, col0 = u.pn * 256 + wc * 32 + 8 * fq;
        u32x4 gq[2][4][2];
#pragma unroll
        for (int ai = 0; ai < 2; ++ai)
#pragma unroll
            for (int m = 0; m < 4; ++m)
#pragma unroll
                for (int bj = 0; bj < 2; ++bj) gq[ai][m][bj] = *(const u32x4*)(P + (size_t)(row0 + ai * 128 + m * 16) * PW + PC_GR + col0 + bj * 128);
#pragma unroll
        for (int ai = 0; ai < 2; ++ai)
#pragma unroll
            for (int m = 0; m < 4; ++m) { const size_t row = (size_t)(row0 + ai * 128 + m * 16);
#pragma unroll
                for (int bj = 0; bj < 2; ++bj) {
                    float gr[8]; unpack8(gq[ai][m][bj], gr);
                    f32x4 v0 = acc[ai][bj][m][0], v1 = acc[ai][bj][m][1];
#pragma unroll
                    for (int j = 0; j < 4; ++j) { v0[j] *= fmaxf(gr[j], 1e-30f); v1[j] *= fmaxf(gr[4 + j], 1e-30f); }
                    *(u32x4*)(O + row * D + col0 + bj * 128) = pack8(v0, v1); } }
    }
};
struct EpiResid {
    static constexpr int NVM = 16; static constexpr bool PERM = false;
    const float* xin_l; const float* xin_c; float* xout_l; float* xout_c; const float* mods; int msel;
    DI void operator()(AccRef acc, const Unit& u, int wr, int wc, int fr, int fq) const {
        const bool lat = u.pm < (NLAT / 256);
        const int rbase = (lat ? u.pm : u.pm - NLAT / 256) * 256 + wr * 64 + fr, col0 = u.pn * 256 + wc * 32 + 4 * fq;
        const float* xi = lat ? xin_l : xin_c; float* xo = lat ? xout_l : xout_c;
        const float* mv = mods + (size_t)(lat ? (u.pm >> 3) : 32) * DIN + msel * D + col0;
        f32x4 g[2][2];
#pragma unroll
        for (int bj = 0; bj < 2; ++bj)
#pragma unroll
            for (int n = 0; n < 2; ++n) g[bj][n] = *(const f32x4*)(mv + bj * 128 + n * 16);
        f32x4 xa[4][2][2], r0[4][2][2];
#define RES_OFF(ai, m) ((size_t)(rbase + (ai) * 128 + (m) * 16) * D + col0)
#pragma unroll
        for (int m = 0; m < 4; ++m)
#pragma unroll
            for (int bj = 0; bj < 2; ++bj)
#pragma unroll
                for (int n = 0; n < 2; ++n) xa[m][bj][n] = *(const f32x4*)(xi + RES_OFF(0, m) + bj * 128 + n * 16);
#pragma unroll
        for (int m = 0; m < 4; ++m)
#pragma unroll
            for (int bj = 0; bj < 2; ++bj)
#pragma unroll
                for (int n = 0; n < 2; ++n) r0[m][bj][n] = xa[m][bj][n] + g[bj][n] * acc[0][bj][m][n];
#pragma unroll
        for (int m = 0; m < 4; ++m)
#pragma unroll
            for (int bj = 0; bj < 2; ++bj)
#pragma unroll
                for (int n = 0; n < 2; ++n) xa[m][bj][n] = *(const f32x4*)(xi + RES_OFF(1, m) + bj * 128 + n * 16);
        asm volatile("" ::: "memory");
#pragma unroll
        for (int m = 0; m < 4; ++m)
#pragma unroll
            for (int bj = 0; bj < 2; ++bj)
#pragma unroll
                for (int n = 0; n < 2; ++n) *(f32x4*)(xo + RES_OFF(0, m) + bj * 128 + n * 16) = r0[m][bj][n];
#pragma unroll
        for (int m = 0; m < 4; ++m)
#pragma unroll
            for (int bj = 0; bj < 2; ++bj)
#pragma unroll
                for (int n = 0; n < 2; ++n) *(f32x4*)(xo + RES_OFF(1, m) + bj * 128 + n * 16) = xa[m][bj][n] + g[bj][n] * acc[1][bj][m][n];
#undef RES_OFF
    }
};
struct EpiSwiglu {
    static constexpr int NVM = 16; static constexpr bool PERM = true; bf16_t* Hd; int ldh; int pan0;
    DI void operator()(AccRef acc, const Unit& u, int wr, int wc, int fr, int fq) const {
        const int row0 = (u.pm - pan0) * 256 + wr * 64 + fr, hc0 = u.pn * 128 + wc * 16 + 4 * fq;
#pragma unroll
        for (int ai = 0; ai < 2; ++ai)
#pragma unroll
            for (int m = 0; m < 4; ++m) { bf16_t* rowp = Hd + (size_t)(row0 + ai * 128 + m * 16) * ldh + hc0;
#pragma unroll
                for (int bj = 0; bj < 2; ++bj) { const f32x4 a = acc[ai][bj][m][0], b = acc[ai][bj][m][1];
                    u32x2 w; w.x = cvt_pk_bf16(fsilu(a[0]) * b[0], fsilu(a[1]) * b[1]); w.y = cvt_pk_bf16(fsilu(a[2]) * b[2], fsilu(a[3]) * b[3]);
                    *(u32x2*)(rowp + bj * 64) = w; } }
    }
};
struct EpiSwiglu8 {
    static constexpr int NVM = 16; static constexpr bool PERM = true; unsigned char* Hd; int ldh; int pan0; float as, hs;
    DI void operator()(AccRef acc, const Unit& u, int wr, int wc, int fr, int fq) const {
        const int row0 = (u.pm - pan0) * 256 + wr * 64 + fr, hc0 = u.pn * 128 + wc * 16 + 4 * fq;
#pragma unroll
        for (int ai = 0; ai < 2; ++ai)
#pragma unroll
            for (int m = 0; m < 4; ++m) { unsigned char* rowp = Hd + (size_t)(row0 + ai * 128 + m * 16) * ldh + hc0;
#pragma unroll
                for (int bj = 0; bj < 2; ++bj) { const f32x4 a = acc[ai][bj][m][0] * as, b = acc[ai][bj][m][1] * (as * hs);
                    *(unsigned*)(rowp + bj * 64) = pack_fp8x4(fsilu(a[0]) * b[0], fsilu(a[1]) * b[1], fsilu(a[2]) * b[2], fsilu(a[3]) * b[3]); } }
    }
};
struct EpiBf16 {
    static constexpr int NVM = 16; static constexpr bool PERM = true; bf16_t* O; int ldc; float sc;
    DI void operator()(AccRef acc, const Unit& u, int wr, int wc, int fr, int fq) const {
        const int row0 = u.pm * 256 + wr * 64 + fr, col0 = u.pn * 256 + wc * 32 + 8 * fq;
#pragma unroll
        for (int ai = 0; ai < 2; ++ai)
#pragma unroll
            for (int m = 0; m < 4; ++m) { bf16_t* rowp = O + (size_t)(row0 + ai * 128 + m * 16) * ldc + col0;
#pragma unroll
                for (int bj = 0; bj < 2; ++bj) *(u32x4*)(rowp + bj * 128) = pack8(acc[ai][bj][m][0] * sc, acc[ai][bj][m][1] * sc); }
    }
};

typedef short v4i16 __attribute__((ext_vector_type(4)));
DI s16x4 tr16(const LAS unsigned char* p) { return __builtin_bit_cast(s16x4, __builtin_amdgcn_ds_read_tr16_b64_v4i16((LAS v4i16*)p)); }
DI bf16x8 cat8(s16x4 lo, s16x4 hi) { return __builtin_shufflevector(lo, hi, 0, 1, 2, 3, 4, 5, 6, 7); }
DI void dma16(const void* g, LAS unsigned char* l) { __builtin_amdgcn_global_load_lds((const unsigned*)g, (LAS unsigned*)l, 16, 0, 0); }
DI bf16x8 packf8(const f32x16& x, int s) {
    u32x4 w; w.x = cvt_pk_bf16(x[8 * s], x[8 * s + 1]); w.y = cvt_pk_bf16(x[8 * s + 2], x[8 * s + 3]); w.z = cvt_pk_bf16(x[8 * s + 4], x[8 * s + 5]); w.w = cvt_pk_bf16(x[8 * s + 6], x[8 * s + 7]);
    return __builtin_bit_cast(bf16x8, w);
}
#define MFMA32(a, b, c) __builtin_amdgcn_mfma_f32_32x32x16_bf16((a), (b), (c), 0, 0, 0)

struct Params { const float* in[28]; float* out; unsigned char* ws; int ph_lo, ph_hi, li, pad; };
typedef const __attribute__((address_space(4))) Params* KP;
DI KP kparams() { KP kp = (KP)__builtin_amdgcn_kernarg_segment_ptr(); asm volatile("" : "+s"(kp)); return kp; }
#define PIN(k) (kparams()->in[k])
#define POUT (kparams()->out)
struct Ctx {
    LAS unsigned char* lds; unsigned char* ws; int tid, lane, wave, vcu, G, gw, NGW, bx;
};

constexpr float WIN8_SCALE = 64.f;
#ifndef FP8_SECS
#define FP8_SECS 0x00
#endif
constexpr int SEC_ORDER[8] = {0, 1, 3, 4, 2, 5, 6, 7};
constexpr int sec_slot(int ps) { int nb = 0, nf = 0; for (int i = 0; i < 8; ++i) { const int s_ = SEC_ORDER[i]; const bool f = (FP8_SECS >> s_) & 1; if (s_ == ps) return f ? (0x100 | nf) : nb; if (f) ++nf; else ++nb; } return 0; }
constexpr int N_SEC_F8 = __builtin_popcount(FP8_SECS), N_SEC_BF = 8 - N_SEC_F8;
constexpr unsigned secmap_of(bool f8) { unsigned m = 0; int k = 0; for (int i = 0; i < 8; ++i) { const int s_ = SEC_ORDER[i]; if ((((FP8_SECS >> s_) & 1) != 0) == f8) { m |= (unsigned)s_ << (4 * k); ++k; } } return m; }
DI int map_row(int kind, int n);
DI int map_row4(int n) { return map_row(1, n) & 0xffff; }
DI int map_row(int kind, int n) {
    if (kind == 0) return n;
    if (kind == 4) return map_row4(n);
    if (kind == 2) return 8 * (n >> 2) + (n & 3);
    if (kind == 3) return 8 * (n >> 2) + (n & 3) + 4;
    const int sec = n >> 9, j = n & 511;
    if (n >= 4096) return (1 << 16) | (N_SEC_F8 * 512 + (n - 4096));
    const int ps = sec == 0 ? 0 : sec == 1 ? 4 : sec == 2 ? 5 : sec == 3 ? 6 : sec == 4 ? 7 : sec == 5 ? 1 : sec == 6 ? 3 : 2;
    const int sl = sec_slot(ps); int jj = j;
    if (sec == 0 || sec == 1) { const int hs = j >> 6, d = j & 63; jj = hs * 64 + (d < 32 ? 2 * d : 2 * (d - 32) + 1); }
    return ((sl & 0x100) ? (1 << 16) : 0) | ((sl & 0xff) * 512 + jj);
}
constexpr int TP_PITCH = 68, TP_SCR = 64 * TP_PITCH * 4;
DI void transpose_load(const float* W, int ldw, int k0, int n0, LAS float* scr, int lane) {
    const int r = lane >> 4, c4 = (lane & 15) * 4; f32x4 v[16];
#pragma unroll
    for (int i = 0; i < 16; ++i) v[i] = *(const f32x4*)(W + (size_t)(k0 + 4 * i + r) * ldw + n0 + c4);
#pragma unroll
    for (int i = 0; i < 16; ++i) *(LAS f32x4*)(scr + (4 * i + r) * TP_PITCH + c4) = v[i];
    LDS_WAIT(); asm volatile("" ::: "memory");
}
DI void transpose_item(const float* W, int ldw, int k0, int n0, bf16_t* WT, int ldt, int kind, LAS float* scr, int lane) {
    transpose_load(W, ldw, k0, n0, scr, lane);
    bf16_t* dst = WT + (size_t)map_row(kind, n0 + lane) * ldt + k0;
#pragma unroll
    for (int j = 0; j < 8; ++j) { const LAS float* s = scr + (8 * j) * TP_PITCH + lane;
        u32x4 o; o.x = cvt_pk_bf16(s[0], s[TP_PITCH]); o.y = cvt_pk_bf16(s[2 * TP_PITCH], s[3 * TP_PITCH]); o.z = cvt_pk_bf16(s[4 * TP_PITCH], s[5 * TP_PITCH]); o.w = cvt_pk_bf16(s[6 * TP_PITCH], s[7 * TP_PITCH]);
        *(u32x4*)(dst + 8 * j) = o; }
    LDS_WAIT(); asm volatile("" ::: "memory");
}
DI void transpose_item8(const float* W, int ldw, int k0, int n0, unsigned char* WT, int ldt, int kind, float sc, LAS float* scr, int lane) {
    transpose_load(W, ldw, k0, n0, scr, lane);
    unsigned char* dst = WT + (size_t)map_row(kind, n0 + lane) * ldt + k0;
#pragma unroll
    for (int j = 0; j < 4; ++j) { const LAS float* s = scr + (16 * j) * TP_PITCH + lane; u32x4 o;
        o.x = pack_fp8x4(s[0] * sc, s[TP_PITCH] * sc, s[2 * TP_PITCH] * sc, s[3 * TP_PITCH] * sc); o.y = pack_fp8x4(s[4 * TP_PITCH] * sc, s[5 * TP_PITCH] * sc, s[6 * TP_PITCH] * sc, s[7 * TP_PITCH] * sc);
        o.z = pack_fp8x4(s[8 * TP_PITCH] * sc, s[9 * TP_PITCH] * sc, s[10 * TP_PITCH] * sc, s[11 * TP_PITCH] * sc); o.w = pack_fp8x4(s[12 * TP_PITCH] * sc, s[13 * TP_PITCH] * sc, s[14 * TP_PITCH] * sc, s[15 * TP_PITCH] * sc);
        *(u32x4*)(dst + 16 * j) = o; }
    LDS_WAIT(); asm volatile("" ::: "memory");
}
DI void transpose_matrix8(const Ctx& C, const float* W, int K, int N, unsigned char* WT, int ldt, int kind, float sc, int& itbase) {
    LAS float* scr = (LAS float*)(C.lds + C.wave * TP_SCR);
    const int nblk = N / 64, nit = (K / 64) * nblk;
    int first = (C.gw - (itbase % C.NGW) + C.NGW) % C.NGW;
    for (int it = first; it < nit; it += C.NGW) transpose_item8(W, N, 64 * (it / nblk), 64 * (it % nblk), WT, ldt, kind, sc, scr, C.lane);
    itbase += nit;
}
DI void transpose_matrix(const Ctx& C, const float* W, int K, int N, bf16_t* WT, int ldt, int kind, int& itbase, int total_unused) {
    (void)total_unused;
    LAS float* scr = (LAS float*)(C.lds + C.wave * TP_SCR);
    const int nblk = N / 64, nit = (K / 64) * nblk;
    int first = (C.gw - (itbase % C.NGW) + C.NGW) % C.NGW;
    for (int it = first; it < nit; it += C.NGW) transpose_item(W, N, 64 * (it / nblk), 64 * (it % nblk), WT, ldt, kind, scr, C.lane);
    itbase += nit;
}
DI void transpose_win(const Ctx& C, const float* W, bf16_t* WA, unsigned char* W8, int& itbase) {
    LAS float* scr = (LAS float*)(C.lds + C.wave * TP_SCR);
    const int nblk = DIN / 64, nit = (D / 64) * nblk;
    int first = (C.gw - (itbase % C.NGW) + C.NGW) % C.NGW;
    for (int it = first; it < nit; it += C.NGW) { const int k0 = 64 * (it / nblk), n0 = 64 * (it % nblk);
        if (map_row(1, n0) >> 16) transpose_item8(W, DIN, k0, n0, W8, D, 4, WIN8_SCALE, scr, C.lane);
        else transpose_item(W, DIN, k0, n0, WA, D, 1, scr, C.lane); }
    itbase += nit;
}
DI void phase_prologue(const Ctx& C) {
    unsigned char* ws = C.ws;
    int itb = 0;
    for (int l = 0; l < 2; ++l) {
        transpose_win(C, PIN(8) + (size_t)l * D * DIN, (bf16_t*)(ws + WS_WIN) + (size_t)l * 4096 * D, ws + WS_WIN8 + (size_t)l * 4096 * D, itb);
        transpose_matrix(C, PIN(17) + (size_t)l * 512 * D, 512, D, (bf16_t*)(ws + WS_WUA) + (size_t)l * D * D, D, 0, itb, 0);
        transpose_matrix(C, PIN(18) + (size_t)l * 512 * D, 512, D, (bf16_t*)(ws + WS_WUA) + (size_t)l * D * D + 512, D, 0, itb, 0);
        transpose_matrix(C, PIN(19) + (size_t)l * D * D, D, D, (bf16_t*)(ws + WS_WO) + (size_t)l * D * D, D, 0, itb, 0);
    }
    transpose_matrix(C, PIN(20), D, DFF, (bf16_t*)(ws + WS_W13), D, 2, itb, 0);
    transpose_matrix(C, PIN(21), D, DFF, (bf16_t*)(ws + WS_W13), D, 3, itb, 0);
    transpose_matrix(C, PIN(22), DFF, D, (bf16_t*)(ws + WS_W2), DFFP, 0, itb, 0);
    { const int gt = C.vcu * 512 + C.tid, NT = C.G * 512;
      bf16_t* w13 = (bf16_t*)(ws + WS_W13) + (size_t)(2 * DFF) * D;
      for (int i = gt; i < (2 * DFFP - 2 * DFF) * D / 8; i += NT) ((u32x4*)w13)[i] = (u32x4){0u, 0u, 0u, 0u};
      bf16_t* w2 = (bf16_t*)(ws + WS_W2);
      for (int i = gt; i < D * (DFFP - DFF) / 8; i += NT) { const int r = i / ((DFFP - DFF) / 8), cc = i % ((DFFP - DFF) / 8); *(u32x4*)(w2 + (size_t)r * DFFP + DFF + cc * 8) = (u32x4){0u, 0u, 0u, 0u}; }
      float2* rope = (float2*)(ws + WS_ROPE);
      for (int i = gt; i < T * 32; i += NT) { const int t = i >> 5, pi = i & 31; const float invf = exp2f(-(float)(pi & 15) * (13.287712379549449f / 16.f));
          const float ang = (float)(pi < 16 ? (t >> 6) : (t & 63)) * invf; rope[i] = make_float2(cosf(ang), sinf(ang)); }
      float* lbs = (float*)(ws + WS_LBS);
      for (int i = gt; i < 2 * 2 * 512; i += NT) { const int l = i >> 10, dir = (i >> 9) & 1, d = i & 511; const float* lb = PIN(dir ? 16 : 15);
          const float p0 = lb[d], p1 = lb[512 + d]; lbs[i] = l == 0 ? 0.f : 1.f / (1.f + expf(p0 - p1)); }
    }
    { float* mods = (float*)(ws + WS_MODS);
      for (int task = C.gw; task < 2 * 33 * 96; task += C.NGW) {
          const int ng = task % 96, r = (task / 96) % 33, l = task / (96 * 33), n = ng * 64 + C.lane;
          const float* cv = r < 32 ? PIN(1) + r * D : PIN(3); const float* W = PIN(4) + (size_t)l * D * DIN + n;
          float acc = PIN(5)[l * DIN + n];
          for (int k0 = 0; k0 < D; k0 += 64) { const float sv = fsilu(cv[k0 + C.lane]);
#pragma unroll 16
              for (int j = 0; j < 64; ++j) acc += __uint_as_float(__builtin_amdgcn_readlane(__float_as_uint(sv), j)) * W[(size_t)(k0 + j) * DIN]; }
          mods[(size_t)(l * 33 + r) * DIN + n] = acc; } }
}
constexpr float W13_SCALE = 64.f, W2_SCALE = 128.f, HID_SCALE = 8.f;
DI void convert_moe_weights(const Ctx& C) {
    unsigned char* ws = C.ws; int itb = 0;
    for (int e = 0; e < NE; ++e) {
        transpose_matrix8(C, PIN(24) + (size_t)e * D * DFE, D, DFE, ws + WS_WM13 + (size_t)e * 2 * DFE * D, D, 2, W13_SCALE, itb);
        transpose_matrix8(C, PIN(25) + (size_t)e * D * DFE, D, DFE, ws + WS_WM13 + (size_t)e * 2 * DFE * D, D, 3, W13_SCALE, itb);
        transpose_matrix8(C, PIN(26) + (size_t)e * DFE * D, DFE, D, ws + WS_WM2 + (size_t)e * D * DFE, DFE, 0, W2_SCALE, itb);
    }
}

template <bool ROUTER>
DI void phase_norm(const Ctx& C, const float* xl, const float* xc, const float* nw, const float* mods, int shsel, int nrows, bf16_t* Hout, const float* rw, unsigned char* route, LAS int* cntL, unsigned char* H8 = nullptr) {
    int nloc = 0;
    f32x4 rwr[4][4][2];
    if (ROUTER) {
#pragma unroll
        for (int j = 0; j < 4; ++j)
#pragma unroll
            for (int q = 0; q < 4; ++q) { const float* rp = rw + (size_t)(256 * j + 4 * C.lane + q) * 8; rwr[j][q][0] = *(const f32x4*)rp; rwr[j][q][1] = *(const f32x4*)(rp + 4); } }
    for (int row0 = C.gw; row0 < nrows; row0 += 2 * C.NGW) {
        const int rows[2] = {row0, row0 + C.NGW}; const bool two = rows[1] < nrows;
        f32x4 v[2][4]; float ss[2] = {0.f, 0.f};
#pragma unroll
        for (int u = 0; u < 2; ++u) { const int row = (u == 1 && !two) ? rows[0] : rows[u]; const float* xr = row < NLAT ? xl + (size_t)row * D : xc + (size_t)(row - NLAT) * D;
#pragma unroll
            for (int j = 0; j < 4; ++j) { v[u][j] = *(const f32x4*)(xr + 256 * j + 4 * C.lane); ss[u] += (v[u][j][0] * v[u][j][0] + v[u][j][1] * v[u][j][1]) + (v[u][j][2] * v[u][j][2] + v[u][j][3] * v[u][j][3]); } }
#pragma unroll
        for (int u = 0; u < 2; ++u) { if (u == 1 && !two) break;
            const int row = rows[u]; const bool lat = row < NLAT;
            const float* mv = mods + (size_t)(lat ? (row >> 11) : 32) * DIN + shsel * D;
            const float rstd = 1.0f / sqrtf(wave_sum(ss[u]) * (1.f / D) + EPS);
            float lg[8];
            if (ROUTER) {
#pragma unroll
                for (int e = 0; e < 8; ++e) lg[e] = 0.f; }
#pragma unroll
            for (int j = 0; j < 4; ++j) { const int c0 = 256 * j + 4 * C.lane;
                const f32x4 w = *(const f32x4*)(nw + c0), sh = *(const f32x4*)(mv + c0), sc = *(const f32x4*)(mv + D + c0);
                f32x4 h = (v[u][j] * rstd) * w * (sc + 1.0f) + sh;
                if (ROUTER) *(unsigned*)((unsigned char*)Hout + (size_t)row * D + c0) = pack_fp8x4(h[0], h[1], h[2], h[3]);
                else { u32x2 o; o.x = cvt_pk_bf16(h[0], h[1]); o.y = cvt_pk_bf16(h[2], h[3]); *(u32x2*)(Hout + (size_t)row * D + c0) = o;
                       if (H8) *(unsigned*)(H8 + (size_t)row * D + c0) = pack_fp8x4(h[0], h[1], h[2], h[3]); }
                if (ROUTER) {
#pragma unroll
                    for (int q = 0; q < 4; ++q) { const f32x4 r0 = rwr[j][q][0], r1 = rwr[j][q][1];
                        lg[0] += h[q] * r0[0]; lg[1] += h[q] * r0[1]; lg[2] += h[q] * r0[2]; lg[3] += h[q] * r0[3]; lg[4] += h[q] * r1[0]; lg[5] += h[q] * r1[1]; lg[6] += h[q] * r1[2]; lg[7] += h[q] * r1[3]; } }
            }
            if (ROUTER) {
                const bool b5 = (C.lane & 32) != 0, b4 = (C.lane & 16) != 0, b3 = (C.lane & 8) != 0; float a4[4], a2[2], a1;
#pragma unroll
                for (int j = 0; j < 4; ++j) { const float snd = b5 ? lg[j] : lg[4 + j]; a4[j] = (b5 ? lg[4 + j] : lg[j]) + __shfl_xor(snd, 32); }
#pragma unroll
                for (int j = 0; j < 2; ++j) { const float snd = b4 ? a4[j] : a4[2 + j]; a2[j] = (b4 ? a4[2 + j] : a4[j]) + __shfl_xor(snd, 16); }
                { const float snd = b3 ? a2[0] : a2[1]; a1 = (b3 ? a2[1] : a2[0]) + __shfl_xor(snd, 8); }
                a1 += __shfl_xor(a1, 4); a1 += __shfl_xor(a1, 2); a1 += __shfl_xor(a1, 1);
                if ((C.lane & 7) == 0) ((LAS float*)(C.lds + C.wave * 4096))[nloc * 8 + (C.lane >> 3)] = a1;
                ++nloc;
            }
        }
    }
    if (ROUTER) {
        LDS_WAIT();
        for (int i = C.lane; i < nloc; i += 64) { const int row = C.gw + i * C.NGW; const LAS float* lp = (const LAS float*)(C.lds + C.wave * 4096) + i * 8;
            float lg[8];
#pragma unroll
            for (int e = 0; e < 8; ++e) lg[e] = lp[e];
            int e1 = 0; float l1 = lg[0];
#pragma unroll
            for (int e = 1; e < 8; ++e) if (lg[e] > l1) { l1 = lg[e]; e1 = e; }
            int e2 = -1; float l2 = -INFINITY;
#pragma unroll
            for (int e = 0; e < 8; ++e) if (e != e1 && lg[e] > l2) { l2 = lg[e]; e2 = e; }
            const float g2 = 1.f / (1.f + expf(l1 - l2)), g1 = 1.f - g2;
            int* rt = (int*)(route + (size_t)row * 24); rt[0] = e1; rt[1] = e2; ((float*)rt)[2] = g1; ((float*)rt)[3] = g2;
            atomicAdd((int*)&cntL[e1], 1); atomicAdd((int*)&cntL[e2], 1);
        }
    }
}

constexpr int AT_XCH = 65536;
DI float max3f(float a, float b, float c) { return fmaxf(fmaxf(a, b), c); }
DI float xhalf(float v, int hi) {
    const auto rr = __builtin_amdgcn_permlane32_swap(__float_as_uint(v), __float_as_uint(v), false, false);
    return __uint_as_float(hi ? rr[0] : rr[1]);
}
constexpr float AT_THR = 8.f;
DI void attn_unit(const Ctx& C, bf16_t* P, int qrow0, int krow_ctx, int krow_lat, int nkt, int h, float lam, const float* anw, float post) {
    const int tid_ = my_tid();
    LAS unsigned char* lds = C.lds; const int lane = tid_ & 63, wid = __builtin_amdgcn_readfirstlane(tid_ >> 6), sub = wid >> 2, qw = wid & 3, r32 = lane & 31, hh = lane >> 5;
    const int tq = (lane & 15) >> 2, tp = lane & 3, blk = (lane >> 4) & 1;
    LAS unsigned char* qlds = lds + AT_XCH + wid * 8192 + r32 * 16;
#pragma unroll
    for (int qb = 0; qb < 2; ++qb) { const bf16_t* qp = P + (size_t)(qrow0 + 64 * qw + 32 * qb + r32) * PW + PC_Q + h * 128 + sub * 64 + 8 * hh;
#pragma unroll
      for (int ks = 0; ks < 4; ++ks) *(LAS bf16x8*)(qlds + ((2 * ks + hh) * 64 + 32 * qb) * 16) = *(const bf16x8*)(qp + 16 * ks); }
    f32x16 O[2][4];
#pragma unroll
    for (int qb = 0; qb < 2; ++qb)
#pragma unroll
        for (int c = 0; c < 4; ++c)
#pragma unroll
            for (int i = 0; i < 16; ++i) O[qb][c][i] = 0.f;
    float m_run[2] = {-INFINITY, -INFINITY}, l_run[2] = {0.f, 0.f};
#define AT_ISSUE(kt, buf) do { const int kr0_ = (kt) < 4 ? krow_ctx + (kt) * 64 : krow_lat + ((kt) - 4) * 64; LAS unsigned char* bb_ = lds + (buf) * 32768; \
        _Pragma("unroll") for (int j_ = 0; j_ < 2; ++j_) { const int c_ = 2 * wid + j_; \
            dma16(P + (size_t)(kr0_ + lane) * PW + PC_K + h * 128 + c_ * 8, bb_ + c_ * 1024); \
            dma16(P + (size_t)(kr0_ + 16 * (c_ & 3) + (lane >> 2)) * PW + PC_V + h * 128 + (c_ >> 2) * 32 + (lane & 3) * 8, bb_ + 16384 + c_ * 1024); } } while (0)
    AT_ISSUE(0, 0);
    int buf = 0;
#pragma unroll 1
    for (int kt = 0; kt < nkt; ++kt) {
        VM_WAIT(); __syncthreads();
        if (kt + 1 < nkt) AT_ISSUE(kt + 1, buf ^ 1);
        const LAS unsigned char* kb = lds + buf * 32768, * vb = kb + 16384 + (4 * hh + tq) * 64 + blk * 32 + tp * 8;
        bf16x8 Pf[2][4];
#pragma unroll
        for (int qb = 0; qb < 2; ++qb) {
            f32x16 s0, s1;
#pragma unroll
            for (int i = 0; i < 16; ++i) { s0[i] = 0.f; s1[i] = 0.f; }
#pragma unroll
            for (int ks = 0; ks < 4; ++ks) { const LAS unsigned char* kp = kb + ((sub * 8 + 2 * ks + hh) * 64 + r32) * 16;
                const bf16x8 k0 = *(const LAS bf16x8*)kp, k1 = *(const LAS bf16x8*)(kp + 512);
                const bf16x8 q = *(const LAS bf16x8*)(qlds + ((2 * ks + hh) * 64 + 32 * qb) * 16);
                s0 = MFMA32(k0, q, s0); s1 = MFMA32(k1, q, s1); }
            float mx = max3f(s0[0], s1[0], s0[1]);
#pragma unroll
            for (int i = 1; i < 16; ++i) mx = (i + 1 < 16) ? max3f(mx, s1[i], s0[i + 1]) : fmaxf(mx, s1[i]);
            mx = fmaxf(mx, xhalf(mx, hh));
            const float mnew = fmaxf(m_run[qb], mx);
            if (__any(mx > m_run[qb] + AT_THR)) { const float alpha = __builtin_amdgcn_exp2f(m_run[qb] - mnew); l_run[qb] *= alpha;
#pragma unroll
                for (int c = 0; c < 4; ++c)
#pragma unroll
                    for (int i = 0; i < 16; ++i) O[qb][c][i] *= alpha;
                m_run[qb] = mnew; }
            const float mr = m_run[qb]; float ps0 = 0.f, ps1 = 0.f;
#pragma unroll
            for (int i = 0; i < 16; ++i) { s0[i] = __builtin_amdgcn_exp2f(s0[i] - mr); s1[i] = __builtin_amdgcn_exp2f(s1[i] - mr); ps0 += s0[i]; ps1 += s1[i]; }
            l_run[qb] += ps0 + ps1;
            Pf[qb][0] = packf8(s0, 0); Pf[qb][1] = packf8(s0, 1); Pf[qb][2] = packf8(s1, 0); Pf[qb][3] = packf8(s1, 1);
        }
#pragma unroll
        for (int cb = 0; cb < 4; ++cb) {
#pragma unroll
            for (int s4 = 0; s4 < 4; ++s4) { const bf16x8 a = cat8(tr16(vb + cb * 4096 + s4 * 1024), tr16(vb + cb * 4096 + s4 * 1024 + 512));
                O[0][cb] = MFMA32(a, Pf[0][s4], O[0][cb]); O[1][cb] = MFMA32(a, Pf[1][s4], O[1][cb]); } }
        buf ^= 1;
    }
#undef AT_ISSUE
    LDS_WAIT(); __syncthreads();
    const int te = my_tid(); const int lane_e = te & 63, wid_e = __builtin_amdgcn_readfirstlane(te >> 6);
    LAS float* xch = (LAS float*)(lds + AT_XCH) + (wid_e & 3) * 4096 + lane_e;
#pragma unroll
    for (int qb = 0; qb < 2; ++qb) {
        const float lt = l_run[qb] + xhalf(l_run[qb], lane_e >> 5); const float inv = 1.f / lt;
        if ((wid_e >> 2) == 1) { const float sc = -lam * inv;
#pragma unroll
            for (int c = 0; c < 4; ++c)
#pragma unroll
                for (int i = 0; i < 16; ++i) xch[(c * 16 + i) * 64] = O[qb][c][i] * sc; }
        LDS_WAIT(); __syncthreads();
        if ((wid_e >> 2) == 0) {
            float ss = 0.f;
#pragma unroll
            for (int c = 0; c < 4; ++c)
#pragma unroll
                for (int i = 0; i < 16; ++i) { const float o = O[qb][c][i] * inv + xch[(c * 16 + i) * 64]; O[qb][c][i] = o; ss += o * o; }
            ss += xhalf(ss, lane_e >> 5);
            const float rs = post / sqrtf(ss * (1.f / 128.f) + EPS);
            bf16_t* op = P + (size_t)(qrow0 + 64 * (wid_e & 3) + 32 * qb + (lane_e & 31)) * PW + PC_Q + h * 128;
#pragma unroll
            for (int c = 0; c < 4; ++c)
#pragma unroll
                for (int g = 0; g < 4; ++g) { const int v0 = 32 * c + 8 * g + 4 * (lane_e >> 5); const f32x4 w = *(const f32x4*)(anw + v0);
                    u32x2 o; o.x = cvt_pk_bf16(O[qb][c][4 * g] * rs * w[0], O[qb][c][4 * g + 1] * rs * w[1]); o.y = cvt_pk_bf16(O[qb][c][4 * g + 2] * rs * w[2], O[qb][c][4 * g + 3] * rs * w[3]);
                    *(u32x2*)(op + v0) = o; }
        }
        LDS_WAIT(); __syncthreads();
    }
}

constexpr int SC_Q = 0, SC_LF = 16384, SC_V0 = 32768, SC_QM = 65536, SC_KMR = 81920, SC_KMS = 98304, SC_SX = 114688, SC_A31 = 147456, SC_A63 = 147968, SC_END = 148480;
DI void scan_chain(const Ctx& C, bf16_t* P, int b, int h, int dir, bool store_ctx) {
    const int tid_ = my_tid();
    LAS unsigned char* lds = C.lds; const int lane = tid_ & 63, wid = __builtin_amdgcn_readfirstlane(tid_ >> 6), r32 = lane & 31, hh = lane >> 5;
    const int tq = (lane & 15) >> 2, tp = lane & 3, blk = (lane >> 4) & 1;
    const int db = wid & 3, tb = wid >> 2;
    const int base_nat = hh * 512 + tq * 64 + blk * 32 + tp * 8;
    const int base_prm = (4 * hh + tq) * 64 + blk * 32 + tp * 8;
    const int lfcol = (dir ? PC_LB : PC_LF) + h * 128, qcol = PC_RQ + h * 128, vcol = PC_RI + h * 128;
    f32x16 ST[2];
#pragma unroll
    for (int j = 0; j < 2; ++j)
#pragma unroll
        for (int i = 0; i < 16; ++i) ST[j][i] = 0.f;
#define SROW(c, i) ((c) < 4 ? NLAT + b * CL + (dir ? 255 - ((c) * 64 + (i)) : (c) * 64 + (i)) : b * T + (dir ? 2047 - (((c) - 4) * 64 + (i)) : ((c) - 4) * 64 + (i)))
#define SDMA(c, colbase, dstoff) do { _Pragma("unroll") for (int j_ = 0; j_ < 2; ++j_) { const int I_ = 2 * wid + j_; const int ti_ = 16 * (I_ & 3) + (lane >> 2); \
        dma16(P + (size_t)SROW(c, ti_) * PW + (colbase) + (I_ >> 2) * 32 + (lane & 3) * 8, lds + (dstoff) + I_ * 1024); } } while (0)
    SDMA(0, qcol, SC_Q); SDMA(0, lfcol, SC_LF); SDMA(0, vcol, SC_V0);
    int vbuf = 0;
    const int t = 32 * tb + r32;
#pragma unroll 1
    for (int c = 0; c < 36; ++c) {
        VM_WAIT(); __syncthreads();
        const LAS unsigned char* Vimg = lds + SC_V0 + vbuf * 16384;
        f32x16 cm;
#pragma unroll
        for (int i = 0; i < 16; ++i) cm[i] = 0.f;
#pragma unroll
        for (int kk = 0; kk < 2; ++kk) { const int ks = 2 * tb + kk;
            const half8 a = __builtin_bit_cast(half8, cat8(tr16(lds + SC_LF + db * 4096 + base_nat + ks * 1024), tr16(lds + SC_LF + db * 4096 + base_nat + ks * 1024 + 256)));
            half8 bm;
#pragma unroll
            for (int j = 0; j < 8; ++j) { const int s = 16 * ks + 8 * hh + j; bm[j] = tb == 0 ? (s > t ? (_Float16)-1.f : (_Float16)0.f) : (s <= t ? (_Float16)1.f : (_Float16)0.f); }
            cm = __builtin_amdgcn_mfma_f32_32x32x16_f16(a, bm, cm, 0, 0, 0); }
#pragma unroll
        for (int g = 0; g < 4; ++g) {
            const int sa = db * 4096 + (t >> 3) * 512 + (t & 7) * 64 + (8 * g + 4 * hh) * 2;
            const u32x2 q4 = *(const LAS u32x2*)(lds + SC_Q + sa); const half4 lf4 = *(const LAS half4*)(lds + SC_LF + sa);
            const float qv[4] = {bflo(q4.x), bfhi(q4.x), bflo(q4.y), bfhi(q4.y)};
            float qm[4], km[4];
#pragma unroll
            for (int e = 0; e < 4; ++e) { const float cv = cm[4 * g + e] * LOG2E; const float E = __builtin_amdgcn_exp2f(cv), Ei = __builtin_amdgcn_exp2f(-cv);
                const float lf = (float)lf4[e]; qm[e] = qv[e] * E; km[e] = (1.f - __builtin_amdgcn_exp2f(lf * LOG2E)) * Ei;
                if (tb == 0 && r32 == 0) ((LAS float*)(lds + SC_A31))[32 * db + 8 * g + 4 * hh + e] = lf - cm[4 * g + e];
                if (tb == 1 && r32 == 31) ((LAS float*)(lds + SC_A63))[32 * db + 8 * g + 4 * hh + e] = cm[4 * g + e]; }
            u32x2 qw2, kw2; qw2.x = cvt_pk_bf16(qm[0], qm[1]); qw2.y = cvt_pk_bf16(qm[2], qm[3]); kw2.x = cvt_pk_bf16(km[0], km[1]); kw2.y = cvt_pk_bf16(km[2], km[3]);
            const int ra = ((4 * db + g) * 64 + t) * 16 + 8 * hh;
            *(LAS u32x2*)(lds + SC_QM + ra) = qw2; *(LAS u32x2*)(lds + SC_KMR + ra) = kw2; *(LAS u32x2*)(lds + SC_KMS + sa) = kw2;
        }
        LDS_WAIT(); __syncthreads();
        if (c + 1 < 36) { SDMA(c + 1, qcol, SC_Q); SDMA(c + 1, lfcol, SC_LF); SDMA(c + 1, vcol, SC_V0 + (vbuf ^ 1) * 16384); }
        { const int d = 32 * db + r32; const float c31 = ((LAS float*)(lds + SC_A31))[d], c63 = ((LAS float*)(lds + SC_A63))[d];
          const float e31 = __expf(c31), dec = __expf(c31 + c63), e63 = __expf(c63);
          f32x16 SN[2];
#pragma unroll
          for (int j = 0; j < 2; ++j) { const int vb2 = 2 * tb + j;
#pragma unroll
              for (int g = 0; g < 4; ++g) { u32x2 w; w.x = cvt_pk_bf16(ST[j][4 * g] * e31, ST[j][4 * g + 1] * e31); w.y = cvt_pk_bf16(ST[j][4 * g + 2] * e31, ST[j][4 * g + 3] * e31);
                  *(LAS u32x2*)(lds + SC_SX + vb2 * 8192 + (d >> 3) * 512 + (d & 7) * 64 + (8 * g + 4 * hh) * 2) = w; }
#pragma unroll
              for (int i = 0; i < 16; ++i) SN[j][i] = 0.f; }
#pragma unroll
          for (int ks = 0; ks < 4; ++ks) {
              const bf16x8 kf = cat8(tr16(lds + SC_KMS + db * 4096 + base_nat + ks * 1024), tr16(lds + SC_KMS + db * 4096 + base_nat + ks * 1024 + 256));
#pragma unroll
              for (int j = 0; j < 2; ++j) { const int vb2 = 2 * tb + j;
                  const bf16x8 vf = cat8(tr16(Vimg + vb2 * 4096 + base_nat + ks * 1024), tr16(Vimg + vb2 * 4096 + base_nat + ks * 1024 + 256));
                  SN[j] = MFMA32(vf, kf, SN[j]); } }
#pragma unroll
          for (int j = 0; j < 2; ++j)
#pragma unroll
              for (int i = 0; i < 16; ++i) ST[j][i] = dec * ST[j][i] + e63 * SN[j][i];
        }
        LDS_WAIT(); __syncthreads();
        { bf16x8 Qmf[8];
#pragma unroll
          for (int kd = 0; kd < 8; ++kd) Qmf[kd] = *(const LAS bf16x8*)(lds + SC_QM + ((2 * kd + hh) * 64 + t) * 16);
          f32x16 o;
#pragma unroll
          for (int i = 0; i < 16; ++i) o[i] = 0.f;
          for (int sb = 0; sb <= tb; ++sb) {
              f32x16 pt;
#pragma unroll
              for (int i = 0; i < 16; ++i) pt[i] = 0.f;
#pragma unroll
              for (int kd = 0; kd < 8; ++kd) { const bf16x8 a = *(const LAS bf16x8*)(lds + SC_KMR + ((2 * kd + hh) * 64 + 32 * sb + r32) * 16); pt = MFMA32(a, Qmf[kd], pt); }
              if (sb == tb) {
#pragma unroll
                  for (int i = 0; i < 16; ++i) if (crow(i, hh) > r32) pt[i] = 0.f; }
              const bf16x8 p0 = packf8(pt, 0), p1 = packf8(pt, 1);
              { const bf16x8 a = cat8(tr16(Vimg + db * 4096 + base_prm + (2 * sb) * 1024), tr16(Vimg + db * 4096 + base_prm + (2 * sb) * 1024 + 512)); o = MFMA32(a, p0, o); }
              { const bf16x8 a = cat8(tr16(Vimg + db * 4096 + base_prm + (2 * sb + 1) * 1024), tr16(Vimg + db * 4096 + base_prm + (2 * sb + 1) * 1024 + 512)); o = MFMA32(a, p1, o); }
          }
#pragma unroll
          for (int kd = 0; kd < 8; ++kd) { const bf16x8 a = cat8(tr16(lds + SC_SX + db * 8192 + base_nat + kd * 1024), tr16(lds + SC_SX + db * 8192 + base_nat + kd * 1024 + 256)); o = MFMA32(a, Qmf[kd], o); }
          if (c >= 4 || store_ctx) { bf16_t* op = P + (size_t)SROW(c, t) * PW + lfcol + 32 * db;
#pragma unroll
              for (int g = 0; g < 4; ++g) { u32x2 w; w.x = cvt_pk_bf16(o[4 * g], o[4 * g + 1]); w.y = cvt_pk_bf16(o[4 * g + 2], o[4 * g + 3]); *(u32x2*)(op + 8 * g + 4 * hh) = w; } }
        }
        vbuf ^= 1;
    }
    VM_WAIT(); LDS_WAIT(); __syncthreads();
#undef SROW
#undef SDMA
}

DI void phase_recprep(const Ctx& C, bf16_t* P, const float* rnw, int nrows) {
    for (int row = C.gw; row < nrows; row += C.NGW) {
        bf16_t* pr = P + (size_t)row * PW + 8 * C.lane;
        float a[8], bb[8], g[8]; unpack8(*(const u32x4*)(pr + PC_LF), a); unpack8(*(const u32x4*)(pr + PC_LB), bb); unpack8(*(const u32x4*)(pr + PC_G), g);
        float ss = 0.f;
#pragma unroll
        for (int j = 0; j < 8; ++j) { a[j] += bb[j]; ss += a[j] * a[j]; }
        ss += __shfl_xor(ss, 1); ss += __shfl_xor(ss, 2); ss += __shfl_xor(ss, 4); ss += __shfl_xor(ss, 8);
        const float rs = 1.0f / sqrtf(ss * (1.f / 128.f) + EPS);
        const f32x4 w0 = *(const f32x4*)(rnw + ((8 * C.lane) & 127)), w1 = *(const f32x4*)(rnw + ((8 * C.lane) & 127) + 4);
        f32x4 o0, o1;
#pragma unroll
        for (int j = 0; j < 4; ++j) { o0[j] = a[j] * rs * w0[j] * g[j]; o1[j] = a[4 + j] * rs * w1[j] * g[4 + j]; }
        *(u32x4*)(pr + PC_LF) = pack8(o0, o1);
    }
}

DI void phase_slots(const Ctx& C, const int* cnt, int* pbout, unsigned char* route, const bf16_t* H2, bf16_t* AG, LAS int* cur) {
    if (C.tid < 16) cur[C.tid] = 0;
    __syncthreads();
    for (int g = C.tid; g < C.G; g += 512) {
#pragma unroll
        for (int k = 0; k < 8; ++k) { const int c = cnt[g * 8 + k]; atomicAdd((int*)&cur[8 + k], c); if (g < C.bx) atomicAdd((int*)&cur[k], c); } }
    __syncthreads();
    if (C.tid < 8) { const int e = C.tid; int pb = 0, pbe = 0;
#pragma unroll
        for (int k = 0; k < 8; ++k) { if (k == e) pbe = pb; pb += (cur[8 + k] + 255) >> 8; }
        const int mine = cur[e];
        if (C.bx == 0) { pbout[e] = pbe; if (e == 7) pbout[8] = pb; }
        cur[e] = pbe * 256 + mine;
    }
    __syncthreads();
    const int nloc = (NLAT - C.gw + C.NGW - 1) / C.NGW;
    LAS int* tab = (LAS int*)(C.lds + C.wave * 2048);
    for (int i = C.lane; i < nloc; i += 64) { int* rt = (int*)(route + (size_t)(C.gw + i * C.NGW) * 24);
        const int s1 = atomicAdd((int*)&cur[rt[0]], 1), s2 = atomicAdd((int*)&cur[rt[1]], 1); rt[4] = s1; rt[5] = s2; tab[2 * i] = s1; tab[2 * i + 1] = s2; }
    LDS_WAIT();
    for (int i = 0; i < nloc; i += 2) { const int i1 = i + 1 < nloc ? i + 1 : i;
        const int sa1 = __builtin_amdgcn_readfirstlane(tab[2 * i]), sa2 = __builtin_amdgcn_readfirstlane(tab[2 * i + 1]), sb1 = __builtin_amdgcn_readfirstlane(tab[2 * i1]), sb2 = __builtin_amdgcn_readfirstlane(tab[2 * i1 + 1]);
        const u32x4 va = *((const u32x4*)((const unsigned char*)H2 + (size_t)(C.gw + i * C.NGW) * D) + C.lane);
        const u32x4 vb = *((const u32x4*)((const unsigned char*)H2 + (size_t)(C.gw + i1 * C.NGW) * D) + C.lane);
        *((u32x4*)((unsigned char*)AG + (size_t)sa1 * D) + C.lane) = va; *((u32x4*)((unsigned char*)AG + (size_t)sa2 * D) + C.lane) = va;
        *((u32x4*)((unsigned char*)AG + (size_t)sb1 * D) + C.lane) = vb; *((u32x4*)((unsigned char*)AG + (size_t)sb2 * D) + C.lane) = vb;
    }
}
DI void phase_final(const Ctx& C, float* x, const unsigned char* route, const bf16_t* Y, const float* mods1, const float* fw) {
    for (int row0 = C.gw; row0 < NLAT; row0 += 2 * C.NGW) {
        const int rows[2] = {row0, row0 + C.NGW < NLAT ? row0 + C.NGW : row0};
        f32x4 v[2][4]; float ss[2] = {0.f, 0.f};
#pragma unroll
        for (int u = 0; u < 2; ++u) { const int row = rows[u];
            const int* rt = (const int*)(route + (size_t)row * 24); const float g1 = ((const float*)rt)[2], g2 = ((const float*)rt)[3]; const int s1 = rt[4], s2 = rt[5];
            const float* mv = mods1 + (size_t)(row >> 11) * DIN + 5 * D; const float* xr = x + (size_t)row * D;
#pragma unroll
            for (int j = 0; j < 4; ++j) { const int c0 = 256 * j + 4 * C.lane;
                const u32x2 y1 = *(const u32x2*)(Y + (size_t)s1 * D + c0), y2 = *(const u32x2*)(Y + (size_t)s2 * D + c0); const f32x4 m5 = *(const f32x4*)(mv + c0);
                f32x4 y; y[0] = g1 * bflo(y1.x) + g2 * bflo(y2.x); y[1] = g1 * bfhi(y1.x) + g2 * bfhi(y2.x); y[2] = g1 * bflo(y1.y) + g2 * bflo(y2.y); y[3] = g1 * bfhi(y1.y) + g2 * bfhi(y2.y);
                v[u][j] = *(const f32x4*)(xr + c0) + m5 * y; ss[u] += (v[u][j][0] * v[u][j][0] + v[u][j][1] * v[u][j][1]) + (v[u][j][2] * v[u][j][2] + v[u][j][3] * v[u][j][3]); } }
#pragma unroll
        for (int u = 0; u < 2; ++u) { if (u == 1 && rows[1] == rows[0]) break;
            const float rstd = 1.0f / sqrtf(wave_sum(ss[u]) * (1.f / D) + EPS); float* xr = x + (size_t)rows[u] * D;
#pragma unroll
            for (int j = 0; j < 4; ++j) { const int c0 = 256 * j + 4 * C.lane; *(f32x4*)(xr + c0) = v[u][j] * rstd * *(const f32x4*)(fw + c0); } }
    }
}

constexpr int LDS_MISC = SC_END;
constexpr int LDS_BYTES = SC_END + 512;
static_assert(LDS_WTAB_OFF == SC_END + 128, "wave table sits behind the barrier words and counters");
constexpr int NPHASE = 20;

DI Ctx make_ctx() {
    extern __shared__ __attribute__((aligned(16))) unsigned char lds_raw[];
    Ctx C; const int t = my_tid();
    unsigned lb = (unsigned)(size_t)(LAS unsigned char*)lds_raw; asm volatile("" : "+s"(lb));
    C.lds = (LAS unsigned char*)(size_t)lb; C.ws = kparams()->ws; C.tid = t; C.lane = t & 63; C.wave = __builtin_amdgcn_readfirstlane(t >> 6);
    int bx = blockIdx.x, G = gridDim.x; asm volatile("" : "+s"(bx), "+s"(G));
    C.bx = bx; C.G = G; C.vcu = (C.G % 8 == 0) ? (bx % 8) * (C.G / 8) + bx / 8 : bx;
    C.gw = C.vcu * 8 + C.wave; C.NGW = C.G * 8;
    return C;
}
DI void grid_barrier() {
    extern __shared__ __attribute__((aligned(16))) unsigned char lds_raw[];
    XcdBarrier b; b.bar = (unsigned*)(kparams()->ws + WS_CTL) + CW_BAR + kparams()->li * XCD_BAR_WORDS; b.x = xb_xcc_id(); b.st = (volatile LAS unsigned*)((LAS unsigned char*)lds_raw + LDS_MISC);
    xcd_barrier(b);
}
#define WSP(T, off) ((T*)(kparams()->ws + (off)))

#define IN(k) (kparams()->ph_lo <= (k) && (k) < kparams()->ph_hi)
#define SEAM(k) do { if (IN(k) && IN((k) + 1)) grid_barrier(); } while (0)


template <int l> DI void layer_phases() {
        const int pb = 1 + 9 * l;
#define LQ() int lq = l; asm volatile("" : "+s"(lq))
#define XL (lq == 0 ? PIN(0) : (const float*)POUT)
#define XC (lq == 0 ? PIN(2) : (const float*)WSP(float, WS_CTXRES))
#define LMODS (WSP(float, WS_MODS) + (size_t)lq * 33 * DIN)
#define NROWS_OUT (lq == 0 ? NTOK : NLAT)
        if (IN(pb + 0)) { LQ(); const Ctx C = make_ctx(); phase_norm<false>(C, XL, XC, PIN(6) + lq * D, LMODS, 0, NTOK, WSP(bf16_t, WS_H), nullptr, nullptr, nullptr, WSP(unsigned char, WS_H8)); }
        SEAM(pb + 0);
        if (IN(pb + 1)) { LQ();
            { const Ctx C = make_ctx();
              Gemm g{WSP(bf16_t, WS_H), WSP(bf16_t, WS_WIN) + (size_t)lq * 4096 * D, NTOK, N_SEC_BF * 512, D, D};
              pg8::StaticOrder S; S.init(g, C.G, C.bx);
              EpiInProj E{WSP(bf16_t, WS_P), WSP(float2, WS_ROPE), WSP(float, WS_LBS) + lq * 1024, WSP(float, WS_LBS) + lq * 1024 + 512, (int)secmap_of(false), 1.f};
              pg8::gemm_phase<EpiInProj, pg8::StaticOrder>(C.lds, g, S, E); }
            if (N_SEC_F8 > 0) { const Ctx C = make_ctx();
              Gemm g{WSP(bf16_t, WS_H8), (const bf16_t*)(WSP(unsigned char, WS_WIN8) + (size_t)lq * 4096 * D), NTOK, N_SEC_F8 * 512, D / 2, D / 2};
              pg8::StaticOrder S; S.init(g, C.G, C.bx);
              EpiInProj E{WSP(bf16_t, WS_P), WSP(float2, WS_ROPE), WSP(float, WS_LBS) + lq * 1024, WSP(float, WS_LBS) + lq * 1024 + 512, (int)secmap_of(true), 1.f / WIN8_SCALE};
              pg8::gemm_phase<EpiInProj, pg8::StaticOrder, true, true>(C.lds, g, S, E); }
        }
        SEAM(pb + 1);
        if (IN(pb + 2)) { LQ(); const Ctx C = make_ctx(); bf16_t* const Pb = WSP(bf16_t, WS_P);
            for (int id = C.vcu; id < NB * 4 * 2; id += C.G) scan_chain(C, Pb, id >> 3, (id >> 1) & 3, id & 1, lq == 0);
            float lam;
            { const float a = wave_sum(PIN(9)[lq * 64 + C.lane] * PIN(10)[lq * 64 + C.lane]), b2 = wave_sum(PIN(11)[lq * 64 + C.lane] * PIN(12)[lq * 64 + C.lane]);
              const float li = 0.8f - 0.6f * expf(-0.3f * (float)lq); lam = expf(a) - expf(b2) + li; lam = __uint_as_float(__builtin_amdgcn_readfirstlane(__float_as_uint(lam))); }
            const float post = __uint_as_float(__builtin_amdgcn_readfirstlane(__float_as_uint(1.f - (0.8f - 0.6f * expf(-0.3f * (float)lq)))));
            const float* anw = PIN(13) + lq * 128;
            const int NU = NB * 4 * 8, U = (NU + C.G - 1) / C.G;
            for (int id = C.vcu * U; id < NU && id < (C.vcu + 1) * U; ++id) { const int bh = id >> 3, qb = id & 7, b = bh >> 2, h = bh & 3;
                attn_unit(C, Pb, b * T + qb * 256, NLAT + b * CL, b * T, 36, h, lam, anw, post); }
            if (lq == 0) for (int id = C.vcu; id < NB * 4; id += C.G) { const int b = id >> 2, h = id & 3;
                attn_unit(C, Pb, NLAT + b * CL, NLAT + b * CL, 0, 4, h, lam, anw, post); }
        }
        SEAM(pb + 2);
        if (IN(pb + 3)) { LQ(); const Ctx C = make_ctx();
            phase_recprep(C, WSP(bf16_t, WS_P), PIN(14) + lq * 128, NROWS_OUT);
            Gemm g{WSP(bf16_t, WS_H8), (const bf16_t*)(WSP(unsigned char, WS_WIN8) + ((size_t)lq * 4096 + N_SEC_F8 * 512) * D), NROWS_OUT, 2048, D / 2, D / 2};
            pg8::StaticOrder S; S.init(g, C.G, C.bx);
            EpiGates E{WSP(bf16_t, WS_P), 1.f / WIN8_SCALE};
            pg8::gemm_phase<EpiGates, pg8::StaticOrder, true, true>(C.lds, g, S, E);
        }
        SEAM(pb + 3);
        if (IN(pb + 4)) { LQ(); const Ctx C = make_ctx();
            Gemm g{WSP(bf16_t, WS_P) + PC_Q, WSP(bf16_t, WS_WUA) + (size_t)lq * D * D, NROWS_OUT, D, D, PW};
            pg8::StaticOrder S; S.init(g, C.G, C.bx); EpiMergeFused E{WSP(bf16_t, WS_P), WSP(bf16_t, WS_MERGED)};
            pg8::gemm_phase<EpiMergeFused, pg8::StaticOrder, true, false, true>(C.lds, g, S, E);
        }
        SEAM(pb + 4);
        if (IN(pb + 5)) { LQ(); const Ctx C = make_ctx();
            Gemm g{WSP(bf16_t, WS_MERGED), WSP(bf16_t, WS_WO) + (size_t)lq * D * D, NROWS_OUT, D, D, D};
            pg8::StaticOrder S; S.init(g, C.G, C.bx);
            EpiResid E{XL, XC, POUT, WSP(float, WS_CTXRES), LMODS, 2};
            pg8::gemm_phase<EpiResid, pg8::StaticOrder>(C.lds, g, S, E);
        }
        SEAM(pb + 5);
        if (l == 0) {
            if (IN(7)) { LQ(); const Ctx C = make_ctx(); phase_norm<false>(C, POUT, WSP(float, WS_CTXRES), PIN(7), LMODS, 3, NTOK, WSP(bf16_t, WS_H), nullptr, nullptr, nullptr); }
            SEAM(7);
            if (IN(8)) { LQ(); const Ctx C = make_ctx();
                Gemm g{WSP(bf16_t, WS_H), WSP(bf16_t, WS_W13), NTOK, 2 * DFFP, D, D};
                pg8::StaticOrder S; S.init(g, C.G, C.bx); EpiSwiglu E{WSP(bf16_t, WS_HID), DFFP, 0};
                pg8::gemm_phase<EpiSwiglu, pg8::StaticOrder>(C.lds, g, S, E);
            }
            SEAM(8);
            if (IN(9)) { LQ(); const Ctx C = make_ctx();
                Gemm g{WSP(bf16_t, WS_HID), WSP(bf16_t, WS_W2), NTOK, D, DFFP, DFFP};
                pg8::StaticOrder S; S.init(g, C.G, C.bx); EpiResid E{POUT, WSP(float, WS_CTXRES), POUT, WSP(float, WS_CTXRES), LMODS, 5};
                pg8::gemm_phase<EpiResid, pg8::StaticOrder>(C.lds, g, S, E);
            }
            SEAM(9);
        } else {
            if (IN(16)) { LQ(); const Ctx C = make_ctx(); LAS int* lcnt = (LAS int*)(C.lds + LDS_MISC + 32);
                if (C.tid < 8) lcnt[C.tid] = 0;
                __syncthreads();
                phase_norm<true>(C, POUT, nullptr, PIN(7) + D, LMODS, 3, NLAT, WSP(bf16_t, WS_H2M), PIN(23), WSP(unsigned char, WS_ROUTE), lcnt);
                __syncthreads();
                if (C.tid < 8) WSP(int, WS_CNT)[C.bx * 8 + C.tid] = lcnt[C.tid];
                convert_moe_weights(C);
            }
            SEAM(16);
            if (IN(17)) { LQ(); const Ctx C = make_ctx(); phase_slots(C, WSP(int, WS_CNT), WSP(int, WS_CNT) + 4096, WSP(unsigned char, WS_ROUTE), WSP(bf16_t, WS_H2M), WSP(bf16_t, WS_AG), (LAS int*)(C.lds + LDS_MISC + 32)); }
            SEAM(17);
            if (IN(18)) { LQ();
                const int ptot = __builtin_amdgcn_readfirstlane(WSP(int, WS_CNT)[4096 + 8]);
                for (int p0 = 0; p0 < ptot; p0 += MOE_CHUNK) {
                    const int np = (ptot - p0) < MOE_CHUNK ? (ptot - p0) : MOE_CHUNK;
#define MOE_ORDER_INIT(S) do { S.so.init(g, C.G, C.bx); S.p0 = p0; S.pbv = WSP(int, WS_CNT) + 4096; } while (0)
                    { const Ctx C = make_ctx(); Gemm g{WSP(bf16_t, WS_AG), WSP(bf16_t, WS_WM13), np * 256, 2 * DFE, D / 2, D / 2};
                      pg8::MoeOrder S; MOE_ORDER_INIT(S); S.apan0 = 0; S.estride = (size_t)2 * DFE * D;
                      EpiSwiglu8 E{WSP(unsigned char, WS_MHID), DFE, p0, 1.f / W13_SCALE, HID_SCALE};
                      pg8::gemm_phase<EpiSwiglu8, pg8::MoeOrder, true, true>(C.lds, g, S, E); }
                    grid_barrier();
                    { const Ctx C = make_ctx(); Gemm g{WSP(bf16_t, WS_MHID), WSP(bf16_t, WS_WM2), np * 256, D, DFE / 2, DFE / 2};
                      pg8::MoeOrder S; MOE_ORDER_INIT(S); S.apan0 = p0; S.estride = (size_t)D * DFE;
                      EpiBf16 E{WSP(bf16_t, WS_Y), D, 1.f / (W2_SCALE * HID_SCALE)};
                      pg8::gemm_phase<EpiBf16, pg8::MoeOrder, true, true>(C.lds, g, S, E); }
                    grid_barrier();
                }
            }
            if (IN(19)) { LQ(); const Ctx C = make_ctx(); phase_final(C, POUT, WSP(unsigned char, WS_ROUTE), WSP(bf16_t, WS_Y), LMODS, PIN(27)); }
        }
}

__global__ void __launch_bounds__(512, 2) fwd_kernel(Params p) {
    extern __shared__ __attribute__((aligned(16))) unsigned char lds_raw[];
    (void)p;
    { volatile LAS unsigned* misc = (volatile LAS unsigned*)((LAS unsigned char*)lds_raw + LDS_MISC);
      if (threadIdx.x < 16) misc[threadIdx.x] = 0u;
      if ((threadIdx.x & 63) == 0) ((volatile LAS int*)((LAS unsigned char*)lds_raw + LDS_WTAB_OFF))[(unsigned)__builtin_amdgcn_s_getreg((5 << 11) | 4) & 63u] = threadIdx.x >> 6;
      __syncthreads();
      (void)xcd_barrier_post((unsigned*)(kparams()->ws + WS_CTL) + CW_BAR + kparams()->li * XCD_BAR_WORDS, misc); }
    if (IN(0)) { const Ctx C = make_ctx(); phase_prologue(C); } SEAM(0);

    layer_phases<0>();
    layer_phases<1>();
#undef IN
#undef SEAM
}


extern "C" void kernel_launch(void* const* d_in, const int* in_sizes, int n_in, void* d_out, int out_size, void* d_ws, size_t ws_size, hipStream_t stream) {
    static int grid = 0;
    if (grid == 0) {
        if (n_in != 28 || out_size != NLAT * D || ws_size < WS_END) { fprintf(stderr, "kernel_launch: unexpected problem (n_in %d, out %d, ws %zu)\n", n_in, out_size, ws_size); grid = -1; return; }
        int dev = 0, cus = 0, per_cu = 0;
        if (hipGetDevice(&dev) != hipSuccess || hipDeviceGetAttribute(&cus, hipDeviceAttributeMultiprocessorCount, dev) != hipSuccess) { grid = -1; return; }
        if (hipFuncSetAttribute((const void*)fwd_kernel, hipFuncAttributeMaxDynamicSharedMemorySize, LDS_BYTES) != hipSuccess) { fprintf(stderr, "kernel_launch: cannot set %d B dynamic LDS\n", LDS_BYTES); grid = -1; return; }
        if (hipOccupancyMaxActiveBlocksPerMultiprocessor(&per_cu, (const void*)fwd_kernel, 512, LDS_BYTES) != hipSuccess || per_cu < 1) fprintf(stderr, "kernel_launch: occupancy query says %d\n", per_cu);
        (void)hipGetLastError();
        grid = cus;
    }
    if (grid < 0) return;
    (void)hipMemsetAsync((char*)d_ws + WS_CTL, 0, CTL_BYTES, stream);
    Params a{};
    for (int i = 0; i < 28; ++i) a.in[i] = (const float*)d_in[i];
    a.out = (float*)d_out; a.ws = (unsigned char*)d_ws; a.ph_lo = 0; a.ph_hi = NPHASE; a.li = 0; a.pad = 0;
    hipLaunchKernelGGL(fwd_kernel, dim3(grid), dim3(512), LDS_BYTES, stream, a);
}
```

```cpp
#include <hip/hip_runtime.h>
#include <cstdio>
#include <cstdint>


constexpr int D = 1024, NB = 32, T = 2048, CL = 256;
constexpr int NLAT = NB * T, NCTX = NB * CL, NTOK = NLAT + NCTX;
constexpr int PW = 4096;
constexpr int DIN = 6144, DFF = 2752, DFFP = 2816, DFE = 3584, NE = 8;
constexpr float EPS = 1e-6f;
constexpr float LOG2E = 1.4426950408889634f;
constexpr float QSCALE = 0.125f * LOG2E;
constexpr int PC_Q = 0, PC_LF = 512, PC_G = 1024, PC_LB = 1536, PC_K = 2048, PC_V = 2560, PC_RQ = 3072, PC_RI = 3584, PC_GA = 2048, PC_GR = 3072;

constexpr size_t MiB = 1u << 20;
constexpr size_t WS_CTL = 0, CTL_BYTES = 1 * MiB;
constexpr size_t WS_MODS = 1 * MiB;
constexpr size_t WS_LBS = 3 * MiB;
constexpr size_t WS_ROPE = 3 * MiB + 65536;
constexpr size_t WS_ROUTE = 4 * MiB;
constexpr size_t WS_CNT = 6 * MiB;
constexpr size_t WS_CTXRES = 8 * MiB;
constexpr size_t WS_WIN = 40 * MiB;
constexpr size_t WS_WIN8 = 56 * MiB;
constexpr size_t WS_H8 = 809 * MiB;
constexpr size_t WS_WUA = 64 * MiB;
constexpr size_t WS_WUR = 66 * MiB;
constexpr size_t WS_WO = 68 * MiB;
constexpr size_t WS_W13 = 72 * MiB;
constexpr size_t WS_W2 = 83 * MiB;
constexpr size_t WS_H = 89 * MiB;
constexpr size_t WS_P = 233 * MiB;
constexpr size_t WS_MERGED = 809 * MiB;
constexpr size_t WS_HID = 233 * MiB;
constexpr size_t WS_WM13 = 8 * MiB;
constexpr size_t WS_WM2 = 120 * MiB;
constexpr size_t WS_AG = 176 * MiB;
constexpr size_t WS_MHID = 436 * MiB;
constexpr size_t WS_Y = 674 * MiB;
constexpr size_t WS_H2M = 896 * MiB;
constexpr size_t WS_END = 1024 * MiB;
constexpr int MOE_CHUNK = 256;

constexpr int CW_BAR = 4096;

#define LAS __attribute__((address_space(3)))
#define GAS __attribute__((address_space(1)))
typedef unsigned short bf16_t;
typedef short bf16x8 __attribute__((ext_vector_type(8)));
typedef short s16x4 __attribute__((ext_vector_type(4)));
typedef _Float16 half8 __attribute__((ext_vector_type(8)));
typedef _Float16 half4 __attribute__((ext_vector_type(4)));
typedef float f32x4 __attribute__((ext_vector_type(4)));
typedef float f32x2 __attribute__((ext_vector_type(2)));
typedef float f32x16 __attribute__((ext_vector_type(16)));
typedef unsigned u32x4 __attribute__((ext_vector_type(4)));
typedef unsigned u32x2 __attribute__((ext_vector_type(2)));
#define DI __device__ __forceinline__
#define LDS_WAIT() asm volatile("s_waitcnt lgkmcnt(0)" ::: "memory")
#define VM_WAIT() asm volatile("s_waitcnt vmcnt(0)" ::: "memory")

typedef __bf16 bf16x2_t __attribute__((ext_vector_type(2)));
DI unsigned cvt_pk_bf16(float lo, float hi) { f32x2 v = {lo, hi}; bf16x2_t b = __builtin_convertvector(v, bf16x2_t); return __builtin_bit_cast(unsigned, b); }
typedef int v8i32 __attribute__((ext_vector_type(8)));
typedef int v4i32 __attribute__((ext_vector_type(4)));
DI unsigned pack_fp8x4(float a, float b, float c, float d) {
    a = fminf(fmaxf(a, -448.f), 448.f); b = fminf(fmaxf(b, -448.f), 448.f); c = fminf(fmaxf(c, -448.f), 448.f); d = fminf(fmaxf(d, -448.f), 448.f);
    int w = 0; w = __builtin_amdgcn_cvt_pk_fp8_f32(a, b, w, false); w = __builtin_amdgcn_cvt_pk_fp8_f32(c, d, w, true); return (unsigned)w; }
DI float bf2f(unsigned short b) { return __uint_as_float(((unsigned)b) << 16); }
DI float bflo(unsigned w) { return __uint_as_float(w << 16); }
DI float bfhi(unsigned w) { return __uint_as_float(w & 0xffff0000u); }
DI float fsilu(float x) { return x * __builtin_amdgcn_rcpf(1.f + __expf(-x)); }
DI float fsigmoid(float x) { return __builtin_amdgcn_rcpf(1.f + __expf(-x)); }
DI float wave_sum(float v) {
#pragma unroll
    for (int o = 1; o < 64; o <<= 1) v += __shfl_xor(v, o);
    return v;
}
DI int crow(int r, int hi) { return (r & 3) + 8 * (r >> 2) + 4 * hi; }

constexpr int LDS_WTAB_OFF = 148480 + 128;
DI int my_tid() {
    extern __shared__ __attribute__((aligned(16))) unsigned char lds_raw[];
    const unsigned hw = (unsigned)__builtin_amdgcn_s_getreg((5 << 11) | 4) & 63u;
    const int w = __builtin_amdgcn_readfirstlane(((volatile LAS int*)((LAS unsigned char*)lds_raw + LDS_WTAB_OFF))[hw]);
    int t = w * 64 + (int)__builtin_amdgcn_mbcnt_hi(~0u, __builtin_amdgcn_mbcnt_lo(~0u, 0u));
    asm volatile("" : "+v"(t)); return t;
}
#define XB_TMO      128
#define XB_XCNT(j)  (256  + 64 * (j))
#define XB_XSUB(j)  (1280 + 64 * (j))
#define XB_XGEN(j)  (2304 + 64 * (j))
#define XB_TOP      3328
#define XB_TOPGEN   3392
#define XCD_BAR_WORDS 3456
#define XB_SPIN_CAP (1u << 22)
DI unsigned xb_ld(unsigned* p)              { return __hip_atomic_load(p, __ATOMIC_RELAXED, __HIP_MEMORY_SCOPE_AGENT); }
DI unsigned xb_add(unsigned* p, unsigned v) { return __hip_atomic_fetch_add(p, v, __ATOMIC_RELAXED, __HIP_MEMORY_SCOPE_AGENT); }
DI unsigned xb_xcc_id() { return (unsigned)__builtin_amdgcn_s_getreg((3 << 11) | 20) & 0xFu; }
#define XB_SPIN(cond, bar) do { unsigned _sp = 0; while (cond) { __builtin_amdgcn_s_sleep(1); \
    if ((++_sp & 255u) == 0u) { if (xb_ld(&(bar)[XB_TMO])) break; if (_sp > XB_SPIN_CAP) { atomicAdd(&(bar)[XB_TMO], 1u); break; } } } } while (0)
struct XcdBarrier { unsigned* bar; unsigned x; volatile LAS unsigned* st; };
DI XcdBarrier xcd_barrier_post(unsigned* bar, volatile LAS unsigned* st) {
    XcdBarrier b; b.bar = bar; b.x = xb_xcc_id(); b.st = st;
    if (my_tid() == 0) (void)xb_add(&bar[XB_XCNT(b.x)], 1u);
    return b;
}
DI void xcd_barrier_complete(unsigned* bar, unsigned x, unsigned& nloc, unsigned& nx) {
    const unsigned G = gridDim.x * gridDim.y * gridDim.z;
    unsigned sum, cnt, mine, sp = 0u;
    for (;;) {
        sum = 0u; cnt = 0u; mine = 0u;
#pragma unroll
        for (unsigned j = 0; j < 16; ++j) { const unsigned c = xb_ld(&bar[XB_XCNT(j)]); sum += c; cnt += (c > 0u) ? 1u : 0u; mine = (j == x) ? c : mine; }
        if (sum == G) break;
        __builtin_amdgcn_s_sleep(1);
        if ((++sp & 255u) == 0u) { if (xb_ld(&bar[XB_TMO])) break; if (sp > XB_SPIN_CAP) { atomicAdd(&bar[XB_TMO], 1u); break; } }
    }
    nloc = mine > 0u ? mine : 1u; nx = cnt > 0u ? cnt : 1u;
}
DI void xcd_barrier(const XcdBarrier& b) {
    asm volatile("s_waitcnt vmcnt(0)" ::: "memory");
    __syncthreads();
    if (my_tid() == 0) {
        unsigned* bar = b.bar;
        __builtin_amdgcn_s_waitcnt(0);
        unsigned nloc = b.st[0], nx = b.st[1];
        if (nloc == 0u) { xcd_barrier_complete(bar, b.x, nloc, nx); b.st[0] = nloc; b.st[1] = nx; }
        const unsigned old = xb_add(&bar[XB_XSUB(b.x)], 1u);
        const unsigned gen = old / nloc;
        if (old + 1u == (gen + 1u) * nloc) {
            __builtin_amdgcn_fence(__ATOMIC_RELEASE, "agent");
            asm volatile("s_waitcnt vmcnt(0)" ::: "memory");
            const unsigned og = xb_add(&bar[XB_TOP], 1u);
            const unsigned tg = og / nx;
            if (og + 1u == (tg + 1u) * nx) xb_add(&bar[XB_TOPGEN], 1u);
            else XB_SPIN(xb_ld(&bar[XB_TOPGEN]) == tg, bar);
            __builtin_amdgcn_fence(__ATOMIC_ACQUIRE, "agent");
            xb_add(&bar[XB_XGEN(b.x)], 1u);
            asm volatile("s_waitcnt vmcnt(0)" ::: "memory");
        } else {
            XB_SPIN(xb_ld(&bar[XB_XGEN(b.x)]) == gen, bar);
            __builtin_amdgcn_fence(__ATOMIC_ACQUIRE, "agent");
            asm volatile("s_waitcnt vmcnt(0)" ::: "memory");
        }
    }
    __syncthreads();
}

namespace pg8 {
constexpr int BM = 256, BK = 64, HALF = 128, HTB = HALF * BK * 2, STAGE_BYTES = 8 * HTB, NXCD = 8, WGM = 8;
__host__ __device__ __forceinline__ int lds_byte(int r, int c) { const int st = (r >> 4) * 2 + (c >> 5), rr = r & 15, cc = c & 31, ob = rr * 64 + cc * 2; return st * 1024 + (ob ^ (((ob >> 9) & 1) << 5)); }
__host__ __device__ __forceinline__ void stage_rc(int b, int& R, int& C) { const int st = b / 1024, sb = b % 1024, swz = sb ^ (((sb >> 9) & 1) << 5); R = (st >> 1) * 16 + swz / 64; C = (st & 1) * 32 + (swz % 64) / 2; }
__host__ __device__ __forceinline__ int perm32(int rho) { const int n = rho >> 4, i = rho & 15; return 8 * (i >> 2) + 4 * n + (i & 3); }

struct Unit { int pm, pn; const char* a; const char* b; };
struct Gemm { const bf16_t* A; const bf16_t* Bt; int M, N, K, lda; };

struct StaticOrder {
    int nM, nN, nwg, G, c;
    DI void init(const Gemm& g, int G_, int c_) { nM = g.M / BM; nN = g.N / BM; nwg = nM * nN; G = G_; c = c_; }
    DI bool tile(int i, int& pm, int& pn) const {
        const int L = i * G + c; if (L >= nwg) return false;
        int wgid = L; { const int q = nwg / NXCD, r = nwg % NXCD, xcd = wgid % NXCD, off = wgid / NXCD; wgid = (xcd < r ? xcd * (q + 1) : r * (q + 1) + (xcd - r) * q) + off; }
        const int nig = WGM * nN, gid = wgid / nig, fm = gid * WGM, gsz = (nM - fm) < WGM ? (nM - fm) : WGM;
        pm = fm + ((wgid % nig) % gsz); pn = (wgid % nig) / gsz; return true;
    }
    DI bool next(const Gemm& g, int i, Unit& u) const { if (!tile(i, u.pm, u.pn)) return false;
        u.a = (const char*)g.A + (size_t)u.pm * ((size_t)BM * g.lda * 2); u.b = (const char*)g.Bt + (size_t)u.pn * ((size_t)BM * g.K * 2); return true; }
};
struct MoeOrder {
    StaticOrder so; int p0, apan0; const int* pbv; size_t estride;
    DI bool next(const Gemm& g, int i, Unit& u) const {
        int pm, pn; if (!so.tile(i, pm, pn)) return false;
        u.pm = p0 + pm; u.pn = pn; int e = 0;
#pragma unroll
        for (int k = 1; k < 8; ++k) e += (u.pm >= __builtin_amdgcn_readfirstlane(pbv[k])) ? 1 : 0;
        u.a = (const char*)g.A + (size_t)(u.pm - apan0) * ((size_t)BM * g.lda * 2); u.b = (const char*)g.Bt + (size_t)e * estride + (size_t)pn * ((size_t)BM * g.K * 2); return true;
    }
};

template <class Epi, class Sched, bool ALIGN_EPI = true, bool F8 = false, bool MIDHOOK = false>
DI void gemm_phase(LAS unsigned char* lds, const Gemm g, const Sched& S, const Epi& E) {
    const int tid_ = my_tid();
    const int tid = tid_, wid = __builtin_amdgcn_readfirstlane(tid >> 6), lane = tid & 63, wr = wid >> 2, wc = wid & 3, fr = lane & 15, fq = lane >> 4;
    const int K = g.K, nt = K / BK;
    unsigned voffA[2], voffB[2];
#pragma unroll
    for (int i = 0; i < 2; ++i) { int R, C; stage_rc(tid * 16 + i * 8192, R, C); const int Rb = Epi::PERM ? ((R & ~31) + perm32(R & 31)) : R;
        voffA[i] = (unsigned)(R * g.lda + C) * 2u; voffB[i] = (unsigned)(Rb * K + C) * 2u; }
    const size_t kstep = (size_t)(BK * 2);
    const size_t hstepA = (size_t)HALF * g.lda * 2, hstepB = (size_t)HALF * K * 2;
    const unsigned ldsw = (unsigned)wid * 1024u;
    const int aoff = lds_byte(wr * 64 + fr, fq * 8), boff = lds_byte(wc * 32 + fr, fq * 8);
#define PG8_SA(b, h) (((b) * 2 + (h)) * HTB)
#define PG8_SB(b, h) ((4 + (b) * 2 + (h)) * HTB)
#define PG8_STAGE(bufoff, gbase, voff) do { _Pragma("unroll") for (int _i = 0; _i < 2; ++_i) \
        __builtin_amdgcn_global_load_lds((const unsigned*)((const char*)(gbase) + (voff)[_i]), (LAS unsigned*)(lds + (bufoff) + ldsw + _i * 8192), 16, 0, 0); } while (0)
#define PG8_LD8(p) __builtin_shufflevector(*(const LAS v4i32*)(p), *(const LAS v4i32*)((p) + 1024), 0, 1, 2, 3, 4, 5, 6, 7)
#define PG8_LDA(dst, b, h) do { if constexpr (F8) { _Pragma("unroll") for (int m = 0; m < 4; ++m) dst##8[m] = PG8_LD8(lds + PG8_SA(b, h) + aoff + m * 2048); } \
        else { _Pragma("unroll") for (int m = 0; m < 4; ++m) _Pragma("unroll") for (int k = 0; k < 2; ++k) dst[m][k] = *(const LAS bf16x8*)(lds + PG8_SA(b, h) + aoff + m * 2048 + k * 1024); } } while (0)
#define PG8_LDB(dst, b, h) do { if constexpr (F8) { _Pragma("unroll") for (int n = 0; n < 2; ++n) dst##8[n] = PG8_LD8(lds + PG8_SB(b, h) + boff + n * 2048); } \
        else { _Pragma("unroll") for (int n = 0; n < 2; ++n) _Pragma("unroll") for (int k = 0; k < 2; ++k) dst[n][k] = *(const LAS bf16x8*)(lds + PG8_SB(b, h) + boff + n * 2048 + k * 1024); } } while (0)
#define PG8_MMA(ai, bj, At, Bt) do { __builtin_amdgcn_s_setprio(1); \
        if constexpr (F8) { _Pragma("unroll") for (int m = 0; m < 4; ++m) _Pragma("unroll") for (int n = 0; n < 2; ++n) \
            asm volatile("v_mfma_scale_f32_16x16x128_f8f6f4 %0, %1, %2, %0, %3, %3 op_sel_hi:[0,0,0]" : "+v"(acc[ai][bj][m][n]) : "v"(Bt##8[n]), "v"(At##8[m]), "v"(one8)); } \
        else { _Pragma("unroll") for (int m = 0; m < 4; ++m) _Pragma("unroll") for (int n = 0; n < 2; ++n) _Pragma("unroll") for (int k = 0; k < 2; ++k) \
            acc[ai][bj][m][n] = __builtin_amdgcn_mfma_f32_16x16x32_bf16(Bt[n][k], At[m][k], acc[ai][bj][m][n], 0, 0, 0); } \
        __builtin_amdgcn_s_setprio(0); } while (0)
#define PG8_WAIT_V(n) asm volatile("s_waitcnt vmcnt(" #n ")" ::: "memory")
#define PG8_WAIT_VX(n) asm volatile("s_waitcnt vmcnt(%0)" :: "n"(n) : "memory")
#define PG8_WAIT_L(n) asm volatile("s_waitcnt lgkmcnt(" #n ")" ::: "memory")
#define PG8_BAR __builtin_amdgcn_s_barrier()
#define PG8_SCHED __builtin_amdgcn_sched_barrier(0)
    Unit cur, nxt; int ui = 0;
    if (!S.next(g, 0, cur)) return;
    f32x4 acc[2][2][4][2];
#pragma unroll
    for (int a = 0; a < 2; ++a)
#pragma unroll
        for (int b = 0; b < 2; ++b)
#pragma unroll
            for (int m = 0; m < 4; ++m)
#pragma unroll
                for (int n = 0; n < 2; ++n) acc[a][b][m][n] = (f32x4){0.f, 0.f, 0.f, 0.f};
    bf16x8 At[4][2], B0[2][2], B1[2][2]; v8i32 At8[4], B08[2], B18[2]; const int one8 = 0x7F7F7F7F;
    const char* cA = cur.a; const char* cB = cur.b;
    PG8_STAGE(PG8_SB(0, 0), cB, voffB); PG8_STAGE(PG8_SB(0, 1), cB + hstepB, voffB); PG8_STAGE(PG8_SA(0, 0), cA, voffA); PG8_STAGE(PG8_SA(0, 1), cA + hstepA, voffA);
    if (wr == 1) PG8_BAR;
    PG8_WAIT_V(2); PG8_BAR;
    PG8_STAGE(PG8_SB(1, 0), cB + kstep, voffB); PG8_STAGE(PG8_SA(1, 0), cA + kstep, voffA); PG8_STAGE(PG8_SB(1, 1), cB + hstepB + kstep, voffB);
    PG8_WAIT_V(6); PG8_BAR;
    for (;;) {
        const bool has_next = S.next(g, ui + 1, nxt);
        const char* nA = has_next ? nxt.a : cA; const char* nB = has_next ? nxt.b : cB;
        for (int t = 0; t < nt; t += 2) {
            const bool last = (t == nt - 2);
            if constexpr (MIDHOOK) { PG8_SCHED; if (t == nt / 2) E.mid(acc, cur, wr, wc, fr, fq); PG8_SCHED; }
            const char* a1 = cA + (size_t)(t + 1) * kstep;
            const char* a2 = last ? nA : cA + (size_t)(t + 2) * kstep; const char* b2 = last ? nB : cB + (size_t)(t + 2) * kstep;
            const char* a3 = a2 + kstep; const char* b3 = b2 + kstep;
            const int relax = __builtin_amdgcn_readfirstlane(((t == 0) && (ui > 0)) ? 1 : 0);
#define PG8_WAIT_V8R asm volatile("s_cmp_lg_u32 %0, 0\n\ts_cbranch_scc1 1f\n\ts_waitcnt vmcnt(8)\n1:\n\ts_waitcnt vmcnt(%1)" :: "s"(relax), "n"(8 + Epi::NVM) : "memory", "scc")
            PG8_LDB(B0, 0, 0); PG8_LDB(B1, 0, 1); PG8_SCHED; PG8_LDA(At, 0, 0); PG8_STAGE(PG8_SA(1, 1), a1 + hstepA, voffA);
            PG8_WAIT_V8R; PG8_WAIT_L(0); PG8_BAR; PG8_MMA(0, 0, At, B0); PG8_MMA(0, 1, At, B1); PG8_BAR; PG8_SCHED;
            PG8_LDA(At, 0, 1); PG8_STAGE(PG8_SB(0, 0), b2, voffB); PG8_STAGE(PG8_SB(0, 1), b2 + hstepB, voffB); PG8_STAGE(PG8_SA(0, 0), a2, voffA);
            PG8_WAIT_V8R; PG8_WAIT_L(0); PG8_BAR; PG8_MMA(1, 0, At, B0); PG8_MMA(1, 1, At, B1); PG8_BAR; PG8_SCHED;
            PG8_LDB(B0, 1, 0); PG8_LDB(B1, 1, 1); PG8_SCHED; PG8_LDA(At, 1, 0); PG8_STAGE(PG8_SA(0, 1), a2 + hstepA, voffA);
            PG8_WAIT_V(8); PG8_WAIT_L(0); PG8_BAR; PG8_MMA(0, 0, At, B0); PG8_MMA(0, 1, At, B1); PG8_BAR; PG8_SCHED;
            PG8_LDA(At, 1, 1); PG8_STAGE(PG8_SB(1, 0), b3, voffB); PG8_STAGE(PG8_SB(1, 1), b3 + hstepB, voffB); PG8_STAGE(PG8_SA(1, 0), a3, voffA);
            PG8_WAIT_V(8); PG8_WAIT_L(0); PG8_BAR; PG8_MMA(1, 0, At, B0); PG8_MMA(1, 1, At, B1); PG8_BAR; PG8_SCHED;
#undef PG8_WAIT_V8R
        }
        if constexpr (ALIGN_EPI) { if (wr == 0) PG8_BAR; }
        if constexpr (F8) asm volatile("s_nop 15\n\ts_nop 15" ::: "memory");
        E(acc, cur, wr, wc, fr, fq);
        if (!has_next) break;
#pragma unroll
        for (int a = 0; a < 2; ++a)
#pragma unroll
            for (int b = 0; b < 2; ++b)
#pragma unroll
                for (int m = 0; m < 4; ++m)
#pragma unroll
                    for (int n = 0; n < 2; ++n) acc[a][b][m][n] = (f32x4){0.f, 0.f, 0.f, 0.f};
        cur = nxt; cA = nA; cB = nB; ++ui;
        if constexpr (ALIGN_EPI) { if (wr == 1) PG8_BAR; }
    }
    PG8_WAIT_V(0);
    if constexpr (!ALIGN_EPI) { if (wr == 0) PG8_BAR; }
    PG8_BAR;
#undef PG8_SA
#undef PG8_SB
#undef PG8_STAGE
#undef PG8_LDA
#undef PG8_LD8
#undef PG8_LDB
#undef PG8_MMA
#undef PG8_WAIT_V
#undef PG8_WAIT_VX
#undef PG8_WAIT_L
#undef PG8_BAR
#undef PG8_SCHED
}
}
using pg8::Unit; using pg8::Gemm;
typedef const f32x4 (&AccRef)[2][2][4][2];

DI u32x4 pack8(const f32x4& v0, const f32x4& v1) { u32x4 w; w.x = cvt_pk_bf16(v0[0], v0[1]); w.y = cvt_pk_bf16(v0[2], v0[3]); w.z = cvt_pk_bf16(v1[0], v1[1]); w.w = cvt_pk_bf16(v1[2], v1[3]); return w; }
DI void unpack8(const u32x4& w, float (&f)[8]) { f[0] = bflo(w.x); f[1] = bfhi(w.x); f[2] = bflo(w.y); f[3] = bfhi(w.y); f[4] = bflo(w.z); f[5] = bfhi(w.z); f[6] = bflo(w.w); f[7] = bfhi(w.w); }

struct EpiInProj {
    static constexpr int NVM = 16; static constexpr bool PERM = true;
    bf16_t* P; const float2* rope; const float* lbf; const float* lbb; int secmap; float asc;
    template <int MODE> DI void run(AccRef acc, const Unit& u, int wr, int wc, int fr, int fq, int sec) const {
        const int row0 = u.pm * 256 + wr * 64 + fr, col0 = sec * 512 + (u.pn & 1) * 256 + wc * 32 + 8 * fq;
        const bool lat = u.pm < (NLAT / 256); const float qs = sec == 0 ? QSCALE : 1.f;
        f32x4 lb0[2], lb1[2];
        if (MODE == 2) {
#pragma unroll
            for (int bj = 0; bj < 2; ++bj) { const float* lb = (sec == 1 ? lbf : lbb) + ((col0 + bj * 128) & 511); lb0[bj] = *(const f32x4*)lb; lb1[bj] = *(const f32x4*)(lb + 4); } }
        f32x4 rr[2][4][2];
        if (MODE == 3) {
#pragma unroll
            for (int ai = 0; ai < 2; ++ai)
#pragma unroll
                for (int m = 0; m < 4; ++m) { const f32x4* rp = (const f32x4*)(rope + (size_t)((row0 + ai * 128 + m * 16) & (T - 1)) * 32 + ((col0 & 63) >> 1));
                    rr[ai][m][0] = lat ? rp[0] : (f32x4){1.f, 0.f, 1.f, 0.f}; rr[ai][m][1] = lat ? rp[1] : (f32x4){1.f, 0.f, 1.f, 0.f}; } }
#pragma unroll
        for (int ai = 0; ai < 2; ++ai)
#pragma unroll
            for (int m = 0; m < 4; ++m) {
                const int row = row0 + ai * 128 + m * 16; bf16_t* rowp = P + (size_t)row * PW + col0;
#pragma unroll
                for (int bj = 0; bj < 2; ++bj) {
                    f32x4 v0 = acc[ai][bj][m][0] * asc, v1 = acc[ai][bj][m][1] * asc; u32x4 w;
                    if (MODE == 3) {
                        {
                            const f32x4 r0 = rr[ai][m][0], r1 = rr[ai][m][1];
                            f32x4 o0, o1;
                            o0[0] = v0[0] * r0[0] - v0[1] * r0[1]; o0[1] = v0[0] * r0[1] + v0[1] * r0[0];
                            o0[2] = v0[2] * r0[2] - v0[3] * r0[3]; o0[3] = v0[2] * r0[3] + v0[3] * r0[2];
                            o1[0] = v1[0] * r1[0] - v1[1] * r1[1]; o1[1] = v1[0] * r1[1] + v1[1] * r1[0];
                            o1[2] = v1[2] * r1[2] - v1[3] * r1[3]; o1[3] = v1[2] * r1[3] + v1[3] * r1[2];
                            v0 = o0; v1 = o1;
                        }
                        w = pack8(v0 * qs, v1 * qs);
                    } else if (MODE == 1) {
#pragma unroll
                        for (int j = 0; j < 4; ++j) { v0[j] = fsilu(v0[j]); v1[j] = fsilu(v1[j]); }
                        w = pack8(v0, v1);
                    } else if (MODE == 2) {
                        half8 hv;
#pragma unroll
                        for (int j = 0; j < 8; ++j) {
                            const float z = fmaxf(j < 4 ? v0[j] : v1[j - 4], -80.f), b = j < 4 ? lb0[bj][j] : lb1[bj][j - 4];
                            const float sg = __builtin_amdgcn_rcpf(1.f + __builtin_amdgcn_exp2f(-LOG2E * z));
                            hv[j] = (_Float16)(0.6931471805599453f * __builtin_amdgcn_logf(b + (1.f - b) * sg));
                        }
                        w = __builtin_bit_cast(u32x4, hv);
                    } else w = pack8(v0, v1);
                    *(u32x4*)(rowp + bj * 128) = w;
                }
            }
    }
    DI void operator()(AccRef acc, const Unit& u, int wr, int wc, int fr, int fq) const {
        const int sec = (secmap >> (4 * (u.pn >> 1))) & 15;
        if (sec == 0 || sec == 4) run<3>(acc, u, wr, wc, fr, fq, sec);
        else if (sec == 2 || sec == 6) run<1>(acc, u, wr, wc, fr, fq, sec);
        else if (sec == 1 || sec == 3) run<2>(acc, u, wr, wc, fr, fq, sec);
        else run<0>(acc, u, wr, wc, fr, fq, sec);
    }
};
struct EpiGates {
    static constexpr int NVM = 16; static constexpr bool PERM = true; bf16_t* P; float asc;
    DI void operator()(AccRef acc, const Unit& u, int wr, int wc, int fr, int fq) const {
        const int row0 = u.pm * 256 + wr * 64 + fr, col0 = PC_GA + u.pn * 256 + wc * 32 + 8 * fq;
#pragma unroll
        for (int ai = 0; ai < 2; ++ai)
#pragma unroll
            for (int m = 0; m < 4; ++m) { bf16_t* rowp = P + (size_t)(row0 + ai * 128 + m * 16) * PW + col0;
#pragma unroll
                for (int bj = 0; bj < 2; ++bj) { f32x4 v0 = acc[ai][bj][m][0] * asc, v1 = acc[ai][bj][m][1] * asc;
#pragma unroll
                    for (int j = 0; j < 4; ++j) { v0[j] = fsigmoid(v0[j]); v1[j] = fsigmoid(v1[j]); }
                    *(u32x4*)(rowp + bj * 128) = pack8(v0, v1); } }
    }
};
struct EpiMergeFused {
    static constexpr int NVM = 16; static constexpr bool PERM = true; const bf16_t* P; bf16_t* O;
    DI void mid(f32x4 (&acc)[2][2][4][2], const Unit& u, int wr, int wc, int fr, int fq) const {
        int row0 = u.pm * 256 + wr * 64 + fr, col0 = u.pn * 256 + wc * 32 + 8 * fq;
        asm volatile("" : "+v"(row0), "+v"(col0));
#pragma unroll
        for (int ai = 0; ai < 2; ++ai)
#pragma unroll
            for (int m = 0; m < 4; ++m) { const size_t row = (size_t)(row0 + ai * 128 + m * 16);
#pragma unroll
                for (int bj = 0; bj < 2; ++bj) {
                    float ga[8], gr[8]; unpack8(*(const u32x4*)(P + row * PW + PC_GA + col0 + bj * 128), ga); unpack8(*(const u32x4*)(P + row * PW + PC_GR + col0 + bj * 128), gr);
#pragma unroll
                    for (int j = 0; j < 4; ++j) { acc[ai][bj][m][0][j] *= ga[j] * __builtin_amdgcn_rcpf(fmaxf(gr[j], 1e-30f)); acc[ai][bj][m][1][j] *= ga[4 + j] * __builtin_amdgcn_rcpf(fmaxf(gr[4 + j], 1e-30f)); } }
                asm volatile("" ::: "memory"); }
    }
    DI void operator()(AccRef acc, const Unit& u, int wr, int wc, int fr, int fq) const {
        const int row0 = u.pm * 256 + wr * 64 + fr, col0 = u.pn * 256 + wc * 32 + 8 * fq;
        u32x4 gq[2][4][2];
#pragma unroll
        for (int ai = 0; ai < 2; ++ai)
#pragma unroll
            for (int m = 0; m < 4; ++m)
#pragma unroll
                for (int bj = 0; bj < 2; ++bj) gq[ai][m][bj] = *(const u32x4*)(P + (size_t)(row0 + ai * 128 + m * 16) * PW + PC_GR + col0 + bj * 128);
#pragma unroll
        for (int ai = 0; ai < 2; ++ai)
#pragma unroll
            for (int m = 0; m < 4; ++m) { const size_t row = (size_t)(row0 + ai * 128 + m * 16);
#pragma unroll
                for (int bj = 0; bj < 2; ++bj) {
                    float gr[8]; unpack8(gq[ai][m][bj], gr);
                    f32x4 v0 = acc[ai][bj][m][0], v1 = acc[ai][bj][m][1];
#pragma unroll
                    for (int j = 0; j < 4; ++j) { v0[j] *= fmaxf(gr[j], 1e-30f); v1[j] *= fmaxf(gr[4 + j], 1e-30f); }
                    *(u32x4*)(O + row * D + col0 + bj * 128) = pack8(v0, v1); } }
    }
};
struct EpiResid {
    static constexpr int NVM = 16; static constexpr bool PERM = false;
    const float* xin_l; const float* xin_c; float* xout_l; float* xout_c; const float* mods; int msel;
    DI void operator()(AccRef acc, const Unit& u, int wr, int wc, int fr, int fq) const {
        const bool lat = u.pm < (NLAT / 256);
        const int rbase = (lat ? u.pm : u.pm - NLAT / 256) * 256 + wr * 64 + fr, col0 = u.pn * 256 + wc * 32 + 4 * fq;
        const float* xi = lat ? xin_l : xin_c; float* xo = lat ? xout_l : xout_c;
        const float* mv = mods + (size_t)(lat ? (u.pm >> 3) : 32) * DIN + msel * D + col0;
        f32x4 g[2][2];
#pragma unroll
        for (int bj = 0; bj < 2; ++bj)
#pragma unroll
            for (int n = 0; n < 2; ++n) g[bj][n] = *(const f32x4*)(mv + bj * 128 + n * 16);
        f32x4 xa[4][2][2], r0[4][2][2];
#define RES_OFF(ai, m) ((size_t)(rbase + (ai) * 128 + (m) * 16) * D + col0)
#pragma unroll
        for (int m = 0; m < 4; ++m)
#pragma unroll
            for (int bj = 0; bj < 2; ++bj)
#pragma unroll
                for (int n = 0; n < 2; ++n) xa[m][bj][n] = *(const f32x4*)(xi + RES_OFF(0, m) + bj * 128 + n * 16);
#pragma unroll
        for (int m = 0; m < 4; ++m)
#pragma unroll
            for (int bj = 0; bj < 2; ++bj)
#pragma unroll
                for (int n = 0; n < 2; ++n) r0[m][bj][n] = xa[m][bj][n] + g[bj][n] * acc[0][bj][m][n];
#pragma unroll
        for (int m = 0; m < 4; ++m)
#pragma unroll
            for (int bj = 0; bj < 2; ++bj)
#pragma unroll
                for (int n = 0; n < 2; ++n) xa[m][bj][n] = *(const f32x4*)(xi + RES_OFF(1, m) + bj * 128 + n * 16);
        asm volatile("" ::: "memory");
#pragma unroll
        for (int m = 0; m < 4; ++m)
#pragma unroll
            for (int bj = 0; bj < 2; ++bj)
#pragma unroll
                for (int n = 0; n < 2; ++n) *(f32x4*)(xo + RES_OFF(0, m) + bj * 128 + n * 16) = r0[m][bj][n];
#pragma unroll
        for (int m = 0; m < 4; ++m)
#pragma unroll
            for (int bj = 0; bj < 2; ++bj)
#pragma unroll
                for (int n = 0; n < 2; ++n) *(f32x4*)(xo + RES_OFF(1, m) + bj * 128 + n * 16) = xa[m][bj][n] + g[bj][n] * acc[1][bj][m][n];
#undef RES_OFF
    }
};
struct EpiSwiglu {
    static constexpr int NVM = 16; static constexpr bool PERM = true; bf16_t* Hd; int ldh; int pan0;
    DI void operator()(AccRef acc, const Unit& u, int wr, int wc, int fr, int fq) const {
        const int row0 = (u.pm - pan0) * 256 + wr * 64 + fr, hc0 = u.pn * 128 + wc * 16 + 4 * fq;
#pragma unroll
        for (int ai = 0; ai < 2; ++ai)
#pragma unroll
            for (int m = 0; m < 4; ++m) { bf16_t* rowp = Hd + (size_t)(row0 + ai * 128 + m * 16) * ldh + hc0;
#pragma unroll
                for (int bj = 0; bj < 2; ++bj) { const f32x4 a = acc[ai][bj][m][0], b = acc[ai][bj][m][1];
                    u32x2 w; w.x = cvt_pk_bf16(fsilu(a[0]) * b[0], fsilu(a[1]) * b[1]); w.y = cvt_pk_bf16(fsilu(a[2]) * b[2], fsilu(a[3]) * b[3]);
                    *(u32x2*)(rowp + bj * 64) = w; } }
    }
};
struct EpiSwiglu8 {
    static constexpr int NVM = 16; static constexpr bool PERM = true; unsigned char* Hd; int ldh; int pan0; float as, hs;
    DI void operator()(AccRef acc, const Unit& u, int wr, int wc, int fr, int fq) const {
        const int row0 = (u.pm - pan0) * 256 + wr * 64 + fr, hc0 = u.pn * 128 + wc * 16 + 4 * fq;
#pragma unroll
        for (int ai = 0; ai < 2; ++ai)
#pragma unroll
            for (int m = 0; m < 4; ++m) { unsigned char* rowp = Hd + (size_t)(row0 + ai * 128 + m * 16) * ldh + hc0;
#pragma unroll
                for (int bj = 0; bj < 2; ++bj) { const f32x4 a = acc[ai][bj][m][0] * as, b = acc[ai][bj][m][1] * (as * hs);
                    *(unsigned*)(rowp + bj * 64) = pack_fp8x4(fsilu(a[0]) * b[0], fsilu(a[1]) * b[1], fsilu(a[2]) * b[2], fsilu(a[3]) * b[3]); } }
    }
};
struct EpiBf16 {
    static constexpr int NVM = 16; static constexpr bool PERM = true; bf16_t* O; int ldc; float sc;
    DI void operator()(AccRef acc, const Unit& u, int wr, int wc, int fr, int fq) const {
        const int row0 = u.pm * 256 + wr * 64 + fr, col0 = u.pn * 256 + wc * 32 + 8 * fq;
#pragma unroll
        for (int ai = 0; ai < 2; ++ai)
#pragma unroll
            for (int m = 0; m < 4; ++m) { bf16_t* rowp = O + (size_t)(row0 + ai * 128 + m * 16) * ldc + col0;
#pragma unroll
                for (int bj = 0; bj < 2; ++bj) *(u32x4*)(rowp + bj * 128) = pack8(acc[ai][bj][m][0] * sc, acc[ai][bj][m][1] * sc); }
    }
};

typedef short v4i16 __attribute__((ext_vector_type(4)));
DI s16x4 tr16(const LAS unsigned char* p) { return __builtin_bit_cast(s16x4, __builtin_amdgcn_ds_read_tr16_b64_v4i16((LAS v4i16*)p)); }
DI bf16x8 cat8(s16x4 lo, s16x4 hi) { return __builtin_shufflevector(lo, hi, 0, 1, 2, 3, 4, 5, 6, 7); }
DI void dma16(const void* g, LAS unsigned char* l) { __builtin_amdgcn_global_load_lds((const unsigned*)g, (LAS unsigned*)l, 16, 0, 0); }
DI bf16x8 packf8(const f32x16& x, int s) {
    u32x4 w; w.x = cvt_pk_bf16(x[8 * s], x[8 * s + 1]); w.y = cvt_pk_bf16(x[8 * s + 2], x[8 * s + 3]); w.z = cvt_pk_bf16(x[8 * s + 4], x[8 * s + 5]); w.w = cvt_pk_bf16(x[8 * s + 6], x[8 * s + 7]);
    return __builtin_bit_cast(bf16x8, w);
}
#define MFMA32(a, b, c) __builtin_amdgcn_mfma_f32_32x32x16_bf16((a), (b), (c), 0, 0, 0)

struct Params { const float* in[28]; float* out; unsigned char* ws; int ph_lo, ph_hi, li, pad; };
typedef const __attribute__((address_space(4))) Params* KP;
DI KP kparams() { KP kp = (KP)__builtin_amdgcn_kernarg_segment_ptr(); asm volatile("" : "+s"(kp)); return kp; }
#define PIN(k) (kparams()->in[k])
#define POUT (kparams()->out)
struct Ctx {
    LAS unsigned char* lds; unsigned char* ws; int tid, lane, wave, vcu, G, gw, NGW, bx;
};

constexpr float WIN8_SCALE = 64.f;
#ifndef FP8_SECS
#define FP8_SECS 0x00
#endif
constexpr int SEC_ORDER[8] = {0, 1, 3, 4, 2, 5, 6, 7};
constexpr int sec_slot(int ps) { int nb = 0, nf = 0; for (int i = 0; i < 8; ++i) { const int s_ = SEC_ORDER[i]; const bool f = (FP8_SECS >> s_) & 1; if (s_ == ps) return f ? (0x100 | nf) : nb; if (f) ++nf; else ++nb; } return 0; }
constexpr int N_SEC_F8 = __builtin_popcount(FP8_SECS), N_SEC_BF = 8 - N_SEC_F8;
constexpr unsigned secmap_of(bool f8) { unsigned m = 0; int k = 0; for (int i = 0; i < 8; ++i) { const int s_ = SEC_ORDER[i]; if ((((FP8_SECS >> s_) & 1) != 0) == f8) { m |= (unsigned)s_ << (4 * k); ++k; } } return m; }
DI int map_row(int kind, int n);
DI int map_row4(int n) { return map_row(1, n) & 0xffff; }
DI int map_row(int kind, int n) {
    if (kind == 0) return n;
    if (kind == 4) return map_row4(n);
    if (kind == 2) return 8 * (n >> 2) + (n & 3);
    if (kind == 3) return 8 * (n >> 2) + (n & 3) + 4;
    const int sec = n >> 9, j = n & 511;
    if (n >= 4096) return (1 << 16) | (N_SEC_F8 * 512 + (n - 4096));
    const int ps = sec == 0 ? 0 : sec == 1 ? 4 : sec == 2 ? 5 : sec == 3 ? 6 : sec == 4 ? 7 : sec == 5 ? 1 : sec == 6 ? 3 : 2;
    const int sl = sec_slot(ps); int jj = j;
    if (sec == 0 || sec == 1) { const int hs = j >> 6, d = j & 63; jj = hs * 64 + (d < 32 ? 2 * d : 2 * (d - 32) + 1); }
    return ((sl & 0x100) ? (1 << 16) : 0) | ((sl & 0xff) * 512 + jj);
}
constexpr int TP_PITCH = 68, TP_SCR = 64 * TP_PITCH * 4;
DI void transpose_load(const float* W, int ldw, int k0, int n0, LAS float* scr, int lane) {
    const int r = lane >> 4, c4 = (lane & 15) * 4; f32x4 v[16];
#pragma unroll
    for (int i = 0; i < 16; ++i) v[i] = *(const f32x4*)(W + (size_t)(k0 + 4 * i + r) * ldw + n0 + c4);
#pragma unroll
    for (int i = 0; i < 16; ++i) *(LAS f32x4*)(scr + (4 * i + r) * TP_PITCH + c4) = v[i];
    LDS_WAIT(); asm volatile("" ::: "memory");
}
DI void transpose_item(const float* W, int ldw, int k0, int n0, bf16_t* WT, int ldt, int kind, LAS float* scr, int lane) {
    transpose_load(W, ldw, k0, n0, scr, lane);
    bf16_t* dst = WT + (size_t)map_row(kind, n0 + lane) * ldt + k0;
#pragma unroll
    for (int j = 0; j < 8; ++j) { const LAS float* s = scr + (8 * j) * TP_PITCH + lane;
        u32x4 o; o.x = cvt_pk_bf16(s[0], s[TP_PITCH]); o.y = cvt_pk_bf16(s[2 * TP_PITCH], s[3 * TP_PITCH]); o.z = cvt_pk_bf16(s[4 * TP_PITCH], s[5 * TP_PITCH]); o.w = cvt_pk_bf16(s[6 * TP_PITCH], s[7 * TP_PITCH]);
        *(u32x4*)(dst + 8 * j) = o; }
    LDS_WAIT(); asm volatile("" ::: "memory");
}
DI void transpose_item8(const float* W, int ldw, int k0, int n0, unsigned char* WT, int ldt, int kind, float sc, LAS float* scr, int lane) {
    transpose_load(W, ldw, k0, n0, scr, lane);
    unsigned char* dst = WT + (size_t)map_row(kind, n0 + lane) * ldt + k0;
#pragma unroll
    for (int j = 0; j < 4; ++j) { const LAS float* s = scr + (16 * j) * TP_PITCH + lane; u32x4 o;
        o.x = pack_fp8x4(s[0] * sc, s[TP_PITCH] * sc, s[2 * TP_PITCH] * sc, s[3 * TP_PITCH] * sc); o.y = pack_fp8x4(s[4 * TP_PITCH] * sc, s[5 * TP_PITCH] * sc, s[6 * TP_PITCH] * sc, s[7 * TP_PITCH] * sc);
        o.z = pack_fp8x4(s[8 * TP_PITCH] * sc, s[9 * TP_PITCH] * sc, s[10 * TP_PITCH] * sc, s[11 * TP_PITCH] * sc); o.w = pack_fp8x4(s[12 * TP_PITCH] * sc, s[13 * TP_PITCH] * sc, s[14 * TP_PITCH] * sc, s[15 * TP_PITCH] * sc);
        *(u32x4*)(dst + 16 * j) = o; }
    LDS_WAIT(); asm volatile("" ::: "memory");
}
DI void transpose_matrix8(const Ctx& C, const float* W, int K, int N, unsigned char* WT, int ldt, int kind, float sc, int& itbase) {
    LAS float* scr = (LAS float*)(C.lds + C.wave * TP_SCR);
    const int nblk = N / 64, nit = (K / 64) * nblk;
    int first = (C.gw - (itbase % C.NGW) + C.NGW) % C.NGW;
    for (int it = first; it < nit; it += C.NGW) transpose_item8(W, N, 64 * (it / nblk), 64 * (it % nblk), WT, ldt, kind, sc, scr, C.lane);
    itbase += nit;
}
DI void transpose_matrix(const Ctx& C, const float* W, int K, int N, bf16_t* WT, int ldt, int kind, int& itbase, int total_unused) {
    (void)total_unused;
    LAS float* scr = (LAS float*)(C.lds + C.wave * TP_SCR);
    const int nblk = N / 64, nit = (K / 64) * nblk;
    int first = (C.gw - (itbase % C.NGW) + C.NGW) % C.NGW;
    for (int it = first; it < nit; it += C.NGW) transpose_item(W, N, 64 * (it / nblk), 64 * (it % nblk), WT, ldt, kind, scr, C.lane);
    itbase += nit;
}
DI void transpose_win(const Ctx& C, const float* W, bf16_t* WA, unsigned char* W8, int& itbase) {
    LAS float* scr = (LAS float*)(C.lds + C.wave * TP_SCR);
    const int nblk = DIN / 64, nit = (D / 64) * nblk;
    int first = (C.gw - (itbase % C.NGW) + C.NGW) % C.NGW;
    for (int it = first; it < nit; it += C.NGW) { const int k0 = 64 * (it / nblk), n0 = 64 * (it % nblk);
        if (map_row(1, n0) >> 16) transpose_item8(W, DIN, k0, n0, W8, D, 4, WIN8_SCALE, scr, C.lane);
        else transpose_item(W, DIN, k0, n0, WA, D, 1, scr, C.lane); }
    itbase += nit;
}
constexpr int MD_SP = 36;
DI void phase_mods(const Ctx& C) {
    if (C.bx >= 2 * 96) return;
    const int l = C.bx / 96, n0 = (C.bx % 96) * 64, kq = C.lane >> 4, cq = C.lane & 15;
    LAS float* S = (LAS float*)C.lds;
    const float* W = PIN(4) + (size_t)l * D * DIN + n0 + 4 * cq; const float* c0 = PIN(1); const float* cc = PIN(3);
    f32x4 acc[33];
#pragma unroll
    for (int r = 0; r < 33; ++r) acc[r] = (f32x4){0.f, 0.f, 0.f, 0.f};
#pragma unroll 1
    for (int kh = 0; kh < 2; ++kh) {
        __syncthreads();
        for (int i = C.tid; i < 33 * 512; i += 512) { const int r = i >> 9, kk = i & 511; S[kk * MD_SP + r] = fsilu(r < 32 ? c0[r * D + kh * 512 + kk] : cc[kh * 512 + kk]); }
        __syncthreads();
        const int kb = C.wave * 64 + kq;
#pragma unroll 1
        for (int ib = 0; ib < 16; ib += 8) { f32x4 w[8];
#pragma unroll
            for (int i = 0; i < 8; ++i) w[i] = *(const f32x4*)(W + (size_t)(kh * 512 + kb + 4 * (ib + i)) * DIN);
#pragma unroll
            for (int i = 0; i < 8; ++i) { const LAS float* sp = S + (kb + 4 * (ib + i)) * MD_SP;
#pragma unroll
                for (int q = 0; q < 8; ++q) { const f32x4 s4 = *(const LAS f32x4*)(sp + 4 * q);
                    acc[4 * q] += w[i] * s4[0]; acc[4 * q + 1] += w[i] * s4[1]; acc[4 * q + 2] += w[i] * s4[2]; acc[4 * q + 3] += w[i] * s4[3]; }
                acc[32] += w[i] * sp[32]; } }
    }
#pragma unroll
    for (int r = 0; r < 33; ++r)
#pragma unroll
        for (int j = 0; j < 4; ++j) { float v = acc[r][j]; v += __shfl_xor(v, 16); v += __shfl_xor(v, 32); asm volatile("" : "+v"(v)); acc[r][j] = v; }
    __syncthreads();
    LAS float* red = (LAS float*)C.lds;
    if (kq == 0) {
#pragma unroll
        for (int r = 0; r < 33; ++r) *(LAS f32x4*)(red + (C.wave * 33 + r) * 64 + 4 * cq) = acc[r]; }
    __syncthreads();
    float* mods = (float*)(C.ws + WS_MODS);
    for (int o = C.tid; o < 33 * 64; o += 512) { const int r = o >> 6, c = o & 63; float v = PIN(5)[l * DIN + n0 + c];
#pragma unroll
        for (int w8 = 0; w8 < 8; ++w8) v += red[(w8 * 33 + r) * 64 + c];
        mods[(size_t)(l * 33 + r) * DIN + n0 + c] = v; }
    __syncthreads();
}
DI void phase_prologue(const Ctx& C) {
    unsigned char* ws = C.ws;
    int itb = 0;
    for (int l = 0; l < 2; ++l) {
        transpose_win(C, PIN(8) + (size_t)l * D * DIN, (bf16_t*)(ws + WS_WIN) + (size_t)l * 4096 * D, ws + WS_WIN8 + (size_t)l * 4096 * D, itb);
        transpose_matrix(C, PIN(17) + (size_t)l * 512 * D, 512, D, (bf16_t*)(ws + WS_WUA) + (size_t)l * D * D, D, 0, itb, 0);
        transpose_matrix(C, PIN(18) + (size_t)l * 512 * D, 512, D, (bf16_t*)(ws + WS_WUA) + (size_t)l * D * D + 512, D, 0, itb, 0);
        transpose_matrix(C, PIN(19) + (size_t)l * D * D, D, D, (bf16_t*)(ws + WS_WO) + (size_t)l * D * D, D, 0, itb, 0);
    }
    transpose_matrix(C, PIN(20), D, DFF, (bf16_t*)(ws + WS_W13), D, 2, itb, 0);
    transpose_matrix(C, PIN(21), D, DFF, (bf16_t*)(ws + WS_W13), D, 3, itb, 0);
    transpose_matrix(C, PIN(22), DFF, D, (bf16_t*)(ws + WS_W2), DFFP, 0, itb, 0);
    { const int gt = C.vcu * 512 + C.tid, NT = C.G * 512;
      bf16_t* w13 = (bf16_t*)(ws + WS_W13) + (size_t)(2 * DFF) * D;
      for (int i = gt; i < (2 * DFFP - 2 * DFF) * D / 8; i += NT) ((u32x4*)w13)[i] = (u32x4){0u, 0u, 0u, 0u};
      bf16_t* w2 = (bf16_t*)(ws + WS_W2);
      for (int i = gt; i < D * (DFFP - DFF) / 8; i += NT) { const int r = i / ((DFFP - DFF) / 8), cc = i % ((DFFP - DFF) / 8); *(u32x4*)(w2 + (size_t)r * DFFP + DFF + cc * 8) = (u32x4){0u, 0u, 0u, 0u}; }
      float2* rope = (float2*)(ws + WS_ROPE);
      for (int i = gt; i < T * 32; i += NT) { const int t = i >> 5, pi = i & 31; const float invf = exp2f(-(float)(pi & 15) * (13.287712379549449f / 16.f));
          const float ang = (float)(pi < 16 ? (t >> 6) : (t & 63)) * invf; rope[i] = make_float2(cosf(ang), sinf(ang)); }
      float* lbs = (float*)(ws + WS_LBS);
      for (int i = gt; i < 2 * 2 * 512; i += NT) { const int l = i >> 10, dir = (i >> 9) & 1, d = i & 511; const float* lb = PIN(dir ? 16 : 15);
          const float p0 = lb[d], p1 = lb[512 + d]; lbs[i] = l == 0 ? 0.f : 1.f / (1.f + expf(p0 - p1)); }
    }
    phase_mods(C);
}
constexpr float W13_SCALE = 64.f, W2_SCALE = 128.f, HID_SCALE = 8.f;
DI void convert_moe_weights(const Ctx& C) {
    unsigned char* ws = C.ws; int itb = 0;
    for (int e = 0; e < NE; ++e) {
        transpose_matrix8(C, PIN(24) + (size_t)e * D * DFE, D, DFE, ws + WS_WM13 + (size_t)e * 2 * DFE * D, D, 2, W13_SCALE, itb);
        transpose_matrix8(C, PIN(25) + (size_t)e * D * DFE, D, DFE, ws + WS_WM13 + (size_t)e * 2 * DFE * D, D, 3, W13_SCALE, itb);
        transpose_matrix8(C, PIN(26) + (size_t)e * DFE * D, DFE, D, ws + WS_WM2 + (size_t)e * D * DFE, DFE, 0, W2_SCALE, itb);
    }
}

template <bool ROUTER>
DI void phase_norm(const Ctx& C, const float* xl, const float* xc, const float* nw, const float* mods, int shsel, int nrows, bf16_t* Hout, const float* rw, unsigned char* route, LAS int* cntL, unsigned char* H8 = nullptr) {
    int nloc = 0;
    f32x4 rwr[4][4][2];
    if (ROUTER) {
#pragma unroll
        for (int j = 0; j < 4; ++j)
#pragma unroll
            for (int q = 0; q < 4; ++q) { const float* rp = rw + (size_t)(256 * j + 4 * C.lane + q) * 8; rwr[j][q][0] = *(const f32x4*)rp; rwr[j][q][1] = *(const f32x4*)(rp + 4); } }
    for (int row0 = C.gw; row0 < nrows; row0 += 2 * C.NGW) {
        const int rows[2] = {row0, row0 + C.NGW}; const bool two = rows[1] < nrows;
        f32x4 v[2][4]; float ss[2] = {0.f, 0.f};
#pragma unroll
        for (int u = 0; u < 2; ++u) { const int row = (u == 1 && !two) ? rows[0] : rows[u]; const float* xr = row < NLAT ? xl + (size_t)row * D : xc + (size_t)(row - NLAT) * D;
#pragma unroll
            for (int j = 0; j < 4; ++j) { v[u][j] = *(const f32x4*)(xr + 256 * j + 4 * C.lane); ss[u] += (v[u][j][0] * v[u][j][0] + v[u][j][1] * v[u][j][1]) + (v[u][j][2] * v[u][j][2] + v[u][j][3] * v[u][j][3]); } }
#pragma unroll
        for (int u = 0; u < 2; ++u) { if (u == 1 && !two) break;
            const int row = rows[u]; const bool lat = row < NLAT;
            const float* mv = mods + (size_t)(lat ? (row >> 11) : 32) * DIN + shsel * D;
            const float rstd = 1.0f / sqrtf(wave_sum(ss[u]) * (1.f / D) + EPS);
            float lg[8];
            if (ROUTER) {
#pragma unroll
                for (int e = 0; e < 8; ++e) lg[e] = 0.f; }
#pragma unroll
            for (int j = 0; j < 4; ++j) { const int c0 = 256 * j + 4 * C.lane;
                const f32x4 w = *(const f32x4*)(nw + c0), sh = *(const f32x4*)(mv + c0), sc = *(const f32x4*)(mv + D + c0);
                f32x4 h = (v[u][j] * rstd) * w * (sc + 1.0f) + sh;
                if (ROUTER) *(unsigned*)((unsigned char*)Hout + (size_t)row * D + c0) = pack_fp8x4(h[0], h[1], h[2], h[3]);
                else { u32x2 o; o.x = cvt_pk_bf16(h[0], h[1]); o.y = cvt_pk_bf16(h[2], h[3]); *(u32x2*)(Hout + (size_t)row * D + c0) = o;
                       if (H8) *(unsigned*)(H8 + (size_t)row * D + c0) = pack_fp8x4(h[0], h[1], h[2], h[3]); }
                if (ROUTER) {
#pragma unroll
                    for (int q = 0; q < 4; ++q) { const f32x4 r0 = rwr[j][q][0], r1 = rwr[j][q][1];
                        lg[0] += h[q] * r0[0]; lg[1] += h[q] * r0[1]; lg[2] += h[q] * r0[2]; lg[3] += h[q] * r0[3]; lg[4] += h[q] * r1[0]; lg[5] += h[q] * r1[1]; lg[6] += h[q] * r1[2]; lg[7] += h[q] * r1[3]; } }
            }
            if (ROUTER) {
                const bool b5 = (C.lane & 32) != 0, b4 = (C.lane & 16) != 0, b3 = (C.lane & 8) != 0; float a4[4], a2[2], a1;
#pragma unroll
                for (int j = 0; j < 4; ++j) { const float snd = b5 ? lg[j] : lg[4 + j]; a4[j] = (b5 ? lg[4 + j] : lg[j]) + __shfl_xor(snd, 32); }
#pragma unroll
                for (int j = 0; j < 2; ++j) { const float snd = b4 ? a4[j] : a4[2 + j]; a2[j] = (b4 ? a4[2 + j] : a4[j]) + __shfl_xor(snd, 16); }
                { const float snd = b3 ? a2[0] : a2[1]; a1 = (b3 ? a2[1] : a2[0]) + __shfl_xor(snd, 8); }
                a1 += __shfl_xor(a1, 4); a1 += __shfl_xor(a1, 2); a1 += __shfl_xor(a1, 1);
                if ((C.lane & 7) == 0) ((LAS float*)(C.lds + C.wave * 4096))[nloc * 8 + (C.lane >> 3)] = a1;
                ++nloc;
            }
        }
    }
    if (ROUTER) {
        LDS_WAIT();
        for (int i = C.lane; i < nloc; i += 64) { const int row = C.gw + i * C.NGW; const LAS float* lp = (const LAS float*)(C.lds + C.wave * 4096) + i * 8;
            float lg[8];
#pragma unroll
            for (int e = 0; e < 8; ++e) lg[e] = lp[e];
            int e1 = 0; float l1 = lg[0];
#pragma unroll
            for (int e = 1; e < 8; ++e) if (lg[e] > l1) { l1 = lg[e]; e1 = e; }
            int e2 = -1; float l2 = -INFINITY;
#pragma unroll
            for (int e = 0; e < 8; ++e) if (e != e1 && lg[e] > l2) { l2 = lg[e]; e2 = e; }
            const float g2 = 1.f / (1.f + expf(l1 - l2)), g1 = 1.f - g2;
            int* rt = (int*)(route + (size_t)row * 24); rt[0] = e1; rt[1] = e2; ((float*)rt)[2] = g1; ((float*)rt)[3] = g2;
            atomicAdd((int*)&cntL[e1], 1); atomicAdd((int*)&cntL[e2], 1);
        }
    }
}

constexpr int AT_XCH = 65536;
DI float max3f(float a, float b, float c) { return fmaxf(fmaxf(a, b), c); }
DI float xhalf(float v, int hi) {
    const auto rr = __builtin_amdgcn_permlane32_swap(__float_as_uint(v), __float_as_uint(v), false, false);
    return __uint_as_float(hi ? rr[0] : rr[1]);
}
constexpr float AT_THR = 8.f;
DI void attn_unit(const Ctx& C, bf16_t* P, int qrow0, int krow_ctx, int krow_lat, int nkt, int h, float lam, const float* anw, float post) {
    const int tid_ = my_tid();
    LAS unsigned char* lds = C.lds; const int lane = tid_ & 63, wid = __builtin_amdgcn_readfirstlane(tid_ >> 6), sub = wid >> 2, qw = wid & 3, r32 = lane & 31, hh = lane >> 5;
    const int tq = (lane & 15) >> 2, tp = lane & 3, blk = (lane >> 4) & 1;
    LAS unsigned char* qlds = lds + AT_XCH + wid * 8192 + r32 * 16;
#pragma unroll
    for (int qb = 0; qb < 2; ++qb) { const bf16_t* qp = P + (size_t)(qrow0 + 64 * qw + 32 * qb + r32) * PW + PC_Q + h * 128 + sub * 64 + 8 * hh;
#pragma unroll
      for (int ks = 0; ks < 4; ++ks) *(LAS bf16x8*)(qlds + ((2 * ks + hh) * 64 + 32 * qb) * 16) = *(const bf16x8*)(qp + 16 * ks); }
    f32x16 O[2][4];
#pragma unroll
    for (int qb = 0; qb < 2; ++qb)
#pragma unroll
        for (int c = 0; c < 4; ++c)
#pragma unroll
            for (int i = 0; i < 16; ++i) O[qb][c][i] = 0.f;
    float m_run[2] = {-INFINITY, -INFINITY}, l_run[2] = {0.f, 0.f};
#define AT_ISSUE(kt, buf) do { const int kr0_ = (kt) < 4 ? krow_ctx + (kt) * 64 : krow_lat + ((kt) - 4) * 64; LAS unsigned char* bb_ = lds + (buf) * 32768; \
        _Pragma("unroll") for (int j_ = 0; j_ < 2; ++j_) { const int c_ = 2 * wid + j_; \
            dma16(P + (size_t)(kr0_ + lane) * PW + PC_K + h * 128 + c_ * 8, bb_ + c_ * 1024); \
            dma16(P + (size_t)(kr0_ + 16 * (c_ & 3) + (lane >> 2)) * PW + PC_V + h * 128 + (c_ >> 2) * 32 + (lane & 3) * 8, bb_ + 16384 + c_ * 1024); } } while (0)
    AT_ISSUE(0, 0);
    int buf = 0;
#pragma unroll 1
    for (int kt = 0; kt < nkt; ++kt) {
        VM_WAIT(); __syncthreads();
        if (kt + 1 < nkt) AT_ISSUE(kt + 1, buf ^ 1);
        const LAS unsigned char* kb = lds + buf * 32768, * vb = kb + 16384 + (4 * hh + tq) * 64 + blk * 32 + tp * 8;
        bf16x8 Pf[2][4];
#pragma unroll
        for (int qb = 0; qb < 2; ++qb) {
            f32x16 s0, s1;
#pragma unroll
            for (int i = 0; i < 16; ++i) { s0[i] = 0.f; s1[i] = 0.f; }
#pragma unroll
            for (int ks = 0; ks < 4; ++ks) { const LAS unsigned char* kp = kb + ((sub * 8 + 2 * ks + hh) * 64 + r32) * 16;
                const bf16x8 k0 = *(const LAS bf16x8*)kp, k1 = *(const LAS bf16x8*)(kp + 512);
                const bf16x8 q = *(const LAS bf16x8*)(qlds + ((2 * ks + hh) * 64 + 32 * qb) * 16);
                s0 = MFMA32(k0, q, s0); s1 = MFMA32(k1, q, s1); }
            float mx = max3f(s0[0], s1[0], s0[1]);
#pragma unroll
            for (int i = 1; i < 16; ++i) mx = (i + 1 < 16) ? max3f(mx, s1[i], s0[i + 1]) : fmaxf(mx, s1[i]);
            mx = fmaxf(mx, xhalf(mx, hh));
            const float mnew = fmaxf(m_run[qb], mx);
            if (__any(mx > m_run[qb] + AT_THR)) { const float alpha = __builtin_amdgcn_exp2f(m_run[qb] - mnew); l_run[qb] *= alpha;
#pragma unroll
                for (int c = 0; c < 4; ++c)
#pragma unroll
                    for (int i = 0; i < 16; ++i) O[qb][c][i] *= alpha;
                m_run[qb] = mnew; }
            const float mr = m_run[qb]; float ps0 = 0.f, ps1 = 0.f;
#pragma unroll
            for (int i = 0; i < 16; ++i) { s0[i] = __builtin_amdgcn_exp2f(s0[i] - mr); s1[i] = __builtin_amdgcn_exp2f(s1[i] - mr); ps0 += s0[i]; ps1 += s1[i]; }
            l_run[qb] += ps0 + ps1;
            Pf[qb][0] = packf8(s0, 0); Pf[qb][1] = packf8(s0, 1); Pf[qb][2] = packf8(s1, 0); Pf[qb][3] = packf8(s1, 1);
        }
#pragma unroll
        for (int cb = 0; cb < 4; ++cb) {
#pragma unroll
            for (int s4 = 0; s4 < 4; ++s4) { const bf16x8 a = cat8(tr16(vb + cb * 4096 + s4 * 1024), tr16(vb + cb * 4096 + s4 * 1024 + 512));
                O[0][cb] = MFMA32(a, Pf[0][s4], O[0][cb]); O[1][cb] = MFMA32(a, Pf[1][s4], O[1][cb]); } }
        buf ^= 1;
    }
#undef AT_ISSUE
    LDS_WAIT(); __syncthreads();
    const int te = my_tid(); const int lane_e = te & 63, wid_e = __builtin_amdgcn_readfirstlane(te >> 6);
    LAS float* xch = (LAS float*)(lds + AT_XCH) + (wid_e & 3) * 4096 + lane_e;
#pragma unroll
    for (int qb = 0; qb < 2; ++qb) {
        const float lt = l_run[qb] + xhalf(l_run[qb], lane_e >> 5); const float inv = 1.f / lt;
        if ((wid_e >> 2) == 1) { const float sc = -lam * inv;
#pragma unroll
            for (int c = 0; c < 4; ++c)
#pragma unroll
                for (int i = 0; i < 16; ++i) xch[(c * 16 + i) * 64] = O[qb][c][i] * sc; }
        LDS_WAIT(); __syncthreads();
        if ((wid_e >> 2) == 0) {
            float ss = 0.f;
#pragma unroll
            for (int c = 0; c < 4; ++c)
#pragma unroll
                for (int i = 0; i < 16; ++i) { const float o = O[qb][c][i] * inv + xch[(c * 16 + i) * 64]; O[qb][c][i] = o; ss += o * o; }
            ss += xhalf(ss, lane_e >> 5);
            const float rs = post / sqrtf(ss * (1.f / 128.f) + EPS);
            bf16_t* op = P + (size_t)(qrow0 + 64 * (wid_e & 3) + 32 * qb + (lane_e & 31)) * PW + PC_Q + h * 128;
#pragma unroll
            for (int c = 0; c < 4; ++c)
#pragma unroll
                for (int g = 0; g < 4; ++g) { const int v0 = 32 * c + 8 * g + 4 * (lane_e >> 5); const f32x4 w = *(const f32x4*)(anw + v0);
                    u32x2 o; o.x = cvt_pk_bf16(O[qb][c][4 * g] * rs * w[0], O[qb][c][4 * g + 1] * rs * w[1]); o.y = cvt_pk_bf16(O[qb][c][4 * g + 2] * rs * w[2], O[qb][c][4 * g + 3] * rs * w[3]);
                    *(u32x2*)(op + v0) = o; }
        }
        LDS_WAIT(); __syncthreads();
    }
}

constexpr int SC_Q = 0, SC_LF = 16384, SC_V0 = 32768, SC_QM = 65536, SC_KMR = 81920, SC_KMS = 98304, SC_SX = 114688, SC_A31 = 147456, SC_A63 = 147968, SC_END = 148480;
DI void scan_chain(const Ctx& C, bf16_t* P, int b, int h, int dir, bool store_ctx) {
    const int tid_ = my_tid();
    LAS unsigned char* lds = C.lds; const int lane = tid_ & 63, wid = __builtin_amdgcn_readfirstlane(tid_ >> 6), r32 = lane & 31, hh = lane >> 5;
    const int tq = (lane & 15) >> 2, tp = lane & 3, blk = (lane >> 4) & 1;
    const int db = wid & 3, tb = wid >> 2;
    const int base_nat = hh * 512 + tq * 64 + blk * 32 + tp * 8;
    const int base_prm = (4 * hh + tq) * 64 + blk * 32 + tp * 8;
    const int lfcol = (dir ? PC_LB : PC_LF) + h * 128, qcol = PC_RQ + h * 128, vcol = PC_RI + h * 128;
    f32x16 ST[2];
#pragma unroll
    for (int j = 0; j < 2; ++j)
#pragma unroll
        for (int i = 0; i < 16; ++i) ST[j][i] = 0.f;
#define SROW(c, i) ((c) < 4 ? NLAT + b * CL + (dir ? 255 - ((c) * 64 + (i)) : (c) * 64 + (i)) : b * T + (dir ? 2047 - (((c) - 4) * 64 + (i)) : ((c) - 4) * 64 + (i)))
#define SDMA(c, colbase, dstoff) do { _Pragma("unroll") for (int j_ = 0; j_ < 2; ++j_) { const int I_ = 2 * wid + j_; const int ti_ = 16 * (I_ & 3) + (lane >> 2); \
        dma16(P + (size_t)SROW(c, ti_) * PW + (colbase) + (I_ >> 2) * 32 + (lane & 3) * 8, lds + (dstoff) + I_ * 1024); } } while (0)
    SDMA(0, qcol, SC_Q); SDMA(0, lfcol, SC_LF); SDMA(0, vcol, SC_V0);
    int vbuf = 0;
    const int t = 32 * tb + r32;
#pragma unroll 1
    for (int c = 0; c < 36; ++c) {
        VM_WAIT(); __syncthreads();
        const LAS unsigned char* Vimg = lds + SC_V0 + vbuf * 16384;
        f32x16 cm;
#pragma unroll
        for (int i = 0; i < 16; ++i) cm[i] = 0.f;
#pragma unroll
        for (int kk = 0; kk < 2; ++kk) { const int ks = 2 * tb + kk;
            const half8 a = __builtin_bit_cast(half8, cat8(tr16(lds + SC_LF + db * 4096 + base_nat + ks * 1024), tr16(lds + SC_LF + db * 4096 + base_nat + ks * 1024 + 256)));
            half8 bm;
#pragma unroll
            for (int j = 0; j < 8; ++j) { const int s = 16 * ks + 8 * hh + j; bm[j] = tb == 0 ? (s > t ? (_Float16)-1.f : (_Float16)0.f) : (s <= t ? (_Float16)1.f : (_Float16)0.f); }
            cm = __builtin_amdgcn_mfma_f32_32x32x16_f16(a, bm, cm, 0, 0, 0); }
#pragma unroll
        for (int g = 0; g < 4; ++g) {
            const int sa = db * 4096 + (t >> 3) * 512 + (t & 7) * 64 + (8 * g + 4 * hh) * 2;
            const u32x2 q4 = *(const LAS u32x2*)(lds + SC_Q + sa); const half4 lf4 = *(const LAS half4*)(lds + SC_LF + sa);
            const float qv[4] = {bflo(q4.x), bfhi(q4.x), bflo(q4.y), bfhi(q4.y)};
            float qm[4], km[4];
#pragma unroll
            for (int e = 0; e < 4; ++e) { const float cv = cm[4 * g + e] * LOG2E; const float E = __builtin_amdgcn_exp2f(cv), Ei = __builtin_amdgcn_exp2f(-cv);
                const float lf = (float)lf4[e]; qm[e] = qv[e] * E; km[e] = (1.f - __builtin_amdgcn_exp2f(lf * LOG2E)) * Ei;
                if (tb == 0 && r32 == 0) ((LAS float*)(lds + SC_A31))[32 * db + 8 * g + 4 * hh + e] = lf - cm[4 * g + e];
                if (tb == 1 && r32 == 31) ((LAS float*)(lds + SC_A63))[32 * db + 8 * g + 4 * hh + e] = cm[4 * g + e]; }
            u32x2 qw2, kw2; qw2.x = cvt_pk_bf16(qm[0], qm[1]); qw2.y = cvt_pk_bf16(qm[2], qm[3]); kw2.x = cvt_pk_bf16(km[0], km[1]); kw2.y = cvt_pk_bf16(km[2], km[3]);
            const int ra = ((4 * db + g) * 64 + t) * 16 + 8 * hh;
            *(LAS u32x2*)(lds + SC_QM + ra) = qw2; *(LAS u32x2*)(lds + SC_KMR + ra) = kw2; *(LAS u32x2*)(lds + SC_KMS + sa) = kw2;
        }
        LDS_WAIT(); __syncthreads();
        if (c + 1 < 36) { SDMA(c + 1, qcol, SC_Q); SDMA(c + 1, lfcol, SC_LF); SDMA(c + 1, vcol, SC_V0 + (vbuf ^ 1) * 16384); }
        { const int d = 32 * db + r32; const float c31 = ((LAS float*)(lds + SC_A31))[d], c63 = ((LAS float*)(lds + SC_A63))[d];
          const float e31 = __expf(c31), dec = __expf(c31 + c63), e63 = __expf(c63);
          f32x16 SN[2];
#pragma unroll
          for (int j = 0; j < 2; ++j) { const int vb2 = 2 * tb + j;
#pragma unroll
              for (int g = 0; g < 4; ++g) { u32x2 w; w.x = cvt_pk_bf16(ST[j][4 * g] * e31, ST[j][4 * g + 1] * e31); w.y = cvt_pk_bf16(ST[j][4 * g + 2] * e31, ST[j][4 * g + 3] * e31);
                  *(LAS u32x2*)(lds + SC_SX + vb2 * 8192 + (d >> 3) * 512 + (d & 7) * 64 + (8 * g + 4 * hh) * 2) = w; }
#pragma unroll
              for (int i = 0; i < 16; ++i) SN[j][i] = 0.f; }
#pragma unroll
          for (int ks = 0; ks < 4; ++ks) {
              const bf16x8 kf = cat8(tr16(lds + SC_KMS + db * 4096 + base_nat + ks * 1024), tr16(lds + SC_KMS + db * 4096 + base_nat + ks * 1024 + 256));
#pragma unroll
              for (int j = 0; j < 2; ++j) { const int vb2 = 2 * tb + j;
                  const bf16x8 vf = cat8(tr16(Vimg + vb2 * 4096 + base_nat + ks * 1024), tr16(Vimg + vb2 * 4096 + base_nat + ks * 1024 + 256));
                  SN[j] = MFMA32(vf, kf, SN[j]); } }
#pragma unroll
          for (int j = 0; j < 2; ++j)
#pragma unroll
              for (int i = 0; i < 16; ++i) ST[j][i] = dec * ST[j][i] + e63 * SN[j][i];
        }
        LDS_WAIT(); __syncthreads();
        { bf16x8 Qmf[8];
#pragma unroll
          for (int kd = 0; kd < 8; ++kd) Qmf[kd] = *(const LAS bf16x8*)(lds + SC_QM + ((2 * kd + hh) * 64 + t) * 16);
          f32x16 o;
#pragma unroll
          for (int i = 0; i < 16; ++i) o[i] = 0.f;
          for (int sb = 0; sb <= tb; ++sb) {
              f32x16 pt;
#pragma unroll
              for (int i = 0; i < 16; ++i) pt[i] = 0.f;
#pragma unroll
              for (int kd = 0; kd < 8; ++kd) { const bf16x8 a = *(const LAS bf16x8*)(lds + SC_KMR + ((2 * kd + hh) * 64 + 32 * sb + r32) * 16); pt = MFMA32(a, Qmf[kd], pt); }
              if (sb == tb) {
#pragma unroll
                  for (int i = 0; i < 16; ++i) if (crow(i, hh) > r32) pt[i] = 0.f; }
              const bf16x8 p0 = packf8(pt, 0), p1 = packf8(pt, 1);
              { const bf16x8 a = cat8(tr16(Vimg + db * 4096 + base_prm + (2 * sb) * 1024), tr16(Vimg + db * 4096 + base_prm + (2 * sb) * 1024 + 512)); o = MFMA32(a, p0, o); }
              { const bf16x8 a = cat8(tr16(Vimg + db * 4096 + base_prm + (2 * sb + 1) * 1024), tr16(Vimg + db * 4096 + base_prm + (2 * sb + 1) * 1024 + 512)); o = MFMA32(a, p1, o); }
          }
#pragma unroll
          for (int kd = 0; kd < 8; ++kd) { const bf16x8 a = cat8(tr16(lds + SC_SX + db * 8192 + base_nat + kd * 1024), tr16(lds + SC_SX + db * 8192 + base_nat + kd * 1024 + 256)); o = MFMA32(a, Qmf[kd], o); }
          if (c >= 4 || store_ctx) { bf16_t* op = P + (size_t)SROW(c, t) * PW + lfcol + 32 * db;
#pragma unroll
              for (int g = 0; g < 4; ++g) { u32x2 w; w.x = cvt_pk_bf16(o[4 * g], o[4 * g + 1]); w.y = cvt_pk_bf16(o[4 * g + 2], o[4 * g + 3]); *(u32x2*)(op + 8 * g + 4 * hh) = w; } }
        }
        vbuf ^= 1;
    }
    VM_WAIT(); LDS_WAIT(); __syncthreads();
#undef SROW
#undef SDMA
}

DI void phase_recprep(const Ctx& C, bf16_t* P, const float* rnw, int nrows) {
    for (int row = C.gw; row < nrows; row += C.NGW) {
        bf16_t* pr = P + (size_t)row * PW + 8 * C.lane;
        float a[8], bb[8], g[8]; unpack8(*(const u32x4*)(pr + PC_LF), a); unpack8(*(const u32x4*)(pr + PC_LB), bb); unpack8(*(const u32x4*)(pr + PC_G), g);
        float ss = 0.f;
#pragma unroll
        for (int j = 0; j < 8; ++j) { a[j] += bb[j]; ss += a[j] * a[j]; }
        ss += __shfl_xor(ss, 1); ss += __shfl_xor(ss, 2); ss += __shfl_xor(ss, 4); ss += __shfl_xor(ss, 8);
        const float rs = 1.0f / sqrtf(ss * (1.f / 128.f) + EPS);
        const f32x4 w0 = *(const f32x4*)(rnw + ((8 * C.lane) & 127)), w1 = *(const f32x4*)(rnw + ((8 * C.lane) & 127) + 4);
        f32x4 o0, o1;
#pragma unroll
        for (int j = 0; j < 4; ++j) { o0[j] = a[j] * rs * w0[j] * g[j]; o1[j] = a[4 + j] * rs * w1[j] * g[4 + j]; }
        *(u32x4*)(pr + PC_LF) = pack8(o0, o1);
    }
}

DI void phase_slots(const Ctx& C, const int* cnt, int* pbout, unsigned char* route, const bf16_t* H2, bf16_t* AG, LAS int* cur) {
    if (C.tid < 16) cur[C.tid] = 0;
    __syncthreads();
    for (int g = C.tid; g < C.G; g += 512) {
#pragma unroll
        for (int k = 0; k < 8; ++k) { const int c = cnt[g * 8 + k]; atomicAdd((int*)&cur[8 + k], c); if (g < C.bx) atomicAdd((int*)&cur[k], c); } }
    __syncthreads();
    if (C.tid < 8) { const int e = C.tid; int pb = 0, pbe = 0;
#pragma unroll
        for (int k = 0; k < 8; ++k) { if (k == e) pbe = pb; pb += (cur[8 + k] + 255) >> 8; }
        const int mine = cur[e];
        if (C.bx == 0) { pbout[e] = pbe; if (e == 7) pbout[8] = pb; }
        cur[e] = pbe * 256 + mine;
    }
    __syncthreads();
    const int nloc = (NLAT - C.gw + C.NGW - 1) / C.NGW;
    LAS int* tab = (LAS int*)(C.lds + C.wave * 2048);
    for (int i = C.lane; i < nloc; i += 64) { int* rt = (int*)(route + (size_t)(C.gw + i * C.NGW) * 24);
        const int s1 = atomicAdd((int*)&cur[rt[0]], 1), s2 = atomicAdd((int*)&cur[rt[1]], 1); rt[4] = s1; rt[5] = s2; tab[2 * i] = s1; tab[2 * i + 1] = s2; }
    LDS_WAIT();
    for (int i = 0; i < nloc; i += 2) { const int i1 = i + 1 < nloc ? i + 1 : i;
        const int sa1 = __builtin_amdgcn_readfirstlane(tab[2 * i]), sa2 = __builtin_amdgcn_readfirstlane(tab[2 * i + 1]), sb1 = __builtin_amdgcn_readfirstlane(tab[2 * i1]), sb2 = __builtin_amdgcn_readfirstlane(tab[2 * i1 + 1]);
        const u32x4 va = *((const u32x4*)((const unsigned char*)H2 + (size_t)(C.gw + i * C.NGW) * D) + C.lane);
        const u32x4 vb = *((const u32x4*)((const unsigned char*)H2 + (size_t)(C.gw + i1 * C.NGW) * D) + C.lane);
        *((u32x4*)((unsigned char*)AG + (size_t)sa1 * D) + C.lane) = va; *((u32x4*)((unsigned char*)AG + (size_t)sa2 * D) + C.lane) = va;
        *((u32x4*)((unsigned char*)AG + (size_t)sb1 * D) + C.lane) = vb; *((u32x4*)((unsigned char*)AG + (size_t)sb2 * D) + C.lane) = vb;
    }
}
DI void phase_final(const Ctx& C, float* x, const unsigned char* route, const bf16_t* Y, const float* mods1, const float* fw) {
    for (int row0 = C.gw; row0 < NLAT; row0 += 2 * C.NGW) {
        const int rows[2] = {row0, row0 + C.NGW < NLAT ? row0 + C.NGW : row0};
        f32x4 v[2][4]; float ss[2] = {0.f, 0.f};
#pragma unroll
        for (int u = 0; u < 2; ++u) { const int row = rows[u];
            const int* rt = (const int*)(route + (size_t)row * 24); const float g1 = ((const float*)rt)[2], g2 = ((const float*)rt)[3]; const int s1 = rt[4], s2 = rt[5];
            const float* mv = mods1 + (size_t)(row >> 11) * DIN + 5 * D; const float* xr = x + (size_t)row * D;
#pragma unroll
            for (int j = 0; j < 4; ++j) { const int c0 = 256 * j + 4 * C.lane;
                const u32x2 y1 = *(const u32x2*)(Y + (size_t)s1 * D + c0), y2 = *(const u32x2*)(Y + (size_t)s2 * D + c0); const f32x4 m5 = *(const f32x4*)(mv + c0);
                f32x4 y; y[0] = g1 * bflo(y1.x) + g2 * bflo(y2.x); y[1] = g1 * bfhi(y1.x) + g2 * bfhi(y2.x); y[2] = g1 * bflo(y1.y) + g2 * bflo(y2.y); y[3] = g1 * bfhi(y1.y) + g2 * bfhi(y2.y);
                v[u][j] = *(const f32x4*)(xr + c0) + m5 * y; ss[u] += (v[u][j][0] * v[u][j][0] + v[u][j][1] * v[u][j][1]) + (v[u][j][2] * v[u][j][2] + v[u][j][3] * v[u][j][3]); } }
#pragma unroll
        for (int u = 0; u < 2; ++u) { if (u == 1 && rows[1] == rows[0]) break;
            const float rstd = 1.0f / sqrtf(wave_sum(ss[u]) * (1.f / D) + EPS); float* xr = x + (size_t)rows[u] * D;
#pragma unroll
            for (int j = 0; j < 4; ++j) { const int c0 = 256 * j + 4 * C.lane; *(f32x4*)(xr + c0) = v[u][j] * rstd * *(const f32x4*)(fw + c0); } }
    }
}

constexpr int LDS_MISC = SC_END;
constexpr int LDS_BYTES = SC_END + 512;
static_assert(LDS_WTAB_OFF == SC_END + 128, "wave table sits behind the barrier words and counters");
constexpr int NPHASE = 20;

DI Ctx make_ctx() {
    extern __shared__ __attribute__((aligned(16))) unsigned char lds_raw[];
    Ctx C; const int t = my_tid();
    unsigned lb = (unsigned)(size_t)(LAS unsigned char*)lds_raw; asm volatile("" : "+s"(lb));
    C.lds = (LAS unsigned char*)(size_t)lb; C.ws = kparams()->ws; C.tid = t; C.lane = t & 63; C.wave = __builtin_amdgcn_readfirstlane(t >> 6);
    int bx = blockIdx.x, G = gridDim.x; asm volatile("" : "+s"(bx), "+s"(G));
    C.bx = bx; C.G = G; C.vcu = (C.G % 8 == 0) ? (bx % 8) * (C.G / 8) + bx / 8 : bx;
    C.gw = C.vcu * 8 + C.wave; C.NGW = C.G * 8;
    return C;
}
DI void grid_barrier() {
    extern __shared__ __attribute__((aligned(16))) unsigned char lds_raw[];
    XcdBarrier b; b.bar = (unsigned*)(kparams()->ws + WS_CTL) + CW_BAR + kparams()->li * XCD_BAR_WORDS; b.x = xb_xcc_id(); b.st = (volatile LAS unsigned*)((LAS unsigned char*)lds_raw + LDS_MISC);
    xcd_barrier(b);
}
#define WSP(T, off) ((T*)(kparams()->ws + (off)))

#define IN(k) (kparams()->ph_lo <= (k) && (k) < kparams()->ph_hi)
#define SEAM(k) do { if (IN(k) && IN((k) + 1)) grid_barrier(); } while (0)


template <int l> DI void layer_phases() {
        const int pb = 1 + 9 * l;
#define LQ() int lq = l; asm volatile("" : "+s"(lq))
#define XL (lq == 0 ? PIN(0) : (const float*)POUT)
#define XC (lq == 0 ? PIN(2) : (const float*)WSP(float, WS_CTXRES))
#define LMODS (WSP(float, WS_MODS) + (size_t)lq * 33 * DIN)
#define NROWS_OUT (lq == 0 ? NTOK : NLAT)
        if (IN(pb + 0)) { LQ(); const Ctx C = make_ctx(); phase_norm<false>(C, XL, XC, PIN(6) + lq * D, LMODS, 0, NTOK, WSP(bf16_t, WS_H), nullptr, nullptr, nullptr, WSP(unsigned char, WS_H8)); }
        SEAM(pb + 0);
        if (IN(pb + 1)) { LQ();
            { const Ctx C = make_ctx();
              Gemm g{WSP(bf16_t, WS_H), WSP(bf16_t, WS_WIN) + (size_t)lq * 4096 * D, NTOK, N_SEC_BF * 512, D, D};
              pg8::StaticOrder S; S.init(g, C.G, C.bx);
              EpiInProj E{WSP(bf16_t, WS_P), WSP(float2, WS_ROPE), WSP(float, WS_LBS) + lq * 1024, WSP(float, WS_LBS) + lq * 1024 + 512, (int)secmap_of(false), 1.f};
              pg8::gemm_phase<EpiInProj, pg8::StaticOrder>(C.lds, g, S, E); }
            if (N_SEC_F8 > 0) { const Ctx C = make_ctx();
              Gemm g{WSP(bf16_t, WS_H8), (const bf16_t*)(WSP(unsigned char, WS_WIN8) + (size_t)lq * 4096 * D), NTOK, N_SEC_F8 * 512, D / 2, D / 2};
              pg8::StaticOrder S; S.init(g, C.G, C.bx);
              EpiInProj E{WSP(bf16_t, WS_P), WSP(float2, WS_ROPE), WSP(float, WS_LBS) + lq * 1024, WSP(float, WS_LBS) + lq * 1024 + 512, (int)secmap_of(true), 1.f / WIN8_SCALE};
              pg8::gemm_phase<EpiInProj, pg8::StaticOrder, true, true>(C.lds, g, S, E); }
        }
        SEAM(pb + 1);
        if (IN(pb + 2)) { LQ(); const Ctx C = make_ctx(); bf16_t* const Pb = WSP(bf16_t, WS_P);
            for (int id = C.vcu; id < NB * 4 * 2; id += C.G) scan_chain(C, Pb, id >> 3, (id >> 1) & 3, id & 1, lq == 0);
            float lam;
            { const float a = wave_sum(PIN(9)[lq * 64 + C.lane] * PIN(10)[lq * 64 + C.lane]), b2 = wave_sum(PIN(11)[lq * 64 + C.lane] * PIN(12)[lq * 64 + C.lane]);
              const float li = 0.8f - 0.6f * expf(-0.3f * (float)lq); lam = expf(a) - expf(b2) + li; lam = __uint_as_float(__builtin_amdgcn_readfirstlane(__float_as_uint(lam))); }
            const float post = __uint_as_float(__builtin_amdgcn_readfirstlane(__float_as_uint(1.f - (0.8f - 0.6f * expf(-0.3f * (float)lq)))));
            const float* anw = PIN(13) + lq * 128;
            const int NU = NB * 4 * 8, U = (NU + C.G - 1) / C.G;
            for (int id = C.vcu * U; id < NU && id < (C.vcu + 1) * U; ++id) { const int bh = id >> 3, qb = id & 7, b = bh >> 2, h = bh & 3;
                attn_unit(C, Pb, b * T + qb * 256, NLAT + b * CL, b * T, 36, h, lam, anw, post); }
            if (lq == 0) for (int id = C.vcu; id < NB * 4; id += C.G) { const int b = id >> 2, h = id & 3;
                attn_unit(C, Pb, NLAT + b * CL, NLAT + b * CL, 0, 4, h, lam, anw, post); }
        }
        SEAM(pb + 2);
        if (IN(pb + 3)) { LQ(); const Ctx C = make_ctx();
            phase_recprep(C, WSP(bf16_t, WS_P), PIN(14) + lq * 128, NROWS_OUT);
            Gemm g{WSP(bf16_t, WS_H8), (const bf16_t*)(WSP(unsigned char, WS_WIN8) + ((size_t)lq * 4096 + N_SEC_F8 * 512) * D), NROWS_OUT, 2048, D / 2, D / 2};
            pg8::StaticOrder S; S.init(g, C.G, C.bx);
            EpiGates E{WSP(bf16_t, WS_P), 1.f / WIN8_SCALE};
            pg8::gemm_phase<EpiGates, pg8::StaticOrder, true, true>(C.lds, g, S, E);
        }
        SEAM(pb + 3);
        if (IN(pb + 4)) { LQ(); const Ctx C = make_ctx();
            Gemm g{WSP(bf16_t, WS_P) + PC_Q, WSP(bf16_t, WS_WUA) + (size_t)lq * D * D, NROWS_OUT, D, D, PW};
            pg8::StaticOrder S; S.init(g, C.G, C.bx); EpiMergeFused E{WSP(bf16_t, WS_P), WSP(bf16_t, WS_MERGED)};
            pg8::gemm_phase<EpiMergeFused, pg8::StaticOrder, true, false, true>(C.lds, g, S, E);
        }
        SEAM(pb + 4);
        if (IN(pb + 5)) { LQ(); const Ctx C = make_ctx();
            Gemm g{WSP(bf16_t, WS_MERGED), WSP(bf16_t, WS_WO) + (size_t)lq * D * D, NROWS_OUT, D, D, D};
            pg8::StaticOrder S; S.init(g, C.G, C.bx);
            EpiResid E{XL, XC, POUT, WSP(float, WS_CTXRES), LMODS, 2};
            pg8::gemm_phase<EpiResid, pg8::StaticOrder>(C.lds, g, S, E);
        }
        SEAM(pb + 5);
        if (l == 0) {
            if (IN(7)) { LQ(); const Ctx C = make_ctx(); phase_norm<false>(C, POUT, WSP(float, WS_CTXRES), PIN(7), LMODS, 3, NTOK, WSP(bf16_t, WS_H), nullptr, nullptr, nullptr); }
            SEAM(7);
            if (IN(8)) { LQ(); const Ctx C = make_ctx();
                Gemm g{WSP(bf16_t, WS_H), WSP(bf16_t, WS_W13), NTOK, 2 * DFFP, D, D};
                pg8::StaticOrder S; S.init(g, C.G, C.bx); EpiSwiglu E{WSP(bf16_t, WS_HID), DFFP, 0};
                pg8::gemm_phase<EpiSwiglu, pg8::StaticOrder>(C.lds, g, S, E);
            }
            SEAM(8);
            if (IN(9)) { LQ(); const Ctx C = make_ctx();
                Gemm g{WSP(bf16_t, WS_HID), WSP(bf16_t, WS_W2), NTOK, D, DFFP, DFFP};
                pg8::StaticOrder S; S.init(g, C.G, C.bx); EpiResid E{POUT, WSP(float, WS_CTXRES), POUT, WSP(float, WS_CTXRES), LMODS, 5};
                pg8::gemm_phase<EpiResid, pg8::StaticOrder>(C.lds, g, S, E);
            }
            SEAM(9);
        } else {
            if (IN(16)) { LQ(); const Ctx C = make_ctx(); LAS int* lcnt = (LAS int*)(C.lds + LDS_MISC + 32);
                if (C.tid < 8) lcnt[C.tid] = 0;
                __syncthreads();
                phase_norm<true>(C, POUT, nullptr, PIN(7) + D, LMODS, 3, NLAT, WSP(bf16_t, WS_H2M), PIN(23), WSP(unsigned char, WS_ROUTE), lcnt);
                __syncthreads();
                if (C.tid < 8) WSP(int, WS_CNT)[C.bx * 8 + C.tid] = lcnt[C.tid];
                convert_moe_weights(C);
            }
            SEAM(16);
            if (IN(17)) { LQ(); const Ctx C = make_ctx(); phase_slots(C, WSP(int, WS_CNT), WSP(int, WS_CNT) + 4096, WSP(unsigned char, WS_ROUTE), WSP(bf16_t, WS_H2M), WSP(bf16_t, WS_AG), (LAS int*)(C.lds + LDS_MISC + 32)); }
            SEAM(17);
            if (IN(18)) { LQ();
                const int ptot = __builtin_amdgcn_readfirstlane(WSP(int, WS_CNT)[4096 + 8]);
                for (int p0 = 0; p0 < ptot; p0 += MOE_CHUNK) {
                    const int np = (ptot - p0) < MOE_CHUNK ? (ptot - p0) : MOE_CHUNK;
#define MOE_ORDER_INIT(S) do { S.so.init(g, C.G, C.bx); S.p0 = p0; S.pbv = WSP(int, WS_CNT) + 4096; } while (0)
                    { const Ctx C = make_ctx(); Gemm g{WSP(bf16_t, WS_AG), WSP(bf16_t, WS_WM13), np * 256, 2 * DFE, D / 2, D / 2};
                      pg8::MoeOrder S; MOE_ORDER_INIT(S); S.apan0 = 0; S.estride = (size_t)2 * DFE * D;
                      EpiSwiglu8 E{WSP(unsigned char, WS_MHID), DFE, p0, 1.f / W13_SCALE, HID_SCALE};
                      pg8::gemm_phase<EpiSwiglu8, pg8::MoeOrder, true, true>(C.lds, g, S, E); }
                    grid_barrier();
                    { const Ctx C = make_ctx(); Gemm g{WSP(bf16_t, WS_MHID), WSP(bf16_t, WS_WM2), np * 256, D, DFE / 2, DFE / 2};
                      pg8::MoeOrder S; MOE_ORDER_INIT(S); S.apan0 = p0; S.estride = (size_t)D * DFE;
                      EpiBf16 E{WSP(bf16_t, WS_Y), D, 1.f / (W2_SCALE * HID_SCALE)};
                      pg8::gemm_phase<EpiBf16, pg8::MoeOrder, true, true>(C.lds, g, S, E); }
                    grid_barrier();
                }
            }
            if (IN(19)) { LQ(); const Ctx C = make_ctx(); phase_final(C, POUT, WSP(unsigned char, WS_ROUTE), WSP(bf16_t, WS_Y), LMODS, PIN(27)); }
        }
}

__global__ void __launch_bounds__(512, 2) fwd_kernel(Params p) {
    extern __shared__ __attribute__((aligned(16))) unsigned char lds_raw[];
    (void)p;
    { volatile LAS unsigned* misc = (volatile LAS unsigned*)((LAS unsigned char*)lds_raw + LDS_MISC);
      if (threadIdx.x < 16) misc[threadIdx.x] = 0u;
      if ((threadIdx.x & 63) == 0) ((volatile LAS int*)((LAS unsigned char*)lds_raw + LDS_WTAB_OFF))[(unsigned)__builtin_amdgcn_s_getreg((5 << 11) | 4) & 63u] = threadIdx.x >> 6;
      __syncthreads();
      (void)xcd_barrier_post((unsigned*)(kparams()->ws + WS_CTL) + CW_BAR + kparams()->li * XCD_BAR_WORDS, misc); }
    if (IN(0)) { const Ctx C = make_ctx(); phase_prologue(C); } SEAM(0);

    layer_phases<0>();
    layer_phases<1>();
#undef IN
#undef SEAM
}


extern "C" void kernel_launch(void* const* d_in, const int* in_sizes, int n_in, void* d_out, int out_size, void* d_ws, size_t ws_size, hipStream_t stream) {
    static int grid = 0;
    if (grid == 0) {
        if (n_in != 28 || out_size != NLAT * D || ws_size < WS_END) { fprintf(stderr, "kernel_launch: unexpected problem (n_in %d, out %d, ws %zu)\n", n_in, out_size, ws_size); grid = -1; return; }
        int dev = 0, cus = 0, per_cu = 0;
        if (hipGetDevice(&dev) != hipSuccess || hipDeviceGetAttribute(&cus, hipDeviceAttributeMultiprocessorCount, dev) != hipSuccess) { grid = -1; return; }
        if (hipFuncSetAttribute((const void*)fwd_kernel, hipFuncAttributeMaxDynamicSharedMemorySize, LDS_BYTES) != hipSuccess) { fprintf(stderr, "kernel_launch: cannot set %d B dynamic LDS\n", LDS_BYTES); grid = -1; return; }
        if (hipOccupancyMaxActiveBlocksPerMultiprocessor(&per_cu, (const void*)fwd_kernel, 512, LDS_BYTES) != hipSuccess || per_cu < 1) fprintf(stderr, "kernel_launch: occupancy query says %d\n", per_cu);
        (void)hipGetLastError();
        grid = cus;
    }
    if (grid < 0) return;
    (void)hipMemsetAsync((char*)d_ws + WS_CTL, 0, CTL_BYTES, stream);
    Params a{};
    for (int i = 0; i < 28; ++i) a.in[i] = (const float*)d_in[i];
    a.out = (float*)d_out; a.ws = (unsigned char*)d_ws; a.ph_lo = 0; a.ph_hi = NPHASE; a.li = 0; a.pad = 0;
    hipLaunchKernelGGL(fwd_kernel, dim3(grid), dim3(512), LDS_BYTES, stream, a);
}
```

```cpp
#include <hip/hip_runtime.h>
#include <cstdio>
#include <cstdint>


constexpr int D = 1024, NB = 32, T = 2048, CL = 256;
constexpr int NLAT = NB * T, NCTX = NB * CL, NTOK = NLAT + NCTX;
constexpr int PW = 4096;
constexpr int DIN = 6144, DFF = 2752, DFFP = 2816, DFE = 3584, NE = 8;
constexpr float EPS = 1e-6f;
constexpr float LOG2E = 1.4426950408889634f;
constexpr float QSCALE = 0.125f * LOG2E;
constexpr int PC_Q = 0, PC_LF = 512, PC_G = 1024, PC_LB = 1536, PC_K = 2048, PC_V = 2560, PC_RQ = 3072, PC_RI = 3584, PC_GA = 2048, PC_GR = 3072;

constexpr size_t MiB = 1u << 20;
constexpr size_t WS_CTL = 0, CTL_BYTES = 1 * MiB;
constexpr size_t WS_MODS = 1 * MiB;
constexpr size_t WS_LBS = 3 * MiB;
constexpr size_t WS_ROPE = 3 * MiB + 65536;
constexpr size_t WS_ROUTE = 4 * MiB;
constexpr size_t WS_CNT = 6 * MiB;
constexpr size_t WS_CTXRES = 8 * MiB;
constexpr size_t WS_WIN = 40 * MiB;
constexpr size_t WS_WIN8 = 56 * MiB;
constexpr size_t WS_H8 = 809 * MiB;
constexpr size_t WS_WUA = 64 * MiB;
constexpr size_t WS_WUR = 66 * MiB;
constexpr size_t WS_WO = 68 * MiB;
constexpr size_t WS_W13 = 72 * MiB;
constexpr size_t WS_W2 = 83 * MiB;
constexpr size_t WS_H = 89 * MiB;
constexpr size_t WS_P = 233 * MiB;
constexpr size_t WS_MERGED = 809 * MiB;
constexpr size_t WS_HID = 233 * MiB;
constexpr size_t WS_WM13 = 8 * MiB;
constexpr size_t WS_WM2 = 120 * MiB;
constexpr size_t WS_AG = 176 * MiB;
constexpr size_t WS_MHID = 436 * MiB;
constexpr size_t WS_Y = 674 * MiB;
constexpr size_t WS_H2M = 896 * MiB;
constexpr size_t WS_END = 1024 * MiB;
constexpr int MOE_CHUNK = 256;

constexpr int CW_BAR = 4096;

#define LAS __attribute__((address_space(3)))
#define GAS __attribute__((address_space(1)))
typedef unsigned short bf16_t;
typedef short bf16x8 __attribute__((ext_vector_type(8)));
typedef short s16x4 __attribute__((ext_vector_type(4)));
typedef _Float16 half8 __attribute__((ext_vector_type(8)));
typedef _Float16 half4 __attribute__((ext_vector_type(4)));
typedef float f32x4 __attribute__((ext_vector_type(4)));
typedef float f32x2 __attribute__((ext_vector_type(2)));
typedef float f32x16 __attribute__((ext_vector_type(16)));
typedef unsigned u32x4 __attribute__((ext_vector_type(4)));
typedef unsigned u32x2 __attribute__((ext_vector_type(2)));
#define DI __device__ __forceinline__
#define LDS_WAIT() asm volatile("s_waitcnt lgkmcnt(0)" ::: "memory")
#define VM_WAIT() asm volatile("s_waitcnt vmcnt(0)" ::: "memory")
#define LDS_BARRIER() do { asm volatile("s_waitcnt lgkmcnt(0)" ::: "memory"); __builtin_amdgcn_s_barrier(); asm volatile("" ::: "memory"); } while (0)

typedef __bf16 bf16x2_t __attribute__((ext_vector_type(2)));
DI unsigned cvt_pk_bf16(float lo, float hi) { f32x2 v = {lo, hi}; bf16x2_t b = __builtin_convertvector(v, bf16x2_t); return __builtin_bit_cast(unsigned, b); }
typedef int v8i32 __attribute__((ext_vector_type(8)));
typedef int v4i32 __attribute__((ext_vector_type(4)));
DI unsigned pack_fp8x4(float a, float b, float c, float d) {
    a = fminf(fmaxf(a, -448.f), 448.f); b = fminf(fmaxf(b, -448.f), 448.f); c = fminf(fmaxf(c, -448.f), 448.f); d = fminf(fmaxf(d, -448.f), 448.f);
    int w = 0; w = __builtin_amdgcn_cvt_pk_fp8_f32(a, b, w, false); w = __builtin_amdgcn_cvt_pk_fp8_f32(c, d, w, true); return (unsigned)w; }
DI float bf2f(unsigned short b) { return __uint_as_float(((unsigned)b) << 16); }
DI float bflo(unsigned w) { return __uint_as_float(w << 16); }
DI float bfhi(unsigned w) { return __uint_as_float(w & 0xffff0000u); }
DI float fsilu(float x) { return x * __builtin_amdgcn_rcpf(1.f + __expf(-x)); }
DI float fsigmoid(float x) { return __builtin_amdgcn_rcpf(1.f + __expf(-x)); }
DI float wave_sum(float v) {
#pragma unroll
    for (int o = 1; o < 64; o <<= 1) v += __shfl_xor(v, o);
    return v;
}
DI int crow(int r, int hi) { return (r & 3) + 8 * (r >> 2) + 4 * hi; }

constexpr int LDS_WTAB_OFF = 148480 + 128;
DI int my_tid() {
    extern __shared__ __attribute__((aligned(16))) unsigned char lds_raw[];
    const unsigned hw = (unsigned)__builtin_amdgcn_s_getreg((5 << 11) | 4) & 63u;
    const int w = __builtin_amdgcn_readfirstlane(((volatile LAS int*)((LAS unsigned char*)lds_raw + LDS_WTAB_OFF))[hw]);
    int t = w * 64 + (int)__builtin_amdgcn_mbcnt_hi(~0u, __builtin_amdgcn_mbcnt_lo(~0u, 0u));
    asm volatile("" : "+v"(t)); return t;
}
#define XB_TMO      128
#define XB_XCNT(j)  (256  + 64 * (j))
#define XB_XSUB(j)  (1280 + 64 * (j))
#define XB_XGEN(j)  (2304 + 64 * (j))
#define XB_TOP      3328
#define XB_TOPGEN   3392
#define XCD_BAR_WORDS 3456
#define XB_SPIN_CAP (1u << 22)
DI unsigned xb_ld(unsigned* p)              { return __hip_atomic_load(p, __ATOMIC_RELAXED, __HIP_MEMORY_SCOPE_AGENT); }
DI unsigned xb_add(unsigned* p, unsigned v) { return __hip_atomic_fetch_add(p, v, __ATOMIC_RELAXED, __HIP_MEMORY_SCOPE_AGENT); }
DI unsigned xb_xcc_id() { return (unsigned)__builtin_amdgcn_s_getreg((3 << 11) | 20) & 0xFu; }
#define XB_SPIN(cond, bar) do { unsigned _sp = 0; while (cond) { __builtin_amdgcn_s_sleep(1); \
    if ((++_sp & 255u) == 0u) { if (xb_ld(&(bar)[XB_TMO])) break; if (_sp > XB_SPIN_CAP) { atomicAdd(&(bar)[XB_TMO], 1u); break; } } } } while (0)
struct XcdBarrier { unsigned* bar; unsigned x; volatile LAS unsigned* st; };
DI XcdBarrier xcd_barrier_post(unsigned* bar, volatile LAS unsigned* st) {
    XcdBarrier b; b.bar = bar; b.x = xb_xcc_id(); b.st = st;
    if (my_tid() == 0) (void)xb_add(&bar[XB_XCNT(b.x)], 1u);
    return b;
}
DI void xcd_barrier_complete(unsigned* bar, unsigned x, unsigned& nloc, unsigned& nx) {
    const unsigned G = gridDim.x * gridDim.y * gridDim.z;
    unsigned sum, cnt, mine, sp = 0u;
    for (;;) {
        sum = 0u; cnt = 0u; mine = 0u;
#pragma unroll
        for (unsigned j = 0; j < 16; ++j) { const unsigned c = xb_ld(&bar[XB_XCNT(j)]); sum += c; cnt += (c > 0u) ? 1u : 0u; mine = (j == x) ? c : mine; }
        if (sum == G) break;
        __builtin_amdgcn_s_sleep(1);
        if ((++sp & 255u) == 0u) { if (xb_ld(&bar[XB_TMO])) break; if (sp > XB_SPIN_CAP) { atomicAdd(&bar[XB_TMO], 1u); break; } }
    }
    nloc = mine > 0u ? mine : 1u; nx = cnt > 0u ? cnt : 1u;
}
DI void xcd_barrier(const XcdBarrier& b) {
    asm volatile("s_waitcnt vmcnt(0)" ::: "memory");
    __syncthreads();
    if (my_tid() == 0) {
        unsigned* bar = b.bar;
        __builtin_amdgcn_s_waitcnt(0);
        unsigned nloc = b.st[0], nx = b.st[1];
        if (nloc == 0u) { xcd_barrier_complete(bar, b.x, nloc, nx); b.st[0] = nloc; b.st[1] = nx; }
        const unsigned old = xb_add(&bar[XB_XSUB(b.x)], 1u);
        const unsigned gen = old / nloc;
        if (old + 1u == (gen + 1u) * nloc) {
            __builtin_amdgcn_fence(__ATOMIC_RELEASE, "agent");
            asm volatile("s_waitcnt vmcnt(0)" ::: "memory");
            const unsigned og = xb_add(&bar[XB_TOP], 1u);
            const unsigned tg = og / nx;
            if (og + 1u == (tg + 1u) * nx) xb_add(&bar[XB_TOPGEN], 1u);
            else XB_SPIN(xb_ld(&bar[XB_TOPGEN]) == tg, bar);
            __builtin_amdgcn_fence(__ATOMIC_ACQUIRE, "agent");
            xb_add(&bar[XB_XGEN(b.x)], 1u);
            asm volatile("s_waitcnt vmcnt(0)" ::: "memory");
        } else {
            XB_SPIN(xb_ld(&bar[XB_XGEN(b.x)]) == gen, bar);
            __builtin_amdgcn_fence(__ATOMIC_ACQUIRE, "agent");
            asm volatile("s_waitcnt vmcnt(0)" ::: "memory");
        }
    }
    __syncthreads();
}

namespace pg8 {
constexpr int BM = 256, BK = 64, HALF = 128, HTB = HALF * BK * 2, STAGE_BYTES = 8 * HTB, NXCD = 8, WGM = 8;
__host__ __device__ __forceinline__ int lds_byte(int r, int c) { const int st = (r >> 4) * 2 + (c >> 5), rr = r & 15, cc = c & 31, ob = rr * 64 + cc * 2; return st * 1024 + (ob ^ (((ob >> 9) & 1) << 5)); }
__host__ __device__ __forceinline__ void stage_rc(int b, int& R, int& C) { const int st = b / 1024, sb = b % 1024, swz = sb ^ (((sb >> 9) & 1) << 5); R = (st >> 1) * 16 + swz / 64; C = (st & 1) * 32 + (swz % 64) / 2; }
__host__ __device__ __forceinline__ int perm32(int rho) { const int n = rho >> 4, i = rho & 15; return 8 * (i >> 2) + 4 * n + (i & 3); }

struct Unit { int pm, pn; const char* a; const char* b; };
struct Gemm { const bf16_t* A; const bf16_t* Bt; int M, N, K, lda; };

struct StaticOrder {
    int nM, nN, nwg, G, c;
    DI void init(const Gemm& g, int G_, int c_) { nM = g.M / BM; nN = g.N / BM; nwg = nM * nN; G = G_; c = c_; }
    DI bool tile(int i, int& pm, int& pn) const {
        const int L = i * G + c; if (L >= nwg) return false;
        int wgid = L; { const int q = nwg / NXCD, r = nwg % NXCD, xcd = wgid % NXCD, off = wgid / NXCD; wgid = (xcd < r ? xcd * (q + 1) : r * (q + 1) + (xcd - r) * q) + off; }
        const int nig = WGM * nN, gid = wgid / nig, fm = gid * WGM, gsz = (nM - fm) < WGM ? (nM - fm) : WGM;
        pm = fm + ((wgid % nig) % gsz); pn = (wgid % nig) / gsz; return true;
    }
    DI bool next(const Gemm& g, int i, Unit& u) const { if (!tile(i, u.pm, u.pn)) return false;
        u.a = (const char*)g.A + (size_t)u.pm * ((size_t)BM * g.lda * 2); u.b = (const char*)g.Bt + (size_t)u.pn * ((size_t)BM * g.K * 2); return true; }
};
struct MoeOrder {
    StaticOrder so; int p0, apan0; int pb[7]; size_t estride;
    DI void load_pb(const int* pbv) {
#pragma unroll
        for (int k = 0; k < 7; ++k) pb[k] = __builtin_amdgcn_readfirstlane(pbv[k + 1]); }
    DI bool next(const Gemm& g, int i, Unit& u) const {
        int pm, pn; if (!so.tile(i, pm, pn)) return false;
        u.pm = p0 + pm; u.pn = pn; int e = 0;
#pragma unroll
        for (int k = 0; k < 7; ++k) e += (u.pm >= pb[k]) ? 1 : 0;
        u.a = (const char*)g.A + (size_t)(u.pm - apan0) * ((size_t)BM * g.lda * 2); u.b = (const char*)g.Bt + (size_t)e * estride + (size_t)pn * ((size_t)BM * g.K * 2); return true;
    }
};

template <class Epi, class Sched, bool ALIGN_EPI = true, bool F8 = false, bool MIDHOOK = false>
DI void gemm_phase(LAS unsigned char* lds, const Gemm g, const Sched& S, const Epi& E) {
    const int tid_ = my_tid();
    const int tid = tid_, wid = __builtin_amdgcn_readfirstlane(tid >> 6), lane = tid & 63, wr = wid >> 2, wc = wid & 3, fr = lane & 15, fq = lane >> 4;
    const int K = g.K, nt = K / BK;
    unsigned voffA[2], voffB[2];
#pragma unroll
    for (int i = 0; i < 2; ++i) { int R, C; stage_rc(tid * 16 + i * 8192, R, C); const int Rb = Epi::PERM ? ((R & ~31) + perm32(R & 31)) : R;
        voffA[i] = (unsigned)(R * g.lda + C) * 2u; voffB[i] = (unsigned)(Rb * K + C) * 2u; }
    const size_t kstep = (size_t)(BK * 2);
    const size_t hstepA = (size_t)HALF * g.lda * 2, hstepB = (size_t)HALF * K * 2;
    const unsigned ldsw = (unsigned)wid * 1024u;
    const int aoff = lds_byte(wr * 64 + fr, fq * 8), boff = lds_byte(wc * 32 + fr, fq * 8);
#define PG8_SA(b, h) (((b) * 2 + (h)) * HTB)
#define PG8_SB(b, h) ((4 + (b) * 2 + (h)) * HTB)
#define PG8_STAGE(bufoff, gbase, voff) do { _Pragma("unroll") for (int _i = 0; _i < 2; ++_i) \
        __builtin_amdgcn_global_load_lds((const unsigned*)((const char*)(gbase) + (voff)[_i]), (LAS unsigned*)(lds + (bufoff) + ldsw + _i * 8192), 16, 0, 0); } while (0)
#define PG8_LD8(p) __builtin_shufflevector(*(const LAS v4i32*)(p), *(const LAS v4i32*)((p) + 1024), 0, 1, 2, 3, 4, 5, 6, 7)
#define PG8_LDA(dst, b, h) do { if constexpr (F8) { _Pragma("unroll") for (int m = 0; m < 4; ++m) dst##8[m] = PG8_LD8(lds + PG8_SA(b, h) + aoff + m * 2048); } \
        else { _Pragma("unroll") for (int m = 0; m < 4; ++m) _Pragma("unroll") for (int k = 0; k < 2; ++k) dst[m][k] = *(const LAS bf16x8*)(lds + PG8_SA(b, h) + aoff + m * 2048 + k * 1024); } } while (0)
#define PG8_LDB(dst, b, h) do { if constexpr (F8) { _Pragma("unroll") for (int n = 0; n < 2; ++n) dst##8[n] = PG8_LD8(lds + PG8_SB(b, h) + boff + n * 2048); } \
        else { _Pragma("unroll") for (int n = 0; n < 2; ++n) _Pragma("unroll") for (int k = 0; k < 2; ++k) dst[n][k] = *(const LAS bf16x8*)(lds + PG8_SB(b, h) + boff + n * 2048 + k * 1024); } } while (0)
#define PG8_MMA(ai, bj, At, Bt) do { __builtin_amdgcn_s_setprio(1); \
        if constexpr (F8) { _Pragma("unroll") for (int m = 0; m < 4; ++m) _Pragma("unroll") for (int n = 0; n < 2; ++n) \
            asm volatile("v_mfma_scale_f32_16x16x128_f8f6f4 %0, %1, %2, %0, %3, %3 op_sel_hi:[0,0,0]" : "+v"(acc[ai][bj][m][n]) : "v"(Bt##8[n]), "v"(At##8[m]), "v"(one8)); } \
        else { _Pragma("unroll") for (int m = 0; m < 4; ++m) _Pragma("unroll") for (int n = 0; n < 2; ++n) _Pragma("unroll") for (int k = 0; k < 2; ++k) \
            acc[ai][bj][m][n] = __builtin_amdgcn_mfma_f32_16x16x32_bf16(Bt[n][k], At[m][k], acc[ai][bj][m][n], 0, 0, 0); } \
        __builtin_amdgcn_s_setprio(0); } while (0)
#define PG8_WAIT_V(n) asm volatile("s_waitcnt vmcnt(" #n ")" ::: "memory")
#define PG8_WAIT_VX(n) asm volatile("s_waitcnt vmcnt(%0)" :: "n"(n) : "memory")
#define PG8_WAIT_L(n) asm volatile("s_waitcnt lgkmcnt(" #n ")" ::: "memory")
#define PG8_BAR __builtin_amdgcn_s_barrier()
#define PG8_SCHED __builtin_amdgcn_sched_barrier(0)
    Unit cur, nxt; int ui = 0;
    if (!S.next(g, 0, cur)) return;
    f32x4 acc[2][2][4][2];
#pragma unroll
    for (int a = 0; a < 2; ++a)
#pragma unroll
        for (int b = 0; b < 2; ++b)
#pragma unroll
            for (int m = 0; m < 4; ++m)
#pragma unroll
                for (int n = 0; n < 2; ++n) acc[a][b][m][n] = (f32x4){0.f, 0.f, 0.f, 0.f};
    bf16x8 At[4][2], B0[2][2], B1[2][2]; v8i32 At8[4], B08[2], B18[2]; const int one8 = 0x7F7F7F7F;
    const char* cA = cur.a; const char* cB = cur.b;
    PG8_STAGE(PG8_SB(0, 0), cB, voffB); PG8_STAGE(PG8_SB(0, 1), cB + hstepB, voffB); PG8_STAGE(PG8_SA(0, 0), cA, voffA); PG8_STAGE(PG8_SA(0, 1), cA + hstepA, voffA);
    if (wr == 1) PG8_BAR;
    PG8_WAIT_V(2); PG8_BAR;
    PG8_STAGE(PG8_SB(1, 0), cB + kstep, voffB); PG8_STAGE(PG8_SA(1, 0), cA + kstep, voffA); PG8_STAGE(PG8_SB(1, 1), cB + hstepB + kstep, voffB);
    PG8_WAIT_V(6); PG8_BAR;
    for (;;) {
        const bool has_next = S.next(g, ui + 1, nxt);
        const char* nA = has_next ? nxt.a : cA; const char* nB = has_next ? nxt.b : cB;
        for (int t = 0; t < nt; t += 2) {
            const bool last = (t == nt - 2);
            if constexpr (MIDHOOK) { PG8_SCHED; if (t == nt / 2) E.mid(acc, cur, wr, wc, fr, fq); PG8_SCHED; }
            const char* a1 = cA + (size_t)(t + 1) * kstep;
            const char* a2 = last ? nA : cA + (size_t)(t + 2) * kstep; const char* b2 = last ? nB : cB + (size_t)(t + 2) * kstep;
            const char* a3 = a2 + kstep; const char* b3 = b2 + kstep;
            const int relax = __builtin_amdgcn_readfirstlane(((t == 0) && (ui > 0)) ? 1 : 0);
#define PG8_WAIT_V8R asm volatile("s_cmp_lg_u32 %0, 0\n\ts_cbranch_scc1 1f\n\ts_waitcnt vmcnt(8)\n1:\n\ts_waitcnt vmcnt(%1)" :: "s"(relax), "n"(8 + Epi::NVM) : "memory", "scc")
            PG8_LDB(B0, 0, 0); PG8_LDB(B1, 0, 1); PG8_SCHED; PG8_LDA(At, 0, 0); PG8_STAGE(PG8_SA(1, 1), a1 + hstepA, voffA);
            PG8_WAIT_V8R; PG8_WAIT_L(0); PG8_BAR; PG8_MMA(0, 0, At, B0); PG8_MMA(0, 1, At, B1); PG8_BAR; PG8_SCHED;
            PG8_LDA(At, 0, 1); PG8_STAGE(PG8_SB(0, 0), b2, voffB); PG8_STAGE(PG8_SB(0, 1), b2 + hstepB, voffB); PG8_STAGE(PG8_SA(0, 0), a2, voffA);
            PG8_WAIT_V8R; PG8_WAIT_L(0); PG8_BAR; PG8_MMA(1, 0, At, B0); PG8_MMA(1, 1, At, B1); PG8_BAR; PG8_SCHED;
            PG8_LDB(B0, 1, 0); PG8_LDB(B1, 1, 1); PG8_SCHED; PG8_LDA(At, 1, 0); PG8_STAGE(PG8_SA(0, 1), a2 + hstepA, voffA);
            PG8_WAIT_V(8); PG8_WAIT_L(0); PG8_BAR; PG8_MMA(0, 0, At, B0); PG8_MMA(0, 1, At, B1); PG8_BAR; PG8_SCHED;
            PG8_LDA(At, 1, 1); PG8_STAGE(PG8_SB(1, 0), b3, voffB); PG8_STAGE(PG8_SB(1, 1), b3 + hstepB, voffB); PG8_STAGE(PG8_SA(1, 0), a3, voffA);
            PG8_WAIT_V(8); PG8_WAIT_L(0); PG8_BAR; PG8_MMA(1, 0, At, B0); PG8_MMA(1, 1, At, B1); PG8_BAR; PG8_SCHED;
#undef PG8_WAIT_V8R
        }
        if constexpr (ALIGN_EPI) { if (wr == 0) PG8_BAR; }
        if constexpr (F8) asm volatile("s_nop 15\n\ts_nop 15" ::: "memory");
        E(acc, cur, wr, wc, fr, fq);
        if (!has_next) break;
#pragma unroll
        for (int a = 0; a < 2; ++a)
#pragma unroll
            for (int b = 0; b < 2; ++b)
#pragma unroll
                for (int m = 0; m < 4; ++m)
#pragma unroll
                    for (int n = 0; n < 2; ++n) acc[a][b][m][n] = (f32x4){0.f, 0.f, 0.f, 0.f};
        cur = nxt; cA = nA; cB = nB; ++ui;
        if constexpr (ALIGN_EPI) { if (wr == 1) PG8_BAR; }
    }
    PG8_WAIT_V(0);
    if constexpr (!ALIGN_EPI) { if (wr == 0) PG8_BAR; }
    PG8_BAR;
#undef PG8_SA
#undef PG8_SB
#undef PG8_STAGE
#undef PG8_LDA
#undef PG8_LD8
#undef PG8_LDB
#undef PG8_MMA
#undef PG8_WAIT_V
#undef PG8_WAIT_VX
#undef PG8_WAIT_L
#undef PG8_BAR
#undef PG8_SCHED
}
}
using pg8::Unit; using pg8::Gemm;
typedef const f32x4 (&AccRef)[2][2][4][2];

DI u32x4 pack8(const f32x4& v0, const f32x4& v1) { u32x4 w; w.x = cvt_pk_bf16(v0[0], v0[1]); w.y = cvt_pk_bf16(v0[2], v0[3]); w.z = cvt_pk_bf16(v1[0], v1[1]); w.w = cvt_pk_bf16(v1[2], v1[3]); return w; }
DI void unpack8(const u32x4& w, float (&f)[8]) { f[0] = bflo(w.x); f[1] = bfhi(w.x); f[2] = bflo(w.y); f[3] = bfhi(w.y); f[4] = bflo(w.z); f[5] = bfhi(w.z); f[6] = bflo(w.w); f[7] = bfhi(w.w); }

struct EpiInProj {
    static constexpr int NVM = 16; static constexpr bool PERM = true;
    bf16_t* P; const float2* rope; const float* lbf; const float* lbb; int secmap; float asc;
    template <int MODE> DI void run(AccRef acc, const Unit& u, int wr, int wc, int fr, int fq, int sec) const {
        const int row0 = u.pm * 256 + wr * 64 + fr, col0 = sec * 512 + (u.pn & 1) * 256 + wc * 32 + 8 * fq;
        const bool lat = u.pm < (NLAT / 256); const float qs = sec == 0 ? QSCALE : 1.f;
        f32x4 lb0[2], lb1[2];
        if (MODE == 2) {
#pragma unroll
            for (int bj = 0; bj < 2; ++bj) { const float* lb = (sec == 1 ? lbf : lbb) + ((col0 + bj * 128) & 511); lb0[bj] = *(const f32x4*)lb; lb1[bj] = *(const f32x4*)(lb + 4); } }
        f32x4 rr[2][4][2];
        if (MODE == 3) {
#pragma unroll
            for (int ai = 0; ai < 2; ++ai)
#pragma unroll
                for (int m = 0; m < 4; ++m) { const f32x4* rp = (const f32x4*)(rope + (size_t)((row0 + ai * 128 + m * 16) & (T - 1)) * 32 + ((col0 & 63) >> 1));
                    rr[ai][m][0] = lat ? rp[0] : (f32x4){1.f, 0.f, 1.f, 0.f}; rr[ai][m][1] = lat ? rp[1] : (f32x4){1.f, 0.f, 1.f, 0.f}; } }
#pragma unroll
        for (int ai = 0; ai < 2; ++ai)
#pragma unroll
            for (int m = 0; m < 4; ++m) {
                const int row = row0 + ai * 128 + m * 16; bf16_t* rowp = P + (size_t)row * PW + col0;
#pragma unroll
                for (int bj = 0; bj < 2; ++bj) {
                    f32x4 v0 = acc[ai][bj][m][0] * asc, v1 = acc[ai][bj][m][1] * asc; u32x4 w;
                    if (MODE == 3) {
                        {
                            const f32x4 r0 = rr[ai][m][0], r1 = rr[ai][m][1];
                            f32x4 o0, o1;
                            o0[0] = v0[0] * r0[0] - v0[1] * r0[1]; o0[1] = v0[0] * r0[1] + v0[1] * r0[0];
                            o0[2] = v0[2] * r0[2] - v0[3] * r0[3]; o0[3] = v0[2] * r0[3] + v0[3] * r0[2];
                            o1[0] = v1[0] * r1[0] - v1[1] * r1[1]; o1[1] = v1[0] * r1[1] + v1[1] * r1[0];
                            o1[2] = v1[2] * r1[2] - v1[3] * r1[3]; o1[3] = v1[2] * r1[3] + v1[3] * r1[2];
                            v0 = o0; v1 = o1;
                        }
                        w = pack8(v0 * qs, v1 * qs);
                    } else if (MODE == 1) {
#pragma unroll
                        for (int j = 0; j < 4; ++j) { v0[j] = fsilu(v0[j]); v1[j] = fsilu(v1[j]); }
                        w = pack8(v0, v1);
                    } else if (MODE == 2) {
                        half8 hv;
#pragma unroll
                        for (int j = 0; j < 8; ++j) {
                            const float z = fmaxf(j < 4 ? v0[j] : v1[j - 4], -80.f), b = j < 4 ? lb0[bj][j] : lb1[bj][j - 4];
                            const float sg = __builtin_amdgcn_rcpf(1.f + __builtin_amdgcn_exp2f(-LOG2E * z));
                            hv[j] = (_Float16)(0.6931471805599453f * __builtin_amdgcn_logf(b + (1.f - b) * sg));
                        }
                        w = __builtin_bit_cast(u32x4, hv);
                    } else w = pack8(v0, v1);
                    *(u32x4*)(rowp + bj * 128) = w;
                }
            }
    }
    DI void operator()(AccRef acc, const Unit& u, int wr, int wc, int fr, int fq) const {
        const int sec = (secmap >> (4 * (u.pn >> 1))) & 15;
        if (sec == 0 || sec == 4) run<3>(acc, u, wr, wc, fr, fq, sec);
        else if (sec == 2 || sec == 6) run<1>(acc, u, wr, wc, fr, fq, sec);
        else if (sec == 1 || sec == 3) run<2>(acc, u, wr, wc, fr, fq, sec);
        else run<0>(acc, u, wr, wc, fr, fq, sec);
    }
};
struct EpiGates {
    static constexpr int NVM = 16; static constexpr bool PERM = true; bf16_t* P; float asc;
    DI void operator()(AccRef acc, const Unit& u, int wr, int wc, int fr, int fq) const {
        const int row0 = u.pm * 256 + wr * 64 + fr, col0 = PC_GA + u.pn * 256 + wc * 32 + 8 * fq;
#pragma unroll
        for (int ai = 0; ai < 2; ++ai)
#pragma unroll
            for (int m = 0; m < 4; ++m) { bf16_t* rowp = P + (size_t)(row0 + ai * 128 + m * 16) * PW + col0;
#pragma unroll
                for (int bj = 0; bj < 2; ++bj) { f32x4 v0 = acc[ai][bj][m][0] * asc, v1 = acc[ai][bj][m][1] * asc;
#pragma unroll
                    for (int j = 0; j < 4; ++j) { v0[j] = fsigmoid(v0[j]); v1[j] = fsigmoid(v1[j]); }
                    *(u32x4*)(rowp + bj * 128) = pack8(v0, v1); } }
    }
};
struct EpiMergeFused {
    static constexpr int NVM = 16; static constexpr bool PERM = true; const bf16_t* P; bf16_t* O;
    DI void mid(f32x4 (&acc)[2][2][4][2], const Unit& u, int wr, int wc, int fr, int fq) const {
        int row0 = u.pm * 256 + wr * 64 + fr, col0 = u.pn * 256 + wc * 32 + 8 * fq;
        asm volatile("" : "+v"(row0), "+v"(col0));
#pragma unroll
        for (int ai = 0; ai < 2; ++ai)
#pragma unroll
            for (int m = 0; m < 4; ++m) { const size_t row = (size_t)(row0 + ai * 128 + m * 16);
#pragma unroll
                for (int bj = 0; bj < 2; ++bj) {
                    float ga[8], gr[8]; unpack8(*(const u32x4*)(P + row * PW + PC_GA + col0 + bj * 128), ga); unpack8(*(const u32x4*)(P + row * PW + PC_GR + col0 + bj * 128), gr);
#pragma unroll
                    for (int j = 0; j < 4; ++j) { acc[ai][bj][m][0][j] *= ga[j] * __builtin_amdgcn_rcpf(fmaxf(gr[j], 1e-30f)); acc[ai][bj][m][1][j] *= ga[4 + j] * __builtin_amdgcn_rcpf(fmaxf(gr[4 + j], 1e-30f)); } }
                asm volatile("" ::: "memory"); }
    }
    DI void operator()(AccRef acc, const Unit& u, int wr, int wc, int fr, int fq) const {
        const int row0 = u.pm * 256 + wr * 64 + fr, col0 = u.pn * 256 + wc * 32 + 8 * fq;
        u32x4 gq[2][4][2];
#pragma unroll
        for (int ai = 0; ai < 2; ++ai)
#pragma unroll
            for (int m = 0; m < 4; ++m)
#pragma unroll
                for (int bj = 0; bj < 2; ++bj) gq[ai][m][bj] = *(const u32x4*)(P + (size_t)(row0 + ai * 128 + m * 16) * PW + PC_GR + col0 + bj * 128);
#pragma unroll
        for (int ai = 0; ai < 2; ++ai)
#pragma unroll
            for (int m = 0; m < 4; ++m) { const size_t row = (size_t)(row0 + ai * 128 + m * 16);
#pragma unroll
                for (int bj = 0; bj < 2; ++bj) {
                    float gr[8]; unpack8(gq[ai][m][bj], gr);
                    f32x4 v0 = acc[ai][bj][m][0], v1 = acc[ai][bj][m][1];
#pragma unroll
                    for (int j = 0; j < 4; ++j) { v0[j] *= fmaxf(gr[j], 1e-30f); v1[j] *= fmaxf(gr[4 + j], 1e-30f); }
                    *(u32x4*)(O + row * D + col0 + bj * 128) = pack8(v0, v1); } }
    }
};
struct EpiResid {
    static constexpr int NVM = 16; static constexpr bool PERM = false;
    const float* xin_l; const float* xin_c; float* xout_l; float* xout_c; const float* mods; int msel;
    DI void operator()(AccRef acc, const Unit& u, int wr, int wc, int fr, int fq) const {
        const bool lat = u.pm < (NLAT / 256);
        const int rbase = (lat ? u.pm : u.pm - NLAT / 256) * 256 + wr * 64 + fr, col0 = u.pn * 256 + wc * 32 + 4 * fq;
        const float* xi = lat ? xin_l : xin_c; float* xo = lat ? xout_l : xout_c;
        const float* mv = mods + (size_t)(lat ? (u.pm >> 3) : 32) * DIN + msel * D + col0;
        f32x4 g[2][2];
#pragma unroll
        for (int bj = 0; bj < 2; ++bj)
#pragma unroll
            for (int n = 0; n < 2; ++n) g[bj][n] = *(const f32x4*)(mv + bj * 128 + n * 16);
        f32x4 xa[4][2][2], r0[4][2][2];
#define RES_OFF(ai, m) ((size_t)(rbase + (ai) * 128 + (m) * 16) * D + col0)
#pragma unroll
        for (int m = 0; m < 4; ++m)
#pragma unroll
            for (int bj = 0; bj < 2; ++bj)
#pragma unroll
                for (int n = 0; n < 2; ++n) xa[m][bj][n] = *(const f32x4*)(xi + RES_OFF(0, m) + bj * 128 + n * 16);
#pragma unroll
        for (int m = 0; m < 4; ++m)
#pragma unroll
            for (int bj = 0; bj < 2; ++bj)
#pragma unroll
                for (int n = 0; n < 2; ++n) r0[m][bj][n] = xa[m][bj][n] + g[bj][n] * acc[0][bj][m][n];
#pragma unroll
        for (int m = 0; m < 4; ++m)
#pragma unroll
            for (int bj = 0; bj < 2; ++bj)
#pragma unroll
                for (int n = 0; n < 2; ++n) xa[m][bj][n] = *(const f32x4*)(xi + RES_OFF(1, m) + bj * 128 + n * 16);
        asm volatile("" ::: "memory");
#pragma unroll
        for (int m = 0; m < 4; ++m)
#pragma unroll
            for (int bj = 0; bj < 2; ++bj)
#pragma unroll
                for (int n = 0; n < 2; ++n) *(f32x4*)(xo + RES_OFF(0, m) + bj * 128 + n * 16) = r0[m][bj][n];
#pragma unroll
        for (int m = 0; m < 4; ++m)
#pragma unroll
            for (int bj = 0; bj < 2; ++bj)
#pragma unroll
                for (int n = 0; n < 2; ++n) *(f32x4*)(xo + RES_OFF(1, m) + bj * 128 + n * 16) = xa[m][bj][n] + g[bj][n] * acc[1][bj][m][n];
#undef RES_OFF
    }
};
struct EpiSwiglu {
    static constexpr int NVM = 16; static constexpr bool PERM = true; bf16_t* Hd; int ldh; int pan0;
    DI void operator()(AccRef acc, const Unit& u, int wr, int wc, int fr, int fq) const {
        const int row0 = (u.pm - pan0) * 256 + wr * 64 + fr, hc0 = u.pn * 128 + wc * 16 + 4 * fq;
#pragma unroll
        for (int ai = 0; ai < 2; ++ai)
#pragma unroll
            for (int m = 0; m < 4; ++m) { bf16_t* rowp = Hd + (size_t)(row0 + ai * 128 + m * 16) * ldh + hc0;
#pragma unroll
                for (int bj = 0; bj < 2; ++bj) { const f32x4 a = acc[ai][bj][m][0], b = acc[ai][bj][m][1];
                    u32x2 w; w.x = cvt_pk_bf16(fsilu(a[0]) * b[0], fsilu(a[1]) * b[1]); w.y = cvt_pk_bf16(fsilu(a[2]) * b[2], fsilu(a[3]) * b[3]);
                    *(u32x2*)(rowp + bj * 64) = w; } }
    }
};
struct EpiSwiglu8 {
    static constexpr int NVM = 16; static constexpr bool PERM = true; unsigned char* Hd; int ldh; int pan0; float as, hs;
    DI void operator()(AccRef acc, const Unit& u, int wr, int wc, int fr, int fq) const {
        const int row0 = (u.pm - pan0) * 256 + wr * 64 + fr, hc0 = u.pn * 128 + wc * 16 + 4 * fq;
#pragma unroll
        for (int ai = 0; ai < 2; ++ai)
#pragma unroll
            for (int m = 0; m < 4; ++m) { unsigned char* rowp = Hd + (size_t)(row0 + ai * 128 + m * 16) * ldh + hc0;
#pragma unroll
                for (int bj = 0; bj < 2; ++bj) { const f32x4 a = acc[ai][bj][m][0] * as, b = acc[ai][bj][m][1] * (as * hs);
                    *(unsigned*)(rowp + bj * 64) = pack_fp8x4(fsilu(a[0]) * b[0], fsilu(a[1]) * b[1], fsilu(a[2]) * b[2], fsilu(a[3]) * b[3]); } }
    }
};
struct EpiBf16 {
    static constexpr int NVM = 16; static constexpr bool PERM = true; bf16_t* O; int ldc; float sc;
    DI void operator()(AccRef acc, const Unit& u, int wr, int wc, int fr, int fq) const {
        const int row0 = u.pm * 256 + wr * 64 + fr, col0 = u.pn * 256 + wc * 32 + 8 * fq;
#pragma unroll
        for (int ai = 0; ai < 2; ++ai)
#pragma unroll
            for (int m = 0; m < 4; ++m) { bf16_t* rowp = O + (size_t)(row0 + ai * 128 + m * 16) * ldc + col0;
#pragma unroll
                for (int bj = 0; bj < 2; ++bj) *(u32x4*)(rowp + bj * 128) = pack8(acc[ai][bj][m][0] * sc, acc[ai][bj][m][1] * sc); }
    }
};

typedef short v4i16 __attribute__((ext_vector_type(4)));
DI s16x4 tr16(const LAS unsigned char* p) { return __builtin_bit_cast(s16x4, __builtin_amdgcn_ds_read_tr16_b64_v4i16((LAS v4i16*)p)); }
DI bf16x8 cat8(s16x4 lo, s16x4 hi) { return __builtin_shufflevector(lo, hi, 0, 1, 2, 3, 4, 5, 6, 7); }
DI void dma16(const void* g, LAS unsigned char* l) { __builtin_amdgcn_global_load_lds((const unsigned*)g, (LAS unsigned*)l, 16, 0, 0); }
DI bf16x8 packf8(const f32x16& x, int s) {
    u32x4 w; w.x = cvt_pk_bf16(x[8 * s], x[8 * s + 1]); w.y = cvt_pk_bf16(x[8 * s + 2], x[8 * s + 3]); w.z = cvt_pk_bf16(x[8 * s + 4], x[8 * s + 5]); w.w = cvt_pk_bf16(x[8 * s + 6], x[8 * s + 7]);
    return __builtin_bit_cast(bf16x8, w);
}
#define MFMA32(a, b, c) __builtin_amdgcn_mfma_f32_32x32x16_bf16((a), (b), (c), 0, 0, 0)

struct Params { const float* in[28]; float* out; unsigned char* ws; int ph_lo, ph_hi, li, pad; };
typedef const __attribute__((address_space(4))) Params* KP;
DI KP kparams() { KP kp = (KP)__builtin_amdgcn_kernarg_segment_ptr(); asm volatile("" : "+s"(kp)); return kp; }
#define PIN(k) (kparams()->in[k])
#define POUT (kparams()->out)
struct Ctx {
    LAS unsigned char* lds; unsigned char* ws; int tid, lane, wave, vcu, G, gw, NGW, bx;
};

constexpr float WIN8_SCALE = 64.f;
#ifndef FP8_SECS
#define FP8_SECS 0x00
#endif
constexpr int SEC_ORDER[8] = {0, 1, 3, 4, 2, 5, 6, 7};
constexpr int sec_slot(int ps) { int nb = 0, nf = 0; for (int i = 0; i < 8; ++i) { const int s_ = SEC_ORDER[i]; const bool f = (FP8_SECS >> s_) & 1; if (s_ == ps) return f ? (0x100 | nf) : nb; if (f) ++nf; else ++nb; } return 0; }
constexpr int N_SEC_F8 = __builtin_popcount(FP8_SECS), N_SEC_BF = 8 - N_SEC_F8;
constexpr unsigned secmap_of(bool f8) { unsigned m = 0; int k = 0; for (int i = 0; i < 8; ++i) { const int s_ = SEC_ORDER[i]; if ((((FP8_SECS >> s_) & 1) != 0) == f8) { m |= (unsigned)s_ << (4 * k); ++k; } } return m; }
DI int map_row(int kind, int n);
DI int map_row4(int n) { return map_row(1, n) & 0xffff; }
DI int map_row(int kind, int n) {
    if (kind == 0) return n;
    if (kind == 4) return map_row4(n);
    if (kind == 2) return 8 * (n >> 2) + (n & 3);
    if (kind == 3) return 8 * (n >> 2) + (n & 3) + 4;
    const int sec = n >> 9, j = n & 511;
    if (n >= 4096) return (1 << 16) | (N_SEC_F8 * 512 + (n - 4096));
    const int ps = sec == 0 ? 0 : sec == 1 ? 4 : sec == 2 ? 5 : sec == 3 ? 6 : sec == 4 ? 7 : sec == 5 ? 1 : sec == 6 ? 3 : 2;
    const int sl = sec_slot(ps); int jj = j;
    if (sec == 0 || sec == 1) { const int hs = j >> 6, d = j & 63; jj = hs * 64 + (d < 32 ? 2 * d : 2 * (d - 32) + 1); }
    return ((sl & 0x100) ? (1 << 16) : 0) | ((sl & 0xff) * 512 + jj);
}
constexpr int TP_PITCH = 68, TP_SCR = 64 * TP_PITCH * 4;
DI void transpose_load(const float* W, int ldw, int k0, int n0, LAS float* scr, int lane) {
    const int r = lane >> 4, c4 = (lane & 15) * 4; f32x4 v[16];
#pragma unroll
    for (int i = 0; i < 16; ++i) v[i] = *(const f32x4*)(W + (size_t)(k0 + 4 * i + r) * ldw + n0 + c4);
#pragma unroll
    for (int i = 0; i < 16; ++i) *(LAS f32x4*)(scr + (4 * i + r) * TP_PITCH + c4) = v[i];
    LDS_WAIT(); asm volatile("" ::: "memory");
}
DI void transpose_item(const float* W, int ldw, int k0, int n0, bf16_t* WT, int ldt, int kind, LAS float* scr, int lane) {
    transpose_load(W, ldw, k0, n0, scr, lane);
    bf16_t* dst = WT + (size_t)map_row(kind, n0 + lane) * ldt + k0;
#pragma unroll
    for (int j = 0; j < 8; ++j) { const LAS float* s = scr + (8 * j) * TP_PITCH + lane;
        u32x4 o; o.x = cvt_pk_bf16(s[0], s[TP_PITCH]); o.y = cvt_pk_bf16(s[2 * TP_PITCH], s[3 * TP_PITCH]); o.z = cvt_pk_bf16(s[4 * TP_PITCH], s[5 * TP_PITCH]); o.w = cvt_pk_bf16(s[6 * TP_PITCH], s[7 * TP_PITCH]);
        *(u32x4*)(dst + 8 * j) = o; }
    LDS_WAIT(); asm volatile("" ::: "memory");
}
DI void transpose_item8(const float* W, int ldw, int k0, int n0, unsigned char* WT, int ldt, int kind, float sc, LAS float* scr, int lane) {
    transpose_load(W, ldw, k0, n0, scr, lane);
    unsigned char* dst = WT + (size_t)map_row(kind, n0 + lane) * ldt + k0;
#pragma unroll
    for (int j = 0; j < 4; ++j) { const LAS float* s = scr + (16 * j) * TP_PITCH + lane; u32x4 o;
        o.x = pack_fp8x4(s[0] * sc, s[TP_PITCH] * sc, s[2 * TP_PITCH] * sc, s[3 * TP_PITCH] * sc); o.y = pack_fp8x4(s[4 * TP_PITCH] * sc, s[5 * TP_PITCH] * sc, s[6 * TP_PITCH] * sc, s[7 * TP_PITCH] * sc);
        o.z = pack_fp8x4(s[8 * TP_PITCH] * sc, s[9 * TP_PITCH] * sc, s[10 * TP_PITCH] * sc, s[11 * TP_PITCH] * sc); o.w = pack_fp8x4(s[12 * TP_PITCH] * sc, s[13 * TP_PITCH] * sc, s[14 * TP_PITCH] * sc, s[15 * TP_PITCH] * sc);
        *(u32x4*)(dst + 16 * j) = o; }
    LDS_WAIT(); asm volatile("" ::: "memory");
}
DI void transpose_matrix8(const Ctx& C, const float* W, int K, int N, unsigned char* WT, int ldt, int kind, float sc, int& itbase) {
    LAS float* scr = (LAS float*)(C.lds + C.wave * TP_SCR);
    const int nblk = N / 64, nit = (K / 64) * nblk;
    int first = (C.gw - (itbase % C.NGW) + C.NGW) % C.NGW;
    for (int it = first; it < nit; it += C.NGW) transpose_item8(W, N, 64 * (it / nblk), 64 * (it % nblk), WT, ldt, kind, sc, scr, C.lane);
    itbase += nit;
}
DI void transpose_matrix(const Ctx& C, const float* W, int K, int N, bf16_t* WT, int ldt, int kind, int& itbase, int total_unused) {
    (void)total_unused;
    LAS float* scr = (LAS float*)(C.lds + C.wave * TP_SCR);
    const int nblk = N / 64, nit = (K / 64) * nblk;
    int first = (C.gw - (itbase % C.NGW) + C.NGW) % C.NGW;
    for (int it = first; it < nit; it += C.NGW) transpose_item(W, N, 64 * (it / nblk), 64 * (it % nblk), WT, ldt, kind, scr, C.lane);
    itbase += nit;
}
DI void transpose_win(const Ctx& C, const float* W, bf16_t* WA, unsigned char* W8, int& itbase) {
    LAS float* scr = (LAS float*)(C.lds + C.wave * TP_SCR);
    const int nblk = DIN / 64, nit = (D / 64) * nblk;
    int first = (C.gw - (itbase % C.NGW) + C.NGW) % C.NGW;
    for (int it = first; it < nit; it += C.NGW) { const int k0 = 64 * (it / nblk), n0 = 64 * (it % nblk);
        if (map_row(1, n0) >> 16) transpose_item8(W, DIN, k0, n0, W8, D, 4, WIN8_SCALE, scr, C.lane);
        else transpose_item(W, DIN, k0, n0, WA, D, 1, scr, C.lane); }
    itbase += nit;
}
constexpr int MD_SP = 36;
DI void phase_mods(const Ctx& C) {
    if (C.bx >= 2 * 96) return;
    const int l = C.bx / 96, n0 = (C.bx % 96) * 64, kq = C.lane >> 4, cq = C.lane & 15;
    LAS float* S = (LAS float*)C.lds;
    const float* W = PIN(4) + (size_t)l * D * DIN + n0 + 4 * cq; const float* c0 = PIN(1); const float* cc = PIN(3);
    f32x4 acc[33];
#pragma unroll
    for (int r = 0; r < 33; ++r) acc[r] = (f32x4){0.f, 0.f, 0.f, 0.f};
#pragma unroll 1
    for (int kh = 0; kh < 2; ++kh) {
        __syncthreads();
        for (int i = C.tid; i < 33 * 512; i += 512) { const int r = i >> 9, kk = i & 511; S[kk * MD_SP + r] = fsilu(r < 32 ? c0[r * D + kh * 512 + kk] : cc[kh * 512 + kk]); }
        __syncthreads();
        const int kb = C.wave * 64 + kq;
#pragma unroll 1
        for (int ib = 0; ib < 16; ib += 8) { f32x4 w[8];
#pragma unroll
            for (int i = 0; i < 8; ++i) w[i] = *(const f32x4*)(W + (size_t)(kh * 512 + kb + 4 * (ib + i)) * DIN);
#pragma unroll
            for (int i = 0; i < 8; ++i) { const LAS float* sp = S + (kb + 4 * (ib + i)) * MD_SP;
#pragma unroll
                for (int q = 0; q < 8; ++q) { const f32x4 s4 = *(const LAS f32x4*)(sp + 4 * q);
                    acc[4 * q] += w[i] * s4[0]; acc[4 * q + 1] += w[i] * s4[1]; acc[4 * q + 2] += w[i] * s4[2]; acc[4 * q + 3] += w[i] * s4[3]; }
                acc[32] += w[i] * sp[32]; } }
    }
#pragma unroll
    for (int r = 0; r < 33; ++r)
#pragma unroll
        for (int j = 0; j < 4; ++j) { float v = acc[r][j]; v += __shfl_xor(v, 16); v += __shfl_xor(v, 32); asm volatile("" : "+v"(v)); acc[r][j] = v; }
    __syncthreads();
    LAS float* red = (LAS float*)C.lds;
    if (kq == 0) {
#pragma unroll
        for (int r = 0; r < 33; ++r) *(LAS f32x4*)(red + (C.wave * 33 + r) * 64 + 4 * cq) = acc[r]; }
    __syncthreads();
    float* mods = (float*)(C.ws + WS_MODS);
    for (int o = C.tid; o < 33 * 64; o += 512) { const int r = o >> 6, c = o & 63; float v = PIN(5)[l * DIN + n0 + c];
#pragma unroll
        for (int w8 = 0; w8 < 8; ++w8) v += red[(w8 * 33 + r) * 64 + c];
        mods[(size_t)(l * 33 + r) * DIN + n0 + c] = v; }
    __syncthreads();
}
DI void phase_prologue(const Ctx& C) {
    unsigned char* ws = C.ws;
    int itb = 0;
    for (int l = 0; l < 2; ++l) {
        transpose_win(C, PIN(8) + (size_t)l * D * DIN, (bf16_t*)(ws + WS_WIN) + (size_t)l * 4096 * D, ws + WS_WIN8 + (size_t)l * 4096 * D, itb);
        transpose_matrix(C, PIN(17) + (size_t)l * 512 * D, 512, D, (bf16_t*)(ws + WS_WUA) + (size_t)l * D * D, D, 0, itb, 0);
        transpose_matrix(C, PIN(18) + (size_t)l * 512 * D, 512, D, (bf16_t*)(ws + WS_WUA) + (size_t)l * D * D + 512, D, 0, itb, 0);
        transpose_matrix(C, PIN(19) + (size_t)l * D * D, D, D, (bf16_t*)(ws + WS_WO) + (size_t)l * D * D, D, 0, itb, 0);
    }
    transpose_matrix(C, PIN(20), D, DFF, (bf16_t*)(ws + WS_W13), D, 2, itb, 0);
    transpose_matrix(C, PIN(21), D, DFF, (bf16_t*)(ws + WS_W13), D, 3, itb, 0);
    transpose_matrix(C, PIN(22), DFF, D, (bf16_t*)(ws + WS_W2), DFFP, 0, itb, 0);
    { const int gt = C.vcu * 512 + C.tid, NT = C.G * 512;
      bf16_t* w13 = (bf16_t*)(ws + WS_W13) + (size_t)(2 * DFF) * D;
      for (int i = gt; i < (2 * DFFP - 2 * DFF) * D / 8; i += NT) ((u32x4*)w13)[i] = (u32x4){0u, 0u, 0u, 0u};
      bf16_t* w2 = (bf16_t*)(ws + WS_W2);
      for (int i = gt; i < D * (DFFP - DFF) / 8; i += NT) { const int r = i / ((DFFP - DFF) / 8), cc = i % ((DFFP - DFF) / 8); *(u32x4*)(w2 + (size_t)r * DFFP + DFF + cc * 8) = (u32x4){0u, 0u, 0u, 0u}; }
      float2* rope = (float2*)(ws + WS_ROPE);
      for (int i = gt; i < T * 32; i += NT) { const int t = i >> 5, pi = i & 31; const float invf = exp2f(-(float)(pi & 15) * (13.287712379549449f / 16.f));
          const float ang = (float)(pi < 16 ? (t >> 6) : (t & 63)) * invf; rope[i] = make_float2(cosf(ang), sinf(ang)); }
      float* lbs = (float*)(ws + WS_LBS);
      for (int i = gt; i < 2 * 2 * 512; i += NT) { const int l = i >> 10, dir = (i >> 9) & 1, d = i & 511; const float* lb = PIN(dir ? 16 : 15);
          const float p0 = lb[d], p1 = lb[512 + d]; lbs[i] = l == 0 ? 0.f : 1.f / (1.f + expf(p0 - p1)); }
    }
    phase_mods(C);
}
constexpr float W13_SCALE = 64.f, W2_SCALE = 128.f, HID_SCALE = 8.f;
DI void convert_moe_weights(const Ctx& C) {
    unsigned char* ws = C.ws; int itb = 0;
    for (int e = 0; e < NE; ++e) {
        transpose_matrix8(C, PIN(24) + (size_t)e * D * DFE, D, DFE, ws + WS_WM13 + (size_t)e * 2 * DFE * D, D, 2, W13_SCALE, itb);
        transpose_matrix8(C, PIN(25) + (size_t)e * D * DFE, D, DFE, ws + WS_WM13 + (size_t)e * 2 * DFE * D, D, 3, W13_SCALE, itb);
        transpose_matrix8(C, PIN(26) + (size_t)e * DFE * D, DFE, D, ws + WS_WM2 + (size_t)e * D * DFE, DFE, 0, W2_SCALE, itb);
    }
}

template <bool ROUTER>
DI void phase_norm(const Ctx& C, const float* xl, const float* xc, const float* nw, const float* mods, int shsel, int nrows, bf16_t* Hout, const float* rw, unsigned char* route, LAS int* cntL, unsigned char* H8 = nullptr) {
    int nloc = 0;
    f32x4 rwr[4][4][2];
    if (ROUTER) {
#pragma unroll
        for (int j = 0; j < 4; ++j)
#pragma unroll
            for (int q = 0; q < 4; ++q) { const float* rp = rw + (size_t)(256 * j + 4 * C.lane + q) * 8; rwr[j][q][0] = *(const f32x4*)rp; rwr[j][q][1] = *(const f32x4*)(rp + 4); } }
    for (int row0 = C.gw; row0 < nrows; row0 += 2 * C.NGW) {
        const int rows[2] = {row0, row0 + C.NGW}; const bool two = rows[1] < nrows;
        f32x4 v[2][4]; float ss[2] = {0.f, 0.f};
#pragma unroll
        for (int u = 0; u < 2; ++u) { const int row = (u == 1 && !two) ? rows[0] : rows[u]; const float* xr = row < NLAT ? xl + (size_t)row * D : xc + (size_t)(row - NLAT) * D;
#pragma unroll
            for (int j = 0; j < 4; ++j) { v[u][j] = *(const f32x4*)(xr + 256 * j + 4 * C.lane); ss[u] += (v[u][j][0] * v[u][j][0] + v[u][j][1] * v[u][j][1]) + (v[u][j][2] * v[u][j][2] + v[u][j][3] * v[u][j][3]); } }
#pragma unroll
        for (int u = 0; u < 2; ++u) { if (u == 1 && !two) break;
            const int row = rows[u]; const bool lat = row < NLAT;
            const float* mv = mods + (size_t)(lat ? (row >> 11) : 32) * DIN + shsel * D;
            const float rstd = 1.0f / sqrtf(wave_sum(ss[u]) * (1.f / D) + EPS);
            float lg[8];
            if (ROUTER) {
#pragma unroll
                for (int e = 0; e < 8; ++e) lg[e] = 0.f; }
#pragma unroll
            for (int j = 0; j < 4; ++j) { const int c0 = 256 * j + 4 * C.lane;
                const f32x4 w = *(const f32x4*)(nw + c0), sh = *(const f32x4*)(mv + c0), sc = *(const f32x4*)(mv + D + c0);
                f32x4 h = (v[u][j] * rstd) * w * (sc + 1.0f) + sh;
                if (ROUTER) *(unsigned*)((unsigned char*)Hout + (size_t)row * D + c0) = pack_fp8x4(h[0], h[1], h[2], h[3]);
                else { u32x2 o; o.x = cvt_pk_bf16(h[0], h[1]); o.y = cvt_pk_bf16(h[2], h[3]); *(u32x2*)(Hout + (size_t)row * D + c0) = o;
                       if (H8) *(unsigned*)(H8 + (size_t)row * D + c0) = pack_fp8x4(h[0], h[1], h[2], h[3]); }
                if (ROUTER) {
#pragma unroll
                    for (int q = 0; q < 4; ++q) { const f32x4 r0 = rwr[j][q][0], r1 = rwr[j][q][1];
                        lg[0] += h[q] * r0[0]; lg[1] += h[q] * r0[1]; lg[2] += h[q] * r0[2]; lg[3] += h[q] * r0[3]; lg[4] += h[q] * r1[0]; lg[5] += h[q] * r1[1]; lg[6] += h[q] * r1[2]; lg[7] += h[q] * r1[3]; } }
            }
            if (ROUTER) {
                const bool b5 = (C.lane & 32) != 0, b4 = (C.lane & 16) != 0, b3 = (C.lane & 8) != 0; float a4[4], a2[2], a1;
#pragma unroll
                for (int j = 0; j < 4; ++j) { const float snd = b5 ? lg[j] : lg[4 + j]; a4[j] = (b5 ? lg[4 + j] : lg[j]) + __shfl_xor(snd, 32); }
#pragma unroll
                for (int j = 0; j < 2; ++j) { const float snd = b4 ? a4[j] : a4[2 + j]; a2[j] = (b4 ? a4[2 + j] : a4[j]) + __shfl_xor(snd, 16); }
                { const float snd = b3 ? a2[0] : a2[1]; a1 = (b3 ? a2[1] : a2[0]) + __shfl_xor(snd, 8); }
                a1 += __shfl_xor(a1, 4); a1 += __shfl_xor(a1, 2); a1 += __shfl_xor(a1, 1);
                if ((C.lane & 7) == 0) ((LAS float*)(C.lds + C.wave * 4096))[nloc * 8 + (C.lane >> 3)] = a1;
                ++nloc;
            }
        }
    }
    if (ROUTER) {
        LDS_WAIT();
        for (int i = C.lane; i < nloc; i += 64) { const int row = C.gw + i * C.NGW; const LAS float* lp = (const LAS float*)(C.lds + C.wave * 4096) + i * 8;
            float lg[8];
#pragma unroll
            for (int e = 0; e < 8; ++e) lg[e] = lp[e];
            int e1 = 0; float l1 = lg[0];
#pragma unroll
            for (int e = 1; e < 8; ++e) if (lg[e] > l1) { l1 = lg[e]; e1 = e; }
            int e2 = -1; float l2 = -INFINITY;
#pragma unroll
            for (int e = 0; e < 8; ++e) if (e != e1 && lg[e] > l2) { l2 = lg[e]; e2 = e; }
            const float g2 = 1.f / (1.f + expf(l1 - l2)), g1 = 1.f - g2;
            int* rt = (int*)(route + (size_t)row * 24); rt[0] = e1; rt[1] = e2; ((float*)rt)[2] = g1; ((float*)rt)[3] = g2;
            atomicAdd((int*)&cntL[e1], 1); atomicAdd((int*)&cntL[e2], 1);
        }
    }
}

constexpr int AT_XCH = 65536, AT_ANW = 131072;
DI float max3f(float a, float b, float c) { return fmaxf(fmaxf(a, b), c); }
DI float xhalf(float v, int hi) {
    const auto rr = __builtin_amdgcn_permlane32_swap(__float_as_uint(v), __float_as_uint(v), false, false);
    return __uint_as_float(hi ? rr[0] : rr[1]);
}
constexpr float AT_THR = 8.f;
DI void attn_unit(const Ctx& C, bf16_t* P, int qrow0, int krow_ctx, int krow_lat, int nkt, int h, float lam, const float* anw, float post) {
    const int tid_ = my_tid();
    LAS unsigned char* lds = C.lds; const int lane = tid_ & 63, wid = __builtin_amdgcn_readfirstlane(tid_ >> 6), sub = wid >> 2, qw = wid & 3, r32 = lane & 31, hh = lane >> 5;
    const int tq = (lane & 15) >> 2, tp = lane & 3, blk = (lane >> 4) & 1;
    LAS unsigned char* qlds = lds + AT_XCH + wid * 8192 + r32 * 16;
#pragma unroll
    for (int qb = 0; qb < 2; ++qb) { const bf16_t* qp = P + (size_t)(qrow0 + 64 * qw + 32 * qb + r32) * PW + PC_Q + h * 128 + sub * 64 + 8 * hh;
#pragma unroll
      for (int ks = 0; ks < 4; ++ks) *(LAS bf16x8*)(qlds + ((2 * ks + hh) * 64 + 32 * qb) * 16) = *(const bf16x8*)(qp + 16 * ks); }
    if (tid_ < 32) *(LAS f32x4*)(lds + AT_ANW + tid_ * 16) = *(const f32x4*)(anw + 4 * tid_);
    f32x16 O[2][4];
#pragma unroll
    for (int qb = 0; qb < 2; ++qb)
#pragma unroll
        for (int c = 0; c < 4; ++c)
#pragma unroll
            for (int i = 0; i < 16; ++i) O[qb][c][i] = 0.f;
    float m_run[2] = {-INFINITY, -INFINITY}, l_run[2] = {0.f, 0.f};
#define AT_ISSUE(kt, buf) do { const int kr0_ = (kt) < 4 ? krow_ctx + (kt) * 64 : krow_lat + ((kt) - 4) * 64; LAS unsigned char* bb_ = lds + (buf) * 32768; \
        _Pragma("unroll") for (int j_ = 0; j_ < 2; ++j_) { const int c_ = 2 * wid + j_; \
            dma16(P + (size_t)(kr0_ + lane) * PW + PC_K + h * 128 + c_ * 8, bb_ + c_ * 1024); \
            dma16(P + (size_t)(kr0_ + 16 * (c_ & 3) + (lane >> 2)) * PW + PC_V + h * 128 + (c_ >> 2) * 32 + (lane & 3) * 8, bb_ + 16384 + c_ * 1024); } } while (0)
    AT_ISSUE(0, 0);
    int buf = 0;
#pragma unroll 1
    for (int kt = 0; kt < nkt; ++kt) {
        VM_WAIT(); __syncthreads();
        if (kt + 1 < nkt) AT_ISSUE(kt + 1, buf ^ 1);
        const LAS unsigned char* kb = lds + buf * 32768, * vb = kb + 16384 + (4 * hh + tq) * 64 + blk * 32 + tp * 8;
        bf16x8 Pf[2][4];
#pragma unroll
        for (int qb = 0; qb < 2; ++qb) {
            f32x16 s0, s1;
#pragma unroll
            for (int i = 0; i < 16; ++i) { s0[i] = 0.f; s1[i] = 0.f; }
#pragma unroll
            for (int ks = 0; ks < 4; ++ks) { const LAS unsigned char* kp = kb + ((sub * 8 + 2 * ks + hh) * 64 + r32) * 16;
                const bf16x8 k0 = *(const LAS bf16x8*)kp, k1 = *(const LAS bf16x8*)(kp + 512);
                const bf16x8 q = *(const LAS bf16x8*)(qlds + ((2 * ks + hh) * 64 + 32 * qb) * 16);
                s0 = MFMA32(k0, q, s0); s1 = MFMA32(k1, q, s1); }
            float mx = max3f(s0[0], s1[0], s0[1]);
#pragma unroll
            for (int i = 1; i < 16; ++i) mx = (i + 1 < 16) ? max3f(mx, s1[i], s0[i + 1]) : fmaxf(mx, s1[i]);
            mx = fmaxf(mx, xhalf(mx, hh));
            const float mnew = fmaxf(m_run[qb], mx);
            if (__any(mx > m_run[qb] + AT_THR)) { const float alpha = __builtin_amdgcn_exp2f(m_run[qb] - mnew); l_run[qb] *= alpha;
#pragma unroll
                for (int c = 0; c < 4; ++c)
#pragma unroll
                    for (int i = 0; i < 16; ++i) O[qb][c][i] *= alpha;
                m_run[qb] = mnew; }
            const float mr = m_run[qb]; float ps0 = 0.f, ps1 = 0.f;
#pragma unroll
            for (int i = 0; i < 16; ++i) { s0[i] = __builtin_amdgcn_exp2f(s0[i] - mr); s1[i] = __builtin_amdgcn_exp2f(s1[i] - mr); ps0 += s0[i]; ps1 += s1[i]; }
            l_run[qb] += ps0 + ps1;
            Pf[qb][0] = packf8(s0, 0); Pf[qb][1] = packf8(s0, 1); Pf[qb][2] = packf8(s1, 0); Pf[qb][3] = packf8(s1, 1);
        }
#pragma unroll
        for (int cb = 0; cb < 4; ++cb) {
#pragma unroll
            for (int s4 = 0; s4 < 4; ++s4) { const bf16x8 a = cat8(tr16(vb + cb * 4096 + s4 * 1024), tr16(vb + cb * 4096 + s4 * 1024 + 512));
                O[0][cb] = MFMA32(a, Pf[0][s4], O[0][cb]); O[1][cb] = MFMA32(a, Pf[1][s4], O[1][cb]); } }
        buf ^= 1;
    }
#undef AT_ISSUE
    LDS_WAIT(); __syncthreads();
    const int te = my_tid(); const int lane_e = te & 63, wid_e = __builtin_amdgcn_readfirstlane(te >> 6);
    LAS float* xch = (LAS float*)(lds + AT_XCH) + (wid_e & 3) * 4096 + lane_e;
#pragma unroll
    for (int qb = 0; qb < 2; ++qb) {
        const float lt = l_run[qb] + xhalf(l_run[qb], lane_e >> 5); const float inv = 1.f / lt;
        if ((wid_e >> 2) == 1) { const float sc = -lam * inv;
#pragma unroll
            for (int c = 0; c < 4; ++c)
#pragma unroll
                for (int i = 0; i < 16; ++i) xch[(c * 16 + i) * 64] = O[qb][c][i] * sc; }
        LDS_WAIT(); __syncthreads();
        if ((wid_e >> 2) == 0) {
            float ss = 0.f;
#pragma unroll
            for (int c = 0; c < 4; ++c)
#pragma unroll
                for (int i = 0; i < 16; ++i) { const float o = O[qb][c][i] * inv + xch[(c * 16 + i) * 64]; O[qb][c][i] = o; ss += o * o; }
            ss += xhalf(ss, lane_e >> 5);
            const float rs = post / sqrtf(ss * (1.f / 128.f) + EPS);
            bf16_t* op = P + (size_t)(qrow0 + 64 * (wid_e & 3) + 32 * qb + (lane_e & 31)) * PW + PC_Q + h * 128;
#pragma unroll
            for (int c = 0; c < 4; ++c)
#pragma unroll
                for (int g = 0; g < 4; ++g) { const int v0 = 32 * c + 8 * g + 4 * (lane_e >> 5); const f32x4 w = *(const LAS f32x4*)(lds + AT_ANW + v0 * 4);
                    u32x2 o; o.x = cvt_pk_bf16(O[qb][c][4 * g] * rs * w[0], O[qb][c][4 * g + 1] * rs * w[1]); o.y = cvt_pk_bf16(O[qb][c][4 * g + 2] * rs * w[2], O[qb][c][4 * g + 3] * rs * w[3]);
                    *(u32x2*)(op + v0) = o; }
        }
        LDS_WAIT(); __syncthreads();
    }
}

constexpr int SC_Q = 0, SC_LF = 16384, SC_V0 = 32768, SC_QM = 65536, SC_KMR = 81920, SC_KMS = 98304, SC_SX = 114688, SC_A31 = 147456, SC_A63 = 147968, SC_END = 148480;
DI void scan_chain(const Ctx& C, bf16_t* P, int b, int h, int dir, bool store_ctx) {
    const int tid_ = my_tid();
    LAS unsigned char* lds = C.lds; const int lane = tid_ & 63, wid = __builtin_amdgcn_readfirstlane(tid_ >> 6), r32 = lane & 31, hh = lane >> 5;
    const int tq = (lane & 15) >> 2, tp = lane & 3, blk = (lane >> 4) & 1;
    const int db = wid & 3, tb = wid >> 2;
    const int base_nat = hh * 512 + tq * 64 + blk * 32 + tp * 8;
    const int base_prm = (4 * hh + tq) * 64 + blk * 32 + tp * 8;
    const int lfcol = (dir ? PC_LB : PC_LF) + h * 128, qcol = PC_RQ + h * 128, vcol = PC_RI + h * 128;
    f32x16 ST[2];
#pragma unroll
    for (int j = 0; j < 2; ++j)
#pragma unroll
        for (int i = 0; i < 16; ++i) ST[j][i] = 0.f;
#define SROW(c, i) ((c) < 4 ? NLAT + b * CL + (dir ? 255 - ((c) * 64 + (i)) : (c) * 64 + (i)) : b * T + (dir ? 2047 - (((c) - 4) * 64 + (i)) : ((c) - 4) * 64 + (i)))
#define SDMA(c, colbase, dstoff) do { _Pragma("unroll") for (int j_ = 0; j_ < 2; ++j_) { const int I_ = 2 * wid + j_; const int ti_ = 16 * (I_ & 3) + (lane >> 2); \
        dma16(P + (size_t)SROW(c, ti_) * PW + (colbase) + (I_ >> 2) * 32 + (lane & 3) * 8, lds + (dstoff) + I_ * 1024); } } while (0)
    SDMA(0, qcol, SC_Q); SDMA(0, lfcol, SC_LF); SDMA(0, vcol, SC_V0);
    int vbuf = 0;
    const int t = 32 * tb + r32;
#pragma unroll 1
    for (int c = 0; c < 36; ++c) {
        { const int st_ = __builtin_amdgcn_readfirstlane((c > 0 && (c > 4 || store_ctx)) ? 1 : 0);
          asm volatile("s_cmp_lg_u32 %0, 0\n\ts_cbranch_scc1 1f\n\ts_waitcnt vmcnt(0)\n1:\n\ts_waitcnt vmcnt(4)" :: "s"(st_) : "memory", "scc"); }
        LDS_BARRIER();
        const LAS unsigned char* Vimg = lds + SC_V0 + vbuf * 16384;
        f32x16 cm;
#pragma unroll
        for (int i = 0; i < 16; ++i) cm[i] = 0.f;
#pragma unroll
        for (int kk = 0; kk < 2; ++kk) { const int ks = 2 * tb + kk;
            const half8 a = __builtin_bit_cast(half8, cat8(tr16(lds + SC_LF + db * 4096 + base_nat + ks * 1024), tr16(lds + SC_LF + db * 4096 + base_nat + ks * 1024 + 256)));
            half8 bm;
#pragma unroll
            for (int j = 0; j < 8; ++j) { const int s = 16 * ks + 8 * hh + j; bm[j] = tb == 0 ? (s > t ? (_Float16)-1.f : (_Float16)0.f) : (s <= t ? (_Float16)1.f : (_Float16)0.f); }
            cm = __builtin_amdgcn_mfma_f32_32x32x16_f16(a, bm, cm, 0, 0, 0); }
#pragma unroll
        for (int g = 0; g < 4; ++g) {
            const int sa = db * 4096 + (t >> 3) * 512 + (t & 7) * 64 + (8 * g + 4 * hh) * 2;
            const u32x2 q4 = *(const LAS u32x2*)(lds + SC_Q + sa); const half4 lf4 = *(const LAS half4*)(lds + SC_LF + sa);
            const float qv[4] = {bflo(q4.x), bfhi(q4.x), bflo(q4.y), bfhi(q4.y)};
            float qm[4], km[4];
#pragma unroll
            for (int e = 0; e < 4; ++e) { const float cv = cm[4 * g + e] * LOG2E; const float E = __builtin_amdgcn_exp2f(cv), Ei = __builtin_amdgcn_exp2f(-cv);
                const float lf = (float)lf4[e]; qm[e] = qv[e] * E; km[e] = (1.f - __builtin_amdgcn_exp2f(lf * LOG2E)) * Ei;
                if (tb == 0 && r32 == 0) ((LAS float*)(lds + SC_A31))[32 * db + 8 * g + 4 * hh + e] = lf - cm[4 * g + e];
                if (tb == 1 && r32 == 31) ((LAS float*)(lds + SC_A63))[32 * db + 8 * g + 4 * hh + e] = cm[4 * g + e]; }
            u32x2 qw2, kw2; qw2.x = cvt_pk_bf16(qm[0], qm[1]); qw2.y = cvt_pk_bf16(qm[2], qm[3]); kw2.x = cvt_pk_bf16(km[0], km[1]); kw2.y = cvt_pk_bf16(km[2], km[3]);
            const int ra = ((4 * db + g) * 64 + t) * 16 + 8 * hh;
            *(LAS u32x2*)(lds + SC_QM + ra) = qw2; *(LAS u32x2*)(lds + SC_KMR + ra) = kw2; *(LAS u32x2*)(lds + SC_KMS + sa) = kw2;
        }
        LDS_BARRIER();
        if (c + 1 < 36) { SDMA(c + 1, qcol, SC_Q); SDMA(c + 1, lfcol, SC_LF); SDMA(c + 1, vcol, SC_V0 + (vbuf ^ 1) * 16384); }
        { const int d = 32 * db + r32; const float c31 = ((LAS float*)(lds + SC_A31))[d], c63 = ((LAS float*)(lds + SC_A63))[d];
          const float e31 = __expf(c31), dec = __expf(c31 + c63), e63 = __expf(c63);
          f32x16 SN[2];
#pragma unroll
          for (int j = 0; j < 2; ++j) { const int vb2 = 2 * tb + j;
#pragma unroll
              for (int g = 0; g < 4; ++g) { u32x2 w; w.x = cvt_pk_bf16(ST[j][4 * g] * e31, ST[j][4 * g + 1] * e31); w.y = cvt_pk_bf16(ST[j][4 * g + 2] * e31, ST[j][4 * g + 3] * e31);
                  *(LAS u32x2*)(lds + SC_SX + vb2 * 8192 + (d >> 3) * 512 + (d & 7) * 64 + (8 * g + 4 * hh) * 2) = w; }
#pragma unroll
              for (int i = 0; i < 16; ++i) SN[j][i] = 0.f; }
#pragma unroll
          for (int ks = 0; ks < 4; ++ks) {
              const bf16x8 kf = cat8(tr16(lds + SC_KMS + db * 4096 + base_nat + ks * 1024), tr16(lds + SC_KMS + db * 4096 + base_nat + ks * 1024 + 256));
#pragma unroll
              for (int j = 0; j < 2; ++j) { const int vb2 = 2 * tb + j;
                  const bf16x8 vf = cat8(tr16(Vimg + vb2 * 4096 + base_nat + ks * 1024), tr16(Vimg + vb2 * 4096 + base_nat + ks * 1024 + 256));
                  SN[j] = MFMA32(vf, kf, SN[j]); } }
#pragma unroll
          for (int j = 0; j < 2; ++j)
#pragma unroll
              for (int i = 0; i < 16; ++i) ST[j][i] = dec * ST[j][i] + e63 * SN[j][i];
        }
        LDS_BARRIER();
        { bf16x8 Qmf[8];
#pragma unroll
          for (int kd = 0; kd < 8; ++kd) Qmf[kd] = *(const LAS bf16x8*)(lds + SC_QM + ((2 * kd + hh) * 64 + t) * 16);
          f32x16 o;
#pragma unroll
          for (int i = 0; i < 16; ++i) o[i] = 0.f;
          for (int sb = 0; sb <= tb; ++sb) {
              f32x16 pt;
#pragma unroll
              for (int i = 0; i < 16; ++i) pt[i] = 0.f;
#pragma unroll
              for (int kd = 0; kd < 8; ++kd) { const bf16x8 a = *(const LAS bf16x8*)(lds + SC_KMR + ((2 * kd + hh) * 64 + 32 * sb + r32) * 16); pt = MFMA32(a, Qmf[kd], pt); }
              if (sb == tb) {
#pragma unroll
                  for (int i = 0; i < 16; ++i) if (crow(i, hh) > r32) pt[i] = 0.f; }
              const bf16x8 p0 = packf8(pt, 0), p1 = packf8(pt, 1);
              { const bf16x8 a = cat8(tr16(Vimg + db * 4096 + base_prm + (2 * sb) * 1024), tr16(Vimg + db * 4096 + base_prm + (2 * sb) * 1024 + 512)); o = MFMA32(a, p0, o); }
              { const bf16x8 a = cat8(tr16(Vimg + db * 4096 + base_prm + (2 * sb + 1) * 1024), tr16(Vimg + db * 4096 + base_prm + (2 * sb + 1) * 1024 + 512)); o = MFMA32(a, p1, o); }
          }
#pragma unroll
          for (int kd = 0; kd < 8; ++kd) { const bf16x8 a = cat8(tr16(lds + SC_SX + db * 8192 + base_nat + kd * 1024), tr16(lds + SC_SX + db * 8192 + base_nat + kd * 1024 + 256)); o = MFMA32(a, Qmf[kd], o); }
          if (c >= 4 || store_ctx) { bf16_t* op = P + (size_t)SROW(c, t) * PW + lfcol + 32 * db;
#pragma unroll
              for (int g = 0; g < 4; ++g) { u32x2 w; w.x = cvt_pk_bf16(o[4 * g], o[4 * g + 1]); w.y = cvt_pk_bf16(o[4 * g + 2], o[4 * g + 3]); *(u32x2*)(op + 8 * g + 4 * hh) = w; } }
        }
        vbuf ^= 1;
    }
    VM_WAIT(); LDS_WAIT(); __syncthreads();
#undef SROW
#undef SDMA
}

DI void phase_recprep(const Ctx& C, bf16_t* P, const float* rnw, int nrows) {
    const f32x4 w0 = *(const f32x4*)(rnw + ((8 * C.lane) & 127)), w1 = *(const f32x4*)(rnw + ((8 * C.lane) & 127) + 4);
    for (int row0 = C.gw; row0 < nrows; row0 += 4 * C.NGW) {
        u32x4 ra[4], rb[4], rg[4];
#pragma unroll
        for (int u = 0; u < 4; ++u) { const int row = row0 + u * C.NGW < nrows ? row0 + u * C.NGW : row0; const bf16_t* pr = P + (size_t)row * PW + 8 * C.lane;
            ra[u] = *(const u32x4*)(pr + PC_LF); rb[u] = *(const u32x4*)(pr + PC_LB); rg[u] = *(const u32x4*)(pr + PC_G); }
#pragma unroll
        for (int u = 0; u < 4; ++u) { const int row = row0 + u * C.NGW; if (row >= nrows) break;
            float a[8], bb[8], g[8]; unpack8(ra[u], a); unpack8(rb[u], bb); unpack8(rg[u], g);
            float ss = 0.f;
#pragma unroll
            for (int j = 0; j < 8; ++j) { a[j] += bb[j]; ss += a[j] * a[j]; }
            ss += __shfl_xor(ss, 1); ss += __shfl_xor(ss, 2); ss += __shfl_xor(ss, 4); ss += __shfl_xor(ss, 8);
            const float rs = 1.0f / sqrtf(ss * (1.f / 128.f) + EPS);
            f32x4 o0, o1;
#pragma unroll
            for (int j = 0; j < 4; ++j) { o0[j] = a[j] * rs * w0[j] * g[j]; o1[j] = a[4 + j] * rs * w1[j] * g[4 + j]; }
            *(u32x4*)(P + (size_t)row * PW + 8 * C.lane + PC_LF) = pack8(o0, o1); }
    }
}

DI void phase_slots(const Ctx& C, const int* cnt, int* pbout, unsigned char* route, const bf16_t* H2, bf16_t* AG, LAS int* cur) {
    if (C.tid < 16) cur[C.tid] = 0;
    __syncthreads();
    for (int g = C.tid; g < C.G; g += 512) {
#pragma unroll
        for (int k = 0; k < 8; ++k) { const int c = cnt[g * 8 + k]; atomicAdd((int*)&cur[8 + k], c); if (g < C.bx) atomicAdd((int*)&cur[k], c); } }
    __syncthreads();
    if (C.tid < 8) { const int e = C.tid; int pb = 0, pbe = 0;
#pragma unroll
        for (int k = 0; k < 8; ++k) { if (k == e) pbe = pb; pb += (cur[8 + k] + 255) >> 8; }
        const int mine = cur[e];
        if (C.bx == 0) { pbout[e] = pbe; if (e == 7) pbout[8] = pb; }
        cur[e] = pbe * 256 + mine;
    }
    __syncthreads();
    const int nloc = (NLAT - C.gw + C.NGW - 1) / C.NGW;
    LAS int* tab = (LAS int*)(C.lds + C.wave * 2048);
    for (int i = C.lane; i < nloc; i += 64) { int* rt = (int*)(route + (size_t)(C.gw + i * C.NGW) * 24);
        const int s1 = atomicAdd((int*)&cur[rt[0]], 1), s2 = atomicAdd((int*)&cur[rt[1]], 1); rt[4] = s1; rt[5] = s2; tab[2 * i] = s1; tab[2 * i + 1] = s2; }
    LDS_WAIT();
    for (int i = 0; i < nloc; i += 2) { const int i1 = i + 1 < nloc ? i + 1 : i;
        const int sa1 = __builtin_amdgcn_readfirstlane(tab[2 * i]), sa2 = __builtin_amdgcn_readfirstlane(tab[2 * i + 1]), sb1 = __builtin_amdgcn_readfirstlane(tab[2 * i1]), sb2 = __builtin_amdgcn_readfirstlane(tab[2 * i1 + 1]);
        const u32x4 va = *((const u32x4*)((const unsigned char*)H2 + (size_t)(C.gw + i * C.NGW) * D) + C.lane);
        const u32x4 vb = *((const u32x4*)((const unsigned char*)H2 + (size_t)(C.gw + i1 * C.NGW) * D) + C.lane);
        *((u32x4*)((unsigned char*)AG + (size_t)sa1 * D) + C.lane) = va; *((u32x4*)((unsigned char*)AG + (size_t)sa2 * D) + C.lane) = va;
        *((u32x4*)((unsigned char*)AG + (size_t)sb1 * D) + C.lane) = vb; *((u32x4*)((unsigned char*)AG + (size_t)sb2 * D) + C.lane) = vb;
    }
}
DI void phase_final(const Ctx& C, float* x, const unsigned char* route, const bf16_t* Y, const float* mods1, const float* fw) {
    for (int row0 = C.gw; row0 < NLAT; row0 += 2 * C.NGW) {
        const int rows[2] = {row0, row0 + C.NGW < NLAT ? row0 + C.NGW : row0};
        f32x4 v[2][4]; float ss[2] = {0.f, 0.f};
#pragma unroll
        for (int u = 0; u < 2; ++u) { const int row = rows[u];
            const int* rt = (const int*)(route + (size_t)row * 24); const float g1 = ((const float*)rt)[2], g2 = ((const float*)rt)[3]; const int s1 = rt[4], s2 = rt[5];
            const float* mv = mods1 + (size_t)(row >> 11) * DIN + 5 * D; const float* xr = x + (size_t)row * D;
#pragma unroll
            for (int j = 0; j < 4; ++j) { const int c0 = 256 * j + 4 * C.lane;
                const u32x2 y1 = *(const u32x2*)(Y + (size_t)s1 * D + c0), y2 = *(const u32x2*)(Y + (size_t)s2 * D + c0); const f32x4 m5 = *(const f32x4*)(mv + c0);
                f32x4 y; y[0] = g1 * bflo(y1.x) + g2 * bflo(y2.x); y[1] = g1 * bfhi(y1.x) + g2 * bfhi(y2.x); y[2] = g1 * bflo(y1.y) + g2 * bflo(y2.y); y[3] = g1 * bfhi(y1.y) + g2 * bfhi(y2.y);
                v[u][j] = *(const f32x4*)(xr + c0) + m5 * y; ss[u] += (v[u][j][0] * v[u][j][0] + v[u][j][1] * v[u][j][1]) + (v[u][j][2] * v[u][j][2] + v[u][j][3] * v[u][j][3]); } }
#pragma unroll
        for (int u = 0; u < 2; ++u) { if (u == 1 && rows[1] == rows[0]) break;
            const float rstd = 1.0f / sqrtf(wave_sum(ss[u]) * (1.f / D) + EPS); float* xr = x + (size_t)rows[u] * D;
#pragma unroll
            for (int j = 0; j < 4; ++j) { const int c0 = 256 * j + 4 * C.lane; *(f32x4*)(xr + c0) = v[u][j] * rstd * *(const f32x4*)(fw + c0); } }
    }
}

constexpr int LDS_MISC = SC_END;
constexpr int LDS_BYTES = SC_END + 512;
static_assert(LDS_WTAB_OFF == SC_END + 128, "wave table sits behind the barrier words and counters");
constexpr int NPHASE = 20;

DI Ctx make_ctx() {
    extern __shared__ __attribute__((aligned(16))) unsigned char lds_raw[];
    Ctx C; const int t = my_tid();
    unsigned lb = (unsigned)(size_t)(LAS unsigned char*)lds_raw; asm volatile("" : "+s"(lb));
    C.lds = (LAS unsigned char*)(size_t)lb; C.ws = kparams()->ws; C.tid = t; C.lane = t & 63; C.wave = __builtin_amdgcn_readfirstlane(t >> 6);
    int bx = blockIdx.x, G = gridDim.x; asm volatile("" : "+s"(bx), "+s"(G));
    C.bx = bx; C.G = G; C.vcu = (C.G % 8 == 0) ? (bx % 8) * (C.G / 8) + bx / 8 : bx;
    C.gw = C.vcu * 8 + C.wave; C.NGW = C.G * 8;
    return C;
}
DI void grid_barrier() {
    extern __shared__ __attribute__((aligned(16))) unsigned char lds_raw[];
    XcdBarrier b; b.bar = (unsigned*)(kparams()->ws + WS_CTL) + CW_BAR + kparams()->li * XCD_BAR_WORDS; b.x = xb_xcc_id(); b.st = (volatile LAS unsigned*)((LAS unsigned char*)lds_raw + LDS_MISC);
    xcd_barrier(b);
}
#define WSP(T, off) ((T*)(kparams()->ws + (off)))

#define IN(k) (kparams()->ph_lo <= (k) && (k) < kparams()->ph_hi)
#define SEAM(k) do { if (IN(k) && IN((k) + 1)) grid_barrier(); } while (0)


template <int l> DI void layer_phases() {
        const int pb = 1 + 9 * l;
#define LQ() int lq = l; asm volatile("" : "+s"(lq))
#define XL (lq == 0 ? PIN(0) : (const float*)POUT)
#define XC (lq == 0 ? PIN(2) : (const float*)WSP(float, WS_CTXRES))
#define LMODS (WSP(float, WS_MODS) + (size_t)lq * 33 * DIN)
#define NROWS_OUT (lq == 0 ? NTOK : NLAT)
        if (IN(pb + 0)) { LQ(); const Ctx C = make_ctx(); phase_norm<false>(C, XL, XC, PIN(6) + lq * D, LMODS, 0, NTOK, WSP(bf16_t, WS_H), nullptr, nullptr, nullptr, WSP(unsigned char, WS_H8)); }
        SEAM(pb + 0);
        if (IN(pb + 1)) { LQ();
            { const Ctx C = make_ctx();
              Gemm g{WSP(bf16_t, WS_H), WSP(bf16_t, WS_WIN) + (size_t)lq * 4096 * D, NTOK, N_SEC_BF * 512, D, D};
              pg8::StaticOrder S; S.init(g, C.G, C.bx);
              EpiInProj E{WSP(bf16_t, WS_P), WSP(float2, WS_ROPE), WSP(float, WS_LBS) + lq * 1024, WSP(float, WS_LBS) + lq * 1024 + 512, (int)secmap_of(false), 1.f};
              pg8::gemm_phase<EpiInProj, pg8::StaticOrder>(C.lds, g, S, E); }
            if (N_SEC_F8 > 0) { const Ctx C = make_ctx();
              Gemm g{WSP(bf16_t, WS_H8), (const bf16_t*)(WSP(unsigned char, WS_WIN8) + (size_t)lq * 4096 * D), NTOK, N_SEC_F8 * 512, D / 2, D / 2};
              pg8::StaticOrder S; S.init(g, C.G, C.bx);
              EpiInProj E{WSP(bf16_t, WS_P), WSP(float2, WS_ROPE), WSP(float, WS_LBS) + lq * 1024, WSP(float, WS_LBS) + lq * 1024 + 512, (int)secmap_of(true), 1.f / WIN8_SCALE};
              pg8::gemm_phase<EpiInProj, pg8::StaticOrder, true, true>(C.lds, g, S, E); }
        }
        SEAM(pb + 1);
        if (IN(pb + 2)) { LQ(); const Ctx C = make_ctx(); bf16_t* const Pb = WSP(bf16_t, WS_P);
            for (int id = C.vcu; id < NB * 4 * 2; id += C.G) scan_chain(C, Pb, id >> 3, (id >> 1) & 3, id & 1, lq == 0);
            float lam;
            { const float a = wave_sum(PIN(9)[lq * 64 + C.lane] * PIN(10)[lq * 64 + C.lane]), b2 = wave_sum(PIN(11)[lq * 64 + C.lane] * PIN(12)[lq * 64 + C.lane]);
              const float li = 0.8f - 0.6f * expf(-0.3f * (float)lq); lam = expf(a) - expf(b2) + li; lam = __uint_as_float(__builtin_amdgcn_readfirstlane(__float_as_uint(lam))); }
            const float post = __uint_as_float(__builtin_amdgcn_readfirstlane(__float_as_uint(1.f - (0.8f - 0.6f * expf(-0.3f * (float)lq)))));
            const float* anw = PIN(13) + lq * 128;
            const int NU = NB * 4 * 8, U = (NU + C.G - 1) / C.G;
            for (int id = C.vcu * U; id < NU && id < (C.vcu + 1) * U; ++id) { const int bh = id >> 3, qb = id & 7, b = bh >> 2, h = bh & 3;
                attn_unit(C, Pb, b * T + qb * 256, NLAT + b * CL, b * T, 36, h, lam, anw, post); }
            if (lq == 0) for (int id = C.vcu; id < NB * 4; id += C.G) { const int b = id >> 2, h = id & 3;
                attn_unit(C, Pb, NLAT + b * CL, NLAT + b * CL, 0, 4, h, lam, anw, post); }
        }
        SEAM(pb + 2);
        if (IN(pb + 3)) { LQ(); const Ctx C = make_ctx();
            phase_recprep(C, WSP(bf16_t, WS_P), PIN(14) + lq * 128, NROWS_OUT);
            Gemm g{WSP(bf16_t, WS_H8), (const bf16_t*)(WSP(unsigned char, WS_WIN8) + ((size_t)lq * 4096 + N_SEC_F8 * 512) * D), NROWS_OUT, 2048, D / 2, D / 2};
            pg8::StaticOrder S; S.init(g, C.G, C.bx);
            EpiGates E{WSP(bf16_t, WS_P), 1.f / WIN8_SCALE};
            pg8::gemm_phase<EpiGates, pg8::StaticOrder, true, true>(C.lds, g, S, E);
        }
        SEAM(pb + 3);
        if (IN(pb + 4)) { LQ(); const Ctx C = make_ctx();
            Gemm g{WSP(bf16_t, WS_P) + PC_Q, WSP(bf16_t, WS_WUA) + (size_t)lq * D * D, NROWS_OUT, D, D, PW};
            pg8::StaticOrder S; S.init(g, C.G, C.bx); EpiMergeFused E{WSP(bf16_t, WS_P), WSP(bf16_t, WS_MERGED)};
            pg8::gemm_phase<EpiMergeFused, pg8::StaticOrder, true, false, true>(C.lds, g, S, E);
        }
        SEAM(pb + 4);
        if (IN(pb + 5)) { LQ(); const Ctx C = make_ctx();
            Gemm g{WSP(bf16_t, WS_MERGED), WSP(bf16_t, WS_WO) + (size_t)lq * D * D, NROWS_OUT, D, D, D};
            pg8::StaticOrder S; S.init(g, C.G, C.bx);
            EpiResid E{XL, XC, POUT, WSP(float, WS_CTXRES), LMODS, 2};
            pg8::gemm_phase<EpiResid, pg8::StaticOrder>(C.lds, g, S, E);
        }
        SEAM(pb + 5);
        if (l == 0) {
            if (IN(7)) { LQ(); const Ctx C = make_ctx(); phase_norm<false>(C, POUT, WSP(float, WS_CTXRES), PIN(7), LMODS, 3, NTOK, WSP(bf16_t, WS_H), nullptr, nullptr, nullptr); }
            SEAM(7);
            if (IN(8)) { LQ(); const Ctx C = make_ctx();
                Gemm g{WSP(bf16_t, WS_H), WSP(bf16_t, WS_W13), NTOK, 2 * DFFP, D, D};
                pg8::StaticOrder S; S.init(g, C.G, C.bx); EpiSwiglu E{WSP(bf16_t, WS_HID), DFFP, 0};
                pg8::gemm_phase<EpiSwiglu, pg8::StaticOrder>(C.lds, g, S, E);
            }
            SEAM(8);
            if (IN(9)) { LQ(); const Ctx C = make_ctx();
                Gemm g{WSP(bf16_t, WS_HID), WSP(bf16_t, WS_W2), NTOK, D, DFFP, DFFP};
                pg8::StaticOrder S; S.init(g, C.G, C.bx); EpiResid E{POUT, WSP(float, WS_CTXRES), POUT, WSP(float, WS_CTXRES), LMODS, 5};
                pg8::gemm_phase<EpiResid, pg8::StaticOrder>(C.lds, g, S, E);
            }
            SEAM(9);
        } else {
            if (IN(16)) { LQ(); const Ctx C = make_ctx(); LAS int* lcnt = (LAS int*)(C.lds + LDS_MISC + 32);
                if (C.tid < 8) lcnt[C.tid] = 0;
                __syncthreads();
                phase_norm<true>(C, POUT, nullptr, PIN(7) + D, LMODS, 3, NLAT, WSP(bf16_t, WS_H2M), PIN(23), WSP(unsigned char, WS_ROUTE), lcnt);
                __syncthreads();
                if (C.tid < 8) WSP(int, WS_CNT)[C.bx * 8 + C.tid] = lcnt[C.tid];
                convert_moe_weights(C);
            }
            SEAM(16);
            if (IN(17)) { LQ(); const Ctx C = make_ctx(); phase_slots(C, WSP(int, WS_CNT), WSP(int, WS_CNT) + 4096, WSP(unsigned char, WS_ROUTE), WSP(bf16_t, WS_H2M), WSP(bf16_t, WS_AG), (LAS int*)(C.lds + LDS_MISC + 32)); }
            SEAM(17);
            if (IN(18)) { LQ();
                const int ptot = __builtin_amdgcn_readfirstlane(WSP(int, WS_CNT)[4096 + 8]);
                for (int p0 = 0; p0 < ptot; p0 += MOE_CHUNK) {
                    const int np = (ptot - p0) < MOE_CHUNK ? (ptot - p0) : MOE_CHUNK;
#define MOE_ORDER_INIT(S) do { S.so.init(g, C.G, C.bx); S.p0 = p0; S.load_pb(WSP(int, WS_CNT) + 4096); } while (0)
                    { const Ctx C = make_ctx(); Gemm g{WSP(bf16_t, WS_AG), WSP(bf16_t, WS_WM13), np * 256, 2 * DFE, D / 2, D / 2};
                      pg8::MoeOrder S; MOE_ORDER_INIT(S); S.apan0 = 0; S.estride = (size_t)2 * DFE * D;
                      EpiSwiglu8 E{WSP(unsigned char, WS_MHID), DFE, p0, 1.f / W13_SCALE, HID_SCALE};
                      pg8::gemm_phase<EpiSwiglu8, pg8::MoeOrder, true, true>(C.lds, g, S, E); }
                    grid_barrier();
                    { const Ctx C = make_ctx(); Gemm g{WSP(bf16_t, WS_MHID), WSP(bf16_t, WS_WM2), np * 256, D, DFE / 2, DFE / 2};
                      pg8::MoeOrder S; MOE_ORDER_INIT(S); S.apan0 = p0; S.estride = (size_t)D * DFE;
                      EpiBf16 E{WSP(bf16_t, WS_Y), D, 1.f / (W2_SCALE * HID_SCALE)};
                      pg8::gemm_phase<EpiBf16, pg8::MoeOrder, true, true>(C.lds, g, S, E); }
                    grid_barrier();
                }
            }
            if (IN(19)) { LQ(); const Ctx C = make_ctx(); phase_final(C, POUT, WSP(unsigned char, WS_ROUTE), WSP(bf16_t, WS_Y), LMODS, PIN(27)); }
        }
}

__global__ void __launch_bounds__(512, 2) fwd_kernel(Params p) {
    extern __shared__ __attribute__((aligned(16))) unsigned char lds_raw[];
    (void)p;
    { volatile LAS unsigned* misc = (volatile LAS unsigned*)((LAS unsigned char*)lds_raw + LDS_MISC);
      if (threadIdx.x < 16) misc[threadIdx.x] = 0u;
      if ((threadIdx.x & 63) == 0) ((volatile LAS int*)((LAS unsigned char*)lds_raw + LDS_WTAB_OFF))[(unsigned)__builtin_amdgcn_s_getreg((5 << 11) | 4) & 63u] = threadIdx.x >> 6;
      __syncthreads();
      (void)xcd_barrier_post((unsigned*)(kparams()->ws + WS_CTL) + CW_BAR + kparams()->li * XCD_BAR_WORDS, misc); }
    if (IN(0)) { const Ctx C = make_ctx(); phase_prologue(C); } SEAM(0);

    layer_phases<0>();
    layer_phases<1>();
#undef IN
#undef SEAM
}


extern "C" void kernel_launch(void* const* d_in, const int* in_sizes, int n_in, void* d_out, int out_size, void* d_ws, size_t ws_size, hipStream_t stream) {
    static int grid = 0;
    if (grid == 0) {
        if (n_in != 28 || out_size != NLAT * D || ws_size < WS_END) { fprintf(stderr, "kernel_launch: unexpected problem (n_in %d, out %d, ws %zu)\n", n_in, out_size, ws_size); grid = -1; return; }
        int dev = 0, cus = 0, per_cu = 0;
        if (hipGetDevice(&dev) != hipSuccess || hipDeviceGetAttribute(&cus, hipDeviceAttributeMultiprocessorCount, dev) != hipSuccess) { grid = -1; return; }
        if (hipFuncSetAttribute((const void*)fwd_kernel, hipFuncAttributeMaxDynamicSharedMemorySize, LDS_BYTES) != hipSuccess) { fprintf(stderr, "kernel_launch: cannot set %d B dynamic LDS\n", LDS_BYTES); grid = -1; return; }
        if (hipOccupancyMaxActiveBlocksPerMultiprocessor(&per_cu, (const void*)fwd_kernel, 512, LDS_BYTES) != hipSuccess || per_cu < 1) fprintf(stderr, "kernel_launch: occupancy query says %d\n", per_cu);
        (void)hipGetLastError();
        grid = cus;
    }
    if (grid < 0) return;
    (void)hipMemsetAsync((char*)d_ws + WS_CTL, 0, CTL_BYTES, stream);
    Params a{};
    for (int i = 0; i < 28; ++i) a.in[i] = (const float*)d_in[i];
    a.out = (float*)d_out; a.ws = (unsigned char*)d_ws; a.ph_lo = 0; a.ph_hi = NPHASE; a.li = 0; a.pad = 0;
    hipLaunchKernelGGL(fwd_kernel, dim3(grid), dim3(512), LDS_BYTES, stream, a);
}
```

```cpp
#include <hip/hip_runtime.h>
#include <cstdio>
#include <cstdint>


constexpr int D = 1024, NB = 32, T = 2048, CL = 256;
constexpr int NLAT = NB * T, NCTX = NB * CL, NTOK = NLAT + NCTX;
constexpr int PW = 4096;
constexpr int DIN = 6144, DFF = 2752, DFFP = 2816, DFE = 3584, NE = 8;
constexpr float EPS = 1e-6f;
constexpr float LOG2E = 1.4426950408889634f;
constexpr float QSCALE = 0.125f * LOG2E;
constexpr int PC_Q = 0, PC_LF = 512, PC_G = 1024, PC_LB = 1536, PC_K = 2048, PC_V = 2560, PC_RQ = 3072, PC_RI = 3584, PC_GA = 2048, PC_GR = 3072;

constexpr size_t MiB = 1u << 20;
constexpr size_t WS_CTL = 0, CTL_BYTES = 1 * MiB;
constexpr size_t WS_MODS = 1 * MiB;
constexpr size_t WS_LBS = 3 * MiB;
constexpr size_t WS_ROPE = 3 * MiB + 65536;
constexpr size_t WS_ROUTE = 4 * MiB;
constexpr size_t WS_CNT = 6 * MiB;
constexpr size_t WS_CTXRES = 8 * MiB;
constexpr size_t WS_WIN = 40 * MiB;
constexpr size_t WS_WIN8 = 56 * MiB;
constexpr size_t WS_H8 = 809 * MiB;
constexpr size_t WS_WUA = 64 * MiB;
constexpr size_t WS_WUR = 66 * MiB;
constexpr size_t WS_WO = 68 * MiB;
constexpr size_t WS_W13 = 72 * MiB;
constexpr size_t WS_W2 = 83 * MiB;
constexpr size_t WS_H = 89 * MiB;
constexpr size_t WS_P = 233 * MiB;
constexpr size_t WS_MERGED = 809 * MiB;
constexpr size_t WS_HID = 233 * MiB;
constexpr size_t WS_WM13 = 8 * MiB;
constexpr size_t WS_WM2 = 120 * MiB;
constexpr size_t WS_AG = 176 * MiB;
constexpr size_t WS_MHID = 436 * MiB;
constexpr size_t WS_Y = 674 * MiB;
constexpr size_t WS_H2M = 896 * MiB;
constexpr size_t WS_END = 1024 * MiB;
constexpr int MOE_CHUNK = 256;

constexpr int CW_BAR = 4096;

#define LAS __attribute__((address_space(3)))
#define GAS __attribute__((address_space(1)))
typedef unsigned short bf16_t;
typedef short bf16x8 __attribute__((ext_vector_type(8)));
typedef short s16x4 __attribute__((ext_vector_type(4)));
typedef _Float16 half8 __attribute__((ext_vector_type(8)));
typedef _Float16 half4 __attribute__((ext_vector_type(4)));
typedef float f32x4 __attribute__((ext_vector_type(4)));
typedef float f32x2 __attribute__((ext_vector_type(2)));
typedef float f32x16 __attribute__((ext_vector_type(16)));
typedef unsigned u32x4 __attribute__((ext_vector_type(4)));
typedef unsigned u32x2 __attribute__((ext_vector_type(2)));
#define DI __device__ __forceinline__
#define LDS_WAIT() asm volatile("s_waitcnt lgkmcnt(0)" ::: "memory")
#define VM_WAIT() asm volatile("s_waitcnt vmcnt(0)" ::: "memory")
#define LDS_BARRIER() do { asm volatile("s_waitcnt lgkmcnt(0)" ::: "memory"); __builtin_amdgcn_s_barrier(); asm volatile("" ::: "memory"); } while (0)

typedef __bf16 bf16x2_t __attribute__((ext_vector_type(2)));
DI unsigned cvt_pk_bf16(float lo, float hi) { f32x2 v = {lo, hi}; bf16x2_t b = __builtin_convertvector(v, bf16x2_t); return __builtin_bit_cast(unsigned, b); }
typedef int v8i32 __attribute__((ext_vector_type(8)));
typedef int v4i32 __attribute__((ext_vector_type(4)));
DI unsigned pack_fp8x4(float a, float b, float c, float d) {
    a = fminf(fmaxf(a, -448.f), 448.f); b = fminf(fmaxf(b, -448.f), 448.f); c = fminf(fmaxf(c, -448.f), 448.f); d = fminf(fmaxf(d, -448.f), 448.f);
    int w = 0; w = __builtin_amdgcn_cvt_pk_fp8_f32(a, b, w, false); w = __builtin_amdgcn_cvt_pk_fp8_f32(c, d, w, true); return (unsigned)w; }
DI float bf2f(unsigned short b) { return __uint_as_float(((unsigned)b) << 16); }
DI float bflo(unsigned w) { return __uint_as_float(w << 16); }
DI float bfhi(unsigned w) { return __uint_as_float(w & 0xffff0000u); }
DI float fsilu(float x) { return x * __builtin_amdgcn_rcpf(1.f + __expf(-x)); }
DI float fsigmoid(float x) { return __builtin_amdgcn_rcpf(1.f + __expf(-x)); }
DI float wave_sum(float v) {
#pragma unroll
    for (int o = 1; o < 64; o <<= 1) v += __shfl_xor(v, o);
    return v;
}
DI int crow(int r, int hi) { return (r & 3) + 8 * (r >> 2) + 4 * hi; }

constexpr int LDS_WTAB_OFF = 148480 + 128;
DI int my_tid() {
    extern __shared__ __attribute__((aligned(16))) unsigned char lds_raw[];
    const unsigned hw = (unsigned)__builtin_amdgcn_s_getreg((5 << 11) | 4) & 63u;
    const int w = __builtin_amdgcn_readfirstlane(((volatile LAS int*)((LAS unsigned char*)lds_raw + LDS_WTAB_OFF))[hw]);
    int t = w * 64 + (int)__builtin_amdgcn_mbcnt_hi(~0u, __builtin_amdgcn_mbcnt_lo(~0u, 0u));
    asm volatile("" : "+v"(t)); return t;
}
#define XB_TMO      128
#define XB_XCNT(j)  (256  + 64 * (j))
#define XB_XSUB(j)  (1280 + 64 * (j))
#define XB_XGEN(j)  (2304 + 64 * (j))
#define XB_TOP      3328
#define XB_TOPGEN   3392
#define XCD_BAR_WORDS 3456
#define XB_SPIN_CAP (1u << 22)
DI unsigned xb_ld(unsigned* p)              { return __hip_atomic_load(p, __ATOMIC_RELAXED, __HIP_MEMORY_SCOPE_AGENT); }
DI unsigned xb_add(unsigned* p, unsigned v) { return __hip_atomic_fetch_add(p, v, __ATOMIC_RELAXED, __HIP_MEMORY_SCOPE_AGENT); }
DI unsigned xb_xcc_id() { return (unsigned)__builtin_amdgcn_s_getreg((3 << 11) | 20) & 0xFu; }
#define XB_SPIN(cond, bar) do { unsigned _sp = 0; while (cond) { __builtin_amdgcn_s_sleep(1); \
    if ((++_sp & 255u) == 0u) { if (xb_ld(&(bar)[XB_TMO])) break; if (_sp > XB_SPIN_CAP) { atomicAdd(&(bar)[XB_TMO], 1u); break; } } } } while (0)
struct XcdBarrier { unsigned* bar; unsigned x; volatile LAS unsigned* st; };
DI XcdBarrier xcd_barrier_post(unsigned* bar, volatile LAS unsigned* st) {
    XcdBarrier b; b.bar = bar; b.x = xb_xcc_id(); b.st = st;
    if (my_tid() == 0) (void)xb_add(&bar[XB_XCNT(b.x)], 1u);
    return b;
}
DI void xcd_barrier_complete(unsigned* bar, unsigned x, unsigned& nloc, unsigned& nx) {
    const unsigned G = gridDim.x * gridDim.y * gridDim.z;
    unsigned sum, cnt, mine, sp = 0u;
    for (;;) {
        sum = 0u; cnt = 0u; mine = 0u;
#pragma unroll
        for (unsigned j = 0; j < 16; ++j) { const unsigned c = xb_ld(&bar[XB_XCNT(j)]); sum += c; cnt += (c > 0u) ? 1u : 0u; mine = (j == x) ? c : mine; }
        if (sum == G) break;
        __builtin_amdgcn_s_sleep(1);
        if ((++sp & 255u) == 0u) { if (xb_ld(&bar[XB_TMO])) break; if (sp > XB_SPIN_CAP) { atomicAdd(&bar[XB_TMO], 1u); break; } }
    }
    nloc = mine > 0u ? mine : 1u; nx = cnt > 0u ? cnt : 1u;
}
DI void xcd_barrier(const XcdBarrier& b) {
    asm volatile("s_waitcnt vmcnt(0)" ::: "memory");
    __syncthreads();
    if (my_tid() == 0) {
        unsigned* bar = b.bar;
        __builtin_amdgcn_s_waitcnt(0);
        unsigned nloc = b.st[0], nx = b.st[1];
        if (nloc == 0u) { xcd_barrier_complete(bar, b.x, nloc, nx); b.st[0] = nloc; b.st[1] = nx; }
        const unsigned old = xb_add(&bar[XB_XSUB(b.x)], 1u);
        const unsigned gen = old / nloc;
        if (old + 1u == (gen + 1u) * nloc) {
            __builtin_amdgcn_fence(__ATOMIC_RELEASE, "agent");
            asm volatile("s_waitcnt vmcnt(0)" ::: "memory");
            const unsigned og = xb_add(&bar[XB_TOP], 1u);
            const unsigned tg = og / nx;
            if (og + 1u == (tg + 1u) * nx) xb_add(&bar[XB_TOPGEN], 1u);
            else XB_SPIN(xb_ld(&bar[XB_TOPGEN]) == tg, bar);
            __builtin_amdgcn_fence(__ATOMIC_ACQUIRE, "agent");
            xb_add(&bar[XB_XGEN(b.x)], 1u);
            asm volatile("s_waitcnt vmcnt(0)" ::: "memory");
        } else {
            XB_SPIN(xb_ld(&bar[XB_XGEN(b.x)]) == gen, bar);
            __builtin_amdgcn_fence(__ATOMIC_ACQUIRE, "agent");
            asm volatile("s_waitcnt vmcnt(0)" ::: "memory");
        }
    }
    __syncthreads();
}

namespace pg8 {
constexpr int BM = 256, BK = 64, HALF = 128, HTB = HALF * BK * 2, STAGE_BYTES = 8 * HTB, NXCD = 8, WGM = 8;
__host__ __device__ __forceinline__ int lds_byte(int r, int c) { const int st = (r >> 4) * 2 + (c >> 5), rr = r & 15, cc = c & 31, ob = rr * 64 + cc * 2; return st * 1024 + (ob ^ (((ob >> 9) & 1) << 5)); }
__host__ __device__ __forceinline__ void stage_rc(int b, int& R, int& C) { const int st = b / 1024, sb = b % 1024, swz = sb ^ (((sb >> 9) & 1) << 5); R = (st >> 1) * 16 + swz / 64; C = (st & 1) * 32 + (swz % 64) / 2; }
__host__ __device__ __forceinline__ int perm32(int rho) { const int n = rho >> 4, i = rho & 15; return 8 * (i >> 2) + 4 * n + (i & 3); }

struct Unit { int pm, pn; const char* a; const char* b; };
struct Gemm { const bf16_t* A; const bf16_t* Bt; int M, N, K, lda; };

struct StaticOrder {
    int nM, nN, nwg, G, c;
    DI void init(const Gemm& g, int G_, int c_) { nM = g.M / BM; nN = g.N / BM; nwg = nM * nN; G = G_; c = c_; }
    DI bool tile(int i, int& pm, int& pn) const {
        const int L = i * G + c; if (L >= nwg) return false;
        int wgid = L; { const int q = nwg / NXCD, r = nwg % NXCD, xcd = wgid % NXCD, off = wgid / NXCD; wgid = (xcd < r ? xcd * (q + 1) : r * (q + 1) + (xcd - r) * q) + off; }
        const int nig = WGM * nN, gid = wgid / nig, fm = gid * WGM, gsz = (nM - fm) < WGM ? (nM - fm) : WGM;
        pm = fm + ((wgid % nig) % gsz); pn = (wgid % nig) / gsz; return true;
    }
    DI bool next(const Gemm& g, int i, Unit& u) const { if (!tile(i, u.pm, u.pn)) return false;
        u.a = (const char*)g.A + (size_t)u.pm * ((size_t)BM * g.lda * 2); u.b = (const char*)g.Bt + (size_t)u.pn * ((size_t)BM * g.K * 2); return true; }
};
struct MoeOrder {
    StaticOrder so; int p0, apan0; int pb[7]; size_t estride;
    DI void load_pb(const int* pbv) {
#pragma unroll
        for (int k = 0; k < 7; ++k) pb[k] = __builtin_amdgcn_readfirstlane(pbv[k + 1]); }
    DI bool next(const Gemm& g, int i, Unit& u) const {
        int pm, pn; if (!so.tile(i, pm, pn)) return false;
        u.pm = p0 + pm; u.pn = pn; int e = 0;
#pragma unroll
        for (int k = 0; k < 7; ++k) e += (u.pm >= pb[k]) ? 1 : 0;
        u.a = (const char*)g.A + (size_t)(u.pm - apan0) * ((size_t)BM * g.lda * 2); u.b = (const char*)g.Bt + (size_t)e * estride + (size_t)pn * ((size_t)BM * g.K * 2); return true;
    }
};

template <class Epi, class Sched, bool ALIGN_EPI = true, bool F8 = false, bool MIDHOOK = false>
DI void gemm_phase(LAS unsigned char* lds, const Gemm g, const Sched& S, const Epi& E) {
    const int tid_ = my_tid();
    const int tid = tid_, wid = __builtin_amdgcn_readfirstlane(tid >> 6), lane = tid & 63, wr = wid >> 2, wc = wid & 3, fr = lane & 15, fq = lane >> 4;
    const int K = g.K, nt = K / BK;
    unsigned voffA[2], voffB[2];
#pragma unroll
    for (int i = 0; i < 2; ++i) { int R, C; stage_rc(tid * 16 + i * 8192, R, C); const int Rb = Epi::PERM ? ((R & ~31) + perm32(R & 31)) : R;
        voffA[i] = (unsigned)(R * g.lda + C) * 2u; voffB[i] = (unsigned)(Rb * K + C) * 2u; }
    const size_t kstep = (size_t)(BK * 2);
    const size_t hstepA = (size_t)HALF * g.lda * 2, hstepB = (size_t)HALF * K * 2;
    const unsigned ldsw = (unsigned)wid * 1024u;
    const int aoff = lds_byte(wr * 64 + fr, fq * 8), boff = lds_byte(wc * 32 + fr, fq * 8);
#define PG8_SA(b, h) (((b) * 2 + (h)) * HTB)
#define PG8_SB(b, h) ((4 + (b) * 2 + (h)) * HTB)
#define PG8_STAGE(bufoff, gbase, voff) do { _Pragma("unroll") for (int _i = 0; _i < 2; ++_i) \
        __builtin_amdgcn_global_load_lds((const unsigned*)((const char*)(gbase) + (voff)[_i]), (LAS unsigned*)(lds + (bufoff) + ldsw + _i * 8192), 16, 0, 0); } while (0)
#define PG8_LD8(p) __builtin_shufflevector(*(const LAS v4i32*)(p), *(const LAS v4i32*)((p) + 1024), 0, 1, 2, 3, 4, 5, 6, 7)
#define PG8_LDA(dst, b, h) do { if constexpr (F8) { _Pragma("unroll") for (int m = 0; m < 4; ++m) dst##8[m] = PG8_LD8(lds + PG8_SA(b, h) + aoff + m * 2048); } \
        else { _Pragma("unroll") for (int m = 0; m < 4; ++m) _Pragma("unroll") for (int k = 0; k < 2; ++k) dst[m][k] = *(const LAS bf16x8*)(lds + PG8_SA(b, h) + aoff + m * 2048 + k * 1024); } } while (0)
#define PG8_LDB(dst, b, h) do { if constexpr (F8) { _Pragma("unroll") for (int n = 0; n < 2; ++n) dst##8[n] = PG8_LD8(lds + PG8_SB(b, h) + boff + n * 2048); } \
        else { _Pragma("unroll") for (int n = 0; n < 2; ++n) _Pragma("unroll") for (int k = 0; k < 2; ++k) dst[n][k] = *(const LAS bf16x8*)(lds + PG8_SB(b, h) + boff + n * 2048 + k * 1024); } } while (0)
#define PG8_MMA(ai, bj, At, Bt) do { __builtin_amdgcn_s_setprio(1); \
        if constexpr (F8) { _Pragma("unroll") for (int m = 0; m < 4; ++m) _Pragma("unroll") for (int n = 0; n < 2; ++n) \
            asm volatile("v_mfma_scale_f32_16x16x128_f8f6f4 %0, %1, %2, %0, %3, %3 op_sel_hi:[0,0,0]" : "+v"(acc[ai][bj][m][n]) : "v"(Bt##8[n]), "v"(At##8[m]), "v"(one8)); } \
        else { _Pragma("unroll") for (int m = 0; m < 4; ++m) _Pragma("unroll") for (int n = 0; n < 2; ++n) _Pragma("unroll") for (int k = 0; k < 2; ++k) \
            acc[ai][bj][m][n] = __builtin_amdgcn_mfma_f32_16x16x32_bf16(Bt[n][k], At[m][k], acc[ai][bj][m][n], 0, 0, 0); } \
        __builtin_amdgcn_s_setprio(0); } while (0)
#define PG8_WAIT_V(n) asm volatile("s_waitcnt vmcnt(" #n ")" ::: "memory")
#define PG8_WAIT_VX(n) asm volatile("s_waitcnt vmcnt(%0)" :: "n"(n) : "memory")
#define PG8_WAIT_L(n) asm volatile("s_waitcnt lgkmcnt(" #n ")" ::: "memory")
#define PG8_BAR __builtin_amdgcn_s_barrier()
#define PG8_SCHED __builtin_amdgcn_sched_barrier(0)
    Unit cur, nxt; int ui = 0;
    if (!S.next(g, 0, cur)) return;
    f32x4 acc[2][2][4][2];
#pragma unroll
    for (int a = 0; a < 2; ++a)
#pragma unroll
        for (int b = 0; b < 2; ++b)
#pragma unroll
            for (int m = 0; m < 4; ++m)
#pragma unroll
                for (int n = 0; n < 2; ++n) acc[a][b][m][n] = (f32x4){0.f, 0.f, 0.f, 0.f};
    bf16x8 At[4][2], B0[2][2], B1[2][2]; v8i32 At8[4], B08[2], B18[2]; const int one8 = 0x7F7F7F7F;
    const char* cA = cur.a; const char* cB = cur.b;
    PG8_STAGE(PG8_SB(0, 0), cB, voffB); PG8_STAGE(PG8_SB(0, 1), cB + hstepB, voffB); PG8_STAGE(PG8_SA(0, 0), cA, voffA); PG8_STAGE(PG8_SA(0, 1), cA + hstepA, voffA);
    if (wr == 1) PG8_BAR;
    PG8_WAIT_V(2); PG8_BAR;
    PG8_STAGE(PG8_SB(1, 0), cB + kstep, voffB); PG8_STAGE(PG8_SA(1, 0), cA + kstep, voffA); PG8_STAGE(PG8_SB(1, 1), cB + hstepB + kstep, voffB);
    PG8_WAIT_V(6); PG8_BAR;
    for (;;) {
        const bool has_next = S.next(g, ui + 1, nxt);
        const char* nA = has_next ? nxt.a : cA; const char* nB = has_next ? nxt.b : cB;
        for (int t = 0; t < nt; t += 2) {
            const bool last = (t == nt - 2);
            if constexpr (MIDHOOK) { PG8_SCHED; if (t == nt / 2) E.mid(acc, cur, wr, wc, fr, fq); PG8_SCHED; }
            const char* a1 = cA + (size_t)(t + 1) * kstep;
            const char* a2 = last ? nA : cA + (size_t)(t + 2) * kstep; const char* b2 = last ? nB : cB + (size_t)(t + 2) * kstep;
            const char* a3 = a2 + kstep; const char* b3 = b2 + kstep;
            const int relax = __builtin_amdgcn_readfirstlane(((t == 0) && (ui > 0)) ? 1 : 0);
#define PG8_WAIT_V8R asm volatile("s_cmp_lg_u32 %0, 0\n\ts_cbranch_scc1 1f\n\ts_waitcnt vmcnt(8)\n1:\n\ts_waitcnt vmcnt(%1)" :: "s"(relax), "n"(8 + Epi::NVM) : "memory", "scc")
            PG8_LDB(B0, 0, 0); PG8_LDB(B1, 0, 1); PG8_SCHED; PG8_LDA(At, 0, 0); PG8_STAGE(PG8_SA(1, 1), a1 + hstepA, voffA);
            PG8_WAIT_V8R; PG8_WAIT_L(0); PG8_BAR; PG8_MMA(0, 0, At, B0); PG8_MMA(0, 1, At, B1); PG8_BAR; PG8_SCHED;
            PG8_LDA(At, 0, 1); PG8_STAGE(PG8_SB(0, 0), b2, voffB); PG8_STAGE(PG8_SB(0, 1), b2 + hstepB, voffB); PG8_STAGE(PG8_SA(0, 0), a2, voffA);
            PG8_WAIT_V8R; PG8_WAIT_L(0); PG8_BAR; PG8_MMA(1, 0, At, B0); PG8_MMA(1, 1, At, B1); PG8_BAR; PG8_SCHED;
            PG8_LDB(B0, 1, 0); PG8_LDB(B1, 1, 1); PG8_SCHED; PG8_LDA(At, 1, 0); PG8_STAGE(PG8_SA(0, 1), a2 + hstepA, voffA);
            PG8_WAIT_V(8); PG8_WAIT_L(0); PG8_BAR; PG8_MMA(0, 0, At, B0); PG8_MMA(0, 1, At, B1); PG8_BAR; PG8_SCHED;
            PG8_LDA(At, 1, 1); PG8_STAGE(PG8_SB(1, 0), b3, voffB); PG8_STAGE(PG8_SB(1, 1), b3 + hstepB, voffB); PG8_STAGE(PG8_SA(1, 0), a3, voffA);
            PG8_WAIT_V(8); PG8_WAIT_L(0); PG8_BAR; PG8_MMA(1, 0, At, B0); PG8_MMA(1, 1, At, B1); PG8_BAR; PG8_SCHED;
#undef PG8_WAIT_V8R
        }
        if constexpr (ALIGN_EPI) { if (wr == 0) PG8_BAR; }
        if constexpr (F8) asm volatile("s_nop 15\n\ts_nop 15" ::: "memory");
        E(acc, cur, wr, wc, fr, fq);
        if (!has_next) break;
#pragma unroll
        for (int a = 0; a < 2; ++a)
#pragma unroll
            for (int b = 0; b < 2; ++b)
#pragma unroll
                for (int m = 0; m < 4; ++m)
#pragma unroll
                    for (int n = 0; n < 2; ++n) acc[a][b][m][n] = (f32x4){0.f, 0.f, 0.f, 0.f};
        cur = nxt; cA = nA; cB = nB; ++ui;
        if constexpr (ALIGN_EPI) { if (wr == 1) PG8_BAR; }
    }
    PG8_WAIT_V(0);
    if constexpr (!ALIGN_EPI) { if (wr == 0) PG8_BAR; }
    PG8_BAR;
#undef PG8_SA
#undef PG8_SB
#undef PG8_STAGE
#undef PG8_LDA
#undef PG8_LD8
#undef PG8_LDB
#undef PG8_MMA
#undef PG8_WAIT_V
#undef PG8_WAIT_VX
#undef PG8_WAIT_L
#undef PG8_BAR
#undef PG8_SCHED
}
}
using pg8::Unit; using pg8::Gemm;
typedef const f32x4 (&AccRef)[2][2][4][2];

DI u32x4 pack8(const f32x4& v0, const f32x4& v1) { u32x4 w; w.x = cvt_pk_bf16(v0[0], v0[1]); w.y = cvt_pk_bf16(v0[2], v0[3]); w.z = cvt_pk_bf16(v1[0], v1[1]); w.w = cvt_pk_bf16(v1[2], v1[3]); return w; }
DI void unpack8(const u32x4& w, float (&f)[8]) { f[0] = bflo(w.x); f[1] = bfhi(w.x); f[2] = bflo(w.y); f[3] = bfhi(w.y); f[4] = bflo(w.z); f[5] = bfhi(w.z); f[6] = bflo(w.w); f[7] = bfhi(w.w); }

struct EpiInProj {
    static constexpr int NVM = 16; static constexpr bool PERM = true;
    bf16_t* P; const float2* rope; const float* lbf; const float* lbb; int secmap; float asc;
    template <int MODE> DI void run(AccRef acc, const Unit& u, int wr, int wc, int fr, int fq, int sec) const {
        const int row0 = u.pm * 256 + wr * 64 + fr, col0 = sec * 512 + (u.pn & 1) * 256 + wc * 32 + 8 * fq;
        const bool lat = u.pm < (NLAT / 256); const float qs = sec == 0 ? QSCALE : 1.f;
        f32x4 lb0[2], lb1[2];
        if (MODE == 2) {
#pragma unroll
            for (int bj = 0; bj < 2; ++bj) { const float* lb = (sec == 1 ? lbf : lbb) + ((col0 + bj * 128) & 511); lb0[bj] = *(const f32x4*)lb; lb1[bj] = *(const f32x4*)(lb + 4); } }
        f32x4 rr[2][4][2];
        if (MODE == 3) {
#pragma unroll
            for (int ai = 0; ai < 2; ++ai)
#pragma unroll
                for (int m = 0; m < 4; ++m) { const f32x4* rp = (const f32x4*)(rope + (size_t)((row0 + ai * 128 + m * 16) & (T - 1)) * 32 + ((col0 & 63) >> 1));
                    rr[ai][m][0] = lat ? rp[0] : (f32x4){1.f, 0.f, 1.f, 0.f}; rr[ai][m][1] = lat ? rp[1] : (f32x4){1.f, 0.f, 1.f, 0.f}; } }
#pragma unroll
        for (int ai = 0; ai < 2; ++ai)
#pragma unroll
            for (int m = 0; m < 4; ++m) {
                const int row = row0 + ai * 128 + m * 16; bf16_t* rowp = P + (size_t)row * PW + col0;
#pragma unroll
                for (int bj = 0; bj < 2; ++bj) {
                    f32x4 v0 = acc[ai][bj][m][0] * asc, v1 = acc[ai][bj][m][1] * asc; u32x4 w;
                    if (MODE == 3) {
                        {
                            const f32x4 r0 = rr[ai][m][0], r1 = rr[ai][m][1];
                            f32x4 o0, o1;
                            o0[0] = v0[0] * r0[0] - v0[1] * r0[1]; o0[1] = v0[0] * r0[1] + v0[1] * r0[0];
                            o0[2] = v0[2] * r0[2] - v0[3] * r0[3]; o0[3] = v0[2] * r0[3] + v0[3] * r0[2];
                            o1[0] = v1[0] * r1[0] - v1[1] * r1[1]; o1[1] = v1[0] * r1[1] + v1[1] * r1[0];
                            o1[2] = v1[2] * r1[2] - v1[3] * r1[3]; o1[3] = v1[2] * r1[3] + v1[3] * r1[2];
                            v0 = o0; v1 = o1;
                        }
                        w = pack8(v0 * qs, v1 * qs);
                    } else if (MODE == 1) {
#pragma unroll
                        for (int j = 0; j < 4; ++j) { v0[j] = fsilu(v0[j]); v1[j] = fsilu(v1[j]); }
                        w = pack8(v0, v1);
                    } else if (MODE == 2) {
                        half8 hv;
#pragma unroll
                        for (int j = 0; j < 8; ++j) {
                            const float z = fmaxf(j < 4 ? v0[j] : v1[j - 4], -80.f), b = j < 4 ? lb0[bj][j] : lb1[bj][j - 4];
                            const float sg = __builtin_amdgcn_rcpf(1.f + __builtin_amdgcn_exp2f(-LOG2E * z));
                            hv[j] = (_Float16)(0.6931471805599453f * __builtin_amdgcn_logf(b + (1.f - b) * sg));
                        }
                        w = __builtin_bit_cast(u32x4, hv);
                    } else w = pack8(v0, v1);
                    *(u32x4*)(rowp + bj * 128) = w;
                }
            }
    }
    DI void operator()(AccRef acc, const Unit& u, int wr, int wc, int fr, int fq) const {
        const int sec = (secmap >> (4 * (u.pn >> 1))) & 15;
        if (sec == 0 || sec == 4) run<3>(acc, u, wr, wc, fr, fq, sec);
        else if (sec == 2 || sec == 6) run<1>(acc, u, wr, wc, fr, fq, sec);
        else if (sec == 1 || sec == 3) run<2>(acc, u, wr, wc, fr, fq, sec);
        else run<0>(acc, u, wr, wc, fr, fq, sec);
    }
};
struct EpiGates {
    static constexpr int NVM = 16; static constexpr bool PERM = true; bf16_t* P; float asc;
    DI void operator()(AccRef acc, const Unit& u, int wr, int wc, int fr, int fq) const {
        const int row0 = u.pm * 256 + wr * 64 + fr, col0 = PC_GA + u.pn * 256 + wc * 32 + 8 * fq;
#pragma unroll
        for (int ai = 0; ai < 2; ++ai)
#pragma unroll
            for (int m = 0; m < 4; ++m) { bf16_t* rowp = P + (size_t)(row0 + ai * 128 + m * 16) * PW + col0;
#pragma unroll
                for (int bj = 0; bj < 2; ++bj) { f32x4 v0 = acc[ai][bj][m][0] * asc, v1 = acc[ai][bj][m][1] * asc;
#pragma unroll
                    for (int j = 0; j < 4; ++j) { v0[j] = fsigmoid(v0[j]); v1[j] = fsigmoid(v1[j]); }
                    *(u32x4*)(rowp + bj * 128) = pack8(v0, v1); } }
    }
};
struct EpiMergeFused {
    static constexpr int NVM = 16; static constexpr bool PERM = true; const bf16_t* P; bf16_t* O;
    DI void mid(f32x4 (&acc)[2][2][4][2], const Unit& u, int wr, int wc, int fr, int fq) const {
        int row0 = u.pm * 256 + wr * 64 + fr, col0 = u.pn * 256 + wc * 32 + 8 * fq;
        asm volatile("" : "+v"(row0), "+v"(col0));
#pragma unroll
        for (int ai = 0; ai < 2; ++ai)
#pragma unroll
            for (int m = 0; m < 4; ++m) { const size_t row = (size_t)(row0 + ai * 128 + m * 16);
#pragma unroll
                for (int bj = 0; bj < 2; ++bj) {
                    float ga[8], gr[8]; unpack8(*(const u32x4*)(P + row * PW + PC_GA + col0 + bj * 128), ga); unpack8(*(const u32x4*)(P + row * PW + PC_GR + col0 + bj * 128), gr);
#pragma unroll
                    for (int j = 0; j < 4; ++j) { acc[ai][bj][m][0][j] *= ga[j] * __builtin_amdgcn_rcpf(fmaxf(gr[j], 1e-30f)); acc[ai][bj][m][1][j] *= ga[4 + j] * __builtin_amdgcn_rcpf(fmaxf(gr[4 + j], 1e-30f)); } }
                asm volatile("" ::: "memory"); }
    }
    DI void operator()(AccRef acc, const Unit& u, int wr, int wc, int fr, int fq) const {
        const int row0 = u.pm * 256 + wr * 64 + fr, col0 = u.pn * 256 + wc * 32 + 8 * fq;
        u32x4 gq[2][4][2];
#pragma unroll
        for (int ai = 0; ai < 2; ++ai)
#pragma unroll
            for (int m = 0; m < 4; ++m)
#pragma unroll
                for (int bj = 0; bj < 2; ++bj) gq[ai][m][bj] = *(const u32x4*)(P + (size_t)(row0 + ai * 128 + m * 16) * PW + PC_GR + col0 + bj * 128);
#pragma unroll
        for (int ai = 0; ai < 2; ++ai)
#pragma unroll
            for (int m = 0; m < 4; ++m) { const size_t row = (size_t)(row0 + ai * 128 + m * 16);
#pragma unroll
                for (int bj = 0; bj < 2; ++bj) {
                    float gr[8]; unpack8(gq[ai][m][bj], gr);
                    f32x4 v0 = acc[ai][bj][m][0], v1 = acc[ai][bj][m][1];
#pragma unroll
                    for (int j = 0; j < 4; ++j) { v0[j] *= fmaxf(gr[j], 1e-30f); v1[j] *= fmaxf(gr[4 + j], 1e-30f); }
                    *(u32x4*)(O + row * D + col0 + bj * 128) = pack8(v0, v1); } }
    }
};
struct EpiResid {
    static constexpr int NVM = 16; static constexpr bool PERM = false;
    const float* xin_l; const float* xin_c; float* xout_l; float* xout_c; const float* mods; int msel;
    DI void operator()(AccRef acc, const Unit& u, int wr, int wc, int fr, int fq) const {
        const bool lat = u.pm < (NLAT / 256);
        const int rbase = (lat ? u.pm : u.pm - NLAT / 256) * 256 + wr * 64 + fr, col0 = u.pn * 256 + wc * 32 + 4 * fq;
        const float* xi = lat ? xin_l : xin_c; float* xo = lat ? xout_l : xout_c;
        const float* mv = mods + (size_t)(lat ? (u.pm >> 3) : 32) * DIN + msel * D + col0;
        f32x4 g[2][2];
#pragma unroll
        for (int bj = 0; bj < 2; ++bj)
#pragma unroll
            for (int n = 0; n < 2; ++n) g[bj][n] = *(const f32x4*)(mv + bj * 128 + n * 16);
        f32x4 xa[4][2][2], r0[4][2][2];
#define RES_OFF(ai, m) ((size_t)(rbase + (ai) * 128 + (m) * 16) * D + col0)
#pragma unroll
        for (int m = 0; m < 4; ++m)
#pragma unroll
            for (int bj = 0; bj < 2; ++bj)
#pragma unroll
                for (int n = 0; n < 2; ++n) xa[m][bj][n] = *(const f32x4*)(xi + RES_OFF(0, m) + bj * 128 + n * 16);
#pragma unroll
        for (int m = 0; m < 4; ++m)
#pragma unroll
            for (int bj = 0; bj < 2; ++bj)
#pragma unroll
                for (int n = 0; n < 2; ++n) r0[m][bj][n] = xa[m][bj][n] + g[bj][n] * acc[0][bj][m][n];
#pragma unroll
        for (int m = 0; m < 4; ++m)
#pragma unroll
            for (int bj = 0; bj < 2; ++bj)
#pragma unroll
                for (int n = 0; n < 2; ++n) xa[m][bj][n] = *(const f32x4*)(xi + RES_OFF(1, m) + bj * 128 + n * 16);
        asm volatile("" ::: "memory");
#pragma unroll
        for (int m = 0; m < 4; ++m)
#pragma unroll
            for (int bj = 0; bj < 2; ++bj)
#pragma unroll
                for (int n = 0; n < 2; ++n) *(f32x4*)(xo + RES_OFF(0, m) + bj * 128 + n * 16) = r0[m][bj][n];
#pragma unroll
        for (int m = 0; m < 4; ++m)
#pragma unroll
            for (int bj = 0; bj < 2; ++bj)
#pragma unroll
                for (int n = 0; n < 2; ++n) *(f32x4*)(xo + RES_OFF(1, m) + bj * 128 + n * 16) = xa[m][bj][n] + g[bj][n] * acc[1][bj][m][n];
#undef RES_OFF
    }
};
struct EpiSwiglu {
    static constexpr int NVM = 16; static constexpr bool PERM = true; bf16_t* Hd; int ldh; int pan0;
    DI void operator()(AccRef acc, const Unit& u, int wr, int wc, int fr, int fq) const {
        const int row0 = (u.pm - pan0) * 256 + wr * 64 + fr, hc0 = u.pn * 128 + wc * 16 + 4 * fq;
#pragma unroll
        for (int ai = 0; ai < 2; ++ai)
#pragma unroll
            for (int m = 0; m < 4; ++m) { bf16_t* rowp = Hd + (size_t)(row0 + ai * 128 + m * 16) * ldh + hc0;
#pragma unroll
                for (int bj = 0; bj < 2; ++bj) { const f32x4 a = acc[ai][bj][m][0], b = acc[ai][bj][m][1];
                    u32x2 w; w.x = cvt_pk_bf16(fsilu(a[0]) * b[0], fsilu(a[1]) * b[1]); w.y = cvt_pk_bf16(fsilu(a[2]) * b[2], fsilu(a[3]) * b[3]);
                    *(u32x2*)(rowp + bj * 64) = w; } }
    }
};
struct EpiSwiglu8 {
    static constexpr int NVM = 16; static constexpr bool PERM = true; unsigned char* Hd; int ldh; int pan0; float as, hs;
    DI void operator()(AccRef acc, const Unit& u, int wr, int wc, int fr, int fq) const {
        const int row0 = (u.pm - pan0) * 256 + wr * 64 + fr, hc0 = u.pn * 128 + wc * 16 + 4 * fq;
#pragma unroll
        for (int ai = 0; ai < 2; ++ai)
#pragma unroll
            for (int m = 0; m < 4; ++m) { unsigned char* rowp = Hd + (size_t)(row0 + ai * 128 + m * 16) * ldh + hc0;
#pragma unroll
                for (int bj = 0; bj < 2; ++bj) { const f32x4 a = acc[ai][bj][m][0] * as, b = acc[ai][bj][m][1] * (as * hs);
                    *(unsigned*)(rowp + bj * 64) = pack_fp8x4(fsilu(a[0]) * b[0], fsilu(a[1]) * b[1], fsilu(a[2]) * b[2], fsilu(a[3]) * b[3]); } }
    }
};
struct EpiBf16 {
    static constexpr int NVM = 16; static constexpr bool PERM = true; bf16_t* O; int ldc; float sc;
    DI void operator()(AccRef acc, const Unit& u, int wr, int wc, int fr, int fq) const {
        const int row0 = u.pm * 256 + wr * 64 + fr, col0 = u.pn * 256 + wc * 32 + 8 * fq;
#pragma unroll
        for (int ai = 0; ai < 2; ++ai)
#pragma unroll
            for (int m = 0; m < 4; ++m) { bf16_t* rowp = O + (size_t)(row0 + ai * 128 + m * 16) * ldc + col0;
#pragma unroll
                for (int bj = 0; bj < 2; ++bj) *(u32x4*)(rowp + bj * 128) = pack8(acc[ai][bj][m][0] * sc, acc[ai][bj][m][1] * sc); }
    }
};

typedef short v4i16 __attribute__((ext_vector_type(4)));
DI s16x4 tr16(const LAS unsigned char* p) { return __builtin_bit_cast(s16x4, __builtin_amdgcn_ds_read_tr16_b64_v4i16((LAS v4i16*)p)); }
DI bf16x8 cat8(s16x4 lo, s16x4 hi) { return __builtin_shufflevector(lo, hi, 0, 1, 2, 3, 4, 5, 6, 7); }
DI void dma16(const void* g, LAS unsigned char* l) { __builtin_amdgcn_global_load_lds((const unsigned*)g, (LAS unsigned*)l, 16, 0, 0); }
DI void dma16a(const void* g, LAS unsigned char* l) {
    const unsigned la = __builtin_amdgcn_readfirstlane((unsigned)(size_t)l);
    asm volatile("s_mov_b32 m0, %1\n\ts_nop 0\n\tglobal_load_lds_dwordx4 %0, off" :: "v"(g), "s"(la) : "memory", "m0");
}
DI bf16x8 packf8(const f32x16& x, int s) {
    u32x4 w; w.x = cvt_pk_bf16(x[8 * s], x[8 * s + 1]); w.y = cvt_pk_bf16(x[8 * s + 2], x[8 * s + 3]); w.z = cvt_pk_bf16(x[8 * s + 4], x[8 * s + 5]); w.w = cvt_pk_bf16(x[8 * s + 6], x[8 * s + 7]);
    return __builtin_bit_cast(bf16x8, w);
}
#define MFMA32(a, b, c) __builtin_amdgcn_mfma_f32_32x32x16_bf16((a), (b), (c), 0, 0, 0)

struct Params { const float* in[28]; float* out; unsigned char* ws; int ph_lo, ph_hi, li, pad; };
typedef const __attribute__((address_space(4))) Params* KP;
DI KP kparams() { KP kp = (KP)__builtin_amdgcn_kernarg_segment_ptr(); asm volatile("" : "+s"(kp)); return kp; }
#define PIN(k) (kparams()->in[k])
#define POUT (kparams()->out)
struct Ctx {
    LAS unsigned char* lds; unsigned char* ws; int tid, lane, wave, vcu, G, gw, NGW, bx;
};

constexpr float WIN8_SCALE = 64.f;
#ifndef FP8_SECS0
#define FP8_SECS0 0x00
#endif
#ifndef FP8_SECS1
#define FP8_SECS1 0xE4
#endif
constexpr int sec_order(int i) { return (int)((0x76524310u >> (4 * i)) & 15u); }
constexpr int sec_slot(int fs, int ps) { int nb = 0, nf = 0; for (int i = 0; i < 8; ++i) { const int s_ = sec_order(i); const bool f = (fs >> s_) & 1; if (s_ == ps) return f ? (0x100 | nf) : nb; if (f) ++nf; else ++nb; } return 0; }
constexpr int n_sec_f8(int fs) { return __builtin_popcount((unsigned)fs); }
constexpr unsigned secmap_of(int fs, bool f8) { unsigned m = 0; int k = 0; for (int i = 0; i < 8; ++i) { const int s_ = sec_order(i); if ((((fs >> s_) & 1) != 0) == f8) { m |= (unsigned)s_ << (4 * k); ++k; } } return m; }
DI int map_row(int kind, int n, int fs) {
    if (kind == 0) return n;
    if (kind == 2) return 8 * (n >> 2) + (n & 3);
    if (kind == 3) return 8 * (n >> 2) + (n & 3) + 4;
    const int sec = n >> 9, j = n & 511; int r;
    if (n >= 4096) r = (1 << 16) | (n_sec_f8(fs) * 512 + (n - 4096));
    else {
        const int ps = sec == 0 ? 0 : sec == 1 ? 4 : sec == 2 ? 5 : sec == 3 ? 6 : sec == 4 ? 7 : sec == 5 ? 1 : sec == 6 ? 3 : 2;
        const int sl = sec_slot(fs, ps); int jj = j;
        if (sec == 0 || sec == 1) { const int hs = j >> 6, d = j & 63; jj = hs * 64 + (d < 32 ? 2 * d : 2 * (d - 32) + 1); }
        r = ((sl & 0x100) ? (1 << 16) : 0) | ((sl & 0xff) * 512 + jj); }
    return kind == 4 ? (r & 0xffff) : r;
}
constexpr int TP_PITCH = 68, TP_SCR = 64 * TP_PITCH * 4;
DI void transpose_load(const float* W, int ldw, int k0, int n0, LAS float* scr, int lane) {
    const int r = lane >> 4, c4 = (lane & 15) * 4; f32x4 v[16];
#pragma unroll
    for (int i = 0; i < 16; ++i) v[i] = *(const f32x4*)(W + (size_t)(k0 + 4 * i + r) * ldw + n0 + c4);
#pragma unroll
    for (int i = 0; i < 16; ++i) *(LAS f32x4*)(scr + (4 * i + r) * TP_PITCH + c4) = v[i];
    LDS_WAIT(); asm volatile("" ::: "memory");
}
DI void transpose_item(const float* W, int ldw, int k0, int n0, bf16_t* WT, int ldt, int kind, LAS float* scr, int lane, int fs = 0) {
    transpose_load(W, ldw, k0, n0, scr, lane);
    bf16_t* dst = WT + (size_t)map_row(kind, n0 + lane, fs) * ldt + k0;
#pragma unroll
    for (int j = 0; j < 8; ++j) { const LAS float* s = scr + (8 * j) * TP_PITCH + lane;
        u32x4 o; o.x = cvt_pk_bf16(s[0], s[TP_PITCH]); o.y = cvt_pk_bf16(s[2 * TP_PITCH], s[3 * TP_PITCH]); o.z = cvt_pk_bf16(s[4 * TP_PITCH], s[5 * TP_PITCH]); o.w = cvt_pk_bf16(s[6 * TP_PITCH], s[7 * TP_PITCH]);
        *(u32x4*)(dst + 8 * j) = o; }
    LDS_WAIT(); asm volatile("" ::: "memory");
}
DI void transpose_item8(const float* W, int ldw, int k0, int n0, unsigned char* WT, int ldt, int kind, float sc, LAS float* scr, int lane, int fs = 0) {
    transpose_load(W, ldw, k0, n0, scr, lane);
    unsigned char* dst = WT + (size_t)map_row(kind, n0 + lane, fs) * ldt + k0;
#pragma unroll
    for (int j = 0; j < 4; ++j) { const LAS float* s = scr + (16 * j) * TP_PITCH + lane; u32x4 o;
        o.x = pack_fp8x4(s[0] * sc, s[TP_PITCH] * sc, s[2 * TP_PITCH] * sc, s[3 * TP_PITCH] * sc); o.y = pack_fp8x4(s[4 * TP_PITCH] * sc, s[5 * TP_PITCH] * sc, s[6 * TP_PITCH] * sc, s[7 * TP_PITCH] * sc);
        o.z = pack_fp8x4(s[8 * TP_PITCH] * sc, s[9 * TP_PITCH] * sc, s[10 * TP_PITCH] * sc, s[11 * TP_PITCH] * sc); o.w = pack_fp8x4(s[12 * TP_PITCH] * sc, s[13 * TP_PITCH] * sc, s[14 * TP_PITCH] * sc, s[15 * TP_PITCH] * sc);
        *(u32x4*)(dst + 16 * j) = o; }
    LDS_WAIT(); asm volatile("" ::: "memory");
}
DI void transpose_matrix8(const Ctx& C, const float* W, int K, int N, unsigned char* WT, int ldt, int kind, float sc, int& itbase) {
    LAS float* scr = (LAS float*)(C.lds + C.wave * TP_SCR);
    const int nblk = N / 64, nit = (K / 64) * nblk;
    int first = (C.gw - (itbase % C.NGW) + C.NGW) % C.NGW;
    for (int it = first; it < nit; it += C.NGW) transpose_item8(W, N, 64 * (it / nblk), 64 * (it % nblk), WT, ldt, kind, sc, scr, C.lane);
    itbase += nit;
}
DI void transpose_matrix(const Ctx& C, const float* W, int K, int N, bf16_t* WT, int ldt, int kind, int& itbase, int total_unused) {
    (void)total_unused;
    LAS float* scr = (LAS float*)(C.lds + C.wave * TP_SCR);
    const int nblk = N / 64, nit = (K / 64) * nblk;
    int first = (C.gw - (itbase % C.NGW) + C.NGW) % C.NGW;
    for (int it = first; it < nit; it += C.NGW) transpose_item(W, N, 64 * (it / nblk), 64 * (it % nblk), WT, ldt, kind, scr, C.lane);
    itbase += nit;
}
DI void transpose_win(const Ctx& C, const float* W, bf16_t* WA, unsigned char* W8, int& itbase, int fs) {
    LAS float* scr = (LAS float*)(C.lds + C.wave * TP_SCR);
    const int nblk = DIN / 64, nit = (D / 64) * nblk;
    int first = (C.gw - (itbase % C.NGW) + C.NGW) % C.NGW;
    for (int it = first; it < nit; it += C.NGW) { const int k0 = 64 * (it / nblk), n0 = 64 * (it % nblk);
        if (map_row(1, n0, fs) >> 16) transpose_item8(W, DIN, k0, n0, W8, D, 4, WIN8_SCALE, scr, C.lane, fs);
        else transpose_item(W, DIN, k0, n0, WA, D, 1, scr, C.lane, fs); }
    itbase += nit;
}
constexpr int MD_SP = 36;
DI void phase_mods(const Ctx& C) {
    if (C.bx >= 2 * 96) return;
    const int l = C.bx / 96, n0 = (C.bx % 96) * 64, kq = C.lane >> 4, cq = C.lane & 15;
    LAS float* S = (LAS float*)C.lds;
    const float* W = PIN(4) + (size_t)l * D * DIN + n0 + 4 * cq; const float* c0 = PIN(1); const float* cc = PIN(3);
    f32x4 acc[33];
#pragma unroll
    for (int r = 0; r < 33; ++r) acc[r] = (f32x4){0.f, 0.f, 0.f, 0.f};
#pragma unroll 1
    for (int kh = 0; kh < 2; ++kh) {
        __syncthreads();
        for (int i = C.tid; i < 33 * 512; i += 512) { const int r = i >> 9, kk = i & 511; S[kk * MD_SP + r] = fsilu(r < 32 ? c0[r * D + kh * 512 + kk] : cc[kh * 512 + kk]); }
        __syncthreads();
        const int kb = C.wave * 64 + kq;
#pragma unroll 1
        for (int ib = 0; ib < 16; ib += 8) { f32x4 w[8];
#pragma unroll
            for (int i = 0; i < 8; ++i) w[i] = *(const f32x4*)(W + (size_t)(kh * 512 + kb + 4 * (ib + i)) * DIN);
#pragma unroll
            for (int i = 0; i < 8; ++i) { const LAS float* sp = S + (kb + 4 * (ib + i)) * MD_SP;
#pragma unroll
                for (int q = 0; q < 8; ++q) { const f32x4 s4 = *(const LAS f32x4*)(sp + 4 * q);
                    acc[4 * q] += w[i] * s4[0]; acc[4 * q + 1] += w[i] * s4[1]; acc[4 * q + 2] += w[i] * s4[2]; acc[4 * q + 3] += w[i] * s4[3]; }
                acc[32] += w[i] * sp[32]; } }
    }
#pragma unroll
    for (int r = 0; r < 33; ++r)
#pragma unroll
        for (int j = 0; j < 4; ++j) { float v = acc[r][j]; v += __shfl_xor(v, 16); v += __shfl_xor(v, 32); asm volatile("" : "+v"(v)); acc[r][j] = v; }
    __syncthreads();
    LAS float* red = (LAS float*)C.lds;
    if (kq == 0) {
#pragma unroll
        for (int r = 0; r < 33; ++r) *(LAS f32x4*)(red + (C.wave * 33 + r) * 64 + 4 * cq) = acc[r]; }
    __syncthreads();
    float* mods = (float*)(C.ws + WS_MODS);
    for (int o = C.tid; o < 33 * 64; o += 512) { const int r = o >> 6, c = o & 63; float v = PIN(5)[l * DIN + n0 + c];
#pragma unroll
        for (int w8 = 0; w8 < 8; ++w8) v += red[(w8 * 33 + r) * 64 + c];
        mods[(size_t)(l * 33 + r) * DIN + n0 + c] = v; }
    __syncthreads();
}
DI void phase_prologue(const Ctx& C) {
    unsigned char* ws = C.ws;
    int itb = 0;
    for (int l = 0; l < 2; ++l) {
        transpose_win(C, PIN(8) + (size_t)l * D * DIN, (bf16_t*)(ws + WS_WIN) + (size_t)l * 4096 * D, ws + WS_WIN8 + (size_t)l * 4096 * D, itb, l == 0 ? FP8_SECS0 : FP8_SECS1);
        transpose_matrix(C, PIN(17) + (size_t)l * 512 * D, 512, D, (bf16_t*)(ws + WS_WUA) + (size_t)l * D * D, D, 0, itb, 0);
        transpose_matrix(C, PIN(18) + (size_t)l * 512 * D, 512, D, (bf16_t*)(ws + WS_WUA) + (size_t)l * D * D + 512, D, 0, itb, 0);
        transpose_matrix(C, PIN(19) + (size_t)l * D * D, D, D, (bf16_t*)(ws + WS_WO) + (size_t)l * D * D, D, 0, itb, 0);
    }
    transpose_matrix(C, PIN(20), D, DFF, (bf16_t*)(ws + WS_W13), D, 2, itb, 0);
    transpose_matrix(C, PIN(21), D, DFF, (bf16_t*)(ws + WS_W13), D, 3, itb, 0);
    transpose_matrix(C, PIN(22), DFF, D, (bf16_t*)(ws + WS_W2), DFFP, 0, itb, 0);
    { const int gt = C.vcu * 512 + C.tid, NT = C.G * 512;
      bf16_t* w13 = (bf16_t*)(ws + WS_W13) + (size_t)(2 * DFF) * D;
      for (int i = gt; i < (2 * DFFP - 2 * DFF) * D / 8; i += NT) ((u32x4*)w13)[i] = (u32x4){0u, 0u, 0u, 0u};
      bf16_t* w2 = (bf16_t*)(ws + WS_W2);
      for (int i = gt; i < D * (DFFP - DFF) / 8; i += NT) { const int r = i / ((DFFP - DFF) / 8), cc = i % ((DFFP - DFF) / 8); *(u32x4*)(w2 + (size_t)r * DFFP + DFF + cc * 8) = (u32x4){0u, 0u, 0u, 0u}; }
      float2* rope = (float2*)(ws + WS_ROPE);
      for (int i = gt; i < T * 32; i += NT) { const int t = i >> 5, pi = i & 31; const float invf = exp2f(-(float)(pi & 15) * (13.287712379549449f / 16.f));
          const float ang = (float)(pi < 16 ? (t >> 6) : (t & 63)) * invf; rope[i] = make_float2(cosf(ang), sinf(ang)); }
      float* lbs = (float*)(ws + WS_LBS);
      for (int i = gt; i < 2 * 2 * 512; i += NT) { const int l = i >> 10, dir = (i >> 9) & 1, d = i & 511; const float* lb = PIN(dir ? 16 : 15);
          const float p0 = lb[d], p1 = lb[512 + d]; lbs[i] = l == 0 ? 0.f : 1.f / (1.f + expf(p0 - p1)); }
    }
    phase_mods(C);
}
constexpr float W13_SCALE = 64.f, W2_SCALE = 128.f, HID_SCALE = 8.f;
DI void convert_moe_weights(const Ctx& C) {
    unsigned char* ws = C.ws; int itb = 0;
    for (int e = 0; e < NE; ++e) {
        transpose_matrix8(C, PIN(24) + (size_t)e * D * DFE, D, DFE, ws + WS_WM13 + (size_t)e * 2 * DFE * D, D, 2, W13_SCALE, itb);
        transpose_matrix8(C, PIN(25) + (size_t)e * D * DFE, D, DFE, ws + WS_WM13 + (size_t)e * 2 * DFE * D, D, 3, W13_SCALE, itb);
        transpose_matrix8(C, PIN(26) + (size_t)e * DFE * D, DFE, D, ws + WS_WM2 + (size_t)e * D * DFE, DFE, 0, W2_SCALE, itb);
    }
}

template <bool ROUTER>
DI void phase_norm(const Ctx& C, const float* xl, const float* xc, const float* nw, const float* mods, int shsel, int nrows, bf16_t* Hout, const float* rw, unsigned char* route, LAS int* cntL, unsigned char* H8 = nullptr) {
    int nloc = 0;
    f32x4 rwr[4][4][2];
    if (ROUTER) {
#pragma unroll
        for (int j = 0; j < 4; ++j)
#pragma unroll
            for (int q = 0; q < 4; ++q) { const float* rp = rw + (size_t)(256 * j + 4 * C.lane + q) * 8; rwr[j][q][0] = *(const f32x4*)rp; rwr[j][q][1] = *(const f32x4*)(rp + 4); } }
    for (int row0 = C.gw; row0 < nrows; row0 += 2 * C.NGW) {
        const int rows[2] = {row0, row0 + C.NGW}; const bool two = rows[1] < nrows;
        f32x4 v[2][4]; float ss[2] = {0.f, 0.f};
#pragma unroll
        for (int u = 0; u < 2; ++u) { const int row = (u == 1 && !two) ? rows[0] : rows[u]; const float* xr = row < NLAT ? xl + (size_t)row * D : xc + (size_t)(row - NLAT) * D;
#pragma unroll
            for (int j = 0; j < 4; ++j) { v[u][j] = *(const f32x4*)(xr + 256 * j + 4 * C.lane); ss[u] += (v[u][j][0] * v[u][j][0] + v[u][j][1] * v[u][j][1]) + (v[u][j][2] * v[u][j][2] + v[u][j][3] * v[u][j][3]); } }
#pragma unroll
        for (int u = 0; u < 2; ++u) { if (u == 1 && !two) break;
            const int row = rows[u]; const bool lat = row < NLAT;
            const float* mv = mods + (size_t)(lat ? (row >> 11) : 32) * DIN + shsel * D;
            const float rstd = 1.0f / sqrtf(wave_sum(ss[u]) * (1.f / D) + EPS);
            float lg[8];
            if (ROUTER) {
#pragma unroll
                for (int e = 0; e < 8; ++e) lg[e] = 0.f; }
#pragma unroll
            for (int j = 0; j < 4; ++j) { const int c0 = 256 * j + 4 * C.lane;
                const f32x4 w = *(const f32x4*)(nw + c0), sh = *(const f32x4*)(mv + c0), sc = *(const f32x4*)(mv + D + c0);
                f32x4 h = (v[u][j] * rstd) * w * (sc + 1.0f) + sh;
                if (ROUTER) *(unsigned*)((unsigned char*)Hout + (size_t)row * D + c0) = pack_fp8x4(h[0], h[1], h[2], h[3]);
                else { u32x2 o; o.x = cvt_pk_bf16(h[0], h[1]); o.y = cvt_pk_bf16(h[2], h[3]); *(u32x2*)(Hout + (size_t)row * D + c0) = o;
                       if (H8) *(unsigned*)(H8 + (size_t)row * D + c0) = pack_fp8x4(h[0], h[1], h[2], h[3]); }
                if (ROUTER) {
#pragma unroll
                    for (int q = 0; q < 4; ++q) { const f32x4 r0 = rwr[j][q][0], r1 = rwr[j][q][1];
                        lg[0] += h[q] * r0[0]; lg[1] += h[q] * r0[1]; lg[2] += h[q] * r0[2]; lg[3] += h[q] * r0[3]; lg[4] += h[q] * r1[0]; lg[5] += h[q] * r1[1]; lg[6] += h[q] * r1[2]; lg[7] += h[q] * r1[3]; } }
            }
            if (ROUTER) {
                const bool b5 = (C.lane & 32) != 0, b4 = (C.lane & 16) != 0, b3 = (C.lane & 8) != 0; float a4[4], a2[2], a1;
#pragma unroll
                for (int j = 0; j < 4; ++j) { const float snd = b5 ? lg[j] : lg[4 + j]; a4[j] = (b5 ? lg[4 + j] : lg[j]) + __shfl_xor(snd, 32); }
#pragma unroll
                for (int j = 0; j < 2; ++j) { const float snd = b4 ? a4[j] : a4[2 + j]; a2[j] = (b4 ? a4[2 + j] : a4[j]) + __shfl_xor(snd, 16); }
                { const float snd = b3 ? a2[0] : a2[1]; a1 = (b3 ? a2[1] : a2[0]) + __shfl_xor(snd, 8); }
                a1 += __shfl_xor(a1, 4); a1 += __shfl_xor(a1, 2); a1 += __shfl_xor(a1, 1);
                if ((C.lane & 7) == 0) ((LAS float*)(C.lds + C.wave * 4096))[nloc * 8 + (C.lane >> 3)] = a1;
                ++nloc;
            }
        }
    }
    if (ROUTER) {
        LDS_WAIT();
        for (int i = C.lane; i < nloc; i += 64) { const int row = C.gw + i * C.NGW; const LAS float* lp = (const LAS float*)(C.lds + C.wave * 4096) + i * 8;
            float lg[8];
#pragma unroll
            for (int e = 0; e < 8; ++e) lg[e] = lp[e];
            int e1 = 0; float l1 = lg[0];
#pragma unroll
            for (int e = 1; e < 8; ++e) if (lg[e] > l1) { l1 = lg[e]; e1 = e; }
            int e2 = -1; float l2 = -INFINITY;
#pragma unroll
            for (int e = 0; e < 8; ++e) if (e != e1 && lg[e] > l2) { l2 = lg[e]; e2 = e; }
            const float g2 = 1.f / (1.f + expf(l1 - l2)), g1 = 1.f - g2;
            int* rt = (int*)(route + (size_t)row * 24); rt[0] = e1; rt[1] = e2; ((float*)rt)[2] = g1; ((float*)rt)[3] = g2;
            atomicAdd((int*)&cntL[e1], 1); atomicAdd((int*)&cntL[e2], 1);
        }
    }
}

constexpr int AT_XCH = 65536, AT_ANW = 131072;
DI float max3f(float a, float b, float c) { return fmaxf(fmaxf(a, b), c); }
DI float xhalf(float v, int hi) {
    const auto rr = __builtin_amdgcn_permlane32_swap(__float_as_uint(v), __float_as_uint(v), false, false);
    return __uint_as_float(hi ? rr[0] : rr[1]);
}
constexpr float AT_THR = 8.f;
DI void attn_unit(const Ctx& C, bf16_t* P, int qrow0, int krow_ctx, int krow_lat, int nkt, int h, float lam, const float* anw, float post) {
    const int tid_ = my_tid();
    LAS unsigned char* lds = C.lds; const int lane = tid_ & 63, wid = __builtin_amdgcn_readfirstlane(tid_ >> 6), sub = wid >> 2, qw = wid & 3, r32 = lane & 31, hh = lane >> 5;
    const int tq = (lane & 15) >> 2, tp = lane & 3, blk = (lane >> 4) & 1;
    LAS unsigned char* qlds = lds + AT_XCH + wid * 8192 + r32 * 16;
#pragma unroll
    for (int qb = 0; qb < 2; ++qb) { const bf16_t* qp = P + (size_t)(qrow0 + 64 * qw + 32 * qb + r32) * PW + PC_Q + h * 128 + sub * 64 + 8 * hh;
#pragma unroll
      for (int ks = 0; ks < 4; ++ks) *(LAS bf16x8*)(qlds + ((2 * ks + hh) * 64 + 32 * qb) * 16) = *(const bf16x8*)(qp + 16 * ks); }
    if (tid_ < 32) *(LAS f32x4*)(lds + AT_ANW + tid_ * 16) = *(const f32x4*)(anw + 4 * tid_);
    f32x16 O[2][4];
#pragma unroll
    for (int qb = 0; qb < 2; ++qb)
#pragma unroll
        for (int c = 0; c < 4; ++c)
#pragma unroll
            for (int i = 0; i < 16; ++i) O[qb][c][i] = 0.f;
    float m_run[2] = {-INFINITY, -INFINITY}, l_run[2] = {0.f, 0.f};
#define AT_ISSUE(kt, buf) do { const int kr0_ = (kt) < 4 ? krow_ctx + (kt) * 64 : krow_lat + ((kt) - 4) * 64; LAS unsigned char* bb_ = lds + (buf) * 32768; \
        _Pragma("unroll") for (int j_ = 0; j_ < 2; ++j_) { const int c_ = 2 * wid + j_; \
            dma16a(P + (size_t)(kr0_ + lane) * PW + PC_K + h * 128 + c_ * 8, bb_ + c_ * 1024); \
            dma16a(P + (size_t)(kr0_ + 16 * (c_ & 3) + (lane >> 2)) * PW + PC_V + h * 128 + (c_ >> 2) * 32 + (lane & 3) * 8, bb_ + 16384 + c_ * 1024); } } while (0)
    AT_ISSUE(0, 0);
    int buf = 0;
#pragma unroll 1
    for (int kt = 0; kt < nkt; ++kt) {
        VM_WAIT(); __syncthreads();
        if (kt + 1 < nkt) AT_ISSUE(kt + 1, buf ^ 1);
        const LAS unsigned char* kb = lds + buf * 32768, * vb = kb + 16384 + (4 * hh + tq) * 64 + blk * 32 + tp * 8;
        bf16x8 Pf[2][4];
#pragma unroll
        for (int qb = 0; qb < 2; ++qb) {
            f32x16 s0, s1;
#pragma unroll
            for (int i = 0; i < 16; ++i) { s0[i] = 0.f; s1[i] = 0.f; }
#pragma unroll
            for (int ks = 0; ks < 4; ++ks) { const LAS unsigned char* kp = kb + ((sub * 8 + 2 * ks + hh) * 64 + r32) * 16;
                const bf16x8 k0 = *(const LAS bf16x8*)kp, k1 = *(const LAS bf16x8*)(kp + 512);
                const bf16x8 q = *(const LAS bf16x8*)(qlds + ((2 * ks + hh) * 64 + 32 * qb) * 16);
                s0 = MFMA32(k0, q, s0); s1 = MFMA32(k1, q, s1); }
            float mx = max3f(s0[0], s1[0], s0[1]);
#pragma unroll
            for (int i = 1; i < 16; ++i) mx = (i + 1 < 16) ? max3f(mx, s1[i], s0[i + 1]) : fmaxf(mx, s1[i]);
            mx = fmaxf(mx, xhalf(mx, hh));
            const float mnew = fmaxf(m_run[qb], mx);
            if (__any(mx > m_run[qb] + AT_THR)) { const float alpha = __builtin_amdgcn_exp2f(m_run[qb] - mnew); l_run[qb] *= alpha;
#pragma unroll
                for (int c = 0; c < 4; ++c)
#pragma unroll
                    for (int i = 0; i < 16; ++i) O[qb][c][i] *= alpha;
                m_run[qb] = mnew; }
            const float mr = m_run[qb]; float ps0 = 0.f, ps1 = 0.f;
#pragma unroll
            for (int i = 0; i < 16; ++i) { s0[i] = __builtin_amdgcn_exp2f(s0[i] - mr); s1[i] = __builtin_amdgcn_exp2f(s1[i] - mr); ps0 += s0[i]; ps1 += s1[i]; }
            l_run[qb] += ps0 + ps1;
            Pf[qb][0] = packf8(s0, 0); Pf[qb][1] = packf8(s0, 1); Pf[qb][2] = packf8(s1, 0); Pf[qb][3] = packf8(s1, 1);
        }
#pragma unroll
        for (int cb = 0; cb < 4; ++cb) {
#pragma unroll
            for (int s4 = 0; s4 < 4; ++s4) { const bf16x8 a = cat8(tr16(vb + cb * 4096 + s4 * 1024), tr16(vb + cb * 4096 + s4 * 1024 + 512));
                O[0][cb] = MFMA32(a, Pf[0][s4], O[0][cb]); O[1][cb] = MFMA32(a, Pf[1][s4], O[1][cb]); } }
        buf ^= 1;
    }
#undef AT_ISSUE
    LDS_WAIT(); __syncthreads();
    const int te = my_tid(); const int lane_e = te & 63, wid_e = __builtin_amdgcn_readfirstlane(te >> 6);
    LAS float* xch = (LAS float*)(lds + AT_XCH) + (wid_e & 3) * 4096 + lane_e;
#pragma unroll
    for (int qb = 0; qb < 2; ++qb) {
        const float lt = l_run[qb] + xhalf(l_run[qb], lane_e >> 5); const float inv = 1.f / lt;
        if ((wid_e >> 2) == 1) { const float sc = -lam * inv;
#pragma unroll
            for (int c = 0; c < 4; ++c)
#pragma unroll
                for (int i = 0; i < 16; ++i) xch[(c * 16 + i) * 64] = O[qb][c][i] * sc; }
        LDS_WAIT(); __syncthreads();
        if ((wid_e >> 2) == 0) {
            float ss = 0.f;
#pragma unroll
            for (int c = 0; c < 4; ++c)
#pragma unroll
                for (int i = 0; i < 16; ++i) { const float o = O[qb][c][i] * inv + xch[(c * 16 + i) * 64]; O[qb][c][i] = o; ss += o * o; }
            ss += xhalf(ss, lane_e >> 5);
            const float rs = post / sqrtf(ss * (1.f / 128.f) + EPS);
            bf16_t* op = P + (size_t)(qrow0 + 64 * (wid_e & 3) + 32 * qb + (lane_e & 31)) * PW + PC_Q + h * 128;
#pragma unroll
            for (int c = 0; c < 4; ++c)
#pragma unroll
                for (int g = 0; g < 4; ++g) { const int v0 = 32 * c + 8 * g + 4 * (lane_e >> 5); const f32x4 w = *(const LAS f32x4*)(lds + AT_ANW + v0 * 4);
                    u32x2 o; o.x = cvt_pk_bf16(O[qb][c][4 * g] * rs * w[0], O[qb][c][4 * g + 1] * rs * w[1]); o.y = cvt_pk_bf16(O[qb][c][4 * g + 2] * rs * w[2], O[qb][c][4 * g + 3] * rs * w[3]);
                    *(u32x2*)(op + v0) = o; }
        }
        LDS_WAIT(); __syncthreads();
    }
}

constexpr int SC_Q = 0, SC_LF = 16384, SC_V0 = 32768, SC_QM = 65536, SC_KMR = 81920, SC_KMS = 98304, SC_SX = 114688, SC_A31 = 147456, SC_A63 = 147968, SC_END = 148480;
DI void scan_chain(const Ctx& C, bf16_t* P, int b, int h, int dir, bool store_ctx) {
    const int tid_ = my_tid();
    LAS unsigned char* lds = C.lds; const int lane = tid_ & 63, wid = __builtin_amdgcn_readfirstlane(tid_ >> 6), r32 = lane & 31, hh = lane >> 5;
    const int tq = (lane & 15) >> 2, tp = lane & 3, blk = (lane >> 4) & 1;
    const int db = wid & 3, tb = wid >> 2;
    const int base_nat = hh * 512 + tq * 64 + blk * 32 + tp * 8;
    const int base_prm = (4 * hh + tq) * 64 + blk * 32 + tp * 8;
    const int lfcol = (dir ? PC_LB : PC_LF) + h * 128, qcol = PC_RQ + h * 128, vcol = PC_RI + h * 128;
    f32x16 ST[2];
#pragma unroll
    for (int j = 0; j < 2; ++j)
#pragma unroll
        for (int i = 0; i < 16; ++i) ST[j][i] = 0.f;
#define SROW(c, i) ((c) < 4 ? NLAT + b * CL + (dir ? 255 - ((c) * 64 + (i)) : (c) * 64 + (i)) : b * T + (dir ? 2047 - (((c) - 4) * 64 + (i)) : ((c) - 4) * 64 + (i)))
#define SDMA(c, colbase, dstoff) do { _Pragma("unroll") for (int j_ = 0; j_ < 2; ++j_) { const int I_ = 2 * wid + j_; const int ti_ = 16 * (I_ & 3) + (lane >> 2); \
        dma16(P + (size_t)SROW(c, ti_) * PW + (colbase) + (I_ >> 2) * 32 + (lane & 3) * 8, lds + (dstoff) + I_ * 1024); } } while (0)
    SDMA(0, qcol, SC_Q); SDMA(0, lfcol, SC_LF); SDMA(0, vcol, SC_V0);
    int vbuf = 0;
    const int t = 32 * tb + r32;
#pragma unroll 1
    for (int c = 0; c < 36; ++c) {
        { const int st_ = __builtin_amdgcn_readfirstlane((c > 0 && (c > 4 || store_ctx)) ? 1 : 0);
          asm volatile("s_cmp_lg_u32 %0, 0\n\ts_cbranch_scc1 1f\n\ts_waitcnt vmcnt(0)\n1:\n\ts_waitcnt vmcnt(4)" :: "s"(st_) : "memory", "scc"); }
        LDS_BARRIER();
        const LAS unsigned char* Vimg = lds + SC_V0 + vbuf * 16384;
        f32x16 cm;
#pragma unroll
        for (int i = 0; i < 16; ++i) cm[i] = 0.f;
#pragma unroll
        for (int kk = 0; kk < 2; ++kk) { const int ks = 2 * tb + kk;
            const half8 a = __builtin_bit_cast(half8, cat8(tr16(lds + SC_LF + db * 4096 + base_nat + ks * 1024), tr16(lds + SC_LF + db * 4096 + base_nat + ks * 1024 + 256)));
            half8 bm;
#pragma unroll
            for (int j = 0; j < 8; ++j) { const int s = 16 * ks + 8 * hh + j; bm[j] = tb == 0 ? (s > t ? (_Float16)-1.f : (_Float16)0.f) : (s <= t ? (_Float16)1.f : (_Float16)0.f); }
            cm = __builtin_amdgcn_mfma_f32_32x32x16_f16(a, bm, cm, 0, 0, 0); }
#pragma unroll
        for (int g = 0; g < 4; ++g) {
            const int sa = db * 4096 + (t >> 3) * 512 + (t & 7) * 64 + (8 * g + 4 * hh) * 2;
            const u32x2 q4 = *(const LAS u32x2*)(lds + SC_Q + sa); const half4 lf4 = *(const LAS half4*)(lds + SC_LF + sa);
            const float qv[4] = {bflo(q4.x), bfhi(q4.x), bflo(q4.y), bfhi(q4.y)};
            float qm[4], km[4];
#pragma unroll
            for (int e = 0; e < 4; ++e) { const float cv = cm[4 * g + e] * LOG2E; const float E = __builtin_amdgcn_exp2f(cv), Ei = __builtin_amdgcn_exp2f(-cv);
                const float lf = (float)lf4[e]; qm[e] = qv[e] * E; km[e] = (1.f - __builtin_amdgcn_exp2f(lf * LOG2E)) * Ei;
                if (tb == 0 && r32 == 0) ((LAS float*)(lds + SC_A31))[32 * db + 8 * g + 4 * hh + e] = lf - cm[4 * g + e];
                if (tb == 1 && r32 == 31) ((LAS float*)(lds + SC_A63))[32 * db + 8 * g + 4 * hh + e] = cm[4 * g + e]; }
            u32x2 qw2, kw2; qw2.x = cvt_pk_bf16(qm[0], qm[1]); qw2.y = cvt_pk_bf16(qm[2], qm[3]); kw2.x = cvt_pk_bf16(km[0], km[1]); kw2.y = cvt_pk_bf16(km[2], km[3]);
            const int ra = ((4 * db + g) * 64 + t) * 16 + 8 * hh;
            *(LAS u32x2*)(lds + SC_QM + ra) = qw2; *(LAS u32x2*)(lds + SC_KMR + ra) = kw2; *(LAS u32x2*)(lds + SC_KMS + sa) = kw2;
        }
        LDS_BARRIER();
        if (c + 1 < 36) { SDMA(c + 1, qcol, SC_Q); SDMA(c + 1, lfcol, SC_LF); SDMA(c + 1, vcol, SC_V0 + (vbuf ^ 1) * 16384); }
        { const int d = 32 * db + r32; const float c31 = ((LAS float*)(lds + SC_A31))[d], c63 = ((LAS float*)(lds + SC_A63))[d];
          const float e31 = __expf(c31), dec = __expf(c31 + c63), e63 = __expf(c63);
          f32x16 SN[2];
#pragma unroll
          for (int j = 0; j < 2; ++j) { const int vb2 = 2 * tb + j;
#pragma unroll
              for (int g = 0; g < 4; ++g) { u32x2 w; w.x = cvt_pk_bf16(ST[j][4 * g] * e31, ST[j][4 * g + 1] * e31); w.y = cvt_pk_bf16(ST[j][4 * g + 2] * e31, ST[j][4 * g + 3] * e31);
                  *(LAS u32x2*)(lds + SC_SX + vb2 * 8192 + (d >> 3) * 512 + (d & 7) * 64 + (8 * g + 4 * hh) * 2) = w; }
#pragma unroll
              for (int i = 0; i < 16; ++i) SN[j][i] = 0.f; }
#pragma unroll
          for (int ks = 0; ks < 4; ++ks) {
              const bf16x8 kf = cat8(tr16(lds + SC_KMS + db * 4096 + base_nat + ks * 1024), tr16(lds + SC_KMS + db * 4096 + base_nat + ks * 1024 + 256));
#pragma unroll
              for (int j = 0; j < 2; ++j) { const int vb2 = 2 * tb + j;
                  const bf16x8 vf = cat8(tr16(Vimg + vb2 * 4096 + base_nat + ks * 1024), tr16(Vimg + vb2 * 4096 + base_nat + ks * 1024 + 256));
                  SN[j] = MFMA32(vf, kf, SN[j]); } }
#pragma unroll
          for (int j = 0; j < 2; ++j)
#pragma unroll
              for (int i = 0; i < 16; ++i) ST[j][i] = dec * ST[j][i] + e63 * SN[j][i];
        }
        LDS_BARRIER();
        { bf16x8 Qmf[8];
#pragma unroll
          for (int kd = 0; kd < 8; ++kd) Qmf[kd] = *(const LAS bf16x8*)(lds + SC_QM + ((2 * kd + hh) * 64 + t) * 16);
          f32x16 o;
#pragma unroll
          for (int i = 0; i < 16; ++i) o[i] = 0.f;
          for (int sb = 0; sb <= tb; ++sb) {
              f32x16 pt;
#pragma unroll
              for (int i = 0; i < 16; ++i) pt[i] = 0.f;
#pragma unroll
              for (int kd = 0; kd < 8; ++kd) { const bf16x8 a = *(const LAS bf16x8*)(lds + SC_KMR + ((2 * kd + hh) * 64 + 32 * sb + r32) * 16); pt = MFMA32(a, Qmf[kd], pt); }
              if (sb == tb) {
#pragma unroll
                  for (int i = 0; i < 16; ++i) if (crow(i, hh) > r32) pt[i] = 0.f; }
              const bf16x8 p0 = packf8(pt, 0), p1 = packf8(pt, 1);
              { const bf16x8 a = cat8(tr16(Vimg + db * 4096 + base_prm + (2 * sb) * 1024), tr16(Vimg + db * 4096 + base_prm + (2 * sb) * 1024 + 512)); o = MFMA32(a, p0, o); }
              { const bf16x8 a = cat8(tr16(Vimg + db * 4096 + base_prm + (2 * sb + 1) * 1024), tr16(Vimg + db * 4096 + base_prm + (2 * sb + 1) * 1024 + 512)); o = MFMA32(a, p1, o); }
          }
#pragma unroll
          for (int kd = 0; kd < 8; ++kd) { const bf16x8 a = cat8(tr16(lds + SC_SX + db * 8192 + base_nat + kd * 1024), tr16(lds + SC_SX + db * 8192 + base_nat + kd * 1024 + 256)); o = MFMA32(a, Qmf[kd], o); }
          if (c >= 4 || store_ctx) { bf16_t* op = P + (size_t)SROW(c, t) * PW + lfcol + 32 * db;
#pragma unroll
              for (int g = 0; g < 4; ++g) { u32x2 w; w.x = cvt_pk_bf16(o[4 * g], o[4 * g + 1]); w.y = cvt_pk_bf16(o[4 * g + 2], o[4 * g + 3]); *(u32x2*)(op + 8 * g + 4 * hh) = w; } }
        }
        vbuf ^= 1;
    }
    VM_WAIT(); LDS_WAIT(); __syncthreads();
#undef SROW
#undef SDMA
}

DI void phase_recprep(const Ctx& C, bf16_t* P, const float* rnw, int nrows) {
    const f32x4 w0 = *(const f32x4*)(rnw + ((8 * C.lane) & 127)), w1 = *(const f32x4*)(rnw + ((8 * C.lane) & 127) + 4);
    for (int row0 = C.gw; row0 < nrows; row0 += 4 * C.NGW) {
        u32x4 ra[4], rb[4], rg[4];
#pragma unroll
        for (int u = 0; u < 4; ++u) { const int row = row0 + u * C.NGW < nrows ? row0 + u * C.NGW : row0; const bf16_t* pr = P + (size_t)row * PW + 8 * C.lane;
            ra[u] = *(const u32x4*)(pr + PC_LF); rb[u] = *(const u32x4*)(pr + PC_LB); rg[u] = *(const u32x4*)(pr + PC_G); }
#pragma unroll
        for (int u = 0; u < 4; ++u) { const int row = row0 + u * C.NGW; if (row >= nrows) break;
            float a[8], bb[8], g[8]; unpack8(ra[u], a); unpack8(rb[u], bb); unpack8(rg[u], g);
            float ss = 0.f;
#pragma unroll
            for (int j = 0; j < 8; ++j) { a[j] += bb[j]; ss += a[j] * a[j]; }
            ss += __shfl_xor(ss, 1); ss += __shfl_xor(ss, 2); ss += __shfl_xor(ss, 4); ss += __shfl_xor(ss, 8);
            const float rs = 1.0f / sqrtf(ss * (1.f / 128.f) + EPS);
            f32x4 o0, o1;
#pragma unroll
            for (int j = 0; j < 4; ++j) { o0[j] = a[j] * rs * w0[j] * g[j]; o1[j] = a[4 + j] * rs * w1[j] * g[4 + j]; }
            *(u32x4*)(P + (size_t)row * PW + 8 * C.lane + PC_LF) = pack8(o0, o1); }
    }
}

DI void phase_slots(const Ctx& C, const int* cnt, int* pbout, unsigned char* route, const bf16_t* H2, bf16_t* AG, LAS int* cur) {
    if (C.tid < 16) cur[C.tid] = 0;
    __syncthreads();
    for (int g = C.tid; g < C.G; g += 512) {
#pragma unroll
        for (int k = 0; k < 8; ++k) { const int c = cnt[g * 8 + k]; atomicAdd((int*)&cur[8 + k], c); if (g < C.bx) atomicAdd((int*)&cur[k], c); } }
    __syncthreads();
    if (C.tid < 8) { const int e = C.tid; int pb = 0, pbe = 0;
#pragma unroll
        for (int k = 0; k < 8; ++k) { if (k == e) pbe = pb; pb += (cur[8 + k] + 255) >> 8; }
        const int mine = cur[e];
        if (C.bx == 0) { pbout[e] = pbe; if (e == 7) pbout[8] = pb; }
        cur[e] = pbe * 256 + mine;
    }
    __syncthreads();
    const int nloc = (NLAT - C.gw + C.NGW - 1) / C.NGW;
    LAS int* tab = (LAS int*)(C.lds + C.wave * 2048);
    for (int i = C.lane; i < nloc; i += 64) { int* rt = (int*)(route + (size_t)(C.gw + i * C.NGW) * 24);
        const int s1 = atomicAdd((int*)&cur[rt[0]], 1), s2 = atomicAdd((int*)&cur[rt[1]], 1); rt[4] = s1; rt[5] = s2; tab[2 * i] = s1; tab[2 * i + 1] = s2; }
    LDS_WAIT();
    for (int i = 0; i < nloc; i += 2) { const int i1 = i + 1 < nloc ? i + 1 : i;
        const int sa1 = __builtin_amdgcn_readfirstlane(tab[2 * i]), sa2 = __builtin_amdgcn_readfirstlane(tab[2 * i + 1]), sb1 = __builtin_amdgcn_readfirstlane(tab[2 * i1]), sb2 = __builtin_amdgcn_readfirstlane(tab[2 * i1 + 1]);
        const u32x4 va = *((const u32x4*)((const unsigned char*)H2 + (size_t)(C.gw + i * C.NGW) * D) + C.lane);
        const u32x4 vb = *((const u32x4*)((const unsigned char*)H2 + (size_t)(C.gw + i1 * C.NGW) * D) + C.lane);
        *((u32x4*)((unsigned char*)AG + (size_t)sa1 * D) + C.lane) = va; *((u32x4*)((unsigned char*)AG + (size_t)sa2 * D) + C.lane) = va;
        *((u32x4*)((unsigned char*)AG + (size_t)sb1 * D) + C.lane) = vb; *((u32x4*)((unsigned char*)AG + (size_t)sb2 * D) + C.lane) = vb;
    }
}
DI void phase_final(const Ctx& C, float* x, const unsigned char* route, const bf16_t* Y, const float* mods1, const float* fw) {
    for (int row0 = C.gw; row0 < NLAT; row0 += 2 * C.NGW) {
        const int rows[2] = {row0, row0 + C.NGW < NLAT ? row0 + C.NGW : row0};
        f32x4 v[2][4]; float ss[2] = {0.f, 0.f};
#pragma unroll
        for (int u = 0; u < 2; ++u) { const int row = rows[u];
            const int* rt = (const int*)(route + (size_t)row * 24); const float g1 = ((const float*)rt)[2], g2 = ((const float*)rt)[3]; const int s1 = rt[4], s2 = rt[5];
            const float* mv = mods1 + (size_t)(row >> 11) * DIN + 5 * D; const float* xr = x + (size_t)row * D;
#pragma unroll
            for (int j = 0; j < 4; ++j) { const int c0 = 256 * j + 4 * C.lane;
                const u32x2 y1 = *(const u32x2*)(Y + (size_t)s1 * D + c0), y2 = *(const u32x2*)(Y + (size_t)s2 * D + c0); const f32x4 m5 = *(const f32x4*)(mv + c0);
                f32x4 y; y[0] = g1 * bflo(y1.x) + g2 * bflo(y2.x); y[1] = g1 * bfhi(y1.x) + g2 * bfhi(y2.x); y[2] = g1 * bflo(y1.y) + g2 * bflo(y2.y); y[3] = g1 * bfhi(y1.y) + g2 * bfhi(y2.y);
                v[u][j] = *(const f32x4*)(xr + c0) + m5 * y; ss[u] += (v[u][j][0] * v[u][j][0] + v[u][j][1] * v[u][j][1]) + (v[u][j][2] * v[u][j][2] + v[u][j][3] * v[u][j][3]); } }
#pragma unroll
        for (int u = 0; u < 2; ++u) { if (u == 1 && rows[1] == rows[0]) break;
            const float rstd = 1.0f / sqrtf(wave_sum(ss[u]) * (1.f / D) + EPS); float* xr = x + (size_t)rows[u] * D;
#pragma unroll
            for (int j = 0; j < 4; ++j) { const int c0 = 256 * j + 4 * C.lane; *(f32x4*)(xr + c0) = v[u][j] * rstd * *(const f32x4*)(fw + c0); } }
    }
}

constexpr int LDS_MISC = SC_END;
constexpr int LDS_BYTES = SC_END + 512;
static_assert(LDS_WTAB_OFF == SC_END + 128, "wave table sits behind the barrier words and counters");
constexpr int NPHASE = 20;

DI Ctx make_ctx() {
    extern __shared__ __attribute__((aligned(16))) unsigned char lds_raw[];
    Ctx C; const int t = my_tid();
    unsigned lb = (unsigned)(size_t)(LAS unsigned char*)lds_raw; asm volatile("" : "+s"(lb));
    C.lds = (LAS unsigned char*)(size_t)lb; C.ws = kparams()->ws; C.tid = t; C.lane = t & 63; C.wave = __builtin_amdgcn_readfirstlane(t >> 6);
    int bx = blockIdx.x, G = gridDim.x; asm volatile("" : "+s"(bx), "+s"(G));
    C.bx = bx; C.G = G; C.vcu = (C.G % 8 == 0) ? (bx % 8) * (C.G / 8) + bx / 8 : bx;
    C.gw = C.vcu * 8 + C.wave; C.NGW = C.G * 8;
    return C;
}
DI void grid_barrier() {
    extern __shared__ __attribute__((aligned(16))) unsigned char lds_raw[];
    XcdBarrier b; b.bar = (unsigned*)(kparams()->ws + WS_CTL) + CW_BAR + kparams()->li * XCD_BAR_WORDS; b.x = xb_xcc_id(); b.st = (volatile LAS unsigned*)((LAS unsigned char*)lds_raw + LDS_MISC);
    xcd_barrier(b);
}
#define WSP(T, off) ((T*)(kparams()->ws + (off)))

#define IN(k) (kparams()->ph_lo <= (k) && (k) < kparams()->ph_hi)
#define SEAM(k) do { if (IN(k) && IN((k) + 1)) grid_barrier(); } while (0)


template <int l> DI void layer_phases() {
        constexpr int FS = l == 0 ? FP8_SECS0 : FP8_SECS1, N_SEC_F8 = n_sec_f8(FS), N_SEC_BF = 8 - N_SEC_F8;
        const int pb = 1 + 9 * l;
#define LQ() int lq = l; asm volatile("" : "+s"(lq))
#define XL (lq == 0 ? PIN(0) : (const float*)POUT)
#define XC (lq == 0 ? PIN(2) : (const float*)WSP(float, WS_CTXRES))
#define LMODS (WSP(float, WS_MODS) + (size_t)lq * 33 * DIN)
#define NROWS_OUT (lq == 0 ? NTOK : NLAT)
        if (IN(pb + 0)) { LQ(); const Ctx C = make_ctx(); phase_norm<false>(C, XL, XC, PIN(6) + lq * D, LMODS, 0, NTOK, WSP(bf16_t, WS_H), nullptr, nullptr, nullptr, WSP(unsigned char, WS_H8)); }
        SEAM(pb + 0);
        if (IN(pb + 1)) { LQ();
            { const Ctx C = make_ctx();
              Gemm g{WSP(bf16_t, WS_H), WSP(bf16_t, WS_WIN) + (size_t)lq * 4096 * D, NTOK, N_SEC_BF * 512, D, D};
              pg8::StaticOrder S; S.init(g, C.G, C.bx);
              EpiInProj E{WSP(bf16_t, WS_P), WSP(float2, WS_ROPE), WSP(float, WS_LBS) + lq * 1024, WSP(float, WS_LBS) + lq * 1024 + 512, (int)secmap_of(FS, false), 1.f};
              pg8::gemm_phase<EpiInProj, pg8::StaticOrder>(C.lds, g, S, E); }
            if (N_SEC_F8 > 0) { const Ctx C = make_ctx();
              Gemm g{WSP(bf16_t, WS_H8), (const bf16_t*)(WSP(unsigned char, WS_WIN8) + (size_t)lq * 4096 * D), NTOK, N_SEC_F8 * 512, D / 2, D / 2};
              pg8::StaticOrder S; S.init(g, C.G, C.bx);
              EpiInProj E{WSP(bf16_t, WS_P), WSP(float2, WS_ROPE), WSP(float, WS_LBS) + lq * 1024, WSP(float, WS_LBS) + lq * 1024 + 512, (int)secmap_of(FS, true), 1.f / WIN8_SCALE};
              pg8::gemm_phase<EpiInProj, pg8::StaticOrder, true, true>(C.lds, g, S, E); }
        }
        SEAM(pb + 1);
        if (IN(pb + 2)) { LQ(); const Ctx C = make_ctx(); bf16_t* const Pb = WSP(bf16_t, WS_P);
            for (int id = C.vcu; id < NB * 4 * 2; id += C.G) scan_chain(C, Pb, id >> 3, (id >> 1) & 3, id & 1, lq == 0);
            float lam;
            { const float a = wave_sum(PIN(9)[lq * 64 + C.lane] * PIN(10)[lq * 64 + C.lane]), b2 = wave_sum(PIN(11)[lq * 64 + C.lane] * PIN(12)[lq * 64 + C.lane]);
              const float li = 0.8f - 0.6f * expf(-0.3f * (float)lq); lam = expf(a) - expf(b2) + li; lam = __uint_as_float(__builtin_amdgcn_readfirstlane(__float_as_uint(lam))); }
            const float post = __uint_as_float(__builtin_amdgcn_readfirstlane(__float_as_uint(1.f - (0.8f - 0.6f * expf(-0.3f * (float)lq)))));
            const float* anw = PIN(13) + lq * 128;
            const int NU = NB * 4 * 8, U = (NU + C.G - 1) / C.G;
            for (int id = C.vcu * U; id < NU && id < (C.vcu + 1) * U; ++id) { const int bh = id >> 3, qb = id & 7, b = bh >> 2, h = bh & 3;
                attn_unit(C, Pb, b * T + qb * 256, NLAT + b * CL, b * T, 36, h, lam, anw, post); }
            if (lq == 0) for (int id = C.vcu; id < NB * 4; id += C.G) { const int b = id >> 2, h = id & 3;
                attn_unit(C, Pb, NLAT + b * CL, NLAT + b * CL, 0, 4, h, lam, anw, post); }
        }
        SEAM(pb + 2);
        if (IN(pb + 3)) { LQ(); const Ctx C = make_ctx();
            phase_recprep(C, WSP(bf16_t, WS_P), PIN(14) + lq * 128, NROWS_OUT);
            Gemm g{WSP(bf16_t, WS_H8), (const bf16_t*)(WSP(unsigned char, WS_WIN8) + ((size_t)lq * 4096 + N_SEC_F8 * 512) * D), NROWS_OUT, 2048, D / 2, D / 2};
            pg8::StaticOrder S; S.init(g, C.G, C.bx);
            EpiGates E{WSP(bf16_t, WS_P), 1.f / WIN8_SCALE};
            pg8::gemm_phase<EpiGates, pg8::StaticOrder, true, true>(C.lds, g, S, E);
        }
        SEAM(pb + 3);
        if (IN(pb + 4)) { LQ(); const Ctx C = make_ctx();
            Gemm g{WSP(bf16_t, WS_P) + PC_Q, WSP(bf16_t, WS_WUA) + (size_t)lq * D * D, NROWS_OUT, D, D, PW};
            pg8::StaticOrder S; S.init(g, C.G, C.bx); EpiMergeFused E{WSP(bf16_t, WS_P), WSP(bf16_t, WS_MERGED)};
            pg8::gemm_phase<EpiMergeFused, pg8::StaticOrder, true, false, true>(C.lds, g, S, E);
        }
        SEAM(pb + 4);
        if (IN(pb + 5)) { LQ(); const Ctx C = make_ctx();
            Gemm g{WSP(bf16_t, WS_MERGED), WSP(bf16_t, WS_WO) + (size_t)lq * D * D, NROWS_OUT, D, D, D};
            pg8::StaticOrder S; S.init(g, C.G, C.bx);
            EpiResid E{XL, XC, POUT, WSP(float, WS_CTXRES), LMODS, 2};
            pg8::gemm_phase<EpiResid, pg8::StaticOrder>(C.lds, g, S, E);
        }
        SEAM(pb + 5);
        if (l == 0) {
            if (IN(7)) { LQ(); const Ctx C = make_ctx(); phase_norm<false>(C, POUT, WSP(float, WS_CTXRES), PIN(7), LMODS, 3, NTOK, WSP(bf16_t, WS_H), nullptr, nullptr, nullptr); }
            SEAM(7);
            if (IN(8)) { LQ(); const Ctx C = make_ctx();
                Gemm g{WSP(bf16_t, WS_H), WSP(bf16_t, WS_W13), NTOK, 2 * DFFP, D, D};
                pg8::StaticOrder S; S.init(g, C.G, C.bx); EpiSwiglu E{WSP(bf16_t, WS_HID), DFFP, 0};
                pg8::gemm_phase<EpiSwiglu, pg8::StaticOrder>(C.lds, g, S, E);
            }
            SEAM(8);
            if (IN(9)) { LQ(); const Ctx C = make_ctx();
                Gemm g{WSP(bf16_t, WS_HID), WSP(bf16_t, WS_W2), NTOK, D, DFFP, DFFP};
                pg8::StaticOrder S; S.init(g, C.G, C.bx); EpiResid E{POUT, WSP(float, WS_CTXRES), POUT, WSP(float, WS_CTXRES), LMODS, 5};
                pg8::gemm_phase<EpiResid, pg8::StaticOrder>(C.lds, g, S, E);
            }
            SEAM(9);
        } else {
            if (IN(16)) { LQ(); const Ctx C = make_ctx(); LAS int* lcnt = (LAS int*)(C.lds + LDS_MISC + 32);
                if (C.tid < 8) lcnt[C.tid] = 0;
                __syncthreads();
                phase_norm<true>(C, POUT, nullptr, PIN(7) + D, LMODS, 3, NLAT, WSP(bf16_t, WS_H2M), PIN(23), WSP(unsigned char, WS_ROUTE), lcnt);
                __syncthreads();
                if (C.tid < 8) WSP(int, WS_CNT)[C.bx * 8 + C.tid] = lcnt[C.tid];
                convert_moe_weights(C);
            }
            SEAM(16);
            if (IN(17)) { LQ(); const Ctx C = make_ctx(); phase_slots(C, WSP(int, WS_CNT), WSP(int, WS_CNT) + 4096, WSP(unsigned char, WS_ROUTE), WSP(bf16_t, WS_H2M), WSP(bf16_t, WS_AG), (LAS int*)(C.lds + LDS_MISC + 32)); }
            SEAM(17);
            if (IN(18)) { LQ();
                const int ptot = __builtin_amdgcn_readfirstlane(WSP(int, WS_CNT)[4096 + 8]);
                for (int p0 = 0; p0 < ptot; p0 += MOE_CHUNK) {
                    const int np = (ptot - p0) < MOE_CHUNK ? (ptot - p0) : MOE_CHUNK;
#define MOE_ORDER_INIT(S) do { S.so.init(g, C.G, C.bx); S.p0 = p0; S.load_pb(WSP(int, WS_CNT) + 4096); } while (0)
                    { const Ctx C = make_ctx(); Gemm g{WSP(bf16_t, WS_AG), WSP(bf16_t, WS_WM13), np * 256, 2 * DFE, D / 2, D / 2};
                      pg8::MoeOrder S; MOE_ORDER_INIT(S); S.apan0 = 0; S.estride = (size_t)2 * DFE * D;
                      EpiSwiglu8 E{WSP(unsigned char, WS_MHID), DFE, p0, 1.f / W13_SCALE, HID_SCALE};
                      pg8::gemm_phase<EpiSwiglu8, pg8::MoeOrder, true, true>(C.lds, g, S, E); }
                    grid_barrier();
                    { const Ctx C = make_ctx(); Gemm g{WSP(bf16_t, WS_MHID), WSP(bf16_t, WS_WM2), np * 256, D, DFE / 2, DFE / 2};
                      pg8::MoeOrder S; MOE_ORDER_INIT(S); S.apan0 = p0; S.estride = (size_t)D * DFE;
                      EpiBf16 E{WSP(bf16_t, WS_Y), D, 1.f / (W2_SCALE * HID_SCALE)};
                      pg8::gemm_phase<EpiBf16, pg8::MoeOrder, true, true>(C.lds, g, S, E); }
                    grid_barrier();
                }
            }
            if (IN(19)) { LQ(); const Ctx C = make_ctx(); phase_final(C, POUT, WSP(unsigned char, WS_ROUTE), WSP(bf16_t, WS_Y), LMODS, PIN(27)); }
        }
}

__global__ void __launch_bounds__(512, 2) fwd_kernel(Params p) {
    extern __shared__ __attribute__((aligned(16))) unsigned char lds_raw[];
    (void)p;
    { volatile LAS unsigned* misc = (volatile LAS unsigned*)((LAS unsigned char*)lds_raw + LDS_MISC);
      if (threadIdx.x < 16) misc[threadIdx.x] = 0u;
      if ((threadIdx.x & 63) == 0) ((volatile LAS int*)((LAS unsigned char*)lds_raw + LDS_WTAB_OFF))[(unsigned)__builtin_amdgcn_s_getreg((5 << 11) | 4) & 63u] = threadIdx.x >> 6;
      __syncthreads();
      (void)xcd_barrier_post((unsigned*)(kparams()->ws + WS_CTL) + CW_BAR + kparams()->li * XCD_BAR_WORDS, misc); }
    if (IN(0)) { const Ctx C = make_ctx(); phase_prologue(C); } SEAM(0);

    layer_phases<0>();
    layer_phases<1>();
#undef IN
#undef SEAM
}


extern "C" void kernel_launch(void* const* d_in, const int* in_sizes, int n_in, void* d_out, int out_size, void* d_ws, size_t ws_size, hipStream_t stream) {
    static int grid = 0;
    if (grid == 0) {
        if (n_in != 28 || out_size != NLAT * D || ws_size < WS_END) { fprintf(stderr, "kernel_launch: unexpected problem (n_in %d, out %d, ws %zu)\n", n_in, out_size, ws_size); grid = -1; return; }
        int dev = 0, cus = 0, per_cu = 0;
        if (hipGetDevice(&dev) != hipSuccess || hipDeviceGetAttribute(&cus, hipDeviceAttributeMultiprocessorCount, dev) != hipSuccess) { grid = -1; return; }
        if (hipFuncSetAttribute((const void*)fwd_kernel, hipFuncAttributeMaxDynamicSharedMemorySize, LDS_BYTES) != hipSuccess) { fprintf(stderr, "kernel_launch: cannot set %d B dynamic LDS\n", LDS_BYTES); grid = -1; return; }
        if (hipOccupancyMaxActiveBlocksPerMultiprocessor(&per_cu, (const void*)fwd_kernel, 512, LDS_BYTES) != hipSuccess || per_cu < 1) fprintf(stderr, "kernel_launch: occupancy query says %d\n", per_cu);
        (void)hipGetLastError();
        grid = cus;
    }
    if (grid < 0) return;
    (void)hipMemsetAsync((char*)d_ws + WS_CTL, 0, CTL_BYTES, stream);
    Params a{};
    for (int i = 0; i < 28; ++i) a.in[i] = (const float*)d_in[i];
    a.out = (float*)d_out; a.ws = (unsigned char*)d_ws; a.ph_lo = 0; a.ph_hi = NPHASE; a.li = 0; a.pad = 0;
    hipLaunchKernelGGL(fwd_kernel, dim3(grid), dim3(512), LDS_BYTES, stream, a);
}
```

```cpp
#include <hip/hip_runtime.h>
#include <cstdio>
#include <cstdint>


constexpr int D = 1024, NB = 32, T = 2048, CL = 256;
constexpr int NLAT = NB * T, NCTX = NB * CL, NTOK = NLAT + NCTX;
constexpr int PW = 4096;
constexpr int DIN = 6144, DFF = 2752, DFFP = 2816, DFE = 3584, NE = 8;
constexpr float EPS = 1e-6f;
constexpr float LOG2E = 1.4426950408889634f;
constexpr float QSCALE = 0.125f * LOG2E;
constexpr int PC_Q = 0, PC_LF = 512, PC_G = 1024, PC_LB = 1536, PC_K = 2048, PC_V = 2560, PC_RQ = 3072, PC_RI = 3584, PC_GA = 2048, PC_GR = 3072;

constexpr size_t MiB = 1u << 20;
constexpr size_t WS_CTL = 0, CTL_BYTES = 1 * MiB;
constexpr size_t WS_MODS = 1 * MiB;
constexpr size_t WS_LBS = 3 * MiB;
constexpr size_t WS_ROPE = 3 * MiB + 65536;
constexpr size_t WS_ROUTE = 4 * MiB;
constexpr size_t WS_CNT = 6 * MiB;
constexpr size_t WS_CTXRES = 8 * MiB;
constexpr size_t WS_WIN = 40 * MiB;
constexpr size_t WS_WIN8 = 56 * MiB;
constexpr size_t WS_H8 = 809 * MiB;
constexpr size_t WS_WUA = 64 * MiB;
constexpr size_t WS_WUR = 66 * MiB;
constexpr size_t WS_WO = 68 * MiB;
constexpr size_t WS_W13 = 72 * MiB;
constexpr size_t WS_W2 = 83 * MiB;
constexpr size_t WS_H = 89 * MiB;
constexpr size_t WS_P = 233 * MiB;
constexpr size_t WS_MERGED = 809 * MiB;
constexpr size_t WS_HID = 233 * MiB;
constexpr size_t WS_WM13 = 8 * MiB;
constexpr size_t WS_WM2 = 120 * MiB;
constexpr size_t WS_AG = 176 * MiB;
constexpr size_t WS_MHID = 436 * MiB;
constexpr size_t WS_Y = 674 * MiB;
constexpr size_t WS_H2M = 896 * MiB;
constexpr size_t WS_END = 1024 * MiB;
constexpr int MOE_CHUNK = 256;

constexpr int CW_BAR = 4096;

#define LAS __attribute__((address_space(3)))
#define GAS __attribute__((address_space(1)))
typedef unsigned short bf16_t;
typedef short bf16x8 __attribute__((ext_vector_type(8)));
typedef short s16x4 __attribute__((ext_vector_type(4)));
typedef _Float16 half8 __attribute__((ext_vector_type(8)));
typedef _Float16 half4 __attribute__((ext_vector_type(4)));
typedef float f32x4 __attribute__((ext_vector_type(4)));
typedef float f32x2 __attribute__((ext_vector_type(2)));
typedef float f32x16 __attribute__((ext_vector_type(16)));
typedef unsigned u32x4 __attribute__((ext_vector_type(4)));
typedef unsigned u32x2 __attribute__((ext_vector_type(2)));
#define DI __device__ __forceinline__
#define LDS_WAIT() asm volatile("s_waitcnt lgkmcnt(0)" ::: "memory")
#define VM_WAIT() asm volatile("s_waitcnt vmcnt(0)" ::: "memory")
#define LDS_BARRIER() do { asm volatile("s_waitcnt lgkmcnt(0)" ::: "memory"); __builtin_amdgcn_s_barrier(); asm volatile("" ::: "memory"); } while (0)

typedef __bf16 bf16x2_t __attribute__((ext_vector_type(2)));
DI unsigned cvt_pk_bf16(float lo, float hi) { f32x2 v = {lo, hi}; bf16x2_t b = __builtin_convertvector(v, bf16x2_t); return __builtin_bit_cast(unsigned, b); }
typedef int v8i32 __attribute__((ext_vector_type(8)));
typedef int v4i32 __attribute__((ext_vector_type(4)));
DI unsigned pack_fp8x4(float a, float b, float c, float d) {
    a = fminf(fmaxf(a, -448.f), 448.f); b = fminf(fmaxf(b, -448.f), 448.f); c = fminf(fmaxf(c, -448.f), 448.f); d = fminf(fmaxf(d, -448.f), 448.f);
    int w = 0; w = __builtin_amdgcn_cvt_pk_fp8_f32(a, b, w, false); w = __builtin_amdgcn_cvt_pk_fp8_f32(c, d, w, true); return (unsigned)w; }
DI float bf2f(unsigned short b) { return __uint_as_float(((unsigned)b) << 16); }
DI float bflo(unsigned w) { return __uint_as_float(w << 16); }
DI float bfhi(unsigned w) { return __uint_as_float(w & 0xffff0000u); }
DI float fsilu(float x) { return x * __builtin_amdgcn_rcpf(1.f + __expf(-x)); }
DI float fsigmoid(float x) { return __builtin_amdgcn_rcpf(1.f + __expf(-x)); }
DI float wave_sum(float v) {
#pragma unroll
    for (int o = 1; o < 64; o <<= 1) v += __shfl_xor(v, o);
    return v;
}
DI int crow(int r, int hi) { return (r & 3) + 8 * (r >> 2) + 4 * hi; }

constexpr int LDS_WTAB_OFF = 148480 + 128;
DI int my_tid() {
    extern __shared__ __attribute__((aligned(16))) unsigned char lds_raw[];
    const unsigned hw = (unsigned)__builtin_amdgcn_s_getreg((5 << 11) | 4) & 63u;
    const int w = __builtin_amdgcn_readfirstlane(((volatile LAS int*)((LAS unsigned char*)lds_raw + LDS_WTAB_OFF))[hw]);
    int t = w * 64 + (int)__builtin_amdgcn_mbcnt_hi(~0u, __builtin_amdgcn_mbcnt_lo(~0u, 0u));
    asm volatile("" : "+v"(t)); return t;
}
#define XB_TMO      128
#define XB_XCNT(j)  (256  + 64 * (j))
#define XB_XSUB(j)  (1280 + 64 * (j))
#define XB_XGEN(j)  (2304 + 64 * (j))
#define XB_TOP      3328
#define XB_TOPGEN   3392
#define XCD_BAR_WORDS 3456
#define XB_SPIN_CAP (1u << 22)
DI unsigned xb_ld(unsigned* p)              { return __hip_atomic_load(p, __ATOMIC_RELAXED, __HIP_MEMORY_SCOPE_AGENT); }
DI unsigned xb_add(unsigned* p, unsigned v) { return __hip_atomic_fetch_add(p, v, __ATOMIC_RELAXED, __HIP_MEMORY_SCOPE_AGENT); }
DI unsigned xb_xcc_id() { return (unsigned)__builtin_amdgcn_s_getreg((3 << 11) | 20) & 0xFu; }
#define XB_SPIN(cond, bar) do { unsigned _sp = 0; while (cond) { __builtin_amdgcn_s_sleep(1); \
    if ((++_sp & 255u) == 0u) { if (xb_ld(&(bar)[XB_TMO])) break; if (_sp > XB_SPIN_CAP) { atomicAdd(&(bar)[XB_TMO], 1u); break; } } } } while (0)
struct XcdBarrier { unsigned* bar; unsigned x; volatile LAS unsigned* st; };
DI XcdBarrier xcd_barrier_post(unsigned* bar, volatile LAS unsigned* st) {
    XcdBarrier b; b.bar = bar; b.x = xb_xcc_id(); b.st = st;
    if (my_tid() == 0) (void)xb_add(&bar[XB_XCNT(b.x)], 1u);
    return b;
}
DI void xcd_barrier_complete(unsigned* bar, unsigned x, unsigned& nloc, unsigned& nx) {
    const unsigned G = gridDim.x * gridDim.y * gridDim.z;
    unsigned sum, cnt, mine, sp = 0u;
    for (;;) {
        sum = 0u; cnt = 0u; mine = 0u;
#pragma unroll
        for (unsigned j = 0; j < 16; ++j) { const unsigned c = xb_ld(&bar[XB_XCNT(j)]); sum += c; cnt += (c > 0u) ? 1u : 0u; mine = (j == x) ? c : mine; }
        if (sum == G) break;
        __builtin_amdgcn_s_sleep(1);
        if ((++sp & 255u) == 0u) { if (xb_ld(&bar[XB_TMO])) break; if (sp > XB_SPIN_CAP) { atomicAdd(&bar[XB_TMO], 1u); break; } }
    }
    nloc = mine > 0u ? mine : 1u; nx = cnt > 0u ? cnt : 1u;
}
DI void xcd_barrier(const XcdBarrier& b) {
    asm volatile("s_waitcnt vmcnt(0)" ::: "memory");
    __syncthreads();
    if (my_tid() == 0) {
        unsigned* bar = b.bar;
        __builtin_amdgcn_s_waitcnt(0);
        unsigned nloc = b.st[0], nx = b.st[1];
        if (nloc == 0u) { xcd_barrier_complete(bar, b.x, nloc, nx); b.st[0] = nloc; b.st[1] = nx; }
        const unsigned old = xb_add(&bar[XB_XSUB(b.x)], 1u);
        const unsigned gen = old / nloc;
        if (old + 1u == (gen + 1u) * nloc) {
            __builtin_amdgcn_fence(__ATOMIC_RELEASE, "agent");
            asm volatile("s_waitcnt vmcnt(0)" ::: "memory");
            const unsigned og = xb_add(&bar[XB_TOP], 1u);
            const unsigned tg = og / nx;
            if (og + 1u == (tg + 1u) * nx) xb_add(&bar[XB_TOPGEN], 1u);
            else XB_SPIN(xb_ld(&bar[XB_TOPGEN]) == tg, bar);
            __builtin_amdgcn_fence(__ATOMIC_ACQUIRE, "agent");
            xb_add(&bar[XB_XGEN(b.x)], 1u);
            asm volatile("s_waitcnt vmcnt(0)" ::: "memory");
        } else {
            XB_SPIN(xb_ld(&bar[XB_XGEN(b.x)]) == gen, bar);
            __builtin_amdgcn_fence(__ATOMIC_ACQUIRE, "agent");
            asm volatile("s_waitcnt vmcnt(0)" ::: "memory");
        }
    }
    __syncthreads();
}

namespace pg8 {
constexpr int BM = 256, BK = 64, HALF = 128, HTB = HALF * BK * 2, STAGE_BYTES = 8 * HTB, NXCD = 8, WGM = 8;
__host__ __device__ __forceinline__ int lds_byte(int r, int c) { const int st = (r >> 4) * 2 + (c >> 5), rr = r & 15, cc = c & 31, ob = rr * 64 + cc * 2; return st * 1024 + (ob ^ (((ob >> 9) & 1) << 5)); }
__host__ __device__ __forceinline__ void stage_rc(int b, int& R, int& C) { const int st = b / 1024, sb = b % 1024, swz = sb ^ (((sb >> 9) & 1) << 5); R = (st >> 1) * 16 + swz / 64; C = (st & 1) * 32 + (swz % 64) / 2; }
__host__ __device__ __forceinline__ int perm32(int rho) { const int n = rho >> 4, i = rho & 15; return 8 * (i >> 2) + 4 * n + (i & 3); }

struct Unit { int pm, pn; const char* a; const char* b; };
struct Gemm { const bf16_t* A; const bf16_t* Bt; int M, N, K, lda; };

struct StaticOrder {
    int nM, nN, nwg, G, c;
    DI void init(const Gemm& g, int G_, int c_) { nM = g.M / BM; nN = g.N / BM; nwg = nM * nN; G = G_; c = c_; }
    DI bool tile(int i, int& pm, int& pn) const {
        const int L = i * G + c; if (L >= nwg) return false;
        int wgid = L; { const int q = nwg / NXCD, r = nwg % NXCD, xcd = wgid % NXCD, off = wgid / NXCD; wgid = (xcd < r ? xcd * (q + 1) : r * (q + 1) + (xcd - r) * q) + off; }
        const int nig = WGM * nN, gid = wgid / nig, fm = gid * WGM, gsz = (nM - fm) < WGM ? (nM - fm) : WGM;
        pm = fm + ((wgid % nig) % gsz); pn = (wgid % nig) / gsz; return true;
    }
    DI bool next(const Gemm& g, int i, Unit& u) const { if (!tile(i, u.pm, u.pn)) return false;
        u.a = (const char*)g.A + (size_t)u.pm * ((size_t)BM * g.lda * 2); u.b = (const char*)g.Bt + (size_t)u.pn * ((size_t)BM * g.K * 2); return true; }
};
struct MoeOrder {
    StaticOrder so; int p0, apan0; int pb[7]; size_t estride;
    DI void load_pb(const int* pbv) {
#pragma unroll
        for (int k = 0; k < 7; ++k) pb[k] = __builtin_amdgcn_readfirstlane(pbv[k + 1]); }
    DI bool next(const Gemm& g, int i, Unit& u) const {
        int pm, pn; if (!so.tile(i, pm, pn)) return false;
        u.pm = p0 + pm; u.pn = pn; int e = 0;
#pragma unroll
        for (int k = 0; k < 7; ++k) e += (u.pm >= pb[k]) ? 1 : 0;
        u.a = (const char*)g.A + (size_t)(u.pm - apan0) * ((size_t)BM * g.lda * 2); u.b = (const char*)g.Bt + (size_t)e * estride + (size_t)pn * ((size_t)BM * g.K * 2); return true;
    }
};

template <class Epi, class Sched, bool ALIGN_EPI = true, bool F8 = false, bool MIDHOOK = false>
DI void gemm_phase(LAS unsigned char* lds, const Gemm g, const Sched& S, const Epi& E) {
    const int tid_ = my_tid();
    const int tid = tid_, wid = __builtin_amdgcn_readfirstlane(tid >> 6), lane = tid & 63, wr = wid >> 2, wc = wid & 3, fr = lane & 15, fq = lane >> 4;
    const int K = g.K, nt = K / BK;
    unsigned voffA[2], voffB[2];
#pragma unroll
    for (int i = 0; i < 2; ++i) { int R, C; stage_rc(tid * 16 + i * 8192, R, C); const int Rb = Epi::PERM ? ((R & ~31) + perm32(R & 31)) : R;
        voffA[i] = (unsigned)(R * g.lda + C) * 2u; voffB[i] = (unsigned)(Rb * K + C) * 2u; }
    const size_t kstep = (size_t)(BK * 2);
    const size_t hstepA = (size_t)HALF * g.lda * 2, hstepB = (size_t)HALF * K * 2;
    const unsigned ldsw = (unsigned)wid * 1024u;
    const int aoff = lds_byte(wr * 64 + fr, fq * 8), boff = lds_byte(wc * 32 + fr, fq * 8);
#define PG8_SA(b, h) (((b) * 2 + (h)) * HTB)
#define PG8_SB(b, h) ((4 + (b) * 2 + (h)) * HTB)
#define PG8_STAGE(bufoff, gbase, voff) do { _Pragma("unroll") for (int _i = 0; _i < 2; ++_i) \
        __builtin_amdgcn_global_load_lds((const unsigned*)((const char*)(gbase) + (voff)[_i]), (LAS unsigned*)(lds + (bufoff) + ldsw + _i * 8192), 16, 0, 0); } while (0)
#define PG8_LD8(p) __builtin_shufflevector(*(const LAS v4i32*)(p), *(const LAS v4i32*)((p) + 1024), 0, 1, 2, 3, 4, 5, 6, 7)
#define PG8_LDA(dst, b, h) do { if constexpr (F8) { _Pragma("unroll") for (int m = 0; m < 4; ++m) dst##8[m] = PG8_LD8(lds + PG8_SA(b, h) + aoff + m * 2048); } \
        else { _Pragma("unroll") for (int m = 0; m < 4; ++m) _Pragma("unroll") for (int k = 0; k < 2; ++k) dst[m][k] = *(const LAS bf16x8*)(lds + PG8_SA(b, h) + aoff + m * 2048 + k * 1024); } } while (0)
#define PG8_LDB(dst, b, h) do { if constexpr (F8) { _Pragma("unroll") for (int n = 0; n < 2; ++n) dst##8[n] = PG8_LD8(lds + PG8_SB(b, h) + boff + n * 2048); } \
        else { _Pragma("unroll") for (int n = 0; n < 2; ++n) _Pragma("unroll") for (int k = 0; k < 2; ++k) dst[n][k] = *(const LAS bf16x8*)(lds + PG8_SB(b, h) + boff + n * 2048 + k * 1024); } } while (0)
#define PG8_MMA(ai, bj, At, Bt) do { __builtin_amdgcn_s_setprio(1); \
        if constexpr (F8) { _Pragma("unroll") for (int m = 0; m < 4; ++m) _Pragma("unroll") for (int n = 0; n < 2; ++n) \
            asm volatile("v_mfma_scale_f32_16x16x128_f8f6f4 %0, %1, %2, %0, %3, %3 op_sel_hi:[0,0,0]" : "+v"(acc[ai][bj][m][n]) : "v"(Bt##8[n]), "v"(At##8[m]), "v"(one8)); } \
        else { _Pragma("unroll") for (int m = 0; m < 4; ++m) _Pragma("unroll") for (int n = 0; n < 2; ++n) _Pragma("unroll") for (int k = 0; k < 2; ++k) \
            acc[ai][bj][m][n] = __builtin_amdgcn_mfma_f32_16x16x32_bf16(Bt[n][k], At[m][k], acc[ai][bj][m][n], 0, 0, 0); } \
        __builtin_amdgcn_s_setprio(0); } while (0)
#define PG8_WAIT_V(n) asm volatile("s_waitcnt vmcnt(" #n ")" ::: "memory")
#define PG8_WAIT_VX(n) asm volatile("s_waitcnt vmcnt(%0)" :: "n"(n) : "memory")
#define PG8_WAIT_L(n) asm volatile("s_waitcnt lgkmcnt(" #n ")" ::: "memory")
#define PG8_BAR __builtin_amdgcn_s_barrier()
#define PG8_SCHED __builtin_amdgcn_sched_barrier(0)
    Unit cur, nxt; int ui = 0;
    if (!S.next(g, 0, cur)) return;
    f32x4 acc[2][2][4][2];
#pragma unroll
    for (int a = 0; a < 2; ++a)
#pragma unroll
        for (int b = 0; b < 2; ++b)
#pragma unroll
            for (int m = 0; m < 4; ++m)
#pragma unroll
                for (int n = 0; n < 2; ++n) acc[a][b][m][n] = (f32x4){0.f, 0.f, 0.f, 0.f};
    bf16x8 At[4][2], B0[2][2], B1[2][2]; v8i32 At8[4], B08[2], B18[2]; const int one8 = 0x7F7F7F7F;
    const char* cA = cur.a; const char* cB = cur.b;
    PG8_STAGE(PG8_SB(0, 0), cB, voffB); PG8_STAGE(PG8_SB(0, 1), cB + hstepB, voffB); PG8_STAGE(PG8_SA(0, 0), cA, voffA); PG8_STAGE(PG8_SA(0, 1), cA + hstepA, voffA);
    if (wr == 1) PG8_BAR;
    PG8_WAIT_V(2); PG8_BAR;
    PG8_STAGE(PG8_SB(1, 0), cB + kstep, voffB); PG8_STAGE(PG8_SA(1, 0), cA + kstep, voffA); PG8_STAGE(PG8_SB(1, 1), cB + hstepB + kstep, voffB);
    PG8_WAIT_V(6); PG8_BAR;
    for (;;) {
        const bool has_next = S.next(g, ui + 1, nxt);
        const char* nA = has_next ? nxt.a : cA; const char* nB = has_next ? nxt.b : cB;
        for (int t = 0; t < nt; t += 2) {
            const bool last = (t == nt - 2);
            if constexpr (MIDHOOK) { PG8_SCHED; if (t == nt / 2) E.mid(acc, cur, wr, wc, fr, fq); PG8_SCHED; }
            const char* a1 = cA + (size_t)(t + 1) * kstep;
            const char* a2 = last ? nA : cA + (size_t)(t + 2) * kstep; const char* b2 = last ? nB : cB + (size_t)(t + 2) * kstep;
            const char* a3 = a2 + kstep; const char* b3 = b2 + kstep;
            const int relax = __builtin_amdgcn_readfirstlane(((t == 0) && (ui > 0)) ? 1 : 0);
#define PG8_WAIT_V8R asm volatile("s_cmp_lg_u32 %0, 0\n\ts_cbranch_scc1 1f\n\ts_waitcnt vmcnt(8)\n1:\n\ts_waitcnt vmcnt(%1)" :: "s"(relax), "n"(8 + Epi::NVM) : "memory", "scc")
            PG8_LDB(B0, 0, 0); PG8_LDB(B1, 0, 1); PG8_SCHED; PG8_LDA(At, 0, 0); PG8_STAGE(PG8_SA(1, 1), a1 + hstepA, voffA);
            PG8_WAIT_V8R; PG8_WAIT_L(0); PG8_BAR; PG8_MMA(0, 0, At, B0); PG8_MMA(0, 1, At, B1); PG8_BAR; PG8_SCHED;
            PG8_LDA(At, 0, 1); PG8_STAGE(PG8_SB(0, 0), b2, voffB); PG8_STAGE(PG8_SB(0, 1), b2 + hstepB, voffB); PG8_STAGE(PG8_SA(0, 0), a2, voffA);
            PG8_WAIT_V8R; PG8_WAIT_L(0); PG8_BAR; PG8_MMA(1, 0, At, B0); PG8_MMA(1, 1, At, B1); PG8_BAR; PG8_SCHED;
            PG8_LDB(B0, 1, 0); PG8_LDB(B1, 1, 1); PG8_SCHED; PG8_LDA(At, 1, 0); PG8_STAGE(PG8_SA(0, 1), a2 + hstepA, voffA);
            PG8_WAIT_V(8); PG8_WAIT_L(0); PG8_BAR; PG8_MMA(0, 0, At, B0); PG8_MMA(0, 1, At, B1); PG8_BAR; PG8_SCHED;
            PG8_LDA(At, 1, 1); PG8_STAGE(PG8_SB(1, 0), b3, voffB); PG8_STAGE(PG8_SB(1, 1), b3 + hstepB, voffB); PG8_STAGE(PG8_SA(1, 0), a3, voffA);
            PG8_WAIT_V(8); PG8_WAIT_L(0); PG8_BAR; PG8_MMA(1, 0, At, B0); PG8_MMA(1, 1, At, B1); PG8_BAR; PG8_SCHED;
#undef PG8_WAIT_V8R
        }
        if constexpr (ALIGN_EPI) { if (wr == 0) PG8_BAR; }
        if constexpr (F8) asm volatile("s_nop 15\n\ts_nop 15" ::: "memory");
        E(acc, cur, wr, wc, fr, fq);
        if (!has_next) break;
#pragma unroll
        for (int a = 0; a < 2; ++a)
#pragma unroll
            for (int b = 0; b < 2; ++b)
#pragma unroll
                for (int m = 0; m < 4; ++m)
#pragma unroll
                    for (int n = 0; n < 2; ++n) acc[a][b][m][n] = (f32x4){0.f, 0.f, 0.f, 0.f};
        cur = nxt; cA = nA; cB = nB; ++ui;
        if constexpr (ALIGN_EPI) { if (wr == 1) PG8_BAR; }
    }
    PG8_WAIT_V(0);
    if constexpr (!ALIGN_EPI) { if (wr == 0) PG8_BAR; }
    PG8_BAR;
#undef PG8_SA
#undef PG8_SB
#undef PG8_STAGE
#undef PG8_LDA
#undef PG8_LD8
#undef PG8_LDB
#undef PG8_MMA
#undef PG8_WAIT_V
#undef PG8_WAIT_VX
#undef PG8_WAIT_L
#undef PG8_BAR
#undef PG8_SCHED
}
}
using pg8::Unit; using pg8::Gemm;
typedef const f32x4 (&AccRef)[2][2][4][2];

DI u32x4 pack8(const f32x4& v0, const f32x4& v1) { u32x4 w; w.x = cvt_pk_bf16(v0[0], v0[1]); w.y = cvt_pk_bf16(v0[2], v0[3]); w.z = cvt_pk_bf16(v1[0], v1[1]); w.w = cvt_pk_bf16(v1[2], v1[3]); return w; }
DI void unpack8(const u32x4& w, float (&f)[8]) { f[0] = bflo(w.x); f[1] = bfhi(w.x); f[2] = bflo(w.y); f[3] = bfhi(w.y); f[4] = bflo(w.z); f[5] = bfhi(w.z); f[6] = bflo(w.w); f[7] = bfhi(w.w); }

struct EpiInProj {
    static constexpr int NVM = 16; static constexpr bool PERM = true;
    bf16_t* P; const float2* rope; const float* lbf; const float* lbb; int secmap; float asc;
    template <int MODE> DI void run(AccRef acc, const Unit& u, int wr, int wc, int fr, int fq, int sec) const {
        const int row0 = u.pm * 256 + wr * 64 + fr, col0 = sec * 512 + (u.pn & 1) * 256 + wc * 32 + 8 * fq;
        const bool lat = u.pm < (NLAT / 256); const float qs = sec == 0 ? QSCALE : 1.f;
        f32x4 lb0[2], lb1[2];
        if (MODE == 2) {
#pragma unroll
            for (int bj = 0; bj < 2; ++bj) { const float* lb = (sec == 1 ? lbf : lbb) + ((col0 + bj * 128) & 511); lb0[bj] = *(const f32x4*)lb; lb1[bj] = *(const f32x4*)(lb + 4); } }
        f32x4 rr[2][4][2];
        if (MODE == 3) {
#pragma unroll
            for (int ai = 0; ai < 2; ++ai)
#pragma unroll
                for (int m = 0; m < 4; ++m) { const f32x4* rp = (const f32x4*)(rope + (size_t)((row0 + ai * 128 + m * 16) & (T - 1)) * 32 + ((col0 & 63) >> 1));
                    rr[ai][m][0] = lat ? rp[0] : (f32x4){1.f, 0.f, 1.f, 0.f}; rr[ai][m][1] = lat ? rp[1] : (f32x4){1.f, 0.f, 1.f, 0.f}; } }
#pragma unroll
        for (int ai = 0; ai < 2; ++ai)
#pragma unroll
            for (int m = 0; m < 4; ++m) {
                const int row = row0 + ai * 128 + m * 16; bf16_t* rowp = P + (size_t)row * PW + col0;
#pragma unroll
                for (int bj = 0; bj < 2; ++bj) {
                    f32x4 v0 = acc[ai][bj][m][0] * asc, v1 = acc[ai][bj][m][1] * asc; u32x4 w;
                    if (MODE == 3) {
                        {
                            const f32x4 r0 = rr[ai][m][0], r1 = rr[ai][m][1];
                            f32x4 o0, o1;
                            o0[0] = v0[0] * r0[0] - v0[1] * r0[1]; o0[1] = v0[0] * r0[1] + v0[1] * r0[0];
                            o0[2] = v0[2] * r0[2] - v0[3] * r0[3]; o0[3] = v0[2] * r0[3] + v0[3] * r0[2];
                            o1[0] = v1[0] * r1[0] - v1[1] * r1[1]; o1[1] = v1[0] * r1[1] + v1[1] * r1[0];
                            o1[2] = v1[2] * r1[2] - v1[3] * r1[3]; o1[3] = v1[2] * r1[3] + v1[3] * r1[2];
                            v0 = o0; v1 = o1;
                        }
                        w = pack8(v0 * qs, v1 * qs);
                    } else if (MODE == 1) {
#pragma unroll
                        for (int j = 0; j < 4; ++j) { v0[j] = fsilu(v0[j]); v1[j] = fsilu(v1[j]); }
                        w = pack8(v0, v1);
                    } else if (MODE == 2) {
                        half8 hv;
#pragma unroll
                        for (int j = 0; j < 8; ++j) {
                            const float z = fmaxf(j < 4 ? v0[j] : v1[j - 4], -80.f), b = j < 4 ? lb0[bj][j] : lb1[bj][j - 4];
                            const float sg = __builtin_amdgcn_rcpf(1.f + __builtin_amdgcn_exp2f(-LOG2E * z));
                            hv[j] = (_Float16)(0.6931471805599453f * __builtin_amdgcn_logf(b + (1.f - b) * sg));
                        }
                        w = __builtin_bit_cast(u32x4, hv);
                    } else w = pack8(v0, v1);
                    *(u32x4*)(rowp + bj * 128) = w;
                }
            }
    }
    DI void operator()(AccRef acc, const Unit& u, int wr, int wc, int fr, int fq) const {
        const int sec = (secmap >> (4 * (u.pn >> 1))) & 15;
        if (sec == 0 || sec == 4) run<3>(acc, u, wr, wc, fr, fq, sec);
        else if (sec == 2 || sec == 6) run<1>(acc, u, wr, wc, fr, fq, sec);
        else if (sec == 1 || sec == 3) run<2>(acc, u, wr, wc, fr, fq, sec);
        else run<0>(acc, u, wr, wc, fr, fq, sec);
    }
};
struct EpiGates {
    static constexpr int NVM = 16; static constexpr bool PERM = true; bf16_t* P; float asc;
    DI void operator()(AccRef acc, const Unit& u, int wr, int wc, int fr, int fq) const {
        const int row0 = u.pm * 256 + wr * 64 + fr, col0 = PC_GA + u.pn * 256 + wc * 32 + 8 * fq;
#pragma unroll
        for (int ai = 0; ai < 2; ++ai)
#pragma unroll
            for (int m = 0; m < 4; ++m) { bf16_t* rowp = P + (size_t)(row0 + ai * 128 + m * 16) * PW + col0;
#pragma unroll
                for (int bj = 0; bj < 2; ++bj) { f32x4 v0 = acc[ai][bj][m][0] * asc, v1 = acc[ai][bj][m][1] * asc;
#pragma unroll
                    for (int j = 0; j < 4; ++j) { v0[j] = fsigmoid(v0[j]); v1[j] = fsigmoid(v1[j]); }
                    *(u32x4*)(rowp + bj * 128) = pack8(v0, v1); } }
    }
};
struct EpiMergeFused {
    static constexpr int NVM = 16; static constexpr bool PERM = true; const bf16_t* P; bf16_t* O;
    DI void mid(f32x4 (&acc)[2][2][4][2], const Unit& u, int wr, int wc, int fr, int fq) const {
        int row0 = u.pm * 256 + wr * 64 + fr, col0 = u.pn * 256 + wc * 32 + 8 * fq;
        asm volatile("" : "+v"(row0), "+v"(col0));
#pragma unroll
        for (int ai = 0; ai < 2; ++ai)
#pragma unroll
            for (int m = 0; m < 4; ++m) { const size_t row = (size_t)(row0 + ai * 128 + m * 16);
#pragma unroll
                for (int bj = 0; bj < 2; ++bj) {
                    float ga[8], gr[8]; unpack8(*(const u32x4*)(P + row * PW + PC_GA + col0 + bj * 128), ga); unpack8(*(const u32x4*)(P + row * PW + PC_GR + col0 + bj * 128), gr);
#pragma unroll
                    for (int j = 0; j < 4; ++j) { acc[ai][bj][m][0][j] *= ga[j] * __builtin_amdgcn_rcpf(fmaxf(gr[j], 1e-30f)); acc[ai][bj][m][1][j] *= ga[4 + j] * __builtin_amdgcn_rcpf(fmaxf(gr[4 + j], 1e-30f)); } }
                asm volatile("" ::: "memory"); }
    }
    DI void operator()(AccRef acc, const Unit& u, int wr, int wc, int fr, int fq) const {
        const int row0 = u.pm * 256 + wr * 64 + fr, col0 = u.pn * 256 + wc * 32 + 8 * fq;
        u32x4 gq[2][4][2];
#pragma unroll
        for (int ai = 0; ai < 2; ++ai)
#pragma unroll
            for (int m = 0; m < 4; ++m)
#pragma unroll
                for (int bj = 0; bj < 2; ++bj) gq[ai][m][bj] = *(const u32x4*)(P + (size_t)(row0 + ai * 128 + m * 16) * PW + PC_GR + col0 + bj * 128);
#pragma unroll
        for (int ai = 0; ai < 2; ++ai)
#pragma unroll
            for (int m = 0; m < 4; ++m) { const size_t row = (size_t)(row0 + ai * 128 + m * 16);
#pragma unroll
                for (int bj = 0; bj < 2; ++bj) {
                    float gr[8]; unpack8(gq[ai][m][bj], gr);
                    f32x4 v0 = acc[ai][bj][m][0], v1 = acc[ai][bj][m][1];
#pragma unroll
                    for (int j = 0; j < 4; ++j) { v0[j] *= fmaxf(gr[j], 1e-30f); v1[j] *= fmaxf(gr[4 + j], 1e-30f); }
                    *(u32x4*)(O + row * D + col0 + bj * 128) = pack8(v0, v1); } }
    }
};
struct EpiResid {
    static constexpr int NVM = 16; static constexpr bool PERM = false;
    const float* xin_l; const float* xin_c; float* xout_l; float* xout_c; const float* mods; int msel;
    DI void operator()(AccRef acc, const Unit& u, int wr, int wc, int fr, int fq) const {
        const bool lat = u.pm < (NLAT / 256);
        const int rbase = (lat ? u.pm : u.pm - NLAT / 256) * 256 + wr * 64 + fr, col0 = u.pn * 256 + wc * 32 + 4 * fq;
        const float* xi = lat ? xin_l : xin_c; float* xo = lat ? xout_l : xout_c;
        const float* mv = mods + (size_t)(lat ? (u.pm >> 3) : 32) * DIN + msel * D + col0;
        f32x4 g[2][2];
#pragma unroll
        for (int bj = 0; bj < 2; ++bj)
#pragma unroll
            for (int n = 0; n < 2; ++n) g[bj][n] = *(const f32x4*)(mv + bj * 128 + n * 16);
        f32x4 xa[4][2][2], r0[4][2][2];
#define RES_OFF(ai, m) ((size_t)(rbase + (ai) * 128 + (m) * 16) * D + col0)
#pragma unroll
        for (int m = 0; m < 4; ++m)
#pragma unroll
            for (int bj = 0; bj < 2; ++bj)
#pragma unroll
                for (int n = 0; n < 2; ++n) xa[m][bj][n] = *(const f32x4*)(xi + RES_OFF(0, m) + bj * 128 + n * 16);
#pragma unroll
        for (int m = 0; m < 4; ++m)
#pragma unroll
            for (int bj = 0; bj < 2; ++bj)
#pragma unroll
                for (int n = 0; n < 2; ++n) r0[m][bj][n] = xa[m][bj][n] + g[bj][n] * acc[0][bj][m][n];
#pragma unroll
        for (int m = 0; m < 4; ++m)
#pragma unroll
            for (int bj = 0; bj < 2; ++bj)
#pragma unroll
                for (int n = 0; n < 2; ++n) xa[m][bj][n] = *(const f32x4*)(xi + RES_OFF(1, m) + bj * 128 + n * 16);
        asm volatile("" ::: "memory");
#pragma unroll
        for (int m = 0; m < 4; ++m)
#pragma unroll
            for (int bj = 0; bj < 2; ++bj)
#pragma unroll
                for (int n = 0; n < 2; ++n) *(f32x4*)(xo + RES_OFF(0, m) + bj * 128 + n * 16) = r0[m][bj][n];
#pragma unroll
        for (int m = 0; m < 4; ++m)
#pragma unroll
            for (int bj = 0; bj < 2; ++bj)
#pragma unroll
                for (int n = 0; n < 2; ++n) *(f32x4*)(xo + RES_OFF(1, m) + bj * 128 + n * 16) = xa[m][bj][n] + g[bj][n] * acc[1][bj][m][n];
#undef RES_OFF
    }
};
struct EpiSwiglu {
    static constexpr int NVM = 16; static constexpr bool PERM = true; bf16_t* Hd; int ldh; int pan0;
    DI void operator()(AccRef acc, const Unit& u, int wr, int wc, int fr, int fq) const {
        const int row0 = (u.pm - pan0) * 256 + wr * 64 + fr, hc0 = u.pn * 128 + wc * 16 + 4 * fq;
#pragma unroll
        for (int ai = 0; ai < 2; ++ai)
#pragma unroll
            for (int m = 0; m < 4; ++m) { bf16_t* rowp = Hd + (size_t)(row0 + ai * 128 + m * 16) * ldh + hc0;
#pragma unroll
                for (int bj = 0; bj < 2; ++bj) { const f32x4 a = acc[ai][bj][m][0], b = acc[ai][bj][m][1];
                    u32x2 w; w.x = cvt_pk_bf16(fsilu(a[0]) * b[0], fsilu(a[1]) * b[1]); w.y = cvt_pk_bf16(fsilu(a[2]) * b[2], fsilu(a[3]) * b[3]);
                    *(u32x2*)(rowp + bj * 64) = w; } }
    }
};
struct EpiSwiglu8 {
    static constexpr int NVM = 16; static constexpr bool PERM = true; unsigned char* Hd; int ldh; int pan0; float as, hs;
    DI void operator()(AccRef acc, const Unit& u, int wr, int wc, int fr, int fq) const {
        const int row0 = (u.pm - pan0) * 256 + wr * 64 + fr, hc0 = u.pn * 128 + wc * 16 + 4 * fq;
#pragma unroll
        for (int ai = 0; ai < 2; ++ai)
#pragma unroll
            for (int m = 0; m < 4; ++m) { unsigned char* rowp = Hd + (size_t)(row0 + ai * 128 + m * 16) * ldh + hc0;
#pragma unroll
                for (int bj = 0; bj < 2; ++bj) { const f32x4 a = acc[ai][bj][m][0] * as, b = acc[ai][bj][m][1] * (as * hs);
                    *(unsigned*)(rowp + bj * 64) = pack_fp8x4(fsilu(a[0]) * b[0], fsilu(a[1]) * b[1], fsilu(a[2]) * b[2], fsilu(a[3]) * b[3]); } }
    }
};
struct EpiBf16 {
    static constexpr int NVM = 16; static constexpr bool PERM = true; bf16_t* O; int ldc; float sc;
    DI void operator()(AccRef acc, const Unit& u, int wr, int wc, int fr, int fq) const {
        const int row0 = u.pm * 256 + wr * 64 + fr, col0 = u.pn * 256 + wc * 32 + 8 * fq;
#pragma unroll
        for (int ai = 0; ai < 2; ++ai)
#pragma unroll
            for (int m = 0; m < 4; ++m) { bf16_t* rowp = O + (size_t)(row0 + ai * 128 + m * 16) * ldc + col0;
#pragma unroll
                for (int bj = 0; bj < 2; ++bj) *(u32x4*)(rowp + bj * 128) = pack8(acc[ai][bj][m][0] * sc, acc[ai][bj][m][1] * sc); }
    }
};

typedef short v4i16 __attribute__((ext_vector_type(4)));
DI s16x4 tr16(const LAS unsigned char* p) { return __builtin_bit_cast(s16x4, __builtin_amdgcn_ds_read_tr16_b64_v4i16((LAS v4i16*)p)); }
DI bf16x8 cat8(s16x4 lo, s16x4 hi) { return __builtin_shufflevector(lo, hi, 0, 1, 2, 3, 4, 5, 6, 7); }
DI void dma16(const void* g, LAS unsigned char* l) { __builtin_amdgcn_global_load_lds((const unsigned*)g, (LAS unsigned*)l, 16, 0, 0); }
DI void dma16a(const void* g, LAS unsigned char* l) {
    const unsigned la = __builtin_amdgcn_readfirstlane((unsigned)(size_t)l);
    asm volatile("s_mov_b32 m0, %1\n\ts_nop 0\n\tglobal_load_lds_dwordx4 %0, off" :: "v"(g), "s"(la) : "memory", "m0");
}
DI bf16x8 packf8(const f32x16& x, int s) {
    u32x4 w; w.x = cvt_pk_bf16(x[8 * s], x[8 * s + 1]); w.y = cvt_pk_bf16(x[8 * s + 2], x[8 * s + 3]); w.z = cvt_pk_bf16(x[8 * s + 4], x[8 * s + 5]); w.w = cvt_pk_bf16(x[8 * s + 6], x[8 * s + 7]);
    return __builtin_bit_cast(bf16x8, w);
}
#define MFMA32(a, b, c) __builtin_amdgcn_mfma_f32_32x32x16_bf16((a), (b), (c), 0, 0, 0)

struct Params { const float* in[28]; float* out; unsigned char* ws; int ph_lo, ph_hi, li, pad; };
typedef const __attribute__((address_space(4))) Params* KP;
DI KP kparams() { KP kp = (KP)__builtin_amdgcn_kernarg_segment_ptr(); asm volatile("" : "+s"(kp)); return kp; }
#define PIN(k) (kparams()->in[k])
#define POUT (kparams()->out)
struct Ctx {
    LAS unsigned char* lds; unsigned char* ws; int tid, lane, wave, vcu, G, gw, NGW, bx;
};

constexpr float WIN8_SCALE = 64.f;
#ifndef FP8_SECS0
#define FP8_SECS0 0x00
#endif
#ifndef FP8_SECS1
#define FP8_SECS1 0xE4
#endif
constexpr int sec_order(int i) { return (int)((0x76524310u >> (4 * i)) & 15u); }
constexpr int sec_slot(int fs, int ps) { int nb = 0, nf = 0; for (int i = 0; i < 8; ++i) { const int s_ = sec_order(i); const bool f = (fs >> s_) & 1; if (s_ == ps) return f ? (0x100 | nf) : nb; if (f) ++nf; else ++nb; } return 0; }
constexpr int n_sec_f8(int fs) { return __builtin_popcount((unsigned)fs); }
constexpr unsigned secmap_of(int fs, bool f8) { unsigned m = 0; int k = 0; for (int i = 0; i < 8; ++i) { const int s_ = sec_order(i); if ((((fs >> s_) & 1) != 0) == f8) { m |= (unsigned)s_ << (4 * k); ++k; } } return m; }
DI int map_row(int kind, int n, int fs) {
    if (kind == 0) return n;
    if (kind == 2) return 8 * (n >> 2) + (n & 3);
    if (kind == 3) return 8 * (n >> 2) + (n & 3) + 4;
    const int sec = n >> 9, j = n & 511; int r;
    if (n >= 4096) r = (1 << 16) | (n_sec_f8(fs) * 512 + (n - 4096));
    else {
        const int ps = sec == 0 ? 0 : sec == 1 ? 4 : sec == 2 ? 5 : sec == 3 ? 6 : sec == 4 ? 7 : sec == 5 ? 1 : sec == 6 ? 3 : 2;
        const int sl = sec_slot(fs, ps); int jj = j;
        if (sec == 0 || sec == 1) { const int hs = j >> 6, d = j & 63; jj = hs * 64 + (d < 32 ? 2 * d : 2 * (d - 32) + 1); }
        r = ((sl & 0x100) ? (1 << 16) : 0) | ((sl & 0xff) * 512 + jj); }
    return kind == 4 ? (r & 0xffff) : r;
}
constexpr int TP_PITCH = 68, TP_SCR = 64 * TP_PITCH * 4;
DI void transpose_load(const float* W, int ldw, int k0, int n0, LAS float* scr, int lane) {
    const int r = lane >> 4, c4 = (lane & 15) * 4; f32x4 v[16];
#pragma unroll
    for (int i = 0; i < 16; ++i) v[i] = *(const f32x4*)(W + (size_t)(k0 + 4 * i + r) * ldw + n0 + c4);
#pragma unroll
    for (int i = 0; i < 16; ++i) *(LAS f32x4*)(scr + (4 * i + r) * TP_PITCH + c4) = v[i];
    LDS_WAIT(); asm volatile("" ::: "memory");
}
DI void transpose_item(const float* W, int ldw, int k0, int n0, bf16_t* WT, int ldt, int kind, LAS float* scr, int lane, int fs = 0) {
    transpose_load(W, ldw, k0, n0, scr, lane);
    bf16_t* dst = WT + (size_t)map_row(kind, n0 + lane, fs) * ldt + k0;
#pragma unroll
    for (int j = 0; j < 8; ++j) { const LAS float* s = scr + (8 * j) * TP_PITCH + lane;
        u32x4 o; o.x = cvt_pk_bf16(s[0], s[TP_PITCH]); o.y = cvt_pk_bf16(s[2 * TP_PITCH], s[3 * TP_PITCH]); o.z = cvt_pk_bf16(s[4 * TP_PITCH], s[5 * TP_PITCH]); o.w = cvt_pk_bf16(s[6 * TP_PITCH], s[7 * TP_PITCH]);
        *(u32x4*)(dst + 8 * j) = o; }
    LDS_WAIT(); asm volatile("" ::: "memory");
}
DI void transpose_item8(const float* W, int ldw, int k0, int n0, unsigned char* WT, int ldt, int kind, float sc, LAS float* scr, int lane, int fs = 0) {
    transpose_load(W, ldw, k0, n0, scr, lane);
    unsigned char* dst = WT + (size_t)map_row(kind, n0 + lane, fs) * ldt + k0;
#pragma unroll
    for (int j = 0; j < 4; ++j) { const LAS float* s = scr + (16 * j) * TP_PITCH + lane; u32x4 o;
        o.x = pack_fp8x4(s[0] * sc, s[TP_PITCH] * sc, s[2 * TP_PITCH] * sc, s[3 * TP_PITCH] * sc); o.y = pack_fp8x4(s[4 * TP_PITCH] * sc, s[5 * TP_PITCH] * sc, s[6 * TP_PITCH] * sc, s[7 * TP_PITCH] * sc);
        o.z = pack_fp8x4(s[8 * TP_PITCH] * sc, s[9 * TP_PITCH] * sc, s[10 * TP_PITCH] * sc, s[11 * TP_PITCH] * sc); o.w = pack_fp8x4(s[12 * TP_PITCH] * sc, s[13 * TP_PITCH] * sc, s[14 * TP_PITCH] * sc, s[15 * TP_PITCH] * sc);
        *(u32x4*)(dst + 16 * j) = o; }
    LDS_WAIT(); asm volatile("" ::: "memory");
}
DI void transpose_matrix8(const Ctx& C, const float* W, int K, int N, unsigned char* WT, int ldt, int kind, float sc, int& itbase) {
    LAS float* scr = (LAS float*)(C.lds + C.wave * TP_SCR);
    const int nblk = N / 64, nit = (K / 64) * nblk;
    int first = (C.gw - (itbase % C.NGW) + C.NGW) % C.NGW;
    for (int it = first; it < nit; it += C.NGW) transpose_item8(W, N, 64 * (it / nblk), 64 * (it % nblk), WT, ldt, kind, sc, scr, C.lane);
    itbase += nit;
}
DI void transpose_matrix(const Ctx& C, const float* W, int K, int N, bf16_t* WT, int ldt, int kind, int& itbase, int total_unused) {
    (void)total_unused;
    LAS float* scr = (LAS float*)(C.lds + C.wave * TP_SCR);
    const int nblk = N / 64, nit = (K / 64) * nblk;
    int first = (C.gw - (itbase % C.NGW) + C.NGW) % C.NGW;
    for (int it = first; it < nit; it += C.NGW) transpose_item(W, N, 64 * (it / nblk), 64 * (it % nblk), WT, ldt, kind, scr, C.lane);
    itbase += nit;
}
DI void transpose_win(const Ctx& C, const float* W, bf16_t* WA, unsigned char* W8, int& itbase, int fs) {
    LAS float* scr = (LAS float*)(C.lds + C.wave * TP_SCR);
    const int nblk = DIN / 64, nit = (D / 64) * nblk;
    int first = (C.gw - (itbase % C.NGW) + C.NGW) % C.NGW;
    for (int it = first; it < nit; it += C.NGW) { const int k0 = 64 * (it / nblk), n0 = 64 * (it % nblk);
        if (map_row(1, n0, fs) >> 16) transpose_item8(W, DIN, k0, n0, W8, D, 4, WIN8_SCALE, scr, C.lane, fs);
        else transpose_item(W, DIN, k0, n0, WA, D, 1, scr, C.lane, fs); }
    itbase += nit;
}
constexpr int MD_SP = 36;
DI void phase_mods(const Ctx& C) {
    if (C.bx >= 2 * 96) return;
    const int l = C.bx / 96, n0 = (C.bx % 96) * 64, kq = C.lane >> 4, cq = C.lane & 15;
    LAS float* S = (LAS float*)C.lds;
    const float* W = PIN(4) + (size_t)l * D * DIN + n0 + 4 * cq; const float* c0 = PIN(1); const float* cc = PIN(3);
    f32x4 acc[33];
#pragma unroll
    for (int r = 0; r < 33; ++r) acc[r] = (f32x4){0.f, 0.f, 0.f, 0.f};
#pragma unroll 1
    for (int kh = 0; kh < 2; ++kh) {
        __syncthreads();
        for (int i = C.tid; i < 33 * 512; i += 512) { const int r = i >> 9, kk = i & 511; S[kk * MD_SP + r] = fsilu(r < 32 ? c0[r * D + kh * 512 + kk] : cc[kh * 512 + kk]); }
        __syncthreads();
        const int kb = C.wave * 64 + kq;
#pragma unroll 1
        for (int ib = 0; ib < 16; ib += 8) { f32x4 w[8];
#pragma unroll
            for (int i = 0; i < 8; ++i) w[i] = *(const f32x4*)(W + (size_t)(kh * 512 + kb + 4 * (ib + i)) * DIN);
#pragma unroll
            for (int i = 0; i < 8; ++i) { const LAS float* sp = S + (kb + 4 * (ib + i)) * MD_SP;
#pragma unroll
                for (int q = 0; q < 8; ++q) { const f32x4 s4 = *(const LAS f32x4*)(sp + 4 * q);
                    acc[4 * q] += w[i] * s4[0]; acc[4 * q + 1] += w[i] * s4[1]; acc[4 * q + 2] += w[i] * s4[2]; acc[4 * q + 3] += w[i] * s4[3]; }
                acc[32] += w[i] * sp[32]; } }
    }
#pragma unroll
    for (int r = 0; r < 33; ++r)
#pragma unroll
        for (int j = 0; j < 4; ++j) { float v = acc[r][j]; v += __shfl_xor(v, 16); v += __shfl_xor(v, 32); asm volatile("" : "+v"(v)); acc[r][j] = v; }
    __syncthreads();
    LAS float* red = (LAS float*)C.lds;
    if (kq == 0) {
#pragma unroll
        for (int r = 0; r < 33; ++r) *(LAS f32x4*)(red + (C.wave * 33 + r) * 64 + 4 * cq) = acc[r]; }
    __syncthreads();
    float* mods = (float*)(C.ws + WS_MODS);
    for (int o = C.tid; o < 33 * 64; o += 512) { const int r = o >> 6, c = o & 63; float v = PIN(5)[l * DIN + n0 + c];
#pragma unroll
        for (int w8 = 0; w8 < 8; ++w8) v += red[(w8 * 33 + r) * 64 + c];
        mods[(size_t)(l * 33 + r) * DIN + n0 + c] = v; }
    __syncthreads();
}
DI void phase_prologue(const Ctx& C) {
    unsigned char* ws = C.ws;
    int itb = 0;
    for (int l = 0; l < 2; ++l) {
        transpose_win(C, PIN(8) + (size_t)l * D * DIN, (bf16_t*)(ws + WS_WIN) + (size_t)l * 4096 * D, ws + WS_WIN8 + (size_t)l * 4096 * D, itb, l == 0 ? FP8_SECS0 : FP8_SECS1);
        transpose_matrix(C, PIN(17) + (size_t)l * 512 * D, 512, D, (bf16_t*)(ws + WS_WUA) + (size_t)l * D * D, D, 0, itb, 0);
        transpose_matrix(C, PIN(18) + (size_t)l * 512 * D, 512, D, (bf16_t*)(ws + WS_WUA) + (size_t)l * D * D + 512, D, 0, itb, 0);
        transpose_matrix(C, PIN(19) + (size_t)l * D * D, D, D, (bf16_t*)(ws + WS_WO) + (size_t)l * D * D, D, 0, itb, 0);
    }
    transpose_matrix(C, PIN(20), D, DFF, (bf16_t*)(ws + WS_W13), D, 2, itb, 0);
    transpose_matrix(C, PIN(21), D, DFF, (bf16_t*)(ws + WS_W13), D, 3, itb, 0);
    transpose_matrix(C, PIN(22), DFF, D, (bf16_t*)(ws + WS_W2), DFFP, 0, itb, 0);
    { const int gt = C.vcu * 512 + C.tid, NT = C.G * 512;
      bf16_t* w13 = (bf16_t*)(ws + WS_W13) + (size_t)(2 * DFF) * D;
      for (int i = gt; i < (2 * DFFP - 2 * DFF) * D / 8; i += NT) ((u32x4*)w13)[i] = (u32x4){0u, 0u, 0u, 0u};
      bf16_t* w2 = (bf16_t*)(ws + WS_W2);
      for (int i = gt; i < D * (DFFP - DFF) / 8; i += NT) { const int r = i / ((DFFP - DFF) / 8), cc = i % ((DFFP - DFF) / 8); *(u32x4*)(w2 + (size_t)r * DFFP + DFF + cc * 8) = (u32x4){0u, 0u, 0u, 0u}; }
      float2* rope = (float2*)(ws + WS_ROPE);
      for (int i = gt; i < T * 32; i += NT) { const int t = i >> 5, pi = i & 31; const float invf = exp2f(-(float)(pi & 15) * (13.287712379549449f / 16.f));
          const float ang = (float)(pi < 16 ? (t >> 6) : (t & 63)) * invf; rope[i] = make_float2(cosf(ang), sinf(ang)); }
      float* lbs = (float*)(ws + WS_LBS);
      for (int i = gt; i < 2 * 2 * 512; i += NT) { const int l = i >> 10, dir = (i >> 9) & 1, d = i & 511; const float* lb = PIN(dir ? 16 : 15);
          const float p0 = lb[d], p1 = lb[512 + d]; lbs[i] = l == 0 ? 0.f : 1.f / (1.f + expf(p0 - p1)); }
    }
    phase_mods(C);
}
constexpr float W13_SCALE = 64.f, W2_SCALE = 128.f, HID_SCALE = 8.f;
DI void convert_moe_weights(const Ctx& C) {
    unsigned char* ws = C.ws; LAS float* scr = (LAS float*)(C.lds + C.wave * TP_SCR);
    const int lane = C.lane, r = lane >> 4, c4 = (lane & 15) * 4;
    constexpr int NIT = NE * 3 * 896;
    static_assert((D / 64) * (DFE / 64) == 896, "items per expert matrix");
    f32x4 v[16];
#define MOE_ITEM(it, W, ldw, k0, n0) const int m_ = (it) / 896, q_ = (it) % 896, e_ = m_ / 3, wh_ = m_ % 3; \
        const float* W = PIN(wh_ == 0 ? 24 : wh_ == 1 ? 25 : 26) + (size_t)e_ * D * DFE; const int ldw = wh_ == 2 ? D : DFE, nb_ = wh_ == 2 ? D / 64 : DFE / 64, k0 = 64 * (q_ / nb_), n0 = 64 * (q_ % nb_)
#define MOE_LOADS(it) do { MOE_ITEM(it, W_, ldw_, k0_, n0_); _Pragma("unroll") for (int i = 0; i < 16; ++i) v[i] = *(const f32x4*)(W_ + (size_t)(k0_ + 4 * i + r) * ldw_ + n0_ + c4); } while (0)
    int it = C.gw;
    if (it < NIT) MOE_LOADS(it);
    for (; it < NIT; it += C.NGW) {
#pragma unroll
        for (int i = 0; i < 16; ++i) *(LAS f32x4*)(scr + (4 * i + r) * TP_PITCH + c4) = v[i];
        LDS_WAIT(); asm volatile("" ::: "memory");
        if (it + C.NGW < NIT) MOE_LOADS(it + C.NGW);
        MOE_ITEM(it, W, ldw, k0, n0); (void)W; (void)ldw;
        const int kind = wh_ == 0 ? 2 : wh_ == 1 ? 3 : 0; const float sc = wh_ == 2 ? W2_SCALE : W13_SCALE;
        unsigned char* dst = (wh_ == 2 ? ws + WS_WM2 + (size_t)e_ * D * DFE : ws + WS_WM13 + (size_t)e_ * 2 * DFE * D) + (size_t)map_row(kind, n0 + lane, 0) * (wh_ == 2 ? DFE : D) + k0;
#pragma unroll
        for (int j = 0; j < 4; ++j) { const LAS float* sp = scr + (16 * j) * TP_PITCH + lane; u32x4 o;
            o.x = pack_fp8x4(sp[0] * sc, sp[TP_PITCH] * sc, sp[2 * TP_PITCH] * sc, sp[3 * TP_PITCH] * sc); o.y = pack_fp8x4(sp[4 * TP_PITCH] * sc, sp[5 * TP_PITCH] * sc, sp[6 * TP_PITCH] * sc, sp[7 * TP_PITCH] * sc);
            o.z = pack_fp8x4(sp[8 * TP_PITCH] * sc, sp[9 * TP_PITCH] * sc, sp[10 * TP_PITCH] * sc, sp[11 * TP_PITCH] * sc); o.w = pack_fp8x4(sp[12 * TP_PITCH] * sc, sp[13 * TP_PITCH] * sc, sp[14 * TP_PITCH] * sc, sp[15 * TP_PITCH] * sc);
            *(u32x4*)(dst + 16 * j) = o; }
        LDS_WAIT(); asm volatile("" ::: "memory");
    }
#undef MOE_ITEM
#undef MOE_LOADS
}

template <bool ROUTER>
DI void phase_norm(const Ctx& C, const float* xl, const float* xc, const float* nw, const float* mods, int shsel, int nrows, bf16_t* Hout, const float* rw, unsigned char* route, LAS int* cntL, unsigned char* H8 = nullptr) {
    int nloc = 0;
    f32x4 rwr[4][4][2];
    if (ROUTER) {
#pragma unroll
        for (int j = 0; j < 4; ++j)
#pragma unroll
            for (int q = 0; q < 4; ++q) { const float* rp = rw + (size_t)(256 * j + 4 * C.lane + q) * 8; rwr[j][q][0] = *(const f32x4*)rp; rwr[j][q][1] = *(const f32x4*)(rp + 4); } }
    for (int row0 = C.gw; row0 < nrows; row0 += 2 * C.NGW) {
        const int rows[2] = {row0, row0 + C.NGW}; const bool two = rows[1] < nrows;
        f32x4 v[2][4]; float ss[2] = {0.f, 0.f};
#pragma unroll
        for (int u = 0; u < 2; ++u) { const int row = (u == 1 && !two) ? rows[0] : rows[u]; const float* xr = row < NLAT ? xl + (size_t)row * D : xc + (size_t)(row - NLAT) * D;
#pragma unroll
            for (int j = 0; j < 4; ++j) { v[u][j] = *(const f32x4*)(xr + 256 * j + 4 * C.lane); ss[u] += (v[u][j][0] * v[u][j][0] + v[u][j][1] * v[u][j][1]) + (v[u][j][2] * v[u][j][2] + v[u][j][3] * v[u][j][3]); } }
#pragma unroll
        for (int u = 0; u < 2; ++u) { if (u == 1 && !two) break;
            const int row = rows[u]; const bool lat = row < NLAT;
            const float* mv = mods + (size_t)(lat ? (row >> 11) : 32) * DIN + shsel * D;
            const float rstd = 1.0f / sqrtf(wave_sum(ss[u]) * (1.f / D) + EPS);
            float lg[8];
            if (ROUTER) {
#pragma unroll
                for (int e = 0; e < 8; ++e) lg[e] = 0.f; }
#pragma unroll
            for (int j = 0; j < 4; ++j) { const int c0 = 256 * j + 4 * C.lane;
                const f32x4 w = *(const f32x4*)(nw + c0), sh = *(const f32x4*)(mv + c0), sc = *(const f32x4*)(mv + D + c0);
                f32x4 h = (v[u][j] * rstd) * w * (sc + 1.0f) + sh;
                if (ROUTER) *(unsigned*)((unsigned char*)Hout + (size_t)row * D + c0) = pack_fp8x4(h[0], h[1], h[2], h[3]);
                else { u32x2 o; o.x = cvt_pk_bf16(h[0], h[1]); o.y = cvt_pk_bf16(h[2], h[3]); *(u32x2*)(Hout + (size_t)row * D + c0) = o;
                       if (H8) *(unsigned*)(H8 + (size_t)row * D + c0) = pack_fp8x4(h[0], h[1], h[2], h[3]); }
                if (ROUTER) {
#pragma unroll
                    for (int q = 0; q < 4; ++q) { const f32x4 r0 = rwr[j][q][0], r1 = rwr[j][q][1];
                        lg[0] += h[q] * r0[0]; lg[1] += h[q] * r0[1]; lg[2] += h[q] * r0[2]; lg[3] += h[q] * r0[3]; lg[4] += h[q] * r1[0]; lg[5] += h[q] * r1[1]; lg[6] += h[q] * r1[2]; lg[7] += h[q] * r1[3]; } }
            }
            if (ROUTER) {
                const bool b5 = (C.lane & 32) != 0, b4 = (C.lane & 16) != 0, b3 = (C.lane & 8) != 0; float a4[4], a2[2], a1;
#pragma unroll
                for (int j = 0; j < 4; ++j) { const float snd = b5 ? lg[j] : lg[4 + j]; a4[j] = (b5 ? lg[4 + j] : lg[j]) + __shfl_xor(snd, 32); }
#pragma unroll
                for (int j = 0; j < 2; ++j) { const float snd = b4 ? a4[j] : a4[2 + j]; a2[j] = (b4 ? a4[2 + j] : a4[j]) + __shfl_xor(snd, 16); }
                { const float snd = b3 ? a2[0] : a2[1]; a1 = (b3 ? a2[1] : a2[0]) + __shfl_xor(snd, 8); }
                a1 += __shfl_xor(a1, 4); a1 += __shfl_xor(a1, 2); a1 += __shfl_xor(a1, 1);
                if ((C.lane & 7) == 0) ((LAS float*)(C.lds + C.wave * 4096))[nloc * 8 + (C.lane >> 3)] = a1;
                ++nloc;
            }
        }
    }
    if (ROUTER) {
        LDS_WAIT();
        for (int i = C.lane; i < nloc; i += 64) { const int row = C.gw + i * C.NGW; const LAS float* lp = (const LAS float*)(C.lds + C.wave * 4096) + i * 8;
            float lg[8];
#pragma unroll
            for (int e = 0; e < 8; ++e) lg[e] = lp[e];
            int e1 = 0; float l1 = lg[0];
#pragma unroll
            for (int e = 1; e < 8; ++e) if (lg[e] > l1) { l1 = lg[e]; e1 = e; }
            int e2 = -1; float l2 = -INFINITY;
#pragma unroll
            for (int e = 0; e < 8; ++e) if (e != e1 && lg[e] > l2) { l2 = lg[e]; e2 = e; }
            const float g2 = 1.f / (1.f + expf(l1 - l2)), g1 = 1.f - g2;
            int* rt = (int*)(route + (size_t)row * 24); rt[0] = e1; rt[1] = e2; ((float*)rt)[2] = g1; ((float*)rt)[3] = g2;
            atomicAdd((int*)&cntL[e1], 1); atomicAdd((int*)&cntL[e2], 1);
        }
    }
}

constexpr int AT_XCH = 65536, AT_ANW = 131072;
DI float max3f(float a, float b, float c) { return fmaxf(fmaxf(a, b), c); }
DI float xhalf(float v, int hi) {
    const auto rr = __builtin_amdgcn_permlane32_swap(__float_as_uint(v), __float_as_uint(v), false, false);
    return __uint_as_float(hi ? rr[0] : rr[1]);
}
constexpr float AT_THR = 8.f;
DI void attn_unit(const Ctx& C, bf16_t* P, int qrow0, int krow_ctx, int krow_lat, int nkt, int h, float lam, const float* anw, float post) {
    const int tid_ = my_tid();
    LAS unsigned char* lds = C.lds; const int lane = tid_ & 63, wid = __builtin_amdgcn_readfirstlane(tid_ >> 6), sub = wid >> 2, qw = wid & 3, r32 = lane & 31, hh = lane >> 5;
    const int tq = (lane & 15) >> 2, tp = lane & 3, blk = (lane >> 4) & 1;
    LAS unsigned char* qlds = lds + AT_XCH + wid * 8192 + r32 * 16;
#pragma unroll
    for (int qb = 0; qb < 2; ++qb) { const bf16_t* qp = P + (size_t)(qrow0 + 64 * qw + 32 * qb + r32) * PW + PC_Q + h * 128 + sub * 64 + 8 * hh;
#pragma unroll
      for (int ks = 0; ks < 4; ++ks) *(LAS bf16x8*)(qlds + ((2 * ks + hh) * 64 + 32 * qb) * 16) = *(const bf16x8*)(qp + 16 * ks); }
    if (tid_ < 32) *(LAS f32x4*)(lds + AT_ANW + tid_ * 16) = *(const f32x4*)(anw + 4 * tid_);
    f32x16 O[2][4];
#pragma unroll
    for (int qb = 0; qb < 2; ++qb)
#pragma unroll
        for (int c = 0; c < 4; ++c)
#pragma unroll
            for (int i = 0; i < 16; ++i) O[qb][c][i] = 0.f;
    float m_run[2] = {-INFINITY, -INFINITY}, l_run[2] = {0.f, 0.f};
#define AT_ISSUE(kt, buf) do { const int kr0_ = (kt) < 4 ? krow_ctx + (kt) * 64 : krow_lat + ((kt) - 4) * 64; LAS unsigned char* bb_ = lds + (buf) * 32768; \
        _Pragma("unroll") for (int j_ = 0; j_ < 2; ++j_) { const int c_ = 2 * wid + j_; \
            dma16a(P + (size_t)(kr0_ + lane) * PW + PC_K + h * 128 + c_ * 8, bb_ + c_ * 1024); \
            dma16a(P + (size_t)(kr0_ + 16 * (c_ & 3) + (lane >> 2)) * PW + PC_V + h * 128 + (c_ >> 2) * 32 + (lane & 3) * 8, bb_ + 16384 + c_ * 1024); } } while (0)
    AT_ISSUE(0, 0);
    int buf = 0;
#pragma unroll 1
    for (int kt = 0; kt < nkt; ++kt) {
        VM_WAIT(); __syncthreads();
        if (kt + 1 < nkt) AT_ISSUE(kt + 1, buf ^ 1);
        const LAS unsigned char* kb = lds + buf * 32768, * vb = kb + 16384 + (4 * hh + tq) * 64 + blk * 32 + tp * 8;
        bf16x8 Pf[2][4];
#pragma unroll
        for (int qb = 0; qb < 2; ++qb) {
            f32x16 s0, s1;
#pragma unroll
            for (int i = 0; i < 16; ++i) { s0[i] = 0.f; s1[i] = 0.f; }
#pragma unroll
            for (int ks = 0; ks < 4; ++ks) { const LAS unsigned char* kp = kb + ((sub * 8 + 2 * ks + hh) * 64 + r32) * 16;
                const bf16x8 k0 = *(const LAS bf16x8*)kp, k1 = *(const LAS bf16x8*)(kp + 512);
                const bf16x8 q = *(const LAS bf16x8*)(qlds + ((2 * ks + hh) * 64 + 32 * qb) * 16);
                s0 = MFMA32(k0, q, s0); s1 = MFMA32(k1, q, s1); }
            float mx = max3f(s0[0], s1[0], s0[1]);
#pragma unroll
            for (int i = 1; i < 16; ++i) mx = (i + 1 < 16) ? max3f(mx, s1[i], s0[i + 1]) : fmaxf(mx, s1[i]);
            mx = fmaxf(mx, xhalf(mx, hh));
            const float mnew = fmaxf(m_run[qb], mx);
            if (__any(mx > m_run[qb] + AT_THR)) { const float alpha = __builtin_amdgcn_exp2f(m_run[qb] - mnew); l_run[qb] *= alpha;
#pragma unroll
                for (int c = 0; c < 4; ++c)
#pragma unroll
                    for (int i = 0; i < 16; ++i) O[qb][c][i] *= alpha;
                m_run[qb] = mnew; }
            const float mr = m_run[qb]; float ps0 = 0.f, ps1 = 0.f;
#pragma unroll
            for (int i = 0; i < 16; ++i) { s0[i] = __builtin_amdgcn_exp2f(s0[i] - mr); s1[i] = __builtin_amdgcn_exp2f(s1[i] - mr); ps0 += s0[i]; ps1 += s1[i]; }
            l_run[qb] += ps0 + ps1;
            Pf[qb][0] = packf8(s0, 0); Pf[qb][1] = packf8(s0, 1); Pf[qb][2] = packf8(s1, 0); Pf[qb][3] = packf8(s1, 1);
        }
#pragma unroll
        for (int cb = 0; cb < 4; ++cb) {
#pragma unroll
            for (int s4 = 0; s4 < 4; ++s4) { const bf16x8 a = cat8(tr16(vb + cb * 4096 + s4 * 1024), tr16(vb + cb * 4096 + s4 * 1024 + 512));
                O[0][cb] = MFMA32(a, Pf[0][s4], O[0][cb]); O[1][cb] = MFMA32(a, Pf[1][s4], O[1][cb]); } }
        buf ^= 1;
    }
#undef AT_ISSUE
    LDS_WAIT(); __syncthreads();
    const int te = my_tid(); const int lane_e = te & 63, wid_e = __builtin_amdgcn_readfirstlane(te >> 6);
    LAS float* xch = (LAS float*)(lds + AT_XCH) + (wid_e & 3) * 4096 + lane_e;
#pragma unroll
    for (int qb = 0; qb < 2; ++qb) {
        const float lt = l_run[qb] + xhalf(l_run[qb], lane_e >> 5); const float inv = 1.f / lt;
        if ((wid_e >> 2) == 1) { const float sc = -lam * inv;
#pragma unroll
            for (int c = 0; c < 4; ++c)
#pragma unroll
                for (int i = 0; i < 16; ++i) xch[(c * 16 + i) * 64] = O[qb][c][i] * sc; }
        LDS_WAIT(); __syncthreads();
        if ((wid_e >> 2) == 0) {
            float ss = 0.f;
#pragma unroll
            for (int c = 0; c < 4; ++c)
#pragma unroll
                for (int i = 0; i < 16; ++i) { const float o = O[qb][c][i] * inv + xch[(c * 16 + i) * 64]; O[qb][c][i] = o; ss += o * o; }
            ss += xhalf(ss, lane_e >> 5);
            const float rs = post / sqrtf(ss * (1.f / 128.f) + EPS);
            bf16_t* op = P + (size_t)(qrow0 + 64 * (wid_e & 3) + 32 * qb + (lane_e & 31)) * PW + PC_Q + h * 128;
#pragma unroll
            for (int c = 0; c < 4; ++c)
#pragma unroll
                for (int g = 0; g < 4; ++g) { const int v0 = 32 * c + 8 * g + 4 * (lane_e >> 5); const f32x4 w = *(const LAS f32x4*)(lds + AT_ANW + v0 * 4);
                    u32x2 o; o.x = cvt_pk_bf16(O[qb][c][4 * g] * rs * w[0], O[qb][c][4 * g + 1] * rs * w[1]); o.y = cvt_pk_bf16(O[qb][c][4 * g + 2] * rs * w[2], O[qb][c][4 * g + 3] * rs * w[3]);
                    *(u32x2*)(op + v0) = o; }
        }
        LDS_WAIT(); __syncthreads();
    }
}

constexpr int SC_Q = 0, SC_LF = 16384, SC_V0 = 32768, SC_QM = 65536, SC_KMR = 81920, SC_KMS = 98304, SC_SX = 114688, SC_A31 = 147456, SC_A63 = 147968, SC_END = 148480;
DI void scan_chain(const Ctx& C, bf16_t* P, int b, int h, int dir, bool store_ctx) {
    const int tid_ = my_tid();
    LAS unsigned char* lds = C.lds; const int lane = tid_ & 63, wid = __builtin_amdgcn_readfirstlane(tid_ >> 6), r32 = lane & 31, hh = lane >> 5;
    const int tq = (lane & 15) >> 2, tp = lane & 3, blk = (lane >> 4) & 1;
    const int db = wid & 3, tb = wid >> 2;
    const int base_nat = hh * 512 + tq * 64 + blk * 32 + tp * 8;
    const int base_prm = (4 * hh + tq) * 64 + blk * 32 + tp * 8;
    const int lfcol = (dir ? PC_LB : PC_LF) + h * 128, qcol = PC_RQ + h * 128, vcol = PC_RI + h * 128;
    f32x16 ST[2];
#pragma unroll
    for (int j = 0; j < 2; ++j)
#pragma unroll
        for (int i = 0; i < 16; ++i) ST[j][i] = 0.f;
#define SROW(c, i) ((c) < 4 ? NLAT + b * CL + (dir ? 255 - ((c) * 64 + (i)) : (c) * 64 + (i)) : b * T + (dir ? 2047 - (((c) - 4) * 64 + (i)) : ((c) - 4) * 64 + (i)))
#define SDMA(c, colbase, dstoff) do { _Pragma("unroll") for (int j_ = 0; j_ < 2; ++j_) { const int I_ = 2 * wid + j_; const int ti_ = 16 * (I_ & 3) + (lane >> 2); \
        dma16(P + (size_t)SROW(c, ti_) * PW + (colbase) + (I_ >> 2) * 32 + (lane & 3) * 8, lds + (dstoff) + I_ * 1024); } } while (0)
    SDMA(0, qcol, SC_Q); SDMA(0, lfcol, SC_LF); SDMA(0, vcol, SC_V0);
    int vbuf = 0;
    const int t = 32 * tb + r32;
#pragma unroll 1
    for (int c = 0; c < 36; ++c) {
        { const int st_ = __builtin_amdgcn_readfirstlane((c > 0 && (c > 4 || store_ctx)) ? 1 : 0);
          asm volatile("s_cmp_lg_u32 %0, 0\n\ts_cbranch_scc1 1f\n\ts_waitcnt vmcnt(0)\n1:\n\ts_waitcnt vmcnt(4)" :: "s"(st_) : "memory", "scc"); }
        LDS_BARRIER();
        const LAS unsigned char* Vimg = lds + SC_V0 + vbuf * 16384;
        f32x16 cm;
#pragma unroll
        for (int i = 0; i < 16; ++i) cm[i] = 0.f;
#pragma unroll
        for (int kk = 0; kk < 2; ++kk) { const int ks = 2 * tb + kk;
            const half8 a = __builtin_bit_cast(half8, cat8(tr16(lds + SC_LF + db * 4096 + base_nat + ks * 1024), tr16(lds + SC_LF + db * 4096 + base_nat + ks * 1024 + 256)));
            half8 bm;
#pragma unroll
            for (int j = 0; j < 8; ++j) { const int s = 16 * ks + 8 * hh + j; bm[j] = tb == 0 ? (s > t ? (_Float16)-1.f : (_Float16)0.f) : (s <= t ? (_Float16)1.f : (_Float16)0.f); }
            cm = __builtin_amdgcn_mfma_f32_32x32x16_f16(a, bm, cm, 0, 0, 0); }
#pragma unroll
        for (int g = 0; g < 4; ++g) {
            const int sa = db * 4096 + (t >> 3) * 512 + (t & 7) * 64 + (8 * g + 4 * hh) * 2;
            const u32x2 q4 = *(const LAS u32x2*)(lds + SC_Q + sa); const half4 lf4 = *(const LAS half4*)(lds + SC_LF + sa);
            const float qv[4] = {bflo(q4.x), bfhi(q4.x), bflo(q4.y), bfhi(q4.y)};
            float qm[4], km[4];
#pragma unroll
            for (int e = 0; e < 4; ++e) { const float cv = cm[4 * g + e] * LOG2E; const float E = __builtin_amdgcn_exp2f(cv), Ei = __builtin_amdgcn_exp2f(-cv);
                const float lf = (float)lf4[e]; qm[e] = qv[e] * E; km[e] = (1.f - __builtin_amdgcn_exp2f(lf * LOG2E)) * Ei;
                if (tb == 0 && r32 == 0) ((LAS float*)(lds + SC_A31))[32 * db + 8 * g + 4 * hh + e] = lf - cm[4 * g + e];
                if (tb == 1 && r32 == 31) ((LAS float*)(lds + SC_A63))[32 * db + 8 * g + 4 * hh + e] = cm[4 * g + e]; }
            u32x2 qw2, kw2; qw2.x = cvt_pk_bf16(qm[0], qm[1]); qw2.y = cvt_pk_bf16(qm[2], qm[3]); kw2.x = cvt_pk_bf16(km[0], km[1]); kw2.y = cvt_pk_bf16(km[2], km[3]);
            const int ra = ((4 * db + g) * 64 + t) * 16 + 8 * hh;
            *(LAS u32x2*)(lds + SC_QM + ra) = qw2; *(LAS u32x2*)(lds + SC_KMR + ra) = kw2; *(LAS u32x2*)(lds + SC_KMS + sa) = kw2;
        }
        LDS_BARRIER();
        if (c + 1 < 36) { SDMA(c + 1, qcol, SC_Q); SDMA(c + 1, lfcol, SC_LF); SDMA(c + 1, vcol, SC_V0 + (vbuf ^ 1) * 16384); }
        { const int d = 32 * db + r32; const float c31 = ((LAS float*)(lds + SC_A31))[d], c63 = ((LAS float*)(lds + SC_A63))[d];
          const float e31 = __expf(c31), dec = __expf(c31 + c63), e63 = __expf(c63);
          f32x16 SN[2];
#pragma unroll
          for (int j = 0; j < 2; ++j) { const int vb2 = 2 * tb + j;
#pragma unroll
              for (int g = 0; g < 4; ++g) { u32x2 w; w.x = cvt_pk_bf16(ST[j][4 * g] * e31, ST[j][4 * g + 1] * e31); w.y = cvt_pk_bf16(ST[j][4 * g + 2] * e31, ST[j][4 * g + 3] * e31);
                  *(LAS u32x2*)(lds + SC_SX + vb2 * 8192 + (d >> 3) * 512 + (d & 7) * 64 + (8 * g + 4 * hh) * 2) = w; }
#pragma unroll
              for (int i = 0; i < 16; ++i) SN[j][i] = 0.f; }
#pragma unroll
          for (int ks = 0; ks < 4; ++ks) {
              const bf16x8 kf = cat8(tr16(lds + SC_KMS + db * 4096 + base_nat + ks * 1024), tr16(lds + SC_KMS + db * 4096 + base_nat + ks * 1024 + 256));
#pragma unroll
              for (int j = 0; j < 2; ++j) { const int vb2 = 2 * tb + j;
                  const bf16x8 vf = cat8(tr16(Vimg + vb2 * 4096 + base_nat + ks * 1024), tr16(Vimg + vb2 * 4096 + base_nat + ks * 1024 + 256));
                  SN[j] = MFMA32(vf, kf, SN[j]); } }
#pragma unroll
          for (int j = 0; j < 2; ++j)
#pragma unroll
              for (int i = 0; i < 16; ++i) ST[j][i] = dec * ST[j][i] + e63 * SN[j][i];
        }
        LDS_BARRIER();
        { bf16x8 Qmf[8];
#pragma unroll
          for (int kd = 0; kd < 8; ++kd) Qmf[kd] = *(const LAS bf16x8*)(lds + SC_QM + ((2 * kd + hh) * 64 + t) * 16);
          f32x16 o;
#pragma unroll
          for (int i = 0; i < 16; ++i) o[i] = 0.f;
          for (int sb = 0; sb <= tb; ++sb) {
              f32x16 pt;
#pragma unroll
              for (int i = 0; i < 16; ++i) pt[i] = 0.f;
#pragma unroll
              for (int kd = 0; kd < 8; ++kd) { const bf16x8 a = *(const LAS bf16x8*)(lds + SC_KMR + ((2 * kd + hh) * 64 + 32 * sb + r32) * 16); pt = MFMA32(a, Qmf[kd], pt); }
              if (sb == tb) {
#pragma unroll
                  for (int i = 0; i < 16; ++i) if (crow(i, hh) > r32) pt[i] = 0.f; }
              const bf16x8 p0 = packf8(pt, 0), p1 = packf8(pt, 1);
              { const bf16x8 a = cat8(tr16(Vimg + db * 4096 + base_prm + (2 * sb) * 1024), tr16(Vimg + db * 4096 + base_prm + (2 * sb) * 1024 + 512)); o = MFMA32(a, p0, o); }
              { const bf16x8 a = cat8(tr16(Vimg + db * 4096 + base_prm + (2 * sb + 1) * 1024), tr16(Vimg + db * 4096 + base_prm + (2 * sb + 1) * 1024 + 512)); o = MFMA32(a, p1, o); }
          }
#pragma unroll
          for (int kd = 0; kd < 8; ++kd) { const bf16x8 a = cat8(tr16(lds + SC_SX + db * 8192 + base_nat + kd * 1024), tr16(lds + SC_SX + db * 8192 + base_nat + kd * 1024 + 256)); o = MFMA32(a, Qmf[kd], o); }
          if (c >= 4 || store_ctx) { bf16_t* op = P + (size_t)SROW(c, t) * PW + lfcol + 32 * db;
#pragma unroll
              for (int g = 0; g < 4; ++g) { u32x2 w; w.x = cvt_pk_bf16(o[4 * g], o[4 * g + 1]); w.y = cvt_pk_bf16(o[4 * g + 2], o[4 * g + 3]); *(u32x2*)(op + 8 * g + 4 * hh) = w; } }
        }
        vbuf ^= 1;
    }
    VM_WAIT(); LDS_WAIT(); __syncthreads();
#undef SROW
#undef SDMA
}

DI void phase_recprep(const Ctx& C, bf16_t* P, const float* rnw, int nrows) {
    const f32x4 w0 = *(const f32x4*)(rnw + ((8 * C.lane) & 127)), w1 = *(const f32x4*)(rnw + ((8 * C.lane) & 127) + 4);
    for (int row0 = C.gw; row0 < nrows; row0 += 4 * C.NGW) {
        u32x4 ra[4], rb[4], rg[4];
#pragma unroll
        for (int u = 0; u < 4; ++u) { const int row = row0 + u * C.NGW < nrows ? row0 + u * C.NGW : row0; const bf16_t* pr = P + (size_t)row * PW + 8 * C.lane;
            ra[u] = *(const u32x4*)(pr + PC_LF); rb[u] = *(const u32x4*)(pr + PC_LB); rg[u] = *(const u32x4*)(pr + PC_G); }
#pragma unroll
        for (int u = 0; u < 4; ++u) { const int row = row0 + u * C.NGW; if (row >= nrows) break;
            float a[8], bb[8], g[8]; unpack8(ra[u], a); unpack8(rb[u], bb); unpack8(rg[u], g);
            float ss = 0.f;
#pragma unroll
            for (int j = 0; j < 8; ++j) { a[j] += bb[j]; ss += a[j] * a[j]; }
            ss += __shfl_xor(ss, 1); ss += __shfl_xor(ss, 2); ss += __shfl_xor(ss, 4); ss += __shfl_xor(ss, 8);
            const float rs = 1.0f / sqrtf(ss * (1.f / 128.f) + EPS);
            f32x4 o0, o1;
#pragma unroll
            for (int j = 0; j < 4; ++j) { o0[j] = a[j] * rs * w0[j] * g[j]; o1[j] = a[4 + j] * rs * w1[j] * g[4 + j]; }
            *(u32x4*)(P + (size_t)row * PW + 8 * C.lane + PC_LF) = pack8(o0, o1); }
    }
}

DI void phase_slots(const Ctx& C, const int* cnt, int* pbout, unsigned char* route, const bf16_t* H2, bf16_t* AG, LAS int* cur) {
    if (C.tid < 16) cur[C.tid] = 0;
    __syncthreads();
    for (int g = C.tid; g < C.G; g += 512) {
#pragma unroll
        for (int k = 0; k < 8; ++k) { const int c = cnt[g * 8 + k]; atomicAdd((int*)&cur[8 + k], c); if (g < C.bx) atomicAdd((int*)&cur[k], c); } }
    __syncthreads();
    if (C.tid < 8) { const int e = C.tid; int pb = 0, pbe = 0;
#pragma unroll
        for (int k = 0; k < 8; ++k) { if (k == e) pbe = pb; pb += (cur[8 + k] + 255) >> 8; }
        const int mine = cur[e];
        if (C.bx == 0) { pbout[e] = pbe; if (e == 7) pbout[8] = pb; }
        cur[e] = pbe * 256 + mine;
    }
    __syncthreads();
    const int nloc = (NLAT - C.gw + C.NGW - 1) / C.NGW;
    LAS int* tab = (LAS int*)(C.lds + C.wave * 2048);
    for (int i = C.lane; i < nloc; i += 64) { int* rt = (int*)(route + (size_t)(C.gw + i * C.NGW) * 24);
        const int s1 = atomicAdd((int*)&cur[rt[0]], 1), s2 = atomicAdd((int*)&cur[rt[1]], 1); rt[4] = s1; rt[5] = s2; tab[2 * i] = s1; tab[2 * i + 1] = s2; }
    LDS_WAIT();
    for (int i = 0; i < nloc; i += 2) { const int i1 = i + 1 < nloc ? i + 1 : i;
        const int sa1 = __builtin_amdgcn_readfirstlane(tab[2 * i]), sa2 = __builtin_amdgcn_readfirstlane(tab[2 * i + 1]), sb1 = __builtin_amdgcn_readfirstlane(tab[2 * i1]), sb2 = __builtin_amdgcn_readfirstlane(tab[2 * i1 + 1]);
        const u32x4 va = *((const u32x4*)((const unsigned char*)H2 + (size_t)(C.gw + i * C.NGW) * D) + C.lane);
        const u32x4 vb = *((const u32x4*)((const unsigned char*)H2 + (size_t)(C.gw + i1 * C.NGW) * D) + C.lane);
        *((u32x4*)((unsigned char*)AG + (size_t)sa1 * D) + C.lane) = va; *((u32x4*)((unsigned char*)AG + (size_t)sa2 * D) + C.lane) = va;
        *((u32x4*)((unsigned char*)AG + (size_t)sb1 * D) + C.lane) = vb; *((u32x4*)((unsigned char*)AG + (size_t)sb2 * D) + C.lane) = vb;
    }
}
DI void phase_final(const Ctx& C, float* x, const unsigned char* route, const bf16_t* Y, const float* mods1, const float* fw) {
    for (int row0 = C.gw; row0 < NLAT; row0 += 2 * C.NGW) {
        const int rows[2] = {row0, row0 + C.NGW < NLAT ? row0 + C.NGW : row0};
        f32x4 v[2][4]; float ss[2] = {0.f, 0.f};
#pragma unroll
        for (int u = 0; u < 2; ++u) { const int row = rows[u];
            const int* rt = (const int*)(route + (size_t)row * 24); const float g1 = ((const float*)rt)[2], g2 = ((const float*)rt)[3]; const int s1 = rt[4], s2 = rt[5];
            const float* mv = mods1 + (size_t)(row >> 11) * DIN + 5 * D; const float* xr = x + (size_t)row * D;
#pragma unroll
            for (int j = 0; j < 4; ++j) { const int c0 = 256 * j + 4 * C.lane;
                const u32x2 y1 = *(const u32x2*)(Y + (size_t)s1 * D + c0), y2 = *(const u32x2*)(Y + (size_t)s2 * D + c0); const f32x4 m5 = *(const f32x4*)(mv + c0);
                f32x4 y; y[0] = g1 * bflo(y1.x) + g2 * bflo(y2.x); y[1] = g1 * bfhi(y1.x) + g2 * bfhi(y2.x); y[2] = g1 * bflo(y1.y) + g2 * bflo(y2.y); y[3] = g1 * bfhi(y1.y) + g2 * bfhi(y2.y);
                v[u][j] = *(const f32x4*)(xr + c0) + m5 * y; ss[u] += (v[u][j][0] * v[u][j][0] + v[u][j][1] * v[u][j][1]) + (v[u][j][2] * v[u][j][2] + v[u][j][3] * v[u][j][3]); } }
#pragma unroll
        for (int u = 0; u < 2; ++u) { if (u == 1 && rows[1] == rows[0]) break;
            const float rstd = 1.0f / sqrtf(wave_sum(ss[u]) * (1.f / D) + EPS); float* xr = x + (size_t)rows[u] * D;
#pragma unroll
            for (int j = 0; j < 4; ++j) { const int c0 = 256 * j + 4 * C.lane; *(f32x4*)(xr + c0) = v[u][j] * rstd * *(const f32x4*)(fw + c0); } }
    }
}

constexpr int LDS_MISC = SC_END;
constexpr int LDS_BYTES = SC_END + 512;
static_assert(LDS_WTAB_OFF == SC_END + 128, "wave table sits behind the barrier words and counters");
constexpr int NPHASE = 20;

DI Ctx make_ctx() {
    extern __shared__ __attribute__((aligned(16))) unsigned char lds_raw[];
    Ctx C; const int t = my_tid();
    unsigned lb = (unsigned)(size_t)(LAS unsigned char*)lds_raw; asm volatile("" : "+s"(lb));
    C.lds = (LAS unsigned char*)(size_t)lb; C.ws = kparams()->ws; C.tid = t; C.lane = t & 63; C.wave = __builtin_amdgcn_readfirstlane(t >> 6);
    int bx = blockIdx.x, G = gridDim.x; asm volatile("" : "+s"(bx), "+s"(G));
    C.bx = bx; C.G = G; C.vcu = (C.G % 8 == 0) ? (bx % 8) * (C.G / 8) + bx / 8 : bx;
    C.gw = C.vcu * 8 + C.wave; C.NGW = C.G * 8;
    return C;
}
DI void grid_barrier() {
    extern __shared__ __attribute__((aligned(16))) unsigned char lds_raw[];
    XcdBarrier b; b.bar = (unsigned*)(kparams()->ws + WS_CTL) + CW_BAR + kparams()->li * XCD_BAR_WORDS; b.x = xb_xcc_id(); b.st = (volatile LAS unsigned*)((LAS unsigned char*)lds_raw + LDS_MISC);
    xcd_barrier(b);
}
#define WSP(T, off) ((T*)(kparams()->ws + (off)))

#define IN(k) (kparams()->ph_lo <= (k) && (k) < kparams()->ph_hi)
#define SEAM(k) do { if (IN(k) && IN((k) + 1)) grid_barrier(); } while (0)


template <int l> DI void layer_phases() {
        constexpr int FS = l == 0 ? FP8_SECS0 : FP8_SECS1, N_SEC_F8 = n_sec_f8(FS), N_SEC_BF = 8 - N_SEC_F8;
        const int pb = 1 + 9 * l;
#define LQ() int lq = l; asm volatile("" : "+s"(lq))
#define XL (lq == 0 ? PIN(0) : (const float*)POUT)
#define XC (lq == 0 ? PIN(2) : (const float*)WSP(float, WS_CTXRES))
#define LMODS (WSP(float, WS_MODS) + (size_t)lq * 33 * DIN)
#define NROWS_OUT (lq == 0 ? NTOK : NLAT)
        if (IN(pb + 0)) { LQ(); const Ctx C = make_ctx(); phase_norm<false>(C, XL, XC, PIN(6) + lq * D, LMODS, 0, NTOK, WSP(bf16_t, WS_H), nullptr, nullptr, nullptr, WSP(unsigned char, WS_H8)); }
        SEAM(pb + 0);
        if (IN(pb + 1)) { LQ();
            { const Ctx C = make_ctx();
              Gemm g{WSP(bf16_t, WS_H), WSP(bf16_t, WS_WIN) + (size_t)lq * 4096 * D, NTOK, N_SEC_BF * 512, D, D};
              pg8::StaticOrder S; S.init(g, C.G, C.bx);
              EpiInProj E{WSP(bf16_t, WS_P), WSP(float2, WS_ROPE), WSP(float, WS_LBS) + lq * 1024, WSP(float, WS_LBS) + lq * 1024 + 512, (int)secmap_of(FS, false), 1.f};
              pg8::gemm_phase<EpiInProj, pg8::StaticOrder>(C.lds, g, S, E); }
            if (N_SEC_F8 > 0) { const Ctx C = make_ctx();
              Gemm g{WSP(bf16_t, WS_H8), (const bf16_t*)(WSP(unsigned char, WS_WIN8) + (size_t)lq * 4096 * D), NTOK, N_SEC_F8 * 512, D / 2, D / 2};
              pg8::StaticOrder S; S.init(g, C.G, C.bx);
              EpiInProj E{WSP(bf16_t, WS_P), WSP(float2, WS_ROPE), WSP(float, WS_LBS) + lq * 1024, WSP(float, WS_LBS) + lq * 1024 + 512, (int)secmap_of(FS, true), 1.f / WIN8_SCALE};
              pg8::gemm_phase<EpiInProj, pg8::StaticOrder, true, true>(C.lds, g, S, E); }
        }
        SEAM(pb + 1);
        if (IN(pb + 2)) { LQ(); const Ctx C = make_ctx(); bf16_t* const Pb = WSP(bf16_t, WS_P);
            for (int id = C.vcu; id < NB * 4 * 2; id += C.G) scan_chain(C, Pb, id >> 3, (id >> 1) & 3, id & 1, lq == 0);
            float lam;
            { const float a = wave_sum(PIN(9)[lq * 64 + C.lane] * PIN(10)[lq * 64 + C.lane]), b2 = wave_sum(PIN(11)[lq * 64 + C.lane] * PIN(12)[lq * 64 + C.lane]);
              const float li = 0.8f - 0.6f * expf(-0.3f * (float)lq); lam = expf(a) - expf(b2) + li; lam = __uint_as_float(__builtin_amdgcn_readfirstlane(__float_as_uint(lam))); }
            const float post = __uint_as_float(__builtin_amdgcn_readfirstlane(__float_as_uint(1.f - (0.8f - 0.6f * expf(-0.3f * (float)lq)))));
            const float* anw = PIN(13) + lq * 128;
            const int NU = NB * 4 * 8, U = (NU + C.G - 1) / C.G;
            for (int id = C.vcu * U; id < NU && id < (C.vcu + 1) * U; ++id) { const int bh = id >> 3, qb = id & 7, b = bh >> 2, h = bh & 3;
                attn_unit(C, Pb, b * T + qb * 256, NLAT + b * CL, b * T, 36, h, lam, anw, post); }
            if (lq == 0) for (int id = C.vcu; id < NB * 4; id += C.G) { const int b = id >> 2, h = id & 3;
                attn_unit(C, Pb, NLAT + b * CL, NLAT + b * CL, 0, 4, h, lam, anw, post); }
        }
        SEAM(pb + 2);
        if (IN(pb + 3)) { LQ(); const Ctx C = make_ctx();
            phase_recprep(C, WSP(bf16_t, WS_P), PIN(14) + lq * 128, NROWS_OUT);
            Gemm g{WSP(bf16_t, WS_H8), (const bf16_t*)(WSP(unsigned char, WS_WIN8) + ((size_t)lq * 4096 + N_SEC_F8 * 512) * D), NROWS_OUT, 2048, D / 2, D / 2};
            pg8::StaticOrder S; S.init(g, C.G, C.bx);
            EpiGates E{WSP(bf16_t, WS_P), 1.f / WIN8_SCALE};
            pg8::gemm_phase<EpiGates, pg8::StaticOrder, true, true>(C.lds, g, S, E);
        }
        SEAM(pb + 3);
        if (IN(pb + 4)) { LQ(); const Ctx C = make_ctx();
            Gemm g{WSP(bf16_t, WS_P) + PC_Q, WSP(bf16_t, WS_WUA) + (size_t)lq * D * D, NROWS_OUT, D, D, PW};
            pg8::StaticOrder S; S.init(g, C.G, C.bx); EpiMergeFused E{WSP(bf16_t, WS_P), WSP(bf16_t, WS_MERGED)};
            pg8::gemm_phase<EpiMergeFused, pg8::StaticOrder, true, false, true>(C.lds, g, S, E);
        }
        SEAM(pb + 4);
        if (IN(pb + 5)) { LQ(); const Ctx C = make_ctx();
            Gemm g{WSP(bf16_t, WS_MERGED), WSP(bf16_t, WS_WO) + (size_t)lq * D * D, NROWS_OUT, D, D, D};
            pg8::StaticOrder S; S.init(g, C.G, C.bx);
            EpiResid E{XL, XC, POUT, WSP(float, WS_CTXRES), LMODS, 2};
            pg8::gemm_phase<EpiResid, pg8::StaticOrder>(C.lds, g, S, E);
        }
        SEAM(pb + 5);
        if (l == 0) {
            if (IN(7)) { LQ(); const Ctx C = make_ctx(); phase_norm<false>(C, POUT, WSP(float, WS_CTXRES), PIN(7), LMODS, 3, NTOK, WSP(bf16_t, WS_H), nullptr, nullptr, nullptr); }
            SEAM(7);
            if (IN(8)) { LQ(); const Ctx C = make_ctx();
                Gemm g{WSP(bf16_t, WS_H), WSP(bf16_t, WS_W13), NTOK, 2 * DFFP, D, D};
                pg8::StaticOrder S; S.init(g, C.G, C.bx); EpiSwiglu E{WSP(bf16_t, WS_HID), DFFP, 0};
                pg8::gemm_phase<EpiSwiglu, pg8::StaticOrder>(C.lds, g, S, E);
            }
            SEAM(8);
            if (IN(9)) { LQ(); const Ctx C = make_ctx();
                Gemm g{WSP(bf16_t, WS_HID), WSP(bf16_t, WS_W2), NTOK, D, DFFP, DFFP};
                pg8::StaticOrder S; S.init(g, C.G, C.bx); EpiResid E{POUT, WSP(float, WS_CTXRES), POUT, WSP(float, WS_CTXRES), LMODS, 5};
                pg8::gemm_phase<EpiResid, pg8::StaticOrder>(C.lds, g, S, E);
            }
            SEAM(9);
        } else {
            if (IN(16)) { LQ(); const Ctx C = make_ctx(); LAS int* lcnt = (LAS int*)(C.lds + LDS_MISC + 32);
                if (C.tid < 8) lcnt[C.tid] = 0;
                __syncthreads();
                phase_norm<true>(C, POUT, nullptr, PIN(7) + D, LMODS, 3, NLAT, WSP(bf16_t, WS_H2M), PIN(23), WSP(unsigned char, WS_ROUTE), lcnt);
                __syncthreads();
                if (C.tid < 8) WSP(int, WS_CNT)[C.bx * 8 + C.tid] = lcnt[C.tid];
                convert_moe_weights(C);
            }
            SEAM(16);
            if (IN(17)) { LQ(); const Ctx C = make_ctx(); phase_slots(C, WSP(int, WS_CNT), WSP(int, WS_CNT) + 4096, WSP(unsigned char, WS_ROUTE), WSP(bf16_t, WS_H2M), WSP(bf16_t, WS_AG), (LAS int*)(C.lds + LDS_MISC + 32)); }
            SEAM(17);
            if (IN(18)) { LQ();
                const int ptot = __builtin_amdgcn_readfirstlane(WSP(int, WS_CNT)[4096 + 8]);
                for (int p0 = 0; p0 < ptot; p0 += MOE_CHUNK) {
                    const int np = (ptot - p0) < MOE_CHUNK ? (ptot - p0) : MOE_CHUNK;
#define MOE_ORDER_INIT(S) do { S.so.init(g, C.G, C.bx); S.p0 = p0; S.load_pb(WSP(int, WS_CNT) + 4096); } while (0)
                    { const Ctx C = make_ctx(); Gemm g{WSP(bf16_t, WS_AG), WSP(bf16_t, WS_WM13), np * 256, 2 * DFE, D / 2, D / 2};
                      pg8::MoeOrder S; MOE_ORDER_INIT(S); S.apan0 = 0; S.estride = (size_t)2 * DFE * D;
                      EpiSwiglu8 E{WSP(unsigned char, WS_MHID), DFE, p0, 1.f / W13_SCALE, HID_SCALE};
                      pg8::gemm_phase<EpiSwiglu8, pg8::MoeOrder, true, true>(C.lds, g, S, E); }
                    grid_barrier();
                    { const Ctx C = make_ctx(); Gemm g{WSP(bf16_t, WS_MHID), WSP(bf16_t, WS_WM2), np * 256, D, DFE / 2, DFE / 2};
                      pg8::MoeOrder S; MOE_ORDER_INIT(S); S.apan0 = p0; S.estride = (size_t)D * DFE;
                      EpiBf16 E{WSP(bf16_t, WS_Y), D, 1.f / (W2_SCALE * HID_SCALE)};
                      pg8::gemm_phase<EpiBf16, pg8::MoeOrder, true, true>(C.lds, g, S, E); }
                    grid_barrier();
                }
            }
            if (IN(19)) { LQ(); const Ctx C = make_ctx(); phase_final(C, POUT, WSP(unsigned char, WS_ROUTE), WSP(bf16_t, WS_Y), LMODS, PIN(27)); }
        }
}

__global__ void __launch_bounds__(512, 2) fwd_kernel(Params p) {
    extern __shared__ __attribute__((aligned(16))) unsigned char lds_raw[];
    (void)p;
    { volatile LAS unsigned* misc = (volatile LAS unsigned*)((LAS unsigned char*)lds_raw + LDS_MISC);
      if (threadIdx.x < 16) misc[threadIdx.x] = 0u;
      if ((threadIdx.x & 63) == 0) ((volatile LAS int*)((LAS unsigned char*)lds_raw + LDS_WTAB_OFF))[(unsigned)__builtin_amdgcn_s_getreg((5 << 11) | 4) & 63u] = threadIdx.x >> 6;
      __syncthreads();
      (void)xcd_barrier_post((unsigned*)(kparams()->ws + WS_CTL) + CW_BAR + kparams()->li * XCD_BAR_WORDS, misc); }
    if (IN(0)) { const Ctx C = make_ctx(); phase_prologue(C); } SEAM(0);

    layer_phases<0>();
    layer_phases<1>();
#undef IN
#undef SEAM
}


extern "C" void kernel_launch(void* const* d_in, const int* in_sizes, int n_in, void* d_out, int out_size, void* d_ws, size_t ws_size, hipStream_t stream) {
    static int grid = 0;
    if (grid == 0) {
        if (n_in != 28 || out_size != NLAT * D || ws_size < WS_END) { fprintf(stderr, "kernel_launch: unexpected problem (n_in %d, out %d, ws %zu)\n", n_in, out_size, ws_size); grid = -1; return; }
        int dev = 0, cus = 0, per_cu = 0;
        if (hipGetDevice(&dev) != hipSuccess || hipDeviceGetAttribute(&cus, hipDeviceAttributeMultiprocessorCount, dev) != hipSuccess) { grid = -1; return; }
        if (hipFuncSetAttribute((const void*)fwd_kernel, hipFuncAttributeMaxDynamicSharedMemorySize, LDS_BYTES) != hipSuccess) { fprintf(stderr, "kernel_launch: cannot set %d B dynamic LDS\n", LDS_BYTES); grid = -1; return; }
        if (hipOccupancyMaxActiveBlocksPerMultiprocessor(&per_cu, (const void*)fwd_kernel, 512, LDS_BYTES) != hipSuccess || per_cu < 1) fprintf(stderr, "kernel_launch: occupancy query says %d\n", per_cu);
        (void)hipGetLastError();
        grid = cus;
    }
    if (grid < 0) return;
    (void)hipMemsetAsync((char*)d_ws + WS_CTL, 0, CTL_BYTES, stream);
    Params a{};
    for (int i = 0; i < 28; ++i) a.in[i] = (const float*)d_in[i];
    a.out = (float*)d_out; a.ws = (unsigned char*)d_ws; a.ph_lo = 0; a.ph_hi = NPHASE; a.li = 0; a.pad = 0;
    hipLaunchKernelGGL(fwd_kernel, dim3(grid), dim3(512), LDS_BYTES, stream, a);
}
```

```cpp
#include <hip/hip_runtime.h>
#include <cstdio>
#include <cstdint>


constexpr int D = 1024, NB = 32, T = 2048, CL = 256;
constexpr int NLAT = NB * T, NCTX = NB * CL, NTOK = NLAT + NCTX;
constexpr int PW = 4096;
constexpr int DIN = 6144, DFF = 2752, DFFP = 2816, DFE = 3584, NE = 8;
constexpr float EPS = 1e-6f;
constexpr float LOG2E = 1.4426950408889634f;
constexpr float QSCALE = 0.125f * LOG2E;
constexpr int PC_Q = 0, PC_LF = 512, PC_G = 1024, PC_LB = 1536, PC_K = 2048, PC_V = 2560, PC_RQ = 3072, PC_RI = 3584, PC_GA = 2048, PC_GR = 3072;

constexpr size_t MiB = 1u << 20;
constexpr size_t WS_CTL = 0, CTL_BYTES = 1 * MiB;
constexpr size_t WS_MODS = 1 * MiB;
constexpr size_t WS_LBS = 3 * MiB;
constexpr size_t WS_ROPE = 3 * MiB + 65536;
constexpr size_t WS_ROUTE = 4 * MiB;
constexpr size_t WS_CNT = 6 * MiB;
constexpr size_t WS_CTXRES = 8 * MiB;
constexpr size_t WS_WIN = 40 * MiB;
constexpr size_t WS_WIN8 = 56 * MiB;
constexpr size_t WS_H8 = 809 * MiB;
constexpr size_t WS_WUA = 64 * MiB;
constexpr size_t WS_WUR = 66 * MiB;
constexpr size_t WS_WO = 68 * MiB;
constexpr size_t WS_W13 = 72 * MiB;
constexpr size_t WS_W2 = 83 * MiB;
constexpr size_t WS_H = 89 * MiB;
constexpr size_t WS_P = 233 * MiB;
constexpr size_t WS_MERGED = 89 * MiB;
constexpr size_t WS_HID = 233 * MiB;
constexpr size_t WS_WM13 = 896 * MiB;
constexpr size_t WS_WM2 = 952 * MiB;
constexpr size_t WS_AG = 89 * MiB;
constexpr size_t WS_MHID = 219 * MiB;
constexpr size_t WS_Y = 458 * MiB;
constexpr size_t WS_H2M = 720 * MiB;
constexpr size_t WS_END = 1024 * MiB;
constexpr int MOE_CHUNK = 256;

constexpr int CW_BAR = 4096;

#define LAS __attribute__((address_space(3)))
#define GAS __attribute__((address_space(1)))
typedef unsigned short bf16_t;
typedef short bf16x8 __attribute__((ext_vector_type(8)));
typedef short s16x4 __attribute__((ext_vector_type(4)));
typedef _Float16 half8 __attribute__((ext_vector_type(8)));
typedef _Float16 half4 __attribute__((ext_vector_type(4)));
typedef float f32x4 __attribute__((ext_vector_type(4)));
typedef float f32x2 __attribute__((ext_vector_type(2)));
typedef float f32x16 __attribute__((ext_vector_type(16)));
typedef unsigned u32x4 __attribute__((ext_vector_type(4)));
typedef unsigned u32x2 __attribute__((ext_vector_type(2)));
#define DI __device__ __forceinline__
#define LDS_WAIT() asm volatile("s_waitcnt lgkmcnt(0)" ::: "memory")
#define VM_WAIT() asm volatile("s_waitcnt vmcnt(0)" ::: "memory")
#define LDS_BARRIER() do { asm volatile("s_waitcnt lgkmcnt(0)" ::: "memory"); __builtin_amdgcn_s_barrier(); asm volatile("" ::: "memory"); } while (0)

typedef __bf16 bf16x2_t __attribute__((ext_vector_type(2)));
DI unsigned cvt_pk_bf16(float lo, float hi) { f32x2 v = {lo, hi}; bf16x2_t b = __builtin_convertvector(v, bf16x2_t); return __builtin_bit_cast(unsigned, b); }
typedef int v8i32 __attribute__((ext_vector_type(8)));
typedef int v4i32 __attribute__((ext_vector_type(4)));
DI unsigned pack_fp8x4(float a, float b, float c, float d) {
    a = fminf(fmaxf(a, -448.f), 448.f); b = fminf(fmaxf(b, -448.f), 448.f); c = fminf(fmaxf(c, -448.f), 448.f); d = fminf(fmaxf(d, -448.f), 448.f);
    int w = 0; w = __builtin_amdgcn_cvt_pk_fp8_f32(a, b, w, false); w = __builtin_amdgcn_cvt_pk_fp8_f32(c, d, w, true); return (unsigned)w; }
DI float bf2f(unsigned short b) { return __uint_as_float(((unsigned)b) << 16); }
DI float bflo(unsigned w) { return __uint_as_float(w << 16); }
DI float bfhi(unsigned w) { return __uint_as_float(w & 0xffff0000u); }
DI float fsilu(float x) { return x * __builtin_amdgcn_rcpf(1.f + __expf(-x)); }
DI float fsigmoid(float x) { return __builtin_amdgcn_rcpf(1.f + __expf(-x)); }
DI float wave_sum(float v) {
#pragma unroll
    for (int o = 1; o < 64; o <<= 1) v += __shfl_xor(v, o);
    return v;
}
DI int crow(int r, int hi) { return (r & 3) + 8 * (r >> 2) + 4 * hi; }

constexpr int LDS_WTAB_OFF = 148480 + 128;
DI int my_tid() {
    extern __shared__ __attribute__((aligned(16))) unsigned char lds_raw[];
    const unsigned hw = (unsigned)__builtin_amdgcn_s_getreg((5 << 11) | 4) & 63u;
    const int w = __builtin_amdgcn_readfirstlane(((volatile LAS int*)((LAS unsigned char*)lds_raw + LDS_WTAB_OFF))[hw]);
    int t = w * 64 + (int)__builtin_amdgcn_mbcnt_hi(~0u, __builtin_amdgcn_mbcnt_lo(~0u, 0u));
    asm volatile("" : "+v"(t)); return t;
}
#define XB_TMO      128
#define XB_XCNT(j)  (256  + 64 * (j))
#define XB_XSUB(j)  (1280 + 64 * (j))
#define XB_XGEN(j)  (2304 + 64 * (j))
#define XB_TOP      3328
#define XB_TOPGEN   3392
#define XCD_BAR_WORDS 3456
#define XB_SPIN_CAP (1u << 22)
DI unsigned xb_ld(unsigned* p)              { return __hip_atomic_load(p, __ATOMIC_RELAXED, __HIP_MEMORY_SCOPE_AGENT); }
DI unsigned xb_add(unsigned* p, unsigned v) { return __hip_atomic_fetch_add(p, v, __ATOMIC_RELAXED, __HIP_MEMORY_SCOPE_AGENT); }
DI unsigned xb_xcc_id() { return (unsigned)__builtin_amdgcn_s_getreg((3 << 11) | 20) & 0xFu; }
#define XB_SPIN(cond, bar) do { unsigned _sp = 0; while (cond) { __builtin_amdgcn_s_sleep(1); \
    if ((++_sp & 255u) == 0u) { if (xb_ld(&(bar)[XB_TMO])) break; if (_sp > XB_SPIN_CAP) { atomicAdd(&(bar)[XB_TMO], 1u); break; } } } } while (0)
struct XcdBarrier { unsigned* bar; unsigned x; volatile LAS unsigned* st; };
DI XcdBarrier xcd_barrier_post(unsigned* bar, volatile LAS unsigned* st) {
    XcdBarrier b; b.bar = bar; b.x = xb_xcc_id(); b.st = st;
    if (my_tid() == 0) (void)xb_add(&bar[XB_XCNT(b.x)], 1u);
    return b;
}
DI void xcd_barrier_complete(unsigned* bar, unsigned x, unsigned& nloc, unsigned& nx) {
    const unsigned G = gridDim.x * gridDim.y * gridDim.z;
    unsigned sum, cnt, mine, sp = 0u;
    for (;;) {
        sum = 0u; cnt = 0u; mine = 0u;
#pragma unroll
        for (unsigned j = 0; j < 16; ++j) { const unsigned c = xb_ld(&bar[XB_XCNT(j)]); sum += c; cnt += (c > 0u) ? 1u : 0u; mine = (j == x) ? c : mine; }
        if (sum == G) break;
        __builtin_amdgcn_s_sleep(1);
        if ((++sp & 255u) == 0u) { if (xb_ld(&bar[XB_TMO])) break; if (sp > XB_SPIN_CAP) { atomicAdd(&bar[XB_TMO], 1u); break; } }
    }
    nloc = mine > 0u ? mine : 1u; nx = cnt > 0u ? cnt : 1u;
}
DI void xcd_barrier(const XcdBarrier& b) {
    asm volatile("s_waitcnt vmcnt(0)" ::: "memory");
    __syncthreads();
    if (my_tid() == 0) {
        unsigned* bar = b.bar;
        __builtin_amdgcn_s_waitcnt(0);
        unsigned nloc = b.st[0], nx = b.st[1];
        if (nloc == 0u) { xcd_barrier_complete(bar, b.x, nloc, nx); b.st[0] = nloc; b.st[1] = nx; }
        const unsigned old = xb_add(&bar[XB_XSUB(b.x)], 1u);
        const unsigned gen = old / nloc;
        if (old + 1u == (gen + 1u) * nloc) {
            __builtin_amdgcn_fence(__ATOMIC_RELEASE, "agent");
            asm volatile("s_waitcnt vmcnt(0)" ::: "memory");
            const unsigned og = xb_add(&bar[XB_TOP], 1u);
            const unsigned tg = og / nx;
            if (og + 1u == (tg + 1u) * nx) xb_add(&bar[XB_TOPGEN], 1u);
            else XB_SPIN(xb_ld(&bar[XB_TOPGEN]) == tg, bar);
            __builtin_amdgcn_fence(__ATOMIC_ACQUIRE, "agent");
            xb_add(&bar[XB_XGEN(b.x)], 1u);
            asm volatile("s_waitcnt vmcnt(0)" ::: "memory");
        } else {
            XB_SPIN(xb_ld(&bar[XB_XGEN(b.x)]) == gen, bar);
            __builtin_amdgcn_fence(__ATOMIC_ACQUIRE, "agent");
            asm volatile("s_waitcnt vmcnt(0)" ::: "memory");
        }
    }
    __syncthreads();
}

namespace pg8 {
constexpr int BM = 256, BK = 64, HALF = 128, HTB = HALF * BK * 2, STAGE_BYTES = 8 * HTB, NXCD = 8, WGM = 8;
__host__ __device__ __forceinline__ int lds_byte(int r, int c) { const int st = (r >> 4) * 2 + (c >> 5), rr = r & 15, cc = c & 31, ob = rr * 64 + cc * 2; return st * 1024 + (ob ^ (((ob >> 9) & 1) << 5)); }
__host__ __device__ __forceinline__ void stage_rc(int b, int& R, int& C) { const int st = b / 1024, sb = b % 1024, swz = sb ^ (((sb >> 9) & 1) << 5); R = (st >> 1) * 16 + swz / 64; C = (st & 1) * 32 + (swz % 64) / 2; }
__host__ __device__ __forceinline__ int perm32(int rho) { const int n = rho >> 4, i = rho & 15; return 8 * (i >> 2) + 4 * n + (i & 3); }

struct Unit { int pm, pn; const char* a; const char* b; };
struct Gemm { const bf16_t* A; const bf16_t* Bt; int M, N, K, lda; };

struct StaticOrder {
    int nM, nN, nwg, G, c;
    DI void init(const Gemm& g, int G_, int c_) { nM = g.M / BM; nN = g.N / BM; nwg = nM * nN; G = G_; c = c_; }
    DI bool tile(int i, int& pm, int& pn) const {
        const int L = i * G + c; if (L >= nwg) return false;
        int wgid = L; { const int q = nwg / NXCD, r = nwg % NXCD, xcd = wgid % NXCD, off = wgid / NXCD; wgid = (xcd < r ? xcd * (q + 1) : r * (q + 1) + (xcd - r) * q) + off; }
        const int nig = WGM * nN, gid = wgid / nig, fm = gid * WGM, gsz = (nM - fm) < WGM ? (nM - fm) : WGM;
        pm = fm + ((wgid % nig) % gsz); pn = (wgid % nig) / gsz; return true;
    }
    DI bool next(const Gemm& g, int i, Unit& u) const { if (!tile(i, u.pm, u.pn)) return false;
        u.a = (const char*)g.A + (size_t)u.pm * ((size_t)BM * g.lda * 2); u.b = (const char*)g.Bt + (size_t)u.pn * ((size_t)BM * g.K * 2); return true; }
};
struct MoeOrder {
    StaticOrder so; int p0, apan0; int pb[7]; size_t estride;
    DI void load_pb(const int* pbv) {
#pragma unroll
        for (int k = 0; k < 7; ++k) pb[k] = __builtin_amdgcn_readfirstlane(pbv[k + 1]); }
    DI bool next(const Gemm& g, int i, Unit& u) const {
        int pm, pn; if (!so.tile(i, pm, pn)) return false;
        u.pm = p0 + pm; u.pn = pn; int e = 0;
#pragma unroll
        for (int k = 0; k < 7; ++k) e += (u.pm >= pb[k]) ? 1 : 0;
        u.a = (const char*)g.A + (size_t)(u.pm - apan0) * ((size_t)BM * g.lda * 2); u.b = (const char*)g.Bt + (size_t)e * estride + (size_t)pn * ((size_t)BM * g.K * 2); return true;
    }
};

template <class Epi, class Sched, bool ALIGN_EPI = true, bool F8 = false, bool MIDHOOK = false>
DI void gemm_phase(LAS unsigned char* lds, const Gemm g, const Sched& S, const Epi& E) {
    const int tid_ = my_tid();
    const int tid = tid_, wid = __builtin_amdgcn_readfirstlane(tid >> 6), lane = tid & 63, wr = wid >> 2, wc = wid & 3, fr = lane & 15, fq = lane >> 4;
    const int K = g.K, nt = K / BK;
    unsigned voffA[2], voffB[2];
#pragma unroll
    for (int i = 0; i < 2; ++i) { int R, C; stage_rc(tid * 16 + i * 8192, R, C); const int Rb = Epi::PERM ? ((R & ~31) + perm32(R & 31)) : R;
        voffA[i] = (unsigned)(R * g.lda + C) * 2u; voffB[i] = (unsigned)(Rb * K + C) * 2u; }
    const size_t kstep = (size_t)(BK * 2);
    const size_t hstepA = (size_t)HALF * g.lda * 2, hstepB = (size_t)HALF * K * 2;
    const unsigned ldsw = (unsigned)wid * 1024u;
    const int aoff = lds_byte(wr * 64 + fr, fq * 8), boff = lds_byte(wc * 32 + fr, fq * 8);
#define PG8_SA(b, h) (((b) * 2 + (h)) * HTB)
#define PG8_SB(b, h) ((4 + (b) * 2 + (h)) * HTB)
#define PG8_STAGE(bufoff, gbase, voff) do { _Pragma("unroll") for (int _i = 0; _i < 2; ++_i) \
        __builtin_amdgcn_global_load_lds((const unsigned*)((const char*)(gbase) + (voff)[_i]), (LAS unsigned*)(lds + (bufoff) + ldsw + _i * 8192), 16, 0, 0); } while (0)
#define PG8_LD8(p) __builtin_shufflevector(*(const LAS v4i32*)(p), *(const LAS v4i32*)((p) + 1024), 0, 1, 2, 3, 4, 5, 6, 7)
#define PG8_LDA(dst, b, h) do { if constexpr (F8) { _Pragma("unroll") for (int m = 0; m < 4; ++m) dst##8[m] = PG8_LD8(lds + PG8_SA(b, h) + aoff + m * 2048); } \
        else { _Pragma("unroll") for (int m = 0; m < 4; ++m) _Pragma("unroll") for (int k = 0; k < 2; ++k) dst[m][k] = *(const LAS bf16x8*)(lds + PG8_SA(b, h) + aoff + m * 2048 + k * 1024); } } while (0)
#define PG8_LDB(dst, b, h) do { if constexpr (F8) { _Pragma("unroll") for (int n = 0; n < 2; ++n) dst##8[n] = PG8_LD8(lds + PG8_SB(b, h) + boff + n * 2048); } \
        else { _Pragma("unroll") for (int n = 0; n < 2; ++n) _Pragma("unroll") for (int k = 0; k < 2; ++k) dst[n][k] = *(const LAS bf16x8*)(lds + PG8_SB(b, h) + boff + n * 2048 + k * 1024); } } while (0)
#define PG8_MMA(ai, bj, At, Bt) do { __builtin_amdgcn_s_setprio(1); \
        if constexpr (F8) { _Pragma("unroll") for (int m = 0; m < 4; ++m) _Pragma("unroll") for (int n = 0; n < 2; ++n) \
            asm volatile("v_mfma_scale_f32_16x16x128_f8f6f4 %0, %1, %2, %0, %3, %3 op_sel_hi:[0,0,0]" : "+v"(acc[ai][bj][m][n]) : "v"(Bt##8[n]), "v"(At##8[m]), "v"(one8)); } \
        else { _Pragma("unroll") for (int m = 0; m < 4; ++m) _Pragma("unroll") for (int n = 0; n < 2; ++n) _Pragma("unroll") for (int k = 0; k < 2; ++k) \
            acc[ai][bj][m][n] = __builtin_amdgcn_mfma_f32_16x16x32_bf16(Bt[n][k], At[m][k], acc[ai][bj][m][n], 0, 0, 0); } \
        __builtin_amdgcn_s_setprio(0); } while (0)
#define PG8_WAIT_V(n) asm volatile("s_waitcnt vmcnt(" #n ")" ::: "memory")
#define PG8_WAIT_VX(n) asm volatile("s_waitcnt vmcnt(%0)" :: "n"(n) : "memory")
#define PG8_WAIT_L(n) asm volatile("s_waitcnt lgkmcnt(" #n ")" ::: "memory")
#define PG8_BAR __builtin_amdgcn_s_barrier()
#define PG8_SCHED __builtin_amdgcn_sched_barrier(0)
    Unit cur, nxt; int ui = 0;
    if (!S.next(g, 0, cur)) return;
    f32x4 acc[2][2][4][2];
#pragma unroll
    for (int a = 0; a < 2; ++a)
#pragma unroll
        for (int b = 0; b < 2; ++b)
#pragma unroll
            for (int m = 0; m < 4; ++m)
#pragma unroll
                for (int n = 0; n < 2; ++n) acc[a][b][m][n] = (f32x4){0.f, 0.f, 0.f, 0.f};
    bf16x8 At[4][2], B0[2][2], B1[2][2]; v8i32 At8[4], B08[2], B18[2]; const int one8 = 0x7F7F7F7F;
    const char* cA = cur.a; const char* cB = cur.b;
    PG8_STAGE(PG8_SB(0, 0), cB, voffB); PG8_STAGE(PG8_SB(0, 1), cB + hstepB, voffB); PG8_STAGE(PG8_SA(0, 0), cA, voffA); PG8_STAGE(PG8_SA(0, 1), cA + hstepA, voffA);
    if (wr == 1) PG8_BAR;
    PG8_WAIT_V(2); PG8_BAR;
    PG8_STAGE(PG8_SB(1, 0), cB + kstep, voffB); PG8_STAGE(PG8_SA(1, 0), cA + kstep, voffA); PG8_STAGE(PG8_SB(1, 1), cB + hstepB + kstep, voffB);
    PG8_WAIT_V(6); PG8_BAR;
    for (;;) {
        const bool has_next = S.next(g, ui + 1, nxt);
        const char* nA = has_next ? nxt.a : cA; const char* nB = has_next ? nxt.b : cB;
        for (int t = 0; t < nt; t += 2) {
            const bool last = (t == nt - 2);
            if constexpr (MIDHOOK) { PG8_SCHED; if (t == nt / 2) E.mid(acc, cur, wr, wc, fr, fq); PG8_SCHED; }
            const char* a1 = cA + (size_t)(t + 1) * kstep;
            const char* a2 = last ? nA : cA + (size_t)(t + 2) * kstep; const char* b2 = last ? nB : cB + (size_t)(t + 2) * kstep;
            const char* a3 = a2 + kstep; const char* b3 = b2 + kstep;
            const int relax = __builtin_amdgcn_readfirstlane(((t == 0) && (ui > 0)) ? 1 : 0);
#define PG8_WAIT_V8R asm volatile("s_cmp_lg_u32 %0, 0\n\ts_cbranch_scc1 1f\n\ts_waitcnt vmcnt(8)\n1:\n\ts_waitcnt vmcnt(%1)" :: "s"(relax), "n"(8 + Epi::NVM) : "memory", "scc")
            PG8_LDB(B0, 0, 0); PG8_LDB(B1, 0, 1); PG8_SCHED; PG8_LDA(At, 0, 0); PG8_STAGE(PG8_SA(1, 1), a1 + hstepA, voffA);
            PG8_WAIT_V8R; PG8_WAIT_L(0); PG8_BAR; PG8_MMA(0, 0, At, B0); PG8_MMA(0, 1, At, B1); PG8_BAR; PG8_SCHED;
            PG8_LDA(At, 0, 1); PG8_STAGE(PG8_SB(0, 0), b2, voffB); PG8_STAGE(PG8_SB(0, 1), b2 + hstepB, voffB); PG8_STAGE(PG8_SA(0, 0), a2, voffA);
            PG8_WAIT_V8R; PG8_WAIT_L(0); PG8_BAR; PG8_MMA(1, 0, At, B0); PG8_MMA(1, 1, At, B1); PG8_BAR; PG8_SCHED;
            PG8_LDB(B0, 1, 0); PG8_LDB(B1, 1, 1); PG8_SCHED; PG8_LDA(At, 1, 0); PG8_STAGE(PG8_SA(0, 1), a2 + hstepA, voffA);
            PG8_WAIT_V(8); PG8_WAIT_L(0); PG8_BAR; PG8_MMA(0, 0, At, B0); PG8_MMA(0, 1, At, B1); PG8_BAR; PG8_SCHED;
            PG8_LDA(At, 1, 1); PG8_STAGE(PG8_SB(1, 0), b3, voffB); PG8_STAGE(PG8_SB(1, 1), b3 + hstepB, voffB); PG8_STAGE(PG8_SA(1, 0), a3, voffA);
            PG8_WAIT_V(8); PG8_WAIT_L(0); PG8_BAR; PG8_MMA(1, 0, At, B0); PG8_MMA(1, 1, At, B1); PG8_BAR; PG8_SCHED;
#undef PG8_WAIT_V8R
        }
        if constexpr (ALIGN_EPI) { if (wr == 0) PG8_BAR; }
        if constexpr (F8) asm volatile("s_nop 15\n\ts_nop 15" ::: "memory");
        E(acc, cur, wr, wc, fr, fq);
        if (!has_next) break;
#pragma unroll
        for (int a = 0; a < 2; ++a)
#pragma unroll
            for (int b = 0; b < 2; ++b)
#pragma unroll
                for (int m = 0; m < 4; ++m)
#pragma unroll
                    for (int n = 0; n < 2; ++n) acc[a][b][m][n] = (f32x4){0.f, 0.f, 0.f, 0.f};
        cur = nxt; cA = nA; cB = nB; ++ui;
        if constexpr (ALIGN_EPI) { if (wr == 1) PG8_BAR; }
    }
    PG8_WAIT_V(0);
    if constexpr (!ALIGN_EPI) { if (wr == 0) PG8_BAR; }
    PG8_BAR;
#undef PG8_SA
#undef PG8_SB
#undef PG8_STAGE
#undef PG8_LDA
#undef PG8_LD8
#undef PG8_LDB
#undef PG8_MMA
#undef PG8_WAIT_V
#undef PG8_WAIT_VX
#undef PG8_WAIT_L
#undef PG8_BAR
#undef PG8_SCHED
}
}
using pg8::Unit; using pg8::Gemm;
typedef const f32x4 (&AccRef)[2][2][4][2];

DI u32x4 pack8(const f32x4& v0, const f32x4& v1) { u32x4 w; w.x = cvt_pk_bf16(v0[0], v0[1]); w.y = cvt_pk_bf16(v0[2], v0[3]); w.z = cvt_pk_bf16(v1[0], v1[1]); w.w = cvt_pk_bf16(v1[2], v1[3]); return w; }
DI void unpack8(const u32x4& w, float (&f)[8]) { f[0] = bflo(w.x); f[1] = bfhi(w.x); f[2] = bflo(w.y); f[3] = bfhi(w.y); f[4] = bflo(w.z); f[5] = bfhi(w.z); f[6] = bflo(w.w); f[7] = bfhi(w.w); }

struct EpiInProj {
    static constexpr int NVM = 16; static constexpr bool PERM = true;
    bf16_t* P; const float2* rope; const float* lbf; const float* lbb; int secmap; float asc;
    template <int MODE> DI void run(AccRef acc, const Unit& u, int wr, int wc, int fr, int fq, int sec) const {
        const int row0 = u.pm * 256 + wr * 64 + fr, col0 = sec * 512 + (u.pn & 1) * 256 + wc * 32 + 8 * fq;
        const bool lat = u.pm < (NLAT / 256); const float qs = sec == 0 ? QSCALE : 1.f;
        f32x4 lb0[2], lb1[2];
        if (MODE == 2) {
#pragma unroll
            for (int bj = 0; bj < 2; ++bj) { const float* lb = (sec == 1 ? lbf : lbb) + ((col0 + bj * 128) & 511); lb0[bj] = *(const f32x4*)lb; lb1[bj] = *(const f32x4*)(lb + 4); } }
        f32x4 rr[2][4][2];
        if (MODE == 3) {
#pragma unroll
            for (int ai = 0; ai < 2; ++ai)
#pragma unroll
                for (int m = 0; m < 4; ++m) { const f32x4* rp = (const f32x4*)(rope + (size_t)((row0 + ai * 128 + m * 16) & (T - 1)) * 32 + ((col0 & 63) >> 1));
                    rr[ai][m][0] = lat ? rp[0] : (f32x4){1.f, 0.f, 1.f, 0.f}; rr[ai][m][1] = lat ? rp[1] : (f32x4){1.f, 0.f, 1.f, 0.f}; } }
#pragma unroll
        for (int ai = 0; ai < 2; ++ai)
#pragma unroll
            for (int m = 0; m < 4; ++m) {
                const int row = row0 + ai * 128 + m * 16; bf16_t* rowp = P + (size_t)row * PW + col0;
#pragma unroll
                for (int bj = 0; bj < 2; ++bj) {
                    f32x4 v0 = acc[ai][bj][m][0] * asc, v1 = acc[ai][bj][m][1] * asc; u32x4 w;
                    if (MODE == 3) {
                        {
                            const f32x4 r0 = rr[ai][m][0], r1 = rr[ai][m][1];
                            f32x4 o0, o1;
                            o0[0] = v0[0] * r0[0] - v0[1] * r0[1]; o0[1] = v0[0] * r0[1] + v0[1] * r0[0];
                            o0[2] = v0[2] * r0[2] - v0[3] * r0[3]; o0[3] = v0[2] * r0[3] + v0[3] * r0[2];
                            o1[0] = v1[0] * r1[0] - v1[1] * r1[1]; o1[1] = v1[0] * r1[1] + v1[1] * r1[0];
                            o1[2] = v1[2] * r1[2] - v1[3] * r1[3]; o1[3] = v1[2] * r1[3] + v1[3] * r1[2];
                            v0 = o0; v1 = o1;
                        }
                        w = pack8(v0 * qs, v1 * qs);
                    } else if (MODE == 1) {
#pragma unroll
                        for (int j = 0; j < 4; ++j) { v0[j] = fsilu(v0[j]); v1[j] = fsilu(v1[j]); }
                        w = pack8(v0, v1);
                    } else if (MODE == 2) {
                        half8 hv;
#pragma unroll
                        for (int j = 0; j < 8; ++j) {
                            const float z = fmaxf(j < 4 ? v0[j] : v1[j - 4], -80.f), b = j < 4 ? lb0[bj][j] : lb1[bj][j - 4];
                            const float sg = __builtin_amdgcn_rcpf(1.f + __builtin_amdgcn_exp2f(-LOG2E * z));
                            hv[j] = (_Float16)(0.6931471805599453f * __builtin_amdgcn_logf(b + (1.f - b) * sg));
                        }
                        w = __builtin_bit_cast(u32x4, hv);
                    } else w = pack8(v0, v1);
                    *(u32x4*)(rowp + bj * 128) = w;
                }
            }
    }
    DI void operator()(AccRef acc, const Unit& u, int wr, int wc, int fr, int fq) const {
        const int sec = (secmap >> (4 * (u.pn >> 1))) & 15;
        if (sec == 0 || sec == 4) run<3>(acc, u, wr, wc, fr, fq, sec);
        else if (sec == 2 || sec == 6) run<1>(acc, u, wr, wc, fr, fq, sec);
        else if (sec == 1 || sec == 3) run<2>(acc, u, wr, wc, fr, fq, sec);
        else run<0>(acc, u, wr, wc, fr, fq, sec);
    }
};
struct EpiGates {
    static constexpr int NVM = 16; static constexpr bool PERM = true; bf16_t* P; float asc;
    DI void operator()(AccRef acc, const Unit& u, int wr, int wc, int fr, int fq) const {
        const int row0 = u.pm * 256 + wr * 64 + fr, col0 = PC_GA + u.pn * 256 + wc * 32 + 8 * fq;
#pragma unroll
        for (int ai = 0; ai < 2; ++ai)
#pragma unroll
            for (int m = 0; m < 4; ++m) { bf16_t* rowp = P + (size_t)(row0 + ai * 128 + m * 16) * PW + col0;
#pragma unroll
                for (int bj = 0; bj < 2; ++bj) { f32x4 v0 = acc[ai][bj][m][0] * asc, v1 = acc[ai][bj][m][1] * asc;
#pragma unroll
                    for (int j = 0; j < 4; ++j) { v0[j] = fsigmoid(v0[j]); v1[j] = fsigmoid(v1[j]); }
                    *(u32x4*)(rowp + bj * 128) = pack8(v0, v1); } }
    }
};
struct EpiMergeFused {
    static constexpr int NVM = 16; static constexpr bool PERM = true; const bf16_t* P; bf16_t* O;
    DI void mid(f32x4 (&acc)[2][2][4][2], const Unit& u, int wr, int wc, int fr, int fq) const {
        int row0 = u.pm * 256 + wr * 64 + fr, col0 = u.pn * 256 + wc * 32 + 8 * fq;
        asm volatile("" : "+v"(row0), "+v"(col0));
#pragma unroll
        for (int ai = 0; ai < 2; ++ai)
#pragma unroll
            for (int m = 0; m < 4; ++m) { const size_t row = (size_t)(row0 + ai * 128 + m * 16);
#pragma unroll
                for (int bj = 0; bj < 2; ++bj) {
                    float ga[8], gr[8]; unpack8(*(const u32x4*)(P + row * PW + PC_GA + col0 + bj * 128), ga); unpack8(*(const u32x4*)(P + row * PW + PC_GR + col0 + bj * 128), gr);
#pragma unroll
                    for (int j = 0; j < 4; ++j) { acc[ai][bj][m][0][j] *= ga[j] * __builtin_amdgcn_rcpf(fmaxf(gr[j], 1e-30f)); acc[ai][bj][m][1][j] *= ga[4 + j] * __builtin_amdgcn_rcpf(fmaxf(gr[4 + j], 1e-30f)); } }
                asm volatile("" ::: "memory"); }
    }
    DI void operator()(AccRef acc, const Unit& u, int wr, int wc, int fr, int fq) const {
        const int row0 = u.pm * 256 + wr * 64 + fr, col0 = u.pn * 256 + wc * 32 + 8 * fq;
        u32x4 gq[2][4][2];
#pragma unroll
        for (int ai = 0; ai < 2; ++ai)
#pragma unroll
            for (int m = 0; m < 4; ++m)
#pragma unroll
                for (int bj = 0; bj < 2; ++bj) gq[ai][m][bj] = *(const u32x4*)(P + (size_t)(row0 + ai * 128 + m * 16) * PW + PC_GR + col0 + bj * 128);
#pragma unroll
        for (int ai = 0; ai < 2; ++ai)
#pragma unroll
            for (int m = 0; m < 4; ++m) { const size_t row = (size_t)(row0 + ai * 128 + m * 16);
#pragma unroll
                for (int bj = 0; bj < 2; ++bj) {
                    float gr[8]; unpack8(gq[ai][m][bj], gr);
                    f32x4 v0 = acc[ai][bj][m][0], v1 = acc[ai][bj][m][1];
#pragma unroll
                    for (int j = 0; j < 4; ++j) { v0[j] *= fmaxf(gr[j], 1e-30f); v1[j] *= fmaxf(gr[4 + j], 1e-30f); }
                    *(u32x4*)(O + row * D + col0 + bj * 128) = pack8(v0, v1); } }
    }
};
struct EpiResid {
    static constexpr int NVM = 16; static constexpr bool PERM = false;
    const float* xin_l; const float* xin_c; float* xout_l; float* xout_c; const float* mods; int msel;
    DI void operator()(AccRef acc, const Unit& u, int wr, int wc, int fr, int fq) const {
        const bool lat = u.pm < (NLAT / 256);
        const int rbase = (lat ? u.pm : u.pm - NLAT / 256) * 256 + wr * 64 + fr, col0 = u.pn * 256 + wc * 32 + 4 * fq;
        const float* xi = lat ? xin_l : xin_c; float* xo = lat ? xout_l : xout_c;
        const float* mv = mods + (size_t)(lat ? (u.pm >> 3) : 32) * DIN + msel * D + col0;
        f32x4 g[2][2];
#pragma unroll
        for (int bj = 0; bj < 2; ++bj)
#pragma unroll
            for (int n = 0; n < 2; ++n) g[bj][n] = *(const f32x4*)(mv + bj * 128 + n * 16);
        f32x4 xa[4][2][2], r0[4][2][2];
#define RES_OFF(ai, m) ((size_t)(rbase + (ai) * 128 + (m) * 16) * D + col0)
#pragma unroll
        for (int m = 0; m < 4; ++m)
#pragma unroll
            for (int bj = 0; bj < 2; ++bj)
#pragma unroll
                for (int n = 0; n < 2; ++n) xa[m][bj][n] = *(const f32x4*)(xi + RES_OFF(0, m) + bj * 128 + n * 16);
#pragma unroll
        for (int m = 0; m < 4; ++m)
#pragma unroll
            for (int bj = 0; bj < 2; ++bj)
#pragma unroll
                for (int n = 0; n < 2; ++n) r0[m][bj][n] = xa[m][bj][n] + g[bj][n] * acc[0][bj][m][n];
#pragma unroll
        for (int m = 0; m < 4; ++m)
#pragma unroll
            for (int bj = 0; bj < 2; ++bj)
#pragma unroll
                for (int n = 0; n < 2; ++n) xa[m][bj][n] = *(const f32x4*)(xi + RES_OFF(1, m) + bj * 128 + n * 16);
        asm volatile("" ::: "memory");
#pragma unroll
        for (int m = 0; m < 4; ++m)
#pragma unroll
            for (int bj = 0; bj < 2; ++bj)
#pragma unroll
                for (int n = 0; n < 2; ++n) *(f32x4*)(xo + RES_OFF(0, m) + bj * 128 + n * 16) = r0[m][bj][n];
#pragma unroll
        for (int m = 0; m < 4; ++m)
#pragma unroll
            for (int bj = 0; bj < 2; ++bj)
#pragma unroll
                for (int n = 0; n < 2; ++n) *(f32x4*)(xo + RES_OFF(1, m) + bj * 128 + n * 16) = xa[m][bj][n] + g[bj][n] * acc[1][bj][m][n];
#undef RES_OFF
    }
};
struct EpiSwiglu {
    static constexpr int NVM = 16; static constexpr bool PERM = true; bf16_t* Hd; int ldh; int pan0;
    DI void operator()(AccRef acc, const Unit& u, int wr, int wc, int fr, int fq) const {
        const int row0 = (u.pm - pan0) * 256 + wr * 64 + fr, hc0 = u.pn * 128 + wc * 16 + 4 * fq;
#pragma unroll
        for (int ai = 0; ai < 2; ++ai)
#pragma unroll
            for (int m = 0; m < 4; ++m) { bf16_t* rowp = Hd + (size_t)(row0 + ai * 128 + m * 16) * ldh + hc0;
#pragma unroll
                for (int bj = 0; bj < 2; ++bj) { const f32x4 a = acc[ai][bj][m][0], b = acc[ai][bj][m][1];
                    u32x2 w; w.x = cvt_pk_bf16(fsilu(a[0]) * b[0], fsilu(a[1]) * b[1]); w.y = cvt_pk_bf16(fsilu(a[2]) * b[2], fsilu(a[3]) * b[3]);
                    *(u32x2*)(rowp + bj * 64) = w; } }
    }
};
struct EpiSwiglu8 {
    static constexpr int NVM = 16; static constexpr bool PERM = true; unsigned char* Hd; int ldh; int pan0; float as, hs;
    DI void operator()(AccRef acc, const Unit& u, int wr, int wc, int fr, int fq) const {
        const int row0 = (u.pm - pan0) * 256 + wr * 64 + fr, hc0 = u.pn * 128 + wc * 16 + 4 * fq;
#pragma unroll
        for (int ai = 0; ai < 2; ++ai)
#pragma unroll
            for (int m = 0; m < 4; ++m) { unsigned char* rowp = Hd + (size_t)(row0 + ai * 128 + m * 16) * ldh + hc0;
#pragma unroll
                for (int bj = 0; bj < 2; ++bj) { const f32x4 a = acc[ai][bj][m][0] * as, b = acc[ai][bj][m][1] * (as * hs);
                    *(unsigned*)(rowp + bj * 64) = pack_fp8x4(fsilu(a[0]) * b[0], fsilu(a[1]) * b[1], fsilu(a[2]) * b[2], fsilu(a[3]) * b[3]); } }
    }
};
struct EpiBf16 {
    static constexpr int NVM = 16; static constexpr bool PERM = true; bf16_t* O; int ldc; float sc;
    DI void operator()(AccRef acc, const Unit& u, int wr, int wc, int fr, int fq) const {
        const int row0 = u.pm * 256 + wr * 64 + fr, col0 = u.pn * 256 + wc * 32 + 8 * fq;
#pragma unroll
        for (int ai = 0; ai < 2; ++ai)
#pragma unroll
            for (int m = 0; m < 4; ++m) { bf16_t* rowp = O + (size_t)(row0 + ai * 128 + m * 16) * ldc + col0;
#pragma unroll
                for (int bj = 0; bj < 2; ++bj) *(u32x4*)(rowp + bj * 128) = pack8(acc[ai][bj][m][0] * sc, acc[ai][bj][m][1] * sc); }
    }
};

typedef short v4i16 __attribute__((ext_vector_type(4)));
DI s16x4 tr16(const LAS unsigned char* p) { return __builtin_bit_cast(s16x4, __builtin_amdgcn_ds_read_tr16_b64_v4i16((LAS v4i16*)p)); }
DI bf16x8 cat8(s16x4 lo, s16x4 hi) { return __builtin_shufflevector(lo, hi, 0, 1, 2, 3, 4, 5, 6, 7); }
DI void dma16(const void* g, LAS unsigned char* l) { __builtin_amdgcn_global_load_lds((const unsigned*)g, (LAS unsigned*)l, 16, 0, 0); }
DI void dma16a(const void* g, LAS unsigned char* l) {
    const unsigned la = __builtin_amdgcn_readfirstlane((unsigned)(size_t)l);
    asm volatile("s_mov_b32 m0, %1\n\ts_nop 0\n\tglobal_load_lds_dwordx4 %0, off" :: "v"(g), "s"(la) : "memory", "m0");
}
DI bf16x8 packf8(const f32x16& x, int s) {
    u32x4 w; w.x = cvt_pk_bf16(x[8 * s], x[8 * s + 1]); w.y = cvt_pk_bf16(x[8 * s + 2], x[8 * s + 3]); w.z = cvt_pk_bf16(x[8 * s + 4], x[8 * s + 5]); w.w = cvt_pk_bf16(x[8 * s + 6], x[8 * s + 7]);
    return __builtin_bit_cast(bf16x8, w);
}
#define MFMA32(a, b, c) __builtin_amdgcn_mfma_f32_32x32x16_bf16((a), (b), (c), 0, 0, 0)

struct Params { const float* in[28]; float* out; unsigned char* ws; int ph_lo, ph_hi, li, pad; };
typedef const __attribute__((address_space(4))) Params* KP;
DI KP kparams() { KP kp = (KP)__builtin_amdgcn_kernarg_segment_ptr(); asm volatile("" : "+s"(kp)); return kp; }
#define PIN(k) (kparams()->in[k])
#define POUT (kparams()->out)
struct Ctx {
    LAS unsigned char* lds; unsigned char* ws; int tid, lane, wave, vcu, G, gw, NGW, bx;
};

constexpr float WIN8_SCALE = 64.f;
#ifndef FP8_SECS0
#define FP8_SECS0 0x00
#endif
#ifndef FP8_SECS1
#define FP8_SECS1 0xE4
#endif
constexpr int sec_order(int i) { return (int)((0x76524310u >> (4 * i)) & 15u); }
constexpr int sec_slot(int fs, int ps) { int nb = 0, nf = 0; for (int i = 0; i < 8; ++i) { const int s_ = sec_order(i); const bool f = (fs >> s_) & 1; if (s_ == ps) return f ? (0x100 | nf) : nb; if (f) ++nf; else ++nb; } return 0; }
constexpr int n_sec_f8(int fs) { return __builtin_popcount((unsigned)fs); }
constexpr unsigned secmap_of(int fs, bool f8) { unsigned m = 0; int k = 0; for (int i = 0; i < 8; ++i) { const int s_ = sec_order(i); if ((((fs >> s_) & 1) != 0) == f8) { m |= (unsigned)s_ << (4 * k); ++k; } } return m; }
DI int map_row(int kind, int n, int fs) {
    if (kind == 0) return n;
    if (kind == 2) return 8 * (n >> 2) + (n & 3);
    if (kind == 3) return 8 * (n >> 2) + (n & 3) + 4;
    const int sec = n >> 9, j = n & 511; int r;
    if (n >= 4096) r = (1 << 16) | (n_sec_f8(fs) * 512 + (n - 4096));
    else {
        const int ps = sec == 0 ? 0 : sec == 1 ? 4 : sec == 2 ? 5 : sec == 3 ? 6 : sec == 4 ? 7 : sec == 5 ? 1 : sec == 6 ? 3 : 2;
        const int sl = sec_slot(fs, ps); int jj = j;
        if (sec == 0 || sec == 1) { const int hs = j >> 6, d = j & 63; jj = hs * 64 + (d < 32 ? 2 * d : 2 * (d - 32) + 1); }
        r = ((sl & 0x100) ? (1 << 16) : 0) | ((sl & 0xff) * 512 + jj); }
    return kind == 4 ? (r & 0xffff) : r;
}
constexpr int TP_PITCH = 68, TP_SCR = 64 * TP_PITCH * 4;
DI void transpose_load(const float* W, int ldw, int k0, int n0, LAS float* scr, int lane) {
    const int r = lane >> 4, c4 = (lane & 15) * 4; f32x4 v[16];
#pragma unroll
    for (int i = 0; i < 16; ++i) v[i] = *(const f32x4*)(W + (size_t)(k0 + 4 * i + r) * ldw + n0 + c4);
#pragma unroll
    for (int i = 0; i < 16; ++i) *(LAS f32x4*)(scr + (4 * i + r) * TP_PITCH + c4) = v[i];
    LDS_WAIT(); asm volatile("" ::: "memory");
}
DI void transpose_item(const float* W, int ldw, int k0, int n0, bf16_t* WT, int ldt, int kind, LAS float* scr, int lane, int fs = 0) {
    transpose_load(W, ldw, k0, n0, scr, lane);
    bf16_t* dst = WT + (size_t)map_row(kind, n0 + lane, fs) * ldt + k0;
#pragma unroll
    for (int j = 0; j < 8; ++j) { const LAS float* s = scr + (8 * j) * TP_PITCH + lane;
        u32x4 o; o.x = cvt_pk_bf16(s[0], s[TP_PITCH]); o.y = cvt_pk_bf16(s[2 * TP_PITCH], s[3 * TP_PITCH]); o.z = cvt_pk_bf16(s[4 * TP_PITCH], s[5 * TP_PITCH]); o.w = cvt_pk_bf16(s[6 * TP_PITCH], s[7 * TP_PITCH]);
        *(u32x4*)(dst + 8 * j) = o; }
    LDS_WAIT(); asm volatile("" ::: "memory");
}
DI void transpose_item8(const float* W, int ldw, int k0, int n0, unsigned char* WT, int ldt, int kind, float sc, LAS float* scr, int lane, int fs = 0) {
    transpose_load(W, ldw, k0, n0, scr, lane);
    unsigned char* dst = WT + (size_t)map_row(kind, n0 + lane, fs) * ldt + k0;
#pragma unroll
    for (int j = 0; j < 4; ++j) { const LAS float* s = scr + (16 * j) * TP_PITCH + lane; u32x4 o;
        o.x = pack_fp8x4(s[0] * sc, s[TP_PITCH] * sc, s[2 * TP_PITCH] * sc, s[3 * TP_PITCH] * sc); o.y = pack_fp8x4(s[4 * TP_PITCH] * sc, s[5 * TP_PITCH] * sc, s[6 * TP_PITCH] * sc, s[7 * TP_PITCH] * sc);
        o.z = pack_fp8x4(s[8 * TP_PITCH] * sc, s[9 * TP_PITCH] * sc, s[10 * TP_PITCH] * sc, s[11 * TP_PITCH] * sc); o.w = pack_fp8x4(s[12 * TP_PITCH] * sc, s[13 * TP_PITCH] * sc, s[14 * TP_PITCH] * sc, s[15 * TP_PITCH] * sc);
        *(u32x4*)(dst + 16 * j) = o; }
    LDS_WAIT(); asm volatile("" ::: "memory");
}
DI void transpose_matrix8(const Ctx& C, const float* W, int K, int N, unsigned char* WT, int ldt, int kind, float sc, int& itbase) {
    LAS float* scr = (LAS float*)(C.lds + C.wave * TP_SCR);
    const int nblk = N / 64, nit = (K / 64) * nblk;
    int first = (C.gw - (itbase % C.NGW) + C.NGW) % C.NGW;
    for (int it = first; it < nit; it += C.NGW) transpose_item8(W, N, 64 * (it / nblk), 64 * (it % nblk), WT, ldt, kind, sc, scr, C.lane);
    itbase += nit;
}
DI void transpose_matrix(const Ctx& C, const float* W, int K, int N, bf16_t* WT, int ldt, int kind, int& itbase, int total_unused) {
    (void)total_unused;
    LAS float* scr = (LAS float*)(C.lds + C.wave * TP_SCR);
    const int nblk = N / 64, nit = (K / 64) * nblk;
    int first = (C.gw - (itbase % C.NGW) + C.NGW) % C.NGW;
    for (int it = first; it < nit; it += C.NGW) transpose_item(W, N, 64 * (it / nblk), 64 * (it % nblk), WT, ldt, kind, scr, C.lane);
    itbase += nit;
}
DI void transpose_win(const Ctx& C, const float* W, bf16_t* WA, unsigned char* W8, int& itbase, int fs) {
    LAS float* scr = (LAS float*)(C.lds + C.wave * TP_SCR);
    const int nblk = DIN / 64, nit = (D / 64) * nblk;
    int first = (C.gw - (itbase % C.NGW) + C.NGW) % C.NGW;
    for (int it = first; it < nit; it += C.NGW) { const int k0 = 64 * (it / nblk), n0 = 64 * (it % nblk);
        if (map_row(1, n0, fs) >> 16) transpose_item8(W, DIN, k0, n0, W8, D, 4, WIN8_SCALE, scr, C.lane, fs);
        else transpose_item(W, DIN, k0, n0, WA, D, 1, scr, C.lane, fs); }
    itbase += nit;
}
constexpr int MD_SP = 36;
DI void phase_mods(const Ctx& C) {
    if (C.bx >= 2 * 96) return;
    const int l = C.bx / 96, n0 = (C.bx % 96) * 64, kq = C.lane >> 4, cq = C.lane & 15;
    LAS float* S = (LAS float*)C.lds;
    const float* W = PIN(4) + (size_t)l * D * DIN + n0 + 4 * cq; const float* c0 = PIN(1); const float* cc = PIN(3);
    f32x4 acc[33];
#pragma unroll
    for (int r = 0; r < 33; ++r) acc[r] = (f32x4){0.f, 0.f, 0.f, 0.f};
#pragma unroll 1
    for (int kh = 0; kh < 2; ++kh) {
        __syncthreads();
        for (int i = C.tid; i < 33 * 512; i += 512) { const int r = i >> 9, kk = i & 511; S[kk * MD_SP + r] = fsilu(r < 32 ? c0[r * D + kh * 512 + kk] : cc[kh * 512 + kk]); }
        __syncthreads();
        const int kb = C.wave * 64 + kq;
#pragma unroll 1
        for (int ib = 0; ib < 16; ib += 8) { f32x4 w[8];
#pragma unroll
            for (int i = 0; i < 8; ++i) w[i] = *(const f32x4*)(W + (size_t)(kh * 512 + kb + 4 * (ib + i)) * DIN);
#pragma unroll
            for (int i = 0; i < 8; ++i) { const LAS float* sp = S + (kb + 4 * (ib + i)) * MD_SP;
#pragma unroll
                for (int q = 0; q < 8; ++q) { const f32x4 s4 = *(const LAS f32x4*)(sp + 4 * q);
                    acc[4 * q] += w[i] * s4[0]; acc[4 * q + 1] += w[i] * s4[1]; acc[4 * q + 2] += w[i] * s4[2]; acc[4 * q + 3] += w[i] * s4[3]; }
                acc[32] += w[i] * sp[32]; } }
    }
#pragma unroll
    for (int r = 0; r < 33; ++r)
#pragma unroll
        for (int j = 0; j < 4; ++j) { float v = acc[r][j]; v += __shfl_xor(v, 16); v += __shfl_xor(v, 32); asm volatile("" : "+v"(v)); acc[r][j] = v; }
    __syncthreads();
    LAS float* red = (LAS float*)C.lds;
    if (kq == 0) {
#pragma unroll
        for (int r = 0; r < 33; ++r) *(LAS f32x4*)(red + (C.wave * 33 + r) * 64 + 4 * cq) = acc[r]; }
    __syncthreads();
    float* mods = (float*)(C.ws + WS_MODS);
    for (int o = C.tid; o < 33 * 64; o += 512) { const int r = o >> 6, c = o & 63; float v = PIN(5)[l * DIN + n0 + c];
#pragma unroll
        for (int w8 = 0; w8 < 8; ++w8) v += red[(w8 * 33 + r) * 64 + c];
        mods[(size_t)(l * 33 + r) * DIN + n0 + c] = v; }
    __syncthreads();
}
DI void phase_prologue(const Ctx& C) {
    unsigned char* ws = C.ws;
    int itb = 0;
    for (int l = 0; l < 2; ++l) {
        transpose_win(C, PIN(8) + (size_t)l * D * DIN, (bf16_t*)(ws + WS_WIN) + (size_t)l * 4096 * D, ws + WS_WIN8 + (size_t)l * 4096 * D, itb, l == 0 ? FP8_SECS0 : FP8_SECS1);
        transpose_matrix(C, PIN(17) + (size_t)l * 512 * D, 512, D, (bf16_t*)(ws + WS_WUA) + (size_t)l * D * D, D, 0, itb, 0);
        transpose_matrix(C, PIN(18) + (size_t)l * 512 * D, 512, D, (bf16_t*)(ws + WS_WUA) + (size_t)l * D * D + 512, D, 0, itb, 0);
        transpose_matrix(C, PIN(19) + (size_t)l * D * D, D, D, (bf16_t*)(ws + WS_WO) + (size_t)l * D * D, D, 0, itb, 0);
    }
    transpose_matrix(C, PIN(20), D, DFF, (bf16_t*)(ws + WS_W13), D, 2, itb, 0);
    transpose_matrix(C, PIN(21), D, DFF, (bf16_t*)(ws + WS_W13), D, 3, itb, 0);
    transpose_matrix(C, PIN(22), DFF, D, (bf16_t*)(ws + WS_W2), DFFP, 0, itb, 0);
    { const int gt = C.vcu * 512 + C.tid, NT = C.G * 512;
      bf16_t* w13 = (bf16_t*)(ws + WS_W13) + (size_t)(2 * DFF) * D;
      for (int i = gt; i < (2 * DFFP - 2 * DFF) * D / 8; i += NT) ((u32x4*)w13)[i] = (u32x4){0u, 0u, 0u, 0u};
      bf16_t* w2 = (bf16_t*)(ws + WS_W2);
      for (int i = gt; i < D * (DFFP - DFF) / 8; i += NT) { const int r = i / ((DFFP - DFF) / 8), cc = i % ((DFFP - DFF) / 8); *(u32x4*)(w2 + (size_t)r * DFFP + DFF + cc * 8) = (u32x4){0u, 0u, 0u, 0u}; }
      float2* rope = (float2*)(ws + WS_ROPE);
      for (int i = gt; i < T * 32; i += NT) { const int t = i >> 5, pi = i & 31; const float invf = exp2f(-(float)(pi & 15) * (13.287712379549449f / 16.f));
          const float ang = (float)(pi < 16 ? (t >> 6) : (t & 63)) * invf; rope[i] = make_float2(cosf(ang), sinf(ang)); }
      float* lbs = (float*)(ws + WS_LBS);
      for (int i = gt; i < 2 * 2 * 512; i += NT) { const int l = i >> 10, dir = (i >> 9) & 1, d = i & 511; const float* lb = PIN(dir ? 16 : 15);
          const float p0 = lb[d], p1 = lb[512 + d]; lbs[i] = l == 0 ? 0.f : 1.f / (1.f + expf(p0 - p1)); }
    }
    phase_mods(C);
}
constexpr float W13_SCALE = 64.f, W2_SCALE = 128.f, HID_SCALE = 8.f;
DI void convert_moe_weights(const Ctx& C, const int gw, const int NGW) {
    unsigned char* ws = C.ws; LAS float* scr = (LAS float*)(C.lds + C.wave * TP_SCR);
    const int lane = C.lane, r = lane >> 4, c4 = (lane & 15) * 4;
    constexpr int NIT = NE * 3 * 896;
    static_assert((D / 64) * (DFE / 64) == 896, "items per expert matrix");
    f32x4 v[16];
#define MOE_ITEM(it, W, ldw, k0, n0) const int m_ = (it) / 896, q_ = (it) % 896, e_ = m_ / 3, wh_ = m_ % 3; \
        const float* W = PIN(wh_ == 0 ? 24 : wh_ == 1 ? 25 : 26) + (size_t)e_ * D * DFE; const int ldw = wh_ == 2 ? D : DFE, nb_ = wh_ == 2 ? D / 64 : DFE / 64, k0 = 64 * (q_ / nb_), n0 = 64 * (q_ % nb_)
#define MOE_LOADS(it) do { MOE_ITEM(it, W_, ldw_, k0_, n0_); _Pragma("unroll") for (int i = 0; i < 16; ++i) v[i] = *(const f32x4*)(W_ + (size_t)(k0_ + 4 * i + r) * ldw_ + n0_ + c4); } while (0)
    int it = gw;
    if (it < NIT) MOE_LOADS(it);
    for (; it < NIT; it += NGW) {
#pragma unroll
        for (int i = 0; i < 16; ++i) *(LAS f32x4*)(scr + (4 * i + r) * TP_PITCH + c4) = v[i];
        LDS_WAIT(); asm volatile("" ::: "memory");
        if (it + NGW < NIT) MOE_LOADS(it + NGW);
        MOE_ITEM(it, W, ldw, k0, n0); (void)W; (void)ldw;
        const int kind = wh_ == 0 ? 2 : wh_ == 1 ? 3 : 0; const float sc = wh_ == 2 ? W2_SCALE : W13_SCALE;
        unsigned char* dst = (wh_ == 2 ? ws + WS_WM2 + (size_t)e_ * D * DFE : ws + WS_WM13 + (size_t)e_ * 2 * DFE * D) + (size_t)map_row(kind, n0 + lane, 0) * (wh_ == 2 ? DFE : D) + k0;
#pragma unroll
        for (int j = 0; j < 4; ++j) { const LAS float* sp = scr + (16 * j) * TP_PITCH + lane; u32x4 o;
            o.x = pack_fp8x4(sp[0] * sc, sp[TP_PITCH] * sc, sp[2 * TP_PITCH] * sc, sp[3 * TP_PITCH] * sc); o.y = pack_fp8x4(sp[4 * TP_PITCH] * sc, sp[5 * TP_PITCH] * sc, sp[6 * TP_PITCH] * sc, sp[7 * TP_PITCH] * sc);
            o.z = pack_fp8x4(sp[8 * TP_PITCH] * sc, sp[9 * TP_PITCH] * sc, sp[10 * TP_PITCH] * sc, sp[11 * TP_PITCH] * sc); o.w = pack_fp8x4(sp[12 * TP_PITCH] * sc, sp[13 * TP_PITCH] * sc, sp[14 * TP_PITCH] * sc, sp[15 * TP_PITCH] * sc);
            *(u32x4*)(dst + 16 * j) = o; }
        LDS_WAIT(); asm volatile("" ::: "memory");
    }
#undef MOE_ITEM
#undef MOE_LOADS
}

template <bool ROUTER>
DI void phase_norm(const Ctx& C, const float* xl, const float* xc, const float* nw, const float* mods, int shsel, int nrows, bf16_t* Hout, const float* rw, unsigned char* route, LAS int* cntL, unsigned char* H8 = nullptr) {
    int nloc = 0;
    f32x4 rwr[4][4][2];
    if (ROUTER) {
#pragma unroll
        for (int j = 0; j < 4; ++j)
#pragma unroll
            for (int q = 0; q < 4; ++q) { const float* rp = rw + (size_t)(256 * j + 4 * C.lane + q) * 8; rwr[j][q][0] = *(const f32x4*)rp; rwr[j][q][1] = *(const f32x4*)(rp + 4); } }
    for (int row0 = C.gw; row0 < nrows; row0 += 2 * C.NGW) {
        const int rows[2] = {row0, row0 + C.NGW}; const bool two = rows[1] < nrows;
        f32x4 v[2][4]; float ss[2] = {0.f, 0.f};
#pragma unroll
        for (int u = 0; u < 2; ++u) { const int row = (u == 1 && !two) ? rows[0] : rows[u]; const float* xr = row < NLAT ? xl + (size_t)row * D : xc + (size_t)(row - NLAT) * D;
#pragma unroll
            for (int j = 0; j < 4; ++j) { v[u][j] = *(const f32x4*)(xr + 256 * j + 4 * C.lane); ss[u] += (v[u][j][0] * v[u][j][0] + v[u][j][1] * v[u][j][1]) + (v[u][j][2] * v[u][j][2] + v[u][j][3] * v[u][j][3]); } }
#pragma unroll
        for (int u = 0; u < 2; ++u) { if (u == 1 && !two) break;
            const int row = rows[u]; const bool lat = row < NLAT;
            const float* mv = mods + (size_t)(lat ? (row >> 11) : 32) * DIN + shsel * D;
            const float rstd = 1.0f / sqrtf(wave_sum(ss[u]) * (1.f / D) + EPS);
            float lg[8];
            if (ROUTER) {
#pragma unroll
                for (int e = 0; e < 8; ++e) lg[e] = 0.f; }
#pragma unroll
            for (int j = 0; j < 4; ++j) { const int c0 = 256 * j + 4 * C.lane;
                const f32x4 w = *(const f32x4*)(nw + c0), sh = *(const f32x4*)(mv + c0), sc = *(const f32x4*)(mv + D + c0);
                f32x4 h = (v[u][j] * rstd) * w * (sc + 1.0f) + sh;
                if (ROUTER) *(unsigned*)((unsigned char*)Hout + (size_t)row * D + c0) = pack_fp8x4(h[0], h[1], h[2], h[3]);
                else { u32x2 o; o.x = cvt_pk_bf16(h[0], h[1]); o.y = cvt_pk_bf16(h[2], h[3]); *(u32x2*)(Hout + (size_t)row * D + c0) = o;
                       if (H8) *(unsigned*)(H8 + (size_t)row * D + c0) = pack_fp8x4(h[0], h[1], h[2], h[3]); }
                if (ROUTER) {
#pragma unroll
                    for (int q = 0; q < 4; ++q) { const f32x4 r0 = rwr[j][q][0], r1 = rwr[j][q][1];
                        lg[0] += h[q] * r0[0]; lg[1] += h[q] * r0[1]; lg[2] += h[q] * r0[2]; lg[3] += h[q] * r0[3]; lg[4] += h[q] * r1[0]; lg[5] += h[q] * r1[1]; lg[6] += h[q] * r1[2]; lg[7] += h[q] * r1[3]; } }
            }
            if (ROUTER) {
                const bool b5 = (C.lane & 32) != 0, b4 = (C.lane & 16) != 0, b3 = (C.lane & 8) != 0; float a4[4], a2[2], a1;
#pragma unroll
                for (int j = 0; j < 4; ++j) { const float snd = b5 ? lg[j] : lg[4 + j]; a4[j] = (b5 ? lg[4 + j] : lg[j]) + __shfl_xor(snd, 32); }
#pragma unroll
                for (int j = 0; j < 2; ++j) { const float snd = b4 ? a4[j] : a4[2 + j]; a2[j] = (b4 ? a4[2 + j] : a4[j]) + __shfl_xor(snd, 16); }
                { const float snd = b3 ? a2[0] : a2[1]; a1 = (b3 ? a2[1] : a2[0]) + __shfl_xor(snd, 8); }
                a1 += __shfl_xor(a1, 4); a1 += __shfl_xor(a1, 2); a1 += __shfl_xor(a1, 1);
                if ((C.lane & 7) == 0) ((LAS float*)(C.lds + C.wave * 4096))[nloc * 8 + (C.lane >> 3)] = a1;
                ++nloc;
            }
        }
    }
    if (ROUTER) {
        LDS_WAIT();
        for (int i = C.lane; i < nloc; i += 64) { const int row = C.gw + i * C.NGW; const LAS float* lp = (const LAS float*)(C.lds + C.wave * 4096) + i * 8;
            float lg[8];
#pragma unroll
            for (int e = 0; e < 8; ++e) lg[e] = lp[e];
            int e1 = 0; float l1 = lg[0];
#pragma unroll
            for (int e = 1; e < 8; ++e) if (lg[e] > l1) { l1 = lg[e]; e1 = e; }
            int e2 = -1; float l2 = -INFINITY;
#pragma unroll
            for (int e = 0; e < 8; ++e) if (e != e1 && lg[e] > l2) { l2 = lg[e]; e2 = e; }
            const float g2 = 1.f / (1.f + expf(l1 - l2)), g1 = 1.f - g2;
            int* rt = (int*)(route + (size_t)row * 24); rt[0] = e1; rt[1] = e2; ((float*)rt)[2] = g1; ((float*)rt)[3] = g2;
            atomicAdd((int*)&cntL[e1], 1); atomicAdd((int*)&cntL[e2], 1);
        }
    }
}

constexpr int AT_XCH = 65536, AT_ANW = 131072;
DI float max3f(float a, float b, float c) { return fmaxf(fmaxf(a, b), c); }
DI float xhalf(float v, int hi) {
    const auto rr = __builtin_amdgcn_permlane32_swap(__float_as_uint(v), __float_as_uint(v), false, false);
    return __uint_as_float(hi ? rr[0] : rr[1]);
}
constexpr float AT_THR = 8.f;
DI void attn_unit(const Ctx& C, bf16_t* P, int qrow0, int krow_ctx, int krow_lat, int nkt, int h, float lam, const float* anw, float post) {
    const int tid_ = my_tid();
    LAS unsigned char* lds = C.lds; const int lane = tid_ & 63, wid = __builtin_amdgcn_readfirstlane(tid_ >> 6), sub = wid >> 2, qw = wid & 3, r32 = lane & 31, hh = lane >> 5;
    const int tq = (lane & 15) >> 2, tp = lane & 3, blk = (lane >> 4) & 1;
    LAS unsigned char* qlds = lds + AT_XCH + wid * 8192 + r32 * 16;
#pragma unroll
    for (int qb = 0; qb < 2; ++qb) { const bf16_t* qp = P + (size_t)(qrow0 + 64 * qw + 32 * qb + r32) * PW + PC_Q + h * 128 + sub * 64 + 8 * hh;
#pragma unroll
      for (int ks = 0; ks < 4; ++ks) *(LAS bf16x8*)(qlds + ((2 * ks + hh) * 64 + 32 * qb) * 16) = *(const bf16x8*)(qp + 16 * ks); }
    if (tid_ < 32) *(LAS f32x4*)(lds + AT_ANW + tid_ * 16) = *(const f32x4*)(anw + 4 * tid_);
    f32x16 O[2][4];
#pragma unroll
    for (int qb = 0; qb < 2; ++qb)
#pragma unroll
        for (int c = 0; c < 4; ++c)
#pragma unroll
            for (int i = 0; i < 16; ++i) O[qb][c][i] = 0.f;
    float m_run[2] = {-INFINITY, -INFINITY}, l_run[2] = {0.f, 0.f};
#define AT_ISSUE(kt, buf) do { const int kr0_ = (kt) < 4 ? krow_ctx + (kt) * 64 : krow_lat + ((kt) - 4) * 64; LAS unsigned char* bb_ = lds + (buf) * 32768; \
        _Pragma("unroll") for (int j_ = 0; j_ < 2; ++j_) { const int c_ = 2 * wid + j_; \
            dma16a(P + (size_t)(kr0_ + lane) * PW + PC_K + h * 128 + c_ * 8, bb_ + c_ * 1024); \
            dma16a(P + (size_t)(kr0_ + 16 * (c_ & 3) + (lane >> 2)) * PW + PC_V + h * 128 + (c_ >> 2) * 32 + (lane & 3) * 8, bb_ + 16384 + c_ * 1024); } } while (0)
    AT_ISSUE(0, 0);
    int buf = 0;
#pragma unroll 1
    for (int kt = 0; kt < nkt; ++kt) {
        VM_WAIT(); __syncthreads();
        if (kt + 1 < nkt) AT_ISSUE(kt + 1, buf ^ 1);
        const LAS unsigned char* kb = lds + buf * 32768, * vb = kb + 16384 + (4 * hh + tq) * 64 + blk * 32 + tp * 8;
        bf16x8 Pf[2][4];
#pragma unroll
        for (int qb = 0; qb < 2; ++qb) {
            f32x16 s0, s1;
#pragma unroll
            for (int i = 0; i < 16; ++i) { s0[i] = 0.f; s1[i] = 0.f; }
#pragma unroll
            for (int ks = 0; ks < 4; ++ks) { const LAS unsigned char* kp = kb + ((sub * 8 + 2 * ks + hh) * 64 + r32) * 16;
                const bf16x8 k0 = *(const LAS bf16x8*)kp, k1 = *(const LAS bf16x8*)(kp + 512);
                const bf16x8 q = *(const LAS bf16x8*)(qlds + ((2 * ks + hh) * 64 + 32 * qb) * 16);
                s0 = MFMA32(k0, q, s0); s1 = MFMA32(k1, q, s1); }
            float mx = max3f(s0[0], s1[0], s0[1]);
#pragma unroll
            for (int i = 1; i < 16; ++i) mx = (i + 1 < 16) ? max3f(mx, s1[i], s0[i + 1]) : fmaxf(mx, s1[i]);
            mx = fmaxf(mx, xhalf(mx, hh));
            const float mnew = fmaxf(m_run[qb], mx);
            if (__any(mx > m_run[qb] + AT_THR)) { const float alpha = __builtin_amdgcn_exp2f(m_run[qb] - mnew); l_run[qb] *= alpha;
#pragma unroll
                for (int c = 0; c < 4; ++c)
#pragma unroll
                    for (int i = 0; i < 16; ++i) O[qb][c][i] *= alpha;
                m_run[qb] = mnew; }
            const float mr = m_run[qb]; float ps0 = 0.f, ps1 = 0.f;
#pragma unroll
            for (int i = 0; i < 16; ++i) { s0[i] = __builtin_amdgcn_exp2f(s0[i] - mr); s1[i] = __builtin_amdgcn_exp2f(s1[i] - mr); ps0 += s0[i]; ps1 += s1[i]; }
            l_run[qb] += ps0 + ps1;
            Pf[qb][0] = packf8(s0, 0); Pf[qb][1] = packf8(s0, 1); Pf[qb][2] = packf8(s1, 0); Pf[qb][3] = packf8(s1, 1);
        }
#pragma unroll
        for (int cb = 0; cb < 4; ++cb) {
#pragma unroll
            for (int s4 = 0; s4 < 4; ++s4) { const bf16x8 a = cat8(tr16(vb + cb * 4096 + s4 * 1024), tr16(vb + cb * 4096 + s4 * 1024 + 512));
                O[0][cb] = MFMA32(a, Pf[0][s4], O[0][cb]); O[1][cb] = MFMA32(a, Pf[1][s4], O[1][cb]); } }
        buf ^= 1;
    }
#undef AT_ISSUE
    LDS_WAIT(); __syncthreads();
    const int te = my_tid(); const int lane_e = te & 63, wid_e = __builtin_amdgcn_readfirstlane(te >> 6);
    LAS float* xch = (LAS float*)(lds + AT_XCH) + (wid_e & 3) * 4096 + lane_e;
#pragma unroll
    for (int qb = 0; qb < 2; ++qb) {
        const float lt = l_run[qb] + xhalf(l_run[qb], lane_e >> 5); const float inv = 1.f / lt;
        if ((wid_e >> 2) == 1) { const float sc = -lam * inv;
#pragma unroll
            for (int c = 0; c < 4; ++c)
#pragma unroll
                for (int i = 0; i < 16; ++i) xch[(c * 16 + i) * 64] = O[qb][c][i] * sc; }
        LDS_WAIT(); __syncthreads();
        if ((wid_e >> 2) == 0) {
            float ss = 0.f;
#pragma unroll
            for (int c = 0; c < 4; ++c)
#pragma unroll
                for (int i = 0; i < 16; ++i) { const float o = O[qb][c][i] * inv + xch[(c * 16 + i) * 64]; O[qb][c][i] = o; ss += o * o; }
            ss += xhalf(ss, lane_e >> 5);
            const float rs = post / sqrtf(ss * (1.f / 128.f) + EPS);
            bf16_t* op = P + (size_t)(qrow0 + 64 * (wid_e & 3) + 32 * qb + (lane_e & 31)) * PW + PC_Q + h * 128;
#pragma unroll
            for (int c = 0; c < 4; ++c)
#pragma unroll
                for (int g = 0; g < 4; ++g) { const int v0 = 32 * c + 8 * g + 4 * (lane_e >> 5); const f32x4 w = *(const LAS f32x4*)(lds + AT_ANW + v0 * 4);
                    u32x2 o; o.x = cvt_pk_bf16(O[qb][c][4 * g] * rs * w[0], O[qb][c][4 * g + 1] * rs * w[1]); o.y = cvt_pk_bf16(O[qb][c][4 * g + 2] * rs * w[2], O[qb][c][4 * g + 3] * rs * w[3]);
                    *(u32x2*)(op + v0) = o; }
        }
        LDS_WAIT(); __syncthreads();
    }
}

constexpr int SC_Q = 0, SC_LF = 16384, SC_V0 = 32768, SC_QM = 65536, SC_KMR = 81920, SC_KMS = 98304, SC_SX = 114688, SC_A31 = 147456, SC_A63 = 147968, SC_END = 148480;
DI void scan_chain(const Ctx& C, bf16_t* P, int b, int h, int dir, bool store_ctx) {
    const int tid_ = my_tid();
    LAS unsigned char* lds = C.lds; const int lane = tid_ & 63, wid = __builtin_amdgcn_readfirstlane(tid_ >> 6), r32 = lane & 31, hh = lane >> 5;
    const int tq = (lane & 15) >> 2, tp = lane & 3, blk = (lane >> 4) & 1;
    const int db = wid & 3, tb = wid >> 2;
    const int base_nat = hh * 512 + tq * 64 + blk * 32 + tp * 8;
    const int base_prm = (4 * hh + tq) * 64 + blk * 32 + tp * 8;
    const int lfcol = (dir ? PC_LB : PC_LF) + h * 128, qcol = PC_RQ + h * 128, vcol = PC_RI + h * 128;
    f32x16 ST[2];
#pragma unroll
    for (int j = 0; j < 2; ++j)
#pragma unroll
        for (int i = 0; i < 16; ++i) ST[j][i] = 0.f;
#define SROW(c, i) ((c) < 4 ? NLAT + b * CL + (dir ? 255 - ((c) * 64 + (i)) : (c) * 64 + (i)) : b * T + (dir ? 2047 - (((c) - 4) * 64 + (i)) : ((c) - 4) * 64 + (i)))
#define SDMA(c, colbase, dstoff) do { _Pragma("unroll") for (int j_ = 0; j_ < 2; ++j_) { const int I_ = 2 * wid + j_; const int ti_ = 16 * (I_ & 3) + (lane >> 2); \
        dma16(P + (size_t)SROW(c, ti_) * PW + (colbase) + (I_ >> 2) * 32 + (lane & 3) * 8, lds + (dstoff) + I_ * 1024); } } while (0)
    SDMA(0, qcol, SC_Q); SDMA(0, lfcol, SC_LF); SDMA(0, vcol, SC_V0);
    int vbuf = 0;
    const int t = 32 * tb + r32;
#pragma unroll 1
    for (int c = 0; c < 36; ++c) {
        { const int st_ = __builtin_amdgcn_readfirstlane((c > 0 && (c > 4 || store_ctx)) ? 1 : 0);
          asm volatile("s_cmp_lg_u32 %0, 0\n\ts_cbranch_scc1 1f\n\ts_waitcnt vmcnt(0)\n1:\n\ts_waitcnt vmcnt(4)" :: "s"(st_) : "memory", "scc"); }
        LDS_BARRIER();
        const LAS unsigned char* Vimg = lds + SC_V0 + vbuf * 16384;
        f32x16 cm;
#pragma unroll
        for (int i = 0; i < 16; ++i) cm[i] = 0.f;
#pragma unroll
        for (int kk = 0; kk < 2; ++kk) { const int ks = 2 * tb + kk;
            const half8 a = __builtin_bit_cast(half8, cat8(tr16(lds + SC_LF + db * 4096 + base_nat + ks * 1024), tr16(lds + SC_LF + db * 4096 + base_nat + ks * 1024 + 256)));
            half8 bm;
#pragma unroll
            for (int j = 0; j < 8; ++j) { const int s = 16 * ks + 8 * hh + j; bm[j] = tb == 0 ? (s > t ? (_Float16)-1.f : (_Float16)0.f) : (s <= t ? (_Float16)1.f : (_Float16)0.f); }
            cm = __builtin_amdgcn_mfma_f32_32x32x16_f16(a, bm, cm, 0, 0, 0); }
#pragma unroll
        for (int g = 0; g < 4; ++g) {
            const int sa = db * 4096 + (t >> 3) * 512 + (t & 7) * 64 + (8 * g + 4 * hh) * 2;
            const u32x2 q4 = *(const LAS u32x2*)(lds + SC_Q + sa); const half4 lf4 = *(const LAS half4*)(lds + SC_LF + sa);
            const float qv[4] = {bflo(q4.x), bfhi(q4.x), bflo(q4.y), bfhi(q4.y)};
            float qm[4], km[4];
#pragma unroll
            for (int e = 0; e < 4; ++e) { const float cv = cm[4 * g + e] * LOG2E; const float E = __builtin_amdgcn_exp2f(cv), Ei = __builtin_amdgcn_exp2f(-cv);
                const float lf = (float)lf4[e]; qm[e] = qv[e] * E; km[e] = (1.f - __builtin_amdgcn_exp2f(lf * LOG2E)) * Ei;
                if (tb == 0 && r32 == 0) ((LAS float*)(lds + SC_A31))[32 * db + 8 * g + 4 * hh + e] = lf - cm[4 * g + e];
                if (tb == 1 && r32 == 31) ((LAS float*)(lds + SC_A63))[32 * db + 8 * g + 4 * hh + e] = cm[4 * g + e]; }
            u32x2 qw2, kw2; qw2.x = cvt_pk_bf16(qm[0], qm[1]); qw2.y = cvt_pk_bf16(qm[2], qm[3]); kw2.x = cvt_pk_bf16(km[0], km[1]); kw2.y = cvt_pk_bf16(km[2], km[3]);
            const int ra = ((4 * db + g) * 64 + t) * 16 + 8 * hh;
            *(LAS u32x2*)(lds + SC_QM + ra) = qw2; *(LAS u32x2*)(lds + SC_KMR + ra) = kw2; *(LAS u32x2*)(lds + SC_KMS + sa) = kw2;
        }
        LDS_BARRIER();
        if (c + 1 < 36) { SDMA(c + 1, qcol, SC_Q); SDMA(c + 1, lfcol, SC_LF); SDMA(c + 1, vcol, SC_V0 + (vbuf ^ 1) * 16384); }
        { const int d = 32 * db + r32; const float c31 = ((LAS float*)(lds + SC_A31))[d], c63 = ((LAS float*)(lds + SC_A63))[d];
          const float e31 = __expf(c31), dec = __expf(c31 + c63), e63 = __expf(c63);
          f32x16 SN[2];
#pragma unroll
          for (int j = 0; j < 2; ++j) { const int vb2 = 2 * tb + j;
#pragma unroll
              for (int g = 0; g < 4; ++g) { u32x2 w; w.x = cvt_pk_bf16(ST[j][4 * g] * e31, ST[j][4 * g + 1] * e31); w.y = cvt_pk_bf16(ST[j][4 * g + 2] * e31, ST[j][4 * g + 3] * e31);
                  *(LAS u32x2*)(lds + SC_SX + vb2 * 8192 + (d >> 3) * 512 + (d & 7) * 64 + (8 * g + 4 * hh) * 2) = w; }
#pragma unroll
              for (int i = 0; i < 16; ++i) SN[j][i] = 0.f; }
#pragma unroll
          for (int ks = 0; ks < 4; ++ks) {
              const bf16x8 kf = cat8(tr16(lds + SC_KMS + db * 4096 + base_nat + ks * 1024), tr16(lds + SC_KMS + db * 4096 + base_nat + ks * 1024 + 256));
#pragma unroll
              for (int j = 0; j < 2; ++j) { const int vb2 = 2 * tb + j;
                  const bf16x8 vf = cat8(tr16(Vimg + vb2 * 4096 + base_nat + ks * 1024), tr16(Vimg + vb2 * 4096 + base_nat + ks * 1024 + 256));
                  SN[j] = MFMA32(vf, kf, SN[j]); } }
#pragma unroll
          for (int j = 0; j < 2; ++j)
#pragma unroll
              for (int i = 0; i < 16; ++i) ST[j][i] = dec * ST[j][i] + e63 * SN[j][i];
        }
        LDS_BARRIER();
        { bf16x8 Qmf[8];
#pragma unroll
          for (int kd = 0; kd < 8; ++kd) Qmf[kd] = *(const LAS bf16x8*)(lds + SC_QM + ((2 * kd + hh) * 64 + t) * 16);
          f32x16 o;
#pragma unroll
          for (int i = 0; i < 16; ++i) o[i] = 0.f;
          for (int sb = 0; sb <= tb; ++sb) {
              f32x16 pt;
#pragma unroll
              for (int i = 0; i < 16; ++i) pt[i] = 0.f;
#pragma unroll
              for (int kd = 0; kd < 8; ++kd) { const bf16x8 a = *(const LAS bf16x8*)(lds + SC_KMR + ((2 * kd + hh) * 64 + 32 * sb + r32) * 16); pt = MFMA32(a, Qmf[kd], pt); }
              if (sb == tb) {
#pragma unroll
                  for (int i = 0; i < 16; ++i) if (crow(i, hh) > r32) pt[i] = 0.f; }
              const bf16x8 p0 = packf8(pt, 0), p1 = packf8(pt, 1);
              { const bf16x8 a = cat8(tr16(Vimg + db * 4096 + base_prm + (2 * sb) * 1024), tr16(Vimg + db * 4096 + base_prm + (2 * sb) * 1024 + 512)); o = MFMA32(a, p0, o); }
              { const bf16x8 a = cat8(tr16(Vimg + db * 4096 + base_prm + (2 * sb + 1) * 1024), tr16(Vimg + db * 4096 + base_prm + (2 * sb + 1) * 1024 + 512)); o = MFMA32(a, p1, o); }
          }
#pragma unroll
          for (int kd = 0; kd < 8; ++kd) { const bf16x8 a = cat8(tr16(lds + SC_SX + db * 8192 + base_nat + kd * 1024), tr16(lds + SC_SX + db * 8192 + base_nat + kd * 1024 + 256)); o = MFMA32(a, Qmf[kd], o); }
          if (c >= 4 || store_ctx) { bf16_t* op = P + (size_t)SROW(c, t) * PW + lfcol + 32 * db;
#pragma unroll
              for (int g = 0; g < 4; ++g) { u32x2 w; w.x = cvt_pk_bf16(o[4 * g], o[4 * g + 1]); w.y = cvt_pk_bf16(o[4 * g + 2], o[4 * g + 3]); *(u32x2*)(op + 8 * g + 4 * hh) = w; } }
        }
        vbuf ^= 1;
    }
    VM_WAIT(); LDS_WAIT(); __syncthreads();
#undef SROW
#undef SDMA
}

DI void phase_recprep(const Ctx& C, bf16_t* P, const float* rnw, int nrows) {
    const f32x4 w0 = *(const f32x4*)(rnw + ((8 * C.lane) & 127)), w1 = *(const f32x4*)(rnw + ((8 * C.lane) & 127) + 4);
    for (int row0 = C.gw; row0 < nrows; row0 += 4 * C.NGW) {
        u32x4 ra[4], rb[4], rg[4];
#pragma unroll
        for (int u = 0; u < 4; ++u) { const int row = row0 + u * C.NGW < nrows ? row0 + u * C.NGW : row0; const bf16_t* pr = P + (size_t)row * PW + 8 * C.lane;
            ra[u] = *(const u32x4*)(pr + PC_LF); rb[u] = *(const u32x4*)(pr + PC_LB); rg[u] = *(const u32x4*)(pr + PC_G); }
#pragma unroll
        for (int u = 0; u < 4; ++u) { const int row = row0 + u * C.NGW; if (row >= nrows) break;
            float a[8], bb[8], g[8]; unpack8(ra[u], a); unpack8(rb[u], bb); unpack8(rg[u], g);
            float ss = 0.f;
#pragma unroll
            for (int j = 0; j < 8; ++j) { a[j] += bb[j]; ss += a[j] * a[j]; }
            ss += __shfl_xor(ss, 1); ss += __shfl_xor(ss, 2); ss += __shfl_xor(ss, 4); ss += __shfl_xor(ss, 8);
            const float rs = 1.0f / sqrtf(ss * (1.f / 128.f) + EPS);
            f32x4 o0, o1;
#pragma unroll
            for (int j = 0; j < 4; ++j) { o0[j] = a[j] * rs * w0[j] * g[j]; o1[j] = a[4 + j] * rs * w1[j] * g[4 + j]; }
            *(u32x4*)(P + (size_t)row * PW + 8 * C.lane + PC_LF) = pack8(o0, o1); }
    }
}

DI void phase_slots(const Ctx& C, const int* cnt, int* pbout, unsigned char* route, const bf16_t* H2, bf16_t* AG, LAS int* cur) {
    if (C.tid < 16) cur[C.tid] = 0;
    __syncthreads();
    for (int g = C.tid; g < C.G; g += 512) {
#pragma unroll
        for (int k = 0; k < 8; ++k) { const int c = cnt[g * 8 + k]; atomicAdd((int*)&cur[8 + k], c); if (g < C.bx) atomicAdd((int*)&cur[k], c); } }
    __syncthreads();
    if (C.tid < 8) { const int e = C.tid; int pb = 0, pbe = 0;
#pragma unroll
        for (int k = 0; k < 8; ++k) { if (k == e) pbe = pb; pb += (cur[8 + k] + 255) >> 8; }
        const int mine = cur[e];
        if (C.bx == 0) { pbout[e] = pbe; if (e == 7) pbout[8] = pb; }
        cur[e] = pbe * 256 + mine;
    }
    __syncthreads();
    const int nloc = (NLAT - C.gw + C.NGW - 1) / C.NGW;
    LAS int* tab = (LAS int*)(C.lds + C.wave * 2048);
    for (int i = C.lane; i < nloc; i += 64) { int* rt = (int*)(route + (size_t)(C.gw + i * C.NGW) * 24);
        const int s1 = atomicAdd((int*)&cur[rt[0]], 1), s2 = atomicAdd((int*)&cur[rt[1]], 1); rt[4] = s1; rt[5] = s2; tab[2 * i] = s1; tab[2 * i + 1] = s2; }
    LDS_WAIT();
    for (int i = 0; i < nloc; i += 2) { const int i1 = i + 1 < nloc ? i + 1 : i;
        const int sa1 = __builtin_amdgcn_readfirstlane(tab[2 * i]), sa2 = __builtin_amdgcn_readfirstlane(tab[2 * i + 1]), sb1 = __builtin_amdgcn_readfirstlane(tab[2 * i1]), sb2 = __builtin_amdgcn_readfirstlane(tab[2 * i1 + 1]);
        const u32x4 va = *((const u32x4*)((const unsigned char*)H2 + (size_t)(C.gw + i * C.NGW) * D) + C.lane);
        const u32x4 vb = *((const u32x4*)((const unsigned char*)H2 + (size_t)(C.gw + i1 * C.NGW) * D) + C.lane);
        *((u32x4*)((unsigned char*)AG + (size_t)sa1 * D) + C.lane) = va; *((u32x4*)((unsigned char*)AG + (size_t)sa2 * D) + C.lane) = va;
        *((u32x4*)((unsigned char*)AG + (size_t)sb1 * D) + C.lane) = vb; *((u32x4*)((unsigned char*)AG + (size_t)sb2 * D) + C.lane) = vb;
    }
}
DI void phase_final(const Ctx& C, float* x, const unsigned char* route, const bf16_t* Y, const float* mods1, const float* fw) {
    for (int row0 = C.gw; row0 < NLAT; row0 += 2 * C.NGW) {
        const int rows[2] = {row0, row0 + C.NGW < NLAT ? row0 + C.NGW : row0};
        f32x4 v[2][4]; float ss[2] = {0.f, 0.f};
#pragma unroll
        for (int u = 0; u < 2; ++u) { const int row = rows[u];
            const int* rt = (const int*)(route + (size_t)row * 24); const float g1 = ((const float*)rt)[2], g2 = ((const float*)rt)[3]; const int s1 = rt[4], s2 = rt[5];
            const float* mv = mods1 + (size_t)(row >> 11) * DIN + 5 * D; const float* xr = x + (size_t)row * D;
#pragma unroll
            for (int j = 0; j < 4; ++j) { const int c0 = 256 * j + 4 * C.lane;
                const u32x2 y1 = *(const u32x2*)(Y + (size_t)s1 * D + c0), y2 = *(const u32x2*)(Y + (size_t)s2 * D + c0); const f32x4 m5 = *(const f32x4*)(mv + c0);
                f32x4 y; y[0] = g1 * bflo(y1.x) + g2 * bflo(y2.x); y[1] = g1 * bfhi(y1.x) + g2 * bfhi(y2.x); y[2] = g1 * bflo(y1.y) + g2 * bflo(y2.y); y[3] = g1 * bfhi(y1.y) + g2 * bfhi(y2.y);
                v[u][j] = *(const f32x4*)(xr + c0) + m5 * y; ss[u] += (v[u][j][0] * v[u][j][0] + v[u][j][1] * v[u][j][1]) + (v[u][j][2] * v[u][j][2] + v[u][j][3] * v[u][j][3]); } }
#pragma unroll
        for (int u = 0; u < 2; ++u) { if (u == 1 && rows[1] == rows[0]) break;
            const float rstd = 1.0f / sqrtf(wave_sum(ss[u]) * (1.f / D) + EPS); float* xr = x + (size_t)rows[u] * D;
#pragma unroll
            for (int j = 0; j < 4; ++j) { const int c0 = 256 * j + 4 * C.lane; *(f32x4*)(xr + c0) = v[u][j] * rstd * *(const f32x4*)(fw + c0); } }
    }
}

constexpr int LDS_MISC = SC_END;
constexpr int LDS_BYTES = SC_END + 512;
static_assert(LDS_WTAB_OFF == SC_END + 128, "wave table sits behind the barrier words and counters");
constexpr int NPHASE = 20;

DI Ctx make_ctx() {
    extern __shared__ __attribute__((aligned(16))) unsigned char lds_raw[];
    Ctx C; const int t = my_tid();
    unsigned lb = (unsigned)(size_t)(LAS unsigned char*)lds_raw; asm volatile("" : "+s"(lb));
    C.lds = (LAS unsigned char*)(size_t)lb; C.ws = kparams()->ws; C.tid = t; C.lane = t & 63; C.wave = __builtin_amdgcn_readfirstlane(t >> 6);
    int bx = blockIdx.x, G = gridDim.x; asm volatile("" : "+s"(bx), "+s"(G));
    C.bx = bx; C.G = G; C.vcu = (C.G % 8 == 0) ? (bx % 8) * (C.G / 8) + bx / 8 : bx;
    C.gw = C.vcu * 8 + C.wave; C.NGW = C.G * 8;
    return C;
}
DI void grid_barrier() {
    extern __shared__ __attribute__((aligned(16))) unsigned char lds_raw[];
    XcdBarrier b; b.bar = (unsigned*)(kparams()->ws + WS_CTL) + CW_BAR + kparams()->li * XCD_BAR_WORDS; b.x = xb_xcc_id(); b.st = (volatile LAS unsigned*)((LAS unsigned char*)lds_raw + LDS_MISC);
    xcd_barrier(b);
}
#define WSP(T, off) ((T*)(kparams()->ws + (off)))

#define IN(k) (kparams()->ph_lo <= (k) && (k) < kparams()->ph_hi)
#define SEAM(k) do { if (IN(k) && IN((k) + 1)) grid_barrier(); } while (0)


template <int l> DI void layer_phases() {
        constexpr int FS = l == 0 ? FP8_SECS0 : FP8_SECS1, N_SEC_F8 = n_sec_f8(FS), N_SEC_BF = 8 - N_SEC_F8;
        const int pb = 1 + 9 * l;
#define LQ() int lq = l; asm volatile("" : "+s"(lq))
#define XL (lq == 0 ? PIN(0) : (const float*)POUT)
#define XC (lq == 0 ? PIN(2) : (const float*)WSP(float, WS_CTXRES))
#define LMODS (WSP(float, WS_MODS) + (size_t)lq * 33 * DIN)
#define NROWS_OUT (lq == 0 ? NTOK : NLAT)
        if (IN(pb + 0)) { LQ(); const Ctx C = make_ctx(); phase_norm<false>(C, XL, XC, PIN(6) + lq * D, LMODS, 0, NTOK, WSP(bf16_t, WS_H), nullptr, nullptr, nullptr, WSP(unsigned char, WS_H8)); }
        SEAM(pb + 0);
        if (IN(pb + 1)) { LQ();
            { const Ctx C = make_ctx();
              Gemm g{WSP(bf16_t, WS_H), WSP(bf16_t, WS_WIN) + (size_t)lq * 4096 * D, NTOK, N_SEC_BF * 512, D, D};
              pg8::StaticOrder S; S.init(g, C.G, C.bx);
              EpiInProj E{WSP(bf16_t, WS_P), WSP(float2, WS_ROPE), WSP(float, WS_LBS) + lq * 1024, WSP(float, WS_LBS) + lq * 1024 + 512, (int)secmap_of(FS, false), 1.f};
              pg8::gemm_phase<EpiInProj, pg8::StaticOrder>(C.lds, g, S, E); }
            if (N_SEC_F8 > 0) { const Ctx C = make_ctx();
              Gemm g{WSP(bf16_t, WS_H8), (const bf16_t*)(WSP(unsigned char, WS_WIN8) + (size_t)lq * 4096 * D), NTOK, N_SEC_F8 * 512, D / 2, D / 2};
              pg8::StaticOrder S; S.init(g, C.G, C.bx);
              EpiInProj E{WSP(bf16_t, WS_P), WSP(float2, WS_ROPE), WSP(float, WS_LBS) + lq * 1024, WSP(float, WS_LBS) + lq * 1024 + 512, (int)secmap_of(FS, true), 1.f / WIN8_SCALE};
              pg8::gemm_phase<EpiInProj, pg8::StaticOrder, true, true>(C.lds, g, S, E); }
        }
        SEAM(pb + 1);
        if (IN(pb + 2)) { LQ(); const Ctx C = make_ctx(); bf16_t* const Pb = WSP(bf16_t, WS_P);
            for (int id = C.vcu; id < NB * 4 * 2; id += C.G) scan_chain(C, Pb, id >> 3, (id >> 1) & 3, id & 1, lq == 0);
            float lam;
            { const float a = wave_sum(PIN(9)[lq * 64 + C.lane] * PIN(10)[lq * 64 + C.lane]), b2 = wave_sum(PIN(11)[lq * 64 + C.lane] * PIN(12)[lq * 64 + C.lane]);
              const float li = 0.8f - 0.6f * expf(-0.3f * (float)lq); lam = expf(a) - expf(b2) + li; lam = __uint_as_float(__builtin_amdgcn_readfirstlane(__float_as_uint(lam))); }
            const float post = __uint_as_float(__builtin_amdgcn_readfirstlane(__float_as_uint(1.f - (0.8f - 0.6f * expf(-0.3f * (float)lq)))));
            const float* anw = PIN(13) + lq * 128;
            const int NU = NB * 4 * 8, U = (NU + C.G - 1) / C.G;
            for (int id = C.vcu * U; id < NU && id < (C.vcu + 1) * U; ++id) { const int bh = id >> 3, qb = id & 7, b = bh >> 2, h = bh & 3;
                attn_unit(C, Pb, b * T + qb * 256, NLAT + b * CL, b * T, 36, h, lam, anw, post); }
            if (lq == 0) for (int id = C.vcu; id < NB * 4; id += C.G) { const int b = id >> 2, h = id & 3;
                attn_unit(C, Pb, NLAT + b * CL, NLAT + b * CL, 0, 4, h, lam, anw, post); }
        }
        SEAM(pb + 2);
        if (IN(pb + 3)) { LQ(); const Ctx C = make_ctx();
            phase_recprep(C, WSP(bf16_t, WS_P), PIN(14) + lq * 128, NROWS_OUT);
            Gemm g{WSP(bf16_t, WS_H8), (const bf16_t*)(WSP(unsigned char, WS_WIN8) + ((size_t)lq * 4096 + N_SEC_F8 * 512) * D), NROWS_OUT, 2048, D / 2, D / 2};
            pg8::StaticOrder S; S.init(g, C.G, C.bx);
            EpiGates E{WSP(bf16_t, WS_P), 1.f / WIN8_SCALE};
            pg8::gemm_phase<EpiGates, pg8::StaticOrder, true, true>(C.lds, g, S, E);
        }
        SEAM(pb + 3);
        if (IN(pb + 4)) { LQ(); const Ctx C = make_ctx();
            Gemm g{WSP(bf16_t, WS_P) + PC_Q, WSP(bf16_t, WS_WUA) + (size_t)lq * D * D, NROWS_OUT, D, D, PW};
            pg8::StaticOrder S; S.init(g, C.G, C.bx); EpiMergeFused E{WSP(bf16_t, WS_P), WSP(bf16_t, WS_MERGED)};
            pg8::gemm_phase<EpiMergeFused, pg8::StaticOrder, true, false, true>(C.lds, g, S, E);
        }
        SEAM(pb + 4);
        if (IN(pb + 5)) { LQ(); const Ctx C = make_ctx();
            Gemm g{WSP(bf16_t, WS_MERGED), WSP(bf16_t, WS_WO) + (size_t)lq * D * D, NROWS_OUT, D, D, D};
            pg8::StaticOrder S; S.init(g, C.G, C.bx);
            EpiResid E{XL, XC, POUT, WSP(float, WS_CTXRES), LMODS, 2};
            pg8::gemm_phase<EpiResid, pg8::StaticOrder>(C.lds, g, S, E);
        }
        SEAM(pb + 5);
        if (l == 0) {
            if (IN(7)) { LQ(); const Ctx C = make_ctx(); phase_norm<false>(C, POUT, WSP(float, WS_CTXRES), PIN(7), LMODS, 3, NTOK, WSP(bf16_t, WS_H), nullptr, nullptr, nullptr); }
            SEAM(7);
            if (IN(8)) { LQ(); const Ctx C = make_ctx();
                Gemm g{WSP(bf16_t, WS_H), WSP(bf16_t, WS_W13), NTOK, 2 * DFFP, D, D};
                pg8::StaticOrder S; S.init(g, C.G, C.bx); EpiSwiglu E{WSP(bf16_t, WS_HID), DFFP, 0};
                pg8::gemm_phase<EpiSwiglu, pg8::StaticOrder>(C.lds, g, S, E);
            }
            SEAM(8);
            if (IN(9)) { LQ(); const Ctx C = make_ctx();
                Gemm g{WSP(bf16_t, WS_HID), WSP(bf16_t, WS_W2), NTOK, D, DFFP, DFFP};
                pg8::StaticOrder S; S.init(g, C.G, C.bx); EpiResid E{POUT, WSP(float, WS_CTXRES), POUT, WSP(float, WS_CTXRES), LMODS, 5};
                pg8::gemm_phase<EpiResid, pg8::StaticOrder>(C.lds, g, S, E);
                { const int rem = S.nwg % C.G, first_idle = rem; if (C.bx >= first_idle) convert_moe_weights(C, (C.bx - first_idle) * 8 + C.wave, (C.G - first_idle) * 8); }
            }
            SEAM(9);
        } else {
            if (IN(16)) { LQ(); const Ctx C = make_ctx(); LAS int* lcnt = (LAS int*)(C.lds + LDS_MISC + 32);
                if (C.tid < 8) lcnt[C.tid] = 0;
                __syncthreads();
                phase_norm<true>(C, POUT, nullptr, PIN(7) + D, LMODS, 3, NLAT, WSP(bf16_t, WS_H2M), PIN(23), WSP(unsigned char, WS_ROUTE), lcnt);
                __syncthreads();
                if (C.tid < 8) WSP(int, WS_CNT)[C.bx * 8 + C.tid] = lcnt[C.tid];
            }
            SEAM(16);
            if (IN(17)) { LQ(); const Ctx C = make_ctx(); phase_slots(C, WSP(int, WS_CNT), WSP(int, WS_CNT) + 4096, WSP(unsigned char, WS_ROUTE), WSP(bf16_t, WS_H2M), WSP(bf16_t, WS_AG), (LAS int*)(C.lds + LDS_MISC + 32)); }
            SEAM(17);
            if (IN(18)) { LQ();
                const int ptot = __builtin_amdgcn_readfirstlane(WSP(int, WS_CNT)[4096 + 8]);
                for (int p0 = 0; p0 < ptot; p0 += MOE_CHUNK) {
                    const int np = (ptot - p0) < MOE_CHUNK ? (ptot - p0) : MOE_CHUNK;
#define MOE_ORDER_INIT(S) do { S.so.init(g, C.G, C.bx); S.p0 = p0; S.load_pb(WSP(int, WS_CNT) + 4096); } while (0)
                    { const Ctx C = make_ctx(); Gemm g{WSP(bf16_t, WS_AG), WSP(bf16_t, WS_WM13), np * 256, 2 * DFE, D / 2, D / 2};
                      pg8::MoeOrder S; MOE_ORDER_INIT(S); S.apan0 = 0; S.estride = (size_t)2 * DFE * D;
                      EpiSwiglu8 E{WSP(unsigned char, WS_MHID), DFE, p0, 1.f / W13_SCALE, HID_SCALE};
                      pg8::gemm_phase<EpiSwiglu8, pg8::MoeOrder, true, true>(C.lds, g, S, E); }
                    grid_barrier();
                    { const Ctx C = make_ctx(); Gemm g{WSP(bf16_t, WS_MHID), WSP(bf16_t, WS_WM2), np * 256, D, DFE / 2, DFE / 2};
                      pg8::MoeOrder S; MOE_ORDER_INIT(S); S.apan0 = p0; S.estride = (size_t)D * DFE;
                      EpiBf16 E{WSP(bf16_t, WS_Y), D, 1.f / (W2_SCALE * HID_SCALE)};
                      pg8::gemm_phase<EpiBf16, pg8::MoeOrder, true, true>(C.lds, g, S, E); }
                    grid_barrier();
                }
            }
            if (IN(19)) { LQ(); const Ctx C = make_ctx(); phase_final(C, POUT, WSP(unsigned char, WS_ROUTE), WSP(bf16_t, WS_Y), LMODS, PIN(27)); }
        }
}

__global__ void __launch_bounds__(512, 2) fwd_kernel(Params p) {
    extern __shared__ __attribute__((aligned(16))) unsigned char lds_raw[];
    (void)p;
    { volatile LAS unsigned* misc = (volatile LAS unsigned*)((LAS unsigned char*)lds_raw + LDS_MISC);
      if (threadIdx.x < 16) misc[threadIdx.x] = 0u;
      if ((threadIdx.x & 63) == 0) ((volatile LAS int*)((LAS unsigned char*)lds_raw + LDS_WTAB_OFF))[(unsigned)__builtin_amdgcn_s_getreg((5 << 11) | 4) & 63u] = threadIdx.x >> 6;
      __syncthreads();
      (void)xcd_barrier_post((unsigned*)(kparams()->ws + WS_CTL) + CW_BAR + kparams()->li * XCD_BAR_WORDS, misc); }
    if (IN(0)) { const Ctx C = make_ctx(); phase_prologue(C); } SEAM(0);

    layer_phases<0>();
    layer_phases<1>();
#undef IN
#undef SEAM
}


extern "C" void kernel_launch(void* const* d_in, const int* in_sizes, int n_in, void* d_out, int out_size, void* d_ws, size_t ws_size, hipStream_t stream) {
    static int grid = 0;
    if (grid == 0) {
        if (n_in != 28 || out_size != NLAT * D || ws_size < WS_END) { fprintf(stderr, "kernel_launch: unexpected problem (n_in %d, out %d, ws %zu)\n", n_in, out_size, ws_size); grid = -1; return; }
        int dev = 0, cus = 0, per_cu = 0;
        if (hipGetDevice(&dev) != hipSuccess || hipDeviceGetAttribute(&cus, hipDeviceAttributeMultiprocessorCount, dev) != hipSuccess) { grid = -1; return; }
        if (hipFuncSetAttribute((const void*)fwd_kernel, hipFuncAttributeMaxDynamicSharedMemorySize, LDS_BYTES) != hipSuccess) { fprintf(stderr, "kernel_launch: cannot set %d B dynamic LDS\n", LDS_BYTES); grid = -1; return; }
        if (hipOccupancyMaxActiveBlocksPerMultiprocessor(&per_cu, (const void*)fwd_kernel, 512, LDS_BYTES) != hipSuccess || per_cu < 1) fprintf(stderr, "kernel_launch: occupancy query says %d\n", per_cu);
        (void)hipGetLastError();
        grid = cus;
    }
    if (grid < 0) return;
    (void)hipMemsetAsync((char*)d_ws + WS_CTL, 0, CTL_BYTES, stream);
    Params a{};
    for (int i = 0; i < 28; ++i) a.in[i] = (const float*)d_in[i];
    a.out = (float*)d_out; a.ws = (unsigned char*)d_ws; a.ph_lo = 0; a.ph_hi = NPHASE; a.li = 0; a.pad = 0;
    hipLaunchKernelGGL(fwd_kernel, dim3(grid), dim3(512), LDS_BYTES, stream, a);
}
```

```cpp
#include <hip/hip_runtime.h>
#include <cstdio>
#include <cstdint>


constexpr int D = 1024, NB = 32, T = 2048, CL = 256;
constexpr int NLAT = NB * T, NCTX = NB * CL, NTOK = NLAT + NCTX;
constexpr int PW = 4096;
constexpr int DIN = 6144, DFF = 2752, DFFP = 2816, DFE = 3584, NE = 8;
constexpr float EPS = 1e-6f;
constexpr float LOG2E = 1.4426950408889634f;
constexpr float QSCALE = 0.125f * LOG2E;
constexpr int PC_Q = 0, PC_LF = 512, PC_G = 1024, PC_LB = 1536, PC_K = 2048, PC_V = 2560, PC_RQ = 3072, PC_RI = 3584, PC_GA = 2048, PC_GR = 3072;

constexpr size_t MiB = 1u << 20;
constexpr size_t WS_CTL = 0, CTL_BYTES = 1 * MiB;
constexpr size_t WS_MODS = 1 * MiB;
constexpr size_t WS_LBS = 3 * MiB;
constexpr size_t WS_ROPE = 3 * MiB + 65536;
constexpr size_t WS_ROUTE = 4 * MiB;
constexpr size_t WS_CNT = 6 * MiB;
constexpr size_t WS_RS0 = 131072;
constexpr size_t WS_BIASF = 7 * MiB;
constexpr size_t WS_AN = 640 * MiB;
constexpr float RS_SCALE = 1024.f;
constexpr size_t WS_CTXRES = 8 * MiB;
constexpr size_t WS_WIN = 40 * MiB;
constexpr size_t WS_WIN8 = 56 * MiB;
constexpr size_t WS_H8 = 809 * MiB;
constexpr size_t WS_WUA = 64 * MiB;
constexpr size_t WS_WUR = 66 * MiB;
constexpr size_t WS_WO = 68 * MiB;
constexpr size_t WS_W13 = 72 * MiB;
constexpr size_t WS_W2 = 83 * MiB;
constexpr size_t WS_H = 89 * MiB;
constexpr size_t WS_P = 233 * MiB;
constexpr size_t WS_MERGED = 89 * MiB;
constexpr size_t WS_HID = 233 * MiB;
constexpr size_t WS_WM13 = 896 * MiB;
constexpr size_t WS_WM2 = 952 * MiB;
constexpr size_t WS_AG = 89 * MiB;
constexpr size_t WS_MHID = 219 * MiB;
constexpr size_t WS_Y = 458 * MiB;
constexpr size_t WS_H2M = 720 * MiB;
constexpr size_t WS_END = 1024 * MiB;
constexpr int MOE_CHUNK = 256;

constexpr int CW_BAR = 4096;

#define LAS __attribute__((address_space(3)))
#define GAS __attribute__((address_space(1)))
typedef unsigned short bf16_t;
typedef short bf16x8 __attribute__((ext_vector_type(8)));
typedef short s16x4 __attribute__((ext_vector_type(4)));
typedef _Float16 half8 __attribute__((ext_vector_type(8)));
typedef _Float16 half4 __attribute__((ext_vector_type(4)));
typedef float f32x4 __attribute__((ext_vector_type(4)));
typedef float f32x2 __attribute__((ext_vector_type(2)));
typedef float f32x16 __attribute__((ext_vector_type(16)));
typedef unsigned u32x4 __attribute__((ext_vector_type(4)));
typedef unsigned u32x2 __attribute__((ext_vector_type(2)));
#define DI __device__ __forceinline__
#define LDS_WAIT() asm volatile("s_waitcnt lgkmcnt(0)" ::: "memory")
#define VM_WAIT() asm volatile("s_waitcnt vmcnt(0)" ::: "memory")
#define LDS_BARRIER() do { asm volatile("s_waitcnt lgkmcnt(0)" ::: "memory"); __builtin_amdgcn_s_barrier(); asm volatile("" ::: "memory"); } while (0)

typedef __bf16 bf16x2_t __attribute__((ext_vector_type(2)));
DI unsigned cvt_pk_bf16(float lo, float hi) { f32x2 v = {lo, hi}; bf16x2_t b = __builtin_convertvector(v, bf16x2_t); return __builtin_bit_cast(unsigned, b); }
typedef int v8i32 __attribute__((ext_vector_type(8)));
typedef int v4i32 __attribute__((ext_vector_type(4)));
DI unsigned pack_fp8x4(float a, float b, float c, float d) {
    a = fminf(fmaxf(a, -448.f), 448.f); b = fminf(fmaxf(b, -448.f), 448.f); c = fminf(fmaxf(c, -448.f), 448.f); d = fminf(fmaxf(d, -448.f), 448.f);
    int w = 0; w = __builtin_amdgcn_cvt_pk_fp8_f32(a, b, w, false); w = __builtin_amdgcn_cvt_pk_fp8_f32(c, d, w, true); return (unsigned)w; }
DI float bf2f(unsigned short b) { return __uint_as_float(((unsigned)b) << 16); }
DI float bflo(unsigned w) { return __uint_as_float(w << 16); }
DI float bfhi(unsigned w) { return __uint_as_float(w & 0xffff0000u); }
DI float fsilu(float x) { return x * __builtin_amdgcn_rcpf(1.f + __expf(-x)); }
DI float fsigmoid(float x) { return __builtin_amdgcn_rcpf(1.f + __expf(-x)); }
DI f32x4 exp2_4(f32x4 e) { return (f32x4){__builtin_amdgcn_exp2f(e[0]), __builtin_amdgcn_exp2f(e[1]), __builtin_amdgcn_exp2f(e[2]), __builtin_amdgcn_exp2f(e[3])}; }
DI f32x4 rcp_4(f32x4 d) { return (f32x4){__builtin_amdgcn_rcpf(d[0]), __builtin_amdgcn_rcpf(d[1]), __builtin_amdgcn_rcpf(d[2]), __builtin_amdgcn_rcpf(d[3])}; }
DI f32x4 sigmoid4(f32x4 x, float nsc) { return rcp_4(exp2_4(x * nsc) + 1.0f); }
DI f32x4 silu_mul4(f32x4 a, f32x4 b, float nsc, float osc) { const float k = 1.f / osc; return (a * b) * rcp_4(exp2_4(a * nsc) * k + k); }
DI float xhalf(float v, int hi) {
    const auto rr = __builtin_amdgcn_permlane32_swap(__float_as_uint(v), __float_as_uint(v), false, false);
    return __uint_as_float(hi ? rr[0] : rr[1]);
}
DI float xrow(float v, int odd) {
    const auto rr = __builtin_amdgcn_permlane16_swap(__float_as_uint(v), __float_as_uint(v), false, false);
    return __uint_as_float(odd ? rr[0] : rr[1]);
}
DI float wave_sum(float v) {
#pragma unroll
    for (int o = 1; o < 64; o <<= 1) v += __shfl_xor(v, o);
    return v;
}
DI int crow(int r, int hi) { return (r & 3) + 8 * (r >> 2) + 4 * hi; }

constexpr int LDS_WTAB_OFF = 148480 + 128;
DI int my_tid() {
    extern __shared__ __attribute__((aligned(16))) unsigned char lds_raw[];
    const unsigned hw = (unsigned)__builtin_amdgcn_s_getreg((5 << 11) | 4) & 63u;
    const int w = __builtin_amdgcn_readfirstlane(((volatile LAS int*)((LAS unsigned char*)lds_raw + LDS_WTAB_OFF))[hw]);
    int t = w * 64 + (int)__builtin_amdgcn_mbcnt_hi(~0u, __builtin_amdgcn_mbcnt_lo(~0u, 0u));
    asm volatile("" : "+v"(t)); return t;
}
#define XB_TMO      128
#define XB_XCNT(j)  (256  + 64 * (j))
#define XB_XSUB(j)  (1280 + 64 * (j))
#define XB_XGEN(j)  (2304 + 64 * (j))
#define XB_TOP      3328
#define XB_TOPGEN   3392
#define XCD_BAR_WORDS 3456
#define XB_SPIN_CAP (1u << 22)
DI unsigned xb_ld(unsigned* p)              { return __hip_atomic_load(p, __ATOMIC_RELAXED, __HIP_MEMORY_SCOPE_AGENT); }
DI unsigned xb_add(unsigned* p, unsigned v) { return __hip_atomic_fetch_add(p, v, __ATOMIC_RELAXED, __HIP_MEMORY_SCOPE_AGENT); }
DI unsigned xb_xcc_id() { return (unsigned)__builtin_amdgcn_s_getreg((3 << 11) | 20) & 0xFu; }
#define XB_SPIN(cond, bar) do { unsigned _sp = 0; while (cond) { __builtin_amdgcn_s_sleep(1); \
    if ((++_sp & 255u) == 0u) { if (xb_ld(&(bar)[XB_TMO])) break; if (_sp > XB_SPIN_CAP) { atomicAdd(&(bar)[XB_TMO], 1u); break; } } } } while (0)
struct XcdBarrier { unsigned* bar; unsigned x; volatile LAS unsigned* st; };
DI XcdBarrier xcd_barrier_post(unsigned* bar, volatile LAS unsigned* st) {
    XcdBarrier b; b.bar = bar; b.x = xb_xcc_id(); b.st = st;
    if (my_tid() == 0) (void)xb_add(&bar[XB_XCNT(b.x)], 1u);
    return b;
}
DI void xcd_barrier_complete(unsigned* bar, unsigned x, unsigned& nloc, unsigned& nx) {
    const unsigned G = gridDim.x * gridDim.y * gridDim.z;
    unsigned sum, cnt, mine, sp = 0u;
    for (;;) {
        sum = 0u; cnt = 0u; mine = 0u;
#pragma unroll
        for (unsigned j = 0; j < 16; ++j) { const unsigned c = xb_ld(&bar[XB_XCNT(j)]); sum += c; cnt += (c > 0u) ? 1u : 0u; mine = (j == x) ? c : mine; }
        if (sum == G) break;
        __builtin_amdgcn_s_sleep(1);
        if ((++sp & 255u) == 0u) { if (xb_ld(&bar[XB_TMO])) break; if (sp > XB_SPIN_CAP) { atomicAdd(&bar[XB_TMO], 1u); break; } }
    }
    nloc = mine > 0u ? mine : 1u; nx = cnt > 0u ? cnt : 1u;
}
DI void xcd_barrier(const XcdBarrier& b) {
    asm volatile("s_waitcnt vmcnt(0)" ::: "memory");
    __syncthreads();
    if (my_tid() == 0) {
        unsigned* bar = b.bar;
        __builtin_amdgcn_s_waitcnt(0);
        unsigned nloc = b.st[0], nx = b.st[1];
        if (nloc == 0u) { xcd_barrier_complete(bar, b.x, nloc, nx); b.st[0] = nloc; b.st[1] = nx; }
        const unsigned old = xb_add(&bar[XB_XSUB(b.x)], 1u);
        const unsigned gen = old / nloc;
        if (old + 1u == (gen + 1u) * nloc) {
            __builtin_amdgcn_fence(__ATOMIC_RELEASE, "agent");
            asm volatile("s_waitcnt vmcnt(0)" ::: "memory");
            const unsigned og = xb_add(&bar[XB_TOP], 1u);
            const unsigned tg = og / nx;
            if (og + 1u == (tg + 1u) * nx) xb_add(&bar[XB_TOPGEN], 1u);
            else XB_SPIN(xb_ld(&bar[XB_TOPGEN]) == tg, bar);
            __builtin_amdgcn_fence(__ATOMIC_ACQUIRE, "agent");
            xb_add(&bar[XB_XGEN(b.x)], 1u);
            asm volatile("s_waitcnt vmcnt(0)" ::: "memory");
        } else {
            XB_SPIN(xb_ld(&bar[XB_XGEN(b.x)]) == gen, bar);
            __builtin_amdgcn_fence(__ATOMIC_ACQUIRE, "agent");
            asm volatile("s_waitcnt vmcnt(0)" ::: "memory");
        }
    }
    __syncthreads();
}

namespace pg8 {
constexpr int BM = 256, BK = 64, HALF = 128, HTB = HALF * BK * 2, STAGE_BYTES = 8 * HTB, NXCD = 8, WGM = 8;
__host__ __device__ __forceinline__ int lds_byte(int r, int c) { const int st = (r >> 4) * 2 + (c >> 5), rr = r & 15, cc = c & 31, ob = rr * 64 + cc * 2; return st * 1024 + (ob ^ (((ob >> 9) & 1) << 5)); }
__host__ __device__ __forceinline__ void stage_rc(int b, int& R, int& C) { const int st = b / 1024, sb = b % 1024, swz = sb ^ (((sb >> 9) & 1) << 5); R = (st >> 1) * 16 + swz / 64; C = (st & 1) * 32 + (swz % 64) / 2; }
__host__ __device__ __forceinline__ int perm32(int rho) { const int n = rho >> 4, i = rho & 15; return 8 * (i >> 2) + 4 * n + (i & 3); }

struct Unit { int pm, pn; const char* a; const char* b; };
struct Gemm { const bf16_t* A; const bf16_t* Bt; int M, N, K, lda; };

struct StaticOrder {
    int nM, nN, nwg, G, c;
    DI void init(const Gemm& g, int G_, int c_) { nM = g.M / BM; nN = g.N / BM; nwg = nM * nN; G = G_; c = c_; }
    DI bool tile(int i, int& pm, int& pn) const {
        const int L = i * G + c; if (L >= nwg) return false;
        int wgid = L; { const int q = nwg / NXCD, r = nwg % NXCD, xcd = wgid % NXCD, off = wgid / NXCD; wgid = (xcd < r ? xcd * (q + 1) : r * (q + 1) + (xcd - r) * q) + off; }
        const int nig = WGM * nN, gid = wgid / nig, fm = gid * WGM, gsz = (nM - fm) < WGM ? (nM - fm) : WGM;
        pm = fm + ((wgid % nig) % gsz); pn = (wgid % nig) / gsz; return true;
    }
    DI bool next(const Gemm& g, int i, Unit& u) const { if (!tile(i, u.pm, u.pn)) return false;
        u.a = (const char*)g.A + (size_t)u.pm * ((size_t)BM * g.lda * 2); u.b = (const char*)g.Bt + (size_t)u.pn * ((size_t)BM * g.K * 2); return true; }
};
struct MoeOrder {
    StaticOrder so; int p0, apan0; int pb[7]; size_t estride;
    DI void load_pb(const int* pbv) {
#pragma unroll
        for (int k = 0; k < 7; ++k) pb[k] = __builtin_amdgcn_readfirstlane(pbv[k + 1]); }
    DI bool next(const Gemm& g, int i, Unit& u) const {
        int pm, pn; if (!so.tile(i, pm, pn)) return false;
        u.pm = p0 + pm; u.pn = pn; int e = 0;
#pragma unroll
        for (int k = 0; k < 7; ++k) e += (u.pm >= pb[k]) ? 1 : 0;
        u.a = (const char*)g.A + (size_t)(u.pm - apan0) * ((size_t)BM * g.lda * 2); u.b = (const char*)g.Bt + (size_t)e * estride + (size_t)pn * ((size_t)BM * g.K * 2); return true;
    }
};

template <class Epi, class Sched, bool ALIGN_EPI = true, bool F8 = false, bool MIDHOOK = false>
DI void gemm_phase(LAS unsigned char* lds, const Gemm g, const Sched& S, const Epi& E) {
    const int tid_ = my_tid();
    const int tid = tid_, wid = __builtin_amdgcn_readfirstlane(tid >> 6), lane = tid & 63, wr = wid >> 2, wc = wid & 3, fr = lane & 15, fq = lane >> 4;
    const int K = g.K, nt = K / BK;
    unsigned voffA[2], voffB[2];
#pragma unroll
    for (int i = 0; i < 2; ++i) { int R, C; stage_rc(tid * 16 + i * 8192, R, C); const int Rb = Epi::PERM ? ((R & ~31) + perm32(R & 31)) : R;
        voffA[i] = (unsigned)(R * g.lda + C) * 2u; voffB[i] = (unsigned)(Rb * K + C) * 2u; }
    const size_t kstep = (size_t)(BK * 2);
    const size_t hstepA = (size_t)HALF * g.lda * 2, hstepB = (size_t)HALF * K * 2;
    const unsigned ldsw = (unsigned)wid * 1024u;
    const int aoff = lds_byte(wr * 64 + fr, fq * 8), boff = lds_byte(wc * 32 + fr, fq * 8);
#define PG8_SA(b, h) (((b) * 2 + (h)) * HTB)
#define PG8_SB(b, h) ((4 + (b) * 2 + (h)) * HTB)
#define PG8_STAGE(bufoff, gbase, voff) do { _Pragma("unroll") for (int _i = 0; _i < 2; ++_i) \
        __builtin_amdgcn_global_load_lds((const unsigned*)((const char*)(gbase) + (voff)[_i]), (LAS unsigned*)(lds + (bufoff) + ldsw + _i * 8192), 16, 0, 0); } while (0)
#define PG8_LD8(p) __builtin_shufflevector(*(const LAS v4i32*)(p), *(const LAS v4i32*)((p) + 1024), 0, 1, 2, 3, 4, 5, 6, 7)
#define PG8_LDA(dst, b, h) do { if constexpr (F8) { _Pragma("unroll") for (int m = 0; m < 4; ++m) dst##8[m] = PG8_LD8(lds + PG8_SA(b, h) + aoff + m * 2048); } \
        else { _Pragma("unroll") for (int m = 0; m < 4; ++m) _Pragma("unroll") for (int k = 0; k < 2; ++k) dst[m][k] = *(const LAS bf16x8*)(lds + PG8_SA(b, h) + aoff + m * 2048 + k * 1024); } } while (0)
#define PG8_LDB(dst, b, h) do { if constexpr (F8) { _Pragma("unroll") for (int n = 0; n < 2; ++n) dst##8[n] = PG8_LD8(lds + PG8_SB(b, h) + boff + n * 2048); } \
        else { _Pragma("unroll") for (int n = 0; n < 2; ++n) _Pragma("unroll") for (int k = 0; k < 2; ++k) dst[n][k] = *(const LAS bf16x8*)(lds + PG8_SB(b, h) + boff + n * 2048 + k * 1024); } } while (0)
#define PG8_MMA(ai, bj, At, Bt) do { __builtin_amdgcn_s_setprio(1); \
        if constexpr (F8) { _Pragma("unroll") for (int m = 0; m < 4; ++m) _Pragma("unroll") for (int n = 0; n < 2; ++n) \
            asm volatile("v_mfma_scale_f32_16x16x128_f8f6f4 %0, %1, %2, %0, %3, %3 op_sel_hi:[0,0,0]" : "+v"(acc[ai][bj][m][n]) : "v"(Bt##8[n]), "v"(At##8[m]), "v"(one8)); } \
        else { _Pragma("unroll") for (int m = 0; m < 4; ++m) _Pragma("unroll") for (int n = 0; n < 2; ++n) _Pragma("unroll") for (int k = 0; k < 2; ++k) \
            acc[ai][bj][m][n] = __builtin_amdgcn_mfma_f32_16x16x32_bf16(Bt[n][k], At[m][k], acc[ai][bj][m][n], 0, 0, 0); } \
        __builtin_amdgcn_s_setprio(0); } while (0)
#define PG8_WAIT_V(n) asm volatile("s_waitcnt vmcnt(" #n ")" ::: "memory")
#define PG8_WAIT_VX(n) asm volatile("s_waitcnt vmcnt(%0)" :: "n"(n) : "memory")
#define PG8_WAIT_L(n) asm volatile("s_waitcnt lgkmcnt(" #n ")" ::: "memory")
#define PG8_BAR __builtin_amdgcn_s_barrier()
#define PG8_SCHED __builtin_amdgcn_sched_barrier(0)
    Unit cur, nxt; int ui = 0;
    if (!S.next(g, 0, cur)) return;
    f32x4 acc[2][2][4][2];
#pragma unroll
    for (int a = 0; a < 2; ++a)
#pragma unroll
        for (int b = 0; b < 2; ++b)
#pragma unroll
            for (int m = 0; m < 4; ++m)
#pragma unroll
                for (int n = 0; n < 2; ++n) acc[a][b][m][n] = (f32x4){0.f, 0.f, 0.f, 0.f};
    bf16x8 At[4][2], B0[2][2], B1[2][2]; v8i32 At8[4], B08[2], B18[2]; const int one8 = 0x7F7F7F7F;
    const char* cA = cur.a; const char* cB = cur.b;
    PG8_STAGE(PG8_SB(0, 0), cB, voffB); PG8_STAGE(PG8_SB(0, 1), cB + hstepB, voffB); PG8_STAGE(PG8_SA(0, 0), cA, voffA); PG8_STAGE(PG8_SA(0, 1), cA + hstepA, voffA);
    if (wr == 1) PG8_BAR;
    PG8_WAIT_V(2); PG8_BAR;
    PG8_STAGE(PG8_SB(1, 0), cB + kstep, voffB); PG8_STAGE(PG8_SA(1, 0), cA + kstep, voffA); PG8_STAGE(PG8_SB(1, 1), cB + hstepB + kstep, voffB);
    PG8_WAIT_V(6); PG8_BAR;
    for (;;) {
        const bool has_next = S.next(g, ui + 1, nxt);
        const char* nA = has_next ? nxt.a : cA; const char* nB = has_next ? nxt.b : cB;
        for (int t = 0; t < nt; t += 2) {
            const bool last = (t == nt - 2);
            if constexpr (MIDHOOK) { PG8_SCHED; if (t == nt / 2) E.mid(acc, cur, wr, wc, fr, fq); PG8_SCHED; }
            const char* a1 = cA + (size_t)(t + 1) * kstep;
            const char* a2 = last ? nA : cA + (size_t)(t + 2) * kstep; const char* b2 = last ? nB : cB + (size_t)(t + 2) * kstep;
            const char* a3 = a2 + kstep; const char* b3 = b2 + kstep;
            const int relax = __builtin_amdgcn_readfirstlane(((t == 0) && (ui > 0)) ? 1 : 0);
#define PG8_WAIT_V8R asm volatile("s_cmp_lg_u32 %0, 0\n\ts_cbranch_scc1 1f\n\ts_waitcnt vmcnt(8)\n1:\n\ts_waitcnt vmcnt(%1)" :: "s"(relax), "n"(8 + Epi::NVM) : "memory", "scc")
            PG8_LDB(B0, 0, 0); PG8_LDB(B1, 0, 1); PG8_SCHED; PG8_LDA(At, 0, 0); PG8_STAGE(PG8_SA(1, 1), a1 + hstepA, voffA);
            PG8_WAIT_V8R; PG8_WAIT_L(0); PG8_BAR; PG8_MMA(0, 0, At, B0); PG8_MMA(0, 1, At, B1); PG8_BAR; PG8_SCHED;
            PG8_LDA(At, 0, 1); PG8_STAGE(PG8_SB(0, 0), b2, voffB); PG8_STAGE(PG8_SB(0, 1), b2 + hstepB, voffB); PG8_STAGE(PG8_SA(0, 0), a2, voffA);
            PG8_WAIT_V8R; PG8_WAIT_L(0); PG8_BAR; PG8_MMA(1, 0, At, B0); PG8_MMA(1, 1, At, B1); PG8_BAR; PG8_SCHED;
            PG8_LDB(B0, 1, 0); PG8_LDB(B1, 1, 1); PG8_SCHED; PG8_LDA(At, 1, 0); PG8_STAGE(PG8_SA(0, 1), a2 + hstepA, voffA);
            PG8_WAIT_V(8); PG8_WAIT_L(0); PG8_BAR; PG8_MMA(0, 0, At, B0); PG8_MMA(0, 1, At, B1); PG8_BAR; PG8_SCHED;
            PG8_LDA(At, 1, 1); PG8_STAGE(PG8_SB(1, 0), b3, voffB); PG8_STAGE(PG8_SB(1, 1), b3 + hstepB, voffB); PG8_STAGE(PG8_SA(1, 0), a3, voffA);
            PG8_WAIT_V(8); PG8_WAIT_L(0); PG8_BAR; PG8_MMA(1, 0, At, B0); PG8_MMA(1, 1, At, B1); PG8_BAR; PG8_SCHED;
#undef PG8_WAIT_V8R
        }
        if constexpr (ALIGN_EPI) { if (wr == 0) PG8_BAR; }
        if constexpr (F8) asm volatile("s_nop 15\n\ts_nop 15" ::: "memory");
        E(acc, cur, wr, wc, fr, fq);
        if (!has_next) break;
#pragma unroll
        for (int a = 0; a < 2; ++a)
#pragma unroll
            for (int b = 0; b < 2; ++b)
#pragma unroll
                for (int m = 0; m < 4; ++m)
#pragma unroll
                    for (int n = 0; n < 2; ++n) acc[a][b][m][n] = (f32x4){0.f, 0.f, 0.f, 0.f};
        cur = nxt; cA = nA; cB = nB; ++ui;
        if constexpr (ALIGN_EPI) { if (wr == 1) PG8_BAR; }
    }
    PG8_WAIT_V(0);
    if constexpr (!ALIGN_EPI) { if (wr == 0) PG8_BAR; }
    PG8_BAR;
#undef PG8_SA
#undef PG8_SB
#undef PG8_STAGE
#undef PG8_LDA
#undef PG8_LD8
#undef PG8_LDB
#undef PG8_MMA
#undef PG8_WAIT_V
#undef PG8_WAIT_VX
#undef PG8_WAIT_L
#undef PG8_BAR
#undef PG8_SCHED
}
}
using pg8::Unit; using pg8::Gemm;
typedef const f32x4 (&AccRef)[2][2][4][2];

DI u32x4 pack8(const f32x4& v0, const f32x4& v1) { u32x4 w; w.x = cvt_pk_bf16(v0[0], v0[1]); w.y = cvt_pk_bf16(v0[2], v0[3]); w.z = cvt_pk_bf16(v1[0], v1[1]); w.w = cvt_pk_bf16(v1[2], v1[3]); return w; }
DI void unpack8(const u32x4& w, float (&f)[8]) { f[0] = bflo(w.x); f[1] = bfhi(w.x); f[2] = bflo(w.y); f[3] = bfhi(w.y); f[4] = bflo(w.z); f[5] = bfhi(w.z); f[6] = bflo(w.w); f[7] = bfhi(w.w); }

struct EpiInProj {
    static constexpr int NVM = 16; static constexpr bool PERM = true;
    bf16_t* P; const float2* rope; const float* lbf; const float* lbb; int secmap; float asc;
    template <int MODE> DI void run(AccRef acc, const Unit& u, int wr, int wc, int fr, int fq, int sec) const {
        const int row0 = u.pm * 256 + wr * 64 + fr, col0 = sec * 512 + (u.pn & 1) * 256 + wc * 32 + 8 * fq;
        const bool lat = u.pm < (NLAT / 256); const float qs = sec == 0 ? QSCALE : 1.f;
        f32x4 lb0[2], lb1[2];
        if (MODE == 2) {
#pragma unroll
            for (int bj = 0; bj < 2; ++bj) { const float* lb = (sec == 1 ? lbf : lbb) + ((col0 + bj * 128) & 511); lb0[bj] = *(const f32x4*)lb; lb1[bj] = *(const f32x4*)(lb + 4); } }
        f32x4 rr[2][4][2];
        if (MODE == 3) {
#pragma unroll
            for (int ai = 0; ai < 2; ++ai)
#pragma unroll
                for (int m = 0; m < 4; ++m) { const f32x4* rp = (const f32x4*)(rope + (size_t)((row0 + ai * 128 + m * 16) & (T - 1)) * 32 + ((col0 & 63) >> 1));
                    rr[ai][m][0] = lat ? rp[0] : (f32x4){1.f, 0.f, 1.f, 0.f}; rr[ai][m][1] = lat ? rp[1] : (f32x4){1.f, 0.f, 1.f, 0.f}; } }
#pragma unroll
        for (int ai = 0; ai < 2; ++ai)
#pragma unroll
            for (int m = 0; m < 4; ++m) {
                const int row = row0 + ai * 128 + m * 16; bf16_t* rowp = P + (size_t)row * PW + col0;
#pragma unroll
                for (int bj = 0; bj < 2; ++bj) {
                    f32x4 v0 = acc[ai][bj][m][0] * asc, v1 = acc[ai][bj][m][1] * asc; u32x4 w;
                    if (MODE == 3) {
                        {
                            const f32x4 r0 = rr[ai][m][0], r1 = rr[ai][m][1];
                            f32x4 o0, o1;
                            o0[0] = v0[0] * r0[0] - v0[1] * r0[1]; o0[1] = v0[0] * r0[1] + v0[1] * r0[0];
                            o0[2] = v0[2] * r0[2] - v0[3] * r0[3]; o0[3] = v0[2] * r0[3] + v0[3] * r0[2];
                            o1[0] = v1[0] * r1[0] - v1[1] * r1[1]; o1[1] = v1[0] * r1[1] + v1[1] * r1[0];
                            o1[2] = v1[2] * r1[2] - v1[3] * r1[3]; o1[3] = v1[2] * r1[3] + v1[3] * r1[2];
                            v0 = o0; v1 = o1;
                        }
                        w = pack8(v0 * qs, v1 * qs);
                    } else if (MODE == 1) {
#pragma unroll
                        for (int j = 0; j < 4; ++j) { v0[j] = fsilu(v0[j]); v1[j] = fsilu(v1[j]); }
                        w = pack8(v0, v1);
                    } else if (MODE == 2) {
                        half8 hv;
#pragma unroll
                        for (int j = 0; j < 8; ++j) {
                            const float z = fmaxf(j < 4 ? v0[j] : v1[j - 4], -80.f), b = j < 4 ? lb0[bj][j] : lb1[bj][j - 4];
                            const float sg = __builtin_amdgcn_rcpf(1.f + __builtin_amdgcn_exp2f(-LOG2E * z));
                            hv[j] = (_Float16)(0.6931471805599453f * __builtin_amdgcn_logf(b + (1.f - b) * sg));
                        }
                        w = __builtin_bit_cast(u32x4, hv);
                    } else w = pack8(v0, v1);
                    *(u32x4*)(rowp + bj * 128) = w;
                }
            }
    }
    DI void operator()(AccRef acc, const Unit& u, int wr, int wc, int fr, int fq) const {
        const int sec = (secmap >> (4 * (u.pn >> 1))) & 15;
        if (sec == 0 || sec == 4) run<3>(acc, u, wr, wc, fr, fq, sec);
        else if (sec == 2 || sec == 6) run<1>(acc, u, wr, wc, fr, fq, sec);
        else if (sec == 1 || sec == 3) run<2>(acc, u, wr, wc, fr, fq, sec);
        else run<0>(acc, u, wr, wc, fr, fq, sec);
    }
};
struct EpiGates {
    static constexpr int NVM = 16; static constexpr bool PERM = true; bf16_t* P; float asc;
    DI void operator()(AccRef acc, const Unit& u, int wr, int wc, int fr, int fq) const {
        const int row0 = u.pm * 256 + wr * 64 + fr, col0 = PC_GA + u.pn * 256 + wc * 32 + 8 * fq;
#pragma unroll
        for (int ai = 0; ai < 2; ++ai)
#pragma unroll
            for (int m = 0; m < 4; ++m) { bf16_t* rowp = P + (size_t)(row0 + ai * 128 + m * 16) * PW + col0;
#pragma unroll
                for (int bj = 0; bj < 2; ++bj) *(u32x4*)(rowp + bj * 128) = pack8(sigmoid4(acc[ai][bj][m][0], -asc * LOG2E), sigmoid4(acc[ai][bj][m][1], -asc * LOG2E)); }
    }
};
struct EpiMergeFused {
    static constexpr int NVM = 16; static constexpr bool PERM = true; const bf16_t* P; bf16_t* O;
    DI void mid(f32x4 (&acc)[2][2][4][2], const Unit& u, int wr, int wc, int fr, int fq) const {
        int row0 = u.pm * 256 + wr * 64 + fr, col0 = u.pn * 256 + wc * 32 + 8 * fq;
        asm volatile("" : "+v"(row0), "+v"(col0));
#pragma unroll
        for (int ai = 0; ai < 2; ++ai)
#pragma unroll
            for (int m = 0; m < 4; ++m) { const size_t row = (size_t)(row0 + ai * 128 + m * 16);
#pragma unroll
                for (int bj = 0; bj < 2; ++bj) {
                    float ga[8], gr[8]; unpack8(*(const u32x4*)(P + row * PW + PC_GA + col0 + bj * 128), ga); unpack8(*(const u32x4*)(P + row * PW + PC_GR + col0 + bj * 128), gr);
#pragma unroll
                    for (int j = 0; j < 4; ++j) { acc[ai][bj][m][0][j] *= ga[j] * __builtin_amdgcn_rcpf(fmaxf(gr[j], 1e-30f)); acc[ai][bj][m][1][j] *= ga[4 + j] * __builtin_amdgcn_rcpf(fmaxf(gr[4 + j], 1e-30f)); } }
                asm volatile("" ::: "memory"); }
    }
    DI void operator()(AccRef acc, const Unit& u, int wr, int wc, int fr, int fq) const {
        const int row0 = u.pm * 256 + wr * 64 + fr, col0 = u.pn * 256 + wc * 32 + 8 * fq;
        u32x4 gq[2][4][2];
#pragma unroll
        for (int ai = 0; ai < 2; ++ai)
#pragma unroll
            for (int m = 0; m < 4; ++m)
#pragma unroll
                for (int bj = 0; bj < 2; ++bj) gq[ai][m][bj] = *(const u32x4*)(P + (size_t)(row0 + ai * 128 + m * 16) * PW + PC_GR + col0 + bj * 128);
#pragma unroll
        for (int ai = 0; ai < 2; ++ai)
#pragma unroll
            for (int m = 0; m < 4; ++m) { const size_t row = (size_t)(row0 + ai * 128 + m * 16);
#pragma unroll
                for (int bj = 0; bj < 2; ++bj) {
                    float gr[8]; unpack8(gq[ai][m][bj], gr);
                    f32x4 v0 = acc[ai][bj][m][0], v1 = acc[ai][bj][m][1];
#pragma unroll
                    for (int j = 0; j < 4; ++j) { v0[j] *= fmaxf(gr[j], 1e-30f); v1[j] *= fmaxf(gr[4 + j], 1e-30f); }
                    *(u32x4*)(O + row * D + col0 + bj * 128) = pack8(v0, v1); } }
    }
};
struct EpiResid {
    static constexpr int NVM = 16; static constexpr bool PERM = false;
    const float* xin_l; const float* xin_c; float* xout_l; float* xout_c; const float* mods; int msel;
    DI void operator()(AccRef acc, const Unit& u, int wr, int wc, int fr, int fq) const {
        const bool lat = u.pm < (NLAT / 256);
        const int rbase = (lat ? u.pm : u.pm - NLAT / 256) * 256 + wr * 64 + fr, col0 = u.pn * 256 + wc * 32 + 4 * fq;
        const float* xi = lat ? xin_l : xin_c; float* xo = lat ? xout_l : xout_c;
        const float* mv = mods + (size_t)(lat ? (u.pm >> 3) : 32) * DIN + msel * D + col0;
        f32x4 g[2][2];
#pragma unroll
        for (int bj = 0; bj < 2; ++bj)
#pragma unroll
            for (int n = 0; n < 2; ++n) g[bj][n] = *(const f32x4*)(mv + bj * 128 + n * 16);
        f32x4 xa[4][2][2], r0[4][2][2];
#define RES_OFF(ai, m) ((size_t)(rbase + (ai) * 128 + (m) * 16) * D + col0)
#pragma unroll
        for (int m = 0; m < 4; ++m)
#pragma unroll
            for (int bj = 0; bj < 2; ++bj)
#pragma unroll
                for (int n = 0; n < 2; ++n) xa[m][bj][n] = *(const f32x4*)(xi + RES_OFF(0, m) + bj * 128 + n * 16);
#pragma unroll
        for (int m = 0; m < 4; ++m)
#pragma unroll
            for (int bj = 0; bj < 2; ++bj)
#pragma unroll
                for (int n = 0; n < 2; ++n) r0[m][bj][n] = xa[m][bj][n] + g[bj][n] * acc[0][bj][m][n];
#pragma unroll
        for (int m = 0; m < 4; ++m)
#pragma unroll
            for (int bj = 0; bj < 2; ++bj)
#pragma unroll
                for (int n = 0; n < 2; ++n) xa[m][bj][n] = *(const f32x4*)(xi + RES_OFF(1, m) + bj * 128 + n * 16);
        asm volatile("" ::: "memory");
#pragma unroll
        for (int m = 0; m < 4; ++m)
#pragma unroll
            for (int bj = 0; bj < 2; ++bj)
#pragma unroll
                for (int n = 0; n < 2; ++n) *(f32x4*)(xo + RES_OFF(0, m) + bj * 128 + n * 16) = r0[m][bj][n];
#pragma unroll
        for (int m = 0; m < 4; ++m)
#pragma unroll
            for (int bj = 0; bj < 2; ++bj)
#pragma unroll
                for (int n = 0; n < 2; ++n) *(f32x4*)(xo + RES_OFF(1, m) + bj * 128 + n * 16) = xa[m][bj][n] + g[bj][n] * acc[1][bj][m][n];
#undef RES_OFF
    }
};
struct EpiResidN {
    static constexpr int NVM = 16; static constexpr bool PERM = true;
    const float* xin_l; const float* xin_c; float* xout_l; float* xout_c; const float* mods; int msel;
    const float* nw; int nsc; bf16_t* A; unsigned* RS;
    DI void operator()(AccRef acc, const Unit& u, int, int, int, int) const {
        const int te_ = my_tid(); const int wid_ = __builtin_amdgcn_readfirstlane(te_ >> 6), wr = wid_ >> 2, wc = wid_ & 3, fr = te_ & 15, fq = (te_ >> 4) & 3;
        const bool lat = u.pm < (NLAT / 256); const int bidx = lat ? (u.pm >> 3) : 32;
        const int rbase = (lat ? u.pm : u.pm - NLAT / 256) * 256 + wr * 64 + fr, urow0 = u.pm * 256 + wr * 64 + fr, col0 = u.pn * 256 + wc * 32 + 8 * fq;
        const float* xi = lat ? xin_l : xin_c; float* xo = lat ? xout_l : xout_c;
        const float* mv = mods + (size_t)bidx * DIN + msel * D + col0; const float* nv = mods + (size_t)bidx * DIN + nsc * D + col0;
        f32x4 (&ga)[2][2][4][2] = const_cast<f32x4 (&)[2][2][4][2]>(acc);
        u32x2 gwp[2][2];
#pragma unroll
        for (int bj = 0; bj < 2; ++bj)
#pragma unroll
            for (int n = 0; n < 2; ++n) { const f32x4 g = *(const f32x4*)(mv + bj * 128 + n * 4); const f32x4 gwf = *(const f32x4*)(nw + col0 + bj * 128 + n * 4) * (*(const f32x4*)(nv + bj * 128 + n * 4) + 1.0f);
                gwp[bj][n].x = cvt_pk_bf16(gwf[0], gwf[1]); gwp[bj][n].y = cvt_pk_bf16(gwf[2], gwf[3]);
#pragma unroll
                for (int ai = 0; ai < 2; ++ai)
#pragma unroll
                    for (int m = 0; m < 4; ++m) ga[ai][bj][m][n] *= g; }
        f32x4 xa[4][2][2];
#define RES_OFF(ai, m) ((size_t)(rbase + (ai) * 128 + (m) * 16) * D + col0)
#define RESN_OUT(ai, m, X) do { const size_t uo_ = (size_t)(urow0 + (ai) * 128 + (m) * 16) * D + col0; float ss_ = 0.f; \
            _Pragma("unroll") for (int bj = 0; bj < 2; ++bj) { const f32x4 x0 = X[m][bj][0], x1 = X[m][bj][1]; \
                *(f32x4*)(xo + RES_OFF(ai, m) + bj * 128) = x0; *(f32x4*)(xo + RES_OFF(ai, m) + bj * 128 + 4) = x1; \
                ss_ += ((x0[0] * x0[0] + x0[1] * x0[1]) + (x0[2] * x0[2] + x0[3] * x0[3])) + ((x1[0] * x1[0] + x1[1] * x1[1]) + (x1[2] * x1[2] + x1[3] * x1[3])); \
                const f32x4 w0_ = {bflo(gwp[bj][0].x), bfhi(gwp[bj][0].x), bflo(gwp[bj][0].y), bfhi(gwp[bj][0].y)}, w1_ = {bflo(gwp[bj][1].x), bfhi(gwp[bj][1].x), bflo(gwp[bj][1].y), bfhi(gwp[bj][1].y)}; \
                *(u32x4*)(A + uo_ + bj * 128) = pack8(x0 * w0_, x1 * w1_); } \
            ss_ += xrow(ss_, fq & 1); ss_ += xhalf(ss_, fq >> 1); \
            if (fq == 0) (void)__hip_atomic_fetch_add(RS + urow0 + (ai) * 128 + (m) * 16, (unsigned)fminf(ss_ * RS_SCALE + 0.5f, 2.6e8f), __ATOMIC_RELAXED, __HIP_MEMORY_SCOPE_AGENT); } while (0)
#pragma unroll
        for (int q = 0; q < 4; ++q) { const int ai = q >> 1, m0 = (q & 1) * 2;
#pragma unroll
            for (int m = m0; m < m0 + 2; ++m)
#pragma unroll
                for (int bj = 0; bj < 2; ++bj)
#pragma unroll
                    for (int n = 0; n < 2; ++n) xa[m][bj][n] = *(const f32x4*)(xi + RES_OFF(ai, m) + bj * 128 + n * 4);
#pragma unroll
            for (int m = m0; m < m0 + 2; ++m)
#pragma unroll
                for (int bj = 0; bj < 2; ++bj)
#pragma unroll
                    for (int n = 0; n < 2; ++n) xa[m][bj][n] = xa[m][bj][n] + ga[ai][bj][m][n];
            asm volatile("" ::: "memory");
#pragma unroll
            for (int m = m0; m < m0 + 2; ++m) RESN_OUT(ai, m, xa); }
#undef RESN_OUT
#undef RES_OFF
    }
};
struct EpiSwiglu {
    static constexpr int NVM = 16; static constexpr bool PERM = true; bf16_t* Hd; int ldh; int pan0; const unsigned* RS; const float* bias;
    DI void operator()(AccRef acc, const Unit& u, int wr, int wc, int fr, int fq) const {
        const int row0 = (u.pm - pan0) * 256 + wr * 64 + fr, hc0 = u.pn * 128 + wc * 16 + 4 * fq;
        f32x4 bz[2][2]; float rsd[2][4];
#pragma unroll
        for (int bj = 0; bj < 2; ++bj) { const float* bp = bias + (size_t)(u.pm < NLAT / 256 ? (u.pm >> 3) : 32) * (2 * DFFP) + u.pn * 256 + bj * 128 + wc * 32 + 8 * fq;
            bz[bj][0] = *(const f32x4*)bp; bz[bj][1] = *(const f32x4*)(bp + 4); }
#pragma unroll
        for (int ai = 0; ai < 2; ++ai)
#pragma unroll
            for (int m = 0; m < 4; ++m) rsd[ai][m] = 1.f / sqrtf((float)RS[u.pm * 256 + wr * 64 + fr + ai * 128 + m * 16] * (1.f / (D * RS_SCALE)) + EPS);
#pragma unroll
        for (int ai = 0; ai < 2; ++ai)
#pragma unroll
            for (int m = 0; m < 4; ++m) { bf16_t* rowp = Hd + (size_t)(row0 + ai * 128 + m * 16) * ldh + hc0;
#pragma unroll
                for (int bj = 0; bj < 2; ++bj) { const f32x4 a = acc[ai][bj][m][0] * rsd[ai][m] + bz[bj][0], b = acc[ai][bj][m][1] * rsd[ai][m] + bz[bj][1];
                    const f32x4 h = silu_mul4(a, b, -LOG2E, 1.f);
                    u32x2 w; w.x = cvt_pk_bf16(h[0], h[1]); w.y = cvt_pk_bf16(h[2], h[3]);
                    *(u32x2*)(rowp + bj * 64) = w; } }
    }
};
struct EpiSwiglu8 {
    static constexpr int NVM = 16; static constexpr bool PERM = true; unsigned char* Hd; int ldh; int pan0; float as, hs;
    DI void operator()(AccRef acc, const Unit& u, int wr, int wc, int fr, int fq) const {
        const int row0 = (u.pm - pan0) * 256 + wr * 64 + fr, hc0 = u.pn * 128 + wc * 16 + 4 * fq;
#pragma unroll
        for (int ai = 0; ai < 2; ++ai)
#pragma unroll
            for (int m = 0; m < 4; ++m) { unsigned char* rowp = Hd + (size_t)(row0 + ai * 128 + m * 16) * ldh + hc0;
#pragma unroll
                for (int bj = 0; bj < 2; ++bj) { const f32x4 h = silu_mul4(acc[ai][bj][m][0], acc[ai][bj][m][1], -as * LOG2E, as * as * hs);
                    *(unsigned*)(rowp + bj * 64) = pack_fp8x4(h[0], h[1], h[2], h[3]); } }
    }
};
struct EpiBf16 {
    static constexpr int NVM = 16; static constexpr bool PERM = true; bf16_t* O; int ldc; float sc;
    DI void operator()(AccRef acc, const Unit& u, int wr, int wc, int fr, int fq) const {
        const int row0 = u.pm * 256 + wr * 64 + fr, col0 = u.pn * 256 + wc * 32 + 8 * fq;
#pragma unroll
        for (int ai = 0; ai < 2; ++ai)
#pragma unroll
            for (int m = 0; m < 4; ++m) { bf16_t* rowp = O + (size_t)(row0 + ai * 128 + m * 16) * ldc + col0;
#pragma unroll
                for (int bj = 0; bj < 2; ++bj) *(u32x4*)(rowp + bj * 128) = pack8(acc[ai][bj][m][0] * sc, acc[ai][bj][m][1] * sc); }
    }
};

typedef short v4i16 __attribute__((ext_vector_type(4)));
DI s16x4 tr16(const LAS unsigned char* p) { return __builtin_bit_cast(s16x4, __builtin_amdgcn_ds_read_tr16_b64_v4i16((LAS v4i16*)p)); }
DI bf16x8 cat8(s16x4 lo, s16x4 hi) { return __builtin_shufflevector(lo, hi, 0, 1, 2, 3, 4, 5, 6, 7); }
DI void dma16(const void* g, LAS unsigned char* l) { __builtin_amdgcn_global_load_lds((const unsigned*)g, (LAS unsigned*)l, 16, 0, 0); }
DI void dma16a(const void* g, LAS unsigned char* l) {
    const unsigned la = __builtin_amdgcn_readfirstlane((unsigned)(size_t)l); unsigned m0s;
    asm volatile("s_mov_b32 %0, m0\n\ts_mov_b32 m0, %2\n\ts_nop 0\n\tglobal_load_lds_dwordx4 %1, off\n\ts_mov_b32 m0, %0" : "=&s"(m0s) : "v"(g), "s"(la) : "memory");
}
DI bf16x8 packf8(const f32x16& x, int s) {
    u32x4 w; w.x = cvt_pk_bf16(x[8 * s], x[8 * s + 1]); w.y = cvt_pk_bf16(x[8 * s + 2], x[8 * s + 3]); w.z = cvt_pk_bf16(x[8 * s + 4], x[8 * s + 5]); w.w = cvt_pk_bf16(x[8 * s + 6], x[8 * s + 7]);
    return __builtin_bit_cast(bf16x8, w);
}
#define MFMA32(a, b, c) __builtin_amdgcn_mfma_f32_32x32x16_bf16((a), (b), (c), 0, 0, 0)

struct Params { const float* in[28]; float* out; unsigned char* ws; int ph_lo, ph_hi, li, pad; };
typedef const __attribute__((address_space(4))) Params* KP;
DI KP kparams() { KP kp = (KP)__builtin_amdgcn_kernarg_segment_ptr(); asm volatile("" : "+s"(kp)); return kp; }
#define PIN(k) (kparams()->in[k])
#define POUT (kparams()->out)
struct Ctx {
    LAS unsigned char* lds; unsigned char* ws; int tid, lane, wave, vcu, G, gw, NGW, bx;
};

constexpr float WIN8_SCALE = 64.f;
#ifndef FP8_SECS0
#define FP8_SECS0 0xE4
#endif
#ifndef FP8_SECS1
#define FP8_SECS1 0xE4
#endif
constexpr int sec_order(int i) { return (int)((0x76524310u >> (4 * i)) & 15u); }
constexpr int sec_slot(int fs, int ps) { int nb = 0, nf = 0; for (int i = 0; i < 8; ++i) { const int s_ = sec_order(i); const bool f = (fs >> s_) & 1; if (s_ == ps) return f ? (0x100 | nf) : nb; if (f) ++nf; else ++nb; } return 0; }
constexpr int n_sec_f8(int fs) { return __builtin_popcount((unsigned)fs); }
constexpr unsigned secmap_of(int fs, bool f8) { unsigned m = 0; int k = 0; for (int i = 0; i < 8; ++i) { const int s_ = sec_order(i); if ((((fs >> s_) & 1) != 0) == f8) { m |= (unsigned)s_ << (4 * k); ++k; } } return m; }
DI int map_row(int kind, int n, int fs) {
    if (kind == 0) return n;
    if (kind == 2) return 8 * (n >> 2) + (n & 3);
    if (kind == 3) return 8 * (n >> 2) + (n & 3) + 4;
    const int sec = n >> 9, j = n & 511; int r;
    if (n >= 4096) r = (1 << 16) | (n_sec_f8(fs) * 512 + (n - 4096));
    else {
        const int ps = sec == 0 ? 0 : sec == 1 ? 4 : sec == 2 ? 5 : sec == 3 ? 6 : sec == 4 ? 7 : sec == 5 ? 1 : sec == 6 ? 3 : 2;
        const int sl = sec_slot(fs, ps); int jj = j;
        if (sec == 0 || sec == 1) { const int hs = j >> 6, d = j & 63; jj = hs * 64 + (d < 32 ? 2 * d : 2 * (d - 32) + 1); }
        r = ((sl & 0x100) ? (1 << 16) : 0) | ((sl & 0xff) * 512 + jj); }
    return kind == 4 ? (r & 0xffff) : r;
}
constexpr int TP_PITCH = 68, TP_SCR = 64 * TP_PITCH * 4;
DI void transpose_load(const float* W, int ldw, int k0, int n0, LAS float* scr, int lane) {
    const int r = lane >> 4, c4 = (lane & 15) * 4; f32x4 v[16];
#pragma unroll
    for (int i = 0; i < 16; ++i) v[i] = *(const f32x4*)(W + (size_t)(k0 + 4 * i + r) * ldw + n0 + c4);
#pragma unroll
    for (int i = 0; i < 16; ++i) *(LAS f32x4*)(scr + (4 * i + r) * TP_PITCH + c4) = v[i];
    LDS_WAIT(); asm volatile("" ::: "memory");
}
DI void transpose_item(const float* W, int ldw, int k0, int n0, bf16_t* WT, int ldt, int kind, LAS float* scr, int lane, int fs = 0) {
    transpose_load(W, ldw, k0, n0, scr, lane);
    bf16_t* dst = WT + (size_t)map_row(kind, n0 + lane, fs) * ldt + k0;
#pragma unroll
    for (int j = 0; j < 8; ++j) { const LAS float* s = scr + (8 * j) * TP_PITCH + lane;
        u32x4 o; o.x = cvt_pk_bf16(s[0], s[TP_PITCH]); o.y = cvt_pk_bf16(s[2 * TP_PITCH], s[3 * TP_PITCH]); o.z = cvt_pk_bf16(s[4 * TP_PITCH], s[5 * TP_PITCH]); o.w = cvt_pk_bf16(s[6 * TP_PITCH], s[7 * TP_PITCH]);
        *(u32x4*)(dst + 8 * j) = o; }
    LDS_WAIT(); asm volatile("" ::: "memory");
}
DI void transpose_item8(const float* W, int ldw, int k0, int n0, unsigned char* WT, int ldt, int kind, float sc, LAS float* scr, int lane, int fs = 0) {
    transpose_load(W, ldw, k0, n0, scr, lane);
    unsigned char* dst = WT + (size_t)map_row(kind, n0 + lane, fs) * ldt + k0;
#pragma unroll
    for (int j = 0; j < 4; ++j) { const LAS float* s = scr + (16 * j) * TP_PITCH + lane; u32x4 o;
        o.x = pack_fp8x4(s[0] * sc, s[TP_PITCH] * sc, s[2 * TP_PITCH] * sc, s[3 * TP_PITCH] * sc); o.y = pack_fp8x4(s[4 * TP_PITCH] * sc, s[5 * TP_PITCH] * sc, s[6 * TP_PITCH] * sc, s[7 * TP_PITCH] * sc);
        o.z = pack_fp8x4(s[8 * TP_PITCH] * sc, s[9 * TP_PITCH] * sc, s[10 * TP_PITCH] * sc, s[11 * TP_PITCH] * sc); o.w = pack_fp8x4(s[12 * TP_PITCH] * sc, s[13 * TP_PITCH] * sc, s[14 * TP_PITCH] * sc, s[15 * TP_PITCH] * sc);
        *(u32x4*)(dst + 16 * j) = o; }
    LDS_WAIT(); asm volatile("" ::: "memory");
}
DI void transpose_matrix8(const Ctx& C, const float* W, int K, int N, unsigned char* WT, int ldt, int kind, float sc, int& itbase) {
    LAS float* scr = (LAS float*)(C.lds + C.wave * TP_SCR);
    const int nblk = N / 64, nit = (K / 64) * nblk;
    int first = (C.gw - (itbase % C.NGW) + C.NGW) % C.NGW;
    for (int it = first; it < nit; it += C.NGW) transpose_item8(W, N, 64 * (it / nblk), 64 * (it % nblk), WT, ldt, kind, sc, scr, C.lane);
    itbase += nit;
}
DI void transpose_matrix(const Ctx& C, const float* W, int K, int N, bf16_t* WT, int ldt, int kind, int& itbase, int total_unused) {
    (void)total_unused;
    LAS float* scr = (LAS float*)(C.lds + C.wave * TP_SCR);
    const int nblk = N / 64, nit = (K / 64) * nblk;
    int first = (C.gw - (itbase % C.NGW) + C.NGW) % C.NGW;
    for (int it = first; it < nit; it += C.NGW) transpose_item(W, N, 64 * (it / nblk), 64 * (it % nblk), WT, ldt, kind, scr, C.lane);
    itbase += nit;
}
DI void transpose_win(const Ctx& C, const float* W, bf16_t* WA, unsigned char* W8, int& itbase, int fs) {
    LAS float* scr = (LAS float*)(C.lds + C.wave * TP_SCR);
    const int nblk = DIN / 64, nit = (D / 64) * nblk;
    int first = (C.gw - (itbase % C.NGW) + C.NGW) % C.NGW;
    for (int it = first; it < nit; it += C.NGW) { const int k0 = 64 * (it / nblk), n0 = 64 * (it % nblk);
        if (map_row(1, n0, fs) >> 16) transpose_item8(W, DIN, k0, n0, W8, D, 4, WIN8_SCALE, scr, C.lane, fs);
        else transpose_item(W, DIN, k0, n0, WA, D, 1, scr, C.lane, fs); }
    itbase += nit;
}
constexpr int MD_SP = 36;
template <int KIND> DI void phase_rowgemm(const Ctx& C, const int task) {
    const int l = task / (KIND == 0 ? 96 : 43), n0 = (task % (KIND == 0 ? 96 : 43)) * 64, kq = C.lane >> 4, cq = C.lane & 15;
    LAS float* S = (LAS float*)C.lds;
    const int ldw = KIND == 0 ? DIN : DFF;
    const float* W = (KIND == 0 ? PIN(4) + (size_t)l * D * DIN : (l ? PIN(21) : PIN(20))) + n0 + 4 * cq; const float* c0 = PIN(1); const float* cc = PIN(3);
    const float* shv = (const float*)(C.ws + WS_MODS) + 3 * D;
    f32x4 acc[33];
#pragma unroll
    for (int r = 0; r < 33; ++r) acc[r] = (f32x4){0.f, 0.f, 0.f, 0.f};
#pragma unroll 1
    for (int kh = 0; kh < 2; ++kh) {
        __syncthreads();
        for (int i = C.tid; i < 33 * 512; i += 512) { const int r = i >> 9, kk = i & 511;
            S[kk * MD_SP + r] = KIND == 0 ? fsilu(r < 32 ? c0[r * D + kh * 512 + kk] : cc[kh * 512 + kk]) : shv[(size_t)r * DIN + kh * 512 + kk]; }
        __syncthreads();
        const int kb = C.wave * 64 + kq;
#pragma unroll 1
        for (int ib = 0; ib < 16; ib += 8) { f32x4 w[8];
#pragma unroll
            for (int i = 0; i < 8; ++i) w[i] = *(const f32x4*)(W + (size_t)(kh * 512 + kb + 4 * (ib + i)) * ldw);
#pragma unroll
            for (int i = 0; i < 8; ++i) { const LAS float* sp = S + (kb + 4 * (ib + i)) * MD_SP;
#pragma unroll
                for (int q = 0; q < 8; ++q) { const f32x4 s4 = *(const LAS f32x4*)(sp + 4 * q);
                    acc[4 * q] += w[i] * s4[0]; acc[4 * q + 1] += w[i] * s4[1]; acc[4 * q + 2] += w[i] * s4[2]; acc[4 * q + 3] += w[i] * s4[3]; }
                acc[32] += w[i] * sp[32]; } }
    }
#pragma unroll
    for (int r = 0; r < 33; ++r)
#pragma unroll
        for (int j = 0; j < 4; ++j) { float v = acc[r][j]; v += __shfl_xor(v, 16); v += __shfl_xor(v, 32); asm volatile("" : "+v"(v)); acc[r][j] = v; }
    __syncthreads();
    LAS float* red = (LAS float*)C.lds;
    if (kq == 0) {
#pragma unroll
        for (int r = 0; r < 33; ++r) *(LAS f32x4*)(red + (C.wave * 33 + r) * 64 + 4 * cq) = acc[r]; }
    __syncthreads();
    float* mods = (float*)(C.ws + WS_MODS); float* bf = (float*)(C.ws + WS_BIASF);
    for (int o = C.tid; o < 33 * 64; o += 512) { const int r = o >> 6, c = o & 63; float v = KIND == 0 ? PIN(5)[l * DIN + n0 + c] : 0.f;
#pragma unroll
        for (int w8 = 0; w8 < 8; ++w8) v += red[(w8 * 33 + r) * 64 + c];
        if (KIND == 0) mods[(size_t)(l * 33 + r) * DIN + n0 + c] = v;
        else bf[(size_t)r * (2 * DFFP) + 2 * (n0 + (c & ~3)) + (c & 3) + 4 * l] = v; }
    __syncthreads();
}
DI void phase_mods(const Ctx& C) { if (C.bx < 2 * 96) phase_rowgemm<0>(C, C.bx); }
DI void phase_prologue_deferred(const Ctx& C) {
    unsigned char* ws = C.ws;
    int itb = 0;
    for (int l = 0; l < 2; ++l) {
        if (l == 1) transpose_win(C, PIN(8) + (size_t)l * D * DIN, (bf16_t*)(ws + WS_WIN) + (size_t)l * 4096 * D, ws + WS_WIN8 + (size_t)l * 4096 * D, itb, FP8_SECS1);
        transpose_matrix(C, PIN(17) + (size_t)l * 512 * D, 512, D, (bf16_t*)(ws + WS_WUA) + (size_t)l * D * D, D, 0, itb, 0);
        transpose_matrix(C, PIN(18) + (size_t)l * 512 * D, 512, D, (bf16_t*)(ws + WS_WUA) + (size_t)l * D * D + 512, D, 0, itb, 0);
        transpose_matrix(C, PIN(19) + (size_t)l * D * D, D, D, (bf16_t*)(ws + WS_WO) + (size_t)l * D * D, D, 0, itb, 0);
    }
    transpose_matrix(C, PIN(20), D, DFF, (bf16_t*)(ws + WS_W13), D, 2, itb, 0);
    transpose_matrix(C, PIN(21), D, DFF, (bf16_t*)(ws + WS_W13), D, 3, itb, 0);
    transpose_matrix(C, PIN(22), DFF, D, (bf16_t*)(ws + WS_W2), DFFP, 0, itb, 0);
}
DI void phase_prologue(const Ctx& C) {
    unsigned char* ws = C.ws;
    int itb = 0;
    transpose_win(C, PIN(8), (bf16_t*)(ws + WS_WIN), ws + WS_WIN8, itb, FP8_SECS0);
    { const int gt = C.vcu * 512 + C.tid, NT = C.G * 512;
      bf16_t* w13 = (bf16_t*)(ws + WS_W13) + (size_t)(2 * DFF) * D;
      for (int i = gt; i < (2 * DFFP - 2 * DFF) * D / 8; i += NT) ((u32x4*)w13)[i] = (u32x4){0u, 0u, 0u, 0u};
      bf16_t* w2 = (bf16_t*)(ws + WS_W2);
      for (int i = gt; i < D * (DFFP - DFF) / 8; i += NT) { const int r = i / ((DFFP - DFF) / 8), cc = i % ((DFFP - DFF) / 8); *(u32x4*)(w2 + (size_t)r * DFFP + DFF + cc * 8) = (u32x4){0u, 0u, 0u, 0u}; }
      float2* rope = (float2*)(ws + WS_ROPE);
      for (int i = gt; i < T * 32; i += NT) { const int t = i >> 5, pi = i & 31; const float invf = exp2f(-(float)(pi & 15) * (13.287712379549449f / 16.f));
          const float ang = (float)(pi < 16 ? (t >> 6) : (t & 63)) * invf; rope[i] = make_float2(cosf(ang), sinf(ang)); }
      float* lbs = (float*)(ws + WS_LBS);
      for (int i = gt; i < 2 * 2 * 512; i += NT) { const int l = i >> 10, dir = (i >> 9) & 1, d = i & 511; const float* lb = PIN(dir ? 16 : 15);
          const float p0 = lb[d], p1 = lb[512 + d]; lbs[i] = l == 0 ? 0.f : 1.f / (1.f + expf(p0 - p1)); }
    }
    phase_mods(C);
}
constexpr float W13_SCALE = 64.f, W2_SCALE = 128.f, HID_SCALE = 8.f;
DI void convert_moe_weights(const Ctx& C, const int gw, const int NGW) {
    unsigned char* ws = C.ws; LAS float* scr = (LAS float*)(C.lds + C.wave * TP_SCR);
    const int lane = C.lane, r = lane >> 4, c4 = (lane & 15) * 4;
    constexpr int NIT = NE * 3 * 896;
    static_assert((D / 64) * (DFE / 64) == 896, "items per expert matrix");
    f32x4 v[16];
#define MOE_ITEM(it, W, ldw, k0, n0) const int m_ = (it) / 896, q_ = (it) % 896, e_ = m_ / 3, wh_ = m_ % 3; \
        const float* W = PIN(wh_ == 0 ? 24 : wh_ == 1 ? 25 : 26) + (size_t)e_ * D * DFE; const int ldw = wh_ == 2 ? D : DFE, nb_ = wh_ == 2 ? D / 64 : DFE / 64, k0 = 64 * (q_ / nb_), n0 = 64 * (q_ % nb_)
#define MOE_LOADS(it) do { MOE_ITEM(it, W_, ldw_, k0_, n0_); _Pragma("unroll") for (int i = 0; i < 16; ++i) v[i] = *(const f32x4*)(W_ + (size_t)(k0_ + 4 * i + r) * ldw_ + n0_ + c4); } while (0)
    int it = gw;
    if (it < NIT) MOE_LOADS(it);
    for (; it < NIT; it += NGW) {
#pragma unroll
        for (int i = 0; i < 16; ++i) *(LAS f32x4*)(scr + (4 * i + r) * TP_PITCH + c4) = v[i];
        LDS_WAIT(); asm volatile("" ::: "memory");
        if (it + NGW < NIT) MOE_LOADS(it + NGW);
        MOE_ITEM(it, W, ldw, k0, n0); (void)W; (void)ldw;
        const int kind = wh_ == 0 ? 2 : wh_ == 1 ? 3 : 0; const float sc = wh_ == 2 ? W2_SCALE : W13_SCALE;
        unsigned char* dst = (wh_ == 2 ? ws + WS_WM2 + (size_t)e_ * D * DFE : ws + WS_WM13 + (size_t)e_ * 2 * DFE * D) + (size_t)map_row(kind, n0 + lane, 0) * (wh_ == 2 ? DFE : D) + k0;
#pragma unroll
        for (int j = 0; j < 4; ++j) { const LAS float* sp = scr + (16 * j) * TP_PITCH + lane; u32x4 o;
            o.x = pack_fp8x4(sp[0] * sc, sp[TP_PITCH] * sc, sp[2 * TP_PITCH] * sc, sp[3 * TP_PITCH] * sc); o.y = pack_fp8x4(sp[4 * TP_PITCH] * sc, sp[5 * TP_PITCH] * sc, sp[6 * TP_PITCH] * sc, sp[7 * TP_PITCH] * sc);
            o.z = pack_fp8x4(sp[8 * TP_PITCH] * sc, sp[9 * TP_PITCH] * sc, sp[10 * TP_PITCH] * sc, sp[11 * TP_PITCH] * sc); o.w = pack_fp8x4(sp[12 * TP_PITCH] * sc, sp[13 * TP_PITCH] * sc, sp[14 * TP_PITCH] * sc, sp[15 * TP_PITCH] * sc);
            *(u32x4*)(dst + 16 * j) = o; }
        LDS_WAIT(); asm volatile("" ::: "memory");
    }
#undef MOE_ITEM
#undef MOE_LOADS
}

template <bool ROUTER>
DI void phase_norm(const Ctx& C, const float* xl, const float* xc, const float* nw, const float* mods, int shsel, int nrows, bf16_t* Hout, const float* rw, unsigned char* route, LAS int* cntL, unsigned char* H8 = nullptr) {
    int nloc = 0;
    LAS f32x4* RT = (LAS f32x4*)(C.lds + 32768);
    if (ROUTER) {
        for (int k = C.tid; k < 2048; k += 512) { const int e = k >> 6, ln = k & 63, jq = e >> 1, half = e & 1; RT[k] = *(const f32x4*)(rw + (size_t)(256 * (jq >> 2) + 4 * ln + (jq & 3)) * 8 + half * 4); }
        __syncthreads(); }
    f32x4 vq[2][4];
#define NORM_XLOADS(dst, r0_) do { _Pragma("unroll") for (int u = 0; u < 2; ++u) { int row_ = (r0_) + u * C.NGW; row_ = row_ < nrows ? row_ : (r0_); \
            const float* xr_ = row_ < NLAT ? xl + (size_t)row_ * D : xc + (size_t)(row_ - NLAT) * D; \
            _Pragma("unroll") for (int j = 0; j < 4; ++j) dst[u][j] = *(const f32x4*)(xr_ + 256 * j + 4 * C.lane); } } while (0)
    if (C.gw < nrows) NORM_XLOADS(vq, C.gw);
    for (int row0 = C.gw; row0 < nrows; row0 += 2 * C.NGW) {
        const int rows[2] = {row0, row0 + C.NGW}; const bool two = rows[1] < nrows;
        f32x4 v[2][4]; float ss[2] = {0.f, 0.f};
#pragma unroll
        for (int u = 0; u < 2; ++u)
#pragma unroll
            for (int j = 0; j < 4; ++j) v[u][j] = vq[u][j];
#pragma unroll
        for (int u = 0; u < 2; ++u)
#pragma unroll
            for (int j = 0; j < 4; ++j) ss[u] += (v[u][j][0] * v[u][j][0] + v[u][j][1] * v[u][j][1]) + (v[u][j][2] * v[u][j][2] + v[u][j][3] * v[u][j][3]);
        f32x4 gwv[2][4], shv[2][4];
#define NORM_MODS(u_) do { const int row_ = ((u_) == 1 && !two) ? rows[0] : rows[u_]; const float* mv_ = mods + (size_t)(row_ < NLAT ? (row_ >> 11) : 32) * DIN + shsel * D; \
            _Pragma("unroll") for (int j = 0; j < 4; ++j) { const int c0 = 256 * j + 4 * C.lane; \
                gwv[u_][j] = *(const f32x4*)(nw + c0) * (*(const f32x4*)(mv_ + D + c0) + 1.0f); shv[u_][j] = *(const f32x4*)(mv_ + c0); } } while (0)
        NORM_MODS(0); NORM_MODS(1); if (row0 + 2 * C.NGW < nrows) NORM_XLOADS(vq, row0 + 2 * C.NGW);
#pragma unroll
        for (int u = 0; u < 2; ++u) { if (u == 1 && !two) break;
            const int row = rows[u];
            const float rstd = 1.0f / sqrtf(wave_sum(ss[u]) * (1.f / D) + EPS);
            float lg[8];
            if (ROUTER) {
#pragma unroll
                for (int e = 0; e < 8; ++e) lg[e] = 0.f; }
#pragma unroll
            for (int j = 0; j < 4; ++j) { const int c0 = 256 * j + 4 * C.lane;
                f32x4 h = (v[u][j] * rstd) * gwv[u][j] + shv[u][j];
                if (ROUTER) *(unsigned*)((unsigned char*)Hout + (size_t)row * D + c0) = pack_fp8x4(h[0], h[1], h[2], h[3]);
                else { u32x2 o; o.x = cvt_pk_bf16(h[0], h[1]); o.y = cvt_pk_bf16(h[2], h[3]); *(u32x2*)(Hout + (size_t)row * D + c0) = o;
                       if (H8) *(unsigned*)(H8 + (size_t)row * D + c0) = pack_fp8x4(h[0], h[1], h[2], h[3]); }
                if (ROUTER) {
#pragma unroll
                    for (int q = 0; q < 4; ++q) { const f32x4 r0 = RT[((j * 4 + q) * 2) * 64 + C.lane], r1 = RT[((j * 4 + q) * 2 + 1) * 64 + C.lane];
                        lg[0] += h[q] * r0[0]; lg[1] += h[q] * r0[1]; lg[2] += h[q] * r0[2]; lg[3] += h[q] * r0[3]; lg[4] += h[q] * r1[0]; lg[5] += h[q] * r1[1]; lg[6] += h[q] * r1[2]; lg[7] += h[q] * r1[3]; } }
            }
            if (ROUTER) {
                const bool b5 = (C.lane & 32) != 0, b4 = (C.lane & 16) != 0, b3 = (C.lane & 8) != 0; float a4[4], a2[2], a1;
#pragma unroll
                for (int j = 0; j < 4; ++j) { const float snd = b5 ? lg[j] : lg[4 + j]; a4[j] = (b5 ? lg[4 + j] : lg[j]) + __shfl_xor(snd, 32); }
#pragma unroll
                for (int j = 0; j < 2; ++j) { const float snd = b4 ? a4[j] : a4[2 + j]; a2[j] = (b4 ? a4[2 + j] : a4[j]) + __shfl_xor(snd, 16); }
                { const float snd = b3 ? a2[0] : a2[1]; a1 = (b3 ? a2[1] : a2[0]) + __shfl_xor(snd, 8); }
                a1 += __shfl_xor(a1, 4); a1 += __shfl_xor(a1, 2); a1 += __shfl_xor(a1, 1);
                if ((C.lane & 7) == 0) ((LAS float*)(C.lds + C.wave * 4096))[nloc * 8 + (C.lane >> 3)] = a1;
                ++nloc;
            }
        }
    }
#undef NORM_MODS
#undef NORM_XLOADS
    if (ROUTER) {
        LDS_WAIT();
        for (int i = C.lane; i < nloc; i += 64) { const int row = C.gw + i * C.NGW; const LAS float* lp = (const LAS float*)(C.lds + C.wave * 4096) + i * 8;
            float lg[8];
#pragma unroll
            for (int e = 0; e < 8; ++e) lg[e] = lp[e];
            int e1 = 0; float l1 = lg[0];
#pragma unroll
            for (int e = 1; e < 8; ++e) if (lg[e] > l1) { l1 = lg[e]; e1 = e; }
            int e2 = -1; float l2 = -INFINITY;
#pragma unroll
            for (int e = 0; e < 8; ++e) if (e != e1 && lg[e] > l2) { l2 = lg[e]; e2 = e; }
            const float g2 = 1.f / (1.f + expf(l1 - l2)), g1 = 1.f - g2;
            int* rt = (int*)(route + (size_t)row * 24); rt[0] = e1; rt[1] = e2; ((float*)rt)[2] = g1; ((float*)rt)[3] = g2;
            atomicAdd((int*)&cntL[e1], 1); atomicAdd((int*)&cntL[e2], 1);
        }
    }
}

constexpr int AT_XCH = 65536, AT_ANW = 131072;
DI float max3f(float a, float b, float c) { return fmaxf(fmaxf(a, b), c); }
constexpr float AT_THR = 8.f;
DI void attn_unit(const Ctx& C, bf16_t* P, int qrow0, int krow_ctx, int krow_lat, int nkt, int h, float lam, const float* anw, float post) {
    const int tid_ = my_tid();
    LAS unsigned char* lds = C.lds; const int lane = tid_ & 63, wid = __builtin_amdgcn_readfirstlane(tid_ >> 6), sub = wid >> 2, qw = wid & 3, r32 = lane & 31, hh = lane >> 5;
    const int tq = (lane & 15) >> 2, tp = lane & 3, blk = (lane >> 4) & 1;
    LAS unsigned char* qlds = lds + AT_XCH + wid * 8192 + r32 * 16;
#pragma unroll
    for (int qb = 0; qb < 2; ++qb) { const bf16_t* qp = P + (size_t)(qrow0 + 64 * qw + 32 * qb + r32) * PW + PC_Q + h * 128 + sub * 64 + 8 * hh;
#pragma unroll
      for (int ks = 0; ks < 4; ++ks) *(LAS bf16x8*)(qlds + ((2 * ks + hh) * 64 + 32 * qb) * 16) = *(const bf16x8*)(qp + 16 * ks); }
    if (tid_ < 32) *(LAS f32x4*)(lds + AT_ANW + tid_ * 16) = *(const f32x4*)(anw + 4 * tid_);
    f32x16 O[2][4];
#pragma unroll
    for (int qb = 0; qb < 2; ++qb)
#pragma unroll
        for (int c = 0; c < 4; ++c)
#pragma unroll
            for (int i = 0; i < 16; ++i) O[qb][c][i] = 0.f;
    float m_run[2] = {-INFINITY, -INFINITY}, l_run[2] = {0.f, 0.f};
#define AT_ISSUE(kt, buf) do { const int kr0_ = (kt) < 4 ? krow_ctx + (kt) * 64 : krow_lat + ((kt) - 4) * 64; LAS unsigned char* bb_ = lds + (buf) * 32768; \
        _Pragma("unroll") for (int j_ = 0; j_ < 2; ++j_) { const int c_ = 2 * wid + j_; \
            dma16a(P + (size_t)(kr0_ + lane) * PW + PC_K + h * 128 + c_ * 8, bb_ + c_ * 1024); \
            dma16a(P + (size_t)(kr0_ + 16 * (c_ & 3) + (lane >> 2)) * PW + PC_V + h * 128 + (c_ >> 2) * 32 + (lane & 3) * 8, bb_ + 16384 + c_ * 1024); } } while (0)
    AT_ISSUE(0, 0);
    int buf = 0;
#pragma unroll 1
    for (int kt = 0; kt < nkt; ++kt) {
        VM_WAIT(); __syncthreads();
        if (kt + 1 < nkt) AT_ISSUE(kt + 1, buf ^ 1);
        const LAS unsigned char* kb = lds + buf * 32768, * vb = kb + 16384 + (4 * hh + tq) * 64 + blk * 32 + tp * 8;
        bf16x8 Pf[2][4];
#pragma unroll
        for (int qb = 0; qb < 2; ++qb) {
            f32x16 s0, s1;
#pragma unroll
            for (int i = 0; i < 16; ++i) { s0[i] = 0.f; s1[i] = 0.f; }
#pragma unroll
            for (int ks = 0; ks < 4; ++ks) { const LAS unsigned char* kp = kb + ((sub * 8 + 2 * ks + hh) * 64 + r32) * 16;
                const bf16x8 k0 = *(const LAS bf16x8*)kp, k1 = *(const LAS bf16x8*)(kp + 512);
                const bf16x8 q = *(const LAS bf16x8*)(qlds + ((2 * ks + hh) * 64 + 32 * qb) * 16);
                s0 = MFMA32(k0, q, s0); s1 = MFMA32(k1, q, s1); }
            float mx = max3f(s0[0], s1[0], s0[1]);
#pragma unroll
            for (int i = 1; i < 16; ++i) mx = (i + 1 < 16) ? max3f(mx, s1[i], s0[i + 1]) : fmaxf(mx, s1[i]);
            mx = fmaxf(mx, xhalf(mx, hh));
            const float mnew = fmaxf(m_run[qb], mx);
            if (__any(mx > m_run[qb] + AT_THR)) { const float alpha = __builtin_amdgcn_exp2f(m_run[qb] - mnew); l_run[qb] *= alpha;
#pragma unroll
                for (int c = 0; c < 4; ++c)
#pragma unroll
                    for (int i = 0; i < 16; ++i) O[qb][c][i] *= alpha;
                m_run[qb] = mnew; }
            const float mr = m_run[qb]; float ps0 = 0.f, ps1 = 0.f;
#pragma unroll
            for (int i = 0; i < 16; ++i) { s0[i] = __builtin_amdgcn_exp2f(s0[i] - mr); s1[i] = __builtin_amdgcn_exp2f(s1[i] - mr); ps0 += s0[i]; ps1 += s1[i]; }
            l_run[qb] += ps0 + ps1;
            Pf[qb][0] = packf8(s0, 0); Pf[qb][1] = packf8(s0, 1); Pf[qb][2] = packf8(s1, 0); Pf[qb][3] = packf8(s1, 1);
        }
#pragma unroll
        for (int cb = 0; cb < 4; ++cb) {
#pragma unroll
            for (int s4 = 0; s4 < 4; ++s4) { const bf16x8 a = cat8(tr16(vb + cb * 4096 + s4 * 1024), tr16(vb + cb * 4096 + s4 * 1024 + 512));
                O[0][cb] = MFMA32(a, Pf[0][s4], O[0][cb]); O[1][cb] = MFMA32(a, Pf[1][s4], O[1][cb]); } }
        buf ^= 1;
    }
#undef AT_ISSUE
    LDS_WAIT(); __syncthreads();
    const int te = my_tid(); const int lane_e = te & 63, wid_e = __builtin_amdgcn_readfirstlane(te >> 6);
    LAS float* xch = (LAS float*)(lds + AT_XCH) + (wid_e & 3) * 4096 + lane_e;
#pragma unroll
    for (int qb = 0; qb < 2; ++qb) {
        const float lt = l_run[qb] + xhalf(l_run[qb], lane_e >> 5); const float inv = 1.f / lt;
        if ((wid_e >> 2) == 1) { const float sc = -lam * inv;
#pragma unroll
            for (int c = 0; c < 4; ++c)
#pragma unroll
                for (int i = 0; i < 16; ++i) xch[(c * 16 + i) * 64] = O[qb][c][i] * sc; }
        LDS_WAIT(); __syncthreads();
        if ((wid_e >> 2) == 0) {
            float ss = 0.f;
#pragma unroll
            for (int c = 0; c < 4; ++c)
#pragma unroll
                for (int i = 0; i < 16; ++i) { const float o = O[qb][c][i] * inv + xch[(c * 16 + i) * 64]; O[qb][c][i] = o; ss += o * o; }
            ss += xhalf(ss, lane_e >> 5);
            const float rs = post / sqrtf(ss * (1.f / 128.f) + EPS);
            bf16_t* op = P + (size_t)(qrow0 + 64 * (wid_e & 3) + 32 * qb + (lane_e & 31)) * PW + PC_Q + h * 128;
#pragma unroll
            for (int c = 0; c < 4; ++c)
#pragma unroll
                for (int g = 0; g < 4; ++g) { const int v0 = 32 * c + 8 * g + 4 * (lane_e >> 5); const f32x4 w = *(const LAS f32x4*)(lds + AT_ANW + v0 * 4);
                    u32x2 o; o.x = cvt_pk_bf16(O[qb][c][4 * g] * rs * w[0], O[qb][c][4 * g + 1] * rs * w[1]); o.y = cvt_pk_bf16(O[qb][c][4 * g + 2] * rs * w[2], O[qb][c][4 * g + 3] * rs * w[3]);
                    *(u32x2*)(op + v0) = o; }
        }
        LDS_WAIT(); __syncthreads();
    }
}

constexpr int SC_Q = 0, SC_LF = 16384, SC_V0 = 32768, SC_QM = 65536, SC_KMR = 81920, SC_KMS = 98304, SC_SX = 114688, SC_A31 = 147456, SC_A63 = 147968, SC_END = 148480;
DI void scan_chain(const Ctx& C, bf16_t* P, int b, int h, int dir, bool store_ctx) {
    const int tid_ = my_tid();
    LAS unsigned char* lds = C.lds; const int lane = tid_ & 63, wid = __builtin_amdgcn_readfirstlane(tid_ >> 6), r32 = lane & 31, hh = lane >> 5;
    const int tq = (lane & 15) >> 2, tp = lane & 3, blk = (lane >> 4) & 1;
    const int db = wid & 3, tb = wid >> 2;
    const int base_nat = hh * 512 + tq * 64 + blk * 32 + tp * 8;
    const int base_prm = (4 * hh + tq) * 64 + blk * 32 + tp * 8;
    const int lfcol = (dir ? PC_LB : PC_LF) + h * 128, qcol = PC_RQ + h * 128, vcol = PC_RI + h * 128;
    f32x16 ST[2];
#pragma unroll
    for (int j = 0; j < 2; ++j)
#pragma unroll
        for (int i = 0; i < 16; ++i) ST[j][i] = 0.f;
#define SROW(c, i) ((c) < 4 ? NLAT + b * CL + (dir ? 255 - ((c) * 64 + (i)) : (c) * 64 + (i)) : b * T + (dir ? 2047 - (((c) - 4) * 64 + (i)) : ((c) - 4) * 64 + (i)))
#define SDMA(c, colbase, dstoff) do { _Pragma("unroll") for (int j_ = 0; j_ < 2; ++j_) { const int I_ = 2 * wid + j_; const int ti_ = 16 * (I_ & 3) + (lane >> 2); \
        dma16(P + (size_t)SROW(c, ti_) * PW + (colbase) + (I_ >> 2) * 32 + (lane & 3) * 8, lds + (dstoff) + I_ * 1024); } } while (0)
    SDMA(0, qcol, SC_Q); SDMA(0, lfcol, SC_LF); SDMA(0, vcol, SC_V0);
    int vbuf = 0;
    const int t = 32 * tb + r32;
#pragma unroll 1
    for (int c = 0; c < 36; ++c) {
        { const int st_ = __builtin_amdgcn_readfirstlane((c > 0 && (c > 4 || store_ctx)) ? 1 : 0);
          asm volatile("s_cmp_lg_u32 %0, 0\n\ts_cbranch_scc1 1f\n\ts_waitcnt vmcnt(0)\n1:\n\ts_waitcnt vmcnt(4)" :: "s"(st_) : "memory", "scc"); }
        LDS_BARRIER();
        const LAS unsigned char* Vimg = lds + SC_V0 + vbuf * 16384;
        f32x16 cm;
#pragma unroll
        for (int i = 0; i < 16; ++i) cm[i] = 0.f;
#pragma unroll
        for (int kk = 0; kk < 2; ++kk) { const int ks = 2 * tb + kk;
            const half8 a = __builtin_bit_cast(half8, cat8(tr16(lds + SC_LF + db * 4096 + base_nat + ks * 1024), tr16(lds + SC_LF + db * 4096 + base_nat + ks * 1024 + 256)));
            half8 bm;
#pragma unroll
            for (int j = 0; j < 8; ++j) { const int s = 16 * ks + 8 * hh + j; bm[j] = tb == 0 ? (s > t ? (_Float16)-1.f : (_Float16)0.f) : (s <= t ? (_Float16)1.f : (_Float16)0.f); }
            cm = __builtin_amdgcn_mfma_f32_32x32x16_f16(a, bm, cm, 0, 0, 0); }
#pragma unroll
        for (int g = 0; g < 4; ++g) {
            const int sa = db * 4096 + (t >> 3) * 512 + (t & 7) * 64 + (8 * g + 4 * hh) * 2;
            const u32x2 q4 = *(const LAS u32x2*)(lds + SC_Q + sa); const half4 lf4 = *(const LAS half4*)(lds + SC_LF + sa);
            const float qv[4] = {bflo(q4.x), bfhi(q4.x), bflo(q4.y), bfhi(q4.y)};
            float qm[4], km[4];
#pragma unroll
            for (int e = 0; e < 4; ++e) { const float cv = cm[4 * g + e] * LOG2E; const float E = __builtin_amdgcn_exp2f(cv), Ei = __builtin_amdgcn_exp2f(-cv);
                const float lf = (float)lf4[e]; qm[e] = qv[e] * E; km[e] = (1.f - __builtin_amdgcn_exp2f(lf * LOG2E)) * Ei;
                if (tb == 0 && r32 == 0) ((LAS float*)(lds + SC_A31))[32 * db + 8 * g + 4 * hh + e] = lf - cm[4 * g + e];
                if (tb == 1 && r32 == 31) ((LAS float*)(lds + SC_A63))[32 * db + 8 * g + 4 * hh + e] = cm[4 * g + e]; }
            u32x2 qw2, kw2; qw2.x = cvt_pk_bf16(qm[0], qm[1]); qw2.y = cvt_pk_bf16(qm[2], qm[3]); kw2.x = cvt_pk_bf16(km[0], km[1]); kw2.y = cvt_pk_bf16(km[2], km[3]);
            const int ra = ((4 * db + g) * 64 + t) * 16 + 8 * hh;
            *(LAS u32x2*)(lds + SC_QM + ra) = qw2; *(LAS u32x2*)(lds + SC_KMR + ra) = kw2; *(LAS u32x2*)(lds + SC_KMS + sa) = kw2;
        }
        LDS_BARRIER();
        if (c + 1 < 36) { SDMA(c + 1, qcol, SC_Q); SDMA(c + 1, lfcol, SC_LF); SDMA(c + 1, vcol, SC_V0 + (vbuf ^ 1) * 16384); }
        { const int d = 32 * db + r32; const float c31 = ((LAS float*)(lds + SC_A31))[d], c63 = ((LAS float*)(lds + SC_A63))[d];
          const float e31 = __expf(c31), dec = __expf(c31 + c63), e63 = __expf(c63);
          f32x16 SN[2];
#pragma unroll
          for (int j = 0; j < 2; ++j) { const int vb2 = 2 * tb + j;
#pragma unroll
              for (int g = 0; g < 4; ++g) { u32x2 w; w.x = cvt_pk_bf16(ST[j][4 * g] * e31, ST[j][4 * g + 1] * e31); w.y = cvt_pk_bf16(ST[j][4 * g + 2] * e31, ST[j][4 * g + 3] * e31);
                  *(LAS u32x2*)(lds + SC_SX + vb2 * 8192 + (d >> 3) * 512 + (d & 7) * 64 + (8 * g + 4 * hh) * 2) = w; }
#pragma unroll
              for (int i = 0; i < 16; ++i) SN[j][i] = 0.f; }
#pragma unroll
          for (int ks = 0; ks < 4; ++ks) {
              const bf16x8 kf = cat8(tr16(lds + SC_KMS + db * 4096 + base_nat + ks * 1024), tr16(lds + SC_KMS + db * 4096 + base_nat + ks * 1024 + 256));
#pragma unroll
              for (int j = 0; j < 2; ++j) { const int vb2 = 2 * tb + j;
                  const bf16x8 vf = cat8(tr16(Vimg + vb2 * 4096 + base_nat + ks * 1024), tr16(Vimg + vb2 * 4096 + base_nat + ks * 1024 + 256));
                  SN[j] = MFMA32(vf, kf, SN[j]); } }
#pragma unroll
          for (int j = 0; j < 2; ++j)
#pragma unroll
              for (int i = 0; i < 16; ++i) ST[j][i] = dec * ST[j][i] + e63 * SN[j][i];
        }
        LDS_BARRIER();
        { bf16x8 Qmf[8];
#pragma unroll
          for (int kd = 0; kd < 8; ++kd) Qmf[kd] = *(const LAS bf16x8*)(lds + SC_QM + ((2 * kd + hh) * 64 + t) * 16);
          f32x16 o;
#pragma unroll
          for (int i = 0; i < 16; ++i) o[i] = 0.f;
          for (int sb = 0; sb <= tb; ++sb) {
              f32x16 pt;
#pragma unroll
              for (int i = 0; i < 16; ++i) pt[i] = 0.f;
#pragma unroll
              for (int kd = 0; kd < 8; ++kd) { const bf16x8 a = *(const LAS bf16x8*)(lds + SC_KMR + ((2 * kd + hh) * 64 + 32 * sb + r32) * 16); pt = MFMA32(a, Qmf[kd], pt); }
              if (sb == tb) {
#pragma unroll
                  for (int i = 0; i < 16; ++i) if (crow(i, hh) > r32) pt[i] = 0.f; }
              const bf16x8 p0 = packf8(pt, 0), p1 = packf8(pt, 1);
              { const bf16x8 a = cat8(tr16(Vimg + db * 4096 + base_prm + (2 * sb) * 1024), tr16(Vimg + db * 4096 + base_prm + (2 * sb) * 1024 + 512)); o = MFMA32(a, p0, o); }
              { const bf16x8 a = cat8(tr16(Vimg + db * 4096 + base_prm + (2 * sb + 1) * 1024), tr16(Vimg + db * 4096 + base_prm + (2 * sb + 1) * 1024 + 512)); o = MFMA32(a, p1, o); }
          }
#pragma unroll
          for (int kd = 0; kd < 8; ++kd) { const bf16x8 a = cat8(tr16(lds + SC_SX + db * 8192 + base_nat + kd * 1024), tr16(lds + SC_SX + db * 8192 + base_nat + kd * 1024 + 256)); o = MFMA32(a, Qmf[kd], o); }
          if (c >= 4 || store_ctx) { bf16_t* op = P + (size_t)SROW(c, t) * PW + lfcol + 32 * db;
#pragma unroll
              for (int g = 0; g < 4; ++g) { u32x2 w; w.x = cvt_pk_bf16(o[4 * g], o[4 * g + 1]); w.y = cvt_pk_bf16(o[4 * g + 2], o[4 * g + 3]); *(u32x2*)(op + 8 * g + 4 * hh) = w; } }
        }
        vbuf ^= 1;
    }
    VM_WAIT(); LDS_WAIT(); __syncthreads();
#undef SROW
#undef SDMA
}

DI void phase_recprep(const Ctx& C, bf16_t* P, const float* rnw, int nrows) {
    const f32x4 w0 = *(const f32x4*)(rnw + ((8 * C.lane) & 127)), w1 = *(const f32x4*)(rnw + ((8 * C.lane) & 127) + 4);
    u32x4 qa[4], qb[4], qg[4];
#define RP_LOADS(r0_) do { _Pragma("unroll") for (int u = 0; u < 4; ++u) { const int row_ = (r0_) + u * C.NGW < nrows ? (r0_) + u * C.NGW : (r0_); const bf16_t* pr_ = P + (size_t)row_ * PW + 8 * C.lane; \
            qa[u] = *(const u32x4*)(pr_ + PC_LF); qb[u] = *(const u32x4*)(pr_ + PC_LB); qg[u] = *(const u32x4*)(pr_ + PC_G); } } while (0)
    if (C.gw < nrows) RP_LOADS(C.gw);
    for (int row0 = C.gw; row0 < nrows; row0 += 4 * C.NGW) {
        u32x4 ra[4], rb[4], rg[4];
#pragma unroll
        for (int u = 0; u < 4; ++u) { ra[u] = qa[u]; rb[u] = qb[u]; rg[u] = qg[u]; }
        if (row0 + 4 * C.NGW < nrows) RP_LOADS(row0 + 4 * C.NGW);
#pragma unroll
        for (int u = 0; u < 4; ++u) { const int row = row0 + u * C.NGW; if (row >= nrows) break;
            float a[8], bb[8], g[8]; unpack8(ra[u], a); unpack8(rb[u], bb); unpack8(rg[u], g);
            float ss = 0.f;
#pragma unroll
            for (int j = 0; j < 8; ++j) { a[j] += bb[j]; ss += a[j] * a[j]; }
            ss += __shfl_xor(ss, 1); ss += __shfl_xor(ss, 2); ss += __shfl_xor(ss, 4); ss += __shfl_xor(ss, 8);
            const float rs = 1.0f / sqrtf(ss * (1.f / 128.f) + EPS);
            f32x4 o0, o1;
#pragma unroll
            for (int j = 0; j < 4; ++j) { o0[j] = a[j] * rs * w0[j] * g[j]; o1[j] = a[4 + j] * rs * w1[j] * g[4 + j]; }
            *(u32x4*)(P + (size_t)row * PW + 8 * C.lane + PC_LF) = pack8(o0, o1); }
    }
#undef RP_LOADS
}

DI void phase_slots(const Ctx& C, const int* cnt, int* pbout, unsigned char* route, const bf16_t* H2, bf16_t* AG, LAS int* cur) {
    if (C.tid < 16) cur[C.tid] = 0;
    __syncthreads();
    for (int g = C.tid; g < C.G; g += 512) {
#pragma unroll
        for (int k = 0; k < 8; ++k) { const int c = cnt[g * 8 + k]; atomicAdd((int*)&cur[8 + k], c); if (g < C.bx) atomicAdd((int*)&cur[k], c); } }
    __syncthreads();
    if (C.tid < 8) { const int e = C.tid; int pb = 0, pbe = 0;
#pragma unroll
        for (int k = 0; k < 8; ++k) { if (k == e) pbe = pb; pb += (cur[8 + k] + 255) >> 8; }
        const int mine = cur[e];
        if (C.bx == 0) { pbout[e] = pbe; if (e == 7) pbout[8] = pb; }
        cur[e] = pbe * 256 + mine;
    }
    __syncthreads();
    const int nloc = (NLAT - C.gw + C.NGW - 1) / C.NGW;
    LAS int* tab = (LAS int*)(C.lds + C.wave * 2048);
    for (int i = C.lane; i < nloc; i += 64) { int* rt = (int*)(route + (size_t)(C.gw + i * C.NGW) * 24);
        const int s1 = atomicAdd((int*)&cur[rt[0]], 1), s2 = atomicAdd((int*)&cur[rt[1]], 1); rt[4] = s1; rt[5] = s2; tab[2 * i] = s1; tab[2 * i + 1] = s2; }
    LDS_WAIT();
    for (int i0 = 0; i0 < nloc; i0 += 8) {
        u32x4 vr[8];
#pragma unroll
        for (int k = 0; k < 8; ++k) { const int i = i0 + k < nloc ? i0 + k : i0; vr[k] = *((const u32x4*)((const unsigned char*)H2 + (size_t)(C.gw + i * C.NGW) * D) + C.lane); }
#pragma unroll
        for (int k = 0; k < 8; ++k) { if (i0 + k >= nloc) break;
            const int s1 = __builtin_amdgcn_readfirstlane(tab[2 * (i0 + k)]), s2 = __builtin_amdgcn_readfirstlane(tab[2 * (i0 + k) + 1]);
            *((u32x4*)((unsigned char*)AG + (size_t)s1 * D) + C.lane) = vr[k]; *((u32x4*)((unsigned char*)AG + (size_t)s2 * D) + C.lane) = vr[k]; }
    }
}
DI void phase_final(const Ctx& C, float* x, const unsigned char* route, const bf16_t* Y, const float* mods1, const float* fw) {
    for (int row0 = C.gw; row0 < NLAT; row0 += 2 * C.NGW) {
        const int rows[2] = {row0, row0 + C.NGW < NLAT ? row0 + C.NGW : row0};
        f32x4 v[2][4]; float ss[2] = {0.f, 0.f};
#pragma unroll
        for (int u = 0; u < 2; ++u) { const int row = rows[u];
            const int* rt = (const int*)(route + (size_t)row * 24); const float g1 = ((const float*)rt)[2], g2 = ((const float*)rt)[3]; const int s1 = rt[4], s2 = rt[5];
            const float* mv = mods1 + (size_t)(row >> 11) * DIN + 5 * D; const float* xr = x + (size_t)row * D;
#pragma unroll
            for (int j = 0; j < 4; ++j) { const int c0 = 256 * j + 4 * C.lane;
                const u32x2 y1 = *(const u32x2*)(Y + (size_t)s1 * D + c0), y2 = *(const u32x2*)(Y + (size_t)s2 * D + c0); const f32x4 m5 = *(const f32x4*)(mv + c0);
                f32x4 y; y[0] = g1 * bflo(y1.x) + g2 * bflo(y2.x); y[1] = g1 * bfhi(y1.x) + g2 * bfhi(y2.x); y[2] = g1 * bflo(y1.y) + g2 * bflo(y2.y); y[3] = g1 * bfhi(y1.y) + g2 * bfhi(y2.y);
                v[u][j] = *(const f32x4*)(xr + c0) + m5 * y; ss[u] += (v[u][j][0] * v[u][j][0] + v[u][j][1] * v[u][j][1]) + (v[u][j][2] * v[u][j][2] + v[u][j][3] * v[u][j][3]); } }
#pragma unroll
        for (int u = 0; u < 2; ++u) { if (u == 1 && rows[1] == rows[0]) break;
            const float rstd = 1.0f / sqrtf(wave_sum(ss[u]) * (1.f / D) + EPS); float* xr = x + (size_t)rows[u] * D;
#pragma unroll
            for (int j = 0; j < 4; ++j) { const int c0 = 256 * j + 4 * C.lane; *(f32x4*)(xr + c0) = v[u][j] * rstd * *(const f32x4*)(fw + c0); } }
    }
}

constexpr int LDS_MISC = SC_END;
constexpr int LDS_BYTES = SC_END + 512;
static_assert(LDS_WTAB_OFF == SC_END + 128, "wave table sits behind the barrier words and counters");
constexpr int NPHASE = 20;

DI Ctx make_ctx() {
    extern __shared__ __attribute__((aligned(16))) unsigned char lds_raw[];
    Ctx C; const int t = my_tid();
    unsigned lb = (unsigned)(size_t)(LAS unsigned char*)lds_raw; asm volatile("" : "+s"(lb));
    C.lds = (LAS unsigned char*)(size_t)lb; C.ws = kparams()->ws; C.tid = t; C.lane = t & 63; C.wave = __builtin_amdgcn_readfirstlane(t >> 6);
    int bx = blockIdx.x, G = gridDim.x; asm volatile("" : "+s"(bx), "+s"(G));
    C.bx = bx; C.G = G; C.vcu = (C.G % 8 == 0) ? (bx % 8) * (C.G / 8) + bx / 8 : bx;
    C.gw = C.vcu * 8 + C.wave; C.NGW = C.G * 8;
    return C;
}
DI void grid_barrier() {
    extern __shared__ __attribute__((aligned(16))) unsigned char lds_raw[];
    XcdBarrier b; b.bar = (unsigned*)(kparams()->ws + WS_CTL) + CW_BAR + kparams()->li * XCD_BAR_WORDS; b.x = xb_xcc_id(); b.st = (volatile LAS unsigned*)((LAS unsigned char*)lds_raw + LDS_MISC);
    xcd_barrier(b);
}
#define WSP(T, off) ((T*)(kparams()->ws + (off)))

#define IN(k) (kparams()->ph_lo <= (k) && (k) < kparams()->ph_hi)
#define SEAM(k) do { if (IN(k) && IN((k) + 1)) grid_barrier(); } while (0)


template <int l> DI void layer_phases() {
        constexpr int FS = l == 0 ? FP8_SECS0 : FP8_SECS1, N_SEC_F8 = n_sec_f8(FS), N_SEC_BF = 8 - N_SEC_F8;
        const int pb = 1 + 9 * l;
#define LQ() int lq = l; asm volatile("" : "+s"(lq))
#define XL (lq == 0 ? PIN(0) : (const float*)POUT)
#define XC (lq == 0 ? PIN(2) : (const float*)WSP(float, WS_CTXRES))
#define LMODS (WSP(float, WS_MODS) + (size_t)lq * 33 * DIN)
#define NROWS_OUT (lq == 0 ? NTOK : NLAT)
        if (IN(pb + 0)) { LQ(); const Ctx C = make_ctx(); phase_norm<false>(C, XL, XC, PIN(6) + lq * D, LMODS, 0, NTOK, WSP(bf16_t, WS_H), nullptr, nullptr, nullptr, WSP(unsigned char, WS_H8)); }
        SEAM(pb + 0);
        if (IN(pb + 1)) { LQ();
            { const Ctx C = make_ctx();
              Gemm g{WSP(bf16_t, WS_H), WSP(bf16_t, WS_WIN) + (size_t)lq * 4096 * D, NTOK, N_SEC_BF * 512, D, D};
              pg8::StaticOrder S; S.init(g, C.G, C.bx);
              EpiInProj E{WSP(bf16_t, WS_P), WSP(float2, WS_ROPE), WSP(float, WS_LBS) + lq * 1024, WSP(float, WS_LBS) + lq * 1024 + 512, (int)secmap_of(FS, false), 1.f};
              pg8::gemm_phase<EpiInProj, pg8::StaticOrder>(C.lds, g, S, E); }
            if (N_SEC_F8 > 0) { const Ctx C = make_ctx();
              Gemm g{WSP(bf16_t, WS_H8), (const bf16_t*)(WSP(unsigned char, WS_WIN8) + (size_t)lq * 4096 * D), NTOK, N_SEC_F8 * 512, D / 2, D / 2};
              pg8::StaticOrder S; S.init(g, C.G, C.bx);
              EpiInProj E{WSP(bf16_t, WS_P), WSP(float2, WS_ROPE), WSP(float, WS_LBS) + lq * 1024, WSP(float, WS_LBS) + lq * 1024 + 512, (int)secmap_of(FS, true), 1.f / WIN8_SCALE};
              pg8::gemm_phase<EpiInProj, pg8::StaticOrder, true, true>(C.lds, g, S, E); }
        }
        SEAM(pb + 1);
        if (IN(pb + 2)) { LQ(); const Ctx C = make_ctx(); bf16_t* const Pb = WSP(bf16_t, WS_P);
            for (int id = C.vcu; id < NB * 4 * 2; id += C.G) scan_chain(C, Pb, id >> 3, (id >> 1) & 3, id & 1, lq == 0);
            float lam;
            { const float a = wave_sum(PIN(9)[lq * 64 + C.lane] * PIN(10)[lq * 64 + C.lane]), b2 = wave_sum(PIN(11)[lq * 64 + C.lane] * PIN(12)[lq * 64 + C.lane]);
              const float li = 0.8f - 0.6f * expf(-0.3f * (float)lq); lam = expf(a) - expf(b2) + li; lam = __uint_as_float(__builtin_amdgcn_readfirstlane(__float_as_uint(lam))); }
            const float post = __uint_as_float(__builtin_amdgcn_readfirstlane(__float_as_uint(1.f - (0.8f - 0.6f * expf(-0.3f * (float)lq)))));
            const float* anw = PIN(13) + lq * 128;
            const int NU = NB * 4 * 8, U = (NU + C.G - 1) / C.G;
            for (int id = C.vcu * U; id < NU && id < (C.vcu + 1) * U; ++id) { const int bh = id >> 3, qb = id & 7, b = bh >> 2, h = bh & 3;
                attn_unit(C, Pb, b * T + qb * 256, NLAT + b * CL, b * T, 36, h, lam, anw, post); }
            if (lq == 0) for (int id = C.vcu; id < NB * 4; id += C.G) { const int b = id >> 2, h = id & 3;
                attn_unit(C, Pb, NLAT + b * CL, NLAT + b * CL, 0, 4, h, lam, anw, post); }
        }
        if (l == 0) { if (IN(pb + 2)) { Ctx C = make_ctx();
            if (C.G <= NB * 4) phase_prologue_deferred(C);
            else if (C.vcu >= NB * 4) { C.gw = (C.vcu - NB * 4) * 8 + C.wave; C.NGW = (C.G - NB * 4) * 8; phase_prologue_deferred(C); } } }
        if (l == 0) { if (IN(pb + 2)) { const Ctx C = make_ctx();
            const int nfree = C.G > NB * 4 ? C.G - NB * 4 : C.G, first = C.G > NB * 4 ? NB * 4 : 0;
            if (C.vcu >= first) for (int t = C.vcu - first; t < 86; t += nfree) phase_rowgemm<1>(C, t);
            if (C.vcu == C.G - 1) { float* bf = WSP(float, WS_BIASF); for (int i = C.tid; i < 33 * (2 * DFFP - 2 * DFF); i += 512) bf[(size_t)(i / (2 * DFFP - 2 * DFF)) * (2 * DFFP) + 2 * DFF + i % (2 * DFFP - 2 * DFF)] = 0.f; } } }
        SEAM(pb + 2);
        if (IN(pb + 3)) { LQ(); const Ctx C = make_ctx();
            phase_recprep(C, WSP(bf16_t, WS_P), PIN(14) + lq * 128, NROWS_OUT);
            Gemm g{WSP(bf16_t, WS_H8), (const bf16_t*)(WSP(unsigned char, WS_WIN8) + ((size_t)lq * 4096 + N_SEC_F8 * 512) * D), NROWS_OUT, 2048, D / 2, D / 2};
            pg8::StaticOrder S; S.init(g, C.G, C.bx);
            EpiGates E{WSP(bf16_t, WS_P), 1.f / WIN8_SCALE};
            pg8::gemm_phase<EpiGates, pg8::StaticOrder, true, true>(C.lds, g, S, E);
        }
        SEAM(pb + 3);
        if (IN(pb + 4)) { LQ(); const Ctx C = make_ctx();
            Gemm g{WSP(bf16_t, WS_P) + PC_Q, WSP(bf16_t, WS_WUA) + (size_t)lq * D * D, NROWS_OUT, D, D, PW};
            pg8::StaticOrder S; S.init(g, C.G, C.bx); EpiMergeFused E{WSP(bf16_t, WS_P), WSP(bf16_t, WS_MERGED)};
            pg8::gemm_phase<EpiMergeFused, pg8::StaticOrder, true, false, true>(C.lds, g, S, E);
        }
        SEAM(pb + 4);
        if (IN(pb + 5)) { LQ(); const Ctx C = make_ctx();
            Gemm g{WSP(bf16_t, WS_MERGED), WSP(bf16_t, WS_WO) + (size_t)lq * D * D, NROWS_OUT, D, D, D};
            pg8::StaticOrder S; S.init(g, C.G, C.bx);
            if constexpr (l == 0) { EpiResidN E{XL, XC, POUT, WSP(float, WS_CTXRES), LMODS, 2, PIN(7), 4, WSP(bf16_t, WS_AN), WSP(unsigned, WS_RS0)};
                pg8::gemm_phase<EpiResidN, pg8::StaticOrder>(C.lds, g, S, E); }
            else { EpiResid E{XL, XC, POUT, WSP(float, WS_CTXRES), LMODS, 2};
                pg8::gemm_phase<EpiResid, pg8::StaticOrder>(C.lds, g, S, E); }
        }
        SEAM(pb + 5);
        if (l == 0) {
            if (IN(8)) { LQ(); const Ctx C = make_ctx();
                Gemm g{WSP(bf16_t, WS_AN), WSP(bf16_t, WS_W13), NTOK, 2 * DFFP, D, D};
                pg8::StaticOrder S; S.init(g, C.G, C.bx); EpiSwiglu E{WSP(bf16_t, WS_HID), DFFP, 0, WSP(unsigned, WS_RS0), WSP(float, WS_BIASF)};
                pg8::gemm_phase<EpiSwiglu, pg8::StaticOrder>(C.lds, g, S, E);
            }
            SEAM(8);
            if (IN(9)) { LQ(); const Ctx C = make_ctx();
                Gemm g{WSP(bf16_t, WS_HID), WSP(bf16_t, WS_W2), NTOK, D, DFFP, DFFP};
                pg8::StaticOrder S; S.init(g, C.G, C.bx); EpiResid E{POUT, WSP(float, WS_CTXRES), POUT, WSP(float, WS_CTXRES), LMODS, 5};
                pg8::gemm_phase<EpiResid, pg8::StaticOrder>(C.lds, g, S, E);
                { const int rem = S.nwg % C.G, first_idle = rem; if (C.bx >= first_idle) convert_moe_weights(C, (C.bx - first_idle) * 8 + C.wave, (C.G - first_idle) * 8); }
            }
            SEAM(9);
        } else {
            if (IN(16)) { LQ(); const Ctx C = make_ctx(); LAS int* lcnt = (LAS int*)(C.lds + LDS_MISC + 32);
                if (C.tid < 8) lcnt[C.tid] = 0;
                __syncthreads();
                phase_norm<true>(C, POUT, nullptr, PIN(7) + D, LMODS, 3, NLAT, WSP(bf16_t, WS_H2M), PIN(23), WSP(unsigned char, WS_ROUTE), lcnt);
                __syncthreads();
                if (C.tid < 8) WSP(int, WS_CNT)[C.bx * 8 + C.tid] = lcnt[C.tid];
            }
            SEAM(16);
            if (IN(17)) { LQ(); const Ctx C = make_ctx(); phase_slots(C, WSP(int, WS_CNT), WSP(int, WS_CNT) + 4096, WSP(unsigned char, WS_ROUTE), WSP(bf16_t, WS_H2M), WSP(bf16_t, WS_AG), (LAS int*)(C.lds + LDS_MISC + 32)); }
            SEAM(17);
            if (IN(18)) { LQ();
                const int ptot = __builtin_amdgcn_readfirstlane(WSP(int, WS_CNT)[4096 + 8]);
                for (int p0 = 0, np_ = 0; p0 < ptot; p0 += np_) {
                    const int np = (ptot - p0) <= MOE_CHUNK + 16 ? (ptot - p0) : MOE_CHUNK; np_ = np;
#define MOE_ORDER_INIT(S) do { S.so.init(g, C.G, C.bx); S.p0 = p0; S.load_pb(WSP(int, WS_CNT) + 4096); } while (0)
                    { const Ctx C = make_ctx(); Gemm g{WSP(bf16_t, WS_AG), WSP(bf16_t, WS_WM13), np * 256, 2 * DFE, D / 2, D / 2};
                      pg8::MoeOrder S; MOE_ORDER_INIT(S); S.apan0 = 0; S.estride = (size_t)2 * DFE * D;
                      EpiSwiglu8 E{WSP(unsigned char, WS_MHID), DFE, p0, 1.f / W13_SCALE, HID_SCALE};
                      pg8::gemm_phase<EpiSwiglu8, pg8::MoeOrder, true, true>(C.lds, g, S, E); }
                    grid_barrier();
                    { const Ctx C = make_ctx(); Gemm g{WSP(bf16_t, WS_MHID), WSP(bf16_t, WS_WM2), np * 256, D, DFE / 2, DFE / 2};
                      pg8::MoeOrder S; MOE_ORDER_INIT(S); S.apan0 = p0; S.estride = (size_t)D * DFE;
                      EpiBf16 E{WSP(bf16_t, WS_Y), D, 1.f / (W2_SCALE * HID_SCALE)};
                      pg8::gemm_phase<EpiBf16, pg8::MoeOrder, true, true>(C.lds, g, S, E); }
                    grid_barrier();
                }
            }
            if (IN(19)) { LQ(); const Ctx C = make_ctx(); phase_final(C, POUT, WSP(unsigned char, WS_ROUTE), WSP(bf16_t, WS_Y), LMODS, PIN(27)); }
        }
}

__global__ void __launch_bounds__(512, 2) fwd_kernel(Params p) {
    extern __shared__ __attribute__((aligned(16))) unsigned char lds_raw[];
    (void)p;
    { volatile LAS unsigned* misc = (volatile LAS unsigned*)((LAS unsigned char*)lds_raw + LDS_MISC);
      if (threadIdx.x < 16) misc[threadIdx.x] = 0u;
      if ((threadIdx.x & 63) == 0) ((volatile LAS int*)((LAS unsigned char*)lds_raw + LDS_WTAB_OFF))[(unsigned)__builtin_amdgcn_s_getreg((5 << 11) | 4) & 63u] = threadIdx.x >> 6;
      __syncthreads();
      (void)xcd_barrier_post((unsigned*)(kparams()->ws + WS_CTL) + CW_BAR + kparams()->li * XCD_BAR_WORDS, misc); }
    if (IN(0)) { const Ctx C = make_ctx(); phase_prologue(C); } SEAM(0);

    layer_phases<0>();
    layer_phases<1>();
#undef IN
#undef SEAM
}


extern "C" void kernel_launch(void* const* d_in, const int* in_sizes, int n_in, void* d_out, int out_size, void* d_ws, size_t ws_size, hipStream_t stream) {
    static int grid = 0;
    if (grid == 0) {
        if (n_in != 28 || out_size != NLAT * D || ws_size < WS_END) { fprintf(stderr, "kernel_launch: unexpected problem (n_in %d, out %d, ws %zu)\n", n_in, out_size, ws_size); grid = -1; return; }
        int dev = 0, cus = 0, per_cu = 0;
        if (hipGetDevice(&dev) != hipSuccess || hipDeviceGetAttribute(&cus, hipDeviceAttributeMultiprocessorCount, dev) != hipSuccess) { grid = -1; return; }
        if (hipFuncSetAttribute((const void*)fwd_kernel, hipFuncAttributeMaxDynamicSharedMemorySize, LDS_BYTES) != hipSuccess) { fprintf(stderr, "kernel_launch: cannot set %d B dynamic LDS\n", LDS_BYTES); grid = -1; return; }
        if (hipOccupancyMaxActiveBlocksPerMultiprocessor(&per_cu, (const void*)fwd_kernel, 512, LDS_BYTES) != hipSuccess || per_cu < 1) fprintf(stderr, "kernel_launch: occupancy query says %d\n", per_cu);
        (void)hipGetLastError();
        grid = cus;
    }
    if (grid < 0) return;
    (void)hipMemsetAsync((char*)d_ws + WS_CTL, 0, CTL_BYTES, stream);
    Params a{};
    for (int i = 0; i < 28; ++i) a.in[i] = (const float*)d_in[i];
    a.out = (float*)d_out; a.ws = (unsigned char*)d_ws; a.ph_lo = 0; a.ph_hi = NPHASE; a.li = 0; a.pad = 0;
    hipLaunchKernelGGL(fwd_kernel, dim3(grid), dim3(512), LDS_BYTES, stream, a);
}
```

```cpp
#include <hip/hip_runtime.h>
#include <cstdio>
#include <cstdint>


constexpr int D = 1024, NB = 32, T = 2048, CL = 256;
constexpr int NLAT = NB * T, NCTX = NB * CL, NTOK = NLAT + NCTX;
constexpr int PW = 4096;
constexpr int DIN = 6144, DFF = 2752, DFFP = 2816, DFE = 3584, NE = 8;
constexpr float EPS = 1e-6f;
constexpr float LOG2E = 1.4426950408889634f;
constexpr float QSCALE = 0.125f * LOG2E;
constexpr int PC_Q = 0, PC_LF = 512, PC_G = 1024, PC_LB = 1536, PC_K = 2048, PC_V = 2560, PC_RQ = 3072, PC_RI = 3584, PC_GA = 2048, PC_GR = 3072;

constexpr size_t MiB = 1u << 20;
constexpr size_t WS_CTL = 0, CTL_BYTES = 1 * MiB;
constexpr size_t WS_MODS = 1 * MiB;
constexpr size_t WS_LBS = 3 * MiB;
constexpr size_t WS_ROPE = 3 * MiB + 65536;
constexpr size_t WS_ROUTE = 4 * MiB;
constexpr size_t WS_CNT = 6 * MiB;
constexpr size_t WS_RS0 = 131072;
constexpr size_t WS_BIASF = 7 * MiB;
constexpr size_t WS_AN = 640 * MiB;
constexpr float RS_SCALE = 1024.f;
constexpr size_t WS_CTXRES = 8 * MiB;
constexpr size_t WS_WIN = 40 * MiB;
constexpr size_t WS_WIN8 = 56 * MiB;
constexpr size_t WS_H8 = 809 * MiB;
constexpr size_t WS_WUA = 64 * MiB;
constexpr size_t WS_WUR = 66 * MiB;
constexpr size_t WS_WO = 68 * MiB;
constexpr size_t WS_W13 = 72 * MiB;
constexpr size_t WS_W2 = 83 * MiB;
constexpr size_t WS_H = 89 * MiB;
constexpr size_t WS_P = 233 * MiB;
constexpr size_t WS_MERGED = 89 * MiB;
constexpr size_t WS_HID = 233 * MiB;
constexpr size_t WS_WM13 = 896 * MiB;
constexpr size_t WS_WM2 = 952 * MiB;
constexpr size_t WS_AG = 89 * MiB;
constexpr size_t WS_MHID = 219 * MiB;
constexpr size_t WS_Y = 458 * MiB;
constexpr size_t WS_H2M = 720 * MiB;
constexpr size_t WS_END = 1024 * MiB;
constexpr int MOE_CHUNK = 256;

constexpr int CW_BAR = 4096;

#define LAS __attribute__((address_space(3)))
#define GAS __attribute__((address_space(1)))
typedef unsigned short bf16_t;
typedef short bf16x8 __attribute__((ext_vector_type(8)));
typedef short s16x4 __attribute__((ext_vector_type(4)));
typedef _Float16 half8 __attribute__((ext_vector_type(8)));
typedef _Float16 half4 __attribute__((ext_vector_type(4)));
typedef float f32x4 __attribute__((ext_vector_type(4)));
typedef float f32x2 __attribute__((ext_vector_type(2)));
typedef float f32x16 __attribute__((ext_vector_type(16)));
typedef unsigned u32x4 __attribute__((ext_vector_type(4)));
typedef unsigned u32x2 __attribute__((ext_vector_type(2)));
#define DI __device__ __forceinline__
#define LDS_WAIT() asm volatile("s_waitcnt lgkmcnt(0)" ::: "memory")
#define VM_WAIT() asm volatile("s_waitcnt vmcnt(0)" ::: "memory")
#define LDS_BARRIER() do { asm volatile("s_waitcnt lgkmcnt(0)" ::: "memory"); __builtin_amdgcn_s_barrier(); asm volatile("" ::: "memory"); } while (0)

typedef __bf16 bf16x2_t __attribute__((ext_vector_type(2)));
DI unsigned cvt_pk_bf16(float lo, float hi) { f32x2 v = {lo, hi}; bf16x2_t b = __builtin_convertvector(v, bf16x2_t); return __builtin_bit_cast(unsigned, b); }
typedef int v8i32 __attribute__((ext_vector_type(8)));
typedef int v4i32 __attribute__((ext_vector_type(4)));
DI unsigned pack_fp8x4(float a, float b, float c, float d) {
    a = fminf(fmaxf(a, -448.f), 448.f); b = fminf(fmaxf(b, -448.f), 448.f); c = fminf(fmaxf(c, -448.f), 448.f); d = fminf(fmaxf(d, -448.f), 448.f);
    int w = 0; w = __builtin_amdgcn_cvt_pk_fp8_f32(a, b, w, false); w = __builtin_amdgcn_cvt_pk_fp8_f32(c, d, w, true); return (unsigned)w; }
DI float bf2f(unsigned short b) { return __uint_as_float(((unsigned)b) << 16); }
DI float bflo(unsigned w) { return __uint_as_float(w << 16); }
DI float bfhi(unsigned w) { return __uint_as_float(w & 0xffff0000u); }
DI float fsilu(float x) { return x * __builtin_amdgcn_rcpf(1.f + __expf(-x)); }
DI float fsigmoid(float x) { return __builtin_amdgcn_rcpf(1.f + __expf(-x)); }
DI float xhalf(float v, int hi) {
    const auto rr = __builtin_amdgcn_permlane32_swap(__float_as_uint(v), __float_as_uint(v), false, false);
    return __uint_as_float(hi ? rr[0] : rr[1]);
}
DI float xrow(float v, int odd) {
    const auto rr = __builtin_amdgcn_permlane16_swap(__float_as_uint(v), __float_as_uint(v), false, false);
    return __uint_as_float(odd ? rr[0] : rr[1]);
}
DI float wave_sum(float v) {
#pragma unroll
    for (int o = 1; o < 64; o <<= 1) v += __shfl_xor(v, o);
    return v;
}
DI int crow(int r, int hi) { return (r & 3) + 8 * (r >> 2) + 4 * hi; }

constexpr int LDS_WTAB_OFF = 148480 + 128;
DI int my_tid() {
    extern __shared__ __attribute__((aligned(16))) unsigned char lds_raw[];
    const unsigned hw = (unsigned)__builtin_amdgcn_s_getreg((5 << 11) | 4) & 63u;
    const int w = __builtin_amdgcn_readfirstlane(((volatile LAS int*)((LAS unsigned char*)lds_raw + LDS_WTAB_OFF))[hw]);
    int t = w * 64 + (int)__builtin_amdgcn_mbcnt_hi(~0u, __builtin_amdgcn_mbcnt_lo(~0u, 0u));
    asm volatile("" : "+v"(t)); return t;
}
#define XB_TMO      128
#define XB_XCNT(j)  (256  + 64 * (j))
#define XB_XSUB(j)  (1280 + 64 * (j))
#define XB_XGEN(j)  (2304 + 64 * (j))
#define XB_TOP      3328
#define XB_TOPGEN   3392
#define XCD_BAR_WORDS 3456
#define XB_SPIN_CAP (1u << 22)
DI unsigned xb_ld(unsigned* p)              { return __hip_atomic_load(p, __ATOMIC_RELAXED, __HIP_MEMORY_SCOPE_AGENT); }
DI unsigned xb_add(unsigned* p, unsigned v) { return __hip_atomic_fetch_add(p, v, __ATOMIC_RELAXED, __HIP_MEMORY_SCOPE_AGENT); }
DI unsigned xb_xcc_id() { return (unsigned)__builtin_amdgcn_s_getreg((3 << 11) | 20) & 0xFu; }
#define XB_SPIN(cond, bar) do { unsigned _sp = 0; while (cond) { __builtin_amdgcn_s_sleep(1); \
    if ((++_sp & 255u) == 0u) { if (xb_ld(&(bar)[XB_TMO])) break; if (_sp > XB_SPIN_CAP) { atomicAdd(&(bar)[XB_TMO], 1u); break; } } } } while (0)
struct XcdBarrier { unsigned* bar; unsigned x; volatile LAS unsigned* st; };
DI XcdBarrier xcd_barrier_post(unsigned* bar, volatile LAS unsigned* st) {
    XcdBarrier b; b.bar = bar; b.x = xb_xcc_id(); b.st = st;
    if (my_tid() == 0) (void)xb_add(&bar[XB_XCNT(b.x)], 1u);
    return b;
}
DI void xcd_barrier_complete(unsigned* bar, unsigned x, unsigned& nloc, unsigned& nx) {
    const unsigned G = gridDim.x * gridDim.y * gridDim.z;
    unsigned sum, cnt, mine, sp = 0u;
    for (;;) {
        sum = 0u; cnt = 0u; mine = 0u;
#pragma unroll
        for (unsigned j = 0; j < 16; ++j) { const unsigned c = xb_ld(&bar[XB_XCNT(j)]); sum += c; cnt += (c > 0u) ? 1u : 0u; mine = (j == x) ? c : mine; }
        if (sum == G) break;
        __builtin_amdgcn_s_sleep(1);
        if ((++sp & 255u) == 0u) { if (xb_ld(&bar[XB_TMO])) break; if (sp > XB_SPIN_CAP) { atomicAdd(&bar[XB_TMO], 1u); break; } }
    }
    nloc = mine > 0u ? mine : 1u; nx = cnt > 0u ? cnt : 1u;
}
DI void xcd_barrier(const XcdBarrier& b) {
    asm volatile("s_waitcnt vmcnt(0)" ::: "memory");
    __syncthreads();
    if (my_tid() == 0) {
        unsigned* bar = b.bar;
        __builtin_amdgcn_s_waitcnt(0);
        unsigned nloc = b.st[0], nx = b.st[1];
        if (nloc == 0u) { xcd_barrier_complete(bar, b.x, nloc, nx); b.st[0] = nloc; b.st[1] = nx; }
        const unsigned old = xb_add(&bar[XB_XSUB(b.x)], 1u);
        const unsigned gen = old / nloc;
        if (old + 1u == (gen + 1u) * nloc) {
            __builtin_amdgcn_fence(__ATOMIC_RELEASE, "agent");
            asm volatile("s_waitcnt vmcnt(0)" ::: "memory");
            const unsigned og = xb_add(&bar[XB_TOP], 1u);
            const unsigned tg = og / nx;
            if (og + 1u == (tg + 1u) * nx) xb_add(&bar[XB_TOPGEN], 1u);
            else XB_SPIN(xb_ld(&bar[XB_TOPGEN]) == tg, bar);
            __builtin_amdgcn_fence(__ATOMIC_ACQUIRE, "agent");
            xb_add(&bar[XB_XGEN(b.x)], 1u);
            asm volatile("s_waitcnt vmcnt(0)" ::: "memory");
        } else {
            XB_SPIN(xb_ld(&bar[XB_XGEN(b.x)]) == gen, bar);
            __builtin_amdgcn_fence(__ATOMIC_ACQUIRE, "agent");
            asm volatile("s_waitcnt vmcnt(0)" ::: "memory");
        }
    }
    __syncthreads();
}

namespace pg8 {
constexpr int BM = 256, BK = 64, HALF = 128, HTB = HALF * BK * 2, STAGE_BYTES = 8 * HTB, NXCD = 8, WGM = 8;
__host__ __device__ __forceinline__ int lds_byte(int r, int c) { const int st = (r >> 4) * 2 + (c >> 5), rr = r & 15, cc = c & 31, ob = rr * 64 + cc * 2; return st * 1024 + (ob ^ (((ob >> 9) & 1) << 5)); }
__host__ __device__ __forceinline__ void stage_rc(int b, int& R, int& C) { const int st = b / 1024, sb = b % 1024, swz = sb ^ (((sb >> 9) & 1) << 5); R = (st >> 1) * 16 + swz / 64; C = (st & 1) * 32 + (swz % 64) / 2; }
__host__ __device__ __forceinline__ int perm32(int rho) { const int n = rho >> 4, i = rho & 15; return 8 * (i >> 2) + 4 * n + (i & 3); }

struct Unit { int pm, pn; const char* a; const char* b; };
struct Gemm { const bf16_t* A; const bf16_t* Bt; int M, N, K, lda; };

struct StaticOrder {
    int nM, nN, nwg, G, c;
    DI void init(const Gemm& g, int G_, int c_) { nM = g.M / BM; nN = g.N / BM; nwg = nM * nN; G = G_; c = c_; }
    DI bool tile(int i, int& pm, int& pn) const {
        const int L = i * G + c; if (L >= nwg) return false;
        int wgid = L; { const int q = nwg / NXCD, r = nwg % NXCD, xcd = wgid % NXCD, off = wgid / NXCD; wgid = (xcd < r ? xcd * (q + 1) : r * (q + 1) + (xcd - r) * q) + off; }
        const int nig = WGM * nN, gid = wgid / nig, fm = gid * WGM, gsz = (nM - fm) < WGM ? (nM - fm) : WGM;
        pm = fm + ((wgid % nig) % gsz); pn = (wgid % nig) / gsz; return true;
    }
    DI bool next(const Gemm& g, int i, Unit& u) const { if (!tile(i, u.pm, u.pn)) return false;
        u.a = (const char*)g.A + (size_t)u.pm * ((size_t)BM * g.lda * 2); u.b = (const char*)g.Bt + (size_t)u.pn * ((size_t)BM * g.K * 2); return true; }
};
struct MoeOrder {
    StaticOrder so; int p0, apan0; int pb[7]; size_t estride;
    DI void load_pb(const int* pbv) {
#pragma unroll
        for (int k = 0; k < 7; ++k) pb[k] = __builtin_amdgcn_readfirstlane(pbv[k + 1]); }
    DI bool next(const Gemm& g, int i, Unit& u) const {
        int pm, pn; if (!so.tile(i, pm, pn)) return false;
        u.pm = p0 + pm; u.pn = pn; int e = 0;
#pragma unroll
        for (int k = 0; k < 7; ++k) e += (u.pm >= pb[k]) ? 1 : 0;
        u.a = (const char*)g.A + (size_t)(u.pm - apan0) * ((size_t)BM * g.lda * 2); u.b = (const char*)g.Bt + (size_t)e * estride + (size_t)pn * ((size_t)BM * g.K * 2); return true;
    }
};

template <class Epi, class Sched, bool ALIGN_EPI = true, bool F8 = false, bool MIDHOOK = false>
DI void gemm_phase(LAS unsigned char* lds, const Gemm g, const Sched& S, const Epi& E) {
    const int tid_ = my_tid();
    const int tid = tid_, wid = __builtin_amdgcn_readfirstlane(tid >> 6), lane = tid & 63, wr = wid >> 2, wc = wid & 3, fr = lane & 15, fq = lane >> 4;
    const int K = g.K, nt = K / BK;
    unsigned voffA[2], voffB[2];
#pragma unroll
    for (int i = 0; i < 2; ++i) { int R, C; stage_rc(tid * 16 + i * 8192, R, C); const int Rb = Epi::PERM ? ((R & ~31) + perm32(R & 31)) : R;
        voffA[i] = (unsigned)(R * g.lda + C) * 2u; voffB[i] = (unsigned)(Rb * K + C) * 2u; }
    const size_t kstep = (size_t)(BK * 2);
    const size_t hstepA = (size_t)HALF * g.lda * 2, hstepB = (size_t)HALF * K * 2;
    const unsigned ldsw = (unsigned)wid * 1024u;
    const int aoff = lds_byte(wr * 64 + fr, fq * 8), boff = lds_byte(wc * 32 + fr, fq * 8);
#define PG8_SA(b, h) (((b) * 2 + (h)) * HTB)
#define PG8_SB(b, h) ((4 + (b) * 2 + (h)) * HTB)
#define PG8_STAGE(bufoff, gbase, voff) do { _Pragma("unroll") for (int _i = 0; _i < 2; ++_i) \
        __builtin_amdgcn_global_load_lds((const unsigned*)((const char*)(gbase) + (voff)[_i]), (LAS unsigned*)(lds + (bufoff) + ldsw + _i * 8192), 16, 0, 0); } while (0)
#define PG8_LD8(p) __builtin_shufflevector(*(const LAS v4i32*)(p), *(const LAS v4i32*)((p) + 1024), 0, 1, 2, 3, 4, 5, 6, 7)
#define PG8_LDA(dst, b, h) do { if constexpr (F8) { _Pragma("unroll") for (int m = 0; m < 4; ++m) dst##8[m] = PG8_LD8(lds + PG8_SA(b, h) + aoff + m * 2048); } \
        else { _Pragma("unroll") for (int m = 0; m < 4; ++m) _Pragma("unroll") for (int k = 0; k < 2; ++k) dst[m][k] = *(const LAS bf16x8*)(lds + PG8_SA(b, h) + aoff + m * 2048 + k * 1024); } } while (0)
#define PG8_LDB(dst, b, h) do { if constexpr (F8) { _Pragma("unroll") for (int n = 0; n < 2; ++n) dst##8[n] = PG8_LD8(lds + PG8_SB(b, h) + boff + n * 2048); } \
        else { _Pragma("unroll") for (int n = 0; n < 2; ++n) _Pragma("unroll") for (int k = 0; k < 2; ++k) dst[n][k] = *(const LAS bf16x8*)(lds + PG8_SB(b, h) + boff + n * 2048 + k * 1024); } } while (0)
#define PG8_MMA(ai, bj, At, Bt) do { __builtin_amdgcn_s_setprio(1); \
        if constexpr (F8) { _Pragma("unroll") for (int m = 0; m < 4; ++m) _Pragma("unroll") for (int n = 0; n < 2; ++n) \
            asm volatile("v_mfma_scale_f32_16x16x128_f8f6f4 %0, %1, %2, %0, %3, %3 op_sel_hi:[0,0,0]" : "+v"(acc[ai][bj][m][n]) : "v"(Bt##8[n]), "v"(At##8[m]), "v"(one8)); } \
        else { _Pragma("unroll") for (int m = 0; m < 4; ++m) _Pragma("unroll") for (int n = 0; n < 2; ++n) _Pragma("unroll") for (int k = 0; k < 2; ++k) \
            acc[ai][bj][m][n] = __builtin_amdgcn_mfma_f32_16x16x32_bf16(Bt[n][k], At[m][k], acc[ai][bj][m][n], 0, 0, 0); } \
        __builtin_amdgcn_s_setprio(0); } while (0)
#define PG8_WAIT_V(n) asm volatile("s_waitcnt vmcnt(" #n ")" ::: "memory")
#define PG8_WAIT_VX(n) asm volatile("s_waitcnt vmcnt(%0)" :: "n"(n) : "memory")
#define PG8_WAIT_L(n) asm volatile("s_waitcnt lgkmcnt(" #n ")" ::: "memory")
#define PG8_BAR __builtin_amdgcn_s_barrier()
#define PG8_SCHED __builtin_amdgcn_sched_barrier(0)
    Unit cur, nxt; int ui = 0;
    if (!S.next(g, 0, cur)) return;
    f32x4 acc[2][2][4][2];
#pragma unroll
    for (int a = 0; a < 2; ++a)
#pragma unroll
        for (int b = 0; b < 2; ++b)
#pragma unroll
            for (int m = 0; m < 4; ++m)
#pragma unroll
                for (int n = 0; n < 2; ++n) acc[a][b][m][n] = (f32x4){0.f, 0.f, 0.f, 0.f};
    bf16x8 At[4][2], B0[2][2], B1[2][2]; v8i32 At8[4], B08[2], B18[2]; const int one8 = 0x7F7F7F7F;
    const char* cA = cur.a; const char* cB = cur.b;
    PG8_STAGE(PG8_SB(0, 0), cB, voffB); PG8_STAGE(PG8_SB(0, 1), cB + hstepB, voffB); PG8_STAGE(PG8_SA(0, 0), cA, voffA); PG8_STAGE(PG8_SA(0, 1), cA + hstepA, voffA);
    if (wr == 1) PG8_BAR;
    PG8_WAIT_V(2); PG8_BAR;
    PG8_STAGE(PG8_SB(1, 0), cB + kstep, voffB); PG8_STAGE(PG8_SA(1, 0), cA + kstep, voffA); PG8_STAGE(PG8_SB(1, 1), cB + hstepB + kstep, voffB);
    PG8_WAIT_V(6); PG8_BAR;
    for (;;) {
        const bool has_next = S.next(g, ui + 1, nxt);
        const char* nA = has_next ? nxt.a : cA; const char* nB = has_next ? nxt.b : cB;
        for (int t = 0; t < nt; t += 2) {
            const bool last = (t == nt - 2);
            if constexpr (MIDHOOK) { PG8_SCHED; if (t == nt / 2) E.mid(acc, cur, wr, wc, fr, fq); PG8_SCHED; }
            const char* a1 = cA + (size_t)(t + 1) * kstep;
            const char* a2 = last ? nA : cA + (size_t)(t + 2) * kstep; const char* b2 = last ? nB : cB + (size_t)(t + 2) * kstep;
            const char* a3 = a2 + kstep; const char* b3 = b2 + kstep;
            const int relax = __builtin_amdgcn_readfirstlane(((t == 0) && (ui > 0)) ? 1 : 0);
#define PG8_WAIT_V8R asm volatile("s_cmp_lg_u32 %0, 0\n\ts_cbranch_scc1 1f\n\ts_waitcnt vmcnt(8)\n1:\n\ts_waitcnt vmcnt(%1)" :: "s"(relax), "n"(8 + Epi::NVM) : "memory", "scc")
            PG8_LDB(B0, 0, 0); PG8_LDB(B1, 0, 1); PG8_SCHED; PG8_LDA(At, 0, 0); PG8_STAGE(PG8_SA(1, 1), a1 + hstepA, voffA);
            PG8_WAIT_V8R; PG8_WAIT_L(0); PG8_BAR; PG8_MMA(0, 0, At, B0); PG8_MMA(0, 1, At, B1); PG8_BAR; PG8_SCHED;
            PG8_LDA(At, 0, 1); PG8_STAGE(PG8_SB(0, 0), b2, voffB); PG8_STAGE(PG8_SB(0, 1), b2 + hstepB, voffB); PG8_STAGE(PG8_SA(0, 0), a2, voffA);
            PG8_WAIT_V8R; PG8_WAIT_L(0); PG8_BAR; PG8_MMA(1, 0, At, B0); PG8_MMA(1, 1, At, B1); PG8_BAR; PG8_SCHED;
            PG8_LDB(B0, 1, 0); PG8_LDB(B1, 1, 1); PG8_SCHED; PG8_LDA(At, 1, 0); PG8_STAGE(PG8_SA(0, 1), a2 + hstepA, voffA);
            PG8_WAIT_V(8); PG8_WAIT_L(0); PG8_BAR; PG8_MMA(0, 0, At, B0); PG8_MMA(0, 1, At, B1); PG8_BAR; PG8_SCHED;
            PG8_LDA(At, 1, 1); PG8_STAGE(PG8_SB(1, 0), b3, voffB); PG8_STAGE(PG8_SB(1, 1), b3 + hstepB, voffB); PG8_STAGE(PG8_SA(1, 0), a3, voffA);
            PG8_WAIT_V(8); PG8_WAIT_L(0); PG8_BAR; PG8_MMA(1, 0, At, B0); PG8_MMA(1, 1, At, B1); PG8_BAR; PG8_SCHED;
#undef PG8_WAIT_V8R
        }
        if constexpr (ALIGN_EPI) { if (wr == 0) PG8_BAR; }
        if constexpr (F8) asm volatile("s_nop 15\n\ts_nop 15" ::: "memory");
        E(acc, cur, wr, wc, fr, fq);
        if (!has_next) break;
#pragma unroll
        for (int a = 0; a < 2; ++a)
#pragma unroll
            for (int b = 0; b < 2; ++b)
#pragma unroll
                for (int m = 0; m < 4; ++m)
#pragma unroll
                    for (int n = 0; n < 2; ++n) acc[a][b][m][n] = (f32x4){0.f, 0.f, 0.f, 0.f};
        cur = nxt; cA = nA; cB = nB; ++ui;
        if constexpr (ALIGN_EPI) { if (wr == 1) PG8_BAR; }
    }
    PG8_WAIT_V(0);
    if constexpr (!ALIGN_EPI) { if (wr == 0) PG8_BAR; }
    PG8_BAR;
#undef PG8_SA
#undef PG8_SB
#undef PG8_STAGE
#undef PG8_LDA
#undef PG8_LD8
#undef PG8_LDB
#undef PG8_MMA
#undef PG8_WAIT_V
#undef PG8_WAIT_VX
#undef PG8_WAIT_L
#undef PG8_BAR
#undef PG8_SCHED
}
}
using pg8::Unit; using pg8::Gemm;
typedef const f32x4 (&AccRef)[2][2][4][2];

DI u32x4 pack8(const f32x4& v0, const f32x4& v1) { u32x4 w; w.x = cvt_pk_bf16(v0[0], v0[1]); w.y = cvt_pk_bf16(v0[2], v0[3]); w.z = cvt_pk_bf16(v1[0], v1[1]); w.w = cvt_pk_bf16(v1[2], v1[3]); return w; }
DI void unpack8(const u32x4& w, float (&f)[8]) { f[0] = bflo(w.x); f[1] = bfhi(w.x); f[2] = bflo(w.y); f[3] = bfhi(w.y); f[4] = bflo(w.z); f[5] = bfhi(w.z); f[6] = bflo(w.w); f[7] = bfhi(w.w); }

struct EpiInProj {
    static constexpr int NVM = 16; static constexpr bool PERM = true;
    bf16_t* P; const float2* rope; const float* lbf; const float* lbb; int secmap; float asc;
    template <int MODE> DI void run(AccRef acc, const Unit& u, int wr, int wc, int fr, int fq, int sec) const {
        const int row0 = u.pm * 256 + wr * 64 + fr, col0 = sec * 512 + (u.pn & 1) * 256 + wc * 32 + 8 * fq;
        const bool lat = u.pm < (NLAT / 256); const float qs = sec == 0 ? QSCALE : 1.f;
        f32x4 lb0[2], lb1[2];
        if (MODE == 2) {
#pragma unroll
            for (int bj = 0; bj < 2; ++bj) { const float* lb = (sec == 1 ? lbf : lbb) + ((col0 + bj * 128) & 511); lb0[bj] = *(const f32x4*)lb; lb1[bj] = *(const f32x4*)(lb + 4); } }
        f32x4 rr[2][4][2];
        if (MODE == 3) {
#pragma unroll
            for (int ai = 0; ai < 2; ++ai)
#pragma unroll
                for (int m = 0; m < 4; ++m) { const f32x4* rp = (const f32x4*)(rope + (size_t)((row0 + ai * 128 + m * 16) & (T - 1)) * 32 + ((col0 & 63) >> 1));
                    rr[ai][m][0] = lat ? rp[0] : (f32x4){1.f, 0.f, 1.f, 0.f}; rr[ai][m][1] = lat ? rp[1] : (f32x4){1.f, 0.f, 1.f, 0.f}; } }
#pragma unroll
        for (int ai = 0; ai < 2; ++ai)
#pragma unroll
            for (int m = 0; m < 4; ++m) {
                const int row = row0 + ai * 128 + m * 16; bf16_t* rowp = P + (size_t)row * PW + col0;
#pragma unroll
                for (int bj = 0; bj < 2; ++bj) {
                    f32x4 v0 = acc[ai][bj][m][0] * asc, v1 = acc[ai][bj][m][1] * asc; u32x4 w;
                    if (MODE == 3) {
                        {
                            const f32x4 r0 = rr[ai][m][0], r1 = rr[ai][m][1];
                            f32x4 o0, o1;
                            o0[0] = v0[0] * r0[0] - v0[1] * r0[1]; o0[1] = v0[0] * r0[1] + v0[1] * r0[0];
                            o0[2] = v0[2] * r0[2] - v0[3] * r0[3]; o0[3] = v0[2] * r0[3] + v0[3] * r0[2];
                            o1[0] = v1[0] * r1[0] - v1[1] * r1[1]; o1[1] = v1[0] * r1[1] + v1[1] * r1[0];
                            o1[2] = v1[2] * r1[2] - v1[3] * r1[3]; o1[3] = v1[2] * r1[3] + v1[3] * r1[2];
                            v0 = o0; v1 = o1;
                        }
                        w = pack8(v0 * qs, v1 * qs);
                    } else if (MODE == 1) {
#pragma unroll
                        for (int j = 0; j < 4; ++j) { v0[j] = fsilu(v0[j]); v1[j] = fsilu(v1[j]); }
                        w = pack8(v0, v1);
                    } else if (MODE == 2) {
                        half8 hv;
#pragma unroll
                        for (int j = 0; j < 8; ++j) {
                            const float z = fmaxf(j < 4 ? v0[j] : v1[j - 4], -80.f), b = j < 4 ? lb0[bj][j] : lb1[bj][j - 4];
                            const float sg = __builtin_amdgcn_rcpf(1.f + __builtin_amdgcn_exp2f(-LOG2E * z));
                            hv[j] = (_Float16)(0.6931471805599453f * __builtin_amdgcn_logf(b + (1.f - b) * sg));
                        }
                        w = __builtin_bit_cast(u32x4, hv);
                    } else w = pack8(v0, v1);
                    *(u32x4*)(rowp + bj * 128) = w;
                }
            }
    }
    DI void operator()(AccRef acc, const Unit& u, int wr, int wc, int fr, int fq) const {
        const int sec = (secmap >> (4 * (u.pn >> 1))) & 15;
        if (sec == 0 || sec == 4) run<3>(acc, u, wr, wc, fr, fq, sec);
        else if (sec == 2 || sec == 6) run<1>(acc, u, wr, wc, fr, fq, sec);
        else if (sec == 1 || sec == 3) run<2>(acc, u, wr, wc, fr, fq, sec);
        else run<0>(acc, u, wr, wc, fr, fq, sec);
    }
};
struct EpiGates {
    static constexpr int NVM = 16; static constexpr bool PERM = true; bf16_t* P; float asc;
    DI void operator()(AccRef acc, const Unit& u, int wr, int wc, int fr, int fq) const {
        const int row0 = u.pm * 256 + wr * 64 + fr, col0 = PC_GA + u.pn * 256 + wc * 32 + 8 * fq;
#pragma unroll
        for (int ai = 0; ai < 2; ++ai)
#pragma unroll
            for (int m = 0; m < 4; ++m) { bf16_t* rowp = P + (size_t)(row0 + ai * 128 + m * 16) * PW + col0;
#pragma unroll
                for (int bj = 0; bj < 2; ++bj) { f32x4 v0 = acc[ai][bj][m][0] * asc, v1 = acc[ai][bj][m][1] * asc;
#pragma unroll
                    for (int j = 0; j < 4; ++j) { v0[j] = fsigmoid(v0[j]); v1[j] = fsigmoid(v1[j]); }
                    *(u32x4*)(rowp + bj * 128) = pack8(v0, v1); } }
    }
};
struct EpiMergeFused {
    static constexpr int NVM = 16; static constexpr bool PERM = true; const bf16_t* P; bf16_t* O;
    DI void mid(f32x4 (&acc)[2][2][4][2], const Unit& u, int wr, int wc, int fr, int fq) const {
        int row0 = u.pm * 256 + wr * 64 + fr, col0 = u.pn * 256 + wc * 32 + 8 * fq;
        asm volatile("" : "+v"(row0), "+v"(col0));
#pragma unroll
        for (int ai = 0; ai < 2; ++ai)
#pragma unroll
            for (int m = 0; m < 4; ++m) { const size_t row = (size_t)(row0 + ai * 128 + m * 16);
#pragma unroll
                for (int bj = 0; bj < 2; ++bj) {
                    float ga[8], gr[8]; unpack8(*(const u32x4*)(P + row * PW + PC_GA + col0 + bj * 128), ga); unpack8(*(const u32x4*)(P + row * PW + PC_GR + col0 + bj * 128), gr);
#pragma unroll
                    for (int j = 0; j < 4; ++j) { acc[ai][bj][m][0][j] *= ga[j] * __builtin_amdgcn_rcpf(fmaxf(gr[j], 1e-30f)); acc[ai][bj][m][1][j] *= ga[4 + j] * __builtin_amdgcn_rcpf(fmaxf(gr[4 + j], 1e-30f)); } }
                asm volatile("" ::: "memory"); }
    }
    DI void operator()(AccRef acc, const Unit& u, int wr, int wc, int fr, int fq) const {
        const int row0 = u.pm * 256 + wr * 64 + fr, col0 = u.pn * 256 + wc * 32 + 8 * fq;
        u32x4 gq[2][4][2];
#pragma unroll
        for (int ai = 0; ai < 2; ++ai)
#pragma unroll
            for (int m = 0; m < 4; ++m)
#pragma unroll
                for (int bj = 0; bj < 2; ++bj) gq[ai][m][bj] = *(const u32x4*)(P + (size_t)(row0 + ai * 128 + m * 16) * PW + PC_GR + col0 + bj * 128);
#pragma unroll
        for (int ai = 0; ai < 2; ++ai)
#pragma unroll
            for (int m = 0; m < 4; ++m) { const size_t row = (size_t)(row0 + ai * 128 + m * 16);
#pragma unroll
                for (int bj = 0; bj < 2; ++bj) {
                    float gr[8]; unpack8(gq[ai][m][bj], gr);
                    f32x4 v0 = acc[ai][bj][m][0], v1 = acc[ai][bj][m][1];
#pragma unroll
                    for (int j = 0; j < 4; ++j) { v0[j] *= fmaxf(gr[j], 1e-30f); v1[j] *= fmaxf(gr[4 + j], 1e-30f); }
                    *(u32x4*)(O + row * D + col0 + bj * 128) = pack8(v0, v1); } }
    }
};
struct EpiResid {
    static constexpr int NVM = 16; static constexpr bool PERM = false;
    const float* xin_l; const float* xin_c; float* xout_l; float* xout_c; const float* mods; int msel;
    DI void operator()(AccRef acc, const Unit& u, int wr, int wc, int fr, int fq) const {
        const bool lat = u.pm < (NLAT / 256);
        const int rbase = (lat ? u.pm : u.pm - NLAT / 256) * 256 + wr * 64 + fr, col0 = u.pn * 256 + wc * 32 + 4 * fq;
        const float* xi = lat ? xin_l : xin_c; float* xo = lat ? xout_l : xout_c;
        const float* mv = mods + (size_t)(lat ? (u.pm >> 3) : 32) * DIN + msel * D + col0;
        f32x4 g[2][2];
#pragma unroll
        for (int bj = 0; bj < 2; ++bj)
#pragma unroll
            for (int n = 0; n < 2; ++n) g[bj][n] = *(const f32x4*)(mv + bj * 128 + n * 16);
        f32x4 xa[4][2][2], r0[4][2][2];
#define RES_OFF(ai, m) ((size_t)(rbase + (ai) * 128 + (m) * 16) * D + col0)
#pragma unroll
        for (int m = 0; m < 4; ++m)
#pragma unroll
            for (int bj = 0; bj < 2; ++bj)
#pragma unroll
                for (int n = 0; n < 2; ++n) xa[m][bj][n] = *(const f32x4*)(xi + RES_OFF(0, m) + bj * 128 + n * 16);
#pragma unroll
        for (int m = 0; m < 4; ++m)
#pragma unroll
            for (int bj = 0; bj < 2; ++bj)
#pragma unroll
                for (int n = 0; n < 2; ++n) r0[m][bj][n] = xa[m][bj][n] + g[bj][n] * acc[0][bj][m][n];
#pragma unroll
        for (int m = 0; m < 4; ++m)
#pragma unroll
            for (int bj = 0; bj < 2; ++bj)
#pragma unroll
                for (int n = 0; n < 2; ++n) xa[m][bj][n] = *(const f32x4*)(xi + RES_OFF(1, m) + bj * 128 + n * 16);
        asm volatile("" ::: "memory");
#pragma unroll
        for (int m = 0; m < 4; ++m)
#pragma unroll
            for (int bj = 0; bj < 2; ++bj)
#pragma unroll
                for (int n = 0; n < 2; ++n) *(f32x4*)(xo + RES_OFF(0, m) + bj * 128 + n * 16) = r0[m][bj][n];
#pragma unroll
        for (int m = 0; m < 4; ++m)
#pragma unroll
            for (int bj = 0; bj < 2; ++bj)
#pragma unroll
                for (int n = 0; n < 2; ++n) *(f32x4*)(xo + RES_OFF(1, m) + bj * 128 + n * 16) = xa[m][bj][n] + g[bj][n] * acc[1][bj][m][n];
#undef RES_OFF
    }
};
struct EpiResidN {
    static constexpr int NVM = 16; static constexpr bool PERM = true;
    const float* xin_l; const float* xin_c; float* xout_l; float* xout_c; const float* mods; int msel;
    const float* nw; int nsc; bf16_t* A; unsigned* RS;
    DI void operator()(AccRef acc, const Unit& u, int, int, int, int) const {
        const int te_ = my_tid(); const int wid_ = __builtin_amdgcn_readfirstlane(te_ >> 6), wr = wid_ >> 2, wc = wid_ & 3, fr = te_ & 15, fq = (te_ >> 4) & 3;
        const bool lat = u.pm < (NLAT / 256); const int bidx = lat ? (u.pm >> 3) : 32;
        const int rbase = (lat ? u.pm : u.pm - NLAT / 256) * 256 + wr * 64 + fr, urow0 = u.pm * 256 + wr * 64 + fr, col0 = u.pn * 256 + wc * 32 + 8 * fq;
        const float* xi = lat ? xin_l : xin_c; float* xo = lat ? xout_l : xout_c;
        const float* mv = mods + (size_t)bidx * DIN + msel * D + col0; const float* nv = mods + (size_t)bidx * DIN + nsc * D + col0;
        f32x4 (&ga)[2][2][4][2] = const_cast<f32x4 (&)[2][2][4][2]>(acc);
        u32x2 gwp[2][2];
#pragma unroll
        for (int bj = 0; bj < 2; ++bj)
#pragma unroll
            for (int n = 0; n < 2; ++n) { const f32x4 g = *(const f32x4*)(mv + bj * 128 + n * 4); const f32x4 gwf = *(const f32x4*)(nw + col0 + bj * 128 + n * 4) * (*(const f32x4*)(nv + bj * 128 + n * 4) + 1.0f);
                gwp[bj][n].x = cvt_pk_bf16(gwf[0], gwf[1]); gwp[bj][n].y = cvt_pk_bf16(gwf[2], gwf[3]);
#pragma unroll
                for (int ai = 0; ai < 2; ++ai)
#pragma unroll
                    for (int m = 0; m < 4; ++m) ga[ai][bj][m][n] *= g; }
        f32x4 xa[4][2][2];
#define RES_OFF(ai, m) ((size_t)(rbase + (ai) * 128 + (m) * 16) * D + col0)
#define RESN_OUT(ai, m, X) do { const size_t uo_ = (size_t)(urow0 + (ai) * 128 + (m) * 16) * D + col0; float ss_ = 0.f; \
            _Pragma("unroll") for (int bj = 0; bj < 2; ++bj) { const f32x4 x0 = X[m][bj][0], x1 = X[m][bj][1]; \
                *(f32x4*)(xo + RES_OFF(ai, m) + bj * 128) = x0; *(f32x4*)(xo + RES_OFF(ai, m) + bj * 128 + 4) = x1; \
                ss_ += ((x0[0] * x0[0] + x0[1] * x0[1]) + (x0[2] * x0[2] + x0[3] * x0[3])) + ((x1[0] * x1[0] + x1[1] * x1[1]) + (x1[2] * x1[2] + x1[3] * x1[3])); \
                const f32x4 w0_ = {bflo(gwp[bj][0].x), bfhi(gwp[bj][0].x), bflo(gwp[bj][0].y), bfhi(gwp[bj][0].y)}, w1_ = {bflo(gwp[bj][1].x), bfhi(gwp[bj][1].x), bflo(gwp[bj][1].y), bfhi(gwp[bj][1].y)}; \
                *(u32x4*)(A + uo_ + bj * 128) = pack8(x0 * w0_, x1 * w1_); } \
            ss_ += xrow(ss_, fq & 1); ss_ += xhalf(ss_, fq >> 1); \
            if (fq == 0) (void)__hip_atomic_fetch_add(RS + urow0 + (ai) * 128 + (m) * 16, (unsigned)fminf(ss_ * RS_SCALE + 0.5f, 2.6e8f), __ATOMIC_RELAXED, __HIP_MEMORY_SCOPE_AGENT); } while (0)
#pragma unroll
        for (int q = 0; q < 4; ++q) { const int ai = q >> 1, m0 = (q & 1) * 2;
#pragma unroll
            for (int m = m0; m < m0 + 2; ++m)
#pragma unroll
                for (int bj = 0; bj < 2; ++bj)
#pragma unroll
                    for (int n = 0; n < 2; ++n) xa[m][bj][n] = *(const f32x4*)(xi + RES_OFF(ai, m) + bj * 128 + n * 4);
#pragma unroll
            for (int m = m0; m < m0 + 2; ++m)
#pragma unroll
                for (int bj = 0; bj < 2; ++bj)
#pragma unroll
                    for (int n = 0; n < 2; ++n) xa[m][bj][n] = xa[m][bj][n] + ga[ai][bj][m][n];
            asm volatile("" ::: "memory");
#pragma unroll
            for (int m = m0; m < m0 + 2; ++m) RESN_OUT(ai, m, xa); }
#undef RESN_OUT
#undef RES_OFF
    }
};
struct EpiSwiglu {
    static constexpr int NVM = 16; static constexpr bool PERM = true; bf16_t* Hd; int ldh; int pan0; const unsigned* RS; const float* bias;
    DI void operator()(AccRef acc, const Unit& u, int wr, int wc, int fr, int fq) const {
        const int row0 = (u.pm - pan0) * 256 + wr * 64 + fr, hc0 = u.pn * 128 + wc * 16 + 4 * fq;
        f32x4 bz[2][2]; float rsd[2][4];
#pragma unroll
        for (int bj = 0; bj < 2; ++bj) { const float* bp = bias + (size_t)(u.pm < NLAT / 256 ? (u.pm >> 3) : 32) * (2 * DFFP) + u.pn * 256 + bj * 128 + wc * 32 + 8 * fq;
            bz[bj][0] = *(const f32x4*)bp; bz[bj][1] = *(const f32x4*)(bp + 4); }
#pragma unroll
        for (int ai = 0; ai < 2; ++ai)
#pragma unroll
            for (int m = 0; m < 4; ++m) rsd[ai][m] = 1.f / sqrtf((float)RS[u.pm * 256 + wr * 64 + fr + ai * 128 + m * 16] * (1.f / (D * RS_SCALE)) + EPS);
#pragma unroll
        for (int ai = 0; ai < 2; ++ai)
#pragma unroll
            for (int m = 0; m < 4; ++m) { bf16_t* rowp = Hd + (size_t)(row0 + ai * 128 + m * 16) * ldh + hc0;
#pragma unroll
                for (int bj = 0; bj < 2; ++bj) { const f32x4 a = acc[ai][bj][m][0] * rsd[ai][m] + bz[bj][0], b = acc[ai][bj][m][1] * rsd[ai][m] + bz[bj][1];
                    u32x2 w; w.x = cvt_pk_bf16(fsilu(a[0]) * b[0], fsilu(a[1]) * b[1]); w.y = cvt_pk_bf16(fsilu(a[2]) * b[2], fsilu(a[3]) * b[3]);
                    *(u32x2*)(rowp + bj * 64) = w; } }
    }
};
struct EpiSwiglu8 {
    static constexpr int NVM = 16; static constexpr bool PERM = true; unsigned char* Hd; int ldh; int pan0; float as, hs;
    DI void operator()(AccRef acc, const Unit& u, int wr, int wc, int fr, int fq) const {
        const int row0 = (u.pm - pan0) * 256 + wr * 64 + fr, hc0 = u.pn * 128 + wc * 16 + 4 * fq;
#pragma unroll
        for (int ai = 0; ai < 2; ++ai)
#pragma unroll
            for (int m = 0; m < 4; ++m) { unsigned char* rowp = Hd + (size_t)(row0 + ai * 128 + m * 16) * ldh + hc0;
#pragma unroll
                for (int bj = 0; bj < 2; ++bj) { const f32x4 a = acc[ai][bj][m][0] * as, b = acc[ai][bj][m][1] * (as * hs);
                    *(unsigned*)(rowp + bj * 64) = pack_fp8x4(fsilu(a[0]) * b[0], fsilu(a[1]) * b[1], fsilu(a[2]) * b[2], fsilu(a[3]) * b[3]); } }
    }
};
struct EpiBf16 {
    static constexpr int NVM = 16; static constexpr bool PERM = true; bf16_t* O; int ldc; float sc;
    DI void operator()(AccRef acc, const Unit& u, int wr, int wc, int fr, int fq) const {
        const int row0 = u.pm * 256 + wr * 64 + fr, col0 = u.pn * 256 + wc * 32 + 8 * fq;
#pragma unroll
        for (int ai = 0; ai < 2; ++ai)
#pragma unroll
            for (int m = 0; m < 4; ++m) { bf16_t* rowp = O + (size_t)(row0 + ai * 128 + m * 16) * ldc + col0;
#pragma unroll
                for (int bj = 0; bj < 2; ++bj) *(u32x4*)(rowp + bj * 128) = pack8(acc[ai][bj][m][0] * sc, acc[ai][bj][m][1] * sc); }
    }
};

typedef short v4i16 __attribute__((ext_vector_type(4)));
DI s16x4 tr16(const LAS unsigned char* p) { return __builtin_bit_cast(s16x4, __builtin_amdgcn_ds_read_tr16_b64_v4i16((LAS v4i16*)p)); }
DI bf16x8 cat8(s16x4 lo, s16x4 hi) { return __builtin_shufflevector(lo, hi, 0, 1, 2, 3, 4, 5, 6, 7); }
DI void dma16(const void* g, LAS unsigned char* l) { __builtin_amdgcn_global_load_lds((const unsigned*)g, (LAS unsigned*)l, 16, 0, 0); }
DI void dma16a(const void* g, LAS unsigned char* l) {
    const unsigned la = __builtin_amdgcn_readfirstlane((unsigned)(size_t)l); unsigned m0s;
    asm volatile("s_mov_b32 %0, m0\n\ts_mov_b32 m0, %2\n\ts_nop 0\n\tglobal_load_lds_dwordx4 %1, off\n\ts_mov_b32 m0, %0" : "=&s"(m0s) : "v"(g), "s"(la) : "memory");
}
DI bf16x8 packf8(const f32x16& x, int s) {
    u32x4 w; w.x = cvt_pk_bf16(x[8 * s], x[8 * s + 1]); w.y = cvt_pk_bf16(x[8 * s + 2], x[8 * s + 3]); w.z = cvt_pk_bf16(x[8 * s + 4], x[8 * s + 5]); w.w = cvt_pk_bf16(x[8 * s + 6], x[8 * s + 7]);
    return __builtin_bit_cast(bf16x8, w);
}
#define MFMA32(a, b, c) __builtin_amdgcn_mfma_f32_32x32x16_bf16((a), (b), (c), 0, 0, 0)

struct Params { const float* in[28]; float* out; unsigned char* ws; int ph_lo, ph_hi, li, pad; };
typedef const __attribute__((address_space(4))) Params* KP;
DI KP kparams() { KP kp = (KP)__builtin_amdgcn_kernarg_segment_ptr(); asm volatile("" : "+s"(kp)); return kp; }
#define PIN(k) (kparams()->in[k])
#define POUT (kparams()->out)
struct Ctx {
    LAS unsigned char* lds; unsigned char* ws; int tid, lane, wave, vcu, G, gw, NGW, bx;
};

constexpr float WIN8_SCALE = 64.f;
#ifndef FP8_SECS0
#define FP8_SECS0 0xE4
#endif
#ifndef FP8_SECS1
#define FP8_SECS1 0xE4
#endif
constexpr int sec_order(int i) { return (int)((0x76524310u >> (4 * i)) & 15u); }
constexpr int sec_slot(int fs, int ps) { int nb = 0, nf = 0; for (int i = 0; i < 8; ++i) { const int s_ = sec_order(i); const bool f = (fs >> s_) & 1; if (s_ == ps) return f ? (0x100 | nf) : nb; if (f) ++nf; else ++nb; } return 0; }
constexpr int n_sec_f8(int fs) { return __builtin_popcount((unsigned)fs); }
constexpr unsigned secmap_of(int fs, bool f8) { unsigned m = 0; int k = 0; for (int i = 0; i < 8; ++i) { const int s_ = sec_order(i); if ((((fs >> s_) & 1) != 0) == f8) { m |= (unsigned)s_ << (4 * k); ++k; } } return m; }
DI int map_row(int kind, int n, int fs) {
    if (kind == 0) return n;
    if (kind == 2) return 8 * (n >> 2) + (n & 3);
    if (kind == 3) return 8 * (n >> 2) + (n & 3) + 4;
    const int sec = n >> 9, j = n & 511; int r;
    if (n >= 4096) r = (1 << 16) | (n_sec_f8(fs) * 512 + (n - 4096));
    else {
        const int ps = sec == 0 ? 0 : sec == 1 ? 4 : sec == 2 ? 5 : sec == 3 ? 6 : sec == 4 ? 7 : sec == 5 ? 1 : sec == 6 ? 3 : 2;
        const int sl = sec_slot(fs, ps); int jj = j;
        if (sec == 0 || sec == 1) { const int hs = j >> 6, d = j & 63; jj = hs * 64 + (d < 32 ? 2 * d : 2 * (d - 32) + 1); }
        r = ((sl & 0x100) ? (1 << 16) : 0) | ((sl & 0xff) * 512 + jj); }
    return kind == 4 ? (r & 0xffff) : r;
}
constexpr int TP_PITCH = 68, TP_SCR = 64 * TP_PITCH * 4;
DI void transpose_load(const float* W, int ldw, int k0, int n0, LAS float* scr, int lane) {
    const int r = lane >> 4, c4 = (lane & 15) * 4; f32x4 v[16];
#pragma unroll
    for (int i = 0; i < 16; ++i) v[i] = *(const f32x4*)(W + (size_t)(k0 + 4 * i + r) * ldw + n0 + c4);
#pragma unroll
    for (int i = 0; i < 16; ++i) *(LAS f32x4*)(scr + (4 * i + r) * TP_PITCH + c4) = v[i];
    LDS_WAIT(); asm volatile("" ::: "memory");
}
DI void transpose_item(const float* W, int ldw, int k0, int n0, bf16_t* WT, int ldt, int kind, LAS float* scr, int lane, int fs = 0) {
    transpose_load(W, ldw, k0, n0, scr, lane);
    bf16_t* dst = WT + (size_t)map_row(kind, n0 + lane, fs) * ldt + k0;
#pragma unroll
    for (int j = 0; j < 8; ++j) { const LAS float* s = scr + (8 * j) * TP_PITCH + lane;
        u32x4 o; o.x = cvt_pk_bf16(s[0], s[TP_PITCH]); o.y = cvt_pk_bf16(s[2 * TP_PITCH], s[3 * TP_PITCH]); o.z = cvt_pk_bf16(s[4 * TP_PITCH], s[5 * TP_PITCH]); o.w = cvt_pk_bf16(s[6 * TP_PITCH], s[7 * TP_PITCH]);
        *(u32x4*)(dst + 8 * j) = o; }
    LDS_WAIT(); asm volatile("" ::: "memory");
}
DI void transpose_item8(const float* W, int ldw, int k0, int n0, unsigned char* WT, int ldt, int kind, float sc, LAS float* scr, int lane, int fs = 0) {
    transpose_load(W, ldw, k0, n0, scr, lane);
    unsigned char* dst = WT + (size_t)map_row(kind, n0 + lane, fs) * ldt + k0;
#pragma unroll
    for (int j = 0; j < 4; ++j) { const LAS float* s = scr + (16 * j) * TP_PITCH + lane; u32x4 o;
        o.x = pack_fp8x4(s[0] * sc, s[TP_PITCH] * sc, s[2 * TP_PITCH] * sc, s[3 * TP_PITCH] * sc); o.y = pack_fp8x4(s[4 * TP_PITCH] * sc, s[5 * TP_PITCH] * sc, s[6 * TP_PITCH] * sc, s[7 * TP_PITCH] * sc);
        o.z = pack_fp8x4(s[8 * TP_PITCH] * sc, s[9 * TP_PITCH] * sc, s[10 * TP_PITCH] * sc, s[11 * TP_PITCH] * sc); o.w = pack_fp8x4(s[12 * TP_PITCH] * sc, s[13 * TP_PITCH] * sc, s[14 * TP_PITCH] * sc, s[15 * TP_PITCH] * sc);
        *(u32x4*)(dst + 16 * j) = o; }
    LDS_WAIT(); asm volatile("" ::: "memory");
}
DI void transpose_matrix8(const Ctx& C, const float* W, int K, int N, unsigned char* WT, int ldt, int kind, float sc, int& itbase) {
    LAS float* scr = (LAS float*)(C.lds + C.wave * TP_SCR);
    const int nblk = N / 64, nit = (K / 64) * nblk;
    int first = (C.gw - (itbase % C.NGW) + C.NGW) % C.NGW;
    for (int it = first; it < nit; it += C.NGW) transpose_item8(W, N, 64 * (it / nblk), 64 * (it % nblk), WT, ldt, kind, sc, scr, C.lane);
    itbase += nit;
}
DI void transpose_matrix(const Ctx& C, const float* W, int K, int N, bf16_t* WT, int ldt, int kind, int& itbase, int total_unused) {
    (void)total_unused;
    LAS float* scr = (LAS float*)(C.lds + C.wave * TP_SCR);
    const int nblk = N / 64, nit = (K / 64) * nblk;
    int first = (C.gw - (itbase % C.NGW) + C.NGW) % C.NGW;
    for (int it = first; it < nit; it += C.NGW) transpose_item(W, N, 64 * (it / nblk), 64 * (it % nblk), WT, ldt, kind, scr, C.lane);
    itbase += nit;
}
DI void transpose_win(const Ctx& C, const float* W, bf16_t* WA, unsigned char* W8, int& itbase, int fs) {
    LAS float* scr = (LAS float*)(C.lds + C.wave * TP_SCR);
    const int nblk = DIN / 64, nit = (D / 64) * nblk;
    int first = (C.gw - (itbase % C.NGW) + C.NGW) % C.NGW;
    for (int it = first; it < nit; it += C.NGW) { const int k0 = 64 * (it / nblk), n0 = 64 * (it % nblk);
        if (map_row(1, n0, fs) >> 16) transpose_item8(W, DIN, k0, n0, W8, D, 4, WIN8_SCALE, scr, C.lane, fs);
        else transpose_item(W, DIN, k0, n0, WA, D, 1, scr, C.lane, fs); }
    itbase += nit;
}
constexpr int MD_SP = 36;
template <int KIND> DI void phase_rowgemm(const Ctx& C, const int task) {
    const int l = task / (KIND == 0 ? 96 : 43), n0 = (task % (KIND == 0 ? 96 : 43)) * 64, kq = C.lane >> 4, cq = C.lane & 15;
    LAS float* S = (LAS float*)C.lds;
    const int ldw = KIND == 0 ? DIN : DFF;
    const float* W = (KIND == 0 ? PIN(4) + (size_t)l * D * DIN : (l ? PIN(21) : PIN(20))) + n0 + 4 * cq; const float* c0 = PIN(1); const float* cc = PIN(3);
    const float* shv = (const float*)(C.ws + WS_MODS) + 3 * D;
    f32x4 acc[33];
#pragma unroll
    for (int r = 0; r < 33; ++r) acc[r] = (f32x4){0.f, 0.f, 0.f, 0.f};
#pragma unroll 1
    for (int kh = 0; kh < 2; ++kh) {
        __syncthreads();
        for (int i = C.tid; i < 33 * 512; i += 512) { const int r = i >> 9, kk = i & 511;
            S[kk * MD_SP + r] = KIND == 0 ? fsilu(r < 32 ? c0[r * D + kh * 512 + kk] : cc[kh * 512 + kk]) : shv[(size_t)r * DIN + kh * 512 + kk]; }
        __syncthreads();
        const int kb = C.wave * 64 + kq;
#pragma unroll 1
        for (int ib = 0; ib < 16; ib += 8) { f32x4 w[8];
#pragma unroll
            for (int i = 0; i < 8; ++i) w[i] = *(const f32x4*)(W + (size_t)(kh * 512 + kb + 4 * (ib + i)) * ldw);
#pragma unroll
            for (int i = 0; i < 8; ++i) { const LAS float* sp = S + (kb + 4 * (ib + i)) * MD_SP;
#pragma unroll
                for (int q = 0; q < 8; ++q) { const f32x4 s4 = *(const LAS f32x4*)(sp + 4 * q);
                    acc[4 * q] += w[i] * s4[0]; acc[4 * q + 1] += w[i] * s4[1]; acc[4 * q + 2] += w[i] * s4[2]; acc[4 * q + 3] += w[i] * s4[3]; }
                acc[32] += w[i] * sp[32]; } }
    }
#pragma unroll
    for (int r = 0; r < 33; ++r)
#pragma unroll
        for (int j = 0; j < 4; ++j) { float v = acc[r][j]; v += __shfl_xor(v, 16); v += __shfl_xor(v, 32); asm volatile("" : "+v"(v)); acc[r][j] = v; }
    __syncthreads();
    LAS float* red = (LAS float*)C.lds;
    if (kq == 0) {
#pragma unroll
        for (int r = 0; r < 33; ++r) *(LAS f32x4*)(red + (C.wave * 33 + r) * 64 + 4 * cq) = acc[r]; }
    __syncthreads();
    float* mods = (float*)(C.ws + WS_MODS); float* bf = (float*)(C.ws + WS_BIASF);
    for (int o = C.tid; o < 33 * 64; o += 512) { const int r = o >> 6, c = o & 63; float v = KIND == 0 ? PIN(5)[l * DIN + n0 + c] : 0.f;
#pragma unroll
        for (int w8 = 0; w8 < 8; ++w8) v += red[(w8 * 33 + r) * 64 + c];
        if (KIND == 0) mods[(size_t)(l * 33 + r) * DIN + n0 + c] = v;
        else bf[(size_t)r * (2 * DFFP) + 2 * (n0 + (c & ~3)) + (c & 3) + 4 * l] = v; }
    __syncthreads();
}
DI void phase_mods(const Ctx& C) { if (C.bx < 2 * 96) phase_rowgemm<0>(C, C.bx); }
DI void phase_prologue_deferred(const Ctx& C) {
    unsigned char* ws = C.ws;
    int itb = 0;
    for (int l = 0; l < 2; ++l) {
        if (l == 1) transpose_win(C, PIN(8) + (size_t)l * D * DIN, (bf16_t*)(ws + WS_WIN) + (size_t)l * 4096 * D, ws + WS_WIN8 + (size_t)l * 4096 * D, itb, FP8_SECS1);
        transpose_matrix(C, PIN(17) + (size_t)l * 512 * D, 512, D, (bf16_t*)(ws + WS_WUA) + (size_t)l * D * D, D, 0, itb, 0);
        transpose_matrix(C, PIN(18) + (size_t)l * 512 * D, 512, D, (bf16_t*)(ws + WS_WUA) + (size_t)l * D * D + 512, D, 0, itb, 0);
        transpose_matrix(C, PIN(19) + (size_t)l * D * D, D, D, (bf16_t*)(ws + WS_WO) + (size_t)l * D * D, D, 0, itb, 0);
    }
    transpose_matrix(C, PIN(20), D, DFF, (bf16_t*)(ws + WS_W13), D, 2, itb, 0);
    transpose_matrix(C, PIN(21), D, DFF, (bf16_t*)(ws + WS_W13), D, 3, itb, 0);
    transpose_matrix(C, PIN(22), DFF, D, (bf16_t*)(ws + WS_W2), DFFP, 0, itb, 0);
}
DI void phase_prologue(const Ctx& C) {
    unsigned char* ws = C.ws;
    int itb = 0;
    transpose_win(C, PIN(8), (bf16_t*)(ws + WS_WIN), ws + WS_WIN8, itb, FP8_SECS0);
    { const int gt = C.vcu * 512 + C.tid, NT = C.G * 512;
      bf16_t* w13 = (bf16_t*)(ws + WS_W13) + (size_t)(2 * DFF) * D;
      for (int i = gt; i < (2 * DFFP - 2 * DFF) * D / 8; i += NT) ((u32x4*)w13)[i] = (u32x4){0u, 0u, 0u, 0u};
      bf16_t* w2 = (bf16_t*)(ws + WS_W2);
      for (int i = gt; i < D * (DFFP - DFF) / 8; i += NT) { const int r = i / ((DFFP - DFF) / 8), cc = i % ((DFFP - DFF) / 8); *(u32x4*)(w2 + (size_t)r * DFFP + DFF + cc * 8) = (u32x4){0u, 0u, 0u, 0u}; }
      float2* rope = (float2*)(ws + WS_ROPE);
      for (int i = gt; i < T * 32; i += NT) { const int t = i >> 5, pi = i & 31; const float invf = exp2f(-(float)(pi & 15) * (13.287712379549449f / 16.f));
          const float ang = (float)(pi < 16 ? (t >> 6) : (t & 63)) * invf; rope[i] = make_float2(cosf(ang), sinf(ang)); }
      float* lbs = (float*)(ws + WS_LBS);
      for (int i = gt; i < 2 * 2 * 512; i += NT) { const int l = i >> 10, dir = (i >> 9) & 1, d = i & 511; const float* lb = PIN(dir ? 16 : 15);
          const float p0 = lb[d], p1 = lb[512 + d]; lbs[i] = l == 0 ? 0.f : 1.f / (1.f + expf(p0 - p1)); }
    }
    phase_mods(C);
}
constexpr float W13_SCALE = 64.f, W2_SCALE = 128.f, HID_SCALE = 8.f;
DI void convert_moe_weights(const Ctx& C, const int gw, const int NGW) {
    unsigned char* ws = C.ws; LAS float* scr = (LAS float*)(C.lds + C.wave * TP_SCR);
    const int lane = C.lane, r = lane >> 4, c4 = (lane & 15) * 4;
    constexpr int NIT = NE * 3 * 896;
    static_assert((D / 64) * (DFE / 64) == 896, "items per expert matrix");
    f32x4 v[16];
#define MOE_ITEM(it, W, ldw, k0, n0) const int m_ = (it) / 896, q_ = (it) % 896, e_ = m_ / 3, wh_ = m_ % 3; \
        const float* W = PIN(wh_ == 0 ? 24 : wh_ == 1 ? 25 : 26) + (size_t)e_ * D * DFE; const int ldw = wh_ == 2 ? D : DFE, nb_ = wh_ == 2 ? D / 64 : DFE / 64, k0 = 64 * (q_ / nb_), n0 = 64 * (q_ % nb_)
#define MOE_LOADS(it) do { MOE_ITEM(it, W_, ldw_, k0_, n0_); _Pragma("unroll") for (int i = 0; i < 16; ++i) v[i] = *(const f32x4*)(W_ + (size_t)(k0_ + 4 * i + r) * ldw_ + n0_ + c4); } while (0)
    int it = gw;
    if (it < NIT) MOE_LOADS(it);
    for (; it < NIT; it += NGW) {
#pragma unroll
        for (int i = 0; i < 16; ++i) *(LAS f32x4*)(scr + (4 * i + r) * TP_PITCH + c4) = v[i];
        LDS_WAIT(); asm volatile("" ::: "memory");
        if (it + NGW < NIT) MOE_LOADS(it + NGW);
        MOE_ITEM(it, W, ldw, k0, n0); (void)W; (void)ldw;
        const int kind = wh_ == 0 ? 2 : wh_ == 1 ? 3 : 0; const float sc = wh_ == 2 ? W2_SCALE : W13_SCALE;
        unsigned char* dst = (wh_ == 2 ? ws + WS_WM2 + (size_t)e_ * D * DFE : ws + WS_WM13 + (size_t)e_ * 2 * DFE * D) + (size_t)map_row(kind, n0 + lane, 0) * (wh_ == 2 ? DFE : D) + k0;
#pragma unroll
        for (int j = 0; j < 4; ++j) { const LAS float* sp = scr + (16 * j) * TP_PITCH + lane; u32x4 o;
            o.x = pack_fp8x4(sp[0] * sc, sp[TP_PITCH] * sc, sp[2 * TP_PITCH] * sc, sp[3 * TP_PITCH] * sc); o.y = pack_fp8x4(sp[4 * TP_PITCH] * sc, sp[5 * TP_PITCH] * sc, sp[6 * TP_PITCH] * sc, sp[7 * TP_PITCH] * sc);
            o.z = pack_fp8x4(sp[8 * TP_PITCH] * sc, sp[9 * TP_PITCH] * sc, sp[10 * TP_PITCH] * sc, sp[11 * TP_PITCH] * sc); o.w = pack_fp8x4(sp[12 * TP_PITCH] * sc, sp[13 * TP_PITCH] * sc, sp[14 * TP_PITCH] * sc, sp[15 * TP_PITCH] * sc);
            *(u32x4*)(dst + 16 * j) = o; }
        LDS_WAIT(); asm volatile("" ::: "memory");
    }
#undef MOE_ITEM
#undef MOE_LOADS
}

template <bool ROUTER>
DI void phase_norm(const Ctx& C, const float* xl, const float* xc, const float* nw, const float* mods, int shsel, int nrows, bf16_t* Hout, const float* rw, unsigned char* route, LAS int* cntL, unsigned char* H8 = nullptr) {
    int nloc = 0;
    LAS f32x4* RT = (LAS f32x4*)(C.lds + 32768);
    if (ROUTER) {
        for (int k = C.tid; k < 2048; k += 512) { const int e = k >> 6, ln = k & 63, jq = e >> 1, half = e & 1; RT[k] = *(const f32x4*)(rw + (size_t)(256 * (jq >> 2) + 4 * ln + (jq & 3)) * 8 + half * 4); }
        __syncthreads(); }
    f32x4 vq[2][4];
#define NORM_XLOADS(dst, r0_) do { _Pragma("unroll") for (int u = 0; u < 2; ++u) { int row_ = (r0_) + u * C.NGW; row_ = row_ < nrows ? row_ : (r0_); \
            const float* xr_ = row_ < NLAT ? xl + (size_t)row_ * D : xc + (size_t)(row_ - NLAT) * D; \
            _Pragma("unroll") for (int j = 0; j < 4; ++j) dst[u][j] = *(const f32x4*)(xr_ + 256 * j + 4 * C.lane); } } while (0)
    if (C.gw < nrows) NORM_XLOADS(vq, C.gw);
    for (int row0 = C.gw; row0 < nrows; row0 += 2 * C.NGW) {
        const int rows[2] = {row0, row0 + C.NGW}; const bool two = rows[1] < nrows;
        f32x4 v[2][4]; float ss[2] = {0.f, 0.f};
#pragma unroll
        for (int u = 0; u < 2; ++u)
#pragma unroll
            for (int j = 0; j < 4; ++j) v[u][j] = vq[u][j];
#pragma unroll
        for (int u = 0; u < 2; ++u)
#pragma unroll
            for (int j = 0; j < 4; ++j) ss[u] += (v[u][j][0] * v[u][j][0] + v[u][j][1] * v[u][j][1]) + (v[u][j][2] * v[u][j][2] + v[u][j][3] * v[u][j][3]);
        f32x4 gwv[2][4], shv[2][4];
#define NORM_MODS(u_) do { const int row_ = ((u_) == 1 && !two) ? rows[0] : rows[u_]; const float* mv_ = mods + (size_t)(row_ < NLAT ? (row_ >> 11) : 32) * DIN + shsel * D; \
            _Pragma("unroll") for (int j = 0; j < 4; ++j) { const int c0 = 256 * j + 4 * C.lane; \
                gwv[u_][j] = *(const f32x4*)(nw + c0) * (*(const f32x4*)(mv_ + D + c0) + 1.0f); shv[u_][j] = *(const f32x4*)(mv_ + c0); } } while (0)
        NORM_MODS(0); NORM_MODS(1); if (row0 + 2 * C.NGW < nrows) NORM_XLOADS(vq, row0 + 2 * C.NGW);
#pragma unroll
        for (int u = 0; u < 2; ++u) { if (u == 1 && !two) break;
            const int row = rows[u];
            const float rstd = 1.0f / sqrtf(wave_sum(ss[u]) * (1.f / D) + EPS);
            float lg[8];
            if (ROUTER) {
#pragma unroll
                for (int e = 0; e < 8; ++e) lg[e] = 0.f; }
#pragma unroll
            for (int j = 0; j < 4; ++j) { const int c0 = 256 * j + 4 * C.lane;
                f32x4 h = (v[u][j] * rstd) * gwv[u][j] + shv[u][j];
                if (ROUTER) *(unsigned*)((unsigned char*)Hout + (size_t)row * D + c0) = pack_fp8x4(h[0], h[1], h[2], h[3]);
                else { u32x2 o; o.x = cvt_pk_bf16(h[0], h[1]); o.y = cvt_pk_bf16(h[2], h[3]); *(u32x2*)(Hout + (size_t)row * D + c0) = o;
                       if (H8) *(unsigned*)(H8 + (size_t)row * D + c0) = pack_fp8x4(h[0], h[1], h[2], h[3]); }
                if (ROUTER) {
#pragma unroll
                    for (int q = 0; q < 4; ++q) { const f32x4 r0 = RT[((j * 4 + q) * 2) * 64 + C.lane], r1 = RT[((j * 4 + q) * 2 + 1) * 64 + C.lane];
                        lg[0] += h[q] * r0[0]; lg[1] += h[q] * r0[1]; lg[2] += h[q] * r0[2]; lg[3] += h[q] * r0[3]; lg[4] += h[q] * r1[0]; lg[5] += h[q] * r1[1]; lg[6] += h[q] * r1[2]; lg[7] += h[q] * r1[3]; } }
            }
            if (ROUTER) {
                const bool b5 = (C.lane & 32) != 0, b4 = (C.lane & 16) != 0, b3 = (C.lane & 8) != 0; float a4[4], a2[2], a1;
#pragma unroll
                for (int j = 0; j < 4; ++j) { const float snd = b5 ? lg[j] : lg[4 + j]; a4[j] = (b5 ? lg[4 + j] : lg[j]) + __shfl_xor(snd, 32); }
#pragma unroll
                for (int j = 0; j < 2; ++j) { const float snd = b4 ? a4[j] : a4[2 + j]; a2[j] = (b4 ? a4[2 + j] : a4[j]) + __shfl_xor(snd, 16); }
                { const float snd = b3 ? a2[0] : a2[1]; a1 = (b3 ? a2[1] : a2[0]) + __shfl_xor(snd, 8); }
                a1 += __shfl_xor(a1, 4); a1 += __shfl_xor(a1, 2); a1 += __shfl_xor(a1, 1);
                if ((C.lane & 7) == 0) ((LAS float*)(C.lds + C.wave * 4096))[nloc * 8 + (C.lane >> 3)] = a1;
                ++nloc;
            }
        }
    }
#undef NORM_MODS
#undef NORM_XLOADS
    if (ROUTER) {
        LDS_WAIT();
        for (int i = C.lane; i < nloc; i += 64) { const int row = C.gw + i * C.NGW; const LAS float* lp = (const LAS float*)(C.lds + C.wave * 4096) + i * 8;
            float lg[8];
#pragma unroll
            for (int e = 0; e < 8; ++e) lg[e] = lp[e];
            int e1 = 0; float l1 = lg[0];
#pragma unroll
            for (int e = 1; e < 8; ++e) if (lg[e] > l1) { l1 = lg[e]; e1 = e; }
            int e2 = -1; float l2 = -INFINITY;
#pragma unroll
            for (int e = 0; e < 8; ++e) if (e != e1 && lg[e] > l2) { l2 = lg[e]; e2 = e; }
            const float g2 = 1.f / (1.f + expf(l1 - l2)), g1 = 1.f - g2;
            int* rt = (int*)(route + (size_t)row * 24); rt[0] = e1; rt[1] = e2; ((float*)rt)[2] = g1; ((float*)rt)[3] = g2;
            atomicAdd((int*)&cntL[e1], 1); atomicAdd((int*)&cntL[e2], 1);
        }
    }
}

constexpr int AT_XCH = 65536, AT_ANW = 131072;
DI float max3f(float a, float b, float c) { return fmaxf(fmaxf(a, b), c); }
constexpr float AT_THR = 8.f;
DI void attn_unit(const Ctx& C, bf16_t* P, int qrow0, int krow_ctx, int krow_lat, int nkt, int h, float lam, const float* anw, float post) {
    const int tid_ = my_tid();
    LAS unsigned char* lds = C.lds; const int lane = tid_ & 63, wid = __builtin_amdgcn_readfirstlane(tid_ >> 6), sub = wid >> 2, qw = wid & 3, r32 = lane & 31, hh = lane >> 5;
    const int tq = (lane & 15) >> 2, tp = lane & 3, blk = (lane >> 4) & 1;
    LAS unsigned char* qlds = lds + AT_XCH + wid * 8192 + r32 * 16;
#pragma unroll
    for (int qb = 0; qb < 2; ++qb) { const bf16_t* qp = P + (size_t)(qrow0 + 64 * qw + 32 * qb + r32) * PW + PC_Q + h * 128 + sub * 64 + 8 * hh;
#pragma unroll
      for (int ks = 0; ks < 4; ++ks) *(LAS bf16x8*)(qlds + ((2 * ks + hh) * 64 + 32 * qb) * 16) = *(const bf16x8*)(qp + 16 * ks); }
    if (tid_ < 32) *(LAS f32x4*)(lds + AT_ANW + tid_ * 16) = *(const f32x4*)(anw + 4 * tid_);
    f32x16 O[2][4];
#pragma unroll
    for (int qb = 0; qb < 2; ++qb)
#pragma unroll
        for (int c = 0; c < 4; ++c)
#pragma unroll
            for (int i = 0; i < 16; ++i) O[qb][c][i] = 0.f;
    float m_run[2] = {-INFINITY, -INFINITY}, l_run[2] = {0.f, 0.f};
#define AT_ISSUE(kt, buf) do { const int kr0_ = (kt) < 4 ? krow_ctx + (kt) * 64 : krow_lat + ((kt) - 4) * 64; LAS unsigned char* bb_ = lds + (buf) * 32768; \
        _Pragma("unroll") for (int j_ = 0; j_ < 2; ++j_) { const int c_ = 2 * wid + j_; \
            dma16a(P + (size_t)(kr0_ + lane) * PW + PC_K + h * 128 + c_ * 8, bb_ + c_ * 1024); \
            dma16a(P + (size_t)(kr0_ + 16 * (c_ & 3) + (lane >> 2)) * PW + PC_V + h * 128 + (c_ >> 2) * 32 + (lane & 3) * 8, bb_ + 16384 + c_ * 1024); } } while (0)
    AT_ISSUE(0, 0);
    int buf = 0;
#pragma unroll 1
    for (int kt = 0; kt < nkt; ++kt) {
        VM_WAIT(); __syncthreads();
        if (kt + 1 < nkt) AT_ISSUE(kt + 1, buf ^ 1);
        const LAS unsigned char* kb = lds + buf * 32768, * vb = kb + 16384 + (4 * hh + tq) * 64 + blk * 32 + tp * 8;
        bf16x8 Pf[2][4];
#pragma unroll
        for (int qb = 0; qb < 2; ++qb) {
            f32x16 s0, s1;
#pragma unroll
            for (int i = 0; i < 16; ++i) { s0[i] = 0.f; s1[i] = 0.f; }
#pragma unroll
            for (int ks = 0; ks < 4; ++ks) { const LAS unsigned char* kp = kb + ((sub * 8 + 2 * ks + hh) * 64 + r32) * 16;
                const bf16x8 k0 = *(const LAS bf16x8*)kp, k1 = *(const LAS bf16x8*)(kp + 512);
                const bf16x8 q = *(const LAS bf16x8*)(qlds + ((2 * ks + hh) * 64 + 32 * qb) * 16);
                s0 = MFMA32(k0, q, s0); s1 = MFMA32(k1, q, s1); }
            float mx = max3f(s0[0], s1[0], s0[1]);
#pragma unroll
            for (int i = 1; i < 16; ++i) mx = (i + 1 < 16) ? max3f(mx, s1[i], s0[i + 1]) : fmaxf(mx, s1[i]);
            mx = fmaxf(mx, xhalf(mx, hh));
            const float mnew = fmaxf(m_run[qb], mx);
            if (__any(mx > m_run[qb] + AT_THR)) { const float alpha = __builtin_amdgcn_exp2f(m_run[qb] - mnew); l_run[qb] *= alpha;
#pragma unroll
                for (int c = 0; c < 4; ++c)
#pragma unroll
                    for (int i = 0; i < 16; ++i) O[qb][c][i] *= alpha;
                m_run[qb] = mnew; }
            const float mr = m_run[qb]; float ps0 = 0.f, ps1 = 0.f;
#pragma unroll
            for (int i = 0; i < 16; ++i) { s0[i] = __builtin_amdgcn_exp2f(s0[i] - mr); s1[i] = __builtin_amdgcn_exp2f(s1[i] - mr); ps0 += s0[i]; ps1 += s1[i]; }
            l_run[qb] += ps0 + ps1;
            Pf[qb][0] = packf8(s0, 0); Pf[qb][1] = packf8(s0, 1); Pf[qb][2] = packf8(s1, 0); Pf[qb][3] = packf8(s1, 1);
        }
#pragma unroll
        for (int cb = 0; cb < 4; ++cb) {
#pragma unroll
            for (int s4 = 0; s4 < 4; ++s4) { const bf16x8 a = cat8(tr16(vb + cb * 4096 + s4 * 1024), tr16(vb + cb * 4096 + s4 * 1024 + 512));
                O[0][cb] = MFMA32(a, Pf[0][s4], O[0][cb]); O[1][cb] = MFMA32(a, Pf[1][s4], O[1][cb]); } }
        buf ^= 1;
    }
#undef AT_ISSUE
    LDS_WAIT(); __syncthreads();
    const int te = my_tid(); const int lane_e = te & 63, wid_e = __builtin_amdgcn_readfirstlane(te >> 6);
    LAS float* xch = (LAS float*)(lds + AT_XCH) + (wid_e & 3) * 4096 + lane_e;
#pragma unroll
    for (int qb = 0; qb < 2; ++qb) {
        const float lt = l_run[qb] + xhalf(l_run[qb], lane_e >> 5); const float inv = 1.f / lt;
        if ((wid_e >> 2) == 1) { const float sc = -lam * inv;
#pragma unroll
            for (int c = 0; c < 4; ++c)
#pragma unroll
                for (int i = 0; i < 16; ++i) xch[(c * 16 + i) * 64] = O[qb][c][i] * sc; }
        LDS_WAIT(); __syncthreads();
        if ((wid_e >> 2) == 0) {
            float ss = 0.f;
#pragma unroll
            for (int c = 0; c < 4; ++c)
#pragma unroll
                for (int i = 0; i < 16; ++i) { const float o = O[qb][c][i] * inv + xch[(c * 16 + i) * 64]; O[qb][c][i] = o; ss += o * o; }
            ss += xhalf(ss, lane_e >> 5);
            const float rs = post / sqrtf(ss * (1.f / 128.f) + EPS);
            bf16_t* op = P + (size_t)(qrow0 + 64 * (wid_e & 3) + 32 * qb + (lane_e & 31)) * PW + PC_Q + h * 128;
#pragma unroll
            for (int c = 0; c < 4; ++c)
#pragma unroll
                for (int g = 0; g < 4; ++g) { const int v0 = 32 * c + 8 * g + 4 * (lane_e >> 5); const f32x4 w = *(const LAS f32x4*)(lds + AT_ANW + v0 * 4);
                    u32x2 o; o.x = cvt_pk_bf16(O[qb][c][4 * g] * rs * w[0], O[qb][c][4 * g + 1] * rs * w[1]); o.y = cvt_pk_bf16(O[qb][c][4 * g + 2] * rs * w[2], O[qb][c][4 * g + 3] * rs * w[3]);
                    *(u32x2*)(op + v0) = o; }
        }
        LDS_WAIT(); __syncthreads();
    }
}

constexpr int SC_Q = 0, SC_LF = 16384, SC_V0 = 32768, SC_QM = 65536, SC_KMR = 81920, SC_KMS = 98304, SC_SX = 114688, SC_A31 = 147456, SC_A63 = 147968, SC_END = 148480;
DI void scan_chain(const Ctx& C, bf16_t* P, int b, int h, int dir, bool store_ctx) {
    const int tid_ = my_tid();
    LAS unsigned char* lds = C.lds; const int lane = tid_ & 63, wid = __builtin_amdgcn_readfirstlane(tid_ >> 6), r32 = lane & 31, hh = lane >> 5;
    const int tq = (lane & 15) >> 2, tp = lane & 3, blk = (lane >> 4) & 1;
    const int db = wid & 3, tb = wid >> 2;
    const int base_nat = hh * 512 + tq * 64 + blk * 32 + tp * 8;
    const int base_prm = (4 * hh + tq) * 64 + blk * 32 + tp * 8;
    const int lfcol = (dir ? PC_LB : PC_LF) + h * 128, qcol = PC_RQ + h * 128, vcol = PC_RI + h * 128;
    f32x16 ST[2];
#pragma unroll
    for (int j = 0; j < 2; ++j)
#pragma unroll
        for (int i = 0; i < 16; ++i) ST[j][i] = 0.f;
#define SROW(c, i) ((c) < 4 ? NLAT + b * CL + (dir ? 255 - ((c) * 64 + (i)) : (c) * 64 + (i)) : b * T + (dir ? 2047 - (((c) - 4) * 64 + (i)) : ((c) - 4) * 64 + (i)))
#define SDMA(c, colbase, dstoff) do { _Pragma("unroll") for (int j_ = 0; j_ < 2; ++j_) { const int I_ = 2 * wid + j_; const int ti_ = 16 * (I_ & 3) + (lane >> 2); \
        dma16(P + (size_t)SROW(c, ti_) * PW + (colbase) + (I_ >> 2) * 32 + (lane & 3) * 8, lds + (dstoff) + I_ * 1024); } } while (0)
    SDMA(0, qcol, SC_Q); SDMA(0, lfcol, SC_LF); SDMA(0, vcol, SC_V0);
    int vbuf = 0;
    const int t = 32 * tb + r32;
#pragma unroll 1
    for (int c = 0; c < 36; ++c) {
        { const int st_ = __builtin_amdgcn_readfirstlane((c > 0 && (c > 4 || store_ctx)) ? 1 : 0);
          asm volatile("s_cmp_lg_u32 %0, 0\n\ts_cbranch_scc1 1f\n\ts_waitcnt vmcnt(0)\n1:\n\ts_waitcnt vmcnt(4)" :: "s"(st_) : "memory", "scc"); }
        LDS_BARRIER();
        const LAS unsigned char* Vimg = lds + SC_V0 + vbuf * 16384;
        f32x16 cm;
#pragma unroll
        for (int i = 0; i < 16; ++i) cm[i] = 0.f;
#pragma unroll
        for (int kk = 0; kk < 2; ++kk) { const int ks = 2 * tb + kk;
            const half8 a = __builtin_bit_cast(half8, cat8(tr16(lds + SC_LF + db * 4096 + base_nat + ks * 1024), tr16(lds + SC_LF + db * 4096 + base_nat + ks * 1024 + 256)));
            half8 bm;
#pragma unroll
            for (int j = 0; j < 8; ++j) { const int s = 16 * ks + 8 * hh + j; bm[j] = tb == 0 ? (s > t ? (_Float16)-1.f : (_Float16)0.f) : (s <= t ? (_Float16)1.f : (_Float16)0.f); }
            cm = __builtin_amdgcn_mfma_f32_32x32x16_f16(a, bm, cm, 0, 0, 0); }
#pragma unroll
        for (int g = 0; g < 4; ++g) {
            const int sa = db * 4096 + (t >> 3) * 512 + (t & 7) * 64 + (8 * g + 4 * hh) * 2;
            const u32x2 q4 = *(const LAS u32x2*)(lds + SC_Q + sa); const half4 lf4 = *(const LAS half4*)(lds + SC_LF + sa);
            const float qv[4] = {bflo(q4.x), bfhi(q4.x), bflo(q4.y), bfhi(q4.y)};
            float qm[4], km[4];
#pragma unroll
            for (int e = 0; e < 4; ++e) { const float cv = cm[4 * g + e] * LOG2E; const float E = __builtin_amdgcn_exp2f(cv), Ei = __builtin_amdgcn_exp2f(-cv);
                const float lf = (float)lf4[e]; qm[e] = qv[e] * E; km[e] = (1.f - __builtin_amdgcn_exp2f(lf * LOG2E)) * Ei;
                if (tb == 0 && r32 == 0) ((LAS float*)(lds + SC_A31))[32 * db + 8 * g + 4 * hh + e] = lf - cm[4 * g + e];
                if (tb == 1 && r32 == 31) ((LAS float*)(lds + SC_A63))[32 * db + 8 * g + 4 * hh + e] = cm[4 * g + e]; }
            u32x2 qw2, kw2; qw2.x = cvt_pk_bf16(qm[0], qm[1]); qw2.y = cvt_pk_bf16(qm[2], qm[3]); kw2.x = cvt_pk_bf16(km[0], km[1]); kw2.y = cvt_pk_bf16(km[2], km[3]);
            const int ra = ((4 * db + g) * 64 + t) * 16 + 8 * hh;
            *(LAS u32x2*)(lds + SC_QM + ra) = qw2; *(LAS u32x2*)(lds + SC_KMR + ra) = kw2; *(LAS u32x2*)(lds + SC_KMS + sa) = kw2;
        }
        LDS_BARRIER();
        if (c + 1 < 36) { SDMA(c + 1, qcol, SC_Q); SDMA(c + 1, lfcol, SC_LF); SDMA(c + 1, vcol, SC_V0 + (vbuf ^ 1) * 16384); }
        { const int d = 32 * db + r32; const float c31 = ((LAS float*)(lds + SC_A31))[d], c63 = ((LAS float*)(lds + SC_A63))[d];
          const float e31 = __expf(c31), dec = __expf(c31 + c63), e63 = __expf(c63);
          f32x16 SN[2];
#pragma unroll
          for (int j = 0; j < 2; ++j) { const int vb2 = 2 * tb + j;
#pragma unroll
              for (int g = 0; g < 4; ++g) { float t0 = ST[j][4 * g] * e31, t1 = ST[j][4 * g + 1] * e31, t2 = ST[j][4 * g + 2] * e31, t3 = ST[j][4 * g + 3] * e31; asm volatile("" : "+v"(t0), "+v"(t1), "+v"(t2), "+v"(t3));
                  u32x2 w; w.x = cvt_pk_bf16(t0, t1); w.y = cvt_pk_bf16(t2, t3);
                  *(LAS u32x2*)(lds + SC_SX + vb2 * 8192 + (d >> 3) * 512 + (d & 7) * 64 + (8 * g + 4 * hh) * 2) = w; }
#pragma unroll
              for (int i = 0; i < 16; ++i) SN[j][i] = 0.f; }
#pragma unroll
          for (int ks = 0; ks < 4; ++ks) {
              const bf16x8 kf = cat8(tr16(lds + SC_KMS + db * 4096 + base_nat + ks * 1024), tr16(lds + SC_KMS + db * 4096 + base_nat + ks * 1024 + 256));
#pragma unroll
              for (int j = 0; j < 2; ++j) { const int vb2 = 2 * tb + j;
                  const bf16x8 vf = cat8(tr16(Vimg + vb2 * 4096 + base_nat + ks * 1024), tr16(Vimg + vb2 * 4096 + base_nat + ks * 1024 + 256));
                  SN[j] = MFMA32(vf, kf, SN[j]); } }
#pragma unroll
          for (int j = 0; j < 2; ++j)
#pragma unroll
              for (int i = 0; i < 16; ++i) { float p = e63 * SN[j][i]; asm volatile("" : "+v"(p)); float r = fmaf(dec, ST[j][i], p); asm volatile("" : "+v"(r)); ST[j][i] = r; }
        }
        LDS_BARRIER();
        { bf16x8 Qmf[8];
#pragma unroll
          for (int kd = 0; kd < 8; ++kd) Qmf[kd] = *(const LAS bf16x8*)(lds + SC_QM + ((2 * kd + hh) * 64 + t) * 16);
          f32x16 o;
#pragma unroll
          for (int i = 0; i < 16; ++i) o[i] = 0.f;
          for (int sb = 0; sb <= tb; ++sb) {
              f32x16 pt;
#pragma unroll
              for (int i = 0; i < 16; ++i) pt[i] = 0.f;
#pragma unroll
              for (int kd = 0; kd < 8; ++kd) { const bf16x8 a = *(const LAS bf16x8*)(lds + SC_KMR + ((2 * kd + hh) * 64 + 32 * sb + r32) * 16); pt = MFMA32(a, Qmf[kd], pt); }
              if (sb == tb) {
#pragma unroll
                  for (int i = 0; i < 16; ++i) if (crow(i, hh) > r32) pt[i] = 0.f; }
              const bf16x8 p0 = packf8(pt, 0), p1 = packf8(pt, 1);
              { const bf16x8 a = cat8(tr16(Vimg + db * 4096 + base_prm + (2 * sb) * 1024), tr16(Vimg + db * 4096 + base_prm + (2 * sb) * 1024 + 512)); o = MFMA32(a, p0, o); }
              { const bf16x8 a = cat8(tr16(Vimg + db * 4096 + base_prm + (2 * sb + 1) * 1024), tr16(Vimg + db * 4096 + base_prm + (2 * sb + 1) * 1024 + 512)); o = MFMA32(a, p1, o); }
          }
#pragma unroll
          for (int kd = 0; kd < 8; ++kd) { const bf16x8 a = cat8(tr16(lds + SC_SX + db * 8192 + base_nat + kd * 1024), tr16(lds + SC_SX + db * 8192 + base_nat + kd * 1024 + 256)); o = MFMA32(a, Qmf[kd], o); }
          if (c >= 4 || store_ctx) { bf16_t* op = P + (size_t)SROW(c, t) * PW + lfcol + 32 * db;
#pragma unroll
              for (int g = 0; g < 4; ++g) { u32x2 w; w.x = cvt_pk_bf16(o[4 * g], o[4 * g + 1]); w.y = cvt_pk_bf16(o[4 * g + 2], o[4 * g + 3]); *(u32x2*)(op + 8 * g + 4 * hh) = w; } }
        }
        vbuf ^= 1;
    }
    VM_WAIT(); LDS_WAIT(); __syncthreads();
#undef SROW
#undef SDMA
}

DI void phase_recprep(const Ctx& C, bf16_t* P, const float* rnw, int nrows) {
    const f32x4 w0 = *(const f32x4*)(rnw + ((8 * C.lane) & 127)), w1 = *(const f32x4*)(rnw + ((8 * C.lane) & 127) + 4);
    u32x4 qa[4], qb[4], qg[4];
#define RP_LOADS(r0_) do { _Pragma("unroll") for (int u = 0; u < 4; ++u) { const int row_ = (r0_) + u * C.NGW < nrows ? (r0_) + u * C.NGW : (r0_); const bf16_t* pr_ = P + (size_t)row_ * PW + 8 * C.lane; \
            qa[u] = *(const u32x4*)(pr_ + PC_LF); qb[u] = *(const u32x4*)(pr_ + PC_LB); qg[u] = *(const u32x4*)(pr_ + PC_G); } } while (0)
    if (C.gw < nrows) RP_LOADS(C.gw);
    for (int row0 = C.gw; row0 < nrows; row0 += 4 * C.NGW) {
        u32x4 ra[4], rb[4], rg[4];
#pragma unroll
        for (int u = 0; u < 4; ++u) { ra[u] = qa[u]; rb[u] = qb[u]; rg[u] = qg[u]; }
        if (row0 + 4 * C.NGW < nrows) RP_LOADS(row0 + 4 * C.NGW);
#pragma unroll
        for (int u = 0; u < 4; ++u) { const int row = row0 + u * C.NGW; if (row >= nrows) break;
            float a[8], bb[8], g[8]; unpack8(ra[u], a); unpack8(rb[u], bb); unpack8(rg[u], g);
            float ss = 0.f;
#pragma unroll
            for (int j = 0; j < 8; ++j) { a[j] += bb[j]; ss += a[j] * a[j]; }
            ss += __shfl_xor(ss, 1); ss += __shfl_xor(ss, 2); ss += __shfl_xor(ss, 4); ss += __shfl_xor(ss, 8);
            const float rs = 1.0f / sqrtf(ss * (1.f / 128.f) + EPS);
            f32x4 o0, o1;
#pragma unroll
            for (int j = 0; j < 4; ++j) { o0[j] = a[j] * rs * w0[j] * g[j]; o1[j] = a[4 + j] * rs * w1[j] * g[4 + j]; }
            *(u32x4*)(P + (size_t)row * PW + 8 * C.lane + PC_LF) = pack8(o0, o1); }
    }
#undef RP_LOADS
}

DI void phase_slots(const Ctx& C, const int* cnt, int* pbout, unsigned char* route, const bf16_t* H2, bf16_t* AG, LAS int* cur) {
    if (C.tid < 16) cur[C.tid] = 0;
    __syncthreads();
    for (int g = C.tid; g < C.G; g += 512) {
#pragma unroll
        for (int k = 0; k < 8; ++k) { const int c = cnt[g * 8 + k]; atomicAdd((int*)&cur[8 + k], c); if (g < C.bx) atomicAdd((int*)&cur[k], c); } }
    __syncthreads();
    if (C.tid < 8) { const int e = C.tid; int pb = 0, pbe = 0;
#pragma unroll
        for (int k = 0; k < 8; ++k) { if (k == e) pbe = pb; pb += (cur[8 + k] + 255) >> 8; }
        const int mine = cur[e];
        if (C.bx == 0) { pbout[e] = pbe; if (e == 7) pbout[8] = pb; }
        cur[e] = pbe * 256 + mine;
    }
    __syncthreads();
    const int nloc = (NLAT - C.gw + C.NGW - 1) / C.NGW;
    LAS int* tab = (LAS int*)(C.lds + C.wave * 2048);
    for (int i = C.lane; i < nloc; i += 64) { int* rt = (int*)(route + (size_t)(C.gw + i * C.NGW) * 24);
        const int s1 = atomicAdd((int*)&cur[rt[0]], 1), s2 = atomicAdd((int*)&cur[rt[1]], 1); rt[4] = s1; rt[5] = s2; tab[2 * i] = s1; tab[2 * i + 1] = s2; }
    LDS_WAIT();
    for (int i0 = 0; i0 < nloc; i0 += 8) {
        u32x4 vr[8];
#pragma unroll
        for (int k = 0; k < 8; ++k) { const int i = i0 + k < nloc ? i0 + k : i0; vr[k] = *((const u32x4*)((const unsigned char*)H2 + (size_t)(C.gw + i * C.NGW) * D) + C.lane); }
#pragma unroll
        for (int k = 0; k < 8; ++k) { if (i0 + k >= nloc) break;
            const int s1 = __builtin_amdgcn_readfirstlane(tab[2 * (i0 + k)]), s2 = __builtin_amdgcn_readfirstlane(tab[2 * (i0 + k) + 1]);
            *((u32x4*)((unsigned char*)AG + (size_t)s1 * D) + C.lane) = vr[k]; *((u32x4*)((unsigned char*)AG + (size_t)s2 * D) + C.lane) = vr[k]; }
    }
}
DI void phase_final(const Ctx& C, float* x, const unsigned char* route, const bf16_t* Y, const float* mods1, const float* fw) {
    for (int row0 = C.gw; row0 < NLAT; row0 += 2 * C.NGW) {
        const int rows[2] = {row0, row0 + C.NGW < NLAT ? row0 + C.NGW : row0};
        f32x4 v[2][4]; float ss[2] = {0.f, 0.f};
#pragma unroll
        for (int u = 0; u < 2; ++u) { const int row = rows[u];
            const int* rt = (const int*)(route + (size_t)row * 24); const float g1 = ((const float*)rt)[2], g2 = ((const float*)rt)[3]; const int s1 = rt[4], s2 = rt[5];
            const float* mv = mods1 + (size_t)(row >> 11) * DIN + 5 * D; const float* xr = x + (size_t)row * D;
#pragma unroll
            for (int j = 0; j < 4; ++j) { const int c0 = 256 * j + 4 * C.lane;
                const u32x2 y1 = *(const u32x2*)(Y + (size_t)s1 * D + c0), y2 = *(const u32x2*)(Y + (size_t)s2 * D + c0); const f32x4 m5 = *(const f32x4*)(mv + c0);
                f32x4 y; y[0] = g1 * bflo(y1.x) + g2 * bflo(y2.x); y[1] = g1 * bfhi(y1.x) + g2 * bfhi(y2.x); y[2] = g1 * bflo(y1.y) + g2 * bflo(y2.y); y[3] = g1 * bfhi(y1.y) + g2 * bfhi(y2.y);
                v[u][j] = *(const f32x4*)(xr + c0) + m5 * y; ss[u] += (v[u][j][0] * v[u][j][0] + v[u][j][1] * v[u][j][1]) + (v[u][j][2] * v[u][j][2] + v[u][j][3] * v[u][j][3]); } }
#pragma unroll
        for (int u = 0; u < 2; ++u) { if (u == 1 && rows[1] == rows[0]) break;
            const float rstd = 1.0f / sqrtf(wave_sum(ss[u]) * (1.f / D) + EPS); float* xr = x + (size_t)rows[u] * D;
#pragma unroll
            for (int j = 0; j < 4; ++j) { const int c0 = 256 * j + 4 * C.lane; *(f32x4*)(xr + c0) = v[u][j] * rstd * *(const f32x4*)(fw + c0); } }
    }
}

constexpr int LDS_MISC = SC_END;
constexpr int LDS_BYTES = SC_END + 512;
static_assert(LDS_WTAB_OFF == SC_END + 128, "wave table sits behind the barrier words and counters");
constexpr int NPHASE = 20;

DI Ctx make_ctx() {
    extern __shared__ __attribute__((aligned(16))) unsigned char lds_raw[];
    Ctx C; const int t = my_tid();
    unsigned lb = (unsigned)(size_t)(LAS unsigned char*)lds_raw; asm volatile("" : "+s"(lb));
    C.lds = (LAS unsigned char*)(size_t)lb; C.ws = kparams()->ws; C.tid = t; C.lane = t & 63; C.wave = __builtin_amdgcn_readfirstlane(t >> 6);
    int bx = blockIdx.x, G = gridDim.x; asm volatile("" : "+s"(bx), "+s"(G));
    C.bx = bx; C.G = G; C.vcu = (C.G % 8 == 0) ? (bx % 8) * (C.G / 8) + bx / 8 : bx;
    C.gw = C.vcu * 8 + C.wave; C.NGW = C.G * 8;
    return C;
}
DI void grid_barrier() {
    extern __shared__ __attribute__((aligned(16))) unsigned char lds_raw[];
    XcdBarrier b; b.bar = (unsigned*)(kparams()->ws + WS_CTL) + CW_BAR + kparams()->li * XCD_BAR_WORDS; b.x = xb_xcc_id(); b.st = (volatile LAS unsigned*)((LAS unsigned char*)lds_raw + LDS_MISC);
    xcd_barrier(b);
}
#define WSP(T, off) ((T*)(kparams()->ws + (off)))

#define IN(k) (kparams()->ph_lo <= (k) && (k) < kparams()->ph_hi)
#define SEAM(k) do { if (IN(k) && IN((k) + 1)) grid_barrier(); } while (0)


template <int l> DI void layer_phases() {
        constexpr int FS = l == 0 ? FP8_SECS0 : FP8_SECS1, N_SEC_F8 = n_sec_f8(FS), N_SEC_BF = 8 - N_SEC_F8;
        const int pb = 1 + 9 * l;
#define LQ() int lq = l; asm volatile("" : "+s"(lq))
#define XL (lq == 0 ? PIN(0) : (const float*)POUT)
#define XC (lq == 0 ? PIN(2) : (const float*)WSP(float, WS_CTXRES))
#define LMODS (WSP(float, WS_MODS) + (size_t)lq * 33 * DIN)
#define NROWS_OUT (lq == 0 ? NTOK : NLAT)
        if (IN(pb + 0)) { LQ(); const Ctx C = make_ctx(); phase_norm<false>(C, XL, XC, PIN(6) + lq * D, LMODS, 0, NTOK, WSP(bf16_t, WS_H), nullptr, nullptr, nullptr, WSP(unsigned char, WS_H8)); }
        SEAM(pb + 0);
        if (IN(pb + 1)) { LQ();
            { const Ctx C = make_ctx();
              Gemm g{WSP(bf16_t, WS_H), WSP(bf16_t, WS_WIN) + (size_t)lq * 4096 * D, NTOK, N_SEC_BF * 512, D, D};
              pg8::StaticOrder S; S.init(g, C.G, C.bx);
              EpiInProj E{WSP(bf16_t, WS_P), WSP(float2, WS_ROPE), WSP(float, WS_LBS) + lq * 1024, WSP(float, WS_LBS) + lq * 1024 + 512, (int)secmap_of(FS, false), 1.f};
              pg8::gemm_phase<EpiInProj, pg8::StaticOrder>(C.lds, g, S, E); }
            if (N_SEC_F8 > 0) { const Ctx C = make_ctx();
              Gemm g{WSP(bf16_t, WS_H8), (const bf16_t*)(WSP(unsigned char, WS_WIN8) + (size_t)lq * 4096 * D), NTOK, N_SEC_F8 * 512, D / 2, D / 2};
              pg8::StaticOrder S; S.init(g, C.G, C.bx);
              EpiInProj E{WSP(bf16_t, WS_P), WSP(float2, WS_ROPE), WSP(float, WS_LBS) + lq * 1024, WSP(float, WS_LBS) + lq * 1024 + 512, (int)secmap_of(FS, true), 1.f / WIN8_SCALE};
              pg8::gemm_phase<EpiInProj, pg8::StaticOrder, true, true>(C.lds, g, S, E); }
        }
        SEAM(pb + 1);
        if (IN(pb + 2)) { LQ(); const Ctx C = make_ctx(); bf16_t* const Pb = WSP(bf16_t, WS_P);
            for (int id = C.vcu; id < NB * 4 * 2; id += C.G) scan_chain(C, Pb, id >> 3, (id >> 1) & 3, id & 1, lq == 0);
            float lam;
            { const float a = wave_sum(PIN(9)[lq * 64 + C.lane] * PIN(10)[lq * 64 + C.lane]), b2 = wave_sum(PIN(11)[lq * 64 + C.lane] * PIN(12)[lq * 64 + C.lane]);
              const float li = 0.8f - 0.6f * expf(-0.3f * (float)lq); lam = expf(a) - expf(b2) + li; lam = __uint_as_float(__builtin_amdgcn_readfirstlane(__float_as_uint(lam))); }
            const float post = __uint_as_float(__builtin_amdgcn_readfirstlane(__float_as_uint(1.f - (0.8f - 0.6f * expf(-0.3f * (float)lq)))));
            const float* anw = PIN(13) + lq * 128;
            const int NU = NB * 4 * 8, U = (NU + C.G - 1) / C.G;
            for (int id = C.vcu * U; id < NU && id < (C.vcu + 1) * U; ++id) { const int bh = id >> 3, qb = id & 7, b = bh >> 2, h = bh & 3;
                attn_unit(C, Pb, b * T + qb * 256, NLAT + b * CL, b * T, 36, h, lam, anw, post); }
            if (lq == 0) for (int id = C.vcu; id < NB * 4; id += C.G) { const int b = id >> 2, h = id & 3;
                attn_unit(C, Pb, NLAT + b * CL, NLAT + b * CL, 0, 4, h, lam, anw, post); }
        }
        if (l == 0) { if (IN(pb + 2)) { Ctx C = make_ctx();
            if (C.G <= NB * 4) phase_prologue_deferred(C);
            else if (C.vcu >= NB * 4) { C.gw = (C.vcu - NB * 4) * 8 + C.wave; C.NGW = (C.G - NB * 4) * 8; phase_prologue_deferred(C); } } }
        if (l == 0) { if (IN(pb + 2)) { const Ctx C = make_ctx();
            const int nfree = C.G > NB * 4 ? C.G - NB * 4 : C.G, first = C.G > NB * 4 ? NB * 4 : 0;
            if (C.vcu >= first) for (int t = C.vcu - first; t < 86; t += nfree) phase_rowgemm<1>(C, t);
            if (C.vcu == C.G - 1) { float* bf = WSP(float, WS_BIASF); for (int i = C.tid; i < 33 * (2 * DFFP - 2 * DFF); i += 512) bf[(size_t)(i / (2 * DFFP - 2 * DFF)) * (2 * DFFP) + 2 * DFF + i % (2 * DFFP - 2 * DFF)] = 0.f; } } }
        SEAM(pb + 2);
        if (IN(pb + 3)) { LQ(); const Ctx C = make_ctx();
            phase_recprep(C, WSP(bf16_t, WS_P), PIN(14) + lq * 128, NROWS_OUT);
            Gemm g{WSP(bf16_t, WS_H8), (const bf16_t*)(WSP(unsigned char, WS_WIN8) + ((size_t)lq * 4096 + N_SEC_F8 * 512) * D), NROWS_OUT, 2048, D / 2, D / 2};
            pg8::StaticOrder S; S.init(g, C.G, C.bx);
            EpiGates E{WSP(bf16_t, WS_P), 1.f / WIN8_SCALE};
            pg8::gemm_phase<EpiGates, pg8::StaticOrder, true, true>(C.lds, g, S, E);
        }
        SEAM(pb + 3);
        if (IN(pb + 4)) { LQ(); const Ctx C = make_ctx();
            Gemm g{WSP(bf16_t, WS_P) + PC_Q, WSP(bf16_t, WS_WUA) + (size_t)lq * D * D, NROWS_OUT, D, D, PW};
            pg8::StaticOrder S; S.init(g, C.G, C.bx); EpiMergeFused E{WSP(bf16_t, WS_P), WSP(bf16_t, WS_MERGED)};
            pg8::gemm_phase<EpiMergeFused, pg8::StaticOrder, true, false, true>(C.lds, g, S, E);
        }
        SEAM(pb + 4);
        if (IN(pb + 5)) { LQ(); const Ctx C = make_ctx();
            Gemm g{WSP(bf16_t, WS_MERGED), WSP(bf16_t, WS_WO) + (size_t)lq * D * D, NROWS_OUT, D, D, D};
            pg8::StaticOrder S; S.init(g, C.G, C.bx);
            if constexpr (l == 0) { EpiResidN E{XL, XC, POUT, WSP(float, WS_CTXRES), LMODS, 2, PIN(7), 4, WSP(bf16_t, WS_AN), WSP(unsigned, WS_RS0)};
                pg8::gemm_phase<EpiResidN, pg8::StaticOrder>(C.lds, g, S, E); }
            else { EpiResid E{XL, XC, POUT, WSP(float, WS_CTXRES), LMODS, 2};
                pg8::gemm_phase<EpiResid, pg8::StaticOrder>(C.lds, g, S, E); }
        }
        SEAM(pb + 5);
        if (l == 0) {
            if (IN(8)) { LQ(); const Ctx C = make_ctx();
                Gemm g{WSP(bf16_t, WS_AN), WSP(bf16_t, WS_W13), NTOK, 2 * DFFP, D, D};
                pg8::StaticOrder S; S.init(g, C.G, C.bx); EpiSwiglu E{WSP(bf16_t, WS_HID), DFFP, 0, WSP(unsigned, WS_RS0), WSP(float, WS_BIASF)};
                pg8::gemm_phase<EpiSwiglu, pg8::StaticOrder>(C.lds, g, S, E);
            }
            SEAM(8);
            if (IN(9)) { LQ(); const Ctx C = make_ctx();
                Gemm g{WSP(bf16_t, WS_HID), WSP(bf16_t, WS_W2), NTOK, D, DFFP, DFFP};
                pg8::StaticOrder S; S.init(g, C.G, C.bx); EpiResid E{POUT, WSP(float, WS_CTXRES), POUT, WSP(float, WS_CTXRES), LMODS, 5};
                pg8::gemm_phase<EpiResid, pg8::StaticOrder>(C.lds, g, S, E);
                { const int rem = S.nwg % C.G, first_idle = rem; if (C.bx >= first_idle) convert_moe_weights(C, (C.bx - first_idle) * 8 + C.wave, (C.G - first_idle) * 8); }
            }
            SEAM(9);
        } else {
            if (IN(16)) { LQ(); const Ctx C = make_ctx(); LAS int* lcnt = (LAS int*)(C.lds + LDS_MISC + 32);
                if (C.tid < 8) lcnt[C.tid] = 0;
                __syncthreads();
                phase_norm<true>(C, POUT, nullptr, PIN(7) + D, LMODS, 3, NLAT, WSP(bf16_t, WS_H2M), PIN(23), WSP(unsigned char, WS_ROUTE), lcnt);
                __syncthreads();
                if (C.tid < 8) WSP(int, WS_CNT)[C.bx * 8 + C.tid] = lcnt[C.tid];
            }
            SEAM(16);
            if (IN(17)) { LQ(); const Ctx C = make_ctx(); phase_slots(C, WSP(int, WS_CNT), WSP(int, WS_CNT) + 4096, WSP(unsigned char, WS_ROUTE), WSP(bf16_t, WS_H2M), WSP(bf16_t, WS_AG), (LAS int*)(C.lds + LDS_MISC + 32)); }
            SEAM(17);
            if (IN(18)) { LQ();
                const int ptot = __builtin_amdgcn_readfirstlane(WSP(int, WS_CNT)[4096 + 8]);
                for (int p0 = 0, np_ = 0; p0 < ptot; p0 += np_) {
                    const int np = (ptot - p0) <= MOE_CHUNK + 16 ? (ptot - p0) : MOE_CHUNK; np_ = np;
#define MOE_ORDER_INIT(S) do { S.so.init(g, C.G, C.bx); S.p0 = p0; S.load_pb(WSP(int, WS_CNT) + 4096); } while (0)
                    { const Ctx C = make_ctx(); Gemm g{WSP(bf16_t, WS_AG), WSP(bf16_t, WS_WM13), np * 256, 2 * DFE, D / 2, D / 2};
                      pg8::MoeOrder S; MOE_ORDER_INIT(S); S.apan0 = 0; S.estride = (size_t)2 * DFE * D;
                      EpiSwiglu8 E{WSP(unsigned char, WS_MHID), DFE, p0, 1.f / W13_SCALE, HID_SCALE};
                      pg8::gemm_phase<EpiSwiglu8, pg8::MoeOrder, true, true>(C.lds, g, S, E); }
                    grid_barrier();
                    { const Ctx C = make_ctx(); Gemm g{WSP(bf16_t, WS_MHID), WSP(bf16_t, WS_WM2), np * 256, D, DFE / 2, DFE / 2};
                      pg8::MoeOrder S; MOE_ORDER_INIT(S); S.apan0 = p0; S.estride = (size_t)D * DFE;
                      EpiBf16 E{WSP(bf16_t, WS_Y), D, 1.f / (W2_SCALE * HID_SCALE)};
                      pg8::gemm_phase<EpiBf16, pg8::MoeOrder, true, true>(C.lds, g, S, E); }
                    grid_barrier();
                }
            }
            if (IN(19)) { LQ(); const Ctx C = make_ctx(); phase_final(C, POUT, WSP(unsigned char, WS_ROUTE), WSP(bf16_t, WS_Y), LMODS, PIN(27)); }
        }
}

__global__ void __launch_bounds__(512, 2) fwd_kernel(Params p) {
    extern __shared__ __attribute__((aligned(16))) unsigned char lds_raw[];
    (void)p;
    { volatile LAS unsigned* misc = (volatile LAS unsigned*)((LAS unsigned char*)lds_raw + LDS_MISC);
      if (threadIdx.x < 16) misc[threadIdx.x] = 0u;
      if ((threadIdx.x & 63) == 0) ((volatile LAS int*)((LAS unsigned char*)lds_raw + LDS_WTAB_OFF))[(unsigned)__builtin_amdgcn_s_getreg((5 << 11) | 4) & 63u] = threadIdx.x >> 6;
      __syncthreads();
      (void)xcd_barrier_post((unsigned*)(kparams()->ws + WS_CTL) + CW_BAR + kparams()->li * XCD_BAR_WORDS, misc); }
    if (IN(0)) { const Ctx C = make_ctx(); phase_prologue(C); } SEAM(0);

    layer_phases<0>();
    layer_phases<1>();
#undef IN
#undef SEAM
}


extern "C" void kernel_launch(void* const* d_in, const int* in_sizes, int n_in, void* d_out, int out_size, void* d_ws, size_t ws_size, hipStream_t stream) {
    static int grid = 0;
    if (grid == 0) {
        if (n_in != 28 || out_size != NLAT * D || ws_size < WS_END) { fprintf(stderr, "kernel_launch: unexpected problem (n_in %d, out %d, ws %zu)\n", n_in, out_size, ws_size); grid = -1; return; }
        int dev = 0, cus = 0, per_cu = 0;
        if (hipGetDevice(&dev) != hipSuccess || hipDeviceGetAttribute(&cus, hipDeviceAttributeMultiprocessorCount, dev) != hipSuccess) { grid = -1; return; }
        if (hipFuncSetAttribute((const void*)fwd_kernel, hipFuncAttributeMaxDynamicSharedMemorySize, LDS_BYTES) != hipSuccess) { fprintf(stderr, "kernel_launch: cannot set %d B dynamic LDS\n", LDS_BYTES); grid = -1; return; }
        if (hipOccupancyMaxActiveBlocksPerMultiprocessor(&per_cu, (const void*)fwd_kernel, 512, LDS_BYTES) != hipSuccess || per_cu < 1) fprintf(stderr, "kernel_launch: occupancy query says %d\n", per_cu);
        (void)hipGetLastError();
        grid = cus;
    }
    if (grid < 0) return;
    (void)hipMemsetAsync((char*)d_ws + WS_CTL, 0, CTL_BYTES, stream);
    Params a{};
    for (int i = 0; i < 28; ++i) a.in[i] = (const float*)d_in[i];
    a.out = (float*)d_out; a.ws = (unsigned char*)d_ws; a.ph_lo = 0; a.ph_hi = NPHASE; a.li = 0; a.pad = 0;
    hipLaunchKernelGGL(fwd_kernel, dim3(grid), dim3(512), LDS_BYTES, stream, a);
}
```

```cpp
#include <hip/hip_runtime.h>
#include <cstdio>
#include <cstdint>


constexpr int D = 1024, NB = 32, T = 2048, CL = 256;
constexpr int NLAT = NB * T, NCTX = NB * CL, NTOK = NLAT + NCTX;
constexpr int PW = 4096;
constexpr int DIN = 6144, DFF = 2752, DFFP = 2816, DFE = 3584, NE = 8;
constexpr float EPS = 1e-6f;
constexpr float LOG2E = 1.4426950408889634f;
constexpr float QSCALE = 0.125f * LOG2E;
constexpr int PC_Q = 0, PC_LF = 512, PC_G = 1024, PC_LB = 1536, PC_K = 2048, PC_V = 2560, PC_RQ = 3072, PC_RI = 3584, PC_GA = 2048, PC_GR = 3072;

constexpr size_t MiB = 1u << 20;
constexpr size_t WS_CTL = 0, CTL_BYTES = 1 * MiB;
constexpr size_t WS_MODS = 1 * MiB;
constexpr size_t WS_LBS = 3 * MiB;
constexpr size_t WS_ROPE = 3 * MiB + 65536;
constexpr size_t WS_ROUTE = 4 * MiB;
constexpr size_t WS_CNT = 6 * MiB;
constexpr size_t WS_RS0 = 131072;
constexpr size_t WS_RS1 = 524288;
constexpr size_t WS_BIASI = 6 * MiB + 131072;
constexpr size_t WS_BIASF = 7 * MiB;
constexpr size_t WS_AN = 640 * MiB;
constexpr float RS_SCALE = 1024.f;
constexpr size_t WS_CTXRES = 8 * MiB;
constexpr size_t WS_WIN = 40 * MiB;
constexpr size_t WS_WIN8 = 56 * MiB;
constexpr size_t WS_H8 = 809 * MiB;
constexpr size_t WS_WUA = 64 * MiB;
constexpr size_t WS_WUR = 66 * MiB;
constexpr size_t WS_WO = 68 * MiB;
constexpr size_t WS_W13 = 72 * MiB;
constexpr size_t WS_W2 = 83 * MiB;
constexpr size_t WS_H = 89 * MiB;
constexpr size_t WS_P = 233 * MiB;
constexpr size_t WS_MERGED = 89 * MiB;
constexpr size_t WS_HID = 233 * MiB;
constexpr size_t WS_WM13 = 896 * MiB;
constexpr size_t WS_WM2 = 952 * MiB;
constexpr size_t WS_AG = 89 * MiB;
constexpr size_t WS_MHID = 219 * MiB;
constexpr size_t WS_Y = 458 * MiB;
constexpr size_t WS_H2M = 720 * MiB;
constexpr size_t WS_END = 1024 * MiB;
constexpr int MOE_CHUNK = 256;

constexpr int CW_BAR = 4096;

#define LAS __attribute__((address_space(3)))
#define GAS __attribute__((address_space(1)))
typedef unsigned short bf16_t;
typedef short bf16x8 __attribute__((ext_vector_type(8)));
typedef short s16x4 __attribute__((ext_vector_type(4)));
typedef _Float16 half8 __attribute__((ext_vector_type(8)));
typedef _Float16 half4 __attribute__((ext_vector_type(4)));
typedef float f32x4 __attribute__((ext_vector_type(4)));
typedef float f32x2 __attribute__((ext_vector_type(2)));
typedef float f32x16 __attribute__((ext_vector_type(16)));
typedef unsigned u32x4 __attribute__((ext_vector_type(4)));
typedef unsigned u32x2 __attribute__((ext_vector_type(2)));
#define DI __device__ __forceinline__
#define LDS_WAIT() asm volatile("s_waitcnt lgkmcnt(0)" ::: "memory")
#define VM_WAIT() asm volatile("s_waitcnt vmcnt(0)" ::: "memory")
#define LDS_BARRIER() do { asm volatile("s_waitcnt lgkmcnt(0)" ::: "memory"); __builtin_amdgcn_s_barrier(); asm volatile("" ::: "memory"); } while (0)

typedef __bf16 bf16x2_t __attribute__((ext_vector_type(2)));
DI unsigned cvt_pk_bf16(float lo, float hi) { f32x2 v = {lo, hi}; bf16x2_t b = __builtin_convertvector(v, bf16x2_t); return __builtin_bit_cast(unsigned, b); }
typedef int v8i32 __attribute__((ext_vector_type(8)));
typedef int v4i32 __attribute__((ext_vector_type(4)));
DI unsigned pack_fp8x4(float a, float b, float c, float d) {
    a = fminf(fmaxf(a, -448.f), 448.f); b = fminf(fmaxf(b, -448.f), 448.f); c = fminf(fmaxf(c, -448.f), 448.f); d = fminf(fmaxf(d, -448.f), 448.f);
    int w = 0; w = __builtin_amdgcn_cvt_pk_fp8_f32(a, b, w, false); w = __builtin_amdgcn_cvt_pk_fp8_f32(c, d, w, true); return (unsigned)w; }
DI float bf2f(unsigned short b) { return __uint_as_float(((unsigned)b) << 16); }
DI float bflo(unsigned w) { return __uint_as_float(w << 16); }
DI float bfhi(unsigned w) { return __uint_as_float(w & 0xffff0000u); }
DI float fsilu(float x) { return x * __builtin_amdgcn_rcpf(1.f + __expf(-x)); }
DI float fsigmoid(float x) { return __builtin_amdgcn_rcpf(1.f + __expf(-x)); }
DI float xhalf(float v, int hi) {
    const auto rr = __builtin_amdgcn_permlane32_swap(__float_as_uint(v), __float_as_uint(v), false, false);
    return __uint_as_float(hi ? rr[0] : rr[1]);
}
DI float xrow(float v, int odd) {
    const auto rr = __builtin_amdgcn_permlane16_swap(__float_as_uint(v), __float_as_uint(v), false, false);
    return __uint_as_float(odd ? rr[0] : rr[1]);
}
DI float wave_sum(float v) {
#pragma unroll
    for (int o = 1; o < 64; o <<= 1) v += __shfl_xor(v, o);
    return v;
}
DI int crow(int r, int hi) { return (r & 3) + 8 * (r >> 2) + 4 * hi; }

constexpr int LDS_WTAB_OFF = 148480 + 128;
DI int my_tid() {
    extern __shared__ __attribute__((aligned(16))) unsigned char lds_raw[];
    const unsigned hw = (unsigned)__builtin_amdgcn_s_getreg((5 << 11) | 4) & 63u;
    const int w = __builtin_amdgcn_readfirstlane(((volatile LAS int*)((LAS unsigned char*)lds_raw + LDS_WTAB_OFF))[hw]);
    int t = w * 64 + (int)__builtin_amdgcn_mbcnt_hi(~0u, __builtin_amdgcn_mbcnt_lo(~0u, 0u));
    asm volatile("" : "+v"(t)); return t;
}
#define XB_TMO      128
#define XB_XCNT(j)  (256  + 64 * (j))
#define XB_XSUB(j)  (1280 + 64 * (j))
#define XB_XGEN(j)  (2304 + 64 * (j))
#define XB_TOP      3328
#define XB_TOPGEN   3392
#define XCD_BAR_WORDS 3456
#define XB_SPIN_CAP (1u << 22)
DI unsigned xb_ld(unsigned* p)              { return __hip_atomic_load(p, __ATOMIC_RELAXED, __HIP_MEMORY_SCOPE_AGENT); }
DI unsigned xb_add(unsigned* p, unsigned v) { return __hip_atomic_fetch_add(p, v, __ATOMIC_RELAXED, __HIP_MEMORY_SCOPE_AGENT); }
DI unsigned xb_xcc_id() { return (unsigned)__builtin_amdgcn_s_getreg((3 << 11) | 20) & 0xFu; }
#define XB_SPIN(cond, bar) do { unsigned _sp = 0; while (cond) { __builtin_amdgcn_s_sleep(1); \
    if ((++_sp & 255u) == 0u) { if (xb_ld(&(bar)[XB_TMO])) break; if (_sp > XB_SPIN_CAP) { atomicAdd(&(bar)[XB_TMO], 1u); break; } } } } while (0)
struct XcdBarrier { unsigned* bar; unsigned x; volatile LAS unsigned* st; };
DI XcdBarrier xcd_barrier_post(unsigned* bar, volatile LAS unsigned* st) {
    XcdBarrier b; b.bar = bar; b.x = xb_xcc_id(); b.st = st;
    if (my_tid() == 0) (void)xb_add(&bar[XB_XCNT(b.x)], 1u);
    return b;
}
DI void xcd_barrier_complete(unsigned* bar, unsigned x, unsigned& nloc, unsigned& nx) {
    const unsigned G = gridDim.x * gridDim.y * gridDim.z;
    unsigned sum, cnt, mine, sp = 0u;
    for (;;) {
        sum = 0u; cnt = 0u; mine = 0u;
#pragma unroll
        for (unsigned j = 0; j < 16; ++j) { const unsigned c = xb_ld(&bar[XB_XCNT(j)]); sum += c; cnt += (c > 0u) ? 1u : 0u; mine = (j == x) ? c : mine; }
        if (sum == G) break;
        __builtin_amdgcn_s_sleep(1);
        if ((++sp & 255u) == 0u) { if (xb_ld(&bar[XB_TMO])) break; if (sp > XB_SPIN_CAP) { atomicAdd(&bar[XB_TMO], 1u); break; } }
    }
    nloc = mine > 0u ? mine : 1u; nx = cnt > 0u ? cnt : 1u;
}
DI void xcd_barrier(const XcdBarrier& b) {
    asm volatile("s_waitcnt vmcnt(0)" ::: "memory");
    __syncthreads();
    if (my_tid() == 0) {
        unsigned* bar = b.bar;
        __builtin_amdgcn_s_waitcnt(0);
        unsigned nloc = b.st[0], nx = b.st[1];
        if (nloc == 0u) { xcd_barrier_complete(bar, b.x, nloc, nx); b.st[0] = nloc; b.st[1] = nx; }
        const unsigned old = xb_add(&bar[XB_XSUB(b.x)], 1u);
        const unsigned gen = old / nloc;
        if (old + 1u == (gen + 1u) * nloc) {
            __builtin_amdgcn_fence(__ATOMIC_RELEASE, "agent");
            asm volatile("s_waitcnt vmcnt(0)" ::: "memory");
            const unsigned og = xb_add(&bar[XB_TOP], 1u);
            const unsigned tg = og / nx;
            if (og + 1u == (tg + 1u) * nx) xb_add(&bar[XB_TOPGEN], 1u);
            else XB_SPIN(xb_ld(&bar[XB_TOPGEN]) == tg, bar);
            __builtin_amdgcn_fence(__ATOMIC_ACQUIRE, "agent");
            xb_add(&bar[XB_XGEN(b.x)], 1u);
            asm volatile("s_waitcnt vmcnt(0)" ::: "memory");
        } else {
            XB_SPIN(xb_ld(&bar[XB_XGEN(b.x)]) == gen, bar);
            __builtin_amdgcn_fence(__ATOMIC_ACQUIRE, "agent");
            asm volatile("s_waitcnt vmcnt(0)" ::: "memory");
        }
    }
    __syncthreads();
}

namespace pg8 {
constexpr int BM = 256, BK = 64, HALF = 128, HTB = HALF * BK * 2, STAGE_BYTES = 8 * HTB, NXCD = 8, WGM = 8;
__host__ __device__ __forceinline__ int lds_byte(int r, int c) { const int st = (r >> 4) * 2 + (c >> 5), rr = r & 15, cc = c & 31, ob = rr * 64 + cc * 2; return st * 1024 + (ob ^ (((ob >> 9) & 1) << 5)); }
__host__ __device__ __forceinline__ void stage_rc(int b, int& R, int& C) { const int st = b / 1024, sb = b % 1024, swz = sb ^ (((sb >> 9) & 1) << 5); R = (st >> 1) * 16 + swz / 64; C = (st & 1) * 32 + (swz % 64) / 2; }
__host__ __device__ __forceinline__ int perm32(int rho) { const int n = rho >> 4, i = rho & 15; return 8 * (i >> 2) + 4 * n + (i & 3); }

struct Unit { int pm, pn; const char* a; const char* b; };
struct Gemm { const bf16_t* A; const bf16_t* Bt; int M, N, K, lda; };

struct StaticOrder {
    int nM, nN, nwg, G, c;
    DI void init(const Gemm& g, int G_, int c_) { nM = g.M / BM; nN = g.N / BM; nwg = nM * nN; G = G_; c = c_; }
    DI bool tile(int i, int& pm, int& pn) const {
        const int L = i * G + c; if (L >= nwg) return false;
        int wgid = L; { const int q = nwg / NXCD, r = nwg % NXCD, xcd = wgid % NXCD, off = wgid / NXCD; wgid = (xcd < r ? xcd * (q + 1) : r * (q + 1) + (xcd - r) * q) + off; }
        const int nig = WGM * nN, gid = wgid / nig, fm = gid * WGM, gsz = (nM - fm) < WGM ? (nM - fm) : WGM;
        pm = fm + ((wgid % nig) % gsz); pn = (wgid % nig) / gsz; return true;
    }
    DI bool next(const Gemm& g, int i, Unit& u) const { if (!tile(i, u.pm, u.pn)) return false;
        u.a = (const char*)g.A + (size_t)u.pm * ((size_t)BM * g.lda * 2); u.b = (const char*)g.Bt + (size_t)u.pn * ((size_t)BM * g.K * 2); return true; }
};
struct MoeOrder {
    StaticOrder so; int p0, apan0; int pb[7]; size_t estride;
    DI void load_pb(const int* pbv) {
#pragma unroll
        for (int k = 0; k < 7; ++k) pb[k] = __builtin_amdgcn_readfirstlane(pbv[k + 1]); }
    DI bool next(const Gemm& g, int i, Unit& u) const {
        int pm, pn; if (!so.tile(i, pm, pn)) return false;
        u.pm = p0 + pm; u.pn = pn; int e = 0;
#pragma unroll
        for (int k = 0; k < 7; ++k) e += (u.pm >= pb[k]) ? 1 : 0;
        u.a = (const char*)g.A + (size_t)(u.pm - apan0) * ((size_t)BM * g.lda * 2); u.b = (const char*)g.Bt + (size_t)e * estride + (size_t)pn * ((size_t)BM * g.K * 2); return true;
    }
};

template <class Epi, class Sched, bool ALIGN_EPI = true, bool F8 = false, bool MIDHOOK = false>
DI void gemm_phase(LAS unsigned char* lds, const Gemm g, const Sched& S, const Epi& E) {
    const int tid_ = my_tid();
    const int tid = tid_, wid = __builtin_amdgcn_readfirstlane(tid >> 6), lane = tid & 63, wr = wid >> 2, wc = wid & 3, fr = lane & 15, fq = lane >> 4;
    const int K = g.K, nt = K / BK;
    unsigned voffA[2], voffB[2];
#pragma unroll
    for (int i = 0; i < 2; ++i) { int R, C; stage_rc(tid * 16 + i * 8192, R, C); const int Rb = Epi::PERM ? ((R & ~31) + perm32(R & 31)) : R;
        voffA[i] = (unsigned)(R * g.lda + C) * 2u; voffB[i] = (unsigned)(Rb * K + C) * 2u; }
    const size_t kstep = (size_t)(BK * 2);
    const size_t hstepA = (size_t)HALF * g.lda * 2, hstepB = (size_t)HALF * K * 2;
    const unsigned ldsw = (unsigned)wid * 1024u;
    const int aoff = lds_byte(wr * 64 + fr, fq * 8), boff = lds_byte(wc * 32 + fr, fq * 8);
#define PG8_SA(b, h) (((b) * 2 + (h)) * HTB)
#define PG8_SB(b, h) ((4 + (b) * 2 + (h)) * HTB)
#define PG8_STAGE(bufoff, gbase, voff) do { _Pragma("unroll") for (int _i = 0; _i < 2; ++_i) \
        __builtin_amdgcn_global_load_lds((const unsigned*)((const char*)(gbase) + (voff)[_i]), (LAS unsigned*)(lds + (bufoff) + ldsw + _i * 8192), 16, 0, 0); } while (0)
#define PG8_LD8(p) __builtin_shufflevector(*(const LAS v4i32*)(p), *(const LAS v4i32*)((p) + 1024), 0, 1, 2, 3, 4, 5, 6, 7)
#define PG8_LDA(dst, b, h) do { if constexpr (F8) { _Pragma("unroll") for (int m = 0; m < 4; ++m) dst##8[m] = PG8_LD8(lds + PG8_SA(b, h) + aoff + m * 2048); } \
        else { _Pragma("unroll") for (int m = 0; m < 4; ++m) _Pragma("unroll") for (int k = 0; k < 2; ++k) dst[m][k] = *(const LAS bf16x8*)(lds + PG8_SA(b, h) + aoff + m * 2048 + k * 1024); } } while (0)
#define PG8_LDB(dst, b, h) do { if constexpr (F8) { _Pragma("unroll") for (int n = 0; n < 2; ++n) dst##8[n] = PG8_LD8(lds + PG8_SB(b, h) + boff + n * 2048); } \
        else { _Pragma("unroll") for (int n = 0; n < 2; ++n) _Pragma("unroll") for (int k = 0; k < 2; ++k) dst[n][k] = *(const LAS bf16x8*)(lds + PG8_SB(b, h) + boff + n * 2048 + k * 1024); } } while (0)
#define PG8_MMA(ai, bj, At, Bt) do { __builtin_amdgcn_s_setprio(1); \
        if constexpr (F8) { _Pragma("unroll") for (int m = 0; m < 4; ++m) _Pragma("unroll") for (int n = 0; n < 2; ++n) \
            asm volatile("v_mfma_scale_f32_16x16x128_f8f6f4 %0, %1, %2, %0, %3, %3 op_sel_hi:[0,0,0]" : "+v"(acc[ai][bj][m][n]) : "v"(Bt##8[n]), "v"(At##8[m]), "v"(one8)); } \
        else { _Pragma("unroll") for (int m = 0; m < 4; ++m) _Pragma("unroll") for (int n = 0; n < 2; ++n) _Pragma("unroll") for (int k = 0; k < 2; ++k) \
            acc[ai][bj][m][n] = __builtin_amdgcn_mfma_f32_16x16x32_bf16(Bt[n][k], At[m][k], acc[ai][bj][m][n], 0, 0, 0); } \
        __builtin_amdgcn_s_setprio(0); } while (0)
#define PG8_WAIT_V(n) asm volatile("s_waitcnt vmcnt(" #n ")" ::: "memory")
#define PG8_WAIT_VX(n) asm volatile("s_waitcnt vmcnt(%0)" :: "n"(n) : "memory")
#define PG8_WAIT_L(n) asm volatile("s_waitcnt lgkmcnt(" #n ")" ::: "memory")
#define PG8_BAR __builtin_amdgcn_s_barrier()
#define PG8_SCHED __builtin_amdgcn_sched_barrier(0)
    Unit cur, nxt; int ui = 0;
    if (!S.next(g, 0, cur)) return;
    f32x4 acc[2][2][4][2];
#pragma unroll
    for (int a = 0; a < 2; ++a)
#pragma unroll
        for (int b = 0; b < 2; ++b)
#pragma unroll
            for (int m = 0; m < 4; ++m)
#pragma unroll
                for (int n = 0; n < 2; ++n) acc[a][b][m][n] = (f32x4){0.f, 0.f, 0.f, 0.f};
    bf16x8 At[4][2], B0[2][2], B1[2][2]; v8i32 At8[4], B08[2], B18[2]; const int one8 = 0x7F7F7F7F;
    const char* cA = cur.a; const char* cB = cur.b;
    PG8_STAGE(PG8_SB(0, 0), cB, voffB); PG8_STAGE(PG8_SB(0, 1), cB + hstepB, voffB); PG8_STAGE(PG8_SA(0, 0), cA, voffA); PG8_STAGE(PG8_SA(0, 1), cA + hstepA, voffA);
    if (wr == 1) PG8_BAR;
    PG8_WAIT_V(2); PG8_BAR;
    PG8_STAGE(PG8_SB(1, 0), cB + kstep, voffB); PG8_STAGE(PG8_SA(1, 0), cA + kstep, voffA); PG8_STAGE(PG8_SB(1, 1), cB + hstepB + kstep, voffB);
    PG8_WAIT_V(6); PG8_BAR;
    for (;;) {
        const bool has_next = S.next(g, ui + 1, nxt);
        const char* nA = has_next ? nxt.a : cA; const char* nB = has_next ? nxt.b : cB;
        for (int t = 0; t < nt; t += 2) {
            const bool last = (t == nt - 2);
            if constexpr (MIDHOOK) { PG8_SCHED; if (t == nt / 2) E.mid(acc, cur, wr, wc, fr, fq); PG8_SCHED; }
            const char* a1 = cA + (size_t)(t + 1) * kstep;
            const char* a2 = last ? nA : cA + (size_t)(t + 2) * kstep; const char* b2 = last ? nB : cB + (size_t)(t + 2) * kstep;
            const char* a3 = a2 + kstep; const char* b3 = b2 + kstep;
            const int relax = __builtin_amdgcn_readfirstlane(((t == 0) && (ui > 0)) ? 1 : 0);
#define PG8_WAIT_V8R asm volatile("s_cmp_lg_u32 %0, 0\n\ts_cbranch_scc1 1f\n\ts_waitcnt vmcnt(8)\n1:\n\ts_waitcnt vmcnt(%1)" :: "s"(relax), "n"(8 + Epi::NVM) : "memory", "scc")
            PG8_LDB(B0, 0, 0); PG8_LDB(B1, 0, 1); PG8_SCHED; PG8_LDA(At, 0, 0); PG8_STAGE(PG8_SA(1, 1), a1 + hstepA, voffA);
            PG8_WAIT_V8R; PG8_WAIT_L(0); PG8_BAR; PG8_MMA(0, 0, At, B0); PG8_MMA(0, 1, At, B1); PG8_BAR; PG8_SCHED;
            PG8_LDA(At, 0, 1); PG8_STAGE(PG8_SB(0, 0), b2, voffB); PG8_STAGE(PG8_SB(0, 1), b2 + hstepB, voffB); PG8_STAGE(PG8_SA(0, 0), a2, voffA);
            PG8_WAIT_V8R; PG8_WAIT_L(0); PG8_BAR; PG8_MMA(1, 0, At, B0); PG8_MMA(1, 1, At, B1); PG8_BAR; PG8_SCHED;
            PG8_LDB(B0, 1, 0); PG8_LDB(B1, 1, 1); PG8_SCHED; PG8_LDA(At, 1, 0); PG8_STAGE(PG8_SA(0, 1), a2 + hstepA, voffA);
            PG8_WAIT_V(8); PG8_WAIT_L(0); PG8_BAR; PG8_MMA(0, 0, At, B0); PG8_MMA(0, 1, At, B1); PG8_BAR; PG8_SCHED;
            PG8_LDA(At, 1, 1); PG8_STAGE(PG8_SB(1, 0), b3, voffB); PG8_STAGE(PG8_SB(1, 1), b3 + hstepB, voffB); PG8_STAGE(PG8_SA(1, 0), a3, voffA);
            PG8_WAIT_V(8); PG8_WAIT_L(0); PG8_BAR; PG8_MMA(1, 0, At, B0); PG8_MMA(1, 1, At, B1); PG8_BAR; PG8_SCHED;
#undef PG8_WAIT_V8R
        }
        if constexpr (ALIGN_EPI) { if (wr == 0) PG8_BAR; }
        if constexpr (F8) asm volatile("s_nop 15\n\ts_nop 15" ::: "memory");
        E(acc, cur, wr, wc, fr, fq);
        if (!has_next) break;
#pragma unroll
        for (int a = 0; a < 2; ++a)
#pragma unroll
            for (int b = 0; b < 2; ++b)
#pragma unroll
                for (int m = 0; m < 4; ++m)
#pragma unroll
                    for (int n = 0; n < 2; ++n) acc[a][b][m][n] = (f32x4){0.f, 0.f, 0.f, 0.f};
        cur = nxt; cA = nA; cB = nB; ++ui;
        if constexpr (ALIGN_EPI) { if (wr == 1) PG8_BAR; }
    }
    PG8_WAIT_V(0);
    if constexpr (!ALIGN_EPI) { if (wr == 0) PG8_BAR; }
    PG8_BAR;
#undef PG8_SA
#undef PG8_SB
#undef PG8_STAGE
#undef PG8_LDA
#undef PG8_LD8
#undef PG8_LDB
#undef PG8_MMA
#undef PG8_WAIT_V
#undef PG8_WAIT_VX
#undef PG8_WAIT_L
#undef PG8_BAR
#undef PG8_SCHED
}
}
using pg8::Unit; using pg8::Gemm;
typedef const f32x4 (&AccRef)[2][2][4][2];

DI u32x4 pack8(const f32x4& v0, const f32x4& v1) { u32x4 w; w.x = cvt_pk_bf16(v0[0], v0[1]); w.y = cvt_pk_bf16(v0[2], v0[3]); w.z = cvt_pk_bf16(v1[0], v1[1]); w.w = cvt_pk_bf16(v1[2], v1[3]); return w; }
DI void unpack8(const u32x4& w, float (&f)[8]) { f[0] = bflo(w.x); f[1] = bfhi(w.x); f[2] = bflo(w.y); f[3] = bfhi(w.y); f[4] = bflo(w.z); f[5] = bfhi(w.z); f[6] = bflo(w.w); f[7] = bfhi(w.w); }

template <bool FN> struct EpiInProjT {
    static constexpr int NVM = 16; static constexpr bool PERM = true;
    bf16_t* P; const float2* rope; const float* lbf; const float* lbb; int secmap; float asc; const unsigned* RS; const float* bias;
    template <int MODE> DI void run(AccRef acc, const Unit& u, int wr, int wc, int fr, int fq, int sec) const {
        if (FN) { const int te_ = my_tid(); const int wid_ = __builtin_amdgcn_readfirstlane(te_ >> 6); wr = wid_ >> 2; wc = wid_ & 3; fr = te_ & 15; fq = (te_ >> 4) & 3; }
        const int row0 = u.pm * 256 + wr * 64 + fr, col0 = sec * 512 + (u.pn & 1) * 256 + wc * 32 + 8 * fq;
        const bool lat = u.pm < (NLAT / 256); const float qs = sec == 0 ? QSCALE : 1.f;
        u32x4 bzp[2]; float rsd[2][4];
        if (FN) {
#pragma unroll
            for (int bj = 0; bj < 2; ++bj) { const float* bp = bias + (size_t)(lat ? (u.pm >> 3) : 32) * DIN + u.pn * 256 + bj * 128 + wc * 32 + 8 * fq; bzp[bj] = pack8(*(const f32x4*)bp, *(const f32x4*)(bp + 4)); }
#pragma unroll
            for (int ai = 0; ai < 2; ++ai)
#pragma unroll
                for (int m = 0; m < 4; ++m) rsd[ai][m] = asc / sqrtf((float)RS[row0 + ai * 128 + m * 16] * (1.f / (D * RS_SCALE)) + EPS); }
        f32x4 lb0[2], lb1[2];
        if (MODE == 2) {
#pragma unroll
            for (int bj = 0; bj < 2; ++bj) { const float* lb = (sec == 1 ? lbf : lbb) + ((col0 + bj * 128) & 511); lb0[bj] = *(const f32x4*)lb; lb1[bj] = *(const f32x4*)(lb + 4); } }
        f32x4 rr[2][4][2];
        if (MODE == 3 && !FN) {
#pragma unroll
            for (int ai = 0; ai < 2; ++ai)
#pragma unroll
                for (int m = 0; m < 4; ++m) { const f32x4* rp = (const f32x4*)(rope + (size_t)((row0 + ai * 128 + m * 16) & (T - 1)) * 32 + ((col0 & 63) >> 1));
                    rr[ai][m][0] = lat ? rp[0] : (f32x4){1.f, 0.f, 1.f, 0.f}; rr[ai][m][1] = lat ? rp[1] : (f32x4){1.f, 0.f, 1.f, 0.f}; } }
#pragma unroll
        for (int ai = 0; ai < 2; ++ai) {
            if (MODE == 3 && FN) {
#pragma unroll
                for (int m = 0; m < 4; ++m) { const f32x4* rp = (const f32x4*)(rope + (size_t)((row0 + ai * 128 + m * 16) & (T - 1)) * 32 + ((col0 & 63) >> 1));
                    rr[ai][m][0] = lat ? rp[0] : (f32x4){1.f, 0.f, 1.f, 0.f}; rr[ai][m][1] = lat ? rp[1] : (f32x4){1.f, 0.f, 1.f, 0.f}; }
                asm volatile("" ::: "memory"); }
#pragma unroll
            for (int m = 0; m < 4; ++m) {
                const int row = row0 + ai * 128 + m * 16; bf16_t* rowp = P + (size_t)row * PW + col0;
#pragma unroll
                for (int bj = 0; bj < 2; ++bj) {
                    f32x4 v0, v1; u32x4 w;
                    if (FN) { float bf_[8]; unpack8(bzp[bj], bf_); v0 = acc[ai][bj][m][0] * rsd[ai][m] + (f32x4){bf_[0], bf_[1], bf_[2], bf_[3]}; v1 = acc[ai][bj][m][1] * rsd[ai][m] + (f32x4){bf_[4], bf_[5], bf_[6], bf_[7]}; } else { v0 = acc[ai][bj][m][0] * asc; v1 = acc[ai][bj][m][1] * asc; }
                    if (MODE == 3) {
                        {
                            const f32x4 r0 = rr[ai][m][0], r1 = rr[ai][m][1];
                            f32x4 o0, o1;
                            o0[0] = v0[0] * r0[0] - v0[1] * r0[1]; o0[1] = v0[0] * r0[1] + v0[1] * r0[0];
                            o0[2] = v0[2] * r0[2] - v0[3] * r0[3]; o0[3] = v0[2] * r0[3] + v0[3] * r0[2];
                            o1[0] = v1[0] * r1[0] - v1[1] * r1[1]; o1[1] = v1[0] * r1[1] + v1[1] * r1[0];
                            o1[2] = v1[2] * r1[2] - v1[3] * r1[3]; o1[3] = v1[2] * r1[3] + v1[3] * r1[2];
                            v0 = o0; v1 = o1;
                        }
                        w = pack8(v0 * qs, v1 * qs);
                    } else if (MODE == 1) {
#pragma unroll
                        for (int j = 0; j < 4; ++j) { v0[j] = fsilu(v0[j]); v1[j] = fsilu(v1[j]); }
                        w = pack8(v0, v1);
                    } else if (MODE == 2) {
                        half8 hv;
#pragma unroll
                        for (int j = 0; j < 8; ++j) {
                            const float z = fmaxf(j < 4 ? v0[j] : v1[j - 4], -80.f), b = j < 4 ? lb0[bj][j] : lb1[bj][j - 4];
                            const float sg = __builtin_amdgcn_rcpf(1.f + __builtin_amdgcn_exp2f(-LOG2E * z));
                            hv[j] = (_Float16)(0.6931471805599453f * __builtin_amdgcn_logf(b + (1.f - b) * sg));
                        }
                        w = __builtin_bit_cast(u32x4, hv);
                    } else w = pack8(v0, v1);
                    *(u32x4*)(rowp + bj * 128) = w;
                }
            } }
    }
    DI void operator()(AccRef acc, const Unit& u, int wr, int wc, int fr, int fq) const {
        const int sec = (secmap >> (4 * (u.pn >> 1))) & 15;
        if (sec == 0 || sec == 4) run<3>(acc, u, wr, wc, fr, fq, sec);
        else if (sec == 2 || sec == 6) run<1>(acc, u, wr, wc, fr, fq, sec);
        else if (sec == 1 || sec == 3) run<2>(acc, u, wr, wc, fr, fq, sec);
        else run<0>(acc, u, wr, wc, fr, fq, sec);
    }
};
typedef EpiInProjT<false> EpiInProj;
template <bool FN> struct EpiGatesT {
    static constexpr int NVM = 16; static constexpr bool PERM = true; bf16_t* P; float asc; const unsigned* RS; const float* bias;
    DI void operator()(AccRef acc, const Unit& u, int wr, int wc, int fr, int fq) const {
        if (FN) { const int te_ = my_tid(); const int wid_ = __builtin_amdgcn_readfirstlane(te_ >> 6); wr = wid_ >> 2; wc = wid_ & 3; fr = te_ & 15; fq = (te_ >> 4) & 3; }
        const int row0 = u.pm * 256 + wr * 64 + fr, col0 = PC_GA + u.pn * 256 + wc * 32 + 8 * fq;
        u32x4 bzp[2]; float rsd[2][4];
        if (FN) {
#pragma unroll
            for (int bj = 0; bj < 2; ++bj) { const float* bp = bias + (size_t)(u.pm < NLAT / 256 ? (u.pm >> 3) : 32) * DIN + u.pn * 256 + bj * 128 + wc * 32 + 8 * fq; bzp[bj] = pack8(*(const f32x4*)bp, *(const f32x4*)(bp + 4)); }
#pragma unroll
            for (int ai = 0; ai < 2; ++ai)
#pragma unroll
                for (int m = 0; m < 4; ++m) rsd[ai][m] = asc / sqrtf((float)RS[row0 + ai * 128 + m * 16] * (1.f / (D * RS_SCALE)) + EPS); }
#pragma unroll
        for (int ai = 0; ai < 2; ++ai)
#pragma unroll
            for (int m = 0; m < 4; ++m) { bf16_t* rowp = P + (size_t)(row0 + ai * 128 + m * 16) * PW + col0;
#pragma unroll
                for (int bj = 0; bj < 2; ++bj) { f32x4 v0, v1;
                    if (FN) { float bf_[8]; unpack8(bzp[bj], bf_); v0 = acc[ai][bj][m][0] * rsd[ai][m] + (f32x4){bf_[0], bf_[1], bf_[2], bf_[3]}; v1 = acc[ai][bj][m][1] * rsd[ai][m] + (f32x4){bf_[4], bf_[5], bf_[6], bf_[7]}; } else { v0 = acc[ai][bj][m][0] * asc; v1 = acc[ai][bj][m][1] * asc; }
#pragma unroll
                    for (int j = 0; j < 4; ++j) { v0[j] = fsigmoid(v0[j]); v1[j] = fsigmoid(v1[j]); }
                    *(u32x4*)(rowp + bj * 128) = pack8(v0, v1); } }
    }
};
typedef EpiGatesT<false> EpiGates;
struct EpiMergeFused {
    static constexpr int NVM = 16; static constexpr bool PERM = true; const bf16_t* P; bf16_t* O;
    DI void mid(f32x4 (&acc)[2][2][4][2], const Unit& u, int wr, int wc, int fr, int fq) const {
        int row0 = u.pm * 256 + wr * 64 + fr, col0 = u.pn * 256 + wc * 32 + 8 * fq;
        asm volatile("" : "+v"(row0), "+v"(col0));
#pragma unroll
        for (int ai = 0; ai < 2; ++ai)
#pragma unroll
            for (int m = 0; m < 4; ++m) { const size_t row = (size_t)(row0 + ai * 128 + m * 16);
#pragma unroll
                for (int bj = 0; bj < 2; ++bj) {
                    float ga[8], gr[8]; unpack8(*(const u32x4*)(P + row * PW + PC_GA + col0 + bj * 128), ga); unpack8(*(const u32x4*)(P + row * PW + PC_GR + col0 + bj * 128), gr);
#pragma unroll
                    for (int j = 0; j < 4; ++j) { acc[ai][bj][m][0][j] *= ga[j] * __builtin_amdgcn_rcpf(fmaxf(gr[j], 1e-30f)); acc[ai][bj][m][1][j] *= ga[4 + j] * __builtin_amdgcn_rcpf(fmaxf(gr[4 + j], 1e-30f)); } }
                asm volatile("" ::: "memory"); }
    }
    DI void operator()(AccRef acc, const Unit& u, int wr, int wc, int fr, int fq) const {
        const int row0 = u.pm * 256 + wr * 64 + fr, col0 = u.pn * 256 + wc * 32 + 8 * fq;
        u32x4 gq[2][4][2];
#pragma unroll
        for (int ai = 0; ai < 2; ++ai)
#pragma unroll
            for (int m = 0; m < 4; ++m)
#pragma unroll
                for (int bj = 0; bj < 2; ++bj) gq[ai][m][bj] = *(const u32x4*)(P + (size_t)(row0 + ai * 128 + m * 16) * PW + PC_GR + col0 + bj * 128);
#pragma unroll
        for (int ai = 0; ai < 2; ++ai)
#pragma unroll
            for (int m = 0; m < 4; ++m) { const size_t row = (size_t)(row0 + ai * 128 + m * 16);
#pragma unroll
                for (int bj = 0; bj < 2; ++bj) {
                    float gr[8]; unpack8(gq[ai][m][bj], gr);
                    f32x4 v0 = acc[ai][bj][m][0], v1 = acc[ai][bj][m][1];
#pragma unroll
                    for (int j = 0; j < 4; ++j) { v0[j] *= fmaxf(gr[j], 1e-30f); v1[j] *= fmaxf(gr[4 + j], 1e-30f); }
                    *(u32x4*)(O + row * D + col0 + bj * 128) = pack8(v0, v1); } }
    }
};
struct EpiResid {
    static constexpr int NVM = 16; static constexpr bool PERM = false;
    const float* xin_l; const float* xin_c; float* xout_l; float* xout_c; const float* mods; int msel;
    DI void operator()(AccRef acc, const Unit& u, int wr, int wc, int fr, int fq) const {
        const bool lat = u.pm < (NLAT / 256);
        const int rbase = (lat ? u.pm : u.pm - NLAT / 256) * 256 + wr * 64 + fr, col0 = u.pn * 256 + wc * 32 + 4 * fq;
        const float* xi = lat ? xin_l : xin_c; float* xo = lat ? xout_l : xout_c;
        const float* mv = mods + (size_t)(lat ? (u.pm >> 3) : 32) * DIN + msel * D + col0;
        f32x4 g[2][2];
#pragma unroll
        for (int bj = 0; bj < 2; ++bj)
#pragma unroll
            for (int n = 0; n < 2; ++n) g[bj][n] = *(const f32x4*)(mv + bj * 128 + n * 16);
        f32x4 xa[4][2][2], r0[4][2][2];
#define RES_OFF(ai, m) ((size_t)(rbase + (ai) * 128 + (m) * 16) * D + col0)
#pragma unroll
        for (int m = 0; m < 4; ++m)
#pragma unroll
            for (int bj = 0; bj < 2; ++bj)
#pragma unroll
                for (int n = 0; n < 2; ++n) xa[m][bj][n] = *(const f32x4*)(xi + RES_OFF(0, m) + bj * 128 + n * 16);
#pragma unroll
        for (int m = 0; m < 4; ++m)
#pragma unroll
            for (int bj = 0; bj < 2; ++bj)
#pragma unroll
                for (int n = 0; n < 2; ++n) r0[m][bj][n] = xa[m][bj][n] + g[bj][n] * acc[0][bj][m][n];
#pragma unroll
        for (int m = 0; m < 4; ++m)
#pragma unroll
            for (int bj = 0; bj < 2; ++bj)
#pragma unroll
                for (int n = 0; n < 2; ++n) xa[m][bj][n] = *(const f32x4*)(xi + RES_OFF(1, m) + bj * 128 + n * 16);
        asm volatile("" ::: "memory");
#pragma unroll
        for (int m = 0; m < 4; ++m)
#pragma unroll
            for (int bj = 0; bj < 2; ++bj)
#pragma unroll
                for (int n = 0; n < 2; ++n) *(f32x4*)(xo + RES_OFF(0, m) + bj * 128 + n * 16) = r0[m][bj][n];
#pragma unroll
        for (int m = 0; m < 4; ++m)
#pragma unroll
            for (int bj = 0; bj < 2; ++bj)
#pragma unroll
                for (int n = 0; n < 2; ++n) *(f32x4*)(xo + RES_OFF(1, m) + bj * 128 + n * 16) = xa[m][bj][n] + g[bj][n] * acc[1][bj][m][n];
#undef RES_OFF
    }
};
template <bool F8C> struct EpiResidN {
    static constexpr int NVM = 16; static constexpr bool PERM = true;
    const float* xin_l; const float* xin_c; float* xout_l; float* xout_c; const float* mods; int msel;
    const float* nw; const float* nmods; int nsc; bf16_t* A; unsigned char* A8; unsigned* RS;
    DI void operator()(AccRef acc, const Unit& u, int, int, int, int) const {
        const int te_ = my_tid(); const int wid_ = __builtin_amdgcn_readfirstlane(te_ >> 6), wr = wid_ >> 2, wc = wid_ & 3, fr = te_ & 15, fq = (te_ >> 4) & 3;
        const bool lat = u.pm < (NLAT / 256); const int bidx = lat ? (u.pm >> 3) : 32;
        const int rbase = (lat ? u.pm : u.pm - NLAT / 256) * 256 + wr * 64 + fr, urow0 = u.pm * 256 + wr * 64 + fr, col0 = u.pn * 256 + wc * 32 + 8 * fq;
        const float* xi = lat ? xin_l : xin_c; float* xo = lat ? xout_l : xout_c;
        const float* mv = mods + (size_t)bidx * DIN + msel * D + col0; const float* nv = nmods + (size_t)bidx * DIN + nsc * D + col0;
        f32x4 (&ga)[2][2][4][2] = const_cast<f32x4 (&)[2][2][4][2]>(acc);
        u32x2 gwp[2][2];
#pragma unroll
        for (int bj = 0; bj < 2; ++bj)
#pragma unroll
            for (int n = 0; n < 2; ++n) { const f32x4 g = *(const f32x4*)(mv + bj * 128 + n * 4); const f32x4 gwf = *(const f32x4*)(nw + col0 + bj * 128 + n * 4) * (*(const f32x4*)(nv + bj * 128 + n * 4) + 1.0f);
                gwp[bj][n].x = cvt_pk_bf16(gwf[0], gwf[1]); gwp[bj][n].y = cvt_pk_bf16(gwf[2], gwf[3]);
#pragma unroll
                for (int ai = 0; ai < 2; ++ai)
#pragma unroll
                    for (int m = 0; m < 4; ++m) ga[ai][bj][m][n] *= g; }
        f32x4 xa[4][2][2];
#define RES_OFF(ai, m) ((size_t)(rbase + (ai) * 128 + (m) * 16) * D + col0)
#define RESN_OUT(ai, m, X) do { const size_t uo_ = (size_t)(urow0 + (ai) * 128 + (m) * 16) * D + col0; float ss_ = 0.f; \
            _Pragma("unroll") for (int bj = 0; bj < 2; ++bj) { const f32x4 x0 = X[m][bj][0], x1 = X[m][bj][1]; \
                *(f32x4*)(xo + RES_OFF(ai, m) + bj * 128) = x0; *(f32x4*)(xo + RES_OFF(ai, m) + bj * 128 + 4) = x1; \
                ss_ += ((x0[0] * x0[0] + x0[1] * x0[1]) + (x0[2] * x0[2] + x0[3] * x0[3])) + ((x1[0] * x1[0] + x1[1] * x1[1]) + (x1[2] * x1[2] + x1[3] * x1[3])); \
                const f32x4 w0_ = {bflo(gwp[bj][0].x), bfhi(gwp[bj][0].x), bflo(gwp[bj][0].y), bfhi(gwp[bj][0].y)}, w1_ = {bflo(gwp[bj][1].x), bfhi(gwp[bj][1].x), bflo(gwp[bj][1].y), bfhi(gwp[bj][1].y)}; \
                const f32x4 a0_ = x0 * w0_, a1_ = x1 * w1_; *(u32x4*)(A + uo_ + bj * 128) = pack8(a0_, a1_); \
                if (F8C) { u32x2 w8_; w8_.x = pack_fp8x4(a0_[0], a0_[1], a0_[2], a0_[3]); w8_.y = pack_fp8x4(a1_[0], a1_[1], a1_[2], a1_[3]); *(u32x2*)(A8 + uo_ + bj * 128) = w8_; } } \
            ss_ += xrow(ss_, fq & 1); ss_ += xhalf(ss_, fq >> 1); \
            if (fq == 0) (void)__hip_atomic_fetch_add(RS + urow0 + (ai) * 128 + (m) * 16, (unsigned)fminf(ss_ * RS_SCALE + 0.5f, 2.6e8f), __ATOMIC_RELAXED, __HIP_MEMORY_SCOPE_AGENT); } while (0)
#pragma unroll
        for (int q = 0; q < 4; ++q) { const int ai = q >> 1, m0 = (q & 1) * 2;
#pragma unroll
            for (int m = m0; m < m0 + 2; ++m)
#pragma unroll
                for (int bj = 0; bj < 2; ++bj)
#pragma unroll
                    for (int n = 0; n < 2; ++n) xa[m][bj][n] = *(const f32x4*)(xi + RES_OFF(ai, m) + bj * 128 + n * 4);
#pragma unroll
            for (int m = m0; m < m0 + 2; ++m)
#pragma unroll
                for (int bj = 0; bj < 2; ++bj)
#pragma unroll
                    for (int n = 0; n < 2; ++n) xa[m][bj][n] = xa[m][bj][n] + ga[ai][bj][m][n];
            asm volatile("" ::: "memory");
#pragma unroll
            for (int m = m0; m < m0 + 2; ++m) RESN_OUT(ai, m, xa); }
#undef RESN_OUT
#undef RES_OFF
    }
};
struct EpiSwiglu {
    static constexpr int NVM = 16; static constexpr bool PERM = true; bf16_t* Hd; int ldh; int pan0; const unsigned* RS; const float* bias;
    DI void operator()(AccRef acc, const Unit& u, int wr, int wc, int fr, int fq) const {
        const int row0 = (u.pm - pan0) * 256 + wr * 64 + fr, hc0 = u.pn * 128 + wc * 16 + 4 * fq;
        f32x4 bz[2][2]; float rsd[2][4];
#pragma unroll
        for (int bj = 0; bj < 2; ++bj) { const float* bp = bias + (size_t)(u.pm < NLAT / 256 ? (u.pm >> 3) : 32) * (2 * DFFP) + u.pn * 256 + bj * 128 + wc * 32 + 8 * fq;
            bz[bj][0] = *(const f32x4*)bp; bz[bj][1] = *(const f32x4*)(bp + 4); }
#pragma unroll
        for (int ai = 0; ai < 2; ++ai)
#pragma unroll
            for (int m = 0; m < 4; ++m) rsd[ai][m] = 1.f / sqrtf((float)RS[u.pm * 256 + wr * 64 + fr + ai * 128 + m * 16] * (1.f / (D * RS_SCALE)) + EPS);
#pragma unroll
        for (int ai = 0; ai < 2; ++ai)
#pragma unroll
            for (int m = 0; m < 4; ++m) { bf16_t* rowp = Hd + (size_t)(row0 + ai * 128 + m * 16) * ldh + hc0;
#pragma unroll
                for (int bj = 0; bj < 2; ++bj) { const f32x4 a = acc[ai][bj][m][0] * rsd[ai][m] + bz[bj][0], b = acc[ai][bj][m][1] * rsd[ai][m] + bz[bj][1];
                    u32x2 w; w.x = cvt_pk_bf16(fsilu(a[0]) * b[0], fsilu(a[1]) * b[1]); w.y = cvt_pk_bf16(fsilu(a[2]) * b[2], fsilu(a[3]) * b[3]);
                    *(u32x2*)(rowp + bj * 64) = w; } }
    }
};
struct EpiSwiglu8 {
    static constexpr int NVM = 16; static constexpr bool PERM = true; unsigned char* Hd; int ldh; int pan0; float as, hs;
    DI void operator()(AccRef acc, const Unit& u, int wr, int wc, int fr, int fq) const {
        const int row0 = (u.pm - pan0) * 256 + wr * 64 + fr, hc0 = u.pn * 128 + wc * 16 + 4 * fq;
#pragma unroll
        for (int ai = 0; ai < 2; ++ai)
#pragma unroll
            for (int m = 0; m < 4; ++m) { unsigned char* rowp = Hd + (size_t)(row0 + ai * 128 + m * 16) * ldh + hc0;
#pragma unroll
                for (int bj = 0; bj < 2; ++bj) { const f32x4 a = acc[ai][bj][m][0] * as, b = acc[ai][bj][m][1] * (as * hs);
                    *(unsigned*)(rowp + bj * 64) = pack_fp8x4(fsilu(a[0]) * b[0], fsilu(a[1]) * b[1], fsilu(a[2]) * b[2], fsilu(a[3]) * b[3]); } }
    }
};
struct EpiBf16 {
    static constexpr int NVM = 16; static constexpr bool PERM = true; bf16_t* O; int ldc; float sc;
    DI void operator()(AccRef acc, const Unit& u, int wr, int wc, int fr, int fq) const {
        const int row0 = u.pm * 256 + wr * 64 + fr, col0 = u.pn * 256 + wc * 32 + 8 * fq;
#pragma unroll
        for (int ai = 0; ai < 2; ++ai)
#pragma unroll
            for (int m = 0; m < 4; ++m) { bf16_t* rowp = O + (size_t)(row0 + ai * 128 + m * 16) * ldc + col0;
#pragma unroll
                for (int bj = 0; bj < 2; ++bj) *(u32x4*)(rowp + bj * 128) = pack8(acc[ai][bj][m][0] * sc, acc[ai][bj][m][1] * sc); }
    }
};

typedef short v4i16 __attribute__((ext_vector_type(4)));
DI s16x4 tr16(const LAS unsigned char* p) { return __builtin_bit_cast(s16x4, __builtin_amdgcn_ds_read_tr16_b64_v4i16((LAS v4i16*)p)); }
DI bf16x8 cat8(s16x4 lo, s16x4 hi) { return __builtin_shufflevector(lo, hi, 0, 1, 2, 3, 4, 5, 6, 7); }
DI void dma16(const void* g, LAS unsigned char* l) { __builtin_amdgcn_global_load_lds((const unsigned*)g, (LAS unsigned*)l, 16, 0, 0); }
DI void dma16a(const void* g, LAS unsigned char* l) {
    const unsigned la = __builtin_amdgcn_readfirstlane((unsigned)(size_t)l); unsigned m0s;
    asm volatile("s_mov_b32 %0, m0\n\ts_mov_b32 m0, %2\n\ts_nop 0\n\tglobal_load_lds_dwordx4 %1, off\n\ts_mov_b32 m0, %0" : "=&s"(m0s) : "v"(g), "s"(la) : "memory");
}
DI bf16x8 packf8(const f32x16& x, int s) {
    u32x4 w; w.x = cvt_pk_bf16(x[8 * s], x[8 * s + 1]); w.y = cvt_pk_bf16(x[8 * s + 2], x[8 * s + 3]); w.z = cvt_pk_bf16(x[8 * s + 4], x[8 * s + 5]); w.w = cvt_pk_bf16(x[8 * s + 6], x[8 * s + 7]);
    return __builtin_bit_cast(bf16x8, w);
}
#define MFMA32(a, b, c) __builtin_amdgcn_mfma_f32_32x32x16_bf16((a), (b), (c), 0, 0, 0)

struct Params { const float* in[28]; float* out; unsigned char* ws; int ph_lo, ph_hi, li, pad; };
typedef const __attribute__((address_space(4))) Params* KP;
DI KP kparams() { KP kp = (KP)__builtin_amdgcn_kernarg_segment_ptr(); asm volatile("" : "+s"(kp)); return kp; }
#define PIN(k) (kparams()->in[k])
#define POUT (kparams()->out)
struct Ctx {
    LAS unsigned char* lds; unsigned char* ws; int tid, lane, wave, vcu, G, gw, NGW, bx;
};

constexpr float WIN8_SCALE = 64.f;
#ifndef FP8_SECS0
#define FP8_SECS0 0xE4
#endif
#ifndef FP8_SECS1
#define FP8_SECS1 0xE4
#endif
constexpr int sec_order(int i) { return (int)((0x76524310u >> (4 * i)) & 15u); }
constexpr int sec_slot(int fs, int ps) { int nb = 0, nf = 0; for (int i = 0; i < 8; ++i) { const int s_ = sec_order(i); const bool f = (fs >> s_) & 1; if (s_ == ps) return f ? (0x100 | nf) : nb; if (f) ++nf; else ++nb; } return 0; }
constexpr int n_sec_f8(int fs) { return __builtin_popcount((unsigned)fs); }
constexpr unsigned secmap_of(int fs, bool f8) { unsigned m = 0; int k = 0; for (int i = 0; i < 8; ++i) { const int s_ = sec_order(i); if ((((fs >> s_) & 1) != 0) == f8) { m |= (unsigned)s_ << (4 * k); ++k; } } return m; }
DI int map_row(int kind, int n, int fs) {
    if (kind == 0) return n;
    if (kind == 2) return 8 * (n >> 2) + (n & 3);
    if (kind == 3) return 8 * (n >> 2) + (n & 3) + 4;
    const int sec = n >> 9, j = n & 511; int r;
    if (n >= 4096) r = (1 << 16) | (n_sec_f8(fs) * 512 + (n - 4096));
    else {
        const int ps = sec == 0 ? 0 : sec == 1 ? 4 : sec == 2 ? 5 : sec == 3 ? 6 : sec == 4 ? 7 : sec == 5 ? 1 : sec == 6 ? 3 : 2;
        const int sl = sec_slot(fs, ps); int jj = j;
        if (sec == 0 || sec == 1) { const int hs = j >> 6, d = j & 63; jj = hs * 64 + (d < 32 ? 2 * d : 2 * (d - 32) + 1); }
        r = ((sl & 0x100) ? (1 << 16) : 0) | ((sl & 0xff) * 512 + jj); }
    return kind == 4 ? (r & 0xffff) : r;
}
constexpr int TP_PITCH = 68, TP_SCR = 64 * TP_PITCH * 4;
DI void transpose_load(const float* W, int ldw, int k0, int n0, LAS float* scr, int lane) {
    const int r = lane >> 4, c4 = (lane & 15) * 4; f32x4 v[16];
#pragma unroll
    for (int i = 0; i < 16; ++i) v[i] = *(const f32x4*)(W + (size_t)(k0 + 4 * i + r) * ldw + n0 + c4);
#pragma unroll
    for (int i = 0; i < 16; ++i) *(LAS f32x4*)(scr + (4 * i + r) * TP_PITCH + c4) = v[i];
    LDS_WAIT(); asm volatile("" ::: "memory");
}
DI void transpose_item(const float* W, int ldw, int k0, int n0, bf16_t* WT, int ldt, int kind, LAS float* scr, int lane, int fs = 0) {
    transpose_load(W, ldw, k0, n0, scr, lane);
    bf16_t* dst = WT + (size_t)map_row(kind, n0 + lane, fs) * ldt + k0;
#pragma unroll
    for (int j = 0; j < 8; ++j) { const LAS float* s = scr + (8 * j) * TP_PITCH + lane;
        u32x4 o; o.x = cvt_pk_bf16(s[0], s[TP_PITCH]); o.y = cvt_pk_bf16(s[2 * TP_PITCH], s[3 * TP_PITCH]); o.z = cvt_pk_bf16(s[4 * TP_PITCH], s[5 * TP_PITCH]); o.w = cvt_pk_bf16(s[6 * TP_PITCH], s[7 * TP_PITCH]);
        *(u32x4*)(dst + 8 * j) = o; }
    LDS_WAIT(); asm volatile("" ::: "memory");
}
DI void transpose_item8(const float* W, int ldw, int k0, int n0, unsigned char* WT, int ldt, int kind, float sc, LAS float* scr, int lane, int fs = 0) {
    transpose_load(W, ldw, k0, n0, scr, lane);
    unsigned char* dst = WT + (size_t)map_row(kind, n0 + lane, fs) * ldt + k0;
#pragma unroll
    for (int j = 0; j < 4; ++j) { const LAS float* s = scr + (16 * j) * TP_PITCH + lane; u32x4 o;
        o.x = pack_fp8x4(s[0] * sc, s[TP_PITCH] * sc, s[2 * TP_PITCH] * sc, s[3 * TP_PITCH] * sc); o.y = pack_fp8x4(s[4 * TP_PITCH] * sc, s[5 * TP_PITCH] * sc, s[6 * TP_PITCH] * sc, s[7 * TP_PITCH] * sc);
        o.z = pack_fp8x4(s[8 * TP_PITCH] * sc, s[9 * TP_PITCH] * sc, s[10 * TP_PITCH] * sc, s[11 * TP_PITCH] * sc); o.w = pack_fp8x4(s[12 * TP_PITCH] * sc, s[13 * TP_PITCH] * sc, s[14 * TP_PITCH] * sc, s[15 * TP_PITCH] * sc);
        *(u32x4*)(dst + 16 * j) = o; }
    LDS_WAIT(); asm volatile("" ::: "memory");
}
DI void transpose_matrix8(const Ctx& C, const float* W, int K, int N, unsigned char* WT, int ldt, int kind, float sc, int& itbase) {
    LAS float* scr = (LAS float*)(C.lds + C.wave * TP_SCR);
    const int nblk = N / 64, nit = (K / 64) * nblk;
    int first = (C.gw - (itbase % C.NGW) + C.NGW) % C.NGW;
    for (int it = first; it < nit; it += C.NGW) transpose_item8(W, N, 64 * (it / nblk), 64 * (it % nblk), WT, ldt, kind, sc, scr, C.lane);
    itbase += nit;
}
DI void transpose_matrix(const Ctx& C, const float* W, int K, int N, bf16_t* WT, int ldt, int kind, int& itbase, int total_unused) {
    (void)total_unused;
    LAS float* scr = (LAS float*)(C.lds + C.wave * TP_SCR);
    const int nblk = N / 64, nit = (K / 64) * nblk;
    int first = (C.gw - (itbase % C.NGW) + C.NGW) % C.NGW;
    for (int it = first; it < nit; it += C.NGW) transpose_item(W, N, 64 * (it / nblk), 64 * (it % nblk), WT, ldt, kind, scr, C.lane);
    itbase += nit;
}
DI void transpose_win(const Ctx& C, const float* W, bf16_t* WA, unsigned char* W8, int& itbase, int fs) {
    LAS float* scr = (LAS float*)(C.lds + C.wave * TP_SCR);
    const int nblk = DIN / 64, nit = (D / 64) * nblk;
    int first = (C.gw - (itbase % C.NGW) + C.NGW) % C.NGW;
    for (int it = first; it < nit; it += C.NGW) { const int k0 = 64 * (it / nblk), n0 = 64 * (it % nblk);
        if (map_row(1, n0, fs) >> 16) transpose_item8(W, DIN, k0, n0, W8, D, 4, WIN8_SCALE, scr, C.lane, fs);
        else transpose_item(W, DIN, k0, n0, WA, D, 1, scr, C.lane, fs); }
    itbase += nit;
}
constexpr int MD_SP = 36;
template <int KIND> DI void phase_rowgemm(const Ctx& C, const int task) {
    const int l = task / (KIND == 1 ? 43 : 96), n0 = (task % (KIND == 1 ? 43 : 96)) * 64, kq = C.lane >> 4, cq = C.lane & 15;
    LAS float* S = (LAS float*)C.lds;
    const int ldw = KIND == 1 ? DFF : DIN;
    const float* W = (KIND == 0 ? PIN(4) + (size_t)l * D * DIN : KIND == 1 ? (l ? PIN(21) : PIN(20)) : PIN(8) + (size_t)D * DIN) + n0 + 4 * cq; const float* c0 = PIN(1); const float* cc = PIN(3);
    const float* shv = (const float*)(C.ws + WS_MODS) + (KIND == 1 ? 3 * D : (size_t)33 * DIN);
    f32x4 acc[33];
#pragma unroll
    for (int r = 0; r < 33; ++r) acc[r] = (f32x4){0.f, 0.f, 0.f, 0.f};
#pragma unroll 1
    for (int kh = 0; kh < 2; ++kh) {
        __syncthreads();
        for (int i = C.tid; i < 33 * 512; i += 512) { const int r = i >> 9, kk = i & 511;
            S[kk * MD_SP + r] = KIND == 0 ? fsilu(r < 32 ? c0[r * D + kh * 512 + kk] : cc[kh * 512 + kk]) : shv[(size_t)r * DIN + kh * 512 + kk]; }
        __syncthreads();
        const int kb = C.wave * 64 + kq;
#pragma unroll 1
        for (int ib = 0; ib < 16; ib += 8) { f32x4 w[8];
#pragma unroll
            for (int i = 0; i < 8; ++i) w[i] = *(const f32x4*)(W + (size_t)(kh * 512 + kb + 4 * (ib + i)) * ldw);
#pragma unroll
            for (int i = 0; i < 8; ++i) { const LAS float* sp = S + (kb + 4 * (ib + i)) * MD_SP;
#pragma unroll
                for (int q = 0; q < 8; ++q) { const f32x4 s4 = *(const LAS f32x4*)(sp + 4 * q);
                    acc[4 * q] += w[i] * s4[0]; acc[4 * q + 1] += w[i] * s4[1]; acc[4 * q + 2] += w[i] * s4[2]; acc[4 * q + 3] += w[i] * s4[3]; }
                acc[32] += w[i] * sp[32]; } }
    }
#pragma unroll
    for (int r = 0; r < 33; ++r)
#pragma unroll
        for (int j = 0; j < 4; ++j) { float v = acc[r][j]; v += __shfl_xor(v, 16); v += __shfl_xor(v, 32); asm volatile("" : "+v"(v)); acc[r][j] = v; }
    __syncthreads();
    LAS float* red = (LAS float*)C.lds;
    if (kq == 0) {
#pragma unroll
        for (int r = 0; r < 33; ++r) *(LAS f32x4*)(red + (C.wave * 33 + r) * 64 + 4 * cq) = acc[r]; }
    __syncthreads();
    float* mods = (float*)(C.ws + WS_MODS); float* bf = (float*)(C.ws + WS_BIASF);
    for (int o = C.tid; o < 33 * 64; o += 512) { const int r = o >> 6, c = o & 63; float v = KIND == 0 ? PIN(5)[l * DIN + n0 + c] : 0.f;
#pragma unroll
        for (int w8 = 0; w8 < 8; ++w8) v += red[(w8 * 33 + r) * 64 + c];
        if (KIND == 0) mods[(size_t)(l * 33 + r) * DIN + n0 + c] = v;
        else if (KIND == 1) bf[(size_t)r * (2 * DFFP) + 2 * (n0 + (c & ~3)) + (c & 3) + 4 * l] = v;
        else { const int mr = map_row(1, n0 + c, FP8_SECS1); ((float*)(C.ws + WS_BIASI))[(size_t)r * DIN + ((mr >> 16) ? (8 - n_sec_f8(FP8_SECS1)) * 512 : 0) + (mr & 0xffff)] = v; } }
    __syncthreads();
}
DI void phase_mods(const Ctx& C) { if (C.bx < 2 * 96) phase_rowgemm<0>(C, C.bx); }
DI void phase_prologue_deferred(const Ctx& C) {
    unsigned char* ws = C.ws;
    int itb = 0;
    for (int l = 0; l < 2; ++l) {
        if (l == 1) transpose_win(C, PIN(8) + (size_t)l * D * DIN, (bf16_t*)(ws + WS_WIN) + (size_t)l * 4096 * D, ws + WS_WIN8 + (size_t)l * 4096 * D, itb, FP8_SECS1);
        transpose_matrix(C, PIN(17) + (size_t)l * 512 * D, 512, D, (bf16_t*)(ws + WS_WUA) + (size_t)l * D * D, D, 0, itb, 0);
        transpose_matrix(C, PIN(18) + (size_t)l * 512 * D, 512, D, (bf16_t*)(ws + WS_WUA) + (size_t)l * D * D + 512, D, 0, itb, 0);
        transpose_matrix(C, PIN(19) + (size_t)l * D * D, D, D, (bf16_t*)(ws + WS_WO) + (size_t)l * D * D, D, 0, itb, 0);
    }
    transpose_matrix(C, PIN(20), D, DFF, (bf16_t*)(ws + WS_W13), D, 2, itb, 0);
    transpose_matrix(C, PIN(21), D, DFF, (bf16_t*)(ws + WS_W13), D, 3, itb, 0);
    transpose_matrix(C, PIN(22), DFF, D, (bf16_t*)(ws + WS_W2), DFFP, 0, itb, 0);
}
DI void phase_prologue(const Ctx& C) {
    unsigned char* ws = C.ws;
    int itb = 0;
    transpose_win(C, PIN(8), (bf16_t*)(ws + WS_WIN), ws + WS_WIN8, itb, FP8_SECS0);
    { const int gt = C.vcu * 512 + C.tid, NT = C.G * 512;
      bf16_t* w13 = (bf16_t*)(ws + WS_W13) + (size_t)(2 * DFF) * D;
      for (int i = gt; i < (2 * DFFP - 2 * DFF) * D / 8; i += NT) ((u32x4*)w13)[i] = (u32x4){0u, 0u, 0u, 0u};
      bf16_t* w2 = (bf16_t*)(ws + WS_W2);
      for (int i = gt; i < D * (DFFP - DFF) / 8; i += NT) { const int r = i / ((DFFP - DFF) / 8), cc = i % ((DFFP - DFF) / 8); *(u32x4*)(w2 + (size_t)r * DFFP + DFF + cc * 8) = (u32x4){0u, 0u, 0u, 0u}; }
      float2* rope = (float2*)(ws + WS_ROPE);
      for (int i = gt; i < T * 32; i += NT) { const int t = i >> 5, pi = i & 31; const float invf = exp2f(-(float)(pi & 15) * (13.287712379549449f / 16.f));
          const float ang = (float)(pi < 16 ? (t >> 6) : (t & 63)) * invf; rope[i] = make_float2(cosf(ang), sinf(ang)); }
      float* lbs = (float*)(ws + WS_LBS);
      for (int i = gt; i < 2 * 2 * 512; i += NT) { const int l = i >> 10, dir = (i >> 9) & 1, d = i & 511; const float* lb = PIN(dir ? 16 : 15);
          const float p0 = lb[d], p1 = lb[512 + d]; lbs[i] = l == 0 ? 0.f : 1.f / (1.f + expf(p0 - p1)); }
    }
    phase_mods(C);
}
constexpr float W13_SCALE = 64.f, W2_SCALE = 128.f, HID_SCALE = 8.f;
DI void convert_moe_weights(const Ctx& C, const int gw, const int NGW) {
    unsigned char* ws = C.ws; LAS float* scr = (LAS float*)(C.lds + C.wave * TP_SCR);
    const int lane = C.lane, r = lane >> 4, c4 = (lane & 15) * 4;
    constexpr int NIT = NE * 3 * 896;
    static_assert((D / 64) * (DFE / 64) == 896, "items per expert matrix");
    f32x4 v[16];
#define MOE_ITEM(it, W, ldw, k0, n0) const int m_ = (it) / 896, q_ = (it) % 896, e_ = m_ / 3, wh_ = m_ % 3; \
        const float* W = PIN(wh_ == 0 ? 24 : wh_ == 1 ? 25 : 26) + (size_t)e_ * D * DFE; const int ldw = wh_ == 2 ? D : DFE, nb_ = wh_ == 2 ? D / 64 : DFE / 64, k0 = 64 * (q_ / nb_), n0 = 64 * (q_ % nb_)
#define MOE_LOADS(it) do { MOE_ITEM(it, W_, ldw_, k0_, n0_); _Pragma("unroll") for (int i = 0; i < 16; ++i) v[i] = *(const f32x4*)(W_ + (size_t)(k0_ + 4 * i + r) * ldw_ + n0_ + c4); } while (0)
    int it = gw;
    if (it < NIT) MOE_LOADS(it);
    for (; it < NIT; it += NGW) {
#pragma unroll
        for (int i = 0; i < 16; ++i) *(LAS f32x4*)(scr + (4 * i + r) * TP_PITCH + c4) = v[i];
        LDS_WAIT(); asm volatile("" ::: "memory");
        if (it + NGW < NIT) MOE_LOADS(it + NGW);
        MOE_ITEM(it, W, ldw, k0, n0); (void)W; (void)ldw;
        const int kind = wh_ == 0 ? 2 : wh_ == 1 ? 3 : 0; const float sc = wh_ == 2 ? W2_SCALE : W13_SCALE;
        unsigned char* dst = (wh_ == 2 ? ws + WS_WM2 + (size_t)e_ * D * DFE : ws + WS_WM13 + (size_t)e_ * 2 * DFE * D) + (size_t)map_row(kind, n0 + lane, 0) * (wh_ == 2 ? DFE : D) + k0;
#pragma unroll
        for (int j = 0; j < 4; ++j) { const LAS float* sp = scr + (16 * j) * TP_PITCH + lane; u32x4 o;
            o.x = pack_fp8x4(sp[0] * sc, sp[TP_PITCH] * sc, sp[2 * TP_PITCH] * sc, sp[3 * TP_PITCH] * sc); o.y = pack_fp8x4(sp[4 * TP_PITCH] * sc, sp[5 * TP_PITCH] * sc, sp[6 * TP_PITCH] * sc, sp[7 * TP_PITCH] * sc);
            o.z = pack_fp8x4(sp[8 * TP_PITCH] * sc, sp[9 * TP_PITCH] * sc, sp[10 * TP_PITCH] * sc, sp[11 * TP_PITCH] * sc); o.w = pack_fp8x4(sp[12 * TP_PITCH] * sc, sp[13 * TP_PITCH] * sc, sp[14 * TP_PITCH] * sc, sp[15 * TP_PITCH] * sc);
            *(u32x4*)(dst + 16 * j) = o; }
        LDS_WAIT(); asm volatile("" ::: "memory");
    }
#undef MOE_ITEM
#undef MOE_LOADS
}

template <bool ROUTER>
DI void phase_norm(const Ctx& C, const float* xl, const float* xc, const float* nw, const float* mods, int shsel, int nrows, bf16_t* Hout, const float* rw, unsigned char* route, LAS int* cntL, unsigned char* H8 = nullptr) {
    int nloc = 0;
    LAS f32x4* RT = (LAS f32x4*)(C.lds + 32768);
    if (ROUTER) {
        for (int k = C.tid; k < 2048; k += 512) { const int e = k >> 6, ln = k & 63, jq = e >> 1, half = e & 1; RT[k] = *(const f32x4*)(rw + (size_t)(256 * (jq >> 2) + 4 * ln + (jq & 3)) * 8 + half * 4); }
        __syncthreads(); }
    f32x4 vq[2][4];
#define NORM_XLOADS(dst, r0_) do { _Pragma("unroll") for (int u = 0; u < 2; ++u) { int row_ = (r0_) + u * C.NGW; row_ = row_ < nrows ? row_ : (r0_); \
            const float* xr_ = row_ < NLAT ? xl + (size_t)row_ * D : xc + (size_t)(row_ - NLAT) * D; \
            _Pragma("unroll") for (int j = 0; j < 4; ++j) dst[u][j] = *(const f32x4*)(xr_ + 256 * j + 4 * C.lane); } } while (0)
    if (C.gw < nrows) NORM_XLOADS(vq, C.gw);
    for (int row0 = C.gw; row0 < nrows; row0 += 2 * C.NGW) {
        const int rows[2] = {row0, row0 + C.NGW}; const bool two = rows[1] < nrows;
        f32x4 v[2][4]; float ss[2] = {0.f, 0.f};
#pragma unroll
        for (int u = 0; u < 2; ++u)
#pragma unroll
            for (int j = 0; j < 4; ++j) v[u][j] = vq[u][j];
#pragma unroll
        for (int u = 0; u < 2; ++u)
#pragma unroll
            for (int j = 0; j < 4; ++j) ss[u] += (v[u][j][0] * v[u][j][0] + v[u][j][1] * v[u][j][1]) + (v[u][j][2] * v[u][j][2] + v[u][j][3] * v[u][j][3]);
        f32x4 gwv[2][4], shv[2][4];
#define NORM_MODS(u_) do { const int row_ = ((u_) == 1 && !two) ? rows[0] : rows[u_]; const float* mv_ = mods + (size_t)(row_ < NLAT ? (row_ >> 11) : 32) * DIN + shsel * D; \
            _Pragma("unroll") for (int j = 0; j < 4; ++j) { const int c0 = 256 * j + 4 * C.lane; \
                gwv[u_][j] = *(const f32x4*)(nw + c0) * (*(const f32x4*)(mv_ + D + c0) + 1.0f); shv[u_][j] = *(const f32x4*)(mv_ + c0); } } while (0)
        NORM_MODS(0); NORM_MODS(1); if (row0 + 2 * C.NGW < nrows) NORM_XLOADS(vq, row0 + 2 * C.NGW);
#pragma unroll
        for (int u = 0; u < 2; ++u) { if (u == 1 && !two) break;
            const int row = rows[u];
            const float rstd = 1.0f / sqrtf(wave_sum(ss[u]) * (1.f / D) + EPS);
            float lg[8];
            if (ROUTER) {
#pragma unroll
                for (int e = 0; e < 8; ++e) lg[e] = 0.f; }
#pragma unroll
            for (int j = 0; j < 4; ++j) { const int c0 = 256 * j + 4 * C.lane;
                f32x4 h = (v[u][j] * rstd) * gwv[u][j] + shv[u][j];
                if (ROUTER) *(unsigned*)((unsigned char*)Hout + (size_t)row * D + c0) = pack_fp8x4(h[0], h[1], h[2], h[3]);
                else { u32x2 o; o.x = cvt_pk_bf16(h[0], h[1]); o.y = cvt_pk_bf16(h[2], h[3]); *(u32x2*)(Hout + (size_t)row * D + c0) = o;
                       if (H8) *(unsigned*)(H8 + (size_t)row * D + c0) = pack_fp8x4(h[0], h[1], h[2], h[3]); }
                if (ROUTER) {
#pragma unroll
                    for (int q = 0; q < 4; ++q) { const f32x4 r0 = RT[((j * 4 + q) * 2) * 64 + C.lane], r1 = RT[((j * 4 + q) * 2 + 1) * 64 + C.lane];
                        lg[0] += h[q] * r0[0]; lg[1] += h[q] * r0[1]; lg[2] += h[q] * r0[2]; lg[3] += h[q] * r0[3]; lg[4] += h[q] * r1[0]; lg[5] += h[q] * r1[1]; lg[6] += h[q] * r1[2]; lg[7] += h[q] * r1[3]; } }
            }
            if (ROUTER) {
                const bool b5 = (C.lane & 32) != 0, b4 = (C.lane & 16) != 0, b3 = (C.lane & 8) != 0; float a4[4], a2[2], a1;
#pragma unroll
                for (int j = 0; j < 4; ++j) { const float snd = b5 ? lg[j] : lg[4 + j]; a4[j] = (b5 ? lg[4 + j] : lg[j]) + __shfl_xor(snd, 32); }
#pragma unroll
                for (int j = 0; j < 2; ++j) { const float snd = b4 ? a4[j] : a4[2 + j]; a2[j] = (b4 ? a4[2 + j] : a4[j]) + __shfl_xor(snd, 16); }
                { const float snd = b3 ? a2[0] : a2[1]; a1 = (b3 ? a2[1] : a2[0]) + __shfl_xor(snd, 8); }
                a1 += __shfl_xor(a1, 4); a1 += __shfl_xor(a1, 2); a1 += __shfl_xor(a1, 1);
                if ((C.lane & 7) == 0) ((LAS float*)(C.lds + C.wave * 4096))[nloc * 8 + (C.lane >> 3)] = a1;
                ++nloc;
            }
        }
    }
#undef NORM_MODS
#undef NORM_XLOADS
    if (ROUTER) {
        LDS_WAIT();
        for (int i = C.lane; i < nloc; i += 64) { const int row = C.gw + i * C.NGW; const LAS float* lp = (const LAS float*)(C.lds + C.wave * 4096) + i * 8;
            float lg[8];
#pragma unroll
            for (int e = 0; e < 8; ++e) lg[e] = lp[e];
            int e1 = 0; float l1 = lg[0];
#pragma unroll
            for (int e = 1; e < 8; ++e) if (lg[e] > l1) { l1 = lg[e]; e1 = e; }
            int e2 = -1; float l2 = -INFINITY;
#pragma unroll
            for (int e = 0; e < 8; ++e) if (e != e1 && lg[e] > l2) { l2 = lg[e]; e2 = e; }
            const float g2 = 1.f / (1.f + expf(l1 - l2)), g1 = 1.f - g2;
            int* rt = (int*)(route + (size_t)row * 24); rt[0] = e1; rt[1] = e2; ((float*)rt)[2] = g1; ((float*)rt)[3] = g2;
            atomicAdd((int*)&cntL[e1], 1); atomicAdd((int*)&cntL[e2], 1);
        }
    }
}

constexpr int AT_XCH = 65536, AT_ANW = 131072;
DI float max3f(float a, float b, float c) { return fmaxf(fmaxf(a, b), c); }
constexpr float AT_THR = 8.f;
DI void attn_unit(const Ctx& C, bf16_t* P, int qrow0, int krow_ctx, int krow_lat, int nkt, int h, float lam, const float* anw, float post) {
    const int tid_ = my_tid();
    LAS unsigned char* lds = C.lds; const int lane = tid_ & 63, wid = __builtin_amdgcn_readfirstlane(tid_ >> 6), sub = wid >> 2, qw = wid & 3, r32 = lane & 31, hh = lane >> 5;
    const int tq = (lane & 15) >> 2, tp = lane & 3, blk = (lane >> 4) & 1;
    LAS unsigned char* qlds = lds + AT_XCH + wid * 8192 + r32 * 16;
#pragma unroll
    for (int qb = 0; qb < 2; ++qb) { const bf16_t* qp = P + (size_t)(qrow0 + 64 * qw + 32 * qb + r32) * PW + PC_Q + h * 128 + sub * 64 + 8 * hh;
#pragma unroll
      for (int ks = 0; ks < 4; ++ks) *(LAS bf16x8*)(qlds + ((2 * ks + hh) * 64 + 32 * qb) * 16) = *(const bf16x8*)(qp + 16 * ks); }
    if (tid_ < 32) *(LAS f32x4*)(lds + AT_ANW + tid_ * 16) = *(const f32x4*)(anw + 4 * tid_);
    f32x16 O[2][4];
#pragma unroll
    for (int qb = 0; qb < 2; ++qb)
#pragma unroll
        for (int c = 0; c < 4; ++c)
#pragma unroll
            for (int i = 0; i < 16; ++i) O[qb][c][i] = 0.f;
    float m_run[2] = {-INFINITY, -INFINITY}, l_run[2] = {0.f, 0.f};
#define AT_ISSUE(kt, buf) do { const int kr0_ = (kt) < 4 ? krow_ctx + (kt) * 64 : krow_lat + ((kt) - 4) * 64; LAS unsigned char* bb_ = lds + (buf) * 32768; \
        _Pragma("unroll") for (int j_ = 0; j_ < 2; ++j_) { const int c_ = 2 * wid + j_; \
            dma16a(P + (size_t)(kr0_ + lane) * PW + PC_K + h * 128 + c_ * 8, bb_ + c_ * 1024); \
            dma16a(P + (size_t)(kr0_ + 16 * (c_ & 3) + (lane >> 2)) * PW + PC_V + h * 128 + (c_ >> 2) * 32 + (lane & 3) * 8, bb_ + 16384 + c_ * 1024); } } while (0)
    AT_ISSUE(0, 0);
    int buf = 0;
#pragma unroll 1
    for (int kt = 0; kt < nkt; ++kt) {
        VM_WAIT(); __syncthreads();
        if (kt + 1 < nkt) AT_ISSUE(kt + 1, buf ^ 1);
        const LAS unsigned char* kb = lds + buf * 32768, * vb = kb + 16384 + (4 * hh + tq) * 64 + blk * 32 + tp * 8;
        bf16x8 Pf[2][4];
#pragma unroll
        for (int qb = 0; qb < 2; ++qb) {
            f32x16 s0, s1;
#pragma unroll
            for (int i = 0; i < 16; ++i) { s0[i] = 0.f; s1[i] = 0.f; }
#pragma unroll
            for (int ks = 0; ks < 4; ++ks) { const LAS unsigned char* kp = kb + ((sub * 8 + 2 * ks + hh) * 64 + r32) * 16;
                const bf16x8 k0 = *(const LAS bf16x8*)kp, k1 = *(const LAS bf16x8*)(kp + 512);
                const bf16x8 q = *(const LAS bf16x8*)(qlds + ((2 * ks + hh) * 64 + 32 * qb) * 16);
                s0 = MFMA32(k0, q, s0); s1 = MFMA32(k1, q, s1); }
            float mx = max3f(s0[0], s1[0], s0[1]);
#pragma unroll
            for (int i = 1; i < 16; ++i) mx = (i + 1 < 16) ? max3f(mx, s1[i], s0[i + 1]) : fmaxf(mx, s1[i]);
            mx = fmaxf(mx, xhalf(mx, hh));
            const float mnew = fmaxf(m_run[qb], mx);
            if (__any(mx > m_run[qb] + AT_THR)) { const float alpha = __builtin_amdgcn_exp2f(m_run[qb] - mnew); l_run[qb] *= alpha;
#pragma unroll
                for (int c = 0; c < 4; ++c)
#pragma unroll
                    for (int i = 0; i < 16; ++i) O[qb][c][i] *= alpha;
                m_run[qb] = mnew; }
            const float mr = m_run[qb]; float ps0 = 0.f, ps1 = 0.f;
#pragma unroll
            for (int i = 0; i < 16; ++i) { s0[i] = __builtin_amdgcn_exp2f(s0[i] - mr); s1[i] = __builtin_amdgcn_exp2f(s1[i] - mr); ps0 += s0[i]; ps1 += s1[i]; }
            l_run[qb] += ps0 + ps1;
            Pf[qb][0] = packf8(s0, 0); Pf[qb][1] = packf8(s0, 1); Pf[qb][2] = packf8(s1, 0); Pf[qb][3] = packf8(s1, 1);
        }
#pragma unroll
        for (int cb = 0; cb < 4; ++cb) {
#pragma unroll
            for (int s4 = 0; s4 < 4; ++s4) { const bf16x8 a = cat8(tr16(vb + cb * 4096 + s4 * 1024), tr16(vb + cb * 4096 + s4 * 1024 + 512));
                O[0][cb] = MFMA32(a, Pf[0][s4], O[0][cb]); O[1][cb] = MFMA32(a, Pf[1][s4], O[1][cb]); } }
        buf ^= 1;
    }
#undef AT_ISSUE
    LDS_WAIT(); __syncthreads();
    const int te = my_tid(); const int lane_e = te & 63, wid_e = __builtin_amdgcn_readfirstlane(te >> 6);
    LAS float* xch = (LAS float*)(lds + AT_XCH) + (wid_e & 3) * 4096 + lane_e;
#pragma unroll
    for (int qb = 0; qb < 2; ++qb) {
        const float lt = l_run[qb] + xhalf(l_run[qb], lane_e >> 5); const float inv = 1.f / lt;
        if ((wid_e >> 2) == 1) { const float sc = -lam * inv;
#pragma unroll
            for (int c = 0; c < 4; ++c)
#pragma unroll
                for (int i = 0; i < 16; ++i) xch[(c * 16 + i) * 64] = O[qb][c][i] * sc; }
        LDS_WAIT(); __syncthreads();
        if ((wid_e >> 2) == 0) {
            float ss = 0.f;
#pragma unroll
            for (int c = 0; c < 4; ++c)
#pragma unroll
                for (int i = 0; i < 16; ++i) { const float o = O[qb][c][i] * inv + xch[(c * 16 + i) * 64]; O[qb][c][i] = o; ss += o * o; }
            ss += xhalf(ss, lane_e >> 5);
            const float rs = post / sqrtf(ss * (1.f / 128.f) + EPS);
            bf16_t* op = P + (size_t)(qrow0 + 64 * (wid_e & 3) + 32 * qb + (lane_e & 31)) * PW + PC_Q + h * 128;
#pragma unroll
            for (int c = 0; c < 4; ++c)
#pragma unroll
                for (int g = 0; g < 4; ++g) { const int v0 = 32 * c + 8 * g + 4 * (lane_e >> 5); const f32x4 w = *(const LAS f32x4*)(lds + AT_ANW + v0 * 4);
                    u32x2 o; o.x = cvt_pk_bf16(O[qb][c][4 * g] * rs * w[0], O[qb][c][4 * g + 1] * rs * w[1]); o.y = cvt_pk_bf16(O[qb][c][4 * g + 2] * rs * w[2], O[qb][c][4 * g + 3] * rs * w[3]);
                    *(u32x2*)(op + v0) = o; }
        }
        LDS_WAIT(); __syncthreads();
    }
}

constexpr int SC_Q = 0, SC_LF = 16384, SC_V0 = 32768, SC_QM = 65536, SC_KMR = 81920, SC_KMS = 98304, SC_SX = 114688, SC_A31 = 147456, SC_A63 = 147968, SC_END = 148480;
DI void scan_chain(const Ctx& C, bf16_t* P, int b, int h, int dir, bool store_ctx) {
    const int tid_ = my_tid();
    LAS unsigned char* lds = C.lds; const int lane = tid_ & 63, wid = __builtin_amdgcn_readfirstlane(tid_ >> 6), r32 = lane & 31, hh = lane >> 5;
    const int tq = (lane & 15) >> 2, tp = lane & 3, blk = (lane >> 4) & 1;
    const int db = wid & 3, tb = wid >> 2;
    const int base_nat = hh * 512 + tq * 64 + blk * 32 + tp * 8;
    const int base_prm = (4 * hh + tq) * 64 + blk * 32 + tp * 8;
    const int lfcol = (dir ? PC_LB : PC_LF) + h * 128, qcol = PC_RQ + h * 128, vcol = PC_RI + h * 128;
    f32x16 ST[2];
#pragma unroll
    for (int j = 0; j < 2; ++j)
#pragma unroll
        for (int i = 0; i < 16; ++i) ST[j][i] = 0.f;
#define SROW(c, i) ((c) < 4 ? NLAT + b * CL + (dir ? 255 - ((c) * 64 + (i)) : (c) * 64 + (i)) : b * T + (dir ? 2047 - (((c) - 4) * 64 + (i)) : ((c) - 4) * 64 + (i)))
#define SDMA(c, colbase, dstoff) do { _Pragma("unroll") for (int j_ = 0; j_ < 2; ++j_) { const int I_ = 2 * wid + j_; const int ti_ = 16 * (I_ & 3) + (lane >> 2); \
        dma16(P + (size_t)SROW(c, ti_) * PW + (colbase) + (I_ >> 2) * 32 + (lane & 3) * 8, lds + (dstoff) + I_ * 1024); } } while (0)
    SDMA(0, qcol, SC_Q); SDMA(0, lfcol, SC_LF); SDMA(0, vcol, SC_V0);
    int vbuf = 0;
    const int t = 32 * tb + r32;
#pragma unroll 1
    for (int c = 0; c < 36; ++c) {
        { const int st_ = __builtin_amdgcn_readfirstlane((c > 0 && (c > 4 || store_ctx)) ? 1 : 0);
          asm volatile("s_cmp_lg_u32 %0, 0\n\ts_cbranch_scc1 1f\n\ts_waitcnt vmcnt(0)\n1:\n\ts_waitcnt vmcnt(4)" :: "s"(st_) : "memory", "scc"); }
        LDS_BARRIER();
        const LAS unsigned char* Vimg = lds + SC_V0 + vbuf * 16384;
        f32x16 cm;
#pragma unroll
        for (int i = 0; i < 16; ++i) cm[i] = 0.f;
#pragma unroll
        for (int kk = 0; kk < 2; ++kk) { const int ks = 2 * tb + kk;
            const half8 a = __builtin_bit_cast(half8, cat8(tr16(lds + SC_LF + db * 4096 + base_nat + ks * 1024), tr16(lds + SC_LF + db * 4096 + base_nat + ks * 1024 + 256)));
            half8 bm;
#pragma unroll
            for (int j = 0; j < 8; ++j) { const int s = 16 * ks + 8 * hh + j; bm[j] = tb == 0 ? (s > t ? (_Float16)-1.f : (_Float16)0.f) : (s <= t ? (_Float16)1.f : (_Float16)0.f); }
            cm = __builtin_amdgcn_mfma_f32_32x32x16_f16(a, bm, cm, 0, 0, 0); }
#pragma unroll
        for (int g = 0; g < 4; ++g) {
            const int sa = db * 4096 + (t >> 3) * 512 + (t & 7) * 64 + (8 * g + 4 * hh) * 2;
            const u32x2 q4 = *(const LAS u32x2*)(lds + SC_Q + sa); const half4 lf4 = *(const LAS half4*)(lds + SC_LF + sa);
            const float qv[4] = {bflo(q4.x), bfhi(q4.x), bflo(q4.y), bfhi(q4.y)};
            float qm[4], km[4];
#pragma unroll
            for (int e = 0; e < 4; ++e) { const float cv = cm[4 * g + e] * LOG2E; const float E = __builtin_amdgcn_exp2f(cv), Ei = __builtin_amdgcn_exp2f(-cv);
                const float lf = (float)lf4[e]; qm[e] = qv[e] * E; km[e] = (1.f - __builtin_amdgcn_exp2f(lf * LOG2E)) * Ei;
                if (tb == 0 && r32 == 0) ((LAS float*)(lds + SC_A31))[32 * db + 8 * g + 4 * hh + e] = lf - cm[4 * g + e];
                if (tb == 1 && r32 == 31) ((LAS float*)(lds + SC_A63))[32 * db + 8 * g + 4 * hh + e] = cm[4 * g + e]; }
            u32x2 qw2, kw2; qw2.x = cvt_pk_bf16(qm[0], qm[1]); qw2.y = cvt_pk_bf16(qm[2], qm[3]); kw2.x = cvt_pk_bf16(km[0], km[1]); kw2.y = cvt_pk_bf16(km[2], km[3]);
            const int ra = ((4 * db + g) * 64 + t) * 16 + 8 * hh;
            *(LAS u32x2*)(lds + SC_QM + ra) = qw2; *(LAS u32x2*)(lds + SC_KMR + ra) = kw2; *(LAS u32x2*)(lds + SC_KMS + sa) = kw2;
        }
        LDS_BARRIER();
        if (c + 1 < 36) { SDMA(c + 1, qcol, SC_Q); SDMA(c + 1, lfcol, SC_LF); SDMA(c + 1, vcol, SC_V0 + (vbuf ^ 1) * 16384); }
        { const int d = 32 * db + r32; const float c31 = ((LAS float*)(lds + SC_A31))[d], c63 = ((LAS float*)(lds + SC_A63))[d];
          const float e31 = __expf(c31), dec = __expf(c31 + c63), e63 = __expf(c63);
          f32x16 SN[2];
#pragma unroll
          for (int j = 0; j < 2; ++j) { const int vb2 = 2 * tb + j;
#pragma unroll
              for (int g = 0; g < 4; ++g) { u32x2 w; w.x = cvt_pk_bf16(ST[j][4 * g] * e31, ST[j][4 * g + 1] * e31); w.y = cvt_pk_bf16(ST[j][4 * g + 2] * e31, ST[j][4 * g + 3] * e31);
                  *(LAS u32x2*)(lds + SC_SX + vb2 * 8192 + (d >> 3) * 512 + (d & 7) * 64 + (8 * g + 4 * hh) * 2) = w; }
#pragma unroll
              for (int i = 0; i < 16; ++i) SN[j][i] = 0.f; }
#pragma unroll
          for (int ks = 0; ks < 4; ++ks) {
              const bf16x8 kf = cat8(tr16(lds + SC_KMS + db * 4096 + base_nat + ks * 1024), tr16(lds + SC_KMS + db * 4096 + base_nat + ks * 1024 + 256));
#pragma unroll
              for (int j = 0; j < 2; ++j) { const int vb2 = 2 * tb + j;
                  const bf16x8 vf = cat8(tr16(Vimg + vb2 * 4096 + base_nat + ks * 1024), tr16(Vimg + vb2 * 4096 + base_nat + ks * 1024 + 256));
                  SN[j] = MFMA32(vf, kf, SN[j]); } }
#pragma unroll
          for (int j = 0; j < 2; ++j)
#pragma unroll
              for (int i = 0; i < 16; ++i) ST[j][i] = dec * ST[j][i] + e63 * SN[j][i];
        }
        LDS_BARRIER();
        { bf16x8 Qmf[8];
#pragma unroll
          for (int kd = 0; kd < 8; ++kd) Qmf[kd] = *(const LAS bf16x8*)(lds + SC_QM + ((2 * kd + hh) * 64 + t) * 16);
          f32x16 o;
#pragma unroll
          for (int i = 0; i < 16; ++i) o[i] = 0.f;
          for (int sb = 0; sb <= tb; ++sb) {
              f32x16 pt;
#pragma unroll
              for (int i = 0; i < 16; ++i) pt[i] = 0.f;
#pragma unroll
              for (int kd = 0; kd < 8; ++kd) { const bf16x8 a = *(const LAS bf16x8*)(lds + SC_KMR + ((2 * kd + hh) * 64 + 32 * sb + r32) * 16); pt = MFMA32(a, Qmf[kd], pt); }
              if (sb == tb) {
#pragma unroll
                  for (int i = 0; i < 16; ++i) if (crow(i, hh) > r32) pt[i] = 0.f; }
              const bf16x8 p0 = packf8(pt, 0), p1 = packf8(pt, 1);
              { const bf16x8 a = cat8(tr16(Vimg + db * 4096 + base_prm + (2 * sb) * 1024), tr16(Vimg + db * 4096 + base_prm + (2 * sb) * 1024 + 512)); o = MFMA32(a, p0, o); }
              { const bf16x8 a = cat8(tr16(Vimg + db * 4096 + base_prm + (2 * sb + 1) * 1024), tr16(Vimg + db * 4096 + base_prm + (2 * sb + 1) * 1024 + 512)); o = MFMA32(a, p1, o); }
          }
#pragma unroll
          for (int kd = 0; kd < 8; ++kd) { const bf16x8 a = cat8(tr16(lds + SC_SX + db * 8192 + base_nat + kd * 1024), tr16(lds + SC_SX + db * 8192 + base_nat + kd * 1024 + 256)); o = MFMA32(a, Qmf[kd], o); }
          if (c >= 4 || store_ctx) { bf16_t* op = P + (size_t)SROW(c, t) * PW + lfcol + 32 * db;
#pragma unroll
              for (int g = 0; g < 4; ++g) { u32x2 w; w.x = cvt_pk_bf16(o[4 * g], o[4 * g + 1]); w.y = cvt_pk_bf16(o[4 * g + 2], o[4 * g + 3]); *(u32x2*)(op + 8 * g + 4 * hh) = w; } }
        }
        vbuf ^= 1;
    }
    VM_WAIT(); LDS_WAIT(); __syncthreads();
#undef SROW
#undef SDMA
}

DI void phase_recprep(const Ctx& C, bf16_t* P, const float* rnw, int nrows) {
    const f32x4 w0 = *(const f32x4*)(rnw + ((8 * C.lane) & 127)), w1 = *(const f32x4*)(rnw + ((8 * C.lane) & 127) + 4);
    u32x4 qa[4], qb[4], qg[4];
#define RP_LOADS(r0_) do { _Pragma("unroll") for (int u = 0; u < 4; ++u) { const int row_ = (r0_) + u * C.NGW < nrows ? (r0_) + u * C.NGW : (r0_); const bf16_t* pr_ = P + (size_t)row_ * PW + 8 * C.lane; \
            qa[u] = *(const u32x4*)(pr_ + PC_LF); qb[u] = *(const u32x4*)(pr_ + PC_LB); qg[u] = *(const u32x4*)(pr_ + PC_G); } } while (0)
    if (C.gw < nrows) RP_LOADS(C.gw);
    for (int row0 = C.gw; row0 < nrows; row0 += 4 * C.NGW) {
        u32x4 ra[4], rb[4], rg[4];
#pragma unroll
        for (int u = 0; u < 4; ++u) { ra[u] = qa[u]; rb[u] = qb[u]; rg[u] = qg[u]; }
        if (row0 + 4 * C.NGW < nrows) RP_LOADS(row0 + 4 * C.NGW);
#pragma unroll
        for (int u = 0; u < 4; ++u) { const int row = row0 + u * C.NGW; if (row >= nrows) break;
            float a[8], bb[8], g[8]; unpack8(ra[u], a); unpack8(rb[u], bb); unpack8(rg[u], g);
            float ss = 0.f;
#pragma unroll
            for (int j = 0; j < 8; ++j) { a[j] += bb[j]; ss += a[j] * a[j]; }
            ss += __shfl_xor(ss, 1); ss += __shfl_xor(ss, 2); ss += __shfl_xor(ss, 4); ss += __shfl_xor(ss, 8);
            const float rs = 1.0f / sqrtf(ss * (1.f / 128.f) + EPS);
            f32x4 o0, o1;
#pragma unroll
            for (int j = 0; j < 4; ++j) { o0[j] = a[j] * rs * w0[j] * g[j]; o1[j] = a[4 + j] * rs * w1[j] * g[4 + j]; }
            *(u32x4*)(P + (size_t)row * PW + 8 * C.lane + PC_LF) = pack8(o0, o1); }
    }
#undef RP_LOADS
}

DI void phase_slots(const Ctx& C, const int* cnt, int* pbout, unsigned char* route, const bf16_t* H2, bf16_t* AG, LAS int* cur) {
    if (C.tid < 16) cur[C.tid] = 0;
    __syncthreads();
    for (int g = C.tid; g < C.G; g += 512) {
#pragma unroll
        for (int k = 0; k < 8; ++k) { const int c = cnt[g * 8 + k]; atomicAdd((int*)&cur[8 + k], c); if (g < C.bx) atomicAdd((int*)&cur[k], c); } }
    __syncthreads();
    if (C.tid < 8) { const int e = C.tid; int pb = 0, pbe = 0;
#pragma unroll
        for (int k = 0; k < 8; ++k) { if (k == e) pbe = pb; pb += (cur[8 + k] + 255) >> 8; }
        const int mine = cur[e];
        if (C.bx == 0) { pbout[e] = pbe; if (e == 7) pbout[8] = pb; }
        cur[e] = pbe * 256 + mine;
    }
    __syncthreads();
    const int nloc = (NLAT - C.gw + C.NGW - 1) / C.NGW;
    LAS int* tab = (LAS int*)(C.lds + C.wave * 2048);
    for (int i = C.lane; i < nloc; i += 64) { int* rt = (int*)(route + (size_t)(C.gw + i * C.NGW) * 24);
        const int s1 = atomicAdd((int*)&cur[rt[0]], 1), s2 = atomicAdd((int*)&cur[rt[1]], 1); rt[4] = s1; rt[5] = s2; tab[2 * i] = s1; tab[2 * i + 1] = s2; }
    LDS_WAIT();
    for (int i0 = 0; i0 < nloc; i0 += 8) {
        u32x4 vr[8];
#pragma unroll
        for (int k = 0; k < 8; ++k) { const int i = i0 + k < nloc ? i0 + k : i0; vr[k] = *((const u32x4*)((const unsigned char*)H2 + (size_t)(C.gw + i * C.NGW) * D) + C.lane); }
#pragma unroll
        for (int k = 0; k < 8; ++k) { if (i0 + k >= nloc) break;
            const int s1 = __builtin_amdgcn_readfirstlane(tab[2 * (i0 + k)]), s2 = __builtin_amdgcn_readfirstlane(tab[2 * (i0 + k) + 1]);
            *((u32x4*)((unsigned char*)AG + (size_t)s1 * D) + C.lane) = vr[k]; *((u32x4*)((unsigned char*)AG + (size_t)s2 * D) + C.lane) = vr[k]; }
    }
}
DI void phase_final(const Ctx& C, float* x, const unsigned char* route, const bf16_t* Y, const float* mods1, const float* fw) {
    for (int row0 = C.gw; row0 < NLAT; row0 += 2 * C.NGW) {
        const int rows[2] = {row0, row0 + C.NGW < NLAT ? row0 + C.NGW : row0};
        f32x4 v[2][4]; float ss[2] = {0.f, 0.f};
#pragma unroll
        for (int u = 0; u < 2; ++u) { const int row = rows[u];
            const int* rt = (const int*)(route + (size_t)row * 24); const float g1 = ((const float*)rt)[2], g2 = ((const float*)rt)[3]; const int s1 = rt[4], s2 = rt[5];
            const float* mv = mods1 + (size_t)(row >> 11) * DIN + 5 * D; const float* xr = x + (size_t)row * D;
#pragma unroll
            for (int j = 0; j < 4; ++j) { const int c0 = 256 * j + 4 * C.lane;
                const u32x2 y1 = *(const u32x2*)(Y + (size_t)s1 * D + c0), y2 = *(const u32x2*)(Y + (size_t)s2 * D + c0); const f32x4 m5 = *(const f32x4*)(mv + c0);
                f32x4 y; y[0] = g1 * bflo(y1.x) + g2 * bflo(y2.x); y[1] = g1 * bfhi(y1.x) + g2 * bfhi(y2.x); y[2] = g1 * bflo(y1.y) + g2 * bflo(y2.y); y[3] = g1 * bfhi(y1.y) + g2 * bfhi(y2.y);
                v[u][j] = *(const f32x4*)(xr + c0) + m5 * y; ss[u] += (v[u][j][0] * v[u][j][0] + v[u][j][1] * v[u][j][1]) + (v[u][j][2] * v[u][j][2] + v[u][j][3] * v[u][j][3]); } }
#pragma unroll
        for (int u = 0; u < 2; ++u) { if (u == 1 && rows[1] == rows[0]) break;
            const float rstd = 1.0f / sqrtf(wave_sum(ss[u]) * (1.f / D) + EPS); float* xr = x + (size_t)rows[u] * D;
#pragma unroll
            for (int j = 0; j < 4; ++j) { const int c0 = 256 * j + 4 * C.lane; *(f32x4*)(xr + c0) = v[u][j] * rstd * *(const f32x4*)(fw + c0); } }
    }
}

constexpr int LDS_MISC = SC_END;
constexpr int LDS_BYTES = SC_END + 512;
static_assert(LDS_WTAB_OFF == SC_END + 128, "wave table sits behind the barrier words and counters");
constexpr int NPHASE = 20;

DI Ctx make_ctx() {
    extern __shared__ __attribute__((aligned(16))) unsigned char lds_raw[];
    Ctx C; const int t = my_tid();
    unsigned lb = (unsigned)(size_t)(LAS unsigned char*)lds_raw; asm volatile("" : "+s"(lb));
    C.lds = (LAS unsigned char*)(size_t)lb; C.ws = kparams()->ws; C.tid = t; C.lane = t & 63; C.wave = __builtin_amdgcn_readfirstlane(t >> 6);
    int bx = blockIdx.x, G = gridDim.x; asm volatile("" : "+s"(bx), "+s"(G));
    C.bx = bx; C.G = G; C.vcu = (C.G % 8 == 0) ? (bx % 8) * (C.G / 8) + bx / 8 : bx;
    C.gw = C.vcu * 8 + C.wave; C.NGW = C.G * 8;
    return C;
}
DI void grid_barrier() {
    extern __shared__ __attribute__((aligned(16))) unsigned char lds_raw[];
    XcdBarrier b; b.bar = (unsigned*)(kparams()->ws + WS_CTL) + CW_BAR + kparams()->li * XCD_BAR_WORDS; b.x = xb_xcc_id(); b.st = (volatile LAS unsigned*)((LAS unsigned char*)lds_raw + LDS_MISC);
    xcd_barrier(b);
}
#define WSP(T, off) ((T*)(kparams()->ws + (off)))

#define IN(k) (kparams()->ph_lo <= (k) && (k) < kparams()->ph_hi)
#define SEAM(k) do { if (IN(k) && IN((k) + 1)) grid_barrier(); } while (0)


template <int l> DI void layer_phases() {
        constexpr int FS = l == 0 ? FP8_SECS0 : FP8_SECS1, N_SEC_F8 = n_sec_f8(FS), N_SEC_BF = 8 - N_SEC_F8;
        const int pb = 1 + 9 * l;
#define LQ() int lq = l; asm volatile("" : "+s"(lq))
#define XL (lq == 0 ? PIN(0) : (const float*)POUT)
#define XC (lq == 0 ? PIN(2) : (const float*)WSP(float, WS_CTXRES))
#define LMODS (WSP(float, WS_MODS) + (size_t)lq * 33 * DIN)
#define NROWS_OUT (lq == 0 ? NTOK : NLAT)
        if constexpr (l == 0) {
        if (IN(pb + 0)) { LQ(); const Ctx C = make_ctx(); phase_norm<false>(C, XL, XC, PIN(6) + lq * D, LMODS, 0, NTOK, WSP(bf16_t, WS_H), nullptr, nullptr, nullptr, WSP(unsigned char, WS_H8)); }
        SEAM(pb + 0); }
        if (IN(pb + 1)) { LQ();
            { const Ctx C = make_ctx();
              Gemm g{WSP(bf16_t, WS_H), WSP(bf16_t, WS_WIN) + (size_t)lq * 4096 * D, NTOK, N_SEC_BF * 512, D, D};
              pg8::StaticOrder S; S.init(g, C.G, C.bx);
              EpiInProjT<l == 1> E{WSP(bf16_t, WS_P), WSP(float2, WS_ROPE), WSP(float, WS_LBS) + lq * 1024, WSP(float, WS_LBS) + lq * 1024 + 512, (int)secmap_of(FS, false), 1.f, WSP(unsigned, WS_RS1), WSP(float, WS_BIASI)};
              pg8::gemm_phase<EpiInProjT<l == 1>, pg8::StaticOrder>(C.lds, g, S, E); }
            if (N_SEC_F8 > 0) { const Ctx C = make_ctx();
              Gemm g{WSP(bf16_t, WS_H8), (const bf16_t*)(WSP(unsigned char, WS_WIN8) + (size_t)lq * 4096 * D), NTOK, N_SEC_F8 * 512, D / 2, D / 2};
              pg8::StaticOrder S; S.init(g, C.G, C.bx);
              EpiInProjT<l == 1> E{WSP(bf16_t, WS_P), WSP(float2, WS_ROPE), WSP(float, WS_LBS) + lq * 1024, WSP(float, WS_LBS) + lq * 1024 + 512, (int)secmap_of(FS, true), 1.f / WIN8_SCALE, WSP(unsigned, WS_RS1), WSP(float, WS_BIASI) + N_SEC_BF * 512};
              pg8::gemm_phase<EpiInProjT<l == 1>, pg8::StaticOrder, true, true>(C.lds, g, S, E); }
        }
        SEAM(pb + 1);
        if (IN(pb + 2)) { LQ(); const Ctx C = make_ctx(); bf16_t* const Pb = WSP(bf16_t, WS_P);
            for (int id = C.vcu; id < NB * 4 * 2; id += C.G) scan_chain(C, Pb, id >> 3, (id >> 1) & 3, id & 1, lq == 0);
            float lam;
            { const float a = wave_sum(PIN(9)[lq * 64 + C.lane] * PIN(10)[lq * 64 + C.lane]), b2 = wave_sum(PIN(11)[lq * 64 + C.lane] * PIN(12)[lq * 64 + C.lane]);
              const float li = 0.8f - 0.6f * expf(-0.3f * (float)lq); lam = expf(a) - expf(b2) + li; lam = __uint_as_float(__builtin_amdgcn_readfirstlane(__float_as_uint(lam))); }
            const float post = __uint_as_float(__builtin_amdgcn_readfirstlane(__float_as_uint(1.f - (0.8f - 0.6f * expf(-0.3f * (float)lq)))));
            const float* anw = PIN(13) + lq * 128;
            const int NU = NB * 4 * 8, U = (NU + C.G - 1) / C.G;
            for (int id = C.vcu * U; id < NU && id < (C.vcu + 1) * U; ++id) { const int bh = id >> 3, qb = id & 7, b = bh >> 2, h = bh & 3;
                attn_unit(C, Pb, b * T + qb * 256, NLAT + b * CL, b * T, 36, h, lam, anw, post); }
            if (lq == 0) for (int id = C.vcu; id < NB * 4; id += C.G) { const int b = id >> 2, h = id & 3;
                attn_unit(C, Pb, NLAT + b * CL, NLAT + b * CL, 0, 4, h, lam, anw, post); }
        }
        if (l == 0) { if (IN(pb + 2)) { Ctx C = make_ctx();
            if (C.G <= NB * 4) phase_prologue_deferred(C);
            else if (C.vcu >= NB * 4) { C.gw = (C.vcu - NB * 4) * 8 + C.wave; C.NGW = (C.G - NB * 4) * 8; phase_prologue_deferred(C); } } }
        if (l == 0) { if (IN(pb + 2)) { const Ctx C = make_ctx();
            const int nfree = C.G > NB * 4 ? C.G - NB * 4 : C.G, first = C.G > NB * 4 ? NB * 4 : 0;
            if (C.vcu >= first) for (int t = C.vcu - first; t < 86; t += nfree) phase_rowgemm<1>(C, t);
            if (C.vcu == C.G - 1) { float* bf = WSP(float, WS_BIASF); for (int i = C.tid; i < 33 * (2 * DFFP - 2 * DFF); i += 512) bf[(size_t)(i / (2 * DFFP - 2 * DFF)) * (2 * DFFP) + 2 * DFF + i % (2 * DFFP - 2 * DFF)] = 0.f; } } }
        SEAM(pb + 2);
        if (IN(pb + 3)) { LQ(); const Ctx C = make_ctx();
            phase_recprep(C, WSP(bf16_t, WS_P), PIN(14) + lq * 128, NROWS_OUT);
            Gemm g{WSP(bf16_t, WS_H8), (const bf16_t*)(WSP(unsigned char, WS_WIN8) + ((size_t)lq * 4096 + N_SEC_F8 * 512) * D), NROWS_OUT, 2048, D / 2, D / 2};
            pg8::StaticOrder S; S.init(g, C.G, C.bx);
            EpiGatesT<l == 1> E{WSP(bf16_t, WS_P), 1.f / WIN8_SCALE, WSP(unsigned, WS_RS1), WSP(float, WS_BIASI) + 4096};
            pg8::gemm_phase<EpiGatesT<l == 1>, pg8::StaticOrder, true, true>(C.lds, g, S, E);
        }
        SEAM(pb + 3);
        if (IN(pb + 4)) { LQ(); const Ctx C = make_ctx();
            Gemm g{WSP(bf16_t, WS_P) + PC_Q, WSP(bf16_t, WS_WUA) + (size_t)lq * D * D, NROWS_OUT, D, D, PW};
            pg8::StaticOrder S; S.init(g, C.G, C.bx); EpiMergeFused E{WSP(bf16_t, WS_P), WSP(bf16_t, WS_MERGED)};
            pg8::gemm_phase<EpiMergeFused, pg8::StaticOrder, true, false, true>(C.lds, g, S, E);
            if constexpr (l == 0) { const int first_idle = S.nwg % C.G; __syncthreads();
                if (first_idle > 0) { if (C.bx >= first_idle) for (int t = C.bx - first_idle; t < 96; t += C.G - first_idle) phase_rowgemm<2>(C, t); }
                else for (int t = C.bx; t < 96; t += C.G) phase_rowgemm<2>(C, t); }
        }
        SEAM(pb + 4);
        if (IN(pb + 5)) { LQ(); const Ctx C = make_ctx();
            Gemm g{WSP(bf16_t, WS_MERGED), WSP(bf16_t, WS_WO) + (size_t)lq * D * D, NROWS_OUT, D, D, D};
            pg8::StaticOrder S; S.init(g, C.G, C.bx);
            if constexpr (l == 0) { EpiResidN<false> E{XL, XC, POUT, WSP(float, WS_CTXRES), LMODS, 2, PIN(7), LMODS, 4, WSP(bf16_t, WS_AN), nullptr, WSP(unsigned, WS_RS0)};
                pg8::gemm_phase<EpiResidN<false>, pg8::StaticOrder>(C.lds, g, S, E); }
            else { EpiResid E{XL, XC, POUT, WSP(float, WS_CTXRES), LMODS, 2};
                pg8::gemm_phase<EpiResid, pg8::StaticOrder>(C.lds, g, S, E); }
        }
        SEAM(pb + 5);
        if (l == 0) {
            if (IN(8)) { LQ(); const Ctx C = make_ctx();
                Gemm g{WSP(bf16_t, WS_AN), WSP(bf16_t, WS_W13), NTOK, 2 * DFFP, D, D};
                pg8::StaticOrder S; S.init(g, C.G, C.bx); EpiSwiglu E{WSP(bf16_t, WS_HID), DFFP, 0, WSP(unsigned, WS_RS0), WSP(float, WS_BIASF)};
                pg8::gemm_phase<EpiSwiglu, pg8::StaticOrder>(C.lds, g, S, E);
            }
            SEAM(8);
            if (IN(9)) { LQ(); const Ctx C = make_ctx();
                Gemm g{WSP(bf16_t, WS_HID), WSP(bf16_t, WS_W2), NTOK, D, DFFP, DFFP};
                pg8::StaticOrder S; S.init(g, C.G, C.bx);
                EpiResidN<true> E{POUT, WSP(float, WS_CTXRES), POUT, WSP(float, WS_CTXRES), LMODS, 5, PIN(6) + D, WSP(float, WS_MODS) + (size_t)33 * DIN, 1, WSP(bf16_t, WS_H), WSP(unsigned char, WS_H8), WSP(unsigned, WS_RS1)};
                pg8::gemm_phase<EpiResidN<true>, pg8::StaticOrder>(C.lds, g, S, E);
                { const int rem = S.nwg % C.G, first_idle = rem; if (C.bx >= first_idle) convert_moe_weights(C, (C.bx - first_idle) * 8 + C.wave, (C.G - first_idle) * 8); }
            }
            SEAM(9);
        } else {
            if (IN(16)) { LQ(); const Ctx C = make_ctx(); LAS int* lcnt = (LAS int*)(C.lds + LDS_MISC + 32);
                if (C.tid < 8) lcnt[C.tid] = 0;
                __syncthreads();
                phase_norm<true>(C, POUT, nullptr, PIN(7) + D, LMODS, 3, NLAT, WSP(bf16_t, WS_H2M), PIN(23), WSP(unsigned char, WS_ROUTE), lcnt);
                __syncthreads();
                if (C.tid < 8) WSP(int, WS_CNT)[C.bx * 8 + C.tid] = lcnt[C.tid];
            }
            SEAM(16);
            if (IN(17)) { LQ(); const Ctx C = make_ctx(); phase_slots(C, WSP(int, WS_CNT), WSP(int, WS_CNT) + 4096, WSP(unsigned char, WS_ROUTE), WSP(bf16_t, WS_H2M), WSP(bf16_t, WS_AG), (LAS int*)(C.lds + LDS_MISC + 32)); }
            SEAM(17);
            if (IN(18)) { LQ();
                const int ptot = __builtin_amdgcn_readfirstlane(WSP(int, WS_CNT)[4096 + 8]);
                for (int p0 = 0, np_ = 0; p0 < ptot; p0 += np_) {
                    const int np = (ptot - p0) <= MOE_CHUNK + 16 ? (ptot - p0) : MOE_CHUNK; np_ = np;
#define MOE_ORDER_INIT(S) do { S.so.init(g, C.G, C.bx); S.p0 = p0; S.load_pb(WSP(int, WS_CNT) + 4096); } while (0)
                    { const Ctx C = make_ctx(); Gemm g{WSP(bf16_t, WS_AG), WSP(bf16_t, WS_WM13), np * 256, 2 * DFE, D / 2, D / 2};
                      pg8::MoeOrder S; MOE_ORDER_INIT(S); S.apan0 = 0; S.estride = (size_t)2 * DFE * D;
                      EpiSwiglu8 E{WSP(unsigned char, WS_MHID), DFE, p0, 1.f / W13_SCALE, HID_SCALE};
                      pg8::gemm_phase<EpiSwiglu8, pg8::MoeOrder, true, true>(C.lds, g, S, E); }
                    grid_barrier();
                    { const Ctx C = make_ctx(); Gemm g{WSP(bf16_t, WS_MHID), WSP(bf16_t, WS_WM2), np * 256, D, DFE / 2, DFE / 2};
                      pg8::MoeOrder S; MOE_ORDER_INIT(S); S.apan0 = p0; S.estride = (size_t)D * DFE;
                      EpiBf16 E{WSP(bf16_t, WS_Y), D, 1.f / (W2_SCALE * HID_SCALE)};
                      pg8::gemm_phase<EpiBf16, pg8::MoeOrder, true, true>(C.lds, g, S, E); }
                    grid_barrier();
                }
            }
            if (IN(19)) { LQ(); const Ctx C = make_ctx(); phase_final(C, POUT, WSP(unsigned char, WS_ROUTE), WSP(bf16_t, WS_Y), LMODS, PIN(27)); }
        }
}

__global__ void __launch_bounds__(512, 2) fwd_kernel(Params p) {
    extern __shared__ __attribute__((aligned(16))) unsigned char lds_raw[];
    (void)p;
    { volatile LAS unsigned* misc = (volatile LAS unsigned*)((LAS unsigned char*)lds_raw + LDS_MISC);
      if (threadIdx.x < 16) misc[threadIdx.x] = 0u;
      if ((threadIdx.x & 63) == 0) ((volatile LAS int*)((LAS unsigned char*)lds_raw + LDS_WTAB_OFF))[(unsigned)__builtin_amdgcn_s_getreg((5 << 11) | 4) & 63u] = threadIdx.x >> 6;
      __syncthreads();
      (void)xcd_barrier_post((unsigned*)(kparams()->ws + WS_CTL) + CW_BAR + kparams()->li * XCD_BAR_WORDS, misc); }
    if (IN(0)) { const Ctx C = make_ctx(); phase_prologue(C); } SEAM(0);

    layer_phases<0>();
    layer_phases<1>();
#undef IN
#undef SEAM
}


extern "C" void kernel_launch(void* const* d_in, const int* in_sizes, int n_in, void* d_out, int out_size, void* d_ws, size_t ws_size, hipStream_t stream) {
    static int grid = 0;
    if (grid == 0) {
        if (n_in != 28 || out_size != NLAT * D || ws_size < WS_END) { fprintf(stderr, "kernel_launch: unexpected problem (n_in %d, out %d, ws %zu)\n", n_in, out_size, ws_size); grid = -1; return; }
        int dev = 0, cus = 0, per_cu = 0;
        if (hipGetDevice(&dev) != hipSuccess || hipDeviceGetAttribute(&cus, hipDeviceAttributeMultiprocessorCount, dev) != hipSuccess) { grid = -1; return; }
        if (hipFuncSetAttribute((const void*)fwd_kernel, hipFuncAttributeMaxDynamicSharedMemorySize, LDS_BYTES) != hipSuccess) { fprintf(stderr, "kernel_launch: cannot set %d B dynamic LDS\n", LDS_BYTES); grid = -1; return; }
        if (hipOccupancyMaxActiveBlocksPerMultiprocessor(&per_cu, (const void*)fwd_kernel, 512, LDS_BYTES) != hipSuccess || per_cu < 1) fprintf(stderr, "kernel_launch: occupancy query says %d\n", per_cu);
        (void)hipGetLastError();
        grid = cus;
    }
    if (grid < 0) return;
    (void)hipMemsetAsync((char*)d_ws + WS_CTL, 0, CTL_BYTES, stream);
    Params a{};
    for (int i = 0; i < 28; ++i) a.in[i] = (const float*)d_in[i];
    a.out = (float*)d_out; a.ws = (unsigned char*)d_ws; a.ph_lo = 0; a.ph_hi = NPHASE; a.li = 0; a.pad = 0;
    hipLaunchKernelGGL(fwd_kernel, dim3(grid), dim3(512), LDS_BYTES, stream, a);
}
```
